# Optimizing an MI355X kernel written in HIP

```python
import jax, jax.numpy as jnp
from jax import lax
import numpy as np

D_MODEL = 1024
BATCH = 8
SEQ = 4096
DEPTH = 1

CTX_LEN = 256
GRID_W = 64
EPS = 1e-6
CHUNK = 128
A_GROUPS = 8
A_WIDTH = 1024
A_GROUP_DIM = A_WIDTH // A_GROUPS
N_HEADS = 16
N_KV_HEADS = 4
HEAD_DIM = 64
B_WIDTH = N_HEADS * HEAD_DIM
KV_WIDTH = N_KV_HEADS * HEAD_DIM
WINDOW = 128
BLOCK = 128
ROPE_BASE = 10000.0
N_EXPERTS = 16
CAPACITY_FACTOR = 2
D_EXPERT = 2048
OFF_U = 0
OFF_VA = OFF_U + A_WIDTH
OFF_Q = OFF_VA + A_WIDTH
OFF_K = OFF_Q + B_WIDTH
OFF_VB = OFF_K + KV_WIDTH
OFF_GATE = OFF_VB + KV_WIDTH
IN_COLS = OFF_GATE + 2 * D_MODEL

kernel_name = "hybrid_gmlp_window_gqa_ec_moe_dit"


def rmsnorm(x, g):
    xf = x.astype(jnp.float32)
    y = xf * lax.rsqrt(jnp.mean(xf * xf, axis=-1, keepdims=True) + EPS)
    return (y * g.astype(jnp.float32)).astype(x.dtype)


def layernorm(x, g, b):
    xf = x.astype(jnp.float32)
    mu = jnp.mean(xf, axis=-1, keepdims=True)
    var = jnp.mean(jnp.square(xf - mu), axis=-1, keepdims=True)
    y = (xf - mu) * lax.rsqrt(var + EPS)
    return (y * g.astype(jnp.float32) + b.astype(jnp.float32)).astype(x.dtype)


def modulate(h, shift, scale):
    return h * (1 + scale) + shift


def _axis_angles(pos, dim):
    freqs = ROPE_BASE ** (-jnp.arange(0, dim, 2, dtype=jnp.float32) / dim)
    return pos.astype(jnp.float32)[:, None] * freqs[None, :]


def _rotate(x, ang):
    x1, x2 = jnp.split(x.astype(jnp.float32), 2, axis=-1)
    cos = jnp.cos(ang)[None, :, None, :]
    sin = jnp.sin(ang)[None, :, None, :]
    return jnp.concatenate([x1 * cos - x2 * sin, x1 * sin + x2 * cos], axis=-1)


def rope_2d(x, row, col):
    half = x.shape[-1] // 2
    xr, xc = x[..., :half], x[..., half:]
    out = jnp.concatenate([_rotate(xr, _axis_angles(row, half)),
                           _rotate(xc, _axis_angles(col, half))], axis=-1)
    return out.astype(x.dtype)


def chunk_gmlp(u, v, ln_g, ln_b, w_s, b_s):
    Bn, L, _ = v.shape
    v = layernorm(v, ln_g, ln_b)
    vc = v.reshape(Bn, L // CHUNK, CHUNK, A_GROUPS, A_GROUP_DIM)
    mixed = jnp.einsum('gpq,bnqgd->bnpgd', w_s, vc) + b_s.T[None, None, :, :, None]
    return u * mixed.reshape(Bn, L, A_WIDTH)


def window_gqa(q, k, v, k_ctx, v_ctx, sink):
    Bn, L, H, Dh = q.shape
    nb = L // BLOCK
    rep = H // N_KV_HEADS
    scale = HEAD_DIM ** -0.5
    qb = q.reshape(Bn, nb, BLOCK, N_KV_HEADS, rep, Dh)

    def band(t):
        tb = t.reshape(Bn, nb, BLOCK, N_KV_HEADS, Dh)
        tp = jnp.pad(tb, ((0, 0), (1, 1), (0, 0), (0, 0), (0, 0)))
        return jnp.concatenate([tp[:, :-2], tp[:, 1:-1], tp[:, 2:]], axis=2)

    kb, vb = band(k), band(v)
    a_idx = jnp.arange(BLOCK)[:, None]
    s_idx = jnp.arange(3 * BLOCK)[None, :]
    rel = s_idx - BLOCK - a_idx
    sink_l = sink.astype(jnp.float32).reshape(N_KV_HEADS, rep)[None, :, :, None, None]
    vals_ctx = v_ctx.astype(jnp.float32)

    def one_block(args):
        n, qn, kn, vn = args
        key_pos = (n - 1) * BLOCK + s_idx
        mask = (jnp.abs(rel) <= WINDOW) & (key_pos >= 0) & (key_pos < L)
        s_loc = jnp.einsum('bqkrd,bskd->bkrqs', qn, kn, preferred_element_type=jnp.float32) * scale
        s_loc = jnp.where(mask, s_loc, jnp.float32(-1e30))
        s_ctx = jnp.einsum('bqkrd,bskd->bkrqs', qn, k_ctx, preferred_element_type=jnp.float32) * scale
        logits = jnp.concatenate([s_loc, s_ctx], axis=-1)
        m = jnp.maximum(jnp.max(logits, axis=-1, keepdims=True), sink_l)
        p = jnp.exp(logits - m)
        denom = jnp.sum(p, axis=-1, keepdims=True) + jnp.exp(sink_l - m)
        vals = jnp.concatenate([vn.astype(jnp.float32), vals_ctx], axis=1)
        out = jnp.einsum('bkrqs,bskd->bqkrd', p / denom, vals)
        return out.astype(q.dtype)

    xs = (jnp.arange(nb), jnp.moveaxis(qb, 1, 0), jnp.moveaxis(kb, 1, 0), jnp.moveaxis(vb, 1, 0))
    out = lax.map(one_block, xs)
    return jnp.moveaxis(out, 0, 1).reshape(Bn, L, H * Dh)


def expert_choice_ffn(h, w_router, w_gate, w_up, w_down):
    Bn, N, D = h.shape
    cap = max(1, CAPACITY_FACTOR * N // N_EXPERTS)
    logits = jnp.einsum('bnd,de->bne', h, w_router, preferred_element_type=jnp.float32)
    aff = jax.nn.softmax(logits, axis=-1)
    top_w, top_idx = lax.top_k(jnp.swapaxes(aff, 1, 2), cap)
    xe = jax.vmap(lambda hb, ib: hb[ib])(h, top_idx)
    g = jnp.einsum('becd,edf->becf', xe, w_gate)
    u = jnp.einsum('becd,edf->becf', xe, w_up)
    y = jnp.einsum('becf,efd->becd', jax.nn.silu(g) * u, w_down)
    y = y * top_w[..., None].astype(y.dtype)
    return jax.vmap(lambda ib, yb: jnp.zeros((N, D), yb.dtype).at[ib.reshape(-1)].add(yb.reshape(-1, D)))(top_idx, y)


def setup_inputs(seed: int = 0) -> dict:
    key = jax.random.key(seed)
    ks = jax.random.split(key, 24)
    f32 = jnp.float32
    D = D_MODEL

    def nrm(k, shape, s):
        return jax.random.normal(k, shape, f32) * s

    return {
        "x": nrm(ks[0], (BATCH, SEQ, D), 1.0),
        "c": nrm(ks[1], (BATCH, D), 1.0),
        "ctx": nrm(ks[2], (BATCH, CTX_LEN, D), 1.0),
        "c_ctx": nrm(ks[3], (D,), 1.0),
        "w_ada": nrm(ks[4], (DEPTH, D, 6 * D), 0.3 * D ** -0.5),
        "b_ada": nrm(ks[5], (DEPTH, 6 * D), 0.02),
        "norm1_g": 1.0 + nrm(ks[6], (DEPTH, D), 0.05),
        "w_in": nrm(ks[7], (DEPTH, D, IN_COLS), D ** -0.5),
        "b_merge_gate": nrm(ks[8], (DEPTH, 2 * D), 0.02),
        "gmlp_ln_g": 1.0 + nrm(ks[9], (DEPTH, A_WIDTH), 0.05),
        "gmlp_ln_b": nrm(ks[10], (DEPTH, A_WIDTH), 0.02),
        "w_spatial": nrm(ks[11], (DEPTH, A_GROUPS, CHUNK, CHUNK), CHUNK ** -0.5),
        "b_spatial": nrm(ks[12], (DEPTH, A_GROUPS, CHUNK), 0.02),
        "attn_sink": nrm(ks[13], (DEPTH, N_HEADS), 0.5),
        "w_proj_a": nrm(ks[14], (DEPTH, A_WIDTH, D), A_WIDTH ** -0.5),
        "w_proj_b": nrm(ks[15], (DEPTH, B_WIDTH, D), B_WIDTH ** -0.5),
        "w_out": nrm(ks[16], (DEPTH, D, D), D ** -0.5),
        "norm2_g": 1.0 + nrm(ks[17], (DEPTH, D), 0.05),
        "w_router": nrm(ks[18], (DEPTH, D, N_EXPERTS), D ** -0.5),
        "w_exp_gate": nrm(ks[19], (DEPTH, N_EXPERTS, D, D_EXPERT), D ** -0.5),
        "w_exp_up": nrm(ks[20], (DEPTH, N_EXPERTS, D, D_EXPERT), D ** -0.5),
        "w_exp_down": nrm(ks[21], (DEPTH, N_EXPERTS, D_EXPERT, D), D_EXPERT ** -0.5),
        "final_g": 1.0 + nrm(ks[22], (D,), 0.05),
    }


def reference(x, c, ctx, c_ctx, w_ada, b_ada, norm1_g, w_in, b_merge_gate, gmlp_ln_g, gmlp_ln_b,
              w_spatial, b_spatial, attn_sink, w_proj_a, w_proj_b, w_out, norm2_g, w_router,
              w_exp_gate, w_exp_up, w_exp_down, final_g):
    Bn, L, D = x.shape
    rows = L // GRID_W
    row = jnp.repeat(jnp.arange(rows), GRID_W)
    col = jnp.tile(jnp.arange(GRID_W), rows)

    for l in range(DEPTH):
        mod = jax.nn.silu(c) @ w_ada[l] + b_ada[l]
        sh1, sc1, g1, sh2, sc2, g2 = jnp.split(mod[:, None, :], 6, axis=-1)
        mod_ctx = jax.nn.silu(c_ctx) @ w_ada[l] + b_ada[l]
        csh1, csc1 = mod_ctx[:D], mod_ctx[D:2 * D]

        h = modulate(rmsnorm(x, norm1_g[l]), sh1, sc1)
        proj = h @ w_in[l]
        u_a, v_a, q, k, v, gates = jnp.split(proj, [OFF_VA, OFF_Q, OFF_K, OFF_VB, OFF_GATE], axis=-1)

        hc = modulate(rmsnorm(ctx, norm1_g[l]), csh1, csc1)
        kv_ctx = hc @ w_in[l][:, OFF_K:OFF_GATE]
        k_ctx, v_ctx = jnp.split(kv_ctx.reshape(Bn, -1, 2 * N_KV_HEADS, HEAD_DIM), 2, axis=2)

        y_a = chunk_gmlp(jax.nn.gelu(u_a), jax.nn.gelu(v_a), gmlp_ln_g[l], gmlp_ln_b[l],
                         w_spatial[l], b_spatial[l])

        qh = rope_2d(q.reshape(Bn, L, N_HEADS, HEAD_DIM), row, col)
        kh = rope_2d(k.reshape(Bn, L, N_KV_HEADS, HEAD_DIM), row, col)
        vh = v.reshape(Bn, L, N_KV_HEADS, HEAD_DIM)
        y_b = window_gqa(qh, kh, vh, k_ctx, v_ctx, attn_sink[l])

        g_a, g_b = jnp.split(jax.nn.sigmoid(gates + b_merge_gate[l]), 2, axis=-1)
        merged = g_a * (y_a @ w_proj_a[l]) + g_b * (y_b @ w_proj_b[l])
        x = x + g1 * (merged @ w_out[l])

        h2 = modulate(rmsnorm(x, norm2_g[l]), sh2, sc2)
        x = x + g2 * expert_choice_ffn(h2, w_router[l], w_exp_gate[l], w_exp_up[l], w_exp_down[l])

    return rmsnorm(x, final_g)
```

```cpp
#include <hip/hip_runtime.h>
#include <cstdio>
#include <cstdint>

#define LAS __attribute__((address_space(3)))
typedef unsigned short bf16_t;
typedef float f32x4 __attribute__((ext_vector_type(4)));
typedef float f32x2 __attribute__((ext_vector_type(2)));
typedef unsigned u32x4 __attribute__((ext_vector_type(4)));
typedef unsigned u32x2 __attribute__((ext_vector_type(2)));
typedef int i32x4 __attribute__((ext_vector_type(4)));

constexpr int DM = 1024, NB = 8, SEQ = 4096, NTOK = NB * SEQ, CTXL = 256, NCTX = NB * CTXL, NROWS_H = NTOK + NCTX;
constexpr int INCOLS = 5632, OFF_Q = 2048, OFF_K = 3072, OFF_VB = 3328, OFF_GATE = 3584;
constexpr int NE = 16, CAP = 512, DE = 2048, NPAIR = NE * NB * CAP;
constexpr float EPS = 1e-6f, LOG2E = 1.4426950408889634f, C2 = 0.125f * LOG2E;
constexpr int NTHREADS = 512, NWAVES = 8;

constexpr size_t MiB = 1u << 20;
constexpr size_t WS_CTL = 0;
constexpr size_t WS_MOD = 1 * MiB;
constexpr size_t WS_ROPE = 1 * MiB + 512 * 1024;
constexpr size_t WS_AFFT = 2 * MiB;
constexpr size_t WS_TOPI = 4 * MiB;
constexpr size_t WS_TOPW = 4 * MiB + 512 * 1024;
constexpr size_t WS_SLOT = 5 * MiB;
constexpr size_t WS_WIN = 8 * MiB;
constexpr size_t WS_WAB = 19 * MiB;
constexpr size_t WS_WO = 23 * MiB;
constexpr size_t WS_R = 25 * MiB;
constexpr size_t WS_H = WS_R;
constexpr size_t WS_VA = WS_R + 68 * MiB;
constexpr size_t WS_KB = WS_VA + 64 * MiB;
constexpr size_t WS_VB = WS_KB + 17 * MiB;
constexpr size_t WS_G = WS_VB + 17 * MiB;
constexpr size_t WS_Y = WS_G + 128 * MiB;
constexpr size_t WS_TMP = WS_Y + 128 * MiB;
constexpr size_t WS_MERGED = WS_H;
constexpr size_t WS_WGU = WS_R;
constexpr size_t WS_WD = WS_R + 128 * MiB;
constexpr size_t WS_H2 = WS_R + 192 * MiB;
constexpr size_t WS_ACT = WS_R + 256 * MiB;
constexpr size_t WS_YB = WS_WGU;
constexpr size_t WS_END = 537 * MiB;
static_assert(WS_TMP + 64 * MiB <= WS_END && WS_ACT + 256 * MiB == WS_END, "ws map");

constexpr int LDS_BYTES = 147456;

__device__ __forceinline__ float bf2f(unsigned b) { return __uint_as_float(b << 16); }
__device__ __forceinline__ unsigned f2bf(float f) { unsigned u = __float_as_uint(f); return (u + 0x7fffu + ((u >> 16) & 1u)) >> 16; }
__device__ __forceinline__ unsigned pk2(float lo, float hi) { return f2bf(lo) | (f2bf(hi) << 16); }
__device__ __forceinline__ void st4bf(bf16_t* p, f32x4 v) { u32x2 w; w.x = pk2(v.x, v.y); w.y = pk2(v.z, v.w); *(u32x2*)p = w; }
__device__ __forceinline__ f32x4 ld4bf(const bf16_t* p) { const u32x2 w = *(const u32x2*)p; f32x4 v; v.x = bf2f(w.x & 0xffffu); v.y = bf2f(w.x >> 16); v.z = bf2f(w.y & 0xffffu); v.w = bf2f(w.y >> 16); return v; }
__device__ __forceinline__ float sigmoidf_(float x) { return 1.f / (1.f + __expf(-x)); }
__device__ __forceinline__ float siluf_(float x) { return x / (1.f + __expf(-x)); }
__device__ __forceinline__ float gelu_t(float x) { const float z2 = 1.5957691216057308f * (x + 0.044715f * x * x * x); return x / (1.f + __expf(-z2)); }
__device__ __forceinline__ float wave_sum(float v) {
#pragma unroll
    for (int o = 1; o < 64; o <<= 1) v += __shfl_xor(v, o);
    return v;
}
__device__ __forceinline__ int wave_sum_i(int v) {
#pragma unroll
    for (int o = 1; o < 64; o <<= 1) v += __shfl_xor(v, o);
    return v;
}
#define LDS_WAIT() asm volatile("s_waitcnt lgkmcnt(0)" ::: "memory")

struct Args { const float* in[23]; float* out; unsigned char* ws; int ph_lo, ph_hi; };
enum { I_X = 0, I_C, I_CTX, I_CCTX, I_WADA, I_BADA, I_N1G, I_WIN, I_BMG, I_LNG, I_LNB, I_WSP, I_BSP, I_SINK, I_WPA, I_WPB, I_WOUT, I_N2G, I_WR, I_WEG, I_WEU, I_WED, I_FING };

struct Unit { int pm, pn; };
struct Gemm {
    const bf16_t* A; const bf16_t* Bt; int lda, ldb, K;
    size_t bgs; int tpg_shift;
    const int* gidx;
};
constexpr int NXCD = 8, WGM = 8;
struct StaticOrder {
    int nM, nN, nwg, G, c, extra;
    __device__ void init(int M, int N, int G_, int c_, int extra_ = 0) { nM = M / 256; nN = N / 256; nwg = nM * nN; G = G_; c = c_; extra = extra_; }
    __device__ bool next(int i, Unit& u) const {
        const long L = (long)i * G + c;
        if (L >= nwg) { const int x = (int)(L - nwg); if (x >= extra) return false; u.pm = NTOK / 256 + (x >> 1); u.pn = 12 + (x & 1); return true; }
        int wgid = (int)L; { const int q = nwg / NXCD, r = nwg % NXCD, xcd = wgid % NXCD, off = wgid / NXCD; wgid = (xcd < r ? xcd * (q + 1) : r * (q + 1) + (xcd - r) * q) + off; }
        const int nig = WGM * nN, gid = wgid / nig, fm = gid * WGM, gsz = (nM - fm) < WGM ? (nM - fm) : WGM;
        u.pm = fm + ((wgid % nig) % gsz); u.pn = (wgid % nig) / gsz; return true;
    }
};

typedef f32x4 Acc[2][2][4][2];

template <class Epi, class Sched, bool GATHER>
__device__ __forceinline__ void naive_gemm_phase(LAS unsigned char* lds, const Gemm g, const Sched& S, const Epi& E) {
    const int tid = threadIdx.x, wid = tid >> 6, lane = tid & 63, wr = wid >> 2, wc = wid & 3, fr = lane & 15, fq = lane >> 4;
    LAS bf16_t* As = (LAS bf16_t*)lds;
    LAS bf16_t* Bs = As + 256 * 72;
    Unit u;
    for (int ui = 0; S.next(ui, u); ++ui) {
        Acc acc;
#pragma unroll
        for (int a = 0; a < 2; ++a)
#pragma unroll
            for (int b = 0; b < 2; ++b)
#pragma unroll
                for (int m = 0; m < 4; ++m)
#pragma unroll
                    for (int n = 0; n < 2; ++n) acc[a][b][m][n] = (f32x4){0.f, 0.f, 0.f, 0.f};
        const bf16_t* Bb = g.Bt + (size_t)(u.pm >> g.tpg_shift) * g.bgs + (size_t)u.pn * 256 * g.ldb;
        for (int kt = 0; kt < g.K / 64; ++kt) {
            __syncthreads();
            for (int p = tid; p < 2048; p += NTHREADS) {
                const int r = p >> 3, c8 = p & 7;
                size_t arow;
                if (GATHER) { const int prow = u.pm * 256 + r; arow = (size_t)((u.pm >> 1) & 7) * SEQ + g.gidx[prow]; } else arow = (size_t)u.pm * 256 + r;
                *(LAS u32x4*)(As + r * 72 + c8 * 8) = *(const u32x4*)(g.A + arow * g.lda + kt * 64 + c8 * 8);
                *(LAS u32x4*)(Bs + r * 72 + c8 * 8) = *(const u32x4*)(Bb + (size_t)r * g.ldb + kt * 64 + c8 * 8);
            }
            __syncthreads();
#pragma unroll 2
            for (int k = 0; k < 64; ++k) {
                float a[2][4], b[2][2][4];
#pragma unroll
                for (int ai = 0; ai < 2; ++ai)
#pragma unroll
                    for (int m = 0; m < 4; ++m) a[ai][m] = bf2f(As[(128 * ai + 64 * wr + 16 * m + fr) * 72 + k]);
#pragma unroll
                for (int bj = 0; bj < 2; ++bj)
#pragma unroll
                    for (int n = 0; n < 2; ++n)
#pragma unroll
                        for (int j = 0; j < 4; ++j) b[bj][n][j] = bf2f(Bs[(128 * bj + 32 * wc + 16 * n + 4 * fq + j) * 72 + k]);
#pragma unroll
                for (int ai = 0; ai < 2; ++ai)
#pragma unroll
                    for (int bj = 0; bj < 2; ++bj)
#pragma unroll
                        for (int m = 0; m < 4; ++m)
#pragma unroll
                            for (int n = 0; n < 2; ++n)
#pragma unroll
                                for (int j = 0; j < 4; ++j) acc[ai][bj][m][n][j] += a[ai][m] * b[bj][n][j];
            }
        }
        E(acc, u, wr, wc, fr, fq);
    }
    __syncthreads();
}

struct EpiIn {
    bf16_t *Y, *VA, *KB, *VB, *G; const float* bgate; const f32x2* rope;
    __device__ __forceinline__ void operator()(const Acc& acc, const Unit& u, int wr, int wc, int fr, int fq) const {
        const int pn = u.pn;
#pragma unroll
        for (int ai = 0; ai < 2; ++ai)
#pragma unroll
            for (int m = 0; m < 4; ++m) {
                const int row = u.pm * 256 + ai * 128 + wr * 64 + m * 16 + fr;
#pragma unroll
                for (int bj = 0; bj < 2; ++bj) {
                    const int cl = bj * 128 + wc * 32 + 4 * fq;
                    f32x4 v0 = acc[ai][bj][m][0], v1 = acc[ai][bj][m][1];
                    if (pn < 4) {
                        bf16_t* p = Y + (size_t)row * 2048 + pn * 256 + cl;
#pragma unroll
                        for (int j = 0; j < 4; ++j) { v0[j] = gelu_t(v0[j]); v1[j] = gelu_t(v1[j]); }
                        st4bf(p, v0); st4bf(p + 16, v1);
                    } else if (pn < 8) {
                        bf16_t* p = VA + (size_t)row * 1024 + (pn - 4) * 256 + cl;
#pragma unroll
                        for (int j = 0; j < 4; ++j) { v0[j] = gelu_t(v0[j]); v1[j] = gelu_t(v1[j]); }
                        st4bf(p, v0); st4bf(p + 16, v1);
                    } else if (pn < 13) {
                        f32x4 o0 = v0, o1 = v1;
                        if (row < NTOK) {
                            const int t = row & (SEQ - 1), pos = (wc & 1) ? (t & 63) : (t >> 6);
                            const f32x2* rp = rope + pos * 16 + 4 * fq;
#pragma unroll
                            for (int j = 0; j < 4; ++j) { const f32x2 cs = rp[j]; o0[j] = v0[j] * cs.x - v1[j] * cs.y; o1[j] = v0[j] * cs.y + v1[j] * cs.x; }
                        }
                        if (pn < 12) { bf16_t* p = Y + (size_t)row * 2048 + 1024 + (pn - 8) * 256 + cl; st4bf(p, o0 * C2); st4bf(p + 16, o1 * C2); }
                        else { bf16_t* p = KB + (size_t)row * 256 + cl; st4bf(p, o0); st4bf(p + 16, o1); }
                    } else if (pn == 13) {
                        bf16_t* p = VB + (size_t)row * 256 + cl; st4bf(p, v0); st4bf(p + 16, v1);
                    } else {
                        const int cg = (pn - 14) * 256 + cl;
                        const f32x4 b0 = *(const f32x4*)(bgate + cg), b1 = *(const f32x4*)(bgate + cg + 16);
#pragma unroll
                        for (int j = 0; j < 4; ++j) { v0[j] = sigmoidf_(v0[j] + b0[j]); v1[j] = sigmoidf_(v1[j] + b1[j]); }
                        bf16_t* p = G + (size_t)row * 2048 + cg; st4bf(p, v0); st4bf(p + 16, v1);
                    }
                }
            }
    }
};
struct EpiA {
    bf16_t* TMP; const bf16_t* G;
    __device__ __forceinline__ void operator()(const Acc& acc, const Unit& u, int wr, int wc, int fr, int fq) const {
#pragma unroll
        for (int ai = 0; ai < 2; ++ai)
#pragma unroll
            for (int m = 0; m < 4; ++m) {
                const int row = u.pm * 256 + ai * 128 + wr * 64 + m * 16 + fr;
#pragma unroll
                for (int bj = 0; bj < 2; ++bj)
#pragma unroll
                    for (int n = 0; n < 2; ++n) {
                        const int c = u.pn * 256 + bj * 128 + wc * 32 + 16 * n + 4 * fq;
                        const f32x4 g = ld4bf(G + (size_t)row * 2048 + c);
                        st4bf(TMP + (size_t)row * 1024 + c, g * acc[ai][bj][m][n]);
                    }
            }
    }
};
struct EpiB {
    bf16_t* MERGED; const bf16_t* TMP; const bf16_t* G;
    __device__ __forceinline__ void operator()(const Acc& acc, const Unit& u, int wr, int wc, int fr, int fq) const {
#pragma unroll
        for (int ai = 0; ai < 2; ++ai)
#pragma unroll
            for (int m = 0; m < 4; ++m) {
                const int row = u.pm * 256 + ai * 128 + wr * 64 + m * 16 + fr;
#pragma unroll
                for (int bj = 0; bj < 2; ++bj)
#pragma unroll
                    for (int n = 0; n < 2; ++n) {
                        const int c = u.pn * 256 + bj * 128 + wc * 32 + 16 * n + 4 * fq;
                        const f32x4 g = ld4bf(G + (size_t)row * 2048 + 1024 + c), t = ld4bf(TMP + (size_t)row * 1024 + c);
                        st4bf(MERGED + (size_t)row * 1024 + c, t + g * acc[ai][bj][m][n]);
                    }
            }
    }
};
struct EpiO {
    float* X1; const float* X; const float* mod;
    __device__ __forceinline__ void operator()(const Acc& acc, const Unit& u, int wr, int wc, int fr, int fq) const {
#pragma unroll
        for (int ai = 0; ai < 2; ++ai)
#pragma unroll
            for (int m = 0; m < 4; ++m) {
                const int row = u.pm * 256 + ai * 128 + wr * 64 + m * 16 + fr; const float* g1 = mod + (size_t)(row >> 12) * 6144 + 2048;
#pragma unroll
                for (int bj = 0; bj < 2; ++bj)
#pragma unroll
                    for (int n = 0; n < 2; ++n) {
                        const int c = u.pn * 256 + bj * 128 + wc * 32 + 16 * n + 4 * fq;
                        const f32x4 xv = *(const f32x4*)(X + (size_t)row * 1024 + c), gv = *(const f32x4*)(g1 + c);
                        *(f32x4*)(X1 + (size_t)row * 1024 + c) = xv + gv * acc[ai][bj][m][n];
                    }
            }
    }
};
struct EpiGU {
    bf16_t* ACT;
    __device__ __forceinline__ void operator()(const Acc& acc, const Unit& u, int wr, int wc, int fr, int fq) const {
#pragma unroll
        for (int ai = 0; ai < 2; ++ai)
#pragma unroll
            for (int m = 0; m < 4; ++m) {
                const int prow = u.pm * 256 + ai * 128 + wr * 64 + m * 16 + fr;
#pragma unroll
                for (int n = 0; n < 2; ++n) {
                    const f32x4 gt = acc[ai][0][m][n], up = acc[ai][1][m][n]; f32x4 a;
#pragma unroll
                    for (int j = 0; j < 4; ++j) a[j] = siluf_(gt[j]) * up[j];
                    st4bf(ACT + (size_t)prow * 2048 + u.pn * 128 + wc * 32 + 16 * n + 4 * fq, a);
                }
            }
    }
};
struct EpiD {
    bf16_t* YB; const float* TOPW;
    __device__ __forceinline__ void operator()(const Acc& acc, const Unit& u, int wr, int wc, int fr, int fq) const {
#pragma unroll
        for (int ai = 0; ai < 2; ++ai)
#pragma unroll
            for (int m = 0; m < 4; ++m) {
                const int prow = u.pm * 256 + ai * 128 + wr * 64 + m * 16 + fr; const float w = TOPW[prow];
#pragma unroll
                for (int bj = 0; bj < 2; ++bj)
#pragma unroll
                    for (int n = 0; n < 2; ++n) {
                        const int c = u.pn * 256 + bj * 128 + wc * 32 + 16 * n + 4 * fq;
                        st4bf(YB + (size_t)prow * 1024 + c, acc[ai][bj][m][n] * w);
                    }
            }
    }
};

__device__ __forceinline__ void transpose_item(const float* W, int N, int k0, int n0, bf16_t* dst, int ldt, LAS float* scr, int lane) {
#pragma unroll 8
    for (int i = 0; i < 32; ++i) { const int kk = 2 * i + (lane >> 5); scr[kk * 33 + (lane & 31)] = W[(size_t)(k0 + kk) * N + n0 + (lane & 31)]; }
    LDS_WAIT();
    const int c = lane & 7;
#pragma unroll
    for (int j = 0; j < 4; ++j) {
        const int n = (lane >> 3) + 8 * j; const LAS float* s = scr + (8 * c) * 33 + n;
        u32x4 o; o.x = pk2(s[0 * 33], s[1 * 33]); o.y = pk2(s[2 * 33], s[3 * 33]); o.z = pk2(s[4 * 33], s[5 * 33]); o.w = pk2(s[6 * 33], s[7 * 33]);
        *(u32x4*)(dst + (size_t)n * ldt + 8 * c) = o;
    }
    LDS_WAIT();
}

__device__ __forceinline__ void adaln_task(int task, const float* c, const float* cctx, const float* w_ada, const float* b_ada, float* mod, LAS float* lds, int tid) {
    LAS float* s = lds; LAS float* red = lds + 9 * 1024;
    for (int i = tid; i < 9 * 1024; i += NTHREADS) { const int r = i >> 10, k = i & 1023; const float v = r < 8 ? c[r * 1024 + k] : cctx[k]; s[i] = v / (1.f + __expf(-v)); }
    __syncthreads();
    const int ch = tid & 7, kr = tid >> 3;
    f32x4 acc[9];
#pragma unroll
    for (int r = 0; r < 9; ++r) acc[r] = (f32x4){0.f, 0.f, 0.f, 0.f};
    const float* wp = w_ada + (size_t)kr * 6144 + task * 32 + ch * 4;
    for (int it = 0; it < 16; ++it) {
        const f32x4 w = *(const f32x4*)(wp + (size_t)it * 64 * 6144); const int k = kr + it * 64;
#pragma unroll
        for (int r = 0; r < 9; ++r) acc[r] += s[r * 1024 + k] * w;
    }
#pragma unroll
    for (int r = 0; r < 9; ++r) *(LAS f32x4*)(red + (kr * 9 + r) * 32 + ch * 4) = acc[r];
    __syncthreads();
    if (tid < 288) { const int r = tid >> 5, col = tid & 31; float sum = 0.f; for (int q = 0; q < 64; ++q) sum += red[(q * 9 + r) * 32 + col]; mod[r * 6144 + task * 32 + col] = sum + b_ada[task * 32 + col]; }
    __syncthreads();
}

__device__ __forceinline__ void rope_table(f32x2* tab, int tid) {
    for (int idx = tid; idx < 1024; idx += NTHREADS) {
        const int pos = idx >> 4, i = idx & 15;
        double f = 1.0;
        for (int q = 0; q < i; ++q) f *= 0.56234132519034908;
        const float ang = (float)pos * (float)f;
        const double a = (double)ang, k = __builtin_rint(a * 0.15915494309189535), r = a - k * 6.283185307179586476925, r2 = r * r;
        double sn = r, ts = r, cs = 1.0, tc = 1.0;
        for (int n = 1; n <= 14; ++n) {
            tc *= -r2 / (double)((2 * n - 1) * (2 * n)); cs += tc;
            ts *= -r2 / (double)((2 * n) * (2 * n + 1)); sn += ts;
        }
        tab[idx] = (f32x2){(float)cs, (float)sn};
    }
}

enum { PH_PRO = 0, PH_HN, PH_IN, PH_MIX, PH_A, PH_B, PH_O, PH_WCONV, PH_H2R, PH_TOPK, PH_GU, PH_D, PH_FIN, PH_COUNT };

__global__ void __launch_bounds__(NTHREADS, 2) fwd(Args args) {
    extern __shared__ __attribute__((aligned(16))) unsigned char lds_raw[];
    LAS unsigned char* lds = (LAS unsigned char*)lds_raw;
    const int tid = threadIdx.x, lane = tid & 63, wave = __builtin_amdgcn_readfirstlane(tid >> 6);
    const int G = gridDim.x, bid = blockIdx.x;
    unsigned char* ws = args.ws;
    const int lo = args.ph_lo, hi = args.ph_hi;
#define IN(k) (lo <= (k) && (k) < hi)
    float* MOD = (float*)(ws + WS_MOD); f32x2* ROPE = (f32x2*)(ws + WS_ROPE);
    float* AFFT = (float*)(ws + WS_AFFT); int* TOPI = (int*)(ws + WS_TOPI); float* TOPW = (float*)(ws + WS_TOPW); int* SLOT = (int*)(ws + WS_SLOT);
    bf16_t* WIN = (bf16_t*)(ws + WS_WIN); bf16_t* WAB = (bf16_t*)(ws + WS_WAB); bf16_t* WO = (bf16_t*)(ws + WS_WO);
    bf16_t* H = (bf16_t*)(ws + WS_H); bf16_t* VA = (bf16_t*)(ws + WS_VA); bf16_t* KB = (bf16_t*)(ws + WS_KB); bf16_t* VB = (bf16_t*)(ws + WS_VB);
    bf16_t* GT = (bf16_t*)(ws + WS_G); bf16_t* Y = (bf16_t*)(ws + WS_Y); bf16_t* TMP = (bf16_t*)(ws + WS_TMP); bf16_t* MERGED = (bf16_t*)(ws + WS_MERGED);
    bf16_t* WGU = (bf16_t*)(ws + WS_WGU); bf16_t* WD = (bf16_t*)(ws + WS_WD); bf16_t* H2 = (bf16_t*)(ws + WS_H2); bf16_t* ACT = (bf16_t*)(ws + WS_ACT); bf16_t* YB = (bf16_t*)(ws + WS_YB);
    const int gw = bid * NWAVES + wave, NGW = G * NWAVES;

    if (IN(PH_PRO)) {
        if (bid < 192) adaln_task(bid, args.in[I_C], args.in[I_CCTX], args.in[I_WADA], args.in[I_BADA], MOD, (LAS float*)lds, tid);
        else if (bid == 192) rope_table(ROPE, tid);
        __syncthreads();
        LAS float* scr = (LAS float*)(lds + wave * 16384);
        constexpr int I_IN = 16 * 176, I_P = 16 * 32;
        for (int it = gw; it < I_IN + 3 * I_P; it += NGW) {
            int r = it;
            if (r < I_IN) { const int kb = r / 176, nb = r % 176; transpose_item(args.in[I_WIN], INCOLS, kb * 64, nb * 32, WIN + (size_t)(nb * 32) * 1024 + kb * 64, 1024, scr, lane); continue; } r -= I_IN;
            if (r < I_P) { const int kb = r / 32, nb = r % 32; transpose_item(args.in[I_WPA], 1024, kb * 64, nb * 32, WAB + (size_t)(nb * 32) * 2048 + kb * 64, 2048, scr, lane); continue; } r -= I_P;
            if (r < I_P) { const int kb = r / 32, nb = r % 32; transpose_item(args.in[I_WPB], 1024, kb * 64, nb * 32, WAB + (size_t)(nb * 32) * 2048 + 1024 + kb * 64, 2048, scr, lane); continue; } r -= I_P;
            { const int kb = r / 32, nb = r % 32; transpose_item(args.in[I_WOUT], 1024, kb * 64, nb * 32, WO + (size_t)(nb * 32) * 1024 + kb * 64, 1024, scr, lane); }
        }
    }
    if (IN(PH_HN)) {
        const float* g1n = args.in[I_N1G];
        for (int row = gw; row < NROWS_H; row += NGW) {
            const float* xr; int mrow;
            if (row < NTOK) { xr = args.in[I_X] + (size_t)row * 1024; mrow = row >> 12; } else { xr = args.in[I_CTX] + (size_t)(row - NTOK) * 1024; mrow = 8; }
            const float* sh = MOD + mrow * 6144; const float* sc = sh + 1024;
            f32x4 v[4]; float ss = 0.f;
#pragma unroll
            for (int j = 0; j < 4; ++j) { v[j] = *(const f32x4*)(xr + 4 * lane + 256 * j); ss += (v[j].x * v[j].x + v[j].y * v[j].y) + (v[j].z * v[j].z + v[j].w * v[j].w); }
            const float rstd = 1.0f / sqrtf(wave_sum(ss) * (1.f / 1024.f) + EPS);
#pragma unroll
            for (int j = 0; j < 4; ++j) {
                const int col = 4 * lane + 256 * j;
                const f32x4 gv = *(const f32x4*)(g1n + col), scv = *(const f32x4*)(sc + col), shv = *(const f32x4*)(sh + col);
                const f32x4 h = (v[j] * rstd * gv) * (1.f + scv) + shv;
                st4bf(H + (size_t)row * 1024 + col, h);
            }
        }
    }
    if (IN(PH_IN)) {
        Gemm g{H, WIN, 1024, 1024, 1024, 0, 30, nullptr}; StaticOrder S; S.init(NTOK, INCOLS, G, bid, 16);
        EpiIn E{Y, VA, KB, VB, GT, args.in[I_BMG], ROPE};
        naive_gemm_phase<EpiIn, StaticOrder, false>(lds, g, S, E);
    }
    if (IN(PH_MIX)) {
        for (int task = bid; task < NB * 32; task += G) {
            const int r0 = task * 128;
            LAS float* Vt = (LAS float*)lds; LAS float* Wt = Vt + 16384; LAS float* mu = Wt + 16384; LAS float* rs = mu + 128;
            __syncthreads();
            for (int rr = 0; rr < 16; ++rr) {
                const int q = wave * 16 + rr; const bf16_t* vr = VA + (size_t)(r0 + q) * 1024;
                f32x4 a[4]; float s = 0.f;
#pragma unroll
                for (int j = 0; j < 4; ++j) { a[j] = ld4bf(vr + 4 * lane + 256 * j); s += (a[j].x + a[j].y) + (a[j].z + a[j].w); }
                const float mean = wave_sum(s) * (1.f / 1024.f); float s2 = 0.f;
#pragma unroll
                for (int j = 0; j < 4; ++j) { const f32x4 d = a[j] - mean; s2 += (d.x * d.x + d.y * d.y) + (d.z * d.z + d.w * d.w); }
                const float rstd = 1.0f / sqrtf(wave_sum(s2) * (1.f / 1024.f) + EPS);
                if (lane == 0) { mu[q] = mean; rs[q] = rstd; }
            }
            __syncthreads();
            for (int g8 = 0; g8 < 8; ++g8) {
                for (int idx = tid; idx < 16384; idx += NTHREADS) {
                    const int q = idx >> 7, d = idx & 127;
                    const float v = bf2f(VA[(size_t)(r0 + q) * 1024 + g8 * 128 + d]);
                    Vt[idx] = (v - mu[q]) * rs[q] * args.in[I_LNG][g8 * 128 + d] + args.in[I_LNB][g8 * 128 + d];
                    Wt[idx] = args.in[I_WSP][g8 * 16384 + idx];
                }
                __syncthreads();
                const int p = tid >> 2, dq = (tid & 3) * 32;
                float acc[32];
#pragma unroll
                for (int j = 0; j < 32; ++j) acc[j] = 0.f;
                for (int q = 0; q < 128; ++q) {
                    const float w = Wt[p * 128 + q];
#pragma unroll
                    for (int j = 0; j < 32; j += 4) { const f32x4 vv = *(const LAS f32x4*)(Vt + q * 128 + dq + j); acc[j] += w * vv.x; acc[j + 1] += w * vv.y; acc[j + 2] += w * vv.z; acc[j + 3] += w * vv.w; }
                }
                const float bs = args.in[I_BSP][g8 * 128 + p];
                bf16_t* yp = Y + (size_t)(r0 + p) * 2048 + g8 * 128 + dq;
#pragma unroll
                for (int j = 0; j < 32; j += 4) {
                    const f32x4 uu = ld4bf(yp + j);
                    st4bf(yp + j, (f32x4){uu.x * (acc[j] + bs), uu.y * (acc[j + 1] + bs), uu.z * (acc[j + 2] + bs), uu.w * (acc[j + 3] + bs)});
                }
                __syncthreads();
            }
        }
        for (int task = bid; task < NB * 32 * 4; task += G) {
            const int kvh = task & 3, n = (task >> 2) & 31, b = task >> 7;
            const int hq = tid >> 7, qi = tid & 127, head = kvh * 4 + hq;
            const size_t row = (size_t)b * SEQ + n * 128 + qi;
            bf16_t* qp = Y + row * 2048 + 1024 + head * 64;
            float q[64], o[64];
#pragma unroll
            for (int d = 0; d < 64; d += 4) { const f32x4 t = ld4bf(qp + d); q[d] = t.x; q[d + 1] = t.y; q[d + 2] = t.z; q[d + 3] = t.w; o[d] = 0.f; o[d + 1] = 0.f; o[d + 2] = 0.f; o[d + 3] = 0.f; }
            float m = -1e30f, l = 0.f;
            LAS float* Kt = (LAS float*)lds; LAS float* Vt = Kt + 128 * 64;
            for (int tile = 0; tile < 5; ++tile) {
                int krow0, kpos0; bool local;
                if (tile < 3) { const int blk = n + tile - 1; if (blk < 0 || blk >= 32) continue; krow0 = b * SEQ + blk * 128; kpos0 = blk * 128; local = true; }
                else { krow0 = NTOK + b * CTXL + (tile - 3) * 128; kpos0 = 0; local = false; }
                __syncthreads();
                for (int idx = tid; idx < 128 * 16; idx += NTHREADS) {
                    const int j = idx >> 4, d4 = (idx & 15) * 4;
                    *(LAS f32x4*)(Kt + j * 64 + d4) = ld4bf(KB + (size_t)(krow0 + j) * 256 + kvh * 64 + d4);
                    *(LAS f32x4*)(Vt + j * 64 + d4) = ld4bf(VB + (size_t)(krow0 + j) * 256 + kvh * 64 + d4);
                }
                __syncthreads();
                const int qpos = n * 128 + qi;
                for (int j = 0; j < 128; ++j) {
                    float s = 0.f;
#pragma unroll
                    for (int d = 0; d < 64; d += 4) { const f32x4 kk = *(const LAS f32x4*)(Kt + j * 64 + d); s += q[d] * kk.x + q[d + 1] * kk.y + q[d + 2] * kk.z + q[d + 3] * kk.w; }
                    bool valid = true;
                    if (local) { const int rel = kpos0 + j - qpos; valid = (rel <= 128) && (rel >= -128); }
                    if (valid) {
                        if (s > m) { const float f = exp2f(m - s); l *= f;
#pragma unroll
                            for (int d = 0; d < 64; ++d) o[d] *= f;
                            m = s; }
                        const float p = exp2f(s - m); l += p;
#pragma unroll
                        for (int d = 0; d < 64; d += 4) { const f32x4 vv = *(const LAS f32x4*)(Vt + j * 64 + d); o[d] += p * vv.x; o[d + 1] += p * vv.y; o[d + 2] += p * vv.z; o[d + 3] += p * vv.w; }
                    }
                }
            }
            { const float s2 = args.in[I_SINK][head] * LOG2E, mf = fmaxf(m, s2), f = exp2f(m - mf); l = l * f + exp2f(s2 - mf); const float inv = f / l;
#pragma unroll
              for (int d = 0; d < 64; d += 4) st4bf(qp + d, (f32x4){o[d] * inv, o[d + 1] * inv, o[d + 2] * inv, o[d + 3] * inv}); }
            __syncthreads();
        }
    }
    if (IN(PH_A)) {
        Gemm g{Y, WAB, 2048, 2048, 1024, 0, 30, nullptr}; StaticOrder S; S.init(NTOK, 1024, G, bid);
        EpiA E{TMP, GT};
        naive_gemm_phase<EpiA, StaticOrder, false>(lds, g, S, E);
    }
    if (IN(PH_B)) {
        Gemm g{Y + 1024, WAB + 1024, 2048, 2048, 1024, 0, 30, nullptr}; StaticOrder S; S.init(NTOK, 1024, G, bid);
        EpiB E{MERGED, TMP, GT};
        naive_gemm_phase<EpiB, StaticOrder, false>(lds, g, S, E);
    }
    if (IN(PH_O)) {
        Gemm g{MERGED, WO, 1024, 1024, 1024, 0, 30, nullptr}; StaticOrder S; S.init(NTOK, 1024, G, bid);
        EpiO E{args.out, args.in[I_X], MOD};
        naive_gemm_phase<EpiO, StaticOrder, false>(lds, g, S, E);
    }
    if (IN(PH_WCONV)) {
        LAS float* scr = (LAS float*)(lds + wave * 16384);
        constexpr int I_G = 16 * 16 * 64, I_D = 16 * 32 * 32;
        for (int it = gw; it < 2 * I_G + I_D; it += NGW) {
            int r = it;
            if (r < 2 * I_G) {
                const int up = r >= I_G; if (up) r -= I_G;
                const int e = r >> 10, kb = (r >> 6) & 15, nb = r & 63, n0 = nb * 32;
                const int drow = 256 * (n0 >> 7) + (n0 & 127) + (up ? 128 : 0);
                transpose_item(args.in[up ? I_WEU : I_WEG] + (size_t)e * 1024 * 2048, 2048, kb * 64, n0, WGU + (size_t)e * 4096 * 1024 + (size_t)drow * 1024 + kb * 64, 1024, scr, lane);
            } else {
                r -= 2 * I_G;
                const int e = r >> 10, kb = (r >> 5) & 31, nb = r & 31;
                transpose_item(args.in[I_WED] + (size_t)e * 2048 * 1024, 1024, kb * 64, nb * 32, WD + (size_t)e * 1024 * 2048 + (size_t)(nb * 32) * 2048 + kb * 64, 2048, scr, lane);
            }
        }
    }
    if (IN(PH_H2R)) {
        LAS float* wT = (LAS float*)lds;
        for (int i = tid; i < 16384; i += NTHREADS) { const int col = i >> 4, e = i & 15; wT[e * 1024 + col] = args.in[I_WR][i]; }
        __syncthreads();
        const float* g2n = args.in[I_N2G];
        for (int row = gw; row < NTOK; row += NGW) {
            const float* xr = args.out + (size_t)row * 1024; const int b = row >> 12, t = row & (SEQ - 1);
            const float* sh = MOD + b * 6144 + 3072; const float* sc = sh + 1024;
            f32x4 v[4]; float ss = 0.f;
#pragma unroll
            for (int j = 0; j < 4; ++j) { v[j] = *(const f32x4*)(xr + 4 * lane + 256 * j); ss += (v[j].x * v[j].x + v[j].y * v[j].y) + (v[j].z * v[j].z + v[j].w * v[j].w); }
            const float rstd = 1.0f / sqrtf(wave_sum(ss) * (1.f / 1024.f) + EPS);
            float lg[16];
#pragma unroll
            for (int e = 0; e < 16; ++e) lg[e] = 0.f;
#pragma unroll
            for (int j = 0; j < 4; ++j) {
                const int col = 4 * lane + 256 * j;
                const f32x4 gv = *(const f32x4*)(g2n + col), scv = *(const f32x4*)(sc + col), shv = *(const f32x4*)(sh + col);
                const f32x4 h = (v[j] * rstd * gv) * (1.f + scv) + shv;
                st4bf(H2 + (size_t)row * 1024 + col, h);
#pragma unroll
                for (int e = 0; e < 16; ++e) { const f32x4 w = *(const LAS f32x4*)(wT + e * 1024 + col); lg[e] += (h.x * w.x + h.y * w.y) + (h.z * w.z + h.w * w.w); if ((e & 3) == 3) asm volatile("" ::: "memory"); }
            }
            float mx = -1e30f;
#pragma unroll
            for (int e = 0; e < 16; ++e) { lg[e] = wave_sum(lg[e]); mx = fmaxf(mx, lg[e]); }
            float den = 0.f;
#pragma unroll
            for (int e = 0; e < 16; ++e) { lg[e] = __expf(lg[e] - mx); den += lg[e]; }
            float mine = 0.f;
#pragma unroll
            for (int e = 0; e < 16; ++e) mine = (lane == e) ? lg[e] : mine;
            if (lane < 16) AFFT[(size_t)(b * 16 + lane) * SEQ + t] = mine / den;
        }
    }
    if (IN(PH_TOPK)) {
        LAS int* wsum = (LAS int*)lds;
        for (int task = bid; task < NE * NB; task += G) {
            const int e = task >> 3, b = task & 7;
            const float* aff = AFFT + (size_t)(b * 16 + e) * SEQ;
            unsigned k[8];
            { const u32x4 a0 = *(const u32x4*)(aff + 8 * tid), a1 = *(const u32x4*)(aff + 8 * tid + 4); k[0] = a0.x; k[1] = a0.y; k[2] = a0.z; k[3] = a0.w; k[4] = a1.x; k[5] = a1.y; k[6] = a1.z; k[7] = a1.w; }
            unsigned T = 0u; int it = 0;
            __syncthreads();
            for (int bit = 30; bit >= 0; --bit, ++it) {
                const unsigned cand = T | (1u << bit); int c = 0;
#pragma unroll
                for (int j = 0; j < 8; ++j) c += (k[j] >= cand) ? 1 : 0;
                c = wave_sum_i(c);
                if (lane == 0) wsum[(it & 1) * 8 + wave] = c;
                __syncthreads();
                int tot = 0;
#pragma unroll
                for (int w = 0; w < 8; ++w) tot += wsum[(it & 1) * 8 + w];
                if (tot >= CAP) T = cand;
            }
            int cg = 0, ce = 0;
#pragma unroll
            for (int j = 0; j < 8; ++j) { cg += (k[j] > T) ? 1 : 0; ce += (k[j] == T) ? 1 : 0; }
            LAS int* sc1 = wsum + 16; LAS int* sc2 = wsum + 32;
            int ie = ce, ig = cg;
#pragma unroll
            for (int o = 1; o < 64; o <<= 1) { const int te = __shfl_up(ie, o), tg = __shfl_up(ig, o); if (lane >= o) { ie += te; ig += tg; } }
            __syncthreads();
            if (lane == 63) { sc1[wave] = ie; sc2[wave] = ig; }
            __syncthreads();
            int ebase = ie - ce, totg = 0;
#pragma unroll
            for (int w = 0; w < 8; ++w) { if (w < wave) ebase += sc1[w]; totg += sc2[w]; }
            const int need = CAP - totg;
            int sel[8], cs = 0, er = ebase;
#pragma unroll
            for (int j = 0; j < 8; ++j) { const bool eq = (k[j] == T); sel[j] = (k[j] > T) || (eq && er < need); er += eq ? 1 : 0; cs += sel[j]; }
            int is = cs;
#pragma unroll
            for (int o = 1; o < 64; o <<= 1) { const int ts = __shfl_up(is, o); if (lane >= o) is += ts; }
            __syncthreads();
            if (lane == 63) sc1[wave] = is;
            __syncthreads();
            int sbase = is - cs;
#pragma unroll
            for (int w = 0; w < 8; ++w) if (w < wave) sbase += sc1[w];
#pragma unroll
            for (int j = 0; j < 8; ++j) {
                const int t = 8 * tid + j; int slot = -1;
                if (sel[j]) { slot = sbase; ++sbase; const int prow = (e * 8 + b) * CAP + slot; TOPI[prow] = t; TOPW[prow] = __uint_as_float(k[j]); }
                SLOT[((size_t)b * SEQ + t) * 16 + e] = slot;
            }
            __syncthreads();
        }
    }
    if (IN(PH_GU)) {
        Gemm g{H2, WGU, 1024, 1024, 1024, (size_t)4096 * 1024, 4, TOPI}; StaticOrder S; S.init(NPAIR, 4096, G, bid);
        EpiGU E{ACT};
        naive_gemm_phase<EpiGU, StaticOrder, true>(lds, g, S, E);
    }
    if (IN(PH_D)) {
        Gemm g{ACT, WD, 2048, 2048, 2048, (size_t)1024 * 2048, 4, nullptr}; StaticOrder S; S.init(NPAIR, 1024, G, bid);
        EpiD E{YB, TOPW};
        naive_gemm_phase<EpiD, StaticOrder, false>(lds, g, S, E);
    }
    if (IN(PH_FIN)) {
        const float* fg = args.in[I_FING];
        for (int row = gw; row < NTOK; row += NGW) {
            float* xr = args.out + (size_t)row * 1024; const int b = row >> 12;
            const float* g2 = MOD + b * 6144 + 5120;
            const int* sl = SLOT + (size_t)row * 16;
            f32x4 a[4];
#pragma unroll
            for (int j = 0; j < 4; ++j) a[j] = (f32x4){0.f, 0.f, 0.f, 0.f};
            for (int e = 0; e < 16; ++e) {
                const int s = sl[e];
                if (s >= 0) { const bf16_t* yr = YB + (size_t)((e * 8 + b) * CAP + s) * 1024;
#pragma unroll
                    for (int j = 0; j < 4; ++j) a[j] += ld4bf(yr + 4 * lane + 256 * j); }
            }
            f32x4 v[4]; float ss = 0.f;
#pragma unroll
            for (int j = 0; j < 4; ++j) { const int col = 4 * lane + 256 * j; v[j] = *(const f32x4*)(xr + col) + *(const f32x4*)(g2 + col) * a[j]; ss += (v[j].x * v[j].x + v[j].y * v[j].y) + (v[j].z * v[j].z + v[j].w * v[j].w); }
            const float rstd = 1.0f / sqrtf(wave_sum(ss) * (1.f / 1024.f) + EPS);
#pragma unroll
            for (int j = 0; j < 4; ++j) { const int col = 4 * lane + 256 * j; *(f32x4*)(xr + col) = v[j] * rstd * *(const f32x4*)(fg + col); }
        }
    }
#undef IN
}

extern "C" void kernel_launch(void* const* d_in, const int* in_sizes, int n_in, void* d_out, int out_size, void* d_ws, size_t ws_size, hipStream_t stream) {
    static int grid = 0;
    if (grid == 0) {
        if (n_in != 23 || in_sizes[0] != NTOK * DM || out_size != NTOK * DM || ws_size < WS_END) {
            fprintf(stderr, "kernel_launch: unexpected problem (n_in %d, in0 %d, out %d, ws %zu < %zu?)\n", n_in, n_in > 0 ? in_sizes[0] : -1, out_size, ws_size, (size_t)WS_END); grid = -1; return; }
        if (hipFuncSetAttribute((const void*)fwd, hipFuncAttributeMaxDynamicSharedMemorySize, LDS_BYTES) != hipSuccess) { fprintf(stderr, "kernel_launch: hipFuncSetAttribute failed\n"); grid = -1; return; }
        int dev = 0, cus = 0;
        if (hipGetDevice(&dev) != hipSuccess || hipDeviceGetAttribute(&cus, hipDeviceAttributeMultiprocessorCount, dev) != hipSuccess) { grid = -1; return; }
        grid = cus;
    }
    if (grid < 0) return;
    (void)hipMemsetAsync((char*)d_ws + WS_CTL, 0, 1 * MiB, stream);
    Args a{};
    for (int i = 0; i < 23; ++i) a.in[i] = (const float*)d_in[i];
    a.out = (float*)d_out; a.ws = (unsigned char*)d_ws;
    for (int ph = 0; ph < PH_COUNT; ++ph) {
        a.ph_lo = ph; a.ph_hi = ph + 1;
        hipLaunchKernelGGL(fwd, dim3(grid), dim3(NTHREADS), LDS_BYTES, stream, a);
    }
}
```

```cpp
#include <hip/hip_runtime.h>
#include <cstdio>
#include <cstdint>

#define LAS __attribute__((address_space(3)))
typedef unsigned short bf16_t;
typedef float f32x4 __attribute__((ext_vector_type(4)));
typedef float f32x2 __attribute__((ext_vector_type(2)));
typedef unsigned u32x4 __attribute__((ext_vector_type(4)));
typedef unsigned u32x2 __attribute__((ext_vector_type(2)));
typedef int i32x4 __attribute__((ext_vector_type(4)));

constexpr int DM = 1024, NB = 8, SEQ = 4096, NTOK = NB * SEQ, CTXL = 256, NCTX = NB * CTXL, NROWS_H = NTOK + NCTX;
constexpr int INCOLS = 5632, OFF_Q = 2048, OFF_K = 3072, OFF_VB = 3328, OFF_GATE = 3584;
constexpr int NE = 16, CAP = 512, DE = 2048, NPAIR = NE * NB * CAP;
constexpr float EPS = 1e-6f, LOG2E = 1.4426950408889634f, C2 = 0.125f * LOG2E;
constexpr int NTHREADS = 512, NWAVES = 8;

constexpr size_t MiB = 1u << 20;
constexpr size_t WS_CTL = 0;
constexpr size_t WS_MOD = 1 * MiB;
constexpr size_t WS_ROPE = 1 * MiB + 512 * 1024;
constexpr size_t WS_AFFT = 2 * MiB;
constexpr size_t WS_TOPI = 4 * MiB;
constexpr size_t WS_TOPW = 4 * MiB + 512 * 1024;
constexpr size_t WS_SLOT = 5 * MiB;
constexpr size_t WS_WIN = 8 * MiB;
constexpr size_t WS_WAB = 19 * MiB;
constexpr size_t WS_WO = 23 * MiB;
constexpr size_t WS_R = 25 * MiB;
constexpr size_t WS_H = WS_R;
constexpr size_t WS_VA = WS_R + 68 * MiB;
constexpr size_t WS_KB = WS_VA + 64 * MiB;
constexpr size_t WS_VB = WS_KB + 17 * MiB;
constexpr size_t WS_G = WS_VB + 17 * MiB;
constexpr size_t WS_Y = WS_G + 128 * MiB;
constexpr size_t WS_TMP = WS_Y + 128 * MiB;
constexpr size_t WS_MERGED = WS_H;
constexpr size_t WS_WGU = WS_R;
constexpr size_t WS_WD = WS_R + 128 * MiB;
constexpr size_t WS_H2 = WS_R + 192 * MiB;
constexpr size_t WS_ACT = WS_R + 256 * MiB;
constexpr size_t WS_YB = WS_WGU;
constexpr size_t WS_END = 537 * MiB;
static_assert(WS_TMP + 64 * MiB <= WS_END && WS_ACT + 256 * MiB == WS_END, "ws map");

constexpr int LDS_BYTES = 147456;

__device__ __forceinline__ float bf2f(unsigned b) { return __uint_as_float(b << 16); }
__device__ __forceinline__ unsigned f2bf(float f) { unsigned u = __float_as_uint(f); return (u + 0x7fffu + ((u >> 16) & 1u)) >> 16; }
__device__ __forceinline__ unsigned pk2(float lo, float hi) { return f2bf(lo) | (f2bf(hi) << 16); }
__device__ __forceinline__ void st4bf(bf16_t* p, f32x4 v) { u32x2 w; w.x = pk2(v.x, v.y); w.y = pk2(v.z, v.w); *(u32x2*)p = w; }
__device__ __forceinline__ f32x4 ld4bf(const bf16_t* p) { const u32x2 w = *(const u32x2*)p; f32x4 v; v.x = bf2f(w.x & 0xffffu); v.y = bf2f(w.x >> 16); v.z = bf2f(w.y & 0xffffu); v.w = bf2f(w.y >> 16); return v; }
__device__ __forceinline__ float sigmoidf_(float x) { return 1.f / (1.f + __expf(-x)); }
__device__ __forceinline__ float siluf_(float x) { return x / (1.f + __expf(-x)); }
__device__ __forceinline__ float gelu_t(float x) { const float z2 = 1.5957691216057308f * (x + 0.044715f * x * x * x); return x / (1.f + __expf(-z2)); }
__device__ __forceinline__ float wave_sum(float v) {
#pragma unroll
    for (int o = 1; o < 64; o <<= 1) v += __shfl_xor(v, o);
    return v;
}
__device__ __forceinline__ int wave_sum_i(int v) {
#pragma unroll
    for (int o = 1; o < 64; o <<= 1) v += __shfl_xor(v, o);
    return v;
}
#define LDS_WAIT() asm volatile("s_waitcnt lgkmcnt(0)" ::: "memory")

struct Args { const float* in[23]; float* out; unsigned char* ws; int ph_lo, ph_hi; };
enum { I_X = 0, I_C, I_CTX, I_CCTX, I_WADA, I_BADA, I_N1G, I_WIN, I_BMG, I_LNG, I_LNB, I_WSP, I_BSP, I_SINK, I_WPA, I_WPB, I_WOUT, I_N2G, I_WR, I_WEG, I_WEU, I_WED, I_FING };

struct Unit { int pm, pn; };
struct Gemm {
    const bf16_t* A; const bf16_t* Bt; int lda, ldb, K;
    size_t bgs; int tpg_shift;
    const int* gidx;
};
constexpr int NXCD = 8, WGM = 8;
struct StaticOrder {
    int nM, nN, nwg, G, c, extra;
    __device__ void init(int M, int N, int G_, int c_, int extra_ = 0) { nM = M / 256; nN = N / 256; nwg = nM * nN; G = G_; c = c_; extra = extra_; }
    __device__ bool next(int i, Unit& u) const {
        const long L = (long)i * G + c;
        if (L >= nwg) { const int x = (int)(L - nwg); if (x >= extra) return false; u.pm = NTOK / 256 + (x >> 1); u.pn = 12 + (x & 1); return true; }
        int wgid = (int)L; { const int q = nwg / NXCD, r = nwg % NXCD, xcd = wgid % NXCD, off = wgid / NXCD; wgid = (xcd < r ? xcd * (q + 1) : r * (q + 1) + (xcd - r) * q) + off; }
        const int nig = WGM * nN, gid = wgid / nig, fm = gid * WGM, gsz = (nM - fm) < WGM ? (nM - fm) : WGM;
        u.pm = fm + ((wgid % nig) % gsz); u.pn = (wgid % nig) / gsz; return true;
    }
};

typedef f32x4 Acc[2][2][4][2];

template <class Epi, class Sched, bool GATHER>
__device__ __forceinline__ void naive_gemm_phase(LAS unsigned char* lds, const Gemm g, const Sched& S, const Epi& E) {
    const int tid = threadIdx.x, wid = tid >> 6, lane = tid & 63, wr = wid >> 2, wc = wid & 3, fr = lane & 15, fq = lane >> 4;
    LAS bf16_t* As = (LAS bf16_t*)lds;
    LAS bf16_t* Bs = As + 256 * 72;
    Unit u;
    for (int ui = 0; S.next(ui, u); ++ui) {
        Acc acc;
#pragma unroll
        for (int a = 0; a < 2; ++a)
#pragma unroll
            for (int b = 0; b < 2; ++b)
#pragma unroll
                for (int m = 0; m < 4; ++m)
#pragma unroll
                    for (int n = 0; n < 2; ++n) acc[a][b][m][n] = (f32x4){0.f, 0.f, 0.f, 0.f};
        const bf16_t* Bb = g.Bt + (size_t)(u.pm >> g.tpg_shift) * g.bgs + (size_t)u.pn * 256 * g.ldb;
        for (int kt = 0; kt < g.K / 64; ++kt) {
            __syncthreads();
            for (int p = tid; p < 2048; p += NTHREADS) {
                const int r = p >> 3, c8 = p & 7;
                size_t arow;
                if (GATHER) { const int prow = u.pm * 256 + r; arow = (size_t)((u.pm >> 1) & 7) * SEQ + g.gidx[prow]; } else arow = (size_t)u.pm * 256 + r;
                *(LAS u32x4*)(As + r * 72 + c8 * 8) = *(const u32x4*)(g.A + arow * g.lda + kt * 64 + c8 * 8);
                *(LAS u32x4*)(Bs + r * 72 + c8 * 8) = *(const u32x4*)(Bb + (size_t)r * g.ldb + kt * 64 + c8 * 8);
            }
            __syncthreads();
#pragma unroll 2
            for (int k = 0; k < 64; ++k) {
                float a[2][4], b[2][2][4];
#pragma unroll
                for (int ai = 0; ai < 2; ++ai)
#pragma unroll
                    for (int m = 0; m < 4; ++m) a[ai][m] = bf2f(As[(128 * ai + 64 * wr + 16 * m + fr) * 72 + k]);
#pragma unroll
                for (int bj = 0; bj < 2; ++bj)
#pragma unroll
                    for (int n = 0; n < 2; ++n)
#pragma unroll
                        for (int j = 0; j < 4; ++j) b[bj][n][j] = bf2f(Bs[(128 * bj + 32 * wc + 16 * n + 4 * fq + j) * 72 + k]);
#pragma unroll
                for (int ai = 0; ai < 2; ++ai)
#pragma unroll
                    for (int bj = 0; bj < 2; ++bj)
#pragma unroll
                        for (int m = 0; m < 4; ++m)
#pragma unroll
                            for (int n = 0; n < 2; ++n)
#pragma unroll
                                for (int j = 0; j < 4; ++j) acc[ai][bj][m][n][j] += a[ai][m] * b[bj][n][j];
            }
        }
        E(acc, u, wr, wc, fr, fq);
    }
    __syncthreads();
}

namespace pg8 {
typedef short bf16x8 __attribute__((ext_vector_type(8)));
constexpr int BK = 64, HALF = 128, HTB = HALF * BK * 2, STAGE_BYTES = 8 * HTB;
__device__ __forceinline__ int lds_byte(int r, int c) { const int st = (r >> 4) * 2 + (c >> 5), rr = r & 15, cc = c & 31, ob = rr * 64 + cc * 2; return st * 1024 + (ob ^ (((ob >> 9) & 1) << 5)); }
__device__ __forceinline__ void stage_rc(int b, int& R, int& C) { const int st = b / 1024, sb = b % 1024, swz = sb ^ (((sb >> 9) & 1) << 5); R = (st >> 1) * 16 + swz / 64; C = (st & 1) * 32 + (swz % 64) / 2; }

template <class Epi, class Sched, bool GATHER>
__device__ __forceinline__ void gemm_phase(LAS unsigned char* lds, const Gemm g, const Sched& S, const Epi& E) {
    const int tid = threadIdx.x, wid = __builtin_amdgcn_readfirstlane(tid >> 6), lane = tid & 63, wr = wid >> 2, wc = wid & 3, fr = lane & 15, fq = lane >> 4;
    const int nt = g.K / BK;
    int Rs[2], Cs[2]; unsigned voffB[2], vA[2][2], vN[2][2];
#pragma unroll
    for (int i = 0; i < 2; ++i) { stage_rc(tid * 16 + i * 8192, Rs[i], Cs[i]); voffB[i] = (unsigned)(Rs[i] * g.ldb + Cs[i]) * 2u; }
    const size_t kstep = (size_t)(BK * 2);
    const size_t hstepB = (size_t)HALF * g.ldb * 2;
    const unsigned ldsw = (unsigned)wid * 1024u;
    const int aoff = lds_byte(wr * 64 + fr, fq * 8), boff = lds_byte(wc * 32 + fr, fq * 8);
#define PG8_SA(b, h) (((b) * 2 + (h)) * HTB)
#define PG8_SB(b, h) ((4 + (b) * 2 + (h)) * HTB)
#define PG8_STAGE(bufoff, gbase, voff) do { _Pragma("unroll") for (int _i = 0; _i < 2; ++_i) \
        __builtin_amdgcn_global_load_lds((const unsigned*)((const char*)(gbase) + (voff)[_i]), (LAS unsigned*)(lds + (bufoff) + ldsw + _i * 8192), 16, 0, 0); } while (0)
#define PG8_LDA(dst, b, h) do { _Pragma("unroll") for (int m = 0; m < 4; ++m) _Pragma("unroll") for (int k = 0; k < 2; ++k) dst[m][k] = *(const LAS bf16x8*)(lds + PG8_SA(b, h) + aoff + m * 2048 + k * 1024); } while (0)
#define PG8_LDB(dst, b, h) do { _Pragma("unroll") for (int n = 0; n < 2; ++n) _Pragma("unroll") for (int k = 0; k < 2; ++k) dst[n][k] = *(const LAS bf16x8*)(lds + PG8_SB(b, h) + boff + n * 2048 + k * 1024); } while (0)
#define PG8_MMA(ai, bj, At, Bt) do { __builtin_amdgcn_s_setprio(1); _Pragma("unroll") for (int m = 0; m < 4; ++m) _Pragma("unroll") for (int n = 0; n < 2; ++n) _Pragma("unroll") for (int k = 0; k < 2; ++k) \
        acc[ai][bj][m][n] = __builtin_amdgcn_mfma_f32_16x16x32_bf16(Bt[n][k], At[m][k], acc[ai][bj][m][n], 0, 0, 0); __builtin_amdgcn_s_setprio(0); } while (0)
#define PG8_WAIT_V(n) asm volatile("s_waitcnt vmcnt(" #n ")" ::: "memory")
#define PG8_WAIT_L(n) asm volatile("s_waitcnt lgkmcnt(" #n ")" ::: "memory")
#define PG8_BAR __builtin_amdgcn_s_barrier()
#define PG8_SCHED __builtin_amdgcn_sched_barrier(0)
#define PG8_AVOFF(dst, U) do { _Pragma("unroll") for (int _h = 0; _h < 2; ++_h) _Pragma("unroll") for (int _i = 0; _i < 2; ++_i) \
        dst[_h][_i] = GATHER ? (unsigned)((((U).pm >> 1) & 7) * SEQ + g.gidx[(U).pm * 256 + _h * 128 + Rs[_i]]) * (unsigned)(g.lda * 2) + (unsigned)(Cs[_i] * 2) \
                             : (unsigned)((_h * 128 + Rs[_i]) * g.lda + Cs[_i]) * 2u; } while (0)
#define PG8_ABASE(U) ((const char*)g.A + (GATHER ? (size_t)0 : (size_t)(U).pm * 256 * g.lda * 2))
#define PG8_BBASE(U) ((const char*)g.Bt + ((size_t)((U).pm >> g.tpg_shift) * g.bgs + (size_t)(U).pn * 256 * g.ldb) * 2)
    Unit cur, nxt; int ui = 0;
    if (!S.next(0, cur)) return;
    Acc acc;
#pragma unroll
    for (int a = 0; a < 2; ++a)
#pragma unroll
        for (int b = 0; b < 2; ++b)
#pragma unroll
            for (int m = 0; m < 4; ++m)
#pragma unroll
                for (int n = 0; n < 2; ++n) acc[a][b][m][n] = (f32x4){0.f, 0.f, 0.f, 0.f};
    bf16x8 At[4][2], B0[2][2], B1[2][2];
    PG8_AVOFF(vA, cur);
    const char* cA = PG8_ABASE(cur); const char* cB = PG8_BBASE(cur);
    PG8_STAGE(PG8_SB(0, 0), cB, voffB); PG8_STAGE(PG8_SB(0, 1), cB + hstepB, voffB); PG8_STAGE(PG8_SA(0, 0), cA, vA[0]); PG8_STAGE(PG8_SA(0, 1), cA, vA[1]);
    if (wr == 1) PG8_BAR;
    PG8_WAIT_V(2); PG8_BAR;
    PG8_STAGE(PG8_SB(1, 0), cB + kstep, voffB); PG8_STAGE(PG8_SA(1, 0), cA + kstep, vA[0]); PG8_STAGE(PG8_SB(1, 1), cB + hstepB + kstep, voffB);
    PG8_WAIT_V(6); PG8_BAR;
    for (;;) {
        const bool has_next = S.next(ui + 1, nxt);
        const char* nA = has_next ? PG8_ABASE(nxt) : cA; const char* nB = has_next ? PG8_BBASE(nxt) : cB;
        if (GATHER) {
            if (has_next) PG8_AVOFF(vN, nxt);
            else {
#pragma unroll
                for (int h = 0; h < 2; ++h)
#pragma unroll
                    for (int i = 0; i < 2; ++i) vN[h][i] = vA[h][i];
            }
        }
        for (int t = 0; t < nt; t += 2) {
            const bool last = (t == nt - 2);
            const char* a1 = cA + (size_t)(t + 1) * kstep;
            const char* a2 = last ? nA : cA + (size_t)(t + 2) * kstep; const char* b2 = last ? nB : cB + (size_t)(t + 2) * kstep;
            const char* a3 = a2 + kstep; const char* b3 = b2 + kstep;
            unsigned v2[2][2];
#pragma unroll
            for (int h = 0; h < 2; ++h)
#pragma unroll
                for (int i = 0; i < 2; ++i) v2[h][i] = (GATHER && last) ? vN[h][i] : vA[h][i];
            PG8_LDB(B0, 0, 0); PG8_LDB(B1, 0, 1); PG8_SCHED; PG8_LDA(At, 0, 0); PG8_STAGE(PG8_SA(1, 1), a1, vA[1]);
            PG8_WAIT_V(8); PG8_WAIT_L(0); PG8_BAR; PG8_MMA(0, 0, At, B0); PG8_MMA(0, 1, At, B1); PG8_BAR; PG8_SCHED;
            PG8_LDA(At, 0, 1); PG8_STAGE(PG8_SB(0, 0), b2, voffB); PG8_STAGE(PG8_SB(0, 1), b2 + hstepB, voffB); PG8_STAGE(PG8_SA(0, 0), a2, v2[0]);
            PG8_WAIT_V(8); PG8_WAIT_L(0); PG8_BAR; PG8_MMA(1, 0, At, B0); PG8_MMA(1, 1, At, B1); PG8_BAR; PG8_SCHED;
            PG8_LDB(B0, 1, 0); PG8_LDB(B1, 1, 1); PG8_SCHED; PG8_LDA(At, 1, 0); PG8_STAGE(PG8_SA(0, 1), a2, v2[1]);
            PG8_WAIT_V(8); PG8_WAIT_L(0); PG8_BAR; PG8_MMA(0, 0, At, B0); PG8_MMA(0, 1, At, B1); PG8_BAR; PG8_SCHED;
            PG8_LDA(At, 1, 1); PG8_STAGE(PG8_SB(1, 0), b3, voffB); PG8_STAGE(PG8_SB(1, 1), b3 + hstepB, voffB); PG8_STAGE(PG8_SA(1, 0), a3, v2[0]);
            PG8_WAIT_V(8); PG8_WAIT_L(0); PG8_BAR; PG8_MMA(1, 0, At, B0); PG8_MMA(1, 1, At, B1); PG8_BAR; PG8_SCHED;
        }
        if (wr == 0) PG8_BAR;
        E(acc, cur, wr, wc, fr, fq);
        if (!has_next) break;
#pragma unroll
        for (int a = 0; a < 2; ++a)
#pragma unroll
            for (int b = 0; b < 2; ++b)
#pragma unroll
                for (int m = 0; m < 4; ++m)
#pragma unroll
                    for (int n = 0; n < 2; ++n) acc[a][b][m][n] = (f32x4){0.f, 0.f, 0.f, 0.f};
        cur = nxt; cA = nA; cB = nB; ++ui;
        if (GATHER) {
#pragma unroll
            for (int h = 0; h < 2; ++h)
#pragma unroll
                for (int i = 0; i < 2; ++i) vA[h][i] = vN[h][i];
        }
        if (wr == 1) PG8_BAR;
    }
    PG8_WAIT_V(0);
    PG8_BAR;
#undef PG8_SA
#undef PG8_SB
#undef PG8_STAGE
#undef PG8_LDA
#undef PG8_LDB
#undef PG8_MMA
#undef PG8_WAIT_V
#undef PG8_WAIT_L
#undef PG8_BAR
#undef PG8_SCHED
#undef PG8_AVOFF
#undef PG8_ABASE
#undef PG8_BBASE
}
}

#ifndef FAST_GEMM
#define FAST_GEMM 1
#endif
#if FAST_GEMM
#define GEMM_PHASE pg8::gemm_phase
#else
#define GEMM_PHASE naive_gemm_phase
#endif

struct EpiIn {
    bf16_t *Y, *VA, *KB, *VB, *G; const float* bgate; const f32x2* rope;
    __device__ __forceinline__ void operator()(const Acc& acc, const Unit& u, int wr, int wc, int fr, int fq) const {
        const int pn = u.pn;
#pragma unroll
        for (int ai = 0; ai < 2; ++ai)
#pragma unroll
            for (int m = 0; m < 4; ++m) {
                const int row = u.pm * 256 + ai * 128 + wr * 64 + m * 16 + fr;
#pragma unroll
                for (int bj = 0; bj < 2; ++bj) {
                    const int cl = bj * 128 + wc * 32 + 4 * fq;
                    f32x4 v0 = acc[ai][bj][m][0], v1 = acc[ai][bj][m][1];
                    if (pn < 4) {
                        bf16_t* p = Y + (size_t)row * 2048 + pn * 256 + cl;
#pragma unroll
                        for (int j = 0; j < 4; ++j) { v0[j] = gelu_t(v0[j]); v1[j] = gelu_t(v1[j]); }
                        st4bf(p, v0); st4bf(p + 16, v1);
                    } else if (pn < 8) {
                        bf16_t* p = VA + (size_t)row * 1024 + (pn - 4) * 256 + cl;
#pragma unroll
                        for (int j = 0; j < 4; ++j) { v0[j] = gelu_t(v0[j]); v1[j] = gelu_t(v1[j]); }
                        st4bf(p, v0); st4bf(p + 16, v1);
                    } else if (pn < 13) {
                        f32x4 o0 = v0, o1 = v1;
                        if (row < NTOK) {
                            const int t = row & (SEQ - 1), pos = (wc & 1) ? (t & 63) : (t >> 6);
                            const f32x2* rp = rope + pos * 16 + 4 * fq;
#pragma unroll
                            for (int j = 0; j < 4; ++j) { const f32x2 cs = rp[j]; o0[j] = v0[j] * cs.x - v1[j] * cs.y; o1[j] = v0[j] * cs.y + v1[j] * cs.x; }
                        }
                        if (pn < 12) { bf16_t* p = Y + (size_t)row * 2048 + 1024 + (pn - 8) * 256 + cl; st4bf(p, o0 * C2); st4bf(p + 16, o1 * C2); }
                        else { bf16_t* p = KB + (size_t)row * 256 + cl; st4bf(p, o0); st4bf(p + 16, o1); }
                    } else if (pn == 13) {
                        bf16_t* p = VB + (size_t)row * 256 + cl; st4bf(p, v0); st4bf(p + 16, v1);
                    } else {
                        const int cg = (pn - 14) * 256 + cl;
                        const f32x4 b0 = *(const f32x4*)(bgate + cg), b1 = *(const f32x4*)(bgate + cg + 16);
#pragma unroll
                        for (int j = 0; j < 4; ++j) { v0[j] = sigmoidf_(v0[j] + b0[j]); v1[j] = sigmoidf_(v1[j] + b1[j]); }
                        bf16_t* p = G + (size_t)row * 2048 + cg; st4bf(p, v0); st4bf(p + 16, v1);
                    }
                }
            }
    }
};
struct EpiA {
    bf16_t* TMP; const bf16_t* G;
    __device__ __forceinline__ void operator()(const Acc& acc, const Unit& u, int wr, int wc, int fr, int fq) const {
#pragma unroll
        for (int ai = 0; ai < 2; ++ai)
#pragma unroll
            for (int m = 0; m < 4; ++m) {
                const int row = u.pm * 256 + ai * 128 + wr * 64 + m * 16 + fr;
#pragma unroll
                for (int bj = 0; bj < 2; ++bj)
#pragma unroll
                    for (int n = 0; n < 2; ++n) {
                        const int c = u.pn * 256 + bj * 128 + wc * 32 + 16 * n + 4 * fq;
                        const f32x4 g = ld4bf(G + (size_t)row * 2048 + c);
                        st4bf(TMP + (size_t)row * 1024 + c, g * acc[ai][bj][m][n]);
                    }
            }
    }
};
struct EpiB {
    bf16_t* MERGED; const bf16_t* TMP; const bf16_t* G;
    __device__ __forceinline__ void operator()(const Acc& acc, const Unit& u, int wr, int wc, int fr, int fq) const {
#pragma unroll
        for (int ai = 0; ai < 2; ++ai)
#pragma unroll
            for (int m = 0; m < 4; ++m) {
                const int row = u.pm * 256 + ai * 128 + wr * 64 + m * 16 + fr;
#pragma unroll
                for (int bj = 0; bj < 2; ++bj)
#pragma unroll
                    for (int n = 0; n < 2; ++n) {
                        const int c = u.pn * 256 + bj * 128 + wc * 32 + 16 * n + 4 * fq;
                        const f32x4 g = ld4bf(G + (size_t)row * 2048 + 1024 + c), t = ld4bf(TMP + (size_t)row * 1024 + c);
                        st4bf(MERGED + (size_t)row * 1024 + c, t + g * acc[ai][bj][m][n]);
                    }
            }
    }
};
struct EpiO {
    float* X1; const float* X; const float* mod;
    __device__ __forceinline__ void operator()(const Acc& acc, const Unit& u, int wr, int wc, int fr, int fq) const {
#pragma unroll
        for (int ai = 0; ai < 2; ++ai)
#pragma unroll
            for (int m = 0; m < 4; ++m) {
                const int row = u.pm * 256 + ai * 128 + wr * 64 + m * 16 + fr; const float* g1 = mod + (size_t)(row >> 12) * 6144 + 2048;
#pragma unroll
                for (int bj = 0; bj < 2; ++bj)
#pragma unroll
                    for (int n = 0; n < 2; ++n) {
                        const int c = u.pn * 256 + bj * 128 + wc * 32 + 16 * n + 4 * fq;
                        const f32x4 xv = *(const f32x4*)(X + (size_t)row * 1024 + c), gv = *(const f32x4*)(g1 + c);
                        *(f32x4*)(X1 + (size_t)row * 1024 + c) = xv + gv * acc[ai][bj][m][n];
                    }
            }
    }
};
struct EpiGU {
    bf16_t* ACT;
    __device__ __forceinline__ void operator()(const Acc& acc, const Unit& u, int wr, int wc, int fr, int fq) const {
#pragma unroll
        for (int ai = 0; ai < 2; ++ai)
#pragma unroll
            for (int m = 0; m < 4; ++m) {
                const int prow = u.pm * 256 + ai * 128 + wr * 64 + m * 16 + fr;
#pragma unroll
                for (int n = 0; n < 2; ++n) {
                    const f32x4 gt = acc[ai][0][m][n], up = acc[ai][1][m][n]; f32x4 a;
#pragma unroll
                    for (int j = 0; j < 4; ++j) a[j] = siluf_(gt[j]) * up[j];
                    st4bf(ACT + (size_t)prow * 2048 + u.pn * 128 + wc * 32 + 16 * n + 4 * fq, a);
                }
            }
    }
};
struct EpiD {
    bf16_t* YB; const float* TOPW;
    __device__ __forceinline__ void operator()(const Acc& acc, const Unit& u, int wr, int wc, int fr, int fq) const {
#pragma unroll
        for (int ai = 0; ai < 2; ++ai)
#pragma unroll
            for (int m = 0; m < 4; ++m) {
                const int prow = u.pm * 256 + ai * 128 + wr * 64 + m * 16 + fr; const float w = TOPW[prow];
#pragma unroll
                for (int bj = 0; bj < 2; ++bj)
#pragma unroll
                    for (int n = 0; n < 2; ++n) {
                        const int c = u.pn * 256 + bj * 128 + wc * 32 + 16 * n + 4 * fq;
                        st4bf(YB + (size_t)prow * 1024 + c, acc[ai][bj][m][n] * w);
                    }
            }
    }
};

__device__ __forceinline__ void transpose_item(const float* W, int N, int k0, int n0, bf16_t* dst, int ldt, LAS float* scr, int lane) {
#pragma unroll 8
    for (int i = 0; i < 32; ++i) { const int kk = 2 * i + (lane >> 5); scr[kk * 33 + (lane & 31)] = W[(size_t)(k0 + kk) * N + n0 + (lane & 31)]; }
    LDS_WAIT();
    const int c = lane & 7;
#pragma unroll
    for (int j = 0; j < 4; ++j) {
        const int n = (lane >> 3) + 8 * j; const LAS float* s = scr + (8 * c) * 33 + n;
        u32x4 o; o.x = pk2(s[0 * 33], s[1 * 33]); o.y = pk2(s[2 * 33], s[3 * 33]); o.z = pk2(s[4 * 33], s[5 * 33]); o.w = pk2(s[6 * 33], s[7 * 33]);
        *(u32x4*)(dst + (size_t)n * ldt + 8 * c) = o;
    }
    LDS_WAIT();
}

__device__ __forceinline__ void adaln_task(int task, const float* c, const float* cctx, const float* w_ada, const float* b_ada, float* mod, LAS float* lds, int tid) {
    LAS float* s = lds; LAS float* red = lds + 9 * 1024;
    for (int i = tid; i < 9 * 1024; i += NTHREADS) { const int r = i >> 10, k = i & 1023; const float v = r < 8 ? c[r * 1024 + k] : cctx[k]; s[i] = v / (1.f + __expf(-v)); }
    __syncthreads();
    const int ch = tid & 7, kr = tid >> 3;
    f32x4 acc[9];
#pragma unroll
    for (int r = 0; r < 9; ++r) acc[r] = (f32x4){0.f, 0.f, 0.f, 0.f};
    const float* wp = w_ada + (size_t)kr * 6144 + task * 32 + ch * 4;
    for (int it = 0; it < 16; ++it) {
        const f32x4 w = *(const f32x4*)(wp + (size_t)it * 64 * 6144); const int k = kr + it * 64;
#pragma unroll
        for (int r = 0; r < 9; ++r) acc[r] += s[r * 1024 + k] * w;
    }
#pragma unroll
    for (int r = 0; r < 9; ++r) *(LAS f32x4*)(red + (kr * 9 + r) * 32 + ch * 4) = acc[r];
    __syncthreads();
    if (tid < 288) { const int r = tid >> 5, col = tid & 31; float sum = 0.f; for (int q = 0; q < 64; ++q) sum += red[(q * 9 + r) * 32 + col]; mod[r * 6144 + task * 32 + col] = sum + b_ada[task * 32 + col]; }
    __syncthreads();
}

__device__ __forceinline__ void rope_table(f32x2* tab, int tid) {
    for (int idx = tid; idx < 1024; idx += NTHREADS) {
        const int pos = idx >> 4, i = idx & 15;
        double f = 1.0;
        for (int q = 0; q < i; ++q) f *= 0.56234132519034908;
        const float ang = (float)pos * (float)f;
        const double a = (double)ang, k = __builtin_rint(a * 0.15915494309189535), r = a - k * 6.283185307179586476925, r2 = r * r;
        double sn = r, ts = r, cs = 1.0, tc = 1.0;
        for (int n = 1; n <= 14; ++n) {
            tc *= -r2 / (double)((2 * n - 1) * (2 * n)); cs += tc;
            ts *= -r2 / (double)((2 * n) * (2 * n + 1)); sn += ts;
        }
        tab[idx] = (f32x2){(float)cs, (float)sn};
    }
}

enum { PH_PRO = 0, PH_HN, PH_IN, PH_MIX, PH_A, PH_B, PH_O, PH_WCONV, PH_H2R, PH_TOPK, PH_GU, PH_D, PH_FIN, PH_COUNT };

__global__ void __launch_bounds__(NTHREADS, 2) fwd(Args args) {
    extern __shared__ __attribute__((aligned(16))) unsigned char lds_raw[];
    LAS unsigned char* lds = (LAS unsigned char*)lds_raw;
    const int tid = threadIdx.x, lane = tid & 63, wave = __builtin_amdgcn_readfirstlane(tid >> 6);
    const int G = gridDim.x, bid = blockIdx.x;
    unsigned char* ws = args.ws;
    const int lo = args.ph_lo, hi = args.ph_hi;
#define IN(k) (lo <= (k) && (k) < hi)
    float* MOD = (float*)(ws + WS_MOD); f32x2* ROPE = (f32x2*)(ws + WS_ROPE);
    float* AFFT = (float*)(ws + WS_AFFT); int* TOPI = (int*)(ws + WS_TOPI); float* TOPW = (float*)(ws + WS_TOPW); int* SLOT = (int*)(ws + WS_SLOT);
    bf16_t* WIN = (bf16_t*)(ws + WS_WIN); bf16_t* WAB = (bf16_t*)(ws + WS_WAB); bf16_t* WO = (bf16_t*)(ws + WS_WO);
    bf16_t* H = (bf16_t*)(ws + WS_H); bf16_t* VA = (bf16_t*)(ws + WS_VA); bf16_t* KB = (bf16_t*)(ws + WS_KB); bf16_t* VB = (bf16_t*)(ws + WS_VB);
    bf16_t* GT = (bf16_t*)(ws + WS_G); bf16_t* Y = (bf16_t*)(ws + WS_Y); bf16_t* TMP = (bf16_t*)(ws + WS_TMP); bf16_t* MERGED = (bf16_t*)(ws + WS_MERGED);
    bf16_t* WGU = (bf16_t*)(ws + WS_WGU); bf16_t* WD = (bf16_t*)(ws + WS_WD); bf16_t* H2 = (bf16_t*)(ws + WS_H2); bf16_t* ACT = (bf16_t*)(ws + WS_ACT); bf16_t* YB = (bf16_t*)(ws + WS_YB);
    const int gw = bid * NWAVES + wave, NGW = G * NWAVES;

    if (IN(PH_PRO)) {
        if (bid < 192) adaln_task(bid, args.in[I_C], args.in[I_CCTX], args.in[I_WADA], args.in[I_BADA], MOD, (LAS float*)lds, tid);
        else if (bid == 192) rope_table(ROPE, tid);
        __syncthreads();
        LAS float* scr = (LAS float*)(lds + wave * 16384);
        constexpr int I_IN = 16 * 176, I_P = 16 * 32;
        for (int it = gw; it < I_IN + 3 * I_P; it += NGW) {
            int r = it;
            if (r < I_IN) { const int kb = r / 176, nb = r % 176; transpose_item(args.in[I_WIN], INCOLS, kb * 64, nb * 32, WIN + (size_t)(nb * 32) * 1024 + kb * 64, 1024, scr, lane); continue; } r -= I_IN;
            if (r < I_P) { const int kb = r / 32, nb = r % 32; transpose_item(args.in[I_WPA], 1024, kb * 64, nb * 32, WAB + (size_t)(nb * 32) * 2048 + kb * 64, 2048, scr, lane); continue; } r -= I_P;
            if (r < I_P) { const int kb = r / 32, nb = r % 32; transpose_item(args.in[I_WPB], 1024, kb * 64, nb * 32, WAB + (size_t)(nb * 32) * 2048 + 1024 + kb * 64, 2048, scr, lane); continue; } r -= I_P;
            { const int kb = r / 32, nb = r % 32; transpose_item(args.in[I_WOUT], 1024, kb * 64, nb * 32, WO + (size_t)(nb * 32) * 1024 + kb * 64, 1024, scr, lane); }
        }
    }
    if (IN(PH_HN)) {
        const float* g1n = args.in[I_N1G];
        for (int row = gw; row < NROWS_H; row += NGW) {
            const float* xr; int mrow;
            if (row < NTOK) { xr = args.in[I_X] + (size_t)row * 1024; mrow = row >> 12; } else { xr = args.in[I_CTX] + (size_t)(row - NTOK) * 1024; mrow = 8; }
            const float* sh = MOD + mrow * 6144; const float* sc = sh + 1024;
            f32x4 v[4]; float ss = 0.f;
#pragma unroll
            for (int j = 0; j < 4; ++j) { v[j] = *(const f32x4*)(xr + 4 * lane + 256 * j); ss += (v[j].x * v[j].x + v[j].y * v[j].y) + (v[j].z * v[j].z + v[j].w * v[j].w); }
            const float rstd = 1.0f / sqrtf(wave_sum(ss) * (1.f / 1024.f) + EPS);
#pragma unroll
            for (int j = 0; j < 4; ++j) {
                const int col = 4 * lane + 256 * j;
                const f32x4 gv = *(const f32x4*)(g1n + col), scv = *(const f32x4*)(sc + col), shv = *(const f32x4*)(sh + col);
                const f32x4 h = (v[j] * rstd * gv) * (1.f + scv) + shv;
                st4bf(H + (size_t)row * 1024 + col, h);
            }
        }
    }
    if (IN(PH_IN)) {
        Gemm g{H, WIN, 1024, 1024, 1024, 0, 30, nullptr}; StaticOrder S; S.init(NTOK, INCOLS, G, bid, 16);
        EpiIn E{Y, VA, KB, VB, GT, args.in[I_BMG], ROPE};
        GEMM_PHASE<EpiIn, StaticOrder, false>(lds, g, S, E);
    }
    if (IN(PH_MIX)) {
        for (int task = bid; task < NB * 32; task += G) {
            const int r0 = task * 128;
            LAS float* Vt = (LAS float*)lds; LAS float* Wt = Vt + 16384; LAS float* mu = Wt + 16384; LAS float* rs = mu + 128;
            __syncthreads();
            for (int rr = 0; rr < 16; ++rr) {
                const int q = wave * 16 + rr; const bf16_t* vr = VA + (size_t)(r0 + q) * 1024;
                f32x4 a[4]; float s = 0.f;
#pragma unroll
                for (int j = 0; j < 4; ++j) { a[j] = ld4bf(vr + 4 * lane + 256 * j); s += (a[j].x + a[j].y) + (a[j].z + a[j].w); }
                const float mean = wave_sum(s) * (1.f / 1024.f); float s2 = 0.f;
#pragma unroll
                for (int j = 0; j < 4; ++j) { const f32x4 d = a[j] - mean; s2 += (d.x * d.x + d.y * d.y) + (d.z * d.z + d.w * d.w); }
                const float rstd = 1.0f / sqrtf(wave_sum(s2) * (1.f / 1024.f) + EPS);
                if (lane == 0) { mu[q] = mean; rs[q] = rstd; }
            }
            __syncthreads();
            for (int g8 = 0; g8 < 8; ++g8) {
                for (int idx = tid; idx < 16384; idx += NTHREADS) {
                    const int q = idx >> 7, d = idx & 127;
                    const float v = bf2f(VA[(size_t)(r0 + q) * 1024 + g8 * 128 + d]);
                    Vt[idx] = (v - mu[q]) * rs[q] * args.in[I_LNG][g8 * 128 + d] + args.in[I_LNB][g8 * 128 + d];
                    Wt[idx] = args.in[I_WSP][g8 * 16384 + idx];
                }
                __syncthreads();
                const int p = tid >> 2, dq = (tid & 3) * 32;
                float acc[32];
#pragma unroll
                for (int j = 0; j < 32; ++j) acc[j] = 0.f;
                for (int q = 0; q < 128; ++q) {
                    const float w = Wt[p * 128 + q];
#pragma unroll
                    for (int j = 0; j < 32; j += 4) { const f32x4 vv = *(const LAS f32x4*)(Vt + q * 128 + dq + j); acc[j] += w * vv.x; acc[j + 1] += w * vv.y; acc[j + 2] += w * vv.z; acc[j + 3] += w * vv.w; }
                }
                const float bs = args.in[I_BSP][g8 * 128 + p];
                bf16_t* yp = Y + (size_t)(r0 + p) * 2048 + g8 * 128 + dq;
#pragma unroll
                for (int j = 0; j < 32; j += 4) {
                    const f32x4 uu = ld4bf(yp + j);
                    st4bf(yp + j, (f32x4){uu.x * (acc[j] + bs), uu.y * (acc[j + 1] + bs), uu.z * (acc[j + 2] + bs), uu.w * (acc[j + 3] + bs)});
                }
                __syncthreads();
            }
        }
        for (int task = bid; task < NB * 32 * 4; task += G) {
            const int kvh = task & 3, n = (task >> 2) & 31, b = task >> 7;
            const int hq = tid >> 7, qi = tid & 127, head = kvh * 4 + hq;
            const size_t row = (size_t)b * SEQ + n * 128 + qi;
            bf16_t* qp = Y + row * 2048 + 1024 + head * 64;
            float q[64], o[64];
#pragma unroll
            for (int d = 0; d < 64; d += 4) { const f32x4 t = ld4bf(qp + d); q[d] = t.x; q[d + 1] = t.y; q[d + 2] = t.z; q[d + 3] = t.w; o[d] = 0.f; o[d + 1] = 0.f; o[d + 2] = 0.f; o[d + 3] = 0.f; }
            float m = -1e30f, l = 0.f;
            LAS float* Kt = (LAS float*)lds; LAS float* Vt = Kt + 128 * 64;
            for (int tile = 0; tile < 5; ++tile) {
                int krow0, kpos0; bool local;
                if (tile < 3) { const int blk = n + tile - 1; if (blk < 0 || blk >= 32) continue; krow0 = b * SEQ + blk * 128; kpos0 = blk * 128; local = true; }
                else { krow0 = NTOK + b * CTXL + (tile - 3) * 128; kpos0 = 0; local = false; }
                __syncthreads();
                for (int idx = tid; idx < 128 * 16; idx += NTHREADS) {
                    const int j = idx >> 4, d4 = (idx & 15) * 4;
                    *(LAS f32x4*)(Kt + j * 64 + d4) = ld4bf(KB + (size_t)(krow0 + j) * 256 + kvh * 64 + d4);
                    *(LAS f32x4*)(Vt + j * 64 + d4) = ld4bf(VB + (size_t)(krow0 + j) * 256 + kvh * 64 + d4);
                }
                __syncthreads();
                const int qpos = n * 128 + qi;
                for (int j = 0; j < 128; ++j) {
                    float s = 0.f;
#pragma unroll
                    for (int d = 0; d < 64; d += 4) { const f32x4 kk = *(const LAS f32x4*)(Kt + j * 64 + d); s += q[d] * kk.x + q[d + 1] * kk.y + q[d + 2] * kk.z + q[d + 3] * kk.w; }
                    bool valid = true;
                    if (local) { const int rel = kpos0 + j - qpos; valid = (rel <= 128) && (rel >= -128); }
                    if (valid) {
                        if (s > m) { const float f = exp2f(m - s); l *= f;
#pragma unroll
                            for (int d = 0; d < 64; ++d) o[d] *= f;
                            m = s; }
                        const float p = exp2f(s - m); l += p;
#pragma unroll
                        for (int d = 0; d < 64; d += 4) { const f32x4 vv = *(const LAS f32x4*)(Vt + j * 64 + d); o[d] += p * vv.x; o[d + 1] += p * vv.y; o[d + 2] += p * vv.z; o[d + 3] += p * vv.w; }
                    }
                }
            }
            { const float s2 = args.in[I_SINK][head] * LOG2E, mf = fmaxf(m, s2), f = exp2f(m - mf); l = l * f + exp2f(s2 - mf); const float inv = f / l;
#pragma unroll
              for (int d = 0; d < 64; d += 4) st4bf(qp + d, (f32x4){o[d] * inv, o[d + 1] * inv, o[d + 2] * inv, o[d + 3] * inv}); }
            __syncthreads();
        }
    }
    if (IN(PH_A)) {
        Gemm g{Y, WAB, 2048, 2048, 1024, 0, 30, nullptr}; StaticOrder S; S.init(NTOK, 1024, G, bid);
        EpiA E{TMP, GT};
        GEMM_PHASE<EpiA, StaticOrder, false>(lds, g, S, E);
    }
    if (IN(PH_B)) {
        Gemm g{Y + 1024, WAB + 1024, 2048, 2048, 1024, 0, 30, nullptr}; StaticOrder S; S.init(NTOK, 1024, G, bid);
        EpiB E{MERGED, TMP, GT};
        GEMM_PHASE<EpiB, StaticOrder, false>(lds, g, S, E);
    }
    if (IN(PH_O)) {
        Gemm g{MERGED, WO, 1024, 1024, 1024, 0, 30, nullptr}; StaticOrder S; S.init(NTOK, 1024, G, bid);
        EpiO E{args.out, args.in[I_X], MOD};
        GEMM_PHASE<EpiO, StaticOrder, false>(lds, g, S, E);
    }
    if (IN(PH_WCONV)) {
        LAS float* scr = (LAS float*)(lds + wave * 16384);
        constexpr int I_G = 16 * 16 * 64, I_D = 16 * 32 * 32;
        for (int it = gw; it < 2 * I_G + I_D; it += NGW) {
            int r = it;
            if (r < 2 * I_G) {
                const int up = r >= I_G; if (up) r -= I_G;
                const int e = r >> 10, kb = (r >> 6) & 15, nb = r & 63, n0 = nb * 32;
                const int drow = 256 * (n0 >> 7) + (n0 & 127) + (up ? 128 : 0);
                transpose_item(args.in[up ? I_WEU : I_WEG] + (size_t)e * 1024 * 2048, 2048, kb * 64, n0, WGU + (size_t)e * 4096 * 1024 + (size_t)drow * 1024 + kb * 64, 1024, scr, lane);
            } else {
                r -= 2 * I_G;
                const int e = r >> 10, kb = (r >> 5) & 31, nb = r & 31;
                transpose_item(args.in[I_WED] + (size_t)e * 2048 * 1024, 1024, kb * 64, nb * 32, WD + (size_t)e * 1024 * 2048 + (size_t)(nb * 32) * 2048 + kb * 64, 2048, scr, lane);
            }
        }
    }
    if (IN(PH_H2R)) {
        LAS float* wT = (LAS float*)lds;
        for (int i = tid; i < 16384; i += NTHREADS) { const int col = i >> 4, e = i & 15; wT[e * 1024 + col] = args.in[I_WR][i]; }
        __syncthreads();
        const float* g2n = args.in[I_N2G];
        for (int row = gw; row < NTOK; row += NGW) {
            const float* xr = args.out + (size_t)row * 1024; const int b = row >> 12, t = row & (SEQ - 1);
            const float* sh = MOD + b * 6144 + 3072; const float* sc = sh + 1024;
            f32x4 v[4]; float ss = 0.f;
#pragma unroll
            for (int j = 0; j < 4; ++j) { v[j] = *(const f32x4*)(xr + 4 * lane + 256 * j); ss += (v[j].x * v[j].x + v[j].y * v[j].y) + (v[j].z * v[j].z + v[j].w * v[j].w); }
            const float rstd = 1.0f / sqrtf(wave_sum(ss) * (1.f / 1024.f) + EPS);
            float lg[16];
#pragma unroll
            for (int e = 0; e < 16; ++e) lg[e] = 0.f;
#pragma unroll
            for (int j = 0; j < 4; ++j) {
                const int col = 4 * lane + 256 * j;
                const f32x4 gv = *(const f32x4*)(g2n + col), scv = *(const f32x4*)(sc + col), shv = *(const f32x4*)(sh + col);
                const f32x4 h = (v[j] * rstd * gv) * (1.f + scv) + shv;
                st4bf(H2 + (size_t)row * 1024 + col, h);
#pragma unroll
                for (int e = 0; e < 16; ++e) { const f32x4 w = *(const LAS f32x4*)(wT + e * 1024 + col); lg[e] += (h.x * w.x + h.y * w.y) + (h.z * w.z + h.w * w.w); if ((e & 3) == 3) asm volatile("" ::: "memory"); }
            }
            float mx = -1e30f;
#pragma unroll
            for (int e = 0; e < 16; ++e) { lg[e] = wave_sum(lg[e]); mx = fmaxf(mx, lg[e]); }
            float den = 0.f;
#pragma unroll
            for (int e = 0; e < 16; ++e) { lg[e] = __expf(lg[e] - mx); den += lg[e]; }
            float mine = 0.f;
#pragma unroll
            for (int e = 0; e < 16; ++e) mine = (lane == e) ? lg[e] : mine;
            if (lane < 16) AFFT[(size_t)(b * 16 + lane) * SEQ + t] = mine / den;
        }
    }
    if (IN(PH_TOPK)) {
        LAS int* wsum = (LAS int*)lds;
        for (int task = bid; task < NE * NB; task += G) {
            const int e = task >> 3, b = task & 7;
            const float* aff = AFFT + (size_t)(b * 16 + e) * SEQ;
            unsigned k[8];
            { const u32x4 a0 = *(const u32x4*)(aff + 8 * tid), a1 = *(const u32x4*)(aff + 8 * tid + 4); k[0] = a0.x; k[1] = a0.y; k[2] = a0.z; k[3] = a0.w; k[4] = a1.x; k[5] = a1.y; k[6] = a1.z; k[7] = a1.w; }
            unsigned T = 0u; int it = 0;
            __syncthreads();
            for (int bit = 30; bit >= 0; --bit, ++it) {
                const unsigned cand = T | (1u << bit); int c = 0;
#pragma unroll
                for (int j = 0; j < 8; ++j) c += (k[j] >= cand) ? 1 : 0;
                c = wave_sum_i(c);
                if (lane == 0) wsum[(it & 1) * 8 + wave] = c;
                __syncthreads();
                int tot = 0;
#pragma unroll
                for (int w = 0; w < 8; ++w) tot += wsum[(it & 1) * 8 + w];
                if (tot >= CAP) T = cand;
            }
            int cg = 0, ce = 0;
#pragma unroll
            for (int j = 0; j < 8; ++j) { cg += (k[j] > T) ? 1 : 0; ce += (k[j] == T) ? 1 : 0; }
            LAS int* sc1 = wsum + 16; LAS int* sc2 = wsum + 32;
            int ie = ce, ig = cg;
#pragma unroll
            for (int o = 1; o < 64; o <<= 1) { const int te = __shfl_up(ie, o), tg = __shfl_up(ig, o); if (lane >= o) { ie += te; ig += tg; } }
            __syncthreads();
            if (lane == 63) { sc1[wave] = ie; sc2[wave] = ig; }
            __syncthreads();
            int ebase = ie - ce, totg = 0;
#pragma unroll
            for (int w = 0; w < 8; ++w) { if (w < wave) ebase += sc1[w]; totg += sc2[w]; }
            const int need = CAP - totg;
            int sel[8], cs = 0, er = ebase;
#pragma unroll
            for (int j = 0; j < 8; ++j) { const bool eq = (k[j] == T); sel[j] = (k[j] > T) || (eq && er < need); er += eq ? 1 : 0; cs += sel[j]; }
            int is = cs;
#pragma unroll
            for (int o = 1; o < 64; o <<= 1) { const int ts = __shfl_up(is, o); if (lane >= o) is += ts; }
            __syncthreads();
            if (lane == 63) sc1[wave] = is;
            __syncthreads();
            int sbase = is - cs;
#pragma unroll
            for (int w = 0; w < 8; ++w) if (w < wave) sbase += sc1[w];
#pragma unroll
            for (int j = 0; j < 8; ++j) {
                const int t = 8 * tid + j; int slot = -1;
                if (sel[j]) { slot = sbase; ++sbase; const int prow = (e * 8 + b) * CAP + slot; TOPI[prow] = t; TOPW[prow] = __uint_as_float(k[j]); }
                SLOT[((size_t)b * SEQ + t) * 16 + e] = slot;
            }
            __syncthreads();
        }
    }
    if (IN(PH_GU)) {
        Gemm g{H2, WGU, 1024, 1024, 1024, (size_t)4096 * 1024, 4, TOPI}; StaticOrder S; S.init(NPAIR, 4096, G, bid);
        EpiGU E{ACT};
        GEMM_PHASE<EpiGU, StaticOrder, true>(lds, g, S, E);
    }
    if (IN(PH_D)) {
        Gemm g{ACT, WD, 2048, 2048, 2048, (size_t)1024 * 2048, 4, nullptr}; StaticOrder S; S.init(NPAIR, 1024, G, bid);
        EpiD E{YB, TOPW};
        GEMM_PHASE<EpiD, StaticOrder, false>(lds, g, S, E);
    }
    if (IN(PH_FIN)) {
        const float* fg = args.in[I_FING];
        for (int row = gw; row < NTOK; row += NGW) {
            float* xr = args.out + (size_t)row * 1024; const int b = row >> 12;
            const float* g2 = MOD + b * 6144 + 5120;
            const int* sl = SLOT + (size_t)row * 16;
            f32x4 a[4];
#pragma unroll
            for (int j = 0; j < 4; ++j) a[j] = (f32x4){0.f, 0.f, 0.f, 0.f};
            for (int e = 0; e < 16; ++e) {
                const int s = sl[e];
                if (s >= 0) { const bf16_t* yr = YB + (size_t)((e * 8 + b) * CAP + s) * 1024;
#pragma unroll
                    for (int j = 0; j < 4; ++j) a[j] += ld4bf(yr + 4 * lane + 256 * j); }
            }
            f32x4 v[4]; float ss = 0.f;
#pragma unroll
            for (int j = 0; j < 4; ++j) { const int col = 4 * lane + 256 * j; v[j] = *(const f32x4*)(xr + col) + *(const f32x4*)(g2 + col) * a[j]; ss += (v[j].x * v[j].x + v[j].y * v[j].y) + (v[j].z * v[j].z + v[j].w * v[j].w); }
            const float rstd = 1.0f / sqrtf(wave_sum(ss) * (1.f / 1024.f) + EPS);
#pragma unroll
            for (int j = 0; j < 4; ++j) { const int col = 4 * lane + 256 * j; *(f32x4*)(xr + col) = v[j] * rstd * *(const f32x4*)(fg + col); }
        }
    }
#undef IN
}

extern "C" void kernel_launch(void* const* d_in, const int* in_sizes, int n_in, void* d_out, int out_size, void* d_ws, size_t ws_size, hipStream_t stream) {
    static int grid = 0;
    if (grid == 0) {
        if (n_in != 23 || in_sizes[0] != NTOK * DM || out_size != NTOK * DM || ws_size < WS_END) {
            fprintf(stderr, "kernel_launch: unexpected problem (n_in %d, in0 %d, out %d, ws %zu < %zu?)\n", n_in, n_in > 0 ? in_sizes[0] : -1, out_size, ws_size, (size_t)WS_END); grid = -1; return; }
        if (hipFuncSetAttribute((const void*)fwd, hipFuncAttributeMaxDynamicSharedMemorySize, LDS_BYTES) != hipSuccess) { fprintf(stderr, "kernel_launch: hipFuncSetAttribute failed\n"); grid = -1; return; }
        int dev = 0, cus = 0;
        if (hipGetDevice(&dev) != hipSuccess || hipDeviceGetAttribute(&cus, hipDeviceAttributeMultiprocessorCount, dev) != hipSuccess) { grid = -1; return; }
        grid = cus;
    }
    if (grid < 0) return;
    (void)hipMemsetAsync((char*)d_ws + WS_CTL, 0, 1 * MiB, stream);
    Args a{};
    for (int i = 0; i < 23; ++i) a.in[i] = (const float*)d_in[i];
    a.out = (float*)d_out; a.ws = (unsigned char*)d_ws;
    for (int ph = 0; ph < PH_COUNT; ++ph) {
        a.ph_lo = ph; a.ph_hi = ph + 1;
        hipLaunchKernelGGL(fwd, dim3(grid), dim3(NTHREADS), LDS_BYTES, stream, a);
    }
}
```

```cpp
#include <hip/hip_runtime.h>
#include <cstdio>
#include <cstdint>

#define LAS __attribute__((address_space(3)))
typedef unsigned short bf16_t;
typedef float f32x4 __attribute__((ext_vector_type(4)));
typedef float f32x2 __attribute__((ext_vector_type(2)));
typedef unsigned u32x4 __attribute__((ext_vector_type(4)));
typedef unsigned u32x2 __attribute__((ext_vector_type(2)));
typedef int i32x4 __attribute__((ext_vector_type(4)));

constexpr int DM = 1024, NB = 8, SEQ = 4096, NTOK = NB * SEQ, CTXL = 256, NCTX = NB * CTXL, NROWS_H = NTOK + NCTX;
constexpr int INCOLS = 5632, OFF_Q = 2048, OFF_K = 3072, OFF_VB = 3328, OFF_GATE = 3584;
constexpr int NE = 16, CAP = 512, DE = 2048, NPAIR = NE * NB * CAP;
constexpr float EPS = 1e-6f, LOG2E = 1.4426950408889634f, C2 = 0.125f * LOG2E;
constexpr int NTHREADS = 512, NWAVES = 8;

constexpr size_t MiB = 1u << 20;
constexpr size_t WS_CTL = 0;
constexpr size_t WS_MOD = 1 * MiB;
constexpr size_t WS_ROPE = 1 * MiB + 512 * 1024;
constexpr size_t WS_AFFT = 2 * MiB;
constexpr size_t WS_TOPI = 4 * MiB;
constexpr size_t WS_TOPW = 4 * MiB + 512 * 1024;
constexpr size_t WS_SLOT = 5 * MiB;
constexpr size_t WS_WSP = 7 * MiB;
constexpr size_t WS_WIN = 8 * MiB;
constexpr size_t WS_WAB = 19 * MiB;
constexpr size_t WS_WO = 23 * MiB;
constexpr size_t WS_R = 25 * MiB;
constexpr size_t WS_H = WS_R;
constexpr size_t WS_VA = WS_R + 68 * MiB;
constexpr size_t WS_KB = WS_VA + 64 * MiB;
constexpr size_t WS_VB = WS_KB + 17 * MiB;
constexpr size_t WS_G = WS_VB + 17 * MiB;
constexpr size_t WS_Y = WS_G + 128 * MiB;
constexpr size_t WS_TMP = WS_Y + 128 * MiB;
constexpr size_t WS_STATS = WS_TMP + 64 * MiB;
constexpr size_t WS_MERGED = WS_H;
constexpr size_t WS_WGU = WS_R;
constexpr size_t WS_WD = WS_R + 128 * MiB;
constexpr size_t WS_H2 = WS_R + 192 * MiB;
constexpr size_t WS_ACT = WS_R + 256 * MiB;
constexpr size_t WS_YB = WS_WGU;
constexpr size_t WS_END = 537 * MiB;
static_assert(WS_STATS + 4 * MiB <= WS_END && WS_ACT + 256 * MiB == WS_END, "ws map");

constexpr int LDS_BYTES = 147456;

__device__ __forceinline__ float bf2f(unsigned b) { return __uint_as_float(b << 16); }
__device__ __forceinline__ unsigned f2bf(float f) { unsigned u = __float_as_uint(f); return (u + 0x7fffu + ((u >> 16) & 1u)) >> 16; }
__device__ __forceinline__ unsigned pk2(float lo, float hi) { typedef float f2_ __attribute__((ext_vector_type(2))); typedef __bf16 b2_ __attribute__((ext_vector_type(2))); f2_ v = {lo, hi}; b2_ b = __builtin_convertvector(v, b2_); return __builtin_bit_cast(unsigned, b); }
__device__ __forceinline__ void st4bf(bf16_t* p, f32x4 v) { u32x2 w; w.x = pk2(v.x, v.y); w.y = pk2(v.z, v.w); *(u32x2*)p = w; }
__device__ __forceinline__ void st8bf(bf16_t* p, f32x4 a, f32x4 b) { u32x4 w; w.x = pk2(a.x, a.y); w.y = pk2(a.z, a.w); w.z = pk2(b.x, b.y); w.w = pk2(b.z, b.w); *(u32x4*)p = w; }
__device__ __forceinline__ void ld8bf(const bf16_t* p, f32x4& a, f32x4& b) { const u32x4 w = *(const u32x4*)p; a.x = bf2f(w.x & 0xffffu); a.y = bf2f(w.x >> 16); a.z = bf2f(w.y & 0xffffu); a.w = bf2f(w.y >> 16); b.x = bf2f(w.z & 0xffffu); b.y = bf2f(w.z >> 16); b.z = bf2f(w.w & 0xffffu); b.w = bf2f(w.w >> 16); }
__device__ __forceinline__ f32x4 ld4bf(const bf16_t* p) { const u32x2 w = *(const u32x2*)p; f32x4 v; v.x = bf2f(w.x & 0xffffu); v.y = bf2f(w.x >> 16); v.z = bf2f(w.y & 0xffffu); v.w = bf2f(w.y >> 16); return v; }
__device__ __forceinline__ float sigmoidf_(float x) { return __builtin_amdgcn_rcpf(1.f + __expf(-x)); }
__device__ __forceinline__ float siluf_(float x) { return x * __builtin_amdgcn_rcpf(1.f + __expf(-x)); }
__device__ __forceinline__ float gelu_t(float x) { const float z2 = 1.5957691216057308f * (x + 0.044715f * x * x * x); return x * __builtin_amdgcn_rcpf(1.f + __expf(-z2)); }
__device__ __forceinline__ float wave_sum(float v) {
#pragma unroll
    for (int o = 1; o < 64; o <<= 1) v += __shfl_xor(v, o);
    return v;
}
__device__ __forceinline__ int wave_sum_i(int v) {
#pragma unroll
    for (int o = 1; o < 64; o <<= 1) v += __shfl_xor(v, o);
    return v;
}
#define LDS_WAIT() asm volatile("s_waitcnt lgkmcnt(0)" ::: "memory")

struct Args { const float* in[23]; float* out; unsigned char* ws; int ph_lo, ph_hi, flags, pad; };
enum { I_X = 0, I_C, I_CTX, I_CCTX, I_WADA, I_BADA, I_N1G, I_WIN, I_BMG, I_LNG, I_LNB, I_WSP, I_BSP, I_SINK, I_WPA, I_WPB, I_WOUT, I_N2G, I_WR, I_WEG, I_WEU, I_WED, I_FING };

struct Unit { int pm, pn; };
struct Gemm {
    const bf16_t* A; const bf16_t* Bt; int lda, ldb, K;
    size_t bgs; int tpg_shift;
    const int* gidx;
};
constexpr int NXCD = 8, WGM = 8;
struct StaticOrder {
    int nM, nN, nwg, G, c, extra, rev;
    __device__ void init(int M, int N, int G_, int c_, int extra_ = 0, int rev_ = 0) { nM = M / 256; nN = N / 256; nwg = nM * nN; G = G_; c = c_; extra = extra_; rev = rev_; }
    __device__ bool next(int i, Unit& u) const {
        const long L = (long)i * G + c;
        if (L >= nwg) { const int x = (int)(L - nwg); if (x >= extra) return false; u.pm = NTOK / 256 + (x >> 1); u.pn = 12 + (x & 1); return true; }
        int wgid = (int)L; { const int q = nwg / NXCD, r = nwg % NXCD, xcd = wgid % NXCD, off = wgid / NXCD; wgid = (xcd < r ? xcd * (q + 1) : r * (q + 1) + (xcd - r) * q) + off; }
        const int nig = WGM * nN, gid = wgid / nig, fm = gid * WGM, gsz = (nM - fm) < WGM ? (nM - fm) : WGM;
        u.pm = fm + ((wgid % nig) % gsz); u.pn = (wgid % nig) / gsz; if (rev) u.pm = nM - 1 - u.pm; return true;
    }
};

struct OneUnit { int pm, pn; __device__ bool next(int i, Unit& u) const { if (i) return false; u.pm = pm; u.pn = pn; return true; } };

typedef f32x4 Acc[2][2][4][2];

namespace pg8 {
typedef short bf16x8 __attribute__((ext_vector_type(8)));
constexpr int BK = 64, HALF = 128, HTB = HALF * BK * 2, STAGE_BYTES = 8 * HTB;
__device__ __forceinline__ int lds_byte(int r, int c) { const int st = (r >> 4) * 2 + (c >> 5), rr = r & 15, cc = c & 31, ob = rr * 64 + cc * 2; return st * 1024 + (ob ^ (((ob >> 9) & 1) << 5)); }
__device__ __forceinline__ void stage_rc(int b, int& R, int& C) { const int st = b / 1024, sb = b % 1024, swz = sb ^ (((sb >> 9) & 1) << 5); R = (st >> 1) * 16 + swz / 64; C = (st & 1) * 32 + (swz % 64) / 2; }

template <class Epi, class Sched, bool GATHER, bool HOOK = false>
__device__ __forceinline__ void gemm_phase(LAS unsigned char* lds, const Gemm g, const Sched& S, const Epi& E) {
    const int tid = threadIdx.x, wid = __builtin_amdgcn_readfirstlane(tid >> 6), lane = tid & 63, wr = wid >> 2, wc = wid & 3, fr = lane & 15, fq = lane >> 4;
    const int nt = g.K / BK;
    int Rs[2], Cs[2]; unsigned voffBp[2][2], voffB[2], voffBn[2], vA[2][2], vN[2][2];
#pragma unroll
    for (int i = 0; i < 2; ++i) { stage_rc(tid * 16 + i * 8192, Rs[i], Cs[i]); voffBp[0][i] = (unsigned)(Rs[i] * g.ldb + Cs[i]) * 2u;
        const int rho = Rs[i] & 31, Rb = (Rs[i] & ~31) + 8 * ((rho & 15) >> 2) + 4 * (rho >> 4) + (rho & 3); voffBp[1][i] = (unsigned)(Rb * g.ldb + Cs[i]) * 2u; }
    const size_t kstep = (size_t)(BK * 2);
    const size_t hstepB = (size_t)HALF * g.ldb * 2;
    const unsigned ldsw = (unsigned)wid * 1024u;
    const int aoff = lds_byte(wr * 64 + fr, fq * 8), boff = lds_byte(wc * 32 + fr, fq * 8);
#define PG8_SA(b, h) (((b) * 2 + (h)) * HTB)
#define PG8_SB(b, h) ((4 + (b) * 2 + (h)) * HTB)
#define PG8_STAGE(bufoff, gbase, voff) do { _Pragma("unroll") for (int _i = 0; _i < 2; ++_i) \
        __builtin_amdgcn_global_load_lds((const unsigned*)((const char*)(gbase) + (voff)[_i]), (LAS unsigned*)(lds + (bufoff) + ldsw + _i * 8192), 16, 0, 0); } while (0)
#define PG8_LDA(dst, b, h) do { _Pragma("unroll") for (int m = 0; m < 4; ++m) _Pragma("unroll") for (int k = 0; k < 2; ++k) dst[m][k] = *(const LAS bf16x8*)(lds + PG8_SA(b, h) + aoff + m * 2048 + k * 1024); } while (0)
#define PG8_LDB(dst, b, h) do { _Pragma("unroll") for (int n = 0; n < 2; ++n) _Pragma("unroll") for (int k = 0; k < 2; ++k) dst[n][k] = *(const LAS bf16x8*)(lds + PG8_SB(b, h) + boff + n * 2048 + k * 1024); } while (0)
#define PG8_MMA(ai, bj, At, Bt) do { __builtin_amdgcn_s_setprio(1); _Pragma("unroll") for (int m = 0; m < 4; ++m) _Pragma("unroll") for (int n = 0; n < 2; ++n) _Pragma("unroll") for (int k = 0; k < 2; ++k) \
        acc[ai][bj][m][n] = __builtin_amdgcn_mfma_f32_16x16x32_bf16(Bt[n][k], At[m][k], acc[ai][bj][m][n], 0, 0, 0); __builtin_amdgcn_s_setprio(0); } while (0)
#define PG8_WAIT_V(n) asm volatile("s_waitcnt vmcnt(" #n ")" ::: "memory")
#define PG8_WAIT_L(n) asm volatile("s_waitcnt lgkmcnt(" #n ")" ::: "memory")
#define PG8_BAR __builtin_amdgcn_s_barrier()
#define PG8_SCHED __builtin_amdgcn_sched_barrier(0)
#define PG8_AVOFF(dst, U) do { _Pragma("unroll") for (int _h = 0; _h < 2; ++_h) _Pragma("unroll") for (int _i = 0; _i < 2; ++_i) \
        dst[_h][_i] = GATHER ? (unsigned)((((U).pm >> 1) & 7) * SEQ + g.gidx[(U).pm * 256 + _h * 128 + Rs[_i]]) * (unsigned)(g.lda * 2) + (unsigned)(Cs[_i] * 2) \
                             : (unsigned)((_h * 128 + Rs[_i]) * g.lda + Cs[_i]) * 2u; } while (0)
#define PG8_ABASE(U) ((const char*)g.A + (GATHER ? (size_t)0 : (size_t)(U).pm * 256 * g.lda * 2))
#define PG8_BBASE(U) ((const char*)g.Bt + ((size_t)((U).pm >> g.tpg_shift) * g.bgs + (size_t)(U).pn * 256 * g.ldb) * 2)
    Unit cur, nxt; int ui = 0;
    if (!S.next(0, cur)) return;
    Acc acc;
#pragma unroll
    for (int a = 0; a < 2; ++a)
#pragma unroll
        for (int b = 0; b < 2; ++b)
#pragma unroll
            for (int m = 0; m < 4; ++m)
#pragma unroll
                for (int n = 0; n < 2; ++n) acc[a][b][m][n] = (f32x4){0.f, 0.f, 0.f, 0.f};
    bf16x8 At[4][2], B0[2][2], B1[2][2];
    PG8_AVOFF(vA, cur);
    { const bool pc = E.perm(cur); voffB[0] = pc ? voffBp[1][0] : voffBp[0][0]; voffB[1] = pc ? voffBp[1][1] : voffBp[0][1]; }
    const char* cA = PG8_ABASE(cur); const char* cB = PG8_BBASE(cur);
    PG8_STAGE(PG8_SB(0, 0), cB, voffB); PG8_STAGE(PG8_SB(0, 1), cB + hstepB, voffB); PG8_STAGE(PG8_SA(0, 0), cA, vA[0]); PG8_STAGE(PG8_SA(0, 1), cA, vA[1]);
    if (wr == 1) PG8_BAR;
    PG8_WAIT_V(2); PG8_BAR;
    PG8_STAGE(PG8_SB(1, 0), cB + kstep, voffB); PG8_STAGE(PG8_SA(1, 0), cA + kstep, vA[0]); PG8_STAGE(PG8_SB(1, 1), cB + hstepB + kstep, voffB);
    PG8_WAIT_V(6); PG8_BAR;
    for (;;) {
        const bool has_next = S.next(ui + 1, nxt);
        const char* nA = has_next ? PG8_ABASE(nxt) : cA; const char* nB = has_next ? PG8_BBASE(nxt) : cB;
        { const bool pn_ = has_next ? E.perm(nxt) : E.perm(cur); voffBn[0] = pn_ ? voffBp[1][0] : voffBp[0][0]; voffBn[1] = pn_ ? voffBp[1][1] : voffBp[0][1]; }
        if (GATHER) {
#pragma unroll
            for (int h = 0; h < 2; ++h)
#pragma unroll
                for (int i = 0; i < 2; ++i) vN[h][i] = vA[h][i];
            if (has_next && wid == 0)
                __builtin_amdgcn_global_load_lds((const unsigned*)(g.gidx + nxt.pm * 256 + lane * 4), (LAS unsigned*)(lds + STAGE_BYTES + (ui & 1) * 1024), 16, 0, 0);
        }
        for (int t = 0; t < nt; t += 2) {
            const bool last = (t == nt - 2);
            if (GATHER) { if (t == 4 && has_next) {
                const LAS int* li = (const LAS int*)(lds + STAGE_BYTES + (ui & 1) * 1024);
#pragma unroll
                for (int h = 0; h < 2; ++h)
#pragma unroll
                    for (int i = 0; i < 2; ++i) vN[h][i] = (unsigned)(((nxt.pm >> 1) & 7) * SEQ + li[h * 128 + Rs[i]]) * (unsigned)(g.lda * 2) + (unsigned)(Cs[i] * 2);
            } }
            if constexpr (HOOK) { if (t == (nt >> 1)) E.mid(acc, cur, wr, wc, fr, fq); }
            const char* a1 = cA + (size_t)(t + 1) * kstep;
            const char* a2 = last ? nA : cA + (size_t)(t + 2) * kstep; const char* b2 = last ? nB : cB + (size_t)(t + 2) * kstep;
            const char* a3 = a2 + kstep; const char* b3 = b2 + kstep;
            unsigned v2[2][2];
#pragma unroll
            for (int h = 0; h < 2; ++h)
#pragma unroll
                for (int i = 0; i < 2; ++i) v2[h][i] = (GATHER && last) ? vN[h][i] : vA[h][i];
            unsigned vb2[2]; vb2[0] = last ? voffBn[0] : voffB[0]; vb2[1] = last ? voffBn[1] : voffB[1];
            PG8_LDB(B0, 0, 0); PG8_LDB(B1, 0, 1); PG8_SCHED; PG8_LDA(At, 0, 0); PG8_STAGE(PG8_SA(1, 1), a1, vA[1]);
            PG8_WAIT_V(8); PG8_WAIT_L(0); PG8_BAR; PG8_MMA(0, 0, At, B0); PG8_MMA(0, 1, At, B1); PG8_BAR; PG8_SCHED;
            PG8_LDA(At, 0, 1); PG8_STAGE(PG8_SB(0, 0), b2, vb2); PG8_STAGE(PG8_SB(0, 1), b2 + hstepB, vb2); PG8_STAGE(PG8_SA(0, 0), a2, v2[0]);
            PG8_WAIT_V(8); PG8_WAIT_L(0); PG8_BAR; PG8_MMA(1, 0, At, B0); PG8_MMA(1, 1, At, B1); PG8_BAR; PG8_SCHED;
            PG8_LDB(B0, 1, 0); PG8_LDB(B1, 1, 1); PG8_SCHED; PG8_LDA(At, 1, 0); PG8_STAGE(PG8_SA(0, 1), a2, v2[1]);
            PG8_WAIT_V(8); PG8_WAIT_L(0); PG8_BAR; PG8_MMA(0, 0, At, B0); PG8_MMA(0, 1, At, B1); PG8_BAR; PG8_SCHED;
            PG8_LDA(At, 1, 1); PG8_STAGE(PG8_SB(1, 0), b3, vb2); PG8_STAGE(PG8_SB(1, 1), b3 + hstepB, vb2); PG8_STAGE(PG8_SA(1, 0), a3, v2[0]);
            PG8_WAIT_V(8); PG8_WAIT_L(0); PG8_BAR; PG8_MMA(1, 0, At, B0); PG8_MMA(1, 1, At, B1); PG8_BAR; PG8_SCHED;
        }
        if (wr == 0) PG8_BAR;
        E(acc, cur, wr, wc, fr, fq);
        if (!has_next) break;
#pragma unroll
        for (int a = 0; a < 2; ++a)
#pragma unroll
            for (int b = 0; b < 2; ++b)
#pragma unroll
                for (int m = 0; m < 4; ++m)
#pragma unroll
                    for (int n = 0; n < 2; ++n) acc[a][b][m][n] = (f32x4){0.f, 0.f, 0.f, 0.f};
        cur = nxt; cA = nA; cB = nB; ++ui; voffB[0] = voffBn[0]; voffB[1] = voffBn[1];
        if (GATHER) {
#pragma unroll
            for (int h = 0; h < 2; ++h)
#pragma unroll
                for (int i = 0; i < 2; ++i) vA[h][i] = vN[h][i];
        }
        if (wr == 1) PG8_BAR;
    }
    PG8_WAIT_V(0);
    PG8_BAR;
#undef PG8_SA
#undef PG8_SB
#undef PG8_STAGE
#undef PG8_LDA
#undef PG8_LDB
#undef PG8_MMA
#undef PG8_WAIT_V
#undef PG8_WAIT_L
#undef PG8_BAR
#undef PG8_SCHED
#undef PG8_AVOFF
#undef PG8_ABASE
#undef PG8_BBASE
}
}

#define GEMM_PHASE pg8::gemm_phase

struct EpiIn {
    bf16_t *Y, *VA, *KB, *VB, *G; const float* bgate; const f32x2* rope; f32x2* STATS;
    __device__ __forceinline__ bool perm(const Unit& u) const { return u.pn < 8 || u.pn > 12; }
    __device__ __forceinline__ void operator()(const Acc& acc, const Unit& u, int wr, int wc, int fr, int fq) const {
        const int pn = u.pn;
#pragma unroll
        for (int ai = 0; ai < 2; ++ai)
#pragma unroll
            for (int m = 0; m < 4; ++m) {
                const int row = u.pm * 256 + ai * 128 + wr * 64 + m * 16 + fr;
                float ssum = 0.f, ssq = 0.f;
#pragma unroll
                for (int bj = 0; bj < 2; ++bj) {
                    f32x4 v0 = acc[ai][bj][m][0], v1 = acc[ai][bj][m][1];
                    if (pn < 8) {
                        const int c8 = bj * 128 + wc * 32 + 8 * fq;
#pragma unroll
                        for (int j = 0; j < 4; ++j) { v0[j] = gelu_t(v0[j]); v1[j] = gelu_t(v1[j]); }
                        if (pn < 4) st8bf(Y + (size_t)row * 2048 + pn * 256 + c8, v0, v1);
                        else {
                            st8bf(VA + (size_t)row * 1024 + (pn - 4) * 256 + c8, v0, v1);
                            ssum += ((v0.x + v0.y) + (v0.z + v0.w)) + ((v1.x + v1.y) + (v1.z + v1.w));
                            ssq += ((v0.x * v0.x + v0.y * v0.y) + (v0.z * v0.z + v0.w * v0.w)) + ((v1.x * v1.x + v1.y * v1.y) + (v1.z * v1.z + v1.w * v1.w));
                        }
                    } else if (pn < 13) {
                        const int cl = bj * 128 + wc * 32 + 4 * fq;
                        f32x4 o0 = v0, o1 = v1;
                        if (row < NTOK) {
                            const int t = row & (SEQ - 1), pos = (wc & 1) ? (t & 63) : (t >> 6);
                            const f32x2* rp = rope + pos * 16 + 4 * fq;
#pragma unroll
                            for (int j = 0; j < 4; ++j) { const f32x2 cs = rp[j]; o0[j] = v0[j] * cs.x - v1[j] * cs.y; o1[j] = v0[j] * cs.y + v1[j] * cs.x; }
                        }
                        if (pn < 12) { bf16_t* p = Y + (size_t)row * 2048 + 1024 + (pn - 8) * 256 + cl; st4bf(p, o0 * C2); st4bf(p + 16, o1 * C2); }
                        else { bf16_t* p = KB + (size_t)row * 256 + cl; st4bf(p, o0); st4bf(p + 16, o1); }
                    } else if (pn == 13) {
                        st8bf(VB + (size_t)row * 256 + bj * 128 + wc * 32 + 8 * fq, v0, v1);
                    } else {
                        const int cg = (pn - 14) * 256 + bj * 128 + wc * 32 + 8 * fq;
                        const f32x4 b0 = *(const f32x4*)(bgate + cg), b1 = *(const f32x4*)(bgate + cg + 4);
#pragma unroll
                        for (int j = 0; j < 4; ++j) { v0[j] = sigmoidf_(v0[j] + b0[j]); v1[j] = sigmoidf_(v1[j] + b1[j]); }
                        st8bf(G + (size_t)row * 2048 + cg, v0, v1);
                    }
                }
                if (pn >= 4 && pn < 8) {
                    ssum += __shfl_xor(ssum, 16); ssum += __shfl_xor(ssum, 32); ssq += __shfl_xor(ssq, 16); ssq += __shfl_xor(ssq, 32);
                    if (fq == 0) STATS[(size_t)row * 16 + (pn - 4) * 4 + wc] = (f32x2){ssum, ssq};
                }
            }
    }
};
struct EpiAB {
    bf16_t* MERGED; const bf16_t* G;
    __device__ __forceinline__ bool perm(const Unit&) const { return true; }
    __device__ __forceinline__ void mid(Acc& acc, const Unit& u, int wr, int wc, int fr, int fq) const {
        int zero; asm volatile("v_mov_b32 %0, 0" : "=v"(zero));
        const bf16_t* gp = G + (size_t)(u.pm * 256 + wr * 64 + fr + zero) * 2048 + u.pn * 256 + wc * 32 + 8 * fq;
#pragma unroll
        for (int ai = 0; ai < 2; ++ai)
#pragma unroll
            for (int m = 0; m < 4; ++m) {
#pragma unroll
                for (int bj = 0; bj < 2; ++bj) {
                    const bf16_t* q = gp + (size_t)(ai * 128 + m * 16) * 2048 + bj * 128;
                    f32x4 ga0, ga1, gb0, gb1; ld8bf(q, ga0, ga1); ld8bf(q + 1024, gb0, gb1);
#pragma unroll
                    for (int j = 0; j < 4; ++j) { acc[ai][bj][m][0][j] *= ga0[j] * __builtin_amdgcn_rcpf(gb0[j]); acc[ai][bj][m][1][j] *= ga1[j] * __builtin_amdgcn_rcpf(gb1[j]); }
                    asm volatile("" ::: "memory");
                }
            }
    }
    __device__ __forceinline__ void operator()(const Acc& acc, const Unit& u, int wr, int wc, int fr, int fq) const {
#pragma unroll
        for (int ai = 0; ai < 2; ++ai)
#pragma unroll
            for (int m = 0; m < 4; ++m) {
                const int row = u.pm * 256 + ai * 128 + wr * 64 + m * 16 + fr;
#pragma unroll
                for (int bj = 0; bj < 2; ++bj) {
                    const int c8 = u.pn * 256 + bj * 128 + wc * 32 + 8 * fq;
                    f32x4 gb0, gb1; ld8bf(G + (size_t)row * 2048 + 1024 + c8, gb0, gb1);
                    st8bf(MERGED + (size_t)row * 1024 + c8, gb0 * acc[ai][bj][m][0], gb1 * acc[ai][bj][m][1]);
                }
            }
    }
};
struct EpiO {
    float* X1; const float* X; const float* mod;
    __device__ __forceinline__ bool perm(const Unit&) const { return false; }
    __device__ __forceinline__ void operator()(const Acc& acc, const Unit& u, int wr, int wc, int fr, int fq) const {
#pragma unroll
        for (int ai = 0; ai < 2; ++ai)
#pragma unroll
            for (int m = 0; m < 4; ++m) {
                const int row = u.pm * 256 + ai * 128 + wr * 64 + m * 16 + fr; const float* g1 = mod + (size_t)(row >> 12) * 6144 + 2048;
#pragma unroll
                for (int bj = 0; bj < 2; ++bj)
#pragma unroll
                    for (int n = 0; n < 2; ++n) {
                        const int c = u.pn * 256 + bj * 128 + wc * 32 + 16 * n + 4 * fq;
                        const f32x4 xv = *(const f32x4*)(X + (size_t)row * 1024 + c), gv = *(const f32x4*)(g1 + c);
                        *(f32x4*)(X1 + (size_t)row * 1024 + c) = xv + gv * acc[ai][bj][m][n];
                    }
            }
    }
};
struct EpiGU {
    bf16_t* ACT;
    __device__ __forceinline__ bool perm(const Unit&) const { return true; }
    __device__ __forceinline__ void operator()(const Acc& acc, const Unit& u, int wr, int wc, int fr, int fq) const {
#pragma unroll
        for (int ai = 0; ai < 2; ++ai)
#pragma unroll
            for (int m = 0; m < 4; ++m) {
                const int prow = u.pm * 256 + ai * 128 + wr * 64 + m * 16 + fr;
                f32x4 a[2];
#pragma unroll
                for (int n = 0; n < 2; ++n) {
                    const f32x4 gt = acc[ai][0][m][n], up = acc[ai][1][m][n];
#pragma unroll
                    for (int j = 0; j < 4; ++j) a[n][j] = siluf_(gt[j]) * up[j];
                }
                st8bf(ACT + (size_t)prow * 2048 + u.pn * 128 + wc * 32 + 8 * fq, a[0], a[1]);
            }
    }
};
struct EpiD {
    bf16_t* YB; const float* TOPW;
    __device__ __forceinline__ bool perm(const Unit&) const { return true; }
    __device__ __forceinline__ void operator()(const Acc& acc, const Unit& u, int wr, int wc, int fr, int fq) const {
#pragma unroll
        for (int ai = 0; ai < 2; ++ai)
#pragma unroll
            for (int m = 0; m < 4; ++m) {
                const int prow = u.pm * 256 + ai * 128 + wr * 64 + m * 16 + fr; const float w = TOPW[prow];
#pragma unroll
                for (int bj = 0; bj < 2; ++bj)
                    st8bf(YB + (size_t)prow * 1024 + u.pn * 256 + bj * 128 + wc * 32 + 8 * fq, acc[ai][bj][m][0] * w, acc[ai][bj][m][1] * w);
            }
    }
};

__device__ __forceinline__ void transpose_item(const float* W, int N, int k0, int n0, bf16_t* dst, int ldt, LAS float* scr, int lane) {
    const int kk = lane >> 3, nq = (lane & 7) * 4;
    f32x4 v[8];
#pragma unroll
    for (int i = 0; i < 8; ++i) v[i] = *(const f32x4*)(W + (size_t)(k0 + 8 * i + kk) * N + n0 + nq);
#pragma unroll
    for (int i = 0; i < 8; ++i) { LAS float* s = scr + (8 * i + kk) * 33 + nq; s[0] = v[i].x; s[1] = v[i].y; s[2] = v[i].z; s[3] = v[i].w; }
    LDS_WAIT();
    const int c = lane & 7;
#pragma unroll
    for (int j = 0; j < 4; ++j) {
        const int n = (lane >> 3) + 8 * j; const LAS float* s = scr + (8 * c) * 33 + n;
        u32x4 o; o.x = pk2(s[0 * 33], s[1 * 33]); o.y = pk2(s[2 * 33], s[3 * 33]); o.z = pk2(s[4 * 33], s[5 * 33]); o.w = pk2(s[6 * 33], s[7 * 33]);
        *(u32x4*)(dst + (size_t)n * ldt + 8 * c) = o;
    }
    LDS_WAIT();
}

struct TrItem { const float* src; bf16_t* dst; int N, ldt; };
__device__ __forceinline__ void tr_load(const TrItem& it, f32x4 (&v)[8], int lane) {
    const int kk = lane >> 3, nq = (lane & 7) * 4;
#pragma unroll
    for (int i = 0; i < 8; ++i) v[i] = *(const f32x4*)(it.src + (size_t)(8 * i + kk) * it.N + nq);
}
__device__ __forceinline__ void tr_store(const TrItem& it, const f32x4 (&v)[8], LAS float* scr, int lane) {
    const int kk = lane >> 3, nq = (lane & 7) * 4;
#pragma unroll
    for (int i = 0; i < 8; ++i) { LAS float* s = scr + (8 * i + kk) * 33 + nq; s[0] = v[i].x; s[1] = v[i].y; s[2] = v[i].z; s[3] = v[i].w; }
    LDS_WAIT();
    const int c = lane & 7;
#pragma unroll
    for (int j = 0; j < 4; ++j) {
        const int n = (lane >> 3) + 8 * j; const LAS float* s = scr + (8 * c) * 33 + n;
        u32x4 o; o.x = pk2(s[0 * 33], s[1 * 33]); o.y = pk2(s[2 * 33], s[3 * 33]); o.z = pk2(s[4 * 33], s[5 * 33]); o.w = pk2(s[6 * 33], s[7 * 33]);
        *(u32x4*)(it.dst + (size_t)n * it.ldt + 8 * c) = o;
    }
    LDS_WAIT();
}

__device__ __forceinline__ void adaln_task(int task, const float* c, const float* cctx, const float* w_ada, const float* b_ada, float* mod, LAS float* lds, int tid) {
    LAS float* s = lds; LAS float* red = lds + 9 * 1024;
    { float cv[18];
#pragma unroll
      for (int q = 0; q < 18; ++q) { const int i = tid + NTHREADS * q, r = i >> 10, k = i & 1023; cv[q] = r < 8 ? c[r * 1024 + k] : cctx[k]; }
#pragma unroll
      for (int q = 0; q < 18; ++q) s[tid + NTHREADS * q] = cv[q] * __builtin_amdgcn_rcpf(1.f + __expf(-cv[q])); }
    __syncthreads();
    const int ch = tid & 7, kr = tid >> 3;
    f32x4 acc[9];
#pragma unroll
    for (int r = 0; r < 9; ++r) acc[r] = (f32x4){0.f, 0.f, 0.f, 0.f};
    const float* wp = w_ada + (size_t)kr * 6144 + task * 32 + ch * 4;
    for (int it = 0; it < 16; ++it) {
        const f32x4 w = *(const f32x4*)(wp + (size_t)it * 64 * 6144); const int k = kr + it * 64;
#pragma unroll
        for (int r = 0; r < 9; ++r) acc[r] += s[r * 1024 + k] * w;
    }
#pragma unroll
    for (int r = 0; r < 9; ++r) *(LAS f32x4*)(red + (kr * 9 + r) * 32 + ch * 4) = acc[r];
    __syncthreads();
    if (tid < 288) { const int r = tid >> 5, col = tid & 31; float sum = 0.f; for (int q = 0; q < 64; ++q) sum += red[(q * 9 + r) * 32 + col]; mod[r * 6144 + task * 32 + col] = sum + b_ada[task * 32 + col]; }
    __syncthreads();
}

__device__ __forceinline__ void rope_table(f32x2* tab, int tid) {
    for (int idx = tid; idx < 1024; idx += NTHREADS) {
        const int pos = idx >> 4, i = idx & 15;
        double f = 1.0;
        for (int q = 0; q < i; ++q) f *= 0.56234132519034908;
        const float ang = (float)pos * (float)f;
        const double a = (double)ang, k = __builtin_rint(a * 0.15915494309189535), r = a - k * 6.283185307179586476925, r2 = r * r;
        double sn = r, ts = r, cs = 1.0, tc = 1.0;
        for (int n = 1; n <= 14; ++n) {
            tc *= -r2 / (double)((2 * n - 1) * (2 * n)); cs += tc;
            ts *= -r2 / (double)((2 * n) * (2 * n + 1)); sn += ts;
        }
        tab[idx] = (f32x2){(float)cs, (float)sn};
    }
}

__device__ __forceinline__ unsigned char* lds_raw_ptr(LAS unsigned char* p) { return (unsigned char*)p; }
namespace mix {
typedef short bf16x8 __attribute__((ext_vector_type(8)));
typedef short s16x4 __attribute__((ext_vector_type(4)));
typedef float f32x16 __attribute__((ext_vector_type(16)));
typedef __attribute__((address_space(3))) const char* lds_cptr;
__device__ __forceinline__ int crow(int r, int hi) { return (r & 3) + 8 * (r >> 2) + 4 * hi; }
__device__ __forceinline__ unsigned cvtpk(float lo, float hi) { typedef float f2 __attribute__((ext_vector_type(2))); typedef __bf16 b2 __attribute__((ext_vector_type(2))); f2 v = {lo, hi}; b2 b = __builtin_convertvector(v, b2); return __builtin_bit_cast(unsigned, b); }
__device__ __forceinline__ s16x4 vtr(lds_cptr p) { return __builtin_bit_cast(s16x4, __builtin_amdgcn_ds_read_tr16_b64_v4i16((__attribute__((address_space(3))) s16x4*)p)); }
__device__ __forceinline__ bf16x8 pk8(s16x4 lo, s16x4 hi) { return (bf16x8){lo[0], lo[1], lo[2], lo[3], hi[0], hi[1], hi[2], hi[3]}; }
__device__ __forceinline__ float max3f(float a, float b, float c) { float r; asm("v_max3_f32 %0, %1, %2, %3" : "=v"(r) : "v"(a), "v"(b), "v"(c)); return r; }
__device__ __forceinline__ float max2f(float a, float b) { float r; asm("v_max_f32_e32 %0, %1, %2" : "=v"(r) : "v"(a), "v"(b)); return r; }
__device__ __forceinline__ float swap_half(float v) { auto rr = __builtin_amdgcn_permlane32_swap(__float_as_uint(v), __float_as_uint(v), false, false); return __uint_as_float((threadIdx.x & 32) ? rr[0] : rr[1]); }

constexpr int A_K = 0, A_V = 24576, A_WS = 49152, A_QST = 53248, A_OST = A_QST, A_OSTW = 8192, A_END = A_QST + 8 * 8192;

__device__ __forceinline__ void attn_unit(int b, int n, int kvh, bf16_t* Y, bf16_t* O, int ldo, const bf16_t* KB, const bf16_t* VB, const float* sink, LAS unsigned char* lds) {
    const int tid = threadIdx.x, lane = tid & 63, r32 = lane & 31, hi = lane >> 5, wid = __builtin_amdgcn_readfirstlane(tid >> 6);
    const int head = kvh * 4 + (wid >> 1);
    const int qrow0 = b * SEQ + n * 128 + (wid & 1) * 64;
    bf16_t* Qw = Y + (size_t)qrow0 * 2048 + 1024 + head * 64;
    LAS bf16x8* qst = (LAS bf16x8*)(lds + A_QST + wid * 8192) + lane;
#pragma unroll
    for (int sb = 0; sb < 2; ++sb)
#pragma unroll
        for (int d0 = 0; d0 < 4; ++d0) qst[(sb * 4 + d0) * 64] = *(const bf16x8*)(Qw + (size_t)(32 * sb + r32) * 2048 + d0 * 16 + hi * 8);
    f32x16 o[2][2];
#pragma unroll
    for (int sb = 0; sb < 2; ++sb)
#pragma unroll
        for (int d0 = 0; d0 < 2; ++d0)
#pragma unroll
            for (int r = 0; r < 16; ++r) o[sb][d0][r] = 0.f;
    float m[2] = {-1e30f, -1e30f}, l[2] = {0.f, 0.f};
    LAS float* wsf = (LAS float*)(lds + A_WS) + wid * 128;
    const int jlo = (n == 0) ? 2 : 0, jhi = (n == 31) ? 3 : 5, T = 4 + (jhi - jlo + 1);
    const size_t koff = (size_t)lane * 256 + wid * 8 + kvh * 64;
    const size_t voff = (size_t)(16 * (wid & 3) + (lane >> 2)) * 256 + (wid >> 2) * 32 + (lane & 3) * 8 + kvh * 64;
    auto tile_row = [&](int t) -> long { return t < 4 ? (long)(NTOK + b * CTXL + 64 * t) : (long)(b * SEQ + (n - 1) * 128 + 64 * (jlo + t - 4)); };
    auto issue = [&](int t) {
        const long row = tile_row(t); const int buf = t % 3;
        __builtin_amdgcn_global_load_lds((const unsigned*)(KB + row * 256 + koff), (LAS unsigned*)(lds + A_K + buf * 8192 + wid * 1024), 16, 0, 0);
        __builtin_amdgcn_global_load_lds((const unsigned*)(VB + row * 256 + voff), (LAS unsigned*)(lds + A_V + buf * 8192 + wid * 1024), 16, 0, 0);
    };
    issue(0); issue(1);
    int slot = 0;
    for (int t = 0; t < T; ++t) {
        if (t + 1 < T) asm volatile("s_waitcnt vmcnt(2) lgkmcnt(0)" ::: "memory"); else asm volatile("s_waitcnt vmcnt(0) lgkmcnt(0)" ::: "memory");
        __builtin_amdgcn_s_barrier();
        if (t + 2 < T) issue(t + 2);
        const lds_cptr Kt = (lds_cptr)(lds + A_K + slot * 8192) + hi * 1024 + r32 * 16;
        const lds_cptr Vt = (lds_cptr)(lds + A_V + slot * 8192) + ((lane >> 4) & 1) * 32 + (lane & 3) * 8 + (4 * hi + ((lane & 15) >> 2)) * 64;
        slot = (slot == 2) ? 0 : slot + 1;
        const bool local = t >= 4;
        const int dl = 64 * (jlo + t - 4) - 128 - 64 * (wid & 1);
        if (local && (dl > 160 || dl < -191)) continue;
        f32x16 p0[2], p1[2];
#pragma unroll
        for (int sb = 0; sb < 2; ++sb)
#pragma unroll
            for (int r = 0; r < 16; ++r) { p0[sb][r] = 0.f; p1[sb][r] = 0.f; }
#pragma unroll
        for (int d0 = 0; d0 < 4; ++d0) {
            const bf16x8 k0 = *(const __attribute__((address_space(3))) bf16x8*)(Kt + d0 * 2048), k1 = *(const __attribute__((address_space(3))) bf16x8*)(Kt + d0 * 2048 + 512);
#pragma unroll
            for (int sb = 0; sb < 2; ++sb) {
                const bf16x8 qf = qst[(sb * 4 + d0) * 64];
                p0[sb] = __builtin_amdgcn_mfma_f32_32x32x16_bf16(k0, qf, p0[sb], 0, 0, 0);
                p1[sb] = __builtin_amdgcn_mfma_f32_32x32x16_bf16(k1, qf, p1[sb], 0, 0, 0);
            }
        }
        if (local && (dl < -97 || dl > 65 || dl - 32 < -97)) {
#pragma unroll
            for (int sb = 0; sb < 2; ++sb)
#pragma unroll
                for (int r = 0; r < 16; ++r) { const int rel = dl - 32 * sb + crow(r, hi) - r32; if (rel < -128 || rel > 128) p0[sb][r] = -1e30f; if (rel + 32 < -128 || rel + 32 > 128) p1[sb][r] = -1e30f; }
        }
        float mn[2];
        asm volatile("s_nop 15\n\ts_nop 7" : "+v"(p0[0]), "+v"(p1[0]), "+v"(p0[1]), "+v"(p1[1]));
#pragma unroll
        for (int sb = 0; sb < 2; ++sb) {
            float a = max3f(p0[sb][0], p0[sb][1], p1[sb][0]), b2 = max3f(p0[sb][2], p0[sb][3], p1[sb][1]); a = max3f(a, p1[sb][2], p1[sb][3]);
#pragma unroll
            for (int r = 4; r < 16; r += 4) { a = max3f(a, p0[sb][r], p0[sb][r + 1]); b2 = max3f(b2, p0[sb][r + 2], p0[sb][r + 3]); a = max3f(a, p1[sb][r], p1[sb][r + 1]); b2 = max3f(b2, p1[sb][r + 2], p1[sb][r + 3]); }
            float rm = max2f(a, b2);
            rm = max2f(rm, swap_half(rm));
            mn[sb] = max2f(m[sb], rm);
        }
        if (__any((mn[0] > m[0]) || (mn[1] > m[1]))) {
            const float f0 = __builtin_amdgcn_exp2f(m[0] - mn[0]), f1 = __builtin_amdgcn_exp2f(m[1] - mn[1]);
            l[0] *= f0; l[1] *= f1;
            if (hi == 0) { wsf[r32] = f0; wsf[64 + r32] = f1; }
            asm volatile("s_waitcnt lgkmcnt(0)" ::: "memory");
#pragma unroll
            for (int r = 0; r < 16; ++r) { const float a = wsf[crow(r, hi)], b2 = wsf[64 + crow(r, hi)]; o[0][0][r] *= a; o[0][1][r] *= a; o[1][0][r] *= b2; o[1][1][r] *= b2; }
            m[0] = mn[0]; m[1] = mn[1];
        }
        u32x4 pw[2][4];
#pragma unroll
        for (int sb = 0; sb < 2; ++sb) {
            float sacc = 0.f;
#pragma unroll
            for (int r = 0; r < 16; ++r) { p0[sb][r] = __builtin_amdgcn_exp2f(p0[sb][r] - m[sb]); p1[sb][r] = __builtin_amdgcn_exp2f(p1[sb][r] - m[sb]); sacc += p0[sb][r] + p1[sb][r]; }
            l[sb] += sacc;
#pragma unroll
            for (int q = 0; q < 4; ++q) { pw[sb][0][q] = cvtpk(p0[sb][2 * q], p0[sb][2 * q + 1]); pw[sb][1][q] = cvtpk(p0[sb][8 + 2 * q], p0[sb][9 + 2 * q]); pw[sb][2][q] = cvtpk(p1[sb][2 * q], p1[sb][2 * q + 1]); pw[sb][3][q] = cvtpk(p1[sb][8 + 2 * q], p1[sb][9 + 2 * q]); }
        }
#pragma unroll
        for (int d0 = 0; d0 < 2; ++d0)
#pragma unroll
            for (int ks = 0; ks < 4; ++ks) {
                const s16x4 vlo = vtr(Vt + d0 * 4096 + ks * 1024), vhi = vtr(Vt + d0 * 4096 + ks * 1024 + 512);
                const bf16x8 vf = pk8(vlo, vhi);
#pragma unroll
                for (int sb = 0; sb < 2; ++sb) o[sb][d0] = __builtin_amdgcn_mfma_f32_32x32x16_bf16(__builtin_bit_cast(bf16x8, pw[sb][ks]), vf, o[sb][d0], 0, 0, 0);
            }
    }
    const float s2 = sink[head] * LOG2E;
    LAS bf16_t* stg = (LAS bf16_t*)(lds + A_OST + wid * A_OSTW);
#pragma unroll
    for (int sb = 0; sb < 2; ++sb) {
        const float lt = l[sb] + swap_half(l[sb]);
        const float mf = fmaxf(m[sb], s2), f = __builtin_amdgcn_exp2f(m[sb] - mf), den = lt * f + __builtin_amdgcn_exp2f(s2 - mf);
        asm volatile("s_waitcnt lgkmcnt(0)" ::: "memory");
        if (hi == 0) wsf[sb * 64 + r32] = f / den;
        asm volatile("s_waitcnt lgkmcnt(0)" ::: "memory");
#pragma unroll
        for (int r = 0; r < 16; ++r) { const float sc = wsf[sb * 64 + crow(r, hi)]; const int orow = crow(r, hi);
            stg[orow * 64 + r32] = (bf16_t)f2bf(o[sb][0][r] * sc); stg[orow * 64 + 32 + r32] = (bf16_t)f2bf(o[sb][1][r] * sc); }
        asm volatile("s_waitcnt lgkmcnt(0)" ::: "memory");
#pragma unroll
        for (int i = 0; i < 4; ++i) { const int row = i * 8 + (lane >> 3), ch = lane & 7; const u32x4 v = *(const LAS u32x4*)(stg + row * 64 + ch * 8); *(u32x4*)(O + (size_t)(qrow0 + 32 * sb + row) * ldo + head * 64 + ch * 8) = v; }
        asm volatile("s_waitcnt lgkmcnt(0)" ::: "memory");
    }
    __syncthreads();
}

constexpr int G_V = 0, G_ST = 65536, G_STW = 8704, G_MU = G_ST + 8 * G_STW;
__device__ __forceinline__ void gmlp_unit(int task, bf16_t* Y, bf16_t* YO, int ldo, const bf16_t* VA, const bf16_t* WSP, const f32x2* STATS, const float* ln_g, const float* ln_b, const float* b_sp, LAS unsigned char* lds) {
    const int tid = threadIdx.x, lane = tid & 63, r32 = lane & 31, hi = lane >> 5, wid = __builtin_amdgcn_readfirstlane(tid >> 6);
    const int r0 = task * 128;
    LAS float* mu = (LAS float*)(lds + G_MU); LAS float* rs = mu + 128;
    if (tid < 128) {
        const f32x4* sp = (const f32x4*)(STATS + (size_t)(r0 + tid) * 16); float s = 0.f, ss = 0.f;
#pragma unroll
        for (int i = 0; i < 8; ++i) { const f32x4 v = sp[i]; s += v.x + v.z; ss += v.y + v.w; }
        const float mean = s * (1.f / 1024.f), var = fmaxf(ss * (1.f / 1024.f) - mean * mean, 0.f);
        mu[tid] = mean; rs[tid] = 1.0f / sqrtf(var + EPS);
    }
    u32x4 raw[4];
#pragma unroll
    for (int i = 0; i < 4; ++i) { const int idx = tid + NTHREADS * i, q = idx >> 4, c8 = idx & 15; raw[i] = *(const u32x4*)(VA + (size_t)(r0 + q) * 1024 + c8 * 8); }
    __syncthreads();
    const int pb = wid >> 1, dh = wid & 1;
    LAS float* st = (LAS float*)(lds + G_ST + wid * G_STW);
    for (int g8 = 0; g8 < 8; ++g8) {
        LAS unsigned char* vb = lds + G_V + (g8 & 1) * 32768;
#pragma unroll
        for (int i = 0; i < 4; ++i) {
            const int idx = tid + NTHREADS * i, q = idx >> 4, c8 = idx & 15, d = c8 * 8;
            const f32x4 g0 = *(const f32x4*)(ln_g + g8 * 128 + d), g1 = *(const f32x4*)(ln_g + g8 * 128 + d + 4), b0 = *(const f32x4*)(ln_b + g8 * 128 + d), b1 = *(const f32x4*)(ln_b + g8 * 128 + d + 4);
            const float mq = mu[q], rq = rs[q]; const u32x4 rw = raw[i];
            float v[8] = {bf2f(rw.x & 0xffffu), bf2f(rw.x >> 16), bf2f(rw.y & 0xffffu), bf2f(rw.y >> 16), bf2f(rw.z & 0xffffu), bf2f(rw.z >> 16), bf2f(rw.w & 0xffffu), bf2f(rw.w >> 16)};
#pragma unroll
            for (int e = 0; e < 4; ++e) { v[e] = (v[e] - mq) * rq * g0[e] + b0[e]; v[4 + e] = (v[4 + e] - mq) * rq * g1[e] + b1[e]; }
            u32x4 w; w.x = pk2(v[0], v[1]); w.y = pk2(v[2], v[3]); w.z = pk2(v[4], v[5]); w.w = pk2(v[6], v[7]);
            *(LAS u32x4*)(vb + ((d >> 5) * 8 + (q >> 4)) * 1024 + (q & 15) * 64 + (d & 31) * 2) = w;
        }
        if (g8 + 1 < 8) {
#pragma unroll
            for (int i = 0; i < 4; ++i) { const int idx = tid + NTHREADS * i, q = idx >> 4, c8 = idx & 15; raw[i] = *(const u32x4*)(VA + (size_t)(r0 + q) * 1024 + (g8 + 1) * 128 + c8 * 8); }
        }
        u32x4 ur[4]; bf16x8 af[8];
        const size_t ybase = (size_t)(r0 + 32 * pb + (lane >> 3)) * 2048 + g8 * 128 + 64 * dh + (lane & 7) * 8;
#pragma unroll
        for (int i = 0; i < 4; ++i) ur[i] = *(const u32x4*)(Y + ybase + (size_t)(8 * i) * 2048);
        const bf16_t* wrow = WSP + (size_t)g8 * 16384 + (size_t)(32 * pb + r32) * 128 + 8 * hi;
#pragma unroll
        for (int ks = 0; ks < 8; ++ks) af[ks] = *(const bf16x8*)(wrow + 16 * ks);
        __syncthreads();
        const lds_cptr Vb = (lds_cptr)vb + ((lane >> 4) & 1) * 32 + (lane & 3) * 8 + (8 * hi + ((lane & 15) >> 2)) * 64;
        f32x16 acc[2];
#pragma unroll
        for (int t2 = 0; t2 < 2; ++t2)
#pragma unroll
            for (int r = 0; r < 16; ++r) acc[t2][r] = 0.f;
#pragma unroll
        for (int ks = 0; ks < 8; ++ks) {
#pragma unroll
            for (int t2 = 0; t2 < 2; ++t2) {
                const int db = 2 * dh + t2;
                const s16x4 vlo = vtr(Vb + (db * 8 + ks) * 1024), vhi = vtr(Vb + (db * 8 + ks) * 1024 + 256);
                acc[t2] = __builtin_amdgcn_mfma_f32_32x32x16_bf16(af[ks], pk8(vlo, vhi), acc[t2], 0, 0, 0);
            }
        }
#pragma unroll
        for (int t2 = 0; t2 < 2; ++t2)
#pragma unroll
            for (int r = 0; r < 16; ++r) st[crow(r, hi) * 68 + 32 * t2 + r32] = acc[t2][r];
        asm volatile("s_waitcnt lgkmcnt(0)" ::: "memory");
#pragma unroll
        for (int i = 0; i < 4; ++i) {
            const int prow = 8 * i + (lane >> 3), ch = lane & 7;
            const f32x4 m0 = *(const LAS f32x4*)(st + prow * 68 + ch * 8), m1 = *(const LAS f32x4*)(st + prow * 68 + ch * 8 + 4);
            const float bs = b_sp[g8 * 128 + 32 * pb + prow]; const u32x4 uw = ur[i];
            u32x4 o;
            o.x = pk2(bf2f(uw.x & 0xffffu) * (m0.x + bs), bf2f(uw.x >> 16) * (m0.y + bs)); o.y = pk2(bf2f(uw.y & 0xffffu) * (m0.z + bs), bf2f(uw.y >> 16) * (m0.w + bs));
            o.z = pk2(bf2f(uw.z & 0xffffu) * (m1.x + bs), bf2f(uw.z >> 16) * (m1.y + bs)); o.w = pk2(bf2f(uw.w & 0xffffu) * (m1.z + bs), bf2f(uw.w >> 16) * (m1.w + bs));
            *(u32x4*)(YO + (size_t)(r0 + 32 * pb + prow) * ldo + g8 * 128 + 64 * dh + ch * 8) = o;
        }
        asm volatile("s_waitcnt lgkmcnt(0)" ::: "memory");
    }
    __syncthreads();
}
}

namespace att2 {
typedef short bf16x8 __attribute__((ext_vector_type(8)));
typedef short s16x4 __attribute__((ext_vector_type(4)));
typedef float f32x16 __attribute__((ext_vector_type(16)));
typedef __attribute__((address_space(3))) const char* lds_cptr;
typedef short v4i16_t __attribute__((ext_vector_type(4)));
__device__ __forceinline__ int crow(int r, int hi) { return (r & 3) + 8 * (r >> 2) + 4 * hi; }
#define SBAR() __builtin_amdgcn_sched_barrier(0)
constexpr int NSLOT = 3, SLOTB = 8192;
constexpr int LDS_K = 0, LDS_V = NSLOT * SLOTB, LDS_WS = 2 * NSLOT * SLOTB, LDS_OST = LDS_WS + 8 * 64 * 4, LDS_BYTES = LDS_OST + 8 * 4096;
__device__ __forceinline__ void glds16(const void* gsrc, unsigned lds_dst) { unsigned keep;
    asm volatile("s_mov_b32 %0, m0\n\ts_mov_b32 m0, %2\n\ts_nop 0\n\tglobal_load_lds_dwordx4 %1, off\n\ts_mov_b32 m0, %0" : "=&s"(keep) : "v"(gsrc), "s"(lds_dst) : "memory"); }
__device__ __forceinline__ float max3f(float a, float b, float c) { float r; asm("v_max3_f32 %0, %1, %2, %3" : "=v"(r) : "v"(a), "v"(b), "v"(c)); return r; }
__device__ __forceinline__ float max2f(float a, float b) { float r; asm("v_max_f32_e32 %0, %1, %2" : "=v"(r) : "v"(a), "v"(b)); return r; }
__device__ __forceinline__ float fadd_s(float a, float b) { float r; asm("v_add_f32_e32 %0, %1, %2" : "=v"(r) : "v"(a), "v"(b)); return r; }
__device__ __forceinline__ float fsub_s(float a, float b) { float r; asm("v_sub_f32_e32 %0, %1, %2" : "=v"(r) : "v"(a), "v"(b)); return r; }
typedef float f32x2_t __attribute__((ext_vector_type(2))); typedef __bf16 bf16x2_t __attribute__((ext_vector_type(2)));
__device__ __forceinline__ unsigned cvtpk_s(float lo, float hi) { f32x2_t v = {lo, hi}; bf16x2_t b = __builtin_convertvector(v, bf16x2_t); return __builtin_bit_cast(unsigned, b); }
#define WAIT_BAR(N) asm volatile("s_waitcnt vmcnt(" #N ") lgkmcnt(0)\n\ts_barrier" ::: "memory")
__device__ __forceinline__ void qkt(f32x16& p0, f32x16& p1, lds_cptr Kslot, const bf16x8* qr, const f32x16& negm, int r32, int hi) {
    const lds_cptr kb = Kslot + hi * 1024 + r32 * 16;
#pragma unroll
    for (int d0 = 0; d0 < 4; ++d0) {
        const bf16x8 b0 = *(const __attribute__((address_space(3))) bf16x8*)(kb + d0 * 2048);
        const bf16x8 b1 = *(const __attribute__((address_space(3))) bf16x8*)(kb + d0 * 2048 + 512);
        if (d0 == 0) { p0 = __builtin_amdgcn_mfma_f32_32x32x16_bf16(b0, qr[0], negm, 0, 0, 0); p1 = __builtin_amdgcn_mfma_f32_32x32x16_bf16(b1, qr[0], negm, 0, 0, 0); }
        else { p0 = __builtin_amdgcn_mfma_f32_32x32x16_bf16(b0, qr[d0], p0, 0, 0, 0); p1 = __builtin_amdgcn_mfma_f32_32x32x16_bf16(b1, qr[d0], p1, 0, 0, 0); }
    }
}
__device__ __forceinline__ void kload8(bf16x8* kf, lds_cptr kp) {
    kf[0] = *(const __attribute__((address_space(3))) bf16x8*)(kp);        kf[1] = *(const __attribute__((address_space(3))) bf16x8*)(kp + 512);
    kf[2] = *(const __attribute__((address_space(3))) bf16x8*)(kp + 2048); kf[3] = *(const __attribute__((address_space(3))) bf16x8*)(kp + 2560);
    kf[4] = *(const __attribute__((address_space(3))) bf16x8*)(kp + 4096); kf[5] = *(const __attribute__((address_space(3))) bf16x8*)(kp + 4608);
    kf[6] = *(const __attribute__((address_space(3))) bf16x8*)(kp + 6144); kf[7] = *(const __attribute__((address_space(3))) bf16x8*)(kp + 6656);
}
__device__ __forceinline__ void kload2(bf16x8* kf, lds_cptr kp, int j) { kf[2 * j] = *(const __attribute__((address_space(3))) bf16x8*)(kp + j * 2048); kf[2 * j + 1] = *(const __attribute__((address_space(3))) bf16x8*)(kp + j * 2048 + 512); }
__device__ __forceinline__ s16x4 vtr(lds_cptr p) { return __builtin_bit_cast(s16x4, __builtin_amdgcn_ds_read_tr16_b64_v4i16((__attribute__((address_space(3))) v4i16_t*)p)); }
__device__ __forceinline__ float rowmax(const f32x16& p0, const f32x16& p1) {
    float a = max3f(p0[0], p0[1], p1[0]), b = max3f(p0[2], p0[3], p1[1]); a = max3f(a, p1[2], p1[3]);
#pragma unroll
    for (int r = 4; r < 16; r += 4) { a = max3f(a, p0[r], p0[r + 1]); b = max3f(b, p0[r + 2], p0[r + 3]); a = max3f(a, p1[r], p1[r + 1]); b = max3f(b, p1[r + 2], p1[r + 3]); }
    const float m = max2f(a, b);
    auto rr = __builtin_amdgcn_permlane32_swap(__float_as_uint(m), __float_as_uint(m), false, false);
    return max2f(__uint_as_float(rr[0]), __uint_as_float(rr[1]));
}
__device__ __forceinline__ void pv(f32x16* o, int vb, bf16x8 pa0, bf16x8 pa1, bf16x8 pa2, bf16x8 pa3) {
#pragma unroll
    for (int d0 = 0; d0 < 2; ++d0) { s16x4 lo[4], hi[4];
#pragma unroll
        for (int ks = 0; ks < 4; ++ks) {
            asm volatile("ds_read_b64_tr_b16 %0,%1 offset:%c2" : "=&v"(lo[ks]) : "v"(vb), "i"(d0 * 4096 + ks * 1024) : "memory");
            asm volatile("ds_read_b64_tr_b16 %0,%1 offset:%c2" : "=&v"(hi[ks]) : "v"(vb), "i"(d0 * 4096 + ks * 1024 + 512) : "memory"); }
        asm volatile("s_waitcnt lgkmcnt(0)" ::: "memory"); SBAR();
#define PK(k) (bf16x8){lo[k][0], lo[k][1], lo[k][2], lo[k][3], hi[k][0], hi[k][1], hi[k][2], hi[k][3]}
        o[d0] = __builtin_amdgcn_mfma_f32_32x32x16_bf16(pa0, PK(0), o[d0], 0, 0, 0);
        o[d0] = __builtin_amdgcn_mfma_f32_32x32x16_bf16(pa1, PK(1), o[d0], 0, 0, 0);
        o[d0] = __builtin_amdgcn_mfma_f32_32x32x16_bf16(pa2, PK(2), o[d0], 0, 0, 0);
        o[d0] = __builtin_amdgcn_mfma_f32_32x32x16_bf16(pa3, PK(3), o[d0], 0, 0, 0);
#undef PK
    }
}
__device__ __forceinline__ void wmask(f32x16& p0, f32x16& p1, int dl, int r32, int hi) {
    const float NEG = -INFINITY;
#pragma unroll
    for (int r = 0; r < 16; ++r) { const int rel = dl + crow(r, hi) - r32; if (rel < -128 || rel > 128) p0[r] = NEG; if (rel + 32 < -128 || rel + 32 > 128) p1[r] = NEG; }
}

template <int THRL> __device__ __forceinline__ void attn_unit(int b, int n, int kvh, int hp, const bf16_t* Y, bf16_t* O, int ldo, const bf16_t* KB, const bf16_t* VB, const float* sink, LAS unsigned char* shm) {
    const int tid = threadIdx.x, lane = tid & 63, r32 = lane & 31, hi = lane >> 5; const int wid = __builtin_amdgcn_readfirstlane(tid >> 6);
    const int head = kvh * 4 + hp * 2 + (wid >> 2), qsub = wid & 3;
    const long qrow0 = (long)b * SEQ + n * 128 + qsub * 32;
    const bf16_t* Qw = Y + qrow0 * 2048 + 1024 + head * 64;
    const unsigned lds0 = (unsigned)(uintptr_t)shm;
    LAS float* wsf = (LAS float*)(shm + LDS_WS) + wid * 64;
    const long koff = (long)lane * 256 + kvh * 64 + wid * 8;
    const long voff = (long)(16 * (wid & 3) + (lane >> 2)) * 256 + kvh * 64 + (wid >> 2) * 32 + (lane & 3) * 8;
    const unsigned kdst = lds0 + LDS_K + wid * 1024, vdst = lds0 + LDS_V + wid * 1024;
    const int jlo = (n == 0) ? 2 : 0, jhi = (n == 31) ? 3 : 5, NT = 4 + (jhi - jlo + 1);
    const long lrow0 = (long)b * SEQ + (n - 1) * 128 + 64 * (jlo - 4), crow0 = (long)NTOK + b * CTXL;
#define TROW(t) ((t) < 4 ? crow0 + 64 * (t) : lrow0 + 64 * (t))
#define DMA_K(t, slot) glds16(KB + TROW(t) * 256 + koff, (unsigned)__builtin_amdgcn_readfirstlane(kdst + (slot)))
#define DMA_V(t, slot) glds16(VB + TROW(t) * 256 + voff, (unsigned)__builtin_amdgcn_readfirstlane(vdst + (slot)))
    const int vb0 = (int)(lds0 + LDS_V) + ((lane >> 4) & 1) * 32 + (lane & 3) * 8 + (4 * hi + ((lane & 15) >> 2)) * 64;
    bf16x8 kf[8];
    const lds_cptr shm3 = (lds_cptr)shm; const lds_cptr kp0 = shm3 + LDS_K + hi * 1024 + r32 * 16; const lds_cptr vp0 = shm3 + LDS_V + ((lane >> 4) & 1) * 32 + (lane & 3) * 8 + (4 * hi + ((lane & 15) >> 2)) * 64;
    DMA_K(0, 0); DMA_V(0, 0); DMA_K(1, SLOTB);
    bf16x8 qr[4];
#pragma unroll
    for (int d0 = 0; d0 < 4; ++d0) qr[d0] = *(const bf16x8*)(Qw + (long)r32 * 2048 + d0 * 16 + hi * 8);
    float mhat = 0.f, l_reg = 0.f; f32x16 o[2]; o[0] = f32x16{}; o[1] = f32x16{}; f32x16 negm = f32x16{}; asm volatile("" : "+v"(negm));
    const int dq = -128 - 32 * qsub;
#define CMASK(P0, P1, t) do { if ((t) >= 4) { const int dl_ = 64 * (jlo + (t) - 4) + dq; if (dl_ < -97 || dl_ > 65) wmask(P0, P1, dl_, r32, hi); } } while (0)
    bool resc = false;
#define START(P0, P1) do { const float rm = rowmax(P0, P1); resc = false; \
    { const float dl = rm; mhat = fadd_s(mhat, dl); \
      _Pragma("unroll") for (int r = 0; r < 16; ++r) { P0[r] = fsub_s(P0[r], dl); P1[r] = fsub_s(P1[r], dl); } \
      _Pragma("unroll") for (int r = 0; r < 16; ++r) negm[r] = -mhat; asm volatile("" : "+v"(negm)); } \
    _Pragma("unroll") for (int r = 0; r < 16; ++r) P0[r] = __builtin_amdgcn_exp2f(P0[r]); } while (0)
#define RESC() do { if (resc) { asm volatile("s_waitcnt lgkmcnt(0)" ::: "memory"); \
      _Pragma("unroll") for (int d_ = 0; d_ < 2; ++d_) _Pragma("unroll") for (int r = 0; r < 16; ++r) o[d_][r] *= wsf[crow(r, hi)]; } } while (0)
    f32x16 pA0, pA1, pB0, pB1;
    int sl_prev = 0, sl_cur = 0, sl_next = SLOTB;
#define ROT() do { sl_prev = sl_cur; sl_cur = sl_next; sl_next = (sl_next == (NSLOT - 1) * SLOTB) ? 0 : sl_next + SLOTB; } while (0)
    DMA_K(2, 2 * SLOTB);
    WAIT_BAR(3);
    qkt(pA0, pA1, shm3 + LDS_K, qr, negm, r32, hi); asm volatile("s_nop 15\n\ts_nop 7" : "+v"(pA0), "+v"(pA1)); CMASK(pA0, pA1, 0);
    START(pA0, pA1);
    _Pragma("unroll") for (int r = 0; r < 16; ++r) pA1[r] = __builtin_amdgcn_exp2f(pA1[r]);
    WAIT_BAR(0);
    DMA_K(3, 0); DMA_V(1, SLOTB);
    ROT();
    kload8(kf, kp0 + sl_cur);
    WAIT_BAR(2);
    s16x4 vlo[8], vhi[8]; u32x4 pw0, pw1, pw2, pw3;
#define PKW(P, B) cvtpk_s(P[B], P[B + 1])
#define PAF(k) __builtin_bit_cast(bf16x8, pw##k)
#define VFR(i) (bf16x8){vlo[i][0], vlo[i][1], vlo[i][2], vlo[i][3], vhi[i][0], vhi[i][1], vhi[i][2], vhi[i][3]}
#define PIN(x) asm volatile("" : "+v"(x))
#define MX3(a, b, c) __builtin_fmaxf(__builtin_fmaxf((a), (b)), (c))
#define GAPA(MF, A0, A1, A2, A3, W0, W1, PW) do { MF; sacc += A0; sacc += A1; sacc += A2; sacc += A3; PIN(sacc); W0; W1; PIN(PW); SBAR(); } while (0)
#define EX(v) __builtin_amdgcn_exp2f(v)
#define GAPB(MF, X, B) do { MF; X[B] = EX(X[B]); X[B + 1] = EX(X[B + 1]); X[B + 2] = EX(X[B + 2]); X[B + 3] = EX(X[B + 3]); PIN(X); SBAR(); } while (0)
#define VRD(i) do { vlo[i] = vtr(vp_ + (((i) >> 2) * 4096 + ((i) & 3) * 1024)); vhi[i] = vtr(vp_ + (((i) >> 2) * 4096 + ((i) & 3) * 1024 + 512)); } while (0)
#define KRD(G, j) do { if (G) { kload2(kf, kp0 + sl_next, j); SBAR(); } } while (0)
#define STEP(C0, C1, P0, P1, t, GK, GV, GL) do { SBAR(); \
    const lds_cptr vp_ = vp0 + sl_prev; \
    VRD(0); SBAR(); float sacc = (P0[0] + P0[1]); \
    GAPA(C0 = __builtin_amdgcn_mfma_f32_32x32x16_bf16(kf[0], qr[0], negm, 0, 0, 0), P0[2], P0[3], P0[4], P0[5],     pw0[0] = PKW(P0, 0), pw0[1] = PKW(P0, 2), pw0); \
    VRD(4); SBAR(); GAPA(C1 = __builtin_amdgcn_mfma_f32_32x32x16_bf16(kf[1], qr[0], negm, 0, 0, 0), P0[6], P0[7], P0[8], P0[9],     pw0[2] = PKW(P0, 4), pw0[3] = PKW(P0, 6), pw0); \
    VRD(1); SBAR(); GAPA(C0 = __builtin_amdgcn_mfma_f32_32x32x16_bf16(kf[2], qr[1], C0, 0, 0, 0),   P0[10], P0[11], P0[12], P0[13], pw1[0] = PKW(P0, 8), pw1[1] = PKW(P0, 10), pw1); \
    VRD(5); SBAR(); GAPA(C1 = __builtin_amdgcn_mfma_f32_32x32x16_bf16(kf[3], qr[1], C1, 0, 0, 0),   P0[14], P0[15], P1[0], P1[1],   pw1[2] = PKW(P0, 12), pw1[3] = PKW(P0, 14), pw1); \
    VRD(2); SBAR(); GAPA(C0 = __builtin_amdgcn_mfma_f32_32x32x16_bf16(kf[4], qr[2], C0, 0, 0, 0),   P1[2], P1[3], P1[4], P1[5],     pw2[0] = PKW(P1, 0), pw2[1] = PKW(P1, 2), pw2); \
    VRD(6); SBAR(); GAPA(C1 = __builtin_amdgcn_mfma_f32_32x32x16_bf16(kf[5], qr[2], C1, 0, 0, 0),   P1[6], P1[7], P1[8], P1[9],     pw2[2] = PKW(P1, 4), pw2[3] = PKW(P1, 6), pw2); \
    VRD(3); SBAR(); GAPA(C0 = __builtin_amdgcn_mfma_f32_32x32x16_bf16(kf[6], qr[3], C0, 0, 0, 0),   P1[10], P1[11], P1[12], P1[13], pw3[0] = PKW(P1, 8), pw3[1] = PKW(P1, 10), pw3); \
    VRD(7); SBAR(); GAPA(C1 = __builtin_amdgcn_mfma_f32_32x32x16_bf16(kf[7], qr[3], C1, 0, 0, 0),   P1[14], P1[15], 0.f, 0.f,       pw3[2] = PKW(P1, 12), pw3[3] = PKW(P1, 14), pw3); \
    l_reg += sacc; \
    if (GK) { DMA_K((t) + 3, sl_cur); } if (GV) { DMA_V((t) + 1, sl_next); } \
    CMASK(C0, C1, t); \
    { float a = MX3(C0[0], C0[1], C1[0]), b2 = MX3(C0[2], C0[3], C1[1]); a = MX3(a, C1[2], C1[3]); \
      _Pragma("unroll") for (int r = 4; r < 16; r += 4) { a = MX3(a, C0[r], C0[r + 1]); b2 = MX3(b2, C0[r + 2], C0[r + 3]); a = MX3(a, C1[r], C1[r + 1]); b2 = MX3(b2, C1[r + 2], C1[r + 3]); } \
      float rm = __builtin_fmaxf(a, b2); { auto rr = __builtin_amdgcn_permlane32_swap(__float_as_uint(rm), __float_as_uint(rm), false, false); rm = __builtin_fmaxf(__uint_as_float(rr[0]), __uint_as_float(rr[1])); } \
      resc = false; \
      if (__builtin_expect(__any(rm > (float)THRL), 0)) { const float dl = __builtin_fmaxf(rm, 0.f); mhat += dl; \
        _Pragma("unroll") for (int r = 0; r < 16; ++r) { C0[r] -= dl; C1[r] -= dl; } \
        _Pragma("unroll") for (int r = 0; r < 16; ++r) negm[r] = -mhat; asm volatile("" : "+v"(negm)); \
        const float f = __builtin_amdgcn_exp2f(-dl); l_reg *= f; if (hi == 0) wsf[r32] = f; resc = true; } } \
    SBAR(); \
    GAPB(o[0] = __builtin_amdgcn_mfma_f32_32x32x16_bf16(PAF(0), VFR(0), o[0], 0, 0, 0), C0, 0); \
    GAPB(o[1] = __builtin_amdgcn_mfma_f32_32x32x16_bf16(PAF(0), VFR(4), o[1], 0, 0, 0), C0, 4); \
    KRD(GL, 0); GAPB(o[0] = __builtin_amdgcn_mfma_f32_32x32x16_bf16(PAF(1), VFR(1), o[0], 0, 0, 0), C0, 8); \
    KRD(GL, 1); GAPB(o[1] = __builtin_amdgcn_mfma_f32_32x32x16_bf16(PAF(1), VFR(5), o[1], 0, 0, 0), C0, 12); \
    KRD(GL, 2); GAPB(o[0] = __builtin_amdgcn_mfma_f32_32x32x16_bf16(PAF(2), VFR(2), o[0], 0, 0, 0), C1, 0); \
    KRD(GL, 3); GAPB(o[1] = __builtin_amdgcn_mfma_f32_32x32x16_bf16(PAF(2), VFR(6), o[1], 0, 0, 0), C1, 4); \
    GAPB(o[0] = __builtin_amdgcn_mfma_f32_32x32x16_bf16(PAF(3), VFR(3), o[0], 0, 0, 0), C1, 8); \
    GAPB(o[1] = __builtin_amdgcn_mfma_f32_32x32x16_bf16(PAF(3), VFR(7), o[1], 0, 0, 0), C1, 12); \
    } while (0)
#define ENDW(tt) do { if ((tt) + 3 < NT) { WAIT_BAR(2); } else if ((tt) + 2 < NT) { WAIT_BAR(1); } else { WAIT_BAR(0); } } while (0)
    int t = 1;
    for (; t + 1 < NT; t += 2) {
        STEP(pB0, pB1, pA0, pA1, t, (t + 3 < NT), (t + 1 < NT), (t + 1 < NT));       ENDW(t);     RESC(); ROT();
        STEP(pA0, pA1, pB0, pB1, t + 1, (t + 4 < NT), (t + 2 < NT), (t + 2 < NT));   ENDW(t + 1); RESC(); ROT();
    }
    STEP(pB0, pB1, pA0, pA1, NT - 1, false, false, false); RESC();
    { float sacc = pB0[0] + pB0[1]; _Pragma("unroll") for (int r = 2; r < 16; ++r) sacc += pB0[r]; _Pragma("unroll") for (int r = 0; r < 16; ++r) sacc += pB1[r]; l_reg += sacc;
      pw0 = (u32x4){PKW(pB0, 0), PKW(pB0, 2), PKW(pB0, 4), PKW(pB0, 6)}; pw1 = (u32x4){PKW(pB0, 8), PKW(pB0, 10), PKW(pB0, 12), PKW(pB0, 14)}; pw2 = (u32x4){PKW(pB1, 0), PKW(pB1, 2), PKW(pB1, 4), PKW(pB1, 6)}; pw3 = (u32x4){PKW(pB1, 8), PKW(pB1, 10), PKW(pB1, 12), PKW(pB1, 14)};
      SBAR(); pv(o, vb0 + sl_cur, PAF(0), PAF(1), PAF(2), PAF(3)); }
    { auto rr = __builtin_amdgcn_permlane32_swap(__float_as_uint(l_reg), __float_as_uint(l_reg), false, false); l_reg = __uint_as_float(rr[0]) + __uint_as_float(rr[1]); }
    l_reg += __builtin_amdgcn_exp2f(fminf(sink[head] * LOG2E - mhat, 80.f));
    if (hi == 0) wsf[32 + r32] = l_reg; asm volatile("s_waitcnt lgkmcnt(0)" ::: "memory");
    float rli[16];
#pragma unroll
    for (int r = 0; r < 16; ++r) rli[r] = __builtin_amdgcn_rcpf(wsf[32 + crow(r, hi)]);
    bf16_t* Ow = O + qrow0 * ldo + head * 64;
    { LAS bf16_t* stg = (LAS bf16_t*)(shm + LDS_OST) + wid * 2048;
#pragma unroll
      for (int r = 0; r < 16; ++r) { const int orow = crow(r, hi);
#pragma unroll
          for (int d0 = 0; d0 < 2; ++d0) stg[orow * 64 + d0 * 32 + r32] = (bf16_t)(pk2(o[d0][r] * rli[r], 0.f) & 0xffffu); }
      asm volatile("s_waitcnt lgkmcnt(0)" ::: "memory");
#pragma unroll
      for (int i = 0; i < 4; ++i) { const int row = i * 8 + (lane >> 3), ch = lane & 7; const u32x4 v = *(const LAS u32x4*)(stg + row * 64 + ch * 8); *(u32x4*)(Ow + (long)row * ldo + ch * 8) = v; } }
    asm volatile("s_waitcnt lgkmcnt(0)\n\ts_barrier" ::: "memory");
#undef TROW
#undef DMA_K
#undef DMA_V
#undef CMASK
#undef START
#undef RESC
#undef ROT
#undef PKW
#undef PAF
#undef VFR
#undef PIN
#undef MX3
#undef GAPA
#undef GAPB
#undef EX
#undef VRD
#undef KRD
#undef STEP
#undef ENDW
}
#undef SBAR
#undef WAIT_BAR
}

#define XB_TMO      128
#define XB_XCNT(j)  (256  + 64 * (j))
#define XB_XSUB(j)  (1280 + 64 * (j))
#define XB_XGEN(j)  (2304 + 64 * (j))
#define XB_TOP      3328
#define XB_TOPGEN   3392
#define XCD_BAR_WORDS 3456
#define XB_SPIN_CAP (1u << 18)
__device__ __forceinline__ unsigned xb_ld(unsigned* p)              { return __hip_atomic_load(p, __ATOMIC_RELAXED, __HIP_MEMORY_SCOPE_AGENT); }
__device__ __forceinline__ unsigned xb_add(unsigned* p, unsigned v) { return __hip_atomic_fetch_add(p, v, __ATOMIC_RELAXED, __HIP_MEMORY_SCOPE_AGENT); }
__device__ __forceinline__ unsigned xb_xcc_id() { return (unsigned)__builtin_amdgcn_s_getreg((3 << 11) | 20) & 0xFu; }
#define XB_SPIN(cond, bar) do { unsigned _sp = 0; while (cond) { __builtin_amdgcn_s_sleep(1); \
    if ((++_sp & 255u) == 0u) { if (xb_ld(&(bar)[XB_TMO])) break; if (_sp > XB_SPIN_CAP) { atomicAdd(&(bar)[XB_TMO], 1u); break; } } } } while (0)
struct XcdBarrier { unsigned* bar; unsigned x; volatile LAS unsigned* st; };
__device__ __forceinline__ XcdBarrier xcd_barrier_post(unsigned* bar, volatile LAS unsigned* st) {
    XcdBarrier b; b.bar = bar; b.x = xb_xcc_id(); b.st = st;
    if (threadIdx.x == 0) (void)xb_add(&bar[XB_XCNT(b.x)], 1u);
    return b;
}
__device__ __forceinline__ void xcd_barrier_complete(unsigned* bar, unsigned x, unsigned& nloc, unsigned& nx) {
    const unsigned G = gridDim.x * gridDim.y * gridDim.z;
    unsigned sum, cnt, mine, sp = 0u;
    for (;;) {
        sum = 0u; cnt = 0u; mine = 0u;
#pragma unroll
        for (unsigned j = 0; j < 16; ++j) { const unsigned c = xb_ld(&bar[XB_XCNT(j)]); sum += c; cnt += (c > 0u) ? 1u : 0u; mine = (j == x) ? c : mine; }
        if (sum == G) break;
        __builtin_amdgcn_s_sleep(1);
        if ((++sp & 255u) == 0u) { if (xb_ld(&bar[XB_TMO])) break; if (sp > XB_SPIN_CAP) { atomicAdd(&bar[XB_TMO], 1u); break; } }
    }
    nloc = mine > 0u ? mine : 1u; nx = cnt > 0u ? cnt : 1u;
}
__device__ __forceinline__ void xcd_barrier(const XcdBarrier& b) {
    asm volatile("s_waitcnt vmcnt(0)" ::: "memory");
    __syncthreads();
    if (threadIdx.x == 0) {
        unsigned* bar = b.bar;
        __builtin_amdgcn_s_waitcnt(0);
        unsigned nloc = b.st[0], nx = b.st[1];
        if (nloc == 0u) { xcd_barrier_complete(bar, b.x, nloc, nx); b.st[0] = nloc; b.st[1] = nx; }
        const unsigned old = xb_add(&bar[XB_XSUB(b.x)], 1u);
        const unsigned gen = old / nloc;
        if (old + 1u == (gen + 1u) * nloc) {
            __builtin_amdgcn_fence(__ATOMIC_RELEASE, "agent");
            asm volatile("s_waitcnt vmcnt(0)" ::: "memory");
            const unsigned og = xb_add(&bar[XB_TOP], 1u);
            const unsigned tg = og / nx;
            if (og + 1u == (tg + 1u) * nx) xb_add(&bar[XB_TOPGEN], 1u);
            else XB_SPIN(xb_ld(&bar[XB_TOPGEN]) == tg, bar);
            __builtin_amdgcn_fence(__ATOMIC_ACQUIRE, "agent");
            xb_add(&bar[XB_XGEN(b.x)], 1u);
            asm volatile("s_waitcnt vmcnt(0)" ::: "memory");
        } else {
            XB_SPIN(xb_ld(&bar[XB_XGEN(b.x)]) == gen, bar);
            __builtin_amdgcn_fence(__ATOMIC_ACQUIRE, "agent");
            asm volatile("s_waitcnt vmcnt(0)" ::: "memory");
        }
    }
    __syncthreads();
}
constexpr int LDSCTL_OFF = LDS_BYTES - 256;
constexpr int CW_BAR = 4096;

#ifndef PROBE_GMLP2
#define PROBE_GMLP2 0
#endif
#ifndef ATT_PIPE
#define ATT_PIPE 1
#endif
#ifndef ATT_THRL
#define ATT_THRL 8
#endif
#ifndef ONE_LAUNCH
#define ONE_LAUNCH 1
#endif
#ifndef FAST_MIX
#define FAST_MIX 1
#endif
#ifndef PROBE_SEQ
#define PROBE_SEQ 0, 1, 2, 3, 4, 5, 6, 7, 8, 9, 10, 11
#endif

enum { PH_PRO = 0, PH_HN, PH_IN, PH_MIX, PH_A, PH_O, PH_H2R, PH_WCONV, PH_TOPK, PH_GU, PH_D, PH_FIN, PH_COUNT };

__global__ void __launch_bounds__(NTHREADS, 2) fwd(Args args) {
    extern __shared__ __attribute__((aligned(16))) unsigned char lds_raw[];
    LAS unsigned char* lds = (LAS unsigned char*)lds_raw;
    const int tid = threadIdx.x, lane = tid & 63, wave = __builtin_amdgcn_readfirstlane(tid >> 6);
    const int G = gridDim.x, bid = blockIdx.x;
    unsigned char* ws = args.ws;
    const int lo = args.ph_lo, hi = args.ph_hi;
#define IN(k) (lo <= (k) && (k) < hi)
    float* MOD = (float*)(ws + WS_MOD); f32x2* ROPE = (f32x2*)(ws + WS_ROPE);
    float* AFFT = (float*)(ws + WS_AFFT); int* TOPI = (int*)(ws + WS_TOPI); float* TOPW = (float*)(ws + WS_TOPW); int* SLOT = (int*)(ws + WS_SLOT);
    bf16_t* WSP = (bf16_t*)(ws + WS_WSP); bf16_t* WIN = (bf16_t*)(ws + WS_WIN); bf16_t* WAB = (bf16_t*)(ws + WS_WAB); bf16_t* WO = (bf16_t*)(ws + WS_WO);
    bf16_t* H = (bf16_t*)(ws + WS_H); bf16_t* VA = (bf16_t*)(ws + WS_VA); bf16_t* KB = (bf16_t*)(ws + WS_KB); bf16_t* VB = (bf16_t*)(ws + WS_VB);
    bf16_t* GT = (bf16_t*)(ws + WS_G); bf16_t* Y = (bf16_t*)(ws + WS_Y); bf16_t* TMP = (bf16_t*)(ws + WS_TMP); bf16_t* MERGED = (bf16_t*)(ws + WS_MERGED);
    bf16_t* WGU = (bf16_t*)(ws + WS_WGU); bf16_t* WD = (bf16_t*)(ws + WS_WD); bf16_t* H2 = (bf16_t*)(ws + WS_H2); bf16_t* ACT = (bf16_t*)(ws + WS_ACT); bf16_t* YB = (bf16_t*)(ws + WS_YB);
    const int gw = bid * NWAVES + wave, NGW = G * NWAVES;
    if (tid < 64) ((LAS unsigned*)(lds + LDSCTL_OFF))[tid] = 0u;
    __syncthreads();
    XcdBarrier bar; bar.bar = (unsigned*)(ws + WS_CTL) + CW_BAR; bar.x = 0; bar.st = nullptr;
    if (ONE_LAUNCH) bar = xcd_barrier_post((unsigned*)(ws + WS_CTL) + CW_BAR, (volatile LAS unsigned*)(lds + LDSCTL_OFF));
#define SEAM(k) do { if (ONE_LAUNCH && IN(k) && IN((k) + 1)) xcd_barrier(bar); } while (0)

    if (IN(PH_PRO)) {
        if (bid < 192) adaln_task(bid, args.in[I_C], args.in[I_CCTX], args.in[I_WADA], args.in[I_BADA], MOD, (LAS float*)lds, tid);
        else if (bid == 192) rope_table(ROPE, tid);
        __syncthreads();
        for (int i = bid * NTHREADS + tid; i < 8 * 128 * 128 / 4; i += G * NTHREADS) st4bf(WSP + 4 * i, *(const f32x4*)(args.in[I_WSP] + 4 * i));
        LAS float* scr = (LAS float*)(lds + wave * 16384);
        constexpr int I_IN = 16 * 176, I_P = 16 * 32;
        for (int it = gw; it < I_IN + 3 * I_P; it += NGW) {
            int r = it;
            if (r < I_IN) { const int kb = r / 176, nb = r % 176; transpose_item(args.in[I_WIN], INCOLS, kb * 64, nb * 32, WIN + (size_t)(nb * 32) * 1024 + kb * 64, 1024, scr, lane); continue; } r -= I_IN;
            if (r < I_P) { const int kb = r / 32, nb = r % 32; transpose_item(args.in[I_WPA], 1024, kb * 64, nb * 32, WAB + (size_t)(nb * 32) * 2048 + kb * 64, 2048, scr, lane); continue; } r -= I_P;
            if (r < I_P) { const int kb = r / 32, nb = r % 32; transpose_item(args.in[I_WPB], 1024, kb * 64, nb * 32, WAB + (size_t)(nb * 32) * 2048 + 1024 + kb * 64, 2048, scr, lane); continue; } r -= I_P;
            { const int kb = r / 32, nb = r % 32; transpose_item(args.in[I_WOUT], 1024, kb * 64, nb * 32, WO + (size_t)(nb * 32) * 1024 + kb * 64, 1024, scr, lane); }
        }
    }
    SEAM(PH_PRO);
    if (IN(PH_HN)) {
        const float* g1n = args.in[I_N1G];
        auto hn_row = [&](int row) {
            const float* xr; int mrow;
            if (row < NTOK) { xr = args.in[I_X] + (size_t)row * 1024; mrow = row >> 12; } else { xr = args.in[I_CTX] + (size_t)(row - NTOK) * 1024; mrow = 8; }
            const float* sh = MOD + mrow * 6144; const float* sc = sh + 1024;
            f32x4 v[4]; float ss = 0.f;
#pragma unroll
            for (int j = 0; j < 4; ++j) { v[j] = *(const f32x4*)(xr + 4 * lane + 256 * j); ss += (v[j].x * v[j].x + v[j].y * v[j].y) + (v[j].z * v[j].z + v[j].w * v[j].w); }
            const float rstd = 1.0f / sqrtf(wave_sum(ss) * (1.f / 1024.f) + EPS);
#pragma unroll
            for (int j = 0; j < 4; ++j) {
                const int col = 4 * lane + 256 * j;
                const f32x4 gv = *(const f32x4*)(g1n + col), scv = *(const f32x4*)(sc + col), shv = *(const f32x4*)(sh + col);
                const f32x4 h = (v[j] * rstd * gv) * (1.f + scv) + shv;
                st4bf(H + (size_t)row * 1024 + col, h);
            }
        };
        for (int cb = bid; cb < NCTX / 8; cb += G) {
            LAS bf16_t* hcs = (LAS bf16_t*)lds;
            __syncthreads();
            {
                const float* xr = args.in[I_CTX] + (size_t)(cb * 8 + wave) * 1024;
                const float* sh = MOD + 8 * 6144; const float* sc = sh + 1024;
                f32x4 v[4]; float ss = 0.f;
#pragma unroll
                for (int j = 0; j < 4; ++j) { v[j] = *(const f32x4*)(xr + 4 * lane + 256 * j); ss += (v[j].x * v[j].x + v[j].y * v[j].y) + (v[j].z * v[j].z + v[j].w * v[j].w); }
                const float rstd = 1.0f / sqrtf(wave_sum(ss) * (1.f / 1024.f) + EPS);
#pragma unroll
                for (int j = 0; j < 4; ++j) {
                    const int col = 4 * lane + 256 * j;
                    const f32x4 gv = *(const f32x4*)(g1n + col), scv = *(const f32x4*)(sc + col), shv = *(const f32x4*)(sh + col);
                    const f32x4 h = (v[j] * rstd * gv) * (1.f + scv) + shv;
                    u32x2 w; w.x = pk2(h.x, h.y); w.y = pk2(h.z, h.w);
                    *(LAS u32x2*)(hcs + wave * 1032 + col) = w;
                }
            }
            __syncthreads();
            {
                typedef short bf16x8_ __attribute__((ext_vector_type(8))); typedef float f32x16_ __attribute__((ext_vector_type(16)));
                const int r32 = lane & 31, hi = lane >> 5;
                const LAS bf16_t* ap = hcs + (r32 & 7) * 1032 + 8 * hi;
                const bf16_t* bp0 = WIN + (size_t)(OFF_K + 64 * wave + r32) * 1024 + 8 * hi; const bf16_t* bp1 = bp0 + 32 * 1024;
                f32x16_ acc0, acc1;
#pragma unroll
                for (int r = 0; r < 16; ++r) { acc0[r] = 0.f; acc1[r] = 0.f; }
#pragma unroll 8
                for (int ks = 0; ks < 64; ++ks) {
                    const bf16x8_ a = *(const LAS bf16x8_*)(ap + 16 * ks), b0 = *(const bf16x8_*)(bp0 + 16 * ks), b1 = *(const bf16x8_*)(bp1 + 16 * ks);
                    acc0 = __builtin_amdgcn_mfma_f32_32x32x16_bf16(a, b0, acc0, 0, 0, 0);
                    acc1 = __builtin_amdgcn_mfma_f32_32x32x16_bf16(a, b1, acc1, 0, 0, 0);
                }
#pragma unroll
                for (int r = 0; r < 4; ++r) {
                    const size_t orow = (size_t)(NTOK + cb * 8 + r + 4 * hi);
                    const int c0 = 64 * wave + r32, c1 = c0 + 32;
                    bf16_t* d0 = (c0 < 256 ? KB + orow * 256 + c0 : VB + orow * 256 + (c0 - 256));
                    bf16_t* d1 = (c1 < 256 ? KB + orow * 256 + c1 : VB + orow * 256 + (c1 - 256));
                    *d0 = (bf16_t)(pk2(acc0[r], 0.f) & 0xffffu); *d1 = (bf16_t)(pk2(acc1[r], 0.f) & 0xffffu);
                }
            }
        }
        __syncthreads();
        for (int row = gw; row < NTOK; row += NGW) hn_row(row);
    }
    SEAM(PH_HN);
    if (IN(PH_IN)) {
        Gemm g{H, WIN, 1024, 1024, 1024, 0, 30, nullptr}; StaticOrder S; S.init(NTOK, INCOLS, G, bid);
        EpiIn E{Y, VA, KB, VB, GT, args.in[I_BMG], ROPE, (f32x2*)(ws + WS_STATS)};
        GEMM_PHASE<EpiIn, StaticOrder, false>(lds, g, S, E);
    }
    SEAM(PH_IN);
    if (IN(PH_MIX) && FAST_MIX) {
        if (!(args.flags & 8)) for (int task = bid; task < NB * 32; task += G) mix::gmlp_unit(task, Y, (args.flags & 2) ? TMP : Y, (args.flags & 2) ? 1024 : 2048, VA, WSP, (const f32x2*)(ws + WS_STATS), args.in[I_LNG], args.in[I_LNB], args.in[I_BSP], lds);
        if (!(args.flags & 1)) for (int task = bid; task < NB * 32 * 4; task += G) {
#if ATT_PIPE
            __syncthreads();
            for (int hp = 0; hp < 2; ++hp) att2::attn_unit<ATT_THRL>(task >> 7, (task >> 2) & 31, task & 3, hp, Y, (args.flags & 4) ? TMP : Y + 1024, (args.flags & 4) ? 1024 : 2048, KB, VB, args.in[I_SINK], lds);
#else
            mix::attn_unit(task >> 7, (task >> 2) & 31, task & 3, Y, (args.flags & 4) ? TMP : Y + 1024, (args.flags & 4) ? 1024 : 2048, KB, VB, args.in[I_SINK], lds);
#endif
        }
    }
    SEAM(PH_MIX);
    if (IN(PH_A)) {
        Gemm g{Y, WAB, 2048, 2048, 2048, 0, 30, nullptr}; StaticOrder S; S.init(NTOK, 1024, G, bid, 0, 1);
        EpiAB E{MERGED, GT};
        GEMM_PHASE<EpiAB, StaticOrder, false, true>(lds, g, S, E);
    }
    SEAM(PH_A);
    if (IN(PH_O)) {
        Gemm g{MERGED, WO, 1024, 1024, 1024, 0, 30, nullptr}; StaticOrder S; S.init(NTOK, 1024, G, bid);
        EpiO E{args.out, args.in[I_X], MOD};
        GEMM_PHASE<EpiO, StaticOrder, false>(lds, g, S, E);
    }
    SEAM(PH_O);
    if (IN(PH_H2R)) {
        LAS float* wT = (LAS float*)lds;
        { f32x4 wv[8];
#pragma unroll
          for (int k = 0; k < 8; ++k) wv[k] = *(const f32x4*)(args.in[I_WR] + 4 * (tid + NTHREADS * k));
#pragma unroll
          for (int k = 0; k < 8; ++k) { const int f = tid + NTHREADS * k, col = f >> 2, e0 = 4 * (f & 3); wT[e0 * 1024 + col] = wv[k].x; wT[(e0 + 1) * 1024 + col] = wv[k].y; wT[(e0 + 2) * 1024 + col] = wv[k].z; wT[(e0 + 3) * 1024 + col] = wv[k].w; } }
        __syncthreads();
        const float* g2n = args.in[I_N2G];
        const bool h32 = lane & 32, h16 = lane & 16, h8 = lane & 8, h4 = lane & 4;
        const int myexp = 8 * (lane >> 5) + 4 * ((lane >> 4) & 1) + 2 * ((lane >> 3) & 1) + ((lane >> 2) & 1);
        f32x4 vn[2][4];
#pragma unroll
        for (int q = 0; q < 2; ++q)
#pragma unroll
            for (int j = 0; j < 4; ++j) vn[q][j] = *(const f32x4*)(args.out + (size_t)(2 * (NTOK / 2 - 1 - (gw < NTOK / 2 ? gw : 0)) + q) * 1024 + 4 * lane + 256 * j);
        for (int rp = gw; rp < NTOK / 2; rp += NGW) {
            const int row0 = 2 * (NTOK / 2 - 1 - rp), b = row0 >> 12;
            const float* sh = MOD + b * 6144 + 3072; const float* sc = sh + 1024;
            f32x4 v[2][4]; float ss[2] = {0.f, 0.f};
#pragma unroll
            for (int q = 0; q < 2; ++q)
#pragma unroll
                for (int j = 0; j < 4; ++j) { v[q][j] = vn[q][j]; ss[q] += (v[q][j].x * v[q][j].x + v[q][j].y * v[q][j].y) + (v[q][j].z * v[q][j].z + v[q][j].w * v[q][j].w); }
            { const int rn = (rp + NGW < NTOK / 2) ? rp + NGW : rp;
#pragma unroll
              for (int q = 0; q < 2; ++q)
#pragma unroll
                  for (int j = 0; j < 4; ++j) vn[q][j] = *(const f32x4*)(args.out + (size_t)(2 * (NTOK / 2 - 1 - rn) + q) * 1024 + 4 * lane + 256 * j); }
            float rstd[2];
#pragma unroll
            for (int q = 0; q < 2; ++q) rstd[q] = 1.0f / sqrtf(wave_sum(ss[q]) * (1.f / 1024.f) + EPS);
            float lg[2][16];
#pragma unroll
            for (int q = 0; q < 2; ++q)
#pragma unroll
                for (int e = 0; e < 16; ++e) lg[q][e] = 0.f;
            f32x4 wb[2][4];
#pragma unroll
            for (int e = 0; e < 4; ++e) wb[0][e] = *(const LAS f32x4*)(wT + e * 1024 + 4 * lane);
            f32x4 h[2];
#pragma unroll
            for (int g = 0; g < 16; ++g) {
                const int j = g >> 2, eg = g & 3, col = 4 * lane + 256 * j;
                if (g + 1 < 16) {
                    const int jn = (g + 1) >> 2, en = (g + 1) & 3;
#pragma unroll
                    for (int e = 0; e < 4; ++e) wb[(g + 1) & 1][e] = *(const LAS f32x4*)(wT + (4 * en + e) * 1024 + 4 * lane + 256 * jn);
                }
                if (eg == 0) {
                    const f32x4 gv = *(const f32x4*)(g2n + col), scv = *(const f32x4*)(sc + col), shv = *(const f32x4*)(sh + col);
#pragma unroll
                    for (int q = 0; q < 2; ++q) { h[q] = (v[q][j] * rstd[q] * gv) * (1.f + scv) + shv; st4bf(H2 + (size_t)(row0 + q) * 1024 + col, h[q]); }
                }
#pragma unroll
                for (int e = 0; e < 4; ++e) {
                    const f32x4 w = wb[g & 1][e];
#pragma unroll
                    for (int q = 0; q < 2; ++q) lg[q][4 * eg + e] += (h[q].x * w.x + h[q].y * w.y) + (h[q].z * w.z + h[q].w * w.w);
                    asm volatile("" : "+v"(lg[0][4 * eg + e]), "+v"(lg[1][4 * eg + e]));
                }
                asm volatile("" ::: "memory");
            }
#pragma unroll
            for (int q = 0; q < 2; ++q) {
                float a8[8], a4[4], a2[2], a1;
#pragma unroll
                for (int i = 0; i < 8; ++i) { const float send = h32 ? lg[q][i] : lg[q][i + 8], keep = h32 ? lg[q][i + 8] : lg[q][i]; a8[i] = keep + __shfl_xor(send, 32); }
#pragma unroll
                for (int i = 0; i < 4; ++i) { const float send = h16 ? a8[i] : a8[i + 4], keep = h16 ? a8[i + 4] : a8[i]; a4[i] = keep + __shfl_xor(send, 16); }
#pragma unroll
                for (int i = 0; i < 2; ++i) { const float send = h8 ? a4[i] : a4[i + 2], keep = h8 ? a4[i + 2] : a4[i]; a2[i] = keep + __shfl_xor(send, 8); }
                { const float send = h4 ? a2[0] : a2[1], keep = h4 ? a2[1] : a2[0]; a1 = keep + __shfl_xor(send, 4); }
                a1 += __shfl_xor(a1, 2); a1 += __shfl_xor(a1, 1);
                float mx = a1;
#pragma unroll
                for (int o = 4; o < 64; o <<= 1) mx = fmaxf(mx, __shfl_xor(mx, o));
                const float p = __expf(a1 - mx); float den = p;
#pragma unroll
                for (int o = 4; o < 64; o <<= 1) den += __shfl_xor(den, o);
                if ((lane & 3) == 0) AFFT[(size_t)(b * 16 + myexp) * SEQ + ((row0 + q) & (SEQ - 1))] = p / den;
            }
        }
    }
    if (IN(PH_WCONV)) {
        __syncthreads();
        LAS float* scr = (LAS float*)(lds + wave * 16384);
        constexpr int I_G = 16 * 16 * 64, I_D = 16 * 32 * 32;
        auto item = [&](int it) -> TrItem {
            int r = it; TrItem t;
            if (r < 2 * I_G) {
                const int up = r >= I_G; if (up) r -= I_G;
                const int e = r >> 10, kb = (r >> 6) & 15, nb = r & 63, n0 = nb * 32;
                const int drow = 256 * (n0 >> 7) + (n0 & 127) + (up ? 128 : 0);
                t.src = args.in[up ? I_WEU : I_WEG] + (size_t)e * 1024 * 2048 + (size_t)(kb * 64) * 2048 + n0; t.N = 2048;
                t.dst = WGU + (size_t)e * 4096 * 1024 + (size_t)drow * 1024 + kb * 64; t.ldt = 1024;
            } else {
                r -= 2 * I_G;
                const int e = r >> 10, kb = (r >> 5) & 31, nb = r & 31;
                t.src = args.in[I_WED] + (size_t)e * 2048 * 1024 + (size_t)(kb * 64) * 1024 + nb * 32; t.N = 1024;
                t.dst = WD + (size_t)e * 1024 * 2048 + (size_t)(nb * 32) * 2048 + kb * 64; t.ldt = 2048;
            }
            return t;
        };
        constexpr int NIT = 2 * I_G + I_D;
        if (gw < NIT) {
            TrItem cur = item(gw); f32x4 vc[8], vn[8];
            tr_load(cur, vc, lane);
            for (int it = gw; it < NIT; it += NGW) {
                const bool more = it + NGW < NIT;
                TrItem nxt = cur;
                if (more) { nxt = item(it + NGW); tr_load(nxt, vn, lane); }
                tr_store(cur, vc, scr, lane);
                cur = nxt;
#pragma unroll
                for (int i = 0; i < 8; ++i) vc[i] = vn[i];
            }
        }
    }
    SEAM(PH_WCONV);
    if (IN(PH_TOPK)) {
        LAS int* wsum = (LAS int*)lds;
        for (int task = bid; task < NE * NB; task += G) {
            const int e = task >> 3, b = task & 7;
            const float* aff = AFFT + (size_t)(b * 16 + e) * SEQ;
            unsigned k[8];
            { const u32x4 a0 = *(const u32x4*)(aff + 8 * tid), a1 = *(const u32x4*)(aff + 8 * tid + 4); k[0] = a0.x; k[1] = a0.y; k[2] = a0.z; k[3] = a0.w; k[4] = a1.x; k[5] = a1.y; k[6] = a1.z; k[7] = a1.w; }
            unsigned T = 0u; int it = 0;
            __syncthreads();
            for (int bit = 30; bit >= 0; --bit, ++it) {
                const unsigned cand = T | (1u << bit); int c = 0;
#pragma unroll
                for (int j = 0; j < 8; ++j) c += __builtin_popcountll(__ballot(k[j] >= cand));
                if (lane == 0) wsum[(it & 1) * 8 + wave] = c;
                __syncthreads();
                int tot = 0;
#pragma unroll
                for (int w = 0; w < 8; ++w) tot += wsum[(it & 1) * 8 + w];
                if (tot >= CAP) T = cand;
            }
            int cg = 0, ce = 0;
#pragma unroll
            for (int j = 0; j < 8; ++j) { cg += (k[j] > T) ? 1 : 0; ce += (k[j] == T) ? 1 : 0; }
            LAS int* sc1 = wsum + 16; LAS int* sc2 = wsum + 32;
            int ie = ce, ig = cg;
#pragma unroll
            for (int o = 1; o < 64; o <<= 1) { const int te = __shfl_up(ie, o), tg = __shfl_up(ig, o); if (lane >= o) { ie += te; ig += tg; } }
            __syncthreads();
            if (lane == 63) { sc1[wave] = ie; sc2[wave] = ig; }
            __syncthreads();
            int ebase = ie - ce, totg = 0;
#pragma unroll
            for (int w = 0; w < 8; ++w) { if (w < wave) ebase += sc1[w]; totg += sc2[w]; }
            const int need = CAP - totg;
            int sel[8], cs = 0, er = ebase;
#pragma unroll
            for (int j = 0; j < 8; ++j) { const bool eq = (k[j] == T); sel[j] = (k[j] > T) || (eq && er < need); er += eq ? 1 : 0; cs += sel[j]; }
            int is = cs;
#pragma unroll
            for (int o = 1; o < 64; o <<= 1) { const int ts = __shfl_up(is, o); if (lane >= o) is += ts; }
            __syncthreads();
            if (lane == 63) sc1[wave] = is;
            __syncthreads();
            int sbase = is - cs;
#pragma unroll
            for (int w = 0; w < 8; ++w) if (w < wave) sbase += sc1[w];
#pragma unroll
            for (int j = 0; j < 8; ++j) {
                const int t = 8 * tid + j; int slot = -1;
                if (sel[j]) { slot = sbase; ++sbase; const int prow = (e * 8 + b) * CAP + slot; TOPI[prow] = t; TOPW[prow] = __uint_as_float(k[j]); }
                SLOT[((size_t)b * SEQ + t) * 16 + e] = slot;
            }
            __syncthreads();
        }
    }
    SEAM(PH_TOPK);
    if (IN(PH_GU)) {
        Gemm g{H2, WGU, 1024, 1024, 1024, (size_t)4096 * 1024, 4, TOPI}; StaticOrder S; S.init(NPAIR, 4096, G, bid);
        EpiGU E{ACT};
        GEMM_PHASE<EpiGU, StaticOrder, true>(lds, g, S, E);
    }
    SEAM(PH_GU);
    if (IN(PH_D)) {
        Gemm g{ACT, WD, 2048, 2048, 2048, (size_t)1024 * 2048, 4, nullptr}; StaticOrder S; S.init(NPAIR, 1024, G, bid, 0, 1);
        EpiD E{YB, TOPW};
        GEMM_PHASE<EpiD, StaticOrder, false>(lds, g, S, E);
    }
    SEAM(PH_D);
    if (IN(PH_FIN)) {
        const float* fg = args.in[I_FING];
        const bf16_t* ZROW = (const bf16_t*)(ws + WS_CTL + 512 * 1024);
        int sln[2] = {-1, -1};
        if (gw < NTOK / 2 && lane < 16) { sln[0] = SLOT[(size_t)(2 * gw) * 16 + lane]; sln[1] = SLOT[(size_t)(2 * gw + 1) * 16 + lane]; }
        for (int rp = gw; rp < NTOK / 2; rp += NGW) {
            const int row0 = 2 * rp, b = row0 >> 12;
            const int sl[2] = {sln[0], sln[1]};
            { const int rn = rp + NGW; if (rn < NTOK / 2 && lane < 16) { sln[0] = SLOT[(size_t)(2 * rn) * 16 + lane]; sln[1] = SLOT[(size_t)(2 * rn + 1) * 16 + lane]; } }
            const float* g2 = MOD + b * 6144 + 5120;
            f32x4 xv[2][4], acc[2][4];
#pragma unroll
            for (int q = 0; q < 2; ++q)
#pragma unroll
                for (int h = 0; h < 2; ++h) { const float* xp = args.out + (size_t)(row0 + q) * 1024 + 512 * h + 8 * lane; xv[q][2 * h] = *(const f32x4*)xp; xv[q][2 * h + 1] = *(const f32x4*)(xp + 4);
                    acc[q][2 * h] = (f32x4){0.f, 0.f, 0.f, 0.f}; acc[q][2 * h + 1] = (f32x4){0.f, 0.f, 0.f, 0.f}; }
#pragma unroll
            for (int q = 0; q < 2; ++q) {
                unsigned long long mask = __ballot(sl[q] >= 0);
                for (;;) {
                    const bf16_t* yr[4];
#pragma unroll
                    for (int k = 0; k < 4; ++k) {
                        if (mask) { const int ex = __builtin_ctzll(mask); mask &= mask - 1; const int s = __builtin_amdgcn_readlane(sl[q], ex); yr[k] = YB + (size_t)((ex * 8 + b) * CAP + s) * 1024; }
                        else yr[k] = ZROW;
                    }
                    u32x4 y[4][2];
#pragma unroll
                    for (int k = 0; k < 4; ++k)
#pragma unroll
                        for (int h = 0; h < 2; ++h) y[k][h] = *(const u32x4*)(yr[k] + 512 * h + 8 * lane);
#pragma unroll
                    for (int k = 0; k < 4; ++k)
#pragma unroll
                        for (int h = 0; h < 2; ++h) { const u32x4 w = y[k][h];
                            acc[q][2 * h] += (f32x4){bf2f(w.x & 0xffffu), bf2f(w.x >> 16), bf2f(w.y & 0xffffu), bf2f(w.y >> 16)};
                            acc[q][2 * h + 1] += (f32x4){bf2f(w.z & 0xffffu), bf2f(w.z >> 16), bf2f(w.w & 0xffffu), bf2f(w.w >> 16)}; }
                    if (!mask) break;
                }
            }
#pragma unroll
            for (int q = 0; q < 2; ++q) {
                float ss = 0.f;
#pragma unroll
                for (int h = 0; h < 2; ++h)
#pragma unroll
                    for (int u4 = 0; u4 < 2; ++u4) { const int col = 512 * h + 8 * lane + 4 * u4; f32x4& v = xv[q][2 * h + u4]; v = v + *(const f32x4*)(g2 + col) * acc[q][2 * h + u4]; ss += (v.x * v.x + v.y * v.y) + (v.z * v.z + v.w * v.w); }
                const float rstd = 1.0f / sqrtf(wave_sum(ss) * (1.f / 1024.f) + EPS);
#pragma unroll
                for (int h = 0; h < 2; ++h)
#pragma unroll
                    for (int u4 = 0; u4 < 2; ++u4) { const int col = 512 * h + 8 * lane + 4 * u4; *(f32x4*)(args.out + (size_t)(row0 + q) * 1024 + col) = xv[q][2 * h + u4] * rstd * *(const f32x4*)(fg + col); }
            }
        }
    }
#undef IN
}

extern "C" void kernel_launch(void* const* d_in, const int* in_sizes, int n_in, void* d_out, int out_size, void* d_ws, size_t ws_size, hipStream_t stream) {
    static int grid = 0;
    if (grid == 0) {
        if (n_in != 23 || in_sizes[0] != NTOK * DM || out_size != NTOK * DM || ws_size < WS_END) {
            fprintf(stderr, "kernel_launch: unexpected problem (n_in %d, in0 %d, out %d, ws %zu < %zu?)\n", n_in, n_in > 0 ? in_sizes[0] : -1, out_size, ws_size, (size_t)WS_END); grid = -1; return; }
        if (hipFuncSetAttribute((const void*)fwd, hipFuncAttributeMaxDynamicSharedMemorySize, LDS_BYTES) != hipSuccess) { fprintf(stderr, "kernel_launch: hipFuncSetAttribute failed\n"); grid = -1; return; }
        int dev = 0, cus = 0;
        if (hipGetDevice(&dev) != hipSuccess || hipDeviceGetAttribute(&cus, hipDeviceAttributeMultiprocessorCount, dev) != hipSuccess) { grid = -1; return; }
        grid = cus;
    }
    if (grid < 0) return;
    (void)hipMemsetAsync((char*)d_ws + WS_CTL, 0, 1 * MiB, stream);
    Args a{};
    for (int i = 0; i < 23; ++i) a.in[i] = (const float*)d_in[i];
    a.out = (float*)d_out; a.ws = (unsigned char*)d_ws;
    if (ONE_LAUNCH) {
        a.ph_lo = 0; a.ph_hi = PH_COUNT;
        hipLaunchKernelGGL(fwd, dim3(grid), dim3(NTHREADS), LDS_BYTES, stream, a);
    } else {
        static const int seq[] = {PROBE_SEQ};
        for (unsigned i = 0; i < sizeof(seq) / sizeof(seq[0]); ++i) {
            a.ph_lo = seq[i] % 100; a.ph_hi = seq[i] % 100 + 1; a.flags = seq[i] / 100;
            hipLaunchKernelGGL(fwd, dim3(grid), dim3(NTHREADS), LDS_BYTES, stream, a);
        }
    }
}
```

```cpp
#include <hip/hip_runtime.h>
#include <cstdio>
#include <cstdint>

#define LAS __attribute__((address_space(3)))
typedef unsigned short bf16_t;
typedef float f32x4 __attribute__((ext_vector_type(4)));
typedef float f32x2 __attribute__((ext_vector_type(2)));
typedef unsigned u32x4 __attribute__((ext_vector_type(4)));
typedef unsigned u32x2 __attribute__((ext_vector_type(2)));
typedef int i32x4 __attribute__((ext_vector_type(4)));

constexpr int DM = 1024, NB = 8, SEQ = 4096, NTOK = NB * SEQ, CTXL = 256, NCTX = NB * CTXL, NROWS_H = NTOK + NCTX;
constexpr int INCOLS = 5632, OFF_Q = 2048, OFF_K = 3072, OFF_VB = 3328, OFF_GATE = 3584;
constexpr int NE = 16, CAP = 512, DE = 2048, NPAIR = NE * NB * CAP;
constexpr float EPS = 1e-6f, LOG2E = 1.4426950408889634f, C2 = 0.125f * LOG2E;
constexpr int NTHREADS = 512, NWAVES = 8;

constexpr size_t MiB = 1u << 20;
constexpr size_t WS_CTL = 0;
constexpr size_t WS_MOD = 1 * MiB;
constexpr size_t WS_ROPE = 1 * MiB + 512 * 1024;
constexpr size_t WS_AFFT = 2 * MiB;
constexpr size_t WS_TOPI = 4 * MiB;
constexpr size_t WS_TOPW = 4 * MiB + 512 * 1024;
constexpr size_t WS_SLOT = 5 * MiB;
constexpr size_t WS_WSP = 7 * MiB;
constexpr size_t WS_WIN = 8 * MiB;
constexpr size_t WS_WAB = 19 * MiB;
constexpr size_t WS_WO = 23 * MiB;
constexpr size_t WS_R = 25 * MiB;
constexpr size_t WS_H = WS_R;
constexpr size_t WS_VA = WS_R + 68 * MiB;
constexpr size_t WS_KB = WS_VA + 64 * MiB;
constexpr size_t WS_VB = WS_KB + 17 * MiB;
constexpr size_t WS_G = WS_VB + 17 * MiB;
constexpr size_t WS_Y = WS_G + 128 * MiB;
constexpr size_t WS_TMP = WS_Y + 128 * MiB;
constexpr size_t WS_STATS = WS_TMP + 64 * MiB;
constexpr size_t WS_MERGED = WS_H;
constexpr size_t WS_WGU = WS_R;
constexpr size_t WS_WD = WS_R + 128 * MiB;
constexpr size_t WS_H2 = WS_R + 192 * MiB;
constexpr size_t WS_ACT = WS_R + 256 * MiB;
constexpr size_t WS_YB = WS_WGU;
constexpr size_t WS_END = 537 * MiB;
static_assert(WS_STATS + 4 * MiB <= WS_END && WS_ACT + 256 * MiB == WS_END, "ws map");

constexpr int LDS_BYTES = 147456;

__device__ __forceinline__ float bf2f(unsigned b) { return __uint_as_float(b << 16); }
__device__ __forceinline__ unsigned f2bf(float f) { unsigned u = __float_as_uint(f); return (u + 0x7fffu + ((u >> 16) & 1u)) >> 16; }
__device__ __forceinline__ unsigned pk2(float lo, float hi) { typedef float f2_ __attribute__((ext_vector_type(2))); typedef __bf16 b2_ __attribute__((ext_vector_type(2))); f2_ v = {lo, hi}; b2_ b = __builtin_convertvector(v, b2_); return __builtin_bit_cast(unsigned, b); }
__device__ __forceinline__ void st4bf(bf16_t* p, f32x4 v) { u32x2 w; w.x = pk2(v.x, v.y); w.y = pk2(v.z, v.w); *(u32x2*)p = w; }
__device__ __forceinline__ void st8bf(bf16_t* p, f32x4 a, f32x4 b) { u32x4 w; w.x = pk2(a.x, a.y); w.y = pk2(a.z, a.w); w.z = pk2(b.x, b.y); w.w = pk2(b.z, b.w); *(u32x4*)p = w; }
__device__ __forceinline__ void ld8bf(const bf16_t* p, f32x4& a, f32x4& b) { const u32x4 w = *(const u32x4*)p; a.x = bf2f(w.x & 0xffffu); a.y = bf2f(w.x >> 16); a.z = bf2f(w.y & 0xffffu); a.w = bf2f(w.y >> 16); b.x = bf2f(w.z & 0xffffu); b.y = bf2f(w.z >> 16); b.z = bf2f(w.w & 0xffffu); b.w = bf2f(w.w >> 16); }
__device__ __forceinline__ f32x4 ld4bf(const bf16_t* p) { const u32x2 w = *(const u32x2*)p; f32x4 v; v.x = bf2f(w.x & 0xffffu); v.y = bf2f(w.x >> 16); v.z = bf2f(w.y & 0xffffu); v.w = bf2f(w.y >> 16); return v; }
__device__ __forceinline__ float sigmoidf_(float x) { return __builtin_amdgcn_rcpf(1.f + __expf(-x)); }
__device__ __forceinline__ float siluf_(float x) { return x * __builtin_amdgcn_rcpf(1.f + __expf(-x)); }
__device__ __forceinline__ float gelu_t(float x) { const float z2 = 1.5957691216057308f * (x + 0.044715f * x * x * x); return x * __builtin_amdgcn_rcpf(1.f + __expf(-z2)); }
__device__ __forceinline__ float wave_sum(float v) {
#pragma unroll
    for (int o = 1; o < 64; o <<= 1) v += __shfl_xor(v, o);
    return v;
}
__device__ __forceinline__ int wave_sum_i(int v) {
#pragma unroll
    for (int o = 1; o < 64; o <<= 1) v += __shfl_xor(v, o);
    return v;
}
#define LDS_WAIT() asm volatile("s_waitcnt lgkmcnt(0)" ::: "memory")

struct Args { const float* in[23]; float* out; unsigned char* ws; int ph_lo, ph_hi, flags, pad; };
enum { I_X = 0, I_C, I_CTX, I_CCTX, I_WADA, I_BADA, I_N1G, I_WIN, I_BMG, I_LNG, I_LNB, I_WSP, I_BSP, I_SINK, I_WPA, I_WPB, I_WOUT, I_N2G, I_WR, I_WEG, I_WEU, I_WED, I_FING };

struct Unit { int pm, pn; };
struct Gemm {
    const bf16_t* A; const bf16_t* Bt; int lda, ldb, K;
    size_t bgs; int tpg_shift;
    const int* gidx;
};
constexpr int NXCD = 8, WGM = 8;
struct StaticOrder {
    int nM, nN, nwg, G, c, extra, rev;
    __device__ void init(int M, int N, int G_, int c_, int extra_ = 0, int rev_ = 0) { nM = M / 256; nN = N / 256; nwg = nM * nN; G = G_; c = c_; extra = extra_; rev = rev_; }
    __device__ bool next(int i, Unit& u) const {
        const long L = (long)i * G + c;
        if (L >= nwg) { const int x = (int)(L - nwg); if (x >= extra) return false; u.pm = NTOK / 256 + (x >> 1); u.pn = 12 + (x & 1); return true; }
        int wgid = (int)L; { const int q = nwg / NXCD, r = nwg % NXCD, xcd = wgid % NXCD, off = wgid / NXCD; wgid = (xcd < r ? xcd * (q + 1) : r * (q + 1) + (xcd - r) * q) + off; }
        const int nig = WGM * nN, gid = wgid / nig, fm = gid * WGM, gsz = (nM - fm) < WGM ? (nM - fm) : WGM;
        u.pm = fm + ((wgid % nig) % gsz); u.pn = (wgid % nig) / gsz; if (rev) u.pm = nM - 1 - u.pm; return true;
    }
};

struct OneUnit { int pm, pn; __device__ bool next(int i, Unit& u) const { if (i) return false; u.pm = pm; u.pn = pn; return true; } };

typedef f32x4 Acc[2][2][4][2];

namespace pg8 {
typedef short bf16x8 __attribute__((ext_vector_type(8)));
constexpr int BK = 64, HALF = 128, HTB = HALF * BK * 2, STAGE_BYTES = 8 * HTB;
__device__ __forceinline__ int lds_byte(int r, int c) { const int st = (r >> 4) * 2 + (c >> 5), rr = r & 15, cc = c & 31, ob = rr * 64 + cc * 2; return st * 1024 + (ob ^ (((ob >> 9) & 1) << 5)); }
__device__ __forceinline__ void stage_rc(int b, int& R, int& C) { const int st = b / 1024, sb = b % 1024, swz = sb ^ (((sb >> 9) & 1) << 5); R = (st >> 1) * 16 + swz / 64; C = (st & 1) * 32 + (swz % 64) / 2; }

template <class Epi, class Sched, bool GATHER, bool HOOK = false>
__device__ __forceinline__ void gemm_phase(LAS unsigned char* lds, const Gemm g, const Sched& S, const Epi& E) {
    const int tid = threadIdx.x, wid = __builtin_amdgcn_readfirstlane(tid >> 6), lane = tid & 63, wr = wid >> 2, wc = wid & 3, fr = lane & 15, fq = lane >> 4;
    const int nt = g.K / BK;
    int Rs[2], Cs[2]; unsigned voffBp[2][2], voffB[2], voffBn[2], vA[2][2], vN[2][2];
#pragma unroll
    for (int i = 0; i < 2; ++i) { stage_rc(tid * 16 + i * 8192, Rs[i], Cs[i]); voffBp[0][i] = (unsigned)(Rs[i] * g.ldb + Cs[i]) * 2u;
        const int rho = Rs[i] & 31, Rb = (Rs[i] & ~31) + 8 * ((rho & 15) >> 2) + 4 * (rho >> 4) + (rho & 3); voffBp[1][i] = (unsigned)(Rb * g.ldb + Cs[i]) * 2u; }
    const size_t kstep = (size_t)(BK * 2);
    const size_t hstepB = (size_t)HALF * g.ldb * 2;
    const unsigned ldsw = (unsigned)wid * 1024u;
    const int aoff = lds_byte(wr * 64 + fr, fq * 8), boff = lds_byte(wc * 32 + fr, fq * 8);
#define PG8_SA(b, h) (((b) * 2 + (h)) * HTB)
#define PG8_SB(b, h) ((4 + (b) * 2 + (h)) * HTB)
#define PG8_STAGE(bufoff, gbase, voff) do { _Pragma("unroll") for (int _i = 0; _i < 2; ++_i) \
        __builtin_amdgcn_global_load_lds((const unsigned*)((const char*)(gbase) + (voff)[_i]), (LAS unsigned*)(lds + (bufoff) + ldsw + _i * 8192), 16, 0, 0); } while (0)
#define PG8_LDA(dst, b, h) do { _Pragma("unroll") for (int m = 0; m < 4; ++m) _Pragma("unroll") for (int k = 0; k < 2; ++k) dst[m][k] = *(const LAS bf16x8*)(lds + PG8_SA(b, h) + aoff + m * 2048 + k * 1024); } while (0)
#define PG8_LDB(dst, b, h) do { _Pragma("unroll") for (int n = 0; n < 2; ++n) _Pragma("unroll") for (int k = 0; k < 2; ++k) dst[n][k] = *(const LAS bf16x8*)(lds + PG8_SB(b, h) + boff + n * 2048 + k * 1024); } while (0)
#define PG8_MMA(ai, bj, At, Bt) do { __builtin_amdgcn_s_setprio(1); _Pragma("unroll") for (int m = 0; m < 4; ++m) _Pragma("unroll") for (int n = 0; n < 2; ++n) _Pragma("unroll") for (int k = 0; k < 2; ++k) \
        acc[ai][bj][m][n] = __builtin_amdgcn_mfma_f32_16x16x32_bf16(Bt[n][k], At[m][k], acc[ai][bj][m][n], 0, 0, 0); __builtin_amdgcn_s_setprio(0); } while (0)
#define PG8_WAIT_V(n) asm volatile("s_waitcnt vmcnt(" #n ")" ::: "memory")
#define PG8_WAIT_L(n) asm volatile("s_waitcnt lgkmcnt(" #n ")" ::: "memory")
#define PG8_BAR __builtin_amdgcn_s_barrier()
#define PG8_SCHED __builtin_amdgcn_sched_barrier(0)
#define PG8_AVOFF(dst, U) do { _Pragma("unroll") for (int _h = 0; _h < 2; ++_h) _Pragma("unroll") for (int _i = 0; _i < 2; ++_i) \
        dst[_h][_i] = GATHER ? (unsigned)((((U).pm >> 1) & 7) * SEQ + g.gidx[(U).pm * 256 + _h * 128 + Rs[_i]]) * (unsigned)(g.lda * 2) + (unsigned)(Cs[_i] * 2) \
                             : (unsigned)((_h * 128 + Rs[_i]) * g.lda + Cs[_i]) * 2u; } while (0)
#define PG8_ABASE(U) ((const char*)g.A + (GATHER ? (size_t)0 : (size_t)(U).pm * 256 * g.lda * 2))
#define PG8_BBASE(U) ((const char*)g.Bt + ((size_t)((U).pm >> g.tpg_shift) * g.bgs + (size_t)(U).pn * 256 * g.ldb) * 2)
    Unit cur, nxt; int ui = 0;
    if (!S.next(0, cur)) return;
    Acc acc;
#pragma unroll
    for (int a = 0; a < 2; ++a)
#pragma unroll
        for (int b = 0; b < 2; ++b)
#pragma unroll
            for (int m = 0; m < 4; ++m)
#pragma unroll
                for (int n = 0; n < 2; ++n) acc[a][b][m][n] = (f32x4){0.f, 0.f, 0.f, 0.f};
    bf16x8 At[4][2], B0[2][2], B1[2][2];
    PG8_AVOFF(vA, cur);
    { const bool pc = E.perm(cur); voffB[0] = pc ? voffBp[1][0] : voffBp[0][0]; voffB[1] = pc ? voffBp[1][1] : voffBp[0][1]; }
    const char* cA = PG8_ABASE(cur); const char* cB = PG8_BBASE(cur);
    PG8_STAGE(PG8_SB(0, 0), cB, voffB); PG8_STAGE(PG8_SB(0, 1), cB + hstepB, voffB); PG8_STAGE(PG8_SA(0, 0), cA, vA[0]); PG8_STAGE(PG8_SA(0, 1), cA, vA[1]);
    if (wr == 1) PG8_BAR;
    PG8_WAIT_V(2); PG8_BAR;
    PG8_STAGE(PG8_SB(1, 0), cB + kstep, voffB); PG8_STAGE(PG8_SA(1, 0), cA + kstep, vA[0]); PG8_STAGE(PG8_SB(1, 1), cB + hstepB + kstep, voffB);
    PG8_WAIT_V(6); PG8_BAR;
    for (;;) {
        const bool has_next = S.next(ui + 1, nxt);
        const char* nA = has_next ? PG8_ABASE(nxt) : cA; const char* nB = has_next ? PG8_BBASE(nxt) : cB;
        { const bool pn_ = has_next ? E.perm(nxt) : E.perm(cur); voffBn[0] = pn_ ? voffBp[1][0] : voffBp[0][0]; voffBn[1] = pn_ ? voffBp[1][1] : voffBp[0][1]; }
        if (GATHER) {
#pragma unroll
            for (int h = 0; h < 2; ++h)
#pragma unroll
                for (int i = 0; i < 2; ++i) vN[h][i] = vA[h][i];
            if (has_next && wid == 0)
                __builtin_amdgcn_global_load_lds((const unsigned*)(g.gidx + nxt.pm * 256 + lane * 4), (LAS unsigned*)(lds + STAGE_BYTES + (ui & 1) * 1024), 16, 0, 0);
        }
        for (int t = 0; t < nt; t += 2) {
            const bool last = (t == nt - 2);
            if (GATHER) { if (t == 4 && has_next) {
                const LAS int* li = (const LAS int*)(lds + STAGE_BYTES + (ui & 1) * 1024);
#pragma unroll
                for (int h = 0; h < 2; ++h)
#pragma unroll
                    for (int i = 0; i < 2; ++i) vN[h][i] = (unsigned)(((nxt.pm >> 1) & 7) * SEQ + li[h * 128 + Rs[i]]) * (unsigned)(g.lda * 2) + (unsigned)(Cs[i] * 2);
            } }
            if constexpr (HOOK) { if (t == (nt >> 1)) E.mid(acc, cur, wr, wc, fr, fq); }
            const char* a1 = cA + (size_t)(t + 1) * kstep;
            const char* a2 = last ? nA : cA + (size_t)(t + 2) * kstep; const char* b2 = last ? nB : cB + (size_t)(t + 2) * kstep;
            const char* a3 = a2 + kstep; const char* b3 = b2 + kstep;
            unsigned v2[2][2];
#pragma unroll
            for (int h = 0; h < 2; ++h)
#pragma unroll
                for (int i = 0; i < 2; ++i) v2[h][i] = (GATHER && last) ? vN[h][i] : vA[h][i];
            unsigned vb2[2]; vb2[0] = last ? voffBn[0] : voffB[0]; vb2[1] = last ? voffBn[1] : voffB[1];
            PG8_LDB(B0, 0, 0); PG8_LDB(B1, 0, 1); PG8_SCHED; PG8_LDA(At, 0, 0); PG8_STAGE(PG8_SA(1, 1), a1, vA[1]);
            PG8_WAIT_V(8); PG8_WAIT_L(0); PG8_BAR; PG8_MMA(0, 0, At, B0); PG8_MMA(0, 1, At, B1); PG8_BAR; PG8_SCHED;
            PG8_LDA(At, 0, 1); PG8_STAGE(PG8_SB(0, 0), b2, vb2); PG8_STAGE(PG8_SB(0, 1), b2 + hstepB, vb2); PG8_STAGE(PG8_SA(0, 0), a2, v2[0]);
            PG8_WAIT_V(8); PG8_WAIT_L(0); PG8_BAR; PG8_MMA(1, 0, At, B0); PG8_MMA(1, 1, At, B1); PG8_BAR; PG8_SCHED;
            PG8_LDB(B0, 1, 0); PG8_LDB(B1, 1, 1); PG8_SCHED; PG8_LDA(At, 1, 0); PG8_STAGE(PG8_SA(0, 1), a2, v2[1]);
            PG8_WAIT_V(8); PG8_WAIT_L(0); PG8_BAR; PG8_MMA(0, 0, At, B0); PG8_MMA(0, 1, At, B1); PG8_BAR; PG8_SCHED;
            PG8_LDA(At, 1, 1); PG8_STAGE(PG8_SB(1, 0), b3, vb2); PG8_STAGE(PG8_SB(1, 1), b3 + hstepB, vb2); PG8_STAGE(PG8_SA(1, 0), a3, v2[0]);
            PG8_WAIT_V(8); PG8_WAIT_L(0); PG8_BAR; PG8_MMA(1, 0, At, B0); PG8_MMA(1, 1, At, B1); PG8_BAR; PG8_SCHED;
        }
        if (wr == 0) PG8_BAR;
        E(acc, cur, wr, wc, fr, fq);
        if (!has_next) break;
#pragma unroll
        for (int a = 0; a < 2; ++a)
#pragma unroll
            for (int b = 0; b < 2; ++b)
#pragma unroll
                for (int m = 0; m < 4; ++m)
#pragma unroll
                    for (int n = 0; n < 2; ++n) acc[a][b][m][n] = (f32x4){0.f, 0.f, 0.f, 0.f};
        cur = nxt; cA = nA; cB = nB; ++ui; voffB[0] = voffBn[0]; voffB[1] = voffBn[1];
        if (GATHER) {
#pragma unroll
            for (int h = 0; h < 2; ++h)
#pragma unroll
                for (int i = 0; i < 2; ++i) vA[h][i] = vN[h][i];
        }
        if (wr == 1) PG8_BAR;
    }
    PG8_WAIT_V(0);
    PG8_BAR;
#undef PG8_SA
#undef PG8_SB
#undef PG8_STAGE
#undef PG8_LDA
#undef PG8_LDB
#undef PG8_MMA
#undef PG8_WAIT_V
#undef PG8_WAIT_L
#undef PG8_BAR
#undef PG8_SCHED
#undef PG8_AVOFF
#undef PG8_ABASE
#undef PG8_BBASE
}
}

#define GEMM_PHASE pg8::gemm_phase

struct EpiIn {
    bf16_t *Y, *VA, *KB, *VB, *G; const float* bgate; const f32x2* rope; f32x2* STATS;
    __device__ __forceinline__ bool perm(const Unit& u) const { return u.pn < 8 || u.pn > 12; }
    __device__ __forceinline__ void operator()(const Acc& acc, const Unit& u, int wr, int wc, int fr, int fq) const {
        const int pn = u.pn;
#pragma unroll
        for (int ai = 0; ai < 2; ++ai)
#pragma unroll
            for (int m = 0; m < 4; ++m) {
                const int row = u.pm * 256 + ai * 128 + wr * 64 + m * 16 + fr;
                float ssum = 0.f, ssq = 0.f;
#pragma unroll
                for (int bj = 0; bj < 2; ++bj) {
                    f32x4 v0 = acc[ai][bj][m][0], v1 = acc[ai][bj][m][1];
                    if (pn < 8) {
                        const int c8 = bj * 128 + wc * 32 + 8 * fq;
#pragma unroll
                        for (int j = 0; j < 4; ++j) { v0[j] = gelu_t(v0[j]); v1[j] = gelu_t(v1[j]); }
                        if (pn < 4) st8bf(Y + (size_t)row * 2048 + pn * 256 + c8, v0, v1);
                        else {
                            st8bf(VA + (size_t)row * 1024 + (pn - 4) * 256 + c8, v0, v1);
                            ssum += ((v0.x + v0.y) + (v0.z + v0.w)) + ((v1.x + v1.y) + (v1.z + v1.w));
                            ssq += ((v0.x * v0.x + v0.y * v0.y) + (v0.z * v0.z + v0.w * v0.w)) + ((v1.x * v1.x + v1.y * v1.y) + (v1.z * v1.z + v1.w * v1.w));
                        }
                    } else if (pn < 13) {
                        const int cl = bj * 128 + wc * 32 + 4 * fq;
                        f32x4 o0 = v0, o1 = v1;
                        if (row < NTOK) {
                            const int t = row & (SEQ - 1), pos = (wc & 1) ? (t & 63) : (t >> 6);
                            const f32x2* rp = rope + pos * 16 + 4 * fq;
#pragma unroll
                            for (int j = 0; j < 4; ++j) { const f32x2 cs = rp[j]; o0[j] = v0[j] * cs.x - v1[j] * cs.y; o1[j] = v0[j] * cs.y + v1[j] * cs.x; }
                        }
                        if (pn < 12) { bf16_t* p = Y + (size_t)row * 2048 + 1024 + (pn - 8) * 256 + cl; st4bf(p, o0 * C2); st4bf(p + 16, o1 * C2); }
                        else { bf16_t* p = KB + (size_t)row * 256 + cl; st4bf(p, o0); st4bf(p + 16, o1); }
                    } else if (pn == 13) {
                        st8bf(VB + (size_t)row * 256 + bj * 128 + wc * 32 + 8 * fq, v0, v1);
                    } else {
                        const int cg = (pn - 14) * 256 + bj * 128 + wc * 32 + 8 * fq;
                        const f32x4 b0 = *(const f32x4*)(bgate + cg), b1 = *(const f32x4*)(bgate + cg + 4);
#pragma unroll
                        for (int j = 0; j < 4; ++j) { v0[j] = sigmoidf_(v0[j] + b0[j]); v1[j] = sigmoidf_(v1[j] + b1[j]); }
                        st8bf(G + (size_t)row * 2048 + cg, v0, v1);
                    }
                }
                if (pn >= 4 && pn < 8) {
                    ssum += __shfl_xor(ssum, 16); ssum += __shfl_xor(ssum, 32); ssq += __shfl_xor(ssq, 16); ssq += __shfl_xor(ssq, 32);
                    if (fq == 0) STATS[(size_t)row * 16 + (pn - 4) * 4 + wc] = (f32x2){ssum, ssq};
                }
            }
    }
};
struct EpiAB {
    bf16_t* MERGED; const bf16_t* G;
    __device__ __forceinline__ bool perm(const Unit&) const { return true; }
    __device__ __forceinline__ void mid(Acc& acc, const Unit& u, int wr, int wc, int fr, int fq) const {
        int zero; asm volatile("v_mov_b32 %0, 0" : "=v"(zero));
        const bf16_t* gp = G + (size_t)(u.pm * 256 + wr * 64 + fr + zero) * 2048 + u.pn * 256 + wc * 32 + 8 * fq;
#pragma unroll
        for (int ai = 0; ai < 2; ++ai)
#pragma unroll
            for (int m = 0; m < 4; ++m) {
#pragma unroll
                for (int bj = 0; bj < 2; ++bj) {
                    const bf16_t* q = gp + (size_t)(ai * 128 + m * 16) * 2048 + bj * 128;
                    f32x4 ga0, ga1, gb0, gb1; ld8bf(q, ga0, ga1); ld8bf(q + 1024, gb0, gb1);
#pragma unroll
                    for (int j = 0; j < 4; ++j) { acc[ai][bj][m][0][j] *= ga0[j] * __builtin_amdgcn_rcpf(gb0[j]); acc[ai][bj][m][1][j] *= ga1[j] * __builtin_amdgcn_rcpf(gb1[j]); }
                    asm volatile("" ::: "memory");
                }
            }
    }
    __device__ __forceinline__ void operator()(const Acc& acc, const Unit& u, int wr, int wc, int fr, int fq) const {
#pragma unroll
        for (int ai = 0; ai < 2; ++ai)
#pragma unroll
            for (int m = 0; m < 4; ++m) {
                const int row = u.pm * 256 + ai * 128 + wr * 64 + m * 16 + fr;
#pragma unroll
                for (int bj = 0; bj < 2; ++bj) {
                    const int c8 = u.pn * 256 + bj * 128 + wc * 32 + 8 * fq;
                    f32x4 gb0, gb1; ld8bf(G + (size_t)row * 2048 + 1024 + c8, gb0, gb1);
                    st8bf(MERGED + (size_t)row * 1024 + c8, gb0 * acc[ai][bj][m][0], gb1 * acc[ai][bj][m][1]);
                }
            }
    }
};
struct EpiO {
    float* X1; const float* X; const float* mod;
    __device__ __forceinline__ bool perm(const Unit&) const { return false; }
    __device__ __forceinline__ void operator()(const Acc& acc, const Unit& u, int wr, int wc, int fr, int fq) const {
#pragma unroll
        for (int ai = 0; ai < 2; ++ai)
#pragma unroll
            for (int m = 0; m < 4; ++m) {
                const int row = u.pm * 256 + ai * 128 + wr * 64 + m * 16 + fr; const float* g1 = mod + (size_t)(row >> 12) * 6144 + 2048;
#pragma unroll
                for (int bj = 0; bj < 2; ++bj)
#pragma unroll
                    for (int n = 0; n < 2; ++n) {
                        const int c = u.pn * 256 + bj * 128 + wc * 32 + 16 * n + 4 * fq;
                        const f32x4 xv = *(const f32x4*)(X + (size_t)row * 1024 + c), gv = *(const f32x4*)(g1 + c);
                        *(f32x4*)(X1 + (size_t)row * 1024 + c) = xv + gv * acc[ai][bj][m][n];
                    }
            }
    }
};
struct EpiGU {
    bf16_t* ACT;
    __device__ __forceinline__ bool perm(const Unit&) const { return true; }
    __device__ __forceinline__ void operator()(const Acc& acc, const Unit& u, int wr, int wc, int fr, int fq) const {
#pragma unroll
        for (int ai = 0; ai < 2; ++ai)
#pragma unroll
            for (int m = 0; m < 4; ++m) {
                const int prow = u.pm * 256 + ai * 128 + wr * 64 + m * 16 + fr;
                f32x4 a[2];
#pragma unroll
                for (int n = 0; n < 2; ++n) {
                    const f32x4 gt = acc[ai][0][m][n], up = acc[ai][1][m][n];
#pragma unroll
                    for (int j = 0; j < 4; ++j) a[n][j] = siluf_(gt[j]) * up[j];
                }
                st8bf(ACT + (size_t)prow * 2048 + u.pn * 128 + wc * 32 + 8 * fq, a[0], a[1]);
            }
    }
};
struct EpiD {
    bf16_t* YB; const float* TOPW;
    __device__ __forceinline__ bool perm(const Unit&) const { return true; }
    __device__ __forceinline__ void operator()(const Acc& acc, const Unit& u, int wr, int wc, int fr, int fq) const {
#pragma unroll
        for (int ai = 0; ai < 2; ++ai)
#pragma unroll
            for (int m = 0; m < 4; ++m) {
                const int prow = u.pm * 256 + ai * 128 + wr * 64 + m * 16 + fr; const float w = TOPW[prow];
#pragma unroll
                for (int bj = 0; bj < 2; ++bj)
                    st8bf(YB + (size_t)prow * 1024 + u.pn * 256 + bj * 128 + wc * 32 + 8 * fq, acc[ai][bj][m][0] * w, acc[ai][bj][m][1] * w);
            }
    }
};

__device__ __forceinline__ void transpose_item(const float* W, int N, int k0, int n0, bf16_t* dst, int ldt, LAS float* scr, int lane) {
    const int kk = lane >> 3, nq = (lane & 7) * 4;
    f32x4 v[8];
#pragma unroll
    for (int i = 0; i < 8; ++i) v[i] = *(const f32x4*)(W + (size_t)(k0 + 8 * i + kk) * N + n0 + nq);
#pragma unroll
    for (int i = 0; i < 8; ++i) { LAS float* s = scr + (8 * i + kk) * 33 + nq; s[0] = v[i].x; s[1] = v[i].y; s[2] = v[i].z; s[3] = v[i].w; }
    LDS_WAIT();
    const int c = lane & 7;
#pragma unroll
    for (int j = 0; j < 4; ++j) {
        const int n = (lane >> 3) + 8 * j; const LAS float* s = scr + (8 * c) * 33 + n;
        u32x4 o; o.x = pk2(s[0 * 33], s[1 * 33]); o.y = pk2(s[2 * 33], s[3 * 33]); o.z = pk2(s[4 * 33], s[5 * 33]); o.w = pk2(s[6 * 33], s[7 * 33]);
        *(u32x4*)(dst + (size_t)n * ldt + 8 * c) = o;
    }
    LDS_WAIT();
}

struct TrItem { const float* src; bf16_t* dst; int N, ldt; };
__device__ __forceinline__ void tr_load(const TrItem& it, f32x4 (&v)[8], int lane) {
    const int kk = lane >> 3, nq = (lane & 7) * 4;
#pragma unroll
    for (int i = 0; i < 8; ++i) v[i] = *(const f32x4*)(it.src + (size_t)(8 * i + kk) * it.N + nq);
}
__device__ __forceinline__ void tr_store(const TrItem& it, const f32x4 (&v)[8], LAS float* scr, int lane) {
    const int kk = lane >> 3, nq = (lane & 7) * 4;
#pragma unroll
    for (int i = 0; i < 8; ++i) { LAS float* s = scr + (8 * i + kk) * 33 + nq; s[0] = v[i].x; s[1] = v[i].y; s[2] = v[i].z; s[3] = v[i].w; }
    LDS_WAIT();
    const int c = lane & 7;
#pragma unroll
    for (int j = 0; j < 4; ++j) {
        const int n = (lane >> 3) + 8 * j; const LAS float* s = scr + (8 * c) * 33 + n;
        u32x4 o; o.x = pk2(s[0 * 33], s[1 * 33]); o.y = pk2(s[2 * 33], s[3 * 33]); o.z = pk2(s[4 * 33], s[5 * 33]); o.w = pk2(s[6 * 33], s[7 * 33]);
        *(u32x4*)(it.dst + (size_t)n * it.ldt + 8 * c) = o;
    }
    LDS_WAIT();
}

__device__ __forceinline__ void adaln_task(int task, const float* c, const float* cctx, const float* w_ada, const float* b_ada, float* mod, LAS float* lds, int tid) {
    LAS float* s = lds; LAS float* red = lds + 9 * 1024;
    { float cv[18];
#pragma unroll
      for (int q = 0; q < 18; ++q) { const int i = tid + NTHREADS * q, r = i >> 10, k = i & 1023; cv[q] = r < 8 ? c[r * 1024 + k] : cctx[k]; }
#pragma unroll
      for (int q = 0; q < 18; ++q) s[tid + NTHREADS * q] = cv[q] * __builtin_amdgcn_rcpf(1.f + __expf(-cv[q])); }
    __syncthreads();
    const int ch = tid & 7, kr = tid >> 3;
    f32x4 acc[9];
#pragma unroll
    for (int r = 0; r < 9; ++r) acc[r] = (f32x4){0.f, 0.f, 0.f, 0.f};
    const float* wp = w_ada + (size_t)kr * 6144 + task * 32 + ch * 4;
    for (int it = 0; it < 16; ++it) {
        const f32x4 w = *(const f32x4*)(wp + (size_t)it * 64 * 6144); const int k = kr + it * 64;
#pragma unroll
        for (int r = 0; r < 9; ++r) acc[r] += s[r * 1024 + k] * w;
    }
#pragma unroll
    for (int r = 0; r < 9; ++r) *(LAS f32x4*)(red + (kr * 9 + r) * 32 + ch * 4) = acc[r];
    __syncthreads();
    if (tid < 288) { const int r = tid >> 5, col = tid & 31; float sum = 0.f; for (int q = 0; q < 64; ++q) sum += red[(q * 9 + r) * 32 + col]; mod[r * 6144 + task * 32 + col] = sum + b_ada[task * 32 + col]; }
    __syncthreads();
}

__device__ __forceinline__ void rope_table(f32x2* tab, int tid) {
    for (int idx = tid; idx < 1024; idx += NTHREADS) {
        const int pos = idx >> 4, i = idx & 15;
        double f = 1.0;
        for (int q = 0; q < i; ++q) f *= 0.56234132519034908;
        const float ang = (float)pos * (float)f;
        const double a = (double)ang, k = __builtin_rint(a * 0.15915494309189535), r = a - k * 6.283185307179586476925, r2 = r * r;
        double sn = r, ts = r, cs = 1.0, tc = 1.0;
        for (int n = 1; n <= 14; ++n) {
            tc *= -r2 / (double)((2 * n - 1) * (2 * n)); cs += tc;
            ts *= -r2 / (double)((2 * n) * (2 * n + 1)); sn += ts;
        }
        tab[idx] = (f32x2){(float)cs, (float)sn};
    }
}

__device__ __forceinline__ unsigned char* lds_raw_ptr(LAS unsigned char* p) { return (unsigned char*)p; }
namespace mix {
typedef short bf16x8 __attribute__((ext_vector_type(8)));
typedef short s16x4 __attribute__((ext_vector_type(4)));
typedef float f32x16 __attribute__((ext_vector_type(16)));
typedef __attribute__((address_space(3))) const char* lds_cptr;
__device__ __forceinline__ int crow(int r, int hi) { return (r & 3) + 8 * (r >> 2) + 4 * hi; }
__device__ __forceinline__ unsigned cvtpk(float lo, float hi) { typedef float f2 __attribute__((ext_vector_type(2))); typedef __bf16 b2 __attribute__((ext_vector_type(2))); f2 v = {lo, hi}; b2 b = __builtin_convertvector(v, b2); return __builtin_bit_cast(unsigned, b); }
__device__ __forceinline__ s16x4 vtr(lds_cptr p) { return __builtin_bit_cast(s16x4, __builtin_amdgcn_ds_read_tr16_b64_v4i16((__attribute__((address_space(3))) s16x4*)p)); }
__device__ __forceinline__ bf16x8 pk8(s16x4 lo, s16x4 hi) { return (bf16x8){lo[0], lo[1], lo[2], lo[3], hi[0], hi[1], hi[2], hi[3]}; }
__device__ __forceinline__ float max3f(float a, float b, float c) { float r; asm("v_max3_f32 %0, %1, %2, %3" : "=v"(r) : "v"(a), "v"(b), "v"(c)); return r; }
__device__ __forceinline__ float max2f(float a, float b) { float r; asm("v_max_f32_e32 %0, %1, %2" : "=v"(r) : "v"(a), "v"(b)); return r; }
__device__ __forceinline__ float swap_half(float v) { auto rr = __builtin_amdgcn_permlane32_swap(__float_as_uint(v), __float_as_uint(v), false, false); return __uint_as_float((threadIdx.x & 32) ? rr[0] : rr[1]); }

constexpr int A_K = 0, A_V = 24576, A_WS = 49152, A_QST = 53248, A_OST = A_QST, A_OSTW = 8192, A_END = A_QST + 8 * 8192;

__device__ __forceinline__ void attn_unit(int b, int n, int kvh, bf16_t* Y, bf16_t* O, int ldo, const bf16_t* KB, const bf16_t* VB, const float* sink, LAS unsigned char* lds) {
    const int tid = threadIdx.x, lane = tid & 63, r32 = lane & 31, hi = lane >> 5, wid = __builtin_amdgcn_readfirstlane(tid >> 6);
    const int head = kvh * 4 + (wid >> 1);
    const int qrow0 = b * SEQ + n * 128 + (wid & 1) * 64;
    bf16_t* Qw = Y + (size_t)qrow0 * 2048 + 1024 + head * 64;
    LAS bf16x8* qst = (LAS bf16x8*)(lds + A_QST + wid * 8192) + lane;
#pragma unroll
    for (int sb = 0; sb < 2; ++sb)
#pragma unroll
        for (int d0 = 0; d0 < 4; ++d0) qst[(sb * 4 + d0) * 64] = *(const bf16x8*)(Qw + (size_t)(32 * sb + r32) * 2048 + d0 * 16 + hi * 8);
    f32x16 o[2][2];
#pragma unroll
    for (int sb = 0; sb < 2; ++sb)
#pragma unroll
        for (int d0 = 0; d0 < 2; ++d0)
#pragma unroll
            for (int r = 0; r < 16; ++r) o[sb][d0][r] = 0.f;
    float m[2] = {-1e30f, -1e30f}, l[2] = {0.f, 0.f};
    LAS float* wsf = (LAS float*)(lds + A_WS) + wid * 128;
    const int jlo = (n == 0) ? 2 : 0, jhi = (n == 31) ? 3 : 5, T = 4 + (jhi - jlo + 1);
    const size_t koff = (size_t)lane * 256 + wid * 8 + kvh * 64;
    const size_t voff = (size_t)(16 * (wid & 3) + (lane >> 2)) * 256 + (wid >> 2) * 32 + (lane & 3) * 8 + kvh * 64;
    auto tile_row = [&](int t) -> long { return t < 4 ? (long)(NTOK + b * CTXL + 64 * t) : (long)(b * SEQ + (n - 1) * 128 + 64 * (jlo + t - 4)); };
    auto issue = [&](int t) {
        const long row = tile_row(t); const int buf = t % 3;
        __builtin_amdgcn_global_load_lds((const unsigned*)(KB + row * 256 + koff), (LAS unsigned*)(lds + A_K + buf * 8192 + wid * 1024), 16, 0, 0);
        __builtin_amdgcn_global_load_lds((const unsigned*)(VB + row * 256 + voff), (LAS unsigned*)(lds + A_V + buf * 8192 + wid * 1024), 16, 0, 0);
    };
    issue(0); issue(1);
    int slot = 0;
    for (int t = 0; t < T; ++t) {
        if (t + 1 < T) asm volatile("s_waitcnt vmcnt(2) lgkmcnt(0)" ::: "memory"); else asm volatile("s_waitcnt vmcnt(0) lgkmcnt(0)" ::: "memory");
        __builtin_amdgcn_s_barrier();
        if (t + 2 < T) issue(t + 2);
        const lds_cptr Kt = (lds_cptr)(lds + A_K + slot * 8192) + hi * 1024 + r32 * 16;
        const lds_cptr Vt = (lds_cptr)(lds + A_V + slot * 8192) + ((lane >> 4) & 1) * 32 + (lane & 3) * 8 + (4 * hi + ((lane & 15) >> 2)) * 64;
        slot = (slot == 2) ? 0 : slot + 1;
        const bool local = t >= 4;
        const int dl = 64 * (jlo + t - 4) - 128 - 64 * (wid & 1);
        if (local && (dl > 160 || dl < -191)) continue;
        f32x16 p0[2], p1[2];
#pragma unroll
        for (int sb = 0; sb < 2; ++sb)
#pragma unroll
            for (int r = 0; r < 16; ++r) { p0[sb][r] = 0.f; p1[sb][r] = 0.f; }
#pragma unroll
        for (int d0 = 0; d0 < 4; ++d0) {
            const bf16x8 k0 = *(const __attribute__((address_space(3))) bf16x8*)(Kt + d0 * 2048), k1 = *(const __attribute__((address_space(3))) bf16x8*)(Kt + d0 * 2048 + 512);
#pragma unroll
            for (int sb = 0; sb < 2; ++sb) {
                const bf16x8 qf = qst[(sb * 4 + d0) * 64];
                p0[sb] = __builtin_amdgcn_mfma_f32_32x32x16_bf16(k0, qf, p0[sb], 0, 0, 0);
                p1[sb] = __builtin_amdgcn_mfma_f32_32x32x16_bf16(k1, qf, p1[sb], 0, 0, 0);
            }
        }
        if (local && (dl < -97 || dl > 65 || dl - 32 < -97)) {
#pragma unroll
            for (int sb = 0; sb < 2; ++sb)
#pragma unroll
                for (int r = 0; r < 16; ++r) { const int rel = dl - 32 * sb + crow(r, hi) - r32; if (rel < -128 || rel > 128) p0[sb][r] = -1e30f; if (rel + 32 < -128 || rel + 32 > 128) p1[sb][r] = -1e30f; }
        }
        float mn[2];
        asm volatile("s_nop 15\n\ts_nop 7" : "+v"(p0[0]), "+v"(p1[0]), "+v"(p0[1]), "+v"(p1[1]));
#pragma unroll
        for (int sb = 0; sb < 2; ++sb) {
            float a = max3f(p0[sb][0], p0[sb][1], p1[sb][0]), b2 = max3f(p0[sb][2], p0[sb][3], p1[sb][1]); a = max3f(a, p1[sb][2], p1[sb][3]);
#pragma unroll
            for (int r = 4; r < 16; r += 4) { a = max3f(a, p0[sb][r], p0[sb][r + 1]); b2 = max3f(b2, p0[sb][r + 2], p0[sb][r + 3]); a = max3f(a, p1[sb][r], p1[sb][r + 1]); b2 = max3f(b2, p1[sb][r + 2], p1[sb][r + 3]); }
            float rm = max2f(a, b2);
            rm = max2f(rm, swap_half(rm));
            mn[sb] = max2f(m[sb], rm);
        }
        if (__any((mn[0] > m[0]) || (mn[1] > m[1]))) {
            const float f0 = __builtin_amdgcn_exp2f(m[0] - mn[0]), f1 = __builtin_amdgcn_exp2f(m[1] - mn[1]);
            l[0] *= f0; l[1] *= f1;
            if (hi == 0) { wsf[r32] = f0; wsf[64 + r32] = f1; }
            asm volatile("s_waitcnt lgkmcnt(0)" ::: "memory");
#pragma unroll
            for (int r = 0; r < 16; ++r) { const float a = wsf[crow(r, hi)], b2 = wsf[64 + crow(r, hi)]; o[0][0][r] *= a; o[0][1][r] *= a; o[1][0][r] *= b2; o[1][1][r] *= b2; }
            m[0] = mn[0]; m[1] = mn[1];
        }
        u32x4 pw[2][4];
#pragma unroll
        for (int sb = 0; sb < 2; ++sb) {
            float sacc = 0.f;
#pragma unroll
            for (int r = 0; r < 16; ++r) { p0[sb][r] = __builtin_amdgcn_exp2f(p0[sb][r] - m[sb]); p1[sb][r] = __builtin_amdgcn_exp2f(p1[sb][r] - m[sb]); sacc += p0[sb][r] + p1[sb][r]; }
            l[sb] += sacc;
#pragma unroll
            for (int q = 0; q < 4; ++q) { pw[sb][0][q] = cvtpk(p0[sb][2 * q], p0[sb][2 * q + 1]); pw[sb][1][q] = cvtpk(p0[sb][8 + 2 * q], p0[sb][9 + 2 * q]); pw[sb][2][q] = cvtpk(p1[sb][2 * q], p1[sb][2 * q + 1]); pw[sb][3][q] = cvtpk(p1[sb][8 + 2 * q], p1[sb][9 + 2 * q]); }
        }
#pragma unroll
        for (int d0 = 0; d0 < 2; ++d0)
#pragma unroll
            for (int ks = 0; ks < 4; ++ks) {
                const s16x4 vlo = vtr(Vt + d0 * 4096 + ks * 1024), vhi = vtr(Vt + d0 * 4096 + ks * 1024 + 512);
                const bf16x8 vf = pk8(vlo, vhi);
#pragma unroll
                for (int sb = 0; sb < 2; ++sb) o[sb][d0] = __builtin_amdgcn_mfma_f32_32x32x16_bf16(__builtin_bit_cast(bf16x8, pw[sb][ks]), vf, o[sb][d0], 0, 0, 0);
            }
    }
    const float s2 = sink[head] * LOG2E;
    LAS bf16_t* stg = (LAS bf16_t*)(lds + A_OST + wid * A_OSTW);
#pragma unroll
    for (int sb = 0; sb < 2; ++sb) {
        const float lt = l[sb] + swap_half(l[sb]);
        const float mf = fmaxf(m[sb], s2), f = __builtin_amdgcn_exp2f(m[sb] - mf), den = lt * f + __builtin_amdgcn_exp2f(s2 - mf);
        asm volatile("s_waitcnt lgkmcnt(0)" ::: "memory");
        if (hi == 0) wsf[sb * 64 + r32] = f / den;
        asm volatile("s_waitcnt lgkmcnt(0)" ::: "memory");
#pragma unroll
        for (int r = 0; r < 16; ++r) { const float sc = wsf[sb * 64 + crow(r, hi)]; const int orow = crow(r, hi);
            stg[orow * 64 + r32] = (bf16_t)f2bf(o[sb][0][r] * sc); stg[orow * 64 + 32 + r32] = (bf16_t)f2bf(o[sb][1][r] * sc); }
        asm volatile("s_waitcnt lgkmcnt(0)" ::: "memory");
#pragma unroll
        for (int i = 0; i < 4; ++i) { const int row = i * 8 + (lane >> 3), ch = lane & 7; const u32x4 v = *(const LAS u32x4*)(stg + row * 64 + ch * 8); *(u32x4*)(O + (size_t)(qrow0 + 32 * sb + row) * ldo + head * 64 + ch * 8) = v; }
        asm volatile("s_waitcnt lgkmcnt(0)" ::: "memory");
    }
    __syncthreads();
}

constexpr int G_V = 0, G_ST = 65536, G_STW = 8704, G_MU = G_ST + 8 * G_STW;
__device__ __forceinline__ void gmlp_unit(int task, bf16_t* Y, bf16_t* YO, int ldo, const bf16_t* VA, const bf16_t* WSP, const f32x2* STATS, const float* ln_g, const float* ln_b, const float* b_sp, LAS unsigned char* lds) {
    const int tid = threadIdx.x, lane = tid & 63, r32 = lane & 31, hi = lane >> 5, wid = __builtin_amdgcn_readfirstlane(tid >> 6);
    const int r0 = task * 128;
    LAS float* mu = (LAS float*)(lds + G_MU); LAS float* rs = mu + 128;
    if (tid < 128) {
        const f32x4* sp = (const f32x4*)(STATS + (size_t)(r0 + tid) * 16); float s = 0.f, ss = 0.f;
#pragma unroll
        for (int i = 0; i < 8; ++i) { const f32x4 v = sp[i]; s += v.x + v.z; ss += v.y + v.w; }
        const float mean = s * (1.f / 1024.f), var = fmaxf(ss * (1.f / 1024.f) - mean * mean, 0.f);
        mu[tid] = mean; rs[tid] = 1.0f / sqrtf(var + EPS);
    }
    u32x4 raw[4];
#pragma unroll
    for (int i = 0; i < 4; ++i) { const int idx = tid + NTHREADS * i, q = idx >> 4, c8 = idx & 15; raw[i] = *(const u32x4*)(VA + (size_t)(r0 + q) * 1024 + c8 * 8); }
    __syncthreads();
    const int pb = wid >> 1, dh = wid & 1;
    LAS float* st = (LAS float*)(lds + G_ST + wid * G_STW);
    for (int g8 = 0; g8 < 8; ++g8) {
        LAS unsigned char* vb = lds + G_V + (g8 & 1) * 32768;
#pragma unroll
        for (int i = 0; i < 4; ++i) {
            const int idx = tid + NTHREADS * i, q = idx >> 4, c8 = idx & 15, d = c8 * 8;
            const f32x4 g0 = *(const f32x4*)(ln_g + g8 * 128 + d), g1 = *(const f32x4*)(ln_g + g8 * 128 + d + 4), b0 = *(const f32x4*)(ln_b + g8 * 128 + d), b1 = *(const f32x4*)(ln_b + g8 * 128 + d + 4);
            const float mq = mu[q], rq = rs[q]; const u32x4 rw = raw[i];
            float v[8] = {bf2f(rw.x & 0xffffu), bf2f(rw.x >> 16), bf2f(rw.y & 0xffffu), bf2f(rw.y >> 16), bf2f(rw.z & 0xffffu), bf2f(rw.z >> 16), bf2f(rw.w & 0xffffu), bf2f(rw.w >> 16)};
#pragma unroll
            for (int e = 0; e < 4; ++e) { v[e] = (v[e] - mq) * rq * g0[e] + b0[e]; v[4 + e] = (v[4 + e] - mq) * rq * g1[e] + b1[e]; }
            u32x4 w; w.x = pk2(v[0], v[1]); w.y = pk2(v[2], v[3]); w.z = pk2(v[4], v[5]); w.w = pk2(v[6], v[7]);
            *(LAS u32x4*)(vb + ((d >> 5) * 8 + (q >> 4)) * 1024 + (q & 15) * 64 + (d & 31) * 2) = w;
        }
        if (g8 + 1 < 8) {
#pragma unroll
            for (int i = 0; i < 4; ++i) { const int idx = tid + NTHREADS * i, q = idx >> 4, c8 = idx & 15; raw[i] = *(const u32x4*)(VA + (size_t)(r0 + q) * 1024 + (g8 + 1) * 128 + c8 * 8); }
        }
        u32x4 ur[4]; bf16x8 af[8];
        const size_t ybase = (size_t)(r0 + 32 * pb + (lane >> 3)) * 2048 + g8 * 128 + 64 * dh + (lane & 7) * 8;
#pragma unroll
        for (int i = 0; i < 4; ++i) ur[i] = *(const u32x4*)(Y + ybase + (size_t)(8 * i) * 2048);
        const bf16_t* wrow = WSP + (size_t)g8 * 16384 + (size_t)(32 * pb + r32) * 128 + 8 * hi;
#pragma unroll
        for (int ks = 0; ks < 8; ++ks) af[ks] = *(const bf16x8*)(wrow + 16 * ks);
        __syncthreads();
        const lds_cptr Vb = (lds_cptr)vb + ((lane >> 4) & 1) * 32 + (lane & 3) * 8 + (8 * hi + ((lane & 15) >> 2)) * 64;
        f32x16 acc[2];
#pragma unroll
        for (int t2 = 0; t2 < 2; ++t2)
#pragma unroll
            for (int r = 0; r < 16; ++r) acc[t2][r] = 0.f;
#pragma unroll
        for (int ks = 0; ks < 8; ++ks) {
#pragma unroll
            for (int t2 = 0; t2 < 2; ++t2) {
                const int db = 2 * dh + t2;
                const s16x4 vlo = vtr(Vb + (db * 8 + ks) * 1024), vhi = vtr(Vb + (db * 8 + ks) * 1024 + 256);
                acc[t2] = __builtin_amdgcn_mfma_f32_32x32x16_bf16(af[ks], pk8(vlo, vhi), acc[t2], 0, 0, 0);
            }
        }
#pragma unroll
        for (int t2 = 0; t2 < 2; ++t2)
#pragma unroll
            for (int r = 0; r < 16; ++r) st[crow(r, hi) * 68 + 32 * t2 + r32] = acc[t2][r];
        asm volatile("s_waitcnt lgkmcnt(0)" ::: "memory");
#pragma unroll
        for (int i = 0; i < 4; ++i) {
            const int prow = 8 * i + (lane >> 3), ch = lane & 7;
            const f32x4 m0 = *(const LAS f32x4*)(st + prow * 68 + ch * 8), m1 = *(const LAS f32x4*)(st + prow * 68 + ch * 8 + 4);
            const float bs = b_sp[g8 * 128 + 32 * pb + prow]; const u32x4 uw = ur[i];
            u32x4 o;
            o.x = pk2(bf2f(uw.x & 0xffffu) * (m0.x + bs), bf2f(uw.x >> 16) * (m0.y + bs)); o.y = pk2(bf2f(uw.y & 0xffffu) * (m0.z + bs), bf2f(uw.y >> 16) * (m0.w + bs));
            o.z = pk2(bf2f(uw.z & 0xffffu) * (m1.x + bs), bf2f(uw.z >> 16) * (m1.y + bs)); o.w = pk2(bf2f(uw.w & 0xffffu) * (m1.z + bs), bf2f(uw.w >> 16) * (m1.w + bs));
            *(u32x4*)(YO + (size_t)(r0 + 32 * pb + prow) * ldo + g8 * 128 + 64 * dh + ch * 8) = o;
        }
        asm volatile("s_waitcnt lgkmcnt(0)" ::: "memory");
    }
    __syncthreads();
}
}

namespace att2 {
typedef short bf16x8 __attribute__((ext_vector_type(8)));
typedef short s16x4 __attribute__((ext_vector_type(4)));
typedef float f32x16 __attribute__((ext_vector_type(16)));
typedef __attribute__((address_space(3))) const char* lds_cptr;
typedef short v4i16_t __attribute__((ext_vector_type(4)));
__device__ __forceinline__ int crow(int r, int hi) { return (r & 3) + 8 * (r >> 2) + 4 * hi; }
#define SBAR() __builtin_amdgcn_sched_barrier(0)
constexpr int NSLOT = 3, SLOTB = 8192;
constexpr int LDS_K = 0, LDS_V = NSLOT * SLOTB, LDS_WS = 2 * NSLOT * SLOTB, LDS_OST = LDS_WS + 8 * 64 * 4, LDS_BYTES = LDS_OST + 8 * 4096;
__device__ __forceinline__ void glds16(const void* gsrc, unsigned lds_dst) { unsigned keep;
    asm volatile("s_mov_b32 %0, m0\n\ts_mov_b32 m0, %2\n\ts_nop 0\n\tglobal_load_lds_dwordx4 %1, off\n\ts_mov_b32 m0, %0" : "=&s"(keep) : "v"(gsrc), "s"(lds_dst) : "memory"); }
__device__ __forceinline__ float max3f(float a, float b, float c) { float r; asm("v_max3_f32 %0, %1, %2, %3" : "=v"(r) : "v"(a), "v"(b), "v"(c)); return r; }
__device__ __forceinline__ float max2f(float a, float b) { float r; asm("v_max_f32_e32 %0, %1, %2" : "=v"(r) : "v"(a), "v"(b)); return r; }
__device__ __forceinline__ float fadd_s(float a, float b) { float r; asm("v_add_f32_e32 %0, %1, %2" : "=v"(r) : "v"(a), "v"(b)); return r; }
__device__ __forceinline__ float fsub_s(float a, float b) { float r; asm("v_sub_f32_e32 %0, %1, %2" : "=v"(r) : "v"(a), "v"(b)); return r; }
typedef float f32x2_t __attribute__((ext_vector_type(2))); typedef __bf16 bf16x2_t __attribute__((ext_vector_type(2)));
__device__ __forceinline__ unsigned cvtpk_s(float lo, float hi) { f32x2_t v = {lo, hi}; bf16x2_t b = __builtin_convertvector(v, bf16x2_t); return __builtin_bit_cast(unsigned, b); }
#define WAIT_BAR(N) asm volatile("s_waitcnt vmcnt(" #N ") lgkmcnt(0)\n\ts_barrier" ::: "memory")
__device__ __forceinline__ void qkt(f32x16& p0, f32x16& p1, lds_cptr Kslot, const bf16x8* qr, const f32x16& negm, int r32, int hi) {
    const lds_cptr kb = Kslot + hi * 1024 + r32 * 16;
#pragma unroll
    for (int d0 = 0; d0 < 4; ++d0) {
        const bf16x8 b0 = *(const __attribute__((address_space(3))) bf16x8*)(kb + d0 * 2048);
        const bf16x8 b1 = *(const __attribute__((address_space(3))) bf16x8*)(kb + d0 * 2048 + 512);
        if (d0 == 0) { p0 = __builtin_amdgcn_mfma_f32_32x32x16_bf16(b0, qr[0], negm, 0, 0, 0); p1 = __builtin_amdgcn_mfma_f32_32x32x16_bf16(b1, qr[0], negm, 0, 0, 0); }
        else { p0 = __builtin_amdgcn_mfma_f32_32x32x16_bf16(b0, qr[d0], p0, 0, 0, 0); p1 = __builtin_amdgcn_mfma_f32_32x32x16_bf16(b1, qr[d0], p1, 0, 0, 0); }
    }
}
__device__ __forceinline__ void kload8(bf16x8* kf, lds_cptr kp) {
    kf[0] = *(const __attribute__((address_space(3))) bf16x8*)(kp);        kf[1] = *(const __attribute__((address_space(3))) bf16x8*)(kp + 512);
    kf[2] = *(const __attribute__((address_space(3))) bf16x8*)(kp + 2048); kf[3] = *(const __attribute__((address_space(3))) bf16x8*)(kp + 2560);
    kf[4] = *(const __attribute__((address_space(3))) bf16x8*)(kp + 4096); kf[5] = *(const __attribute__((address_space(3))) bf16x8*)(kp + 4608);
    kf[6] = *(const __attribute__((address_space(3))) bf16x8*)(kp + 6144); kf[7] = *(const __attribute__((address_space(3))) bf16x8*)(kp + 6656);
}
__device__ __forceinline__ void kload2(bf16x8* kf, lds_cptr kp, int j) { kf[2 * j] = *(const __attribute__((address_space(3))) bf16x8*)(kp + j * 2048); kf[2 * j + 1] = *(const __attribute__((address_space(3))) bf16x8*)(kp + j * 2048 + 512); }
__device__ __forceinline__ s16x4 vtr(lds_cptr p) { return __builtin_bit_cast(s16x4, __builtin_amdgcn_ds_read_tr16_b64_v4i16((__attribute__((address_space(3))) v4i16_t*)p)); }
__device__ __forceinline__ float rowmax(const f32x16& p0, const f32x16& p1) {
    float a = max3f(p0[0], p0[1], p1[0]), b = max3f(p0[2], p0[3], p1[1]); a = max3f(a, p1[2], p1[3]);
#pragma unroll
    for (int r = 4; r < 16; r += 4) { a = max3f(a, p0[r], p0[r + 1]); b = max3f(b, p0[r + 2], p0[r + 3]); a = max3f(a, p1[r], p1[r + 1]); b = max3f(b, p1[r + 2], p1[r + 3]); }
    const float m = max2f(a, b);
    auto rr = __builtin_amdgcn_permlane32_swap(__float_as_uint(m), __float_as_uint(m), false, false);
    return max2f(__uint_as_float(rr[0]), __uint_as_float(rr[1]));
}
__device__ __forceinline__ void pv(f32x16* o, int vb, bf16x8 pa0, bf16x8 pa1, bf16x8 pa2, bf16x8 pa3) {
#pragma unroll
    for (int d0 = 0; d0 < 2; ++d0) { s16x4 lo[4], hi[4];
#pragma unroll
        for (int ks = 0; ks < 4; ++ks) {
            asm volatile("ds_read_b64_tr_b16 %0,%1 offset:%c2" : "=&v"(lo[ks]) : "v"(vb), "i"(d0 * 4096 + ks * 1024) : "memory");
            asm volatile("ds_read_b64_tr_b16 %0,%1 offset:%c2" : "=&v"(hi[ks]) : "v"(vb), "i"(d0 * 4096 + ks * 1024 + 512) : "memory"); }
        asm volatile("s_waitcnt lgkmcnt(0)" ::: "memory"); SBAR();
#define PK(k) (bf16x8){lo[k][0], lo[k][1], lo[k][2], lo[k][3], hi[k][0], hi[k][1], hi[k][2], hi[k][3]}
        o[d0] = __builtin_amdgcn_mfma_f32_32x32x16_bf16(pa0, PK(0), o[d0], 0, 0, 0);
        o[d0] = __builtin_amdgcn_mfma_f32_32x32x16_bf16(pa1, PK(1), o[d0], 0, 0, 0);
        o[d0] = __builtin_amdgcn_mfma_f32_32x32x16_bf16(pa2, PK(2), o[d0], 0, 0, 0);
        o[d0] = __builtin_amdgcn_mfma_f32_32x32x16_bf16(pa3, PK(3), o[d0], 0, 0, 0);
#undef PK
    }
}
__device__ __forceinline__ void wmask(f32x16& p0, f32x16& p1, int dl, int r32, int hi) {
    const float NEG = -INFINITY;
#pragma unroll
    for (int r = 0; r < 16; ++r) { const int rel = dl + crow(r, hi) - r32; if (rel < -128 || rel > 128) p0[r] = NEG; if (rel + 32 < -128 || rel + 32 > 128) p1[r] = NEG; }
}

template <int THRL> __device__ __forceinline__ void attn_unit(int b, int n, int kvh, int hp, int base, bool primed, bool has_next, int nb, int nn, int nkvh, int nhp, bf16x8 (&qr)[4], int& nbase,
                                                              const bf16_t* Y, bf16_t* O, int ldo, const bf16_t* KB, const bf16_t* VB, const float* sink, LAS unsigned char* shm) {
    const int tid = threadIdx.x, lane = tid & 63, r32 = lane & 31, hi = lane >> 5; const int wid = __builtin_amdgcn_readfirstlane(tid >> 6);
    const int head = kvh * 4 + hp * 2 + (wid >> 2), qsub = wid & 3;
    const long qrow0 = (long)b * SEQ + n * 128 + qsub * 32;
    const bf16_t* Qw = Y + qrow0 * 2048 + 1024 + head * 64;
    const unsigned lds0 = (unsigned)(uintptr_t)shm;
    LAS float* wsf = (LAS float*)(shm + LDS_WS) + wid * 64;
    const long koff = (long)lane * 256 + kvh * 64 + wid * 8;
    const long voff = (long)(16 * (wid & 3) + (lane >> 2)) * 256 + kvh * 64 + (wid >> 2) * 32 + (lane & 3) * 8;
    const unsigned kdst = lds0 + LDS_K + wid * 1024, vdst = lds0 + LDS_V + wid * 1024;
    const int jlo = (n == 0) ? 2 : 0, jhi = (n == 31) ? 3 : 5, NT = 4 + (jhi - jlo + 1);
    const long lrow0 = (long)b * SEQ + (n - 1) * 128 + 64 * (jlo - 4), crow0 = (long)NTOK + b * CTXL;
#define TROW(t) ((t) < 4 ? crow0 + 64 * (t) : lrow0 + 64 * (t))
#define DMA_K(t, slot) glds16(KB + TROW(t) * 256 + koff, (unsigned)__builtin_amdgcn_readfirstlane(kdst + (slot)))
#define DMA_V(t, slot) glds16(VB + TROW(t) * 256 + voff, (unsigned)__builtin_amdgcn_readfirstlane(vdst + (slot)))
    const int vb0 = (int)(lds0 + LDS_V) + ((lane >> 4) & 1) * 32 + (lane & 3) * 8 + (4 * hi + ((lane & 15) >> 2)) * 64;
    bf16x8 kf[8];
    const lds_cptr shm3 = (lds_cptr)shm; const lds_cptr kp0 = shm3 + LDS_K + hi * 1024 + r32 * 16; const lds_cptr vp0 = shm3 + LDS_V + ((lane >> 4) & 1) * 32 + (lane & 3) * 8 + (4 * hi + ((lane & 15) >> 2)) * 64;
    const int s0 = base, s1 = (s0 == (NSLOT - 1) * SLOTB) ? 0 : s0 + SLOTB, s2 = (s1 == (NSLOT - 1) * SLOTB) ? 0 : s1 + SLOTB;
    if (!primed) {
        DMA_K(0, s0); DMA_V(0, s0); DMA_K(1, s1); DMA_K(2, s2);
#pragma unroll
        for (int d0 = 0; d0 < 4; ++d0) qr[d0] = *(const bf16x8*)(Qw + (long)r32 * 2048 + d0 * 16 + hi * 8);
    }
    float mhat = 0.f, l_reg = 0.f; f32x16 o[2]; o[0] = f32x16{}; o[1] = f32x16{}; f32x16 negm = f32x16{}; asm volatile("" : "+v"(negm));
    const int dq = -128 - 32 * qsub;
#define CMASK(P0, P1, t) do { if ((t) >= 4) { const int dl_ = 64 * (jlo + (t) - 4) + dq; if (dl_ < -97 || dl_ > 65) wmask(P0, P1, dl_, r32, hi); } } while (0)
    bool resc = false;
#define START(P0, P1) do { const float rm = rowmax(P0, P1); resc = false; \
    { const float dl = rm; mhat = fadd_s(mhat, dl); \
      _Pragma("unroll") for (int r = 0; r < 16; ++r) { P0[r] = fsub_s(P0[r], dl); P1[r] = fsub_s(P1[r], dl); } \
      _Pragma("unroll") for (int r = 0; r < 16; ++r) negm[r] = -mhat; asm volatile("" : "+v"(negm)); } \
    _Pragma("unroll") for (int r = 0; r < 16; ++r) P0[r] = __builtin_amdgcn_exp2f(P0[r]); } while (0)
#define RESC() do { if (resc) { asm volatile("s_waitcnt lgkmcnt(0)" ::: "memory"); \
      _Pragma("unroll") for (int d_ = 0; d_ < 2; ++d_) _Pragma("unroll") for (int r = 0; r < 16; ++r) o[d_][r] *= wsf[crow(r, hi)]; } } while (0)
    f32x16 pA0, pA1, pB0, pB1;
    int sl_prev = s0, sl_cur = s0, sl_next = s1;
#define ROT() do { sl_prev = sl_cur; sl_cur = sl_next; sl_next = (sl_next == (NSLOT - 1) * SLOTB) ? 0 : sl_next + SLOTB; } while (0)
    WAIT_BAR(7);
    qkt(pA0, pA1, shm3 + LDS_K + s0, qr, negm, r32, hi); asm volatile("s_nop 15\n\ts_nop 7" : "+v"(pA0), "+v"(pA1)); CMASK(pA0, pA1, 0);
    START(pA0, pA1);
    _Pragma("unroll") for (int r = 0; r < 16; ++r) pA1[r] = __builtin_amdgcn_exp2f(pA1[r]);
    WAIT_BAR(0);
    DMA_K(3, s0); DMA_V(1, s1);
    ROT();
    kload8(kf, kp0 + sl_cur);
    WAIT_BAR(2);
    s16x4 vlo[8], vhi[8]; u32x4 pw0, pw1, pw2, pw3;
#define PKW(P, B) cvtpk_s(P[B], P[B + 1])
#define PAF(k) __builtin_bit_cast(bf16x8, pw##k)
#define VFR(i) (bf16x8){vlo[i][0], vlo[i][1], vlo[i][2], vlo[i][3], vhi[i][0], vhi[i][1], vhi[i][2], vhi[i][3]}
#define PIN(x) asm volatile("" : "+v"(x))
#define MX3(a, b, c) __builtin_fmaxf(__builtin_fmaxf((a), (b)), (c))
#define GAPA(MF, A0, A1, A2, A3, W0, W1, PW) do { MF; sacc += A0; sacc += A1; sacc += A2; sacc += A3; PIN(sacc); W0; W1; PIN(PW); SBAR(); } while (0)
#define EX(v) __builtin_amdgcn_exp2f(v)
#define GAPB(MF, X, B) do { MF; X[B] = EX(X[B]); X[B + 1] = EX(X[B + 1]); X[B + 2] = EX(X[B + 2]); X[B + 3] = EX(X[B + 3]); PIN(X); SBAR(); } while (0)
#define VRD(i) do { vlo[i] = vtr(vp_ + (((i) >> 2) * 4096 + ((i) & 3) * 1024)); vhi[i] = vtr(vp_ + (((i) >> 2) * 4096 + ((i) & 3) * 1024 + 512)); } while (0)
#define KRD(G, j) do { if (G) { kload2(kf, kp0 + sl_next, j); SBAR(); } } while (0)
#define STEP(C0, C1, P0, P1, t, GK, GV, GL) do { SBAR(); \
    const lds_cptr vp_ = vp0 + sl_prev; \
    VRD(0); SBAR(); float sacc = (P0[0] + P0[1]); \
    GAPA(C0 = __builtin_amdgcn_mfma_f32_32x32x16_bf16(kf[0], qr[0], negm, 0, 0, 0), P0[2], P0[3], P0[4], P0[5],     pw0[0] = PKW(P0, 0), pw0[1] = PKW(P0, 2), pw0); \
    VRD(4); SBAR(); GAPA(C1 = __builtin_amdgcn_mfma_f32_32x32x16_bf16(kf[1], qr[0], negm, 0, 0, 0), P0[6], P0[7], P0[8], P0[9],     pw0[2] = PKW(P0, 4), pw0[3] = PKW(P0, 6), pw0); \
    VRD(1); SBAR(); GAPA(C0 = __builtin_amdgcn_mfma_f32_32x32x16_bf16(kf[2], qr[1], C0, 0, 0, 0),   P0[10], P0[11], P0[12], P0[13], pw1[0] = PKW(P0, 8), pw1[1] = PKW(P0, 10), pw1); \
    VRD(5); SBAR(); GAPA(C1 = __builtin_amdgcn_mfma_f32_32x32x16_bf16(kf[3], qr[1], C1, 0, 0, 0),   P0[14], P0[15], P1[0], P1[1],   pw1[2] = PKW(P0, 12), pw1[3] = PKW(P0, 14), pw1); \
    VRD(2); SBAR(); GAPA(C0 = __builtin_amdgcn_mfma_f32_32x32x16_bf16(kf[4], qr[2], C0, 0, 0, 0),   P1[2], P1[3], P1[4], P1[5],     pw2[0] = PKW(P1, 0), pw2[1] = PKW(P1, 2), pw2); \
    VRD(6); SBAR(); GAPA(C1 = __builtin_amdgcn_mfma_f32_32x32x16_bf16(kf[5], qr[2], C1, 0, 0, 0),   P1[6], P1[7], P1[8], P1[9],     pw2[2] = PKW(P1, 4), pw2[3] = PKW(P1, 6), pw2); \
    VRD(3); SBAR(); GAPA(C0 = __builtin_amdgcn_mfma_f32_32x32x16_bf16(kf[6], qr[3], C0, 0, 0, 0),   P1[10], P1[11], P1[12], P1[13], pw3[0] = PKW(P1, 8), pw3[1] = PKW(P1, 10), pw3); \
    VRD(7); SBAR(); GAPA(C1 = __builtin_amdgcn_mfma_f32_32x32x16_bf16(kf[7], qr[3], C1, 0, 0, 0),   P1[14], P1[15], 0.f, 0.f,       pw3[2] = PKW(P1, 12), pw3[3] = PKW(P1, 14), pw3); \
    l_reg += sacc; \
    if (GK) { DMA_K((t) + 3, sl_cur); } if (GV) { DMA_V((t) + 1, sl_next); } \
    CMASK(C0, C1, t); \
    { float a = MX3(C0[0], C0[1], C1[0]), b2 = MX3(C0[2], C0[3], C1[1]); a = MX3(a, C1[2], C1[3]); \
      _Pragma("unroll") for (int r = 4; r < 16; r += 4) { a = MX3(a, C0[r], C0[r + 1]); b2 = MX3(b2, C0[r + 2], C0[r + 3]); a = MX3(a, C1[r], C1[r + 1]); b2 = MX3(b2, C1[r + 2], C1[r + 3]); } \
      float rm = __builtin_fmaxf(a, b2); { auto rr = __builtin_amdgcn_permlane32_swap(__float_as_uint(rm), __float_as_uint(rm), false, false); rm = __builtin_fmaxf(__uint_as_float(rr[0]), __uint_as_float(rr[1])); } \
      resc = false; \
      if (__builtin_expect(__any(rm > (float)THRL), 0)) { const float dl = __builtin_fmaxf(rm, 0.f); mhat += dl; \
        _Pragma("unroll") for (int r = 0; r < 16; ++r) { C0[r] -= dl; C1[r] -= dl; } \
        _Pragma("unroll") for (int r = 0; r < 16; ++r) negm[r] = -mhat; asm volatile("" : "+v"(negm)); \
        const float f = __builtin_amdgcn_exp2f(-dl); l_reg *= f; if (hi == 0) wsf[r32] = f; resc = true; } } \
    SBAR(); \
    GAPB(o[0] = __builtin_amdgcn_mfma_f32_32x32x16_bf16(PAF(0), VFR(0), o[0], 0, 0, 0), C0, 0); \
    GAPB(o[1] = __builtin_amdgcn_mfma_f32_32x32x16_bf16(PAF(0), VFR(4), o[1], 0, 0, 0), C0, 4); \
    KRD(GL, 0); GAPB(o[0] = __builtin_amdgcn_mfma_f32_32x32x16_bf16(PAF(1), VFR(1), o[0], 0, 0, 0), C0, 8); \
    KRD(GL, 1); GAPB(o[1] = __builtin_amdgcn_mfma_f32_32x32x16_bf16(PAF(1), VFR(5), o[1], 0, 0, 0), C0, 12); \
    KRD(GL, 2); GAPB(o[0] = __builtin_amdgcn_mfma_f32_32x32x16_bf16(PAF(2), VFR(2), o[0], 0, 0, 0), C1, 0); \
    KRD(GL, 3); GAPB(o[1] = __builtin_amdgcn_mfma_f32_32x32x16_bf16(PAF(2), VFR(6), o[1], 0, 0, 0), C1, 4); \
    GAPB(o[0] = __builtin_amdgcn_mfma_f32_32x32x16_bf16(PAF(3), VFR(3), o[0], 0, 0, 0), C1, 8); \
    GAPB(o[1] = __builtin_amdgcn_mfma_f32_32x32x16_bf16(PAF(3), VFR(7), o[1], 0, 0, 0), C1, 12); \
    } while (0)
#define ENDW(tt) do { if ((tt) + 3 < NT) { WAIT_BAR(2); } else if ((tt) + 2 < NT) { WAIT_BAR(1); } else { WAIT_BAR(0); } } while (0)
    int t = 1;
    for (; t + 1 < NT; t += 2) {
        STEP(pB0, pB1, pA0, pA1, t, (t + 3 < NT), (t + 1 < NT), (t + 1 < NT));       ENDW(t);     RESC(); ROT();
        STEP(pA0, pA1, pB0, pB1, t + 1, (t + 4 < NT), (t + 2 < NT), (t + 2 < NT));   ENDW(t + 1); RESC(); ROT();
    }
    nbase = sl_next;
    if (has_next) {
        const long nr = (long)NTOK + nb * CTXL; const long nko = (long)lane * 256 + nkvh * 64 + wid * 8, nvo = (long)(16 * (wid & 3) + (lane >> 2)) * 256 + nkvh * 64 + (wid >> 2) * 32 + (lane & 3) * 8;
        const int n0 = sl_next, n1 = (n0 == (NSLOT - 1) * SLOTB) ? 0 : n0 + SLOTB, n2 = (n1 == (NSLOT - 1) * SLOTB) ? 0 : n1 + SLOTB;
        glds16(KB + nr * 256 + nko, (unsigned)__builtin_amdgcn_readfirstlane(kdst + n0)); glds16(VB + nr * 256 + nvo, (unsigned)__builtin_amdgcn_readfirstlane(vdst + n0));
        glds16(KB + (nr + 64) * 256 + nko, (unsigned)__builtin_amdgcn_readfirstlane(kdst + n1)); glds16(KB + (nr + 128) * 256 + nko, (unsigned)__builtin_amdgcn_readfirstlane(kdst + n2));
    }
    STEP(pB0, pB1, pA0, pA1, NT - 1, false, false, false); RESC();
    { float sacc = pB0[0] + pB0[1]; _Pragma("unroll") for (int r = 2; r < 16; ++r) sacc += pB0[r]; _Pragma("unroll") for (int r = 0; r < 16; ++r) sacc += pB1[r]; l_reg += sacc;
      pw0 = (u32x4){PKW(pB0, 0), PKW(pB0, 2), PKW(pB0, 4), PKW(pB0, 6)}; pw1 = (u32x4){PKW(pB0, 8), PKW(pB0, 10), PKW(pB0, 12), PKW(pB0, 14)}; pw2 = (u32x4){PKW(pB1, 0), PKW(pB1, 2), PKW(pB1, 4), PKW(pB1, 6)}; pw3 = (u32x4){PKW(pB1, 8), PKW(pB1, 10), PKW(pB1, 12), PKW(pB1, 14)};
      SBAR(); pv(o, vb0 + sl_cur, PAF(0), PAF(1), PAF(2), PAF(3)); }
    if (has_next) {
        asm volatile("" ::: "memory");
        const bf16_t* nQw = Y + ((long)nb * SEQ + nn * 128 + qsub * 32) * 2048 + 1024 + (nkvh * 4 + nhp * 2 + (wid >> 2)) * 64;
#pragma unroll
        for (int d0 = 0; d0 < 4; ++d0) qr[d0] = *(const bf16x8*)(nQw + (long)r32 * 2048 + d0 * 16 + hi * 8);
    }
    { auto rr = __builtin_amdgcn_permlane32_swap(__float_as_uint(l_reg), __float_as_uint(l_reg), false, false); l_reg = __uint_as_float(rr[0]) + __uint_as_float(rr[1]); }
    l_reg += __builtin_amdgcn_exp2f(fminf(sink[head] * LOG2E - mhat, 80.f));
    if (hi == 0) wsf[32 + r32] = l_reg; asm volatile("s_waitcnt lgkmcnt(0)" ::: "memory");
    float rli[16];
#pragma unroll
    for (int r = 0; r < 16; ++r) rli[r] = __builtin_amdgcn_rcpf(wsf[32 + crow(r, hi)]);
    bf16_t* Ow = O + qrow0 * ldo + head * 64;
    { LAS bf16_t* stg = (LAS bf16_t*)(shm + LDS_OST) + wid * 2048;
#pragma unroll
      for (int r = 0; r < 16; ++r) { const int orow = crow(r, hi);
#pragma unroll
          for (int d0 = 0; d0 < 2; ++d0) stg[orow * 64 + d0 * 32 + r32] = (bf16_t)(pk2(o[d0][r] * rli[r], 0.f) & 0xffffu); }
      asm volatile("s_waitcnt lgkmcnt(0)" ::: "memory");
#pragma unroll
      for (int i = 0; i < 4; ++i) { const int row = i * 8 + (lane >> 3), ch = lane & 7; const u32x4 v = *(const LAS u32x4*)(stg + row * 64 + ch * 8); *(u32x4*)(Ow + (long)row * ldo + ch * 8) = v; } }
    asm volatile("s_waitcnt lgkmcnt(0)\n\ts_barrier" ::: "memory");
#undef TROW
#undef DMA_K
#undef DMA_V
#undef CMASK
#undef START
#undef RESC
#undef ROT
#undef PKW
#undef PAF
#undef VFR
#undef PIN
#undef MX3
#undef GAPA
#undef GAPB
#undef EX
#undef VRD
#undef KRD
#undef STEP
#undef ENDW
}
#undef SBAR
#undef WAIT_BAR
}

#define XB_TMO      128
#define XB_XCNT(j)  (256  + 64 * (j))
#define XB_XSUB(j)  (1280 + 64 * (j))
#define XB_XGEN(j)  (2304 + 64 * (j))
#define XB_TOP      3328
#define XB_TOPGEN   3392
#define XCD_BAR_WORDS 3456
#define XB_SPIN_CAP (1u << 18)
__device__ __forceinline__ unsigned xb_ld(unsigned* p)              { return __hip_atomic_load(p, __ATOMIC_RELAXED, __HIP_MEMORY_SCOPE_AGENT); }
__device__ __forceinline__ unsigned xb_add(unsigned* p, unsigned v) { return __hip_atomic_fetch_add(p, v, __ATOMIC_RELAXED, __HIP_MEMORY_SCOPE_AGENT); }
__device__ __forceinline__ unsigned xb_xcc_id() { return (unsigned)__builtin_amdgcn_s_getreg((3 << 11) | 20) & 0xFu; }
#define XB_SPIN(cond, bar) do { unsigned _sp = 0; while (cond) { __builtin_amdgcn_s_sleep(1); \
    if ((++_sp & 255u) == 0u) { if (xb_ld(&(bar)[XB_TMO])) break; if (_sp > XB_SPIN_CAP) { atomicAdd(&(bar)[XB_TMO], 1u); break; } } } } while (0)
struct XcdBarrier { unsigned* bar; unsigned x; volatile LAS unsigned* st; };
__device__ __forceinline__ XcdBarrier xcd_barrier_post(unsigned* bar, volatile LAS unsigned* st) {
    XcdBarrier b; b.bar = bar; b.x = xb_xcc_id(); b.st = st;
    if (threadIdx.x == 0) (void)xb_add(&bar[XB_XCNT(b.x)], 1u);
    return b;
}
__device__ __forceinline__ void xcd_barrier_complete(unsigned* bar, unsigned x, unsigned& nloc, unsigned& nx) {
    const unsigned G = gridDim.x * gridDim.y * gridDim.z;
    unsigned sum, cnt, mine, sp = 0u;
    for (;;) {
        sum = 0u; cnt = 0u; mine = 0u;
#pragma unroll
        for (unsigned j = 0; j < 16; ++j) { const unsigned c = xb_ld(&bar[XB_XCNT(j)]); sum += c; cnt += (c > 0u) ? 1u : 0u; mine = (j == x) ? c : mine; }
        if (sum == G) break;
        __builtin_amdgcn_s_sleep(1);
        if ((++sp & 255u) == 0u) { if (xb_ld(&bar[XB_TMO])) break; if (sp > XB_SPIN_CAP) { atomicAdd(&bar[XB_TMO], 1u); break; } }
    }
    nloc = mine > 0u ? mine : 1u; nx = cnt > 0u ? cnt : 1u;
}
__device__ __forceinline__ void xcd_barrier(const XcdBarrier& b) {
    asm volatile("s_waitcnt vmcnt(0)" ::: "memory");
    __syncthreads();
    if (threadIdx.x == 0) {
        unsigned* bar = b.bar;
        __builtin_amdgcn_s_waitcnt(0);
        unsigned nloc = b.st[0], nx = b.st[1];
        if (nloc == 0u) { xcd_barrier_complete(bar, b.x, nloc, nx); b.st[0] = nloc; b.st[1] = nx; }
        const unsigned old = xb_add(&bar[XB_XSUB(b.x)], 1u);
        const unsigned gen = old / nloc;
        if (old + 1u == (gen + 1u) * nloc) {
            __builtin_amdgcn_fence(__ATOMIC_RELEASE, "agent");
            asm volatile("s_waitcnt vmcnt(0)" ::: "memory");
            const unsigned og = xb_add(&bar[XB_TOP], 1u);
            const unsigned tg = og / nx;
            if (og + 1u == (tg + 1u) * nx) xb_add(&bar[XB_TOPGEN], 1u);
            else XB_SPIN(xb_ld(&bar[XB_TOPGEN]) == tg, bar);
            __builtin_amdgcn_fence(__ATOMIC_ACQUIRE, "agent");
            xb_add(&bar[XB_XGEN(b.x)], 1u);
            asm volatile("s_waitcnt vmcnt(0)" ::: "memory");
        } else {
            XB_SPIN(xb_ld(&bar[XB_XGEN(b.x)]) == gen, bar);
            __builtin_amdgcn_fence(__ATOMIC_ACQUIRE, "agent");
            asm volatile("s_waitcnt vmcnt(0)" ::: "memory");
        }
    }
    __syncthreads();
}
constexpr int LDSCTL_OFF = LDS_BYTES - 256;
constexpr int CW_BAR = 4096;

#ifndef PROBE_GMLP2
#define PROBE_GMLP2 0
#endif
#ifndef ATT_PIPE
#define ATT_PIPE 1
#endif
#ifndef ATT_THRL
#define ATT_THRL 8
#endif
#ifndef ONE_LAUNCH
#define ONE_LAUNCH 1
#endif
#ifndef FAST_MIX
#define FAST_MIX 1
#endif
#ifndef PROBE_SEQ
#define PROBE_SEQ 0, 1, 2, 3, 4, 5, 6, 7, 8, 9, 10, 11
#endif

enum { PH_PRO = 0, PH_HN, PH_IN, PH_MIX, PH_A, PH_O, PH_H2R, PH_WCONV, PH_TOPK, PH_GU, PH_D, PH_FIN, PH_COUNT };

__global__ void __launch_bounds__(NTHREADS, 2) fwd(Args args) {
    extern __shared__ __attribute__((aligned(16))) unsigned char lds_raw[];
    LAS unsigned char* lds = (LAS unsigned char*)lds_raw;
    const int tid = threadIdx.x, lane = tid & 63, wave = __builtin_amdgcn_readfirstlane(tid >> 6);
    const int G = gridDim.x, bid = blockIdx.x;
    unsigned char* ws = args.ws;
    const int lo = args.ph_lo, hi = args.ph_hi;
#define IN(k) (lo <= (k) && (k) < hi)
    float* MOD = (float*)(ws + WS_MOD); f32x2* ROPE = (f32x2*)(ws + WS_ROPE);
    float* AFFT = (float*)(ws + WS_AFFT); int* TOPI = (int*)(ws + WS_TOPI); float* TOPW = (float*)(ws + WS_TOPW); int* SLOT = (int*)(ws + WS_SLOT);
    bf16_t* WSP = (bf16_t*)(ws + WS_WSP); bf16_t* WIN = (bf16_t*)(ws + WS_WIN); bf16_t* WAB = (bf16_t*)(ws + WS_WAB); bf16_t* WO = (bf16_t*)(ws + WS_WO);
    bf16_t* H = (bf16_t*)(ws + WS_H); bf16_t* VA = (bf16_t*)(ws + WS_VA); bf16_t* KB = (bf16_t*)(ws + WS_KB); bf16_t* VB = (bf16_t*)(ws + WS_VB);
    bf16_t* GT = (bf16_t*)(ws + WS_G); bf16_t* Y = (bf16_t*)(ws + WS_Y); bf16_t* TMP = (bf16_t*)(ws + WS_TMP); bf16_t* MERGED = (bf16_t*)(ws + WS_MERGED);
    bf16_t* WGU = (bf16_t*)(ws + WS_WGU); bf16_t* WD = (bf16_t*)(ws + WS_WD); bf16_t* H2 = (bf16_t*)(ws + WS_H2); bf16_t* ACT = (bf16_t*)(ws + WS_ACT); bf16_t* YB = (bf16_t*)(ws + WS_YB);
    const int gw = bid * NWAVES + wave, NGW = G * NWAVES;
    if (tid < 64) ((LAS unsigned*)(lds + LDSCTL_OFF))[tid] = 0u;
    __syncthreads();
    XcdBarrier bar; bar.bar = (unsigned*)(ws + WS_CTL) + CW_BAR; bar.x = 0; bar.st = nullptr;
    if (ONE_LAUNCH) bar = xcd_barrier_post((unsigned*)(ws + WS_CTL) + CW_BAR, (volatile LAS unsigned*)(lds + LDSCTL_OFF));
#define SEAM(k) do { if (ONE_LAUNCH && IN(k) && IN((k) + 1)) xcd_barrier(bar); } while (0)

    if (IN(PH_PRO)) {
        if (bid < 192) adaln_task(bid, args.in[I_C], args.in[I_CCTX], args.in[I_WADA], args.in[I_BADA], MOD, (LAS float*)lds, tid);
        else if (bid == 192) rope_table(ROPE, tid);
        __syncthreads();
        for (int i = bid * NTHREADS + tid; i < 8 * 128 * 128 / 4; i += G * NTHREADS) st4bf(WSP + 4 * i, *(const f32x4*)(args.in[I_WSP] + 4 * i));
        LAS float* scr = (LAS float*)(lds + wave * 16384);
        constexpr int I_IN = 16 * 176, I_P = 16 * 32;
        for (int it = gw; it < I_IN + 3 * I_P; it += NGW) {
            int r = it;
            if (r < I_IN) { const int kb = r / 176, nb = r % 176; transpose_item(args.in[I_WIN], INCOLS, kb * 64, nb * 32, WIN + (size_t)(nb * 32) * 1024 + kb * 64, 1024, scr, lane); continue; } r -= I_IN;
            if (r < I_P) { const int kb = r / 32, nb = r % 32; transpose_item(args.in[I_WPA], 1024, kb * 64, nb * 32, WAB + (size_t)(nb * 32) * 2048 + kb * 64, 2048, scr, lane); continue; } r -= I_P;
            if (r < I_P) { const int kb = r / 32, nb = r % 32; transpose_item(args.in[I_WPB], 1024, kb * 64, nb * 32, WAB + (size_t)(nb * 32) * 2048 + 1024 + kb * 64, 2048, scr, lane); continue; } r -= I_P;
            { const int kb = r / 32, nb = r % 32; transpose_item(args.in[I_WOUT], 1024, kb * 64, nb * 32, WO + (size_t)(nb * 32) * 1024 + kb * 64, 1024, scr, lane); }
        }
    }
    SEAM(PH_PRO);
    if (IN(PH_HN)) {
        const float* g1n = args.in[I_N1G];
        auto hn_row = [&](int row) {
            const float* xr; int mrow;
            if (row < NTOK) { xr = args.in[I_X] + (size_t)row * 1024; mrow = row >> 12; } else { xr = args.in[I_CTX] + (size_t)(row - NTOK) * 1024; mrow = 8; }
            const float* sh = MOD + mrow * 6144; const float* sc = sh + 1024;
            f32x4 v[4]; float ss = 0.f;
#pragma unroll
            for (int j = 0; j < 4; ++j) { v[j] = *(const f32x4*)(xr + 4 * lane + 256 * j); ss += (v[j].x * v[j].x + v[j].y * v[j].y) + (v[j].z * v[j].z + v[j].w * v[j].w); }
            const float rstd = 1.0f / sqrtf(wave_sum(ss) * (1.f / 1024.f) + EPS);
#pragma unroll
            for (int j = 0; j < 4; ++j) {
                const int col = 4 * lane + 256 * j;
                const f32x4 gv = *(const f32x4*)(g1n + col), scv = *(const f32x4*)(sc + col), shv = *(const f32x4*)(sh + col);
                const f32x4 h = (v[j] * rstd * gv) * (1.f + scv) + shv;
                st4bf(H + (size_t)row * 1024 + col, h);
            }
        };
        for (int row = gw; row < NROWS_H; row += NGW) hn_row(row);
    }
    SEAM(PH_HN);
    if (IN(PH_IN)) {
        Gemm g{H, WIN, 1024, 1024, 1024, 0, 30, nullptr}; StaticOrder S; S.init(NTOK, INCOLS, G, bid, 16);
        EpiIn E{Y, VA, KB, VB, GT, args.in[I_BMG], ROPE, (f32x2*)(ws + WS_STATS)};
        GEMM_PHASE<EpiIn, StaticOrder, false>(lds, g, S, E);
    }
    SEAM(PH_IN);
    if (IN(PH_MIX) && FAST_MIX) {
        if (!(args.flags & 8)) for (int task = bid; task < NB * 32; task += G) mix::gmlp_unit(task, Y, (args.flags & 2) ? TMP : Y, (args.flags & 2) ? 1024 : 2048, VA, WSP, (const f32x2*)(ws + WS_STATS), args.in[I_LNG], args.in[I_LNB], args.in[I_BSP], lds);
#if ATT_PIPE
        att2::bf16x8 att_qr[4]; int att_base = 0; bool att_primed = false;
#endif
        if (!(args.flags & 1)) for (int task = bid; task < NB * 32 * 4; task += G) {
#if ATT_PIPE
            for (int hp = 0; hp < 2; ++hp) {
                const bool more = (hp == 0) || (task + G < NB * 32 * 4); const int ntask = hp == 0 ? task : task + G; int nbase_ = 0;
                att2::attn_unit<ATT_THRL>(task >> 7, (task >> 2) & 31, task & 3, hp, att_base, att_primed, more, ntask >> 7, (ntask >> 2) & 31, ntask & 3, hp ^ 1, att_qr, nbase_,
                                          Y, (args.flags & 4) ? TMP : Y + 1024, (args.flags & 4) ? 1024 : 2048, KB, VB, args.in[I_SINK], lds);
                att_base = nbase_; att_primed = more;
            }
#else
            mix::attn_unit(task >> 7, (task >> 2) & 31, task & 3, Y, (args.flags & 4) ? TMP : Y + 1024, (args.flags & 4) ? 1024 : 2048, KB, VB, args.in[I_SINK], lds);
#endif
        }
    }
    SEAM(PH_MIX);
    if (IN(PH_A)) {
        Gemm g{Y, WAB, 2048, 2048, 2048, 0, 30, nullptr}; StaticOrder S; S.init(NTOK, 1024, G, bid, 0, 1);
        EpiAB E{MERGED, GT};
        GEMM_PHASE<EpiAB, StaticOrder, false, true>(lds, g, S, E);
    }
    SEAM(PH_A);
    if (IN(PH_O)) {
        Gemm g{MERGED, WO, 1024, 1024, 1024, 0, 30, nullptr}; StaticOrder S; S.init(NTOK, 1024, G, bid);
        EpiO E{args.out, args.in[I_X], MOD};
        GEMM_PHASE<EpiO, StaticOrder, false>(lds, g, S, E);
    }
    SEAM(PH_O);
    if (IN(PH_H2R)) {
        LAS float* wT = (LAS float*)lds;
        { f32x4 wv[8];
#pragma unroll
          for (int k = 0; k < 8; ++k) wv[k] = *(const f32x4*)(args.in[I_WR] + 4 * (tid + NTHREADS * k));
#pragma unroll
          for (int k = 0; k < 8; ++k) { const int f = tid + NTHREADS * k, col = f >> 2, e0 = 4 * (f & 3); wT[e0 * 1024 + col] = wv[k].x; wT[(e0 + 1) * 1024 + col] = wv[k].y; wT[(e0 + 2) * 1024 + col] = wv[k].z; wT[(e0 + 3) * 1024 + col] = wv[k].w; } }
        __syncthreads();
        const float* g2n = args.in[I_N2G];
        const bool h32 = lane & 32, h16 = lane & 16, h8 = lane & 8, h4 = lane & 4;
        const int myexp = 8 * (lane >> 5) + 4 * ((lane >> 4) & 1) + 2 * ((lane >> 3) & 1) + ((lane >> 2) & 1);
        f32x4 vn[2][4];
#pragma unroll
        for (int q = 0; q < 2; ++q)
#pragma unroll
            for (int j = 0; j < 4; ++j) vn[q][j] = *(const f32x4*)(args.out + (size_t)(2 * (NTOK / 2 - 1 - (gw < NTOK / 2 ? gw : 0)) + q) * 1024 + 4 * lane + 256 * j);
        for (int rp = gw; rp < NTOK / 2; rp += NGW) {
            const int row0 = 2 * (NTOK / 2 - 1 - rp), b = row0 >> 12;
            const float* sh = MOD + b * 6144 + 3072; const float* sc = sh + 1024;
            f32x4 v[2][4]; float ss[2] = {0.f, 0.f};
#pragma unroll
            for (int q = 0; q < 2; ++q)
#pragma unroll
                for (int j = 0; j < 4; ++j) { v[q][j] = vn[q][j]; ss[q] += (v[q][j].x * v[q][j].x + v[q][j].y * v[q][j].y) + (v[q][j].z * v[q][j].z + v[q][j].w * v[q][j].w); }
            { const int rn = (rp + NGW < NTOK / 2) ? rp + NGW : rp;
#pragma unroll
              for (int q = 0; q < 2; ++q)
#pragma unroll
                  for (int j = 0; j < 4; ++j) vn[q][j] = *(const f32x4*)(args.out + (size_t)(2 * (NTOK / 2 - 1 - rn) + q) * 1024 + 4 * lane + 256 * j); }
            float rstd[2];
#pragma unroll
            for (int q = 0; q < 2; ++q) rstd[q] = 1.0f / sqrtf(wave_sum(ss[q]) * (1.f / 1024.f) + EPS);
            float lg[2][16];
#pragma unroll
            for (int q = 0; q < 2; ++q)
#pragma unroll
                for (int e = 0; e < 16; ++e) lg[q][e] = 0.f;
            f32x4 wb[2][4];
#pragma unroll
            for (int e = 0; e < 4; ++e) wb[0][e] = *(const LAS f32x4*)(wT + e * 1024 + 4 * lane);
            f32x4 h[2];
#pragma unroll
            for (int g = 0; g < 16; ++g) {
                const int j = g >> 2, eg = g & 3, col = 4 * lane + 256 * j;
                if (g + 1 < 16) {
                    const int jn = (g + 1) >> 2, en = (g + 1) & 3;
#pragma unroll
                    for (int e = 0; e < 4; ++e) wb[(g + 1) & 1][e] = *(const LAS f32x4*)(wT + (4 * en + e) * 1024 + 4 * lane + 256 * jn);
                }
                if (eg == 0) {
                    const f32x4 gv = *(const f32x4*)(g2n + col), scv = *(const f32x4*)(sc + col), shv = *(const f32x4*)(sh + col);
#pragma unroll
                    for (int q = 0; q < 2; ++q) { h[q] = (v[q][j] * rstd[q] * gv) * (1.f + scv) + shv; st4bf(H2 + (size_t)(row0 + q) * 1024 + col, h[q]); }
                }
#pragma unroll
                for (int e = 0; e < 4; ++e) {
                    const f32x4 w = wb[g & 1][e];
#pragma unroll
                    for (int q = 0; q < 2; ++q) lg[q][4 * eg + e] += (h[q].x * w.x + h[q].y * w.y) + (h[q].z * w.z + h[q].w * w.w);
                    asm volatile("" : "+v"(lg[0][4 * eg + e]), "+v"(lg[1][4 * eg + e]));
                }
                asm volatile("" ::: "memory");
            }
#pragma unroll
            for (int q = 0; q < 2; ++q) {
                float a8[8], a4[4], a2[2], a1;
#pragma unroll
                for (int i = 0; i < 8; ++i) { const float send = h32 ? lg[q][i] : lg[q][i + 8], keep = h32 ? lg[q][i + 8] : lg[q][i]; a8[i] = keep + __shfl_xor(send, 32); }
#pragma unroll
                for (int i = 0; i < 4; ++i) { const float send = h16 ? a8[i] : a8[i + 4], keep = h16 ? a8[i + 4] : a8[i]; a4[i] = keep + __shfl_xor(send, 16); }
#pragma unroll
                for (int i = 0; i < 2; ++i) { const float send = h8 ? a4[i] : a4[i + 2], keep = h8 ? a4[i + 2] : a4[i]; a2[i] = keep + __shfl_xor(send, 8); }
                { const float send = h4 ? a2[0] : a2[1], keep = h4 ? a2[1] : a2[0]; a1 = keep + __shfl_xor(send, 4); }
                a1 += __shfl_xor(a1, 2); a1 += __shfl_xor(a1, 1);
                float mx = a1;
#pragma unroll
                for (int o = 4; o < 64; o <<= 1) mx = fmaxf(mx, __shfl_xor(mx, o));
                const float p = __expf(a1 - mx); float den = p;
#pragma unroll
                for (int o = 4; o < 64; o <<= 1) den += __shfl_xor(den, o);
                if ((lane & 3) == 0) AFFT[(size_t)(b * 16 + myexp) * SEQ + ((row0 + q) & (SEQ - 1))] = p / den;
            }
        }
    }
    if (IN(PH_WCONV)) {
        __syncthreads();
        LAS float* scr = (LAS float*)(lds + wave * 16384);
        constexpr int I_G = 16 * 16 * 64, I_D = 16 * 32 * 32;
        auto item = [&](int it) -> TrItem {
            int r = it; TrItem t;
            if (r < 2 * I_G) {
                const int up = r >= I_G; if (up) r -= I_G;
                const int e = r >> 10, kb = (r >> 6) & 15, nb = r & 63, n0 = nb * 32;
                const int drow = 256 * (n0 >> 7) + (n0 & 127) + (up ? 128 : 0);
                t.src = args.in[up ? I_WEU : I_WEG] + (size_t)e * 1024 * 2048 + (size_t)(kb * 64) * 2048 + n0; t.N = 2048;
                t.dst = WGU + (size_t)e * 4096 * 1024 + (size_t)drow * 1024 + kb * 64; t.ldt = 1024;
            } else {
                r -= 2 * I_G;
                const int e = r >> 10, kb = (r >> 5) & 31, nb = r & 31;
                t.src = args.in[I_WED] + (size_t)e * 2048 * 1024 + (size_t)(kb * 64) * 1024 + nb * 32; t.N = 1024;
                t.dst = WD + (size_t)e * 1024 * 2048 + (size_t)(nb * 32) * 2048 + kb * 64; t.ldt = 2048;
            }
            return t;
        };
        constexpr int NIT = 2 * I_G + I_D;
        if (gw < NIT) {
            TrItem cur = item(gw); f32x4 vc[8], vn[8];
            tr_load(cur, vc, lane);
            for (int it = gw; it < NIT; it += NGW) {
                const bool more = it + NGW < NIT;
                TrItem nxt = cur;
                if (more) { nxt = item(it + NGW); tr_load(nxt, vn, lane); }
                tr_store(cur, vc, scr, lane);
                cur = nxt;
#pragma unroll
                for (int i = 0; i < 8; ++i) vc[i] = vn[i];
            }
        }
    }
    SEAM(PH_WCONV);
    if (IN(PH_TOPK)) {
        LAS int* wsum = (LAS int*)lds;
        for (int task = bid; task < NE * NB; task += G) {
            const int e = task >> 3, b = task & 7;
            const float* aff = AFFT + (size_t)(b * 16 + e) * SEQ;
            unsigned k[8];
            { const u32x4 a0 = *(const u32x4*)(aff + 8 * tid), a1 = *(const u32x4*)(aff + 8 * tid + 4); k[0] = a0.x; k[1] = a0.y; k[2] = a0.z; k[3] = a0.w; k[4] = a1.x; k[5] = a1.y; k[6] = a1.z; k[7] = a1.w; }
            unsigned T = 0u; int it = 0;
            __syncthreads();
            for (int bit = 30; bit >= 0; --bit, ++it) {
                const unsigned cand = T | (1u << bit); int c = 0;
#pragma unroll
                for (int j = 0; j < 8; ++j) c += __builtin_popcountll(__ballot(k[j] >= cand));
                if (lane == 0) wsum[(it & 1) * 8 + wave] = c;
                __syncthreads();
                int tot = 0;
#pragma unroll
                for (int w = 0; w < 8; ++w) tot += wsum[(it & 1) * 8 + w];
                if (tot >= CAP) T = cand;
            }
            int cg = 0, ce = 0;
#pragma unroll
            for (int j = 0; j < 8; ++j) { cg += (k[j] > T) ? 1 : 0; ce += (k[j] == T) ? 1 : 0; }
            LAS int* sc1 = wsum + 16; LAS int* sc2 = wsum + 32;
            int ie = ce, ig = cg;
#pragma unroll
            for (int o = 1; o < 64; o <<= 1) { const int te = __shfl_up(ie, o), tg = __shfl_up(ig, o); if (lane >= o) { ie += te; ig += tg; } }
            __syncthreads();
            if (lane == 63) { sc1[wave] = ie; sc2[wave] = ig; }
            __syncthreads();
            int ebase = ie - ce, totg = 0;
#pragma unroll
            for (int w = 0; w < 8; ++w) { if (w < wave) ebase += sc1[w]; totg += sc2[w]; }
            const int need = CAP - totg;
            int sel[8], cs = 0, er = ebase;
#pragma unroll
            for (int j = 0; j < 8; ++j) { const bool eq = (k[j] == T); sel[j] = (k[j] > T) || (eq && er < need); er += eq ? 1 : 0; cs += sel[j]; }
            int is = cs;
#pragma unroll
            for (int o = 1; o < 64; o <<= 1) { const int ts = __shfl_up(is, o); if (lane >= o) is += ts; }
            __syncthreads();
            if (lane == 63) sc1[wave] = is;
            __syncthreads();
            int sbase = is - cs;
#pragma unroll
            for (int w = 0; w < 8; ++w) if (w < wave) sbase += sc1[w];
#pragma unroll
            for (int j = 0; j < 8; ++j) {
                const int t = 8 * tid + j; int slot = -1;
                if (sel[j]) { slot = sbase; ++sbase; const int prow = (e * 8 + b) * CAP + slot; TOPI[prow] = t; TOPW[prow] = __uint_as_float(k[j]); }
                SLOT[((size_t)b * SEQ + t) * 16 + e] = slot;
            }
            __syncthreads();
        }
    }
    SEAM(PH_TOPK);
    if (IN(PH_GU)) {
        Gemm g{H2, WGU, 1024, 1024, 1024, (size_t)4096 * 1024, 4, TOPI}; StaticOrder S; S.init(NPAIR, 4096, G, bid);
        EpiGU E{ACT};
        GEMM_PHASE<EpiGU, StaticOrder, true>(lds, g, S, E);
    }
    SEAM(PH_GU);
    if (IN(PH_D)) {
        Gemm g{ACT, WD, 2048, 2048, 2048, (size_t)1024 * 2048, 4, nullptr}; StaticOrder S; S.init(NPAIR, 1024, G, bid, 0, 1);
        EpiD E{YB, TOPW};
        GEMM_PHASE<EpiD, StaticOrder, false>(lds, g, S, E);
    }
    SEAM(PH_D);
    if (IN(PH_FIN)) {
        const float* fg = args.in[I_FING];
        const bf16_t* ZROW = (const bf16_t*)(ws + WS_CTL + 512 * 1024);
        int sln[2] = {-1, -1};
        if (gw < NTOK / 2 && lane < 16) { sln[0] = SLOT[(size_t)(2 * gw) * 16 + lane]; sln[1] = SLOT[(size_t)(2 * gw + 1) * 16 + lane]; }
        for (int rp = gw; rp < NTOK / 2; rp += NGW) {
            const int row0 = 2 * rp, b = row0 >> 12;
            const int sl[2] = {sln[0], sln[1]};
            { const int rn = rp + NGW; if (rn < NTOK / 2 && lane < 16) { sln[0] = SLOT[(size_t)(2 * rn) * 16 + lane]; sln[1] = SLOT[(size_t)(2 * rn + 1) * 16 + lane]; } }
            const float* g2 = MOD + b * 6144 + 5120;
            f32x4 xv[2][4], acc[2][4];
#pragma unroll
            for (int q = 0; q < 2; ++q)
#pragma unroll
                for (int h = 0; h < 2; ++h) { const float* xp = args.out + (size_t)(row0 + q) * 1024 + 512 * h + 8 * lane; xv[q][2 * h] = *(const f32x4*)xp; xv[q][2 * h + 1] = *(const f32x4*)(xp + 4);
                    acc[q][2 * h] = (f32x4){0.f, 0.f, 0.f, 0.f}; acc[q][2 * h + 1] = (f32x4){0.f, 0.f, 0.f, 0.f}; }
#pragma unroll
            for (int q = 0; q < 2; ++q) {
                unsigned long long mask = __ballot(sl[q] >= 0);
                for (;;) {
                    const bf16_t* yr[4];
#pragma unroll
                    for (int k = 0; k < 4; ++k) {
                        if (mask) { const int ex = __builtin_ctzll(mask); mask &= mask - 1; const int s = __builtin_amdgcn_readlane(sl[q], ex); yr[k] = YB + (size_t)((ex * 8 + b) * CAP + s) * 1024; }
                        else yr[k] = ZROW;
                    }
                    u32x4 y[4][2];
#pragma unroll
                    for (int k = 0; k < 4; ++k)
#pragma unroll
                        for (int h = 0; h < 2; ++h) y[k][h] = *(const u32x4*)(yr[k] + 512 * h + 8 * lane);
#pragma unroll
                    for (int k = 0; k < 4; ++k)
#pragma unroll
                        for (int h = 0; h < 2; ++h) { const u32x4 w = y[k][h];
                            acc[q][2 * h] += (f32x4){bf2f(w.x & 0xffffu), bf2f(w.x >> 16), bf2f(w.y & 0xffffu), bf2f(w.y >> 16)};
                            acc[q][2 * h + 1] += (f32x4){bf2f(w.z & 0xffffu), bf2f(w.z >> 16), bf2f(w.w & 0xffffu), bf2f(w.w >> 16)}; }
                    if (!mask) break;
                }
            }
#pragma unroll
            for (int q = 0; q < 2; ++q) {
                float ss = 0.f;
#pragma unroll
                for (int h = 0; h < 2; ++h)
#pragma unroll
                    for (int u4 = 0; u4 < 2; ++u4) { const int col = 512 * h + 8 * lane + 4 * u4; f32x4& v = xv[q][2 * h + u4]; v = v + *(const f32x4*)(g2 + col) * acc[q][2 * h + u4]; ss += (v.x * v.x + v.y * v.y) + (v.z * v.z + v.w * v.w); }
                const float rstd = 1.0f / sqrtf(wave_sum(ss) * (1.f / 1024.f) + EPS);
#pragma unroll
                for (int h = 0; h < 2; ++h)
#pragma unroll
                    for (int u4 = 0; u4 < 2; ++u4) { const int col = 512 * h + 8 * lane + 4 * u4; *(f32x4*)(args.out + (size_t)(row0 + q) * 1024 + col) = xv[q][2 * h + u4] * rstd * *(const f32x4*)(fg + col); }
            }
        }
    }
#undef IN
}

extern "C" void kernel_launch(void* const* d_in, const int* in_sizes, int n_in, void* d_out, int out_size, void* d_ws, size_t ws_size, hipStream_t stream) {
    static int grid = 0;
    if (grid == 0) {
        if (n_in != 23 || in_sizes[0] != NTOK * DM || out_size != NTOK * DM || ws_size < WS_END) {
            fprintf(stderr, "kernel_launch: unexpected problem (n_in %d, in0 %d, out %d, ws %zu < %zu?)\n", n_in, n_in > 0 ? in_sizes[0] : -1, out_size, ws_size, (size_t)WS_END); grid = -1; return; }
        if (hipFuncSetAttribute((const void*)fwd, hipFuncAttributeMaxDynamicSharedMemorySize, LDS_BYTES) != hipSuccess) { fprintf(stderr, "kernel_launch: hipFuncSetAttribute failed\n"); grid = -1; return; }
        int dev = 0, cus = 0;
        if (hipGetDevice(&dev) != hipSuccess || hipDeviceGetAttribute(&cus, hipDeviceAttributeMultiprocessorCount, dev) != hipSuccess) { grid = -1; return; }
        grid = cus;
    }
    if (grid < 0) return;
    (void)hipMemsetAsync((char*)d_ws + WS_CTL, 0, 1 * MiB, stream);
    Args a{};
    for (int i = 0; i < 23; ++i) a.in[i] = (const float*)d_in[i];
    a.out = (float*)d_out; a.ws = (unsigned char*)d_ws;
    if (ONE_LAUNCH) {
        a.ph_lo = 0; a.ph_hi = PH_COUNT;
        hipLaunchKernelGGL(fwd, dim3(grid), dim3(NTHREADS), LDS_BYTES, stream, a);
    } else {
        static const int seq[] = {PROBE_SEQ};
        for (unsigned i = 0; i < sizeof(seq) / sizeof(seq[0]); ++i) {
            a.ph_lo = seq[i] % 100; a.ph_hi = seq[i] % 100 + 1; a.flags = seq[i] / 100;
            hipLaunchKernelGGL(fwd, dim3(grid), dim3(NTHREADS), LDS_BYTES, stream, a);
        }
    }
}
```

```cpp
#include <hip/hip_runtime.h>
#include <cstdio>
#include <cstdint>

#define LAS __attribute__((address_space(3)))
typedef unsigned short bf16_t;
typedef float f32x4 __attribute__((ext_vector_type(4)));
typedef float f32x2 __attribute__((ext_vector_type(2)));
typedef unsigned u32x4 __attribute__((ext_vector_type(4)));
typedef unsigned u32x2 __attribute__((ext_vector_type(2)));
typedef int i32x4 __attribute__((ext_vector_type(4)));

constexpr int DM = 1024, NB = 8, SEQ = 4096, NTOK = NB * SEQ, CTXL = 256, NCTX = NB * CTXL, NROWS_H = NTOK + NCTX;
constexpr int INCOLS = 5632, OFF_Q = 2048, OFF_K = 3072, OFF_VB = 3328, OFF_GATE = 3584;
constexpr int NE = 16, CAP = 512, DE = 2048, NPAIR = NE * NB * CAP;
constexpr float EPS = 1e-6f, LOG2E = 1.4426950408889634f, C2 = 0.125f * LOG2E;
constexpr int NTHREADS = 512, NWAVES = 8;

constexpr size_t MiB = 1u << 20;
constexpr size_t WS_CTL = 0;
constexpr size_t WS_MOD = 1 * MiB;
constexpr size_t WS_ROPE = 1 * MiB + 512 * 1024;
constexpr size_t WS_AFFT = 2 * MiB;
constexpr size_t WS_TOPI = 4 * MiB;
constexpr size_t WS_TOPW = 4 * MiB + 512 * 1024;
constexpr size_t WS_SLOT = 5 * MiB;
constexpr size_t WS_WSP = 7 * MiB;
constexpr size_t WS_WIN = 8 * MiB;
constexpr size_t WS_WAB = 19 * MiB;
constexpr size_t WS_WO = 23 * MiB;
constexpr size_t WS_R = 25 * MiB;
constexpr size_t WS_H = WS_R;
constexpr size_t WS_VA = WS_R + 68 * MiB;
constexpr size_t WS_KB = WS_VA + 64 * MiB;
constexpr size_t WS_VB = WS_KB + 17 * MiB;
constexpr size_t WS_G = WS_VB + 17 * MiB;
constexpr size_t WS_Y = WS_G + 128 * MiB;
constexpr size_t WS_TMP = WS_Y + 128 * MiB;
constexpr size_t WS_STATS = WS_TMP + 64 * MiB;
constexpr size_t WS_MERGED = WS_H;
constexpr size_t WS_WGU = WS_R;
constexpr size_t WS_WD = WS_R + 128 * MiB;
constexpr size_t WS_H2 = WS_R + 192 * MiB;
constexpr size_t WS_ACT = WS_R + 256 * MiB;
constexpr size_t WS_YB = WS_WGU;
constexpr size_t WS_END = 537 * MiB;
static_assert(WS_STATS + 4 * MiB <= WS_END && WS_ACT + 256 * MiB == WS_END, "ws map");

constexpr int LDS_BYTES = 147456;

__device__ __forceinline__ float bf2f(unsigned b) { return __uint_as_float(b << 16); }
__device__ __forceinline__ unsigned f2bf(float f) { unsigned u = __float_as_uint(f); return (u + 0x7fffu + ((u >> 16) & 1u)) >> 16; }
__device__ __forceinline__ unsigned pk2(float lo, float hi) { typedef float f2_ __attribute__((ext_vector_type(2))); typedef __bf16 b2_ __attribute__((ext_vector_type(2))); f2_ v = {lo, hi}; b2_ b = __builtin_convertvector(v, b2_); return __builtin_bit_cast(unsigned, b); }
__device__ __forceinline__ void st4bf(bf16_t* p, f32x4 v) { u32x2 w; w.x = pk2(v.x, v.y); w.y = pk2(v.z, v.w); *(u32x2*)p = w; }
__device__ __forceinline__ void st8bf(bf16_t* p, f32x4 a, f32x4 b) { u32x4 w; w.x = pk2(a.x, a.y); w.y = pk2(a.z, a.w); w.z = pk2(b.x, b.y); w.w = pk2(b.z, b.w); *(u32x4*)p = w; }
__device__ __forceinline__ void ld8bf(const bf16_t* p, f32x4& a, f32x4& b) { const u32x4 w = *(const u32x4*)p; a.x = bf2f(w.x & 0xffffu); a.y = bf2f(w.x >> 16); a.z = bf2f(w.y & 0xffffu); a.w = bf2f(w.y >> 16); b.x = bf2f(w.z & 0xffffu); b.y = bf2f(w.z >> 16); b.z = bf2f(w.w & 0xffffu); b.w = bf2f(w.w >> 16); }
__device__ __forceinline__ f32x4 ld4bf(const bf16_t* p) { const u32x2 w = *(const u32x2*)p; f32x4 v; v.x = bf2f(w.x & 0xffffu); v.y = bf2f(w.x >> 16); v.z = bf2f(w.y & 0xffffu); v.w = bf2f(w.y >> 16); return v; }
__device__ __forceinline__ float sigmoidf_(float x) { return __builtin_amdgcn_rcpf(1.f + __expf(-x)); }
__device__ __forceinline__ float siluf_(float x) { return x * __builtin_amdgcn_rcpf(1.f + __expf(-x)); }
__device__ __forceinline__ float gelu_t(float x) { const float z2 = 1.5957691216057308f * (x + 0.044715f * x * x * x); return x * __builtin_amdgcn_rcpf(1.f + __expf(-z2)); }
__device__ __forceinline__ float wave_sum(float v) {
#pragma unroll
    for (int o = 1; o < 64; o <<= 1) v += __shfl_xor(v, o);
    return v;
}
__device__ __forceinline__ int wave_sum_i(int v) {
#pragma unroll
    for (int o = 1; o < 64; o <<= 1) v += __shfl_xor(v, o);
    return v;
}
#define LDS_WAIT() asm volatile("s_waitcnt lgkmcnt(0)" ::: "memory")

struct Args { const float* in[23]; float* out; unsigned char* ws; int ph_lo, ph_hi, flags, pad; };
enum { I_X = 0, I_C, I_CTX, I_CCTX, I_WADA, I_BADA, I_N1G, I_WIN, I_BMG, I_LNG, I_LNB, I_WSP, I_BSP, I_SINK, I_WPA, I_WPB, I_WOUT, I_N2G, I_WR, I_WEG, I_WEU, I_WED, I_FING };

struct Unit { int pm, pn; };
struct Gemm {
    const bf16_t* A; const bf16_t* Bt; int lda, ldb, K;
    size_t bgs; int tpg_shift;
    const int* gidx;
};
constexpr int NXCD = 8, WGM = 8;
struct StaticOrder {
    int nM, nN, nwg, G, c, extra, rev;
    __device__ void init(int M, int N, int G_, int c_, int extra_ = 0, int rev_ = 0) { nM = M / 256; nN = N / 256; nwg = nM * nN; G = G_; c = c_; extra = extra_; rev = rev_; }
    __device__ bool next(int i, Unit& u) const {
        const long L = (long)i * G + c;
        if (L >= nwg) { const int x = (int)(L - nwg); if (x >= extra) return false; u.pm = NTOK / 256 + (x >> 1); u.pn = 12 + (x & 1); return true; }
        int wgid = (int)L; { const int q = nwg / NXCD, r = nwg % NXCD, xcd = wgid % NXCD, off = wgid / NXCD; wgid = (xcd < r ? xcd * (q + 1) : r * (q + 1) + (xcd - r) * q) + off; }
        const int nig = WGM * nN, gid = wgid / nig, fm = gid * WGM, gsz = (nM - fm) < WGM ? (nM - fm) : WGM;
        u.pm = fm + ((wgid % nig) % gsz); u.pn = (wgid % nig) / gsz; if (rev) u.pm = nM - 1 - u.pm; return true;
    }
};

struct OneUnit { int pm, pn; __device__ bool next(int i, Unit& u) const { if (i) return false; u.pm = pm; u.pn = pn; return true; } };

typedef f32x4 Acc[2][2][4][2];

namespace pg8 {
typedef short bf16x8 __attribute__((ext_vector_type(8)));
constexpr int BK = 64, HALF = 128, HTB = HALF * BK * 2, STAGE_BYTES = 8 * HTB;
__device__ __forceinline__ int lds_byte(int r, int c) { const int st = (r >> 4) * 2 + (c >> 5), rr = r & 15, cc = c & 31, ob = rr * 64 + cc * 2; return st * 1024 + (ob ^ (((ob >> 9) & 1) << 5)); }
__device__ __forceinline__ void stage_rc(int b, int& R, int& C) { const int st = b / 1024, sb = b % 1024, swz = sb ^ (((sb >> 9) & 1) << 5); R = (st >> 1) * 16 + swz / 64; C = (st & 1) * 32 + (swz % 64) / 2; }

template <class Epi, class Sched, bool GATHER, bool HOOK = false>
__device__ __forceinline__ void gemm_phase(LAS unsigned char* lds, const Gemm g, const Sched& S, const Epi& E) {
    const int tid = threadIdx.x, wid = __builtin_amdgcn_readfirstlane(tid >> 6), lane = tid & 63, wr = wid >> 2, wc = wid & 3, fr = lane & 15, fq = lane >> 4;
    const int nt = g.K / BK;
    int Rs[2], Cs[2]; unsigned voffBp[2][2], voffB[2], voffBn[2], vA[2][2], vN[2][2];
#pragma unroll
    for (int i = 0; i < 2; ++i) { stage_rc(tid * 16 + i * 8192, Rs[i], Cs[i]); voffBp[0][i] = (unsigned)(Rs[i] * g.ldb + Cs[i]) * 2u;
        const int rho = Rs[i] & 31, Rb = (Rs[i] & ~31) + 8 * ((rho & 15) >> 2) + 4 * (rho >> 4) + (rho & 3); voffBp[1][i] = (unsigned)(Rb * g.ldb + Cs[i]) * 2u; }
    const size_t kstep = (size_t)(BK * 2);
    const size_t hstepB = (size_t)HALF * g.ldb * 2;
    const unsigned ldsw = (unsigned)wid * 1024u;
    const int aoff = lds_byte(wr * 64 + fr, fq * 8), boff = lds_byte(wc * 32 + fr, fq * 8);
#define PG8_SA(b, h) (((b) * 2 + (h)) * HTB)
#define PG8_SB(b, h) ((4 + (b) * 2 + (h)) * HTB)
#define PG8_STAGE(bufoff, gbase, voff) do { _Pragma("unroll") for (int _i = 0; _i < 2; ++_i) \
        __builtin_amdgcn_global_load_lds((const unsigned*)((const char*)(gbase) + (voff)[_i]), (LAS unsigned*)(lds + (bufoff) + ldsw + _i * 8192), 16, 0, 0); } while (0)
#define PG8_LDA(dst, b, h) do { _Pragma("unroll") for (int m = 0; m < 4; ++m) _Pragma("unroll") for (int k = 0; k < 2; ++k) dst[m][k] = *(const LAS bf16x8*)(lds + PG8_SA(b, h) + aoff + m * 2048 + k * 1024); } while (0)
#define PG8_LDB(dst, b, h) do { _Pragma("unroll") for (int n = 0; n < 2; ++n) _Pragma("unroll") for (int k = 0; k < 2; ++k) dst[n][k] = *(const LAS bf16x8*)(lds + PG8_SB(b, h) + boff + n * 2048 + k * 1024); } while (0)
#define PG8_MMA(ai, bj, At, Bt) do { __builtin_amdgcn_s_setprio(1); _Pragma("unroll") for (int m = 0; m < 4; ++m) _Pragma("unroll") for (int n = 0; n < 2; ++n) _Pragma("unroll") for (int k = 0; k < 2; ++k) \
        acc[ai][bj][m][n] = __builtin_amdgcn_mfma_f32_16x16x32_bf16(Bt[n][k], At[m][k], acc[ai][bj][m][n], 0, 0, 0); __builtin_amdgcn_s_setprio(0); } while (0)
#define PG8_WAIT_V(n) asm volatile("s_waitcnt vmcnt(" #n ")" ::: "memory")
#define PG8_WAIT_L(n) asm volatile("s_waitcnt lgkmcnt(" #n ")" ::: "memory")
#define PG8_BAR __builtin_amdgcn_s_barrier()
#define PG8_SCHED __builtin_amdgcn_sched_barrier(0)
#define PG8_AVOFF(dst, U) do { _Pragma("unroll") for (int _h = 0; _h < 2; ++_h) _Pragma("unroll") for (int _i = 0; _i < 2; ++_i) \
        dst[_h][_i] = GATHER ? (unsigned)((((U).pm >> 1) & 7) * SEQ + g.gidx[(U).pm * 256 + _h * 128 + Rs[_i]]) * (unsigned)(g.lda * 2) + (unsigned)(Cs[_i] * 2) \
                             : (unsigned)((_h * 128 + Rs[_i]) * g.lda + Cs[_i]) * 2u; } while (0)
#define PG8_ABASE(U) ((const char*)g.A + (GATHER ? (size_t)0 : (size_t)(U).pm * 256 * g.lda * 2))
#define PG8_BBASE(U) ((const char*)g.Bt + ((size_t)((U).pm >> g.tpg_shift) * g.bgs + (size_t)(U).pn * 256 * g.ldb) * 2)
    Unit cur, nxt; int ui = 0;
    if (!S.next(0, cur)) return;
    Acc acc;
#pragma unroll
    for (int a = 0; a < 2; ++a)
#pragma unroll
        for (int b = 0; b < 2; ++b)
#pragma unroll
            for (int m = 0; m < 4; ++m)
#pragma unroll
                for (int n = 0; n < 2; ++n) acc[a][b][m][n] = (f32x4){0.f, 0.f, 0.f, 0.f};
    bf16x8 At[4][2], B0[2][2], B1[2][2];
    PG8_AVOFF(vA, cur);
    { const bool pc = E.perm(cur); voffB[0] = pc ? voffBp[1][0] : voffBp[0][0]; voffB[1] = pc ? voffBp[1][1] : voffBp[0][1]; }
    const char* cA = PG8_ABASE(cur); const char* cB = PG8_BBASE(cur);
    PG8_STAGE(PG8_SB(0, 0), cB, voffB); PG8_STAGE(PG8_SB(0, 1), cB + hstepB, voffB); PG8_STAGE(PG8_SA(0, 0), cA, vA[0]); PG8_STAGE(PG8_SA(0, 1), cA, vA[1]);
    if (wr == 1) PG8_BAR;
    PG8_WAIT_V(2); PG8_BAR;
    PG8_STAGE(PG8_SB(1, 0), cB + kstep, voffB); PG8_STAGE(PG8_SA(1, 0), cA + kstep, vA[0]); PG8_STAGE(PG8_SB(1, 1), cB + hstepB + kstep, voffB);
    PG8_WAIT_V(6); PG8_BAR;
    for (;;) {
        const bool has_next = S.next(ui + 1, nxt);
        const char* nA = has_next ? PG8_ABASE(nxt) : cA; const char* nB = has_next ? PG8_BBASE(nxt) : cB;
        { const bool pn_ = has_next ? E.perm(nxt) : E.perm(cur); voffBn[0] = pn_ ? voffBp[1][0] : voffBp[0][0]; voffBn[1] = pn_ ? voffBp[1][1] : voffBp[0][1]; }
        if (GATHER) {
#pragma unroll
            for (int h = 0; h < 2; ++h)
#pragma unroll
                for (int i = 0; i < 2; ++i) vN[h][i] = vA[h][i];
            if (has_next && wid == 0)
                __builtin_amdgcn_global_load_lds((const unsigned*)(g.gidx + nxt.pm * 256 + lane * 4), (LAS unsigned*)(lds + STAGE_BYTES + (ui & 1) * 1024), 16, 0, 0);
        }
        for (int t = 0; t < nt; t += 2) {
            const bool last = (t == nt - 2);
            if (GATHER) { if (t == 4 && has_next) {
                const LAS int* li = (const LAS int*)(lds + STAGE_BYTES + (ui & 1) * 1024);
#pragma unroll
                for (int h = 0; h < 2; ++h)
#pragma unroll
                    for (int i = 0; i < 2; ++i) vN[h][i] = (unsigned)(((nxt.pm >> 1) & 7) * SEQ + li[h * 128 + Rs[i]]) * (unsigned)(g.lda * 2) + (unsigned)(Cs[i] * 2);
            } }
            if constexpr (HOOK) { if (t == (nt >> 1)) E.mid(acc, cur, wr, wc, fr, fq); }
            const char* a1 = cA + (size_t)(t + 1) * kstep;
            const char* a2 = last ? nA : cA + (size_t)(t + 2) * kstep; const char* b2 = last ? nB : cB + (size_t)(t + 2) * kstep;
            const char* a3 = a2 + kstep; const char* b3 = b2 + kstep;
            unsigned v2[2][2];
#pragma unroll
            for (int h = 0; h < 2; ++h)
#pragma unroll
                for (int i = 0; i < 2; ++i) v2[h][i] = (GATHER && last) ? vN[h][i] : vA[h][i];
            unsigned vb2[2]; vb2[0] = last ? voffBn[0] : voffB[0]; vb2[1] = last ? voffBn[1] : voffB[1];
            PG8_LDB(B0, 0, 0); PG8_LDB(B1, 0, 1); PG8_SCHED; PG8_LDA(At, 0, 0); PG8_STAGE(PG8_SA(1, 1), a1, vA[1]);
            PG8_WAIT_V(8); PG8_WAIT_L(0); PG8_BAR; PG8_MMA(0, 0, At, B0); PG8_MMA(0, 1, At, B1); PG8_BAR; PG8_SCHED;
            PG8_LDA(At, 0, 1); PG8_STAGE(PG8_SB(0, 0), b2, vb2); PG8_STAGE(PG8_SB(0, 1), b2 + hstepB, vb2); PG8_STAGE(PG8_SA(0, 0), a2, v2[0]);
            PG8_WAIT_V(8); PG8_WAIT_L(0); PG8_BAR; PG8_MMA(1, 0, At, B0); PG8_MMA(1, 1, At, B1); PG8_BAR; PG8_SCHED;
            PG8_LDB(B0, 1, 0); PG8_LDB(B1, 1, 1); PG8_SCHED; PG8_LDA(At, 1, 0); PG8_STAGE(PG8_SA(0, 1), a2, v2[1]);
            PG8_WAIT_V(8); PG8_WAIT_L(0); PG8_BAR; PG8_MMA(0, 0, At, B0); PG8_MMA(0, 1, At, B1); PG8_BAR; PG8_SCHED;
            PG8_LDA(At, 1, 1); PG8_STAGE(PG8_SB(1, 0), b3, vb2); PG8_STAGE(PG8_SB(1, 1), b3 + hstepB, vb2); PG8_STAGE(PG8_SA(1, 0), a3, v2[0]);
            PG8_WAIT_V(8); PG8_WAIT_L(0); PG8_BAR; PG8_MMA(1, 0, At, B0); PG8_MMA(1, 1, At, B1); PG8_BAR; PG8_SCHED;
        }
        if (wr == 0) PG8_BAR;
        E(acc, cur, wr, wc, fr, fq);
        if (!has_next) break;
#pragma unroll
        for (int a = 0; a < 2; ++a)
#pragma unroll
            for (int b = 0; b < 2; ++b)
#pragma unroll
                for (int m = 0; m < 4; ++m)
#pragma unroll
                    for (int n = 0; n < 2; ++n) acc[a][b][m][n] = (f32x4){0.f, 0.f, 0.f, 0.f};
        cur = nxt; cA = nA; cB = nB; ++ui; voffB[0] = voffBn[0]; voffB[1] = voffBn[1];
        if (GATHER) {
#pragma unroll
            for (int h = 0; h < 2; ++h)
#pragma unroll
                for (int i = 0; i < 2; ++i) vA[h][i] = vN[h][i];
        }
        if (wr == 1) PG8_BAR;
    }
    PG8_WAIT_V(0);
    PG8_BAR;
#undef PG8_SA
#undef PG8_SB
#undef PG8_STAGE
#undef PG8_LDA
#undef PG8_LDB
#undef PG8_MMA
#undef PG8_WAIT_V
#undef PG8_WAIT_L
#undef PG8_BAR
#undef PG8_SCHED
#undef PG8_AVOFF
#undef PG8_ABASE
#undef PG8_BBASE
}
}

#define GEMM_PHASE pg8::gemm_phase

struct EpiIn {
    bf16_t *Y, *VA, *KB, *VB, *G; const float* bgate; const f32x2* rope; f32x2* STATS;
    __device__ __forceinline__ bool perm(const Unit& u) const { return u.pn < 8 || u.pn > 12; }
    template <int KIND> __device__ __forceinline__ void run(const Acc& acc, const Unit& u, int wr, int wc, int fr, int fq) const {
        const int pn = u.pn;
#pragma unroll
        for (int ai = 0; ai < 2; ++ai)
#pragma unroll
            for (int m = 0; m < 4; ++m) {
                const int row = u.pm * 256 + ai * 128 + wr * 64 + m * 16 + fr;
                float ssum = 0.f, ssq = 0.f;
#pragma unroll
                for (int bj = 0; bj < 2; ++bj) {
                    f32x4 v0 = acc[ai][bj][m][0], v1 = acc[ai][bj][m][1];
                    if constexpr (KIND == 0 || KIND == 1) {
                        const int c8 = bj * 128 + wc * 32 + 8 * fq;
#pragma unroll
                        for (int j = 0; j < 4; ++j) { v0[j] = gelu_t(v0[j]); v1[j] = gelu_t(v1[j]); }
                        if constexpr (KIND == 0) st8bf(Y + (size_t)row * 2048 + pn * 256 + c8, v0, v1);
                        else {
                            st8bf(VA + (size_t)row * 1024 + (pn - 4) * 256 + c8, v0, v1);
                            ssum += ((v0.x + v0.y) + (v0.z + v0.w)) + ((v1.x + v1.y) + (v1.z + v1.w));
                            ssq += ((v0.x * v0.x + v0.y * v0.y) + (v0.z * v0.z + v0.w * v0.w)) + ((v1.x * v1.x + v1.y * v1.y) + (v1.z * v1.z + v1.w * v1.w));
                        }
                    } else if constexpr (KIND == 2) {
                        const int cl = bj * 128 + wc * 32 + 4 * fq;
                        f32x4 o0 = v0, o1 = v1;
                        if (row < NTOK) {
                            const int t = row & (SEQ - 1), pos = (wc & 1) ? (t & 63) : (t >> 6);
                            const f32x2* rp = rope + pos * 16 + 4 * fq;
#pragma unroll
                            for (int j = 0; j < 4; ++j) { const f32x2 cs = rp[j]; o0[j] = v0[j] * cs.x - v1[j] * cs.y; o1[j] = v0[j] * cs.y + v1[j] * cs.x; }
                        }
                        if (pn < 12) { bf16_t* p = Y + (size_t)row * 2048 + 1024 + (pn - 8) * 256 + cl; st4bf(p, o0 * C2); st4bf(p + 16, o1 * C2); }
                        else { bf16_t* p = KB + (size_t)row * 256 + cl; st4bf(p, o0); st4bf(p + 16, o1); }
                    } else if constexpr (KIND == 3) {
                        st8bf(VB + (size_t)row * 256 + bj * 128 + wc * 32 + 8 * fq, v0, v1);
                    } else {
                        const int cg = (pn - 14) * 256 + bj * 128 + wc * 32 + 8 * fq;
                        const f32x4 b0 = *(const f32x4*)(bgate + cg), b1 = *(const f32x4*)(bgate + cg + 4);
#pragma unroll
                        for (int j = 0; j < 4; ++j) { v0[j] = sigmoidf_(v0[j] + b0[j]); v1[j] = sigmoidf_(v1[j] + b1[j]); }
                        st8bf(G + (size_t)row * 2048 + cg, v0, v1);
                    }
                }
                if constexpr (KIND == 1) {
                    ssum += __shfl_xor(ssum, 16); ssum += __shfl_xor(ssum, 32); ssq += __shfl_xor(ssq, 16); ssq += __shfl_xor(ssq, 32);
                    if (fq == 0) STATS[(size_t)row * 16 + (pn - 4) * 4 + wc] = (f32x2){ssum, ssq};
                }
            }
    }
    __device__ __forceinline__ void operator()(const Acc& acc, const Unit& u, int wr, int wc, int fr, int fq) const {
        const int pn = u.pn;
        if (pn < 4) run<0>(acc, u, wr, wc, fr, fq);
        else if (pn < 8) run<1>(acc, u, wr, wc, fr, fq);
        else if (pn < 13) run<2>(acc, u, wr, wc, fr, fq);
        else if (pn == 13) run<3>(acc, u, wr, wc, fr, fq);
        else run<4>(acc, u, wr, wc, fr, fq);
    }
};
struct EpiAB {
    bf16_t* MERGED; const bf16_t* G;
    __device__ __forceinline__ bool perm(const Unit&) const { return true; }
    __device__ __forceinline__ void mid(Acc& acc, const Unit& u, int wr, int wc, int fr, int fq) const {
        int zero; asm volatile("v_mov_b32 %0, 0" : "=v"(zero));
        const bf16_t* gp = G + (size_t)(u.pm * 256 + wr * 64 + fr + zero) * 2048 + u.pn * 256 + wc * 32 + 8 * fq;
#pragma unroll
        for (int ai = 0; ai < 2; ++ai)
#pragma unroll
            for (int m = 0; m < 4; ++m) {
#pragma unroll
                for (int bj = 0; bj < 2; ++bj) {
                    const bf16_t* q = gp + (size_t)(ai * 128 + m * 16) * 2048 + bj * 128;
                    f32x4 ga0, ga1, gb0, gb1; ld8bf(q, ga0, ga1); ld8bf(q + 1024, gb0, gb1);
#pragma unroll
                    for (int j = 0; j < 4; ++j) { acc[ai][bj][m][0][j] *= ga0[j] * __builtin_amdgcn_rcpf(gb0[j]); acc[ai][bj][m][1][j] *= ga1[j] * __builtin_amdgcn_rcpf(gb1[j]); }
                    asm volatile("" ::: "memory");
                }
            }
    }
    __device__ __forceinline__ void operator()(const Acc& acc, const Unit& u, int wr, int wc, int fr, int fq) const {
#pragma unroll
        for (int ai = 0; ai < 2; ++ai)
#pragma unroll
            for (int m = 0; m < 4; ++m) {
                const int row = u.pm * 256 + ai * 128 + wr * 64 + m * 16 + fr;
#pragma unroll
                for (int bj = 0; bj < 2; ++bj) {
                    const int c8 = u.pn * 256 + bj * 128 + wc * 32 + 8 * fq;
                    f32x4 gb0, gb1; ld8bf(G + (size_t)row * 2048 + 1024 + c8, gb0, gb1);
                    st8bf(MERGED + (size_t)row * 1024 + c8, gb0 * acc[ai][bj][m][0], gb1 * acc[ai][bj][m][1]);
                }
            }
    }
};
struct EpiO {
    float* X1; const float* X; const float* mod;
    __device__ __forceinline__ bool perm(const Unit&) const { return false; }
    __device__ __forceinline__ void operator()(const Acc& acc, const Unit& u, int wr, int wc, int fr, int fq) const {
#pragma unroll
        for (int ai = 0; ai < 2; ++ai)
#pragma unroll
            for (int m = 0; m < 4; ++m) {
                const int row = u.pm * 256 + ai * 128 + wr * 64 + m * 16 + fr; const float* g1 = mod + (size_t)(row >> 12) * 6144 + 2048;
#pragma unroll
                for (int bj = 0; bj < 2; ++bj)
#pragma unroll
                    for (int n = 0; n < 2; ++n) {
                        const int c = u.pn * 256 + bj * 128 + wc * 32 + 16 * n + 4 * fq;
                        const f32x4 xv = *(const f32x4*)(X + (size_t)row * 1024 + c), gv = *(const f32x4*)(g1 + c);
                        *(f32x4*)(X1 + (size_t)row * 1024 + c) = xv + gv * acc[ai][bj][m][n];
                    }
            }
    }
};
struct EpiGU {
    bf16_t* ACT;
    __device__ __forceinline__ bool perm(const Unit&) const { return true; }
    __device__ __forceinline__ void operator()(const Acc& acc, const Unit& u, int wr, int wc, int fr, int fq) const {
#pragma unroll
        for (int ai = 0; ai < 2; ++ai)
#pragma unroll
            for (int m = 0; m < 4; ++m) {
                const int prow = u.pm * 256 + ai * 128 + wr * 64 + m * 16 + fr;
                f32x4 a[2];
#pragma unroll
                for (int n = 0; n < 2; ++n) {
                    const f32x4 gt = acc[ai][0][m][n], up = acc[ai][1][m][n];
#pragma unroll
                    for (int j = 0; j < 4; ++j) a[n][j] = siluf_(gt[j]) * up[j];
                }
                st8bf(ACT + (size_t)prow * 2048 + u.pn * 128 + wc * 32 + 8 * fq, a[0], a[1]);
            }
    }
};
struct EpiD {
    bf16_t* YB; const float* TOPW;
    __device__ __forceinline__ bool perm(const Unit&) const { return true; }
    __device__ __forceinline__ void operator()(const Acc& acc, const Unit& u, int wr, int wc, int fr, int fq) const {
#pragma unroll
        for (int ai = 0; ai < 2; ++ai)
#pragma unroll
            for (int m = 0; m < 4; ++m) {
                const int prow = u.pm * 256 + ai * 128 + wr * 64 + m * 16 + fr; const float w = TOPW[prow];
#pragma unroll
                for (int bj = 0; bj < 2; ++bj)
                    st8bf(YB + (size_t)prow * 1024 + u.pn * 256 + bj * 128 + wc * 32 + 8 * fq, acc[ai][bj][m][0] * w, acc[ai][bj][m][1] * w);
            }
    }
};

__device__ __forceinline__ void transpose_item(const float* W, int N, int k0, int n0, bf16_t* dst, int ldt, LAS float* scr, int lane) {
    const int kk = lane >> 3, nq = (lane & 7) * 4;
    f32x4 v[8];
#pragma unroll
    for (int i = 0; i < 8; ++i) v[i] = *(const f32x4*)(W + (size_t)(k0 + 8 * i + kk) * N + n0 + nq);
#pragma unroll
    for (int i = 0; i < 8; ++i) { LAS float* s = scr + (8 * i + kk) * 33 + nq; s[0] = v[i].x; s[1] = v[i].y; s[2] = v[i].z; s[3] = v[i].w; }
    LDS_WAIT();
    const int c = lane & 7;
#pragma unroll
    for (int j = 0; j < 4; ++j) {
        const int n = (lane >> 3) + 8 * j; const LAS float* s = scr + (8 * c) * 33 + n;
        u32x4 o; o.x = pk2(s[0 * 33], s[1 * 33]); o.y = pk2(s[2 * 33], s[3 * 33]); o.z = pk2(s[4 * 33], s[5 * 33]); o.w = pk2(s[6 * 33], s[7 * 33]);
        *(u32x4*)(dst + (size_t)n * ldt + 8 * c) = o;
    }
    LDS_WAIT();
}

struct TrItem { const float* src; bf16_t* dst; int N, ldt; };
__device__ __forceinline__ void tr_load(const TrItem& it, f32x4 (&v)[8], int lane) {
    const int kk = lane >> 3, nq = (lane & 7) * 4;
#pragma unroll
    for (int i = 0; i < 8; ++i) v[i] = *(const f32x4*)(it.src + (size_t)(8 * i + kk) * it.N + nq);
}
__device__ __forceinline__ void tr_store(const TrItem& it, const f32x4 (&v)[8], LAS float* scr, int lane) {
    const int kk = lane >> 3, nq = (lane & 7) * 4;
#pragma unroll
    for (int i = 0; i < 8; ++i) { LAS float* s = scr + (8 * i + kk) * 33 + nq; s[0] = v[i].x; s[1] = v[i].y; s[2] = v[i].z; s[3] = v[i].w; }
    LDS_WAIT();
    const int c = lane & 7;
#pragma unroll
    for (int j = 0; j < 4; ++j) {
        const int n = (lane >> 3) + 8 * j; const LAS float* s = scr + (8 * c) * 33 + n;
        u32x4 o; o.x = pk2(s[0 * 33], s[1 * 33]); o.y = pk2(s[2 * 33], s[3 * 33]); o.z = pk2(s[4 * 33], s[5 * 33]); o.w = pk2(s[6 * 33], s[7 * 33]);
        *(u32x4*)(it.dst + (size_t)n * it.ldt + 8 * c) = o;
    }
    LDS_WAIT();
}

__device__ __forceinline__ void adaln_task(int task, const float* c, const float* cctx, const float* w_ada, const float* b_ada, float* mod, LAS float* lds, int tid) {
    LAS float* s = lds; LAS float* red = lds + 9 * 1024;
    { float cv[18];
#pragma unroll
      for (int q = 0; q < 18; ++q) { const int i = tid + NTHREADS * q, r = i >> 10, k = i & 1023; cv[q] = r < 8 ? c[r * 1024 + k] : cctx[k]; }
#pragma unroll
      for (int q = 0; q < 18; ++q) s[tid + NTHREADS * q] = cv[q] * __builtin_amdgcn_rcpf(1.f + __expf(-cv[q])); }
    __syncthreads();
    const int ch = tid & 7, kr = tid >> 3;
    f32x4 acc[9];
#pragma unroll
    for (int r = 0; r < 9; ++r) acc[r] = (f32x4){0.f, 0.f, 0.f, 0.f};
    const float* wp = w_ada + (size_t)kr * 6144 + task * 32 + ch * 4;
    for (int it = 0; it < 16; ++it) {
        const f32x4 w = *(const f32x4*)(wp + (size_t)it * 64 * 6144); const int k = kr + it * 64;
#pragma unroll
        for (int r = 0; r < 9; ++r) acc[r] += s[r * 1024 + k] * w;
    }
#pragma unroll
    for (int r = 0; r < 9; ++r) *(LAS f32x4*)(red + (kr * 9 + r) * 32 + ch * 4) = acc[r];
    __syncthreads();
    if (tid < 288) { const int r = tid >> 5, col = tid & 31; float sum = 0.f; for (int q = 0; q < 64; ++q) sum += red[(q * 9 + r) * 32 + col]; mod[r * 6144 + task * 32 + col] = sum + b_ada[task * 32 + col]; }
    __syncthreads();
}

__device__ __forceinline__ void rope_table(f32x2* tab, int tid) {
    for (int idx = tid; idx < 1024; idx += NTHREADS) {
        const int pos = idx >> 4, i = idx & 15;
        double f = 1.0;
        for (int q = 0; q < i; ++q) f *= 0.56234132519034908;
        const float ang = (float)pos * (float)f;
        const double a = (double)ang, k = __builtin_rint(a * 0.15915494309189535), r = a - k * 6.283185307179586476925, r2 = r * r;
        double sn = r, ts = r, cs = 1.0, tc = 1.0;
        for (int n = 1; n <= 14; ++n) {
            tc *= -r2 / (double)((2 * n - 1) * (2 * n)); cs += tc;
            ts *= -r2 / (double)((2 * n) * (2 * n + 1)); sn += ts;
        }
        tab[idx] = (f32x2){(float)cs, (float)sn};
    }
}

__device__ __forceinline__ unsigned char* lds_raw_ptr(LAS unsigned char* p) { return (unsigned char*)p; }
namespace mix {
typedef short bf16x8 __attribute__((ext_vector_type(8)));
typedef short s16x4 __attribute__((ext_vector_type(4)));
typedef float f32x16 __attribute__((ext_vector_type(16)));
typedef __attribute__((address_space(3))) const char* lds_cptr;
__device__ __forceinline__ int crow(int r, int hi) { return (r & 3) + 8 * (r >> 2) + 4 * hi; }
__device__ __forceinline__ unsigned cvtpk(float lo, float hi) { typedef float f2 __attribute__((ext_vector_type(2))); typedef __bf16 b2 __attribute__((ext_vector_type(2))); f2 v = {lo, hi}; b2 b = __builtin_convertvector(v, b2); return __builtin_bit_cast(unsigned, b); }
__device__ __forceinline__ s16x4 vtr(lds_cptr p) { return __builtin_bit_cast(s16x4, __builtin_amdgcn_ds_read_tr16_b64_v4i16((__attribute__((address_space(3))) s16x4*)p)); }
__device__ __forceinline__ bf16x8 pk8(s16x4 lo, s16x4 hi) { return (bf16x8){lo[0], lo[1], lo[2], lo[3], hi[0], hi[1], hi[2], hi[3]}; }
__device__ __forceinline__ float max3f(float a, float b, float c) { float r; asm("v_max3_f32 %0, %1, %2, %3" : "=v"(r) : "v"(a), "v"(b), "v"(c)); return r; }
__device__ __forceinline__ float max2f(float a, float b) { float r; asm("v_max_f32_e32 %0, %1, %2" : "=v"(r) : "v"(a), "v"(b)); return r; }
__device__ __forceinline__ float swap_half(float v) { auto rr = __builtin_amdgcn_permlane32_swap(__float_as_uint(v), __float_as_uint(v), false, false); return __uint_as_float((threadIdx.x & 32) ? rr[0] : rr[1]); }

constexpr int A_K = 0, A_V = 24576, A_WS = 49152, A_QST = 53248, A_OST = A_QST, A_OSTW = 8192, A_END = A_QST + 8 * 8192;

__device__ __forceinline__ void attn_unit(int b, int n, int kvh, bf16_t* Y, bf16_t* O, int ldo, const bf16_t* KB, const bf16_t* VB, const float* sink, LAS unsigned char* lds) {
    const int tid = threadIdx.x, lane = tid & 63, r32 = lane & 31, hi = lane >> 5, wid = __builtin_amdgcn_readfirstlane(tid >> 6);
    const int head = kvh * 4 + (wid >> 1);
    const int qrow0 = b * SEQ + n * 128 + (wid & 1) * 64;
    bf16_t* Qw = Y + (size_t)qrow0 * 2048 + 1024 + head * 64;
    LAS bf16x8* qst = (LAS bf16x8*)(lds + A_QST + wid * 8192) + lane;
#pragma unroll
    for (int sb = 0; sb < 2; ++sb)
#pragma unroll
        for (int d0 = 0; d0 < 4; ++d0) qst[(sb * 4 + d0) * 64] = *(const bf16x8*)(Qw + (size_t)(32 * sb + r32) * 2048 + d0 * 16 + hi * 8);
    f32x16 o[2][2];
#pragma unroll
    for (int sb = 0; sb < 2; ++sb)
#pragma unroll
        for (int d0 = 0; d0 < 2; ++d0)
#pragma unroll
            for (int r = 0; r < 16; ++r) o[sb][d0][r] = 0.f;
    float m[2] = {-1e30f, -1e30f}, l[2] = {0.f, 0.f};
    LAS float* wsf = (LAS float*)(lds + A_WS) + wid * 128;
    const int jlo = (n == 0) ? 2 : 0, jhi = (n == 31) ? 3 : 5, T = 4 + (jhi - jlo + 1);
    const size_t koff = (size_t)lane * 256 + wid * 8 + kvh * 64;
    const size_t voff = (size_t)(16 * (wid & 3) + (lane >> 2)) * 256 + (wid >> 2) * 32 + (lane & 3) * 8 + kvh * 64;
    auto tile_row = [&](int t) -> long { return t < 4 ? (long)(NTOK + b * CTXL + 64 * t) : (long)(b * SEQ + (n - 1) * 128 + 64 * (jlo + t - 4)); };
    auto issue = [&](int t) {
        const long row = tile_row(t); const int buf = t % 3;
        __builtin_amdgcn_global_load_lds((const unsigned*)(KB + row * 256 + koff), (LAS unsigned*)(lds + A_K + buf * 8192 + wid * 1024), 16, 0, 0);
        __builtin_amdgcn_global_load_lds((const unsigned*)(VB + row * 256 + voff), (LAS unsigned*)(lds + A_V + buf * 8192 + wid * 1024), 16, 0, 0);
    };
    issue(0); issue(1);
    int slot = 0;
    for (int t = 0; t < T; ++t) {
        if (t + 1 < T) asm volatile("s_waitcnt vmcnt(2) lgkmcnt(0)" ::: "memory"); else asm volatile("s_waitcnt vmcnt(0) lgkmcnt(0)" ::: "memory");
        __builtin_amdgcn_s_barrier();
        if (t + 2 < T) issue(t + 2);
        const lds_cptr Kt = (lds_cptr)(lds + A_K + slot * 8192) + hi * 1024 + r32 * 16;
        const lds_cptr Vt = (lds_cptr)(lds + A_V + slot * 8192) + ((lane >> 4) & 1) * 32 + (lane & 3) * 8 + (4 * hi + ((lane & 15) >> 2)) * 64;
        slot = (slot == 2) ? 0 : slot + 1;
        const bool local = t >= 4;
        const int dl = 64 * (jlo + t - 4) - 128 - 64 * (wid & 1);
        if (local && (dl > 160 || dl < -191)) continue;
        f32x16 p0[2], p1[2];
#pragma unroll
        for (int sb = 0; sb < 2; ++sb)
#pragma unroll
            for (int r = 0; r < 16; ++r) { p0[sb][r] = 0.f; p1[sb][r] = 0.f; }
#pragma unroll
        for (int d0 = 0; d0 < 4; ++d0) {
            const bf16x8 k0 = *(const __attribute__((address_space(3))) bf16x8*)(Kt + d0 * 2048), k1 = *(const __attribute__((address_space(3))) bf16x8*)(Kt + d0 * 2048 + 512);
#pragma unroll
            for (int sb = 0; sb < 2; ++sb) {
                const bf16x8 qf = qst[(sb * 4 + d0) * 64];
                p0[sb] = __builtin_amdgcn_mfma_f32_32x32x16_bf16(k0, qf, p0[sb], 0, 0, 0);
                p1[sb] = __builtin_amdgcn_mfma_f32_32x32x16_bf16(k1, qf, p1[sb], 0, 0, 0);
            }
        }
        if (local && (dl < -97 || dl > 65 || dl - 32 < -97)) {
#pragma unroll
            for (int sb = 0; sb < 2; ++sb)
#pragma unroll
                for (int r = 0; r < 16; ++r) { const int rel = dl - 32 * sb + crow(r, hi) - r32; if (rel < -128 || rel > 128) p0[sb][r] = -1e30f; if (rel + 32 < -128 || rel + 32 > 128) p1[sb][r] = -1e30f; }
        }
        float mn[2];
        asm volatile("s_nop 15\n\ts_nop 7" : "+v"(p0[0]), "+v"(p1[0]), "+v"(p0[1]), "+v"(p1[1]));
#pragma unroll
        for (int sb = 0; sb < 2; ++sb) {
            float a = max3f(p0[sb][0], p0[sb][1], p1[sb][0]), b2 = max3f(p0[sb][2], p0[sb][3], p1[sb][1]); a = max3f(a, p1[sb][2], p1[sb][3]);
#pragma unroll
            for (int r = 4; r < 16; r += 4) { a = max3f(a, p0[sb][r], p0[sb][r + 1]); b2 = max3f(b2, p0[sb][r + 2], p0[sb][r + 3]); a = max3f(a, p1[sb][r], p1[sb][r + 1]); b2 = max3f(b2, p1[sb][r + 2], p1[sb][r + 3]); }
            float rm = max2f(a, b2);
            rm = max2f(rm, swap_half(rm));
            mn[sb] = max2f(m[sb], rm);
        }
        if (__any((mn[0] > m[0]) || (mn[1] > m[1]))) {
            const float f0 = __builtin_amdgcn_exp2f(m[0] - mn[0]), f1 = __builtin_amdgcn_exp2f(m[1] - mn[1]);
            l[0] *= f0; l[1] *= f1;
            if (hi == 0) { wsf[r32] = f0; wsf[64 + r32] = f1; }
            asm volatile("s_waitcnt lgkmcnt(0)" ::: "memory");
#pragma unroll
            for (int r = 0; r < 16; ++r) { const float a = wsf[crow(r, hi)], b2 = wsf[64 + crow(r, hi)]; o[0][0][r] *= a; o[0][1][r] *= a; o[1][0][r] *= b2; o[1][1][r] *= b2; }
            m[0] = mn[0]; m[1] = mn[1];
        }
        u32x4 pw[2][4];
#pragma unroll
        for (int sb = 0; sb < 2; ++sb) {
            float sacc = 0.f;
#pragma unroll
            for (int r = 0; r < 16; ++r) { p0[sb][r] = __builtin_amdgcn_exp2f(p0[sb][r] - m[sb]); p1[sb][r] = __builtin_amdgcn_exp2f(p1[sb][r] - m[sb]); sacc += p0[sb][r] + p1[sb][r]; }
            l[sb] += sacc;
#pragma unroll
            for (int q = 0; q < 4; ++q) { pw[sb][0][q] = cvtpk(p0[sb][2 * q], p0[sb][2 * q + 1]); pw[sb][1][q] = cvtpk(p0[sb][8 + 2 * q], p0[sb][9 + 2 * q]); pw[sb][2][q] = cvtpk(p1[sb][2 * q], p1[sb][2 * q + 1]); pw[sb][3][q] = cvtpk(p1[sb][8 + 2 * q], p1[sb][9 + 2 * q]); }
        }
#pragma unroll
        for (int d0 = 0; d0 < 2; ++d0)
#pragma unroll
            for (int ks = 0; ks < 4; ++ks) {
                const s16x4 vlo = vtr(Vt + d0 * 4096 + ks * 1024), vhi = vtr(Vt + d0 * 4096 + ks * 1024 + 512);
                const bf16x8 vf = pk8(vlo, vhi);
#pragma unroll
                for (int sb = 0; sb < 2; ++sb) o[sb][d0] = __builtin_amdgcn_mfma_f32_32x32x16_bf16(__builtin_bit_cast(bf16x8, pw[sb][ks]), vf, o[sb][d0], 0, 0, 0);
            }
    }
    const float s2 = sink[head] * LOG2E;
    LAS bf16_t* stg = (LAS bf16_t*)(lds + A_OST + wid * A_OSTW);
#pragma unroll
    for (int sb = 0; sb < 2; ++sb) {
        const float lt = l[sb] + swap_half(l[sb]);
        const float mf = fmaxf(m[sb], s2), f = __builtin_amdgcn_exp2f(m[sb] - mf), den = lt * f + __builtin_amdgcn_exp2f(s2 - mf);
        asm volatile("s_waitcnt lgkmcnt(0)" ::: "memory");
        if (hi == 0) wsf[sb * 64 + r32] = f / den;
        asm volatile("s_waitcnt lgkmcnt(0)" ::: "memory");
#pragma unroll
        for (int r = 0; r < 16; ++r) { const float sc = wsf[sb * 64 + crow(r, hi)]; const int orow = crow(r, hi);
            stg[orow * 64 + r32] = (bf16_t)f2bf(o[sb][0][r] * sc); stg[orow * 64 + 32 + r32] = (bf16_t)f2bf(o[sb][1][r] * sc); }
        asm volatile("s_waitcnt lgkmcnt(0)" ::: "memory");
#pragma unroll
        for (int i = 0; i < 4; ++i) { const int row = i * 8 + (lane >> 3), ch = lane & 7; const u32x4 v = *(const LAS u32x4*)(stg + row * 64 + ch * 8); *(u32x4*)(O + (size_t)(qrow0 + 32 * sb + row) * ldo + head * 64 + ch * 8) = v; }
        asm volatile("s_waitcnt lgkmcnt(0)" ::: "memory");
    }
    __syncthreads();
}

constexpr int G_V = 0, G_ST = 65536, G_STW = 8704, G_MU = G_ST + 8 * G_STW;
__device__ __forceinline__ void gmlp_unit(int task, bf16_t* Y, bf16_t* YO, int ldo, const bf16_t* VA, const bf16_t* WSP, const f32x2* STATS, const float* ln_g, const float* ln_b, const float* b_sp, LAS unsigned char* lds) {
    const int tid = threadIdx.x, lane = tid & 63, r32 = lane & 31, hi = lane >> 5, wid = __builtin_amdgcn_readfirstlane(tid >> 6);
    const int r0 = task * 128;
    LAS float* mu = (LAS float*)(lds + G_MU); LAS float* rs = mu + 128;
    if (tid < 128) {
        const f32x4* sp = (const f32x4*)(STATS + (size_t)(r0 + tid) * 16); float s = 0.f, ss = 0.f;
#pragma unroll
        for (int i = 0; i < 8; ++i) { const f32x4 v = sp[i]; s += v.x + v.z; ss += v.y + v.w; }
        const float mean = s * (1.f / 1024.f), var = fmaxf(ss * (1.f / 1024.f) - mean * mean, 0.f);
        mu[tid] = mean; rs[tid] = 1.0f / sqrtf(var + EPS);
    }
    u32x4 raw[4];
#pragma unroll
    for (int i = 0; i < 4; ++i) { const int idx = tid + NTHREADS * i, q = idx >> 4, c8 = idx & 15; raw[i] = *(const u32x4*)(VA + (size_t)(r0 + q) * 1024 + c8 * 8); }
    __syncthreads();
    const int pb = wid >> 1, dh = wid & 1;
    LAS float* st = (LAS float*)(lds + G_ST + wid * G_STW);
    for (int g8 = 0; g8 < 8; ++g8) {
        LAS unsigned char* vb = lds + G_V + (g8 & 1) * 32768;
#pragma unroll
        for (int i = 0; i < 4; ++i) {
            const int idx = tid + NTHREADS * i, q = idx >> 4, c8 = idx & 15, d = c8 * 8;
            const f32x4 g0 = *(const f32x4*)(ln_g + g8 * 128 + d), g1 = *(const f32x4*)(ln_g + g8 * 128 + d + 4), b0 = *(const f32x4*)(ln_b + g8 * 128 + d), b1 = *(const f32x4*)(ln_b + g8 * 128 + d + 4);
            const float mq = mu[q], rq = rs[q]; const u32x4 rw = raw[i];
            float v[8] = {bf2f(rw.x & 0xffffu), bf2f(rw.x >> 16), bf2f(rw.y & 0xffffu), bf2f(rw.y >> 16), bf2f(rw.z & 0xffffu), bf2f(rw.z >> 16), bf2f(rw.w & 0xffffu), bf2f(rw.w >> 16)};
#pragma unroll
            for (int e = 0; e < 4; ++e) { v[e] = (v[e] - mq) * rq * g0[e] + b0[e]; v[4 + e] = (v[4 + e] - mq) * rq * g1[e] + b1[e]; }
            u32x4 w; w.x = pk2(v[0], v[1]); w.y = pk2(v[2], v[3]); w.z = pk2(v[4], v[5]); w.w = pk2(v[6], v[7]);
            *(LAS u32x4*)(vb + ((d >> 5) * 8 + (q >> 4)) * 1024 + (q & 15) * 64 + (d & 31) * 2) = w;
        }
        if (g8 + 1 < 8) {
#pragma unroll
            for (int i = 0; i < 4; ++i) { const int idx = tid + NTHREADS * i, q = idx >> 4, c8 = idx & 15; raw[i] = *(const u32x4*)(VA + (size_t)(r0 + q) * 1024 + (g8 + 1) * 128 + c8 * 8); }
        }
        u32x4 ur[4]; bf16x8 af[8];
        const size_t ybase = (size_t)(r0 + 32 * pb + (lane >> 3)) * 2048 + g8 * 128 + 64 * dh + (lane & 7) * 8;
#pragma unroll
        for (int i = 0; i < 4; ++i) ur[i] = *(const u32x4*)(Y + ybase + (size_t)(8 * i) * 2048);
        const bf16_t* wrow = WSP + (size_t)g8 * 16384 + (size_t)(32 * pb + r32) * 128 + 8 * hi;
#pragma unroll
        for (int ks = 0; ks < 8; ++ks) af[ks] = *(const bf16x8*)(wrow + 16 * ks);
        __syncthreads();
        const lds_cptr Vb = (lds_cptr)vb + ((lane >> 4) & 1) * 32 + (lane & 3) * 8 + (8 * hi + ((lane & 15) >> 2)) * 64;
        f32x16 acc[2];
#pragma unroll
        for (int t2 = 0; t2 < 2; ++t2)
#pragma unroll
            for (int r = 0; r < 16; ++r) acc[t2][r] = 0.f;
#pragma unroll
        for (int ks = 0; ks < 8; ++ks) {
#pragma unroll
            for (int t2 = 0; t2 < 2; ++t2) {
                const int db = 2 * dh + t2;
                const s16x4 vlo = vtr(Vb + (db * 8 + ks) * 1024), vhi = vtr(Vb + (db * 8 + ks) * 1024 + 256);
                acc[t2] = __builtin_amdgcn_mfma_f32_32x32x16_bf16(af[ks], pk8(vlo, vhi), acc[t2], 0, 0, 0);
            }
        }
#pragma unroll
        for (int t2 = 0; t2 < 2; ++t2)
#pragma unroll
            for (int r = 0; r < 16; ++r) st[crow(r, hi) * 68 + 32 * t2 + r32] = acc[t2][r];
        asm volatile("s_waitcnt lgkmcnt(0)" ::: "memory");
#pragma unroll
        for (int i = 0; i < 4; ++i) {
            const int prow = 8 * i + (lane >> 3), ch = lane & 7;
            const f32x4 m0 = *(const LAS f32x4*)(st + prow * 68 + ch * 8), m1 = *(const LAS f32x4*)(st + prow * 68 + ch * 8 + 4);
            const float bs = b_sp[g8 * 128 + 32 * pb + prow]; const u32x4 uw = ur[i];
            u32x4 o;
            o.x = pk2(bf2f(uw.x & 0xffffu) * (m0.x + bs), bf2f(uw.x >> 16) * (m0.y + bs)); o.y = pk2(bf2f(uw.y & 0xffffu) * (m0.z + bs), bf2f(uw.y >> 16) * (m0.w + bs));
            o.z = pk2(bf2f(uw.z & 0xffffu) * (m1.x + bs), bf2f(uw.z >> 16) * (m1.y + bs)); o.w = pk2(bf2f(uw.w & 0xffffu) * (m1.z + bs), bf2f(uw.w >> 16) * (m1.w + bs));
            *(u32x4*)(YO + (size_t)(r0 + 32 * pb + prow) * ldo + g8 * 128 + 64 * dh + ch * 8) = o;
        }
        asm volatile("s_waitcnt lgkmcnt(0)" ::: "memory");
    }
    __syncthreads();
}
}

namespace att2 {
typedef short bf16x8 __attribute__((ext_vector_type(8)));
typedef short s16x4 __attribute__((ext_vector_type(4)));
typedef float f32x16 __attribute__((ext_vector_type(16)));
typedef __attribute__((address_space(3))) const char* lds_cptr;
typedef short v4i16_t __attribute__((ext_vector_type(4)));
__device__ __forceinline__ int crow(int r, int hi) { return (r & 3) + 8 * (r >> 2) + 4 * hi; }
#define SBAR() __builtin_amdgcn_sched_barrier(0)
constexpr int NSLOT = 3, SLOTB = 8192;
constexpr int LDS_K = 0, LDS_V = NSLOT * SLOTB, LDS_WS = 2 * NSLOT * SLOTB, LDS_OST = LDS_WS + 8 * 64 * 4, LDS_BYTES = LDS_OST + 8 * 4096;
__device__ __forceinline__ void glds16(const void* gsrc, unsigned lds_dst) { unsigned keep;
    asm volatile("s_mov_b32 %0, m0\n\ts_mov_b32 m0, %2\n\ts_nop 0\n\tglobal_load_lds_dwordx4 %1, off\n\ts_mov_b32 m0, %0" : "=&s"(keep) : "v"(gsrc), "s"(lds_dst) : "memory"); }
__device__ __forceinline__ float max3f(float a, float b, float c) { float r; asm("v_max3_f32 %0, %1, %2, %3" : "=v"(r) : "v"(a), "v"(b), "v"(c)); return r; }
__device__ __forceinline__ float max2f(float a, float b) { float r; asm("v_max_f32_e32 %0, %1, %2" : "=v"(r) : "v"(a), "v"(b)); return r; }
__device__ __forceinline__ float fadd_s(float a, float b) { float r; asm("v_add_f32_e32 %0, %1, %2" : "=v"(r) : "v"(a), "v"(b)); return r; }
__device__ __forceinline__ float fsub_s(float a, float b) { float r; asm("v_sub_f32_e32 %0, %1, %2" : "=v"(r) : "v"(a), "v"(b)); return r; }
typedef float f32x2_t __attribute__((ext_vector_type(2))); typedef __bf16 bf16x2_t __attribute__((ext_vector_type(2)));
__device__ __forceinline__ unsigned cvtpk_s(float lo, float hi) { f32x2_t v = {lo, hi}; bf16x2_t b = __builtin_convertvector(v, bf16x2_t); return __builtin_bit_cast(unsigned, b); }
#define WAIT_BAR(N) asm volatile("s_waitcnt vmcnt(" #N ") lgkmcnt(0)\n\ts_barrier" ::: "memory")
__device__ __forceinline__ void qkt(f32x16& p0, f32x16& p1, lds_cptr Kslot, const bf16x8* qr, const f32x16& negm, int r32, int hi) {
    const lds_cptr kb = Kslot + hi * 1024 + r32 * 16;
#pragma unroll
    for (int d0 = 0; d0 < 4; ++d0) {
        const bf16x8 b0 = *(const __attribute__((address_space(3))) bf16x8*)(kb + d0 * 2048);
        const bf16x8 b1 = *(const __attribute__((address_space(3))) bf16x8*)(kb + d0 * 2048 + 512);
        if (d0 == 0) { p0 = __builtin_amdgcn_mfma_f32_32x32x16_bf16(b0, qr[0], negm, 0, 0, 0); p1 = __builtin_amdgcn_mfma_f32_32x32x16_bf16(b1, qr[0], negm, 0, 0, 0); }
        else { p0 = __builtin_amdgcn_mfma_f32_32x32x16_bf16(b0, qr[d0], p0, 0, 0, 0); p1 = __builtin_amdgcn_mfma_f32_32x32x16_bf16(b1, qr[d0], p1, 0, 0, 0); }
    }
}
__device__ __forceinline__ void kload8(bf16x8* kf, lds_cptr kp) {
    kf[0] = *(const __attribute__((address_space(3))) bf16x8*)(kp);        kf[1] = *(const __attribute__((address_space(3))) bf16x8*)(kp + 512);
    kf[2] = *(const __attribute__((address_space(3))) bf16x8*)(kp + 2048); kf[3] = *(const __attribute__((address_space(3))) bf16x8*)(kp + 2560);
    kf[4] = *(const __attribute__((address_space(3))) bf16x8*)(kp + 4096); kf[5] = *(const __attribute__((address_space(3))) bf16x8*)(kp + 4608);
    kf[6] = *(const __attribute__((address_space(3))) bf16x8*)(kp + 6144); kf[7] = *(const __attribute__((address_space(3))) bf16x8*)(kp + 6656);
}
__device__ __forceinline__ void kload2(bf16x8* kf, lds_cptr kp, int j) { kf[2 * j] = *(const __attribute__((address_space(3))) bf16x8*)(kp + j * 2048); kf[2 * j + 1] = *(const __attribute__((address_space(3))) bf16x8*)(kp + j * 2048 + 512); }
__device__ __forceinline__ s16x4 vtr(lds_cptr p) { return __builtin_bit_cast(s16x4, __builtin_amdgcn_ds_read_tr16_b64_v4i16((__attribute__((address_space(3))) v4i16_t*)p)); }
__device__ __forceinline__ float rowmax(const f32x16& p0, const f32x16& p1) {
    float a = max3f(p0[0], p0[1], p1[0]), b = max3f(p0[2], p0[3], p1[1]); a = max3f(a, p1[2], p1[3]);
#pragma unroll
    for (int r = 4; r < 16; r += 4) { a = max3f(a, p0[r], p0[r + 1]); b = max3f(b, p0[r + 2], p0[r + 3]); a = max3f(a, p1[r], p1[r + 1]); b = max3f(b, p1[r + 2], p1[r + 3]); }
    const float m = max2f(a, b);
    auto rr = __builtin_amdgcn_permlane32_swap(__float_as_uint(m), __float_as_uint(m), false, false);
    return max2f(__uint_as_float(rr[0]), __uint_as_float(rr[1]));
}
__device__ __forceinline__ void pv(f32x16* o, int vb, bf16x8 pa0, bf16x8 pa1, bf16x8 pa2, bf16x8 pa3) {
#pragma unroll
    for (int d0 = 0; d0 < 2; ++d0) { s16x4 lo[4], hi[4];
#pragma unroll
        for (int ks = 0; ks < 4; ++ks) {
            asm volatile("ds_read_b64_tr_b16 %0,%1 offset:%c2" : "=&v"(lo[ks]) : "v"(vb), "i"(d0 * 4096 + ks * 1024) : "memory");
            asm volatile("ds_read_b64_tr_b16 %0,%1 offset:%c2" : "=&v"(hi[ks]) : "v"(vb), "i"(d0 * 4096 + ks * 1024 + 512) : "memory"); }
        asm volatile("s_waitcnt lgkmcnt(0)" ::: "memory"); SBAR();
#define PK(k) (bf16x8){lo[k][0], lo[k][1], lo[k][2], lo[k][3], hi[k][0], hi[k][1], hi[k][2], hi[k][3]}
        o[d0] = __builtin_amdgcn_mfma_f32_32x32x16_bf16(pa0, PK(0), o[d0], 0, 0, 0);
        o[d0] = __builtin_amdgcn_mfma_f32_32x32x16_bf16(pa1, PK(1), o[d0], 0, 0, 0);
        o[d0] = __builtin_amdgcn_mfma_f32_32x32x16_bf16(pa2, PK(2), o[d0], 0, 0, 0);
        o[d0] = __builtin_amdgcn_mfma_f32_32x32x16_bf16(pa3, PK(3), o[d0], 0, 0, 0);
#undef PK
    }
}
__device__ __forceinline__ void wmask(f32x16& p0, f32x16& p1, int dl, int r32, int hi) {
    const float NEG = -INFINITY;
#pragma unroll
    for (int r = 0; r < 16; ++r) { const int rel = dl + crow(r, hi) - r32; if (rel < -128 || rel > 128) p0[r] = NEG; if (rel + 32 < -128 || rel + 32 > 128) p1[r] = NEG; }
}

template <int THRL> __device__ __forceinline__ void attn_unit(int b, int n, int kvh, int hp, int base, bool primed, bool has_next, int nb, int nn, int nkvh, int nhp, bf16x8 (&qr)[4], int& nbase,
                                                              const bf16_t* Y, bf16_t* O, int ldo, const bf16_t* KB, const bf16_t* VB, const float* sink, LAS unsigned char* shm) {
    const int tid = threadIdx.x, lane = tid & 63, r32 = lane & 31, hi = lane >> 5; const int wid = __builtin_amdgcn_readfirstlane(tid >> 6);
    const int head = kvh * 4 + hp * 2 + (wid >> 2), qsub = wid & 3;
    const long qrow0 = (long)b * SEQ + n * 128 + qsub * 32;
    const bf16_t* Qw = Y + qrow0 * 2048 + 1024 + head * 64;
    const unsigned lds0 = (unsigned)(uintptr_t)shm;
    LAS float* wsf = (LAS float*)(shm + LDS_WS) + wid * 64;
    const long koff = (long)lane * 256 + kvh * 64 + wid * 8;
    const long voff = (long)(16 * (wid & 3) + (lane >> 2)) * 256 + kvh * 64 + (wid >> 2) * 32 + (lane & 3) * 8;
    const unsigned kdst = lds0 + LDS_K + wid * 1024, vdst = lds0 + LDS_V + wid * 1024;
    const int jlo = (n == 0) ? 2 : 0, jhi = (n == 31) ? 3 : 5, NT = 4 + (jhi - jlo + 1);
    const long lrow0 = (long)b * SEQ + (n - 1) * 128 + 64 * (jlo - 4), crow0 = (long)NTOK + b * CTXL;
#define TROW(t) ((t) < 4 ? crow0 + 64 * (t) : lrow0 + 64 * (t))
#define DMA_K(t, slot) glds16(KB + TROW(t) * 256 + koff, (unsigned)__builtin_amdgcn_readfirstlane(kdst + (slot)))
#define DMA_V(t, slot) glds16(VB + TROW(t) * 256 + voff, (unsigned)__builtin_amdgcn_readfirstlane(vdst + (slot)))
    const int vb0 = (int)(lds0 + LDS_V) + ((lane >> 4) & 1) * 32 + (lane & 3) * 8 + (4 * hi + ((lane & 15) >> 2)) * 64;
    bf16x8 kf[8];
    const lds_cptr shm3 = (lds_cptr)shm; const lds_cptr kp0 = shm3 + LDS_K + hi * 1024 + r32 * 16; const lds_cptr vp0 = shm3 + LDS_V + ((lane >> 4) & 1) * 32 + (lane & 3) * 8 + (4 * hi + ((lane & 15) >> 2)) * 64;
    const int s0 = base, s1 = (s0 == (NSLOT - 1) * SLOTB) ? 0 : s0 + SLOTB, s2 = (s1 == (NSLOT - 1) * SLOTB) ? 0 : s1 + SLOTB;
    if (!primed) {
        DMA_K(0, s0); DMA_V(0, s0); DMA_K(1, s1); DMA_K(2, s2);
#pragma unroll
        for (int d0 = 0; d0 < 4; ++d0) qr[d0] = *(const bf16x8*)(Qw + (long)r32 * 2048 + d0 * 16 + hi * 8);
    }
    float mhat = 0.f, l_reg = 0.f; f32x16 o[2]; o[0] = f32x16{}; o[1] = f32x16{}; f32x16 negm = f32x16{}; asm volatile("" : "+v"(negm));
    const int dq = -128 - 32 * qsub;
#define CMASK(P0, P1, t) do { if ((t) >= 4) { const int dl_ = 64 * (jlo + (t) - 4) + dq; if (dl_ < -97 || dl_ > 65) wmask(P0, P1, dl_, r32, hi); } } while (0)
    bool resc = false;
#define START(P0, P1) do { const float rm = rowmax(P0, P1); resc = false; \
    { const float dl = rm; mhat = fadd_s(mhat, dl); \
      _Pragma("unroll") for (int r = 0; r < 16; ++r) { P0[r] = fsub_s(P0[r], dl); P1[r] = fsub_s(P1[r], dl); } \
      _Pragma("unroll") for (int r = 0; r < 16; ++r) negm[r] = -mhat; asm volatile("" : "+v"(negm)); } \
    _Pragma("unroll") for (int r = 0; r < 16; ++r) P0[r] = __builtin_amdgcn_exp2f(P0[r]); } while (0)
#define RESC() do { if (resc) { asm volatile("s_waitcnt lgkmcnt(0)" ::: "memory"); \
      _Pragma("unroll") for (int d_ = 0; d_ < 2; ++d_) _Pragma("unroll") for (int r = 0; r < 16; ++r) o[d_][r] *= wsf[crow(r, hi)]; } } while (0)
    f32x16 pA0, pA1, pB0, pB1;
    int sl_prev = s0, sl_cur = s0, sl_next = s1;
#define ROT() do { sl_prev = sl_cur; sl_cur = sl_next; sl_next = (sl_next == (NSLOT - 1) * SLOTB) ? 0 : sl_next + SLOTB; } while (0)
    WAIT_BAR(7);
    qkt(pA0, pA1, shm3 + LDS_K + s0, qr, negm, r32, hi); asm volatile("s_nop 15\n\ts_nop 7" : "+v"(pA0), "+v"(pA1)); CMASK(pA0, pA1, 0);
    START(pA0, pA1);
    _Pragma("unroll") for (int r = 0; r < 16; ++r) pA1[r] = __builtin_amdgcn_exp2f(pA1[r]);
    WAIT_BAR(0);
    DMA_K(3, s0); DMA_V(1, s1);
    ROT();
    kload8(kf, kp0 + sl_cur);
    WAIT_BAR(2);
    s16x4 vlo[8], vhi[8]; u32x4 pw0, pw1, pw2, pw3;
#define PKW(P, B) cvtpk_s(P[B], P[B + 1])
#define PAF(k) __builtin_bit_cast(bf16x8, pw##k)
#define VFR(i) (bf16x8){vlo[i][0], vlo[i][1], vlo[i][2], vlo[i][3], vhi[i][0], vhi[i][1], vhi[i][2], vhi[i][3]}
#define PIN(x) asm volatile("" : "+v"(x))
#define MX3(a, b, c) __builtin_fmaxf(__builtin_fmaxf((a), (b)), (c))
#define GAPA(MF, A0, A1, A2, A3, W0, W1, PW) do { MF; sacc += A0; sacc += A1; sacc += A2; sacc += A3; PIN(sacc); W0; W1; PIN(PW); SBAR(); } while (0)
#define EX(v) __builtin_amdgcn_exp2f(v)
#define GAPB(MF, X, B) do { MF; X[B] = EX(X[B]); X[B + 1] = EX(X[B + 1]); X[B + 2] = EX(X[B + 2]); X[B + 3] = EX(X[B + 3]); PIN(X); SBAR(); } while (0)
#define VRD(i) do { vlo[i] = vtr(vp_ + (((i) >> 2) * 4096 + ((i) & 3) * 1024)); vhi[i] = vtr(vp_ + (((i) >> 2) * 4096 + ((i) & 3) * 1024 + 512)); } while (0)
#define KRD(G, j) do { if (G) { kload2(kf, kp0 + sl_next, j); SBAR(); } } while (0)
#define STEP(C0, C1, P0, P1, t, GK, GV, GL) do { SBAR(); \
    const lds_cptr vp_ = vp0 + sl_prev; \
    VRD(0); SBAR(); float sacc = (P0[0] + P0[1]); \
    GAPA(C0 = __builtin_amdgcn_mfma_f32_32x32x16_bf16(kf[0], qr[0], negm, 0, 0, 0), P0[2], P0[3], P0[4], P0[5],     pw0[0] = PKW(P0, 0), pw0[1] = PKW(P0, 2), pw0); \
    VRD(4); SBAR(); GAPA(C1 = __builtin_amdgcn_mfma_f32_32x32x16_bf16(kf[1], qr[0], negm, 0, 0, 0), P0[6], P0[7], P0[8], P0[9],     pw0[2] = PKW(P0, 4), pw0[3] = PKW(P0, 6), pw0); \
    VRD(1); SBAR(); GAPA(C0 = __builtin_amdgcn_mfma_f32_32x32x16_bf16(kf[2], qr[1], C0, 0, 0, 0),   P0[10], P0[11], P0[12], P0[13], pw1[0] = PKW(P0, 8), pw1[1] = PKW(P0, 10), pw1); \
    VRD(5); SBAR(); GAPA(C1 = __builtin_amdgcn_mfma_f32_32x32x16_bf16(kf[3], qr[1], C1, 0, 0, 0),   P0[14], P0[15], P1[0], P1[1],   pw1[2] = PKW(P0, 12), pw1[3] = PKW(P0, 14), pw1); \
    VRD(2); SBAR(); GAPA(C0 = __builtin_amdgcn_mfma_f32_32x32x16_bf16(kf[4], qr[2], C0, 0, 0, 0),   P1[2], P1[3], P1[4], P1[5],     pw2[0] = PKW(P1, 0), pw2[1] = PKW(P1, 2), pw2); \
    VRD(6); SBAR(); GAPA(C1 = __builtin_amdgcn_mfma_f32_32x32x16_bf16(kf[5], qr[2], C1, 0, 0, 0),   P1[6], P1[7], P1[8], P1[9],     pw2[2] = PKW(P1, 4), pw2[3] = PKW(P1, 6), pw2); \
    VRD(3); SBAR(); GAPA(C0 = __builtin_amdgcn_mfma_f32_32x32x16_bf16(kf[6], qr[3], C0, 0, 0, 0),   P1[10], P1[11], P1[12], P1[13], pw3[0] = PKW(P1, 8), pw3[1] = PKW(P1, 10), pw3); \
    VRD(7); SBAR(); GAPA(C1 = __builtin_amdgcn_mfma_f32_32x32x16_bf16(kf[7], qr[3], C1, 0, 0, 0),   P1[14], P1[15], 0.f, 0.f,       pw3[2] = PKW(P1, 12), pw3[3] = PKW(P1, 14), pw3); \
    l_reg += sacc; \
    if (GK) { DMA_K((t) + 3, sl_cur); } if (GV) { DMA_V((t) + 1, sl_next); } \
    CMASK(C0, C1, t); \
    { float a = MX3(C0[0], C0[1], C1[0]), b2 = MX3(C0[2], C0[3], C1[1]); a = MX3(a, C1[2], C1[3]); \
      _Pragma("unroll") for (int r = 4; r < 16; r += 4) { a = MX3(a, C0[r], C0[r + 1]); b2 = MX3(b2, C0[r + 2], C0[r + 3]); a = MX3(a, C1[r], C1[r + 1]); b2 = MX3(b2, C1[r + 2], C1[r + 3]); } \
      float rm = __builtin_fmaxf(a, b2); { auto rr = __builtin_amdgcn_permlane32_swap(__float_as_uint(rm), __float_as_uint(rm), false, false); rm = __builtin_fmaxf(__uint_as_float(rr[0]), __uint_as_float(rr[1])); } \
      resc = false; \
      if (__builtin_expect(__any(rm > (float)THRL), 0)) { const float dl = __builtin_fmaxf(rm, 0.f); mhat += dl; \
        _Pragma("unroll") for (int r = 0; r < 16; ++r) { C0[r] -= dl; C1[r] -= dl; } \
        _Pragma("unroll") for (int r = 0; r < 16; ++r) negm[r] = -mhat; asm volatile("" : "+v"(negm)); \
        const float f = __builtin_amdgcn_exp2f(-dl); l_reg *= f; if (hi == 0) wsf[r32] = f; resc = true; } } \
    SBAR(); \
    GAPB(o[0] = __builtin_amdgcn_mfma_f32_32x32x16_bf16(PAF(0), VFR(0), o[0], 0, 0, 0), C0, 0); \
    GAPB(o[1] = __builtin_amdgcn_mfma_f32_32x32x16_bf16(PAF(0), VFR(4), o[1], 0, 0, 0), C0, 4); \
    KRD(GL, 0); GAPB(o[0] = __builtin_amdgcn_mfma_f32_32x32x16_bf16(PAF(1), VFR(1), o[0], 0, 0, 0), C0, 8); \
    KRD(GL, 1); GAPB(o[1] = __builtin_amdgcn_mfma_f32_32x32x16_bf16(PAF(1), VFR(5), o[1], 0, 0, 0), C0, 12); \
    KRD(GL, 2); GAPB(o[0] = __builtin_amdgcn_mfma_f32_32x32x16_bf16(PAF(2), VFR(2), o[0], 0, 0, 0), C1, 0); \
    KRD(GL, 3); GAPB(o[1] = __builtin_amdgcn_mfma_f32_32x32x16_bf16(PAF(2), VFR(6), o[1], 0, 0, 0), C1, 4); \
    GAPB(o[0] = __builtin_amdgcn_mfma_f32_32x32x16_bf16(PAF(3), VFR(3), o[0], 0, 0, 0), C1, 8); \
    GAPB(o[1] = __builtin_amdgcn_mfma_f32_32x32x16_bf16(PAF(3), VFR(7), o[1], 0, 0, 0), C1, 12); \
    } while (0)
#define ENDW(tt) do { if ((tt) + 3 < NT) { WAIT_BAR(2); } else if ((tt) + 2 < NT) { WAIT_BAR(1); } else { WAIT_BAR(0); } } while (0)
    int t = 1;
    for (; t + 1 < NT; t += 2) {
        STEP(pB0, pB1, pA0, pA1, t, (t + 3 < NT), (t + 1 < NT), (t + 1 < NT));       ENDW(t);     RESC(); ROT();
        STEP(pA0, pA1, pB0, pB1, t + 1, (t + 4 < NT), (t + 2 < NT), (t + 2 < NT));   ENDW(t + 1); RESC(); ROT();
    }
    nbase = sl_next;
    if (has_next) {
        const long nr = (long)NTOK + nb * CTXL; const long nko = (long)lane * 256 + nkvh * 64 + wid * 8, nvo = (long)(16 * (wid & 3) + (lane >> 2)) * 256 + nkvh * 64 + (wid >> 2) * 32 + (lane & 3) * 8;
        const int n0 = sl_next, n1 = (n0 == (NSLOT - 1) * SLOTB) ? 0 : n0 + SLOTB, n2 = (n1 == (NSLOT - 1) * SLOTB) ? 0 : n1 + SLOTB;
        glds16(KB + nr * 256 + nko, (unsigned)__builtin_amdgcn_readfirstlane(kdst + n0)); glds16(VB + nr * 256 + nvo, (unsigned)__builtin_amdgcn_readfirstlane(vdst + n0));
        glds16(KB + (nr + 64) * 256 + nko, (unsigned)__builtin_amdgcn_readfirstlane(kdst + n1)); glds16(KB + (nr + 128) * 256 + nko, (unsigned)__builtin_amdgcn_readfirstlane(kdst + n2));
    }
    STEP(pB0, pB1, pA0, pA1, NT - 1, false, false, false); RESC();
    { float sacc = pB0[0] + pB0[1]; _Pragma("unroll") for (int r = 2; r < 16; ++r) sacc += pB0[r]; _Pragma("unroll") for (int r = 0; r < 16; ++r) sacc += pB1[r]; l_reg += sacc;
      pw0 = (u32x4){PKW(pB0, 0), PKW(pB0, 2), PKW(pB0, 4), PKW(pB0, 6)}; pw1 = (u32x4){PKW(pB0, 8), PKW(pB0, 10), PKW(pB0, 12), PKW(pB0, 14)}; pw2 = (u32x4){PKW(pB1, 0), PKW(pB1, 2), PKW(pB1, 4), PKW(pB1, 6)}; pw3 = (u32x4){PKW(pB1, 8), PKW(pB1, 10), PKW(pB1, 12), PKW(pB1, 14)};
      SBAR(); pv(o, vb0 + sl_cur, PAF(0), PAF(1), PAF(2), PAF(3)); }
    if (has_next) {
        asm volatile("" ::: "memory");
        const bf16_t* nQw = Y + ((long)nb * SEQ + nn * 128 + qsub * 32) * 2048 + 1024 + (nkvh * 4 + nhp * 2 + (wid >> 2)) * 64;
#pragma unroll
        for (int d0 = 0; d0 < 4; ++d0) qr[d0] = *(const bf16x8*)(nQw + (long)r32 * 2048 + d0 * 16 + hi * 8);
    }
    { auto rr = __builtin_amdgcn_permlane32_swap(__float_as_uint(l_reg), __float_as_uint(l_reg), false, false); l_reg = __uint_as_float(rr[0]) + __uint_as_float(rr[1]); }
    l_reg += __builtin_amdgcn_exp2f(fminf(sink[head] * LOG2E - mhat, 80.f));
    if (hi == 0) wsf[32 + r32] = l_reg; asm volatile("s_waitcnt lgkmcnt(0)" ::: "memory");
    float rli[16];
#pragma unroll
    for (int r = 0; r < 16; ++r) rli[r] = __builtin_amdgcn_rcpf(wsf[32 + crow(r, hi)]);
    bf16_t* Ow = O + qrow0 * ldo + head * 64;
    { LAS bf16_t* stg = (LAS bf16_t*)(shm + LDS_OST) + wid * 2048;
#pragma unroll
      for (int r = 0; r < 16; ++r) { const int orow = crow(r, hi);
#pragma unroll
          for (int d0 = 0; d0 < 2; ++d0) stg[orow * 64 + d0 * 32 + r32] = (bf16_t)(pk2(o[d0][r] * rli[r], 0.f) & 0xffffu); }
      asm volatile("s_waitcnt lgkmcnt(0)" ::: "memory");
#pragma unroll
      for (int i = 0; i < 4; ++i) { const int row = i * 8 + (lane >> 3), ch = lane & 7; const u32x4 v = *(const LAS u32x4*)(stg + row * 64 + ch * 8); *(u32x4*)(Ow + (long)row * ldo + ch * 8) = v; } }
    asm volatile("s_waitcnt lgkmcnt(0)\n\ts_barrier" ::: "memory");
#undef TROW
#undef DMA_K
#undef DMA_V
#undef CMASK
#undef START
#undef RESC
#undef ROT
#undef PKW
#undef PAF
#undef VFR
#undef PIN
#undef MX3
#undef GAPA
#undef GAPB
#undef EX
#undef VRD
#undef KRD
#undef STEP
#undef ENDW
}
#undef SBAR
#undef WAIT_BAR
}

#define XB_TMO      128
#define XB_XCNT(j)  (256  + 64 * (j))
#define XB_XSUB(j)  (1280 + 64 * (j))
#define XB_XGEN(j)  (2304 + 64 * (j))
#define XB_TOP      3328
#define XB_TOPGEN   3392
#define XCD_BAR_WORDS 3456
#define XB_SPIN_CAP (1u << 18)
__device__ __forceinline__ unsigned xb_ld(unsigned* p)              { return __hip_atomic_load(p, __ATOMIC_RELAXED, __HIP_MEMORY_SCOPE_AGENT); }
__device__ __forceinline__ unsigned xb_add(unsigned* p, unsigned v) { return __hip_atomic_fetch_add(p, v, __ATOMIC_RELAXED, __HIP_MEMORY_SCOPE_AGENT); }
__device__ __forceinline__ unsigned xb_xcc_id() { return (unsigned)__builtin_amdgcn_s_getreg((3 << 11) | 20) & 0xFu; }
#define XB_SPIN(cond, bar) do { unsigned _sp = 0; while (cond) { __builtin_amdgcn_s_sleep(1); \
    if ((++_sp & 255u) == 0u) { if (xb_ld(&(bar)[XB_TMO])) break; if (_sp > XB_SPIN_CAP) { atomicAdd(&(bar)[XB_TMO], 1u); break; } } } } while (0)
struct XcdBarrier { unsigned* bar; unsigned x; volatile LAS unsigned* st; };
__device__ __forceinline__ XcdBarrier xcd_barrier_post(unsigned* bar, volatile LAS unsigned* st) {
    XcdBarrier b; b.bar = bar; b.x = xb_xcc_id(); b.st = st;
    if (threadIdx.x == 0) (void)xb_add(&bar[XB_XCNT(b.x)], 1u);
    return b;
}
__device__ __forceinline__ void xcd_barrier_complete(unsigned* bar, unsigned x, unsigned& nloc, unsigned& nx) {
    const unsigned G = gridDim.x * gridDim.y * gridDim.z;
    unsigned sum, cnt, mine, sp = 0u;
    for (;;) {
        sum = 0u; cnt = 0u; mine = 0u;
#pragma unroll
        for (unsigned j = 0; j < 16; ++j) { const unsigned c = xb_ld(&bar[XB_XCNT(j)]); sum += c; cnt += (c > 0u) ? 1u : 0u; mine = (j == x) ? c : mine; }
        if (sum == G) break;
        __builtin_amdgcn_s_sleep(1);
        if ((++sp & 255u) == 0u) { if (xb_ld(&bar[XB_TMO])) break; if (sp > XB_SPIN_CAP) { atomicAdd(&bar[XB_TMO], 1u); break; } }
    }
    nloc = mine > 0u ? mine : 1u; nx = cnt > 0u ? cnt : 1u;
}
__device__ __forceinline__ void xcd_barrier(const XcdBarrier& b) {
    asm volatile("s_waitcnt vmcnt(0)" ::: "memory");
    __syncthreads();
    if (threadIdx.x == 0) {
        unsigned* bar = b.bar;
        __builtin_amdgcn_s_waitcnt(0);
        unsigned nloc = b.st[0], nx = b.st[1];
        if (nloc == 0u) { xcd_barrier_complete(bar, b.x, nloc, nx); b.st[0] = nloc; b.st[1] = nx; }
        const unsigned old = xb_add(&bar[XB_XSUB(b.x)], 1u);
        const unsigned gen = old / nloc;
        if (old + 1u == (gen + 1u) * nloc) {
            __builtin_amdgcn_fence(__ATOMIC_RELEASE, "agent");
            asm volatile("s_waitcnt vmcnt(0)" ::: "memory");
            const unsigned og = xb_add(&bar[XB_TOP], 1u);
            const unsigned tg = og / nx;
            if (og + 1u == (tg + 1u) * nx) xb_add(&bar[XB_TOPGEN], 1u);
            else XB_SPIN(xb_ld(&bar[XB_TOPGEN]) == tg, bar);
            __builtin_amdgcn_fence(__ATOMIC_ACQUIRE, "agent");
            xb_add(&bar[XB_XGEN(b.x)], 1u);
            asm volatile("s_waitcnt vmcnt(0)" ::: "memory");
        } else {
            XB_SPIN(xb_ld(&bar[XB_XGEN(b.x)]) == gen, bar);
            __builtin_amdgcn_fence(__ATOMIC_ACQUIRE, "agent");
            asm volatile("s_waitcnt vmcnt(0)" ::: "memory");
        }
    }
    __syncthreads();
}
constexpr int LDSCTL_OFF = LDS_BYTES - 256;
constexpr int CW_BAR = 4096;

#ifndef PROBE_GMLP2
#define PROBE_GMLP2 0
#endif
#ifndef ATT_PIPE
#define ATT_PIPE 1
#endif
#ifndef ATT_THRL
#define ATT_THRL 8
#endif
#ifndef ONE_LAUNCH
#define ONE_LAUNCH 1
#endif
#ifndef FAST_MIX
#define FAST_MIX 1
#endif
#ifndef PROBE_SEQ
#define PROBE_SEQ 0, 1, 2, 3, 4, 5, 6, 7, 8, 9, 10, 11
#endif

enum { PH_PRO = 0, PH_HN, PH_IN, PH_MIX, PH_A, PH_O, PH_H2R, PH_WCONV, PH_TOPK, PH_GU, PH_D, PH_FIN, PH_COUNT };

__global__ void __launch_bounds__(NTHREADS, 2) fwd(Args args) {
    extern __shared__ __attribute__((aligned(16))) unsigned char lds_raw[];
    LAS unsigned char* lds = (LAS unsigned char*)lds_raw;
    const int tid = threadIdx.x, lane = tid & 63, wave = __builtin_amdgcn_readfirstlane(tid >> 6);
    const int G = gridDim.x, bid = blockIdx.x;
    unsigned char* ws = args.ws;
    const int lo = args.ph_lo, hi = args.ph_hi;
#define IN(k) (lo <= (k) && (k) < hi)
    float* MOD = (float*)(ws + WS_MOD); f32x2* ROPE = (f32x2*)(ws + WS_ROPE);
    float* AFFT = (float*)(ws + WS_AFFT); int* TOPI = (int*)(ws + WS_TOPI); float* TOPW = (float*)(ws + WS_TOPW); int* SLOT = (int*)(ws + WS_SLOT);
    bf16_t* WSP = (bf16_t*)(ws + WS_WSP); bf16_t* WIN = (bf16_t*)(ws + WS_WIN); bf16_t* WAB = (bf16_t*)(ws + WS_WAB); bf16_t* WO = (bf16_t*)(ws + WS_WO);
    bf16_t* H = (bf16_t*)(ws + WS_H); bf16_t* VA = (bf16_t*)(ws + WS_VA); bf16_t* KB = (bf16_t*)(ws + WS_KB); bf16_t* VB = (bf16_t*)(ws + WS_VB);
    bf16_t* GT = (bf16_t*)(ws + WS_G); bf16_t* Y = (bf16_t*)(ws + WS_Y); bf16_t* TMP = (bf16_t*)(ws + WS_TMP); bf16_t* MERGED = (bf16_t*)(ws + WS_MERGED);
    bf16_t* WGU = (bf16_t*)(ws + WS_WGU); bf16_t* WD = (bf16_t*)(ws + WS_WD); bf16_t* H2 = (bf16_t*)(ws + WS_H2); bf16_t* ACT = (bf16_t*)(ws + WS_ACT); bf16_t* YB = (bf16_t*)(ws + WS_YB);
    const int gw = bid * NWAVES + wave, NGW = G * NWAVES;
    if (tid < 64) ((LAS unsigned*)(lds + LDSCTL_OFF))[tid] = 0u;
    __syncthreads();
    XcdBarrier bar; bar.bar = (unsigned*)(ws + WS_CTL) + CW_BAR; bar.x = 0; bar.st = nullptr;
    if (ONE_LAUNCH) bar = xcd_barrier_post((unsigned*)(ws + WS_CTL) + CW_BAR, (volatile LAS unsigned*)(lds + LDSCTL_OFF));
#define SEAM(k) do { if (ONE_LAUNCH && IN(k) && IN((k) + 1)) xcd_barrier(bar); } while (0)

    if (IN(PH_PRO)) {
        if (bid < 192) adaln_task(bid, args.in[I_C], args.in[I_CCTX], args.in[I_WADA], args.in[I_BADA], MOD, (LAS float*)lds, tid);
        else if (bid == 192) rope_table(ROPE, tid);
        __syncthreads();
        for (int i = bid * NTHREADS + tid; i < 8 * 128 * 128 / 4; i += G * NTHREADS) st4bf(WSP + 4 * i, *(const f32x4*)(args.in[I_WSP] + 4 * i));
        LAS float* scr = (LAS float*)(lds + wave * 16384);
        constexpr int I_IN = 16 * 176, I_P = 16 * 32;
        for (int it = gw; it < I_IN + 3 * I_P; it += NGW) {
            int r = it;
            if (r < I_IN) { const int kb = r / 176, nb = r % 176; transpose_item(args.in[I_WIN], INCOLS, kb * 64, nb * 32, WIN + (size_t)(nb * 32) * 1024 + kb * 64, 1024, scr, lane); continue; } r -= I_IN;
            if (r < I_P) { const int kb = r / 32, nb = r % 32; transpose_item(args.in[I_WPA], 1024, kb * 64, nb * 32, WAB + (size_t)(nb * 32) * 2048 + kb * 64, 2048, scr, lane); continue; } r -= I_P;
            if (r < I_P) { const int kb = r / 32, nb = r % 32; transpose_item(args.in[I_WPB], 1024, kb * 64, nb * 32, WAB + (size_t)(nb * 32) * 2048 + 1024 + kb * 64, 2048, scr, lane); continue; } r -= I_P;
            { const int kb = r / 32, nb = r % 32; transpose_item(args.in[I_WOUT], 1024, kb * 64, nb * 32, WO + (size_t)(nb * 32) * 1024 + kb * 64, 1024, scr, lane); }
        }
    }
    SEAM(PH_PRO);
    if (IN(PH_HN)) {
        const float* g1n = args.in[I_N1G];
        auto hn_row = [&](int row) {
            const float* xr; int mrow;
            if (row < NTOK) { xr = args.in[I_X] + (size_t)row * 1024; mrow = row >> 12; } else { xr = args.in[I_CTX] + (size_t)(row - NTOK) * 1024; mrow = 8; }
            const float* sh = MOD + mrow * 6144; const float* sc = sh + 1024;
            f32x4 v[4]; float ss = 0.f;
#pragma unroll
            for (int j = 0; j < 4; ++j) { v[j] = *(const f32x4*)(xr + 4 * lane + 256 * j); ss += (v[j].x * v[j].x + v[j].y * v[j].y) + (v[j].z * v[j].z + v[j].w * v[j].w); }
            const float rstd = 1.0f / sqrtf(wave_sum(ss) * (1.f / 1024.f) + EPS);
#pragma unroll
            for (int j = 0; j < 4; ++j) {
                const int col = 4 * lane + 256 * j;
                const f32x4 gv = *(const f32x4*)(g1n + col), scv = *(const f32x4*)(sc + col), shv = *(const f32x4*)(sh + col);
                const f32x4 h = (v[j] * rstd * gv) * (1.f + scv) + shv;
                st4bf(H + (size_t)row * 1024 + col, h);
            }
        };
        for (int row = gw; row < NROWS_H; row += NGW) hn_row(row);
    }
    SEAM(PH_HN);
    if (IN(PH_IN)) {
        Gemm g{H, WIN, 1024, 1024, 1024, 0, 30, nullptr}; StaticOrder S; S.init(NTOK, INCOLS, G, bid, 16);
        EpiIn E{Y, VA, KB, VB, GT, args.in[I_BMG], ROPE, (f32x2*)(ws + WS_STATS)};
        GEMM_PHASE<EpiIn, StaticOrder, false>(lds, g, S, E);
    }
    SEAM(PH_IN);
    if (IN(PH_MIX) && FAST_MIX) {
        if (!(args.flags & 8)) for (int task = bid; task < NB * 32; task += G) mix::gmlp_unit(task, Y, (args.flags & 2) ? TMP : Y, (args.flags & 2) ? 1024 : 2048, VA, WSP, (const f32x2*)(ws + WS_STATS), args.in[I_LNG], args.in[I_LNB], args.in[I_BSP], lds);
#if ATT_PIPE
        att2::bf16x8 att_qr[4]; int att_base = 0; bool att_primed = false;
#endif
        if (!(args.flags & 1)) for (int task = bid; task < NB * 32 * 4; task += G) {
#if ATT_PIPE
            for (int hp = 0; hp < 2; ++hp) {
                const bool more = (hp == 0) || (task + G < NB * 32 * 4); const int ntask = hp == 0 ? task : task + G; int nbase_ = 0;
                att2::attn_unit<ATT_THRL>(task >> 7, (task >> 2) & 31, task & 3, hp, att_base, att_primed, more, ntask >> 7, (ntask >> 2) & 31, ntask & 3, hp ^ 1, att_qr, nbase_,
                                          Y, (args.flags & 4) ? TMP : Y + 1024, (args.flags & 4) ? 1024 : 2048, KB, VB, args.in[I_SINK], lds);
                att_base = nbase_; att_primed = more;
            }
#else
            mix::attn_unit(task >> 7, (task >> 2) & 31, task & 3, Y, (args.flags & 4) ? TMP : Y + 1024, (args.flags & 4) ? 1024 : 2048, KB, VB, args.in[I_SINK], lds);
#endif
        }
    }
    SEAM(PH_MIX);
    if (IN(PH_A)) {
        Gemm g{Y, WAB, 2048, 2048, 2048, 0, 30, nullptr}; StaticOrder S; S.init(NTOK, 1024, G, bid, 0, 1);
        EpiAB E{MERGED, GT};
        GEMM_PHASE<EpiAB, StaticOrder, false, true>(lds, g, S, E);
    }
    SEAM(PH_A);
    if (IN(PH_O)) {
        Gemm g{MERGED, WO, 1024, 1024, 1024, 0, 30, nullptr}; StaticOrder S; S.init(NTOK, 1024, G, bid);
        EpiO E{args.out, args.in[I_X], MOD};
        GEMM_PHASE<EpiO, StaticOrder, false>(lds, g, S, E);
    }
    SEAM(PH_O);
    if (IN(PH_H2R)) {
        LAS float* wT = (LAS float*)lds;
        { f32x4 wv[8];
#pragma unroll
          for (int k = 0; k < 8; ++k) wv[k] = *(const f32x4*)(args.in[I_WR] + 4 * (tid + NTHREADS * k));
#pragma unroll
          for (int k = 0; k < 8; ++k) { const int f = tid + NTHREADS * k, col = f >> 2, e0 = 4 * (f & 3); wT[e0 * 1024 + col] = wv[k].x; wT[(e0 + 1) * 1024 + col] = wv[k].y; wT[(e0 + 2) * 1024 + col] = wv[k].z; wT[(e0 + 3) * 1024 + col] = wv[k].w; } }
        __syncthreads();
        const float* g2n = args.in[I_N2G];
        const bool h32 = lane & 32, h16 = lane & 16, h8 = lane & 8, h4 = lane & 4;
        const int myexp = 8 * (lane >> 5) + 4 * ((lane >> 4) & 1) + 2 * ((lane >> 3) & 1) + ((lane >> 2) & 1);
        f32x4 vn[2][4];
#pragma unroll
        for (int q = 0; q < 2; ++q)
#pragma unroll
            for (int j = 0; j < 4; ++j) vn[q][j] = *(const f32x4*)(args.out + (size_t)(2 * (NTOK / 2 - 1 - (gw < NTOK / 2 ? gw : 0)) + q) * 1024 + 4 * lane + 256 * j);
        for (int rp = gw; rp < NTOK / 2; rp += NGW) {
            const int row0 = 2 * (NTOK / 2 - 1 - rp), b = row0 >> 12;
            const float* sh = MOD + b * 6144 + 3072; const float* sc = sh + 1024;
            f32x4 v[2][4]; float ss[2] = {0.f, 0.f};
#pragma unroll
            for (int q = 0; q < 2; ++q)
#pragma unroll
                for (int j = 0; j < 4; ++j) { v[q][j] = vn[q][j]; ss[q] += (v[q][j].x * v[q][j].x + v[q][j].y * v[q][j].y) + (v[q][j].z * v[q][j].z + v[q][j].w * v[q][j].w); }
            { const int rn = (rp + NGW < NTOK / 2) ? rp + NGW : rp;
#pragma unroll
              for (int q = 0; q < 2; ++q)
#pragma unroll
                  for (int j = 0; j < 4; ++j) vn[q][j] = *(const f32x4*)(args.out + (size_t)(2 * (NTOK / 2 - 1 - rn) + q) * 1024 + 4 * lane + 256 * j); }
            float rstd[2];
#pragma unroll
            for (int q = 0; q < 2; ++q) rstd[q] = 1.0f / sqrtf(wave_sum(ss[q]) * (1.f / 1024.f) + EPS);
            float lg[2][16];
#pragma unroll
            for (int q = 0; q < 2; ++q)
#pragma unroll
                for (int e = 0; e < 16; ++e) lg[q][e] = 0.f;
            f32x4 wb[2][4];
#pragma unroll
            for (int e = 0; e < 4; ++e) wb[0][e] = *(const LAS f32x4*)(wT + e * 1024 + 4 * lane);
            f32x4 h[2];
#pragma unroll
            for (int g = 0; g < 16; ++g) {
                const int j = g >> 2, eg = g & 3, col = 4 * lane + 256 * j;
                if (g + 1 < 16) {
                    const int jn = (g + 1) >> 2, en = (g + 1) & 3;
#pragma unroll
                    for (int e = 0; e < 4; ++e) wb[(g + 1) & 1][e] = *(const LAS f32x4*)(wT + (4 * en + e) * 1024 + 4 * lane + 256 * jn);
                }
                if (eg == 0) {
                    const f32x4 gv = *(const f32x4*)(g2n + col), scv = *(const f32x4*)(sc + col), shv = *(const f32x4*)(sh + col);
#pragma unroll
                    for (int q = 0; q < 2; ++q) { h[q] = (v[q][j] * rstd[q] * gv) * (1.f + scv) + shv; st4bf(H2 + (size_t)(row0 + q) * 1024 + col, h[q]); }
                }
#pragma unroll
                for (int e = 0; e < 4; ++e) {
                    const f32x4 w = wb[g & 1][e];
#pragma unroll
                    for (int q = 0; q < 2; ++q) lg[q][4 * eg + e] += (h[q].x * w.x + h[q].y * w.y) + (h[q].z * w.z + h[q].w * w.w);
                    asm volatile("" : "+v"(lg[0][4 * eg + e]), "+v"(lg[1][4 * eg + e]));
                }
                asm volatile("" ::: "memory");
            }
#pragma unroll
            for (int q = 0; q < 2; ++q) {
                float a8[8], a4[4], a2[2], a1;
#pragma unroll
                for (int i = 0; i < 8; ++i) { const float send = h32 ? lg[q][i] : lg[q][i + 8], keep = h32 ? lg[q][i + 8] : lg[q][i]; a8[i] = keep + __shfl_xor(send, 32); }
#pragma unroll
                for (int i = 0; i < 4; ++i) { const float send = h16 ? a8[i] : a8[i + 4], keep = h16 ? a8[i + 4] : a8[i]; a4[i] = keep + __shfl_xor(send, 16); }
#pragma unroll
                for (int i = 0; i < 2; ++i) { const float send = h8 ? a4[i] : a4[i + 2], keep = h8 ? a4[i + 2] : a4[i]; a2[i] = keep + __shfl_xor(send, 8); }
                { const float send = h4 ? a2[0] : a2[1], keep = h4 ? a2[1] : a2[0]; a1 = keep + __shfl_xor(send, 4); }
                a1 += __shfl_xor(a1, 2); a1 += __shfl_xor(a1, 1);
                float mx = a1;
#pragma unroll
                for (int o = 4; o < 64; o <<= 1) mx = fmaxf(mx, __shfl_xor(mx, o));
                const float p = __expf(a1 - mx); float den = p;
#pragma unroll
                for (int o = 4; o < 64; o <<= 1) den += __shfl_xor(den, o);
                if ((lane & 3) == 0) AFFT[(size_t)(b * 16 + myexp) * SEQ + ((row0 + q) & (SEQ - 1))] = p / den;
            }
        }
    }
    if (IN(PH_WCONV)) {
        __syncthreads();
        LAS float* scr = (LAS float*)(lds + wave * 16384);
        constexpr int I_G = 16 * 16 * 64, I_D = 16 * 32 * 32;
        auto item = [&](int it) -> TrItem {
            int r = it; TrItem t;
            if (r < 2 * I_G) {
                const int up = r >= I_G; if (up) r -= I_G;
                const int e = r >> 10, kb = (r >> 6) & 15, nb = r & 63, n0 = nb * 32;
                const int drow = 256 * (n0 >> 7) + (n0 & 127) + (up ? 128 : 0);
                t.src = args.in[up ? I_WEU : I_WEG] + (size_t)e * 1024 * 2048 + (size_t)(kb * 64) * 2048 + n0; t.N = 2048;
                t.dst = WGU + (size_t)e * 4096 * 1024 + (size_t)drow * 1024 + kb * 64; t.ldt = 1024;
            } else {
                r -= 2 * I_G;
                const int e = r >> 10, kb = (r >> 5) & 31, nb = r & 31;
                t.src = args.in[I_WED] + (size_t)e * 2048 * 1024 + (size_t)(kb * 64) * 1024 + nb * 32; t.N = 1024;
                t.dst = WD + (size_t)e * 1024 * 2048 + (size_t)(nb * 32) * 2048 + kb * 64; t.ldt = 2048;
            }
            return t;
        };
        constexpr int NIT = 2 * I_G + I_D;
        if (gw < NIT) {
            TrItem cur = item(gw); f32x4 vc[8], vn[8];
            tr_load(cur, vc, lane);
            for (int it = gw; it < NIT; it += NGW) {
                const bool more = it + NGW < NIT;
                TrItem nxt = cur;
                if (more) { nxt = item(it + NGW); tr_load(nxt, vn, lane); }
                tr_store(cur, vc, scr, lane);
                cur = nxt;
#pragma unroll
                for (int i = 0; i < 8; ++i) vc[i] = vn[i];
            }
        }
    }
    SEAM(PH_WCONV);
    if (IN(PH_TOPK)) {
        LAS int* wsum = (LAS int*)lds;
        for (int task = bid; task < NE * NB; task += G) {
            const int e = task >> 3, b = task & 7;
            const float* aff = AFFT + (size_t)(b * 16 + e) * SEQ;
            unsigned k[8];
            { const u32x4 a0 = *(const u32x4*)(aff + 8 * tid), a1 = *(const u32x4*)(aff + 8 * tid + 4); k[0] = a0.x; k[1] = a0.y; k[2] = a0.z; k[3] = a0.w; k[4] = a1.x; k[5] = a1.y; k[6] = a1.z; k[7] = a1.w; }
            unsigned T = 0u; int it = 0;
            __syncthreads();
            for (int bit = 30; bit >= 0; --bit, ++it) {
                const unsigned cand = T | (1u << bit); int c = 0;
#pragma unroll
                for (int j = 0; j < 8; ++j) c += __builtin_popcountll(__ballot(k[j] >= cand));
                if (lane == 0) wsum[(it & 1) * 8 + wave] = c;
                __syncthreads();
                int tot = 0;
#pragma unroll
                for (int w = 0; w < 8; ++w) tot += wsum[(it & 1) * 8 + w];
                if (tot >= CAP) T = cand;
            }
            int cg = 0, ce = 0;
#pragma unroll
            for (int j = 0; j < 8; ++j) { cg += (k[j] > T) ? 1 : 0; ce += (k[j] == T) ? 1 : 0; }
            LAS int* sc1 = wsum + 16; LAS int* sc2 = wsum + 32;
            int ie = ce, ig = cg;
#pragma unroll
            for (int o = 1; o < 64; o <<= 1) { const int te = __shfl_up(ie, o), tg = __shfl_up(ig, o); if (lane >= o) { ie += te; ig += tg; } }
            __syncthreads();
            if (lane == 63) { sc1[wave] = ie; sc2[wave] = ig; }
            __syncthreads();
            int ebase = ie - ce, totg = 0;
#pragma unroll
            for (int w = 0; w < 8; ++w) { if (w < wave) ebase += sc1[w]; totg += sc2[w]; }
            const int need = CAP - totg;
            int sel[8], cs = 0, er = ebase;
#pragma unroll
            for (int j = 0; j < 8; ++j) { const bool eq = (k[j] == T); sel[j] = (k[j] > T) || (eq && er < need); er += eq ? 1 : 0; cs += sel[j]; }
            int is = cs;
#pragma unroll
            for (int o = 1; o < 64; o <<= 1) { const int ts = __shfl_up(is, o); if (lane >= o) is += ts; }
            __syncthreads();
            if (lane == 63) sc1[wave] = is;
            __syncthreads();
            int sbase = is - cs;
#pragma unroll
            for (int w = 0; w < 8; ++w) if (w < wave) sbase += sc1[w];
#pragma unroll
            for (int j = 0; j < 8; ++j) {
                const int t = 8 * tid + j; int slot = -1;
                if (sel[j]) { slot = sbase; ++sbase; const int prow = (e * 8 + b) * CAP + slot; TOPI[prow] = t; TOPW[prow] = __uint_as_float(k[j]); }
                SLOT[((size_t)b * SEQ + t) * 16 + e] = slot;
            }
            __syncthreads();
        }
    }
    SEAM(PH_TOPK);
    if (IN(PH_GU)) {
        Gemm g{H2, WGU, 1024, 1024, 1024, (size_t)4096 * 1024, 4, TOPI}; StaticOrder S; S.init(NPAIR, 4096, G, bid);
        EpiGU E{ACT};
        GEMM_PHASE<EpiGU, StaticOrder, true>(lds, g, S, E);
    }
    SEAM(PH_GU);
    if (IN(PH_D)) {
        Gemm g{ACT, WD, 2048, 2048, 2048, (size_t)1024 * 2048, 4, nullptr}; StaticOrder S; S.init(NPAIR, 1024, G, bid, 0, 1);
        EpiD E{YB, TOPW};
        GEMM_PHASE<EpiD, StaticOrder, false>(lds, g, S, E);
    }
    SEAM(PH_D);
    if (IN(PH_FIN)) {
        const float* fg = args.in[I_FING];
        const bf16_t* ZROW = (const bf16_t*)(ws + WS_CTL + 512 * 1024);
        int sln[2] = {-1, -1};
        if (gw < NTOK / 2 && lane < 16) { sln[0] = SLOT[(size_t)(2 * gw) * 16 + lane]; sln[1] = SLOT[(size_t)(2 * gw + 1) * 16 + lane]; }
        for (int rp = gw; rp < NTOK / 2; rp += NGW) {
            const int row0 = 2 * rp, b = row0 >> 12;
            const int sl[2] = {sln[0], sln[1]};
            { const int rn = rp + NGW; if (rn < NTOK / 2 && lane < 16) { sln[0] = SLOT[(size_t)(2 * rn) * 16 + lane]; sln[1] = SLOT[(size_t)(2 * rn + 1) * 16 + lane]; } }
            const float* g2 = MOD + b * 6144 + 5120;
            f32x4 xv[2][4], acc[2][4];
#pragma unroll
            for (int q = 0; q < 2; ++q)
#pragma unroll
                for (int h = 0; h < 2; ++h) { const float* xp = args.out + (size_t)(row0 + q) * 1024 + 512 * h + 8 * lane; xv[q][2 * h] = *(const f32x4*)xp; xv[q][2 * h + 1] = *(const f32x4*)(xp + 4);
                    acc[q][2 * h] = (f32x4){0.f, 0.f, 0.f, 0.f}; acc[q][2 * h + 1] = (f32x4){0.f, 0.f, 0.f, 0.f}; }
#pragma unroll
            for (int q = 0; q < 2; ++q) {
                unsigned long long mask = __ballot(sl[q] >= 0);
                for (;;) {
                    const bf16_t* yr[4];
#pragma unroll
                    for (int k = 0; k < 4; ++k) {
                        if (mask) { const int ex = __builtin_ctzll(mask); mask &= mask - 1; const int s = __builtin_amdgcn_readlane(sl[q], ex); yr[k] = YB + (size_t)((ex * 8 + b) * CAP + s) * 1024; }
                        else yr[k] = ZROW;
                    }
                    u32x4 y[4][2];
#pragma unroll
                    for (int k = 0; k < 4; ++k)
#pragma unroll
                        for (int h = 0; h < 2; ++h) y[k][h] = *(const u32x4*)(yr[k] + 512 * h + 8 * lane);
#pragma unroll
                    for (int k = 0; k < 4; ++k)
#pragma unroll
                        for (int h = 0; h < 2; ++h) { const u32x4 w = y[k][h];
                            acc[q][2 * h] += (f32x4){bf2f(w.x & 0xffffu), bf2f(w.x >> 16), bf2f(w.y & 0xffffu), bf2f(w.y >> 16)};
                            acc[q][2 * h + 1] += (f32x4){bf2f(w.z & 0xffffu), bf2f(w.z >> 16), bf2f(w.w & 0xffffu), bf2f(w.w >> 16)}; }
                    if (!mask) break;
                }
            }
#pragma unroll
            for (int q = 0; q < 2; ++q) {
                float ss = 0.f;
#pragma unroll
                for (int h = 0; h < 2; ++h)
#pragma unroll
                    for (int u4 = 0; u4 < 2; ++u4) { const int col = 512 * h + 8 * lane + 4 * u4; f32x4& v = xv[q][2 * h + u4]; v = v + *(const f32x4*)(g2 + col) * acc[q][2 * h + u4]; ss += (v.x * v.x + v.y * v.y) + (v.z * v.z + v.w * v.w); }
                const float rstd = 1.0f / sqrtf(wave_sum(ss) * (1.f / 1024.f) + EPS);
#pragma unroll
                for (int h = 0; h < 2; ++h)
#pragma unroll
                    for (int u4 = 0; u4 < 2; ++u4) { const int col = 512 * h + 8 * lane + 4 * u4; *(f32x4*)(args.out + (size_t)(row0 + q) * 1024 + col) = xv[q][2 * h + u4] * rstd * *(const f32x4*)(fg + col); }
            }
        }
    }
#undef IN
}

extern "C" void kernel_launch(void* const* d_in, const int* in_sizes, int n_in, void* d_out, int out_size, void* d_ws, size_t ws_size, hipStream_t stream) {
    static int grid = 0;
    if (grid == 0) {
        if (n_in != 23 || in_sizes[0] != NTOK * DM || out_size != NTOK * DM || ws_size < WS_END) {
            fprintf(stderr, "kernel_launch: unexpected problem (n_in %d, in0 %d, out %d, ws %zu < %zu?)\n", n_in, n_in > 0 ? in_sizes[0] : -1, out_size, ws_size, (size_t)WS_END); grid = -1; return; }
        if (hipFuncSetAttribute((const void*)fwd, hipFuncAttributeMaxDynamicSharedMemorySize, LDS_BYTES) != hipSuccess) { fprintf(stderr, "kernel_launch: hipFuncSetAttribute failed\n"); grid = -1; return; }
        int dev = 0, cus = 0;
        if (hipGetDevice(&dev) != hipSuccess || hipDeviceGetAttribute(&cus, hipDeviceAttributeMultiprocessorCount, dev) != hipSuccess) { grid = -1; return; }
        grid = cus;
    }
    if (grid < 0) return;
    (void)hipMemsetAsync((char*)d_ws + WS_CTL, 0, 1 * MiB, stream);
    Args a{};
    for (int i = 0; i < 23; ++i) a.in[i] = (const float*)d_in[i];
    a.out = (float*)d_out; a.ws = (unsigned char*)d_ws;
    if (ONE_LAUNCH) {
        a.ph_lo = 0; a.ph_hi = PH_COUNT;
        hipLaunchKernelGGL(fwd, dim3(grid), dim3(NTHREADS), LDS_BYTES, stream, a);
    } else {
        static const int seq[] = {PROBE_SEQ};
        for (unsigned i = 0; i < sizeof(seq) / sizeof(seq[0]); ++i) {
            a.ph_lo = seq[i] % 100; a.ph_hi = seq[i] % 100 + 1; a.flags = seq[i] / 100;
            hipLaunchKernelGGL(fwd, dim3(grid), dim3(NTHREADS), LDS_BYTES, stream, a);
        }
    }
}
```

```cpp
#include <hip/hip_runtime.h>
#include <cstdio>
#include <cstdint>

#define LAS __attribute__((address_space(3)))
typedef unsigned short bf16_t;
typedef float f32x4 __attribute__((ext_vector_type(4)));
typedef float f32x2 __attribute__((ext_vector_type(2)));
typedef unsigned u32x4 __attribute__((ext_vector_type(4)));
typedef unsigned u32x2 __attribute__((ext_vector_type(2)));
typedef int i32x4 __attribute__((ext_vector_type(4)));

constexpr int DM = 1024, NB = 8, SEQ = 4096, NTOK = NB * SEQ, CTXL = 256, NCTX = NB * CTXL, NROWS_H = NTOK + NCTX;
constexpr int INCOLS = 5632, OFF_Q = 2048, OFF_K = 3072, OFF_VB = 3328, OFF_GATE = 3584;
constexpr int NE = 16, CAP = 512, DE = 2048, NPAIR = NE * NB * CAP;
constexpr float EPS = 1e-6f, LOG2E = 1.4426950408889634f, C2 = 0.125f * LOG2E;
constexpr int NTHREADS = 512, NWAVES = 8;

constexpr size_t MiB = 1u << 20;
constexpr size_t WS_CTL = 0;
constexpr size_t WS_MOD = 1 * MiB;
constexpr size_t WS_ROPE = 1 * MiB + 512 * 1024;
constexpr size_t WS_AFFT = 2 * MiB;
constexpr size_t WS_TOPI = 4 * MiB;
constexpr size_t WS_TOPW = 4 * MiB + 512 * 1024;
constexpr size_t WS_SLOT = 5 * MiB;
constexpr size_t WS_WSP = 7 * MiB;
constexpr size_t WS_WIN = 8 * MiB;
constexpr size_t WS_WAB = 19 * MiB;
constexpr size_t WS_WO = 23 * MiB;
constexpr size_t WS_R = 25 * MiB;
constexpr size_t WS_H = WS_R;
constexpr size_t WS_VA = WS_R + 68 * MiB;
constexpr size_t WS_KB = WS_VA + 64 * MiB;
constexpr size_t WS_VB = WS_KB + 17 * MiB;
constexpr size_t WS_G = WS_VB + 17 * MiB;
constexpr size_t WS_Y = WS_G + 128 * MiB;
constexpr size_t WS_TMP = WS_Y + 128 * MiB;
constexpr size_t WS_STATS = WS_TMP + 64 * MiB;
constexpr size_t WS_MERGED = WS_H;
constexpr size_t WS_WGU = WS_R;
constexpr size_t WS_WD = WS_R + 128 * MiB;
constexpr size_t WS_H2 = WS_R + 192 * MiB;
constexpr size_t WS_ACT = WS_R + 256 * MiB;
constexpr size_t WS_YB = WS_WGU;
constexpr size_t WS_END = 537 * MiB;
static_assert(WS_STATS + 4 * MiB <= WS_END && WS_ACT + 256 * MiB == WS_END, "ws map");

constexpr int LDS_BYTES = 147456;

__device__ __forceinline__ float bf2f(unsigned b) { return __uint_as_float(b << 16); }
__device__ __forceinline__ unsigned f2bf(float f) { unsigned u = __float_as_uint(f); return (u + 0x7fffu + ((u >> 16) & 1u)) >> 16; }
__device__ __forceinline__ unsigned pk2(float lo, float hi) { typedef float f2_ __attribute__((ext_vector_type(2))); typedef __bf16 b2_ __attribute__((ext_vector_type(2))); f2_ v = {lo, hi}; b2_ b = __builtin_convertvector(v, b2_); return __builtin_bit_cast(unsigned, b); }
__device__ __forceinline__ void st4bf(bf16_t* p, f32x4 v) { u32x2 w; w.x = pk2(v.x, v.y); w.y = pk2(v.z, v.w); *(u32x2*)p = w; }
__device__ __forceinline__ void st8bf(bf16_t* p, f32x4 a, f32x4 b) { u32x4 w; w.x = pk2(a.x, a.y); w.y = pk2(a.z, a.w); w.z = pk2(b.x, b.y); w.w = pk2(b.z, b.w); *(u32x4*)p = w; }
__device__ __forceinline__ void ld8bf(const bf16_t* p, f32x4& a, f32x4& b) { const u32x4 w = *(const u32x4*)p; a.x = bf2f(w.x & 0xffffu); a.y = bf2f(w.x >> 16); a.z = bf2f(w.y & 0xffffu); a.w = bf2f(w.y >> 16); b.x = bf2f(w.z & 0xffffu); b.y = bf2f(w.z >> 16); b.z = bf2f(w.w & 0xffffu); b.w = bf2f(w.w >> 16); }
__device__ __forceinline__ f32x4 ld4bf(const bf16_t* p) { const u32x2 w = *(const u32x2*)p; f32x4 v; v.x = bf2f(w.x & 0xffffu); v.y = bf2f(w.x >> 16); v.z = bf2f(w.y & 0xffffu); v.w = bf2f(w.y >> 16); return v; }
__device__ __forceinline__ float sigmoidf_(float x) { return __builtin_amdgcn_rcpf(1.f + __builtin_amdgcn_exp2f(x * -1.4426950409f)); }
__device__ __forceinline__ float siluf_(float x) { return x * __builtin_amdgcn_rcpf(1.f + __builtin_amdgcn_exp2f(x * -1.4426950409f)); }
__device__ __forceinline__ float gelu_t(float x) { const float t = x * __builtin_fmaf(x * x, -0.10294324f, -2.3022082f); return x * __builtin_amdgcn_rcpf(1.f + __builtin_amdgcn_exp2f(t)); }
__device__ __forceinline__ float wave_sum(float v) {
#pragma unroll
    for (int o = 1; o < 64; o <<= 1) v += __shfl_xor(v, o);
    return v;
}
__device__ __forceinline__ int wave_sum_i(int v) {
#pragma unroll
    for (int o = 1; o < 64; o <<= 1) v += __shfl_xor(v, o);
    return v;
}
#define LDS_WAIT() asm volatile("s_waitcnt lgkmcnt(0)" ::: "memory")

struct Args { const float* in[23]; float* out; unsigned char* ws; int ph_lo, ph_hi, flags, pad; };
enum { I_X = 0, I_C, I_CTX, I_CCTX, I_WADA, I_BADA, I_N1G, I_WIN, I_BMG, I_LNG, I_LNB, I_WSP, I_BSP, I_SINK, I_WPA, I_WPB, I_WOUT, I_N2G, I_WR, I_WEG, I_WEU, I_WED, I_FING };

struct Unit { int pm, pn; };
struct Gemm {
    const bf16_t* A; const bf16_t* Bt; int lda, ldb, K;
    size_t bgs; int tpg_shift;
    const int* gidx;
};
constexpr int NXCD = 8, WGM = 8;
struct StaticOrder {
    int nM, nN, nwg, G, c, extra, rev;
    __device__ void init(int M, int N, int G_, int c_, int extra_ = 0, int rev_ = 0) { nM = M / 256; nN = N / 256; nwg = nM * nN; G = G_; c = c_; extra = extra_; rev = rev_; }
    __device__ bool next(int i, Unit& u) const {
        const long L = (long)i * G + c;
        if (L >= nwg) { const int x = (int)(L - nwg); if (x >= extra) return false; u.pm = NTOK / 256 + (x >> 1); u.pn = 12 + (x & 1); return true; }
        int wgid = (int)L; { const int q = nwg / NXCD, r = nwg % NXCD, xcd = wgid % NXCD, off = wgid / NXCD; wgid = (xcd < r ? xcd * (q + 1) : r * (q + 1) + (xcd - r) * q) + off; }
        const int nig = WGM * nN, gid = wgid / nig, fm = gid * WGM, gsz = (nM - fm) < WGM ? (nM - fm) : WGM;
        u.pm = fm + ((wgid % nig) % gsz); u.pn = (wgid % nig) / gsz; if (rev) u.pm = nM - 1 - u.pm; return true;
    }
};

struct OneUnit { int pm, pn; __device__ bool next(int i, Unit& u) const { if (i) return false; u.pm = pm; u.pn = pn; return true; } };

typedef f32x4 Acc[2][2][4][2];

namespace pg8 {
typedef short bf16x8 __attribute__((ext_vector_type(8)));
constexpr int BK = 64, HALF = 128, HTB = HALF * BK * 2, STAGE_BYTES = 8 * HTB;
__device__ __forceinline__ int lds_byte(int r, int c) { const int st = (r >> 4) * 2 + (c >> 5), rr = r & 15, cc = c & 31, ob = rr * 64 + cc * 2; return st * 1024 + (ob ^ (((ob >> 9) & 1) << 5)); }
__device__ __forceinline__ void stage_rc(int b, int& R, int& C) { const int st = b / 1024, sb = b % 1024, swz = sb ^ (((sb >> 9) & 1) << 5); R = (st >> 1) * 16 + swz / 64; C = (st & 1) * 32 + (swz % 64) / 2; }

template <class Epi, class Sched, bool GATHER, bool HOOK = false>
__device__ __forceinline__ void gemm_phase(LAS unsigned char* lds, const Gemm g, const Sched& S, const Epi& E) {
    const int tid = threadIdx.x, wid = __builtin_amdgcn_readfirstlane(tid >> 6), lane = tid & 63, wr = wid >> 2, wc = wid & 3, fr = lane & 15, fq = lane >> 4;
    const int nt = g.K / BK;
    int Rs[2], Cs[2]; unsigned voffBp[2][2], voffB[2], voffBn[2], vA[2][2], vN[2][2];
#pragma unroll
    for (int i = 0; i < 2; ++i) { stage_rc(tid * 16 + i * 8192, Rs[i], Cs[i]); voffBp[0][i] = (unsigned)(Rs[i] * g.ldb + Cs[i]) * 2u;
        const int rho = Rs[i] & 31, Rb = (Rs[i] & ~31) + 8 * ((rho & 15) >> 2) + 4 * (rho >> 4) + (rho & 3); voffBp[1][i] = (unsigned)(Rb * g.ldb + Cs[i]) * 2u; }
    const size_t kstep = (size_t)(BK * 2);
    const size_t hstepB = (size_t)HALF * g.ldb * 2;
    const unsigned ldsw = (unsigned)wid * 1024u;
    const int aoff = lds_byte(wr * 64 + fr, fq * 8), boff = lds_byte(wc * 32 + fr, fq * 8);
#define PG8_SA(b, h) (((b) * 2 + (h)) * HTB)
#define PG8_SB(b, h) ((4 + (b) * 2 + (h)) * HTB)
#define PG8_STAGE(bufoff, gbase, voff) do { _Pragma("unroll") for (int _i = 0; _i < 2; ++_i) \
        __builtin_amdgcn_global_load_lds((const unsigned*)((const char*)(gbase) + (voff)[_i]), (LAS unsigned*)(lds + (bufoff) + ldsw + _i * 8192), 16, 0, 0); } while (0)
#define PG8_LDA(dst, b, h) do { _Pragma("unroll") for (int m = 0; m < 4; ++m) _Pragma("unroll") for (int k = 0; k < 2; ++k) dst[m][k] = *(const LAS bf16x8*)(lds + PG8_SA(b, h) + aoff + m * 2048 + k * 1024); } while (0)
#define PG8_LDB(dst, b, h) do { _Pragma("unroll") for (int n = 0; n < 2; ++n) _Pragma("unroll") for (int k = 0; k < 2; ++k) dst[n][k] = *(const LAS bf16x8*)(lds + PG8_SB(b, h) + boff + n * 2048 + k * 1024); } while (0)
#define PG8_MMA(ai, bj, At, Bt) do { __builtin_amdgcn_s_setprio(1); _Pragma("unroll") for (int m = 0; m < 4; ++m) _Pragma("unroll") for (int n = 0; n < 2; ++n) _Pragma("unroll") for (int k = 0; k < 2; ++k) \
        acc[ai][bj][m][n] = __builtin_amdgcn_mfma_f32_16x16x32_bf16(Bt[n][k], At[m][k], acc[ai][bj][m][n], 0, 0, 0); __builtin_amdgcn_s_setprio(0); } while (0)
#define PG8_WAIT_V(n) asm volatile("s_waitcnt vmcnt(" #n ")" ::: "memory")
#define PG8_WAIT_L(n) asm volatile("s_waitcnt lgkmcnt(" #n ")" ::: "memory")
#define PG8_BAR __builtin_amdgcn_s_barrier()
#define PG8_SCHED __builtin_amdgcn_sched_barrier(0)
#define PG8_AVOFF(dst, U) do { _Pragma("unroll") for (int _h = 0; _h < 2; ++_h) _Pragma("unroll") for (int _i = 0; _i < 2; ++_i) \
        dst[_h][_i] = GATHER ? (unsigned)((((U).pm >> 1) & 7) * SEQ + g.gidx[(U).pm * 256 + _h * 128 + Rs[_i]]) * (unsigned)(g.lda * 2) + (unsigned)(Cs[_i] * 2) \
                             : (unsigned)((_h * 128 + Rs[_i]) * g.lda + Cs[_i]) * 2u; } while (0)
#define PG8_ABASE(U) ((const char*)g.A + (GATHER ? (size_t)0 : (size_t)(U).pm * 256 * g.lda * 2))
#define PG8_BBASE(U) ((const char*)g.Bt + ((size_t)((U).pm >> g.tpg_shift) * g.bgs + (size_t)(U).pn * 256 * g.ldb) * 2)
    Unit cur, nxt; int ui = 0;
    if (!S.next(0, cur)) return;
    Acc acc;
#pragma unroll
    for (int a = 0; a < 2; ++a)
#pragma unroll
        for (int b = 0; b < 2; ++b)
#pragma unroll
            for (int m = 0; m < 4; ++m)
#pragma unroll
                for (int n = 0; n < 2; ++n) acc[a][b][m][n] = (f32x4){0.f, 0.f, 0.f, 0.f};
    bf16x8 At[4][2], B0[2][2], B1[2][2];
    PG8_AVOFF(vA, cur);
    { const bool pc = E.perm(cur); voffB[0] = pc ? voffBp[1][0] : voffBp[0][0]; voffB[1] = pc ? voffBp[1][1] : voffBp[0][1]; }
    const char* cA = PG8_ABASE(cur); const char* cB = PG8_BBASE(cur);
    PG8_STAGE(PG8_SB(0, 0), cB, voffB); PG8_STAGE(PG8_SB(0, 1), cB + hstepB, voffB); PG8_STAGE(PG8_SA(0, 0), cA, vA[0]); PG8_STAGE(PG8_SA(0, 1), cA, vA[1]);
    if (wr == 1) PG8_BAR;
    PG8_WAIT_V(2); PG8_BAR;
    PG8_STAGE(PG8_SB(1, 0), cB + kstep, voffB); PG8_STAGE(PG8_SA(1, 0), cA + kstep, vA[0]); PG8_STAGE(PG8_SB(1, 1), cB + hstepB + kstep, voffB);
    PG8_WAIT_V(6); PG8_BAR;
    for (;;) {
        const bool has_next = S.next(ui + 1, nxt);
        const char* nA = has_next ? PG8_ABASE(nxt) : cA; const char* nB = has_next ? PG8_BBASE(nxt) : cB;
        { const bool pn_ = has_next ? E.perm(nxt) : E.perm(cur); voffBn[0] = pn_ ? voffBp[1][0] : voffBp[0][0]; voffBn[1] = pn_ ? voffBp[1][1] : voffBp[0][1]; }
        if (GATHER) {
#pragma unroll
            for (int h = 0; h < 2; ++h)
#pragma unroll
                for (int i = 0; i < 2; ++i) vN[h][i] = vA[h][i];
            if (has_next && wid == 0)
                __builtin_amdgcn_global_load_lds((const unsigned*)(g.gidx + nxt.pm * 256 + lane * 4), (LAS unsigned*)(lds + STAGE_BYTES + (ui & 1) * 1024), 16, 0, 0);
        }
        for (int t = 0; t < nt; t += 2) {
            const bool last = (t == nt - 2);
            if (GATHER) { if (t == 4 && has_next) {
                const LAS int* li = (const LAS int*)(lds + STAGE_BYTES + (ui & 1) * 1024);
#pragma unroll
                for (int h = 0; h < 2; ++h)
#pragma unroll
                    for (int i = 0; i < 2; ++i) vN[h][i] = (unsigned)(((nxt.pm >> 1) & 7) * SEQ + li[h * 128 + Rs[i]]) * (unsigned)(g.lda * 2) + (unsigned)(Cs[i] * 2);
            } }
            if constexpr (HOOK) { if (t == (nt >> 1)) E.mid(acc, cur, wr, wc, fr, fq); }
            const char* a1 = cA + (size_t)(t + 1) * kstep;
            const char* a2 = last ? nA : cA + (size_t)(t + 2) * kstep; const char* b2 = last ? nB : cB + (size_t)(t + 2) * kstep;
            const char* a3 = a2 + kstep; const char* b3 = b2 + kstep;
            unsigned v2[2][2];
#pragma unroll
            for (int h = 0; h < 2; ++h)
#pragma unroll
                for (int i = 0; i < 2; ++i) v2[h][i] = (GATHER && last) ? vN[h][i] : vA[h][i];
            unsigned vb2[2]; vb2[0] = last ? voffBn[0] : voffB[0]; vb2[1] = last ? voffBn[1] : voffB[1];
            PG8_LDB(B0, 0, 0); PG8_LDB(B1, 0, 1); PG8_SCHED; PG8_LDA(At, 0, 0); PG8_STAGE(PG8_SA(1, 1), a1, vA[1]);
            PG8_WAIT_V(8); PG8_WAIT_L(0); PG8_BAR; PG8_MMA(0, 0, At, B0); PG8_MMA(0, 1, At, B1); PG8_BAR; PG8_SCHED;
            PG8_LDA(At, 0, 1); PG8_STAGE(PG8_SB(0, 0), b2, vb2); PG8_STAGE(PG8_SB(0, 1), b2 + hstepB, vb2); PG8_STAGE(PG8_SA(0, 0), a2, v2[0]);
            PG8_WAIT_V(8); PG8_WAIT_L(0); PG8_BAR; PG8_MMA(1, 0, At, B0); PG8_MMA(1, 1, At, B1); PG8_BAR; PG8_SCHED;
            PG8_LDB(B0, 1, 0); PG8_LDB(B1, 1, 1); PG8_SCHED; PG8_LDA(At, 1, 0); PG8_STAGE(PG8_SA(0, 1), a2, v2[1]);
            PG8_WAIT_V(8); PG8_WAIT_L(0); PG8_BAR; PG8_MMA(0, 0, At, B0); PG8_MMA(0, 1, At, B1); PG8_BAR; PG8_SCHED;
            PG8_LDA(At, 1, 1); PG8_STAGE(PG8_SB(1, 0), b3, vb2); PG8_STAGE(PG8_SB(1, 1), b3 + hstepB, vb2); PG8_STAGE(PG8_SA(1, 0), a3, v2[0]);
            PG8_WAIT_V(8); PG8_WAIT_L(0); PG8_BAR; PG8_MMA(1, 0, At, B0); PG8_MMA(1, 1, At, B1); PG8_BAR; PG8_SCHED;
        }
        if (wr == 0) PG8_BAR;
        E(acc, cur, wr, wc, fr, fq);
        if (!has_next) break;
#pragma unroll
        for (int a = 0; a < 2; ++a)
#pragma unroll
            for (int b = 0; b < 2; ++b)
#pragma unroll
                for (int m = 0; m < 4; ++m)
#pragma unroll
                    for (int n = 0; n < 2; ++n) acc[a][b][m][n] = (f32x4){0.f, 0.f, 0.f, 0.f};
        cur = nxt; cA = nA; cB = nB; ++ui; voffB[0] = voffBn[0]; voffB[1] = voffBn[1];
        if (GATHER) {
#pragma unroll
            for (int h = 0; h < 2; ++h)
#pragma unroll
                for (int i = 0; i < 2; ++i) vA[h][i] = vN[h][i];
        }
        if (wr == 1) PG8_BAR;
    }
    PG8_WAIT_V(0);
    PG8_BAR;
#undef PG8_SA
#undef PG8_SB
#undef PG8_STAGE
#undef PG8_LDA
#undef PG8_LDB
#undef PG8_MMA
#undef PG8_WAIT_V
#undef PG8_WAIT_L
#undef PG8_BAR
#undef PG8_SCHED
#undef PG8_AVOFF
#undef PG8_ABASE
#undef PG8_BBASE
}
}

#define GEMM_PHASE pg8::gemm_phase

struct EpiIn {
    bf16_t *Y, *VA, *KB, *VB, *G; const float* bgate; const f32x2* rope; f32x2* STATS;
    __device__ __forceinline__ bool perm(const Unit& u) const { return u.pn < 8 || u.pn > 12; }
    template <int KIND> __device__ __forceinline__ void run(const Acc& acc, const Unit& u, int wr, int wc, int fr, int fq) const {
        const int pn = u.pn;
#pragma unroll
        for (int ai = 0; ai < 2; ++ai)
#pragma unroll
            for (int m = 0; m < 4; ++m) {
                const int row = u.pm * 256 + ai * 128 + wr * 64 + m * 16 + fr;
                float ssum = 0.f, ssq = 0.f;
#pragma unroll
                for (int bj = 0; bj < 2; ++bj) {
                    f32x4 v0 = acc[ai][bj][m][0], v1 = acc[ai][bj][m][1];
                    if constexpr (KIND == 0 || KIND == 1) {
                        const int c8 = bj * 128 + wc * 32 + 8 * fq;
#pragma unroll
                        for (int j = 0; j < 4; ++j) { v0[j] = gelu_t(v0[j]); v1[j] = gelu_t(v1[j]); }
                        if constexpr (KIND == 0) st8bf(Y + (size_t)row * 2048 + pn * 256 + c8, v0, v1);
                        else {
                            st8bf(VA + (size_t)row * 1024 + (pn - 4) * 256 + c8, v0, v1);
                            ssum += ((v0.x + v0.y) + (v0.z + v0.w)) + ((v1.x + v1.y) + (v1.z + v1.w));
                            ssq += ((v0.x * v0.x + v0.y * v0.y) + (v0.z * v0.z + v0.w * v0.w)) + ((v1.x * v1.x + v1.y * v1.y) + (v1.z * v1.z + v1.w * v1.w));
                        }
                    } else if constexpr (KIND == 2) {
                        const int cl = bj * 128 + wc * 32 + 4 * fq;
                        f32x4 o0 = v0, o1 = v1;
                        if (row < NTOK) {
                            const int t = row & (SEQ - 1), pos = (wc & 1) ? (t & 63) : (t >> 6);
                            const f32x2* rp = rope + pos * 16 + 4 * fq;
#pragma unroll
                            for (int j = 0; j < 4; ++j) { const f32x2 cs = rp[j]; o0[j] = v0[j] * cs.x - v1[j] * cs.y; o1[j] = v0[j] * cs.y + v1[j] * cs.x; }
                        }
                        if (pn < 12) { bf16_t* p = Y + (size_t)row * 2048 + 1024 + (pn - 8) * 256 + cl; st4bf(p, o0 * C2); st4bf(p + 16, o1 * C2); }
                        else { bf16_t* p = KB + (size_t)row * 256 + cl; st4bf(p, o0); st4bf(p + 16, o1); }
                    } else if constexpr (KIND == 3) {
                        st8bf(VB + (size_t)row * 256 + bj * 128 + wc * 32 + 8 * fq, v0, v1);
                    } else {
                        const int cg = (pn - 14) * 256 + bj * 128 + wc * 32 + 8 * fq;
                        const f32x4 b0 = *(const f32x4*)(bgate + cg), b1 = *(const f32x4*)(bgate + cg + 4);
#pragma unroll
                        for (int j = 0; j < 4; ++j) { v0[j] = sigmoidf_(v0[j] + b0[j]); v1[j] = sigmoidf_(v1[j] + b1[j]); }
                        st8bf(G + (size_t)row * 2048 + cg, v0, v1);
                    }
                }
                if constexpr (KIND == 1) {
                    ssum += __shfl_xor(ssum, 16); ssum += __shfl_xor(ssum, 32); ssq += __shfl_xor(ssq, 16); ssq += __shfl_xor(ssq, 32);
                    if (fq == 0) STATS[(size_t)row * 16 + (pn - 4) * 4 + wc] = (f32x2){ssum, ssq};
                }
            }
    }
    __device__ __forceinline__ void operator()(const Acc& acc, const Unit& u, int wr, int wc, int fr, int fq) const {
        const int pn = u.pn;
        if (pn < 4) run<0>(acc, u, wr, wc, fr, fq);
        else if (pn < 8) run<1>(acc, u, wr, wc, fr, fq);
        else if (pn < 13) run<2>(acc, u, wr, wc, fr, fq);
        else if (pn == 13) run<3>(acc, u, wr, wc, fr, fq);
        else run<4>(acc, u, wr, wc, fr, fq);
    }
};
struct EpiAB {
    bf16_t* MERGED; const bf16_t* G;
    __device__ __forceinline__ bool perm(const Unit&) const { return true; }
    __device__ __forceinline__ void mid(Acc& acc, const Unit& u, int wr, int wc, int fr, int fq) const {
        int zero; asm volatile("v_mov_b32 %0, 0" : "=v"(zero));
        const bf16_t* gp = G + (size_t)(u.pm * 256 + wr * 64 + fr + zero) * 2048 + u.pn * 256 + wc * 32 + 8 * fq;
#pragma unroll
        for (int ai = 0; ai < 2; ++ai)
#pragma unroll
            for (int m = 0; m < 4; ++m) {
#pragma unroll
                for (int bj = 0; bj < 2; ++bj) {
                    const bf16_t* q = gp + (size_t)(ai * 128 + m * 16) * 2048 + bj * 128;
                    f32x4 ga0, ga1, gb0, gb1; ld8bf(q, ga0, ga1); ld8bf(q + 1024, gb0, gb1);
#pragma unroll
                    for (int j = 0; j < 4; ++j) { acc[ai][bj][m][0][j] *= ga0[j] * __builtin_amdgcn_rcpf(gb0[j]); acc[ai][bj][m][1][j] *= ga1[j] * __builtin_amdgcn_rcpf(gb1[j]); }
                    asm volatile("" ::: "memory");
                }
            }
    }
    __device__ __forceinline__ void operator()(const Acc& acc, const Unit& u, int wr, int wc, int fr, int fq) const {
#pragma unroll
        for (int ai = 0; ai < 2; ++ai)
#pragma unroll
            for (int m = 0; m < 4; ++m) {
                const int row = u.pm * 256 + ai * 128 + wr * 64 + m * 16 + fr;
#pragma unroll
                for (int bj = 0; bj < 2; ++bj) {
                    const int c8 = u.pn * 256 + bj * 128 + wc * 32 + 8 * fq;
                    f32x4 gb0, gb1; ld8bf(G + (size_t)row * 2048 + 1024 + c8, gb0, gb1);
                    st8bf(MERGED + (size_t)row * 1024 + c8, gb0 * acc[ai][bj][m][0], gb1 * acc[ai][bj][m][1]);
                }
            }
    }
};
struct EpiO {
    float* X1; const float* X; const float* mod;
    __device__ __forceinline__ bool perm(const Unit&) const { return false; }
    __device__ __forceinline__ void operator()(const Acc& acc, const Unit& u, int wr, int wc, int fr, int fq) const {
#pragma unroll
        for (int ai = 0; ai < 2; ++ai)
#pragma unroll
            for (int m = 0; m < 4; ++m) {
                const int row = u.pm * 256 + ai * 128 + wr * 64 + m * 16 + fr; const float* g1 = mod + (size_t)(row >> 12) * 6144 + 2048;
#pragma unroll
                for (int bj = 0; bj < 2; ++bj)
#pragma unroll
                    for (int n = 0; n < 2; ++n) {
                        const int c = u.pn * 256 + bj * 128 + wc * 32 + 16 * n + 4 * fq;
                        const f32x4 xv = *(const f32x4*)(X + (size_t)row * 1024 + c), gv = *(const f32x4*)(g1 + c);
                        *(f32x4*)(X1 + (size_t)row * 1024 + c) = xv + gv * acc[ai][bj][m][n];
                    }
            }
    }
};
struct EpiGU {
    bf16_t* ACT;
    __device__ __forceinline__ bool perm(const Unit&) const { return true; }
    __device__ __forceinline__ void operator()(const Acc& acc, const Unit& u, int wr, int wc, int fr, int fq) const {
#pragma unroll
        for (int ai = 0; ai < 2; ++ai)
#pragma unroll
            for (int m = 0; m < 4; ++m) {
                const int prow = u.pm * 256 + ai * 128 + wr * 64 + m * 16 + fr;
                f32x4 a[2];
#pragma unroll
                for (int n = 0; n < 2; ++n) {
                    const f32x4 gt = acc[ai][0][m][n], up = acc[ai][1][m][n];
#pragma unroll
                    for (int j = 0; j < 4; ++j) a[n][j] = siluf_(gt[j]) * up[j];
                }
                st8bf(ACT + (size_t)prow * 2048 + u.pn * 128 + wc * 32 + 8 * fq, a[0], a[1]);
            }
    }
};
struct EpiD {
    bf16_t* YB; const float* TOPW;
    __device__ __forceinline__ bool perm(const Unit&) const { return true; }
    __device__ __forceinline__ void operator()(const Acc& acc, const Unit& u, int wr, int wc, int fr, int fq) const {
#pragma unroll
        for (int ai = 0; ai < 2; ++ai)
#pragma unroll
            for (int m = 0; m < 4; ++m) {
                const int prow = u.pm * 256 + ai * 128 + wr * 64 + m * 16 + fr; const float w = TOPW[prow];
#pragma unroll
                for (int bj = 0; bj < 2; ++bj)
                    st8bf(YB + (size_t)prow * 1024 + u.pn * 256 + bj * 128 + wc * 32 + 8 * fq, acc[ai][bj][m][0] * w, acc[ai][bj][m][1] * w);
            }
    }
};

__device__ __forceinline__ void transpose_item(const float* W, int N, int k0, int n0, bf16_t* dst, int ldt, LAS float* scr, int lane) {
    const int kk = lane >> 3, nq = (lane & 7) * 4;
    f32x4 v[8];
#pragma unroll
    for (int i = 0; i < 8; ++i) v[i] = *(const f32x4*)(W + (size_t)(k0 + 8 * i + kk) * N + n0 + nq);
#pragma unroll
    for (int i = 0; i < 8; ++i) { LAS float* s = scr + (8 * i + kk) * 33 + nq; s[0] = v[i].x; s[1] = v[i].y; s[2] = v[i].z; s[3] = v[i].w; }
    LDS_WAIT();
    const int c = lane & 7;
#pragma unroll
    for (int j = 0; j < 4; ++j) {
        const int n = (lane >> 3) + 8 * j; const LAS float* s = scr + (8 * c) * 33 + n;
        u32x4 o; o.x = pk2(s[0 * 33], s[1 * 33]); o.y = pk2(s[2 * 33], s[3 * 33]); o.z = pk2(s[4 * 33], s[5 * 33]); o.w = pk2(s[6 * 33], s[7 * 33]);
        *(u32x4*)(dst + (size_t)n * ldt + 8 * c) = o;
    }
    LDS_WAIT();
}

struct TrItem { const float* src; bf16_t* dst; int N, ldt; };
__device__ __forceinline__ void tr_load(const TrItem& it, f32x4 (&v)[8], int lane) {
    const int kk = lane >> 3, nq = (lane & 7) * 4;
#pragma unroll
    for (int i = 0; i < 8; ++i) v[i] = *(const f32x4*)(it.src + (size_t)(8 * i + kk) * it.N + nq);
}
__device__ __forceinline__ void tr_store(const TrItem& it, const f32x4 (&v)[8], LAS float* scr, int lane) {
    const int kk = lane >> 3, nq = (lane & 7) * 4;
#pragma unroll
    for (int i = 0; i < 8; ++i) { LAS float* s = scr + (8 * i + kk) * 33 + nq; s[0] = v[i].x; s[1] = v[i].y; s[2] = v[i].z; s[3] = v[i].w; }
    LDS_WAIT();
    const int c = lane & 7;
#pragma unroll
    for (int j = 0; j < 4; ++j) {
        const int n = (lane >> 3) + 8 * j; const LAS float* s = scr + (8 * c) * 33 + n;
        u32x4 o; o.x = pk2(s[0 * 33], s[1 * 33]); o.y = pk2(s[2 * 33], s[3 * 33]); o.z = pk2(s[4 * 33], s[5 * 33]); o.w = pk2(s[6 * 33], s[7 * 33]);
        *(u32x4*)(it.dst + (size_t)n * it.ldt + 8 * c) = o;
    }
    LDS_WAIT();
}

__device__ __forceinline__ void adaln_task(int task, const float* c, const float* cctx, const float* w_ada, const float* b_ada, float* mod, LAS float* lds, int tid) {
    LAS float* s = lds; LAS float* red = lds + 9 * 1024;
    { float cv[18];
#pragma unroll
      for (int q = 0; q < 18; ++q) { const int i = tid + NTHREADS * q, r = i >> 10, k = i & 1023; cv[q] = r < 8 ? c[r * 1024 + k] : cctx[k]; }
#pragma unroll
      for (int q = 0; q < 18; ++q) s[tid + NTHREADS * q] = cv[q] * __builtin_amdgcn_rcpf(1.f + __expf(-cv[q])); }
    __syncthreads();
    const int ch = tid & 7, kr = tid >> 3;
    f32x4 acc[9];
#pragma unroll
    for (int r = 0; r < 9; ++r) acc[r] = (f32x4){0.f, 0.f, 0.f, 0.f};
    const float* wp = w_ada + (size_t)kr * 6144 + task * 32 + ch * 4;
    for (int it = 0; it < 16; ++it) {
        const f32x4 w = *(const f32x4*)(wp + (size_t)it * 64 * 6144); const int k = kr + it * 64;
#pragma unroll
        for (int r = 0; r < 9; ++r) acc[r] += s[r * 1024 + k] * w;
    }
#pragma unroll
    for (int r = 0; r < 9; ++r) *(LAS f32x4*)(red + (kr * 9 + r) * 32 + ch * 4) = acc[r];
    __syncthreads();
    if (tid < 288) { const int r = tid >> 5, col = tid & 31; float sum = 0.f; for (int q = 0; q < 64; ++q) sum += red[(q * 9 + r) * 32 + col]; mod[r * 6144 + task * 32 + col] = sum + b_ada[task * 32 + col]; }
    __syncthreads();
}

__device__ __forceinline__ void rope_table(f32x2* tab, int tid) {
    for (int idx = tid; idx < 1024; idx += NTHREADS) {
        const int pos = idx >> 4, i = idx & 15;
        double f = 1.0;
        for (int q = 0; q < i; ++q) f *= 0.56234132519034908;
        const float ang = (float)pos * (float)f;
        const double a = (double)ang, k = __builtin_rint(a * 0.15915494309189535), r = a - k * 6.283185307179586476925, r2 = r * r;
        double sn = r, ts = r, cs = 1.0, tc = 1.0;
        for (int n = 1; n <= 14; ++n) {
            tc *= -r2 / (double)((2 * n - 1) * (2 * n)); cs += tc;
            ts *= -r2 / (double)((2 * n) * (2 * n + 1)); sn += ts;
        }
        tab[idx] = (f32x2){(float)cs, (float)sn};
    }
}

__device__ __forceinline__ unsigned char* lds_raw_ptr(LAS unsigned char* p) { return (unsigned char*)p; }
namespace mix {
typedef short bf16x8 __attribute__((ext_vector_type(8)));
typedef short s16x4 __attribute__((ext_vector_type(4)));
typedef float f32x16 __attribute__((ext_vector_type(16)));
typedef __attribute__((address_space(3))) const char* lds_cptr;
__device__ __forceinline__ int crow(int r, int hi) { return (r & 3) + 8 * (r >> 2) + 4 * hi; }
__device__ __forceinline__ unsigned cvtpk(float lo, float hi) { typedef float f2 __attribute__((ext_vector_type(2))); typedef __bf16 b2 __attribute__((ext_vector_type(2))); f2 v = {lo, hi}; b2 b = __builtin_convertvector(v, b2); return __builtin_bit_cast(unsigned, b); }
__device__ __forceinline__ s16x4 vtr(lds_cptr p) { return __builtin_bit_cast(s16x4, __builtin_amdgcn_ds_read_tr16_b64_v4i16((__attribute__((address_space(3))) s16x4*)p)); }
__device__ __forceinline__ bf16x8 pk8(s16x4 lo, s16x4 hi) { return (bf16x8){lo[0], lo[1], lo[2], lo[3], hi[0], hi[1], hi[2], hi[3]}; }
__device__ __forceinline__ float max3f(float a, float b, float c) { float r; asm("v_max3_f32 %0, %1, %2, %3" : "=v"(r) : "v"(a), "v"(b), "v"(c)); return r; }
__device__ __forceinline__ float max2f(float a, float b) { float r; asm("v_max_f32_e32 %0, %1, %2" : "=v"(r) : "v"(a), "v"(b)); return r; }
__device__ __forceinline__ float swap_half(float v) { auto rr = __builtin_amdgcn_permlane32_swap(__float_as_uint(v), __float_as_uint(v), false, false); return __uint_as_float((threadIdx.x & 32) ? rr[0] : rr[1]); }

constexpr int A_K = 0, A_V = 24576, A_WS = 49152, A_QST = 53248, A_OST = A_QST, A_OSTW = 8192, A_END = A_QST + 8 * 8192;

__device__ __forceinline__ void attn_unit(int b, int n, int kvh, bf16_t* Y, bf16_t* O, int ldo, const bf16_t* KB, const bf16_t* VB, const float* sink, LAS unsigned char* lds) {
    const int tid = threadIdx.x, lane = tid & 63, r32 = lane & 31, hi = lane >> 5, wid = __builtin_amdgcn_readfirstlane(tid >> 6);
    const int head = kvh * 4 + (wid >> 1);
    const int qrow0 = b * SEQ + n * 128 + (wid & 1) * 64;
    bf16_t* Qw = Y + (size_t)qrow0 * 2048 + 1024 + head * 64;
    LAS bf16x8* qst = (LAS bf16x8*)(lds + A_QST + wid * 8192) + lane;
#pragma unroll
    for (int sb = 0; sb < 2; ++sb)
#pragma unroll
        for (int d0 = 0; d0 < 4; ++d0) qst[(sb * 4 + d0) * 64] = *(const bf16x8*)(Qw + (size_t)(32 * sb + r32) * 2048 + d0 * 16 + hi * 8);
    f32x16 o[2][2];
#pragma unroll
    for (int sb = 0; sb < 2; ++sb)
#pragma unroll
        for (int d0 = 0; d0 < 2; ++d0)
#pragma unroll
            for (int r = 0; r < 16; ++r) o[sb][d0][r] = 0.f;
    float m[2] = {-1e30f, -1e30f}, l[2] = {0.f, 0.f};
    LAS float* wsf = (LAS float*)(lds + A_WS) + wid * 128;
    const int jlo = (n == 0) ? 2 : 0, jhi = (n == 31) ? 3 : 5, T = 4 + (jhi - jlo + 1);
    const size_t koff = (size_t)lane * 256 + wid * 8 + kvh * 64;
    const size_t voff = (size_t)(16 * (wid & 3) + (lane >> 2)) * 256 + (wid >> 2) * 32 + (lane & 3) * 8 + kvh * 64;
    auto tile_row = [&](int t) -> long { return t < 4 ? (long)(NTOK + b * CTXL + 64 * t) : (long)(b * SEQ + (n - 1) * 128 + 64 * (jlo + t - 4)); };
    auto issue = [&](int t) {
        const long row = tile_row(t); const int buf = t % 3;
        __builtin_amdgcn_global_load_lds((const unsigned*)(KB + row * 256 + koff), (LAS unsigned*)(lds + A_K + buf * 8192 + wid * 1024), 16, 0, 0);
        __builtin_amdgcn_global_load_lds((const unsigned*)(VB + row * 256 + voff), (LAS unsigned*)(lds + A_V + buf * 8192 + wid * 1024), 16, 0, 0);
    };
    issue(0); issue(1);
    int slot = 0;
    for (int t = 0; t < T; ++t) {
        if (t + 1 < T) asm volatile("s_waitcnt vmcnt(2) lgkmcnt(0)" ::: "memory"); else asm volatile("s_waitcnt vmcnt(0) lgkmcnt(0)" ::: "memory");
        __builtin_amdgcn_s_barrier();
        if (t + 2 < T) issue(t + 2);
        const lds_cptr Kt = (lds_cptr)(lds + A_K + slot * 8192) + hi * 1024 + r32 * 16;
        const lds_cptr Vt = (lds_cptr)(lds + A_V + slot * 8192) + ((lane >> 4) & 1) * 32 + (lane & 3) * 8 + (4 * hi + ((lane & 15) >> 2)) * 64;
        slot = (slot == 2) ? 0 : slot + 1;
        const bool local = t >= 4;
        const int dl = 64 * (jlo + t - 4) - 128 - 64 * (wid & 1);
        if (local && (dl > 160 || dl < -191)) continue;
        f32x16 p0[2], p1[2];
#pragma unroll
        for (int sb = 0; sb < 2; ++sb)
#pragma unroll
            for (int r = 0; r < 16; ++r) { p0[sb][r] = 0.f; p1[sb][r] = 0.f; }
#pragma unroll
        for (int d0 = 0; d0 < 4; ++d0) {
            const bf16x8 k0 = *(const __attribute__((address_space(3))) bf16x8*)(Kt + d0 * 2048), k1 = *(const __attribute__((address_space(3))) bf16x8*)(Kt + d0 * 2048 + 512);
#pragma unroll
            for (int sb = 0; sb < 2; ++sb) {
                const bf16x8 qf = qst[(sb * 4 + d0) * 64];
                p0[sb] = __builtin_amdgcn_mfma_f32_32x32x16_bf16(k0, qf, p0[sb], 0, 0, 0);
                p1[sb] = __builtin_amdgcn_mfma_f32_32x32x16_bf16(k1, qf, p1[sb], 0, 0, 0);
            }
        }
        if (local && (dl < -97 || dl > 65 || dl - 32 < -97)) {
#pragma unroll
            for (int sb = 0; sb < 2; ++sb)
#pragma unroll
                for (int r = 0; r < 16; ++r) { const int rel = dl - 32 * sb + crow(r, hi) - r32; if (rel < -128 || rel > 128) p0[sb][r] = -1e30f; if (rel + 32 < -128 || rel + 32 > 128) p1[sb][r] = -1e30f; }
        }
        float mn[2];
        asm volatile("s_nop 15\n\ts_nop 7" : "+v"(p0[0]), "+v"(p1[0]), "+v"(p0[1]), "+v"(p1[1]));
#pragma unroll
        for (int sb = 0; sb < 2; ++sb) {
            float a = max3f(p0[sb][0], p0[sb][1], p1[sb][0]), b2 = max3f(p0[sb][2], p0[sb][3], p1[sb][1]); a = max3f(a, p1[sb][2], p1[sb][3]);
#pragma unroll
            for (int r = 4; r < 16; r += 4) { a = max3f(a, p0[sb][r], p0[sb][r + 1]); b2 = max3f(b2, p0[sb][r + 2], p0[sb][r + 3]); a = max3f(a, p1[sb][r], p1[sb][r + 1]); b2 = max3f(b2, p1[sb][r + 2], p1[sb][r + 3]); }
            float rm = max2f(a, b2);
            rm = max2f(rm, swap_half(rm));
            mn[sb] = max2f(m[sb], rm);
        }
        if (__any((mn[0] > m[0]) || (mn[1] > m[1]))) {
            const float f0 = __builtin_amdgcn_exp2f(m[0] - mn[0]), f1 = __builtin_amdgcn_exp2f(m[1] - mn[1]);
            l[0] *= f0; l[1] *= f1;
            if (hi == 0) { wsf[r32] = f0; wsf[64 + r32] = f1; }
            asm volatile("s_waitcnt lgkmcnt(0)" ::: "memory");
#pragma unroll
            for (int r = 0; r < 16; ++r) { const float a = wsf[crow(r, hi)], b2 = wsf[64 + crow(r, hi)]; o[0][0][r] *= a; o[0][1][r] *= a; o[1][0][r] *= b2; o[1][1][r] *= b2; }
            m[0] = mn[0]; m[1] = mn[1];
        }
        u32x4 pw[2][4];
#pragma unroll
        for (int sb = 0; sb < 2; ++sb) {
            float sacc = 0.f;
#pragma unroll
            for (int r = 0; r < 16; ++r) { p0[sb][r] = __builtin_amdgcn_exp2f(p0[sb][r] - m[sb]); p1[sb][r] = __builtin_amdgcn_exp2f(p1[sb][r] - m[sb]); sacc += p0[sb][r] + p1[sb][r]; }
            l[sb] += sacc;
#pragma unroll
            for (int q = 0; q < 4; ++q) { pw[sb][0][q] = cvtpk(p0[sb][2 * q], p0[sb][2 * q + 1]); pw[sb][1][q] = cvtpk(p0[sb][8 + 2 * q], p0[sb][9 + 2 * q]); pw[sb][2][q] = cvtpk(p1[sb][2 * q], p1[sb][2 * q + 1]); pw[sb][3][q] = cvtpk(p1[sb][8 + 2 * q], p1[sb][9 + 2 * q]); }
        }
#pragma unroll
        for (int d0 = 0; d0 < 2; ++d0)
#pragma unroll
            for (int ks = 0; ks < 4; ++ks) {
                const s16x4 vlo = vtr(Vt + d0 * 4096 + ks * 1024), vhi = vtr(Vt + d0 * 4096 + ks * 1024 + 512);
                const bf16x8 vf = pk8(vlo, vhi);
#pragma unroll
                for (int sb = 0; sb < 2; ++sb) o[sb][d0] = __builtin_amdgcn_mfma_f32_32x32x16_bf16(__builtin_bit_cast(bf16x8, pw[sb][ks]), vf, o[sb][d0], 0, 0, 0);
            }
    }
    const float s2 = sink[head] * LOG2E;
    LAS bf16_t* stg = (LAS bf16_t*)(lds + A_OST + wid * A_OSTW);
#pragma unroll
    for (int sb = 0; sb < 2; ++sb) {
        const float lt = l[sb] + swap_half(l[sb]);
        const float mf = fmaxf(m[sb], s2), f = __builtin_amdgcn_exp2f(m[sb] - mf), den = lt * f + __builtin_amdgcn_exp2f(s2 - mf);
        asm volatile("s_waitcnt lgkmcnt(0)" ::: "memory");
        if (hi == 0) wsf[sb * 64 + r32] = f / den;
        asm volatile("s_waitcnt lgkmcnt(0)" ::: "memory");
#pragma unroll
        for (int r = 0; r < 16; ++r) { const float sc = wsf[sb * 64 + crow(r, hi)]; const int orow = crow(r, hi);
            stg[orow * 64 + r32] = (bf16_t)f2bf(o[sb][0][r] * sc); stg[orow * 64 + 32 + r32] = (bf16_t)f2bf(o[sb][1][r] * sc); }
        asm volatile("s_waitcnt lgkmcnt(0)" ::: "memory");
#pragma unroll
        for (int i = 0; i < 4; ++i) { const int row = i * 8 + (lane >> 3), ch = lane & 7; const u32x4 v = *(const LAS u32x4*)(stg + row * 64 + ch * 8); *(u32x4*)(O + (size_t)(qrow0 + 32 * sb + row) * ldo + head * 64 + ch * 8) = v; }
        asm volatile("s_waitcnt lgkmcnt(0)" ::: "memory");
    }
    __syncthreads();
}

constexpr int G_V = 0, G_ST = 65536, G_STW = 8704, G_MU = G_ST + 8 * G_STW;
__device__ __forceinline__ void gmlp_unit(int task, bf16_t* Y, bf16_t* YO, int ldo, const bf16_t* VA, const bf16_t* WSP, const f32x2* STATS, const float* ln_g, const float* ln_b, const float* b_sp, LAS unsigned char* lds) {
    const int tid = threadIdx.x, lane = tid & 63, r32 = lane & 31, hi = lane >> 5, wid = __builtin_amdgcn_readfirstlane(tid >> 6);
    const int r0 = task * 128;
    LAS float* mu = (LAS float*)(lds + G_MU); LAS float* rs = mu + 128;
    if (tid < 128) {
        const f32x4* sp = (const f32x4*)(STATS + (size_t)(r0 + tid) * 16); float s = 0.f, ss = 0.f;
#pragma unroll
        for (int i = 0; i < 8; ++i) { const f32x4 v = sp[i]; s += v.x + v.z; ss += v.y + v.w; }
        const float mean = s * (1.f / 1024.f), var = fmaxf(ss * (1.f / 1024.f) - mean * mean, 0.f);
        mu[tid] = mean; rs[tid] = 1.0f / sqrtf(var + EPS);
    }
    u32x4 raw[4];
#pragma unroll
    for (int i = 0; i < 4; ++i) { const int idx = tid + NTHREADS * i, q = idx >> 4, c8 = idx & 15; raw[i] = *(const u32x4*)(VA + (size_t)(r0 + q) * 1024 + c8 * 8); }
    __syncthreads();
    const int pb = wid >> 1, dh = wid & 1;
    LAS float* st = (LAS float*)(lds + G_ST + wid * G_STW);
    for (int g8 = 0; g8 < 8; ++g8) {
        LAS unsigned char* vb = lds + G_V + (g8 & 1) * 32768;
#pragma unroll
        for (int i = 0; i < 4; ++i) {
            const int idx = tid + NTHREADS * i, q = idx >> 4, c8 = idx & 15, d = c8 * 8;
            const f32x4 g0 = *(const f32x4*)(ln_g + g8 * 128 + d), g1 = *(const f32x4*)(ln_g + g8 * 128 + d + 4), b0 = *(const f32x4*)(ln_b + g8 * 128 + d), b1 = *(const f32x4*)(ln_b + g8 * 128 + d + 4);
            const float mq = mu[q], rq = rs[q]; const u32x4 rw = raw[i];
            float v[8] = {bf2f(rw.x & 0xffffu), bf2f(rw.x >> 16), bf2f(rw.y & 0xffffu), bf2f(rw.y >> 16), bf2f(rw.z & 0xffffu), bf2f(rw.z >> 16), bf2f(rw.w & 0xffffu), bf2f(rw.w >> 16)};
#pragma unroll
            for (int e = 0; e < 4; ++e) { v[e] = (v[e] - mq) * rq * g0[e] + b0[e]; v[4 + e] = (v[4 + e] - mq) * rq * g1[e] + b1[e]; }
            u32x4 w; w.x = pk2(v[0], v[1]); w.y = pk2(v[2], v[3]); w.z = pk2(v[4], v[5]); w.w = pk2(v[6], v[7]);
            *(LAS u32x4*)(vb + ((d >> 5) * 8 + (q >> 4)) * 1024 + (q & 15) * 64 + (d & 31) * 2) = w;
        }
        if (g8 + 1 < 8) {
#pragma unroll
            for (int i = 0; i < 4; ++i) { const int idx = tid + NTHREADS * i, q = idx >> 4, c8 = idx & 15; raw[i] = *(const u32x4*)(VA + (size_t)(r0 + q) * 1024 + (g8 + 1) * 128 + c8 * 8); }
        }
        u32x4 ur[4]; bf16x8 af[8];
        const size_t ybase = (size_t)(r0 + 32 * pb + (lane >> 3)) * 2048 + g8 * 128 + 64 * dh + (lane & 7) * 8;
#pragma unroll
        for (int i = 0; i < 4; ++i) ur[i] = *(const u32x4*)(Y + ybase + (size_t)(8 * i) * 2048);
        const bf16_t* wrow = WSP + (size_t)g8 * 16384 + (size_t)(32 * pb + r32) * 128 + 8 * hi;
#pragma unroll
        for (int ks = 0; ks < 8; ++ks) af[ks] = *(const bf16x8*)(wrow + 16 * ks);
        __syncthreads();
        const lds_cptr Vb = (lds_cptr)vb + ((lane >> 4) & 1) * 32 + (lane & 3) * 8 + (8 * hi + ((lane & 15) >> 2)) * 64;
        f32x16 acc[2];
#pragma unroll
        for (int t2 = 0; t2 < 2; ++t2)
#pragma unroll
            for (int r = 0; r < 16; ++r) acc[t2][r] = 0.f;
#pragma unroll
        for (int ks = 0; ks < 8; ++ks) {
#pragma unroll
            for (int t2 = 0; t2 < 2; ++t2) {
                const int db = 2 * dh + t2;
                const s16x4 vlo = vtr(Vb + (db * 8 + ks) * 1024), vhi = vtr(Vb + (db * 8 + ks) * 1024 + 256);
                acc[t2] = __builtin_amdgcn_mfma_f32_32x32x16_bf16(af[ks], pk8(vlo, vhi), acc[t2], 0, 0, 0);
            }
        }
#pragma unroll
        for (int t2 = 0; t2 < 2; ++t2)
#pragma unroll
            for (int r = 0; r < 16; ++r) st[crow(r, hi) * 68 + 32 * t2 + r32] = acc[t2][r];
        asm volatile("s_waitcnt lgkmcnt(0)" ::: "memory");
#pragma unroll
        for (int i = 0; i < 4; ++i) {
            const int prow = 8 * i + (lane >> 3), ch = lane & 7;
            const f32x4 m0 = *(const LAS f32x4*)(st + prow * 68 + ch * 8), m1 = *(const LAS f32x4*)(st + prow * 68 + ch * 8 + 4);
            const float bs = b_sp[g8 * 128 + 32 * pb + prow]; const u32x4 uw = ur[i];
            u32x4 o;
            o.x = pk2(bf2f(uw.x & 0xffffu) * (m0.x + bs), bf2f(uw.x >> 16) * (m0.y + bs)); o.y = pk2(bf2f(uw.y & 0xffffu) * (m0.z + bs), bf2f(uw.y >> 16) * (m0.w + bs));
            o.z = pk2(bf2f(uw.z & 0xffffu) * (m1.x + bs), bf2f(uw.z >> 16) * (m1.y + bs)); o.w = pk2(bf2f(uw.w & 0xffffu) * (m1.z + bs), bf2f(uw.w >> 16) * (m1.w + bs));
            *(u32x4*)(YO + (size_t)(r0 + 32 * pb + prow) * ldo + g8 * 128 + 64 * dh + ch * 8) = o;
        }
        asm volatile("s_waitcnt lgkmcnt(0)" ::: "memory");
    }
    __syncthreads();
}
}

namespace att2 {
typedef short bf16x8 __attribute__((ext_vector_type(8)));
typedef short s16x4 __attribute__((ext_vector_type(4)));
typedef float f32x16 __attribute__((ext_vector_type(16)));
typedef __attribute__((address_space(3))) const char* lds_cptr;
typedef short v4i16_t __attribute__((ext_vector_type(4)));
__device__ __forceinline__ int crow(int r, int hi) { return (r & 3) + 8 * (r >> 2) + 4 * hi; }
#define SBAR() __builtin_amdgcn_sched_barrier(0)
constexpr int NSLOT = 3, SLOTB = 8192;
constexpr int LDS_K = 0, LDS_V = NSLOT * SLOTB, LDS_WS = 2 * NSLOT * SLOTB, LDS_OST = LDS_WS + 8 * 64 * 4, LDS_BYTES = LDS_OST + 8 * 4096;
__device__ __forceinline__ void glds16(const void* gsrc, unsigned lds_dst) { unsigned keep;
    asm volatile("s_mov_b32 %0, m0\n\ts_mov_b32 m0, %2\n\ts_nop 0\n\tglobal_load_lds_dwordx4 %1, off\n\ts_mov_b32 m0, %0" : "=&s"(keep) : "v"(gsrc), "s"(lds_dst) : "memory"); }
__device__ __forceinline__ float max3f(float a, float b, float c) { float r; asm("v_max3_f32 %0, %1, %2, %3" : "=v"(r) : "v"(a), "v"(b), "v"(c)); return r; }
__device__ __forceinline__ float max2f(float a, float b) { float r; asm("v_max_f32_e32 %0, %1, %2" : "=v"(r) : "v"(a), "v"(b)); return r; }
__device__ __forceinline__ float fadd_s(float a, float b) { float r; asm("v_add_f32_e32 %0, %1, %2" : "=v"(r) : "v"(a), "v"(b)); return r; }
__device__ __forceinline__ float fsub_s(float a, float b) { float r; asm("v_sub_f32_e32 %0, %1, %2" : "=v"(r) : "v"(a), "v"(b)); return r; }
typedef float f32x2_t __attribute__((ext_vector_type(2))); typedef __bf16 bf16x2_t __attribute__((ext_vector_type(2)));
__device__ __forceinline__ unsigned cvtpk_s(float lo, float hi) { f32x2_t v = {lo, hi}; bf16x2_t b = __builtin_convertvector(v, bf16x2_t); return __builtin_bit_cast(unsigned, b); }
#define WAIT_BAR(N) asm volatile("s_waitcnt vmcnt(" #N ") lgkmcnt(0)\n\ts_barrier" ::: "memory")
__device__ __forceinline__ void qkt(f32x16& p0, f32x16& p1, lds_cptr Kslot, const bf16x8* qr, const f32x16& negm, int r32, int hi) {
    const lds_cptr kb = Kslot + hi * 1024 + r32 * 16;
#pragma unroll
    for (int d0 = 0; d0 < 4; ++d0) {
        const bf16x8 b0 = *(const __attribute__((address_space(3))) bf16x8*)(kb + d0 * 2048);
        const bf16x8 b1 = *(const __attribute__((address_space(3))) bf16x8*)(kb + d0 * 2048 + 512);
        if (d0 == 0) { p0 = __builtin_amdgcn_mfma_f32_32x32x16_bf16(b0, qr[0], negm, 0, 0, 0); p1 = __builtin_amdgcn_mfma_f32_32x32x16_bf16(b1, qr[0], negm, 0, 0, 0); }
        else { p0 = __builtin_amdgcn_mfma_f32_32x32x16_bf16(b0, qr[d0], p0, 0, 0, 0); p1 = __builtin_amdgcn_mfma_f32_32x32x16_bf16(b1, qr[d0], p1, 0, 0, 0); }
    }
}
__device__ __forceinline__ void kload8(bf16x8* kf, lds_cptr kp) {
    kf[0] = *(const __attribute__((address_space(3))) bf16x8*)(kp);        kf[1] = *(const __attribute__((address_space(3))) bf16x8*)(kp + 512);
    kf[2] = *(const __attribute__((address_space(3))) bf16x8*)(kp + 2048); kf[3] = *(const __attribute__((address_space(3))) bf16x8*)(kp + 2560);
    kf[4] = *(const __attribute__((address_space(3))) bf16x8*)(kp + 4096); kf[5] = *(const __attribute__((address_space(3))) bf16x8*)(kp + 4608);
    kf[6] = *(const __attribute__((address_space(3))) bf16x8*)(kp + 6144); kf[7] = *(const __attribute__((address_space(3))) bf16x8*)(kp + 6656);
}
__device__ __forceinline__ void kload2(bf16x8* kf, lds_cptr kp, int j) { kf[2 * j] = *(const __attribute__((address_space(3))) bf16x8*)(kp + j * 2048); kf[2 * j + 1] = *(const __attribute__((address_space(3))) bf16x8*)(kp + j * 2048 + 512); }
__device__ __forceinline__ s16x4 vtr(lds_cptr p) { return __builtin_bit_cast(s16x4, __builtin_amdgcn_ds_read_tr16_b64_v4i16((__attribute__((address_space(3))) v4i16_t*)p)); }
__device__ __forceinline__ float rowmax(const f32x16& p0, const f32x16& p1) {
    float a = max3f(p0[0], p0[1], p1[0]), b = max3f(p0[2], p0[3], p1[1]); a = max3f(a, p1[2], p1[3]);
#pragma unroll
    for (int r = 4; r < 16; r += 4) { a = max3f(a, p0[r], p0[r + 1]); b = max3f(b, p0[r + 2], p0[r + 3]); a = max3f(a, p1[r], p1[r + 1]); b = max3f(b, p1[r + 2], p1[r + 3]); }
    const float m = max2f(a, b);
    auto rr = __builtin_amdgcn_permlane32_swap(__float_as_uint(m), __float_as_uint(m), false, false);
    return max2f(__uint_as_float(rr[0]), __uint_as_float(rr[1]));
}
__device__ __forceinline__ void pv(f32x16* o, int vb, bf16x8 pa0, bf16x8 pa1, bf16x8 pa2, bf16x8 pa3) {
#pragma unroll
    for (int d0 = 0; d0 < 2; ++d0) { s16x4 lo[4], hi[4];
#pragma unroll
        for (int ks = 0; ks < 4; ++ks) {
            asm volatile("ds_read_b64_tr_b16 %0,%1 offset:%c2" : "=&v"(lo[ks]) : "v"(vb), "i"(d0 * 4096 + ks * 1024) : "memory");
            asm volatile("ds_read_b64_tr_b16 %0,%1 offset:%c2" : "=&v"(hi[ks]) : "v"(vb), "i"(d0 * 4096 + ks * 1024 + 512) : "memory"); }
        asm volatile("s_waitcnt lgkmcnt(0)" ::: "memory"); SBAR();
#define PK(k) (bf16x8){lo[k][0], lo[k][1], lo[k][2], lo[k][3], hi[k][0], hi[k][1], hi[k][2], hi[k][3]}
        o[d0] = __builtin_amdgcn_mfma_f32_32x32x16_bf16(pa0, PK(0), o[d0], 0, 0, 0);
        o[d0] = __builtin_amdgcn_mfma_f32_32x32x16_bf16(pa1, PK(1), o[d0], 0, 0, 0);
        o[d0] = __builtin_amdgcn_mfma_f32_32x32x16_bf16(pa2, PK(2), o[d0], 0, 0, 0);
        o[d0] = __builtin_amdgcn_mfma_f32_32x32x16_bf16(pa3, PK(3), o[d0], 0, 0, 0);
#undef PK
    }
}
__device__ __forceinline__ void wmask(f32x16& p0, f32x16& p1, int dl, int r32, int hi) {
    const float NEG = -INFINITY;
#pragma unroll
    for (int r = 0; r < 16; ++r) { const int rel = dl + crow(r, hi) - r32; if (rel < -128 || rel > 128) p0[r] = NEG; if (rel + 32 < -128 || rel + 32 > 128) p1[r] = NEG; }
}

template <int THRL> __device__ __forceinline__ void attn_unit(int b, int n, int kvh, int hp, int base, bool primed, bool has_next, int nb, int nn, int nkvh, int nhp, bf16x8 (&qr)[4], int& nbase,
                                                              const bf16_t* Y, bf16_t* O, int ldo, const bf16_t* KB, const bf16_t* VB, const float* sink, LAS unsigned char* shm) {
    const int tid = threadIdx.x, lane = tid & 63, r32 = lane & 31, hi = lane >> 5; const int wid = __builtin_amdgcn_readfirstlane(tid >> 6);
    const int head = kvh * 4 + hp * 2 + (wid >> 2), qsub = wid & 3;
    const long qrow0 = (long)b * SEQ + n * 128 + qsub * 32;
    const bf16_t* Qw = Y + qrow0 * 2048 + 1024 + head * 64;
    const unsigned lds0 = (unsigned)(uintptr_t)shm;
    LAS float* wsf = (LAS float*)(shm + LDS_WS) + wid * 64;
    const long koff = (long)lane * 256 + kvh * 64 + wid * 8;
    const long voff = (long)(16 * (wid & 3) + (lane >> 2)) * 256 + kvh * 64 + (wid >> 2) * 32 + (lane & 3) * 8;
    const unsigned kdst = lds0 + LDS_K + wid * 1024, vdst = lds0 + LDS_V + wid * 1024;
    const int jlo = (n == 0) ? 2 : 0, jhi = (n == 31) ? 3 : 5, NT = 4 + (jhi - jlo + 1);
    const long lrow0 = (long)b * SEQ + (n - 1) * 128 + 64 * (jlo - 4), crow0 = (long)NTOK + b * CTXL;
#define TROW(t) ((t) < 4 ? crow0 + 64 * (t) : lrow0 + 64 * (t))
#define DMA_K(t, slot) glds16(KB + TROW(t) * 256 + koff, (unsigned)__builtin_amdgcn_readfirstlane(kdst + (slot)))
#define DMA_V(t, slot) glds16(VB + TROW(t) * 256 + voff, (unsigned)__builtin_amdgcn_readfirstlane(vdst + (slot)))
    const int vb0 = (int)(lds0 + LDS_V) + ((lane >> 4) & 1) * 32 + (lane & 3) * 8 + (4 * hi + ((lane & 15) >> 2)) * 64;
    bf16x8 kf[8];
    const lds_cptr shm3 = (lds_cptr)shm; const lds_cptr kp0 = shm3 + LDS_K + hi * 1024 + r32 * 16; const lds_cptr vp0 = shm3 + LDS_V + ((lane >> 4) & 1) * 32 + (lane & 3) * 8 + (4 * hi + ((lane & 15) >> 2)) * 64;
    const int s0 = base, s1 = (s0 == (NSLOT - 1) * SLOTB) ? 0 : s0 + SLOTB, s2 = (s1 == (NSLOT - 1) * SLOTB) ? 0 : s1 + SLOTB;
    if (!primed) {
        DMA_K(0, s0); DMA_V(0, s0); DMA_K(1, s1); DMA_K(2, s2);
#pragma unroll
        for (int d0 = 0; d0 < 4; ++d0) qr[d0] = *(const bf16x8*)(Qw + (long)r32 * 2048 + d0 * 16 + hi * 8);
    }
    float mhat = 0.f, l_reg = 0.f; f32x16 o[2]; o[0] = f32x16{}; o[1] = f32x16{}; f32x16 negm = f32x16{}; asm volatile("" : "+v"(negm));
    const int dq = -128 - 32 * qsub;
#define CMASK(P0, P1, t) do { if ((t) >= 4) { const int dl_ = 64 * (jlo + (t) - 4) + dq; if (dl_ < -97 || dl_ > 65) wmask(P0, P1, dl_, r32, hi); } } while (0)
    bool resc = false;
#define START(P0, P1) do { const float rm = rowmax(P0, P1); resc = false; \
    { const float dl = rm; mhat = fadd_s(mhat, dl); \
      _Pragma("unroll") for (int r = 0; r < 16; ++r) { P0[r] = fsub_s(P0[r], dl); P1[r] = fsub_s(P1[r], dl); } \
      _Pragma("unroll") for (int r = 0; r < 16; ++r) negm[r] = -mhat; asm volatile("" : "+v"(negm)); } \
    _Pragma("unroll") for (int r = 0; r < 16; ++r) P0[r] = __builtin_amdgcn_exp2f(P0[r]); } while (0)
#define RESC() do { if (resc) { asm volatile("s_waitcnt lgkmcnt(0)" ::: "memory"); \
      _Pragma("unroll") for (int d_ = 0; d_ < 2; ++d_) _Pragma("unroll") for (int r = 0; r < 16; ++r) o[d_][r] *= wsf[crow(r, hi)]; } } while (0)
    f32x16 pA0, pA1, pB0, pB1;
    int sl_prev = s0, sl_cur = s0, sl_next = s1;
#define ROT() do { sl_prev = sl_cur; sl_cur = sl_next; sl_next = (sl_next == (NSLOT - 1) * SLOTB) ? 0 : sl_next + SLOTB; } while (0)
    WAIT_BAR(7);
    qkt(pA0, pA1, shm3 + LDS_K + s0, qr, negm, r32, hi); asm volatile("s_nop 15\n\ts_nop 7" : "+v"(pA0), "+v"(pA1)); CMASK(pA0, pA1, 0);
    START(pA0, pA1);
    _Pragma("unroll") for (int r = 0; r < 16; ++r) pA1[r] = __builtin_amdgcn_exp2f(pA1[r]);
    WAIT_BAR(0);
    DMA_K(3, s0); DMA_V(1, s1);
    ROT();
    kload8(kf, kp0 + sl_cur);
    WAIT_BAR(2);
    s16x4 vlo[8], vhi[8]; u32x4 pw0, pw1, pw2, pw3;
#define PKW(P, B) cvtpk_s(P[B], P[B + 1])
#define PAF(k) __builtin_bit_cast(bf16x8, pw##k)
#define VFR(i) (bf16x8){vlo[i][0], vlo[i][1], vlo[i][2], vlo[i][3], vhi[i][0], vhi[i][1], vhi[i][2], vhi[i][3]}
#define PIN(x) asm volatile("" : "+v"(x))
#define MX3(a, b, c) __builtin_fmaxf(__builtin_fmaxf((a), (b)), (c))
#define GAPA(MF, A0, A1, A2, A3, W0, W1, PW) do { MF; sacc += A0; sacc += A1; sacc += A2; sacc += A3; PIN(sacc); W0; W1; PIN(PW); SBAR(); } while (0)
#define EX(v) __builtin_amdgcn_exp2f(v)
#define GAPB(MF, X, B) do { MF; X[B] = EX(X[B]); X[B + 1] = EX(X[B + 1]); X[B + 2] = EX(X[B + 2]); X[B + 3] = EX(X[B + 3]); PIN(X); SBAR(); } while (0)
#define VRD(i) do { vlo[i] = vtr(vp_ + (((i) >> 2) * 4096 + ((i) & 3) * 1024)); vhi[i] = vtr(vp_ + (((i) >> 2) * 4096 + ((i) & 3) * 1024 + 512)); } while (0)
#define KRD(G, j) do { if (G) { kload2(kf, kp0 + sl_next, j); SBAR(); } } while (0)
#define STEP(C0, C1, P0, P1, t, GK, GV, GL) do { SBAR(); \
    const lds_cptr vp_ = vp0 + sl_prev; \
    VRD(0); SBAR(); float sacc = (P0[0] + P0[1]); \
    GAPA(C0 = __builtin_amdgcn_mfma_f32_32x32x16_bf16(kf[0], qr[0], negm, 0, 0, 0), P0[2], P0[3], P0[4], P0[5],     pw0[0] = PKW(P0, 0), pw0[1] = PKW(P0, 2), pw0); \
    VRD(4); SBAR(); GAPA(C1 = __builtin_amdgcn_mfma_f32_32x32x16_bf16(kf[1], qr[0], negm, 0, 0, 0), P0[6], P0[7], P0[8], P0[9],     pw0[2] = PKW(P0, 4), pw0[3] = PKW(P0, 6), pw0); \
    VRD(1); SBAR(); GAPA(C0 = __builtin_amdgcn_mfma_f32_32x32x16_bf16(kf[2], qr[1], C0, 0, 0, 0),   P0[10], P0[11], P0[12], P0[13], pw1[0] = PKW(P0, 8), pw1[1] = PKW(P0, 10), pw1); \
    VRD(5); SBAR(); GAPA(C1 = __builtin_amdgcn_mfma_f32_32x32x16_bf16(kf[3], qr[1], C1, 0, 0, 0),   P0[14], P0[15], P1[0], P1[1],   pw1[2] = PKW(P0, 12), pw1[3] = PKW(P0, 14), pw1); \
    VRD(2); SBAR(); GAPA(C0 = __builtin_amdgcn_mfma_f32_32x32x16_bf16(kf[4], qr[2], C0, 0, 0, 0),   P1[2], P1[3], P1[4], P1[5],     pw2[0] = PKW(P1, 0), pw2[1] = PKW(P1, 2), pw2); \
    VRD(6); SBAR(); GAPA(C1 = __builtin_amdgcn_mfma_f32_32x32x16_bf16(kf[5], qr[2], C1, 0, 0, 0),   P1[6], P1[7], P1[8], P1[9],     pw2[2] = PKW(P1, 4), pw2[3] = PKW(P1, 6), pw2); \
    VRD(3); SBAR(); GAPA(C0 = __builtin_amdgcn_mfma_f32_32x32x16_bf16(kf[6], qr[3], C0, 0, 0, 0),   P1[10], P1[11], P1[12], P1[13], pw3[0] = PKW(P1, 8), pw3[1] = PKW(P1, 10), pw3); \
    VRD(7); SBAR(); GAPA(C1 = __builtin_amdgcn_mfma_f32_32x32x16_bf16(kf[7], qr[3], C1, 0, 0, 0),   P1[14], P1[15], 0.f, 0.f,       pw3[2] = PKW(P1, 12), pw3[3] = PKW(P1, 14), pw3); \
    l_reg += sacc; \
    if (GK) { DMA_K((t) + 3, sl_cur); } if (GV) { DMA_V((t) + 1, sl_next); } \
    CMASK(C0, C1, t); \
    { float a = MX3(C0[0], C0[1], C1[0]), b2 = MX3(C0[2], C0[3], C1[1]); a = MX3(a, C1[2], C1[3]); \
      _Pragma("unroll") for (int r = 4; r < 16; r += 4) { a = MX3(a, C0[r], C0[r + 1]); b2 = MX3(b2, C0[r + 2], C0[r + 3]); a = MX3(a, C1[r], C1[r + 1]); b2 = MX3(b2, C1[r + 2], C1[r + 3]); } \
      float rm = __builtin_fmaxf(a, b2); { auto rr = __builtin_amdgcn_permlane32_swap(__float_as_uint(rm), __float_as_uint(rm), false, false); rm = __builtin_fmaxf(__uint_as_float(rr[0]), __uint_as_float(rr[1])); } \
      resc = false; \
      if (__builtin_expect(__any(rm > (float)THRL), 0)) { const float dl = __builtin_fmaxf(rm, 0.f); mhat += dl; \
        _Pragma("unroll") for (int r = 0; r < 16; ++r) { C0[r] -= dl; C1[r] -= dl; } \
        _Pragma("unroll") for (int r = 0; r < 16; ++r) negm[r] = -mhat; asm volatile("" : "+v"(negm)); \
        const float f = __builtin_amdgcn_exp2f(-dl); l_reg *= f; if (hi == 0) wsf[r32] = f; resc = true; } } \
    SBAR(); \
    GAPB(o[0] = __builtin_amdgcn_mfma_f32_32x32x16_bf16(PAF(0), VFR(0), o[0], 0, 0, 0), C0, 0); \
    GAPB(o[1] = __builtin_amdgcn_mfma_f32_32x32x16_bf16(PAF(0), VFR(4), o[1], 0, 0, 0), C0, 4); \
    KRD(GL, 0); GAPB(o[0] = __builtin_amdgcn_mfma_f32_32x32x16_bf16(PAF(1), VFR(1), o[0], 0, 0, 0), C0, 8); \
    KRD(GL, 1); GAPB(o[1] = __builtin_amdgcn_mfma_f32_32x32x16_bf16(PAF(1), VFR(5), o[1], 0, 0, 0), C0, 12); \
    KRD(GL, 2); GAPB(o[0] = __builtin_amdgcn_mfma_f32_32x32x16_bf16(PAF(2), VFR(2), o[0], 0, 0, 0), C1, 0); \
    KRD(GL, 3); GAPB(o[1] = __builtin_amdgcn_mfma_f32_32x32x16_bf16(PAF(2), VFR(6), o[1], 0, 0, 0), C1, 4); \
    GAPB(o[0] = __builtin_amdgcn_mfma_f32_32x32x16_bf16(PAF(3), VFR(3), o[0], 0, 0, 0), C1, 8); \
    GAPB(o[1] = __builtin_amdgcn_mfma_f32_32x32x16_bf16(PAF(3), VFR(7), o[1], 0, 0, 0), C1, 12); \
    } while (0)
#define ENDW(tt) do { if ((tt) + 3 < NT) { WAIT_BAR(2); } else if ((tt) + 2 < NT) { WAIT_BAR(1); } else { WAIT_BAR(0); } } while (0)
    int t = 1;
    for (; t + 1 < NT; t += 2) {
        STEP(pB0, pB1, pA0, pA1, t, (t + 3 < NT), (t + 1 < NT), (t + 1 < NT));       ENDW(t);     RESC(); ROT();
        STEP(pA0, pA1, pB0, pB1, t + 1, (t + 4 < NT), (t + 2 < NT), (t + 2 < NT));   ENDW(t + 1); RESC(); ROT();
    }
    nbase = sl_next;
    if (has_next) {
        const long nr = (long)NTOK + nb * CTXL; const long nko = (long)lane * 256 + nkvh * 64 + wid * 8, nvo = (long)(16 * (wid & 3) + (lane >> 2)) * 256 + nkvh * 64 + (wid >> 2) * 32 + (lane & 3) * 8;
        const int n0 = sl_next, n1 = (n0 == (NSLOT - 1) * SLOTB) ? 0 : n0 + SLOTB, n2 = (n1 == (NSLOT - 1) * SLOTB) ? 0 : n1 + SLOTB;
        glds16(KB + nr * 256 + nko, (unsigned)__builtin_amdgcn_readfirstlane(kdst + n0)); glds16(VB + nr * 256 + nvo, (unsigned)__builtin_amdgcn_readfirstlane(vdst + n0));
        glds16(KB + (nr + 64) * 256 + nko, (unsigned)__builtin_amdgcn_readfirstlane(kdst + n1)); glds16(KB + (nr + 128) * 256 + nko, (unsigned)__builtin_amdgcn_readfirstlane(kdst + n2));
    }
    STEP(pB0, pB1, pA0, pA1, NT - 1, false, false, false); RESC();
    { float sacc = pB0[0] + pB0[1]; _Pragma("unroll") for (int r = 2; r < 16; ++r) sacc += pB0[r]; _Pragma("unroll") for (int r = 0; r < 16; ++r) sacc += pB1[r]; l_reg += sacc;
      pw0 = (u32x4){PKW(pB0, 0), PKW(pB0, 2), PKW(pB0, 4), PKW(pB0, 6)}; pw1 = (u32x4){PKW(pB0, 8), PKW(pB0, 10), PKW(pB0, 12), PKW(pB0, 14)}; pw2 = (u32x4){PKW(pB1, 0), PKW(pB1, 2), PKW(pB1, 4), PKW(pB1, 6)}; pw3 = (u32x4){PKW(pB1, 8), PKW(pB1, 10), PKW(pB1, 12), PKW(pB1, 14)};
      SBAR(); pv(o, vb0 + sl_cur, PAF(0), PAF(1), PAF(2), PAF(3)); }
    if (has_next) {
        asm volatile("" ::: "memory");
        const bf16_t* nQw = Y + ((long)nb * SEQ + nn * 128 + qsub * 32) * 2048 + 1024 + (nkvh * 4 + nhp * 2 + (wid >> 2)) * 64;
#pragma unroll
        for (int d0 = 0; d0 < 4; ++d0) qr[d0] = *(const bf16x8*)(nQw + (long)r32 * 2048 + d0 * 16 + hi * 8);
    }
    { auto rr = __builtin_amdgcn_permlane32_swap(__float_as_uint(l_reg), __float_as_uint(l_reg), false, false); l_reg = __uint_as_float(rr[0]) + __uint_as_float(rr[1]); }
    l_reg += __builtin_amdgcn_exp2f(fminf(sink[head] * LOG2E - mhat, 80.f));
    if (hi == 0) wsf[32 + r32] = l_reg; asm volatile("s_waitcnt lgkmcnt(0)" ::: "memory");
    float rli[16];
#pragma unroll
    for (int r = 0; r < 16; ++r) rli[r] = __builtin_amdgcn_rcpf(wsf[32 + crow(r, hi)]);
    bf16_t* Ow = O + qrow0 * ldo + head * 64;
    { LAS bf16_t* stg = (LAS bf16_t*)(shm + LDS_OST) + wid * 2048;
#pragma unroll
      for (int r = 0; r < 16; ++r) { const int orow = crow(r, hi);
#pragma unroll
          for (int d0 = 0; d0 < 2; ++d0) stg[orow * 64 + d0 * 32 + r32] = (bf16_t)(pk2(o[d0][r] * rli[r], 0.f) & 0xffffu); }
      asm volatile("s_waitcnt lgkmcnt(0)" ::: "memory");
#pragma unroll
      for (int i = 0; i < 4; ++i) { const int row = i * 8 + (lane >> 3), ch = lane & 7; const u32x4 v = *(const LAS u32x4*)(stg + row * 64 + ch * 8); *(u32x4*)(Ow + (long)row * ldo + ch * 8) = v; } }
    asm volatile("s_waitcnt lgkmcnt(0)\n\ts_barrier" ::: "memory");
#undef TROW
#undef DMA_K
#undef DMA_V
#undef CMASK
#undef START
#undef RESC
#undef ROT
#undef PKW
#undef PAF
#undef VFR
#undef PIN
#undef MX3
#undef GAPA
#undef GAPB
#undef EX
#undef VRD
#undef KRD
#undef STEP
#undef ENDW
}
#undef SBAR
#undef WAIT_BAR
}

#define XB_TMO      128
#define XB_XCNT(j)  (256  + 64 * (j))
#define XB_XSUB(j)  (1280 + 64 * (j))
#define XB_XGEN(j)  (2304 + 64 * (j))
#define XB_TOP      3328
#define XB_TOPGEN   3392
#define XCD_BAR_WORDS 3456
#define XB_SPIN_CAP (1u << 18)
__device__ __forceinline__ unsigned xb_ld(unsigned* p)              { return __hip_atomic_load(p, __ATOMIC_RELAXED, __HIP_MEMORY_SCOPE_AGENT); }
__device__ __forceinline__ unsigned xb_add(unsigned* p, unsigned v) { return __hip_atomic_fetch_add(p, v, __ATOMIC_RELAXED, __HIP_MEMORY_SCOPE_AGENT); }
__device__ __forceinline__ unsigned xb_xcc_id() { return (unsigned)__builtin_amdgcn_s_getreg((3 << 11) | 20) & 0xFu; }
#define XB_SPIN(cond, bar) do { unsigned _sp = 0; while (cond) { __builtin_amdgcn_s_sleep(1); \
    if ((++_sp & 255u) == 0u) { if (xb_ld(&(bar)[XB_TMO])) break; if (_sp > XB_SPIN_CAP) { atomicAdd(&(bar)[XB_TMO], 1u); break; } } } } while (0)
struct XcdBarrier { unsigned* bar; unsigned x; volatile LAS unsigned* st; };
__device__ __forceinline__ XcdBarrier xcd_barrier_post(unsigned* bar, volatile LAS unsigned* st) {
    XcdBarrier b; b.bar = bar; b.x = xb_xcc_id(); b.st = st;
    if (threadIdx.x == 0) (void)xb_add(&bar[XB_XCNT(b.x)], 1u);
    return b;
}
__device__ __forceinline__ void xcd_barrier_complete(unsigned* bar, unsigned x, unsigned& nloc, unsigned& nx) {
    const unsigned G = gridDim.x * gridDim.y * gridDim.z;
    unsigned sum, cnt, mine, sp = 0u;
    for (;;) {
        sum = 0u; cnt = 0u; mine = 0u;
#pragma unroll
        for (unsigned j = 0; j < 16; ++j) { const unsigned c = xb_ld(&bar[XB_XCNT(j)]); sum += c; cnt += (c > 0u) ? 1u : 0u; mine = (j == x) ? c : mine; }
        if (sum == G) break;
        __builtin_amdgcn_s_sleep(1);
        if ((++sp & 255u) == 0u) { if (xb_ld(&bar[XB_TMO])) break; if (sp > XB_SPIN_CAP) { atomicAdd(&bar[XB_TMO], 1u); break; } }
    }
    nloc = mine > 0u ? mine : 1u; nx = cnt > 0u ? cnt : 1u;
}
__device__ __forceinline__ void xcd_barrier(const XcdBarrier& b) {
    asm volatile("s_waitcnt vmcnt(0)" ::: "memory");
    __syncthreads();
    if (threadIdx.x == 0) {
        unsigned* bar = b.bar;
        __builtin_amdgcn_s_waitcnt(0);
        unsigned nloc = b.st[0], nx = b.st[1];
        if (nloc == 0u) { xcd_barrier_complete(bar, b.x, nloc, nx); b.st[0] = nloc; b.st[1] = nx; }
        const unsigned old = xb_add(&bar[XB_XSUB(b.x)], 1u);
        const unsigned gen = old / nloc;
        if (old + 1u == (gen + 1u) * nloc) {
            __builtin_amdgcn_fence(__ATOMIC_RELEASE, "agent");
            asm volatile("s_waitcnt vmcnt(0)" ::: "memory");
            const unsigned og = xb_add(&bar[XB_TOP], 1u);
            const unsigned tg = og / nx;
            if (og + 1u == (tg + 1u) * nx) xb_add(&bar[XB_TOPGEN], 1u);
            else XB_SPIN(xb_ld(&bar[XB_TOPGEN]) == tg, bar);
            __builtin_amdgcn_fence(__ATOMIC_ACQUIRE, "agent");
            xb_add(&bar[XB_XGEN(b.x)], 1u);
            asm volatile("s_waitcnt vmcnt(0)" ::: "memory");
        } else {
            XB_SPIN(xb_ld(&bar[XB_XGEN(b.x)]) == gen, bar);
            __builtin_amdgcn_fence(__ATOMIC_ACQUIRE, "agent");
            asm volatile("s_waitcnt vmcnt(0)" ::: "memory");
        }
    }
    __syncthreads();
}
constexpr int LDSCTL_OFF = LDS_BYTES - 256;
constexpr int CW_BAR = 4096;

#ifndef PROBE_GMLP2
#define PROBE_GMLP2 0
#endif
#ifndef ATT_PIPE
#define ATT_PIPE 1
#endif
#ifndef ATT_THRL
#define ATT_THRL 8
#endif
#ifndef ONE_LAUNCH
#define ONE_LAUNCH 1
#endif
#ifndef FAST_MIX
#define FAST_MIX 1
#endif
#ifndef PROBE_SEQ
#define PROBE_SEQ 0, 1, 2, 3, 4, 5, 6, 7, 8, 9, 10, 11
#endif

enum { PH_PRO = 0, PH_HN, PH_IN, PH_MIX, PH_A, PH_O, PH_H2R, PH_WCONV, PH_TOPK, PH_GU, PH_D, PH_FIN, PH_COUNT };

__global__ void __launch_bounds__(NTHREADS, 2) fwd(Args args) {
    extern __shared__ __attribute__((aligned(16))) unsigned char lds_raw[];
    LAS unsigned char* lds = (LAS unsigned char*)lds_raw;
    const int tid = threadIdx.x, lane = tid & 63, wave = __builtin_amdgcn_readfirstlane(tid >> 6);
    const int G = gridDim.x, bid = blockIdx.x;
    unsigned char* ws = args.ws;
    const int lo = args.ph_lo, hi = args.ph_hi;
#define IN(k) (lo <= (k) && (k) < hi)
    float* MOD = (float*)(ws + WS_MOD); f32x2* ROPE = (f32x2*)(ws + WS_ROPE);
    float* AFFT = (float*)(ws + WS_AFFT); int* TOPI = (int*)(ws + WS_TOPI); float* TOPW = (float*)(ws + WS_TOPW); int* SLOT = (int*)(ws + WS_SLOT);
    bf16_t* WSP = (bf16_t*)(ws + WS_WSP); bf16_t* WIN = (bf16_t*)(ws + WS_WIN); bf16_t* WAB = (bf16_t*)(ws + WS_WAB); bf16_t* WO = (bf16_t*)(ws + WS_WO);
    bf16_t* H = (bf16_t*)(ws + WS_H); bf16_t* VA = (bf16_t*)(ws + WS_VA); bf16_t* KB = (bf16_t*)(ws + WS_KB); bf16_t* VB = (bf16_t*)(ws + WS_VB);
    bf16_t* GT = (bf16_t*)(ws + WS_G); bf16_t* Y = (bf16_t*)(ws + WS_Y); bf16_t* TMP = (bf16_t*)(ws + WS_TMP); bf16_t* MERGED = (bf16_t*)(ws + WS_MERGED);
    bf16_t* WGU = (bf16_t*)(ws + WS_WGU); bf16_t* WD = (bf16_t*)(ws + WS_WD); bf16_t* H2 = (bf16_t*)(ws + WS_H2); bf16_t* ACT = (bf16_t*)(ws + WS_ACT); bf16_t* YB = (bf16_t*)(ws + WS_YB);
    const int gw = bid * NWAVES + wave, NGW = G * NWAVES;
    if (tid < 64) ((LAS unsigned*)(lds + LDSCTL_OFF))[tid] = 0u;
    __syncthreads();
    XcdBarrier bar; bar.bar = (unsigned*)(ws + WS_CTL) + CW_BAR; bar.x = 0; bar.st = nullptr;
    if (ONE_LAUNCH) bar = xcd_barrier_post((unsigned*)(ws + WS_CTL) + CW_BAR, (volatile LAS unsigned*)(lds + LDSCTL_OFF));
#define SEAM(k) do { if (ONE_LAUNCH && IN(k) && IN((k) + 1)) xcd_barrier(bar); } while (0)

    if (IN(PH_PRO)) {
        if (bid < 192) adaln_task(bid, args.in[I_C], args.in[I_CCTX], args.in[I_WADA], args.in[I_BADA], MOD, (LAS float*)lds, tid);
        else if (bid == 192) rope_table(ROPE, tid);
        __syncthreads();
        for (int i = bid * NTHREADS + tid; i < 8 * 128 * 128 / 4; i += G * NTHREADS) st4bf(WSP + 4 * i, *(const f32x4*)(args.in[I_WSP] + 4 * i));
        LAS float* scr = (LAS float*)(lds + wave * 16384);
        constexpr int I_IN = 16 * 176, I_P = 16 * 32;
        for (int it = gw; it < I_IN + 3 * I_P; it += NGW) {
            int r = it;
            if (r < I_IN) { const int kb = r / 176, nb = r % 176; transpose_item(args.in[I_WIN], INCOLS, kb * 64, nb * 32, WIN + (size_t)(nb * 32) * 1024 + kb * 64, 1024, scr, lane); continue; } r -= I_IN;
            if (r < I_P) { const int kb = r / 32, nb = r % 32; transpose_item(args.in[I_WPA], 1024, kb * 64, nb * 32, WAB + (size_t)(nb * 32) * 2048 + kb * 64, 2048, scr, lane); continue; } r -= I_P;
            if (r < I_P) { const int kb = r / 32, nb = r % 32; transpose_item(args.in[I_WPB], 1024, kb * 64, nb * 32, WAB + (size_t)(nb * 32) * 2048 + 1024 + kb * 64, 2048, scr, lane); continue; } r -= I_P;
            { const int kb = r / 32, nb = r % 32; transpose_item(args.in[I_WOUT], 1024, kb * 64, nb * 32, WO + (size_t)(nb * 32) * 1024 + kb * 64, 1024, scr, lane); }
        }
    }
    SEAM(PH_PRO);
    if (IN(PH_HN)) {
        const float* g1n = args.in[I_N1G];
        auto hn_row = [&](int row) {
            const float* xr; int mrow;
            if (row < NTOK) { xr = args.in[I_X] + (size_t)row * 1024; mrow = row >> 12; } else { xr = args.in[I_CTX] + (size_t)(row - NTOK) * 1024; mrow = 8; }
            const float* sh = MOD + mrow * 6144; const float* sc = sh + 1024;
            f32x4 v[4]; float ss = 0.f;
#pragma unroll
            for (int j = 0; j < 4; ++j) { v[j] = *(const f32x4*)(xr + 4 * lane + 256 * j); ss += (v[j].x * v[j].x + v[j].y * v[j].y) + (v[j].z * v[j].z + v[j].w * v[j].w); }
            const float rstd = 1.0f / sqrtf(wave_sum(ss) * (1.f / 1024.f) + EPS);
#pragma unroll
            for (int j = 0; j < 4; ++j) {
                const int col = 4 * lane + 256 * j;
                const f32x4 gv = *(const f32x4*)(g1n + col), scv = *(const f32x4*)(sc + col), shv = *(const f32x4*)(sh + col);
                const f32x4 h = (v[j] * rstd * gv) * (1.f + scv) + shv;
                st4bf(H + (size_t)row * 1024 + col, h);
            }
        };
        for (int row = gw; row < NROWS_H; row += NGW) hn_row(row);
    }
    SEAM(PH_HN);
    if (IN(PH_IN)) {
        Gemm g{H, WIN, 1024, 1024, 1024, 0, 30, nullptr}; StaticOrder S; S.init(NTOK, INCOLS, G, bid, 16);
        EpiIn E{Y, VA, KB, VB, GT, args.in[I_BMG], ROPE, (f32x2*)(ws + WS_STATS)};
        GEMM_PHASE<EpiIn, StaticOrder, false>(lds, g, S, E);
    }
    SEAM(PH_IN);
    if (IN(PH_MIX) && FAST_MIX) {
        if (!(args.flags & 8)) for (int task = bid; task < NB * 32; task += G) mix::gmlp_unit(task, Y, (args.flags & 2) ? TMP : Y, (args.flags & 2) ? 1024 : 2048, VA, WSP, (const f32x2*)(ws + WS_STATS), args.in[I_LNG], args.in[I_LNB], args.in[I_BSP], lds);
#if ATT_PIPE
        att2::bf16x8 att_qr[4]; int att_base = 0; bool att_primed = false;
#endif
        if (!(args.flags & 1)) for (int task = bid; task < NB * 32 * 4; task += G) {
#if ATT_PIPE
            for (int hp = 0; hp < 2; ++hp) {
                const bool more = (hp == 0) || (task + G < NB * 32 * 4); const int ntask = hp == 0 ? task : task + G; int nbase_ = 0;
                att2::attn_unit<ATT_THRL>(task >> 7, (task >> 2) & 31, task & 3, hp, att_base, att_primed, more, ntask >> 7, (ntask >> 2) & 31, ntask & 3, hp ^ 1, att_qr, nbase_,
                                          Y, (args.flags & 4) ? TMP : Y + 1024, (args.flags & 4) ? 1024 : 2048, KB, VB, args.in[I_SINK], lds);
                att_base = nbase_; att_primed = more;
            }
#else
            mix::attn_unit(task >> 7, (task >> 2) & 31, task & 3, Y, (args.flags & 4) ? TMP : Y + 1024, (args.flags & 4) ? 1024 : 2048, KB, VB, args.in[I_SINK], lds);
#endif
        }
    }
    SEAM(PH_MIX);
    if (IN(PH_A)) {
        Gemm g{Y, WAB, 2048, 2048, 2048, 0, 30, nullptr}; StaticOrder S; S.init(NTOK, 1024, G, bid, 0, 1);
        EpiAB E{MERGED, GT};
        GEMM_PHASE<EpiAB, StaticOrder, false, true>(lds, g, S, E);
    }
    SEAM(PH_A);
    if (IN(PH_O)) {
        Gemm g{MERGED, WO, 1024, 1024, 1024, 0, 30, nullptr}; StaticOrder S; S.init(NTOK, 1024, G, bid);
        EpiO E{args.out, args.in[I_X], MOD};
        GEMM_PHASE<EpiO, StaticOrder, false>(lds, g, S, E);
    }
    SEAM(PH_O);
    if (IN(PH_H2R)) {
        LAS float* wT = (LAS float*)lds;
        { f32x4 wv[8];
#pragma unroll
          for (int k = 0; k < 8; ++k) wv[k] = *(const f32x4*)(args.in[I_WR] + 4 * (tid + NTHREADS * k));
#pragma unroll
          for (int k = 0; k < 8; ++k) { const int f = tid + NTHREADS * k, col = f >> 2, e0 = 4 * (f & 3); wT[e0 * 1024 + col] = wv[k].x; wT[(e0 + 1) * 1024 + col] = wv[k].y; wT[(e0 + 2) * 1024 + col] = wv[k].z; wT[(e0 + 3) * 1024 + col] = wv[k].w; } }
        __syncthreads();
        const float* g2n = args.in[I_N2G];
        const bool h32 = lane & 32, h16 = lane & 16, h8 = lane & 8, h4 = lane & 4;
        const int myexp = 8 * (lane >> 5) + 4 * ((lane >> 4) & 1) + 2 * ((lane >> 3) & 1) + ((lane >> 2) & 1);
        f32x4 vn[2][4];
#pragma unroll
        for (int q = 0; q < 2; ++q)
#pragma unroll
            for (int j = 0; j < 4; ++j) vn[q][j] = *(const f32x4*)(args.out + (size_t)(2 * (NTOK / 2 - 1 - (gw < NTOK / 2 ? gw : 0)) + q) * 1024 + 4 * lane + 256 * j);
        for (int rp = gw; rp < NTOK / 2; rp += NGW) {
            const int row0 = 2 * (NTOK / 2 - 1 - rp), b = row0 >> 12;
            const float* sh = MOD + b * 6144 + 3072; const float* sc = sh + 1024;
            f32x4 v[2][4]; float ss[2] = {0.f, 0.f};
#pragma unroll
            for (int q = 0; q < 2; ++q)
#pragma unroll
                for (int j = 0; j < 4; ++j) { v[q][j] = vn[q][j]; ss[q] += (v[q][j].x * v[q][j].x + v[q][j].y * v[q][j].y) + (v[q][j].z * v[q][j].z + v[q][j].w * v[q][j].w); }
            { const int rn = (rp + NGW < NTOK / 2) ? rp + NGW : rp;
#pragma unroll
              for (int q = 0; q < 2; ++q)
#pragma unroll
                  for (int j = 0; j < 4; ++j) vn[q][j] = *(const f32x4*)(args.out + (size_t)(2 * (NTOK / 2 - 1 - rn) + q) * 1024 + 4 * lane + 256 * j); }
            float rstd[2];
#pragma unroll
            for (int q = 0; q < 2; ++q) rstd[q] = 1.0f / sqrtf(wave_sum(ss[q]) * (1.f / 1024.f) + EPS);
            float lg[2][16];
#pragma unroll
            for (int q = 0; q < 2; ++q)
#pragma unroll
                for (int e = 0; e < 16; ++e) lg[q][e] = 0.f;
            f32x4 wb[2][4];
#pragma unroll
            for (int e = 0; e < 4; ++e) wb[0][e] = *(const LAS f32x4*)(wT + e * 1024 + 4 * lane);
            f32x4 h[2];
#pragma unroll
            for (int g = 0; g < 16; ++g) {
                const int j = g >> 2, eg = g & 3, col = 4 * lane + 256 * j;
                if (g + 1 < 16) {
                    const int jn = (g + 1) >> 2, en = (g + 1) & 3;
#pragma unroll
                    for (int e = 0; e < 4; ++e) wb[(g + 1) & 1][e] = *(const LAS f32x4*)(wT + (4 * en + e) * 1024 + 4 * lane + 256 * jn);
                }
                if (eg == 0) {
                    const f32x4 gv = *(const f32x4*)(g2n + col), scv = *(const f32x4*)(sc + col), shv = *(const f32x4*)(sh + col);
#pragma unroll
                    for (int q = 0; q < 2; ++q) { h[q] = (v[q][j] * rstd[q] * gv) * (1.f + scv) + shv; st4bf(H2 + (size_t)(row0 + q) * 1024 + col, h[q]); }
                }
#pragma unroll
                for (int e = 0; e < 4; ++e) {
                    const f32x4 w = wb[g & 1][e];
#pragma unroll
                    for (int q = 0; q < 2; ++q) lg[q][4 * eg + e] += (h[q].x * w.x + h[q].y * w.y) + (h[q].z * w.z + h[q].w * w.w);
                    asm volatile("" : "+v"(lg[0][4 * eg + e]), "+v"(lg[1][4 * eg + e]));
                }
                asm volatile("" ::: "memory");
            }
#pragma unroll
            for (int q = 0; q < 2; ++q) {
                float a8[8], a4[4], a2[2], a1;
#pragma unroll
                for (int i = 0; i < 8; ++i) { const float send = h32 ? lg[q][i] : lg[q][i + 8], keep = h32 ? lg[q][i + 8] : lg[q][i]; a8[i] = keep + __shfl_xor(send, 32); }
#pragma unroll
                for (int i = 0; i < 4; ++i) { const float send = h16 ? a8[i] : a8[i + 4], keep = h16 ? a8[i + 4] : a8[i]; a4[i] = keep + __shfl_xor(send, 16); }
#pragma unroll
                for (int i = 0; i < 2; ++i) { const float send = h8 ? a4[i] : a4[i + 2], keep = h8 ? a4[i + 2] : a4[i]; a2[i] = keep + __shfl_xor(send, 8); }
                { const float send = h4 ? a2[0] : a2[1], keep = h4 ? a2[1] : a2[0]; a1 = keep + __shfl_xor(send, 4); }
                a1 += __shfl_xor(a1, 2); a1 += __shfl_xor(a1, 1);
                float mx = a1;
#pragma unroll
                for (int o = 4; o < 64; o <<= 1) mx = fmaxf(mx, __shfl_xor(mx, o));
                const float p = __expf(a1 - mx); float den = p;
#pragma unroll
                for (int o = 4; o < 64; o <<= 1) den += __shfl_xor(den, o);
                if ((lane & 3) == 0) AFFT[(size_t)(b * 16 + myexp) * SEQ + ((row0 + q) & (SEQ - 1))] = p / den;
            }
        }
    }
    if (IN(PH_WCONV)) {
        __syncthreads();
        LAS float* scr = (LAS float*)(lds + wave * 16384);
        constexpr int I_G = 16 * 16 * 64, I_D = 16 * 32 * 32;
        auto item = [&](int it) -> TrItem {
            int r = it; TrItem t;
            if (r < 2 * I_G) {
                const int up = r >= I_G; if (up) r -= I_G;
                const int e = r >> 10, kb = (r >> 6) & 15, nb = r & 63, n0 = nb * 32;
                const int drow = 256 * (n0 >> 7) + (n0 & 127) + (up ? 128 : 0);
                t.src = args.in[up ? I_WEU : I_WEG] + (size_t)e * 1024 * 2048 + (size_t)(kb * 64) * 2048 + n0; t.N = 2048;
                t.dst = WGU + (size_t)e * 4096 * 1024 + (size_t)drow * 1024 + kb * 64; t.ldt = 1024;
            } else {
                r -= 2 * I_G;
                const int e = r >> 10, kb = (r >> 5) & 31, nb = r & 31;
                t.src = args.in[I_WED] + (size_t)e * 2048 * 1024 + (size_t)(kb * 64) * 1024 + nb * 32; t.N = 1024;
                t.dst = WD + (size_t)e * 1024 * 2048 + (size_t)(nb * 32) * 2048 + kb * 64; t.ldt = 2048;
            }
            return t;
        };
        constexpr int NIT = 2 * I_G + I_D;
        if (gw < NIT) {
            TrItem cur = item(gw); f32x4 vc[8], vn[8];
            tr_load(cur, vc, lane);
            for (int it = gw; it < NIT; it += NGW) {
                const bool more = it + NGW < NIT;
                TrItem nxt = cur;
                if (more) { nxt = item(it + NGW); tr_load(nxt, vn, lane); }
                tr_store(cur, vc, scr, lane);
                cur = nxt;
#pragma unroll
                for (int i = 0; i < 8; ++i) vc[i] = vn[i];
            }
        }
    }
    SEAM(PH_WCONV);
    if (IN(PH_TOPK)) {
        LAS int* wsum = (LAS int*)lds;
        for (int task = bid; task < NE * NB; task += G) {
            const int e = task >> 3, b = task & 7;
            const float* aff = AFFT + (size_t)(b * 16 + e) * SEQ;
            unsigned k[8];
            { const u32x4 a0 = *(const u32x4*)(aff + 8 * tid), a1 = *(const u32x4*)(aff + 8 * tid + 4); k[0] = a0.x; k[1] = a0.y; k[2] = a0.z; k[3] = a0.w; k[4] = a1.x; k[5] = a1.y; k[6] = a1.z; k[7] = a1.w; }
            unsigned T = 0u; int it = 0;
            __syncthreads();
            for (int bit = 30; bit >= 0; --bit, ++it) {
                const unsigned cand = T | (1u << bit); int c = 0;
#pragma unroll
                for (int j = 0; j < 8; ++j) c += __builtin_popcountll(__ballot(k[j] >= cand));
                if (lane == 0) wsum[(it & 1) * 8 + wave] = c;
                __syncthreads();
                int tot = 0;
#pragma unroll
                for (int w = 0; w < 8; ++w) tot += wsum[(it & 1) * 8 + w];
                if (tot >= CAP) T = cand;
            }
            int cg = 0, ce = 0;
#pragma unroll
            for (int j = 0; j < 8; ++j) { cg += (k[j] > T) ? 1 : 0; ce += (k[j] == T) ? 1 : 0; }
            LAS int* sc1 = wsum + 16; LAS int* sc2 = wsum + 32;
            int ie = ce, ig = cg;
#pragma unroll
            for (int o = 1; o < 64; o <<= 1) { const int te = __shfl_up(ie, o), tg = __shfl_up(ig, o); if (lane >= o) { ie += te; ig += tg; } }
            __syncthreads();
            if (lane == 63) { sc1[wave] = ie; sc2[wave] = ig; }
            __syncthreads();
            int ebase = ie - ce, totg = 0;
#pragma unroll
            for (int w = 0; w < 8; ++w) { if (w < wave) ebase += sc1[w]; totg += sc2[w]; }
            const int need = CAP - totg;
            int sel[8], cs = 0, er = ebase;
#pragma unroll
            for (int j = 0; j < 8; ++j) { const bool eq = (k[j] == T); sel[j] = (k[j] > T) || (eq && er < need); er += eq ? 1 : 0; cs += sel[j]; }
            int is = cs;
#pragma unroll
            for (int o = 1; o < 64; o <<= 1) { const int ts = __shfl_up(is, o); if (lane >= o) is += ts; }
            __syncthreads();
            if (lane == 63) sc1[wave] = is;
            __syncthreads();
            int sbase = is - cs;
#pragma unroll
            for (int w = 0; w < 8; ++w) if (w < wave) sbase += sc1[w];
#pragma unroll
            for (int j = 0; j < 8; ++j) {
                const int t = 8 * tid + j; int slot = -1;
                if (sel[j]) { slot = sbase; ++sbase; const int prow = (e * 8 + b) * CAP + slot; TOPI[prow] = t; TOPW[prow] = __uint_as_float(k[j]); }
                SLOT[((size_t)b * SEQ + t) * 16 + e] = slot;
            }
            __syncthreads();
        }
    }
    SEAM(PH_TOPK);
    if (IN(PH_GU)) {
        Gemm g{H2, WGU, 1024, 1024, 1024, (size_t)4096 * 1024, 4, TOPI}; StaticOrder S; S.init(NPAIR, 4096, G, bid);
        EpiGU E{ACT};
        GEMM_PHASE<EpiGU, StaticOrder, true>(lds, g, S, E);
    }
    SEAM(PH_GU);
    if (IN(PH_D)) {
        Gemm g{ACT, WD, 2048, 2048, 2048, (size_t)1024 * 2048, 4, nullptr}; StaticOrder S; S.init(NPAIR, 1024, G, bid, 0, 1);
        EpiD E{YB, TOPW};
        GEMM_PHASE<EpiD, StaticOrder, false>(lds, g, S, E);
    }
    SEAM(PH_D);
    if (IN(PH_FIN)) {
        const float* fg = args.in[I_FING];
        const bf16_t* ZROW = (const bf16_t*)(ws + WS_CTL + 512 * 1024);
        int sln[2] = {-1, -1};
        if (gw < NTOK / 2 && lane < 16) { sln[0] = SLOT[(size_t)(2 * gw) * 16 + lane]; sln[1] = SLOT[(size_t)(2 * gw + 1) * 16 + lane]; }
        for (int rp = gw; rp < NTOK / 2; rp += NGW) {
            const int row0 = 2 * rp, b = row0 >> 12;
            const int sl[2] = {sln[0], sln[1]};
            { const int rn = rp + NGW; if (rn < NTOK / 2 && lane < 16) { sln[0] = SLOT[(size_t)(2 * rn) * 16 + lane]; sln[1] = SLOT[(size_t)(2 * rn + 1) * 16 + lane]; } }
            const float* g2 = MOD + b * 6144 + 5120;
            f32x4 xv[2][4], acc[2][4];
#pragma unroll
            for (int q = 0; q < 2; ++q)
#pragma unroll
                for (int h = 0; h < 2; ++h) { const float* xp = args.out + (size_t)(row0 + q) * 1024 + 512 * h + 8 * lane; xv[q][2 * h] = *(const f32x4*)xp; xv[q][2 * h + 1] = *(const f32x4*)(xp + 4);
                    acc[q][2 * h] = (f32x4){0.f, 0.f, 0.f, 0.f}; acc[q][2 * h + 1] = (f32x4){0.f, 0.f, 0.f, 0.f}; }
#pragma unroll
            for (int q = 0; q < 2; ++q) {
                unsigned long long mask = __ballot(sl[q] >= 0);
                for (;;) {
                    const bf16_t* yr[4];
#pragma unroll
                    for (int k = 0; k < 4; ++k) {
                        if (mask) { const int ex = __builtin_ctzll(mask); mask &= mask - 1; const int s = __builtin_amdgcn_readlane(sl[q], ex); yr[k] = YB + (size_t)((ex * 8 + b) * CAP + s) * 1024; }
                        else yr[k] = ZROW;
                    }
                    u32x4 y[4][2];
#pragma unroll
                    for (int k = 0; k < 4; ++k)
#pragma unroll
                        for (int h = 0; h < 2; ++h) y[k][h] = *(const u32x4*)(yr[k] + 512 * h + 8 * lane);
#pragma unroll
                    for (int k = 0; k < 4; ++k)
#pragma unroll
                        for (int h = 0; h < 2; ++h) { const u32x4 w = y[k][h];
                            acc[q][2 * h] += (f32x4){bf2f(w.x & 0xffffu), bf2f(w.x >> 16), bf2f(w.y & 0xffffu), bf2f(w.y >> 16)};
                            acc[q][2 * h + 1] += (f32x4){bf2f(w.z & 0xffffu), bf2f(w.z >> 16), bf2f(w.w & 0xffffu), bf2f(w.w >> 16)}; }
                    if (!mask) break;
                }
            }
#pragma unroll
            for (int q = 0; q < 2; ++q) {
                float ss = 0.f;
#pragma unroll
                for (int h = 0; h < 2; ++h)
#pragma unroll
                    for (int u4 = 0; u4 < 2; ++u4) { const int col = 512 * h + 8 * lane + 4 * u4; f32x4& v = xv[q][2 * h + u4]; v = v + *(const f32x4*)(g2 + col) * acc[q][2 * h + u4]; ss += (v.x * v.x + v.y * v.y) + (v.z * v.z + v.w * v.w); }
                const float rstd = 1.0f / sqrtf(wave_sum(ss) * (1.f / 1024.f) + EPS);
#pragma unroll
                for (int h = 0; h < 2; ++h)
#pragma unroll
                    for (int u4 = 0; u4 < 2; ++u4) { const int col = 512 * h + 8 * lane + 4 * u4; *(f32x4*)(args.out + (size_t)(row0 + q) * 1024 + col) = xv[q][2 * h + u4] * rstd * *(const f32x4*)(fg + col); }
            }
        }
    }
#undef IN
}

extern "C" void kernel_launch(void* const* d_in, const int* in_sizes, int n_in, void* d_out, int out_size, void* d_ws, size_t ws_size, hipStream_t stream) {
    static int grid = 0;
    if (grid == 0) {
        if (n_in != 23 || in_sizes[0] != NTOK * DM || out_size != NTOK * DM || ws_size < WS_END) {
            fprintf(stderr, "kernel_launch: unexpected problem (n_in %d, in0 %d, out %d, ws %zu < %zu?)\n", n_in, n_in > 0 ? in_sizes[0] : -1, out_size, ws_size, (size_t)WS_END); grid = -1; return; }
        if (hipFuncSetAttribute((const void*)fwd, hipFuncAttributeMaxDynamicSharedMemorySize, LDS_BYTES) != hipSuccess) { fprintf(stderr, "kernel_launch: hipFuncSetAttribute failed\n"); grid = -1; return; }
        int dev = 0, cus = 0;
        if (hipGetDevice(&dev) != hipSuccess || hipDeviceGetAttribute(&cus, hipDeviceAttributeMultiprocessorCount, dev) != hipSuccess) { grid = -1; return; }
        grid = cus;
    }
    if (grid < 0) return;
    (void)hipMemsetAsync((char*)d_ws + WS_CTL, 0, 1 * MiB, stream);
    Args a{};
    for (int i = 0; i < 23; ++i) a.in[i] = (const float*)d_in[i];
    a.out = (float*)d_out; a.ws = (unsigned char*)d_ws;
    if (ONE_LAUNCH) {
        a.ph_lo = 0; a.ph_hi = PH_COUNT;
        hipLaunchKernelGGL(fwd, dim3(grid), dim3(NTHREADS), LDS_BYTES, stream, a);
    } else {
        static const int seq[] = {PROBE_SEQ};
        for (unsigned i = 0; i < sizeof(seq) / sizeof(seq[0]); ++i) {
            a.ph_lo = seq[i] % 100; a.ph_hi = seq[i] % 100 + 1; a.flags = seq[i] / 100;
            hipLaunchKernelGGL(fwd, dim3(grid), dim3(NTHREADS), LDS_BYTES, stream, a);
        }
    }
}
```

```cpp
#include <hip/hip_runtime.h>
#include <cstdio>
#include <cstdint>

#define LAS __attribute__((address_space(3)))
typedef unsigned short bf16_t;
typedef float f32x4 __attribute__((ext_vector_type(4)));
typedef float f32x2 __attribute__((ext_vector_type(2)));
typedef unsigned u32x4 __attribute__((ext_vector_type(4)));
typedef unsigned u32x2 __attribute__((ext_vector_type(2)));
typedef int i32x4 __attribute__((ext_vector_type(4)));

constexpr int DM = 1024, NB = 8, SEQ = 4096, NTOK = NB * SEQ, CTXL = 256, NCTX = NB * CTXL, NROWS_H = NTOK + NCTX;
constexpr int INCOLS = 5632, OFF_Q = 2048, OFF_K = 3072, OFF_VB = 3328, OFF_GATE = 3584;
constexpr int NE = 16, CAP = 512, DE = 2048, NPAIR = NE * NB * CAP;
constexpr float EPS = 1e-6f, LOG2E = 1.4426950408889634f, C2 = 0.125f * LOG2E;
constexpr int NTHREADS = 512, NWAVES = 8;

constexpr size_t MiB = 1u << 20;
constexpr size_t WS_CTL = 0;
constexpr size_t WS_MOD = 1 * MiB;
constexpr size_t WS_ROPE = 1 * MiB + 512 * 1024;
constexpr size_t WS_AFFT = 2 * MiB;
constexpr size_t WS_TOPI = 4 * MiB;
constexpr size_t WS_TOPW = 4 * MiB + 512 * 1024;
constexpr size_t WS_SLOT = 5 * MiB;
constexpr size_t WS_WSP = 7 * MiB;
constexpr size_t WS_WIN = 8 * MiB;
constexpr size_t WS_WAB = 19 * MiB;
constexpr size_t WS_WO = 23 * MiB;
constexpr size_t WS_R = 25 * MiB;
constexpr size_t WS_H = WS_R;
constexpr size_t WS_VA = WS_R + 68 * MiB;
constexpr size_t WS_KB = WS_VA + 64 * MiB;
constexpr size_t WS_VB = WS_KB + 17 * MiB;
constexpr size_t WS_G = WS_VB + 17 * MiB;
constexpr size_t WS_Y = WS_G + 128 * MiB;
constexpr size_t WS_TMP = WS_Y + 128 * MiB;
constexpr size_t WS_STATS = WS_TMP + 64 * MiB;
constexpr size_t WS_MERGED = WS_H;
constexpr size_t WS_WGU = WS_R;
constexpr size_t WS_WD = WS_R + 128 * MiB;
constexpr size_t WS_H2 = WS_R + 192 * MiB;
constexpr size_t WS_ACT = WS_R + 256 * MiB;
constexpr size_t WS_YB = WS_WGU;
constexpr size_t WS_END = 537 * MiB;
static_assert(WS_STATS + 4 * MiB <= WS_END && WS_ACT + 256 * MiB == WS_END, "ws map");

constexpr int LDS_BYTES = 147456;

__device__ __forceinline__ float bf2f(unsigned b) { return __uint_as_float(b << 16); }
__device__ __forceinline__ unsigned f2bf(float f) { unsigned u = __float_as_uint(f); return (u + 0x7fffu + ((u >> 16) & 1u)) >> 16; }
__device__ __forceinline__ unsigned pk2(float lo, float hi) { typedef float f2_ __attribute__((ext_vector_type(2))); typedef __bf16 b2_ __attribute__((ext_vector_type(2))); f2_ v = {lo, hi}; b2_ b = __builtin_convertvector(v, b2_); return __builtin_bit_cast(unsigned, b); }
__device__ __forceinline__ void st4bf(bf16_t* p, f32x4 v) { u32x2 w; w.x = pk2(v.x, v.y); w.y = pk2(v.z, v.w); *(u32x2*)p = w; }
__device__ __forceinline__ void st8bf(bf16_t* p, f32x4 a, f32x4 b) { u32x4 w; w.x = pk2(a.x, a.y); w.y = pk2(a.z, a.w); w.z = pk2(b.x, b.y); w.w = pk2(b.z, b.w); *(u32x4*)p = w; }
__device__ __forceinline__ void ld8bf(const bf16_t* p, f32x4& a, f32x4& b) { const u32x4 w = *(const u32x4*)p; a.x = bf2f(w.x & 0xffffu); a.y = bf2f(w.x >> 16); a.z = bf2f(w.y & 0xffffu); a.w = bf2f(w.y >> 16); b.x = bf2f(w.z & 0xffffu); b.y = bf2f(w.z >> 16); b.z = bf2f(w.w & 0xffffu); b.w = bf2f(w.w >> 16); }
__device__ __forceinline__ f32x4 ld4bf(const bf16_t* p) { const u32x2 w = *(const u32x2*)p; f32x4 v; v.x = bf2f(w.x & 0xffffu); v.y = bf2f(w.x >> 16); v.z = bf2f(w.y & 0xffffu); v.w = bf2f(w.y >> 16); return v; }
__device__ __forceinline__ float sigmoidf_(float x) { return __builtin_amdgcn_rcpf(1.f + __builtin_amdgcn_exp2f(x * -1.4426950409f)); }
__device__ __forceinline__ float siluf_(float x) { return x * __builtin_amdgcn_rcpf(1.f + __builtin_amdgcn_exp2f(x * -1.4426950409f)); }
__device__ __forceinline__ float gelu_t(float x) { const float t = x * __builtin_fmaf(x * x, -0.10294324f, -2.3022082f); return x * __builtin_amdgcn_rcpf(1.f + __builtin_amdgcn_exp2f(t)); }
__device__ __forceinline__ f32x2 rcp2_(f32x2 d) { f32x2 r; r.x = __builtin_amdgcn_rcpf(d.x); r.y = __builtin_amdgcn_rcpf(d.y); return r; }
__device__ __forceinline__ f32x2 exp2_2_(f32x2 t) { f32x2 e; e.x = __builtin_amdgcn_exp2f(t.x); e.y = __builtin_amdgcn_exp2f(t.y); return e; }
__device__ __forceinline__ f32x2 gelu2_(f32x2 x) { const f32x2 t = x * ((x * x) * -0.10294324f + -2.3022082f); return x * rcp2_(exp2_2_(t) + 1.0f); }
__device__ __forceinline__ f32x2 sigm2_(f32x2 x) { return rcp2_(exp2_2_(x * -1.4426950409f) + 1.0f); }
__device__ __forceinline__ f32x4 gelu4_(f32x4 v) { const f32x2 a = gelu2_((f32x2){v.x, v.y}), b = gelu2_((f32x2){v.z, v.w}); return (f32x4){a.x, a.y, b.x, b.y}; }
__device__ __forceinline__ f32x4 sigm4_(f32x4 v) { const f32x2 a = sigm2_((f32x2){v.x, v.y}), b = sigm2_((f32x2){v.z, v.w}); return (f32x4){a.x, a.y, b.x, b.y}; }
__device__ __forceinline__ float wave_sum(float v) {
#pragma unroll
    for (int o = 1; o < 64; o <<= 1) v += __shfl_xor(v, o);
    return v;
}
__device__ __forceinline__ int wave_sum_i(int v) {
#pragma unroll
    for (int o = 1; o < 64; o <<= 1) v += __shfl_xor(v, o);
    return v;
}
#define LDS_WAIT() asm volatile("s_waitcnt lgkmcnt(0)" ::: "memory")

struct Args { const float* in[23]; float* out; unsigned char* ws; int ph_lo, ph_hi, flags, pad; };
enum { I_X = 0, I_C, I_CTX, I_CCTX, I_WADA, I_BADA, I_N1G, I_WIN, I_BMG, I_LNG, I_LNB, I_WSP, I_BSP, I_SINK, I_WPA, I_WPB, I_WOUT, I_N2G, I_WR, I_WEG, I_WEU, I_WED, I_FING };

struct Unit { int pm, pn; };
struct Gemm {
    const bf16_t* A; const bf16_t* Bt; int lda, ldb, K;
    size_t bgs; int tpg_shift;
    const int* gidx;
};
constexpr int NXCD = 8, WGM = 8;
struct StaticOrder {
    int nM, nN, nwg, G, c, extra, rev;
    __device__ void init(int M, int N, int G_, int c_, int extra_ = 0, int rev_ = 0) { nM = M / 256; nN = N / 256; nwg = nM * nN; G = G_; c = c_; extra = extra_; rev = rev_; }
    __device__ bool next(int i, Unit& u) const {
        const long L = (long)i * G + c;
        if (L >= nwg) { const int x = (int)(L - nwg); if (x >= extra) return false; u.pm = NTOK / 256 + (x >> 1); u.pn = 12 + (x & 1); return true; }
        int wgid = (int)L; { const int q = nwg / NXCD, r = nwg % NXCD, xcd = wgid % NXCD, off = wgid / NXCD; wgid = (xcd < r ? xcd * (q + 1) : r * (q + 1) + (xcd - r) * q) + off; }
        const int nig = WGM * nN, gid = wgid / nig, fm = gid * WGM, gsz = (nM - fm) < WGM ? (nM - fm) : WGM;
        u.pm = fm + ((wgid % nig) % gsz); u.pn = (wgid % nig) / gsz; if (rev) u.pm = nM - 1 - u.pm; return true;
    }
};

struct OneUnit { int pm, pn; __device__ bool next(int i, Unit& u) const { if (i) return false; u.pm = pm; u.pn = pn; return true; } };

typedef f32x4 Acc[2][2][4][2];

namespace pg8 {
typedef short bf16x8 __attribute__((ext_vector_type(8)));
constexpr int BK = 64, HALF = 128, HTB = HALF * BK * 2, STAGE_BYTES = 8 * HTB;
__device__ __forceinline__ int lds_byte(int r, int c) { const int st = (r >> 4) * 2 + (c >> 5), rr = r & 15, cc = c & 31, ob = rr * 64 + cc * 2; return st * 1024 + (ob ^ (((ob >> 9) & 1) << 5)); }
__device__ __forceinline__ void stage_rc(int b, int& R, int& C) { const int st = b / 1024, sb = b % 1024, swz = sb ^ (((sb >> 9) & 1) << 5); R = (st >> 1) * 16 + swz / 64; C = (st & 1) * 32 + (swz % 64) / 2; }

template <class Epi, class Sched, bool GATHER, bool HOOK = false>
__device__ __forceinline__ void gemm_phase(LAS unsigned char* lds, const Gemm g, const Sched& S, const Epi& E) {
    const int tid = threadIdx.x, wid = __builtin_amdgcn_readfirstlane(tid >> 6), lane = tid & 63, wr = wid >> 2, wc = wid & 3, fr = lane & 15, fq = lane >> 4;
    const int nt = g.K / BK;
    int Rs[2], Cs[2]; unsigned voffBp[2][2], voffB[2], voffBn[2], vA[2][2], vN[2][2];
#pragma unroll
    for (int i = 0; i < 2; ++i) { stage_rc(tid * 16 + i * 8192, Rs[i], Cs[i]); voffBp[0][i] = (unsigned)(Rs[i] * g.ldb + Cs[i]) * 2u;
        const int rho = Rs[i] & 31, Rb = (Rs[i] & ~31) + 8 * ((rho & 15) >> 2) + 4 * (rho >> 4) + (rho & 3); voffBp[1][i] = (unsigned)(Rb * g.ldb + Cs[i]) * 2u; }
    const size_t kstep = (size_t)(BK * 2);
    const size_t hstepB = (size_t)HALF * g.ldb * 2;
    const unsigned ldsw = (unsigned)wid * 1024u;
    const int aoff = lds_byte(wr * 64 + fr, fq * 8), boff = lds_byte(wc * 32 + fr, fq * 8);
#define PG8_SA(b, h) (((b) * 2 + (h)) * HTB)
#define PG8_SB(b, h) ((4 + (b) * 2 + (h)) * HTB)
#define PG8_STAGE(bufoff, gbase, voff) do { _Pragma("unroll") for (int _i = 0; _i < 2; ++_i) \
        __builtin_amdgcn_global_load_lds((const unsigned*)((const char*)(gbase) + (voff)[_i]), (LAS unsigned*)(lds + (bufoff) + ldsw + _i * 8192), 16, 0, 0); } while (0)
#define PG8_LDA(dst, b, h) do { _Pragma("unroll") for (int m = 0; m < 4; ++m) _Pragma("unroll") for (int k = 0; k < 2; ++k) dst[m][k] = *(const LAS bf16x8*)(lds + PG8_SA(b, h) + aoff + m * 2048 + k * 1024); } while (0)
#define PG8_LDB(dst, b, h) do { _Pragma("unroll") for (int n = 0; n < 2; ++n) _Pragma("unroll") for (int k = 0; k < 2; ++k) dst[n][k] = *(const LAS bf16x8*)(lds + PG8_SB(b, h) + boff + n * 2048 + k * 1024); } while (0)
#define PG8_MMA(ai, bj, At, Bt) do { __builtin_amdgcn_s_setprio(1); _Pragma("unroll") for (int m = 0; m < 4; ++m) _Pragma("unroll") for (int n = 0; n < 2; ++n) _Pragma("unroll") for (int k = 0; k < 2; ++k) \
        acc[ai][bj][m][n] = __builtin_amdgcn_mfma_f32_16x16x32_bf16(Bt[n][k], At[m][k], acc[ai][bj][m][n], 0, 0, 0); __builtin_amdgcn_s_setprio(0); } while (0)
#define PG8_WAIT_V(n) asm volatile("s_waitcnt vmcnt(" #n ")" ::: "memory")
#define PG8_WAIT_L(n) asm volatile("s_waitcnt lgkmcnt(" #n ")" ::: "memory")
#define PG8_BAR __builtin_amdgcn_s_barrier()
#define PG8_SCHED __builtin_amdgcn_sched_barrier(0)
#define PG8_AVOFF(dst, U) do { _Pragma("unroll") for (int _h = 0; _h < 2; ++_h) _Pragma("unroll") for (int _i = 0; _i < 2; ++_i) \
        dst[_h][_i] = GATHER ? (unsigned)((((U).pm >> 1) & 7) * SEQ + g.gidx[(U).pm * 256 + _h * 128 + Rs[_i]]) * (unsigned)(g.lda * 2) + (unsigned)(Cs[_i] * 2) \
                             : (unsigned)((_h * 128 + Rs[_i]) * g.lda + Cs[_i]) * 2u; } while (0)
#define PG8_ABASE(U) ((const char*)g.A + (GATHER ? (size_t)0 : (size_t)(U).pm * 256 * g.lda * 2))
#define PG8_BBASE(U) ((const char*)g.Bt + ((size_t)((U).pm >> g.tpg_shift) * g.bgs + (size_t)(U).pn * 256 * g.ldb) * 2)
    Unit cur, nxt; int ui = 0;
    if (!S.next(0, cur)) return;
    Acc acc;
#pragma unroll
    for (int a = 0; a < 2; ++a)
#pragma unroll
        for (int b = 0; b < 2; ++b)
#pragma unroll
            for (int m = 0; m < 4; ++m)
#pragma unroll
                for (int n = 0; n < 2; ++n) acc[a][b][m][n] = (f32x4){0.f, 0.f, 0.f, 0.f};
    bf16x8 At[4][2], B0[2][2], B1[2][2];
    PG8_AVOFF(vA, cur);
    { const bool pc = E.perm(cur); voffB[0] = pc ? voffBp[1][0] : voffBp[0][0]; voffB[1] = pc ? voffBp[1][1] : voffBp[0][1]; }
    const char* cA = PG8_ABASE(cur); const char* cB = PG8_BBASE(cur);
    PG8_STAGE(PG8_SB(0, 0), cB, voffB); PG8_STAGE(PG8_SB(0, 1), cB + hstepB, voffB); PG8_STAGE(PG8_SA(0, 0), cA, vA[0]); PG8_STAGE(PG8_SA(0, 1), cA, vA[1]);
    if (wr == 1) PG8_BAR;
    PG8_WAIT_V(2); PG8_BAR;
    PG8_STAGE(PG8_SB(1, 0), cB + kstep, voffB); PG8_STAGE(PG8_SA(1, 0), cA + kstep, vA[0]); PG8_STAGE(PG8_SB(1, 1), cB + hstepB + kstep, voffB);
    PG8_WAIT_V(6); PG8_BAR;
    for (;;) {
        const bool has_next = S.next(ui + 1, nxt);
        const char* nA = has_next ? PG8_ABASE(nxt) : cA; const char* nB = has_next ? PG8_BBASE(nxt) : cB;
        { const bool pn_ = has_next ? E.perm(nxt) : E.perm(cur); voffBn[0] = pn_ ? voffBp[1][0] : voffBp[0][0]; voffBn[1] = pn_ ? voffBp[1][1] : voffBp[0][1]; }
        if (GATHER) {
#pragma unroll
            for (int h = 0; h < 2; ++h)
#pragma unroll
                for (int i = 0; i < 2; ++i) vN[h][i] = vA[h][i];
            if (has_next && wid == 0)
                __builtin_amdgcn_global_load_lds((const unsigned*)(g.gidx + nxt.pm * 256 + lane * 4), (LAS unsigned*)(lds + STAGE_BYTES + (ui & 1) * 1024), 16, 0, 0);
        }
        for (int t = 0; t < nt; t += 2) {
            const bool last = (t == nt - 2);
            if (GATHER) { if (t == 4 && has_next) {
                const LAS int* li = (const LAS int*)(lds + STAGE_BYTES + (ui & 1) * 1024);
#pragma unroll
                for (int h = 0; h < 2; ++h)
#pragma unroll
                    for (int i = 0; i < 2; ++i) vN[h][i] = (unsigned)(((nxt.pm >> 1) & 7) * SEQ + li[h * 128 + Rs[i]]) * (unsigned)(g.lda * 2) + (unsigned)(Cs[i] * 2);
            } }
            if constexpr (HOOK) { if (t == (nt >> 1)) E.mid(acc, cur, wr, wc, fr, fq); }
            const char* a1 = cA + (size_t)(t + 1) * kstep;
            const char* a2 = last ? nA : cA + (size_t)(t + 2) * kstep; const char* b2 = last ? nB : cB + (size_t)(t + 2) * kstep;
            const char* a3 = a2 + kstep; const char* b3 = b2 + kstep;
            unsigned v2[2][2];
#pragma unroll
            for (int h = 0; h < 2; ++h)
#pragma unroll
                for (int i = 0; i < 2; ++i) v2[h][i] = (GATHER && last) ? vN[h][i] : vA[h][i];
            unsigned vb2[2]; vb2[0] = last ? voffBn[0] : voffB[0]; vb2[1] = last ? voffBn[1] : voffB[1];
            PG8_LDB(B0, 0, 0); PG8_LDB(B1, 0, 1); PG8_SCHED; PG8_LDA(At, 0, 0); PG8_STAGE(PG8_SA(1, 1), a1, vA[1]);
            PG8_WAIT_V(8); PG8_WAIT_L(0); PG8_BAR; PG8_MMA(0, 0, At, B0); PG8_MMA(0, 1, At, B1); PG8_BAR; PG8_SCHED;
            PG8_LDA(At, 0, 1); PG8_STAGE(PG8_SB(0, 0), b2, vb2); PG8_STAGE(PG8_SB(0, 1), b2 + hstepB, vb2); PG8_STAGE(PG8_SA(0, 0), a2, v2[0]);
            PG8_WAIT_V(8); PG8_WAIT_L(0); PG8_BAR; PG8_MMA(1, 0, At, B0); PG8_MMA(1, 1, At, B1); PG8_BAR; PG8_SCHED;
            PG8_LDB(B0, 1, 0); PG8_LDB(B1, 1, 1); PG8_SCHED; PG8_LDA(At, 1, 0); PG8_STAGE(PG8_SA(0, 1), a2, v2[1]);
            PG8_WAIT_V(8); PG8_WAIT_L(0); PG8_BAR; PG8_MMA(0, 0, At, B0); PG8_MMA(0, 1, At, B1); PG8_BAR; PG8_SCHED;
            PG8_LDA(At, 1, 1); PG8_STAGE(PG8_SB(1, 0), b3, vb2); PG8_STAGE(PG8_SB(1, 1), b3 + hstepB, vb2); PG8_STAGE(PG8_SA(1, 0), a3, v2[0]);
            PG8_WAIT_V(8); PG8_WAIT_L(0); PG8_BAR; PG8_MMA(1, 0, At, B0); PG8_MMA(1, 1, At, B1); PG8_BAR; PG8_SCHED;
        }
        if (wr == 0) PG8_BAR;
        E(acc, cur, wr, wc, fr, fq);
        if (!has_next) break;
#pragma unroll
        for (int a = 0; a < 2; ++a)
#pragma unroll
            for (int b = 0; b < 2; ++b)
#pragma unroll
                for (int m = 0; m < 4; ++m)
#pragma unroll
                    for (int n = 0; n < 2; ++n) acc[a][b][m][n] = (f32x4){0.f, 0.f, 0.f, 0.f};
        cur = nxt; cA = nA; cB = nB; ++ui; voffB[0] = voffBn[0]; voffB[1] = voffBn[1];
        if (GATHER) {
#pragma unroll
            for (int h = 0; h < 2; ++h)
#pragma unroll
                for (int i = 0; i < 2; ++i) vA[h][i] = vN[h][i];
        }
        if (wr == 1) PG8_BAR;
    }
    PG8_WAIT_V(0);
    PG8_BAR;
#undef PG8_SA
#undef PG8_SB
#undef PG8_STAGE
#undef PG8_LDA
#undef PG8_LDB
#undef PG8_MMA
#undef PG8_WAIT_V
#undef PG8_WAIT_L
#undef PG8_BAR
#undef PG8_SCHED
#undef PG8_AVOFF
#undef PG8_ABASE
#undef PG8_BBASE
}
}

#define GEMM_PHASE pg8::gemm_phase

struct EpiIn {
    bf16_t *Y, *VA, *KB, *VB, *G; const float* bgate; const f32x2* rope; f32x2* STATS;
    __device__ __forceinline__ bool perm(const Unit& u) const { return u.pn < 8 || u.pn > 12; }
    template <int KIND> __device__ __forceinline__ void run(const Acc& acc, const Unit& u, int wr, int wc, int fr, int fq) const {
        const int pn = u.pn;
#pragma unroll
        for (int ai = 0; ai < 2; ++ai)
#pragma unroll
            for (int m = 0; m < 4; ++m) {
                const int row = u.pm * 256 + ai * 128 + wr * 64 + m * 16 + fr;
                float ssum = 0.f, ssq = 0.f;
#pragma unroll
                for (int bj = 0; bj < 2; ++bj) {
                    f32x4 v0 = acc[ai][bj][m][0], v1 = acc[ai][bj][m][1];
                    if constexpr (KIND == 0 || KIND == 1) {
                        const int c8 = bj * 128 + wc * 32 + 8 * fq;
                        v0 = gelu4_(v0); v1 = gelu4_(v1);
                        if constexpr (KIND == 0) st8bf(Y + (size_t)row * 2048 + pn * 256 + c8, v0, v1);
                        else {
                            st8bf(VA + (size_t)row * 1024 + (pn - 4) * 256 + c8, v0, v1);
                            ssum += ((v0.x + v0.y) + (v0.z + v0.w)) + ((v1.x + v1.y) + (v1.z + v1.w));
                            ssq += ((v0.x * v0.x + v0.y * v0.y) + (v0.z * v0.z + v0.w * v0.w)) + ((v1.x * v1.x + v1.y * v1.y) + (v1.z * v1.z + v1.w * v1.w));
                        }
                    } else if constexpr (KIND == 2) {
                        const int cl = bj * 128 + wc * 32 + 4 * fq;
                        f32x4 o0 = v0, o1 = v1;
                        if (row < NTOK) {
                            const int t = row & (SEQ - 1), pos = (wc & 1) ? (t & 63) : (t >> 6);
                            const f32x2* rp = rope + pos * 16 + 4 * fq;
#pragma unroll
                            for (int j = 0; j < 4; ++j) { const f32x2 cs = rp[j]; o0[j] = v0[j] * cs.x - v1[j] * cs.y; o1[j] = v0[j] * cs.y + v1[j] * cs.x; }
                        }
                        if (pn < 12) { bf16_t* p = Y + (size_t)row * 2048 + 1024 + (pn - 8) * 256 + cl; st4bf(p, o0 * C2); st4bf(p + 16, o1 * C2); }
                        else { bf16_t* p = KB + (size_t)row * 256 + cl; st4bf(p, o0); st4bf(p + 16, o1); }
                    } else if constexpr (KIND == 3) {
                        st8bf(VB + (size_t)row * 256 + bj * 128 + wc * 32 + 8 * fq, v0, v1);
                    } else {
                        const int cg = (pn - 14) * 256 + bj * 128 + wc * 32 + 8 * fq;
                        const f32x4 b0 = *(const f32x4*)(bgate + cg), b1 = *(const f32x4*)(bgate + cg + 4);
                        v0 = sigm4_(v0 + b0); v1 = sigm4_(v1 + b1);
                        st8bf(G + (size_t)row * 2048 + cg, v0, v1);
                    }
                }
                if constexpr (KIND == 1) {
                    ssum += __shfl_xor(ssum, 16); ssum += __shfl_xor(ssum, 32); ssq += __shfl_xor(ssq, 16); ssq += __shfl_xor(ssq, 32);
                    if (fq == 0) STATS[(size_t)row * 16 + (pn - 4) * 4 + wc] = (f32x2){ssum, ssq};
                }
            }
    }
    __device__ __forceinline__ void operator()(const Acc& acc, const Unit& u, int wr, int wc, int fr, int fq) const {
        const int pn = u.pn;
        if (pn < 4) run<0>(acc, u, wr, wc, fr, fq);
        else if (pn < 8) run<1>(acc, u, wr, wc, fr, fq);
        else if (pn < 13) run<2>(acc, u, wr, wc, fr, fq);
        else if (pn == 13) run<3>(acc, u, wr, wc, fr, fq);
        else run<4>(acc, u, wr, wc, fr, fq);
    }
};
struct EpiAB {
    bf16_t* MERGED; const bf16_t* G;
    __device__ __forceinline__ bool perm(const Unit&) const { return true; }
    __device__ __forceinline__ void mid(Acc& acc, const Unit& u, int wr, int wc, int fr, int fq) const {
        int zero; asm volatile("v_mov_b32 %0, 0" : "=v"(zero));
        const bf16_t* gp = G + (size_t)(u.pm * 256 + wr * 64 + fr + zero) * 2048 + u.pn * 256 + wc * 32 + 8 * fq;
#pragma unroll
        for (int ai = 0; ai < 2; ++ai)
#pragma unroll
            for (int m = 0; m < 4; ++m) {
#pragma unroll
                for (int bj = 0; bj < 2; ++bj) {
                    const bf16_t* q = gp + (size_t)(ai * 128 + m * 16) * 2048 + bj * 128;
                    f32x4 ga0, ga1, gb0, gb1; ld8bf(q, ga0, ga1); ld8bf(q + 1024, gb0, gb1);
#pragma unroll
                    for (int j = 0; j < 4; ++j) { acc[ai][bj][m][0][j] *= ga0[j] * __builtin_amdgcn_rcpf(gb0[j]); acc[ai][bj][m][1][j] *= ga1[j] * __builtin_amdgcn_rcpf(gb1[j]); }
                    asm volatile("" ::: "memory");
                }
            }
    }
    __device__ __forceinline__ void operator()(const Acc& acc, const Unit& u, int wr, int wc, int fr, int fq) const {
#pragma unroll
        for (int ai = 0; ai < 2; ++ai)
#pragma unroll
            for (int m = 0; m < 4; ++m) {
                const int row = u.pm * 256 + ai * 128 + wr * 64 + m * 16 + fr;
#pragma unroll
                for (int bj = 0; bj < 2; ++bj) {
                    const int c8 = u.pn * 256 + bj * 128 + wc * 32 + 8 * fq;
                    f32x4 gb0, gb1; ld8bf(G + (size_t)row * 2048 + 1024 + c8, gb0, gb1);
                    st8bf(MERGED + (size_t)row * 1024 + c8, gb0 * acc[ai][bj][m][0], gb1 * acc[ai][bj][m][1]);
                }
            }
    }
};
struct EpiO {
    float* X1; const float* X; const float* mod;
    __device__ __forceinline__ bool perm(const Unit&) const { return false; }
    __device__ __forceinline__ void operator()(const Acc& acc, const Unit& u, int wr, int wc, int fr, int fq) const {
#pragma unroll
        for (int ai = 0; ai < 2; ++ai)
#pragma unroll
            for (int m = 0; m < 4; ++m) {
                const int row = u.pm * 256 + ai * 128 + wr * 64 + m * 16 + fr; const float* g1 = mod + (size_t)(row >> 12) * 6144 + 2048;
#pragma unroll
                for (int bj = 0; bj < 2; ++bj)
#pragma unroll
                    for (int n = 0; n < 2; ++n) {
                        const int c = u.pn * 256 + bj * 128 + wc * 32 + 16 * n + 4 * fq;
                        const f32x4 xv = *(const f32x4*)(X + (size_t)row * 1024 + c), gv = *(const f32x4*)(g1 + c);
                        *(f32x4*)(X1 + (size_t)row * 1024 + c) = xv + gv * acc[ai][bj][m][n];
                    }
            }
    }
};
struct EpiGU {
    bf16_t* ACT;
    __device__ __forceinline__ bool perm(const Unit&) const { return true; }
    __device__ __forceinline__ void operator()(const Acc& acc, const Unit& u, int wr, int wc, int fr, int fq) const {
#pragma unroll
        for (int ai = 0; ai < 2; ++ai)
#pragma unroll
            for (int m = 0; m < 4; ++m) {
                const int prow = u.pm * 256 + ai * 128 + wr * 64 + m * 16 + fr;
                f32x4 a[2];
#pragma unroll
                for (int n = 0; n < 2; ++n) {
                    const f32x4 gt = acc[ai][0][m][n], up = acc[ai][1][m][n];
                    a[n] = gt * sigm4_(gt) * up;
                }
                st8bf(ACT + (size_t)prow * 2048 + u.pn * 128 + wc * 32 + 8 * fq, a[0], a[1]);
            }
    }
};
struct EpiD {
    bf16_t* YB; const float* TOPW;
    __device__ __forceinline__ bool perm(const Unit&) const { return true; }
    __device__ __forceinline__ void operator()(const Acc& acc, const Unit& u, int wr, int wc, int fr, int fq) const {
#pragma unroll
        for (int ai = 0; ai < 2; ++ai)
#pragma unroll
            for (int m = 0; m < 4; ++m) {
                const int prow = u.pm * 256 + ai * 128 + wr * 64 + m * 16 + fr; const float w = TOPW[prow];
#pragma unroll
                for (int bj = 0; bj < 2; ++bj)
                    st8bf(YB + (size_t)prow * 1024 + u.pn * 256 + bj * 128 + wc * 32 + 8 * fq, acc[ai][bj][m][0] * w, acc[ai][bj][m][1] * w);
            }
    }
};

__device__ __forceinline__ void transpose_item(const float* W, int N, int k0, int n0, bf16_t* dst, int ldt, LAS float* scr, int lane) {
    const int kk = lane >> 3, nq = (lane & 7) * 4;
    f32x4 v[8];
#pragma unroll
    for (int i = 0; i < 8; ++i) v[i] = *(const f32x4*)(W + (size_t)(k0 + 8 * i + kk) * N + n0 + nq);
#pragma unroll
    for (int i = 0; i < 8; ++i) { LAS float* s = scr + (8 * i + kk) * 33 + nq; s[0] = v[i].x; s[1] = v[i].y; s[2] = v[i].z; s[3] = v[i].w; }
    LDS_WAIT();
    const int c = lane & 7;
#pragma unroll
    for (int j = 0; j < 4; ++j) {
        const int n = (lane >> 3) + 8 * j; const LAS float* s = scr + (8 * c) * 33 + n;
        u32x4 o; o.x = pk2(s[0 * 33], s[1 * 33]); o.y = pk2(s[2 * 33], s[3 * 33]); o.z = pk2(s[4 * 33], s[5 * 33]); o.w = pk2(s[6 * 33], s[7 * 33]);
        *(u32x4*)(dst + (size_t)n * ldt + 8 * c) = o;
    }
    LDS_WAIT();
}

struct TrItem { const float* src; bf16_t* dst; int N, ldt; };
__device__ __forceinline__ void tr_load(const TrItem& it, f32x4 (&v)[8], int lane) {
    const int kk = lane >> 3, nq = (lane & 7) * 4;
#pragma unroll
    for (int i = 0; i < 8; ++i) v[i] = *(const f32x4*)(it.src + (size_t)(8 * i + kk) * it.N + nq);
}
__device__ __forceinline__ void tr_store(const TrItem& it, const f32x4 (&v)[8], LAS float* scr, int lane) {
    const int kk = lane >> 3, nq = (lane & 7) * 4;
#pragma unroll
    for (int i = 0; i < 8; ++i) { LAS float* s = scr + (8 * i + kk) * 33 + nq; s[0] = v[i].x; s[1] = v[i].y; s[2] = v[i].z; s[3] = v[i].w; }
    LDS_WAIT();
    const int c = lane & 7;
#pragma unroll
    for (int j = 0; j < 4; ++j) {
        const int n = (lane >> 3) + 8 * j; const LAS float* s = scr + (8 * c) * 33 + n;
        u32x4 o; o.x = pk2(s[0 * 33], s[1 * 33]); o.y = pk2(s[2 * 33], s[3 * 33]); o.z = pk2(s[4 * 33], s[5 * 33]); o.w = pk2(s[6 * 33], s[7 * 33]);
        *(u32x4*)(it.dst + (size_t)n * it.ldt + 8 * c) = o;
    }
    LDS_WAIT();
}

__device__ __forceinline__ void adaln_task(int task, const float* c, const float* cctx, const float* w_ada, const float* b_ada, float* mod, LAS float* lds, int tid) {
    LAS float* s = lds; LAS float* red = lds + 9 * 1024;
    { float cv[18];
#pragma unroll
      for (int q = 0; q < 18; ++q) { const int i = tid + NTHREADS * q, r = i >> 10, k = i & 1023; cv[q] = r < 8 ? c[r * 1024 + k] : cctx[k]; }
#pragma unroll
      for (int q = 0; q < 18; ++q) s[tid + NTHREADS * q] = cv[q] * __builtin_amdgcn_rcpf(1.f + __expf(-cv[q])); }
    __syncthreads();
    const int ch = tid & 7, kr = tid >> 3;
    f32x4 acc[9];
#pragma unroll
    for (int r = 0; r < 9; ++r) acc[r] = (f32x4){0.f, 0.f, 0.f, 0.f};
    const float* wp = w_ada + (size_t)kr * 6144 + task * 32 + ch * 4;
    for (int it = 0; it < 16; ++it) {
        const f32x4 w = *(const f32x4*)(wp + (size_t)it * 64 * 6144); const int k = kr + it * 64;
#pragma unroll
        for (int r = 0; r < 9; ++r) acc[r] += s[r * 1024 + k] * w;
    }
#pragma unroll
    for (int r = 0; r < 9; ++r) *(LAS f32x4*)(red + (kr * 9 + r) * 32 + ch * 4) = acc[r];
    __syncthreads();
    if (tid < 288) { const int r = tid >> 5, col = tid & 31; float sum = 0.f; for (int q = 0; q < 64; ++q) sum += red[(q * 9 + r) * 32 + col]; mod[r * 6144 + task * 32 + col] = sum + b_ada[task * 32 + col]; }
    __syncthreads();
}

__device__ __forceinline__ void rope_table(f32x2* tab, int tid) {
    for (int idx = tid; idx < 1024; idx += NTHREADS) {
        const int pos = idx >> 4, i = idx & 15;
        double f = 1.0;
        for (int q = 0; q < i; ++q) f *= 0.56234132519034908;
        const float ang = (float)pos * (float)f;
        const double a = (double)ang, k = __builtin_rint(a * 0.15915494309189535), r = a - k * 6.283185307179586476925, r2 = r * r;
        double sn = r, ts = r, cs = 1.0, tc = 1.0;
        for (int n = 1; n <= 14; ++n) {
            tc *= -r2 / (double)((2 * n - 1) * (2 * n)); cs += tc;
            ts *= -r2 / (double)((2 * n) * (2 * n + 1)); sn += ts;
        }
        tab[idx] = (f32x2){(float)cs, (float)sn};
    }
}

__device__ __forceinline__ unsigned char* lds_raw_ptr(LAS unsigned char* p) { return (unsigned char*)p; }
namespace mix {
typedef short bf16x8 __attribute__((ext_vector_type(8)));
typedef short s16x4 __attribute__((ext_vector_type(4)));
typedef float f32x16 __attribute__((ext_vector_type(16)));
typedef __attribute__((address_space(3))) const char* lds_cptr;
__device__ __forceinline__ int crow(int r, int hi) { return (r & 3) + 8 * (r >> 2) + 4 * hi; }
__device__ __forceinline__ unsigned cvtpk(float lo, float hi) { typedef float f2 __attribute__((ext_vector_type(2))); typedef __bf16 b2 __attribute__((ext_vector_type(2))); f2 v = {lo, hi}; b2 b = __builtin_convertvector(v, b2); return __builtin_bit_cast(unsigned, b); }
__device__ __forceinline__ s16x4 vtr(lds_cptr p) { return __builtin_bit_cast(s16x4, __builtin_amdgcn_ds_read_tr16_b64_v4i16((__attribute__((address_space(3))) s16x4*)p)); }
__device__ __forceinline__ bf16x8 pk8(s16x4 lo, s16x4 hi) { return (bf16x8){lo[0], lo[1], lo[2], lo[3], hi[0], hi[1], hi[2], hi[3]}; }
__device__ __forceinline__ float max3f(float a, float b, float c) { float r; asm("v_max3_f32 %0, %1, %2, %3" : "=v"(r) : "v"(a), "v"(b), "v"(c)); return r; }
__device__ __forceinline__ float max2f(float a, float b) { float r; asm("v_max_f32_e32 %0, %1, %2" : "=v"(r) : "v"(a), "v"(b)); return r; }
__device__ __forceinline__ float swap_half(float v) { auto rr = __builtin_amdgcn_permlane32_swap(__float_as_uint(v), __float_as_uint(v), false, false); return __uint_as_float((threadIdx.x & 32) ? rr[0] : rr[1]); }

constexpr int A_K = 0, A_V = 24576, A_WS = 49152, A_QST = 53248, A_OST = A_QST, A_OSTW = 8192, A_END = A_QST + 8 * 8192;

__device__ __forceinline__ void attn_unit(int b, int n, int kvh, bf16_t* Y, bf16_t* O, int ldo, const bf16_t* KB, const bf16_t* VB, const float* sink, LAS unsigned char* lds) {
    const int tid = threadIdx.x, lane = tid & 63, r32 = lane & 31, hi = lane >> 5, wid = __builtin_amdgcn_readfirstlane(tid >> 6);
    const int head = kvh * 4 + (wid >> 1);
    const int qrow0 = b * SEQ + n * 128 + (wid & 1) * 64;
    bf16_t* Qw = Y + (size_t)qrow0 * 2048 + 1024 + head * 64;
    LAS bf16x8* qst = (LAS bf16x8*)(lds + A_QST + wid * 8192) + lane;
#pragma unroll
    for (int sb = 0; sb < 2; ++sb)
#pragma unroll
        for (int d0 = 0; d0 < 4; ++d0) qst[(sb * 4 + d0) * 64] = *(const bf16x8*)(Qw + (size_t)(32 * sb + r32) * 2048 + d0 * 16 + hi * 8);
    f32x16 o[2][2];
#pragma unroll
    for (int sb = 0; sb < 2; ++sb)
#pragma unroll
        for (int d0 = 0; d0 < 2; ++d0)
#pragma unroll
            for (int r = 0; r < 16; ++r) o[sb][d0][r] = 0.f;
    float m[2] = {-1e30f, -1e30f}, l[2] = {0.f, 0.f};
    LAS float* wsf = (LAS float*)(lds + A_WS) + wid * 128;
    const int jlo = (n == 0) ? 2 : 0, jhi = (n == 31) ? 3 : 5, T = 4 + (jhi - jlo + 1);
    const size_t koff = (size_t)lane * 256 + wid * 8 + kvh * 64;
    const size_t voff = (size_t)(16 * (wid & 3) + (lane >> 2)) * 256 + (wid >> 2) * 32 + (lane & 3) * 8 + kvh * 64;
    auto tile_row = [&](int t) -> long { return t < 4 ? (long)(NTOK + b * CTXL + 64 * t) : (long)(b * SEQ + (n - 1) * 128 + 64 * (jlo + t - 4)); };
    auto issue = [&](int t) {
        const long row = tile_row(t); const int buf = t % 3;
        __builtin_amdgcn_global_load_lds((const unsigned*)(KB + row * 256 + koff), (LAS unsigned*)(lds + A_K + buf * 8192 + wid * 1024), 16, 0, 0);
        __builtin_amdgcn_global_load_lds((const unsigned*)(VB + row * 256 + voff), (LAS unsigned*)(lds + A_V + buf * 8192 + wid * 1024), 16, 0, 0);
    };
    issue(0); issue(1);
    int slot = 0;
    for (int t = 0; t < T; ++t) {
        if (t + 1 < T) asm volatile("s_waitcnt vmcnt(2) lgkmcnt(0)" ::: "memory"); else asm volatile("s_waitcnt vmcnt(0) lgkmcnt(0)" ::: "memory");
        __builtin_amdgcn_s_barrier();
        if (t + 2 < T) issue(t + 2);
        const lds_cptr Kt = (lds_cptr)(lds + A_K + slot * 8192) + hi * 1024 + r32 * 16;
        const lds_cptr Vt = (lds_cptr)(lds + A_V + slot * 8192) + ((lane >> 4) & 1) * 32 + (lane & 3) * 8 + (4 * hi + ((lane & 15) >> 2)) * 64;
        slot = (slot == 2) ? 0 : slot + 1;
        const bool local = t >= 4;
        const int dl = 64 * (jlo + t - 4) - 128 - 64 * (wid & 1);
        if (local && (dl > 160 || dl < -191)) continue;
        f32x16 p0[2], p1[2];
#pragma unroll
        for (int sb = 0; sb < 2; ++sb)
#pragma unroll
            for (int r = 0; r < 16; ++r) { p0[sb][r] = 0.f; p1[sb][r] = 0.f; }
#pragma unroll
        for (int d0 = 0; d0 < 4; ++d0) {
            const bf16x8 k0 = *(const __attribute__((address_space(3))) bf16x8*)(Kt + d0 * 2048), k1 = *(const __attribute__((address_space(3))) bf16x8*)(Kt + d0 * 2048 + 512);
#pragma unroll
            for (int sb = 0; sb < 2; ++sb) {
                const bf16x8 qf = qst[(sb * 4 + d0) * 64];
                p0[sb] = __builtin_amdgcn_mfma_f32_32x32x16_bf16(k0, qf, p0[sb], 0, 0, 0);
                p1[sb] = __builtin_amdgcn_mfma_f32_32x32x16_bf16(k1, qf, p1[sb], 0, 0, 0);
            }
        }
        if (local && (dl < -97 || dl > 65 || dl - 32 < -97)) {
#pragma unroll
            for (int sb = 0; sb < 2; ++sb)
#pragma unroll
                for (int r = 0; r < 16; ++r) { const int rel = dl - 32 * sb + crow(r, hi) - r32; if (rel < -128 || rel > 128) p0[sb][r] = -1e30f; if (rel + 32 < -128 || rel + 32 > 128) p1[sb][r] = -1e30f; }
        }
        float mn[2];
        asm volatile("s_nop 15\n\ts_nop 7" : "+v"(p0[0]), "+v"(p1[0]), "+v"(p0[1]), "+v"(p1[1]));
#pragma unroll
        for (int sb = 0; sb < 2; ++sb) {
            float a = max3f(p0[sb][0], p0[sb][1], p1[sb][0]), b2 = max3f(p0[sb][2], p0[sb][3], p1[sb][1]); a = max3f(a, p1[sb][2], p1[sb][3]);
#pragma unroll
            for (int r = 4; r < 16; r += 4) { a = max3f(a, p0[sb][r], p0[sb][r + 1]); b2 = max3f(b2, p0[sb][r + 2], p0[sb][r + 3]); a = max3f(a, p1[sb][r], p1[sb][r + 1]); b2 = max3f(b2, p1[sb][r + 2], p1[sb][r + 3]); }
            float rm = max2f(a, b2);
            rm = max2f(rm, swap_half(rm));
            mn[sb] = max2f(m[sb], rm);
        }
        if (__any((mn[0] > m[0]) || (mn[1] > m[1]))) {
            const float f0 = __builtin_amdgcn_exp2f(m[0] - mn[0]), f1 = __builtin_amdgcn_exp2f(m[1] - mn[1]);
            l[0] *= f0; l[1] *= f1;
            if (hi == 0) { wsf[r32] = f0; wsf[64 + r32] = f1; }
            asm volatile("s_waitcnt lgkmcnt(0)" ::: "memory");
#pragma unroll
            for (int r = 0; r < 16; ++r) { const float a = wsf[crow(r, hi)], b2 = wsf[64 + crow(r, hi)]; o[0][0][r] *= a; o[0][1][r] *= a; o[1][0][r] *= b2; o[1][1][r] *= b2; }
            m[0] = mn[0]; m[1] = mn[1];
        }
        u32x4 pw[2][4];
#pragma unroll
        for (int sb = 0; sb < 2; ++sb) {
            float sacc = 0.f;
#pragma unroll
            for (int r = 0; r < 16; ++r) { p0[sb][r] = __builtin_amdgcn_exp2f(p0[sb][r] - m[sb]); p1[sb][r] = __builtin_amdgcn_exp2f(p1[sb][r] - m[sb]); sacc += p0[sb][r] + p1[sb][r]; }
            l[sb] += sacc;
#pragma unroll
            for (int q = 0; q < 4; ++q) { pw[sb][0][q] = cvtpk(p0[sb][2 * q], p0[sb][2 * q + 1]); pw[sb][1][q] = cvtpk(p0[sb][8 + 2 * q], p0[sb][9 + 2 * q]); pw[sb][2][q] = cvtpk(p1[sb][2 * q], p1[sb][2 * q + 1]); pw[sb][3][q] = cvtpk(p1[sb][8 + 2 * q], p1[sb][9 + 2 * q]); }
        }
#pragma unroll
        for (int d0 = 0; d0 < 2; ++d0)
#pragma unroll
            for (int ks = 0; ks < 4; ++ks) {
                const s16x4 vlo = vtr(Vt + d0 * 4096 + ks * 1024), vhi = vtr(Vt + d0 * 4096 + ks * 1024 + 512);
                const bf16x8 vf = pk8(vlo, vhi);
#pragma unroll
                for (int sb = 0; sb < 2; ++sb) o[sb][d0] = __builtin_amdgcn_mfma_f32_32x32x16_bf16(__builtin_bit_cast(bf16x8, pw[sb][ks]), vf, o[sb][d0], 0, 0, 0);
            }
    }
    const float s2 = sink[head] * LOG2E;
    LAS bf16_t* stg = (LAS bf16_t*)(lds + A_OST + wid * A_OSTW);
#pragma unroll
    for (int sb = 0; sb < 2; ++sb) {
        const float lt = l[sb] + swap_half(l[sb]);
        const float mf = fmaxf(m[sb], s2), f = __builtin_amdgcn_exp2f(m[sb] - mf), den = lt * f + __builtin_amdgcn_exp2f(s2 - mf);
        asm volatile("s_waitcnt lgkmcnt(0)" ::: "memory");
        if (hi == 0) wsf[sb * 64 + r32] = f / den;
        asm volatile("s_waitcnt lgkmcnt(0)" ::: "memory");
#pragma unroll
        for (int r = 0; r < 16; ++r) { const float sc = wsf[sb * 64 + crow(r, hi)]; const int orow = crow(r, hi);
            stg[orow * 64 + r32] = (bf16_t)f2bf(o[sb][0][r] * sc); stg[orow * 64 + 32 + r32] = (bf16_t)f2bf(o[sb][1][r] * sc); }
        asm volatile("s_waitcnt lgkmcnt(0)" ::: "memory");
#pragma unroll
        for (int i = 0; i < 4; ++i) { const int row = i * 8 + (lane >> 3), ch = lane & 7; const u32x4 v = *(const LAS u32x4*)(stg + row * 64 + ch * 8); *(u32x4*)(O + (size_t)(qrow0 + 32 * sb + row) * ldo + head * 64 + ch * 8) = v; }
        asm volatile("s_waitcnt lgkmcnt(0)" ::: "memory");
    }
    __syncthreads();
}

constexpr int G_V = 0, G_ST = 65536, G_STW = 8704, G_MU = G_ST + 8 * G_STW;
__device__ __forceinline__ void gmlp_unit(int task, bf16_t* Y, bf16_t* YO, int ldo, const bf16_t* VA, const bf16_t* WSP, const f32x2* STATS, const float* ln_g, const float* ln_b, const float* b_sp, LAS unsigned char* lds) {
    const int tid = threadIdx.x, lane = tid & 63, r32 = lane & 31, hi = lane >> 5, wid = __builtin_amdgcn_readfirstlane(tid >> 6);
    const int r0 = task * 128;
    LAS float* mu = (LAS float*)(lds + G_MU); LAS float* rs = mu + 128;
    if (tid < 128) {
        const f32x4* sp = (const f32x4*)(STATS + (size_t)(r0 + tid) * 16); float s = 0.f, ss = 0.f;
#pragma unroll
        for (int i = 0; i < 8; ++i) { const f32x4 v = sp[i]; s += v.x + v.z; ss += v.y + v.w; }
        const float mean = s * (1.f / 1024.f), var = fmaxf(ss * (1.f / 1024.f) - mean * mean, 0.f);
        mu[tid] = mean; rs[tid] = 1.0f / sqrtf(var + EPS);
    }
    u32x4 raw[4];
#pragma unroll
    for (int i = 0; i < 4; ++i) { const int idx = tid + NTHREADS * i, q = idx >> 4, c8 = idx & 15; raw[i] = *(const u32x4*)(VA + (size_t)(r0 + q) * 1024 + c8 * 8); }
    __syncthreads();
    const int pb = wid >> 1, dh = wid & 1;
    LAS float* st = (LAS float*)(lds + G_ST + wid * G_STW);
    for (int g8 = 0; g8 < 8; ++g8) {
        LAS unsigned char* vb = lds + G_V + (g8 & 1) * 32768;
#pragma unroll
        for (int i = 0; i < 4; ++i) {
            const int idx = tid + NTHREADS * i, q = idx >> 4, c8 = idx & 15, d = c8 * 8;
            const f32x4 g0 = *(const f32x4*)(ln_g + g8 * 128 + d), g1 = *(const f32x4*)(ln_g + g8 * 128 + d + 4), b0 = *(const f32x4*)(ln_b + g8 * 128 + d), b1 = *(const f32x4*)(ln_b + g8 * 128 + d + 4);
            const float mq = mu[q], rq = rs[q]; const u32x4 rw = raw[i];
            float v[8] = {bf2f(rw.x & 0xffffu), bf2f(rw.x >> 16), bf2f(rw.y & 0xffffu), bf2f(rw.y >> 16), bf2f(rw.z & 0xffffu), bf2f(rw.z >> 16), bf2f(rw.w & 0xffffu), bf2f(rw.w >> 16)};
#pragma unroll
            for (int e = 0; e < 4; ++e) { v[e] = (v[e] - mq) * rq * g0[e] + b0[e]; v[4 + e] = (v[4 + e] - mq) * rq * g1[e] + b1[e]; }
            u32x4 w; w.x = pk2(v[0], v[1]); w.y = pk2(v[2], v[3]); w.z = pk2(v[4], v[5]); w.w = pk2(v[6], v[7]);
            *(LAS u32x4*)(vb + ((d >> 5) * 8 + (q >> 4)) * 1024 + (q & 15) * 64 + (d & 31) * 2) = w;
        }
        if (g8 + 1 < 8) {
#pragma unroll
            for (int i = 0; i < 4; ++i) { const int idx = tid + NTHREADS * i, q = idx >> 4, c8 = idx & 15; raw[i] = *(const u32x4*)(VA + (size_t)(r0 + q) * 1024 + (g8 + 1) * 128 + c8 * 8); }
        }
        u32x4 ur[4]; bf16x8 af[8];
        const size_t ybase = (size_t)(r0 + 32 * pb + (lane >> 3)) * 2048 + g8 * 128 + 64 * dh + (lane & 7) * 8;
#pragma unroll
        for (int i = 0; i < 4; ++i) ur[i] = *(const u32x4*)(Y + ybase + (size_t)(8 * i) * 2048);
        const bf16_t* wrow = WSP + (size_t)g8 * 16384 + (size_t)(32 * pb + r32) * 128 + 8 * hi;
#pragma unroll
        for (int ks = 0; ks < 8; ++ks) af[ks] = *(const bf16x8*)(wrow + 16 * ks);
        __syncthreads();
        const lds_cptr Vb = (lds_cptr)vb + ((lane >> 4) & 1) * 32 + (lane & 3) * 8 + (8 * hi + ((lane & 15) >> 2)) * 64;
        f32x16 acc[2];
#pragma unroll
        for (int t2 = 0; t2 < 2; ++t2)
#pragma unroll
            for (int r = 0; r < 16; ++r) acc[t2][r] = 0.f;
#pragma unroll
        for (int ks = 0; ks < 8; ++ks) {
#pragma unroll
            for (int t2 = 0; t2 < 2; ++t2) {
                const int db = 2 * dh + t2;
                const s16x4 vlo = vtr(Vb + (db * 8 + ks) * 1024), vhi = vtr(Vb + (db * 8 + ks) * 1024 + 256);
                acc[t2] = __builtin_amdgcn_mfma_f32_32x32x16_bf16(af[ks], pk8(vlo, vhi), acc[t2], 0, 0, 0);
            }
        }
#pragma unroll
        for (int t2 = 0; t2 < 2; ++t2)
#pragma unroll
            for (int r = 0; r < 16; ++r) st[crow(r, hi) * 68 + 32 * t2 + r32] = acc[t2][r];
        asm volatile("s_waitcnt lgkmcnt(0)" ::: "memory");
#pragma unroll
        for (int i = 0; i < 4; ++i) {
            const int prow = 8 * i + (lane >> 3), ch = lane & 7;
            const f32x4 m0 = *(const LAS f32x4*)(st + prow * 68 + ch * 8), m1 = *(const LAS f32x4*)(st + prow * 68 + ch * 8 + 4);
            const float bs = b_sp[g8 * 128 + 32 * pb + prow]; const u32x4 uw = ur[i];
            u32x4 o;
            o.x = pk2(bf2f(uw.x & 0xffffu) * (m0.x + bs), bf2f(uw.x >> 16) * (m0.y + bs)); o.y = pk2(bf2f(uw.y & 0xffffu) * (m0.z + bs), bf2f(uw.y >> 16) * (m0.w + bs));
            o.z = pk2(bf2f(uw.z & 0xffffu) * (m1.x + bs), bf2f(uw.z >> 16) * (m1.y + bs)); o.w = pk2(bf2f(uw.w & 0xffffu) * (m1.z + bs), bf2f(uw.w >> 16) * (m1.w + bs));
            *(u32x4*)(YO + (size_t)(r0 + 32 * pb + prow) * ldo + g8 * 128 + 64 * dh + ch * 8) = o;
        }
        asm volatile("s_waitcnt lgkmcnt(0)" ::: "memory");
    }
    __syncthreads();
}
}

namespace att2 {
typedef short bf16x8 __attribute__((ext_vector_type(8)));
typedef short s16x4 __attribute__((ext_vector_type(4)));
typedef float f32x16 __attribute__((ext_vector_type(16)));
typedef __attribute__((address_space(3))) const char* lds_cptr;
typedef short v4i16_t __attribute__((ext_vector_type(4)));
__device__ __forceinline__ int crow(int r, int hi) { return (r & 3) + 8 * (r >> 2) + 4 * hi; }
#define SBAR() __builtin_amdgcn_sched_barrier(0)
constexpr int NSLOT = 3, SLOTB = 8192;
constexpr int LDS_K = 0, LDS_V = NSLOT * SLOTB, LDS_WS = 2 * NSLOT * SLOTB, LDS_OST = LDS_WS + 8 * 64 * 4, LDS_BYTES = LDS_OST + 8 * 4096;
__device__ __forceinline__ void glds16(const void* gsrc, unsigned lds_dst) { unsigned keep;
    asm volatile("s_mov_b32 %0, m0\n\ts_mov_b32 m0, %2\n\ts_nop 0\n\tglobal_load_lds_dwordx4 %1, off\n\ts_mov_b32 m0, %0" : "=&s"(keep) : "v"(gsrc), "s"(lds_dst) : "memory"); }
__device__ __forceinline__ float max3f(float a, float b, float c) { float r; asm("v_max3_f32 %0, %1, %2, %3" : "=v"(r) : "v"(a), "v"(b), "v"(c)); return r; }
__device__ __forceinline__ float max2f(float a, float b) { float r; asm("v_max_f32_e32 %0, %1, %2" : "=v"(r) : "v"(a), "v"(b)); return r; }
__device__ __forceinline__ float fadd_s(float a, float b) { float r; asm("v_add_f32_e32 %0, %1, %2" : "=v"(r) : "v"(a), "v"(b)); return r; }
__device__ __forceinline__ float fsub_s(float a, float b) { float r; asm("v_sub_f32_e32 %0, %1, %2" : "=v"(r) : "v"(a), "v"(b)); return r; }
typedef float f32x2_t __attribute__((ext_vector_type(2))); typedef __bf16 bf16x2_t __attribute__((ext_vector_type(2)));
__device__ __forceinline__ unsigned cvtpk_s(float lo, float hi) { f32x2_t v = {lo, hi}; bf16x2_t b = __builtin_convertvector(v, bf16x2_t); return __builtin_bit_cast(unsigned, b); }
#define WAIT_BAR(N) asm volatile("s_waitcnt vmcnt(" #N ") lgkmcnt(0)\n\ts_barrier" ::: "memory")
__device__ __forceinline__ void qkt(f32x16& p0, f32x16& p1, lds_cptr Kslot, const bf16x8* qr, const f32x16& negm, int r32, int hi) {
    const lds_cptr kb = Kslot + hi * 1024 + r32 * 16;
#pragma unroll
    for (int d0 = 0; d0 < 4; ++d0) {
        const bf16x8 b0 = *(const __attribute__((address_space(3))) bf16x8*)(kb + d0 * 2048);
        const bf16x8 b1 = *(const __attribute__((address_space(3))) bf16x8*)(kb + d0 * 2048 + 512);
        if (d0 == 0) { p0 = __builtin_amdgcn_mfma_f32_32x32x16_bf16(b0, qr[0], negm, 0, 0, 0); p1 = __builtin_amdgcn_mfma_f32_32x32x16_bf16(b1, qr[0], negm, 0, 0, 0); }
        else { p0 = __builtin_amdgcn_mfma_f32_32x32x16_bf16(b0, qr[d0], p0, 0, 0, 0); p1 = __builtin_amdgcn_mfma_f32_32x32x16_bf16(b1, qr[d0], p1, 0, 0, 0); }
    }
}
__device__ __forceinline__ void kload8(bf16x8* kf, lds_cptr kp) {
    kf[0] = *(const __attribute__((address_space(3))) bf16x8*)(kp);        kf[1] = *(const __attribute__((address_space(3))) bf16x8*)(kp + 512);
    kf[2] = *(const __attribute__((address_space(3))) bf16x8*)(kp + 2048); kf[3] = *(const __attribute__((address_space(3))) bf16x8*)(kp + 2560);
    kf[4] = *(const __attribute__((address_space(3))) bf16x8*)(kp + 4096); kf[5] = *(const __attribute__((address_space(3))) bf16x8*)(kp + 4608);
    kf[6] = *(const __attribute__((address_space(3))) bf16x8*)(kp + 6144); kf[7] = *(const __attribute__((address_space(3))) bf16x8*)(kp + 6656);
}
__device__ __forceinline__ void kload2(bf16x8* kf, lds_cptr kp, int j) { kf[2 * j] = *(const __attribute__((address_space(3))) bf16x8*)(kp + j * 2048); kf[2 * j + 1] = *(const __attribute__((address_space(3))) bf16x8*)(kp + j * 2048 + 512); }
__device__ __forceinline__ s16x4 vtr(lds_cptr p) { return __builtin_bit_cast(s16x4, __builtin_amdgcn_ds_read_tr16_b64_v4i16((__attribute__((address_space(3))) v4i16_t*)p)); }
__device__ __forceinline__ float rowmax(const f32x16& p0, const f32x16& p1) {
    float a = max3f(p0[0], p0[1], p1[0]), b = max3f(p0[2], p0[3], p1[1]); a = max3f(a, p1[2], p1[3]);
#pragma unroll
    for (int r = 4; r < 16; r += 4) { a = max3f(a, p0[r], p0[r + 1]); b = max3f(b, p0[r + 2], p0[r + 3]); a = max3f(a, p1[r], p1[r + 1]); b = max3f(b, p1[r + 2], p1[r + 3]); }
    const float m = max2f(a, b);
    auto rr = __builtin_amdgcn_permlane32_swap(__float_as_uint(m), __float_as_uint(m), false, false);
    return max2f(__uint_as_float(rr[0]), __uint_as_float(rr[1]));
}
__device__ __forceinline__ void pv(f32x16* o, int vb, bf16x8 pa0, bf16x8 pa1, bf16x8 pa2, bf16x8 pa3) {
#pragma unroll
    for (int d0 = 0; d0 < 2; ++d0) { s16x4 lo[4], hi[4];
#pragma unroll
        for (int ks = 0; ks < 4; ++ks) {
            asm volatile("ds_read_b64_tr_b16 %0,%1 offset:%c2" : "=&v"(lo[ks]) : "v"(vb), "i"(d0 * 4096 + ks * 1024) : "memory");
            asm volatile("ds_read_b64_tr_b16 %0,%1 offset:%c2" : "=&v"(hi[ks]) : "v"(vb), "i"(d0 * 4096 + ks * 1024 + 512) : "memory"); }
        asm volatile("s_waitcnt lgkmcnt(0)" ::: "memory"); SBAR();
#define PK(k) (bf16x8){lo[k][0], lo[k][1], lo[k][2], lo[k][3], hi[k][0], hi[k][1], hi[k][2], hi[k][3]}
        o[d0] = __builtin_amdgcn_mfma_f32_32x32x16_bf16(pa0, PK(0), o[d0], 0, 0, 0);
        o[d0] = __builtin_amdgcn_mfma_f32_32x32x16_bf16(pa1, PK(1), o[d0], 0, 0, 0);
        o[d0] = __builtin_amdgcn_mfma_f32_32x32x16_bf16(pa2, PK(2), o[d0], 0, 0, 0);
        o[d0] = __builtin_amdgcn_mfma_f32_32x32x16_bf16(pa3, PK(3), o[d0], 0, 0, 0);
#undef PK
    }
}
__device__ __forceinline__ void wmask(f32x16& p0, f32x16& p1, int dl, int r32, int hi) {
    const float NEG = -INFINITY;
#pragma unroll
    for (int r = 0; r < 16; ++r) { const int rel = dl + crow(r, hi) - r32; if (rel < -128 || rel > 128) p0[r] = NEG; if (rel + 32 < -128 || rel + 32 > 128) p1[r] = NEG; }
}

template <int THRL> __device__ __forceinline__ void attn_unit(int b, int n, int kvh, int hp, int base, bool primed, bool has_next, int nb, int nn, int nkvh, int nhp, bf16x8 (&qr)[4], int& nbase,
                                                              const bf16_t* Y, bf16_t* O, int ldo, const bf16_t* KB, const bf16_t* VB, const float* sink, LAS unsigned char* shm) {
    const int tid = threadIdx.x, lane = tid & 63, r32 = lane & 31, hi = lane >> 5; const int wid = __builtin_amdgcn_readfirstlane(tid >> 6);
    const int head = kvh * 4 + hp * 2 + (wid >> 2), qsub = wid & 3;
    const long qrow0 = (long)b * SEQ + n * 128 + qsub * 32;
    const bf16_t* Qw = Y + qrow0 * 2048 + 1024 + head * 64;
    const unsigned lds0 = (unsigned)(uintptr_t)shm;
    LAS float* wsf = (LAS float*)(shm + LDS_WS) + wid * 64;
    const long koff = (long)lane * 256 + kvh * 64 + wid * 8;
    const long voff = (long)(16 * (wid & 3) + (lane >> 2)) * 256 + kvh * 64 + (wid >> 2) * 32 + (lane & 3) * 8;
    const unsigned kdst = lds0 + LDS_K + wid * 1024, vdst = lds0 + LDS_V + wid * 1024;
    const int jlo = (n == 0) ? 2 : 0, jhi = (n == 31) ? 3 : 5, NT = 4 + (jhi - jlo + 1);
    const long lrow0 = (long)b * SEQ + (n - 1) * 128 + 64 * (jlo - 4), crow0 = (long)NTOK + b * CTXL;
#define TROW(t) ((t) < 4 ? crow0 + 64 * (t) : lrow0 + 64 * (t))
#define DMA_K(t, slot) glds16(KB + TROW(t) * 256 + koff, (unsigned)__builtin_amdgcn_readfirstlane(kdst + (slot)))
#define DMA_V(t, slot) glds16(VB + TROW(t) * 256 + voff, (unsigned)__builtin_amdgcn_readfirstlane(vdst + (slot)))
    const int vb0 = (int)(lds0 + LDS_V) + ((lane >> 4) & 1) * 32 + (lane & 3) * 8 + (4 * hi + ((lane & 15) >> 2)) * 64;
    bf16x8 kf[8];
    const lds_cptr shm3 = (lds_cptr)shm; const lds_cptr kp0 = shm3 + LDS_K + hi * 1024 + r32 * 16; const lds_cptr vp0 = shm3 + LDS_V + ((lane >> 4) & 1) * 32 + (lane & 3) * 8 + (4 * hi + ((lane & 15) >> 2)) * 64;
    const int s0 = base, s1 = (s0 == (NSLOT - 1) * SLOTB) ? 0 : s0 + SLOTB, s2 = (s1 == (NSLOT - 1) * SLOTB) ? 0 : s1 + SLOTB;
    if (!primed) {
        DMA_K(0, s0); DMA_V(0, s0); DMA_K(1, s1); DMA_K(2, s2);
#pragma unroll
        for (int d0 = 0; d0 < 4; ++d0) qr[d0] = *(const bf16x8*)(Qw + (long)r32 * 2048 + d0 * 16 + hi * 8);
    }
    float mhat = 0.f, l_reg = 0.f; f32x16 o[2]; o[0] = f32x16{}; o[1] = f32x16{}; f32x16 negm = f32x16{}; asm volatile("" : "+v"(negm));
    const int dq = -128 - 32 * qsub;
#define CMASK(P0, P1, t) do { if ((t) >= 4) { const int dl_ = 64 * (jlo + (t) - 4) + dq; if (dl_ < -97 || dl_ > 65) wmask(P0, P1, dl_, r32, hi); } } while (0)
    bool resc = false;
#define START(P0, P1) do { const float rm = rowmax(P0, P1); resc = false; \
    { const float dl = rm; mhat = fadd_s(mhat, dl); \
      _Pragma("unroll") for (int r = 0; r < 16; ++r) { P0[r] = fsub_s(P0[r], dl); P1[r] = fsub_s(P1[r], dl); } \
      _Pragma("unroll") for (int r = 0; r < 16; ++r) negm[r] = -mhat; asm volatile("" : "+v"(negm)); } \
    _Pragma("unroll") for (int r = 0; r < 16; ++r) P0[r] = __builtin_amdgcn_exp2f(P0[r]); } while (0)
#define RESC() do { if (resc) { asm volatile("s_waitcnt lgkmcnt(0)" ::: "memory"); \
      _Pragma("unroll") for (int d_ = 0; d_ < 2; ++d_) _Pragma("unroll") for (int r = 0; r < 16; ++r) o[d_][r] *= wsf[crow(r, hi)]; } } while (0)
    f32x16 pA0, pA1, pB0, pB1;
    int sl_prev = s0, sl_cur = s0, sl_next = s1;
#define ROT() do { sl_prev = sl_cur; sl_cur = sl_next; sl_next = (sl_next == (NSLOT - 1) * SLOTB) ? 0 : sl_next + SLOTB; } while (0)
    WAIT_BAR(7);
    qkt(pA0, pA1, shm3 + LDS_K + s0, qr, negm, r32, hi); asm volatile("s_nop 15\n\ts_nop 7" : "+v"(pA0), "+v"(pA1)); CMASK(pA0, pA1, 0);
    START(pA0, pA1);
    _Pragma("unroll") for (int r = 0; r < 16; ++r) pA1[r] = __builtin_amdgcn_exp2f(pA1[r]);
    WAIT_BAR(0);
    DMA_K(3, s0); DMA_V(1, s1);
    ROT();
    kload8(kf, kp0 + sl_cur);
    WAIT_BAR(2);
    s16x4 vlo[8], vhi[8]; u32x4 pw0, pw1, pw2, pw3;
#define PKW(P, B) cvtpk_s(P[B], P[B + 1])
#define PAF(k) __builtin_bit_cast(bf16x8, pw##k)
#define VFR(i) (bf16x8){vlo[i][0], vlo[i][1], vlo[i][2], vlo[i][3], vhi[i][0], vhi[i][1], vhi[i][2], vhi[i][3]}
#define PIN(x) asm volatile("" : "+v"(x))
#define MX3(a, b, c) __builtin_fmaxf(__builtin_fmaxf((a), (b)), (c))
#define GAPA(MF, A0, A1, A2, A3, W0, W1, PW) do { MF; sacc += A0; sacc += A1; sacc += A2; sacc += A3; PIN(sacc); W0; W1; PIN(PW); SBAR(); } while (0)
#define EX(v) __builtin_amdgcn_exp2f(v)
#define GAPB(MF, X, B) do { MF; X[B] = EX(X[B]); X[B + 1] = EX(X[B + 1]); X[B + 2] = EX(X[B + 2]); X[B + 3] = EX(X[B + 3]); PIN(X); SBAR(); } while (0)
#define VRD(i) do { vlo[i] = vtr(vp_ + (((i) >> 2) * 4096 + ((i) & 3) * 1024)); vhi[i] = vtr(vp_ + (((i) >> 2) * 4096 + ((i) & 3) * 1024 + 512)); } while (0)
#define KRD(G, j) do { if (G) { kload2(kf, kp0 + sl_next, j); SBAR(); } } while (0)
#define STEP(C0, C1, P0, P1, t, GK, GV, GL) do { SBAR(); \
    const lds_cptr vp_ = vp0 + sl_prev; \
    VRD(0); SBAR(); float sacc = (P0[0] + P0[1]); \
    GAPA(C0 = __builtin_amdgcn_mfma_f32_32x32x16_bf16(kf[0], qr[0], negm, 0, 0, 0), P0[2], P0[3], P0[4], P0[5],     pw0[0] = PKW(P0, 0), pw0[1] = PKW(P0, 2), pw0); \
    VRD(4); SBAR(); GAPA(C1 = __builtin_amdgcn_mfma_f32_32x32x16_bf16(kf[1], qr[0], negm, 0, 0, 0), P0[6], P0[7], P0[8], P0[9],     pw0[2] = PKW(P0, 4), pw0[3] = PKW(P0, 6), pw0); \
    VRD(1); SBAR(); GAPA(C0 = __builtin_amdgcn_mfma_f32_32x32x16_bf16(kf[2], qr[1], C0, 0, 0, 0),   P0[10], P0[11], P0[12], P0[13], pw1[0] = PKW(P0, 8), pw1[1] = PKW(P0, 10), pw1); \
    VRD(5); SBAR(); GAPA(C1 = __builtin_amdgcn_mfma_f32_32x32x16_bf16(kf[3], qr[1], C1, 0, 0, 0),   P0[14], P0[15], P1[0], P1[1],   pw1[2] = PKW(P0, 12), pw1[3] = PKW(P0, 14), pw1); \
    VRD(2); SBAR(); GAPA(C0 = __builtin_amdgcn_mfma_f32_32x32x16_bf16(kf[4], qr[2], C0, 0, 0, 0),   P1[2], P1[3], P1[4], P1[5],     pw2[0] = PKW(P1, 0), pw2[1] = PKW(P1, 2), pw2); \
    VRD(6); SBAR(); GAPA(C1 = __builtin_amdgcn_mfma_f32_32x32x16_bf16(kf[5], qr[2], C1, 0, 0, 0),   P1[6], P1[7], P1[8], P1[9],     pw2[2] = PKW(P1, 4), pw2[3] = PKW(P1, 6), pw2); \
    VRD(3); SBAR(); GAPA(C0 = __builtin_amdgcn_mfma_f32_32x32x16_bf16(kf[6], qr[3], C0, 0, 0, 0),   P1[10], P1[11], P1[12], P1[13], pw3[0] = PKW(P1, 8), pw3[1] = PKW(P1, 10), pw3); \
    VRD(7); SBAR(); GAPA(C1 = __builtin_amdgcn_mfma_f32_32x32x16_bf16(kf[7], qr[3], C1, 0, 0, 0),   P1[14], P1[15], 0.f, 0.f,       pw3[2] = PKW(P1, 12), pw3[3] = PKW(P1, 14), pw3); \
    l_reg += sacc; \
    if (GK) { DMA_K((t) + 3, sl_cur); } if (GV) { DMA_V((t) + 1, sl_next); } \
    CMASK(C0, C1, t); \
    { float a = MX3(C0[0], C0[1], C1[0]), b2 = MX3(C0[2], C0[3], C1[1]); a = MX3(a, C1[2], C1[3]); \
      _Pragma("unroll") for (int r = 4; r < 16; r += 4) { a = MX3(a, C0[r], C0[r + 1]); b2 = MX3(b2, C0[r + 2], C0[r + 3]); a = MX3(a, C1[r], C1[r + 1]); b2 = MX3(b2, C1[r + 2], C1[r + 3]); } \
      float rm = __builtin_fmaxf(a, b2); { auto rr = __builtin_amdgcn_permlane32_swap(__float_as_uint(rm), __float_as_uint(rm), false, false); rm = __builtin_fmaxf(__uint_as_float(rr[0]), __uint_as_float(rr[1])); } \
      resc = false; \
      if (__builtin_expect(__any(rm > (float)THRL), 0)) { const float dl = __builtin_fmaxf(rm, 0.f); mhat += dl; \
        _Pragma("unroll") for (int r = 0; r < 16; ++r) { C0[r] -= dl; C1[r] -= dl; } \
        _Pragma("unroll") for (int r = 0; r < 16; ++r) negm[r] = -mhat; asm volatile("" : "+v"(negm)); \
        const float f = __builtin_amdgcn_exp2f(-dl); l_reg *= f; if (hi == 0) wsf[r32] = f; resc = true; } } \
    SBAR(); \
    GAPB(o[0] = __builtin_amdgcn_mfma_f32_32x32x16_bf16(PAF(0), VFR(0), o[0], 0, 0, 0), C0, 0); \
    GAPB(o[1] = __builtin_amdgcn_mfma_f32_32x32x16_bf16(PAF(0), VFR(4), o[1], 0, 0, 0), C0, 4); \
    KRD(GL, 0); GAPB(o[0] = __builtin_amdgcn_mfma_f32_32x32x16_bf16(PAF(1), VFR(1), o[0], 0, 0, 0), C0, 8); \
    KRD(GL, 1); GAPB(o[1] = __builtin_amdgcn_mfma_f32_32x32x16_bf16(PAF(1), VFR(5), o[1], 0, 0, 0), C0, 12); \
    KRD(GL, 2); GAPB(o[0] = __builtin_amdgcn_mfma_f32_32x32x16_bf16(PAF(2), VFR(2), o[0], 0, 0, 0), C1, 0); \
    KRD(GL, 3); GAPB(o[1] = __builtin_amdgcn_mfma_f32_32x32x16_bf16(PAF(2), VFR(6), o[1], 0, 0, 0), C1, 4); \
    GAPB(o[0] = __builtin_amdgcn_mfma_f32_32x32x16_bf16(PAF(3), VFR(3), o[0], 0, 0, 0), C1, 8); \
    GAPB(o[1] = __builtin_amdgcn_mfma_f32_32x32x16_bf16(PAF(3), VFR(7), o[1], 0, 0, 0), C1, 12); \
    } while (0)
#define ENDW(tt) do { if ((tt) + 3 < NT) { WAIT_BAR(2); } else if ((tt) + 2 < NT) { WAIT_BAR(1); } else { WAIT_BAR(0); } } while (0)
    int t = 1;
    for (; t + 1 < NT; t += 2) {
        STEP(pB0, pB1, pA0, pA1, t, (t + 3 < NT), (t + 1 < NT), (t + 1 < NT));       ENDW(t);     RESC(); ROT();
        STEP(pA0, pA1, pB0, pB1, t + 1, (t + 4 < NT), (t + 2 < NT), (t + 2 < NT));   ENDW(t + 1); RESC(); ROT();
    }
    nbase = sl_next;
    if (has_next) {
        const long nr = (long)NTOK + nb * CTXL; const long nko = (long)lane * 256 + nkvh * 64 + wid * 8, nvo = (long)(16 * (wid & 3) + (lane >> 2)) * 256 + nkvh * 64 + (wid >> 2) * 32 + (lane & 3) * 8;
        const int n0 = sl_next, n1 = (n0 == (NSLOT - 1) * SLOTB) ? 0 : n0 + SLOTB, n2 = (n1 == (NSLOT - 1) * SLOTB) ? 0 : n1 + SLOTB;
        glds16(KB + nr * 256 + nko, (unsigned)__builtin_amdgcn_readfirstlane(kdst + n0)); glds16(VB + nr * 256 + nvo, (unsigned)__builtin_amdgcn_readfirstlane(vdst + n0));
        glds16(KB + (nr + 64) * 256 + nko, (unsigned)__builtin_amdgcn_readfirstlane(kdst + n1)); glds16(KB + (nr + 128) * 256 + nko, (unsigned)__builtin_amdgcn_readfirstlane(kdst + n2));
    }
    STEP(pB0, pB1, pA0, pA1, NT - 1, false, false, false); RESC();
    { float sacc = pB0[0] + pB0[1]; _Pragma("unroll") for (int r = 2; r < 16; ++r) sacc += pB0[r]; _Pragma("unroll") for (int r = 0; r < 16; ++r) sacc += pB1[r]; l_reg += sacc;
      pw0 = (u32x4){PKW(pB0, 0), PKW(pB0, 2), PKW(pB0, 4), PKW(pB0, 6)}; pw1 = (u32x4){PKW(pB0, 8), PKW(pB0, 10), PKW(pB0, 12), PKW(pB0, 14)}; pw2 = (u32x4){PKW(pB1, 0), PKW(pB1, 2), PKW(pB1, 4), PKW(pB1, 6)}; pw3 = (u32x4){PKW(pB1, 8), PKW(pB1, 10), PKW(pB1, 12), PKW(pB1, 14)};
      SBAR(); pv(o, vb0 + sl_cur, PAF(0), PAF(1), PAF(2), PAF(3)); }
    if (has_next) {
        asm volatile("" ::: "memory");
        const bf16_t* nQw = Y + ((long)nb * SEQ + nn * 128 + qsub * 32) * 2048 + 1024 + (nkvh * 4 + nhp * 2 + (wid >> 2)) * 64;
#pragma unroll
        for (int d0 = 0; d0 < 4; ++d0) qr[d0] = *(const bf16x8*)(nQw + (long)r32 * 2048 + d0 * 16 + hi * 8);
    }
    { auto rr = __builtin_amdgcn_permlane32_swap(__float_as_uint(l_reg), __float_as_uint(l_reg), false, false); l_reg = __uint_as_float(rr[0]) + __uint_as_float(rr[1]); }
    l_reg += __builtin_amdgcn_exp2f(fminf(sink[head] * LOG2E - mhat, 80.f));
    if (hi == 0) wsf[32 + r32] = l_reg; asm volatile("s_waitcnt lgkmcnt(0)" ::: "memory");
    float rli[16];
#pragma unroll
    for (int r = 0; r < 16; ++r) rli[r] = __builtin_amdgcn_rcpf(wsf[32 + crow(r, hi)]);
    bf16_t* Ow = O + qrow0 * ldo + head * 64;
    { LAS bf16_t* stg = (LAS bf16_t*)(shm + LDS_OST) + wid * 2048;
#pragma unroll
      for (int r = 0; r < 16; ++r) { const int orow = crow(r, hi);
#pragma unroll
          for (int d0 = 0; d0 < 2; ++d0) stg[orow * 64 + d0 * 32 + r32] = (bf16_t)(pk2(o[d0][r] * rli[r], 0.f) & 0xffffu); }
      asm volatile("s_waitcnt lgkmcnt(0)" ::: "memory");
#pragma unroll
      for (int i = 0; i < 4; ++i) { const int row = i * 8 + (lane >> 3), ch = lane & 7; const u32x4 v = *(const LAS u32x4*)(stg + row * 64 + ch * 8); *(u32x4*)(Ow + (long)row * ldo + ch * 8) = v; } }
    asm volatile("s_waitcnt lgkmcnt(0)\n\ts_barrier" ::: "memory");
#undef TROW
#undef DMA_K
#undef DMA_V
#undef CMASK
#undef START
#undef RESC
#undef ROT
#undef PKW
#undef PAF
#undef VFR
#undef PIN
#undef MX3
#undef GAPA
#undef GAPB
#undef EX
#undef VRD
#undef KRD
#undef STEP
#undef ENDW
}
#undef SBAR
#undef WAIT_BAR
}

#define XB_TMO      128
#define XB_XCNT(j)  (256  + 64 * (j))
#define XB_XSUB(j)  (1280 + 64 * (j))
#define XB_XGEN(j)  (2304 + 64 * (j))
#define XB_TOP      3328
#define XB_TOPGEN   3392
#define XCD_BAR_WORDS 3456
#define XB_SPIN_CAP (1u << 18)
__device__ __forceinline__ unsigned xb_ld(unsigned* p)              { return __hip_atomic_load(p, __ATOMIC_RELAXED, __HIP_MEMORY_SCOPE_AGENT); }
__device__ __forceinline__ unsigned xb_add(unsigned* p, unsigned v) { return __hip_atomic_fetch_add(p, v, __ATOMIC_RELAXED, __HIP_MEMORY_SCOPE_AGENT); }
__device__ __forceinline__ unsigned xb_xcc_id() { return (unsigned)__builtin_amdgcn_s_getreg((3 << 11) | 20) & 0xFu; }
#define XB_SPIN(cond, bar) do { unsigned _sp = 0; while (cond) { __builtin_amdgcn_s_sleep(1); \
    if ((++_sp & 255u) == 0u) { if (xb_ld(&(bar)[XB_TMO])) break; if (_sp > XB_SPIN_CAP) { atomicAdd(&(bar)[XB_TMO], 1u); break; } } } } while (0)
struct XcdBarrier { unsigned* bar; unsigned x; volatile LAS unsigned* st; };
__device__ __forceinline__ XcdBarrier xcd_barrier_post(unsigned* bar, volatile LAS unsigned* st) {
    XcdBarrier b; b.bar = bar; b.x = xb_xcc_id(); b.st = st;
    if (threadIdx.x == 0) (void)xb_add(&bar[XB_XCNT(b.x)], 1u);
    return b;
}
__device__ __forceinline__ void xcd_barrier_complete(unsigned* bar, unsigned x, unsigned& nloc, unsigned& nx) {
    const unsigned G = gridDim.x * gridDim.y * gridDim.z;
    unsigned sum, cnt, mine, sp = 0u;
    for (;;) {
        sum = 0u; cnt = 0u; mine = 0u;
#pragma unroll
        for (unsigned j = 0; j < 16; ++j) { const unsigned c = xb_ld(&bar[XB_XCNT(j)]); sum += c; cnt += (c > 0u) ? 1u : 0u; mine = (j == x) ? c : mine; }
        if (sum == G) break;
        __builtin_amdgcn_s_sleep(1);
        if ((++sp & 255u) == 0u) { if (xb_ld(&bar[XB_TMO])) break; if (sp > XB_SPIN_CAP) { atomicAdd(&bar[XB_TMO], 1u); break; } }
    }
    nloc = mine > 0u ? mine : 1u; nx = cnt > 0u ? cnt : 1u;
}
__device__ __forceinline__ void xcd_barrier(const XcdBarrier& b) {
    asm volatile("s_waitcnt vmcnt(0)" ::: "memory");
    __syncthreads();
    if (threadIdx.x == 0) {
        unsigned* bar = b.bar;
        __builtin_amdgcn_s_waitcnt(0);
        unsigned nloc = b.st[0], nx = b.st[1];
        if (nloc == 0u) { xcd_barrier_complete(bar, b.x, nloc, nx); b.st[0] = nloc; b.st[1] = nx; }
        const unsigned old = xb_add(&bar[XB_XSUB(b.x)], 1u);
        const unsigned gen = old / nloc;
        if (old + 1u == (gen + 1u) * nloc) {
            __builtin_amdgcn_fence(__ATOMIC_RELEASE, "agent");
            asm volatile("s_waitcnt vmcnt(0)" ::: "memory");
            const unsigned og = xb_add(&bar[XB_TOP], 1u);
            const unsigned tg = og / nx;
            if (og + 1u == (tg + 1u) * nx) xb_add(&bar[XB_TOPGEN], 1u);
            else XB_SPIN(xb_ld(&bar[XB_TOPGEN]) == tg, bar);
            __builtin_amdgcn_fence(__ATOMIC_ACQUIRE, "agent");
            xb_add(&bar[XB_XGEN(b.x)], 1u);
            asm volatile("s_waitcnt vmcnt(0)" ::: "memory");
        } else {
            XB_SPIN(xb_ld(&bar[XB_XGEN(b.x)]) == gen, bar);
            __builtin_amdgcn_fence(__ATOMIC_ACQUIRE, "agent");
            asm volatile("s_waitcnt vmcnt(0)" ::: "memory");
        }
    }
    __syncthreads();
}
constexpr int LDSCTL_OFF = LDS_BYTES - 256;
constexpr int CW_BAR = 4096;

#ifndef PROBE_GMLP2
#define PROBE_GMLP2 0
#endif
#ifndef ATT_PIPE
#define ATT_PIPE 1
#endif
#ifndef ATT_THRL
#define ATT_THRL 8
#endif
#ifndef ONE_LAUNCH
#define ONE_LAUNCH 1
#endif
#ifndef FAST_MIX
#define FAST_MIX 1
#endif
#ifndef PROBE_SEQ
#define PROBE_SEQ 0, 1, 2, 3, 4, 5, 6, 7, 8, 9, 10, 11
#endif

enum { PH_PRO = 0, PH_HN, PH_IN, PH_MIX, PH_A, PH_O, PH_H2R, PH_WCONV, PH_TOPK, PH_GU, PH_D, PH_FIN, PH_COUNT };

__global__ void __launch_bounds__(NTHREADS, 2) fwd(Args args) {
    extern __shared__ __attribute__((aligned(16))) unsigned char lds_raw[];
    LAS unsigned char* lds = (LAS unsigned char*)lds_raw;
    const int tid = threadIdx.x, lane = tid & 63, wave = __builtin_amdgcn_readfirstlane(tid >> 6);
    const int G = gridDim.x, bid = blockIdx.x;
    unsigned char* ws = args.ws;
    const int lo = args.ph_lo, hi = args.ph_hi;
#define IN(k) (lo <= (k) && (k) < hi)
    float* MOD = (float*)(ws + WS_MOD); f32x2* ROPE = (f32x2*)(ws + WS_ROPE);
    float* AFFT = (float*)(ws + WS_AFFT); int* TOPI = (int*)(ws + WS_TOPI); float* TOPW = (float*)(ws + WS_TOPW); int* SLOT = (int*)(ws + WS_SLOT);
    bf16_t* WSP = (bf16_t*)(ws + WS_WSP); bf16_t* WIN = (bf16_t*)(ws + WS_WIN); bf16_t* WAB = (bf16_t*)(ws + WS_WAB); bf16_t* WO = (bf16_t*)(ws + WS_WO);
    bf16_t* H = (bf16_t*)(ws + WS_H); bf16_t* VA = (bf16_t*)(ws + WS_VA); bf16_t* KB = (bf16_t*)(ws + WS_KB); bf16_t* VB = (bf16_t*)(ws + WS_VB);
    bf16_t* GT = (bf16_t*)(ws + WS_G); bf16_t* Y = (bf16_t*)(ws + WS_Y); bf16_t* TMP = (bf16_t*)(ws + WS_TMP); bf16_t* MERGED = (bf16_t*)(ws + WS_MERGED);
    bf16_t* WGU = (bf16_t*)(ws + WS_WGU); bf16_t* WD = (bf16_t*)(ws + WS_WD); bf16_t* H2 = (bf16_t*)(ws + WS_H2); bf16_t* ACT = (bf16_t*)(ws + WS_ACT); bf16_t* YB = (bf16_t*)(ws + WS_YB);
    const int gw = bid * NWAVES + wave, NGW = G * NWAVES;
    if (tid < 64) ((LAS unsigned*)(lds + LDSCTL_OFF))[tid] = 0u;
    __syncthreads();
    XcdBarrier bar; bar.bar = (unsigned*)(ws + WS_CTL) + CW_BAR; bar.x = 0; bar.st = nullptr;
    if (ONE_LAUNCH) bar = xcd_barrier_post((unsigned*)(ws + WS_CTL) + CW_BAR, (volatile LAS unsigned*)(lds + LDSCTL_OFF));
#define SEAM(k) do { if (ONE_LAUNCH && IN(k) && IN((k) + 1)) xcd_barrier(bar); } while (0)

    if (IN(PH_PRO)) {
        if (bid < 192) adaln_task(bid, args.in[I_C], args.in[I_CCTX], args.in[I_WADA], args.in[I_BADA], MOD, (LAS float*)lds, tid);
        else if (bid == 192) rope_table(ROPE, tid);
        __syncthreads();
        for (int i = bid * NTHREADS + tid; i < 8 * 128 * 128 / 4; i += G * NTHREADS) st4bf(WSP + 4 * i, *(const f32x4*)(args.in[I_WSP] + 4 * i));
        LAS float* scr = (LAS float*)(lds + wave * 16384);
        constexpr int I_IN = 16 * 176, I_P = 16 * 32;
        for (int it = gw; it < I_IN + 3 * I_P; it += NGW) {
            int r = it;
            if (r < I_IN) { const int kb = r / 176, nb = r % 176; transpose_item(args.in[I_WIN], INCOLS, kb * 64, nb * 32, WIN + (size_t)(nb * 32) * 1024 + kb * 64, 1024, scr, lane); continue; } r -= I_IN;
            if (r < I_P) { const int kb = r / 32, nb = r % 32; transpose_item(args.in[I_WPA], 1024, kb * 64, nb * 32, WAB + (size_t)(nb * 32) * 2048 + kb * 64, 2048, scr, lane); continue; } r -= I_P;
            if (r < I_P) { const int kb = r / 32, nb = r % 32; transpose_item(args.in[I_WPB], 1024, kb * 64, nb * 32, WAB + (size_t)(nb * 32) * 2048 + 1024 + kb * 64, 2048, scr, lane); continue; } r -= I_P;
            { const int kb = r / 32, nb = r % 32; transpose_item(args.in[I_WOUT], 1024, kb * 64, nb * 32, WO + (size_t)(nb * 32) * 1024 + kb * 64, 1024, scr, lane); }
        }
    }
    SEAM(PH_PRO);
    if (IN(PH_HN)) {
        const float* g1n = args.in[I_N1G];
        auto hn_row = [&](int row) {
            const float* xr; int mrow;
            if (row < NTOK) { xr = args.in[I_X] + (size_t)row * 1024; mrow = row >> 12; } else { xr = args.in[I_CTX] + (size_t)(row - NTOK) * 1024; mrow = 8; }
            const float* sh = MOD + mrow * 6144; const float* sc = sh + 1024;
            f32x4 v[4]; float ss = 0.f;
#pragma unroll
            for (int j = 0; j < 4; ++j) { v[j] = *(const f32x4*)(xr + 4 * lane + 256 * j); ss += (v[j].x * v[j].x + v[j].y * v[j].y) + (v[j].z * v[j].z + v[j].w * v[j].w); }
            const float rstd = 1.0f / sqrtf(wave_sum(ss) * (1.f / 1024.f) + EPS);
#pragma unroll
            for (int j = 0; j < 4; ++j) {
                const int col = 4 * lane + 256 * j;
                const f32x4 gv = *(const f32x4*)(g1n + col), scv = *(const f32x4*)(sc + col), shv = *(const f32x4*)(sh + col);
                const f32x4 h = (v[j] * rstd * gv) * (1.f + scv) + shv;
                st4bf(H + (size_t)row * 1024 + col, h);
            }
        };
        for (int row = gw; row < NROWS_H; row += NGW) hn_row(row);
    }
    SEAM(PH_HN);
    if (IN(PH_IN)) {
        Gemm g{H, WIN, 1024, 1024, 1024, 0, 30, nullptr}; StaticOrder S; S.init(NTOK, INCOLS, G, bid, 16);
        EpiIn E{Y, VA, KB, VB, GT, args.in[I_BMG], ROPE, (f32x2*)(ws + WS_STATS)};
        GEMM_PHASE<EpiIn, StaticOrder, false>(lds, g, S, E);
    }
    SEAM(PH_IN);
    if (IN(PH_MIX) && FAST_MIX) {
        if (!(args.flags & 8)) for (int task = bid; task < NB * 32; task += G) mix::gmlp_unit(task, Y, (args.flags & 2) ? TMP : Y, (args.flags & 2) ? 1024 : 2048, VA, WSP, (const f32x2*)(ws + WS_STATS), args.in[I_LNG], args.in[I_LNB], args.in[I_BSP], lds);
#if ATT_PIPE
        att2::bf16x8 att_qr[4]; int att_base = 0; bool att_primed = false;
#endif
        if (!(args.flags & 1)) for (int task = bid; task < NB * 32 * 4; task += G) {
#if ATT_PIPE
            for (int hp = 0; hp < 2; ++hp) {
                const bool more = (hp == 0) || (task + G < NB * 32 * 4); const int ntask = hp == 0 ? task : task + G; int nbase_ = 0;
                att2::attn_unit<ATT_THRL>(task >> 7, (task >> 2) & 31, task & 3, hp, att_base, att_primed, more, ntask >> 7, (ntask >> 2) & 31, ntask & 3, hp ^ 1, att_qr, nbase_,
                                          Y, (args.flags & 4) ? TMP : Y + 1024, (args.flags & 4) ? 1024 : 2048, KB, VB, args.in[I_SINK], lds);
                att_base = nbase_; att_primed = more;
            }
#else
            mix::attn_unit(task >> 7, (task >> 2) & 31, task & 3, Y, (args.flags & 4) ? TMP : Y + 1024, (args.flags & 4) ? 1024 : 2048, KB, VB, args.in[I_SINK], lds);
#endif
        }
    }
    SEAM(PH_MIX);
    if (IN(PH_A)) {
        Gemm g{Y, WAB, 2048, 2048, 2048, 0, 30, nullptr}; StaticOrder S; S.init(NTOK, 1024, G, bid, 0, 1);
        EpiAB E{MERGED, GT};
        GEMM_PHASE<EpiAB, StaticOrder, false, true>(lds, g, S, E);
    }
    SEAM(PH_A);
    if (IN(PH_O)) {
        Gemm g{MERGED, WO, 1024, 1024, 1024, 0, 30, nullptr}; StaticOrder S; S.init(NTOK, 1024, G, bid);
        EpiO E{args.out, args.in[I_X], MOD};
        GEMM_PHASE<EpiO, StaticOrder, false>(lds, g, S, E);
    }
    SEAM(PH_O);
    if (IN(PH_H2R)) {
        LAS float* wT = (LAS float*)lds;
        { f32x4 wv[8];
#pragma unroll
          for (int k = 0; k < 8; ++k) wv[k] = *(const f32x4*)(args.in[I_WR] + 4 * (tid + NTHREADS * k));
#pragma unroll
          for (int k = 0; k < 8; ++k) { const int f = tid + NTHREADS * k, col = f >> 2, e0 = 4 * (f & 3); wT[e0 * 1024 + col] = wv[k].x; wT[(e0 + 1) * 1024 + col] = wv[k].y; wT[(e0 + 2) * 1024 + col] = wv[k].z; wT[(e0 + 3) * 1024 + col] = wv[k].w; } }
        __syncthreads();
        const float* g2n = args.in[I_N2G];
        const bool h32 = lane & 32, h16 = lane & 16, h8 = lane & 8, h4 = lane & 4;
        const int myexp = 8 * (lane >> 5) + 4 * ((lane >> 4) & 1) + 2 * ((lane >> 3) & 1) + ((lane >> 2) & 1);
        f32x4 vn[2][4];
#pragma unroll
        for (int q = 0; q < 2; ++q)
#pragma unroll
            for (int j = 0; j < 4; ++j) vn[q][j] = *(const f32x4*)(args.out + (size_t)(2 * (NTOK / 2 - 1 - (gw < NTOK / 2 ? gw : 0)) + q) * 1024 + 4 * lane + 256 * j);
        for (int rp = gw; rp < NTOK / 2; rp += NGW) {
            const int row0 = 2 * (NTOK / 2 - 1 - rp), b = row0 >> 12;
            const float* sh = MOD + b * 6144 + 3072; const float* sc = sh + 1024;
            f32x4 v[2][4]; float ss[2] = {0.f, 0.f};
#pragma unroll
            for (int q = 0; q < 2; ++q)
#pragma unroll
                for (int j = 0; j < 4; ++j) { v[q][j] = vn[q][j]; ss[q] += (v[q][j].x * v[q][j].x + v[q][j].y * v[q][j].y) + (v[q][j].z * v[q][j].z + v[q][j].w * v[q][j].w); }
            { const int rn = (rp + NGW < NTOK / 2) ? rp + NGW : rp;
#pragma unroll
              for (int q = 0; q < 2; ++q)
#pragma unroll
                  for (int j = 0; j < 4; ++j) vn[q][j] = *(const f32x4*)(args.out + (size_t)(2 * (NTOK / 2 - 1 - rn) + q) * 1024 + 4 * lane + 256 * j); }
            float rstd[2];
#pragma unroll
            for (int q = 0; q < 2; ++q) rstd[q] = 1.0f / sqrtf(wave_sum(ss[q]) * (1.f / 1024.f) + EPS);
            float lg[2][16];
#pragma unroll
            for (int q = 0; q < 2; ++q)
#pragma unroll
                for (int e = 0; e < 16; ++e) lg[q][e] = 0.f;
            f32x4 wb[2][4];
#pragma unroll
            for (int e = 0; e < 4; ++e) wb[0][e] = *(const LAS f32x4*)(wT + e * 1024 + 4 * lane);
            f32x4 h[2];
#pragma unroll
            for (int g = 0; g < 16; ++g) {
                const int j = g >> 2, eg = g & 3, col = 4 * lane + 256 * j;
                if (g + 1 < 16) {
                    const int jn = (g + 1) >> 2, en = (g + 1) & 3;
#pragma unroll
                    for (int e = 0; e < 4; ++e) wb[(g + 1) & 1][e] = *(const LAS f32x4*)(wT + (4 * en + e) * 1024 + 4 * lane + 256 * jn);
                }
                if (eg == 0) {
                    const f32x4 gv = *(const f32x4*)(g2n + col), scv = *(const f32x4*)(sc + col), shv = *(const f32x4*)(sh + col);
#pragma unroll
                    for (int q = 0; q < 2; ++q) { h[q] = (v[q][j] * rstd[q] * gv) * (1.f + scv) + shv; st4bf(H2 + (size_t)(row0 + q) * 1024 + col, h[q]); }
                }
#pragma unroll
                for (int e = 0; e < 4; ++e) {
                    const f32x4 w = wb[g & 1][e];
#pragma unroll
                    for (int q = 0; q < 2; ++q) lg[q][4 * eg + e] += (h[q].x * w.x + h[q].y * w.y) + (h[q].z * w.z + h[q].w * w.w);
                    asm volatile("" : "+v"(lg[0][4 * eg + e]), "+v"(lg[1][4 * eg + e]));
                }
                asm volatile("" ::: "memory");
            }
#pragma unroll
            for (int q = 0; q < 2; ++q) {
                float a8[8], a4[4], a2[2], a1;
#pragma unroll
                for (int i = 0; i < 8; ++i) { const float send = h32 ? lg[q][i] : lg[q][i + 8], keep = h32 ? lg[q][i + 8] : lg[q][i]; a8[i] = keep + __shfl_xor(send, 32); }
#pragma unroll
                for (int i = 0; i < 4; ++i) { const float send = h16 ? a8[i] : a8[i + 4], keep = h16 ? a8[i + 4] : a8[i]; a4[i] = keep + __shfl_xor(send, 16); }
#pragma unroll
                for (int i = 0; i < 2; ++i) { const float send = h8 ? a4[i] : a4[i + 2], keep = h8 ? a4[i + 2] : a4[i]; a2[i] = keep + __shfl_xor(send, 8); }
                { const float send = h4 ? a2[0] : a2[1], keep = h4 ? a2[1] : a2[0]; a1 = keep + __shfl_xor(send, 4); }
                a1 += __shfl_xor(a1, 2); a1 += __shfl_xor(a1, 1);
                float mx = a1;
#pragma unroll
                for (int o = 4; o < 64; o <<= 1) mx = fmaxf(mx, __shfl_xor(mx, o));
                const float p = __expf(a1 - mx); float den = p;
#pragma unroll
                for (int o = 4; o < 64; o <<= 1) den += __shfl_xor(den, o);
                if ((lane & 3) == 0) AFFT[(size_t)(b * 16 + myexp) * SEQ + ((row0 + q) & (SEQ - 1))] = p / den;
            }
        }
    }
    if (IN(PH_WCONV)) {
        __syncthreads();
        LAS float* scr = (LAS float*)(lds + wave * 16384);
        constexpr int I_G = 16 * 16 * 64, I_D = 16 * 32 * 32;
        auto item = [&](int it) -> TrItem {
            int r = it; TrItem t;
            if (r < 2 * I_G) {
                const int up = r >= I_G; if (up) r -= I_G;
                const int e = r >> 10, kb = (r >> 6) & 15, nb = r & 63, n0 = nb * 32;
                const int drow = 256 * (n0 >> 7) + (n0 & 127) + (up ? 128 : 0);
                t.src = args.in[up ? I_WEU : I_WEG] + (size_t)e * 1024 * 2048 + (size_t)(kb * 64) * 2048 + n0; t.N = 2048;
                t.dst = WGU + (size_t)e * 4096 * 1024 + (size_t)drow * 1024 + kb * 64; t.ldt = 1024;
            } else {
                r -= 2 * I_G;
                const int e = r >> 10, kb = (r >> 5) & 31, nb = r & 31;
                t.src = args.in[I_WED] + (size_t)e * 2048 * 1024 + (size_t)(kb * 64) * 1024 + nb * 32; t.N = 1024;
                t.dst = WD + (size_t)e * 1024 * 2048 + (size_t)(nb * 32) * 2048 + kb * 64; t.ldt = 2048;
            }
            return t;
        };
        constexpr int NIT = 2 * I_G + I_D;
        if (gw < NIT) {
            TrItem cur = item(gw); f32x4 vc[8], vn[8];
            tr_load(cur, vc, lane);
            for (int it = gw; it < NIT; it += NGW) {
                const bool more = it + NGW < NIT;
                TrItem nxt = cur;
                if (more) { nxt = item(it + NGW); tr_load(nxt, vn, lane); }
                tr_store(cur, vc, scr, lane);
                cur = nxt;
#pragma unroll
                for (int i = 0; i < 8; ++i) vc[i] = vn[i];
            }
        }
    }
    SEAM(PH_WCONV);
    if (IN(PH_TOPK)) {
        LAS int* wsum = (LAS int*)lds;
        for (int task = bid; task < NE * NB; task += G) {
            const int e = task >> 3, b = task & 7;
            const float* aff = AFFT + (size_t)(b * 16 + e) * SEQ;
            unsigned k[8];
            { const u32x4 a0 = *(const u32x4*)(aff + 8 * tid), a1 = *(const u32x4*)(aff + 8 * tid + 4); k[0] = a0.x; k[1] = a0.y; k[2] = a0.z; k[3] = a0.w; k[4] = a1.x; k[5] = a1.y; k[6] = a1.z; k[7] = a1.w; }
            unsigned T = 0u; int it = 0;
            __syncthreads();
            for (int bit = 30; bit >= 0; --bit, ++it) {
                const unsigned cand = T | (1u << bit); int c = 0;
#pragma unroll
                for (int j = 0; j < 8; ++j) c += __builtin_popcountll(__ballot(k[j] >= cand));
                if (lane == 0) wsum[(it & 1) * 8 + wave] = c;
                __syncthreads();
                int tot = 0;
#pragma unroll
                for (int w = 0; w < 8; ++w) tot += wsum[(it & 1) * 8 + w];
                if (tot >= CAP) T = cand;
            }
            int cg = 0, ce = 0;
#pragma unroll
            for (int j = 0; j < 8; ++j) { cg += (k[j] > T) ? 1 : 0; ce += (k[j] == T) ? 1 : 0; }
            LAS int* sc1 = wsum + 16; LAS int* sc2 = wsum + 32;
            int ie = ce, ig = cg;
#pragma unroll
            for (int o = 1; o < 64; o <<= 1) { const int te = __shfl_up(ie, o), tg = __shfl_up(ig, o); if (lane >= o) { ie += te; ig += tg; } }
            __syncthreads();
            if (lane == 63) { sc1[wave] = ie; sc2[wave] = ig; }
            __syncthreads();
            int ebase = ie - ce, totg = 0;
#pragma unroll
            for (int w = 0; w < 8; ++w) { if (w < wave) ebase += sc1[w]; totg += sc2[w]; }
            const int need = CAP - totg;
            int sel[8], cs = 0, er = ebase;
#pragma unroll
            for (int j = 0; j < 8; ++j) { const bool eq = (k[j] == T); sel[j] = (k[j] > T) || (eq && er < need); er += eq ? 1 : 0; cs += sel[j]; }
            int is = cs;
#pragma unroll
            for (int o = 1; o < 64; o <<= 1) { const int ts = __shfl_up(is, o); if (lane >= o) is += ts; }
            __syncthreads();
            if (lane == 63) sc1[wave] = is;
            __syncthreads();
            int sbase = is - cs;
#pragma unroll
            for (int w = 0; w < 8; ++w) if (w < wave) sbase += sc1[w];
#pragma unroll
            for (int j = 0; j < 8; ++j) {
                const int t = 8 * tid + j; int slot = -1;
                if (sel[j]) { slot = sbase; ++sbase; const int prow = (e * 8 + b) * CAP + slot; TOPI[prow] = t; TOPW[prow] = __uint_as_float(k[j]); }
                SLOT[((size_t)b * SEQ + t) * 16 + e] = slot;
            }
            __syncthreads();
        }
    }
    SEAM(PH_TOPK);
    if (IN(PH_GU)) {
        Gemm g{H2, WGU, 1024, 1024, 1024, (size_t)4096 * 1024, 4, TOPI}; StaticOrder S; S.init(NPAIR, 4096, G, bid);
        EpiGU E{ACT};
        GEMM_PHASE<EpiGU, StaticOrder, true>(lds, g, S, E);
    }
    SEAM(PH_GU);
    if (IN(PH_D)) {
        Gemm g{ACT, WD, 2048, 2048, 2048, (size_t)1024 * 2048, 4, nullptr}; StaticOrder S; S.init(NPAIR, 1024, G, bid, 0, 1);
        EpiD E{YB, TOPW};
        GEMM_PHASE<EpiD, StaticOrder, false>(lds, g, S, E);
    }
    SEAM(PH_D);
    if (IN(PH_FIN)) {
        const float* fg = args.in[I_FING];
        const bf16_t* ZROW = (const bf16_t*)(ws + WS_CTL + 512 * 1024);
        int sln[2] = {-1, -1};
        if (gw < NTOK / 2 && lane < 16) { sln[0] = SLOT[(size_t)(2 * gw) * 16 + lane]; sln[1] = SLOT[(size_t)(2 * gw + 1) * 16 + lane]; }
        for (int rp = gw; rp < NTOK / 2; rp += NGW) {
            const int row0 = 2 * rp, b = row0 >> 12;
            const int sl[2] = {sln[0], sln[1]};
            { const int rn = rp + NGW; if (rn < NTOK / 2 && lane < 16) { sln[0] = SLOT[(size_t)(2 * rn) * 16 + lane]; sln[1] = SLOT[(size_t)(2 * rn + 1) * 16 + lane]; } }
            const float* g2 = MOD + b * 6144 + 5120;
            f32x4 xv[2][4], acc[2][4];
#pragma unroll
            for (int q = 0; q < 2; ++q)
#pragma unroll
                for (int h = 0; h < 2; ++h) { const float* xp = args.out + (size_t)(row0 + q) * 1024 + 512 * h + 8 * lane; xv[q][2 * h] = *(const f32x4*)xp; xv[q][2 * h + 1] = *(const f32x4*)(xp + 4);
                    acc[q][2 * h] = (f32x4){0.f, 0.f, 0.f, 0.f}; acc[q][2 * h + 1] = (f32x4){0.f, 0.f, 0.f, 0.f}; }
#pragma unroll
            for (int q = 0; q < 2; ++q) {
                unsigned long long mask = __ballot(sl[q] >= 0);
                for (;;) {
                    const bf16_t* yr[4];
#pragma unroll
                    for (int k = 0; k < 4; ++k) {
                        if (mask) { const int ex = __builtin_ctzll(mask); mask &= mask - 1; const int s = __builtin_amdgcn_readlane(sl[q], ex); yr[k] = YB + (size_t)((ex * 8 + b) * CAP + s) * 1024; }
                        else yr[k] = ZROW;
                    }
                    u32x4 y[4][2];
#pragma unroll
                    for (int k = 0; k < 4; ++k)
#pragma unroll
                        for (int h = 0; h < 2; ++h) y[k][h] = *(const u32x4*)(yr[k] + 512 * h + 8 * lane);
#pragma unroll
                    for (int k = 0; k < 4; ++k)
#pragma unroll
                        for (int h = 0; h < 2; ++h) { const u32x4 w = y[k][h];
                            acc[q][2 * h] += (f32x4){bf2f(w.x & 0xffffu), bf2f(w.x >> 16), bf2f(w.y & 0xffffu), bf2f(w.y >> 16)};
                            acc[q][2 * h + 1] += (f32x4){bf2f(w.z & 0xffffu), bf2f(w.z >> 16), bf2f(w.w & 0xffffu), bf2f(w.w >> 16)}; }
                    if (!mask) break;
                }
            }
#pragma unroll
            for (int q = 0; q < 2; ++q) {
                float ss = 0.f;
#pragma unroll
                for (int h = 0; h < 2; ++h)
#pragma unroll
                    for (int u4 = 0; u4 < 2; ++u4) { const int col = 512 * h + 8 * lane + 4 * u4; f32x4& v = xv[q][2 * h + u4]; v = v + *(const f32x4*)(g2 + col) * acc[q][2 * h + u4]; ss += (v.x * v.x + v.y * v.y) + (v.z * v.z + v.w * v.w); }
                const float rstd = 1.0f / sqrtf(wave_sum(ss) * (1.f / 1024.f) + EPS);
#pragma unroll
                for (int h = 0; h < 2; ++h)
#pragma unroll
                    for (int u4 = 0; u4 < 2; ++u4) { const int col = 512 * h + 8 * lane + 4 * u4; *(f32x4*)(args.out + (size_t)(row0 + q) * 1024 + col) = xv[q][2 * h + u4] * rstd * *(const f32x4*)(fg + col); }
            }
        }
    }
#undef IN
}

extern "C" void kernel_launch(void* const* d_in, const int* in_sizes, int n_in, void* d_out, int out_size, void* d_ws, size_t ws_size, hipStream_t stream) {
    static int grid = 0;
    if (grid == 0) {
        if (n_in != 23 || in_sizes[0] != NTOK * DM || out_size != NTOK * DM || ws_size < WS_END) {
            fprintf(stderr, "kernel_launch: unexpected problem (n_in %d, in0 %d, out %d, ws %zu < %zu?)\n", n_in, n_in > 0 ? in_sizes[0] : -1, out_size, ws_size, (size_t)WS_END); grid = -1; return; }
        if (hipFuncSetAttribute((const void*)fwd, hipFuncAttributeMaxDynamicSharedMemorySize, LDS_BYTES) != hipSuccess) { fprintf(stderr, "kernel_launch: hipFuncSetAttribute failed\n"); grid = -1; return; }
        int dev = 0, cus = 0;
        if (hipGetDevice(&dev) != hipSuccess || hipDeviceGetAttribute(&cus, hipDeviceAttributeMultiprocessorCount, dev) != hipSuccess) { grid = -1; return; }
        grid = cus;
    }
    if (grid < 0) return;
    (void)hipMemsetAsync((char*)d_ws + WS_CTL, 0, 1 * MiB, stream);
    Args a{};
    for (int i = 0; i < 23; ++i) a.in[i] = (const float*)d_in[i];
    a.out = (float*)d_out; a.ws = (unsigned char*)d_ws;
    if (ONE_LAUNCH) {
        a.ph_lo = 0; a.ph_hi = PH_COUNT;
        hipLaunchKernelGGL(fwd, dim3(grid), dim3(NTHREADS), LDS_BYTES, stream, a);
    } else {
        static const int seq[] = {PROBE_SEQ};
        for (unsigned i = 0; i < sizeof(seq) / sizeof(seq[0]); ++i) {
            a.ph_lo = seq[i] % 100; a.ph_hi = seq[i] % 100 + 1; a.flags = seq[i] / 100;
            hipLaunchKernelGGL(fwd, dim3(grid), dim3(NTHREADS), LDS_BYTES, stream, a);
        }
    }
}
```

```cpp
#include <hip/hip_runtime.h>
#include <cstdio>
#include <cstdint>

#define LAS __attribute__((address_space(3)))
typedef unsigned short bf16_t;
typedef float f32x4 __attribute__((ext_vector_type(4)));
typedef float f32x2 __attribute__((ext_vector_type(2)));
typedef unsigned u32x4 __attribute__((ext_vector_type(4)));
typedef unsigned u32x2 __attribute__((ext_vector_type(2)));
typedef int i32x4 __attribute__((ext_vector_type(4)));

constexpr int DM = 1024, NB = 8, SEQ = 4096, NTOK = NB * SEQ, CTXL = 256, NCTX = NB * CTXL, NROWS_H = NTOK + NCTX;
constexpr int INCOLS = 5632, OFF_Q = 2048, OFF_K = 3072, OFF_VB = 3328, OFF_GATE = 3584;
constexpr int NE = 16, CAP = 512, DE = 2048, NPAIR = NE * NB * CAP;
constexpr float EPS = 1e-6f, LOG2E = 1.4426950408889634f, C2 = 0.125f * LOG2E;
constexpr int NTHREADS = 512, NWAVES = 8;

constexpr size_t MiB = 1u << 20;
constexpr size_t WS_CTL = 0;
constexpr size_t WS_MOD = 1 * MiB;
constexpr size_t WS_ROPE = 1 * MiB + 512 * 1024;
constexpr size_t WS_AFFT = 2 * MiB;
constexpr size_t WS_TOPI = 4 * MiB;
constexpr size_t WS_TOPW = 4 * MiB + 512 * 1024;
constexpr size_t WS_SLOT = 5 * MiB;
constexpr size_t WS_WSP = 7 * MiB;
constexpr size_t WS_WIN = 8 * MiB;
constexpr size_t WS_WAB = 19 * MiB;
constexpr size_t WS_WO = 23 * MiB;
constexpr size_t WS_R = 25 * MiB;
constexpr size_t WS_H = WS_R;
constexpr size_t WS_VA = WS_R + 68 * MiB;
constexpr size_t WS_KB = WS_VA + 64 * MiB;
constexpr size_t WS_VB = WS_KB + 17 * MiB;
constexpr size_t WS_G = WS_VB + 17 * MiB;
constexpr size_t WS_Y = WS_G + 128 * MiB;
constexpr size_t WS_TMP = WS_Y + 128 * MiB;
constexpr size_t WS_STATS = WS_TMP + 64 * MiB;
constexpr size_t WS_MERGED = WS_H;
constexpr size_t WS_WGU = WS_R;
constexpr size_t WS_WD = WS_R + 128 * MiB;
constexpr size_t WS_H2 = WS_R + 192 * MiB;
constexpr size_t WS_ACT = WS_R + 256 * MiB;
constexpr size_t WS_YB = WS_WGU;
constexpr size_t WS_END = 537 * MiB;
static_assert(WS_STATS + 4 * MiB <= WS_END && WS_ACT + 256 * MiB == WS_END, "ws map");

constexpr int LDS_BYTES = 147456;

__device__ __forceinline__ float bf2f(unsigned b) { return __uint_as_float(b << 16); }
__device__ __forceinline__ unsigned f2bf(float f) { unsigned u = __float_as_uint(f); return (u + 0x7fffu + ((u >> 16) & 1u)) >> 16; }
__device__ __forceinline__ unsigned pk2(float lo, float hi) { typedef float f2_ __attribute__((ext_vector_type(2))); typedef __bf16 b2_ __attribute__((ext_vector_type(2))); f2_ v = {lo, hi}; b2_ b = __builtin_convertvector(v, b2_); return __builtin_bit_cast(unsigned, b); }
__device__ __forceinline__ void st4bf(bf16_t* p, f32x4 v) { u32x2 w; w.x = pk2(v.x, v.y); w.y = pk2(v.z, v.w); *(u32x2*)p = w; }
__device__ __forceinline__ void st8bf(bf16_t* p, f32x4 a, f32x4 b) { u32x4 w; w.x = pk2(a.x, a.y); w.y = pk2(a.z, a.w); w.z = pk2(b.x, b.y); w.w = pk2(b.z, b.w); *(u32x4*)p = w; }
__device__ __forceinline__ void ld8bf(const bf16_t* p, f32x4& a, f32x4& b) { const u32x4 w = *(const u32x4*)p; a.x = bf2f(w.x & 0xffffu); a.y = bf2f(w.x >> 16); a.z = bf2f(w.y & 0xffffu); a.w = bf2f(w.y >> 16); b.x = bf2f(w.z & 0xffffu); b.y = bf2f(w.z >> 16); b.z = bf2f(w.w & 0xffffu); b.w = bf2f(w.w >> 16); }
__device__ __forceinline__ f32x4 ld4bf(const bf16_t* p) { const u32x2 w = *(const u32x2*)p; f32x4 v; v.x = bf2f(w.x & 0xffffu); v.y = bf2f(w.x >> 16); v.z = bf2f(w.y & 0xffffu); v.w = bf2f(w.y >> 16); return v; }
__device__ __forceinline__ float sigmoidf_(float x) { return __builtin_amdgcn_rcpf(1.f + __builtin_amdgcn_exp2f(x * -1.4426950409f)); }
__device__ __forceinline__ float siluf_(float x) { return x * __builtin_amdgcn_rcpf(1.f + __builtin_amdgcn_exp2f(x * -1.4426950409f)); }
__device__ __forceinline__ float gelu_t(float x) { const float t = x * __builtin_fmaf(x * x, -0.10294324f, -2.3022082f); return x * __builtin_amdgcn_rcpf(1.f + __builtin_amdgcn_exp2f(t)); }
__device__ __forceinline__ f32x2 rcp2_(f32x2 d) { f32x2 r; r.x = __builtin_amdgcn_rcpf(d.x); r.y = __builtin_amdgcn_rcpf(d.y); return r; }
__device__ __forceinline__ f32x2 exp2_2_(f32x2 t) { f32x2 e; e.x = __builtin_amdgcn_exp2f(t.x); e.y = __builtin_amdgcn_exp2f(t.y); return e; }
__device__ __forceinline__ f32x2 gelu2_(f32x2 x) { const f32x2 t = x * ((x * x) * -0.10294324f + -2.3022082f); return x * rcp2_(exp2_2_(t) + 1.0f); }
__device__ __forceinline__ f32x2 sigm2_(f32x2 x) { return rcp2_(exp2_2_(x * -1.4426950409f) + 1.0f); }
__device__ __forceinline__ f32x4 gelu4_(f32x4 v) { const f32x2 a = gelu2_((f32x2){v.x, v.y}), b = gelu2_((f32x2){v.z, v.w}); return (f32x4){a.x, a.y, b.x, b.y}; }
__device__ __forceinline__ f32x4 sigm4_(f32x4 v) { const f32x2 a = sigm2_((f32x2){v.x, v.y}), b = sigm2_((f32x2){v.z, v.w}); return (f32x4){a.x, a.y, b.x, b.y}; }
__device__ __forceinline__ float wave_sum(float v) {
#pragma unroll
    for (int o = 1; o < 64; o <<= 1) v += __shfl_xor(v, o);
    return v;
}
__device__ __forceinline__ int wave_sum_i(int v) {
#pragma unroll
    for (int o = 1; o < 64; o <<= 1) v += __shfl_xor(v, o);
    return v;
}
#define LDS_WAIT() asm volatile("s_waitcnt lgkmcnt(0)" ::: "memory")

struct Args { const float* in[23]; float* out; unsigned char* ws; int ph_lo, ph_hi, flags, pad; };
enum { I_X = 0, I_C, I_CTX, I_CCTX, I_WADA, I_BADA, I_N1G, I_WIN, I_BMG, I_LNG, I_LNB, I_WSP, I_BSP, I_SINK, I_WPA, I_WPB, I_WOUT, I_N2G, I_WR, I_WEG, I_WEU, I_WED, I_FING };

struct Unit { int pm, pn; };
struct Gemm {
    const bf16_t* A; const bf16_t* Bt; int lda, ldb, K;
    size_t bgs; int tpg_shift;
    const int* gidx;
};
constexpr int NXCD = 8, WGM = 8;
struct StaticOrder {
    int nM, nN, nwg, G, c, extra, rev;
    __device__ void init(int M, int N, int G_, int c_, int extra_ = 0, int rev_ = 0) { nM = M / 256; nN = N / 256; nwg = nM * nN; G = G_; c = c_; extra = extra_; rev = rev_; }
    __device__ bool next(int i, Unit& u) const {
        const long L = (long)i * G + c;
        if (L >= nwg) { const int x = (int)(L - nwg); if (x >= extra) return false; u.pm = NTOK / 256 + (x >> 1); u.pn = 12 + (x & 1); return true; }
        int wgid = (int)L; { const int q = nwg / NXCD, r = nwg % NXCD, xcd = wgid % NXCD, off = wgid / NXCD; wgid = (xcd < r ? xcd * (q + 1) : r * (q + 1) + (xcd - r) * q) + off; }
        const int nig = WGM * nN, gid = wgid / nig, fm = gid * WGM, gsz = (nM - fm) < WGM ? (nM - fm) : WGM;
        u.pm = fm + ((wgid % nig) % gsz); u.pn = (wgid % nig) / gsz; if (rev) u.pm = nM - 1 - u.pm; return true;
    }
};

struct OneUnit { int pm, pn; __device__ bool next(int i, Unit& u) const { if (i) return false; u.pm = pm; u.pn = pn; return true; } };

typedef f32x4 Acc[2][2][4][2];

namespace pg8 {
typedef short bf16x8 __attribute__((ext_vector_type(8)));
constexpr int BK = 64, HALF = 128, HTB = HALF * BK * 2, STAGE_BYTES = 8 * HTB;
__device__ __forceinline__ int lds_byte(int r, int c) { const int st = (r >> 4) * 2 + (c >> 5), rr = r & 15, cc = c & 31, ob = rr * 64 + cc * 2; return st * 1024 + (ob ^ (((ob >> 9) & 1) << 5)); }
__device__ __forceinline__ void stage_rc(int b, int& R, int& C) { const int st = b / 1024, sb = b % 1024, swz = sb ^ (((sb >> 9) & 1) << 5); R = (st >> 1) * 16 + swz / 64; C = (st & 1) * 32 + (swz % 64) / 2; }

template <class Epi, class Sched, bool GATHER, bool HOOK = false>
__device__ __forceinline__ void gemm_phase(LAS unsigned char* lds, const Gemm g, const Sched& S, const Epi& E) {
    const int tid = threadIdx.x, wid = __builtin_amdgcn_readfirstlane(tid >> 6), lane = tid & 63, wr = wid >> 2, wc = wid & 3, fr = lane & 15, fq = lane >> 4;
    const int nt = g.K / BK;
    int Rs[2], Cs[2]; unsigned voffBp[2][2], voffB[2], voffBn[2], vA[2][2], vN[2][2];
#pragma unroll
    for (int i = 0; i < 2; ++i) { stage_rc(tid * 16 + i * 8192, Rs[i], Cs[i]); voffBp[0][i] = (unsigned)(Rs[i] * g.ldb + Cs[i]) * 2u;
        const int rho = Rs[i] & 31, Rb = (Rs[i] & ~31) + 8 * ((rho & 15) >> 2) + 4 * (rho >> 4) + (rho & 3); voffBp[1][i] = (unsigned)(Rb * g.ldb + Cs[i]) * 2u; }
    const size_t kstep = (size_t)(BK * 2);
    const size_t hstepB = (size_t)HALF * g.ldb * 2;
    const unsigned ldsw = (unsigned)wid * 1024u;
    const int aoff = lds_byte(wr * 64 + fr, fq * 8), boff = lds_byte(wc * 32 + fr, fq * 8);
#define PG8_SA(b, h) (((b) * 2 + (h)) * HTB)
#define PG8_SB(b, h) ((4 + (b) * 2 + (h)) * HTB)
#define PG8_STAGE(bufoff, gbase, voff) do { _Pragma("unroll") for (int _i = 0; _i < 2; ++_i) \
        __builtin_amdgcn_global_load_lds((const unsigned*)((const char*)(gbase) + (voff)[_i]), (LAS unsigned*)(lds + (bufoff) + ldsw + _i * 8192), 16, 0, 0); } while (0)
#define PG8_LDA(dst, b, h) do { _Pragma("unroll") for (int m = 0; m < 4; ++m) _Pragma("unroll") for (int k = 0; k < 2; ++k) dst[m][k] = *(const LAS bf16x8*)(lds + PG8_SA(b, h) + aoff + m * 2048 + k * 1024); } while (0)
#define PG8_LDB(dst, b, h) do { _Pragma("unroll") for (int n = 0; n < 2; ++n) _Pragma("unroll") for (int k = 0; k < 2; ++k) dst[n][k] = *(const LAS bf16x8*)(lds + PG8_SB(b, h) + boff + n * 2048 + k * 1024); } while (0)
#define PG8_MMA(ai, bj, At, Bt) do { __builtin_amdgcn_s_setprio(1); _Pragma("unroll") for (int m = 0; m < 4; ++m) _Pragma("unroll") for (int n = 0; n < 2; ++n) _Pragma("unroll") for (int k = 0; k < 2; ++k) \
        acc[ai][bj][m][n] = __builtin_amdgcn_mfma_f32_16x16x32_bf16(Bt[n][k], At[m][k], acc[ai][bj][m][n], 0, 0, 0); __builtin_amdgcn_s_setprio(0); } while (0)
#define PG8_WAIT_V(n) asm volatile("s_waitcnt vmcnt(" #n ")" ::: "memory")
#define PG8_WAIT_L(n) asm volatile("s_waitcnt lgkmcnt(" #n ")" ::: "memory")
#define PG8_BAR __builtin_amdgcn_s_barrier()
#define PG8_SCHED __builtin_amdgcn_sched_barrier(0)
#define PG8_AVOFF(dst, U) do { _Pragma("unroll") for (int _h = 0; _h < 2; ++_h) _Pragma("unroll") for (int _i = 0; _i < 2; ++_i) \
        dst[_h][_i] = GATHER ? (unsigned)((((U).pm >> 1) & 7) * SEQ + g.gidx[(U).pm * 256 + _h * 128 + Rs[_i]]) * (unsigned)(g.lda * 2) + (unsigned)(Cs[_i] * 2) \
                             : (unsigned)((_h * 128 + Rs[_i]) * g.lda + Cs[_i]) * 2u; } while (0)
#define PG8_ABASE(U) ((const char*)g.A + (GATHER ? (size_t)0 : (size_t)(U).pm * 256 * g.lda * 2))
#define PG8_BBASE(U) ((const char*)g.Bt + ((size_t)((U).pm >> g.tpg_shift) * g.bgs + (size_t)(U).pn * 256 * g.ldb) * 2)
    Unit cur, nxt; int ui = 0;
    if (!S.next(0, cur)) return;
    Acc acc;
#pragma unroll
    for (int a = 0; a < 2; ++a)
#pragma unroll
        for (int b = 0; b < 2; ++b)
#pragma unroll
            for (int m = 0; m < 4; ++m)
#pragma unroll
                for (int n = 0; n < 2; ++n) acc[a][b][m][n] = (f32x4){0.f, 0.f, 0.f, 0.f};
    bf16x8 At[4][2], B0[2][2], B1[2][2];
    PG8_AVOFF(vA, cur);
    { const bool pc = E.perm(cur); voffB[0] = pc ? voffBp[1][0] : voffBp[0][0]; voffB[1] = pc ? voffBp[1][1] : voffBp[0][1]; }
    const char* cA = PG8_ABASE(cur); const char* cB = PG8_BBASE(cur);
    PG8_STAGE(PG8_SB(0, 0), cB, voffB); PG8_STAGE(PG8_SB(0, 1), cB + hstepB, voffB); PG8_STAGE(PG8_SA(0, 0), cA, vA[0]); PG8_STAGE(PG8_SA(0, 1), cA, vA[1]);
    if (wr == 1) PG8_BAR;
    PG8_WAIT_V(2); PG8_BAR;
    PG8_STAGE(PG8_SB(1, 0), cB + kstep, voffB); PG8_STAGE(PG8_SA(1, 0), cA + kstep, vA[0]); PG8_STAGE(PG8_SB(1, 1), cB + hstepB + kstep, voffB);
    PG8_WAIT_V(6); PG8_BAR;
    for (;;) {
        const bool has_next = S.next(ui + 1, nxt);
        const char* nA = has_next ? PG8_ABASE(nxt) : cA; const char* nB = has_next ? PG8_BBASE(nxt) : cB;
        { const bool pn_ = has_next ? E.perm(nxt) : E.perm(cur); voffBn[0] = pn_ ? voffBp[1][0] : voffBp[0][0]; voffBn[1] = pn_ ? voffBp[1][1] : voffBp[0][1]; }
        if (GATHER) {
#pragma unroll
            for (int h = 0; h < 2; ++h)
#pragma unroll
                for (int i = 0; i < 2; ++i) vN[h][i] = vA[h][i];
            if (has_next && wid == 0)
                __builtin_amdgcn_global_load_lds((const unsigned*)(g.gidx + nxt.pm * 256 + lane * 4), (LAS unsigned*)(lds + STAGE_BYTES + (ui & 1) * 1024), 16, 0, 0);
        }
        for (int t = 0; t < nt; t += 2) {
            const bool last = (t == nt - 2);
            if (GATHER) { if (t == 4 && has_next) {
                const LAS int* li = (const LAS int*)(lds + STAGE_BYTES + (ui & 1) * 1024);
#pragma unroll
                for (int h = 0; h < 2; ++h)
#pragma unroll
                    for (int i = 0; i < 2; ++i) vN[h][i] = (unsigned)(((nxt.pm >> 1) & 7) * SEQ + li[h * 128 + Rs[i]]) * (unsigned)(g.lda * 2) + (unsigned)(Cs[i] * 2);
            } }
            if constexpr (HOOK) { if (t == (nt >> 1)) E.mid(acc, cur, wr, wc, fr, fq); }
            const char* a1 = cA + (size_t)(t + 1) * kstep;
            const char* a2 = last ? nA : cA + (size_t)(t + 2) * kstep; const char* b2 = last ? nB : cB + (size_t)(t + 2) * kstep;
            const char* a3 = a2 + kstep; const char* b3 = b2 + kstep;
            unsigned v2[2][2];
#pragma unroll
            for (int h = 0; h < 2; ++h)
#pragma unroll
                for (int i = 0; i < 2; ++i) v2[h][i] = (GATHER && last) ? vN[h][i] : vA[h][i];
            unsigned vb2[2]; vb2[0] = last ? voffBn[0] : voffB[0]; vb2[1] = last ? voffBn[1] : voffB[1];
            PG8_LDB(B0, 0, 0); PG8_LDB(B1, 0, 1); PG8_SCHED; PG8_LDA(At, 0, 0); PG8_STAGE(PG8_SA(1, 1), a1, vA[1]);
            PG8_WAIT_V(8); PG8_WAIT_L(0); PG8_BAR; PG8_MMA(0, 0, At, B0); PG8_MMA(0, 1, At, B1); PG8_BAR; PG8_SCHED;
            PG8_LDA(At, 0, 1); PG8_STAGE(PG8_SB(0, 0), b2, vb2); PG8_STAGE(PG8_SB(0, 1), b2 + hstepB, vb2); PG8_STAGE(PG8_SA(0, 0), a2, v2[0]);
            PG8_WAIT_V(8); PG8_WAIT_L(0); PG8_BAR; PG8_MMA(1, 0, At, B0); PG8_MMA(1, 1, At, B1); PG8_BAR; PG8_SCHED;
            PG8_LDB(B0, 1, 0); PG8_LDB(B1, 1, 1); PG8_SCHED; PG8_LDA(At, 1, 0); PG8_STAGE(PG8_SA(0, 1), a2, v2[1]);
            PG8_WAIT_V(8); PG8_WAIT_L(0); PG8_BAR; PG8_MMA(0, 0, At, B0); PG8_MMA(0, 1, At, B1); PG8_BAR; PG8_SCHED;
            PG8_LDA(At, 1, 1); PG8_STAGE(PG8_SB(1, 0), b3, vb2); PG8_STAGE(PG8_SB(1, 1), b3 + hstepB, vb2); PG8_STAGE(PG8_SA(1, 0), a3, v2[0]);
            PG8_WAIT_V(8); PG8_WAIT_L(0); PG8_BAR; PG8_MMA(1, 0, At, B0); PG8_MMA(1, 1, At, B1); PG8_BAR; PG8_SCHED;
        }
        if (wr == 0) PG8_BAR;
        E(acc, cur, wr, wc, fr, fq);
        if (!has_next) break;
#pragma unroll
        for (int a = 0; a < 2; ++a)
#pragma unroll
            for (int b = 0; b < 2; ++b)
#pragma unroll
                for (int m = 0; m < 4; ++m)
#pragma unroll
                    for (int n = 0; n < 2; ++n) acc[a][b][m][n] = (f32x4){0.f, 0.f, 0.f, 0.f};
        cur = nxt; cA = nA; cB = nB; ++ui; voffB[0] = voffBn[0]; voffB[1] = voffBn[1];
        if (GATHER) {
#pragma unroll
            for (int h = 0; h < 2; ++h)
#pragma unroll
                for (int i = 0; i < 2; ++i) vA[h][i] = vN[h][i];
        }
        if (wr == 1) PG8_BAR;
    }
    PG8_WAIT_V(0);
    PG8_BAR;
#undef PG8_SA
#undef PG8_SB
#undef PG8_STAGE
#undef PG8_LDA
#undef PG8_LDB
#undef PG8_MMA
#undef PG8_WAIT_V
#undef PG8_WAIT_L
#undef PG8_BAR
#undef PG8_SCHED
#undef PG8_AVOFF
#undef PG8_ABASE
#undef PG8_BBASE
}
}

#define GEMM_PHASE pg8::gemm_phase

struct EpiIn {
    bf16_t *Y, *VA, *KB, *VB, *G; const float* bgate; const f32x2* rope; f32x2* STATS;
    __device__ __forceinline__ bool perm(const Unit& u) const { return u.pn < 8 || u.pn > 12; }
    template <int KIND> __device__ __forceinline__ void run(const Acc& acc, const Unit& u, int wr, int wc, int fr, int fq) const {
        const int pn = u.pn;
#pragma unroll
        for (int ai = 0; ai < 2; ++ai)
#pragma unroll
            for (int m = 0; m < 4; ++m) {
                const int row = u.pm * 256 + ai * 128 + wr * 64 + m * 16 + fr;
                float ssum = 0.f, ssq = 0.f;
#pragma unroll
                for (int bj = 0; bj < 2; ++bj) {
                    f32x4 v0 = acc[ai][bj][m][0], v1 = acc[ai][bj][m][1];
                    if constexpr (KIND == 0 || KIND == 1) {
                        const int c8 = bj * 128 + wc * 32 + 8 * fq;
                        v0 = gelu4_(v0); v1 = gelu4_(v1);
                        if constexpr (KIND == 0) st8bf(Y + (size_t)row * 2048 + pn * 256 + c8, v0, v1);
                        else {
                            st8bf(VA + (size_t)row * 1024 + (pn - 4) * 256 + c8, v0, v1);
                            ssum += ((v0.x + v0.y) + (v0.z + v0.w)) + ((v1.x + v1.y) + (v1.z + v1.w));
                            ssq += ((v0.x * v0.x + v0.y * v0.y) + (v0.z * v0.z + v0.w * v0.w)) + ((v1.x * v1.x + v1.y * v1.y) + (v1.z * v1.z + v1.w * v1.w));
                        }
                    } else if constexpr (KIND == 2) {
                        const int cl = bj * 128 + wc * 32 + 4 * fq;
                        f32x4 o0 = v0, o1 = v1;
                        if (row < NTOK) {
                            const int t = row & (SEQ - 1), pos = (wc & 1) ? (t & 63) : (t >> 6);
                            const f32x2* rp = rope + pos * 16 + 4 * fq;
#pragma unroll
                            for (int j = 0; j < 4; ++j) { const f32x2 cs = rp[j]; o0[j] = v0[j] * cs.x - v1[j] * cs.y; o1[j] = v0[j] * cs.y + v1[j] * cs.x; }
                        }
                        if (pn < 12) { bf16_t* p = Y + (size_t)row * 2048 + 1024 + (pn - 8) * 256 + cl; st4bf(p, o0 * C2); st4bf(p + 16, o1 * C2); }
                        else { bf16_t* p = KB + (size_t)row * 256 + cl; st4bf(p, o0); st4bf(p + 16, o1); }
                    } else if constexpr (KIND == 3) {
                        st8bf(VB + (size_t)row * 256 + bj * 128 + wc * 32 + 8 * fq, v0, v1);
                    } else {
                        const int cg = (pn - 14) * 256 + bj * 128 + wc * 32 + 8 * fq;
                        const f32x4 b0 = *(const f32x4*)(bgate + cg), b1 = *(const f32x4*)(bgate + cg + 4);
                        v0 = sigm4_(v0 + b0); v1 = sigm4_(v1 + b1);
                        st8bf(G + (size_t)row * 2048 + cg, v0, v1);
                    }
                }
                if constexpr (KIND == 1) {
                    ssum += __shfl_xor(ssum, 16); ssum += __shfl_xor(ssum, 32); ssq += __shfl_xor(ssq, 16); ssq += __shfl_xor(ssq, 32);
                    if (fq == 0) STATS[(size_t)row * 16 + (pn - 4) * 4 + wc] = (f32x2){ssum, ssq};
                }
            }
    }
    __device__ __forceinline__ void operator()(const Acc& acc, const Unit& u, int wr, int wc, int fr, int fq) const {
        const int pn = u.pn;
        if (pn < 4) run<0>(acc, u, wr, wc, fr, fq);
        else if (pn < 8) run<1>(acc, u, wr, wc, fr, fq);
        else if (pn < 13) run<2>(acc, u, wr, wc, fr, fq);
        else if (pn == 13) run<3>(acc, u, wr, wc, fr, fq);
        else run<4>(acc, u, wr, wc, fr, fq);
    }
};
struct EpiAB {
    bf16_t* MERGED; const bf16_t* G;
    __device__ __forceinline__ bool perm(const Unit&) const { return true; }
    __device__ __forceinline__ void mid(Acc& acc, const Unit& u, int wr, int wc, int fr, int fq) const {
        int zero; asm volatile("v_mov_b32 %0, 0" : "=v"(zero));
        const bf16_t* gp = G + (size_t)(u.pm * 256 + wr * 64 + fr + zero) * 2048 + u.pn * 256 + wc * 32 + 8 * fq;
#pragma unroll
        for (int ai = 0; ai < 2; ++ai)
#pragma unroll
            for (int m = 0; m < 4; ++m) {
#pragma unroll
                for (int bj = 0; bj < 2; ++bj) {
                    const bf16_t* q = gp + (size_t)(ai * 128 + m * 16) * 2048 + bj * 128;
                    f32x4 ga0, ga1, gb0, gb1; ld8bf(q, ga0, ga1); ld8bf(q + 1024, gb0, gb1);
#pragma unroll
                    for (int j = 0; j < 4; ++j) { acc[ai][bj][m][0][j] *= ga0[j] * __builtin_amdgcn_rcpf(gb0[j]); acc[ai][bj][m][1][j] *= ga1[j] * __builtin_amdgcn_rcpf(gb1[j]); }
                    asm volatile("" ::: "memory");
                }
            }
    }
    __device__ __forceinline__ void operator()(const Acc& acc, const Unit& u, int wr, int wc, int fr, int fq) const {
#pragma unroll
        for (int ai = 0; ai < 2; ++ai)
#pragma unroll
            for (int m = 0; m < 4; ++m) {
                const int row = u.pm * 256 + ai * 128 + wr * 64 + m * 16 + fr;
#pragma unroll
                for (int bj = 0; bj < 2; ++bj) {
                    const int c8 = u.pn * 256 + bj * 128 + wc * 32 + 8 * fq;
                    f32x4 gb0, gb1; ld8bf(G + (size_t)row * 2048 + 1024 + c8, gb0, gb1);
                    st8bf(MERGED + (size_t)row * 1024 + c8, gb0 * acc[ai][bj][m][0], gb1 * acc[ai][bj][m][1]);
                }
            }
    }
};
struct EpiO {
    bf16_t* D16; const float* mod;
    __device__ __forceinline__ bool perm(const Unit&) const { return true; }
    __device__ __forceinline__ void operator()(const Acc& acc, const Unit& u, int wr, int wc, int fr, int fq) const {
        const float* g1 = mod + (size_t)((u.pm * 256) >> 12) * 6144 + 2048;
#pragma unroll
        for (int bj = 0; bj < 2; ++bj) {
            const int c8 = u.pn * 256 + bj * 128 + wc * 32 + 8 * fq;
            const f32x4 ga = *(const f32x4*)(g1 + c8), gb = *(const f32x4*)(g1 + c8 + 4);
#pragma unroll
            for (int ai = 0; ai < 2; ++ai)
#pragma unroll
                for (int m = 0; m < 4; ++m) {
                    const int row = u.pm * 256 + ai * 128 + wr * 64 + m * 16 + fr;
                    st8bf(D16 + (size_t)row * 2048 + 1024 + c8, ga * acc[ai][bj][m][0], gb * acc[ai][bj][m][1]);
                }
        }
    }
};
struct EpiGU {
    bf16_t* ACT;
    __device__ __forceinline__ bool perm(const Unit&) const { return true; }
    __device__ __forceinline__ void operator()(const Acc& acc, const Unit& u, int wr, int wc, int fr, int fq) const {
#pragma unroll
        for (int ai = 0; ai < 2; ++ai)
#pragma unroll
            for (int m = 0; m < 4; ++m) {
                const int prow = u.pm * 256 + ai * 128 + wr * 64 + m * 16 + fr;
                f32x4 a[2];
#pragma unroll
                for (int n = 0; n < 2; ++n) {
                    const f32x4 gt = acc[ai][0][m][n], up = acc[ai][1][m][n];
                    a[n] = gt * sigm4_(gt) * up;
                }
                st8bf(ACT + (size_t)prow * 2048 + u.pn * 128 + wc * 32 + 8 * fq, a[0], a[1]);
            }
    }
};
struct EpiD {
    bf16_t* YB; const float* TOPW;
    __device__ __forceinline__ bool perm(const Unit&) const { return true; }
    __device__ __forceinline__ void operator()(const Acc& acc, const Unit& u, int wr, int wc, int fr, int fq) const {
#pragma unroll
        for (int ai = 0; ai < 2; ++ai)
#pragma unroll
            for (int m = 0; m < 4; ++m) {
                const int prow = u.pm * 256 + ai * 128 + wr * 64 + m * 16 + fr; const float w = TOPW[prow];
#pragma unroll
                for (int bj = 0; bj < 2; ++bj)
                    st8bf(YB + (size_t)prow * 1024 + u.pn * 256 + bj * 128 + wc * 32 + 8 * fq, acc[ai][bj][m][0] * w, acc[ai][bj][m][1] * w);
            }
    }
};

__device__ __forceinline__ void transpose_item(const float* W, int N, int k0, int n0, bf16_t* dst, int ldt, LAS float* scr, int lane) {
    const int kk = lane >> 3, nq = (lane & 7) * 4;
    f32x4 v[8];
#pragma unroll
    for (int i = 0; i < 8; ++i) v[i] = *(const f32x4*)(W + (size_t)(k0 + 8 * i + kk) * N + n0 + nq);
#pragma unroll
    for (int i = 0; i < 8; ++i) { LAS float* s = scr + (8 * i + kk) * 33 + nq; s[0] = v[i].x; s[1] = v[i].y; s[2] = v[i].z; s[3] = v[i].w; }
    LDS_WAIT();
    const int c = lane & 7;
#pragma unroll
    for (int j = 0; j < 4; ++j) {
        const int n = (lane >> 3) + 8 * j; const LAS float* s = scr + (8 * c) * 33 + n;
        u32x4 o; o.x = pk2(s[0 * 33], s[1 * 33]); o.y = pk2(s[2 * 33], s[3 * 33]); o.z = pk2(s[4 * 33], s[5 * 33]); o.w = pk2(s[6 * 33], s[7 * 33]);
        *(u32x4*)(dst + (size_t)n * ldt + 8 * c) = o;
    }
    LDS_WAIT();
}

struct TrItem { const float* src; bf16_t* dst; int N, ldt; };
__device__ __forceinline__ void tr_load(const TrItem& it, f32x4 (&v)[8], int lane) {
    const int kk = lane >> 3, nq = (lane & 7) * 4;
#pragma unroll
    for (int i = 0; i < 8; ++i) v[i] = *(const f32x4*)(it.src + (size_t)(8 * i + kk) * it.N + nq);
}
__device__ __forceinline__ void tr_store(const TrItem& it, const f32x4 (&v)[8], LAS float* scr, int lane) {
    const int kk = lane >> 3, nq = (lane & 7) * 4;
#pragma unroll
    for (int i = 0; i < 8; ++i) { LAS float* s = scr + (8 * i + kk) * 33 + nq; s[0] = v[i].x; s[1] = v[i].y; s[2] = v[i].z; s[3] = v[i].w; }
    LDS_WAIT();
    const int c = lane & 7;
#pragma unroll
    for (int j = 0; j < 4; ++j) {
        const int n = (lane >> 3) + 8 * j; const LAS float* s = scr + (8 * c) * 33 + n;
        u32x4 o; o.x = pk2(s[0 * 33], s[1 * 33]); o.y = pk2(s[2 * 33], s[3 * 33]); o.z = pk2(s[4 * 33], s[5 * 33]); o.w = pk2(s[6 * 33], s[7 * 33]);
        *(u32x4*)(it.dst + (size_t)n * it.ldt + 8 * c) = o;
    }
    LDS_WAIT();
}

__device__ __forceinline__ void adaln_task(int task, const float* c, const float* cctx, const float* w_ada, const float* b_ada, float* mod, LAS float* lds, int tid) {
    LAS float* s = lds; LAS float* red = lds + 9 * 1024;
    { float cv[18];
#pragma unroll
      for (int q = 0; q < 18; ++q) { const int i = tid + NTHREADS * q, r = i >> 10, k = i & 1023; cv[q] = r < 8 ? c[r * 1024 + k] : cctx[k]; }
#pragma unroll
      for (int q = 0; q < 18; ++q) s[tid + NTHREADS * q] = cv[q] * __builtin_amdgcn_rcpf(1.f + __expf(-cv[q])); }
    __syncthreads();
    const int ch = tid & 7, kr = tid >> 3;
    f32x4 acc[9];
#pragma unroll
    for (int r = 0; r < 9; ++r) acc[r] = (f32x4){0.f, 0.f, 0.f, 0.f};
    const float* wp = w_ada + (size_t)kr * 6144 + task * 32 + ch * 4;
    for (int it = 0; it < 16; ++it) {
        const f32x4 w = *(const f32x4*)(wp + (size_t)it * 64 * 6144); const int k = kr + it * 64;
#pragma unroll
        for (int r = 0; r < 9; ++r) acc[r] += s[r * 1024 + k] * w;
    }
#pragma unroll
    for (int r = 0; r < 9; ++r) *(LAS f32x4*)(red + (kr * 9 + r) * 32 + ch * 4) = acc[r];
    __syncthreads();
    if (tid < 288) { const int r = tid >> 5, col = tid & 31; float sum = 0.f; for (int q = 0; q < 64; ++q) sum += red[(q * 9 + r) * 32 + col]; mod[r * 6144 + task * 32 + col] = sum + b_ada[task * 32 + col]; }
    __syncthreads();
}

__device__ __forceinline__ void rope_table(f32x2* tab, int tid) {
    for (int idx = tid; idx < 1024; idx += NTHREADS) {
        const int pos = idx >> 4, i = idx & 15;
        double f = 1.0;
        for (int q = 0; q < i; ++q) f *= 0.56234132519034908;
        const float ang = (float)pos * (float)f;
        const double a = (double)ang, k = __builtin_rint(a * 0.15915494309189535), r = a - k * 6.283185307179586476925, r2 = r * r;
        double sn = r, ts = r, cs = 1.0, tc = 1.0;
        for (int n = 1; n <= 14; ++n) {
            tc *= -r2 / (double)((2 * n - 1) * (2 * n)); cs += tc;
            ts *= -r2 / (double)((2 * n) * (2 * n + 1)); sn += ts;
        }
        tab[idx] = (f32x2){(float)cs, (float)sn};
    }
}

__device__ __forceinline__ unsigned char* lds_raw_ptr(LAS unsigned char* p) { return (unsigned char*)p; }
namespace mix {
typedef short bf16x8 __attribute__((ext_vector_type(8)));
typedef short s16x4 __attribute__((ext_vector_type(4)));
typedef float f32x16 __attribute__((ext_vector_type(16)));
typedef __attribute__((address_space(3))) const char* lds_cptr;
__device__ __forceinline__ int crow(int r, int hi) { return (r & 3) + 8 * (r >> 2) + 4 * hi; }
__device__ __forceinline__ unsigned cvtpk(float lo, float hi) { typedef float f2 __attribute__((ext_vector_type(2))); typedef __bf16 b2 __attribute__((ext_vector_type(2))); f2 v = {lo, hi}; b2 b = __builtin_convertvector(v, b2); return __builtin_bit_cast(unsigned, b); }
__device__ __forceinline__ s16x4 vtr(lds_cptr p) { return __builtin_bit_cast(s16x4, __builtin_amdgcn_ds_read_tr16_b64_v4i16((__attribute__((address_space(3))) s16x4*)p)); }
__device__ __forceinline__ bf16x8 pk8(s16x4 lo, s16x4 hi) { return (bf16x8){lo[0], lo[1], lo[2], lo[3], hi[0], hi[1], hi[2], hi[3]}; }
__device__ __forceinline__ float max3f(float a, float b, float c) { float r; asm("v_max3_f32 %0, %1, %2, %3" : "=v"(r) : "v"(a), "v"(b), "v"(c)); return r; }
__device__ __forceinline__ float max2f(float a, float b) { float r; asm("v_max_f32_e32 %0, %1, %2" : "=v"(r) : "v"(a), "v"(b)); return r; }
__device__ __forceinline__ float swap_half(float v) { auto rr = __builtin_amdgcn_permlane32_swap(__float_as_uint(v), __float_as_uint(v), false, false); return __uint_as_float((threadIdx.x & 32) ? rr[0] : rr[1]); }

constexpr int A_K = 0, A_V = 24576, A_WS = 49152, A_QST = 53248, A_OST = A_QST, A_OSTW = 8192, A_END = A_QST + 8 * 8192;

__device__ __forceinline__ void attn_unit(int b, int n, int kvh, bf16_t* Y, bf16_t* O, int ldo, const bf16_t* KB, const bf16_t* VB, const float* sink, LAS unsigned char* lds) {
    const int tid = threadIdx.x, lane = tid & 63, r32 = lane & 31, hi = lane >> 5, wid = __builtin_amdgcn_readfirstlane(tid >> 6);
    const int head = kvh * 4 + (wid >> 1);
    const int qrow0 = b * SEQ + n * 128 + (wid & 1) * 64;
    bf16_t* Qw = Y + (size_t)qrow0 * 2048 + 1024 + head * 64;
    LAS bf16x8* qst = (LAS bf16x8*)(lds + A_QST + wid * 8192) + lane;
#pragma unroll
    for (int sb = 0; sb < 2; ++sb)
#pragma unroll
        for (int d0 = 0; d0 < 4; ++d0) qst[(sb * 4 + d0) * 64] = *(const bf16x8*)(Qw + (size_t)(32 * sb + r32) * 2048 + d0 * 16 + hi * 8);
    f32x16 o[2][2];
#pragma unroll
    for (int sb = 0; sb < 2; ++sb)
#pragma unroll
        for (int d0 = 0; d0 < 2; ++d0)
#pragma unroll
            for (int r = 0; r < 16; ++r) o[sb][d0][r] = 0.f;
    float m[2] = {-1e30f, -1e30f}, l[2] = {0.f, 0.f};
    LAS float* wsf = (LAS float*)(lds + A_WS) + wid * 128;
    const int jlo = (n == 0) ? 2 : 0, jhi = (n == 31) ? 3 : 5, T = 4 + (jhi - jlo + 1);
    const size_t koff = (size_t)lane * 256 + wid * 8 + kvh * 64;
    const size_t voff = (size_t)(16 * (wid & 3) + (lane >> 2)) * 256 + (wid >> 2) * 32 + (lane & 3) * 8 + kvh * 64;
    auto tile_row = [&](int t) -> long { return t < 4 ? (long)(NTOK + b * CTXL + 64 * t) : (long)(b * SEQ + (n - 1) * 128 + 64 * (jlo + t - 4)); };
    auto issue = [&](int t) {
        const long row = tile_row(t); const int buf = t % 3;
        __builtin_amdgcn_global_load_lds((const unsigned*)(KB + row * 256 + koff), (LAS unsigned*)(lds + A_K + buf * 8192 + wid * 1024), 16, 0, 0);
        __builtin_amdgcn_global_load_lds((const unsigned*)(VB + row * 256 + voff), (LAS unsigned*)(lds + A_V + buf * 8192 + wid * 1024), 16, 0, 0);
    };
    issue(0); issue(1);
    int slot = 0;
    for (int t = 0; t < T; ++t) {
        if (t + 1 < T) asm volatile("s_waitcnt vmcnt(2) lgkmcnt(0)" ::: "memory"); else asm volatile("s_waitcnt vmcnt(0) lgkmcnt(0)" ::: "memory");
        __builtin_amdgcn_s_barrier();
        if (t + 2 < T) issue(t + 2);
        const lds_cptr Kt = (lds_cptr)(lds + A_K + slot * 8192) + hi * 1024 + r32 * 16;
        const lds_cptr Vt = (lds_cptr)(lds + A_V + slot * 8192) + ((lane >> 4) & 1) * 32 + (lane & 3) * 8 + (4 * hi + ((lane & 15) >> 2)) * 64;
        slot = (slot == 2) ? 0 : slot + 1;
        const bool local = t >= 4;
        const int dl = 64 * (jlo + t - 4) - 128 - 64 * (wid & 1);
        if (local && (dl > 160 || dl < -191)) continue;
        f32x16 p0[2], p1[2];
#pragma unroll
        for (int sb = 0; sb < 2; ++sb)
#pragma unroll
            for (int r = 0; r < 16; ++r) { p0[sb][r] = 0.f; p1[sb][r] = 0.f; }
#pragma unroll
        for (int d0 = 0; d0 < 4; ++d0) {
            const bf16x8 k0 = *(const __attribute__((address_space(3))) bf16x8*)(Kt + d0 * 2048), k1 = *(const __attribute__((address_space(3))) bf16x8*)(Kt + d0 * 2048 + 512);
#pragma unroll
            for (int sb = 0; sb < 2; ++sb) {
                const bf16x8 qf = qst[(sb * 4 + d0) * 64];
                p0[sb] = __builtin_amdgcn_mfma_f32_32x32x16_bf16(k0, qf, p0[sb], 0, 0, 0);
                p1[sb] = __builtin_amdgcn_mfma_f32_32x32x16_bf16(k1, qf, p1[sb], 0, 0, 0);
            }
        }
        if (local && (dl < -97 || dl > 65 || dl - 32 < -97)) {
#pragma unroll
            for (int sb = 0; sb < 2; ++sb)
#pragma unroll
                for (int r = 0; r < 16; ++r) { const int rel = dl - 32 * sb + crow(r, hi) - r32; if (rel < -128 || rel > 128) p0[sb][r] = -1e30f; if (rel + 32 < -128 || rel + 32 > 128) p1[sb][r] = -1e30f; }
        }
        float mn[2];
        asm volatile("s_nop 15\n\ts_nop 7" : "+v"(p0[0]), "+v"(p1[0]), "+v"(p0[1]), "+v"(p1[1]));
#pragma unroll
        for (int sb = 0; sb < 2; ++sb) {
            float a = max3f(p0[sb][0], p0[sb][1], p1[sb][0]), b2 = max3f(p0[sb][2], p0[sb][3], p1[sb][1]); a = max3f(a, p1[sb][2], p1[sb][3]);
#pragma unroll
            for (int r = 4; r < 16; r += 4) { a = max3f(a, p0[sb][r], p0[sb][r + 1]); b2 = max3f(b2, p0[sb][r + 2], p0[sb][r + 3]); a = max3f(a, p1[sb][r], p1[sb][r + 1]); b2 = max3f(b2, p1[sb][r + 2], p1[sb][r + 3]); }
            float rm = max2f(a, b2);
            rm = max2f(rm, swap_half(rm));
            mn[sb] = max2f(m[sb], rm);
        }
        if (__any((mn[0] > m[0]) || (mn[1] > m[1]))) {
            const float f0 = __builtin_amdgcn_exp2f(m[0] - mn[0]), f1 = __builtin_amdgcn_exp2f(m[1] - mn[1]);
            l[0] *= f0; l[1] *= f1;
            if (hi == 0) { wsf[r32] = f0; wsf[64 + r32] = f1; }
            asm volatile("s_waitcnt lgkmcnt(0)" ::: "memory");
#pragma unroll
            for (int r = 0; r < 16; ++r) { const float a = wsf[crow(r, hi)], b2 = wsf[64 + crow(r, hi)]; o[0][0][r] *= a; o[0][1][r] *= a; o[1][0][r] *= b2; o[1][1][r] *= b2; }
            m[0] = mn[0]; m[1] = mn[1];
        }
        u32x4 pw[2][4];
#pragma unroll
        for (int sb = 0; sb < 2; ++sb) {
            float sacc = 0.f;
#pragma unroll
            for (int r = 0; r < 16; ++r) { p0[sb][r] = __builtin_amdgcn_exp2f(p0[sb][r] - m[sb]); p1[sb][r] = __builtin_amdgcn_exp2f(p1[sb][r] - m[sb]); sacc += p0[sb][r] + p1[sb][r]; }
            l[sb] += sacc;
#pragma unroll
            for (int q = 0; q < 4; ++q) { pw[sb][0][q] = cvtpk(p0[sb][2 * q], p0[sb][2 * q + 1]); pw[sb][1][q] = cvtpk(p0[sb][8 + 2 * q], p0[sb][9 + 2 * q]); pw[sb][2][q] = cvtpk(p1[sb][2 * q], p1[sb][2 * q + 1]); pw[sb][3][q] = cvtpk(p1[sb][8 + 2 * q], p1[sb][9 + 2 * q]); }
        }
#pragma unroll
        for (int d0 = 0; d0 < 2; ++d0)
#pragma unroll
            for (int ks = 0; ks < 4; ++ks) {
                const s16x4 vlo = vtr(Vt + d0 * 4096 + ks * 1024), vhi = vtr(Vt + d0 * 4096 + ks * 1024 + 512);
                const bf16x8 vf = pk8(vlo, vhi);
#pragma unroll
                for (int sb = 0; sb < 2; ++sb) o[sb][d0] = __builtin_amdgcn_mfma_f32_32x32x16_bf16(__builtin_bit_cast(bf16x8, pw[sb][ks]), vf, o[sb][d0], 0, 0, 0);
            }
    }
    const float s2 = sink[head] * LOG2E;
    LAS bf16_t* stg = (LAS bf16_t*)(lds + A_OST + wid * A_OSTW);
#pragma unroll
    for (int sb = 0; sb < 2; ++sb) {
        const float lt = l[sb] + swap_half(l[sb]);
        const float mf = fmaxf(m[sb], s2), f = __builtin_amdgcn_exp2f(m[sb] - mf), den = lt * f + __builtin_amdgcn_exp2f(s2 - mf);
        asm volatile("s_waitcnt lgkmcnt(0)" ::: "memory");
        if (hi == 0) wsf[sb * 64 + r32] = f / den;
        asm volatile("s_waitcnt lgkmcnt(0)" ::: "memory");
#pragma unroll
        for (int r = 0; r < 16; ++r) { const float sc = wsf[sb * 64 + crow(r, hi)]; const int orow = crow(r, hi);
            stg[orow * 64 + r32] = (bf16_t)f2bf(o[sb][0][r] * sc); stg[orow * 64 + 32 + r32] = (bf16_t)f2bf(o[sb][1][r] * sc); }
        asm volatile("s_waitcnt lgkmcnt(0)" ::: "memory");
#pragma unroll
        for (int i = 0; i < 4; ++i) { const int row = i * 8 + (lane >> 3), ch = lane & 7; const u32x4 v = *(const LAS u32x4*)(stg + row * 64 + ch * 8); *(u32x4*)(O + (size_t)(qrow0 + 32 * sb + row) * ldo + head * 64 + ch * 8) = v; }
        asm volatile("s_waitcnt lgkmcnt(0)" ::: "memory");
    }
    __syncthreads();
}

constexpr int G_V = 0, G_ST = 65536, G_STW = 8704, G_MU = G_ST + 8 * G_STW;
__device__ __forceinline__ void gmlp_unit(int task, bf16_t* Y, bf16_t* YO, int ldo, const bf16_t* VA, const bf16_t* WSP, const f32x2* STATS, const float* ln_g, const float* ln_b, const float* b_sp, LAS unsigned char* lds) {
    const int tid = threadIdx.x, lane = tid & 63, r32 = lane & 31, hi = lane >> 5, wid = __builtin_amdgcn_readfirstlane(tid >> 6);
    const int r0 = task * 128;
    LAS float* mu = (LAS float*)(lds + G_MU); LAS float* rs = mu + 128;
    if (tid < 128) {
        const f32x4* sp = (const f32x4*)(STATS + (size_t)(r0 + tid) * 16); float s = 0.f, ss = 0.f;
#pragma unroll
        for (int i = 0; i < 8; ++i) { const f32x4 v = sp[i]; s += v.x + v.z; ss += v.y + v.w; }
        const float mean = s * (1.f / 1024.f), var = fmaxf(ss * (1.f / 1024.f) - mean * mean, 0.f);
        mu[tid] = mean; rs[tid] = 1.0f / sqrtf(var + EPS);
    }
    u32x4 raw[4];
#pragma unroll
    for (int i = 0; i < 4; ++i) { const int idx = tid + NTHREADS * i, q = idx >> 4, c8 = idx & 15; raw[i] = *(const u32x4*)(VA + (size_t)(r0 + q) * 1024 + c8 * 8); }
    __syncthreads();
    const int pb = wid >> 1, dh = wid & 1;
    LAS float* st = (LAS float*)(lds + G_ST + wid * G_STW);
    for (int g8 = 0; g8 < 8; ++g8) {
        LAS unsigned char* vb = lds + G_V + (g8 & 1) * 32768;
#pragma unroll
        for (int i = 0; i < 4; ++i) {
            const int idx = tid + NTHREADS * i, q = idx >> 4, c8 = idx & 15, d = c8 * 8;
            const f32x4 g0 = *(const f32x4*)(ln_g + g8 * 128 + d), g1 = *(const f32x4*)(ln_g + g8 * 128 + d + 4), b0 = *(const f32x4*)(ln_b + g8 * 128 + d), b1 = *(const f32x4*)(ln_b + g8 * 128 + d + 4);
            const float mq = mu[q], rq = rs[q]; const u32x4 rw = raw[i];
            float v[8] = {bf2f(rw.x & 0xffffu), bf2f(rw.x >> 16), bf2f(rw.y & 0xffffu), bf2f(rw.y >> 16), bf2f(rw.z & 0xffffu), bf2f(rw.z >> 16), bf2f(rw.w & 0xffffu), bf2f(rw.w >> 16)};
#pragma unroll
            for (int e = 0; e < 4; ++e) { v[e] = (v[e] - mq) * rq * g0[e] + b0[e]; v[4 + e] = (v[4 + e] - mq) * rq * g1[e] + b1[e]; }
            u32x4 w; w.x = pk2(v[0], v[1]); w.y = pk2(v[2], v[3]); w.z = pk2(v[4], v[5]); w.w = pk2(v[6], v[7]);
            *(LAS u32x4*)(vb + ((d >> 5) * 8 + (q >> 4)) * 1024 + (q & 15) * 64 + (d & 31) * 2) = w;
        }
        if (g8 + 1 < 8) {
#pragma unroll
            for (int i = 0; i < 4; ++i) { const int idx = tid + NTHREADS * i, q = idx >> 4, c8 = idx & 15; raw[i] = *(const u32x4*)(VA + (size_t)(r0 + q) * 1024 + (g8 + 1) * 128 + c8 * 8); }
        }
        u32x4 ur[4]; bf16x8 af[8];
        const size_t ybase = (size_t)(r0 + 32 * pb + (lane >> 3)) * 2048 + g8 * 128 + 64 * dh + (lane & 7) * 8;
#pragma unroll
        for (int i = 0; i < 4; ++i) ur[i] = *(const u32x4*)(Y + ybase + (size_t)(8 * i) * 2048);
        const bf16_t* wrow = WSP + (size_t)g8 * 16384 + (size_t)(32 * pb + r32) * 128 + 8 * hi;
#pragma unroll
        for (int ks = 0; ks < 8; ++ks) af[ks] = *(const bf16x8*)(wrow + 16 * ks);
        __syncthreads();
        const lds_cptr Vb = (lds_cptr)vb + ((lane >> 4) & 1) * 32 + (lane & 3) * 8 + (8 * hi + ((lane & 15) >> 2)) * 64;
        f32x16 acc[2];
#pragma unroll
        for (int t2 = 0; t2 < 2; ++t2)
#pragma unroll
            for (int r = 0; r < 16; ++r) acc[t2][r] = 0.f;
#pragma unroll
        for (int ks = 0; ks < 8; ++ks) {
#pragma unroll
            for (int t2 = 0; t2 < 2; ++t2) {
                const int db = 2 * dh + t2;
                const s16x4 vlo = vtr(Vb + (db * 8 + ks) * 1024), vhi = vtr(Vb + (db * 8 + ks) * 1024 + 256);
                acc[t2] = __builtin_amdgcn_mfma_f32_32x32x16_bf16(af[ks], pk8(vlo, vhi), acc[t2], 0, 0, 0);
            }
        }
#pragma unroll
        for (int t2 = 0; t2 < 2; ++t2)
#pragma unroll
            for (int r = 0; r < 16; ++r) st[crow(r, hi) * 68 + 32 * t2 + r32] = acc[t2][r];
        asm volatile("s_waitcnt lgkmcnt(0)" ::: "memory");
#pragma unroll
        for (int i = 0; i < 4; ++i) {
            const int prow = 8 * i + (lane >> 3), ch = lane & 7;
            const f32x4 m0 = *(const LAS f32x4*)(st + prow * 68 + ch * 8), m1 = *(const LAS f32x4*)(st + prow * 68 + ch * 8 + 4);
            const float bs = b_sp[g8 * 128 + 32 * pb + prow]; const u32x4 uw = ur[i];
            u32x4 o;
            o.x = pk2(bf2f(uw.x & 0xffffu) * (m0.x + bs), bf2f(uw.x >> 16) * (m0.y + bs)); o.y = pk2(bf2f(uw.y & 0xffffu) * (m0.z + bs), bf2f(uw.y >> 16) * (m0.w + bs));
            o.z = pk2(bf2f(uw.z & 0xffffu) * (m1.x + bs), bf2f(uw.z >> 16) * (m1.y + bs)); o.w = pk2(bf2f(uw.w & 0xffffu) * (m1.z + bs), bf2f(uw.w >> 16) * (m1.w + bs));
            *(u32x4*)(YO + (size_t)(r0 + 32 * pb + prow) * ldo + g8 * 128 + 64 * dh + ch * 8) = o;
        }
        asm volatile("s_waitcnt lgkmcnt(0)" ::: "memory");
    }
    __syncthreads();
}
}

namespace att2 {
typedef short bf16x8 __attribute__((ext_vector_type(8)));
typedef short s16x4 __attribute__((ext_vector_type(4)));
typedef float f32x16 __attribute__((ext_vector_type(16)));
typedef __attribute__((address_space(3))) const char* lds_cptr;
typedef short v4i16_t __attribute__((ext_vector_type(4)));
__device__ __forceinline__ int crow(int r, int hi) { return (r & 3) + 8 * (r >> 2) + 4 * hi; }
#define SBAR() __builtin_amdgcn_sched_barrier(0)
constexpr int NSLOT = 3, SLOTB = 8192;
constexpr int LDS_K = 0, LDS_V = NSLOT * SLOTB, LDS_WS = 2 * NSLOT * SLOTB, LDS_OST = LDS_WS + 8 * 64 * 4, LDS_BYTES = LDS_OST + 8 * 4096;
__device__ __forceinline__ void glds16(const void* gsrc, unsigned lds_dst) { unsigned keep;
    asm volatile("s_mov_b32 %0, m0\n\ts_mov_b32 m0, %2\n\ts_nop 0\n\tglobal_load_lds_dwordx4 %1, off\n\ts_mov_b32 m0, %0" : "=&s"(keep) : "v"(gsrc), "s"(lds_dst) : "memory"); }
__device__ __forceinline__ float max3f(float a, float b, float c) { float r; asm("v_max3_f32 %0, %1, %2, %3" : "=v"(r) : "v"(a), "v"(b), "v"(c)); return r; }
__device__ __forceinline__ float max2f(float a, float b) { float r; asm("v_max_f32_e32 %0, %1, %2" : "=v"(r) : "v"(a), "v"(b)); return r; }
__device__ __forceinline__ float fadd_s(float a, float b) { float r; asm("v_add_f32_e32 %0, %1, %2" : "=v"(r) : "v"(a), "v"(b)); return r; }
__device__ __forceinline__ float fsub_s(float a, float b) { float r; asm("v_sub_f32_e32 %0, %1, %2" : "=v"(r) : "v"(a), "v"(b)); return r; }
typedef float f32x2_t __attribute__((ext_vector_type(2))); typedef __bf16 bf16x2_t __attribute__((ext_vector_type(2)));
__device__ __forceinline__ unsigned cvtpk_s(float lo, float hi) { f32x2_t v = {lo, hi}; bf16x2_t b = __builtin_convertvector(v, bf16x2_t); return __builtin_bit_cast(unsigned, b); }
#define WAIT_BAR(N) asm volatile("s_waitcnt vmcnt(" #N ") lgkmcnt(0)\n\ts_barrier" ::: "memory")
__device__ __forceinline__ void qkt(f32x16& p0, f32x16& p1, lds_cptr Kslot, const bf16x8* qr, const f32x16& negm, int r32, int hi) {
    const lds_cptr kb = Kslot + hi * 1024 + r32 * 16;
#pragma unroll
    for (int d0 = 0; d0 < 4; ++d0) {
        const bf16x8 b0 = *(const __attribute__((address_space(3))) bf16x8*)(kb + d0 * 2048);
        const bf16x8 b1 = *(const __attribute__((address_space(3))) bf16x8*)(kb + d0 * 2048 + 512);
        if (d0 == 0) { p0 = __builtin_amdgcn_mfma_f32_32x32x16_bf16(b0, qr[0], negm, 0, 0, 0); p1 = __builtin_amdgcn_mfma_f32_32x32x16_bf16(b1, qr[0], negm, 0, 0, 0); }
        else { p0 = __builtin_amdgcn_mfma_f32_32x32x16_bf16(b0, qr[d0], p0, 0, 0, 0); p1 = __builtin_amdgcn_mfma_f32_32x32x16_bf16(b1, qr[d0], p1, 0, 0, 0); }
    }
}
__device__ __forceinline__ void kload8(bf16x8* kf, lds_cptr kp) {
    kf[0] = *(const __attribute__((address_space(3))) bf16x8*)(kp);        kf[1] = *(const __attribute__((address_space(3))) bf16x8*)(kp + 512);
    kf[2] = *(const __attribute__((address_space(3))) bf16x8*)(kp + 2048); kf[3] = *(const __attribute__((address_space(3))) bf16x8*)(kp + 2560);
    kf[4] = *(const __attribute__((address_space(3))) bf16x8*)(kp + 4096); kf[5] = *(const __attribute__((address_space(3))) bf16x8*)(kp + 4608);
    kf[6] = *(const __attribute__((address_space(3))) bf16x8*)(kp + 6144); kf[7] = *(const __attribute__((address_space(3))) bf16x8*)(kp + 6656);
}
__device__ __forceinline__ void kload2(bf16x8* kf, lds_cptr kp, int j) { kf[2 * j] = *(const __attribute__((address_space(3))) bf16x8*)(kp + j * 2048); kf[2 * j + 1] = *(const __attribute__((address_space(3))) bf16x8*)(kp + j * 2048 + 512); }
__device__ __forceinline__ s16x4 vtr(lds_cptr p) { return __builtin_bit_cast(s16x4, __builtin_amdgcn_ds_read_tr16_b64_v4i16((__attribute__((address_space(3))) v4i16_t*)p)); }
__device__ __forceinline__ float rowmax(const f32x16& p0, const f32x16& p1) {
    float a = max3f(p0[0], p0[1], p1[0]), b = max3f(p0[2], p0[3], p1[1]); a = max3f(a, p1[2], p1[3]);
#pragma unroll
    for (int r = 4; r < 16; r += 4) { a = max3f(a, p0[r], p0[r + 1]); b = max3f(b, p0[r + 2], p0[r + 3]); a = max3f(a, p1[r], p1[r + 1]); b = max3f(b, p1[r + 2], p1[r + 3]); }
    const float m = max2f(a, b);
    auto rr = __builtin_amdgcn_permlane32_swap(__float_as_uint(m), __float_as_uint(m), false, false);
    return max2f(__uint_as_float(rr[0]), __uint_as_float(rr[1]));
}
__device__ __forceinline__ void pv(f32x16* o, int vb, bf16x8 pa0, bf16x8 pa1, bf16x8 pa2, bf16x8 pa3) {
#pragma unroll
    for (int d0 = 0; d0 < 2; ++d0) { s16x4 lo[4], hi[4];
#pragma unroll
        for (int ks = 0; ks < 4; ++ks) {
            asm volatile("ds_read_b64_tr_b16 %0,%1 offset:%c2" : "=&v"(lo[ks]) : "v"(vb), "i"(d0 * 4096 + ks * 1024) : "memory");
            asm volatile("ds_read_b64_tr_b16 %0,%1 offset:%c2" : "=&v"(hi[ks]) : "v"(vb), "i"(d0 * 4096 + ks * 1024 + 512) : "memory"); }
        asm volatile("s_waitcnt lgkmcnt(0)" ::: "memory"); SBAR();
#define PK(k) (bf16x8){lo[k][0], lo[k][1], lo[k][2], lo[k][3], hi[k][0], hi[k][1], hi[k][2], hi[k][3]}
        o[d0] = __builtin_amdgcn_mfma_f32_32x32x16_bf16(pa0, PK(0), o[d0], 0, 0, 0);
        o[d0] = __builtin_amdgcn_mfma_f32_32x32x16_bf16(pa1, PK(1), o[d0], 0, 0, 0);
        o[d0] = __builtin_amdgcn_mfma_f32_32x32x16_bf16(pa2, PK(2), o[d0], 0, 0, 0);
        o[d0] = __builtin_amdgcn_mfma_f32_32x32x16_bf16(pa3, PK(3), o[d0], 0, 0, 0);
#undef PK
    }
}
__device__ __forceinline__ void wmask(f32x16& p0, f32x16& p1, int dl, int r32, int hi) {
    const float NEG = -INFINITY;
#pragma unroll
    for (int r = 0; r < 16; ++r) { const int rel = dl + crow(r, hi) - r32; if (rel < -128 || rel > 128) p0[r] = NEG; if (rel + 32 < -128 || rel + 32 > 128) p1[r] = NEG; }
}

template <int THRL> __device__ __forceinline__ void attn_unit(int b, int n, int kvh, int hp, int base, bool primed, bool has_next, int nb, int nn, int nkvh, int nhp, bf16x8 (&qr)[4], int& nbase,
                                                              const bf16_t* Y, bf16_t* O, int ldo, const bf16_t* KB, const bf16_t* VB, const float* sink, LAS unsigned char* shm) {
    const int tid = threadIdx.x, lane = tid & 63, r32 = lane & 31, hi = lane >> 5; const int wid = __builtin_amdgcn_readfirstlane(tid >> 6);
    const int head = kvh * 4 + hp * 2 + (wid >> 2), qsub = wid & 3;
    const long qrow0 = (long)b * SEQ + n * 128 + qsub * 32;
    const bf16_t* Qw = Y + qrow0 * 2048 + 1024 + head * 64;
    const unsigned lds0 = (unsigned)(uintptr_t)shm;
    LAS float* wsf = (LAS float*)(shm + LDS_WS) + wid * 64;
    const long koff = (long)lane * 256 + kvh * 64 + wid * 8;
    const long voff = (long)(16 * (wid & 3) + (lane >> 2)) * 256 + kvh * 64 + (wid >> 2) * 32 + (lane & 3) * 8;
    const unsigned kdst = lds0 + LDS_K + wid * 1024, vdst = lds0 + LDS_V + wid * 1024;
    const int jlo = (n == 0) ? 2 : 0, jhi = (n == 31) ? 3 : 5, NT = 4 + (jhi - jlo + 1);
    const long lrow0 = (long)b * SEQ + (n - 1) * 128 + 64 * (jlo - 4), crow0 = (long)NTOK + b * CTXL;
#define TROW(t) ((t) < 4 ? crow0 + 64 * (t) : lrow0 + 64 * (t))
#define DMA_K(t, slot) glds16(KB + TROW(t) * 256 + koff, (unsigned)__builtin_amdgcn_readfirstlane(kdst + (slot)))
#define DMA_V(t, slot) glds16(VB + TROW(t) * 256 + voff, (unsigned)__builtin_amdgcn_readfirstlane(vdst + (slot)))
    const int vb0 = (int)(lds0 + LDS_V) + ((lane >> 4) & 1) * 32 + (lane & 3) * 8 + (4 * hi + ((lane & 15) >> 2)) * 64;
    bf16x8 kf[8];
    const lds_cptr shm3 = (lds_cptr)shm; const lds_cptr kp0 = shm3 + LDS_K + hi * 1024 + r32 * 16; const lds_cptr vp0 = shm3 + LDS_V + ((lane >> 4) & 1) * 32 + (lane & 3) * 8 + (4 * hi + ((lane & 15) >> 2)) * 64;
    const int s0 = base, s1 = (s0 == (NSLOT - 1) * SLOTB) ? 0 : s0 + SLOTB, s2 = (s1 == (NSLOT - 1) * SLOTB) ? 0 : s1 + SLOTB;
    if (!primed) {
        DMA_K(0, s0); DMA_V(0, s0); DMA_K(1, s1); DMA_K(2, s2);
#pragma unroll
        for (int d0 = 0; d0 < 4; ++d0) qr[d0] = *(const bf16x8*)(Qw + (long)r32 * 2048 + d0 * 16 + hi * 8);
    }
    float mhat = 0.f, l_reg = 0.f; f32x16 o[2]; o[0] = f32x16{}; o[1] = f32x16{}; f32x16 negm = f32x16{}; asm volatile("" : "+v"(negm));
    const int dq = -128 - 32 * qsub;
#define CMASK(P0, P1, t) do { if ((t) >= 4) { const int dl_ = 64 * (jlo + (t) - 4) + dq; if (dl_ < -97 || dl_ > 65) wmask(P0, P1, dl_, r32, hi); } } while (0)
    bool resc = false;
#define START(P0, P1) do { const float rm = rowmax(P0, P1); resc = false; \
    { const float dl = rm; mhat = fadd_s(mhat, dl); \
      _Pragma("unroll") for (int r = 0; r < 16; ++r) { P0[r] = fsub_s(P0[r], dl); P1[r] = fsub_s(P1[r], dl); } \
      _Pragma("unroll") for (int r = 0; r < 16; ++r) negm[r] = -mhat; asm volatile("" : "+v"(negm)); } \
    _Pragma("unroll") for (int r = 0; r < 16; ++r) P0[r] = __builtin_amdgcn_exp2f(P0[r]); } while (0)
#define RESC() do { if (resc) { asm volatile("s_waitcnt lgkmcnt(0)" ::: "memory"); \
      _Pragma("unroll") for (int d_ = 0; d_ < 2; ++d_) _Pragma("unroll") for (int r = 0; r < 16; ++r) o[d_][r] *= wsf[crow(r, hi)]; } } while (0)
    f32x16 pA0, pA1, pB0, pB1;
    int sl_prev = s0, sl_cur = s0, sl_next = s1;
#define ROT() do { sl_prev = sl_cur; sl_cur = sl_next; sl_next = (sl_next == (NSLOT - 1) * SLOTB) ? 0 : sl_next + SLOTB; } while (0)
    WAIT_BAR(7);
    qkt(pA0, pA1, shm3 + LDS_K + s0, qr, negm, r32, hi); asm volatile("s_nop 15\n\ts_nop 7" : "+v"(pA0), "+v"(pA1)); CMASK(pA0, pA1, 0);
    START(pA0, pA1);
    _Pragma("unroll") for (int r = 0; r < 16; ++r) pA1[r] = __builtin_amdgcn_exp2f(pA1[r]);
    WAIT_BAR(0);
    DMA_K(3, s0); DMA_V(1, s1);
    ROT();
    kload8(kf, kp0 + sl_cur);
    WAIT_BAR(2);
    s16x4 vlo[8], vhi[8]; u32x4 pw0, pw1, pw2, pw3;
#define PKW(P, B) cvtpk_s(P[B], P[B + 1])
#define PAF(k) __builtin_bit_cast(bf16x8, pw##k)
#define VFR(i) (bf16x8){vlo[i][0], vlo[i][1], vlo[i][2], vlo[i][3], vhi[i][0], vhi[i][1], vhi[i][2], vhi[i][3]}
#define PIN(x) asm volatile("" : "+v"(x))
#define MX3(a, b, c) __builtin_fmaxf(__builtin_fmaxf((a), (b)), (c))
#define GAPA(MF, A0, A1, A2, A3, W0, W1, PW) do { MF; sacc += A0; sacc += A1; sacc += A2; sacc += A3; PIN(sacc); W0; W1; PIN(PW); SBAR(); } while (0)
#define EX(v) __builtin_amdgcn_exp2f(v)
#define GAPB(MF, X, B) do { MF; X[B] = EX(X[B]); X[B + 1] = EX(X[B + 1]); X[B + 2] = EX(X[B + 2]); X[B + 3] = EX(X[B + 3]); PIN(X); SBAR(); } while (0)
#define VRD(i) do { vlo[i] = vtr(vp_ + (((i) >> 2) * 4096 + ((i) & 3) * 1024)); vhi[i] = vtr(vp_ + (((i) >> 2) * 4096 + ((i) & 3) * 1024 + 512)); } while (0)
#define KRD(G, j) do { if (G) { kload2(kf, kp0 + sl_next, j); SBAR(); } } while (0)
#define STEP(C0, C1, P0, P1, t, GK, GV, GL) do { SBAR(); \
    const lds_cptr vp_ = vp0 + sl_prev; \
    VRD(0); SBAR(); float sacc = (P0[0] + P0[1]); \
    GAPA(C0 = __builtin_amdgcn_mfma_f32_32x32x16_bf16(kf[0], qr[0], negm, 0, 0, 0), P0[2], P0[3], P0[4], P0[5],     pw0[0] = PKW(P0, 0), pw0[1] = PKW(P0, 2), pw0); \
    VRD(4); SBAR(); GAPA(C1 = __builtin_amdgcn_mfma_f32_32x32x16_bf16(kf[1], qr[0], negm, 0, 0, 0), P0[6], P0[7], P0[8], P0[9],     pw0[2] = PKW(P0, 4), pw0[3] = PKW(P0, 6), pw0); \
    VRD(1); SBAR(); GAPA(C0 = __builtin_amdgcn_mfma_f32_32x32x16_bf16(kf[2], qr[1], C0, 0, 0, 0),   P0[10], P0[11], P0[12], P0[13], pw1[0] = PKW(P0, 8), pw1[1] = PKW(P0, 10), pw1); \
    VRD(5); SBAR(); GAPA(C1 = __builtin_amdgcn_mfma_f32_32x32x16_bf16(kf[3], qr[1], C1, 0, 0, 0),   P0[14], P0[15], P1[0], P1[1],   pw1[2] = PKW(P0, 12), pw1[3] = PKW(P0, 14), pw1); \
    VRD(2); SBAR(); GAPA(C0 = __builtin_amdgcn_mfma_f32_32x32x16_bf16(kf[4], qr[2], C0, 0, 0, 0),   P1[2], P1[3], P1[4], P1[5],     pw2[0] = PKW(P1, 0), pw2[1] = PKW(P1, 2), pw2); \
    VRD(6); SBAR(); GAPA(C1 = __builtin_amdgcn_mfma_f32_32x32x16_bf16(kf[5], qr[2], C1, 0, 0, 0),   P1[6], P1[7], P1[8], P1[9],     pw2[2] = PKW(P1, 4), pw2[3] = PKW(P1, 6), pw2); \
    VRD(3); SBAR(); GAPA(C0 = __builtin_amdgcn_mfma_f32_32x32x16_bf16(kf[6], qr[3], C0, 0, 0, 0),   P1[10], P1[11], P1[12], P1[13], pw3[0] = PKW(P1, 8), pw3[1] = PKW(P1, 10), pw3); \
    VRD(7); SBAR(); GAPA(C1 = __builtin_amdgcn_mfma_f32_32x32x16_bf16(kf[7], qr[3], C1, 0, 0, 0),   P1[14], P1[15], 0.f, 0.f,       pw3[2] = PKW(P1, 12), pw3[3] = PKW(P1, 14), pw3); \
    l_reg += sacc; \
    if (GK) { DMA_K((t) + 3, sl_cur); } if (GV) { DMA_V((t) + 1, sl_next); } \
    CMASK(C0, C1, t); \
    { float a = MX3(C0[0], C0[1], C1[0]), b2 = MX3(C0[2], C0[3], C1[1]); a = MX3(a, C1[2], C1[3]); \
      _Pragma("unroll") for (int r = 4; r < 16; r += 4) { a = MX3(a, C0[r], C0[r + 1]); b2 = MX3(b2, C0[r + 2], C0[r + 3]); a = MX3(a, C1[r], C1[r + 1]); b2 = MX3(b2, C1[r + 2], C1[r + 3]); } \
      float rm = __builtin_fmaxf(a, b2); { auto rr = __builtin_amdgcn_permlane32_swap(__float_as_uint(rm), __float_as_uint(rm), false, false); rm = __builtin_fmaxf(__uint_as_float(rr[0]), __uint_as_float(rr[1])); } \
      resc = false; \
      if (__builtin_expect(__any(rm > (float)THRL), 0)) { const float dl = __builtin_fmaxf(rm, 0.f); mhat += dl; \
        _Pragma("unroll") for (int r = 0; r < 16; ++r) { C0[r] -= dl; C1[r] -= dl; } \
        _Pragma("unroll") for (int r = 0; r < 16; ++r) negm[r] = -mhat; asm volatile("" : "+v"(negm)); \
        const float f = __builtin_amdgcn_exp2f(-dl); l_reg *= f; if (hi == 0) wsf[r32] = f; resc = true; } } \
    SBAR(); \
    GAPB(o[0] = __builtin_amdgcn_mfma_f32_32x32x16_bf16(PAF(0), VFR(0), o[0], 0, 0, 0), C0, 0); \
    GAPB(o[1] = __builtin_amdgcn_mfma_f32_32x32x16_bf16(PAF(0), VFR(4), o[1], 0, 0, 0), C0, 4); \
    KRD(GL, 0); GAPB(o[0] = __builtin_amdgcn_mfma_f32_32x32x16_bf16(PAF(1), VFR(1), o[0], 0, 0, 0), C0, 8); \
    KRD(GL, 1); GAPB(o[1] = __builtin_amdgcn_mfma_f32_32x32x16_bf16(PAF(1), VFR(5), o[1], 0, 0, 0), C0, 12); \
    KRD(GL, 2); GAPB(o[0] = __builtin_amdgcn_mfma_f32_32x32x16_bf16(PAF(2), VFR(2), o[0], 0, 0, 0), C1, 0); \
    KRD(GL, 3); GAPB(o[1] = __builtin_amdgcn_mfma_f32_32x32x16_bf16(PAF(2), VFR(6), o[1], 0, 0, 0), C1, 4); \
    GAPB(o[0] = __builtin_amdgcn_mfma_f32_32x32x16_bf16(PAF(3), VFR(3), o[0], 0, 0, 0), C1, 8); \
    GAPB(o[1] = __builtin_amdgcn_mfma_f32_32x32x16_bf16(PAF(3), VFR(7), o[1], 0, 0, 0), C1, 12); \
    } while (0)
#define ENDW(tt) do { if ((tt) + 3 < NT) { WAIT_BAR(2); } else if ((tt) + 2 < NT) { WAIT_BAR(1); } else { WAIT_BAR(0); } } while (0)
    int t = 1;
    for (; t + 1 < NT; t += 2) {
        STEP(pB0, pB1, pA0, pA1, t, (t + 3 < NT), (t + 1 < NT), (t + 1 < NT));       ENDW(t);     RESC(); ROT();
        STEP(pA0, pA1, pB0, pB1, t + 1, (t + 4 < NT), (t + 2 < NT), (t + 2 < NT));   ENDW(t + 1); RESC(); ROT();
    }
    nbase = sl_next;
    if (has_next) {
        const long nr = (long)NTOK + nb * CTXL; const long nko = (long)lane * 256 + nkvh * 64 + wid * 8, nvo = (long)(16 * (wid & 3) + (lane >> 2)) * 256 + nkvh * 64 + (wid >> 2) * 32 + (lane & 3) * 8;
        const int n0 = sl_next, n1 = (n0 == (NSLOT - 1) * SLOTB) ? 0 : n0 + SLOTB, n2 = (n1 == (NSLOT - 1) * SLOTB) ? 0 : n1 + SLOTB;
        glds16(KB + nr * 256 + nko, (unsigned)__builtin_amdgcn_readfirstlane(kdst + n0)); glds16(VB + nr * 256 + nvo, (unsigned)__builtin_amdgcn_readfirstlane(vdst + n0));
        glds16(KB + (nr + 64) * 256 + nko, (unsigned)__builtin_amdgcn_readfirstlane(kdst + n1)); glds16(KB + (nr + 128) * 256 + nko, (unsigned)__builtin_amdgcn_readfirstlane(kdst + n2));
    }
    STEP(pB0, pB1, pA0, pA1, NT - 1, false, false, false); RESC();
    { float sacc = pB0[0] + pB0[1]; _Pragma("unroll") for (int r = 2; r < 16; ++r) sacc += pB0[r]; _Pragma("unroll") for (int r = 0; r < 16; ++r) sacc += pB1[r]; l_reg += sacc;
      pw0 = (u32x4){PKW(pB0, 0), PKW(pB0, 2), PKW(pB0, 4), PKW(pB0, 6)}; pw1 = (u32x4){PKW(pB0, 8), PKW(pB0, 10), PKW(pB0, 12), PKW(pB0, 14)}; pw2 = (u32x4){PKW(pB1, 0), PKW(pB1, 2), PKW(pB1, 4), PKW(pB1, 6)}; pw3 = (u32x4){PKW(pB1, 8), PKW(pB1, 10), PKW(pB1, 12), PKW(pB1, 14)};
      SBAR(); pv(o, vb0 + sl_cur, PAF(0), PAF(1), PAF(2), PAF(3)); }
    if (has_next) {
        asm volatile("" ::: "memory");
        const bf16_t* nQw = Y + ((long)nb * SEQ + nn * 128 + qsub * 32) * 2048 + 1024 + (nkvh * 4 + nhp * 2 + (wid >> 2)) * 64;
#pragma unroll
        for (int d0 = 0; d0 < 4; ++d0) qr[d0] = *(const bf16x8*)(nQw + (long)r32 * 2048 + d0 * 16 + hi * 8);
    }
    { auto rr = __builtin_amdgcn_permlane32_swap(__float_as_uint(l_reg), __float_as_uint(l_reg), false, false); l_reg = __uint_as_float(rr[0]) + __uint_as_float(rr[1]); }
    l_reg += __builtin_amdgcn_exp2f(fminf(sink[head] * LOG2E - mhat, 80.f));
    if (hi == 0) wsf[32 + r32] = l_reg; asm volatile("s_waitcnt lgkmcnt(0)" ::: "memory");
    float rli[16];
#pragma unroll
    for (int r = 0; r < 16; ++r) rli[r] = __builtin_amdgcn_rcpf(wsf[32 + crow(r, hi)]);
    bf16_t* Ow = O + qrow0 * ldo + head * 64;
    { LAS bf16_t* stg = (LAS bf16_t*)(shm + LDS_OST) + wid * 2048;
#pragma unroll
      for (int r = 0; r < 16; ++r) { const int orow = crow(r, hi);
#pragma unroll
          for (int d0 = 0; d0 < 2; ++d0) stg[orow * 64 + d0 * 32 + r32] = (bf16_t)(pk2(o[d0][r] * rli[r], 0.f) & 0xffffu); }
      asm volatile("s_waitcnt lgkmcnt(0)" ::: "memory");
#pragma unroll
      for (int i = 0; i < 4; ++i) { const int row = i * 8 + (lane >> 3), ch = lane & 7; const u32x4 v = *(const LAS u32x4*)(stg + row * 64 + ch * 8); *(u32x4*)(Ow + (long)row * ldo + ch * 8) = v; } }
    asm volatile("s_waitcnt lgkmcnt(0)\n\ts_barrier" ::: "memory");
#undef TROW
#undef DMA_K
#undef DMA_V
#undef CMASK
#undef START
#undef RESC
#undef ROT
#undef PKW
#undef PAF
#undef VFR
#undef PIN
#undef MX3
#undef GAPA
#undef GAPB
#undef EX
#undef VRD
#undef KRD
#undef STEP
#undef ENDW
}
#undef SBAR
#undef WAIT_BAR
}

#define XB_TMO      128
#define XB_XCNT(j)  (256  + 64 * (j))
#define XB_XSUB(j)  (1280 + 64 * (j))
#define XB_XGEN(j)  (2304 + 64 * (j))
#define XB_TOP      3328
#define XB_TOPGEN   3392
#define XCD_BAR_WORDS 3456
#define XB_SPIN_CAP (1u << 18)
__device__ __forceinline__ unsigned xb_ld(unsigned* p)              { return __hip_atomic_load(p, __ATOMIC_RELAXED, __HIP_MEMORY_SCOPE_AGENT); }
__device__ __forceinline__ unsigned xb_add(unsigned* p, unsigned v) { return __hip_atomic_fetch_add(p, v, __ATOMIC_RELAXED, __HIP_MEMORY_SCOPE_AGENT); }
__device__ __forceinline__ unsigned xb_xcc_id() { return (unsigned)__builtin_amdgcn_s_getreg((3 << 11) | 20) & 0xFu; }
#define XB_SPIN(cond, bar) do { unsigned _sp = 0; while (cond) { __builtin_amdgcn_s_sleep(1); \
    if ((++_sp & 255u) == 0u) { if (xb_ld(&(bar)[XB_TMO])) break; if (_sp > XB_SPIN_CAP) { atomicAdd(&(bar)[XB_TMO], 1u); break; } } } } while (0)
struct XcdBarrier { unsigned* bar; unsigned x; volatile LAS unsigned* st; };
__device__ __forceinline__ XcdBarrier xcd_barrier_post(unsigned* bar, volatile LAS unsigned* st) {
    XcdBarrier b; b.bar = bar; b.x = xb_xcc_id(); b.st = st;
    if (threadIdx.x == 0) (void)xb_add(&bar[XB_XCNT(b.x)], 1u);
    return b;
}
__device__ __forceinline__ void xcd_barrier_complete(unsigned* bar, unsigned x, unsigned& nloc, unsigned& nx) {
    const unsigned G = gridDim.x * gridDim.y * gridDim.z;
    unsigned sum, cnt, mine, sp = 0u;
    for (;;) {
        sum = 0u; cnt = 0u; mine = 0u;
#pragma unroll
        for (unsigned j = 0; j < 16; ++j) { const unsigned c = xb_ld(&bar[XB_XCNT(j)]); sum += c; cnt += (c > 0u) ? 1u : 0u; mine = (j == x) ? c : mine; }
        if (sum == G) break;
        __builtin_amdgcn_s_sleep(1);
        if ((++sp & 255u) == 0u) { if (xb_ld(&bar[XB_TMO])) break; if (sp > XB_SPIN_CAP) { atomicAdd(&bar[XB_TMO], 1u); break; } }
    }
    nloc = mine > 0u ? mine : 1u; nx = cnt > 0u ? cnt : 1u;
}
__device__ __forceinline__ void xcd_barrier(const XcdBarrier& b) {
    asm volatile("s_waitcnt vmcnt(0)" ::: "memory");
    __syncthreads();
    if (threadIdx.x == 0) {
        unsigned* bar = b.bar;
        __builtin_amdgcn_s_waitcnt(0);
        unsigned nloc = b.st[0], nx = b.st[1];
        if (nloc == 0u) { xcd_barrier_complete(bar, b.x, nloc, nx); b.st[0] = nloc; b.st[1] = nx; }
        const unsigned old = xb_add(&bar[XB_XSUB(b.x)], 1u);
        const unsigned gen = old / nloc;
        if (old + 1u == (gen + 1u) * nloc) {
            __builtin_amdgcn_fence(__ATOMIC_RELEASE, "agent");
            asm volatile("s_waitcnt vmcnt(0)" ::: "memory");
            const unsigned og = xb_add(&bar[XB_TOP], 1u);
            const unsigned tg = og / nx;
            if (og + 1u == (tg + 1u) * nx) xb_add(&bar[XB_TOPGEN], 1u);
            else XB_SPIN(xb_ld(&bar[XB_TOPGEN]) == tg, bar);
            __builtin_amdgcn_fence(__ATOMIC_ACQUIRE, "agent");
            xb_add(&bar[XB_XGEN(b.x)], 1u);
            asm volatile("s_waitcnt vmcnt(0)" ::: "memory");
        } else {
            XB_SPIN(xb_ld(&bar[XB_XGEN(b.x)]) == gen, bar);
            __builtin_amdgcn_fence(__ATOMIC_ACQUIRE, "agent");
            asm volatile("s_waitcnt vmcnt(0)" ::: "memory");
        }
    }
    __syncthreads();
}
constexpr int LDSCTL_OFF = LDS_BYTES - 256;
constexpr int CW_BAR = 4096;

#ifndef PROBE_GMLP2
#define PROBE_GMLP2 0
#endif
#ifndef ATT_PIPE
#define ATT_PIPE 1
#endif
#ifndef ATT_THRL
#define ATT_THRL 8
#endif
#ifndef ONE_LAUNCH
#define ONE_LAUNCH 1
#endif
#ifndef FAST_MIX
#define FAST_MIX 1
#endif
#ifndef PROBE_SEQ
#define PROBE_SEQ 0, 1, 2, 3, 4, 5, 6, 7, 8, 9, 10, 11
#endif

enum { PH_PRO = 0, PH_HN, PH_IN, PH_MIX, PH_A, PH_O, PH_H2R, PH_WCONV, PH_TOPK, PH_GU, PH_D, PH_FIN, PH_COUNT };

__global__ void __launch_bounds__(NTHREADS, 2) fwd(Args args) {
    extern __shared__ __attribute__((aligned(16))) unsigned char lds_raw[];
    LAS unsigned char* lds = (LAS unsigned char*)lds_raw;
    const int tid = threadIdx.x, lane = tid & 63, wave = __builtin_amdgcn_readfirstlane(tid >> 6);
    const int G = gridDim.x, bid = blockIdx.x;
    unsigned char* ws = args.ws;
    const int lo = args.ph_lo, hi = args.ph_hi;
#define IN(k) (lo <= (k) && (k) < hi)
    float* MOD = (float*)(ws + WS_MOD); f32x2* ROPE = (f32x2*)(ws + WS_ROPE);
    float* AFFT = (float*)(ws + WS_AFFT); int* TOPI = (int*)(ws + WS_TOPI); float* TOPW = (float*)(ws + WS_TOPW); int* SLOT = (int*)(ws + WS_SLOT);
    bf16_t* WSP = (bf16_t*)(ws + WS_WSP); bf16_t* WIN = (bf16_t*)(ws + WS_WIN); bf16_t* WAB = (bf16_t*)(ws + WS_WAB); bf16_t* WO = (bf16_t*)(ws + WS_WO);
    bf16_t* H = (bf16_t*)(ws + WS_H); bf16_t* VA = (bf16_t*)(ws + WS_VA); bf16_t* KB = (bf16_t*)(ws + WS_KB); bf16_t* VB = (bf16_t*)(ws + WS_VB);
    bf16_t* GT = (bf16_t*)(ws + WS_G); bf16_t* Y = (bf16_t*)(ws + WS_Y); bf16_t* TMP = (bf16_t*)(ws + WS_TMP); bf16_t* MERGED = (bf16_t*)(ws + WS_MERGED);
    bf16_t* WGU = (bf16_t*)(ws + WS_WGU); bf16_t* WD = (bf16_t*)(ws + WS_WD); bf16_t* H2 = (bf16_t*)(ws + WS_H2); bf16_t* ACT = (bf16_t*)(ws + WS_ACT); bf16_t* YB = (bf16_t*)(ws + WS_YB);
    const int gw = bid * NWAVES + wave, NGW = G * NWAVES;
    if (tid < 64) ((LAS unsigned*)(lds + LDSCTL_OFF))[tid] = 0u;
    __syncthreads();
    XcdBarrier bar; bar.bar = (unsigned*)(ws + WS_CTL) + CW_BAR; bar.x = 0; bar.st = nullptr;
    if (ONE_LAUNCH) bar = xcd_barrier_post((unsigned*)(ws + WS_CTL) + CW_BAR, (volatile LAS unsigned*)(lds + LDSCTL_OFF));
#define SEAM(k) do { if (ONE_LAUNCH && IN(k) && IN((k) + 1)) xcd_barrier(bar); } while (0)

    if (IN(PH_PRO)) {
        if (bid < 192) adaln_task(bid, args.in[I_C], args.in[I_CCTX], args.in[I_WADA], args.in[I_BADA], MOD, (LAS float*)lds, tid);
        else if (bid == 192) rope_table(ROPE, tid);
        __syncthreads();
        for (int i = bid * NTHREADS + tid; i < 8 * 128 * 128 / 4; i += G * NTHREADS) st4bf(WSP + 4 * i, *(const f32x4*)(args.in[I_WSP] + 4 * i));
        LAS float* scr = (LAS float*)(lds + wave * 16384);
        constexpr int I_IN = 16 * 176, I_P = 16 * 32;
        for (int it = gw; it < I_IN + 3 * I_P; it += NGW) {
            int r = it;
            if (r < I_IN) { const int kb = r / 176, nb = r % 176; transpose_item(args.in[I_WIN], INCOLS, kb * 64, nb * 32, WIN + (size_t)(nb * 32) * 1024 + kb * 64, 1024, scr, lane); continue; } r -= I_IN;
            if (r < I_P) { const int kb = r / 32, nb = r % 32; transpose_item(args.in[I_WPA], 1024, kb * 64, nb * 32, WAB + (size_t)(nb * 32) * 2048 + kb * 64, 2048, scr, lane); continue; } r -= I_P;
            if (r < I_P) { const int kb = r / 32, nb = r % 32; transpose_item(args.in[I_WPB], 1024, kb * 64, nb * 32, WAB + (size_t)(nb * 32) * 2048 + 1024 + kb * 64, 2048, scr, lane); continue; } r -= I_P;
            { const int kb = r / 32, nb = r % 32; transpose_item(args.in[I_WOUT], 1024, kb * 64, nb * 32, WO + (size_t)(nb * 32) * 1024 + kb * 64, 1024, scr, lane); }
        }
    }
    SEAM(PH_PRO);
    if (IN(PH_HN)) {
        const float* g1n = args.in[I_N1G];
        auto hn_row = [&](int row) {
            const float* xr; int mrow;
            if (row < NTOK) { xr = args.in[I_X] + (size_t)row * 1024; mrow = row >> 12; } else { xr = args.in[I_CTX] + (size_t)(row - NTOK) * 1024; mrow = 8; }
            const float* sh = MOD + mrow * 6144; const float* sc = sh + 1024;
            f32x4 v[4]; float ss = 0.f;
#pragma unroll
            for (int j = 0; j < 4; ++j) { v[j] = *(const f32x4*)(xr + 4 * lane + 256 * j); ss += (v[j].x * v[j].x + v[j].y * v[j].y) + (v[j].z * v[j].z + v[j].w * v[j].w); }
            const float rstd = 1.0f / sqrtf(wave_sum(ss) * (1.f / 1024.f) + EPS);
#pragma unroll
            for (int j = 0; j < 4; ++j) {
                const int col = 4 * lane + 256 * j;
                const f32x4 gv = *(const f32x4*)(g1n + col), scv = *(const f32x4*)(sc + col), shv = *(const f32x4*)(sh + col);
                const f32x4 h = (v[j] * rstd * gv) * (1.f + scv) + shv;
                st4bf(H + (size_t)row * 1024 + col, h);
            }
        };
        for (int row = gw; row < NROWS_H; row += NGW) hn_row(row);
    }
    SEAM(PH_HN);
    if (IN(PH_IN)) {
        Gemm g{H, WIN, 1024, 1024, 1024, 0, 30, nullptr}; StaticOrder S; S.init(NTOK, INCOLS, G, bid, 16);
        EpiIn E{Y, VA, KB, VB, GT, args.in[I_BMG], ROPE, (f32x2*)(ws + WS_STATS)};
        GEMM_PHASE<EpiIn, StaticOrder, false>(lds, g, S, E);
    }
    SEAM(PH_IN);
    if (IN(PH_MIX) && FAST_MIX) {
        if (!(args.flags & 8)) for (int task = bid; task < NB * 32; task += G) mix::gmlp_unit(task, Y, (args.flags & 2) ? TMP : Y, (args.flags & 2) ? 1024 : 2048, VA, WSP, (const f32x2*)(ws + WS_STATS), args.in[I_LNG], args.in[I_LNB], args.in[I_BSP], lds);
#if ATT_PIPE
        att2::bf16x8 att_qr[4]; int att_base = 0; bool att_primed = false;
#endif
        if (!(args.flags & 1)) for (int task = bid; task < NB * 32 * 4; task += G) {
#if ATT_PIPE
            for (int hp = 0; hp < 2; ++hp) {
                const bool more = (hp == 0) || (task + G < NB * 32 * 4); const int ntask = hp == 0 ? task : task + G; int nbase_ = 0;
                att2::attn_unit<ATT_THRL>(task >> 7, (task >> 2) & 31, task & 3, hp, att_base, att_primed, more, ntask >> 7, (ntask >> 2) & 31, ntask & 3, hp ^ 1, att_qr, nbase_,
                                          Y, (args.flags & 4) ? TMP : Y + 1024, (args.flags & 4) ? 1024 : 2048, KB, VB, args.in[I_SINK], lds);
                att_base = nbase_; att_primed = more;
            }
#else
            mix::attn_unit(task >> 7, (task >> 2) & 31, task & 3, Y, (args.flags & 4) ? TMP : Y + 1024, (args.flags & 4) ? 1024 : 2048, KB, VB, args.in[I_SINK], lds);
#endif
        }
    }
    SEAM(PH_MIX);
    if (IN(PH_A)) {
        Gemm g{Y, WAB, 2048, 2048, 2048, 0, 30, nullptr}; StaticOrder S; S.init(NTOK, 1024, G, bid, 0, 1);
        EpiAB E{MERGED, GT};
        GEMM_PHASE<EpiAB, StaticOrder, false, true>(lds, g, S, E);
    }
    SEAM(PH_A);
    if (IN(PH_O)) {
        Gemm g{MERGED, WO, 1024, 1024, 1024, 0, 30, nullptr}; StaticOrder S; S.init(NTOK, 1024, G, bid);
        EpiO E{(bf16_t*)args.out, MOD};
        GEMM_PHASE<EpiO, StaticOrder, false>(lds, g, S, E);
    }
    SEAM(PH_O);
    if (IN(PH_H2R)) {
        LAS float* wT = (LAS float*)lds;
        { f32x4 wv[8];
#pragma unroll
          for (int k = 0; k < 8; ++k) wv[k] = *(const f32x4*)(args.in[I_WR] + 4 * (tid + NTHREADS * k));
#pragma unroll
          for (int k = 0; k < 8; ++k) { const int f = tid + NTHREADS * k, col = f >> 2, e0 = 4 * (f & 3); wT[e0 * 1024 + col] = wv[k].x; wT[(e0 + 1) * 1024 + col] = wv[k].y; wT[(e0 + 2) * 1024 + col] = wv[k].z; wT[(e0 + 3) * 1024 + col] = wv[k].w; } }
        __syncthreads();
        const float* g2n = args.in[I_N2G];
        const bool h32 = lane & 32, h16 = lane & 16, h8 = lane & 8, h4 = lane & 4;
        const int myexp = 8 * (lane >> 5) + 4 * ((lane >> 4) & 1) + 2 * ((lane >> 3) & 1) + ((lane >> 2) & 1);
        const bf16_t* D16 = (const bf16_t*)args.out;
        f32x4 vn[2][4]; u32x2 dn[2][4];
#pragma unroll
        for (int q = 0; q < 2; ++q)
#pragma unroll
            for (int j = 0; j < 4; ++j) { const size_t r_ = (size_t)(2 * (NTOK / 2 - 1 - (gw < NTOK / 2 ? gw : 0)) + q); vn[q][j] = *(const f32x4*)(args.in[I_X] + r_ * 1024 + 4 * lane + 256 * j); dn[q][j] = *(const u32x2*)(D16 + r_ * 2048 + 1024 + 4 * lane + 256 * j); }
        for (int rp = gw; rp < NTOK / 2; rp += NGW) {
            const int row0 = 2 * (NTOK / 2 - 1 - rp), b = row0 >> 12;
            const float* sh = MOD + b * 6144 + 3072; const float* sc = sh + 1024;
            f32x4 v[2][4]; float ss[2] = {0.f, 0.f};
#pragma unroll
            for (int q = 0; q < 2; ++q)
#pragma unroll
                for (int j = 0; j < 4; ++j) { const u32x2 dw = dn[q][j]; v[q][j] = vn[q][j] + (f32x4){bf2f(dw.x & 0xffffu), bf2f(dw.x >> 16), bf2f(dw.y & 0xffffu), bf2f(dw.y >> 16)}; ss[q] += (v[q][j].x * v[q][j].x + v[q][j].y * v[q][j].y) + (v[q][j].z * v[q][j].z + v[q][j].w * v[q][j].w); }
            { const int rn = (rp + NGW < NTOK / 2) ? rp + NGW : rp;
#pragma unroll
              for (int q = 0; q < 2; ++q)
#pragma unroll
                  for (int j = 0; j < 4; ++j) { const size_t r_ = (size_t)(2 * (NTOK / 2 - 1 - rn) + q); vn[q][j] = *(const f32x4*)(args.in[I_X] + r_ * 1024 + 4 * lane + 256 * j); dn[q][j] = *(const u32x2*)(D16 + r_ * 2048 + 1024 + 4 * lane + 256 * j); } }
            float rstd[2];
#pragma unroll
            for (int q = 0; q < 2; ++q) rstd[q] = 1.0f / sqrtf(wave_sum(ss[q]) * (1.f / 1024.f) + EPS);
            float lg[2][16];
#pragma unroll
            for (int q = 0; q < 2; ++q)
#pragma unroll
                for (int e = 0; e < 16; ++e) lg[q][e] = 0.f;
            f32x4 wb[2][4];
#pragma unroll
            for (int e = 0; e < 4; ++e) wb[0][e] = *(const LAS f32x4*)(wT + e * 1024 + 4 * lane);
            f32x4 h[2];
#pragma unroll
            for (int g = 0; g < 16; ++g) {
                const int j = g >> 2, eg = g & 3, col = 4 * lane + 256 * j;
                if (g + 1 < 16) {
                    const int jn = (g + 1) >> 2, en = (g + 1) & 3;
#pragma unroll
                    for (int e = 0; e < 4; ++e) wb[(g + 1) & 1][e] = *(const LAS f32x4*)(wT + (4 * en + e) * 1024 + 4 * lane + 256 * jn);
                }
                if (eg == 0) {
                    const f32x4 gv = *(const f32x4*)(g2n + col), scv = *(const f32x4*)(sc + col), shv = *(const f32x4*)(sh + col);
#pragma unroll
                    for (int q = 0; q < 2; ++q) { h[q] = (v[q][j] * rstd[q] * gv) * (1.f + scv) + shv; st4bf(H2 + (size_t)(row0 + q) * 1024 + col, h[q]); }
                }
#pragma unroll
                for (int e = 0; e < 4; ++e) {
                    const f32x4 w = wb[g & 1][e];
#pragma unroll
                    for (int q = 0; q < 2; ++q) lg[q][4 * eg + e] += (h[q].x * w.x + h[q].y * w.y) + (h[q].z * w.z + h[q].w * w.w);
                    asm volatile("" : "+v"(lg[0][4 * eg + e]), "+v"(lg[1][4 * eg + e]));
                }
                asm volatile("" ::: "memory");
            }
#pragma unroll
            for (int q = 0; q < 2; ++q) {
                float a8[8], a4[4], a2[2], a1;
#pragma unroll
                for (int i = 0; i < 8; ++i) { const float send = h32 ? lg[q][i] : lg[q][i + 8], keep = h32 ? lg[q][i + 8] : lg[q][i]; a8[i] = keep + __shfl_xor(send, 32); }
#pragma unroll
                for (int i = 0; i < 4; ++i) { const float send = h16 ? a8[i] : a8[i + 4], keep = h16 ? a8[i + 4] : a8[i]; a4[i] = keep + __shfl_xor(send, 16); }
#pragma unroll
                for (int i = 0; i < 2; ++i) { const float send = h8 ? a4[i] : a4[i + 2], keep = h8 ? a4[i + 2] : a4[i]; a2[i] = keep + __shfl_xor(send, 8); }
                { const float send = h4 ? a2[0] : a2[1], keep = h4 ? a2[1] : a2[0]; a1 = keep + __shfl_xor(send, 4); }
                a1 += __shfl_xor(a1, 2); a1 += __shfl_xor(a1, 1);
                float mx = a1;
#pragma unroll
                for (int o = 4; o < 64; o <<= 1) mx = fmaxf(mx, __shfl_xor(mx, o));
                const float p = __expf(a1 - mx); float den = p;
#pragma unroll
                for (int o = 4; o < 64; o <<= 1) den += __shfl_xor(den, o);
                if ((lane & 3) == 0) AFFT[(size_t)(b * 16 + myexp) * SEQ + ((row0 + q) & (SEQ - 1))] = p / den;
            }
        }
    }
    if (IN(PH_WCONV)) {
        __syncthreads();
        LAS float* scr = (LAS float*)(lds + wave * 16384);
        constexpr int I_G = 16 * 16 * 64, I_D = 16 * 32 * 32;
        auto item = [&](int it) -> TrItem {
            int r = it; TrItem t;
            if (r < 2 * I_G) {
                const int up = r >= I_G; if (up) r -= I_G;
                const int e = r >> 10, kb = (r >> 6) & 15, nb = r & 63, n0 = nb * 32;
                const int drow = 256 * (n0 >> 7) + (n0 & 127) + (up ? 128 : 0);
                t.src = args.in[up ? I_WEU : I_WEG] + (size_t)e * 1024 * 2048 + (size_t)(kb * 64) * 2048 + n0; t.N = 2048;
                t.dst = WGU + (size_t)e * 4096 * 1024 + (size_t)drow * 1024 + kb * 64; t.ldt = 1024;
            } else {
                r -= 2 * I_G;
                const int e = r >> 10, kb = (r >> 5) & 31, nb = r & 31;
                t.src = args.in[I_WED] + (size_t)e * 2048 * 1024 + (size_t)(kb * 64) * 1024 + nb * 32; t.N = 1024;
                t.dst = WD + (size_t)e * 1024 * 2048 + (size_t)(nb * 32) * 2048 + kb * 64; t.ldt = 2048;
            }
            return t;
        };
        constexpr int NIT = 2 * I_G + I_D;
        if (gw < NIT) {
            TrItem cur = item(gw); f32x4 vc[8], vn[8];
            tr_load(cur, vc, lane);
            for (int it = gw; it < NIT; it += NGW) {
                const bool more = it + NGW < NIT;
                TrItem nxt = cur;
                if (more) { nxt = item(it + NGW); tr_load(nxt, vn, lane); }
                tr_store(cur, vc, scr, lane);
                cur = nxt;
#pragma unroll
                for (int i = 0; i < 8; ++i) vc[i] = vn[i];
            }
        }
    }
    SEAM(PH_WCONV);
    if (IN(PH_TOPK)) {
        LAS int* wsum = (LAS int*)lds;
        for (int task = bid; task < NE * NB; task += G) {
            const int e = task >> 3, b = task & 7;
            const float* aff = AFFT + (size_t)(b * 16 + e) * SEQ;
            unsigned k[8];
            { const u32x4 a0 = *(const u32x4*)(aff + 8 * tid), a1 = *(const u32x4*)(aff + 8 * tid + 4); k[0] = a0.x; k[1] = a0.y; k[2] = a0.z; k[3] = a0.w; k[4] = a1.x; k[5] = a1.y; k[6] = a1.z; k[7] = a1.w; }
            unsigned T = 0u; int it = 0;
            __syncthreads();
            for (int bit = 30; bit >= 0; --bit, ++it) {
                const unsigned cand = T | (1u << bit); int c = 0;
#pragma unroll
                for (int j = 0; j < 8; ++j) c += __builtin_popcountll(__ballot(k[j] >= cand));
                if (lane == 0) wsum[(it & 1) * 8 + wave] = c;
                __syncthreads();
                int tot = 0;
#pragma unroll
                for (int w = 0; w < 8; ++w) tot += wsum[(it & 1) * 8 + w];
                if (tot >= CAP) T = cand;
            }
            int cg = 0, ce = 0;
#pragma unroll
            for (int j = 0; j < 8; ++j) { cg += (k[j] > T) ? 1 : 0; ce += (k[j] == T) ? 1 : 0; }
            LAS int* sc1 = wsum + 16; LAS int* sc2 = wsum + 32;
            int ie = ce, ig = cg;
#pragma unroll
            for (int o = 1; o < 64; o <<= 1) { const int te = __shfl_up(ie, o), tg = __shfl_up(ig, o); if (lane >= o) { ie += te; ig += tg; } }
            __syncthreads();
            if (lane == 63) { sc1[wave] = ie; sc2[wave] = ig; }
            __syncthreads();
            int ebase = ie - ce, totg = 0;
#pragma unroll
            for (int w = 0; w < 8; ++w) { if (w < wave) ebase += sc1[w]; totg += sc2[w]; }
            const int need = CAP - totg;
            int sel[8], cs = 0, er = ebase;
#pragma unroll
            for (int j = 0; j < 8; ++j) { const bool eq = (k[j] == T); sel[j] = (k[j] > T) || (eq && er < need); er += eq ? 1 : 0; cs += sel[j]; }
            int is = cs;
#pragma unroll
            for (int o = 1; o < 64; o <<= 1) { const int ts = __shfl_up(is, o); if (lane >= o) is += ts; }
            __syncthreads();
            if (lane == 63) sc1[wave] = is;
            __syncthreads();
            int sbase = is - cs;
#pragma unroll
            for (int w = 0; w < 8; ++w) if (w < wave) sbase += sc1[w];
#pragma unroll
            for (int j = 0; j < 8; ++j) {
                const int t = 8 * tid + j; int slot = -1;
                if (sel[j]) { slot = sbase; ++sbase; const int prow = (e * 8 + b) * CAP + slot; TOPI[prow] = t; TOPW[prow] = __uint_as_float(k[j]); }
                SLOT[((size_t)b * SEQ + t) * 16 + e] = slot;
            }
            __syncthreads();
        }
    }
    SEAM(PH_TOPK);
    if (IN(PH_GU)) {
        Gemm g{H2, WGU, 1024, 1024, 1024, (size_t)4096 * 1024, 4, TOPI}; StaticOrder S; S.init(NPAIR, 4096, G, bid);
        EpiGU E{ACT};
        GEMM_PHASE<EpiGU, StaticOrder, true>(lds, g, S, E);
    }
    SEAM(PH_GU);
    if (IN(PH_D)) {
        Gemm g{ACT, WD, 2048, 2048, 2048, (size_t)1024 * 2048, 4, nullptr}; StaticOrder S; S.init(NPAIR, 1024, G, bid, 0, 1);
        EpiD E{YB, TOPW};
        GEMM_PHASE<EpiD, StaticOrder, false>(lds, g, S, E);
    }
    SEAM(PH_D);
    if (IN(PH_FIN)) {
        const float* fg = args.in[I_FING];
        const bf16_t* ZROW = (const bf16_t*)(ws + WS_CTL + 512 * 1024);
        int sln[2] = {-1, -1};
        if (gw < NTOK / 2 && lane < 16) { sln[0] = SLOT[(size_t)(2 * gw) * 16 + lane]; sln[1] = SLOT[(size_t)(2 * gw + 1) * 16 + lane]; }
        for (int rp = gw; rp < NTOK / 2; rp += NGW) {
            const int row0 = 2 * rp, b = row0 >> 12;
            const int sl[2] = {sln[0], sln[1]};
            { const int rn = rp + NGW; if (rn < NTOK / 2 && lane < 16) { sln[0] = SLOT[(size_t)(2 * rn) * 16 + lane]; sln[1] = SLOT[(size_t)(2 * rn + 1) * 16 + lane]; } }
            const float* g2 = MOD + b * 6144 + 5120;
            f32x4 xv[2][4], acc[2][4];
#pragma unroll
            for (int q = 0; q < 2; ++q)
#pragma unroll
                for (int h = 0; h < 2; ++h) { const float* xp = args.in[I_X] + (size_t)(row0 + q) * 1024 + 512 * h + 8 * lane; f32x4 d0_, d1_; ld8bf((const bf16_t*)args.out + (size_t)(row0 + q) * 2048 + 1024 + 512 * h + 8 * lane, d0_, d1_);
                    xv[q][2 * h] = *(const f32x4*)xp + d0_; xv[q][2 * h + 1] = *(const f32x4*)(xp + 4) + d1_;
                    acc[q][2 * h] = (f32x4){0.f, 0.f, 0.f, 0.f}; acc[q][2 * h + 1] = (f32x4){0.f, 0.f, 0.f, 0.f}; }
#pragma unroll
            for (int q = 0; q < 2; ++q) {
                unsigned long long mask = __ballot(sl[q] >= 0);
                for (;;) {
                    const bf16_t* yr[4];
#pragma unroll
                    for (int k = 0; k < 4; ++k) {
                        if (mask) { const int ex = __builtin_ctzll(mask); mask &= mask - 1; const int s = __builtin_amdgcn_readlane(sl[q], ex); yr[k] = YB + (size_t)((ex * 8 + b) * CAP + s) * 1024; }
                        else yr[k] = ZROW;
                    }
                    u32x4 y[4][2];
#pragma unroll
                    for (int k = 0; k < 4; ++k)
#pragma unroll
                        for (int h = 0; h < 2; ++h) y[k][h] = *(const u32x4*)(yr[k] + 512 * h + 8 * lane);
#pragma unroll
                    for (int k = 0; k < 4; ++k)
#pragma unroll
                        for (int h = 0; h < 2; ++h) { const u32x4 w = y[k][h];
                            acc[q][2 * h] += (f32x4){bf2f(w.x & 0xffffu), bf2f(w.x >> 16), bf2f(w.y & 0xffffu), bf2f(w.y >> 16)};
                            acc[q][2 * h + 1] += (f32x4){bf2f(w.z & 0xffffu), bf2f(w.z >> 16), bf2f(w.w & 0xffffu), bf2f(w.w >> 16)}; }
                    if (!mask) break;
                }
            }
#pragma unroll
            for (int q = 0; q < 2; ++q) {
                float ss = 0.f;
#pragma unroll
                for (int h = 0; h < 2; ++h)
#pragma unroll
                    for (int u4 = 0; u4 < 2; ++u4) { const int col = 512 * h + 8 * lane + 4 * u4; f32x4& v = xv[q][2 * h + u4]; v = v + *(const f32x4*)(g2 + col) * acc[q][2 * h + u4]; ss += (v.x * v.x + v.y * v.y) + (v.z * v.z + v.w * v.w); }
                const float rstd = 1.0f / sqrtf(wave_sum(ss) * (1.f / 1024.f) + EPS);
#pragma unroll
                for (int h = 0; h < 2; ++h)
#pragma unroll
                    for (int u4 = 0; u4 < 2; ++u4) { const int col = 512 * h + 8 * lane + 4 * u4; *(f32x4*)(args.out + (size_t)(row0 + q) * 1024 + col) = xv[q][2 * h + u4] * rstd * *(const f32x4*)(fg + col); }
            }
        }
    }
#undef IN
}

extern "C" void kernel_launch(void* const* d_in, const int* in_sizes, int n_in, void* d_out, int out_size, void* d_ws, size_t ws_size, hipStream_t stream) {
    static int grid = 0;
    if (grid == 0) {
        if (n_in != 23 || in_sizes[0] != NTOK * DM || out_size != NTOK * DM || ws_size < WS_END) {
            fprintf(stderr, "kernel_launch: unexpected problem (n_in %d, in0 %d, out %d, ws %zu < %zu?)\n", n_in, n_in > 0 ? in_sizes[0] : -1, out_size, ws_size, (size_t)WS_END); grid = -1; return; }
        if (hipFuncSetAttribute((const void*)fwd, hipFuncAttributeMaxDynamicSharedMemorySize, LDS_BYTES) != hipSuccess) { fprintf(stderr, "kernel_launch: hipFuncSetAttribute failed\n"); grid = -1; return; }
        int dev = 0, cus = 0;
        if (hipGetDevice(&dev) != hipSuccess || hipDeviceGetAttribute(&cus, hipDeviceAttributeMultiprocessorCount, dev) != hipSuccess) { grid = -1; return; }
        grid = cus;
    }
    if (grid < 0) return;
    (void)hipMemsetAsync((char*)d_ws + WS_CTL, 0, 1 * MiB, stream);
    Args a{};
    for (int i = 0; i < 23; ++i) a.in[i] = (const float*)d_in[i];
    a.out = (float*)d_out; a.ws = (unsigned char*)d_ws;
    if (ONE_LAUNCH) {
        a.ph_lo = 0; a.ph_hi = PH_COUNT;
        hipLaunchKernelGGL(fwd, dim3(grid), dim3(NTHREADS), LDS_BYTES, stream, a);
    } else {
        static const int seq[] = {PROBE_SEQ};
        for (unsigned i = 0; i < sizeof(seq) / sizeof(seq[0]); ++i) {
            a.ph_lo = seq[i] % 100; a.ph_hi = seq[i] % 100 + 1; a.flags = seq[i] / 100;
            hipLaunchKernelGGL(fwd, dim3(grid), dim3(NTHREADS), LDS_BYTES, stream, a);
        }
    }
}
```

```cpp
#include <hip/hip_runtime.h>
#include <cstdio>
#include <cstdint>

#define LAS __attribute__((address_space(3)))
typedef unsigned short bf16_t;
typedef float f32x4 __attribute__((ext_vector_type(4)));
typedef float f32x2 __attribute__((ext_vector_type(2)));
typedef unsigned u32x4 __attribute__((ext_vector_type(4)));
typedef unsigned u32x2 __attribute__((ext_vector_type(2)));
typedef int i32x4 __attribute__((ext_vector_type(4)));

constexpr int DM = 1024, NB = 8, SEQ = 4096, NTOK = NB * SEQ, CTXL = 256, NCTX = NB * CTXL, NROWS_H = NTOK + NCTX;
constexpr int INCOLS = 5632, OFF_Q = 2048, OFF_K = 3072, OFF_VB = 3328, OFF_GATE = 3584;
constexpr int NE = 16, CAP = 512, DE = 2048, NPAIR = NE * NB * CAP;
constexpr float EPS = 1e-6f, LOG2E = 1.4426950408889634f, C2 = 0.125f * LOG2E;
constexpr int NTHREADS = 512, NWAVES = 8;

constexpr size_t MiB = 1u << 20;
constexpr size_t WS_CTL = 0;
constexpr size_t WS_MOD = 1 * MiB;
constexpr size_t WS_ROPE = 1 * MiB + 512 * 1024;
constexpr size_t WS_AFFT = 2 * MiB;
constexpr size_t WS_TOPI = 4 * MiB;
constexpr size_t WS_TOPW = 4 * MiB + 512 * 1024;
constexpr size_t WS_SLOT = 5 * MiB;
constexpr size_t WS_WSP = 7 * MiB;
constexpr size_t WS_WIN = 8 * MiB;
constexpr size_t WS_WAB = 19 * MiB;
constexpr size_t WS_WO = 23 * MiB;
constexpr size_t WS_R = 25 * MiB;
constexpr size_t WS_H = WS_R;
constexpr size_t WS_VA = WS_R + 68 * MiB;
constexpr size_t WS_KB = WS_VA + 64 * MiB;
constexpr size_t WS_VB = WS_KB + 17 * MiB;
constexpr size_t WS_G = WS_VB + 17 * MiB;
constexpr size_t WS_Y = WS_G + 128 * MiB;
constexpr size_t WS_TMP = WS_Y + 128 * MiB;
constexpr size_t WS_STATS = WS_TMP + 64 * MiB;
constexpr size_t WS_MERGED = WS_H;
constexpr size_t WS_WGU = WS_R;
constexpr size_t WS_WD = WS_R + 128 * MiB;
constexpr size_t WS_H2 = WS_R + 192 * MiB;
constexpr size_t WS_ACT = WS_R + 256 * MiB;
constexpr size_t WS_YB = WS_WGU;
constexpr size_t WS_END = 537 * MiB;
static_assert(WS_STATS + 4 * MiB <= WS_END && WS_ACT + 256 * MiB == WS_END, "ws map");

constexpr int LDS_BYTES = 147456;

__device__ __forceinline__ float bf2f(unsigned b) { return __uint_as_float(b << 16); }
__device__ __forceinline__ unsigned f2bf(float f) { unsigned u = __float_as_uint(f); return (u + 0x7fffu + ((u >> 16) & 1u)) >> 16; }
__device__ __forceinline__ unsigned pk2(float lo, float hi) { typedef float f2_ __attribute__((ext_vector_type(2))); typedef __bf16 b2_ __attribute__((ext_vector_type(2))); f2_ v = {lo, hi}; b2_ b = __builtin_convertvector(v, b2_); return __builtin_bit_cast(unsigned, b); }
__device__ __forceinline__ void st4bf(bf16_t* p, f32x4 v) { u32x2 w; w.x = pk2(v.x, v.y); w.y = pk2(v.z, v.w); *(u32x2*)p = w; }
__device__ __forceinline__ void st8bf(bf16_t* p, f32x4 a, f32x4 b) { u32x4 w; w.x = pk2(a.x, a.y); w.y = pk2(a.z, a.w); w.z = pk2(b.x, b.y); w.w = pk2(b.z, b.w); *(u32x4*)p = w; }
__device__ __forceinline__ void ld8bf(const bf16_t* p, f32x4& a, f32x4& b) { const u32x4 w = *(const u32x4*)p; a.x = bf2f(w.x & 0xffffu); a.y = bf2f(w.x >> 16); a.z = bf2f(w.y & 0xffffu); a.w = bf2f(w.y >> 16); b.x = bf2f(w.z & 0xffffu); b.y = bf2f(w.z >> 16); b.z = bf2f(w.w & 0xffffu); b.w = bf2f(w.w >> 16); }
__device__ __forceinline__ f32x4 ld4bf(const bf16_t* p) { const u32x2 w = *(const u32x2*)p; f32x4 v; v.x = bf2f(w.x & 0xffffu); v.y = bf2f(w.x >> 16); v.z = bf2f(w.y & 0xffffu); v.w = bf2f(w.y >> 16); return v; }
__device__ __forceinline__ float sigmoidf_(float x) { return __builtin_amdgcn_rcpf(1.f + __builtin_amdgcn_exp2f(x * -1.4426950409f)); }
__device__ __forceinline__ float siluf_(float x) { return x * __builtin_amdgcn_rcpf(1.f + __builtin_amdgcn_exp2f(x * -1.4426950409f)); }
__device__ __forceinline__ float gelu_t(float x) { const float t = x * __builtin_fmaf(x * x, -0.10294324f, -2.3022082f); return x * __builtin_amdgcn_rcpf(1.f + __builtin_amdgcn_exp2f(t)); }
__device__ __forceinline__ f32x2 rcp2_(f32x2 d) { f32x2 r; r.x = __builtin_amdgcn_rcpf(d.x); r.y = __builtin_amdgcn_rcpf(d.y); return r; }
__device__ __forceinline__ f32x2 exp2_2_(f32x2 t) { f32x2 e; e.x = __builtin_amdgcn_exp2f(t.x); e.y = __builtin_amdgcn_exp2f(t.y); return e; }
__device__ __forceinline__ f32x2 gelu2_(f32x2 x) { const f32x2 t = x * ((x * x) * -0.10294324f + -2.3022082f); return x * rcp2_(exp2_2_(t) + 1.0f); }
__device__ __forceinline__ f32x2 sigm2_(f32x2 x) { return rcp2_(exp2_2_(x * -1.4426950409f) + 1.0f); }
__device__ __forceinline__ f32x4 gelu4_(f32x4 v) { const f32x2 a = gelu2_((f32x2){v.x, v.y}), b = gelu2_((f32x2){v.z, v.w}); return (f32x4){a.x, a.y, b.x, b.y}; }
__device__ __forceinline__ f32x4 sigm4_(f32x4 v) { const f32x2 a = sigm2_((f32x2){v.x, v.y}), b = sigm2_((f32x2){v.z, v.w}); return (f32x4){a.x, a.y, b.x, b.y}; }
__device__ __forceinline__ float wave_sum(float v) {
#pragma unroll
    for (int o = 1; o < 64; o <<= 1) v += __shfl_xor(v, o);
    return v;
}
__device__ __forceinline__ int wave_sum_i(int v) {
#pragma unroll
    for (int o = 1; o < 64; o <<= 1) v += __shfl_xor(v, o);
    return v;
}
#define LDS_WAIT() asm volatile("s_waitcnt lgkmcnt(0)" ::: "memory")

struct Args { const float* in[23]; float* out; unsigned char* ws; int ph_lo, ph_hi, flags, pad; };
enum { I_X = 0, I_C, I_CTX, I_CCTX, I_WADA, I_BADA, I_N1G, I_WIN, I_BMG, I_LNG, I_LNB, I_WSP, I_BSP, I_SINK, I_WPA, I_WPB, I_WOUT, I_N2G, I_WR, I_WEG, I_WEU, I_WED, I_FING };

struct Unit { int pm, pn; };
struct Gemm {
    const bf16_t* A; const bf16_t* Bt; int lda, ldb, K;
    size_t bgs; int tpg_shift;
    const int* gidx;
};
constexpr int NXCD = 8, WGM = 8;
struct StaticOrder {
    int nM, nN, nwg, G, c, extra, rev;
    __device__ void init(int M, int N, int G_, int c_, int extra_ = 0, int rev_ = 0) { nM = M / 256; nN = N / 256; nwg = nM * nN; G = G_; c = c_; extra = extra_; rev = rev_; }
    __device__ bool next(int i, Unit& u) const {
        const long L = (long)i * G + c;
        if (L >= nwg) { const int x = (int)(L - nwg); if (x >= extra) return false; u.pm = NTOK / 256 + (x >> 1); u.pn = 12 + (x & 1); return true; }
        int wgid = (int)L; { const int q = nwg / NXCD, r = nwg % NXCD, xcd = wgid % NXCD, off = wgid / NXCD; wgid = (xcd < r ? xcd * (q + 1) : r * (q + 1) + (xcd - r) * q) + off; }
        const int nig = WGM * nN, gid = wgid / nig, fm = gid * WGM, gsz = (nM - fm) < WGM ? (nM - fm) : WGM;
        u.pm = fm + ((wgid % nig) % gsz); u.pn = (wgid % nig) / gsz; if (rev) u.pm = nM - 1 - u.pm; return true;
    }
};

struct OneUnit { int pm, pn; __device__ bool next(int i, Unit& u) const { if (i) return false; u.pm = pm; u.pn = pn; return true; } };

typedef f32x4 Acc[2][2][4][2];

namespace pg8 {
typedef short bf16x8 __attribute__((ext_vector_type(8)));
constexpr int BK = 64, HALF = 128, HTB = HALF * BK * 2, STAGE_BYTES = 8 * HTB;
__device__ __forceinline__ int lds_byte(int r, int c) { const int st = (r >> 4) * 2 + (c >> 5), rr = r & 15, cc = c & 31, ob = rr * 64 + cc * 2; return st * 1024 + (ob ^ (((ob >> 9) & 1) << 5)); }
__device__ __forceinline__ void stage_rc(int b, int& R, int& C) { const int st = b / 1024, sb = b % 1024, swz = sb ^ (((sb >> 9) & 1) << 5); R = (st >> 1) * 16 + swz / 64; C = (st & 1) * 32 + (swz % 64) / 2; }

template <class Epi, class Sched, bool GATHER, bool HOOK = false>
__device__ __forceinline__ void gemm_phase(LAS unsigned char* lds, const Gemm g, const Sched& S, const Epi& E) {
    const int tid = threadIdx.x, wid = __builtin_amdgcn_readfirstlane(tid >> 6), lane = tid & 63, wr = wid >> 2, wc = wid & 3, fr = lane & 15, fq = lane >> 4;
    const int nt = g.K / BK;
    int Rs[2], Cs[2]; unsigned voffBp[2][2], voffB[2], voffBn[2], vA[2][2], vN[2][2];
#pragma unroll
    for (int i = 0; i < 2; ++i) { stage_rc(tid * 16 + i * 8192, Rs[i], Cs[i]); voffBp[0][i] = (unsigned)(Rs[i] * g.ldb + Cs[i]) * 2u;
        const int rho = Rs[i] & 31, Rb = (Rs[i] & ~31) + 8 * ((rho & 15) >> 2) + 4 * (rho >> 4) + (rho & 3); voffBp[1][i] = (unsigned)(Rb * g.ldb + Cs[i]) * 2u; }
    const size_t kstep = (size_t)(BK * 2);
    const size_t hstepB = (size_t)HALF * g.ldb * 2;
    const unsigned ldsw = (unsigned)wid * 1024u;
    const int aoff = lds_byte(wr * 64 + fr, fq * 8), boff = lds_byte(wc * 32 + fr, fq * 8);
#define PG8_SA(b, h) (((b) * 2 + (h)) * HTB)
#define PG8_SB(b, h) ((4 + (b) * 2 + (h)) * HTB)
#define PG8_STAGE(bufoff, gbase, voff) do { _Pragma("unroll") for (int _i = 0; _i < 2; ++_i) \
        __builtin_amdgcn_global_load_lds((const unsigned*)((const char*)(gbase) + (voff)[_i]), (LAS unsigned*)(lds + (bufoff) + ldsw + _i * 8192), 16, 0, 0); } while (0)
#define PG8_LDA(dst, b, h) do { _Pragma("unroll") for (int m = 0; m < 4; ++m) _Pragma("unroll") for (int k = 0; k < 2; ++k) dst[m][k] = *(const LAS bf16x8*)(lds + PG8_SA(b, h) + aoff + m * 2048 + k * 1024); } while (0)
#define PG8_LDB(dst, b, h) do { _Pragma("unroll") for (int n = 0; n < 2; ++n) _Pragma("unroll") for (int k = 0; k < 2; ++k) dst[n][k] = *(const LAS bf16x8*)(lds + PG8_SB(b, h) + boff + n * 2048 + k * 1024); } while (0)
#define PG8_MMA(ai, bj, At, Bt) do { __builtin_amdgcn_s_setprio(1); _Pragma("unroll") for (int m = 0; m < 4; ++m) _Pragma("unroll") for (int n = 0; n < 2; ++n) _Pragma("unroll") for (int k = 0; k < 2; ++k) \
        acc[ai][bj][m][n] = __builtin_amdgcn_mfma_f32_16x16x32_bf16(Bt[n][k], At[m][k], acc[ai][bj][m][n], 0, 0, 0); __builtin_amdgcn_s_setprio(0); } while (0)
#define PG8_WAIT_V(n) asm volatile("s_waitcnt vmcnt(" #n ")" ::: "memory")
#define PG8_WAIT_L(n) asm volatile("s_waitcnt lgkmcnt(" #n ")" ::: "memory")
#define PG8_BAR __builtin_amdgcn_s_barrier()
#define PG8_SCHED __builtin_amdgcn_sched_barrier(0)
#define PG8_AVOFF(dst, U) do { _Pragma("unroll") for (int _h = 0; _h < 2; ++_h) _Pragma("unroll") for (int _i = 0; _i < 2; ++_i) \
        dst[_h][_i] = GATHER ? (unsigned)((((U).pm >> 1) & 7) * SEQ + g.gidx[(U).pm * 256 + _h * 128 + Rs[_i]]) * (unsigned)(g.lda * 2) + (unsigned)(Cs[_i] * 2) \
                             : (unsigned)((_h * 128 + Rs[_i]) * g.lda + Cs[_i]) * 2u; } while (0)
#define PG8_ABASE(U) ((const char*)g.A + (GATHER ? (size_t)0 : (size_t)(U).pm * 256 * g.lda * 2))
#define PG8_BBASE(U) ((const char*)g.Bt + ((size_t)((U).pm >> g.tpg_shift) * g.bgs + (size_t)(U).pn * 256 * g.ldb) * 2)
    Unit cur, nxt; int ui = 0;
    if (!S.next(0, cur)) return;
    Acc acc;
#pragma unroll
    for (int a = 0; a < 2; ++a)
#pragma unroll
        for (int b = 0; b < 2; ++b)
#pragma unroll
            for (int m = 0; m < 4; ++m)
#pragma unroll
                for (int n = 0; n < 2; ++n) acc[a][b][m][n] = (f32x4){0.f, 0.f, 0.f, 0.f};
    bf16x8 At[4][2], B0[2][2], B1[2][2];
    PG8_AVOFF(vA, cur);
    { const bool pc = E.perm(cur); voffB[0] = pc ? voffBp[1][0] : voffBp[0][0]; voffB[1] = pc ? voffBp[1][1] : voffBp[0][1]; }
    const char* cA = PG8_ABASE(cur); const char* cB = PG8_BBASE(cur);
    PG8_STAGE(PG8_SB(0, 0), cB, voffB); PG8_STAGE(PG8_SB(0, 1), cB + hstepB, voffB); PG8_STAGE(PG8_SA(0, 0), cA, vA[0]); PG8_STAGE(PG8_SA(0, 1), cA, vA[1]);
    if (wr == 1) PG8_BAR;
    PG8_WAIT_V(2); PG8_BAR;
    PG8_STAGE(PG8_SB(1, 0), cB + kstep, voffB); PG8_STAGE(PG8_SA(1, 0), cA + kstep, vA[0]); PG8_STAGE(PG8_SB(1, 1), cB + hstepB + kstep, voffB);
    PG8_WAIT_V(6); PG8_BAR;
    for (;;) {
        const bool has_next = S.next(ui + 1, nxt);
        const char* nA = has_next ? PG8_ABASE(nxt) : cA; const char* nB = has_next ? PG8_BBASE(nxt) : cB;
        { const bool pn_ = has_next ? E.perm(nxt) : E.perm(cur); voffBn[0] = pn_ ? voffBp[1][0] : voffBp[0][0]; voffBn[1] = pn_ ? voffBp[1][1] : voffBp[0][1]; }
        if (GATHER) {
#pragma unroll
            for (int h = 0; h < 2; ++h)
#pragma unroll
                for (int i = 0; i < 2; ++i) vN[h][i] = vA[h][i];
            if (has_next && wid == 0)
                __builtin_amdgcn_global_load_lds((const unsigned*)(g.gidx + nxt.pm * 256 + lane * 4), (LAS unsigned*)(lds + STAGE_BYTES + (ui & 1) * 1024), 16, 0, 0);
        }
        for (int t = 0; t < nt; t += 2) {
            const bool last = (t == nt - 2);
            if (GATHER) { if (t == 4 && has_next) {
                const LAS int* li = (const LAS int*)(lds + STAGE_BYTES + (ui & 1) * 1024);
#pragma unroll
                for (int h = 0; h < 2; ++h)
#pragma unroll
                    for (int i = 0; i < 2; ++i) vN[h][i] = (unsigned)(((nxt.pm >> 1) & 7) * SEQ + li[h * 128 + Rs[i]]) * (unsigned)(g.lda * 2) + (unsigned)(Cs[i] * 2);
            } }
            if constexpr (HOOK) { if (t == (nt >> 1)) E.mid(acc, cur, wr, wc, fr, fq); }
            const char* a1 = cA + (size_t)(t + 1) * kstep;
            const char* a2 = last ? nA : cA + (size_t)(t + 2) * kstep; const char* b2 = last ? nB : cB + (size_t)(t + 2) * kstep;
            const char* a3 = a2 + kstep; const char* b3 = b2 + kstep;
            unsigned v2[2][2];
#pragma unroll
            for (int h = 0; h < 2; ++h)
#pragma unroll
                for (int i = 0; i < 2; ++i) v2[h][i] = (GATHER && last) ? vN[h][i] : vA[h][i];
            unsigned vb2[2]; vb2[0] = last ? voffBn[0] : voffB[0]; vb2[1] = last ? voffBn[1] : voffB[1];
            PG8_LDB(B0, 0, 0); PG8_LDB(B1, 0, 1); PG8_SCHED; PG8_LDA(At, 0, 0); PG8_STAGE(PG8_SA(1, 1), a1, vA[1]);
            PG8_WAIT_V(8); PG8_WAIT_L(0); PG8_BAR; PG8_MMA(0, 0, At, B0); PG8_MMA(0, 1, At, B1); PG8_BAR; PG8_SCHED;
            PG8_LDA(At, 0, 1); PG8_STAGE(PG8_SB(0, 0), b2, vb2); PG8_STAGE(PG8_SB(0, 1), b2 + hstepB, vb2); PG8_STAGE(PG8_SA(0, 0), a2, v2[0]);
            PG8_WAIT_V(8); PG8_WAIT_L(0); PG8_BAR; PG8_MMA(1, 0, At, B0); PG8_MMA(1, 1, At, B1); PG8_BAR; PG8_SCHED;
            PG8_LDB(B0, 1, 0); PG8_LDB(B1, 1, 1); PG8_SCHED; PG8_LDA(At, 1, 0); PG8_STAGE(PG8_SA(0, 1), a2, v2[1]);
            PG8_WAIT_V(8); PG8_WAIT_L(0); PG8_BAR; PG8_MMA(0, 0, At, B0); PG8_MMA(0, 1, At, B1); PG8_BAR; PG8_SCHED;
            PG8_LDA(At, 1, 1); PG8_STAGE(PG8_SB(1, 0), b3, vb2); PG8_STAGE(PG8_SB(1, 1), b3 + hstepB, vb2); PG8_STAGE(PG8_SA(1, 0), a3, v2[0]);
            PG8_WAIT_V(8); PG8_WAIT_L(0); PG8_BAR; PG8_MMA(1, 0, At, B0); PG8_MMA(1, 1, At, B1); PG8_BAR; PG8_SCHED;
        }
        if (wr == 0) PG8_BAR;
        E(acc, cur, wr, wc, fr, fq);
        if (!has_next) break;
#pragma unroll
        for (int a = 0; a < 2; ++a)
#pragma unroll
            for (int b = 0; b < 2; ++b)
#pragma unroll
                for (int m = 0; m < 4; ++m)
#pragma unroll
                    for (int n = 0; n < 2; ++n) acc[a][b][m][n] = (f32x4){0.f, 0.f, 0.f, 0.f};
        cur = nxt; cA = nA; cB = nB; ++ui; voffB[0] = voffBn[0]; voffB[1] = voffBn[1];
        if (GATHER) {
#pragma unroll
            for (int h = 0; h < 2; ++h)
#pragma unroll
                for (int i = 0; i < 2; ++i) vA[h][i] = vN[h][i];
        }
        if (wr == 1) PG8_BAR;
    }
    PG8_WAIT_V(0);
    PG8_BAR;
#undef PG8_SA
#undef PG8_SB
#undef PG8_STAGE
#undef PG8_LDA
#undef PG8_LDB
#undef PG8_MMA
#undef PG8_WAIT_V
#undef PG8_WAIT_L
#undef PG8_BAR
#undef PG8_SCHED
#undef PG8_AVOFF
#undef PG8_ABASE
#undef PG8_BBASE
}
}

#define GEMM_PHASE pg8::gemm_phase

struct EpiIn {
    bf16_t *Y, *VA, *KB, *VB, *G; const float* bgate; const f32x2* rope; f32x2* STATS;
    __device__ __forceinline__ bool perm(const Unit& u) const { return u.pn < 8 || u.pn > 12; }
    template <int KIND> __device__ __forceinline__ void run(const Acc& acc, const Unit& u, int wr, int wc, int fr, int fq) const {
        const int pn = u.pn;
#pragma unroll
        for (int ai = 0; ai < 2; ++ai)
#pragma unroll
            for (int m = 0; m < 4; ++m) {
                const int row = u.pm * 256 + ai * 128 + wr * 64 + m * 16 + fr;
                float ssum = 0.f, ssq = 0.f;
#pragma unroll
                for (int bj = 0; bj < 2; ++bj) {
                    f32x4 v0 = acc[ai][bj][m][0], v1 = acc[ai][bj][m][1];
                    if constexpr (KIND == 0 || KIND == 1) {
                        const int c8 = bj * 128 + wc * 32 + 8 * fq;
                        v0 = gelu4_(v0); v1 = gelu4_(v1);
                        if constexpr (KIND == 0) st8bf(Y + (size_t)row * 2048 + pn * 256 + c8, v0, v1);
                        else {
                            st8bf(VA + (size_t)row * 1024 + (pn - 4) * 256 + c8, v0, v1);
                            ssum += ((v0.x + v0.y) + (v0.z + v0.w)) + ((v1.x + v1.y) + (v1.z + v1.w));
                            ssq += ((v0.x * v0.x + v0.y * v0.y) + (v0.z * v0.z + v0.w * v0.w)) + ((v1.x * v1.x + v1.y * v1.y) + (v1.z * v1.z + v1.w * v1.w));
                        }
                    } else if constexpr (KIND == 2) {
                        const int cl = bj * 128 + wc * 32 + 4 * fq;
                        f32x4 o0 = v0, o1 = v1;
                        if (row < NTOK) {
                            const int t = row & (SEQ - 1), pos = (wc & 1) ? (t & 63) : (t >> 6);
                            const f32x2* rp = rope + pos * 16 + 4 * fq;
#pragma unroll
                            for (int j = 0; j < 4; ++j) { const f32x2 cs = rp[j]; o0[j] = v0[j] * cs.x - v1[j] * cs.y; o1[j] = v0[j] * cs.y + v1[j] * cs.x; }
                        }
                        if (pn < 12) { bf16_t* p = Y + (size_t)row * 2048 + 1024 + (pn - 8) * 256 + cl; st4bf(p, o0 * C2); st4bf(p + 16, o1 * C2); }
                        else { bf16_t* p = KB + (size_t)row * 256 + cl; st4bf(p, o0); st4bf(p + 16, o1); }
                    } else if constexpr (KIND == 3) {
                        st8bf(VB + (size_t)row * 256 + bj * 128 + wc * 32 + 8 * fq, v0, v1);
                    } else {
                        if (bj == 0) {
                            const int ch = (pn - 14) * 128 + wc * 32 + 8 * fq;
                            const f32x4 a0 = sigm4_(v0 + *(const f32x4*)(bgate + ch)), a1 = sigm4_(v1 + *(const f32x4*)(bgate + ch + 4));
                            const f32x4 g0 = sigm4_(acc[ai][1][m][0] + *(const f32x4*)(bgate + 1024 + ch)), g1 = sigm4_(acc[ai][1][m][1] + *(const f32x4*)(bgate + 1024 + ch + 4));
                            f32x4 r0, r1;
#pragma unroll
                            for (int j = 0; j < 4; ++j) { r0[j] = a0[j] * __builtin_amdgcn_rcpf(g0[j]); r1[j] = a1[j] * __builtin_amdgcn_rcpf(g1[j]); }
                            st8bf(G + (size_t)row * 2048 + ch, r0, r1); st8bf(G + (size_t)row * 2048 + 1024 + ch, g0, g1);
                        }
                    }
                }
                if constexpr (KIND == 1) {
                    ssum += __shfl_xor(ssum, 16); ssum += __shfl_xor(ssum, 32); ssq += __shfl_xor(ssq, 16); ssq += __shfl_xor(ssq, 32);
                    if (fq == 0) STATS[(size_t)row * 16 + (pn - 4) * 4 + wc] = (f32x2){ssum, ssq};
                }
            }
    }
    __device__ __forceinline__ void operator()(const Acc& acc, const Unit& u, int wr, int wc, int fr, int fq) const {
        const int pn = u.pn;
        if (pn < 4) run<0>(acc, u, wr, wc, fr, fq);
        else if (pn < 8) run<1>(acc, u, wr, wc, fr, fq);
        else if (pn < 13) run<2>(acc, u, wr, wc, fr, fq);
        else if (pn == 13) run<3>(acc, u, wr, wc, fr, fq);
        else run<4>(acc, u, wr, wc, fr, fq);
    }
};
struct EpiAB {
    bf16_t* MERGED; const bf16_t* G;
    __device__ __forceinline__ bool perm(const Unit&) const { return true; }
    __device__ __forceinline__ void mid(Acc& acc, const Unit& u, int wr, int wc, int fr, int fq) const {
        int zero; asm volatile("v_mov_b32 %0, 0" : "=v"(zero));
        const bf16_t* gp = G + (size_t)(u.pm * 256 + wr * 64 + fr + zero) * 2048 + u.pn * 256 + wc * 32 + 8 * fq;
#pragma unroll
        for (int ai = 0; ai < 2; ++ai)
#pragma unroll
            for (int m = 0; m < 4; ++m) {
#pragma unroll
                for (int bj = 0; bj < 2; ++bj) {
                    const bf16_t* q = gp + (size_t)(ai * 128 + m * 16) * 2048 + bj * 128;
                    f32x4 r0, r1; ld8bf(q, r0, r1);
                    acc[ai][bj][m][0] *= r0; acc[ai][bj][m][1] *= r1;
                    asm volatile("" ::: "memory");
                }
            }
    }
    __device__ __forceinline__ void operator()(const Acc& acc, const Unit& u, int wr, int wc, int fr, int fq) const {
#pragma unroll
        for (int ai = 0; ai < 2; ++ai)
#pragma unroll
            for (int m = 0; m < 4; ++m) {
                const int row = u.pm * 256 + ai * 128 + wr * 64 + m * 16 + fr;
#pragma unroll
                for (int bj = 0; bj < 2; ++bj) {
                    const int c8 = u.pn * 256 + bj * 128 + wc * 32 + 8 * fq;
                    f32x4 gb0, gb1; ld8bf(G + (size_t)row * 2048 + 1024 + c8, gb0, gb1);
                    st8bf(MERGED + (size_t)row * 1024 + c8, gb0 * acc[ai][bj][m][0], gb1 * acc[ai][bj][m][1]);
                }
            }
    }
};
struct EpiO {
    bf16_t* D16; const float* mod;
    __device__ __forceinline__ bool perm(const Unit&) const { return true; }
    __device__ __forceinline__ void operator()(const Acc& acc, const Unit& u, int wr, int wc, int fr, int fq) const {
        const float* g1 = mod + (size_t)((u.pm * 256) >> 12) * 6144 + 2048;
#pragma unroll
        for (int bj = 0; bj < 2; ++bj) {
            const int c8 = u.pn * 256 + bj * 128 + wc * 32 + 8 * fq;
            const f32x4 ga = *(const f32x4*)(g1 + c8), gb = *(const f32x4*)(g1 + c8 + 4);
#pragma unroll
            for (int ai = 0; ai < 2; ++ai)
#pragma unroll
                for (int m = 0; m < 4; ++m) {
                    const int row = u.pm * 256 + ai * 128 + wr * 64 + m * 16 + fr;
                    st8bf(D16 + (size_t)row * 2048 + 1024 + c8, ga * acc[ai][bj][m][0], gb * acc[ai][bj][m][1]);
                }
        }
    }
};
struct EpiGU {
    bf16_t* ACT;
    __device__ __forceinline__ bool perm(const Unit&) const { return true; }
    __device__ __forceinline__ void operator()(const Acc& acc, const Unit& u, int wr, int wc, int fr, int fq) const {
#pragma unroll
        for (int ai = 0; ai < 2; ++ai)
#pragma unroll
            for (int m = 0; m < 4; ++m) {
                const int prow = u.pm * 256 + ai * 128 + wr * 64 + m * 16 + fr;
                f32x4 a[2];
#pragma unroll
                for (int n = 0; n < 2; ++n) {
                    const f32x4 gt = acc[ai][0][m][n], up = acc[ai][1][m][n];
                    a[n] = gt * sigm4_(gt) * up;
                }
                st8bf(ACT + (size_t)prow * 2048 + u.pn * 128 + wc * 32 + 8 * fq, a[0], a[1]);
            }
    }
};
struct EpiD {
    bf16_t* YB; const float* TOPW;
    __device__ __forceinline__ bool perm(const Unit&) const { return true; }
    __device__ __forceinline__ void operator()(const Acc& acc, const Unit& u, int wr, int wc, int fr, int fq) const {
#pragma unroll
        for (int ai = 0; ai < 2; ++ai)
#pragma unroll
            for (int m = 0; m < 4; ++m) {
                const int prow = u.pm * 256 + ai * 128 + wr * 64 + m * 16 + fr; const float w = TOPW[prow];
#pragma unroll
                for (int bj = 0; bj < 2; ++bj)
                    st8bf(YB + (size_t)prow * 1024 + u.pn * 256 + bj * 128 + wc * 32 + 8 * fq, acc[ai][bj][m][0] * w, acc[ai][bj][m][1] * w);
            }
    }
};

__device__ __forceinline__ void transpose_item(const float* W, int N, int k0, int n0, bf16_t* dst, int ldt, LAS float* scr, int lane) {
    const int kk = lane >> 3, nq = (lane & 7) * 4;
    f32x4 v[8];
#pragma unroll
    for (int i = 0; i < 8; ++i) v[i] = *(const f32x4*)(W + (size_t)(k0 + 8 * i + kk) * N + n0 + nq);
#pragma unroll
    for (int i = 0; i < 8; ++i) { LAS float* s = scr + (8 * i + kk) * 33 + nq; s[0] = v[i].x; s[1] = v[i].y; s[2] = v[i].z; s[3] = v[i].w; }
    LDS_WAIT();
    const int c = lane & 7;
#pragma unroll
    for (int j = 0; j < 4; ++j) {
        const int n = (lane >> 3) + 8 * j; const LAS float* s = scr + (8 * c) * 33 + n;
        u32x4 o; o.x = pk2(s[0 * 33], s[1 * 33]); o.y = pk2(s[2 * 33], s[3 * 33]); o.z = pk2(s[4 * 33], s[5 * 33]); o.w = pk2(s[6 * 33], s[7 * 33]);
        *(u32x4*)(dst + (size_t)n * ldt + 8 * c) = o;
    }
    LDS_WAIT();
}

struct TrItem { const float* src; bf16_t* dst; int N, ldt; };
__device__ __forceinline__ void tr_load(const TrItem& it, f32x4 (&v)[8], int lane) {
    const int kk = lane >> 3, nq = (lane & 7) * 4;
#pragma unroll
    for (int i = 0; i < 8; ++i) v[i] = *(const f32x4*)(it.src + (size_t)(8 * i + kk) * it.N + nq);
}
__device__ __forceinline__ void tr_store(const TrItem& it, const f32x4 (&v)[8], LAS float* scr, int lane) {
    const int kk = lane >> 3, nq = (lane & 7) * 4;
#pragma unroll
    for (int i = 0; i < 8; ++i) { LAS float* s = scr + (8 * i + kk) * 33 + nq; s[0] = v[i].x; s[1] = v[i].y; s[2] = v[i].z; s[3] = v[i].w; }
    LDS_WAIT();
    const int c = lane & 7;
#pragma unroll
    for (int j = 0; j < 4; ++j) {
        const int n = (lane >> 3) + 8 * j; const LAS float* s = scr + (8 * c) * 33 + n;
        u32x4 o; o.x = pk2(s[0 * 33], s[1 * 33]); o.y = pk2(s[2 * 33], s[3 * 33]); o.z = pk2(s[4 * 33], s[5 * 33]); o.w = pk2(s[6 * 33], s[7 * 33]);
        *(u32x4*)(it.dst + (size_t)n * it.ldt + 8 * c) = o;
    }
    LDS_WAIT();
}

__device__ __forceinline__ void adaln_task(int task, const float* c, const float* cctx, const float* w_ada, const float* b_ada, float* mod, LAS float* lds, int tid) {
    LAS float* s = lds; LAS float* red = lds + 9 * 1024;
    { float cv[18];
#pragma unroll
      for (int q = 0; q < 18; ++q) { const int i = tid + NTHREADS * q, r = i >> 10, k = i & 1023; cv[q] = r < 8 ? c[r * 1024 + k] : cctx[k]; }
#pragma unroll
      for (int q = 0; q < 18; ++q) s[tid + NTHREADS * q] = cv[q] * __builtin_amdgcn_rcpf(1.f + __expf(-cv[q])); }
    __syncthreads();
    const int ch = tid & 7, kr = tid >> 3;
    f32x4 acc[9];
#pragma unroll
    for (int r = 0; r < 9; ++r) acc[r] = (f32x4){0.f, 0.f, 0.f, 0.f};
    const float* wp = w_ada + (size_t)kr * 6144 + task * 32 + ch * 4;
    for (int it = 0; it < 16; ++it) {
        const f32x4 w = *(const f32x4*)(wp + (size_t)it * 64 * 6144); const int k = kr + it * 64;
#pragma unroll
        for (int r = 0; r < 9; ++r) acc[r] += s[r * 1024 + k] * w;
    }
#pragma unroll
    for (int r = 0; r < 9; ++r) *(LAS f32x4*)(red + (kr * 9 + r) * 32 + ch * 4) = acc[r];
    __syncthreads();
    if (tid < 288) { const int r = tid >> 5, col = tid & 31; float sum = 0.f; for (int q = 0; q < 64; ++q) sum += red[(q * 9 + r) * 32 + col]; mod[r * 6144 + task * 32 + col] = sum + b_ada[task * 32 + col]; }
    __syncthreads();
}

__device__ __forceinline__ void rope_table(f32x2* tab, int tid) {
    for (int idx = tid; idx < 1024; idx += NTHREADS) {
        const int pos = idx >> 4, i = idx & 15;
        double f = 1.0;
        for (int q = 0; q < i; ++q) f *= 0.56234132519034908;
        const float ang = (float)pos * (float)f;
        const double a = (double)ang, k = __builtin_rint(a * 0.15915494309189535), r = a - k * 6.283185307179586476925, r2 = r * r;
        double sn = r, ts = r, cs = 1.0, tc = 1.0;
        for (int n = 1; n <= 14; ++n) {
            tc *= -r2 / (double)((2 * n - 1) * (2 * n)); cs += tc;
            ts *= -r2 / (double)((2 * n) * (2 * n + 1)); sn += ts;
        }
        tab[idx] = (f32x2){(float)cs, (float)sn};
    }
}

__device__ __forceinline__ unsigned char* lds_raw_ptr(LAS unsigned char* p) { return (unsigned char*)p; }
namespace mix {
typedef short bf16x8 __attribute__((ext_vector_type(8)));
typedef short s16x4 __attribute__((ext_vector_type(4)));
typedef float f32x16 __attribute__((ext_vector_type(16)));
typedef __attribute__((address_space(3))) const char* lds_cptr;
__device__ __forceinline__ int crow(int r, int hi) { return (r & 3) + 8 * (r >> 2) + 4 * hi; }
__device__ __forceinline__ unsigned cvtpk(float lo, float hi) { typedef float f2 __attribute__((ext_vector_type(2))); typedef __bf16 b2 __attribute__((ext_vector_type(2))); f2 v = {lo, hi}; b2 b = __builtin_convertvector(v, b2); return __builtin_bit_cast(unsigned, b); }
__device__ __forceinline__ s16x4 vtr(lds_cptr p) { return __builtin_bit_cast(s16x4, __builtin_amdgcn_ds_read_tr16_b64_v4i16((__attribute__((address_space(3))) s16x4*)p)); }
__device__ __forceinline__ bf16x8 pk8(s16x4 lo, s16x4 hi) { return (bf16x8){lo[0], lo[1], lo[2], lo[3], hi[0], hi[1], hi[2], hi[3]}; }
__device__ __forceinline__ float max3f(float a, float b, float c) { float r; asm("v_max3_f32 %0, %1, %2, %3" : "=v"(r) : "v"(a), "v"(b), "v"(c)); return r; }
__device__ __forceinline__ float max2f(float a, float b) { float r; asm("v_max_f32_e32 %0, %1, %2" : "=v"(r) : "v"(a), "v"(b)); return r; }
__device__ __forceinline__ float swap_half(float v) { auto rr = __builtin_amdgcn_permlane32_swap(__float_as_uint(v), __float_as_uint(v), false, false); return __uint_as_float((threadIdx.x & 32) ? rr[0] : rr[1]); }

constexpr int A_K = 0, A_V = 24576, A_WS = 49152, A_QST = 53248, A_OST = A_QST, A_OSTW = 8192, A_END = A_QST + 8 * 8192;

__device__ __forceinline__ void attn_unit(int b, int n, int kvh, bf16_t* Y, bf16_t* O, int ldo, const bf16_t* KB, const bf16_t* VB, const float* sink, LAS unsigned char* lds) {
    const int tid = threadIdx.x, lane = tid & 63, r32 = lane & 31, hi = lane >> 5, wid = __builtin_amdgcn_readfirstlane(tid >> 6);
    const int head = kvh * 4 + (wid >> 1);
    const int qrow0 = b * SEQ + n * 128 + (wid & 1) * 64;
    bf16_t* Qw = Y + (size_t)qrow0 * 2048 + 1024 + head * 64;
    LAS bf16x8* qst = (LAS bf16x8*)(lds + A_QST + wid * 8192) + lane;
#pragma unroll
    for (int sb = 0; sb < 2; ++sb)
#pragma unroll
        for (int d0 = 0; d0 < 4; ++d0) qst[(sb * 4 + d0) * 64] = *(const bf16x8*)(Qw + (size_t)(32 * sb + r32) * 2048 + d0 * 16 + hi * 8);
    f32x16 o[2][2];
#pragma unroll
    for (int sb = 0; sb < 2; ++sb)
#pragma unroll
        for (int d0 = 0; d0 < 2; ++d0)
#pragma unroll
            for (int r = 0; r < 16; ++r) o[sb][d0][r] = 0.f;
    float m[2] = {-1e30f, -1e30f}, l[2] = {0.f, 0.f};
    LAS float* wsf = (LAS float*)(lds + A_WS) + wid * 128;
    const int jlo = (n == 0) ? 2 : 0, jhi = (n == 31) ? 3 : 5, T = 4 + (jhi - jlo + 1);
    const size_t koff = (size_t)lane * 256 + wid * 8 + kvh * 64;
    const size_t voff = (size_t)(16 * (wid & 3) + (lane >> 2)) * 256 + (wid >> 2) * 32 + (lane & 3) * 8 + kvh * 64;
    auto tile_row = [&](int t) -> long { return t < 4 ? (long)(NTOK + b * CTXL + 64 * t) : (long)(b * SEQ + (n - 1) * 128 + 64 * (jlo + t - 4)); };
    auto issue = [&](int t) {
        const long row = tile_row(t); const int buf = t % 3;
        __builtin_amdgcn_global_load_lds((const unsigned*)(KB + row * 256 + koff), (LAS unsigned*)(lds + A_K + buf * 8192 + wid * 1024), 16, 0, 0);
        __builtin_amdgcn_global_load_lds((const unsigned*)(VB + row * 256 + voff), (LAS unsigned*)(lds + A_V + buf * 8192 + wid * 1024), 16, 0, 0);
    };
    issue(0); issue(1);
    int slot = 0;
    for (int t = 0; t < T; ++t) {
        if (t + 1 < T) asm volatile("s_waitcnt vmcnt(2) lgkmcnt(0)" ::: "memory"); else asm volatile("s_waitcnt vmcnt(0) lgkmcnt(0)" ::: "memory");
        __builtin_amdgcn_s_barrier();
        if (t + 2 < T) issue(t + 2);
        const lds_cptr Kt = (lds_cptr)(lds + A_K + slot * 8192) + hi * 1024 + r32 * 16;
        const lds_cptr Vt = (lds_cptr)(lds + A_V + slot * 8192) + ((lane >> 4) & 1) * 32 + (lane & 3) * 8 + (4 * hi + ((lane & 15) >> 2)) * 64;
        slot = (slot == 2) ? 0 : slot + 1;
        const bool local = t >= 4;
        const int dl = 64 * (jlo + t - 4) - 128 - 64 * (wid & 1);
        if (local && (dl > 160 || dl < -191)) continue;
        f32x16 p0[2], p1[2];
#pragma unroll
        for (int sb = 0; sb < 2; ++sb)
#pragma unroll
            for (int r = 0; r < 16; ++r) { p0[sb][r] = 0.f; p1[sb][r] = 0.f; }
#pragma unroll
        for (int d0 = 0; d0 < 4; ++d0) {
            const bf16x8 k0 = *(const __attribute__((address_space(3))) bf16x8*)(Kt + d0 * 2048), k1 = *(const __attribute__((address_space(3))) bf16x8*)(Kt + d0 * 2048 + 512);
#pragma unroll
            for (int sb = 0; sb < 2; ++sb) {
                const bf16x8 qf = qst[(sb * 4 + d0) * 64];
                p0[sb] = __builtin_amdgcn_mfma_f32_32x32x16_bf16(k0, qf, p0[sb], 0, 0, 0);
                p1[sb] = __builtin_amdgcn_mfma_f32_32x32x16_bf16(k1, qf, p1[sb], 0, 0, 0);
            }
        }
        if (local && (dl < -97 || dl > 65 || dl - 32 < -97)) {
#pragma unroll
            for (int sb = 0; sb < 2; ++sb)
#pragma unroll
                for (int r = 0; r < 16; ++r) { const int rel = dl - 32 * sb + crow(r, hi) - r32; if (rel < -128 || rel > 128) p0[sb][r] = -1e30f; if (rel + 32 < -128 || rel + 32 > 128) p1[sb][r] = -1e30f; }
        }
        float mn[2];
        asm volatile("s_nop 15\n\ts_nop 7" : "+v"(p0[0]), "+v"(p1[0]), "+v"(p0[1]), "+v"(p1[1]));
#pragma unroll
        for (int sb = 0; sb < 2; ++sb) {
            float a = max3f(p0[sb][0], p0[sb][1], p1[sb][0]), b2 = max3f(p0[sb][2], p0[sb][3], p1[sb][1]); a = max3f(a, p1[sb][2], p1[sb][3]);
#pragma unroll
            for (int r = 4; r < 16; r += 4) { a = max3f(a, p0[sb][r], p0[sb][r + 1]); b2 = max3f(b2, p0[sb][r + 2], p0[sb][r + 3]); a = max3f(a, p1[sb][r], p1[sb][r + 1]); b2 = max3f(b2, p1[sb][r + 2], p1[sb][r + 3]); }
            float rm = max2f(a, b2);
            rm = max2f(rm, swap_half(rm));
            mn[sb] = max2f(m[sb], rm);
        }
        if (__any((mn[0] > m[0]) || (mn[1] > m[1]))) {
            const float f0 = __builtin_amdgcn_exp2f(m[0] - mn[0]), f1 = __builtin_amdgcn_exp2f(m[1] - mn[1]);
            l[0] *= f0; l[1] *= f1;
            if (hi == 0) { wsf[r32] = f0; wsf[64 + r32] = f1; }
            asm volatile("s_waitcnt lgkmcnt(0)" ::: "memory");
#pragma unroll
            for (int r = 0; r < 16; ++r) { const float a = wsf[crow(r, hi)], b2 = wsf[64 + crow(r, hi)]; o[0][0][r] *= a; o[0][1][r] *= a; o[1][0][r] *= b2; o[1][1][r] *= b2; }
            m[0] = mn[0]; m[1] = mn[1];
        }
        u32x4 pw[2][4];
#pragma unroll
        for (int sb = 0; sb < 2; ++sb) {
            float sacc = 0.f;
#pragma unroll
            for (int r = 0; r < 16; ++r) { p0[sb][r] = __builtin_amdgcn_exp2f(p0[sb][r] - m[sb]); p1[sb][r] = __builtin_amdgcn_exp2f(p1[sb][r] - m[sb]); sacc += p0[sb][r] + p1[sb][r]; }
            l[sb] += sacc;
#pragma unroll
            for (int q = 0; q < 4; ++q) { pw[sb][0][q] = cvtpk(p0[sb][2 * q], p0[sb][2 * q + 1]); pw[sb][1][q] = cvtpk(p0[sb][8 + 2 * q], p0[sb][9 + 2 * q]); pw[sb][2][q] = cvtpk(p1[sb][2 * q], p1[sb][2 * q + 1]); pw[sb][3][q] = cvtpk(p1[sb][8 + 2 * q], p1[sb][9 + 2 * q]); }
        }
#pragma unroll
        for (int d0 = 0; d0 < 2; ++d0)
#pragma unroll
            for (int ks = 0; ks < 4; ++ks) {
                const s16x4 vlo = vtr(Vt + d0 * 4096 + ks * 1024), vhi = vtr(Vt + d0 * 4096 + ks * 1024 + 512);
                const bf16x8 vf = pk8(vlo, vhi);
#pragma unroll
                for (int sb = 0; sb < 2; ++sb) o[sb][d0] = __builtin_amdgcn_mfma_f32_32x32x16_bf16(__builtin_bit_cast(bf16x8, pw[sb][ks]), vf, o[sb][d0], 0, 0, 0);
            }
    }
    const float s2 = sink[head] * LOG2E;
    LAS bf16_t* stg = (LAS bf16_t*)(lds + A_OST + wid * A_OSTW);
#pragma unroll
    for (int sb = 0; sb < 2; ++sb) {
        const float lt = l[sb] + swap_half(l[sb]);
        const float mf = fmaxf(m[sb], s2), f = __builtin_amdgcn_exp2f(m[sb] - mf), den = lt * f + __builtin_amdgcn_exp2f(s2 - mf);
        asm volatile("s_waitcnt lgkmcnt(0)" ::: "memory");
        if (hi == 0) wsf[sb * 64 + r32] = f / den;
        asm volatile("s_waitcnt lgkmcnt(0)" ::: "memory");
#pragma unroll
        for (int r = 0; r < 16; ++r) { const float sc = wsf[sb * 64 + crow(r, hi)]; const int orow = crow(r, hi);
            stg[orow * 64 + r32] = (bf16_t)f2bf(o[sb][0][r] * sc); stg[orow * 64 + 32 + r32] = (bf16_t)f2bf(o[sb][1][r] * sc); }
        asm volatile("s_waitcnt lgkmcnt(0)" ::: "memory");
#pragma unroll
        for (int i = 0; i < 4; ++i) { const int row = i * 8 + (lane >> 3), ch = lane & 7; const u32x4 v = *(const LAS u32x4*)(stg + row * 64 + ch * 8); *(u32x4*)(O + (size_t)(qrow0 + 32 * sb + row) * ldo + head * 64 + ch * 8) = v; }
        asm volatile("s_waitcnt lgkmcnt(0)" ::: "memory");
    }
    __syncthreads();
}

constexpr int G_V = 0, G_ST = 65536, G_STW = 8704, G_MU = G_ST + 8 * G_STW;
__device__ __forceinline__ void gmlp_unit(int task, bf16_t* Y, bf16_t* YO, int ldo, const bf16_t* VA, const bf16_t* WSP, const f32x2* STATS, const float* ln_g, const float* ln_b, const float* b_sp, LAS unsigned char* lds) {
    const int tid = threadIdx.x, lane = tid & 63, r32 = lane & 31, hi = lane >> 5, wid = __builtin_amdgcn_readfirstlane(tid >> 6);
    const int r0 = task * 128;
    LAS float* mu = (LAS float*)(lds + G_MU); LAS float* rs = mu + 128;
    if (tid < 128) {
        const f32x4* sp = (const f32x4*)(STATS + (size_t)(r0 + tid) * 16); float s = 0.f, ss = 0.f;
#pragma unroll
        for (int i = 0; i < 8; ++i) { const f32x4 v = sp[i]; s += v.x + v.z; ss += v.y + v.w; }
        const float mean = s * (1.f / 1024.f), var = fmaxf(ss * (1.f / 1024.f) - mean * mean, 0.f);
        mu[tid] = mean; rs[tid] = 1.0f / sqrtf(var + EPS);
    }
    u32x4 raw[4];
#pragma unroll
    for (int i = 0; i < 4; ++i) { const int idx = tid + NTHREADS * i, q = idx >> 4, c8 = idx & 15; raw[i] = *(const u32x4*)(VA + (size_t)(r0 + q) * 1024 + c8 * 8); }
    __syncthreads();
    const int pb = wid >> 1, dh = wid & 1;
    LAS float* st = (LAS float*)(lds + G_ST + wid * G_STW);
    for (int g8 = 0; g8 < 8; ++g8) {
        LAS unsigned char* vb = lds + G_V + (g8 & 1) * 32768;
#pragma unroll
        for (int i = 0; i < 4; ++i) {
            const int idx = tid + NTHREADS * i, q = idx >> 4, c8 = idx & 15, d = c8 * 8;
            const f32x4 g0 = *(const f32x4*)(ln_g + g8 * 128 + d), g1 = *(const f32x4*)(ln_g + g8 * 128 + d + 4), b0 = *(const f32x4*)(ln_b + g8 * 128 + d), b1 = *(const f32x4*)(ln_b + g8 * 128 + d + 4);
            const float mq = mu[q], rq = rs[q]; const u32x4 rw = raw[i];
            float v[8] = {bf2f(rw.x & 0xffffu), bf2f(rw.x >> 16), bf2f(rw.y & 0xffffu), bf2f(rw.y >> 16), bf2f(rw.z & 0xffffu), bf2f(rw.z >> 16), bf2f(rw.w & 0xffffu), bf2f(rw.w >> 16)};
#pragma unroll
            for (int e = 0; e < 4; ++e) { v[e] = (v[e] - mq) * rq * g0[e] + b0[e]; v[4 + e] = (v[4 + e] - mq) * rq * g1[e] + b1[e]; }
            u32x4 w; w.x = pk2(v[0], v[1]); w.y = pk2(v[2], v[3]); w.z = pk2(v[4], v[5]); w.w = pk2(v[6], v[7]);
            *(LAS u32x4*)(vb + ((d >> 5) * 8 + (q >> 4)) * 1024 + (q & 15) * 64 + (d & 31) * 2) = w;
        }
        if (g8 + 1 < 8) {
#pragma unroll
            for (int i = 0; i < 4; ++i) { const int idx = tid + NTHREADS * i, q = idx >> 4, c8 = idx & 15; raw[i] = *(const u32x4*)(VA + (size_t)(r0 + q) * 1024 + (g8 + 1) * 128 + c8 * 8); }
        }
        u32x4 ur[4]; bf16x8 af[8];
        const size_t ybase = (size_t)(r0 + 32 * pb + (lane >> 3)) * 2048 + g8 * 128 + 64 * dh + (lane & 7) * 8;
#pragma unroll
        for (int i = 0; i < 4; ++i) ur[i] = *(const u32x4*)(Y + ybase + (size_t)(8 * i) * 2048);
        const bf16_t* wrow = WSP + (size_t)g8 * 16384 + (size_t)(32 * pb + r32) * 128 + 8 * hi;
#pragma unroll
        for (int ks = 0; ks < 8; ++ks) af[ks] = *(const bf16x8*)(wrow + 16 * ks);
        __syncthreads();
        const lds_cptr Vb = (lds_cptr)vb + ((lane >> 4) & 1) * 32 + (lane & 3) * 8 + (8 * hi + ((lane & 15) >> 2)) * 64;
        f32x16 acc[2];
#pragma unroll
        for (int t2 = 0; t2 < 2; ++t2)
#pragma unroll
            for (int r = 0; r < 16; ++r) acc[t2][r] = 0.f;
#pragma unroll
        for (int ks = 0; ks < 8; ++ks) {
#pragma unroll
            for (int t2 = 0; t2 < 2; ++t2) {
                const int db = 2 * dh + t2;
                const s16x4 vlo = vtr(Vb + (db * 8 + ks) * 1024), vhi = vtr(Vb + (db * 8 + ks) * 1024 + 256);
                acc[t2] = __builtin_amdgcn_mfma_f32_32x32x16_bf16(af[ks], pk8(vlo, vhi), acc[t2], 0, 0, 0);
            }
        }
#pragma unroll
        for (int t2 = 0; t2 < 2; ++t2)
#pragma unroll
            for (int r = 0; r < 16; ++r) st[crow(r, hi) * 68 + 32 * t2 + r32] = acc[t2][r];
        asm volatile("s_waitcnt lgkmcnt(0)" ::: "memory");
#pragma unroll
        for (int i = 0; i < 4; ++i) {
            const int prow = 8 * i + (lane >> 3), ch = lane & 7;
            const f32x4 m0 = *(const LAS f32x4*)(st + prow * 68 + ch * 8), m1 = *(const LAS f32x4*)(st + prow * 68 + ch * 8 + 4);
            const float bs = b_sp[g8 * 128 + 32 * pb + prow]; const u32x4 uw = ur[i];
            u32x4 o;
            o.x = pk2(bf2f(uw.x & 0xffffu) * (m0.x + bs), bf2f(uw.x >> 16) * (m0.y + bs)); o.y = pk2(bf2f(uw.y & 0xffffu) * (m0.z + bs), bf2f(uw.y >> 16) * (m0.w + bs));
            o.z = pk2(bf2f(uw.z & 0xffffu) * (m1.x + bs), bf2f(uw.z >> 16) * (m1.y + bs)); o.w = pk2(bf2f(uw.w & 0xffffu) * (m1.z + bs), bf2f(uw.w >> 16) * (m1.w + bs));
            *(u32x4*)(YO + (size_t)(r0 + 32 * pb + prow) * ldo + g8 * 128 + 64 * dh + ch * 8) = o;
        }
        asm volatile("s_waitcnt lgkmcnt(0)" ::: "memory");
    }
    __syncthreads();
}
}

namespace att2 {
typedef short bf16x8 __attribute__((ext_vector_type(8)));
typedef short s16x4 __attribute__((ext_vector_type(4)));
typedef float f32x16 __attribute__((ext_vector_type(16)));
typedef __attribute__((address_space(3))) const char* lds_cptr;
typedef short v4i16_t __attribute__((ext_vector_type(4)));
__device__ __forceinline__ int crow(int r, int hi) { return (r & 3) + 8 * (r >> 2) + 4 * hi; }
#define SBAR() __builtin_amdgcn_sched_barrier(0)
constexpr int NSLOT = 3, SLOTB = 8192;
constexpr int LDS_K = 0, LDS_V = NSLOT * SLOTB, LDS_WS = 2 * NSLOT * SLOTB, LDS_OST = LDS_WS + 8 * 64 * 4, LDS_BYTES = LDS_OST + 8 * 4096;
__device__ __forceinline__ void glds16(const void* gsrc, unsigned lds_dst) { unsigned keep;
    asm volatile("s_mov_b32 %0, m0\n\ts_mov_b32 m0, %2\n\ts_nop 0\n\tglobal_load_lds_dwordx4 %1, off\n\ts_mov_b32 m0, %0" : "=&s"(keep) : "v"(gsrc), "s"(lds_dst) : "memory"); }
__device__ __forceinline__ float max3f(float a, float b, float c) { float r; asm("v_max3_f32 %0, %1, %2, %3" : "=v"(r) : "v"(a), "v"(b), "v"(c)); return r; }
__device__ __forceinline__ float max2f(float a, float b) { float r; asm("v_max_f32_e32 %0, %1, %2" : "=v"(r) : "v"(a), "v"(b)); return r; }
__device__ __forceinline__ float fadd_s(float a, float b) { float r; asm("v_add_f32_e32 %0, %1, %2" : "=v"(r) : "v"(a), "v"(b)); return r; }
__device__ __forceinline__ float fsub_s(float a, float b) { float r; asm("v_sub_f32_e32 %0, %1, %2" : "=v"(r) : "v"(a), "v"(b)); return r; }
typedef float f32x2_t __attribute__((ext_vector_type(2))); typedef __bf16 bf16x2_t __attribute__((ext_vector_type(2)));
__device__ __forceinline__ unsigned cvtpk_s(float lo, float hi) { f32x2_t v = {lo, hi}; bf16x2_t b = __builtin_convertvector(v, bf16x2_t); return __builtin_bit_cast(unsigned, b); }
#define WAIT_BAR(N) asm volatile("s_waitcnt vmcnt(" #N ") lgkmcnt(0)\n\ts_barrier" ::: "memory")
__device__ __forceinline__ void qkt(f32x16& p0, f32x16& p1, lds_cptr Kslot, const bf16x8* qr, const f32x16& negm, int r32, int hi) {
    const lds_cptr kb = Kslot + hi * 1024 + r32 * 16;
#pragma unroll
    for (int d0 = 0; d0 < 4; ++d0) {
        const bf16x8 b0 = *(const __attribute__((address_space(3))) bf16x8*)(kb + d0 * 2048);
        const bf16x8 b1 = *(const __attribute__((address_space(3))) bf16x8*)(kb + d0 * 2048 + 512);
        if (d0 == 0) { p0 = __builtin_amdgcn_mfma_f32_32x32x16_bf16(b0, qr[0], negm, 0, 0, 0); p1 = __builtin_amdgcn_mfma_f32_32x32x16_bf16(b1, qr[0], negm, 0, 0, 0); }
        else { p0 = __builtin_amdgcn_mfma_f32_32x32x16_bf16(b0, qr[d0], p0, 0, 0, 0); p1 = __builtin_amdgcn_mfma_f32_32x32x16_bf16(b1, qr[d0], p1, 0, 0, 0); }
    }
}
__device__ __forceinline__ void kload8(bf16x8* kf, lds_cptr kp) {
    kf[0] = *(const __attribute__((address_space(3))) bf16x8*)(kp);        kf[1] = *(const __attribute__((address_space(3))) bf16x8*)(kp + 512);
    kf[2] = *(const __attribute__((address_space(3))) bf16x8*)(kp + 2048); kf[3] = *(const __attribute__((address_space(3))) bf16x8*)(kp + 2560);
    kf[4] = *(const __attribute__((address_space(3))) bf16x8*)(kp + 4096); kf[5] = *(const __attribute__((address_space(3))) bf16x8*)(kp + 4608);
    kf[6] = *(const __attribute__((address_space(3))) bf16x8*)(kp + 6144); kf[7] = *(const __attribute__((address_space(3))) bf16x8*)(kp + 6656);
}
__device__ __forceinline__ void kload2(bf16x8* kf, lds_cptr kp, int j) { kf[2 * j] = *(const __attribute__((address_space(3))) bf16x8*)(kp + j * 2048); kf[2 * j + 1] = *(const __attribute__((address_space(3))) bf16x8*)(kp + j * 2048 + 512); }
__device__ __forceinline__ s16x4 vtr(lds_cptr p) { return __builtin_bit_cast(s16x4, __builtin_amdgcn_ds_read_tr16_b64_v4i16((__attribute__((address_space(3))) v4i16_t*)p)); }
__device__ __forceinline__ float rowmax(const f32x16& p0, const f32x16& p1) {
    float a = max3f(p0[0], p0[1], p1[0]), b = max3f(p0[2], p0[3], p1[1]); a = max3f(a, p1[2], p1[3]);
#pragma unroll
    for (int r = 4; r < 16; r += 4) { a = max3f(a, p0[r], p0[r + 1]); b = max3f(b, p0[r + 2], p0[r + 3]); a = max3f(a, p1[r], p1[r + 1]); b = max3f(b, p1[r + 2], p1[r + 3]); }
    const float m = max2f(a, b);
    auto rr = __builtin_amdgcn_permlane32_swap(__float_as_uint(m), __float_as_uint(m), false, false);
    return max2f(__uint_as_float(rr[0]), __uint_as_float(rr[1]));
}
__device__ __forceinline__ void pv(f32x16* o, int vb, bf16x8 pa0, bf16x8 pa1, bf16x8 pa2, bf16x8 pa3) {
#pragma unroll
    for (int d0 = 0; d0 < 2; ++d0) { s16x4 lo[4], hi[4];
#pragma unroll
        for (int ks = 0; ks < 4; ++ks) {
            asm volatile("ds_read_b64_tr_b16 %0,%1 offset:%c2" : "=&v"(lo[ks]) : "v"(vb), "i"(d0 * 4096 + ks * 1024) : "memory");
            asm volatile("ds_read_b64_tr_b16 %0,%1 offset:%c2" : "=&v"(hi[ks]) : "v"(vb), "i"(d0 * 4096 + ks * 1024 + 512) : "memory"); }
        asm volatile("s_waitcnt lgkmcnt(0)" ::: "memory"); SBAR();
#define PK(k) (bf16x8){lo[k][0], lo[k][1], lo[k][2], lo[k][3], hi[k][0], hi[k][1], hi[k][2], hi[k][3]}
        o[d0] = __builtin_amdgcn_mfma_f32_32x32x16_bf16(pa0, PK(0), o[d0], 0, 0, 0);
        o[d0] = __builtin_amdgcn_mfma_f32_32x32x16_bf16(pa1, PK(1), o[d0], 0, 0, 0);
        o[d0] = __builtin_amdgcn_mfma_f32_32x32x16_bf16(pa2, PK(2), o[d0], 0, 0, 0);
        o[d0] = __builtin_amdgcn_mfma_f32_32x32x16_bf16(pa3, PK(3), o[d0], 0, 0, 0);
#undef PK
    }
}
__device__ __forceinline__ void wmask(f32x16& p0, f32x16& p1, int dl, int r32, int hi) {
    const float NEG = -INFINITY;
#pragma unroll
    for (int r = 0; r < 16; ++r) { const int rel = dl + crow(r, hi) - r32; if (rel < -128 || rel > 128) p0[r] = NEG; if (rel + 32 < -128 || rel + 32 > 128) p1[r] = NEG; }
}

template <int THRL> __device__ __forceinline__ void attn_unit(int b, int n, int kvh, int hp, int base, bool primed, bool has_next, int nb, int nn, int nkvh, int nhp, bf16x8 (&qr)[4], int& nbase,
                                                              const bf16_t* Y, bf16_t* O, int ldo, const bf16_t* KB, const bf16_t* VB, const float* sink, LAS unsigned char* shm) {
    const int tid = threadIdx.x, lane = tid & 63, r32 = lane & 31, hi = lane >> 5; const int wid = __builtin_amdgcn_readfirstlane(tid >> 6);
    const int head = kvh * 4 + hp * 2 + (wid >> 2), qsub = wid & 3;
    const long qrow0 = (long)b * SEQ + n * 128 + qsub * 32;
    const bf16_t* Qw = Y + qrow0 * 2048 + 1024 + head * 64;
    const unsigned lds0 = (unsigned)(uintptr_t)shm;
    LAS float* wsf = (LAS float*)(shm + LDS_WS) + wid * 64;
    const long koff = (long)lane * 256 + kvh * 64 + wid * 8;
    const long voff = (long)(16 * (wid & 3) + (lane >> 2)) * 256 + kvh * 64 + (wid >> 2) * 32 + (lane & 3) * 8;
    const unsigned kdst = lds0 + LDS_K + wid * 1024, vdst = lds0 + LDS_V + wid * 1024;
    const int jlo = (n == 0) ? 2 : 0, jhi = (n == 31) ? 3 : 5, NT = 4 + (jhi - jlo + 1);
    const long lrow0 = (long)b * SEQ + (n - 1) * 128 + 64 * (jlo - 4), crow0 = (long)NTOK + b * CTXL;
#define TROW(t) ((t) < 4 ? crow0 + 64 * (t) : lrow0 + 64 * (t))
#define DMA_K(t, slot) glds16(KB + TROW(t) * 256 + koff, (unsigned)__builtin_amdgcn_readfirstlane(kdst + (slot)))
#define DMA_V(t, slot) glds16(VB + TROW(t) * 256 + voff, (unsigned)__builtin_amdgcn_readfirstlane(vdst + (slot)))
    const int vb0 = (int)(lds0 + LDS_V) + ((lane >> 4) & 1) * 32 + (lane & 3) * 8 + (4 * hi + ((lane & 15) >> 2)) * 64;
    bf16x8 kf[8];
    const lds_cptr shm3 = (lds_cptr)shm; const lds_cptr kp0 = shm3 + LDS_K + hi * 1024 + r32 * 16; const lds_cptr vp0 = shm3 + LDS_V + ((lane >> 4) & 1) * 32 + (lane & 3) * 8 + (4 * hi + ((lane & 15) >> 2)) * 64;
    const int s0 = base, s1 = (s0 == (NSLOT - 1) * SLOTB) ? 0 : s0 + SLOTB, s2 = (s1 == (NSLOT - 1) * SLOTB) ? 0 : s1 + SLOTB;
    if (!primed) {
        DMA_K(0, s0); DMA_V(0, s0); DMA_K(1, s1); DMA_K(2, s2);
#pragma unroll
        for (int d0 = 0; d0 < 4; ++d0) qr[d0] = *(const bf16x8*)(Qw + (long)r32 * 2048 + d0 * 16 + hi * 8);
    }
    float mhat = 0.f, l_reg = 0.f; f32x16 o[2]; o[0] = f32x16{}; o[1] = f32x16{}; f32x16 negm = f32x16{}; asm volatile("" : "+v"(negm));
    const int dq = -128 - 32 * qsub;
#define CMASK(P0, P1, t) do { if ((t) >= 4) { const int dl_ = 64 * (jlo + (t) - 4) + dq; if (dl_ < -97 || dl_ > 65) wmask(P0, P1, dl_, r32, hi); } } while (0)
    bool resc = false;
#define START(P0, P1) do { const float rm = rowmax(P0, P1); resc = false; \
    { const float dl = rm; mhat = fadd_s(mhat, dl); \
      _Pragma("unroll") for (int r = 0; r < 16; ++r) { P0[r] = fsub_s(P0[r], dl); P1[r] = fsub_s(P1[r], dl); } \
      _Pragma("unroll") for (int r = 0; r < 16; ++r) negm[r] = -mhat; asm volatile("" : "+v"(negm)); } \
    _Pragma("unroll") for (int r = 0; r < 16; ++r) P0[r] = __builtin_amdgcn_exp2f(P0[r]); } while (0)
#define RESC() do { if (resc) { asm volatile("s_waitcnt lgkmcnt(0)" ::: "memory"); \
      _Pragma("unroll") for (int d_ = 0; d_ < 2; ++d_) _Pragma("unroll") for (int r = 0; r < 16; ++r) o[d_][r] *= wsf[crow(r, hi)]; } } while (0)
    f32x16 pA0, pA1, pB0, pB1;
    int sl_prev = s0, sl_cur = s0, sl_next = s1;
#define ROT() do { sl_prev = sl_cur; sl_cur = sl_next; sl_next = (sl_next == (NSLOT - 1) * SLOTB) ? 0 : sl_next + SLOTB; } while (0)
    WAIT_BAR(7);
    qkt(pA0, pA1, shm3 + LDS_K + s0, qr, negm, r32, hi); asm volatile("s_nop 15\n\ts_nop 7" : "+v"(pA0), "+v"(pA1)); CMASK(pA0, pA1, 0);
    START(pA0, pA1);
    _Pragma("unroll") for (int r = 0; r < 16; ++r) pA1[r] = __builtin_amdgcn_exp2f(pA1[r]);
    WAIT_BAR(0);
    DMA_K(3, s0); DMA_V(1, s1);
    ROT();
    kload8(kf, kp0 + sl_cur);
    WAIT_BAR(2);
    s16x4 vlo[8], vhi[8]; u32x4 pw0, pw1, pw2, pw3;
#define PKW(P, B) cvtpk_s(P[B], P[B + 1])
#define PAF(k) __builtin_bit_cast(bf16x8, pw##k)
#define VFR(i) (bf16x8){vlo[i][0], vlo[i][1], vlo[i][2], vlo[i][3], vhi[i][0], vhi[i][1], vhi[i][2], vhi[i][3]}
#define PIN(x) asm volatile("" : "+v"(x))
#define MX3(a, b, c) __builtin_fmaxf(__builtin_fmaxf((a), (b)), (c))
#define GAPA(MF, A0, A1, A2, A3, W0, W1, PW) do { MF; sacc += A0; sacc += A1; sacc += A2; sacc += A3; PIN(sacc); W0; W1; PIN(PW); SBAR(); } while (0)
#define EX(v) __builtin_amdgcn_exp2f(v)
#define GAPB(MF, X, B) do { MF; X[B] = EX(X[B]); X[B + 1] = EX(X[B + 1]); X[B + 2] = EX(X[B + 2]); X[B + 3] = EX(X[B + 3]); PIN(X); SBAR(); } while (0)
#define VRD(i) do { vlo[i] = vtr(vp_ + (((i) >> 2) * 4096 + ((i) & 3) * 1024)); vhi[i] = vtr(vp_ + (((i) >> 2) * 4096 + ((i) & 3) * 1024 + 512)); } while (0)
#define KRD(G, j) do { if (G) { kload2(kf, kp0 + sl_next, j); SBAR(); } } while (0)
#define STEP(C0, C1, P0, P1, t, GK, GV, GL) do { SBAR(); \
    const lds_cptr vp_ = vp0 + sl_prev; \
    VRD(0); SBAR(); float sacc = (P0[0] + P0[1]); \
    GAPA(C0 = __builtin_amdgcn_mfma_f32_32x32x16_bf16(kf[0], qr[0], negm, 0, 0, 0), P0[2], P0[3], P0[4], P0[5],     pw0[0] = PKW(P0, 0), pw0[1] = PKW(P0, 2), pw0); \
    VRD(4); SBAR(); GAPA(C1 = __builtin_amdgcn_mfma_f32_32x32x16_bf16(kf[1], qr[0], negm, 0, 0, 0), P0[6], P0[7], P0[8], P0[9],     pw0[2] = PKW(P0, 4), pw0[3] = PKW(P0, 6), pw0); \
    VRD(1); SBAR(); GAPA(C0 = __builtin_amdgcn_mfma_f32_32x32x16_bf16(kf[2], qr[1], C0, 0, 0, 0),   P0[10], P0[11], P0[12], P0[13], pw1[0] = PKW(P0, 8), pw1[1] = PKW(P0, 10), pw1); \
    VRD(5); SBAR(); GAPA(C1 = __builtin_amdgcn_mfma_f32_32x32x16_bf16(kf[3], qr[1], C1, 0, 0, 0),   P0[14], P0[15], P1[0], P1[1],   pw1[2] = PKW(P0, 12), pw1[3] = PKW(P0, 14), pw1); \
    VRD(2); SBAR(); GAPA(C0 = __builtin_amdgcn_mfma_f32_32x32x16_bf16(kf[4], qr[2], C0, 0, 0, 0),   P1[2], P1[3], P1[4], P1[5],     pw2[0] = PKW(P1, 0), pw2[1] = PKW(P1, 2), pw2); \
    VRD(6); SBAR(); GAPA(C1 = __builtin_amdgcn_mfma_f32_32x32x16_bf16(kf[5], qr[2], C1, 0, 0, 0),   P1[6], P1[7], P1[8], P1[9],     pw2[2] = PKW(P1, 4), pw2[3] = PKW(P1, 6), pw2); \
    VRD(3); SBAR(); GAPA(C0 = __builtin_amdgcn_mfma_f32_32x32x16_bf16(kf[6], qr[3], C0, 0, 0, 0),   P1[10], P1[11], P1[12], P1[13], pw3[0] = PKW(P1, 8), pw3[1] = PKW(P1, 10), pw3); \
    VRD(7); SBAR(); GAPA(C1 = __builtin_amdgcn_mfma_f32_32x32x16_bf16(kf[7], qr[3], C1, 0, 0, 0),   P1[14], P1[15], 0.f, 0.f,       pw3[2] = PKW(P1, 12), pw3[3] = PKW(P1, 14), pw3); \
    l_reg += sacc; \
    if (GK) { DMA_K((t) + 3, sl_cur); } if (GV) { DMA_V((t) + 1, sl_next); } \
    CMASK(C0, C1, t); \
    { float a = MX3(C0[0], C0[1], C1[0]), b2 = MX3(C0[2], C0[3], C1[1]); a = MX3(a, C1[2], C1[3]); \
      _Pragma("unroll") for (int r = 4; r < 16; r += 4) { a = MX3(a, C0[r], C0[r + 1]); b2 = MX3(b2, C0[r + 2], C0[r + 3]); a = MX3(a, C1[r], C1[r + 1]); b2 = MX3(b2, C1[r + 2], C1[r + 3]); } \
      float rm = __builtin_fmaxf(a, b2); { auto rr = __builtin_amdgcn_permlane32_swap(__float_as_uint(rm), __float_as_uint(rm), false, false); rm = __builtin_fmaxf(__uint_as_float(rr[0]), __uint_as_float(rr[1])); } \
      resc = false; \
      if (__builtin_expect(__any(rm > (float)THRL), 0)) { const float dl = __builtin_fmaxf(rm, 0.f); mhat += dl; \
        _Pragma("unroll") for (int r = 0; r < 16; ++r) { C0[r] -= dl; C1[r] -= dl; } \
        _Pragma("unroll") for (int r = 0; r < 16; ++r) negm[r] = -mhat; asm volatile("" : "+v"(negm)); \
        const float f = __builtin_amdgcn_exp2f(-dl); l_reg *= f; if (hi == 0) wsf[r32] = f; resc = true; } } \
    SBAR(); \
    GAPB(o[0] = __builtin_amdgcn_mfma_f32_32x32x16_bf16(PAF(0), VFR(0), o[0], 0, 0, 0), C0, 0); \
    GAPB(o[1] = __builtin_amdgcn_mfma_f32_32x32x16_bf16(PAF(0), VFR(4), o[1], 0, 0, 0), C0, 4); \
    KRD(GL, 0); GAPB(o[0] = __builtin_amdgcn_mfma_f32_32x32x16_bf16(PAF(1), VFR(1), o[0], 0, 0, 0), C0, 8); \
    KRD(GL, 1); GAPB(o[1] = __builtin_amdgcn_mfma_f32_32x32x16_bf16(PAF(1), VFR(5), o[1], 0, 0, 0), C0, 12); \
    KRD(GL, 2); GAPB(o[0] = __builtin_amdgcn_mfma_f32_32x32x16_bf16(PAF(2), VFR(2), o[0], 0, 0, 0), C1, 0); \
    KRD(GL, 3); GAPB(o[1] = __builtin_amdgcn_mfma_f32_32x32x16_bf16(PAF(2), VFR(6), o[1], 0, 0, 0), C1, 4); \
    GAPB(o[0] = __builtin_amdgcn_mfma_f32_32x32x16_bf16(PAF(3), VFR(3), o[0], 0, 0, 0), C1, 8); \
    GAPB(o[1] = __builtin_amdgcn_mfma_f32_32x32x16_bf16(PAF(3), VFR(7), o[1], 0, 0, 0), C1, 12); \
    } while (0)
#define ENDW(tt) do { if ((tt) + 3 < NT) { WAIT_BAR(2); } else if ((tt) + 2 < NT) { WAIT_BAR(1); } else { WAIT_BAR(0); } } while (0)
    int t = 1;
    for (; t + 1 < NT; t += 2) {
        STEP(pB0, pB1, pA0, pA1, t, (t + 3 < NT), (t + 1 < NT), (t + 1 < NT));       ENDW(t);     RESC(); ROT();
        STEP(pA0, pA1, pB0, pB1, t + 1, (t + 4 < NT), (t + 2 < NT), (t + 2 < NT));   ENDW(t + 1); RESC(); ROT();
    }
    nbase = sl_next;
    if (has_next) {
        const long nr = (long)NTOK + nb * CTXL; const long nko = (long)lane * 256 + nkvh * 64 + wid * 8, nvo = (long)(16 * (wid & 3) + (lane >> 2)) * 256 + nkvh * 64 + (wid >> 2) * 32 + (lane & 3) * 8;
        const int n0 = sl_next, n1 = (n0 == (NSLOT - 1) * SLOTB) ? 0 : n0 + SLOTB, n2 = (n1 == (NSLOT - 1) * SLOTB) ? 0 : n1 + SLOTB;
        glds16(KB + nr * 256 + nko, (unsigned)__builtin_amdgcn_readfirstlane(kdst + n0)); glds16(VB + nr * 256 + nvo, (unsigned)__builtin_amdgcn_readfirstlane(vdst + n0));
        glds16(KB + (nr + 64) * 256 + nko, (unsigned)__builtin_amdgcn_readfirstlane(kdst + n1)); glds16(KB + (nr + 128) * 256 + nko, (unsigned)__builtin_amdgcn_readfirstlane(kdst + n2));
    }
    STEP(pB0, pB1, pA0, pA1, NT - 1, false, false, false); RESC();
    { float sacc = pB0[0] + pB0[1]; _Pragma("unroll") for (int r = 2; r < 16; ++r) sacc += pB0[r]; _Pragma("unroll") for (int r = 0; r < 16; ++r) sacc += pB1[r]; l_reg += sacc;
      pw0 = (u32x4){PKW(pB0, 0), PKW(pB0, 2), PKW(pB0, 4), PKW(pB0, 6)}; pw1 = (u32x4){PKW(pB0, 8), PKW(pB0, 10), PKW(pB0, 12), PKW(pB0, 14)}; pw2 = (u32x4){PKW(pB1, 0), PKW(pB1, 2), PKW(pB1, 4), PKW(pB1, 6)}; pw3 = (u32x4){PKW(pB1, 8), PKW(pB1, 10), PKW(pB1, 12), PKW(pB1, 14)};
      SBAR(); pv(o, vb0 + sl_cur, PAF(0), PAF(1), PAF(2), PAF(3)); }
    if (has_next) {
        asm volatile("" ::: "memory");
        const bf16_t* nQw = Y + ((long)nb * SEQ + nn * 128 + qsub * 32) * 2048 + 1024 + (nkvh * 4 + nhp * 2 + (wid >> 2)) * 64;
#pragma unroll
        for (int d0 = 0; d0 < 4; ++d0) qr[d0] = *(const bf16x8*)(nQw + (long)r32 * 2048 + d0 * 16 + hi * 8);
    }
    { auto rr = __builtin_amdgcn_permlane32_swap(__float_as_uint(l_reg), __float_as_uint(l_reg), false, false); l_reg = __uint_as_float(rr[0]) + __uint_as_float(rr[1]); }
    l_reg += __builtin_amdgcn_exp2f(fminf(sink[head] * LOG2E - mhat, 80.f));
    if (hi == 0) wsf[32 + r32] = l_reg; asm volatile("s_waitcnt lgkmcnt(0)" ::: "memory");
    float rli[16];
#pragma unroll
    for (int r = 0; r < 16; ++r) rli[r] = __builtin_amdgcn_rcpf(wsf[32 + crow(r, hi)]);
    bf16_t* Ow = O + qrow0 * ldo + head * 64;
    { LAS bf16_t* stg = (LAS bf16_t*)(shm + LDS_OST) + wid * 2048;
#pragma unroll
      for (int r = 0; r < 16; ++r) { const int orow = crow(r, hi);
#pragma unroll
          for (int d0 = 0; d0 < 2; ++d0) stg[orow * 64 + d0 * 32 + r32] = (bf16_t)(pk2(o[d0][r] * rli[r], 0.f) & 0xffffu); }
      asm volatile("s_waitcnt lgkmcnt(0)" ::: "memory");
#pragma unroll
      for (int i = 0; i < 4; ++i) { const int row = i * 8 + (lane >> 3), ch = lane & 7; const u32x4 v = *(const LAS u32x4*)(stg + row * 64 + ch * 8); *(u32x4*)(Ow + (long)row * ldo + ch * 8) = v; } }
    asm volatile("s_waitcnt lgkmcnt(0)\n\ts_barrier" ::: "memory");
#undef TROW
#undef DMA_K
#undef DMA_V
#undef CMASK
#undef START
#undef RESC
#undef ROT
#undef PKW
#undef PAF
#undef VFR
#undef PIN
#undef MX3
#undef GAPA
#undef GAPB
#undef EX
#undef VRD
#undef KRD
#undef STEP
#undef ENDW
}
#undef SBAR
#undef WAIT_BAR
}

#define XB_TMO      128
#define XB_XCNT(j)  (256  + 64 * (j))
#define XB_XSUB(j)  (1280 + 64 * (j))
#define XB_XGEN(j)  (2304 + 64 * (j))
#define XB_TOP      3328
#define XB_TOPGEN   3392
#define XCD_BAR_WORDS 3456
#define XB_SPIN_CAP (1u << 18)
__device__ __forceinline__ unsigned xb_ld(unsigned* p)              { return __hip_atomic_load(p, __ATOMIC_RELAXED, __HIP_MEMORY_SCOPE_AGENT); }
__device__ __forceinline__ unsigned xb_add(unsigned* p, unsigned v) { return __hip_atomic_fetch_add(p, v, __ATOMIC_RELAXED, __HIP_MEMORY_SCOPE_AGENT); }
__device__ __forceinline__ unsigned xb_xcc_id() { return (unsigned)__builtin_amdgcn_s_getreg((3 << 11) | 20) & 0xFu; }
#define XB_SPIN(cond, bar) do { unsigned _sp = 0; while (cond) { __builtin_amdgcn_s_sleep(1); \
    if ((++_sp & 255u) == 0u) { if (xb_ld(&(bar)[XB_TMO])) break; if (_sp > XB_SPIN_CAP) { atomicAdd(&(bar)[XB_TMO], 1u); break; } } } } while (0)
struct XcdBarrier { unsigned* bar; unsigned x; volatile LAS unsigned* st; };
__device__ __forceinline__ XcdBarrier xcd_barrier_post(unsigned* bar, volatile LAS unsigned* st) {
    XcdBarrier b; b.bar = bar; b.x = xb_xcc_id(); b.st = st;
    if (threadIdx.x == 0) (void)xb_add(&bar[XB_XCNT(b.x)], 1u);
    return b;
}
__device__ __forceinline__ void xcd_barrier_complete(unsigned* bar, unsigned x, unsigned& nloc, unsigned& nx) {
    const unsigned G = gridDim.x * gridDim.y * gridDim.z;
    unsigned sum, cnt, mine, sp = 0u;
    for (;;) {
        sum = 0u; cnt = 0u; mine = 0u;
#pragma unroll
        for (unsigned j = 0; j < 16; ++j) { const unsigned c = xb_ld(&bar[XB_XCNT(j)]); sum += c; cnt += (c > 0u) ? 1u : 0u; mine = (j == x) ? c : mine; }
        if (sum == G) break;
        __builtin_amdgcn_s_sleep(1);
        if ((++sp & 255u) == 0u) { if (xb_ld(&bar[XB_TMO])) break; if (sp > XB_SPIN_CAP) { atomicAdd(&bar[XB_TMO], 1u); break; } }
    }
    nloc = mine > 0u ? mine : 1u; nx = cnt > 0u ? cnt : 1u;
}
__device__ __forceinline__ void xcd_barrier(const XcdBarrier& b) {
    asm volatile("s_waitcnt vmcnt(0)" ::: "memory");
    __syncthreads();
    if (threadIdx.x == 0) {
        unsigned* bar = b.bar;
        __builtin_amdgcn_s_waitcnt(0);
        unsigned nloc = b.st[0], nx = b.st[1];
        if (nloc == 0u) { xcd_barrier_complete(bar, b.x, nloc, nx); b.st[0] = nloc; b.st[1] = nx; }
        const unsigned old = xb_add(&bar[XB_XSUB(b.x)], 1u);
        const unsigned gen = old / nloc;
        if (old + 1u == (gen + 1u) * nloc) {
            __builtin_amdgcn_fence(__ATOMIC_RELEASE, "agent");
            asm volatile("s_waitcnt vmcnt(0)" ::: "memory");
            const unsigned og = xb_add(&bar[XB_TOP], 1u);
            const unsigned tg = og / nx;
            if (og + 1u == (tg + 1u) * nx) xb_add(&bar[XB_TOPGEN], 1u);
            else XB_SPIN(xb_ld(&bar[XB_TOPGEN]) == tg, bar);
            __builtin_amdgcn_fence(__ATOMIC_ACQUIRE, "agent");
            xb_add(&bar[XB_XGEN(b.x)], 1u);
            asm volatile("s_waitcnt vmcnt(0)" ::: "memory");
        } else {
            XB_SPIN(xb_ld(&bar[XB_XGEN(b.x)]) == gen, bar);
            __builtin_amdgcn_fence(__ATOMIC_ACQUIRE, "agent");
            asm volatile("s_waitcnt vmcnt(0)" ::: "memory");
        }
    }
    __syncthreads();
}
constexpr int LDSCTL_OFF = LDS_BYTES - 256;
constexpr int CW_BAR = 4096;

#ifndef PROBE_GMLP2
#define PROBE_GMLP2 0
#endif
#ifndef ATT_PIPE
#define ATT_PIPE 1
#endif
#ifndef ATT_THRL
#define ATT_THRL 8
#endif
#ifndef ONE_LAUNCH
#define ONE_LAUNCH 1
#endif
#ifndef FAST_MIX
#define FAST_MIX 1
#endif
#ifndef PROBE_SEQ
#define PROBE_SEQ 0, 1, 2, 3, 4, 5, 6, 7, 8, 9, 10, 11
#endif

enum { PH_PRO = 0, PH_HN, PH_IN, PH_MIX, PH_A, PH_O, PH_H2R, PH_WCONV, PH_TOPK, PH_GU, PH_D, PH_FIN, PH_COUNT };

__global__ void __launch_bounds__(NTHREADS, 2) fwd(Args args) {
    extern __shared__ __attribute__((aligned(16))) unsigned char lds_raw[];
    LAS unsigned char* lds = (LAS unsigned char*)lds_raw;
    const int tid = threadIdx.x, lane = tid & 63, wave = __builtin_amdgcn_readfirstlane(tid >> 6);
    const int G = gridDim.x, bid = blockIdx.x;
    unsigned char* ws = args.ws;
    const int lo = args.ph_lo, hi = args.ph_hi;
#define IN(k) (lo <= (k) && (k) < hi)
    float* MOD = (float*)(ws + WS_MOD); f32x2* ROPE = (f32x2*)(ws + WS_ROPE);
    float* AFFT = (float*)(ws + WS_AFFT); int* TOPI = (int*)(ws + WS_TOPI); float* TOPW = (float*)(ws + WS_TOPW); int* SLOT = (int*)(ws + WS_SLOT);
    bf16_t* WSP = (bf16_t*)(ws + WS_WSP); bf16_t* WIN = (bf16_t*)(ws + WS_WIN); bf16_t* WAB = (bf16_t*)(ws + WS_WAB); bf16_t* WO = (bf16_t*)(ws + WS_WO);
    bf16_t* H = (bf16_t*)(ws + WS_H); bf16_t* VA = (bf16_t*)(ws + WS_VA); bf16_t* KB = (bf16_t*)(ws + WS_KB); bf16_t* VB = (bf16_t*)(ws + WS_VB);
    bf16_t* GT = (bf16_t*)(ws + WS_G); bf16_t* Y = (bf16_t*)(ws + WS_Y); bf16_t* TMP = (bf16_t*)(ws + WS_TMP); bf16_t* MERGED = (bf16_t*)(ws + WS_MERGED);
    bf16_t* WGU = (bf16_t*)(ws + WS_WGU); bf16_t* WD = (bf16_t*)(ws + WS_WD); bf16_t* H2 = (bf16_t*)(ws + WS_H2); bf16_t* ACT = (bf16_t*)(ws + WS_ACT); bf16_t* YB = (bf16_t*)(ws + WS_YB);
    const int gw = bid * NWAVES + wave, NGW = G * NWAVES;
    if (tid < 64) ((LAS unsigned*)(lds + LDSCTL_OFF))[tid] = 0u;
    __syncthreads();
    XcdBarrier bar; bar.bar = (unsigned*)(ws + WS_CTL) + CW_BAR; bar.x = 0; bar.st = nullptr;
    if (ONE_LAUNCH) bar = xcd_barrier_post((unsigned*)(ws + WS_CTL) + CW_BAR, (volatile LAS unsigned*)(lds + LDSCTL_OFF));
#define SEAM(k) do { if (ONE_LAUNCH && IN(k) && IN((k) + 1)) xcd_barrier(bar); } while (0)

    if (IN(PH_PRO)) {
        if (bid < 192) adaln_task(bid, args.in[I_C], args.in[I_CCTX], args.in[I_WADA], args.in[I_BADA], MOD, (LAS float*)lds, tid);
        else if (bid == 192) rope_table(ROPE, tid);
        __syncthreads();
        for (int i = bid * NTHREADS + tid; i < 8 * 128 * 128 / 4; i += G * NTHREADS) st4bf(WSP + 4 * i, *(const f32x4*)(args.in[I_WSP] + 4 * i));
        LAS float* scr = (LAS float*)(lds + wave * 16384);
        constexpr int I_IN = 16 * 176, I_P = 16 * 32;
        for (int it = gw; it < I_IN + 3 * I_P; it += NGW) {
            int r = it;
            if (r < I_IN) { const int kb = r / 176, nb = r % 176, n0 = nb * 32; int drow = n0;
                if (n0 >= OFF_GATE) { const int gcol = n0 - OFF_GATE, isb = gcol >= 1024, ch = gcol & 1023; drow = OFF_GATE + 256 * (ch >> 7) + (ch & 127) + (isb ? 128 : 0); }
                transpose_item(args.in[I_WIN], INCOLS, kb * 64, n0, WIN + (size_t)drow * 1024 + kb * 64, 1024, scr, lane); continue; } r -= I_IN;
            if (r < I_P) { const int kb = r / 32, nb = r % 32; transpose_item(args.in[I_WPA], 1024, kb * 64, nb * 32, WAB + (size_t)(nb * 32) * 2048 + kb * 64, 2048, scr, lane); continue; } r -= I_P;
            if (r < I_P) { const int kb = r / 32, nb = r % 32; transpose_item(args.in[I_WPB], 1024, kb * 64, nb * 32, WAB + (size_t)(nb * 32) * 2048 + 1024 + kb * 64, 2048, scr, lane); continue; } r -= I_P;
            { const int kb = r / 32, nb = r % 32; transpose_item(args.in[I_WOUT], 1024, kb * 64, nb * 32, WO + (size_t)(nb * 32) * 1024 + kb * 64, 1024, scr, lane); }
        }
    }
    SEAM(PH_PRO);
    if (IN(PH_HN)) {
        const float* g1n = args.in[I_N1G];
        auto hn_row = [&](int row) {
            const float* xr; int mrow;
            if (row < NTOK) { xr = args.in[I_X] + (size_t)row * 1024; mrow = row >> 12; } else { xr = args.in[I_CTX] + (size_t)(row - NTOK) * 1024; mrow = 8; }
            const float* sh = MOD + mrow * 6144; const float* sc = sh + 1024;
            f32x4 v[4]; float ss = 0.f;
#pragma unroll
            for (int j = 0; j < 4; ++j) { v[j] = *(const f32x4*)(xr + 4 * lane + 256 * j); ss += (v[j].x * v[j].x + v[j].y * v[j].y) + (v[j].z * v[j].z + v[j].w * v[j].w); }
            const float rstd = 1.0f / sqrtf(wave_sum(ss) * (1.f / 1024.f) + EPS);
#pragma unroll
            for (int j = 0; j < 4; ++j) {
                const int col = 4 * lane + 256 * j;
                const f32x4 gv = *(const f32x4*)(g1n + col), scv = *(const f32x4*)(sc + col), shv = *(const f32x4*)(sh + col);
                const f32x4 h = (v[j] * rstd * gv) * (1.f + scv) + shv;
                st4bf(H + (size_t)row * 1024 + col, h);
            }
        };
        for (int row = gw; row < NROWS_H; row += NGW) hn_row(row);
    }
    SEAM(PH_HN);
    if (IN(PH_IN)) {
        Gemm g{H, WIN, 1024, 1024, 1024, 0, 30, nullptr}; StaticOrder S; S.init(NTOK, INCOLS, G, bid, 16);
        EpiIn E{Y, VA, KB, VB, GT, args.in[I_BMG], ROPE, (f32x2*)(ws + WS_STATS)};
        GEMM_PHASE<EpiIn, StaticOrder, false>(lds, g, S, E);
    }
    SEAM(PH_IN);
    if (IN(PH_MIX) && FAST_MIX) {
        if (!(args.flags & 8)) for (int task = bid; task < NB * 32; task += G) mix::gmlp_unit(task, Y, (args.flags & 2) ? TMP : Y, (args.flags & 2) ? 1024 : 2048, VA, WSP, (const f32x2*)(ws + WS_STATS), args.in[I_LNG], args.in[I_LNB], args.in[I_BSP], lds);
#if ATT_PIPE
        att2::bf16x8 att_qr[4]; int att_base = 0; bool att_primed = false;
#endif
        if (!(args.flags & 1)) for (int task = bid; task < NB * 32 * 4; task += G) {
#if ATT_PIPE
            for (int hp = 0; hp < 2; ++hp) {
                const bool more = (hp == 0) || (task + G < NB * 32 * 4); const int ntask = hp == 0 ? task : task + G; int nbase_ = 0;
                att2::attn_unit<ATT_THRL>(task >> 7, (task >> 2) & 31, task & 3, hp, att_base, att_primed, more, ntask >> 7, (ntask >> 2) & 31, ntask & 3, hp ^ 1, att_qr, nbase_,
                                          Y, (args.flags & 4) ? TMP : Y + 1024, (args.flags & 4) ? 1024 : 2048, KB, VB, args.in[I_SINK], lds);
                att_base = nbase_; att_primed = more;
            }
#else
            mix::attn_unit(task >> 7, (task >> 2) & 31, task & 3, Y, (args.flags & 4) ? TMP : Y + 1024, (args.flags & 4) ? 1024 : 2048, KB, VB, args.in[I_SINK], lds);
#endif
        }
    }
    SEAM(PH_MIX);
    if (IN(PH_A)) {
        Gemm g{Y, WAB, 2048, 2048, 2048, 0, 30, nullptr}; StaticOrder S; S.init(NTOK, 1024, G, bid, 0, 1);
        EpiAB E{MERGED, GT};
        GEMM_PHASE<EpiAB, StaticOrder, false, true>(lds, g, S, E);
    }
    SEAM(PH_A);
    if (IN(PH_O)) {
        Gemm g{MERGED, WO, 1024, 1024, 1024, 0, 30, nullptr}; StaticOrder S; S.init(NTOK, 1024, G, bid);
        EpiO E{(bf16_t*)args.out, MOD};
        GEMM_PHASE<EpiO, StaticOrder, false>(lds, g, S, E);
    }
    SEAM(PH_O);
    if (IN(PH_H2R)) {
        LAS float* wT = (LAS float*)lds;
        { f32x4 wv[8];
#pragma unroll
          for (int k = 0; k < 8; ++k) wv[k] = *(const f32x4*)(args.in[I_WR] + 4 * (tid + NTHREADS * k));
#pragma unroll
          for (int k = 0; k < 8; ++k) { const int f = tid + NTHREADS * k, col = f >> 2, e0 = 4 * (f & 3); wT[e0 * 1024 + col] = wv[k].x; wT[(e0 + 1) * 1024 + col] = wv[k].y; wT[(e0 + 2) * 1024 + col] = wv[k].z; wT[(e0 + 3) * 1024 + col] = wv[k].w; } }
        __syncthreads();
        const float* g2n = args.in[I_N2G];
        const bool h32 = lane & 32, h16 = lane & 16, h8 = lane & 8, h4 = lane & 4;
        const int myexp = 8 * (lane >> 5) + 4 * ((lane >> 4) & 1) + 2 * ((lane >> 3) & 1) + ((lane >> 2) & 1);
        const bf16_t* D16 = (const bf16_t*)args.out;
        f32x4 vn[2][4]; u32x2 dn[2][4];
#pragma unroll
        for (int q = 0; q < 2; ++q)
#pragma unroll
            for (int j = 0; j < 4; ++j) { const size_t r_ = (size_t)(2 * (NTOK / 2 - 1 - (gw < NTOK / 2 ? gw : 0)) + q); vn[q][j] = *(const f32x4*)(args.in[I_X] + r_ * 1024 + 4 * lane + 256 * j); dn[q][j] = *(const u32x2*)(D16 + r_ * 2048 + 1024 + 4 * lane + 256 * j); }
        for (int rp = gw; rp < NTOK / 2; rp += NGW) {
            const int row0 = 2 * (NTOK / 2 - 1 - rp), b = row0 >> 12;
            const float* sh = MOD + b * 6144 + 3072; const float* sc = sh + 1024;
            f32x4 v[2][4]; float ss[2] = {0.f, 0.f};
#pragma unroll
            for (int q = 0; q < 2; ++q)
#pragma unroll
                for (int j = 0; j < 4; ++j) { const u32x2 dw = dn[q][j]; v[q][j] = vn[q][j] + (f32x4){bf2f(dw.x & 0xffffu), bf2f(dw.x >> 16), bf2f(dw.y & 0xffffu), bf2f(dw.y >> 16)}; ss[q] += (v[q][j].x * v[q][j].x + v[q][j].y * v[q][j].y) + (v[q][j].z * v[q][j].z + v[q][j].w * v[q][j].w); }
            { const int rn = (rp + NGW < NTOK / 2) ? rp + NGW : rp;
#pragma unroll
              for (int q = 0; q < 2; ++q)
#pragma unroll
                  for (int j = 0; j < 4; ++j) { const size_t r_ = (size_t)(2 * (NTOK / 2 - 1 - rn) + q); vn[q][j] = *(const f32x4*)(args.in[I_X] + r_ * 1024 + 4 * lane + 256 * j); dn[q][j] = *(const u32x2*)(D16 + r_ * 2048 + 1024 + 4 * lane + 256 * j); } }
            float rstd[2];
#pragma unroll
            for (int q = 0; q < 2; ++q) rstd[q] = 1.0f / sqrtf(wave_sum(ss[q]) * (1.f / 1024.f) + EPS);
            float lg[2][16];
#pragma unroll
            for (int q = 0; q < 2; ++q)
#pragma unroll
                for (int e = 0; e < 16; ++e) lg[q][e] = 0.f;
            f32x4 wb[2][4];
#pragma unroll
            for (int e = 0; e < 4; ++e) wb[0][e] = *(const LAS f32x4*)(wT + e * 1024 + 4 * lane);
            f32x4 h[2];
#pragma unroll
            for (int g = 0; g < 16; ++g) {
                const int j = g >> 2, eg = g & 3, col = 4 * lane + 256 * j;
                if (g + 1 < 16) {
                    const int jn = (g + 1) >> 2, en = (g + 1) & 3;
#pragma unroll
                    for (int e = 0; e < 4; ++e) wb[(g + 1) & 1][e] = *(const LAS f32x4*)(wT + (4 * en + e) * 1024 + 4 * lane + 256 * jn);
                }
                if (eg == 0) {
                    const f32x4 gv = *(const f32x4*)(g2n + col), scv = *(const f32x4*)(sc + col), shv = *(const f32x4*)(sh + col);
#pragma unroll
                    for (int q = 0; q < 2; ++q) { h[q] = (v[q][j] * rstd[q] * gv) * (1.f + scv) + shv; st4bf(H2 + (size_t)(row0 + q) * 1024 + col, h[q]); }
                }
#pragma unroll
                for (int e = 0; e < 4; ++e) {
                    const f32x4 w = wb[g & 1][e];
#pragma unroll
                    for (int q = 0; q < 2; ++q) lg[q][4 * eg + e] += (h[q].x * w.x + h[q].y * w.y) + (h[q].z * w.z + h[q].w * w.w);
                    asm volatile("" : "+v"(lg[0][4 * eg + e]), "+v"(lg[1][4 * eg + e]));
                }
                asm volatile("" ::: "memory");
            }
#pragma unroll
            for (int q = 0; q < 2; ++q) {
                float a8[8], a4[4], a2[2], a1;
#pragma unroll
                for (int i = 0; i < 8; ++i) { const float send = h32 ? lg[q][i] : lg[q][i + 8], keep = h32 ? lg[q][i + 8] : lg[q][i]; a8[i] = keep + __shfl_xor(send, 32); }
#pragma unroll
                for (int i = 0; i < 4; ++i) { const float send = h16 ? a8[i] : a8[i + 4], keep = h16 ? a8[i + 4] : a8[i]; a4[i] = keep + __shfl_xor(send, 16); }
#pragma unroll
                for (int i = 0; i < 2; ++i) { const float send = h8 ? a4[i] : a4[i + 2], keep = h8 ? a4[i + 2] : a4[i]; a2[i] = keep + __shfl_xor(send, 8); }
                { const float send = h4 ? a2[0] : a2[1], keep = h4 ? a2[1] : a2[0]; a1 = keep + __shfl_xor(send, 4); }
                a1 += __shfl_xor(a1, 2); a1 += __shfl_xor(a1, 1);
                float mx = a1;
#pragma unroll
                for (int o = 4; o < 64; o <<= 1) mx = fmaxf(mx, __shfl_xor(mx, o));
                const float p = __expf(a1 - mx); float den = p;
#pragma unroll
                for (int o = 4; o < 64; o <<= 1) den += __shfl_xor(den, o);
                if ((lane & 3) == 0) AFFT[(size_t)(b * 16 + myexp) * SEQ + ((row0 + q) & (SEQ - 1))] = p / den;
            }
        }
    }
    if (IN(PH_WCONV)) {
        __syncthreads();
        LAS float* scr = (LAS float*)(lds + wave * 16384);
        constexpr int I_G = 16 * 16 * 64, I_D = 16 * 32 * 32;
        auto item = [&](int it) -> TrItem {
            int r = it; TrItem t;
            if (r < 2 * I_G) {
                const int up = r >= I_G; if (up) r -= I_G;
                const int e = r >> 10, kb = (r >> 6) & 15, nb = r & 63, n0 = nb * 32;
                const int drow = 256 * (n0 >> 7) + (n0 & 127) + (up ? 128 : 0);
                t.src = args.in[up ? I_WEU : I_WEG] + (size_t)e * 1024 * 2048 + (size_t)(kb * 64) * 2048 + n0; t.N = 2048;
                t.dst = WGU + (size_t)e * 4096 * 1024 + (size_t)drow * 1024 + kb * 64; t.ldt = 1024;
            } else {
                r -= 2 * I_G;
                const int e = r >> 10, kb = (r >> 5) & 31, nb = r & 31;
                t.src = args.in[I_WED] + (size_t)e * 2048 * 1024 + (size_t)(kb * 64) * 1024 + nb * 32; t.N = 1024;
                t.dst = WD + (size_t)e * 1024 * 2048 + (size_t)(nb * 32) * 2048 + kb * 64; t.ldt = 2048;
            }
            return t;
        };
        constexpr int NIT = 2 * I_G + I_D;
        if (gw < NIT) {
            TrItem cur = item(gw); f32x4 vc[8], vn[8];
            tr_load(cur, vc, lane);
            for (int it = gw; it < NIT; it += NGW) {
                const bool more = it + NGW < NIT;
                TrItem nxt = cur;
                if (more) { nxt = item(it + NGW); tr_load(nxt, vn, lane); }
                tr_store(cur, vc, scr, lane);
                cur = nxt;
#pragma unroll
                for (int i = 0; i < 8; ++i) vc[i] = vn[i];
            }
        }
    }
    SEAM(PH_WCONV);
    if (IN(PH_TOPK)) {
        LAS int* wsum = (LAS int*)lds;
        for (int task = bid; task < NE * NB; task += G) {
            const int e = task >> 3, b = task & 7;
            const float* aff = AFFT + (size_t)(b * 16 + e) * SEQ;
            unsigned k[8];
            { const u32x4 a0 = *(const u32x4*)(aff + 8 * tid), a1 = *(const u32x4*)(aff + 8 * tid + 4); k[0] = a0.x; k[1] = a0.y; k[2] = a0.z; k[3] = a0.w; k[4] = a1.x; k[5] = a1.y; k[6] = a1.z; k[7] = a1.w; }
            unsigned T = 0u; int it = 0;
            __syncthreads();
            for (int bit = 30; bit >= 0; --bit, ++it) {
                const unsigned cand = T | (1u << bit); int c = 0;
#pragma unroll
                for (int j = 0; j < 8; ++j) c += __builtin_popcountll(__ballot(k[j] >= cand));
                if (lane == 0) wsum[(it & 1) * 8 + wave] = c;
                __syncthreads();
                int tot = 0;
#pragma unroll
                for (int w = 0; w < 8; ++w) tot += wsum[(it & 1) * 8 + w];
                if (tot >= CAP) T = cand;
            }
            int cg = 0, ce = 0;
#pragma unroll
            for (int j = 0; j < 8; ++j) { cg += (k[j] > T) ? 1 : 0; ce += (k[j] == T) ? 1 : 0; }
            LAS int* sc1 = wsum + 16; LAS int* sc2 = wsum + 32;
            int ie = ce, ig = cg;
#pragma unroll
            for (int o = 1; o < 64; o <<= 1) { const int te = __shfl_up(ie, o), tg = __shfl_up(ig, o); if (lane >= o) { ie += te; ig += tg; } }
            __syncthreads();
            if (lane == 63) { sc1[wave] = ie; sc2[wave] = ig; }
            __syncthreads();
            int ebase = ie - ce, totg = 0;
#pragma unroll
            for (int w = 0; w < 8; ++w) { if (w < wave) ebase += sc1[w]; totg += sc2[w]; }
            const int need = CAP - totg;
            int sel[8], cs = 0, er = ebase;
#pragma unroll
            for (int j = 0; j < 8; ++j) { const bool eq = (k[j] == T); sel[j] = (k[j] > T) || (eq && er < need); er += eq ? 1 : 0; cs += sel[j]; }
            int is = cs;
#pragma unroll
            for (int o = 1; o < 64; o <<= 1) { const int ts = __shfl_up(is, o); if (lane >= o) is += ts; }
            __syncthreads();
            if (lane == 63) sc1[wave] = is;
            __syncthreads();
            int sbase = is - cs;
#pragma unroll
            for (int w = 0; w < 8; ++w) if (w < wave) sbase += sc1[w];
#pragma unroll
            for (int j = 0; j < 8; ++j) {
                const int t = 8 * tid + j; int slot = -1;
                if (sel[j]) { slot = sbase; ++sbase; const int prow = (e * 8 + b) * CAP + slot; TOPI[prow] = t; TOPW[prow] = __uint_as_float(k[j]); }
                SLOT[((size_t)b * SEQ + t) * 16 + e] = slot;
            }
            __syncthreads();
        }
    }
    SEAM(PH_TOPK);
    if (IN(PH_GU)) {
        Gemm g{H2, WGU, 1024, 1024, 1024, (size_t)4096 * 1024, 4, TOPI}; StaticOrder S; S.init(NPAIR, 4096, G, bid);
        EpiGU E{ACT};
        GEMM_PHASE<EpiGU, StaticOrder, true>(lds, g, S, E);
    }
    SEAM(PH_GU);
    if (IN(PH_D)) {
        Gemm g{ACT, WD, 2048, 2048, 2048, (size_t)1024 * 2048, 4, nullptr}; StaticOrder S; S.init(NPAIR, 1024, G, bid, 0, 1);
        EpiD E{YB, TOPW};
        GEMM_PHASE<EpiD, StaticOrder, false>(lds, g, S, E);
    }
    SEAM(PH_D);
    if (IN(PH_FIN)) {
        const float* fg = args.in[I_FING];
        const bf16_t* ZROW = (const bf16_t*)(ws + WS_CTL + 512 * 1024);
        int sln[2] = {-1, -1};
        if (gw < NTOK / 2 && lane < 16) { sln[0] = SLOT[(size_t)(2 * gw) * 16 + lane]; sln[1] = SLOT[(size_t)(2 * gw + 1) * 16 + lane]; }
        for (int rp = gw; rp < NTOK / 2; rp += NGW) {
            const int row0 = 2 * rp, b = row0 >> 12;
            const int sl[2] = {sln[0], sln[1]};
            { const int rn = rp + NGW; if (rn < NTOK / 2 && lane < 16) { sln[0] = SLOT[(size_t)(2 * rn) * 16 + lane]; sln[1] = SLOT[(size_t)(2 * rn + 1) * 16 + lane]; } }
            const float* g2 = MOD + b * 6144 + 5120;
            f32x4 xv[2][4], acc[2][4];
#pragma unroll
            for (int q = 0; q < 2; ++q)
#pragma unroll
                for (int h = 0; h < 2; ++h) { const float* xp = args.in[I_X] + (size_t)(row0 + q) * 1024 + 512 * h + 8 * lane; f32x4 d0_, d1_; ld8bf((const bf16_t*)args.out + (size_t)(row0 + q) * 2048 + 1024 + 512 * h + 8 * lane, d0_, d1_);
                    xv[q][2 * h] = *(const f32x4*)xp + d0_; xv[q][2 * h + 1] = *(const f32x4*)(xp + 4) + d1_;
                    acc[q][2 * h] = (f32x4){0.f, 0.f, 0.f, 0.f}; acc[q][2 * h + 1] = (f32x4){0.f, 0.f, 0.f, 0.f}; }
#pragma unroll
            for (int q = 0; q < 2; ++q) {
                unsigned long long mask = __ballot(sl[q] >= 0);
                for (;;) {
                    const bf16_t* yr[4];
#pragma unroll
                    for (int k = 0; k < 4; ++k) {
                        if (mask) { const int ex = __builtin_ctzll(mask); mask &= mask - 1; const int s = __builtin_amdgcn_readlane(sl[q], ex); yr[k] = YB + (size_t)((ex * 8 + b) * CAP + s) * 1024; }
                        else yr[k] = ZROW;
                    }
                    u32x4 y[4][2];
#pragma unroll
                    for (int k = 0; k < 4; ++k)
#pragma unroll
                        for (int h = 0; h < 2; ++h) y[k][h] = *(const u32x4*)(yr[k] + 512 * h + 8 * lane);
#pragma unroll
                    for (int k = 0; k < 4; ++k)
#pragma unroll
                        for (int h = 0; h < 2; ++h) { const u32x4 w = y[k][h];
                            acc[q][2 * h] += (f32x4){bf2f(w.x & 0xffffu), bf2f(w.x >> 16), bf2f(w.y & 0xffffu), bf2f(w.y >> 16)};
                            acc[q][2 * h + 1] += (f32x4){bf2f(w.z & 0xffffu), bf2f(w.z >> 16), bf2f(w.w & 0xffffu), bf2f(w.w >> 16)}; }
                    if (!mask) break;
                }
            }
#pragma unroll
            for (int q = 0; q < 2; ++q) {
                float ss = 0.f;
#pragma unroll
                for (int h = 0; h < 2; ++h)
#pragma unroll
                    for (int u4 = 0; u4 < 2; ++u4) { const int col = 512 * h + 8 * lane + 4 * u4; f32x4& v = xv[q][2 * h + u4]; v = v + *(const f32x4*)(g2 + col) * acc[q][2 * h + u4]; ss += (v.x * v.x + v.y * v.y) + (v.z * v.z + v.w * v.w); }
                const float rstd = 1.0f / sqrtf(wave_sum(ss) * (1.f / 1024.f) + EPS);
#pragma unroll
                for (int h = 0; h < 2; ++h)
#pragma unroll
                    for (int u4 = 0; u4 < 2; ++u4) { const int col = 512 * h + 8 * lane + 4 * u4; *(f32x4*)(args.out + (size_t)(row0 + q) * 1024 + col) = xv[q][2 * h + u4] * rstd * *(const f32x4*)(fg + col); }
            }
        }
    }
#undef IN
}

extern "C" void kernel_launch(void* const* d_in, const int* in_sizes, int n_in, void* d_out, int out_size, void* d_ws, size_t ws_size, hipStream_t stream) {
    static int grid = 0;
    if (grid == 0) {
        if (n_in != 23 || in_sizes[0] != NTOK * DM || out_size != NTOK * DM || ws_size < WS_END) {
            fprintf(stderr, "kernel_launch: unexpected problem (n_in %d, in0 %d, out %d, ws %zu < %zu?)\n", n_in, n_in > 0 ? in_sizes[0] : -1, out_size, ws_size, (size_t)WS_END); grid = -1; return; }
        if (hipFuncSetAttribute((const void*)fwd, hipFuncAttributeMaxDynamicSharedMemorySize, LDS_BYTES) != hipSuccess) { fprintf(stderr, "kernel_launch: hipFuncSetAttribute failed\n"); grid = -1; return; }
        int dev = 0, cus = 0;
        if (hipGetDevice(&dev) != hipSuccess || hipDeviceGetAttribute(&cus, hipDeviceAttributeMultiprocessorCount, dev) != hipSuccess) { grid = -1; return; }
        grid = cus;
    }
    if (grid < 0) return;
    (void)hipMemsetAsync((char*)d_ws + WS_CTL, 0, 1 * MiB, stream);
    Args a{};
    for (int i = 0; i < 23; ++i) a.in[i] = (const float*)d_in[i];
    a.out = (float*)d_out; a.ws = (unsigned char*)d_ws;
    if (ONE_LAUNCH) {
        a.ph_lo = 0; a.ph_hi = PH_COUNT;
        hipLaunchKernelGGL(fwd, dim3(grid), dim3(NTHREADS), LDS_BYTES, stream, a);
    } else {
        static const int seq[] = {PROBE_SEQ};
        for (unsigned i = 0; i < sizeof(seq) / sizeof(seq[0]); ++i) {
            a.ph_lo = seq[i] % 100; a.ph_hi = seq[i] % 100 + 1; a.flags = seq[i] / 100;
            hipLaunchKernelGGL(fwd, dim3(grid), dim3(NTHREADS), LDS_BYTES, stream, a);
        }
    }
}
```

```cpp
#include <hip/hip_runtime.h>
#include <cstdio>
#include <cstdint>

#define LAS __attribute__((address_space(3)))
typedef unsigned short bf16_t;
typedef float f32x4 __attribute__((ext_vector_type(4)));
typedef float f32x2 __attribute__((ext_vector_type(2)));
typedef unsigned u32x4 __attribute__((ext_vector_type(4)));
typedef unsigned u32x2 __attribute__((ext_vector_type(2)));
typedef int i32x4 __attribute__((ext_vector_type(4)));

constexpr int DM = 1024, NB = 8, SEQ = 4096, NTOK = NB * SEQ, CTXL = 256, NCTX = NB * CTXL, NROWS_H = NTOK + NCTX;
constexpr int INCOLS = 5632, OFF_Q = 2048, OFF_K = 3072, OFF_VB = 3328, OFF_GATE = 3584;
constexpr int NE = 16, CAP = 512, DE = 2048, NPAIR = NE * NB * CAP;
constexpr float EPS = 1e-6f, LOG2E = 1.4426950408889634f, C2 = 0.125f * LOG2E;
constexpr int NTHREADS = 512, NWAVES = 8;

constexpr size_t MiB = 1u << 20;
constexpr size_t WS_CTL = 0;
constexpr size_t WS_MOD = 1 * MiB;
constexpr size_t WS_ROPE = 1 * MiB + 512 * 1024;
constexpr size_t WS_AFFT = 2 * MiB;
constexpr size_t WS_TOPI = 4 * MiB;
constexpr size_t WS_TOPW = 4 * MiB + 512 * 1024;
constexpr size_t WS_SLOT = 5 * MiB;
constexpr size_t WS_WSP = 7 * MiB;
constexpr size_t WS_WIN = 8 * MiB;
constexpr size_t WS_WAB = 19 * MiB;
constexpr size_t WS_WO = 23 * MiB;
constexpr size_t WS_R = 25 * MiB;
constexpr size_t WS_H = WS_R;
constexpr size_t WS_VA = WS_R + 68 * MiB;
constexpr size_t WS_KB = WS_VA + 64 * MiB;
constexpr size_t WS_VB = WS_KB + 17 * MiB;
constexpr size_t WS_G = WS_VB + 17 * MiB;
constexpr size_t WS_Y = WS_G + 128 * MiB;
constexpr size_t WS_TMP = WS_Y + 128 * MiB;
constexpr size_t WS_STATS = WS_TMP + 64 * MiB;
constexpr size_t WS_MERGED = WS_H;
constexpr size_t WS_WGU = WS_R;
constexpr size_t WS_WD = WS_R + 128 * MiB;
constexpr size_t WS_H2 = WS_R + 192 * MiB;
constexpr size_t WS_ACT = WS_R + 256 * MiB;
constexpr size_t WS_YB = WS_WGU;
constexpr size_t WS_END = 537 * MiB;
static_assert(WS_STATS + 4 * MiB <= WS_END && WS_ACT + 256 * MiB == WS_END, "ws map");

constexpr int LDS_BYTES = 147456;

__device__ __forceinline__ float bf2f(unsigned b) { return __uint_as_float(b << 16); }
__device__ __forceinline__ unsigned f2bf(float f) { unsigned u = __float_as_uint(f); return (u + 0x7fffu + ((u >> 16) & 1u)) >> 16; }
__device__ __forceinline__ unsigned pk2(float lo, float hi) { typedef float f2_ __attribute__((ext_vector_type(2))); typedef __bf16 b2_ __attribute__((ext_vector_type(2))); f2_ v = {lo, hi}; b2_ b = __builtin_convertvector(v, b2_); return __builtin_bit_cast(unsigned, b); }
__device__ __forceinline__ void st4bf(bf16_t* p, f32x4 v) { u32x2 w; w.x = pk2(v.x, v.y); w.y = pk2(v.z, v.w); *(u32x2*)p = w; }
__device__ __forceinline__ void st8bf(bf16_t* p, f32x4 a, f32x4 b) { u32x4 w; w.x = pk2(a.x, a.y); w.y = pk2(a.z, a.w); w.z = pk2(b.x, b.y); w.w = pk2(b.z, b.w); *(u32x4*)p = w; }
__device__ __forceinline__ void ld8bf(const bf16_t* p, f32x4& a, f32x4& b) { const u32x4 w = *(const u32x4*)p; a.x = bf2f(w.x & 0xffffu); a.y = bf2f(w.x >> 16); a.z = bf2f(w.y & 0xffffu); a.w = bf2f(w.y >> 16); b.x = bf2f(w.z & 0xffffu); b.y = bf2f(w.z >> 16); b.z = bf2f(w.w & 0xffffu); b.w = bf2f(w.w >> 16); }
__device__ __forceinline__ f32x4 ld4bf(const bf16_t* p) { const u32x2 w = *(const u32x2*)p; f32x4 v; v.x = bf2f(w.x & 0xffffu); v.y = bf2f(w.x >> 16); v.z = bf2f(w.y & 0xffffu); v.w = bf2f(w.y >> 16); return v; }
__device__ __forceinline__ float sigmoidf_(float x) { return __builtin_amdgcn_rcpf(1.f + __builtin_amdgcn_exp2f(x * -1.4426950409f)); }
__device__ __forceinline__ float siluf_(float x) { return x * __builtin_amdgcn_rcpf(1.f + __builtin_amdgcn_exp2f(x * -1.4426950409f)); }
__device__ __forceinline__ float gelu_t(float x) { const float t = x * __builtin_fmaf(x * x, -0.10294324f, -2.3022082f); return x * __builtin_amdgcn_rcpf(1.f + __builtin_amdgcn_exp2f(t)); }
__device__ __forceinline__ f32x2 rcp2_(f32x2 d) { f32x2 r; r.x = __builtin_amdgcn_rcpf(d.x); r.y = __builtin_amdgcn_rcpf(d.y); return r; }
__device__ __forceinline__ f32x2 exp2_2_(f32x2 t) { f32x2 e; e.x = __builtin_amdgcn_exp2f(t.x); e.y = __builtin_amdgcn_exp2f(t.y); return e; }
__device__ __forceinline__ f32x2 gelu2_(f32x2 x) { const f32x2 t = x * ((x * x) * -0.10294324f + -2.3022082f); return x * rcp2_(exp2_2_(t) + 1.0f); }
__device__ __forceinline__ f32x2 sigm2_(f32x2 x) { return rcp2_(exp2_2_(x * -1.4426950409f) + 1.0f); }
__device__ __forceinline__ f32x4 gelu4_(f32x4 v) { const f32x2 a = gelu2_((f32x2){v.x, v.y}), b = gelu2_((f32x2){v.z, v.w}); return (f32x4){a.x, a.y, b.x, b.y}; }
__device__ __forceinline__ f32x4 sigm4_(f32x4 v) { const f32x2 a = sigm2_((f32x2){v.x, v.y}), b = sigm2_((f32x2){v.z, v.w}); return (f32x4){a.x, a.y, b.x, b.y}; }
template <int CTRL> __device__ __forceinline__ float dpp_f(float v) { const int i = __builtin_bit_cast(int, v); return __builtin_bit_cast(float, __builtin_amdgcn_update_dpp(i, i, CTRL, 0xf, 0xf, true)); }
__device__ __forceinline__ float xchg16(float v) { auto r = __builtin_amdgcn_permlane16_swap(__float_as_uint(v), __float_as_uint(v), false, false); return __uint_as_float((threadIdx.x & 16) ? r[0] : r[1]); }
__device__ __forceinline__ float xchg32(float v) { auto r = __builtin_amdgcn_permlane32_swap(__float_as_uint(v), __float_as_uint(v), false, false); return __uint_as_float((threadIdx.x & 32) ? r[0] : r[1]); }
__device__ __forceinline__ float wave_sum(float v) {
    v += dpp_f<0xB1>(v); v += dpp_f<0x4E>(v); v += dpp_f<0x141>(v); v += dpp_f<0x140>(v); v += xchg16(v); v += xchg32(v);
    return v;
}
__device__ __forceinline__ int wave_sum_i(int v) {
#pragma unroll
    for (int o = 1; o < 64; o <<= 1) v += __shfl_xor(v, o);
    return v;
}
#define LDS_WAIT() asm volatile("s_waitcnt lgkmcnt(0)" ::: "memory")

struct Args { const float* in[23]; float* out; unsigned char* ws; int ph_lo, ph_hi, flags, pad; };
enum { I_X = 0, I_C, I_CTX, I_CCTX, I_WADA, I_BADA, I_N1G, I_WIN, I_BMG, I_LNG, I_LNB, I_WSP, I_BSP, I_SINK, I_WPA, I_WPB, I_WOUT, I_N2G, I_WR, I_WEG, I_WEU, I_WED, I_FING };

struct Unit { int pm, pn; };
struct Gemm {
    const bf16_t* A; const bf16_t* Bt; int lda, ldb, K;
    size_t bgs; int tpg_shift;
    const int* gidx;
};
constexpr int NXCD = 8, WGM = 8;
struct StaticOrder {
    int nM, nN, nwg, G, c, extra, rev;
    __device__ void init(int M, int N, int G_, int c_, int extra_ = 0, int rev_ = 0) { nM = M / 256; nN = N / 256; nwg = nM * nN; G = G_; c = c_; extra = extra_; rev = rev_; }
    __device__ bool next(int i, Unit& u) const {
        const long L = (long)i * G + c;
        if (L >= nwg) { const int x = (int)(L - nwg); if (x >= extra) return false; u.pm = NTOK / 256 + (x >> 1); u.pn = 12 + (x & 1); return true; }
        int wgid = (int)L; { const int q = nwg / NXCD, r = nwg % NXCD, xcd = wgid % NXCD, off = wgid / NXCD; wgid = (xcd < r ? xcd * (q + 1) : r * (q + 1) + (xcd - r) * q) + off; }
        const int nig = WGM * nN, gid = wgid / nig, fm = gid * WGM, gsz = (nM - fm) < WGM ? (nM - fm) : WGM;
        u.pm = fm + ((wgid % nig) % gsz); u.pn = (wgid % nig) / gsz; if (rev) u.pm = nM - 1 - u.pm; return true;
    }
};

struct OneUnit { int pm, pn; __device__ bool next(int i, Unit& u) const { if (i) return false; u.pm = pm; u.pn = pn; return true; } };

typedef f32x4 Acc[2][2][4][2];

namespace pg8 {
typedef short bf16x8 __attribute__((ext_vector_type(8)));
constexpr int BK = 64, HALF = 128, HTB = HALF * BK * 2, STAGE_BYTES = 8 * HTB;
__device__ __forceinline__ int lds_byte(int r, int c) { const int st = (r >> 4) * 2 + (c >> 5), rr = r & 15, cc = c & 31, ob = rr * 64 + cc * 2; return st * 1024 + (ob ^ (((ob >> 9) & 1) << 5)); }
__device__ __forceinline__ void stage_rc(int b, int& R, int& C) { const int st = b / 1024, sb = b % 1024, swz = sb ^ (((sb >> 9) & 1) << 5); R = (st >> 1) * 16 + swz / 64; C = (st & 1) * 32 + (swz % 64) / 2; }

template <class Epi, class Sched, bool GATHER, bool HOOK = false>
__device__ __forceinline__ void gemm_phase(LAS unsigned char* lds, const Gemm g, const Sched& S, const Epi& E) {
    const int tid = threadIdx.x, wid = __builtin_amdgcn_readfirstlane(tid >> 6), lane = tid & 63, wr = wid >> 2, wc = wid & 3, fr = lane & 15, fq = lane >> 4;
    const int nt = g.K / BK;
    int Rs[2], Cs[2]; unsigned voffBp[2][2], voffB[2], voffBn[2], vA[2][2], vN[2][2];
#pragma unroll
    for (int i = 0; i < 2; ++i) { stage_rc(tid * 16 + i * 8192, Rs[i], Cs[i]); voffBp[0][i] = (unsigned)(Rs[i] * g.ldb + Cs[i]) * 2u;
        const int rho = Rs[i] & 31, Rb = (Rs[i] & ~31) + 8 * ((rho & 15) >> 2) + 4 * (rho >> 4) + (rho & 3); voffBp[1][i] = (unsigned)(Rb * g.ldb + Cs[i]) * 2u; }
    const size_t kstep = (size_t)(BK * 2);
    const size_t hstepB = (size_t)HALF * g.ldb * 2;
    const unsigned ldsw = (unsigned)wid * 1024u;
    const int aoff = lds_byte(wr * 64 + fr, fq * 8), boff = lds_byte(wc * 32 + fr, fq * 8);
#define PG8_SA(b, h) (((b) * 2 + (h)) * HTB)
#define PG8_SB(b, h) ((4 + (b) * 2 + (h)) * HTB)
#define PG8_STAGE(bufoff, gbase, voff) do { _Pragma("unroll") for (int _i = 0; _i < 2; ++_i) \
        __builtin_amdgcn_global_load_lds((const unsigned*)((const char*)(gbase) + (voff)[_i]), (LAS unsigned*)(lds + (bufoff) + ldsw + _i * 8192), 16, 0, 0); } while (0)
#define PG8_LDA(dst, b, h) do { _Pragma("unroll") for (int m = 0; m < 4; ++m) _Pragma("unroll") for (int k = 0; k < 2; ++k) dst[m][k] = *(const LAS bf16x8*)(lds + PG8_SA(b, h) + aoff + m * 2048 + k * 1024); } while (0)
#define PG8_LDB(dst, b, h) do { _Pragma("unroll") for (int n = 0; n < 2; ++n) _Pragma("unroll") for (int k = 0; k < 2; ++k) dst[n][k] = *(const LAS bf16x8*)(lds + PG8_SB(b, h) + boff + n * 2048 + k * 1024); } while (0)
#define PG8_MMA(ai, bj, At, Bt) do { __builtin_amdgcn_s_setprio(1); _Pragma("unroll") for (int m = 0; m < 4; ++m) _Pragma("unroll") for (int n = 0; n < 2; ++n) _Pragma("unroll") for (int k = 0; k < 2; ++k) \
        acc[ai][bj][m][n] = __builtin_amdgcn_mfma_f32_16x16x32_bf16(Bt[n][k], At[m][k], acc[ai][bj][m][n], 0, 0, 0); __builtin_amdgcn_s_setprio(0); } while (0)
#define PG8_WAIT_V(n) asm volatile("s_waitcnt vmcnt(" #n ")" ::: "memory")
#define PG8_WAIT_L(n) asm volatile("s_waitcnt lgkmcnt(" #n ")" ::: "memory")
#define PG8_BAR __builtin_amdgcn_s_barrier()
#define PG8_SCHED __builtin_amdgcn_sched_barrier(0)
#define PG8_AVOFF(dst, U) do { _Pragma("unroll") for (int _h = 0; _h < 2; ++_h) _Pragma("unroll") for (int _i = 0; _i < 2; ++_i) \
        dst[_h][_i] = GATHER ? (unsigned)((((U).pm >> 1) & 7) * SEQ + g.gidx[(U).pm * 256 + _h * 128 + Rs[_i]]) * (unsigned)(g.lda * 2) + (unsigned)(Cs[_i] * 2) \
                             : (unsigned)((_h * 128 + Rs[_i]) * g.lda + Cs[_i]) * 2u; } while (0)
#define PG8_ABASE(U) ((const char*)g.A + (GATHER ? (size_t)0 : (size_t)(U).pm * 256 * g.lda * 2))
#define PG8_BBASE(U) ((const char*)g.Bt + ((size_t)((U).pm >> g.tpg_shift) * g.bgs + (size_t)(U).pn * 256 * g.ldb) * 2)
    Unit cur, nxt; int ui = 0;
    if (!S.next(0, cur)) return;
    Acc acc;
#pragma unroll
    for (int a = 0; a < 2; ++a)
#pragma unroll
        for (int b = 0; b < 2; ++b)
#pragma unroll
            for (int m = 0; m < 4; ++m)
#pragma unroll
                for (int n = 0; n < 2; ++n) acc[a][b][m][n] = (f32x4){0.f, 0.f, 0.f, 0.f};
    bf16x8 At[4][2], B0[2][2], B1[2][2];
    PG8_AVOFF(vA, cur);
    { const bool pc = E.perm(cur); voffB[0] = pc ? voffBp[1][0] : voffBp[0][0]; voffB[1] = pc ? voffBp[1][1] : voffBp[0][1]; }
    const char* cA = PG8_ABASE(cur); const char* cB = PG8_BBASE(cur);
    PG8_STAGE(PG8_SB(0, 0), cB, voffB); PG8_STAGE(PG8_SB(0, 1), cB + hstepB, voffB); PG8_STAGE(PG8_SA(0, 0), cA, vA[0]); PG8_STAGE(PG8_SA(0, 1), cA, vA[1]);
    if (wr == 1) PG8_BAR;
    PG8_WAIT_V(2); PG8_BAR;
    PG8_STAGE(PG8_SB(1, 0), cB + kstep, voffB); PG8_STAGE(PG8_SA(1, 0), cA + kstep, vA[0]); PG8_STAGE(PG8_SB(1, 1), cB + hstepB + kstep, voffB);
    PG8_WAIT_V(6); PG8_BAR;
    for (;;) {
        const bool has_next = S.next(ui + 1, nxt);
        const char* nA = has_next ? PG8_ABASE(nxt) : cA; const char* nB = has_next ? PG8_BBASE(nxt) : cB;
        { const bool pn_ = has_next ? E.perm(nxt) : E.perm(cur); voffBn[0] = pn_ ? voffBp[1][0] : voffBp[0][0]; voffBn[1] = pn_ ? voffBp[1][1] : voffBp[0][1]; }
        if (GATHER) {
#pragma unroll
            for (int h = 0; h < 2; ++h)
#pragma unroll
                for (int i = 0; i < 2; ++i) vN[h][i] = vA[h][i];
            if (has_next && wid == 0)
                __builtin_amdgcn_global_load_lds((const unsigned*)(g.gidx + nxt.pm * 256 + lane * 4), (LAS unsigned*)(lds + STAGE_BYTES + (ui & 1) * 1024), 16, 0, 0);
        }
        for (int t = 0; t < nt; t += 2) {
            const bool last = (t == nt - 2);
            if (GATHER) { if (t == 4 && has_next) {
                const LAS int* li = (const LAS int*)(lds + STAGE_BYTES + (ui & 1) * 1024);
#pragma unroll
                for (int h = 0; h < 2; ++h)
#pragma unroll
                    for (int i = 0; i < 2; ++i) vN[h][i] = (unsigned)(((nxt.pm >> 1) & 7) * SEQ + li[h * 128 + Rs[i]]) * (unsigned)(g.lda * 2) + (unsigned)(Cs[i] * 2);
            } }
            if constexpr (HOOK) { if (t == (nt >> 1)) E.mid(acc, cur, wr, wc, fr, fq); }
            const char* a1 = cA + (size_t)(t + 1) * kstep;
            const char* a2 = last ? nA : cA + (size_t)(t + 2) * kstep; const char* b2 = last ? nB : cB + (size_t)(t + 2) * kstep;
            const char* a3 = a2 + kstep; const char* b3 = b2 + kstep;
            unsigned v2[2][2];
#pragma unroll
            for (int h = 0; h < 2; ++h)
#pragma unroll
                for (int i = 0; i < 2; ++i) v2[h][i] = (GATHER && last) ? vN[h][i] : vA[h][i];
            unsigned vb2[2]; vb2[0] = last ? voffBn[0] : voffB[0]; vb2[1] = last ? voffBn[1] : voffB[1];
            PG8_LDB(B0, 0, 0); PG8_LDB(B1, 0, 1); PG8_SCHED; PG8_LDA(At, 0, 0); PG8_STAGE(PG8_SA(1, 1), a1, vA[1]);
            PG8_WAIT_V(8); PG8_WAIT_L(0); PG8_BAR; PG8_MMA(0, 0, At, B0); PG8_MMA(0, 1, At, B1); PG8_BAR; PG8_SCHED;
            PG8_LDA(At, 0, 1); PG8_STAGE(PG8_SB(0, 0), b2, vb2); PG8_STAGE(PG8_SB(0, 1), b2 + hstepB, vb2); PG8_STAGE(PG8_SA(0, 0), a2, v2[0]);
            PG8_WAIT_V(8); PG8_WAIT_L(0); PG8_BAR; PG8_MMA(1, 0, At, B0); PG8_MMA(1, 1, At, B1); PG8_BAR; PG8_SCHED;
            PG8_LDB(B0, 1, 0); PG8_LDB(B1, 1, 1); PG8_SCHED; PG8_LDA(At, 1, 0); PG8_STAGE(PG8_SA(0, 1), a2, v2[1]);
            PG8_WAIT_V(8); PG8_WAIT_L(0); PG8_BAR; PG8_MMA(0, 0, At, B0); PG8_MMA(0, 1, At, B1); PG8_BAR; PG8_SCHED;
            PG8_LDA(At, 1, 1); PG8_STAGE(PG8_SB(1, 0), b3, vb2); PG8_STAGE(PG8_SB(1, 1), b3 + hstepB, vb2); PG8_STAGE(PG8_SA(1, 0), a3, v2[0]);
            PG8_WAIT_V(8); PG8_WAIT_L(0); PG8_BAR; PG8_MMA(1, 0, At, B0); PG8_MMA(1, 1, At, B1); PG8_BAR; PG8_SCHED;
        }
        if (wr == 0) PG8_BAR;
        E(acc, cur, wr, wc, fr, fq);
        if (!has_next) break;
#pragma unroll
        for (int a = 0; a < 2; ++a)
#pragma unroll
            for (int b = 0; b < 2; ++b)
#pragma unroll
                for (int m = 0; m < 4; ++m)
#pragma unroll
                    for (int n = 0; n < 2; ++n) acc[a][b][m][n] = (f32x4){0.f, 0.f, 0.f, 0.f};
        cur = nxt; cA = nA; cB = nB; ++ui; voffB[0] = voffBn[0]; voffB[1] = voffBn[1];
        if (GATHER) {
#pragma unroll
            for (int h = 0; h < 2; ++h)
#pragma unroll
                for (int i = 0; i < 2; ++i) vA[h][i] = vN[h][i];
        }
        if (wr == 1) PG8_BAR;
    }
    PG8_WAIT_V(0);
    PG8_BAR;
#undef PG8_SA
#undef PG8_SB
#undef PG8_STAGE
#undef PG8_LDA
#undef PG8_LDB
#undef PG8_MMA
#undef PG8_WAIT_V
#undef PG8_WAIT_L
#undef PG8_BAR
#undef PG8_SCHED
#undef PG8_AVOFF
#undef PG8_ABASE
#undef PG8_BBASE
}
}

#define GEMM_PHASE pg8::gemm_phase

struct EpiIn {
    bf16_t *Y, *VA, *KB, *VB, *G; const float* bgate; const f32x2* rope; f32x2* STATS;
    __device__ __forceinline__ bool perm(const Unit& u) const { return u.pn < 8 || u.pn > 12; }
    template <int KIND> __device__ __forceinline__ void run(const Acc& acc, const Unit& u, int wr, int wc, int fr, int fq) const {
        const int pn = u.pn;
#pragma unroll
        for (int ai = 0; ai < 2; ++ai)
#pragma unroll
            for (int m = 0; m < 4; ++m) {
                const int row = u.pm * 256 + ai * 128 + wr * 64 + m * 16 + fr;
                float ssum = 0.f, ssq = 0.f;
#pragma unroll
                for (int bj = 0; bj < 2; ++bj) {
                    f32x4 v0 = acc[ai][bj][m][0], v1 = acc[ai][bj][m][1];
                    if constexpr (KIND == 0 || KIND == 1) {
                        const int c8 = bj * 128 + wc * 32 + 8 * fq;
                        v0 = gelu4_(v0); v1 = gelu4_(v1);
                        if constexpr (KIND == 0) st8bf(Y + (size_t)row * 2048 + pn * 256 + c8, v0, v1);
                        else {
                            st8bf(VA + (size_t)row * 1024 + (pn - 4) * 256 + c8, v0, v1);
                            ssum += ((v0.x + v0.y) + (v0.z + v0.w)) + ((v1.x + v1.y) + (v1.z + v1.w));
                            ssq += ((v0.x * v0.x + v0.y * v0.y) + (v0.z * v0.z + v0.w * v0.w)) + ((v1.x * v1.x + v1.y * v1.y) + (v1.z * v1.z + v1.w * v1.w));
                        }
                    } else if constexpr (KIND == 2) {
                        const int cl = bj * 128 + wc * 32 + 4 * fq;
                        f32x4 o0 = v0, o1 = v1;
                        if (row < NTOK) {
                            const int t = row & (SEQ - 1), pos = (wc & 1) ? (t & 63) : (t >> 6);
                            const f32x2* rp = rope + pos * 16 + 4 * fq;
#pragma unroll
                            for (int j = 0; j < 4; ++j) { const f32x2 cs = rp[j]; o0[j] = v0[j] * cs.x - v1[j] * cs.y; o1[j] = v0[j] * cs.y + v1[j] * cs.x; }
                        }
                        if (pn < 12) { bf16_t* p = Y + (size_t)row * 2048 + 1024 + (pn - 8) * 256 + cl; st4bf(p, o0 * C2); st4bf(p + 16, o1 * C2); }
                        else { bf16_t* p = KB + (size_t)row * 256 + cl; st4bf(p, o0); st4bf(p + 16, o1); }
                    } else if constexpr (KIND == 3) {
                        st8bf(VB + (size_t)row * 256 + bj * 128 + wc * 32 + 8 * fq, v0, v1);
                    } else {
                        if (bj == 0) {
                            const int ch = (pn - 14) * 128 + wc * 32 + 8 * fq;
                            const f32x4 a0 = sigm4_(v0 + *(const f32x4*)(bgate + ch)), a1 = sigm4_(v1 + *(const f32x4*)(bgate + ch + 4));
                            const f32x4 g0 = sigm4_(acc[ai][1][m][0] + *(const f32x4*)(bgate + 1024 + ch)), g1 = sigm4_(acc[ai][1][m][1] + *(const f32x4*)(bgate + 1024 + ch + 4));
                            f32x4 r0, r1;
#pragma unroll
                            for (int j = 0; j < 4; ++j) { r0[j] = a0[j] * __builtin_amdgcn_rcpf(g0[j]); r1[j] = a1[j] * __builtin_amdgcn_rcpf(g1[j]); }
                            st8bf(G + (size_t)row * 2048 + ch, r0, r1); st8bf(G + (size_t)row * 2048 + 1024 + ch, g0, g1);
                        }
                    }
                }
                if constexpr (KIND == 1) {
                    ssum += xchg16(ssum); ssum += xchg32(ssum); ssq += xchg16(ssq); ssq += xchg32(ssq);
                    if (fq == 0) STATS[(size_t)row * 16 + (pn - 4) * 4 + wc] = (f32x2){ssum, ssq};
                }
            }
    }
    __device__ __forceinline__ void operator()(const Acc& acc, const Unit& u, int wr, int wc, int fr, int fq) const {
        const int pn = u.pn;
        if (pn < 4) run<0>(acc, u, wr, wc, fr, fq);
        else if (pn < 8) run<1>(acc, u, wr, wc, fr, fq);
        else if (pn < 13) run<2>(acc, u, wr, wc, fr, fq);
        else if (pn == 13) run<3>(acc, u, wr, wc, fr, fq);
        else run<4>(acc, u, wr, wc, fr, fq);
    }
};
struct EpiAB {
    bf16_t* MERGED; const bf16_t* G;
    __device__ __forceinline__ bool perm(const Unit&) const { return true; }
    __device__ __forceinline__ void mid(Acc& acc, const Unit& u, int wr, int wc, int fr, int fq) const {
        int zero; asm volatile("v_mov_b32 %0, 0" : "=v"(zero));
        const bf16_t* gp = G + (size_t)(u.pm * 256 + wr * 64 + fr + zero) * 2048 + u.pn * 256 + wc * 32 + 8 * fq;
#pragma unroll
        for (int ai = 0; ai < 2; ++ai)
#pragma unroll
            for (int m = 0; m < 4; ++m) {
#pragma unroll
                for (int bj = 0; bj < 2; ++bj) {
                    const bf16_t* q = gp + (size_t)(ai * 128 + m * 16) * 2048 + bj * 128;
                    f32x4 r0, r1; ld8bf(q, r0, r1);
                    acc[ai][bj][m][0] *= r0; acc[ai][bj][m][1] *= r1;
                    asm volatile("" ::: "memory");
                }
            }
    }
    __device__ __forceinline__ void operator()(const Acc& acc, const Unit& u, int wr, int wc, int fr, int fq) const {
#pragma unroll
        for (int ai = 0; ai < 2; ++ai)
#pragma unroll
            for (int m = 0; m < 4; ++m) {
                const int row = u.pm * 256 + ai * 128 + wr * 64 + m * 16 + fr;
#pragma unroll
                for (int bj = 0; bj < 2; ++bj) {
                    const int c8 = u.pn * 256 + bj * 128 + wc * 32 + 8 * fq;
                    f32x4 gb0, gb1; ld8bf(G + (size_t)row * 2048 + 1024 + c8, gb0, gb1);
                    st8bf(MERGED + (size_t)row * 1024 + c8, gb0 * acc[ai][bj][m][0], gb1 * acc[ai][bj][m][1]);
                }
            }
    }
};
struct EpiO {
    bf16_t* D16; const float* mod;
    __device__ __forceinline__ bool perm(const Unit&) const { return true; }
    __device__ __forceinline__ void operator()(const Acc& acc, const Unit& u, int wr, int wc, int fr, int fq) const {
        const float* g1 = mod + (size_t)((u.pm * 256) >> 12) * 6144 + 2048;
#pragma unroll
        for (int bj = 0; bj < 2; ++bj) {
            const int c8 = u.pn * 256 + bj * 128 + wc * 32 + 8 * fq;
            const f32x4 ga = *(const f32x4*)(g1 + c8), gb = *(const f32x4*)(g1 + c8 + 4);
#pragma unroll
            for (int ai = 0; ai < 2; ++ai)
#pragma unroll
                for (int m = 0; m < 4; ++m) {
                    const int row = u.pm * 256 + ai * 128 + wr * 64 + m * 16 + fr;
                    st8bf(D16 + (size_t)row * 2048 + 1024 + c8, ga * acc[ai][bj][m][0], gb * acc[ai][bj][m][1]);
                }
        }
    }
};
struct EpiGU {
    bf16_t* ACT;
    __device__ __forceinline__ bool perm(const Unit&) const { return true; }
    __device__ __forceinline__ void operator()(const Acc& acc, const Unit& u, int wr, int wc, int fr, int fq) const {
#pragma unroll
        for (int ai = 0; ai < 2; ++ai)
#pragma unroll
            for (int m = 0; m < 4; ++m) {
                const int prow = u.pm * 256 + ai * 128 + wr * 64 + m * 16 + fr;
                f32x4 a[2];
#pragma unroll
                for (int n = 0; n < 2; ++n) {
                    const f32x4 gt = acc[ai][0][m][n], up = acc[ai][1][m][n];
                    a[n] = gt * sigm4_(gt) * up;
                }
                st8bf(ACT + (size_t)prow * 2048 + u.pn * 128 + wc * 32 + 8 * fq, a[0], a[1]);
            }
    }
};
struct EpiD {
    bf16_t* YB; const float* TOPW;
    __device__ __forceinline__ bool perm(const Unit&) const { return true; }
    __device__ __forceinline__ void operator()(const Acc& acc, const Unit& u, int wr, int wc, int fr, int fq) const {
#pragma unroll
        for (int ai = 0; ai < 2; ++ai)
#pragma unroll
            for (int m = 0; m < 4; ++m) {
                const int prow = u.pm * 256 + ai * 128 + wr * 64 + m * 16 + fr; const float w = TOPW[prow];
#pragma unroll
                for (int bj = 0; bj < 2; ++bj)
                    st8bf(YB + (size_t)prow * 1024 + u.pn * 256 + bj * 128 + wc * 32 + 8 * fq, acc[ai][bj][m][0] * w, acc[ai][bj][m][1] * w);
            }
    }
};

__device__ __forceinline__ void transpose_item(const float* W, int N, int k0, int n0, bf16_t* dst, int ldt, LAS float* scr, int lane) {
    const int kk = lane >> 3, nq = (lane & 7) * 4;
    f32x4 v[8];
#pragma unroll
    for (int i = 0; i < 8; ++i) v[i] = *(const f32x4*)(W + (size_t)(k0 + 8 * i + kk) * N + n0 + nq);
#pragma unroll
    for (int i = 0; i < 8; ++i) { LAS float* s = scr + (8 * i + kk) * 33 + nq; s[0] = v[i].x; s[1] = v[i].y; s[2] = v[i].z; s[3] = v[i].w; }
    LDS_WAIT();
    const int c = lane & 7;
#pragma unroll
    for (int j = 0; j < 4; ++j) {
        const int n = (lane >> 3) + 8 * j; const LAS float* s = scr + (8 * c) * 33 + n;
        u32x4 o; o.x = pk2(s[0 * 33], s[1 * 33]); o.y = pk2(s[2 * 33], s[3 * 33]); o.z = pk2(s[4 * 33], s[5 * 33]); o.w = pk2(s[6 * 33], s[7 * 33]);
        *(u32x4*)(dst + (size_t)n * ldt + 8 * c) = o;
    }
    LDS_WAIT();
}

struct TrItem { const float* src; bf16_t* dst; int N, ldt; };
__device__ __forceinline__ void tr_load(const TrItem& it, f32x4 (&v)[8], int lane) {
    const int kk = lane >> 3, nq = (lane & 7) * 4;
#pragma unroll
    for (int i = 0; i < 8; ++i) v[i] = *(const f32x4*)(it.src + (size_t)(8 * i + kk) * it.N + nq);
}
__device__ __forceinline__ void tr_store(const TrItem& it, const f32x4 (&v)[8], LAS float* scr, int lane) {
    const int kk = lane >> 3, nq = (lane & 7) * 4;
#pragma unroll
    for (int i = 0; i < 8; ++i) { LAS float* s = scr + (8 * i + kk) * 33 + nq; s[0] = v[i].x; s[1] = v[i].y; s[2] = v[i].z; s[3] = v[i].w; }
    LDS_WAIT();
    const int c = lane & 7;
#pragma unroll
    for (int j = 0; j < 4; ++j) {
        const int n = (lane >> 3) + 8 * j; const LAS float* s = scr + (8 * c) * 33 + n;
        u32x4 o; o.x = pk2(s[0 * 33], s[1 * 33]); o.y = pk2(s[2 * 33], s[3 * 33]); o.z = pk2(s[4 * 33], s[5 * 33]); o.w = pk2(s[6 * 33], s[7 * 33]);
        *(u32x4*)(it.dst + (size_t)n * it.ldt + 8 * c) = o;
    }
    LDS_WAIT();
}

__device__ __forceinline__ void adaln_task(int task, const float* c, const float* cctx, const float* w_ada, const float* b_ada, float* mod, LAS float* lds, int tid) {
    LAS float* s = lds; LAS float* red = lds + 9 * 1024;
    { float cv[18];
#pragma unroll
      for (int q = 0; q < 18; ++q) { const int i = tid + NTHREADS * q, r = i >> 10, k = i & 1023; cv[q] = r < 8 ? c[r * 1024 + k] : cctx[k]; }
#pragma unroll
      for (int q = 0; q < 18; ++q) s[tid + NTHREADS * q] = cv[q] * __builtin_amdgcn_rcpf(1.f + __expf(-cv[q])); }
    __syncthreads();
    const int ch = tid & 7, kr = tid >> 3;
    f32x4 acc[9];
#pragma unroll
    for (int r = 0; r < 9; ++r) acc[r] = (f32x4){0.f, 0.f, 0.f, 0.f};
    const float* wp = w_ada + (size_t)kr * 6144 + task * 32 + ch * 4;
    for (int it = 0; it < 16; ++it) {
        const f32x4 w = *(const f32x4*)(wp + (size_t)it * 64 * 6144); const int k = kr + it * 64;
#pragma unroll
        for (int r = 0; r < 9; ++r) acc[r] += s[r * 1024 + k] * w;
    }
#pragma unroll
    for (int r = 0; r < 9; ++r) *(LAS f32x4*)(red + (kr * 9 + r) * 32 + ch * 4) = acc[r];
    __syncthreads();
    if (tid < 288) { const int r = tid >> 5, col = tid & 31; float sum = 0.f; for (int q = 0; q < 64; ++q) sum += red[(q * 9 + r) * 32 + col]; mod[r * 6144 + task * 32 + col] = sum + b_ada[task * 32 + col]; }
    __syncthreads();
}

__device__ __forceinline__ void rope_table(f32x2* tab, int tid) {
    for (int idx = tid; idx < 1024; idx += NTHREADS) {
        const int pos = idx >> 4, i = idx & 15;
        double f = 1.0;
        for (int q = 0; q < i; ++q) f *= 0.56234132519034908;
        const float ang = (float)pos * (float)f;
        const double a = (double)ang, k = __builtin_rint(a * 0.15915494309189535), r = a - k * 6.283185307179586476925, r2 = r * r;
        double sn = r, ts = r, cs = 1.0, tc = 1.0;
        for (int n = 1; n <= 14; ++n) {
            tc *= -r2 / (double)((2 * n - 1) * (2 * n)); cs += tc;
            ts *= -r2 / (double)((2 * n) * (2 * n + 1)); sn += ts;
        }
        tab[idx] = (f32x2){(float)cs, (float)sn};
    }
}

__device__ __forceinline__ unsigned char* lds_raw_ptr(LAS unsigned char* p) { return (unsigned char*)p; }
namespace mix {
typedef short bf16x8 __attribute__((ext_vector_type(8)));
typedef short s16x4 __attribute__((ext_vector_type(4)));
typedef float f32x16 __attribute__((ext_vector_type(16)));
typedef __attribute__((address_space(3))) const char* lds_cptr;
__device__ __forceinline__ int crow(int r, int hi) { return (r & 3) + 8 * (r >> 2) + 4 * hi; }
__device__ __forceinline__ unsigned cvtpk(float lo, float hi) { typedef float f2 __attribute__((ext_vector_type(2))); typedef __bf16 b2 __attribute__((ext_vector_type(2))); f2 v = {lo, hi}; b2 b = __builtin_convertvector(v, b2); return __builtin_bit_cast(unsigned, b); }
__device__ __forceinline__ s16x4 vtr(lds_cptr p) { return __builtin_bit_cast(s16x4, __builtin_amdgcn_ds_read_tr16_b64_v4i16((__attribute__((address_space(3))) s16x4*)p)); }
__device__ __forceinline__ bf16x8 pk8(s16x4 lo, s16x4 hi) { return (bf16x8){lo[0], lo[1], lo[2], lo[3], hi[0], hi[1], hi[2], hi[3]}; }
__device__ __forceinline__ float max3f(float a, float b, float c) { float r; asm("v_max3_f32 %0, %1, %2, %3" : "=v"(r) : "v"(a), "v"(b), "v"(c)); return r; }
__device__ __forceinline__ float max2f(float a, float b) { float r; asm("v_max_f32_e32 %0, %1, %2" : "=v"(r) : "v"(a), "v"(b)); return r; }
__device__ __forceinline__ float swap_half(float v) { auto rr = __builtin_amdgcn_permlane32_swap(__float_as_uint(v), __float_as_uint(v), false, false); return __uint_as_float((threadIdx.x & 32) ? rr[0] : rr[1]); }

constexpr int A_K = 0, A_V = 24576, A_WS = 49152, A_QST = 53248, A_OST = A_QST, A_OSTW = 8192, A_END = A_QST + 8 * 8192;

__device__ __forceinline__ void attn_unit(int b, int n, int kvh, bf16_t* Y, bf16_t* O, int ldo, const bf16_t* KB, const bf16_t* VB, const float* sink, LAS unsigned char* lds) {
    const int tid = threadIdx.x, lane = tid & 63, r32 = lane & 31, hi = lane >> 5, wid = __builtin_amdgcn_readfirstlane(tid >> 6);
    const int head = kvh * 4 + (wid >> 1);
    const int qrow0 = b * SEQ + n * 128 + (wid & 1) * 64;
    bf16_t* Qw = Y + (size_t)qrow0 * 2048 + 1024 + head * 64;
    LAS bf16x8* qst = (LAS bf16x8*)(lds + A_QST + wid * 8192) + lane;
#pragma unroll
    for (int sb = 0; sb < 2; ++sb)
#pragma unroll
        for (int d0 = 0; d0 < 4; ++d0) qst[(sb * 4 + d0) * 64] = *(const bf16x8*)(Qw + (size_t)(32 * sb + r32) * 2048 + d0 * 16 + hi * 8);
    f32x16 o[2][2];
#pragma unroll
    for (int sb = 0; sb < 2; ++sb)
#pragma unroll
        for (int d0 = 0; d0 < 2; ++d0)
#pragma unroll
            for (int r = 0; r < 16; ++r) o[sb][d0][r] = 0.f;
    float m[2] = {-1e30f, -1e30f}, l[2] = {0.f, 0.f};
    LAS float* wsf = (LAS float*)(lds + A_WS) + wid * 128;
    const int jlo = (n == 0) ? 2 : 0, jhi = (n == 31) ? 3 : 5, T = 4 + (jhi - jlo + 1);
    const size_t koff = (size_t)lane * 256 + wid * 8 + kvh * 64;
    const size_t voff = (size_t)(16 * (wid & 3) + (lane >> 2)) * 256 + (wid >> 2) * 32 + (lane & 3) * 8 + kvh * 64;
    auto tile_row = [&](int t) -> long { return t < 4 ? (long)(NTOK + b * CTXL + 64 * t) : (long)(b * SEQ + (n - 1) * 128 + 64 * (jlo + t - 4)); };
    auto issue = [&](int t) {
        const long row = tile_row(t); const int buf = t % 3;
        __builtin_amdgcn_global_load_lds((const unsigned*)(KB + row * 256 + koff), (LAS unsigned*)(lds + A_K + buf * 8192 + wid * 1024), 16, 0, 0);
        __builtin_amdgcn_global_load_lds((const unsigned*)(VB + row * 256 + voff), (LAS unsigned*)(lds + A_V + buf * 8192 + wid * 1024), 16, 0, 0);
    };
    issue(0); issue(1);
    int slot = 0;
    for (int t = 0; t < T; ++t) {
        if (t + 1 < T) asm volatile("s_waitcnt vmcnt(2) lgkmcnt(0)" ::: "memory"); else asm volatile("s_waitcnt vmcnt(0) lgkmcnt(0)" ::: "memory");
        __builtin_amdgcn_s_barrier();
        if (t + 2 < T) issue(t + 2);
        const lds_cptr Kt = (lds_cptr)(lds + A_K + slot * 8192) + hi * 1024 + r32 * 16;
        const lds_cptr Vt = (lds_cptr)(lds + A_V + slot * 8192) + ((lane >> 4) & 1) * 32 + (lane & 3) * 8 + (4 * hi + ((lane & 15) >> 2)) * 64;
        slot = (slot == 2) ? 0 : slot + 1;
        const bool local = t >= 4;
        const int dl = 64 * (jlo + t - 4) - 128 - 64 * (wid & 1);
        if (local && (dl > 160 || dl < -191)) continue;
        f32x16 p0[2], p1[2];
#pragma unroll
        for (int sb = 0; sb < 2; ++sb)
#pragma unroll
            for (int r = 0; r < 16; ++r) { p0[sb][r] = 0.f; p1[sb][r] = 0.f; }
#pragma unroll
        for (int d0 = 0; d0 < 4; ++d0) {
            const bf16x8 k0 = *(const __attribute__((address_space(3))) bf16x8*)(Kt + d0 * 2048), k1 = *(const __attribute__((address_space(3))) bf16x8*)(Kt + d0 * 2048 + 512);
#pragma unroll
            for (int sb = 0; sb < 2; ++sb) {
                const bf16x8 qf = qst[(sb * 4 + d0) * 64];
                p0[sb] = __builtin_amdgcn_mfma_f32_32x32x16_bf16(k0, qf, p0[sb], 0, 0, 0);
                p1[sb] = __builtin_amdgcn_mfma_f32_32x32x16_bf16(k1, qf, p1[sb], 0, 0, 0);
            }
        }
        if (local && (dl < -97 || dl > 65 || dl - 32 < -97)) {
#pragma unroll
            for (int sb = 0; sb < 2; ++sb)
#pragma unroll
                for (int r = 0; r < 16; ++r) { const int rel = dl - 32 * sb + crow(r, hi) - r32; if (rel < -128 || rel > 128) p0[sb][r] = -1e30f; if (rel + 32 < -128 || rel + 32 > 128) p1[sb][r] = -1e30f; }
        }
        float mn[2];
        asm volatile("s_nop 15\n\ts_nop 7" : "+v"(p0[0]), "+v"(p1[0]), "+v"(p0[1]), "+v"(p1[1]));
#pragma unroll
        for (int sb = 0; sb < 2; ++sb) {
            float a = max3f(p0[sb][0], p0[sb][1], p1[sb][0]), b2 = max3f(p0[sb][2], p0[sb][3], p1[sb][1]); a = max3f(a, p1[sb][2], p1[sb][3]);
#pragma unroll
            for (int r = 4; r < 16; r += 4) { a = max3f(a, p0[sb][r], p0[sb][r + 1]); b2 = max3f(b2, p0[sb][r + 2], p0[sb][r + 3]); a = max3f(a, p1[sb][r], p1[sb][r + 1]); b2 = max3f(b2, p1[sb][r + 2], p1[sb][r + 3]); }
            float rm = max2f(a, b2);
            rm = max2f(rm, swap_half(rm));
            mn[sb] = max2f(m[sb], rm);
        }
        if (__any((mn[0] > m[0]) || (mn[1] > m[1]))) {
            const float f0 = __builtin_amdgcn_exp2f(m[0] - mn[0]), f1 = __builtin_amdgcn_exp2f(m[1] - mn[1]);
            l[0] *= f0; l[1] *= f1;
            if (hi == 0) { wsf[r32] = f0; wsf[64 + r32] = f1; }
            asm volatile("s_waitcnt lgkmcnt(0)" ::: "memory");
#pragma unroll
            for (int r = 0; r < 16; ++r) { const float a = wsf[crow(r, hi)], b2 = wsf[64 + crow(r, hi)]; o[0][0][r] *= a; o[0][1][r] *= a; o[1][0][r] *= b2; o[1][1][r] *= b2; }
            m[0] = mn[0]; m[1] = mn[1];
        }
        u32x4 pw[2][4];
#pragma unroll
        for (int sb = 0; sb < 2; ++sb) {
            float sacc = 0.f;
#pragma unroll
            for (int r = 0; r < 16; ++r) { p0[sb][r] = __builtin_amdgcn_exp2f(p0[sb][r] - m[sb]); p1[sb][r] = __builtin_amdgcn_exp2f(p1[sb][r] - m[sb]); sacc += p0[sb][r] + p1[sb][r]; }
            l[sb] += sacc;
#pragma unroll
            for (int q = 0; q < 4; ++q) { pw[sb][0][q] = cvtpk(p0[sb][2 * q], p0[sb][2 * q + 1]); pw[sb][1][q] = cvtpk(p0[sb][8 + 2 * q], p0[sb][9 + 2 * q]); pw[sb][2][q] = cvtpk(p1[sb][2 * q], p1[sb][2 * q + 1]); pw[sb][3][q] = cvtpk(p1[sb][8 + 2 * q], p1[sb][9 + 2 * q]); }
        }
#pragma unroll
        for (int d0 = 0; d0 < 2; ++d0)
#pragma unroll
            for (int ks = 0; ks < 4; ++ks) {
                const s16x4 vlo = vtr(Vt + d0 * 4096 + ks * 1024), vhi = vtr(Vt + d0 * 4096 + ks * 1024 + 512);
                const bf16x8 vf = pk8(vlo, vhi);
#pragma unroll
                for (int sb = 0; sb < 2; ++sb) o[sb][d0] = __builtin_amdgcn_mfma_f32_32x32x16_bf16(__builtin_bit_cast(bf16x8, pw[sb][ks]), vf, o[sb][d0], 0, 0, 0);
            }
    }
    const float s2 = sink[head] * LOG2E;
    LAS bf16_t* stg = (LAS bf16_t*)(lds + A_OST + wid * A_OSTW);
#pragma unroll
    for (int sb = 0; sb < 2; ++sb) {
        const float lt = l[sb] + swap_half(l[sb]);
        const float mf = fmaxf(m[sb], s2), f = __builtin_amdgcn_exp2f(m[sb] - mf), den = lt * f + __builtin_amdgcn_exp2f(s2 - mf);
        asm volatile("s_waitcnt lgkmcnt(0)" ::: "memory");
        if (hi == 0) wsf[sb * 64 + r32] = f / den;
        asm volatile("s_waitcnt lgkmcnt(0)" ::: "memory");
#pragma unroll
        for (int r = 0; r < 16; ++r) { const float sc = wsf[sb * 64 + crow(r, hi)]; const int orow = crow(r, hi);
            stg[orow * 64 + r32] = (bf16_t)f2bf(o[sb][0][r] * sc); stg[orow * 64 + 32 + r32] = (bf16_t)f2bf(o[sb][1][r] * sc); }
        asm volatile("s_waitcnt lgkmcnt(0)" ::: "memory");
#pragma unroll
        for (int i = 0; i < 4; ++i) { const int row = i * 8 + (lane >> 3), ch = lane & 7; const u32x4 v = *(const LAS u32x4*)(stg + row * 64 + ch * 8); *(u32x4*)(O + (size_t)(qrow0 + 32 * sb + row) * ldo + head * 64 + ch * 8) = v; }
        asm volatile("s_waitcnt lgkmcnt(0)" ::: "memory");
    }
    __syncthreads();
}

constexpr int G_V = 0, G_ST = 65536, G_STW = 8704, G_MU = G_ST + 8 * G_STW;
__device__ __forceinline__ void gmlp_unit(int task, bf16_t* Y, bf16_t* YO, int ldo, const bf16_t* VA, const bf16_t* WSP, const f32x2* STATS, const float* ln_g, const float* ln_b, const float* b_sp, LAS unsigned char* lds) {
    const int tid = threadIdx.x, lane = tid & 63, r32 = lane & 31, hi = lane >> 5, wid = __builtin_amdgcn_readfirstlane(tid >> 6);
    const int r0 = task * 128;
    LAS float* mu = (LAS float*)(lds + G_MU); LAS float* rs = mu + 128;
    if (tid < 128) {
        const f32x4* sp = (const f32x4*)(STATS + (size_t)(r0 + tid) * 16); float s = 0.f, ss = 0.f;
#pragma unroll
        for (int i = 0; i < 8; ++i) { const f32x4 v = sp[i]; s += v.x + v.z; ss += v.y + v.w; }
        const float mean = s * (1.f / 1024.f), var = fmaxf(ss * (1.f / 1024.f) - mean * mean, 0.f);
        mu[tid] = mean; rs[tid] = 1.0f / sqrtf(var + EPS);
    }
    u32x4 raw[4];
#pragma unroll
    for (int i = 0; i < 4; ++i) { const int idx = tid + NTHREADS * i, q = idx >> 4, c8 = idx & 15; raw[i] = *(const u32x4*)(VA + (size_t)(r0 + q) * 1024 + c8 * 8); }
    __syncthreads();
    const int pb = wid >> 1, dh = wid & 1;
    LAS float* st = (LAS float*)(lds + G_ST + wid * G_STW);
    for (int g8 = 0; g8 < 8; ++g8) {
        LAS unsigned char* vb = lds + G_V + (g8 & 1) * 32768;
#pragma unroll
        for (int i = 0; i < 4; ++i) {
            const int idx = tid + NTHREADS * i, q = idx >> 4, c8 = idx & 15, d = c8 * 8;
            const f32x4 g0 = *(const f32x4*)(ln_g + g8 * 128 + d), g1 = *(const f32x4*)(ln_g + g8 * 128 + d + 4), b0 = *(const f32x4*)(ln_b + g8 * 128 + d), b1 = *(const f32x4*)(ln_b + g8 * 128 + d + 4);
            const float mq = mu[q], rq = rs[q]; const u32x4 rw = raw[i];
            float v[8] = {bf2f(rw.x & 0xffffu), bf2f(rw.x >> 16), bf2f(rw.y & 0xffffu), bf2f(rw.y >> 16), bf2f(rw.z & 0xffffu), bf2f(rw.z >> 16), bf2f(rw.w & 0xffffu), bf2f(rw.w >> 16)};
#pragma unroll
            for (int e = 0; e < 4; ++e) { v[e] = (v[e] - mq) * rq * g0[e] + b0[e]; v[4 + e] = (v[4 + e] - mq) * rq * g1[e] + b1[e]; }
            u32x4 w; w.x = pk2(v[0], v[1]); w.y = pk2(v[2], v[3]); w.z = pk2(v[4], v[5]); w.w = pk2(v[6], v[7]);
            *(LAS u32x4*)(vb + ((d >> 5) * 8 + (q >> 4)) * 1024 + (q & 15) * 64 + (d & 31) * 2) = w;
        }
        if (g8 + 1 < 8) {
#pragma unroll
            for (int i = 0; i < 4; ++i) { const int idx = tid + NTHREADS * i, q = idx >> 4, c8 = idx & 15; raw[i] = *(const u32x4*)(VA + (size_t)(r0 + q) * 1024 + (g8 + 1) * 128 + c8 * 8); }
        }
        u32x4 ur[4]; bf16x8 af[8];
        const size_t ybase = (size_t)(r0 + 32 * pb + (lane >> 3)) * 2048 + g8 * 128 + 64 * dh + (lane & 7) * 8;
#pragma unroll
        for (int i = 0; i < 4; ++i) ur[i] = *(const u32x4*)(Y + ybase + (size_t)(8 * i) * 2048);
        const bf16_t* wrow = WSP + (size_t)g8 * 16384 + (size_t)(32 * pb + r32) * 128 + 8 * hi;
#pragma unroll
        for (int ks = 0; ks < 8; ++ks) af[ks] = *(const bf16x8*)(wrow + 16 * ks);
        __syncthreads();
        const lds_cptr Vb = (lds_cptr)vb + ((lane >> 4) & 1) * 32 + (lane & 3) * 8 + (8 * hi + ((lane & 15) >> 2)) * 64;
        f32x16 acc[2];
#pragma unroll
        for (int t2 = 0; t2 < 2; ++t2)
#pragma unroll
            for (int r = 0; r < 16; ++r) acc[t2][r] = 0.f;
#pragma unroll
        for (int ks = 0; ks < 8; ++ks) {
#pragma unroll
            for (int t2 = 0; t2 < 2; ++t2) {
                const int db = 2 * dh + t2;
                const s16x4 vlo = vtr(Vb + (db * 8 + ks) * 1024), vhi = vtr(Vb + (db * 8 + ks) * 1024 + 256);
                acc[t2] = __builtin_amdgcn_mfma_f32_32x32x16_bf16(af[ks], pk8(vlo, vhi), acc[t2], 0, 0, 0);
            }
        }
#pragma unroll
        for (int t2 = 0; t2 < 2; ++t2)
#pragma unroll
            for (int r = 0; r < 16; ++r) st[crow(r, hi) * 68 + 32 * t2 + r32] = acc[t2][r];
        asm volatile("s_waitcnt lgkmcnt(0)" ::: "memory");
#pragma unroll
        for (int i = 0; i < 4; ++i) {
            const int prow = 8 * i + (lane >> 3), ch = lane & 7;
            const f32x4 m0 = *(const LAS f32x4*)(st + prow * 68 + ch * 8), m1 = *(const LAS f32x4*)(st + prow * 68 + ch * 8 + 4);
            const float bs = b_sp[g8 * 128 + 32 * pb + prow]; const u32x4 uw = ur[i];
            u32x4 o;
            o.x = pk2(bf2f(uw.x & 0xffffu) * (m0.x + bs), bf2f(uw.x >> 16) * (m0.y + bs)); o.y = pk2(bf2f(uw.y & 0xffffu) * (m0.z + bs), bf2f(uw.y >> 16) * (m0.w + bs));
            o.z = pk2(bf2f(uw.z & 0xffffu) * (m1.x + bs), bf2f(uw.z >> 16) * (m1.y + bs)); o.w = pk2(bf2f(uw.w & 0xffffu) * (m1.z + bs), bf2f(uw.w >> 16) * (m1.w + bs));
            *(u32x4*)(YO + (size_t)(r0 + 32 * pb + prow) * ldo + g8 * 128 + 64 * dh + ch * 8) = o;
        }
        asm volatile("s_waitcnt lgkmcnt(0)" ::: "memory");
    }
    __syncthreads();
}
}

namespace att2 {
typedef short bf16x8 __attribute__((ext_vector_type(8)));
typedef short s16x4 __attribute__((ext_vector_type(4)));
typedef float f32x16 __attribute__((ext_vector_type(16)));
typedef __attribute__((address_space(3))) const char* lds_cptr;
typedef short v4i16_t __attribute__((ext_vector_type(4)));
__device__ __forceinline__ int crow(int r, int hi) { return (r & 3) + 8 * (r >> 2) + 4 * hi; }
#define SBAR() __builtin_amdgcn_sched_barrier(0)
constexpr int NSLOT = 3, SLOTB = 8192;
constexpr int LDS_K = 0, LDS_V = NSLOT * SLOTB, LDS_WS = 2 * NSLOT * SLOTB, LDS_OST = LDS_WS + 8 * 64 * 4, LDS_BYTES = LDS_OST + 8 * 4096;
__device__ __forceinline__ void glds16(const void* gsrc, unsigned lds_dst) { unsigned keep;
    asm volatile("s_mov_b32 %0, m0\n\ts_mov_b32 m0, %2\n\ts_nop 0\n\tglobal_load_lds_dwordx4 %1, off\n\ts_mov_b32 m0, %0" : "=&s"(keep) : "v"(gsrc), "s"(lds_dst) : "memory"); }
__device__ __forceinline__ float max3f(float a, float b, float c) { float r; asm("v_max3_f32 %0, %1, %2, %3" : "=v"(r) : "v"(a), "v"(b), "v"(c)); return r; }
__device__ __forceinline__ float max2f(float a, float b) { float r; asm("v_max_f32_e32 %0, %1, %2" : "=v"(r) : "v"(a), "v"(b)); return r; }
__device__ __forceinline__ float fadd_s(float a, float b) { float r; asm("v_add_f32_e32 %0, %1, %2" : "=v"(r) : "v"(a), "v"(b)); return r; }
__device__ __forceinline__ float fsub_s(float a, float b) { float r; asm("v_sub_f32_e32 %0, %1, %2" : "=v"(r) : "v"(a), "v"(b)); return r; }
typedef float f32x2_t __attribute__((ext_vector_type(2))); typedef __bf16 bf16x2_t __attribute__((ext_vector_type(2)));
__device__ __forceinline__ unsigned cvtpk_s(float lo, float hi) { f32x2_t v = {lo, hi}; bf16x2_t b = __builtin_convertvector(v, bf16x2_t); return __builtin_bit_cast(unsigned, b); }
#define WAIT_BAR(N) asm volatile("s_waitcnt vmcnt(" #N ") lgkmcnt(0)\n\ts_barrier" ::: "memory")
__device__ __forceinline__ void qkt(f32x16& p0, f32x16& p1, lds_cptr Kslot, const bf16x8* qr, const f32x16& negm, int r32, int hi) {
    const lds_cptr kb = Kslot + hi * 1024 + r32 * 16;
#pragma unroll
    for (int d0 = 0; d0 < 4; ++d0) {
        const bf16x8 b0 = *(const __attribute__((address_space(3))) bf16x8*)(kb + d0 * 2048);
        const bf16x8 b1 = *(const __attribute__((address_space(3))) bf16x8*)(kb + d0 * 2048 + 512);
        if (d0 == 0) { p0 = __builtin_amdgcn_mfma_f32_32x32x16_bf16(b0, qr[0], negm, 0, 0, 0); p1 = __builtin_amdgcn_mfma_f32_32x32x16_bf16(b1, qr[0], negm, 0, 0, 0); }
        else { p0 = __builtin_amdgcn_mfma_f32_32x32x16_bf16(b0, qr[d0], p0, 0, 0, 0); p1 = __builtin_amdgcn_mfma_f32_32x32x16_bf16(b1, qr[d0], p1, 0, 0, 0); }
    }
}
__device__ __forceinline__ void kload8(bf16x8* kf, lds_cptr kp) {
    kf[0] = *(const __attribute__((address_space(3))) bf16x8*)(kp);        kf[1] = *(const __attribute__((address_space(3))) bf16x8*)(kp + 512);
    kf[2] = *(const __attribute__((address_space(3))) bf16x8*)(kp + 2048); kf[3] = *(const __attribute__((address_space(3))) bf16x8*)(kp + 2560);
    kf[4] = *(const __attribute__((address_space(3))) bf16x8*)(kp + 4096); kf[5] = *(const __attribute__((address_space(3))) bf16x8*)(kp + 4608);
    kf[6] = *(const __attribute__((address_space(3))) bf16x8*)(kp + 6144); kf[7] = *(const __attribute__((address_space(3))) bf16x8*)(kp + 6656);
}
__device__ __forceinline__ void kload2(bf16x8* kf, lds_cptr kp, int j) { kf[2 * j] = *(const __attribute__((address_space(3))) bf16x8*)(kp + j * 2048); kf[2 * j + 1] = *(const __attribute__((address_space(3))) bf16x8*)(kp + j * 2048 + 512); }
__device__ __forceinline__ s16x4 vtr(lds_cptr p) { return __builtin_bit_cast(s16x4, __builtin_amdgcn_ds_read_tr16_b64_v4i16((__attribute__((address_space(3))) v4i16_t*)p)); }
__device__ __forceinline__ float rowmax(const f32x16& p0, const f32x16& p1) {
    float a = max3f(p0[0], p0[1], p1[0]), b = max3f(p0[2], p0[3], p1[1]); a = max3f(a, p1[2], p1[3]);
#pragma unroll
    for (int r = 4; r < 16; r += 4) { a = max3f(a, p0[r], p0[r + 1]); b = max3f(b, p0[r + 2], p0[r + 3]); a = max3f(a, p1[r], p1[r + 1]); b = max3f(b, p1[r + 2], p1[r + 3]); }
    const float m = max2f(a, b);
    auto rr = __builtin_amdgcn_permlane32_swap(__float_as_uint(m), __float_as_uint(m), false, false);
    return max2f(__uint_as_float(rr[0]), __uint_as_float(rr[1]));
}
__device__ __forceinline__ void pv(f32x16* o, int vb, bf16x8 pa0, bf16x8 pa1, bf16x8 pa2, bf16x8 pa3) {
#pragma unroll
    for (int d0 = 0; d0 < 2; ++d0) { s16x4 lo[4], hi[4];
#pragma unroll
        for (int ks = 0; ks < 4; ++ks) {
            asm volatile("ds_read_b64_tr_b16 %0,%1 offset:%c2" : "=&v"(lo[ks]) : "v"(vb), "i"(d0 * 4096 + ks * 1024) : "memory");
            asm volatile("ds_read_b64_tr_b16 %0,%1 offset:%c2" : "=&v"(hi[ks]) : "v"(vb), "i"(d0 * 4096 + ks * 1024 + 512) : "memory"); }
        asm volatile("s_waitcnt lgkmcnt(0)" ::: "memory"); SBAR();
#define PK(k) (bf16x8){lo[k][0], lo[k][1], lo[k][2], lo[k][3], hi[k][0], hi[k][1], hi[k][2], hi[k][3]}
        o[d0] = __builtin_amdgcn_mfma_f32_32x32x16_bf16(pa0, PK(0), o[d0], 0, 0, 0);
        o[d0] = __builtin_amdgcn_mfma_f32_32x32x16_bf16(pa1, PK(1), o[d0], 0, 0, 0);
        o[d0] = __builtin_amdgcn_mfma_f32_32x32x16_bf16(pa2, PK(2), o[d0], 0, 0, 0);
        o[d0] = __builtin_amdgcn_mfma_f32_32x32x16_bf16(pa3, PK(3), o[d0], 0, 0, 0);
#undef PK
    }
}
__device__ __forceinline__ void wmask(f32x16& p0, f32x16& p1, int dl, int r32, int hi) {
    const float NEG = -INFINITY;
#pragma unroll
    for (int r = 0; r < 16; ++r) { const int rel = dl + crow(r, hi) - r32; if (rel < -128 || rel > 128) p0[r] = NEG; if (rel + 32 < -128 || rel + 32 > 128) p1[r] = NEG; }
}

template <int THRL> __device__ __forceinline__ void attn_unit(int b, int n, int kvh, int hp, int base, bool primed, bool has_next, int nb, int nn, int nkvh, int nhp, bf16x8 (&qr)[4], int& nbase,
                                                              const bf16_t* Y, bf16_t* O, int ldo, const bf16_t* KB, const bf16_t* VB, const float* sink, LAS unsigned char* shm) {
    const int tid = threadIdx.x, lane = tid & 63, r32 = lane & 31, hi = lane >> 5; const int wid = __builtin_amdgcn_readfirstlane(tid >> 6);
    const int head = kvh * 4 + hp * 2 + (wid >> 2), qsub = wid & 3;
    const long qrow0 = (long)b * SEQ + n * 128 + qsub * 32;
    const bf16_t* Qw = Y + qrow0 * 2048 + 1024 + head * 64;
    const unsigned lds0 = (unsigned)(uintptr_t)shm;
    LAS float* wsf = (LAS float*)(shm + LDS_WS) + wid * 64;
    const long koff = (long)lane * 256 + kvh * 64 + wid * 8;
    const long voff = (long)(16 * (wid & 3) + (lane >> 2)) * 256 + kvh * 64 + (wid >> 2) * 32 + (lane & 3) * 8;
    const unsigned kdst = lds0 + LDS_K + wid * 1024, vdst = lds0 + LDS_V + wid * 1024;
    const int jlo = (n == 0) ? 2 : 0, jhi = (n == 31) ? 3 : 5, NT = 4 + (jhi - jlo + 1);
    const long lrow0 = (long)b * SEQ + (n - 1) * 128 + 64 * (jlo - 4), crow0 = (long)NTOK + b * CTXL;
#define TROW(t) ((t) < 4 ? crow0 + 64 * (t) : lrow0 + 64 * (t))
#define DMA_K(t, slot) glds16(KB + TROW(t) * 256 + koff, (unsigned)__builtin_amdgcn_readfirstlane(kdst + (slot)))
#define DMA_V(t, slot) glds16(VB + TROW(t) * 256 + voff, (unsigned)__builtin_amdgcn_readfirstlane(vdst + (slot)))
    const int vb0 = (int)(lds0 + LDS_V) + ((lane >> 4) & 1) * 32 + (lane & 3) * 8 + (4 * hi + ((lane & 15) >> 2)) * 64;
    bf16x8 kf[8];
    const lds_cptr shm3 = (lds_cptr)shm; const lds_cptr kp0 = shm3 + LDS_K + hi * 1024 + r32 * 16; const lds_cptr vp0 = shm3 + LDS_V + ((lane >> 4) & 1) * 32 + (lane & 3) * 8 + (4 * hi + ((lane & 15) >> 2)) * 64;
    const int s0 = base, s1 = (s0 == (NSLOT - 1) * SLOTB) ? 0 : s0 + SLOTB, s2 = (s1 == (NSLOT - 1) * SLOTB) ? 0 : s1 + SLOTB;
    if (!primed) {
        DMA_K(0, s0); DMA_V(0, s0); DMA_K(1, s1); DMA_K(2, s2);
#pragma unroll
        for (int d0 = 0; d0 < 4; ++d0) qr[d0] = *(const bf16x8*)(Qw + (long)r32 * 2048 + d0 * 16 + hi * 8);
    }
    float mhat = 0.f, l_reg = 0.f; f32x16 o[2]; o[0] = f32x16{}; o[1] = f32x16{}; f32x16 negm = f32x16{}; asm volatile("" : "+v"(negm));
    const int dq = -128 - 32 * qsub;
#define CMASK(P0, P1, t) do { if ((t) >= 4) { const int dl_ = 64 * (jlo + (t) - 4) + dq; if (dl_ < -97 || dl_ > 65) wmask(P0, P1, dl_, r32, hi); } } while (0)
    bool resc = false;
#define START(P0, P1) do { const float rm = rowmax(P0, P1); resc = false; \
    { const float dl = rm; mhat = fadd_s(mhat, dl); \
      _Pragma("unroll") for (int r = 0; r < 16; ++r) { P0[r] = fsub_s(P0[r], dl); P1[r] = fsub_s(P1[r], dl); } \
      _Pragma("unroll") for (int r = 0; r < 16; ++r) negm[r] = -mhat; asm volatile("" : "+v"(negm)); } \
    _Pragma("unroll") for (int r = 0; r < 16; ++r) P0[r] = __builtin_amdgcn_exp2f(P0[r]); } while (0)
#define RESC() do { if (resc) { asm volatile("s_waitcnt lgkmcnt(0)" ::: "memory"); \
      _Pragma("unroll") for (int d_ = 0; d_ < 2; ++d_) _Pragma("unroll") for (int r = 0; r < 16; ++r) o[d_][r] *= wsf[crow(r, hi)]; } } while (0)
    f32x16 pA0, pA1, pB0, pB1;
    int sl_prev = s0, sl_cur = s0, sl_next = s1;
#define ROT() do { sl_prev = sl_cur; sl_cur = sl_next; sl_next = (sl_next == (NSLOT - 1) * SLOTB) ? 0 : sl_next + SLOTB; } while (0)
    WAIT_BAR(7);
    qkt(pA0, pA1, shm3 + LDS_K + s0, qr, negm, r32, hi); asm volatile("s_nop 15\n\ts_nop 7" : "+v"(pA0), "+v"(pA1)); CMASK(pA0, pA1, 0);
    START(pA0, pA1);
    _Pragma("unroll") for (int r = 0; r < 16; ++r) pA1[r] = __builtin_amdgcn_exp2f(pA1[r]);
    WAIT_BAR(0);
    DMA_K(3, s0); DMA_V(1, s1);
    ROT();
    kload8(kf, kp0 + sl_cur);
    WAIT_BAR(2);
    s16x4 vlo[8], vhi[8]; u32x4 pw0, pw1, pw2, pw3;
#define PKW(P, B) cvtpk_s(P[B], P[B + 1])
#define PAF(k) __builtin_bit_cast(bf16x8, pw##k)
#define VFR(i) (bf16x8){vlo[i][0], vlo[i][1], vlo[i][2], vlo[i][3], vhi[i][0], vhi[i][1], vhi[i][2], vhi[i][3]}
#define PIN(x) asm volatile("" : "+v"(x))
#define MX3(a, b, c) __builtin_fmaxf(__builtin_fmaxf((a), (b)), (c))
#define GAPA(MF, A0, A1, A2, A3, W0, W1, PW) do { MF; sacc += A0; sacc += A1; sacc += A2; sacc += A3; PIN(sacc); W0; W1; PIN(PW); SBAR(); } while (0)
#define EX(v) __builtin_amdgcn_exp2f(v)
#define GAPB(MF, X, B) do { MF; X[B] = EX(X[B]); X[B + 1] = EX(X[B + 1]); X[B + 2] = EX(X[B + 2]); X[B + 3] = EX(X[B + 3]); PIN(X); SBAR(); } while (0)
#define VRD(i) do { vlo[i] = vtr(vp_ + (((i) >> 2) * 4096 + ((i) & 3) * 1024)); vhi[i] = vtr(vp_ + (((i) >> 2) * 4096 + ((i) & 3) * 1024 + 512)); } while (0)
#define KRD(G, j) do { if (G) { kload2(kf, kp0 + sl_next, j); SBAR(); } } while (0)
#define STEP(C0, C1, P0, P1, t, GK, GV, GL) do { SBAR(); \
    const lds_cptr vp_ = vp0 + sl_prev; \
    VRD(0); SBAR(); float sacc = (P0[0] + P0[1]); \
    GAPA(C0 = __builtin_amdgcn_mfma_f32_32x32x16_bf16(kf[0], qr[0], negm, 0, 0, 0), P0[2], P0[3], P0[4], P0[5],     pw0[0] = PKW(P0, 0), pw0[1] = PKW(P0, 2), pw0); \
    VRD(4); SBAR(); GAPA(C1 = __builtin_amdgcn_mfma_f32_32x32x16_bf16(kf[1], qr[0], negm, 0, 0, 0), P0[6], P0[7], P0[8], P0[9],     pw0[2] = PKW(P0, 4), pw0[3] = PKW(P0, 6), pw0); \
    VRD(1); SBAR(); GAPA(C0 = __builtin_amdgcn_mfma_f32_32x32x16_bf16(kf[2], qr[1], C0, 0, 0, 0),   P0[10], P0[11], P0[12], P0[13], pw1[0] = PKW(P0, 8), pw1[1] = PKW(P0, 10), pw1); \
    VRD(5); SBAR(); GAPA(C1 = __builtin_amdgcn_mfma_f32_32x32x16_bf16(kf[3], qr[1], C1, 0, 0, 0),   P0[14], P0[15], P1[0], P1[1],   pw1[2] = PKW(P0, 12), pw1[3] = PKW(P0, 14), pw1); \
    VRD(2); SBAR(); GAPA(C0 = __builtin_amdgcn_mfma_f32_32x32x16_bf16(kf[4], qr[2], C0, 0, 0, 0),   P1[2], P1[3], P1[4], P1[5],     pw2[0] = PKW(P1, 0), pw2[1] = PKW(P1, 2), pw2); \
    VRD(6); SBAR(); GAPA(C1 = __builtin_amdgcn_mfma_f32_32x32x16_bf16(kf[5], qr[2], C1, 0, 0, 0),   P1[6], P1[7], P1[8], P1[9],     pw2[2] = PKW(P1, 4), pw2[3] = PKW(P1, 6), pw2); \
    VRD(3); SBAR(); GAPA(C0 = __builtin_amdgcn_mfma_f32_32x32x16_bf16(kf[6], qr[3], C0, 0, 0, 0),   P1[10], P1[11], P1[12], P1[13], pw3[0] = PKW(P1, 8), pw3[1] = PKW(P1, 10), pw3); \
    VRD(7); SBAR(); GAPA(C1 = __builtin_amdgcn_mfma_f32_32x32x16_bf16(kf[7], qr[3], C1, 0, 0, 0),   P1[14], P1[15], 0.f, 0.f,       pw3[2] = PKW(P1, 12), pw3[3] = PKW(P1, 14), pw3); \
    l_reg += sacc; \
    if (GK) { DMA_K((t) + 3, sl_cur); } if (GV) { DMA_V((t) + 1, sl_next); } \
    CMASK(C0, C1, t); \
    { float a = MX3(C0[0], C0[1], C1[0]), b2 = MX3(C0[2], C0[3], C1[1]); a = MX3(a, C1[2], C1[3]); \
      _Pragma("unroll") for (int r = 4; r < 16; r += 4) { a = MX3(a, C0[r], C0[r + 1]); b2 = MX3(b2, C0[r + 2], C0[r + 3]); a = MX3(a, C1[r], C1[r + 1]); b2 = MX3(b2, C1[r + 2], C1[r + 3]); } \
      float rm = __builtin_fmaxf(a, b2); { auto rr = __builtin_amdgcn_permlane32_swap(__float_as_uint(rm), __float_as_uint(rm), false, false); rm = __builtin_fmaxf(__uint_as_float(rr[0]), __uint_as_float(rr[1])); } \
      resc = false; \
      if (__builtin_expect(__any(rm > (float)THRL), 0)) { const float dl = __builtin_fmaxf(rm, 0.f); mhat += dl; \
        _Pragma("unroll") for (int r = 0; r < 16; ++r) { C0[r] -= dl; C1[r] -= dl; } \
        _Pragma("unroll") for (int r = 0; r < 16; ++r) negm[r] = -mhat; asm volatile("" : "+v"(negm)); \
        const float f = __builtin_amdgcn_exp2f(-dl); l_reg *= f; if (hi == 0) wsf[r32] = f; resc = true; } } \
    SBAR(); \
    GAPB(o[0] = __builtin_amdgcn_mfma_f32_32x32x16_bf16(PAF(0), VFR(0), o[0], 0, 0, 0), C0, 0); \
    GAPB(o[1] = __builtin_amdgcn_mfma_f32_32x32x16_bf16(PAF(0), VFR(4), o[1], 0, 0, 0), C0, 4); \
    KRD(GL, 0); GAPB(o[0] = __builtin_amdgcn_mfma_f32_32x32x16_bf16(PAF(1), VFR(1), o[0], 0, 0, 0), C0, 8); \
    KRD(GL, 1); GAPB(o[1] = __builtin_amdgcn_mfma_f32_32x32x16_bf16(PAF(1), VFR(5), o[1], 0, 0, 0), C0, 12); \
    KRD(GL, 2); GAPB(o[0] = __builtin_amdgcn_mfma_f32_32x32x16_bf16(PAF(2), VFR(2), o[0], 0, 0, 0), C1, 0); \
    KRD(GL, 3); GAPB(o[1] = __builtin_amdgcn_mfma_f32_32x32x16_bf16(PAF(2), VFR(6), o[1], 0, 0, 0), C1, 4); \
    GAPB(o[0] = __builtin_amdgcn_mfma_f32_32x32x16_bf16(PAF(3), VFR(3), o[0], 0, 0, 0), C1, 8); \
    GAPB(o[1] = __builtin_amdgcn_mfma_f32_32x32x16_bf16(PAF(3), VFR(7), o[1], 0, 0, 0), C1, 12); \
    } while (0)
#define ENDW(tt) do { if ((tt) + 3 < NT) { WAIT_BAR(2); } else if ((tt) + 2 < NT) { WAIT_BAR(1); } else { WAIT_BAR(0); } } while (0)
    int t = 1;
    for (; t + 1 < NT; t += 2) {
        STEP(pB0, pB1, pA0, pA1, t, (t + 3 < NT), (t + 1 < NT), (t + 1 < NT));       ENDW(t);     RESC(); ROT();
        STEP(pA0, pA1, pB0, pB1, t + 1, (t + 4 < NT), (t + 2 < NT), (t + 2 < NT));   ENDW(t + 1); RESC(); ROT();
    }
    nbase = sl_next;
    if (has_next) {
        const long nr = (long)NTOK + nb * CTXL; const long nko = (long)lane * 256 + nkvh * 64 + wid * 8, nvo = (long)(16 * (wid & 3) + (lane >> 2)) * 256 + nkvh * 64 + (wid >> 2) * 32 + (lane & 3) * 8;
        const int n0 = sl_next, n1 = (n0 == (NSLOT - 1) * SLOTB) ? 0 : n0 + SLOTB, n2 = (n1 == (NSLOT - 1) * SLOTB) ? 0 : n1 + SLOTB;
        glds16(KB + nr * 256 + nko, (unsigned)__builtin_amdgcn_readfirstlane(kdst + n0)); glds16(VB + nr * 256 + nvo, (unsigned)__builtin_amdgcn_readfirstlane(vdst + n0));
        glds16(KB + (nr + 64) * 256 + nko, (unsigned)__builtin_amdgcn_readfirstlane(kdst + n1)); glds16(KB + (nr + 128) * 256 + nko, (unsigned)__builtin_amdgcn_readfirstlane(kdst + n2));
    }
    STEP(pB0, pB1, pA0, pA1, NT - 1, false, false, false); RESC();
    { float sacc = pB0[0] + pB0[1]; _Pragma("unroll") for (int r = 2; r < 16; ++r) sacc += pB0[r]; _Pragma("unroll") for (int r = 0; r < 16; ++r) sacc += pB1[r]; l_reg += sacc;
      pw0 = (u32x4){PKW(pB0, 0), PKW(pB0, 2), PKW(pB0, 4), PKW(pB0, 6)}; pw1 = (u32x4){PKW(pB0, 8), PKW(pB0, 10), PKW(pB0, 12), PKW(pB0, 14)}; pw2 = (u32x4){PKW(pB1, 0), PKW(pB1, 2), PKW(pB1, 4), PKW(pB1, 6)}; pw3 = (u32x4){PKW(pB1, 8), PKW(pB1, 10), PKW(pB1, 12), PKW(pB1, 14)};
      SBAR(); pv(o, vb0 + sl_cur, PAF(0), PAF(1), PAF(2), PAF(3)); }
    if (has_next) {
        asm volatile("" ::: "memory");
        const bf16_t* nQw = Y + ((long)nb * SEQ + nn * 128 + qsub * 32) * 2048 + 1024 + (nkvh * 4 + nhp * 2 + (wid >> 2)) * 64;
#pragma unroll
        for (int d0 = 0; d0 < 4; ++d0) qr[d0] = *(const bf16x8*)(nQw + (long)r32 * 2048 + d0 * 16 + hi * 8);
    }
    { auto rr = __builtin_amdgcn_permlane32_swap(__float_as_uint(l_reg), __float_as_uint(l_reg), false, false); l_reg = __uint_as_float(rr[0]) + __uint_as_float(rr[1]); }
    l_reg += __builtin_amdgcn_exp2f(fminf(sink[head] * LOG2E - mhat, 80.f));
    if (hi == 0) wsf[32 + r32] = l_reg; asm volatile("s_waitcnt lgkmcnt(0)" ::: "memory");
    float rli[16];
#pragma unroll
    for (int r = 0; r < 16; ++r) rli[r] = __builtin_amdgcn_rcpf(wsf[32 + crow(r, hi)]);
    bf16_t* Ow = O + qrow0 * ldo + head * 64;
    { LAS bf16_t* stg = (LAS bf16_t*)(shm + LDS_OST) + wid * 2048;
#pragma unroll
      for (int r = 0; r < 16; ++r) { const int orow = crow(r, hi);
#pragma unroll
          for (int d0 = 0; d0 < 2; ++d0) stg[orow * 64 + d0 * 32 + r32] = (bf16_t)(pk2(o[d0][r] * rli[r], 0.f) & 0xffffu); }
      asm volatile("s_waitcnt lgkmcnt(0)" ::: "memory");
#pragma unroll
      for (int i = 0; i < 4; ++i) { const int row = i * 8 + (lane >> 3), ch = lane & 7; const u32x4 v = *(const LAS u32x4*)(stg + row * 64 + ch * 8); *(u32x4*)(Ow + (long)row * ldo + ch * 8) = v; } }
    asm volatile("s_waitcnt lgkmcnt(0)\n\ts_barrier" ::: "memory");
#undef TROW
#undef DMA_K
#undef DMA_V
#undef CMASK
#undef START
#undef RESC
#undef ROT
#undef PKW
#undef PAF
#undef VFR
#undef PIN
#undef MX3
#undef GAPA
#undef GAPB
#undef EX
#undef VRD
#undef KRD
#undef STEP
#undef ENDW
}
#undef SBAR
#undef WAIT_BAR
}

#define XB_TMO      128
#define XB_XCNT(j)  (256  + 64 * (j))
#define XB_XSUB(j)  (1280 + 64 * (j))
#define XB_XGEN(j)  (2304 + 64 * (j))
#define XB_TOP      3328
#define XB_TOPGEN   3392
#define XCD_BAR_WORDS 3456
#define XB_SPIN_CAP (1u << 18)
__device__ __forceinline__ unsigned xb_ld(unsigned* p)              { return __hip_atomic_load(p, __ATOMIC_RELAXED, __HIP_MEMORY_SCOPE_AGENT); }
__device__ __forceinline__ unsigned xb_add(unsigned* p, unsigned v) { return __hip_atomic_fetch_add(p, v, __ATOMIC_RELAXED, __HIP_MEMORY_SCOPE_AGENT); }
__device__ __forceinline__ unsigned xb_xcc_id() { return (unsigned)__builtin_amdgcn_s_getreg((3 << 11) | 20) & 0xFu; }
#define XB_SPIN(cond, bar) do { unsigned _sp = 0; while (cond) { __builtin_amdgcn_s_sleep(1); \
    if ((++_sp & 255u) == 0u) { if (xb_ld(&(bar)[XB_TMO])) break; if (_sp > XB_SPIN_CAP) { atomicAdd(&(bar)[XB_TMO], 1u); break; } } } } while (0)
struct XcdBarrier { unsigned* bar; unsigned x; volatile LAS unsigned* st; };
__device__ __forceinline__ XcdBarrier xcd_barrier_post(unsigned* bar, volatile LAS unsigned* st) {
    XcdBarrier b; b.bar = bar; b.x = xb_xcc_id(); b.st = st;
    if (threadIdx.x == 0) (void)xb_add(&bar[XB_XCNT(b.x)], 1u);
    return b;
}
__device__ __forceinline__ void xcd_barrier_complete(unsigned* bar, unsigned x, unsigned& nloc, unsigned& nx) {
    const unsigned G = gridDim.x * gridDim.y * gridDim.z;
    unsigned sum, cnt, mine, sp = 0u;
    for (;;) {
        sum = 0u; cnt = 0u; mine = 0u;
#pragma unroll
        for (unsigned j = 0; j < 16; ++j) { const unsigned c = xb_ld(&bar[XB_XCNT(j)]); sum += c; cnt += (c > 0u) ? 1u : 0u; mine = (j == x) ? c : mine; }
        if (sum == G) break;
        __builtin_amdgcn_s_sleep(1);
        if ((++sp & 255u) == 0u) { if (xb_ld(&bar[XB_TMO])) break; if (sp > XB_SPIN_CAP) { atomicAdd(&bar[XB_TMO], 1u); break; } }
    }
    nloc = mine > 0u ? mine : 1u; nx = cnt > 0u ? cnt : 1u;
}
__device__ __forceinline__ void xcd_barrier(const XcdBarrier& b) {
    asm volatile("s_waitcnt vmcnt(0)" ::: "memory");
    __syncthreads();
    if (threadIdx.x == 0) {
        unsigned* bar = b.bar;
        __builtin_amdgcn_s_waitcnt(0);
        unsigned nloc = b.st[0], nx = b.st[1];
        if (nloc == 0u) { xcd_barrier_complete(bar, b.x, nloc, nx); b.st[0] = nloc; b.st[1] = nx; }
        const unsigned old = xb_add(&bar[XB_XSUB(b.x)], 1u);
        const unsigned gen = old / nloc;
        if (old + 1u == (gen + 1u) * nloc) {
            __builtin_amdgcn_fence(__ATOMIC_RELEASE, "agent");
            asm volatile("s_waitcnt vmcnt(0)" ::: "memory");
            const unsigned og = xb_add(&bar[XB_TOP], 1u);
            const unsigned tg = og / nx;
            if (og + 1u == (tg + 1u) * nx) xb_add(&bar[XB_TOPGEN], 1u);
            else XB_SPIN(xb_ld(&bar[XB_TOPGEN]) == tg, bar);
            __builtin_amdgcn_fence(__ATOMIC_ACQUIRE, "agent");
            xb_add(&bar[XB_XGEN(b.x)], 1u);
            asm volatile("s_waitcnt vmcnt(0)" ::: "memory");
        } else {
            XB_SPIN(xb_ld(&bar[XB_XGEN(b.x)]) == gen, bar);
            __builtin_amdgcn_fence(__ATOMIC_ACQUIRE, "agent");
            asm volatile("s_waitcnt vmcnt(0)" ::: "memory");
        }
    }
    __syncthreads();
}
constexpr int LDSCTL_OFF = LDS_BYTES - 256;
constexpr int CW_BAR = 4096, CW_CTX = 8192;

#ifndef PROBE_GMLP2
#define PROBE_GMLP2 0
#endif
#ifndef ATT_PIPE
#define ATT_PIPE 1
#endif
#ifndef ATT_THRL
#define ATT_THRL 8
#endif
#ifndef ONE_LAUNCH
#define ONE_LAUNCH 1
#endif
#ifndef FAST_MIX
#define FAST_MIX 1
#endif
#ifndef PROBE_SEQ
#define PROBE_SEQ 0, 1, 2, 3, 4, 5, 6, 7, 8, 9, 10, 11
#endif

enum { PH_PRO = 0, PH_HN, PH_IN, PH_MIX, PH_A, PH_O, PH_H2R, PH_WCONV, PH_TOPK, PH_GU, PH_D, PH_FIN, PH_COUNT };

__global__ void __launch_bounds__(NTHREADS, 2) fwd(Args args) {
    extern __shared__ __attribute__((aligned(16))) unsigned char lds_raw[];
    LAS unsigned char* lds = (LAS unsigned char*)lds_raw;
    const int tid = threadIdx.x, lane = tid & 63, wave = __builtin_amdgcn_readfirstlane(tid >> 6);
    const int G = gridDim.x, bid = blockIdx.x;
    unsigned char* ws = args.ws;
    const int lo = args.ph_lo, hi = args.ph_hi;
#define IN(k) (lo <= (k) && (k) < hi)
    float* MOD = (float*)(ws + WS_MOD); f32x2* ROPE = (f32x2*)(ws + WS_ROPE);
    float* AFFT = (float*)(ws + WS_AFFT); int* TOPI = (int*)(ws + WS_TOPI); float* TOPW = (float*)(ws + WS_TOPW); int* SLOT = (int*)(ws + WS_SLOT);
    bf16_t* WSP = (bf16_t*)(ws + WS_WSP); bf16_t* WIN = (bf16_t*)(ws + WS_WIN); bf16_t* WAB = (bf16_t*)(ws + WS_WAB); bf16_t* WO = (bf16_t*)(ws + WS_WO);
    bf16_t* H = (bf16_t*)(ws + WS_H); bf16_t* VA = (bf16_t*)(ws + WS_VA); bf16_t* KB = (bf16_t*)(ws + WS_KB); bf16_t* VB = (bf16_t*)(ws + WS_VB);
    bf16_t* GT = (bf16_t*)(ws + WS_G); bf16_t* Y = (bf16_t*)(ws + WS_Y); bf16_t* TMP = (bf16_t*)(ws + WS_TMP); bf16_t* MERGED = (bf16_t*)(ws + WS_MERGED);
    bf16_t* WGU = (bf16_t*)(ws + WS_WGU); bf16_t* WD = (bf16_t*)(ws + WS_WD); bf16_t* H2 = (bf16_t*)(ws + WS_H2); bf16_t* ACT = (bf16_t*)(ws + WS_ACT); bf16_t* YB = (bf16_t*)(ws + WS_YB);
    const int gw = bid * NWAVES + wave, NGW = G * NWAVES;
    if (tid < 64) ((LAS unsigned*)(lds + LDSCTL_OFF))[tid] = 0u;
    __syncthreads();
    XcdBarrier bar; bar.bar = (unsigned*)(ws + WS_CTL) + CW_BAR; bar.x = 0; bar.st = nullptr;
    if (ONE_LAUNCH) bar = xcd_barrier_post((unsigned*)(ws + WS_CTL) + CW_BAR, (volatile LAS unsigned*)(lds + LDSCTL_OFF));
#define SEAM(k) do { if (ONE_LAUNCH && IN(k) && IN((k) + 1)) xcd_barrier(bar); } while (0)

    if (IN(PH_PRO)) {
        if (bid < 192) adaln_task(bid, args.in[I_C], args.in[I_CCTX], args.in[I_WADA], args.in[I_BADA], MOD, (LAS float*)lds, tid);
        else if (bid == 192) rope_table(ROPE, tid);
        __syncthreads();
        for (int i = bid * NTHREADS + tid; i < 8 * 128 * 128 / 4; i += G * NTHREADS) st4bf(WSP + 4 * i, *(const f32x4*)(args.in[I_WSP] + 4 * i));
        LAS float* scr = (LAS float*)(lds + wave * 16384);
        constexpr int I_IN = 16 * 176, I_P = 16 * 32;
        for (int it = gw; it < I_IN + 3 * I_P; it += NGW) {
            int r = it;
            if (r < I_IN) { const int kb = r / 176, nb = r % 176, n0 = nb * 32; int drow = n0;
                if (n0 >= OFF_GATE) { const int gcol = n0 - OFF_GATE, isb = gcol >= 1024, ch = gcol & 1023; drow = OFF_GATE + 256 * (ch >> 7) + (ch & 127) + (isb ? 128 : 0); }
                transpose_item(args.in[I_WIN], INCOLS, kb * 64, n0, WIN + (size_t)drow * 1024 + kb * 64, 1024, scr, lane); continue; } r -= I_IN;
            if (r < I_P) { const int kb = r / 32, nb = r % 32; transpose_item(args.in[I_WPA], 1024, kb * 64, nb * 32, WAB + (size_t)(nb * 32) * 2048 + kb * 64, 2048, scr, lane); continue; } r -= I_P;
            if (r < I_P) { const int kb = r / 32, nb = r % 32; transpose_item(args.in[I_WPB], 1024, kb * 64, nb * 32, WAB + (size_t)(nb * 32) * 2048 + 1024 + kb * 64, 2048, scr, lane); continue; } r -= I_P;
            { const int kb = r / 32, nb = r % 32; transpose_item(args.in[I_WOUT], 1024, kb * 64, nb * 32, WO + (size_t)(nb * 32) * 1024 + kb * 64, 1024, scr, lane); }
        }
    }
    SEAM(PH_PRO);
    if (IN(PH_HN)) {
        const float* g1n = args.in[I_N1G];
        auto hn_row = [&](int row) {
            const float* xr; int mrow;
            if (row < NTOK) { xr = args.in[I_X] + (size_t)row * 1024; mrow = row >> 12; } else { xr = args.in[I_CTX] + (size_t)(row - NTOK) * 1024; mrow = 8; }
            const float* sh = MOD + mrow * 6144; const float* sc = sh + 1024;
            f32x4 v[4]; float ss = 0.f;
#pragma unroll
            for (int j = 0; j < 4; ++j) { v[j] = *(const f32x4*)(xr + 4 * lane + 256 * j); ss += (v[j].x * v[j].x + v[j].y * v[j].y) + (v[j].z * v[j].z + v[j].w * v[j].w); }
            const float rstd = 1.0f / sqrtf(wave_sum(ss) * (1.f / 1024.f) + EPS);
#pragma unroll
            for (int j = 0; j < 4; ++j) {
                const int col = 4 * lane + 256 * j;
                const f32x4 gv = *(const f32x4*)(g1n + col), scv = *(const f32x4*)(sc + col), shv = *(const f32x4*)(sh + col);
                const f32x4 h = (v[j] * rstd * gv) * (1.f + scv) + shv;
                st4bf(H + (size_t)row * 1024 + col, h);
            }
        };
        for (int row = gw; row < NROWS_H; row += NGW) hn_row(row);
    }
    SEAM(PH_HN);
    if (IN(PH_IN)) {
        Gemm g{H, WIN, 1024, 1024, 1024, 0, 30, nullptr}; StaticOrder S; S.init(NTOK, INCOLS, G, bid, G == 256 ? 0 : 16);
        EpiIn E{Y, VA, KB, VB, GT, args.in[I_BMG], ROPE, (f32x2*)(ws + WS_STATS)};
        GEMM_PHASE<EpiIn, StaticOrder, false>(lds, g, S, E);
    }
    SEAM(PH_IN);
    if (IN(PH_MIX) && FAST_MIX) {
        unsigned* ctxcnt = (unsigned*)(ws + WS_CTL) + CW_CTX;
        if (G == 256 && bid < 16) {
            Gemm g{H, WIN, 1024, 1024, 1024, 0, 30, nullptr}; OneUnit S{NTOK / 256 + (bid >> 1), 12 + (bid & 1)};
            EpiIn E{Y, VA, KB, VB, GT, args.in[I_BMG], ROPE, (f32x2*)(ws + WS_STATS)};
            GEMM_PHASE<EpiIn, OneUnit, false>(lds, g, S, E);
            asm volatile("s_waitcnt vmcnt(0)" ::: "memory");
            __syncthreads();
            if (tid == 0) { __builtin_amdgcn_fence(__ATOMIC_RELEASE, "agent"); asm volatile("s_waitcnt vmcnt(0)" ::: "memory"); xb_add(ctxcnt, 1u); }
        }
        if (!(args.flags & 8)) for (int task = bid; task < NB * 32; task += G) mix::gmlp_unit(task, Y, (args.flags & 2) ? TMP : Y, (args.flags & 2) ? 1024 : 2048, VA, WSP, (const f32x2*)(ws + WS_STATS), args.in[I_LNG], args.in[I_LNB], args.in[I_BSP], lds);
        if (tid == 0) {
            unsigned sp = 0; while (xb_ld(ctxcnt) < 16u) { __builtin_amdgcn_s_sleep(2); if (++sp > (1u << 22)) break; }
            __builtin_amdgcn_fence(__ATOMIC_ACQUIRE, "agent"); asm volatile("s_waitcnt vmcnt(0)" ::: "memory");
        }
        __syncthreads();
#if ATT_PIPE
        att2::bf16x8 att_qr[4]; int att_base = 0; bool att_primed = false;
        int ubase, ucnt;
        if (G != 256) { ubase = bid * 8; ucnt = 0; }
        else if (bid < 16) { ubase = 6 * bid; ucnt = 6; } else if (bid < 48) { ubase = 96 + 9 * (bid - 16); ucnt = 9; } else { ubase = 384 + 8 * (bid - 48); ucnt = 8; }
        if (!(args.flags & 1)) for (int i = 0; i < ucnt; ++i) {
            const int u_ = ubase + i, task = u_ >> 1, hp = u_ & 1, un = u_ + 1, ntask = un >> 1; const bool more = i + 1 < ucnt; int nbase_ = 0;
            att2::attn_unit<ATT_THRL>(task >> 7, (task >> 2) & 31, task & 3, hp, att_base, att_primed, more, ntask >> 7, (ntask >> 2) & 31, ntask & 3, un & 1, att_qr, nbase_,
                                      Y, (args.flags & 4) ? TMP : Y + 1024, (args.flags & 4) ? 1024 : 2048, KB, VB, args.in[I_SINK], lds);
            att_base = nbase_; att_primed = more;
        }
        if (G != 256 && !(args.flags & 1)) for (int u_ = bid; u_ < NB * 32 * 8; u_ += G) {
            const int task = u_ >> 1; int nbase_ = 0;
            att2::attn_unit<ATT_THRL>(task >> 7, (task >> 2) & 31, task & 3, u_ & 1, 0, false, false, 0, 0, 0, 0, att_qr, nbase_, Y, (args.flags & 4) ? TMP : Y + 1024, (args.flags & 4) ? 1024 : 2048, KB, VB, args.in[I_SINK], lds);
        }
#else
        if (!(args.flags & 1)) for (int task = bid; task < NB * 32 * 4; task += G) mix::attn_unit(task >> 7, (task >> 2) & 31, task & 3, Y, (args.flags & 4) ? TMP : Y + 1024, (args.flags & 4) ? 1024 : 2048, KB, VB, args.in[I_SINK], lds);
#endif
    }
    SEAM(PH_MIX);
    if (IN(PH_A)) {
        Gemm g{Y, WAB, 2048, 2048, 2048, 0, 30, nullptr}; StaticOrder S; S.init(NTOK, 1024, G, bid, 0, 1);
        EpiAB E{MERGED, GT};
        GEMM_PHASE<EpiAB, StaticOrder, false, true>(lds, g, S, E);
    }
    SEAM(PH_A);
    if (IN(PH_O)) {
        Gemm g{MERGED, WO, 1024, 1024, 1024, 0, 30, nullptr}; StaticOrder S; S.init(NTOK, 1024, G, bid);
        EpiO E{(bf16_t*)args.out, MOD};
        GEMM_PHASE<EpiO, StaticOrder, false>(lds, g, S, E);
    }
    SEAM(PH_O);
    if (IN(PH_H2R)) {
        LAS float* wT = (LAS float*)lds;
        { f32x4 wv[8];
#pragma unroll
          for (int k = 0; k < 8; ++k) wv[k] = *(const f32x4*)(args.in[I_WR] + 4 * (tid + NTHREADS * k));
#pragma unroll
          for (int k = 0; k < 8; ++k) { const int f = tid + NTHREADS * k, col = f >> 2, e0 = 4 * (f & 3); wT[e0 * 1024 + col] = wv[k].x; wT[(e0 + 1) * 1024 + col] = wv[k].y; wT[(e0 + 2) * 1024 + col] = wv[k].z; wT[(e0 + 3) * 1024 + col] = wv[k].w; } }
        __syncthreads();
        const float* g2n = args.in[I_N2G];
        const int H2CH = (NTOK / 2 + NGW - 1) / NGW;
        const bool h32 = lane & 32, h16 = lane & 16, h8 = lane & 8, h4 = lane & 4;
        const int myexp = 8 * (lane >> 5) + 4 * ((lane >> 4) & 1) + 2 * ((lane >> 3) & 1) + ((lane >> 2) & 1);
        const bf16_t* D16 = (const bf16_t*)args.out;
        f32x4 vn[2][4]; u32x2 dn[2][4];
#pragma unroll
        for (int q = 0; q < 2; ++q)
#pragma unroll
            for (int j = 0; j < 4; ++j) { const size_t r_ = (size_t)(2 * (NTOK / 2 - 1 - (gw * H2CH < NTOK / 2 ? gw * H2CH : 0)) + q); vn[q][j] = *(const f32x4*)(args.in[I_X] + r_ * 1024 + 4 * lane + 256 * j); dn[q][j] = *(const u32x2*)(D16 + r_ * 2048 + 1024 + 4 * lane + 256 * j); }
        f32x4 amod[4], smod[4]; int bcur = -1;
        for (int kk = 0; kk < H2CH; ++kk) {
            const int rp = gw * H2CH + kk; if (rp >= NTOK / 2) break;
            const int row0 = 2 * (NTOK / 2 - 1 - rp), b = row0 >> 12;
            if (b != bcur) { bcur = b; const float* sh = MOD + b * 6144 + 3072; const float* sc = sh + 1024;
#pragma unroll
                for (int j = 0; j < 4; ++j) { const int col = 4 * lane + 256 * j; amod[j] = *(const f32x4*)(g2n + col) * (1.f + *(const f32x4*)(sc + col)); smod[j] = *(const f32x4*)(sh + col); } }
            f32x4 v[2][4]; float ss[2] = {0.f, 0.f};
#pragma unroll
            for (int q = 0; q < 2; ++q)
#pragma unroll
                for (int j = 0; j < 4; ++j) { const u32x2 dw = dn[q][j]; v[q][j] = vn[q][j] + (f32x4){bf2f(dw.x & 0xffffu), bf2f(dw.x >> 16), bf2f(dw.y & 0xffffu), bf2f(dw.y >> 16)}; ss[q] += (v[q][j].x * v[q][j].x + v[q][j].y * v[q][j].y) + (v[q][j].z * v[q][j].z + v[q][j].w * v[q][j].w); }
            { const int rn = (kk + 1 < H2CH && rp + 1 < NTOK / 2) ? rp + 1 : rp;
#pragma unroll
              for (int q = 0; q < 2; ++q)
#pragma unroll
                  for (int j = 0; j < 4; ++j) { const size_t r_ = (size_t)(2 * (NTOK / 2 - 1 - rn) + q); vn[q][j] = *(const f32x4*)(args.in[I_X] + r_ * 1024 + 4 * lane + 256 * j); dn[q][j] = *(const u32x2*)(D16 + r_ * 2048 + 1024 + 4 * lane + 256 * j); } }
            float rstd[2];
#pragma unroll
            for (int q = 0; q < 2; ++q) rstd[q] = 1.0f / sqrtf(wave_sum(ss[q]) * (1.f / 1024.f) + EPS);
            float lg[2][16];
#pragma unroll
            for (int q = 0; q < 2; ++q)
#pragma unroll
                for (int e = 0; e < 16; ++e) lg[q][e] = 0.f;
            f32x4 wb[2][4];
#pragma unroll
            for (int e = 0; e < 4; ++e) wb[0][e] = *(const LAS f32x4*)(wT + e * 1024 + 4 * lane);
            f32x4 h[2];
#pragma unroll
            for (int g = 0; g < 16; ++g) {
                const int j = g >> 2, eg = g & 3, col = 4 * lane + 256 * j;
                if (g + 1 < 16) {
                    const int jn = (g + 1) >> 2, en = (g + 1) & 3;
#pragma unroll
                    for (int e = 0; e < 4; ++e) wb[(g + 1) & 1][e] = *(const LAS f32x4*)(wT + (4 * en + e) * 1024 + 4 * lane + 256 * jn);
                }
                if (eg == 0) {
#pragma unroll
                    for (int q = 0; q < 2; ++q) { h[q] = (v[q][j] * rstd[q]) * amod[j] + smod[j]; st4bf(H2 + (size_t)(row0 + q) * 1024 + col, h[q]); }
                }
#pragma unroll
                for (int e = 0; e < 4; ++e) {
                    const f32x4 w = wb[g & 1][e];
#pragma unroll
                    for (int q = 0; q < 2; ++q) lg[q][4 * eg + e] += (h[q].x * w.x + h[q].y * w.y) + (h[q].z * w.z + h[q].w * w.w);
                    asm volatile("" : "+v"(lg[0][4 * eg + e]), "+v"(lg[1][4 * eg + e]));
                }
                asm volatile("" ::: "memory");
            }
#pragma unroll
            for (int q = 0; q < 2; ++q) {
                float a8[8], a4[4], a2[2], a1;
#pragma unroll
                for (int i = 0; i < 8; ++i) { const float send = h32 ? lg[q][i] : lg[q][i + 8], keep = h32 ? lg[q][i + 8] : lg[q][i]; a8[i] = keep + xchg32(send); }
#pragma unroll
                for (int i = 0; i < 4; ++i) { const float send = h16 ? a8[i] : a8[i + 4], keep = h16 ? a8[i + 4] : a8[i]; a4[i] = keep + xchg16(send); }
#pragma unroll
                for (int i = 0; i < 2; ++i) { const float send = h8 ? a4[i] : a4[i + 2], keep = h8 ? a4[i + 2] : a4[i]; a2[i] = keep + dpp_f<0x140>(send); }
                { const float send = h4 ? a2[0] : a2[1], keep = h4 ? a2[1] : a2[0]; a1 = keep + dpp_f<0x141>(send); }
                a1 += dpp_f<0x4E>(a1); a1 += dpp_f<0xB1>(a1);
                float mx = a1;
                mx = fmaxf(mx, dpp_f<0x141>(mx)); mx = fmaxf(mx, dpp_f<0x140>(mx)); mx = fmaxf(mx, xchg16(mx)); mx = fmaxf(mx, xchg32(mx));
                const float p = __expf(a1 - mx); float den = p;
                den += dpp_f<0x141>(den); den += dpp_f<0x140>(den); den += xchg16(den); den += xchg32(den);
                if ((lane & 3) == 0) AFFT[(size_t)(b * 16 + myexp) * SEQ + ((row0 + q) & (SEQ - 1))] = p / den;
            }
        }
    }
    if (IN(PH_WCONV)) {
        __syncthreads();
        LAS float* scr = (LAS float*)(lds + wave * 16384);
        constexpr int I_G = 16 * 16 * 64, I_D = 16 * 32 * 32;
        auto item = [&](int it) -> TrItem {
            int r = it; TrItem t;
            if (r < 2 * I_G) {
                const int up = r >= I_G; if (up) r -= I_G;
                const int e = r >> 10, kb = (r >> 6) & 15, nb = r & 63, n0 = nb * 32;
                const int drow = 256 * (n0 >> 7) + (n0 & 127) + (up ? 128 : 0);
                t.src = args.in[up ? I_WEU : I_WEG] + (size_t)e * 1024 * 2048 + (size_t)(kb * 64) * 2048 + n0; t.N = 2048;
                t.dst = WGU + (size_t)e * 4096 * 1024 + (size_t)drow * 1024 + kb * 64; t.ldt = 1024;
            } else {
                r -= 2 * I_G;
                const int e = r >> 10, kb = (r >> 5) & 31, nb = r & 31;
                t.src = args.in[I_WED] + (size_t)e * 2048 * 1024 + (size_t)(kb * 64) * 1024 + nb * 32; t.N = 1024;
                t.dst = WD + (size_t)e * 1024 * 2048 + (size_t)(nb * 32) * 2048 + kb * 64; t.ldt = 2048;
            }
            return t;
        };
        constexpr int NIT = 2 * I_G + I_D;
        if (gw < NIT) {
            TrItem cur = item(gw); f32x4 vc[8], vn[8];
            tr_load(cur, vc, lane);
            for (int it = gw; it < NIT; it += NGW) {
                const bool more = it + NGW < NIT;
                TrItem nxt = cur;
                if (more) { nxt = item(it + NGW); tr_load(nxt, vn, lane); }
                tr_store(cur, vc, scr, lane);
                cur = nxt;
#pragma unroll
                for (int i = 0; i < 8; ++i) vc[i] = vn[i];
            }
        }
    }
    SEAM(PH_WCONV);
    if (IN(PH_TOPK)) {
        LAS int* wsum = (LAS int*)lds;
        for (int task = bid; task < NE * NB; task += G) {
            const int e = task >> 3, b = task & 7;
            const float* aff = AFFT + (size_t)(b * 16 + e) * SEQ;
            unsigned k[8];
            { const u32x4 a0 = *(const u32x4*)(aff + 8 * tid), a1 = *(const u32x4*)(aff + 8 * tid + 4); k[0] = a0.x; k[1] = a0.y; k[2] = a0.z; k[3] = a0.w; k[4] = a1.x; k[5] = a1.y; k[6] = a1.z; k[7] = a1.w; }
            unsigned T = 0u; int it = 0;
            __syncthreads();
            for (int bit = 30; bit >= 0; --bit, ++it) {
                const unsigned cand = T | (1u << bit); int c = 0;
#pragma unroll
                for (int j = 0; j < 8; ++j) c += __builtin_popcountll(__ballot(k[j] >= cand));
                if (lane == 0) wsum[(it & 1) * 8 + wave] = c;
                __syncthreads();
                int tot = 0;
#pragma unroll
                for (int w = 0; w < 8; ++w) tot += wsum[(it & 1) * 8 + w];
                if (tot >= CAP) T = cand;
            }
            int cg = 0, ce = 0;
#pragma unroll
            for (int j = 0; j < 8; ++j) { cg += (k[j] > T) ? 1 : 0; ce += (k[j] == T) ? 1 : 0; }
            LAS int* sc1 = wsum + 16; LAS int* sc2 = wsum + 32;
            int ie = ce, ig = cg;
#pragma unroll
            for (int o = 1; o < 64; o <<= 1) { const int te = __shfl_up(ie, o), tg = __shfl_up(ig, o); if (lane >= o) { ie += te; ig += tg; } }
            __syncthreads();
            if (lane == 63) { sc1[wave] = ie; sc2[wave] = ig; }
            __syncthreads();
            int ebase = ie - ce, totg = 0;
#pragma unroll
            for (int w = 0; w < 8; ++w) { if (w < wave) ebase += sc1[w]; totg += sc2[w]; }
            const int need = CAP - totg;
            int sel[8], cs = 0, er = ebase;
#pragma unroll
            for (int j = 0; j < 8; ++j) { const bool eq = (k[j] == T); sel[j] = (k[j] > T) || (eq && er < need); er += eq ? 1 : 0; cs += sel[j]; }
            int is = cs;
#pragma unroll
            for (int o = 1; o < 64; o <<= 1) { const int ts = __shfl_up(is, o); if (lane >= o) is += ts; }
            __syncthreads();
            if (lane == 63) sc1[wave] = is;
            __syncthreads();
            int sbase = is - cs;
#pragma unroll
            for (int w = 0; w < 8; ++w) if (w < wave) sbase += sc1[w];
#pragma unroll
            for (int j = 0; j < 8; ++j) {
                const int t = 8 * tid + j; int slot = -1;
                if (sel[j]) { slot = sbase; ++sbase; const int prow = (e * 8 + b) * CAP + slot; TOPI[prow] = t; TOPW[prow] = __uint_as_float(k[j]); }
                SLOT[((size_t)b * SEQ + t) * 16 + e] = slot;
            }
            __syncthreads();
        }
    }
    SEAM(PH_TOPK);
    if (IN(PH_GU)) {
        Gemm g{H2, WGU, 1024, 1024, 1024, (size_t)4096 * 1024, 4, TOPI}; StaticOrder S; S.init(NPAIR, 4096, G, bid);
        EpiGU E{ACT};
        GEMM_PHASE<EpiGU, StaticOrder, true>(lds, g, S, E);
    }
    SEAM(PH_GU);
    if (IN(PH_D)) {
        Gemm g{ACT, WD, 2048, 2048, 2048, (size_t)1024 * 2048, 4, nullptr}; StaticOrder S; S.init(NPAIR, 1024, G, bid, 0, 1);
        EpiD E{YB, TOPW};
        GEMM_PHASE<EpiD, StaticOrder, false>(lds, g, S, E);
    }
    SEAM(PH_D);
    if (IN(PH_FIN)) {
        const float* fg = args.in[I_FING];
        const bf16_t* ZROW = (const bf16_t*)(ws + WS_CTL + 512 * 1024);
        int sln[2] = {-1, -1};
        if (gw < NTOK / 2 && lane < 16) { sln[0] = SLOT[(size_t)(2 * gw) * 16 + lane]; sln[1] = SLOT[(size_t)(2 * gw + 1) * 16 + lane]; }
        for (int rp = gw; rp < NTOK / 2; rp += NGW) {
            const int row0 = 2 * rp, b = row0 >> 12;
            const int sl[2] = {sln[0], sln[1]};
            { const int rn = rp + NGW; if (rn < NTOK / 2 && lane < 16) { sln[0] = SLOT[(size_t)(2 * rn) * 16 + lane]; sln[1] = SLOT[(size_t)(2 * rn + 1) * 16 + lane]; } }
            const float* g2 = MOD + b * 6144 + 5120;
            f32x4 xv[2][4], acc[2][4];
#pragma unroll
            for (int q = 0; q < 2; ++q)
#pragma unroll
                for (int h = 0; h < 2; ++h) { const float* xp = args.in[I_X] + (size_t)(row0 + q) * 1024 + 512 * h + 8 * lane; f32x4 d0_, d1_; ld8bf((const bf16_t*)args.out + (size_t)(row0 + q) * 2048 + 1024 + 512 * h + 8 * lane, d0_, d1_);
                    xv[q][2 * h] = *(const f32x4*)xp + d0_; xv[q][2 * h + 1] = *(const f32x4*)(xp + 4) + d1_;
                    acc[q][2 * h] = (f32x4){0.f, 0.f, 0.f, 0.f}; acc[q][2 * h + 1] = (f32x4){0.f, 0.f, 0.f, 0.f}; }
#pragma unroll
            for (int q = 0; q < 2; ++q) {
                unsigned long long mask = __ballot(sl[q] >= 0);
                for (;;) {
                    const bf16_t* yr[4];
#pragma unroll
                    for (int k = 0; k < 4; ++k) {
                        if (mask) { const int ex = __builtin_ctzll(mask); mask &= mask - 1; const int s = __builtin_amdgcn_readlane(sl[q], ex); yr[k] = YB + (size_t)((ex * 8 + b) * CAP + s) * 1024; }
                        else yr[k] = ZROW;
                    }
                    u32x4 y[4][2];
#pragma unroll
                    for (int k = 0; k < 4; ++k)
#pragma unroll
                        for (int h = 0; h < 2; ++h) y[k][h] = *(const u32x4*)(yr[k] + 512 * h + 8 * lane);
#pragma unroll
                    for (int k = 0; k < 4; ++k)
#pragma unroll
                        for (int h = 0; h < 2; ++h) { const u32x4 w = y[k][h];
                            acc[q][2 * h] += (f32x4){bf2f(w.x & 0xffffu), bf2f(w.x >> 16), bf2f(w.y & 0xffffu), bf2f(w.y >> 16)};
                            acc[q][2 * h + 1] += (f32x4){bf2f(w.z & 0xffffu), bf2f(w.z >> 16), bf2f(w.w & 0xffffu), bf2f(w.w >> 16)}; }
                    if (!mask) break;
                }
            }
#pragma unroll
            for (int q = 0; q < 2; ++q) {
                float ss = 0.f;
#pragma unroll
                for (int h = 0; h < 2; ++h)
#pragma unroll
                    for (int u4 = 0; u4 < 2; ++u4) { const int col = 512 * h + 8 * lane + 4 * u4; f32x4& v = xv[q][2 * h + u4]; v = v + *(const f32x4*)(g2 + col) * acc[q][2 * h + u4]; ss += (v.x * v.x + v.y * v.y) + (v.z * v.z + v.w * v.w); }
                const float rstd = 1.0f / sqrtf(wave_sum(ss) * (1.f / 1024.f) + EPS);
#pragma unroll
                for (int h = 0; h < 2; ++h)
#pragma unroll
                    for (int u4 = 0; u4 < 2; ++u4) { const int col = 512 * h + 8 * lane + 4 * u4; *(f32x4*)(args.out + (size_t)(row0 + q) * 1024 + col) = xv[q][2 * h + u4] * rstd * *(const f32x4*)(fg + col); }
            }
        }
    }
#undef IN
}

extern "C" void kernel_launch(void* const* d_in, const int* in_sizes, int n_in, void* d_out, int out_size, void* d_ws, size_t ws_size, hipStream_t stream) {
    static int grid = 0;
    if (grid == 0) {
        if (n_in != 23 || in_sizes[0] != NTOK * DM || out_size != NTOK * DM || ws_size < WS_END) {
            fprintf(stderr, "kernel_launch: unexpected problem (n_in %d, in0 %d, out %d, ws %zu < %zu?)\n", n_in, n_in > 0 ? in_sizes[0] : -1, out_size, ws_size, (size_t)WS_END); grid = -1; return; }
        if (hipFuncSetAttribute((const void*)fwd, hipFuncAttributeMaxDynamicSharedMemorySize, LDS_BYTES) != hipSuccess) { fprintf(stderr, "kernel_launch: hipFuncSetAttribute failed\n"); grid = -1; return; }
        int dev = 0, cus = 0;
        if (hipGetDevice(&dev) != hipSuccess || hipDeviceGetAttribute(&cus, hipDeviceAttributeMultiprocessorCount, dev) != hipSuccess) { grid = -1; return; }
        grid = cus;
    }
    if (grid < 0) return;
    (void)hipMemsetAsync((char*)d_ws + WS_CTL, 0, 1 * MiB, stream);
    Args a{};
    for (int i = 0; i < 23; ++i) a.in[i] = (const float*)d_in[i];
    a.out = (float*)d_out; a.ws = (unsigned char*)d_ws;
    if (ONE_LAUNCH) {
        a.ph_lo = 0; a.ph_hi = PH_COUNT;
        hipLaunchKernelGGL(fwd, dim3(grid), dim3(NTHREADS), LDS_BYTES, stream, a);
    } else {
        static const int seq[] = {PROBE_SEQ};
        for (unsigned i = 0; i < sizeof(seq) / sizeof(seq[0]); ++i) {
            a.ph_lo = seq[i] % 100; a.ph_hi = seq[i] % 100 + 1; a.flags = seq[i] / 100;
            hipLaunchKernelGGL(fwd, dim3(grid), dim3(NTHREADS), LDS_BYTES, stream, a);
        }
    }
}
```

```cpp
#include <hip/hip_runtime.h>
#include <cstdio>
#include <cstdint>

#define LAS __attribute__((address_space(3)))
typedef unsigned short bf16_t;
typedef float f32x4 __attribute__((ext_vector_type(4)));
typedef float f32x2 __attribute__((ext_vector_type(2)));
typedef unsigned u32x4 __attribute__((ext_vector_type(4)));
typedef unsigned u32x2 __attribute__((ext_vector_type(2)));
typedef int i32x4 __attribute__((ext_vector_type(4)));

constexpr int DM = 1024, NB = 8, SEQ = 4096, NTOK = NB * SEQ, CTXL = 256, NCTX = NB * CTXL, NROWS_H = NTOK + NCTX;
constexpr int INCOLS = 5632, OFF_Q = 2048, OFF_K = 3072, OFF_VB = 3328, OFF_GATE = 3584;
constexpr int NE = 16, CAP = 512, DE = 2048, NPAIR = NE * NB * CAP;
constexpr float EPS = 1e-6f, LOG2E = 1.4426950408889634f, C2 = 0.125f * LOG2E;
constexpr int NTHREADS = 512, NWAVES = 8;

constexpr size_t MiB = 1u << 20;
constexpr size_t WS_CTL = 0;
constexpr size_t WS_MOD = 1 * MiB;
constexpr size_t WS_ROPE = 1 * MiB + 512 * 1024;
constexpr size_t WS_AFFT = 2 * MiB;
constexpr size_t WS_TOPI = 4 * MiB;
constexpr size_t WS_TOPW = 4 * MiB + 512 * 1024;
constexpr size_t WS_SLOT = 5 * MiB;
constexpr size_t WS_WSP = 7 * MiB;
constexpr size_t WS_WIN = 8 * MiB;
constexpr size_t WS_WAB = 19 * MiB;
constexpr size_t WS_WO = 23 * MiB;
constexpr size_t WS_R = 25 * MiB;
constexpr size_t WS_H = WS_R;
constexpr size_t WS_VA = WS_R + 68 * MiB;
constexpr size_t WS_KB = WS_VA + 64 * MiB;
constexpr size_t WS_VB = WS_KB + 17 * MiB;
constexpr size_t WS_G = WS_VB + 17 * MiB;
constexpr size_t WS_Y = WS_G + 128 * MiB;
constexpr size_t WS_TMP = WS_Y + 128 * MiB;
constexpr size_t WS_STATS = WS_TMP + 64 * MiB;
constexpr size_t WS_MERGED = WS_H;
constexpr size_t WS_WGU = WS_R;
constexpr size_t WS_WD = WS_R + 128 * MiB;
constexpr size_t WS_H2 = WS_R + 192 * MiB;
constexpr size_t WS_ACT = WS_R + 256 * MiB;
constexpr size_t WS_YB = WS_WGU;
constexpr size_t WS_END = 537 * MiB;
static_assert(WS_STATS + 4 * MiB <= WS_END && WS_ACT + 256 * MiB == WS_END, "ws map");

constexpr int LDS_BYTES = 147456;

__device__ __forceinline__ float bf2f(unsigned b) { return __uint_as_float(b << 16); }
__device__ __forceinline__ unsigned f2bf(float f) { unsigned u = __float_as_uint(f); return (u + 0x7fffu + ((u >> 16) & 1u)) >> 16; }
__device__ __forceinline__ unsigned pk2(float lo, float hi) { typedef float f2_ __attribute__((ext_vector_type(2))); typedef __bf16 b2_ __attribute__((ext_vector_type(2))); f2_ v = {lo, hi}; b2_ b = __builtin_convertvector(v, b2_); return __builtin_bit_cast(unsigned, b); }
__device__ __forceinline__ void st4bf(bf16_t* p, f32x4 v) { u32x2 w; w.x = pk2(v.x, v.y); w.y = pk2(v.z, v.w); *(u32x2*)p = w; }
__device__ __forceinline__ void st8bf(bf16_t* p, f32x4 a, f32x4 b) { u32x4 w; w.x = pk2(a.x, a.y); w.y = pk2(a.z, a.w); w.z = pk2(b.x, b.y); w.w = pk2(b.z, b.w); *(u32x4*)p = w; }
__device__ __forceinline__ void ld8bf(const bf16_t* p, f32x4& a, f32x4& b) { const u32x4 w = *(const u32x4*)p; a.x = bf2f(w.x & 0xffffu); a.y = bf2f(w.x >> 16); a.z = bf2f(w.y & 0xffffu); a.w = bf2f(w.y >> 16); b.x = bf2f(w.z & 0xffffu); b.y = bf2f(w.z >> 16); b.z = bf2f(w.w & 0xffffu); b.w = bf2f(w.w >> 16); }
__device__ __forceinline__ f32x4 ld4bf(const bf16_t* p) { const u32x2 w = *(const u32x2*)p; f32x4 v; v.x = bf2f(w.x & 0xffffu); v.y = bf2f(w.x >> 16); v.z = bf2f(w.y & 0xffffu); v.w = bf2f(w.y >> 16); return v; }
__device__ __forceinline__ float sigmoidf_(float x) { return __builtin_amdgcn_rcpf(1.f + __builtin_amdgcn_exp2f(x * -1.4426950409f)); }
__device__ __forceinline__ float siluf_(float x) { return x * __builtin_amdgcn_rcpf(1.f + __builtin_amdgcn_exp2f(x * -1.4426950409f)); }
__device__ __forceinline__ float gelu_t(float x) { const float t = x * __builtin_fmaf(x * x, -0.10294324f, -2.3022082f); return x * __builtin_amdgcn_rcpf(1.f + __builtin_amdgcn_exp2f(t)); }
__device__ __forceinline__ f32x2 rcp2_(f32x2 d) { f32x2 r; r.x = __builtin_amdgcn_rcpf(d.x); r.y = __builtin_amdgcn_rcpf(d.y); return r; }
__device__ __forceinline__ f32x2 exp2_2_(f32x2 t) { f32x2 e; e.x = __builtin_amdgcn_exp2f(t.x); e.y = __builtin_amdgcn_exp2f(t.y); return e; }
__device__ __forceinline__ f32x2 gelu2_(f32x2 x) { const f32x2 t = x * ((x * x) * -0.10294324f + -2.3022082f); return x * rcp2_(exp2_2_(t) + 1.0f); }
__device__ __forceinline__ f32x2 sigm2_(f32x2 x) { return rcp2_(exp2_2_(x * -1.4426950409f) + 1.0f); }
__device__ __forceinline__ f32x4 gelu4_(f32x4 v) { const f32x2 a = gelu2_((f32x2){v.x, v.y}), b = gelu2_((f32x2){v.z, v.w}); return (f32x4){a.x, a.y, b.x, b.y}; }
__device__ __forceinline__ f32x4 sigm4_(f32x4 v) { const f32x2 a = sigm2_((f32x2){v.x, v.y}), b = sigm2_((f32x2){v.z, v.w}); return (f32x4){a.x, a.y, b.x, b.y}; }
template <int CTRL> __device__ __forceinline__ float dpp_f(float v) { const int i = __builtin_bit_cast(int, v); return __builtin_bit_cast(float, __builtin_amdgcn_update_dpp(i, i, CTRL, 0xf, 0xf, true)); }
__device__ __forceinline__ float xchg16(float v) { auto r = __builtin_amdgcn_permlane16_swap(__float_as_uint(v), __float_as_uint(v), false, false); return __uint_as_float((threadIdx.x & 16) ? r[0] : r[1]); }
__device__ __forceinline__ float xchg32(float v) { auto r = __builtin_amdgcn_permlane32_swap(__float_as_uint(v), __float_as_uint(v), false, false); return __uint_as_float((threadIdx.x & 32) ? r[0] : r[1]); }
__device__ __forceinline__ float wave_sum(float v) {
    v += dpp_f<0xB1>(v); v += dpp_f<0x4E>(v); v += dpp_f<0x141>(v); v += dpp_f<0x140>(v); v += xchg16(v); v += xchg32(v);
    return v;
}
__device__ __forceinline__ int wave_sum_i(int v) {
#pragma unroll
    for (int o = 1; o < 64; o <<= 1) v += __shfl_xor(v, o);
    return v;
}
#define LDS_WAIT() asm volatile("s_waitcnt lgkmcnt(0)" ::: "memory")

struct Args { const float* in[23]; float* out; unsigned char* ws; int ph_lo, ph_hi, flags, pad; };
enum { I_X = 0, I_C, I_CTX, I_CCTX, I_WADA, I_BADA, I_N1G, I_WIN, I_BMG, I_LNG, I_LNB, I_WSP, I_BSP, I_SINK, I_WPA, I_WPB, I_WOUT, I_N2G, I_WR, I_WEG, I_WEU, I_WED, I_FING };

struct Unit { int pm, pn; };
struct Gemm {
    const bf16_t* A; const bf16_t* Bt; int lda, ldb, K;
    size_t bgs; int tpg_shift;
    const int* gidx;
};
constexpr int NXCD = 8, WGM = 8;
struct StaticOrder {
    int nM, nN, nwg, G, c, extra, rev;
    __device__ void init(int M, int N, int G_, int c_, int extra_ = 0, int rev_ = 0) { nM = M / 256; nN = N / 256; nwg = nM * nN; G = G_; c = c_; extra = extra_; rev = rev_; }
    __device__ bool next(int i, Unit& u) const {
        const long L = (long)i * G + c;
        if (L >= nwg) { const int x = (int)(L - nwg); if (x >= extra) return false; u.pm = NTOK / 256 + (x >> 1); u.pn = 12 + (x & 1); return true; }
        int wgid = (int)L; { const int q = nwg / NXCD, r = nwg % NXCD, xcd = wgid % NXCD, off = wgid / NXCD; wgid = (xcd < r ? xcd * (q + 1) : r * (q + 1) + (xcd - r) * q) + off; }
        const int nig = WGM * nN, gid = wgid / nig, fm = gid * WGM, gsz = (nM - fm) < WGM ? (nM - fm) : WGM;
        u.pm = fm + ((wgid % nig) % gsz); u.pn = (wgid % nig) / gsz; if (rev) u.pm = nM - 1 - u.pm; return true;
    }
};

struct OneUnit { int pm, pn; __device__ bool next(int i, Unit& u) const { if (i) return false; u.pm = pm; u.pn = pn; return true; } };

typedef f32x4 Acc[2][2][4][2];

namespace pg8 {
typedef short bf16x8 __attribute__((ext_vector_type(8)));
constexpr int BK = 64, HALF = 128, HTB = HALF * BK * 2, STAGE_BYTES = 8 * HTB;
__device__ __forceinline__ int lds_byte(int r, int c) { const int st = (r >> 4) * 2 + (c >> 5), rr = r & 15, cc = c & 31, ob = rr * 64 + cc * 2; return st * 1024 + (ob ^ (((ob >> 9) & 1) << 5)); }
__device__ __forceinline__ void stage_rc(int b, int& R, int& C) { const int st = b / 1024, sb = b % 1024, swz = sb ^ (((sb >> 9) & 1) << 5); R = (st >> 1) * 16 + swz / 64; C = (st & 1) * 32 + (swz % 64) / 2; }

template <class Epi, class Sched, bool GATHER, bool HOOK = false>
__device__ __forceinline__ void gemm_phase(LAS unsigned char* lds, const Gemm g, const Sched& S, const Epi& E) {
    const int tid = threadIdx.x, wid = __builtin_amdgcn_readfirstlane(tid >> 6), lane = tid & 63, wr = wid >> 2, wc = wid & 3, fr = lane & 15, fq = lane >> 4;
    const int nt = g.K / BK;
    int Rs[2], Cs[2]; unsigned voffBp[2][2], voffB[2], voffBn[2], vA[2][2], vN[2][2];
#pragma unroll
    for (int i = 0; i < 2; ++i) { stage_rc(tid * 16 + i * 8192, Rs[i], Cs[i]); voffBp[0][i] = (unsigned)(Rs[i] * g.ldb + Cs[i]) * 2u;
        const int rho = Rs[i] & 31, Rb = (Rs[i] & ~31) + 8 * ((rho & 15) >> 2) + 4 * (rho >> 4) + (rho & 3); voffBp[1][i] = (unsigned)(Rb * g.ldb + Cs[i]) * 2u; }
    const size_t kstep = (size_t)(BK * 2);
    const size_t hstepB = (size_t)HALF * g.ldb * 2;
    const unsigned ldsw = (unsigned)wid * 1024u;
    const int aoff = lds_byte(wr * 64 + fr, fq * 8), boff = lds_byte(wc * 32 + fr, fq * 8);
#define PG8_SA(b, h) (((b) * 2 + (h)) * HTB)
#define PG8_SB(b, h) ((4 + (b) * 2 + (h)) * HTB)
#define PG8_STAGE(bufoff, gbase, voff) do { _Pragma("unroll") for (int _i = 0; _i < 2; ++_i) \
        __builtin_amdgcn_global_load_lds((const unsigned*)((const char*)(gbase) + (voff)[_i]), (LAS unsigned*)(lds + (bufoff) + ldsw + _i * 8192), 16, 0, 0); } while (0)
#define PG8_LDA(dst, b, h) do { _Pragma("unroll") for (int m = 0; m < 4; ++m) _Pragma("unroll") for (int k = 0; k < 2; ++k) dst[m][k] = *(const LAS bf16x8*)(lds + PG8_SA(b, h) + aoff + m * 2048 + k * 1024); } while (0)
#define PG8_LDB(dst, b, h) do { _Pragma("unroll") for (int n = 0; n < 2; ++n) _Pragma("unroll") for (int k = 0; k < 2; ++k) dst[n][k] = *(const LAS bf16x8*)(lds + PG8_SB(b, h) + boff + n * 2048 + k * 1024); } while (0)
#define PG8_MMA(ai, bj, At, Bt) do { __builtin_amdgcn_s_setprio(1); _Pragma("unroll") for (int m = 0; m < 4; ++m) _Pragma("unroll") for (int n = 0; n < 2; ++n) _Pragma("unroll") for (int k = 0; k < 2; ++k) \
        acc[ai][bj][m][n] = __builtin_amdgcn_mfma_f32_16x16x32_bf16(Bt[n][k], At[m][k], acc[ai][bj][m][n], 0, 0, 0); __builtin_amdgcn_s_setprio(0); } while (0)
#define PG8_WAIT_V(n) asm volatile("s_waitcnt vmcnt(" #n ")" ::: "memory")
#define PG8_WAIT_L(n) asm volatile("s_waitcnt lgkmcnt(" #n ")" ::: "memory")
#define PG8_BAR __builtin_amdgcn_s_barrier()
#define PG8_SCHED __builtin_amdgcn_sched_barrier(0)
#define PG8_AVOFF(dst, U) do { _Pragma("unroll") for (int _h = 0; _h < 2; ++_h) _Pragma("unroll") for (int _i = 0; _i < 2; ++_i) \
        dst[_h][_i] = GATHER ? (unsigned)((((U).pm >> 1) & 7) * SEQ + g.gidx[(U).pm * 256 + _h * 128 + Rs[_i]]) * (unsigned)(g.lda * 2) + (unsigned)(Cs[_i] * 2) \
                             : (unsigned)((_h * 128 + Rs[_i]) * g.lda + Cs[_i]) * 2u; } while (0)
#define PG8_ABASE(U) ((const char*)g.A + (GATHER ? (size_t)0 : (size_t)(U).pm * 256 * g.lda * 2))
#define PG8_BBASE(U) ((const char*)g.Bt + ((size_t)((U).pm >> g.tpg_shift) * g.bgs + (size_t)(U).pn * 256 * g.ldb) * 2)
    Unit cur, nxt; int ui = 0;
    if (!S.next(0, cur)) return;
    Acc acc;
#pragma unroll
    for (int a = 0; a < 2; ++a)
#pragma unroll
        for (int b = 0; b < 2; ++b)
#pragma unroll
            for (int m = 0; m < 4; ++m)
#pragma unroll
                for (int n = 0; n < 2; ++n) acc[a][b][m][n] = (f32x4){0.f, 0.f, 0.f, 0.f};
    bf16x8 At[4][2], B0[2][2], B1[2][2];
    PG8_AVOFF(vA, cur);
    { const bool pc = E.perm(cur); voffB[0] = pc ? voffBp[1][0] : voffBp[0][0]; voffB[1] = pc ? voffBp[1][1] : voffBp[0][1]; }
    const char* cA = PG8_ABASE(cur); const char* cB = PG8_BBASE(cur);
    PG8_STAGE(PG8_SB(0, 0), cB, voffB); PG8_STAGE(PG8_SB(0, 1), cB + hstepB, voffB); PG8_STAGE(PG8_SA(0, 0), cA, vA[0]); PG8_STAGE(PG8_SA(0, 1), cA, vA[1]);
    if (wr == 1) PG8_BAR;
    PG8_WAIT_V(2); PG8_BAR;
    PG8_STAGE(PG8_SB(1, 0), cB + kstep, voffB); PG8_STAGE(PG8_SA(1, 0), cA + kstep, vA[0]); PG8_STAGE(PG8_SB(1, 1), cB + hstepB + kstep, voffB);
    PG8_WAIT_V(6); PG8_BAR;
    for (;;) {
        const bool has_next = S.next(ui + 1, nxt);
        const char* nA = has_next ? PG8_ABASE(nxt) : cA; const char* nB = has_next ? PG8_BBASE(nxt) : cB;
        { const bool pn_ = has_next ? E.perm(nxt) : E.perm(cur); voffBn[0] = pn_ ? voffBp[1][0] : voffBp[0][0]; voffBn[1] = pn_ ? voffBp[1][1] : voffBp[0][1]; }
        if (GATHER) {
#pragma unroll
            for (int h = 0; h < 2; ++h)
#pragma unroll
                for (int i = 0; i < 2; ++i) vN[h][i] = vA[h][i];
            if (has_next && wid == 0)
                __builtin_amdgcn_global_load_lds((const unsigned*)(g.gidx + nxt.pm * 256 + lane * 4), (LAS unsigned*)(lds + STAGE_BYTES + (ui & 1) * 1024), 16, 0, 0);
        }
        for (int t = 0; t < nt; t += 2) {
            const bool last = (t == nt - 2);
            if (GATHER) { if (t == 4 && has_next) {
                const LAS int* li = (const LAS int*)(lds + STAGE_BYTES + (ui & 1) * 1024);
#pragma unroll
                for (int h = 0; h < 2; ++h)
#pragma unroll
                    for (int i = 0; i < 2; ++i) vN[h][i] = (unsigned)(((nxt.pm >> 1) & 7) * SEQ + li[h * 128 + Rs[i]]) * (unsigned)(g.lda * 2) + (unsigned)(Cs[i] * 2);
            } }
            if constexpr (HOOK) { if (t == (nt >> 1)) E.mid(acc, cur, wr, wc, fr, fq); }
            const char* a1 = cA + (size_t)(t + 1) * kstep;
            const char* a2 = last ? nA : cA + (size_t)(t + 2) * kstep; const char* b2 = last ? nB : cB + (size_t)(t + 2) * kstep;
            const char* a3 = a2 + kstep; const char* b3 = b2 + kstep;
            unsigned v2[2][2];
#pragma unroll
            for (int h = 0; h < 2; ++h)
#pragma unroll
                for (int i = 0; i < 2; ++i) v2[h][i] = (GATHER && last) ? vN[h][i] : vA[h][i];
            unsigned vb2[2]; vb2[0] = last ? voffBn[0] : voffB[0]; vb2[1] = last ? voffBn[1] : voffB[1];
            PG8_LDB(B0, 0, 0); PG8_LDB(B1, 0, 1); PG8_SCHED; PG8_LDA(At, 0, 0); PG8_STAGE(PG8_SA(1, 1), a1, vA[1]);
            PG8_WAIT_V(8); PG8_WAIT_L(0); PG8_BAR; PG8_MMA(0, 0, At, B0); PG8_MMA(0, 1, At, B1); PG8_BAR; PG8_SCHED;
            PG8_LDA(At, 0, 1); PG8_STAGE(PG8_SB(0, 0), b2, vb2); PG8_STAGE(PG8_SB(0, 1), b2 + hstepB, vb2); PG8_STAGE(PG8_SA(0, 0), a2, v2[0]);
            PG8_WAIT_V(8); PG8_WAIT_L(0); PG8_BAR; PG8_MMA(1, 0, At, B0); PG8_MMA(1, 1, At, B1); PG8_BAR; PG8_SCHED;
            PG8_LDB(B0, 1, 0); PG8_LDB(B1, 1, 1); PG8_SCHED; PG8_LDA(At, 1, 0); PG8_STAGE(PG8_SA(0, 1), a2, v2[1]);
            PG8_WAIT_V(8); PG8_WAIT_L(0); PG8_BAR; PG8_MMA(0, 0, At, B0); PG8_MMA(0, 1, At, B1); PG8_BAR; PG8_SCHED;
            PG8_LDA(At, 1, 1); PG8_STAGE(PG8_SB(1, 0), b3, vb2); PG8_STAGE(PG8_SB(1, 1), b3 + hstepB, vb2); PG8_STAGE(PG8_SA(1, 0), a3, v2[0]);
            PG8_WAIT_V(8); PG8_WAIT_L(0); PG8_BAR; PG8_MMA(1, 0, At, B0); PG8_MMA(1, 1, At, B1); PG8_BAR; PG8_SCHED;
        }
        if (wr == 0) PG8_BAR;
        E(acc, cur, wr, wc, fr, fq);
        if (!has_next) break;
#pragma unroll
        for (int a = 0; a < 2; ++a)
#pragma unroll
            for (int b = 0; b < 2; ++b)
#pragma unroll
                for (int m = 0; m < 4; ++m)
#pragma unroll
                    for (int n = 0; n < 2; ++n) acc[a][b][m][n] = (f32x4){0.f, 0.f, 0.f, 0.f};
        cur = nxt; cA = nA; cB = nB; ++ui; voffB[0] = voffBn[0]; voffB[1] = voffBn[1];
        if (GATHER) {
#pragma unroll
            for (int h = 0; h < 2; ++h)
#pragma unroll
                for (int i = 0; i < 2; ++i) vA[h][i] = vN[h][i];
        }
        if (wr == 1) PG8_BAR;
    }
    PG8_WAIT_V(0);
    PG8_BAR;
#undef PG8_SA
#undef PG8_SB
#undef PG8_STAGE
#undef PG8_LDA
#undef PG8_LDB
#undef PG8_MMA
#undef PG8_WAIT_V
#undef PG8_WAIT_L
#undef PG8_BAR
#undef PG8_SCHED
#undef PG8_AVOFF
#undef PG8_ABASE
#undef PG8_BBASE
}
}

#define GEMM_PHASE pg8::gemm_phase

struct EpiIn {
    bf16_t *Y, *VA, *KB, *VB, *G; const float* bgate; const f32x2* rope; f32x2* STATS;
    __device__ __forceinline__ bool perm(const Unit& u) const { return u.pn < 8 || u.pn > 12; }
    template <int KIND> __device__ __forceinline__ void run(const Acc& acc, const Unit& u, int wr, int wc, int fr, int fq) const {
        const int pn = u.pn;
#pragma unroll
        for (int ai = 0; ai < 2; ++ai)
#pragma unroll
            for (int m = 0; m < 4; ++m) {
                const int row = u.pm * 256 + ai * 128 + wr * 64 + m * 16 + fr;
                float ssum = 0.f, ssq = 0.f;
#pragma unroll
                for (int bj = 0; bj < 2; ++bj) {
                    f32x4 v0 = acc[ai][bj][m][0], v1 = acc[ai][bj][m][1];
                    if constexpr (KIND == 0 || KIND == 1) {
                        const int c8 = bj * 128 + wc * 32 + 8 * fq;
                        v0 = gelu4_(v0); v1 = gelu4_(v1);
                        if constexpr (KIND == 0) st8bf(Y + (size_t)row * 2048 + pn * 256 + c8, v0, v1);
                        else {
                            st8bf(VA + (size_t)row * 1024 + (pn - 4) * 256 + c8, v0, v1);
                            ssum += ((v0.x + v0.y) + (v0.z + v0.w)) + ((v1.x + v1.y) + (v1.z + v1.w));
                            ssq += ((v0.x * v0.x + v0.y * v0.y) + (v0.z * v0.z + v0.w * v0.w)) + ((v1.x * v1.x + v1.y * v1.y) + (v1.z * v1.z + v1.w * v1.w));
                        }
                    } else if constexpr (KIND == 2) {
                        const int cl = bj * 128 + wc * 32 + 4 * fq;
                        f32x4 o0 = v0, o1 = v1;
                        if (row < NTOK) {
                            const int t = row & (SEQ - 1), pos = (wc & 1) ? (t & 63) : (t >> 6);
                            const f32x2* rp = rope + pos * 16 + 4 * fq;
#pragma unroll
                            for (int j = 0; j < 4; ++j) { const f32x2 cs = rp[j]; o0[j] = v0[j] * cs.x - v1[j] * cs.y; o1[j] = v0[j] * cs.y + v1[j] * cs.x; }
                        }
                        if (pn < 12) { bf16_t* p = Y + (size_t)row * 2048 + 1024 + (pn - 8) * 256 + cl; st4bf(p, o0 * C2); st4bf(p + 16, o1 * C2); }
                        else { bf16_t* p = KB + (size_t)row * 256 + cl; st4bf(p, o0); st4bf(p + 16, o1); }
                    } else if constexpr (KIND == 3) {
                        st8bf(VB + (size_t)row * 256 + bj * 128 + wc * 32 + 8 * fq, v0, v1);
                    } else {
                        if (bj == 0) {
                            const int ch = (pn - 14) * 128 + wc * 32 + 8 * fq;
                            const f32x4 a0 = sigm4_(v0 + *(const f32x4*)(bgate + ch)), a1 = sigm4_(v1 + *(const f32x4*)(bgate + ch + 4));
                            const f32x4 g0 = sigm4_(acc[ai][1][m][0] + *(const f32x4*)(bgate + 1024 + ch)), g1 = sigm4_(acc[ai][1][m][1] + *(const f32x4*)(bgate + 1024 + ch + 4));
                            f32x4 r0, r1;
#pragma unroll
                            for (int j = 0; j < 4; ++j) { r0[j] = a0[j] * __builtin_amdgcn_rcpf(g0[j]); r1[j] = a1[j] * __builtin_amdgcn_rcpf(g1[j]); }
                            st8bf(G + (size_t)row * 2048 + ch, r0, r1); st8bf(G + (size_t)row * 2048 + 1024 + ch, g0, g1);
                        }
                    }
                }
                if constexpr (KIND == 1) {
                    ssum += xchg16(ssum); ssum += xchg32(ssum); ssq += xchg16(ssq); ssq += xchg32(ssq);
                    if (fq == 0) STATS[(size_t)row * 16 + (pn - 4) * 4 + wc] = (f32x2){ssum, ssq};
                }
            }
    }
    __device__ __forceinline__ void operator()(const Acc& acc, const Unit& u, int wr, int wc, int fr, int fq) const {
        const int pn = u.pn;
        if (pn < 4) run<0>(acc, u, wr, wc, fr, fq);
        else if (pn < 8) run<1>(acc, u, wr, wc, fr, fq);
        else if (pn < 13) run<2>(acc, u, wr, wc, fr, fq);
        else if (pn == 13) run<3>(acc, u, wr, wc, fr, fq);
        else run<4>(acc, u, wr, wc, fr, fq);
    }
};
struct EpiAB {
    bf16_t* MERGED; const bf16_t* G;
    __device__ __forceinline__ bool perm(const Unit&) const { return true; }
    __device__ __forceinline__ void mid(Acc& acc, const Unit& u, int wr, int wc, int fr, int fq) const {
        int zero; asm volatile("v_mov_b32 %0, 0" : "=v"(zero));
        const bf16_t* gp = G + (size_t)(u.pm * 256 + wr * 64 + fr + zero) * 2048 + u.pn * 256 + wc * 32 + 8 * fq;
#pragma unroll
        for (int ai = 0; ai < 2; ++ai)
#pragma unroll
            for (int m = 0; m < 4; ++m) {
#pragma unroll
                for (int bj = 0; bj < 2; ++bj) {
                    const bf16_t* q = gp + (size_t)(ai * 128 + m * 16) * 2048 + bj * 128;
                    f32x4 r0, r1; ld8bf(q, r0, r1);
                    acc[ai][bj][m][0] *= r0; acc[ai][bj][m][1] *= r1;
                    asm volatile("" ::: "memory");
                }
            }
    }
    __device__ __forceinline__ void operator()(const Acc& acc, const Unit& u, int wr, int wc, int fr, int fq) const {
#pragma unroll
        for (int ai = 0; ai < 2; ++ai)
#pragma unroll
            for (int m = 0; m < 4; ++m) {
                const int row = u.pm * 256 + ai * 128 + wr * 64 + m * 16 + fr;
#pragma unroll
                for (int bj = 0; bj < 2; ++bj) {
                    const int c8 = u.pn * 256 + bj * 128 + wc * 32 + 8 * fq;
                    f32x4 gb0, gb1; ld8bf(G + (size_t)row * 2048 + 1024 + c8, gb0, gb1);
                    st8bf(MERGED + (size_t)row * 1024 + c8, gb0 * acc[ai][bj][m][0], gb1 * acc[ai][bj][m][1]);
                }
            }
    }
};
struct EpiO {
    bf16_t* D16; const float* mod;
    __device__ __forceinline__ bool perm(const Unit&) const { return true; }
    __device__ __forceinline__ void operator()(const Acc& acc, const Unit& u, int wr, int wc, int fr, int fq) const {
        const float* g1 = mod + (size_t)((u.pm * 256) >> 12) * 6144 + 2048;
#pragma unroll
        for (int bj = 0; bj < 2; ++bj) {
            const int c8 = u.pn * 256 + bj * 128 + wc * 32 + 8 * fq;
            const f32x4 ga = *(const f32x4*)(g1 + c8), gb = *(const f32x4*)(g1 + c8 + 4);
#pragma unroll
            for (int ai = 0; ai < 2; ++ai)
#pragma unroll
                for (int m = 0; m < 4; ++m) {
                    const int row = u.pm * 256 + ai * 128 + wr * 64 + m * 16 + fr;
                    st8bf(D16 + (size_t)row * 2048 + 1024 + c8, ga * acc[ai][bj][m][0], gb * acc[ai][bj][m][1]);
                }
        }
    }
};
struct EpiGU {
    bf16_t* ACT;
    __device__ __forceinline__ bool perm(const Unit&) const { return true; }
    __device__ __forceinline__ void operator()(const Acc& acc, const Unit& u, int wr, int wc, int fr, int fq) const {
#pragma unroll
        for (int ai = 0; ai < 2; ++ai)
#pragma unroll
            for (int m = 0; m < 4; ++m) {
                const int prow = u.pm * 256 + ai * 128 + wr * 64 + m * 16 + fr;
                f32x4 a[2];
#pragma unroll
                for (int n = 0; n < 2; ++n) {
                    const f32x4 gt = acc[ai][0][m][n], up = acc[ai][1][m][n];
                    a[n] = gt * sigm4_(gt) * up;
                }
                st8bf(ACT + (size_t)prow * 2048 + u.pn * 128 + wc * 32 + 8 * fq, a[0], a[1]);
            }
    }
};
struct EpiD {
    bf16_t* YB; const float* TOPW;
    __device__ __forceinline__ bool perm(const Unit&) const { return true; }
    __device__ __forceinline__ void operator()(const Acc& acc, const Unit& u, int wr, int wc, int fr, int fq) const {
#pragma unroll
        for (int ai = 0; ai < 2; ++ai)
#pragma unroll
            for (int m = 0; m < 4; ++m) {
                const int prow = u.pm * 256 + ai * 128 + wr * 64 + m * 16 + fr; const float w = TOPW[prow];
#pragma unroll
                for (int bj = 0; bj < 2; ++bj)
                    st8bf(YB + (size_t)prow * 1024 + u.pn * 256 + bj * 128 + wc * 32 + 8 * fq, acc[ai][bj][m][0] * w, acc[ai][bj][m][1] * w);
            }
    }
};

__device__ __forceinline__ void transpose_item(const float* W, int N, int k0, int n0, bf16_t* dst, int ldt, LAS float* scr, int lane) {
    const int kk = lane >> 3, nq = (lane & 7) * 4;
    f32x4 v[8];
#pragma unroll
    for (int i = 0; i < 8; ++i) v[i] = *(const f32x4*)(W + (size_t)(k0 + 8 * i + kk) * N + n0 + nq);
#pragma unroll
    for (int i = 0; i < 8; ++i) { LAS float* s = scr + (8 * i + kk) * 33 + nq; s[0] = v[i].x; s[1] = v[i].y; s[2] = v[i].z; s[3] = v[i].w; }
    LDS_WAIT();
    const int c = lane & 7;
#pragma unroll
    for (int j = 0; j < 4; ++j) {
        const int n = (lane >> 3) + 8 * j; const LAS float* s = scr + (8 * c) * 33 + n;
        u32x4 o; o.x = pk2(s[0 * 33], s[1 * 33]); o.y = pk2(s[2 * 33], s[3 * 33]); o.z = pk2(s[4 * 33], s[5 * 33]); o.w = pk2(s[6 * 33], s[7 * 33]);
        *(u32x4*)(dst + (size_t)n * ldt + 8 * c) = o;
    }
    LDS_WAIT();
}

struct TrItem { const float* src; bf16_t* dst; int N, ldt; };
__device__ __forceinline__ void tr_load(const TrItem& it, f32x4 (&v)[8], int lane) {
    const int kk = lane >> 3, nq = (lane & 7) * 4;
#pragma unroll
    for (int i = 0; i < 8; ++i) v[i] = *(const f32x4*)(it.src + (size_t)(8 * i + kk) * it.N + nq);
}
__device__ __forceinline__ void tr_store(const TrItem& it, const f32x4 (&v)[8], LAS float* scr, int lane) {
    const int kk = lane >> 3, nq = (lane & 7) * 4;
#pragma unroll
    for (int i = 0; i < 8; ++i) { LAS float* s = scr + (8 * i + kk) * 33 + nq; s[0] = v[i].x; s[1] = v[i].y; s[2] = v[i].z; s[3] = v[i].w; }
    LDS_WAIT();
    const int c = lane & 7;
#pragma unroll
    for (int j = 0; j < 4; ++j) {
        const int n = (lane >> 3) + 8 * j; const LAS float* s = scr + (8 * c) * 33 + n;
        u32x4 o; o.x = pk2(s[0 * 33], s[1 * 33]); o.y = pk2(s[2 * 33], s[3 * 33]); o.z = pk2(s[4 * 33], s[5 * 33]); o.w = pk2(s[6 * 33], s[7 * 33]);
        *(u32x4*)(it.dst + (size_t)n * it.ldt + 8 * c) = o;
    }
    LDS_WAIT();
}

__device__ __forceinline__ void adaln_task(int task, const float* c, const float* cctx, const float* w_ada, const float* b_ada, float* mod, LAS float* lds, int tid) {
    LAS float* s = lds; LAS float* red = lds + 9 * 1024;
    { float cv[18];
#pragma unroll
      for (int q = 0; q < 18; ++q) { const int i = tid + NTHREADS * q, r = i >> 10, k = i & 1023; cv[q] = r < 8 ? c[r * 1024 + k] : cctx[k]; }
#pragma unroll
      for (int q = 0; q < 18; ++q) s[tid + NTHREADS * q] = cv[q] * __builtin_amdgcn_rcpf(1.f + __expf(-cv[q])); }
    __syncthreads();
    const int ch = tid & 7, kr = tid >> 3;
    f32x4 acc[9];
#pragma unroll
    for (int r = 0; r < 9; ++r) acc[r] = (f32x4){0.f, 0.f, 0.f, 0.f};
    const float* wp = w_ada + (size_t)kr * 6144 + task * 32 + ch * 4;
    for (int it = 0; it < 16; ++it) {
        const f32x4 w = *(const f32x4*)(wp + (size_t)it * 64 * 6144); const int k = kr + it * 64;
#pragma unroll
        for (int r = 0; r < 9; ++r) acc[r] += s[r * 1024 + k] * w;
    }
#pragma unroll
    for (int r = 0; r < 9; ++r) *(LAS f32x4*)(red + (kr * 9 + r) * 32 + ch * 4) = acc[r];
    __syncthreads();
    if (tid < 288) { const int r = tid >> 5, col = tid & 31; float sum = 0.f; for (int q = 0; q < 64; ++q) sum += red[(q * 9 + r) * 32 + col]; mod[r * 6144 + task * 32 + col] = sum + b_ada[task * 32 + col]; }
    __syncthreads();
}

__device__ __forceinline__ void rope_table(f32x2* tab, int tid) {
    for (int idx = tid; idx < 1024; idx += NTHREADS) {
        const int pos = idx >> 4, i = idx & 15;
        double f = 1.0;
        for (int q = 0; q < i; ++q) f *= 0.56234132519034908;
        const float ang = (float)pos * (float)f;
        const double a = (double)ang, k = __builtin_rint(a * 0.15915494309189535), r = a - k * 6.283185307179586476925, r2 = r * r;
        double sn = r, ts = r, cs = 1.0, tc = 1.0;
        for (int n = 1; n <= 14; ++n) {
            tc *= -r2 / (double)((2 * n - 1) * (2 * n)); cs += tc;
            ts *= -r2 / (double)((2 * n) * (2 * n + 1)); sn += ts;
        }
        tab[idx] = (f32x2){(float)cs, (float)sn};
    }
}

__device__ __forceinline__ unsigned char* lds_raw_ptr(LAS unsigned char* p) { return (unsigned char*)p; }
namespace mix {
typedef short bf16x8 __attribute__((ext_vector_type(8)));
typedef short s16x4 __attribute__((ext_vector_type(4)));
typedef float f32x16 __attribute__((ext_vector_type(16)));
typedef __attribute__((address_space(3))) const char* lds_cptr;
__device__ __forceinline__ int crow(int r, int hi) { return (r & 3) + 8 * (r >> 2) + 4 * hi; }
__device__ __forceinline__ unsigned cvtpk(float lo, float hi) { typedef float f2 __attribute__((ext_vector_type(2))); typedef __bf16 b2 __attribute__((ext_vector_type(2))); f2 v = {lo, hi}; b2 b = __builtin_convertvector(v, b2); return __builtin_bit_cast(unsigned, b); }
__device__ __forceinline__ s16x4 vtr(lds_cptr p) { return __builtin_bit_cast(s16x4, __builtin_amdgcn_ds_read_tr16_b64_v4i16((__attribute__((address_space(3))) s16x4*)p)); }
__device__ __forceinline__ bf16x8 pk8(s16x4 lo, s16x4 hi) { return (bf16x8){lo[0], lo[1], lo[2], lo[3], hi[0], hi[1], hi[2], hi[3]}; }
__device__ __forceinline__ float max3f(float a, float b, float c) { float r; asm("v_max3_f32 %0, %1, %2, %3" : "=v"(r) : "v"(a), "v"(b), "v"(c)); return r; }
__device__ __forceinline__ float max2f(float a, float b) { float r; asm("v_max_f32_e32 %0, %1, %2" : "=v"(r) : "v"(a), "v"(b)); return r; }
__device__ __forceinline__ float swap_half(float v) { auto rr = __builtin_amdgcn_permlane32_swap(__float_as_uint(v), __float_as_uint(v), false, false); return __uint_as_float((threadIdx.x & 32) ? rr[0] : rr[1]); }

constexpr int A_K = 0, A_V = 24576, A_WS = 49152, A_QST = 53248, A_OST = A_QST, A_OSTW = 8192, A_END = A_QST + 8 * 8192;

__device__ __forceinline__ void attn_unit(int b, int n, int kvh, bf16_t* Y, bf16_t* O, int ldo, const bf16_t* KB, const bf16_t* VB, const float* sink, LAS unsigned char* lds) {
    const int tid = threadIdx.x, lane = tid & 63, r32 = lane & 31, hi = lane >> 5, wid = __builtin_amdgcn_readfirstlane(tid >> 6);
    const int head = kvh * 4 + (wid >> 1);
    const int qrow0 = b * SEQ + n * 128 + (wid & 1) * 64;
    bf16_t* Qw = Y + (size_t)qrow0 * 2048 + 1024 + head * 64;
    LAS bf16x8* qst = (LAS bf16x8*)(lds + A_QST + wid * 8192) + lane;
#pragma unroll
    for (int sb = 0; sb < 2; ++sb)
#pragma unroll
        for (int d0 = 0; d0 < 4; ++d0) qst[(sb * 4 + d0) * 64] = *(const bf16x8*)(Qw + (size_t)(32 * sb + r32) * 2048 + d0 * 16 + hi * 8);
    f32x16 o[2][2];
#pragma unroll
    for (int sb = 0; sb < 2; ++sb)
#pragma unroll
        for (int d0 = 0; d0 < 2; ++d0)
#pragma unroll
            for (int r = 0; r < 16; ++r) o[sb][d0][r] = 0.f;
    float m[2] = {-1e30f, -1e30f}, l[2] = {0.f, 0.f};
    LAS float* wsf = (LAS float*)(lds + A_WS) + wid * 128;
    const int jlo = (n == 0) ? 2 : 0, jhi = (n == 31) ? 3 : 5, T = 4 + (jhi - jlo + 1);
    const size_t koff = (size_t)lane * 256 + wid * 8 + kvh * 64;
    const size_t voff = (size_t)(16 * (wid & 3) + (lane >> 2)) * 256 + (wid >> 2) * 32 + (lane & 3) * 8 + kvh * 64;
    auto tile_row = [&](int t) -> long { return t < 4 ? (long)(NTOK + b * CTXL + 64 * t) : (long)(b * SEQ + (n - 1) * 128 + 64 * (jlo + t - 4)); };
    auto issue = [&](int t) {
        const long row = tile_row(t); const int buf = t % 3;
        __builtin_amdgcn_global_load_lds((const unsigned*)(KB + row * 256 + koff), (LAS unsigned*)(lds + A_K + buf * 8192 + wid * 1024), 16, 0, 0);
        __builtin_amdgcn_global_load_lds((const unsigned*)(VB + row * 256 + voff), (LAS unsigned*)(lds + A_V + buf * 8192 + wid * 1024), 16, 0, 0);
    };
    issue(0); issue(1);
    int slot = 0;
    for (int t = 0; t < T; ++t) {
        if (t + 1 < T) asm volatile("s_waitcnt vmcnt(2) lgkmcnt(0)" ::: "memory"); else asm volatile("s_waitcnt vmcnt(0) lgkmcnt(0)" ::: "memory");
        __builtin_amdgcn_s_barrier();
        if (t + 2 < T) issue(t + 2);
        const lds_cptr Kt = (lds_cptr)(lds + A_K + slot * 8192) + hi * 1024 + r32 * 16;
        const lds_cptr Vt = (lds_cptr)(lds + A_V + slot * 8192) + ((lane >> 4) & 1) * 32 + (lane & 3) * 8 + (4 * hi + ((lane & 15) >> 2)) * 64;
        slot = (slot == 2) ? 0 : slot + 1;
        const bool local = t >= 4;
        const int dl = 64 * (jlo + t - 4) - 128 - 64 * (wid & 1);
        if (local && (dl > 160 || dl < -191)) continue;
        f32x16 p0[2], p1[2];
#pragma unroll
        for (int sb = 0; sb < 2; ++sb)
#pragma unroll
            for (int r = 0; r < 16; ++r) { p0[sb][r] = 0.f; p1[sb][r] = 0.f; }
#pragma unroll
        for (int d0 = 0; d0 < 4; ++d0) {
            const bf16x8 k0 = *(const __attribute__((address_space(3))) bf16x8*)(Kt + d0 * 2048), k1 = *(const __attribute__((address_space(3))) bf16x8*)(Kt + d0 * 2048 + 512);
#pragma unroll
            for (int sb = 0; sb < 2; ++sb) {
                const bf16x8 qf = qst[(sb * 4 + d0) * 64];
                p0[sb] = __builtin_amdgcn_mfma_f32_32x32x16_bf16(k0, qf, p0[sb], 0, 0, 0);
                p1[sb] = __builtin_amdgcn_mfma_f32_32x32x16_bf16(k1, qf, p1[sb], 0, 0, 0);
            }
        }
        if (local && (dl < -97 || dl > 65 || dl - 32 < -97)) {
#pragma unroll
            for (int sb = 0; sb < 2; ++sb)
#pragma unroll
                for (int r = 0; r < 16; ++r) { const int rel = dl - 32 * sb + crow(r, hi) - r32; if (rel < -128 || rel > 128) p0[sb][r] = -1e30f; if (rel + 32 < -128 || rel + 32 > 128) p1[sb][r] = -1e30f; }
        }
        float mn[2];
        asm volatile("s_nop 15\n\ts_nop 7" : "+v"(p0[0]), "+v"(p1[0]), "+v"(p0[1]), "+v"(p1[1]));
#pragma unroll
        for (int sb = 0; sb < 2; ++sb) {
            float a = max3f(p0[sb][0], p0[sb][1], p1[sb][0]), b2 = max3f(p0[sb][2], p0[sb][3], p1[sb][1]); a = max3f(a, p1[sb][2], p1[sb][3]);
#pragma unroll
            for (int r = 4; r < 16; r += 4) { a = max3f(a, p0[sb][r], p0[sb][r + 1]); b2 = max3f(b2, p0[sb][r + 2], p0[sb][r + 3]); a = max3f(a, p1[sb][r], p1[sb][r + 1]); b2 = max3f(b2, p1[sb][r + 2], p1[sb][r + 3]); }
            float rm = max2f(a, b2);
            rm = max2f(rm, swap_half(rm));
            mn[sb] = max2f(m[sb], rm);
        }
        if (__any((mn[0] > m[0]) || (mn[1] > m[1]))) {
            const float f0 = __builtin_amdgcn_exp2f(m[0] - mn[0]), f1 = __builtin_amdgcn_exp2f(m[1] - mn[1]);
            l[0] *= f0; l[1] *= f1;
            if (hi == 0) { wsf[r32] = f0; wsf[64 + r32] = f1; }
            asm volatile("s_waitcnt lgkmcnt(0)" ::: "memory");
#pragma unroll
            for (int r = 0; r < 16; ++r) { const float a = wsf[crow(r, hi)], b2 = wsf[64 + crow(r, hi)]; o[0][0][r] *= a; o[0][1][r] *= a; o[1][0][r] *= b2; o[1][1][r] *= b2; }
            m[0] = mn[0]; m[1] = mn[1];
        }
        u32x4 pw[2][4];
#pragma unroll
        for (int sb = 0; sb < 2; ++sb) {
            float sacc = 0.f;
#pragma unroll
            for (int r = 0; r < 16; ++r) { p0[sb][r] = __builtin_amdgcn_exp2f(p0[sb][r] - m[sb]); p1[sb][r] = __builtin_amdgcn_exp2f(p1[sb][r] - m[sb]); sacc += p0[sb][r] + p1[sb][r]; }
            l[sb] += sacc;
#pragma unroll
            for (int q = 0; q < 4; ++q) { pw[sb][0][q] = cvtpk(p0[sb][2 * q], p0[sb][2 * q + 1]); pw[sb][1][q] = cvtpk(p0[sb][8 + 2 * q], p0[sb][9 + 2 * q]); pw[sb][2][q] = cvtpk(p1[sb][2 * q], p1[sb][2 * q + 1]); pw[sb][3][q] = cvtpk(p1[sb][8 + 2 * q], p1[sb][9 + 2 * q]); }
        }
#pragma unroll
        for (int d0 = 0; d0 < 2; ++d0)
#pragma unroll
            for (int ks = 0; ks < 4; ++ks) {
                const s16x4 vlo = vtr(Vt + d0 * 4096 + ks * 1024), vhi = vtr(Vt + d0 * 4096 + ks * 1024 + 512);
                const bf16x8 vf = pk8(vlo, vhi);
#pragma unroll
                for (int sb = 0; sb < 2; ++sb) o[sb][d0] = __builtin_amdgcn_mfma_f32_32x32x16_bf16(__builtin_bit_cast(bf16x8, pw[sb][ks]), vf, o[sb][d0], 0, 0, 0);
            }
    }
    const float s2 = sink[head] * LOG2E;
    LAS bf16_t* stg = (LAS bf16_t*)(lds + A_OST + wid * A_OSTW);
#pragma unroll
    for (int sb = 0; sb < 2; ++sb) {
        const float lt = l[sb] + swap_half(l[sb]);
        const float mf = fmaxf(m[sb], s2), f = __builtin_amdgcn_exp2f(m[sb] - mf), den = lt * f + __builtin_amdgcn_exp2f(s2 - mf);
        asm volatile("s_waitcnt lgkmcnt(0)" ::: "memory");
        if (hi == 0) wsf[sb * 64 + r32] = f / den;
        asm volatile("s_waitcnt lgkmcnt(0)" ::: "memory");
#pragma unroll
        for (int r = 0; r < 16; ++r) { const float sc = wsf[sb * 64 + crow(r, hi)]; const int orow = crow(r, hi);
            stg[orow * 64 + r32] = (bf16_t)f2bf(o[sb][0][r] * sc); stg[orow * 64 + 32 + r32] = (bf16_t)f2bf(o[sb][1][r] * sc); }
        asm volatile("s_waitcnt lgkmcnt(0)" ::: "memory");
#pragma unroll
        for (int i = 0; i < 4; ++i) { const int row = i * 8 + (lane >> 3), ch = lane & 7; const u32x4 v = *(const LAS u32x4*)(stg + row * 64 + ch * 8); *(u32x4*)(O + (size_t)(qrow0 + 32 * sb + row) * ldo + head * 64 + ch * 8) = v; }
        asm volatile("s_waitcnt lgkmcnt(0)" ::: "memory");
    }
    __syncthreads();
}

constexpr int G_V = 0, G_ST = 65536, G_STW = 8704, G_MU = G_ST + 8 * G_STW;
__device__ __forceinline__ void gmlp_unit(int task, bf16_t* Y, bf16_t* YO, int ldo, const bf16_t* VA, const bf16_t* WSP, const f32x2* STATS, const float* ln_g, const float* ln_b, const float* b_sp, LAS unsigned char* lds) {
    const int tid = threadIdx.x, lane = tid & 63, r32 = lane & 31, hi = lane >> 5, wid = __builtin_amdgcn_readfirstlane(tid >> 6);
    const int r0 = task * 128;
    LAS float* mu = (LAS float*)(lds + G_MU); LAS float* rs = mu + 128;
    if (tid < 128) {
        const f32x4* sp = (const f32x4*)(STATS + (size_t)(r0 + tid) * 16); float s = 0.f, ss = 0.f;
#pragma unroll
        for (int i = 0; i < 8; ++i) { const f32x4 v = sp[i]; s += v.x + v.z; ss += v.y + v.w; }
        const float mean = s * (1.f / 1024.f), var = fmaxf(ss * (1.f / 1024.f) - mean * mean, 0.f);
        mu[tid] = mean; rs[tid] = 1.0f / sqrtf(var + EPS);
    }
    u32x4 raw[4];
#pragma unroll
    for (int i = 0; i < 4; ++i) { const int idx = tid + NTHREADS * i, q = idx >> 4, c8 = idx & 15; raw[i] = *(const u32x4*)(VA + (size_t)(r0 + q) * 1024 + c8 * 8); }
    __syncthreads();
    const int pb = wid >> 1, dh = wid & 1;
    LAS float* st = (LAS float*)(lds + G_ST + wid * G_STW);
    for (int g8 = 0; g8 < 8; ++g8) {
        LAS unsigned char* vb = lds + G_V + (g8 & 1) * 32768;
#pragma unroll
        for (int i = 0; i < 4; ++i) {
            const int idx = tid + NTHREADS * i, q = idx >> 4, c8 = idx & 15, d = c8 * 8;
            const f32x4 g0 = *(const f32x4*)(ln_g + g8 * 128 + d), g1 = *(const f32x4*)(ln_g + g8 * 128 + d + 4), b0 = *(const f32x4*)(ln_b + g8 * 128 + d), b1 = *(const f32x4*)(ln_b + g8 * 128 + d + 4);
            const float mq = mu[q], rq = rs[q]; const u32x4 rw = raw[i];
            float v[8] = {bf2f(rw.x & 0xffffu), bf2f(rw.x >> 16), bf2f(rw.y & 0xffffu), bf2f(rw.y >> 16), bf2f(rw.z & 0xffffu), bf2f(rw.z >> 16), bf2f(rw.w & 0xffffu), bf2f(rw.w >> 16)};
#pragma unroll
            for (int e = 0; e < 4; ++e) { v[e] = (v[e] - mq) * rq * g0[e] + b0[e]; v[4 + e] = (v[4 + e] - mq) * rq * g1[e] + b1[e]; }
            u32x4 w; w.x = pk2(v[0], v[1]); w.y = pk2(v[2], v[3]); w.z = pk2(v[4], v[5]); w.w = pk2(v[6], v[7]);
            *(LAS u32x4*)(vb + ((d >> 5) * 8 + (q >> 4)) * 1024 + (q & 15) * 64 + (d & 31) * 2) = w;
        }
        if (g8 + 1 < 8) {
#pragma unroll
            for (int i = 0; i < 4; ++i) { const int idx = tid + NTHREADS * i, q = idx >> 4, c8 = idx & 15; raw[i] = *(const u32x4*)(VA + (size_t)(r0 + q) * 1024 + (g8 + 1) * 128 + c8 * 8); }
        }
        u32x4 ur[4]; bf16x8 af[8];
        const size_t ybase = (size_t)(r0 + 32 * pb + (lane >> 3)) * 2048 + g8 * 128 + 64 * dh + (lane & 7) * 8;
#pragma unroll
        for (int i = 0; i < 4; ++i) ur[i] = *(const u32x4*)(Y + ybase + (size_t)(8 * i) * 2048);
        const bf16_t* wrow = WSP + (size_t)g8 * 16384 + (size_t)(32 * pb + r32) * 128 + 8 * hi;
#pragma unroll
        for (int ks = 0; ks < 8; ++ks) af[ks] = *(const bf16x8*)(wrow + 16 * ks);
        __syncthreads();
        const lds_cptr Vb = (lds_cptr)vb + ((lane >> 4) & 1) * 32 + (lane & 3) * 8 + (8 * hi + ((lane & 15) >> 2)) * 64;
        f32x16 acc[2];
#pragma unroll
        for (int t2 = 0; t2 < 2; ++t2)
#pragma unroll
            for (int r = 0; r < 16; ++r) acc[t2][r] = 0.f;
#pragma unroll
        for (int ks = 0; ks < 8; ++ks) {
#pragma unroll
            for (int t2 = 0; t2 < 2; ++t2) {
                const int db = 2 * dh + t2;
                const s16x4 vlo = vtr(Vb + (db * 8 + ks) * 1024), vhi = vtr(Vb + (db * 8 + ks) * 1024 + 256);
                acc[t2] = __builtin_amdgcn_mfma_f32_32x32x16_bf16(af[ks], pk8(vlo, vhi), acc[t2], 0, 0, 0);
            }
        }
#pragma unroll
        for (int t2 = 0; t2 < 2; ++t2)
#pragma unroll
            for (int r = 0; r < 16; ++r) st[crow(r, hi) * 68 + 32 * t2 + r32] = acc[t2][r];
        asm volatile("s_waitcnt lgkmcnt(0)" ::: "memory");
#pragma unroll
        for (int i = 0; i < 4; ++i) {
            const int prow = 8 * i + (lane >> 3), ch = lane & 7;
            const f32x4 m0 = *(const LAS f32x4*)(st + prow * 68 + ch * 8), m1 = *(const LAS f32x4*)(st + prow * 68 + ch * 8 + 4);
            const float bs = b_sp[g8 * 128 + 32 * pb + prow]; const u32x4 uw = ur[i];
            u32x4 o;
            o.x = pk2(bf2f(uw.x & 0xffffu) * (m0.x + bs), bf2f(uw.x >> 16) * (m0.y + bs)); o.y = pk2(bf2f(uw.y & 0xffffu) * (m0.z + bs), bf2f(uw.y >> 16) * (m0.w + bs));
            o.z = pk2(bf2f(uw.z & 0xffffu) * (m1.x + bs), bf2f(uw.z >> 16) * (m1.y + bs)); o.w = pk2(bf2f(uw.w & 0xffffu) * (m1.z + bs), bf2f(uw.w >> 16) * (m1.w + bs));
            *(u32x4*)(YO + (size_t)(r0 + 32 * pb + prow) * ldo + g8 * 128 + 64 * dh + ch * 8) = o;
        }
        asm volatile("s_waitcnt lgkmcnt(0)" ::: "memory");
    }
    __syncthreads();
}
}

namespace att2 {
typedef short bf16x8 __attribute__((ext_vector_type(8)));
typedef short s16x4 __attribute__((ext_vector_type(4)));
typedef float f32x16 __attribute__((ext_vector_type(16)));
typedef __attribute__((address_space(3))) const char* lds_cptr;
typedef short v4i16_t __attribute__((ext_vector_type(4)));
__device__ __forceinline__ int crow(int r, int hi) { return (r & 3) + 8 * (r >> 2) + 4 * hi; }
#define SBAR() __builtin_amdgcn_sched_barrier(0)
constexpr int NSLOT = 3, SLOTB = 8192;
constexpr int LDS_K = 0, LDS_V = NSLOT * SLOTB, LDS_WS = 2 * NSLOT * SLOTB, LDS_OST = LDS_WS + 8 * 64 * 4, LDS_BYTES = LDS_OST + 8 * 4096;
__device__ __forceinline__ void glds16(const void* gsrc, unsigned lds_dst) { unsigned keep;
    asm volatile("s_mov_b32 %0, m0\n\ts_mov_b32 m0, %2\n\ts_nop 0\n\tglobal_load_lds_dwordx4 %1, off\n\ts_mov_b32 m0, %0" : "=&s"(keep) : "v"(gsrc), "s"(lds_dst) : "memory"); }
__device__ __forceinline__ float max3f(float a, float b, float c) { float r; asm("v_max3_f32 %0, %1, %2, %3" : "=v"(r) : "v"(a), "v"(b), "v"(c)); return r; }
__device__ __forceinline__ float max2f(float a, float b) { float r; asm("v_max_f32_e32 %0, %1, %2" : "=v"(r) : "v"(a), "v"(b)); return r; }
__device__ __forceinline__ float fadd_s(float a, float b) { float r; asm("v_add_f32_e32 %0, %1, %2" : "=v"(r) : "v"(a), "v"(b)); return r; }
__device__ __forceinline__ float fsub_s(float a, float b) { float r; asm("v_sub_f32_e32 %0, %1, %2" : "=v"(r) : "v"(a), "v"(b)); return r; }
typedef float f32x2_t __attribute__((ext_vector_type(2))); typedef __bf16 bf16x2_t __attribute__((ext_vector_type(2)));
__device__ __forceinline__ unsigned cvtpk_s(float lo, float hi) { f32x2_t v = {lo, hi}; bf16x2_t b = __builtin_convertvector(v, bf16x2_t); return __builtin_bit_cast(unsigned, b); }
#define WAIT_BAR(N) asm volatile("s_waitcnt vmcnt(" #N ") lgkmcnt(0)\n\ts_barrier" ::: "memory")
__device__ __forceinline__ void qkt(f32x16& p0, f32x16& p1, lds_cptr Kslot, const bf16x8* qr, const f32x16& negm, int r32, int hi) {
    const lds_cptr kb = Kslot + hi * 1024 + r32 * 16;
#pragma unroll
    for (int d0 = 0; d0 < 4; ++d0) {
        const bf16x8 b0 = *(const __attribute__((address_space(3))) bf16x8*)(kb + d0 * 2048);
        const bf16x8 b1 = *(const __attribute__((address_space(3))) bf16x8*)(kb + d0 * 2048 + 512);
        if (d0 == 0) { p0 = __builtin_amdgcn_mfma_f32_32x32x16_bf16(b0, qr[0], negm, 0, 0, 0); p1 = __builtin_amdgcn_mfma_f32_32x32x16_bf16(b1, qr[0], negm, 0, 0, 0); }
        else { p0 = __builtin_amdgcn_mfma_f32_32x32x16_bf16(b0, qr[d0], p0, 0, 0, 0); p1 = __builtin_amdgcn_mfma_f32_32x32x16_bf16(b1, qr[d0], p1, 0, 0, 0); }
    }
}
__device__ __forceinline__ void kload8(bf16x8* kf, lds_cptr kp) {
    kf[0] = *(const __attribute__((address_space(3))) bf16x8*)(kp);        kf[1] = *(const __attribute__((address_space(3))) bf16x8*)(kp + 512);
    kf[2] = *(const __attribute__((address_space(3))) bf16x8*)(kp + 2048); kf[3] = *(const __attribute__((address_space(3))) bf16x8*)(kp + 2560);
    kf[4] = *(const __attribute__((address_space(3))) bf16x8*)(kp + 4096); kf[5] = *(const __attribute__((address_space(3))) bf16x8*)(kp + 4608);
    kf[6] = *(const __attribute__((address_space(3))) bf16x8*)(kp + 6144); kf[7] = *(const __attribute__((address_space(3))) bf16x8*)(kp + 6656);
}
__device__ __forceinline__ void kload2(bf16x8* kf, lds_cptr kp, int j) { kf[2 * j] = *(const __attribute__((address_space(3))) bf16x8*)(kp + j * 2048); kf[2 * j + 1] = *(const __attribute__((address_space(3))) bf16x8*)(kp + j * 2048 + 512); }
__device__ __forceinline__ s16x4 vtr(lds_cptr p) { return __builtin_bit_cast(s16x4, __builtin_amdgcn_ds_read_tr16_b64_v4i16((__attribute__((address_space(3))) v4i16_t*)p)); }
__device__ __forceinline__ float rowmax(const f32x16& p0, const f32x16& p1) {
    float a = max3f(p0[0], p0[1], p1[0]), b = max3f(p0[2], p0[3], p1[1]); a = max3f(a, p1[2], p1[3]);
#pragma unroll
    for (int r = 4; r < 16; r += 4) { a = max3f(a, p0[r], p0[r + 1]); b = max3f(b, p0[r + 2], p0[r + 3]); a = max3f(a, p1[r], p1[r + 1]); b = max3f(b, p1[r + 2], p1[r + 3]); }
    const float m = max2f(a, b);
    auto rr = __builtin_amdgcn_permlane32_swap(__float_as_uint(m), __float_as_uint(m), false, false);
    return max2f(__uint_as_float(rr[0]), __uint_as_float(rr[1]));
}
__device__ __forceinline__ void pv(f32x16* o, int vb, bf16x8 pa0, bf16x8 pa1, bf16x8 pa2, bf16x8 pa3) {
#pragma unroll
    for (int d0 = 0; d0 < 2; ++d0) { s16x4 lo[4], hi[4];
#pragma unroll
        for (int ks = 0; ks < 4; ++ks) {
            asm volatile("ds_read_b64_tr_b16 %0,%1 offset:%c2" : "=&v"(lo[ks]) : "v"(vb), "i"(d0 * 4096 + ks * 1024) : "memory");
            asm volatile("ds_read_b64_tr_b16 %0,%1 offset:%c2" : "=&v"(hi[ks]) : "v"(vb), "i"(d0 * 4096 + ks * 1024 + 512) : "memory"); }
        asm volatile("s_waitcnt lgkmcnt(0)" ::: "memory"); SBAR();
#define PK(k) (bf16x8){lo[k][0], lo[k][1], lo[k][2], lo[k][3], hi[k][0], hi[k][1], hi[k][2], hi[k][3]}
        o[d0] = __builtin_amdgcn_mfma_f32_32x32x16_bf16(pa0, PK(0), o[d0], 0, 0, 0);
        o[d0] = __builtin_amdgcn_mfma_f32_32x32x16_bf16(pa1, PK(1), o[d0], 0, 0, 0);
        o[d0] = __builtin_amdgcn_mfma_f32_32x32x16_bf16(pa2, PK(2), o[d0], 0, 0, 0);
        o[d0] = __builtin_amdgcn_mfma_f32_32x32x16_bf16(pa3, PK(3), o[d0], 0, 0, 0);
#undef PK
    }
}
__device__ __forceinline__ void wmask(f32x16& p0, f32x16& p1, int dl, int r32, int hi) {
    const float NEG = -INFINITY;
#pragma unroll
    for (int r = 0; r < 16; ++r) { const int rel = dl + crow(r, hi) - r32; if (rel < -128 || rel > 128) p0[r] = NEG; if (rel + 32 < -128 || rel + 32 > 128) p1[r] = NEG; }
}

template <int THRL> __device__ __forceinline__ void attn_unit(int b, int n, int kvh, int hp, int base, bool primed, bool has_next, int nb, int nn, int nkvh, int nhp, bf16x8 (&qr)[4], int& nbase,
                                                              const bf16_t* Y, bf16_t* O, int ldo, const bf16_t* KB, const bf16_t* VB, const float* sink, LAS unsigned char* shm) {
    const int tid = threadIdx.x, lane = tid & 63, r32 = lane & 31, hi = lane >> 5; const int wid = __builtin_amdgcn_readfirstlane(tid >> 6);
    const int head = kvh * 4 + hp * 2 + (wid >> 2), qsub = wid & 3;
    const long qrow0 = (long)b * SEQ + n * 128 + qsub * 32;
    const bf16_t* Qw = Y + qrow0 * 2048 + 1024 + head * 64;
    const unsigned lds0 = (unsigned)(uintptr_t)shm;
    LAS float* wsf = (LAS float*)(shm + LDS_WS) + wid * 64;
    const long koff = (long)lane * 256 + kvh * 64 + wid * 8;
    const long voff = (long)(16 * (wid & 3) + (lane >> 2)) * 256 + kvh * 64 + (wid >> 2) * 32 + (lane & 3) * 8;
    const unsigned kdst = lds0 + LDS_K + wid * 1024, vdst = lds0 + LDS_V + wid * 1024;
    const int jlo = (n == 0) ? 2 : 0, jhi = (n == 31) ? 3 : 5, NT = 4 + (jhi - jlo + 1);
    const long lrow0 = (long)b * SEQ + (n - 1) * 128 + 64 * (jlo - 4), crow0 = (long)NTOK + b * CTXL;
#define TROW(t) ((t) < 4 ? crow0 + 64 * (t) : lrow0 + 64 * (t))
#define DMA_K(t, slot) glds16(KB + TROW(t) * 256 + koff, (unsigned)__builtin_amdgcn_readfirstlane(kdst + (slot)))
#define DMA_V(t, slot) glds16(VB + TROW(t) * 256 + voff, (unsigned)__builtin_amdgcn_readfirstlane(vdst + (slot)))
    const int vb0 = (int)(lds0 + LDS_V) + ((lane >> 4) & 1) * 32 + (lane & 3) * 8 + (4 * hi + ((lane & 15) >> 2)) * 64;
    bf16x8 kf[8];
    const lds_cptr shm3 = (lds_cptr)shm; const lds_cptr kp0 = shm3 + LDS_K + hi * 1024 + r32 * 16; const lds_cptr vp0 = shm3 + LDS_V + ((lane >> 4) & 1) * 32 + (lane & 3) * 8 + (4 * hi + ((lane & 15) >> 2)) * 64;
    const int s0 = base, s1 = (s0 == (NSLOT - 1) * SLOTB) ? 0 : s0 + SLOTB, s2 = (s1 == (NSLOT - 1) * SLOTB) ? 0 : s1 + SLOTB;
    if (!primed) {
        DMA_K(0, s0); DMA_V(0, s0); DMA_K(1, s1); DMA_K(2, s2);
#pragma unroll
        for (int d0 = 0; d0 < 4; ++d0) qr[d0] = *(const bf16x8*)(Qw + (long)r32 * 2048 + d0 * 16 + hi * 8);
    }
    float mhat = 0.f, l_reg = 0.f; f32x16 o[2]; o[0] = f32x16{}; o[1] = f32x16{}; f32x16 negm = f32x16{}; asm volatile("" : "+v"(negm));
    const int dq = -128 - 32 * qsub;
#define CMASK(P0, P1, t) do { if ((t) >= 4) { const int dl_ = 64 * (jlo + (t) - 4) + dq; if (dl_ < -97 || dl_ > 65) wmask(P0, P1, dl_, r32, hi); } } while (0)
    bool resc = false;
#define START(P0, P1) do { const float rm = rowmax(P0, P1); resc = false; \
    { const float dl = rm; mhat = fadd_s(mhat, dl); \
      _Pragma("unroll") for (int r = 0; r < 16; ++r) { P0[r] = fsub_s(P0[r], dl); P1[r] = fsub_s(P1[r], dl); } \
      _Pragma("unroll") for (int r = 0; r < 16; ++r) negm[r] = -mhat; asm volatile("" : "+v"(negm)); } \
    _Pragma("unroll") for (int r = 0; r < 16; ++r) P0[r] = __builtin_amdgcn_exp2f(P0[r]); } while (0)
#define RESC() do { if (resc) { asm volatile("s_waitcnt lgkmcnt(0)" ::: "memory"); \
      _Pragma("unroll") for (int d_ = 0; d_ < 2; ++d_) _Pragma("unroll") for (int r = 0; r < 16; ++r) o[d_][r] *= wsf[crow(r, hi)]; } } while (0)
    f32x16 pA0, pA1, pB0, pB1;
    int sl_prev = s0, sl_cur = s0, sl_next = s1;
#define ROT() do { sl_prev = sl_cur; sl_cur = sl_next; sl_next = (sl_next == (NSLOT - 1) * SLOTB) ? 0 : sl_next + SLOTB; } while (0)
    WAIT_BAR(7);
    qkt(pA0, pA1, shm3 + LDS_K + s0, qr, negm, r32, hi); asm volatile("s_nop 15\n\ts_nop 7" : "+v"(pA0), "+v"(pA1)); CMASK(pA0, pA1, 0);
    START(pA0, pA1);
    _Pragma("unroll") for (int r = 0; r < 16; ++r) pA1[r] = __builtin_amdgcn_exp2f(pA1[r]);
    WAIT_BAR(0);
    DMA_K(3, s0); DMA_V(1, s1);
    ROT();
    kload8(kf, kp0 + sl_cur);
    WAIT_BAR(2);
    s16x4 vlo[8], vhi[8]; u32x4 pw0, pw1, pw2, pw3;
#define PKW(P, B) cvtpk_s(P[B], P[B + 1])
#define PAF(k) __builtin_bit_cast(bf16x8, pw##k)
#define VFR(i) (bf16x8){vlo[i][0], vlo[i][1], vlo[i][2], vlo[i][3], vhi[i][0], vhi[i][1], vhi[i][2], vhi[i][3]}
#define PIN(x) asm volatile("" : "+v"(x))
#define MX3(a, b, c) __builtin_fmaxf(__builtin_fmaxf((a), (b)), (c))
#define GAPA(MF, A0, A1, A2, A3, W0, W1, PW) do { MF; sacc += A0; sacc += A1; sacc += A2; sacc += A3; PIN(sacc); W0; W1; PIN(PW); SBAR(); } while (0)
#define EX(v) __builtin_amdgcn_exp2f(v)
#define GAPB(MF, X, B) do { MF; X[B] = EX(X[B]); X[B + 1] = EX(X[B + 1]); X[B + 2] = EX(X[B + 2]); X[B + 3] = EX(X[B + 3]); PIN(X); SBAR(); } while (0)
#define VRD(i) do { vlo[i] = vtr(vp_ + (((i) >> 2) * 4096 + ((i) & 3) * 1024)); vhi[i] = vtr(vp_ + (((i) >> 2) * 4096 + ((i) & 3) * 1024 + 512)); } while (0)
#define KRD(G, j) do { if (G) { kload2(kf, kp0 + sl_next, j); SBAR(); } } while (0)
#define STEP(C0, C1, P0, P1, t, GK, GV, GL) do { SBAR(); \
    const lds_cptr vp_ = vp0 + sl_prev; \
    VRD(0); SBAR(); float sacc = (P0[0] + P0[1]); \
    GAPA(C0 = __builtin_amdgcn_mfma_f32_32x32x16_bf16(kf[0], qr[0], negm, 0, 0, 0), P0[2], P0[3], P0[4], P0[5],     pw0[0] = PKW(P0, 0), pw0[1] = PKW(P0, 2), pw0); \
    VRD(4); SBAR(); GAPA(C1 = __builtin_amdgcn_mfma_f32_32x32x16_bf16(kf[1], qr[0], negm, 0, 0, 0), P0[6], P0[7], P0[8], P0[9],     pw0[2] = PKW(P0, 4), pw0[3] = PKW(P0, 6), pw0); \
    VRD(1); SBAR(); GAPA(C0 = __builtin_amdgcn_mfma_f32_32x32x16_bf16(kf[2], qr[1], C0, 0, 0, 0),   P0[10], P0[11], P0[12], P0[13], pw1[0] = PKW(P0, 8), pw1[1] = PKW(P0, 10), pw1); \
    VRD(5); SBAR(); GAPA(C1 = __builtin_amdgcn_mfma_f32_32x32x16_bf16(kf[3], qr[1], C1, 0, 0, 0),   P0[14], P0[15], P1[0], P1[1],   pw1[2] = PKW(P0, 12), pw1[3] = PKW(P0, 14), pw1); \
    VRD(2); SBAR(); GAPA(C0 = __builtin_amdgcn_mfma_f32_32x32x16_bf16(kf[4], qr[2], C0, 0, 0, 0),   P1[2], P1[3], P1[4], P1[5],     pw2[0] = PKW(P1, 0), pw2[1] = PKW(P1, 2), pw2); \
    VRD(6); SBAR(); GAPA(C1 = __builtin_amdgcn_mfma_f32_32x32x16_bf16(kf[5], qr[2], C1, 0, 0, 0),   P1[6], P1[7], P1[8], P1[9],     pw2[2] = PKW(P1, 4), pw2[3] = PKW(P1, 6), pw2); \
    VRD(3); SBAR(); GAPA(C0 = __builtin_amdgcn_mfma_f32_32x32x16_bf16(kf[6], qr[3], C0, 0, 0, 0),   P1[10], P1[11], P1[12], P1[13], pw3[0] = PKW(P1, 8), pw3[1] = PKW(P1, 10), pw3); \
    VRD(7); SBAR(); GAPA(C1 = __builtin_amdgcn_mfma_f32_32x32x16_bf16(kf[7], qr[3], C1, 0, 0, 0),   P1[14], P1[15], 0.f, 0.f,       pw3[2] = PKW(P1, 12), pw3[3] = PKW(P1, 14), pw3); \
    l_reg += sacc; \
    if (GK) { DMA_K((t) + 3, sl_cur); } if (GV) { DMA_V((t) + 1, sl_next); } \
    CMASK(C0, C1, t); \
    { float a = MX3(C0[0], C0[1], C1[0]), b2 = MX3(C0[2], C0[3], C1[1]); a = MX3(a, C1[2], C1[3]); \
      _Pragma("unroll") for (int r = 4; r < 16; r += 4) { a = MX3(a, C0[r], C0[r + 1]); b2 = MX3(b2, C0[r + 2], C0[r + 3]); a = MX3(a, C1[r], C1[r + 1]); b2 = MX3(b2, C1[r + 2], C1[r + 3]); } \
      float rm = __builtin_fmaxf(a, b2); { auto rr = __builtin_amdgcn_permlane32_swap(__float_as_uint(rm), __float_as_uint(rm), false, false); rm = __builtin_fmaxf(__uint_as_float(rr[0]), __uint_as_float(rr[1])); } \
      resc = false; \
      if (__builtin_expect(__any(rm > (float)THRL), 0)) { const float dl = __builtin_fmaxf(rm, 0.f); mhat += dl; \
        _Pragma("unroll") for (int r = 0; r < 16; ++r) { C0[r] -= dl; C1[r] -= dl; } \
        _Pragma("unroll") for (int r = 0; r < 16; ++r) negm[r] = -mhat; asm volatile("" : "+v"(negm)); \
        const float f = __builtin_amdgcn_exp2f(-dl); l_reg *= f; if (hi == 0) wsf[r32] = f; resc = true; } } \
    SBAR(); \
    GAPB(o[0] = __builtin_amdgcn_mfma_f32_32x32x16_bf16(PAF(0), VFR(0), o[0], 0, 0, 0), C0, 0); \
    GAPB(o[1] = __builtin_amdgcn_mfma_f32_32x32x16_bf16(PAF(0), VFR(4), o[1], 0, 0, 0), C0, 4); \
    KRD(GL, 0); GAPB(o[0] = __builtin_amdgcn_mfma_f32_32x32x16_bf16(PAF(1), VFR(1), o[0], 0, 0, 0), C0, 8); \
    KRD(GL, 1); GAPB(o[1] = __builtin_amdgcn_mfma_f32_32x32x16_bf16(PAF(1), VFR(5), o[1], 0, 0, 0), C0, 12); \
    KRD(GL, 2); GAPB(o[0] = __builtin_amdgcn_mfma_f32_32x32x16_bf16(PAF(2), VFR(2), o[0], 0, 0, 0), C1, 0); \
    KRD(GL, 3); GAPB(o[1] = __builtin_amdgcn_mfma_f32_32x32x16_bf16(PAF(2), VFR(6), o[1], 0, 0, 0), C1, 4); \
    GAPB(o[0] = __builtin_amdgcn_mfma_f32_32x32x16_bf16(PAF(3), VFR(3), o[0], 0, 0, 0), C1, 8); \
    GAPB(o[1] = __builtin_amdgcn_mfma_f32_32x32x16_bf16(PAF(3), VFR(7), o[1], 0, 0, 0), C1, 12); \
    } while (0)
#define ENDW(tt) do { if ((tt) + 3 < NT) { WAIT_BAR(2); } else if ((tt) + 2 < NT) { WAIT_BAR(1); } else { WAIT_BAR(0); } } while (0)
    int t = 1;
    for (; t + 1 < NT; t += 2) {
        STEP(pB0, pB1, pA0, pA1, t, (t + 3 < NT), (t + 1 < NT), (t + 1 < NT));       ENDW(t);     RESC(); ROT();
        STEP(pA0, pA1, pB0, pB1, t + 1, (t + 4 < NT), (t + 2 < NT), (t + 2 < NT));   ENDW(t + 1); RESC(); ROT();
    }
    nbase = sl_next;
    if (has_next) {
        const long nr = (long)NTOK + nb * CTXL; const long nko = (long)lane * 256 + nkvh * 64 + wid * 8, nvo = (long)(16 * (wid & 3) + (lane >> 2)) * 256 + nkvh * 64 + (wid >> 2) * 32 + (lane & 3) * 8;
        const int n0 = sl_next, n1 = (n0 == (NSLOT - 1) * SLOTB) ? 0 : n0 + SLOTB, n2 = (n1 == (NSLOT - 1) * SLOTB) ? 0 : n1 + SLOTB;
        glds16(KB + nr * 256 + nko, (unsigned)__builtin_amdgcn_readfirstlane(kdst + n0)); glds16(VB + nr * 256 + nvo, (unsigned)__builtin_amdgcn_readfirstlane(vdst + n0));
        glds16(KB + (nr + 64) * 256 + nko, (unsigned)__builtin_amdgcn_readfirstlane(kdst + n1)); glds16(KB + (nr + 128) * 256 + nko, (unsigned)__builtin_amdgcn_readfirstlane(kdst + n2));
    }
    STEP(pB0, pB1, pA0, pA1, NT - 1, false, false, false); RESC();
    { float sacc = pB0[0] + pB0[1]; _Pragma("unroll") for (int r = 2; r < 16; ++r) sacc += pB0[r]; _Pragma("unroll") for (int r = 0; r < 16; ++r) sacc += pB1[r]; l_reg += sacc;
      pw0 = (u32x4){PKW(pB0, 0), PKW(pB0, 2), PKW(pB0, 4), PKW(pB0, 6)}; pw1 = (u32x4){PKW(pB0, 8), PKW(pB0, 10), PKW(pB0, 12), PKW(pB0, 14)}; pw2 = (u32x4){PKW(pB1, 0), PKW(pB1, 2), PKW(pB1, 4), PKW(pB1, 6)}; pw3 = (u32x4){PKW(pB1, 8), PKW(pB1, 10), PKW(pB1, 12), PKW(pB1, 14)};
      SBAR(); pv(o, vb0 + sl_cur, PAF(0), PAF(1), PAF(2), PAF(3)); }
    if (has_next) {
        asm volatile("" ::: "memory");
        const bf16_t* nQw = Y + ((long)nb * SEQ + nn * 128 + qsub * 32) * 2048 + 1024 + (nkvh * 4 + nhp * 2 + (wid >> 2)) * 64;
#pragma unroll
        for (int d0 = 0; d0 < 4; ++d0) qr[d0] = *(const bf16x8*)(nQw + (long)r32 * 2048 + d0 * 16 + hi * 8);
    }
    { auto rr = __builtin_amdgcn_permlane32_swap(__float_as_uint(l_reg), __float_as_uint(l_reg), false, false); l_reg = __uint_as_float(rr[0]) + __uint_as_float(rr[1]); }
    l_reg += __builtin_amdgcn_exp2f(fminf(sink[head] * LOG2E - mhat, 80.f));
    if (hi == 0) wsf[32 + r32] = l_reg; asm volatile("s_waitcnt lgkmcnt(0)" ::: "memory");
    float rli[16];
#pragma unroll
    for (int r = 0; r < 16; ++r) rli[r] = __builtin_amdgcn_rcpf(wsf[32 + crow(r, hi)]);
    bf16_t* Ow = O + qrow0 * ldo + head * 64;
    { LAS bf16_t* stg = (LAS bf16_t*)(shm + LDS_OST) + wid * 2048;
#pragma unroll
      for (int r = 0; r < 16; ++r) { const int orow = crow(r, hi);
#pragma unroll
          for (int d0 = 0; d0 < 2; ++d0) stg[orow * 64 + d0 * 32 + r32] = (bf16_t)(pk2(o[d0][r] * rli[r], 0.f) & 0xffffu); }
      asm volatile("s_waitcnt lgkmcnt(0)" ::: "memory");
#pragma unroll
      for (int i = 0; i < 4; ++i) { const int row = i * 8 + (lane >> 3), ch = lane & 7; const u32x4 v = *(const LAS u32x4*)(stg + row * 64 + ch * 8); *(u32x4*)(Ow + (long)row * ldo + ch * 8) = v; } }
    asm volatile("s_waitcnt lgkmcnt(0)\n\ts_barrier" ::: "memory");
#undef TROW
#undef DMA_K
#undef DMA_V
#undef CMASK
#undef START
#undef RESC
#undef ROT
#undef PKW
#undef PAF
#undef VFR
#undef PIN
#undef MX3
#undef GAPA
#undef GAPB
#undef EX
#undef VRD
#undef KRD
#undef STEP
#undef ENDW
}
#undef SBAR
#undef WAIT_BAR
}

#define XB_TMO      128
#define XB_XCNT(j)  (256  + 64 * (j))
#define XB_XSUB(j)  (1280 + 64 * (j))
#define XB_XGEN(j)  (2304 + 64 * (j))
#define XB_TOP      3328
#define XB_TOPGEN   3392
#define XCD_BAR_WORDS 3456
#define XB_SPIN_CAP (1u << 18)
__device__ __forceinline__ unsigned xb_ld(unsigned* p)              { return __hip_atomic_load(p, __ATOMIC_RELAXED, __HIP_MEMORY_SCOPE_AGENT); }
__device__ __forceinline__ unsigned xb_add(unsigned* p, unsigned v) { return __hip_atomic_fetch_add(p, v, __ATOMIC_RELAXED, __HIP_MEMORY_SCOPE_AGENT); }
__device__ __forceinline__ unsigned xb_xcc_id() { return (unsigned)__builtin_amdgcn_s_getreg((3 << 11) | 20) & 0xFu; }
#define XB_SPIN(cond, bar) do { unsigned _sp = 0; while (cond) { __builtin_amdgcn_s_sleep(1); \
    if ((++_sp & 255u) == 0u) { if (xb_ld(&(bar)[XB_TMO])) break; if (_sp > XB_SPIN_CAP) { atomicAdd(&(bar)[XB_TMO], 1u); break; } } } } while (0)
struct XcdBarrier { unsigned* bar; unsigned x; volatile LAS unsigned* st; };
__device__ __forceinline__ XcdBarrier xcd_barrier_post(unsigned* bar, volatile LAS unsigned* st) {
    XcdBarrier b; b.bar = bar; b.x = xb_xcc_id(); b.st = st;
    if (threadIdx.x == 0) (void)xb_add(&bar[XB_XCNT(b.x)], 1u);
    return b;
}
__device__ __forceinline__ void xcd_barrier_complete(unsigned* bar, unsigned x, unsigned& nloc, unsigned& nx) {
    const unsigned G = gridDim.x * gridDim.y * gridDim.z;
    unsigned sum, cnt, mine, sp = 0u;
    for (;;) {
        sum = 0u; cnt = 0u; mine = 0u;
#pragma unroll
        for (unsigned j = 0; j < 16; ++j) { const unsigned c = xb_ld(&bar[XB_XCNT(j)]); sum += c; cnt += (c > 0u) ? 1u : 0u; mine = (j == x) ? c : mine; }
        if (sum == G) break;
        __builtin_amdgcn_s_sleep(1);
        if ((++sp & 255u) == 0u) { if (xb_ld(&bar[XB_TMO])) break; if (sp > XB_SPIN_CAP) { atomicAdd(&bar[XB_TMO], 1u); break; } }
    }
    nloc = mine > 0u ? mine : 1u; nx = cnt > 0u ? cnt : 1u;
}
__device__ __forceinline__ void xcd_barrier(const XcdBarrier& b) {
    asm volatile("s_waitcnt vmcnt(0)" ::: "memory");
    __syncthreads();
    if (threadIdx.x == 0) {
        unsigned* bar = b.bar;
        __builtin_amdgcn_s_waitcnt(0);
        unsigned nloc = b.st[0], nx = b.st[1];
        if (nloc == 0u) { xcd_barrier_complete(bar, b.x, nloc, nx); b.st[0] = nloc; b.st[1] = nx; }
        const unsigned old = xb_add(&bar[XB_XSUB(b.x)], 1u);
        const unsigned gen = old / nloc;
        if (old + 1u == (gen + 1u) * nloc) {
            __builtin_amdgcn_fence(__ATOMIC_RELEASE, "agent");
            asm volatile("s_waitcnt vmcnt(0)" ::: "memory");
            const unsigned og = xb_add(&bar[XB_TOP], 1u);
            const unsigned tg = og / nx;
            if (og + 1u == (tg + 1u) * nx) xb_add(&bar[XB_TOPGEN], 1u);
            else XB_SPIN(xb_ld(&bar[XB_TOPGEN]) == tg, bar);
            __builtin_amdgcn_fence(__ATOMIC_ACQUIRE, "agent");
            xb_add(&bar[XB_XGEN(b.x)], 1u);
            asm volatile("s_waitcnt vmcnt(0)" ::: "memory");
        } else {
            XB_SPIN(xb_ld(&bar[XB_XGEN(b.x)]) == gen, bar);
            __builtin_amdgcn_fence(__ATOMIC_ACQUIRE, "agent");
            asm volatile("s_waitcnt vmcnt(0)" ::: "memory");
        }
    }
    __syncthreads();
}
constexpr int LDSCTL_OFF = LDS_BYTES - 256;
constexpr int CW_BAR = 4096, CW_CTX = 8192;

#ifndef PROBE_GMLP2
#define PROBE_GMLP2 0
#endif
#ifndef ATT_PIPE
#define ATT_PIPE 1
#endif
#ifndef ATT_THRL
#define ATT_THRL 8
#endif
#ifndef ONE_LAUNCH
#define ONE_LAUNCH 1
#endif
#ifndef FAST_MIX
#define FAST_MIX 1
#endif
#ifndef PROBE_SEQ
#define PROBE_SEQ 0, 1, 2, 3, 4, 5, 6, 7, 8, 9, 10, 11
#endif

enum { PH_PRO = 0, PH_HN, PH_IN, PH_MIX, PH_A, PH_O, PH_H2R, PH_WCONV, PH_TOPK, PH_GU, PH_D, PH_FIN, PH_COUNT };

__global__ void __launch_bounds__(NTHREADS, 2) fwd(Args args) {
    extern __shared__ __attribute__((aligned(16))) unsigned char lds_raw[];
    LAS unsigned char* lds = (LAS unsigned char*)lds_raw;
    const int tid = threadIdx.x, lane = tid & 63, wave = __builtin_amdgcn_readfirstlane(tid >> 6);
    const int G = gridDim.x, bid = blockIdx.x;
    unsigned char* ws = args.ws;
    const int lo = args.ph_lo, hi = args.ph_hi;
#define IN(k) (lo <= (k) && (k) < hi)
    float* MOD = (float*)(ws + WS_MOD); f32x2* ROPE = (f32x2*)(ws + WS_ROPE);
    float* AFFT = (float*)(ws + WS_AFFT); int* TOPI = (int*)(ws + WS_TOPI); float* TOPW = (float*)(ws + WS_TOPW); int* SLOT = (int*)(ws + WS_SLOT);
    bf16_t* WSP = (bf16_t*)(ws + WS_WSP); bf16_t* WIN = (bf16_t*)(ws + WS_WIN); bf16_t* WAB = (bf16_t*)(ws + WS_WAB); bf16_t* WO = (bf16_t*)(ws + WS_WO);
    bf16_t* H = (bf16_t*)(ws + WS_H); bf16_t* VA = (bf16_t*)(ws + WS_VA); bf16_t* KB = (bf16_t*)(ws + WS_KB); bf16_t* VB = (bf16_t*)(ws + WS_VB);
    bf16_t* GT = (bf16_t*)(ws + WS_G); bf16_t* Y = (bf16_t*)(ws + WS_Y); bf16_t* TMP = (bf16_t*)(ws + WS_TMP); bf16_t* MERGED = (bf16_t*)(ws + WS_MERGED);
    bf16_t* WGU = (bf16_t*)(ws + WS_WGU); bf16_t* WD = (bf16_t*)(ws + WS_WD); bf16_t* H2 = (bf16_t*)(ws + WS_H2); bf16_t* ACT = (bf16_t*)(ws + WS_ACT); bf16_t* YB = (bf16_t*)(ws + WS_YB);
    const int gw = bid * NWAVES + wave, NGW = G * NWAVES;
    if (tid < 64) ((LAS unsigned*)(lds + LDSCTL_OFF))[tid] = 0u;
    __syncthreads();
    XcdBarrier bar; bar.bar = (unsigned*)(ws + WS_CTL) + CW_BAR; bar.x = 0; bar.st = nullptr;
    if (ONE_LAUNCH) bar = xcd_barrier_post((unsigned*)(ws + WS_CTL) + CW_BAR, (volatile LAS unsigned*)(lds + LDSCTL_OFF));
#define SEAM(k) do { if (ONE_LAUNCH && IN(k) && IN((k) + 1)) xcd_barrier(bar); } while (0)

    if (IN(PH_PRO)) {
        if (bid < 192) adaln_task(bid, args.in[I_C], args.in[I_CCTX], args.in[I_WADA], args.in[I_BADA], MOD, (LAS float*)lds, tid);
        else if (bid == 192) rope_table(ROPE, tid);
        __syncthreads();
        for (int i = bid * NTHREADS + tid; i < 8 * 128 * 128 / 4; i += G * NTHREADS) st4bf(WSP + 4 * i, *(const f32x4*)(args.in[I_WSP] + 4 * i));
        LAS float* scr = (LAS float*)(lds + wave * 16384);
        constexpr int I_IN = 16 * 176, I_P = 16 * 32;
        for (int it = gw; it < I_IN + 3 * I_P; it += NGW) {
            int r = it;
            if (r < I_IN) { const int kb = r / 176, nb = r % 176, n0 = nb * 32; int drow = n0;
                if (n0 >= OFF_GATE) { const int gcol = n0 - OFF_GATE, isb = gcol >= 1024, ch = gcol & 1023; drow = OFF_GATE + 256 * (ch >> 7) + (ch & 127) + (isb ? 128 : 0); }
                transpose_item(args.in[I_WIN], INCOLS, kb * 64, n0, WIN + (size_t)drow * 1024 + kb * 64, 1024, scr, lane); continue; } r -= I_IN;
            if (r < I_P) { const int kb = r / 32, nb = r % 32; transpose_item(args.in[I_WPA], 1024, kb * 64, nb * 32, WAB + (size_t)(nb * 32) * 2048 + kb * 64, 2048, scr, lane); continue; } r -= I_P;
            if (r < I_P) { const int kb = r / 32, nb = r % 32; transpose_item(args.in[I_WPB], 1024, kb * 64, nb * 32, WAB + (size_t)(nb * 32) * 2048 + 1024 + kb * 64, 2048, scr, lane); continue; } r -= I_P;
            { const int kb = r / 32, nb = r % 32; transpose_item(args.in[I_WOUT], 1024, kb * 64, nb * 32, WO + (size_t)(nb * 32) * 1024 + kb * 64, 1024, scr, lane); }
        }
    }
    SEAM(PH_PRO);
    if (IN(PH_HN)) {
        const float* g1n = args.in[I_N1G];
        const int HCH = (NROWS_H + NGW - 1) / NGW;
        f32x4 am[4], sm[4]; int mcur = -1;
        for (int kk = 0; kk < HCH; ++kk) {
            const int row = gw * HCH + kk; if (row >= NROWS_H) break;
            const float* xr; int mrow;
            if (row < NTOK) { xr = args.in[I_X] + (size_t)row * 1024; mrow = row >> 12; } else { xr = args.in[I_CTX] + (size_t)(row - NTOK) * 1024; mrow = 8; }
            f32x4 v[4]; float ss = 0.f;
#pragma unroll
            for (int j = 0; j < 4; ++j) { v[j] = *(const f32x4*)(xr + 4 * lane + 256 * j); ss += (v[j].x * v[j].x + v[j].y * v[j].y) + (v[j].z * v[j].z + v[j].w * v[j].w); }
            if (mrow != mcur) { mcur = mrow; const float* sh = MOD + mrow * 6144; const float* sc = sh + 1024;
#pragma unroll
                for (int j = 0; j < 4; ++j) { const int col = 4 * lane + 256 * j; am[j] = *(const f32x4*)(g1n + col) * (1.f + *(const f32x4*)(sc + col)); sm[j] = *(const f32x4*)(sh + col); } }
            const float rstd = 1.0f / sqrtf(wave_sum(ss) * (1.f / 1024.f) + EPS);
#pragma unroll
            for (int j = 0; j < 4; ++j) st4bf(H + (size_t)row * 1024 + 4 * lane + 256 * j, (v[j] * rstd) * am[j] + sm[j]);
        }
    }
    SEAM(PH_HN);
    if (IN(PH_IN)) {
        Gemm g{H, WIN, 1024, 1024, 1024, 0, 30, nullptr}; StaticOrder S; S.init(NTOK, INCOLS, G, bid, G == 256 ? 0 : 16);
        EpiIn E{Y, VA, KB, VB, GT, args.in[I_BMG], ROPE, (f32x2*)(ws + WS_STATS)};
        GEMM_PHASE<EpiIn, StaticOrder, false>(lds, g, S, E);
    }
    SEAM(PH_IN);
    if (IN(PH_MIX) && FAST_MIX) {
        unsigned* ctxcnt = (unsigned*)(ws + WS_CTL) + CW_CTX;
        if (G == 256 && bid < 16) {
            Gemm g{H, WIN, 1024, 1024, 1024, 0, 30, nullptr}; OneUnit S{NTOK / 256 + (bid >> 1), 12 + (bid & 1)};
            EpiIn E{Y, VA, KB, VB, GT, args.in[I_BMG], ROPE, (f32x2*)(ws + WS_STATS)};
            GEMM_PHASE<EpiIn, OneUnit, false>(lds, g, S, E);
            asm volatile("s_waitcnt vmcnt(0)" ::: "memory");
            __syncthreads();
            if (tid == 0) { __builtin_amdgcn_fence(__ATOMIC_RELEASE, "agent"); asm volatile("s_waitcnt vmcnt(0)" ::: "memory"); xb_add(ctxcnt, 1u); }
        }
        if (!(args.flags & 8)) for (int task = bid; task < NB * 32; task += G) mix::gmlp_unit(task, Y, (args.flags & 2) ? TMP : Y, (args.flags & 2) ? 1024 : 2048, VA, WSP, (const f32x2*)(ws + WS_STATS), args.in[I_LNG], args.in[I_LNB], args.in[I_BSP], lds);
        if (tid == 0) {
            unsigned sp = 0; while (xb_ld(ctxcnt) < 16u) { __builtin_amdgcn_s_sleep(2); if (++sp > (1u << 22)) break; }
            __builtin_amdgcn_fence(__ATOMIC_ACQUIRE, "agent"); asm volatile("s_waitcnt vmcnt(0)" ::: "memory");
        }
        __syncthreads();
#if ATT_PIPE
        att2::bf16x8 att_qr[4]; int att_base = 0; bool att_primed = false;
        int ubase, ucnt;
        if (G != 256) { ubase = bid * 8; ucnt = 0; }
        else if (bid < 16) { ubase = 6 * bid; ucnt = 6; } else if (bid < 48) { ubase = 96 + 9 * (bid - 16); ucnt = 9; } else { ubase = 384 + 8 * (bid - 48); ucnt = 8; }
        if (!(args.flags & 1)) for (int i = 0; i < ucnt; ++i) {
            const int u_ = ubase + i, task = u_ >> 1, hp = u_ & 1, un = u_ + 1, ntask = un >> 1; const bool more = i + 1 < ucnt; int nbase_ = 0;
            att2::attn_unit<ATT_THRL>(task >> 7, (task >> 2) & 31, task & 3, hp, att_base, att_primed, more, ntask >> 7, (ntask >> 2) & 31, ntask & 3, un & 1, att_qr, nbase_,
                                      Y, (args.flags & 4) ? TMP : Y + 1024, (args.flags & 4) ? 1024 : 2048, KB, VB, args.in[I_SINK], lds);
            att_base = nbase_; att_primed = more;
        }
        if (G != 256 && !(args.flags & 1)) for (int u_ = bid; u_ < NB * 32 * 8; u_ += G) {
            const int task = u_ >> 1; int nbase_ = 0;
            att2::attn_unit<ATT_THRL>(task >> 7, (task >> 2) & 31, task & 3, u_ & 1, 0, false, false, 0, 0, 0, 0, att_qr, nbase_, Y, (args.flags & 4) ? TMP : Y + 1024, (args.flags & 4) ? 1024 : 2048, KB, VB, args.in[I_SINK], lds);
        }
#else
        if (!(args.flags & 1)) for (int task = bid; task < NB * 32 * 4; task += G) mix::attn_unit(task >> 7, (task >> 2) & 31, task & 3, Y, (args.flags & 4) ? TMP : Y + 1024, (args.flags & 4) ? 1024 : 2048, KB, VB, args.in[I_SINK], lds);
#endif
    }
    SEAM(PH_MIX);
    if (IN(PH_A)) {
        Gemm g{Y, WAB, 2048, 2048, 2048, 0, 30, nullptr}; StaticOrder S; S.init(NTOK, 1024, G, bid, 0, 1);
        EpiAB E{MERGED, GT};
        GEMM_PHASE<EpiAB, StaticOrder, false, true>(lds, g, S, E);
    }
    SEAM(PH_A);
    if (IN(PH_O)) {
        Gemm g{MERGED, WO, 1024, 1024, 1024, 0, 30, nullptr}; StaticOrder S; S.init(NTOK, 1024, G, bid);
        EpiO E{(bf16_t*)args.out, MOD};
        GEMM_PHASE<EpiO, StaticOrder, false>(lds, g, S, E);
    }
    SEAM(PH_O);
    if (IN(PH_H2R)) {
        LAS float* wT = (LAS float*)lds;
        { f32x4 wv[8];
#pragma unroll
          for (int k = 0; k < 8; ++k) wv[k] = *(const f32x4*)(args.in[I_WR] + 4 * (tid + NTHREADS * k));
#pragma unroll
          for (int k = 0; k < 8; ++k) { const int f = tid + NTHREADS * k, col = f >> 2, e0 = 4 * (f & 3); wT[e0 * 1024 + col] = wv[k].x; wT[(e0 + 1) * 1024 + col] = wv[k].y; wT[(e0 + 2) * 1024 + col] = wv[k].z; wT[(e0 + 3) * 1024 + col] = wv[k].w; } }
        __syncthreads();
        const float* g2n = args.in[I_N2G];
        const int H2CH = (NTOK / 2 + NGW - 1) / NGW;
        const bool h32 = lane & 32, h16 = lane & 16, h8 = lane & 8, h4 = lane & 4;
        const int myexp = 8 * (lane >> 5) + 4 * ((lane >> 4) & 1) + 2 * ((lane >> 3) & 1) + ((lane >> 2) & 1);
        const bf16_t* D16 = (const bf16_t*)args.out;
        f32x4 vn[2][4]; u32x2 dn[2][4];
#pragma unroll
        for (int q = 0; q < 2; ++q)
#pragma unroll
            for (int j = 0; j < 4; ++j) { const size_t r_ = (size_t)(2 * (NTOK / 2 - 1 - (gw * H2CH < NTOK / 2 ? gw * H2CH : 0)) + q); vn[q][j] = *(const f32x4*)(args.in[I_X] + r_ * 1024 + 4 * lane + 256 * j); dn[q][j] = *(const u32x2*)(D16 + r_ * 2048 + 1024 + 4 * lane + 256 * j); }
        f32x4 amod[4], smod[4]; int bcur = -1;
        for (int kk = 0; kk < H2CH; ++kk) {
            const int rp = gw * H2CH + kk; if (rp >= NTOK / 2) break;
            const int row0 = 2 * (NTOK / 2 - 1 - rp), b = row0 >> 12;
            if (b != bcur) { bcur = b; const float* sh = MOD + b * 6144 + 3072; const float* sc = sh + 1024;
#pragma unroll
                for (int j = 0; j < 4; ++j) { const int col = 4 * lane + 256 * j; amod[j] = *(const f32x4*)(g2n + col) * (1.f + *(const f32x4*)(sc + col)); smod[j] = *(const f32x4*)(sh + col); } }
            f32x4 v[2][4]; float ss[2] = {0.f, 0.f};
#pragma unroll
            for (int q = 0; q < 2; ++q)
#pragma unroll
                for (int j = 0; j < 4; ++j) { const u32x2 dw = dn[q][j]; v[q][j] = vn[q][j] + (f32x4){bf2f(dw.x & 0xffffu), bf2f(dw.x >> 16), bf2f(dw.y & 0xffffu), bf2f(dw.y >> 16)}; ss[q] += (v[q][j].x * v[q][j].x + v[q][j].y * v[q][j].y) + (v[q][j].z * v[q][j].z + v[q][j].w * v[q][j].w); }
            { const int rn = (kk + 1 < H2CH && rp + 1 < NTOK / 2) ? rp + 1 : rp;
#pragma unroll
              for (int q = 0; q < 2; ++q)
#pragma unroll
                  for (int j = 0; j < 4; ++j) { const size_t r_ = (size_t)(2 * (NTOK / 2 - 1 - rn) + q); vn[q][j] = *(const f32x4*)(args.in[I_X] + r_ * 1024 + 4 * lane + 256 * j); dn[q][j] = *(const u32x2*)(D16 + r_ * 2048 + 1024 + 4 * lane + 256 * j); } }
            float rstd[2];
#pragma unroll
            for (int q = 0; q < 2; ++q) rstd[q] = 1.0f / sqrtf(wave_sum(ss[q]) * (1.f / 1024.f) + EPS);
            float lg[2][16];
#pragma unroll
            for (int q = 0; q < 2; ++q)
#pragma unroll
                for (int e = 0; e < 16; ++e) lg[q][e] = 0.f;
            f32x4 wb[2][4];
#pragma unroll
            for (int e = 0; e < 4; ++e) wb[0][e] = *(const LAS f32x4*)(wT + e * 1024 + 4 * lane);
            f32x4 h[2];
#pragma unroll
            for (int g = 0; g < 16; ++g) {
                const int j = g >> 2, eg = g & 3, col = 4 * lane + 256 * j;
                if (g + 1 < 16) {
                    const int jn = (g + 1) >> 2, en = (g + 1) & 3;
#pragma unroll
                    for (int e = 0; e < 4; ++e) wb[(g + 1) & 1][e] = *(const LAS f32x4*)(wT + (4 * en + e) * 1024 + 4 * lane + 256 * jn);
                }
                if (eg == 0) {
#pragma unroll
                    for (int q = 0; q < 2; ++q) { h[q] = (v[q][j] * rstd[q]) * amod[j] + smod[j]; st4bf(H2 + (size_t)(row0 + q) * 1024 + col, h[q]); }
                }
#pragma unroll
                for (int e = 0; e < 4; ++e) {
                    const f32x4 w = wb[g & 1][e];
#pragma unroll
                    for (int q = 0; q < 2; ++q) lg[q][4 * eg + e] += (h[q].x * w.x + h[q].y * w.y) + (h[q].z * w.z + h[q].w * w.w);
                    asm volatile("" : "+v"(lg[0][4 * eg + e]), "+v"(lg[1][4 * eg + e]));
                }
                asm volatile("" ::: "memory");
            }
#pragma unroll
            for (int q = 0; q < 2; ++q) {
                float a8[8], a4[4], a2[2], a1;
#pragma unroll
                for (int i = 0; i < 8; ++i) { const float send = h32 ? lg[q][i] : lg[q][i + 8], keep = h32 ? lg[q][i + 8] : lg[q][i]; a8[i] = keep + xchg32(send); }
#pragma unroll
                for (int i = 0; i < 4; ++i) { const float send = h16 ? a8[i] : a8[i + 4], keep = h16 ? a8[i + 4] : a8[i]; a4[i] = keep + xchg16(send); }
#pragma unroll
                for (int i = 0; i < 2; ++i) { const float send = h8 ? a4[i] : a4[i + 2], keep = h8 ? a4[i + 2] : a4[i]; a2[i] = keep + dpp_f<0x140>(send); }
                { const float send = h4 ? a2[0] : a2[1], keep = h4 ? a2[1] : a2[0]; a1 = keep + dpp_f<0x141>(send); }
                a1 += dpp_f<0x4E>(a1); a1 += dpp_f<0xB1>(a1);
                float mx = a1;
                mx = fmaxf(mx, dpp_f<0x141>(mx)); mx = fmaxf(mx, dpp_f<0x140>(mx)); mx = fmaxf(mx, xchg16(mx)); mx = fmaxf(mx, xchg32(mx));
                const float p = __expf(a1 - mx); float den = p;
                den += dpp_f<0x141>(den); den += dpp_f<0x140>(den); den += xchg16(den); den += xchg32(den);
                if ((lane & 3) == 0) AFFT[(size_t)(b * 16 + myexp) * SEQ + ((row0 + q) & (SEQ - 1))] = p / den;
            }
        }
    }
    if (IN(PH_WCONV)) {
        __syncthreads();
        LAS float* scr = (LAS float*)(lds + wave * 16384);
        constexpr int I_G = 16 * 16 * 64, I_D = 16 * 32 * 32;
        auto item = [&](int it) -> TrItem {
            int r = it; TrItem t;
            if (r < 2 * I_G) {
                const int up = r >= I_G; if (up) r -= I_G;
                const int e = r >> 10, kb = (r >> 6) & 15, nb = r & 63, n0 = nb * 32;
                const int drow = 256 * (n0 >> 7) + (n0 & 127) + (up ? 128 : 0);
                t.src = args.in[up ? I_WEU : I_WEG] + (size_t)e * 1024 * 2048 + (size_t)(kb * 64) * 2048 + n0; t.N = 2048;
                t.dst = WGU + (size_t)e * 4096 * 1024 + (size_t)drow * 1024 + kb * 64; t.ldt = 1024;
            } else {
                r -= 2 * I_G;
                const int e = r >> 10, kb = (r >> 5) & 31, nb = r & 31;
                t.src = args.in[I_WED] + (size_t)e * 2048 * 1024 + (size_t)(kb * 64) * 1024 + nb * 32; t.N = 1024;
                t.dst = WD + (size_t)e * 1024 * 2048 + (size_t)(nb * 32) * 2048 + kb * 64; t.ldt = 2048;
            }
            return t;
        };
        constexpr int NIT = 2 * I_G + I_D;
        if (gw < NIT) {
            TrItem cur = item(gw); f32x4 vc[8], vn[8];
            tr_load(cur, vc, lane);
            for (int it = gw; it < NIT; it += NGW) {
                const bool more = it + NGW < NIT;
                TrItem nxt = cur;
                if (more) { nxt = item(it + NGW); tr_load(nxt, vn, lane); }
                tr_store(cur, vc, scr, lane);
                cur = nxt;
#pragma unroll
                for (int i = 0; i < 8; ++i) vc[i] = vn[i];
            }
        }
    }
    SEAM(PH_WCONV);
    if (IN(PH_TOPK)) {
        LAS int* wsum = (LAS int*)lds;
        for (int task = bid; task < NE * NB; task += G) {
            const int e = task >> 3, b = task & 7;
            const float* aff = AFFT + (size_t)(b * 16 + e) * SEQ;
            unsigned k[8];
            { const u32x4 a0 = *(const u32x4*)(aff + 8 * tid), a1 = *(const u32x4*)(aff + 8 * tid + 4); k[0] = a0.x; k[1] = a0.y; k[2] = a0.z; k[3] = a0.w; k[4] = a1.x; k[5] = a1.y; k[6] = a1.z; k[7] = a1.w; }
            unsigned T = 0u; int it = 0;
            __syncthreads();
            for (int bit = 30; bit >= 0; --bit, ++it) {
                const unsigned cand = T | (1u << bit); int c = 0;
#pragma unroll
                for (int j = 0; j < 8; ++j) c += __builtin_popcountll(__ballot(k[j] >= cand));
                if (lane == 0) wsum[(it & 1) * 8 + wave] = c;
                __syncthreads();
                int tot = 0;
#pragma unroll
                for (int w = 0; w < 8; ++w) tot += wsum[(it & 1) * 8 + w];
                if (tot >= CAP) T = cand;
            }
            int cg = 0, ce = 0;
#pragma unroll
            for (int j = 0; j < 8; ++j) { cg += (k[j] > T) ? 1 : 0; ce += (k[j] == T) ? 1 : 0; }
            LAS int* sc1 = wsum + 16; LAS int* sc2 = wsum + 32;
            int ie = ce, ig = cg;
#pragma unroll
            for (int o = 1; o < 64; o <<= 1) { const int te = __shfl_up(ie, o), tg = __shfl_up(ig, o); if (lane >= o) { ie += te; ig += tg; } }
            __syncthreads();
            if (lane == 63) { sc1[wave] = ie; sc2[wave] = ig; }
            __syncthreads();
            int ebase = ie - ce, totg = 0;
#pragma unroll
            for (int w = 0; w < 8; ++w) { if (w < wave) ebase += sc1[w]; totg += sc2[w]; }
            const int need = CAP - totg;
            int sel[8], cs = 0, er = ebase;
#pragma unroll
            for (int j = 0; j < 8; ++j) { const bool eq = (k[j] == T); sel[j] = (k[j] > T) || (eq && er < need); er += eq ? 1 : 0; cs += sel[j]; }
            int is = cs;
#pragma unroll
            for (int o = 1; o < 64; o <<= 1) { const int ts = __shfl_up(is, o); if (lane >= o) is += ts; }
            __syncthreads();
            if (lane == 63) sc1[wave] = is;
            __syncthreads();
            int sbase = is - cs;
#pragma unroll
            for (int w = 0; w < 8; ++w) if (w < wave) sbase += sc1[w];
#pragma unroll
            for (int j = 0; j < 8; ++j) {
                const int t = 8 * tid + j; int slot = -1;
                if (sel[j]) { slot = sbase; ++sbase; const int prow = (e * 8 + b) * CAP + slot; TOPI[prow] = t; TOPW[prow] = __uint_as_float(k[j]); }
                SLOT[((size_t)b * SEQ + t) * 16 + e] = slot;
            }
            __syncthreads();
        }
    }
    SEAM(PH_TOPK);
    if (IN(PH_GU)) {
        Gemm g{H2, WGU, 1024, 1024, 1024, (size_t)4096 * 1024, 4, TOPI}; StaticOrder S; S.init(NPAIR, 4096, G, bid);
        EpiGU E{ACT};
        GEMM_PHASE<EpiGU, StaticOrder, true>(lds, g, S, E);
    }
    SEAM(PH_GU);
    if (IN(PH_D)) {
        Gemm g{ACT, WD, 2048, 2048, 2048, (size_t)1024 * 2048, 4, nullptr}; StaticOrder S; S.init(NPAIR, 1024, G, bid, 0, 1);
        EpiD E{YB, TOPW};
        GEMM_PHASE<EpiD, StaticOrder, false>(lds, g, S, E);
    }
    SEAM(PH_D);
    if (IN(PH_FIN)) {
        const float* fg = args.in[I_FING];
        const bf16_t* ZROW = (const bf16_t*)(ws + WS_CTL + 512 * 1024);
        int sln[2] = {-1, -1};
        const int FCH = (NTOK / 2 + NGW - 1) / NGW;
        if (gw * FCH < NTOK / 2 && lane < 16) { sln[0] = SLOT[(size_t)(2 * gw * FCH) * 16 + lane]; sln[1] = SLOT[(size_t)(2 * gw * FCH + 1) * 16 + lane]; }
        f32x4 g2v[4], fgv[4]; int bcur = -1;
#pragma unroll
        for (int h = 0; h < 2; ++h) { fgv[2 * h] = *(const f32x4*)(fg + 512 * h + 8 * lane); fgv[2 * h + 1] = *(const f32x4*)(fg + 512 * h + 8 * lane + 4); }
        for (int kk = 0; kk < FCH; ++kk) {
            const int rp = gw * FCH + kk; if (rp >= NTOK / 2) break;
            const int row0 = 2 * rp, b = row0 >> 12;
            const int sl[2] = {sln[0], sln[1]};
            { const int rn = rp + 1; if (kk + 1 < FCH && rn < NTOK / 2 && lane < 16) { sln[0] = SLOT[(size_t)(2 * rn) * 16 + lane]; sln[1] = SLOT[(size_t)(2 * rn + 1) * 16 + lane]; } }
            if (b != bcur) { bcur = b; const float* g2 = MOD + b * 6144 + 5120;
#pragma unroll
                for (int h = 0; h < 2; ++h) { g2v[2 * h] = *(const f32x4*)(g2 + 512 * h + 8 * lane); g2v[2 * h + 1] = *(const f32x4*)(g2 + 512 * h + 8 * lane + 4); } }
            f32x4 xv[2][4], acc[2][4];
#pragma unroll
            for (int q = 0; q < 2; ++q)
#pragma unroll
                for (int h = 0; h < 2; ++h) { const float* xp = args.in[I_X] + (size_t)(row0 + q) * 1024 + 512 * h + 8 * lane; f32x4 d0_, d1_; ld8bf((const bf16_t*)args.out + (size_t)(row0 + q) * 2048 + 1024 + 512 * h + 8 * lane, d0_, d1_);
                    xv[q][2 * h] = *(const f32x4*)xp + d0_; xv[q][2 * h + 1] = *(const f32x4*)(xp + 4) + d1_;
                    acc[q][2 * h] = (f32x4){0.f, 0.f, 0.f, 0.f}; acc[q][2 * h + 1] = (f32x4){0.f, 0.f, 0.f, 0.f}; }
#pragma unroll
            for (int q = 0; q < 2; ++q) {
                unsigned long long mask = __ballot(sl[q] >= 0);
                for (;;) {
                    const bf16_t* yr[4];
#pragma unroll
                    for (int k = 0; k < 4; ++k) {
                        if (mask) { const int ex = __builtin_ctzll(mask); mask &= mask - 1; const int s = __builtin_amdgcn_readlane(sl[q], ex); yr[k] = YB + (size_t)((ex * 8 + b) * CAP + s) * 1024; }
                        else yr[k] = ZROW;
                    }
                    u32x4 y[4][2];
#pragma unroll
                    for (int k = 0; k < 4; ++k)
#pragma unroll
                        for (int h = 0; h < 2; ++h) y[k][h] = *(const u32x4*)(yr[k] + 512 * h + 8 * lane);
#pragma unroll
                    for (int k = 0; k < 4; ++k)
#pragma unroll
                        for (int h = 0; h < 2; ++h) { const u32x4 w = y[k][h];
                            acc[q][2 * h] += (f32x4){bf2f(w.x & 0xffffu), bf2f(w.x >> 16), bf2f(w.y & 0xffffu), bf2f(w.y >> 16)};
                            acc[q][2 * h + 1] += (f32x4){bf2f(w.z & 0xffffu), bf2f(w.z >> 16), bf2f(w.w & 0xffffu), bf2f(w.w >> 16)}; }
                    if (!mask) break;
                }
            }
#pragma unroll
            for (int q = 0; q < 2; ++q) {
                float ss = 0.f;
#pragma unroll
                for (int h = 0; h < 2; ++h)
#pragma unroll
                    for (int u4 = 0; u4 < 2; ++u4) { const int col = 512 * h + 8 * lane + 4 * u4; f32x4& v = xv[q][2 * h + u4]; v = v + g2v[2 * h + u4] * acc[q][2 * h + u4]; ss += (v.x * v.x + v.y * v.y) + (v.z * v.z + v.w * v.w); }
                const float rstd = 1.0f / sqrtf(wave_sum(ss) * (1.f / 1024.f) + EPS);
#pragma unroll
                for (int h = 0; h < 2; ++h)
#pragma unroll
                    for (int u4 = 0; u4 < 2; ++u4) { const int col = 512 * h + 8 * lane + 4 * u4; *(f32x4*)(args.out + (size_t)(row0 + q) * 1024 + col) = xv[q][2 * h + u4] * rstd * fgv[2 * h + u4]; }
            }
        }
    }
#undef IN
}

extern "C" void kernel_launch(void* const* d_in, const int* in_sizes, int n_in, void* d_out, int out_size, void* d_ws, size_t ws_size, hipStream_t stream) {
    static int grid = 0;
    if (grid == 0) {
        if (n_in != 23 || in_sizes[0] != NTOK * DM || out_size != NTOK * DM || ws_size < WS_END) {
            fprintf(stderr, "kernel_launch: unexpected problem (n_in %d, in0 %d, out %d, ws %zu < %zu?)\n", n_in, n_in > 0 ? in_sizes[0] : -1, out_size, ws_size, (size_t)WS_END); grid = -1; return; }
        if (hipFuncSetAttribute((const void*)fwd, hipFuncAttributeMaxDynamicSharedMemorySize, LDS_BYTES) != hipSuccess) { fprintf(stderr, "kernel_launch: hipFuncSetAttribute failed\n"); grid = -1; return; }
        int dev = 0, cus = 0;
        if (hipGetDevice(&dev) != hipSuccess || hipDeviceGetAttribute(&cus, hipDeviceAttributeMultiprocessorCount, dev) != hipSuccess) { grid = -1; return; }
        grid = cus;
    }
    if (grid < 0) return;
    (void)hipMemsetAsync((char*)d_ws + WS_CTL, 0, 1 * MiB, stream);
    Args a{};
    for (int i = 0; i < 23; ++i) a.in[i] = (const float*)d_in[i];
    a.out = (float*)d_out; a.ws = (unsigned char*)d_ws;
    if (ONE_LAUNCH) {
        a.ph_lo = 0; a.ph_hi = PH_COUNT;
        hipLaunchKernelGGL(fwd, dim3(grid), dim3(NTHREADS), LDS_BYTES, stream, a);
    } else {
        static const int seq[] = {PROBE_SEQ};
        for (unsigned i = 0; i < sizeof(seq) / sizeof(seq[0]); ++i) {
            a.ph_lo = seq[i] % 100; a.ph_hi = seq[i] % 100 + 1; a.flags = seq[i] / 100;
            hipLaunchKernelGGL(fwd, dim3(grid), dim3(NTHREADS), LDS_BYTES, stream, a);
        }
    }
}
```

```cpp
#include <hip/hip_runtime.h>
#include <cstdio>
#include <cstdint>

#define LAS __attribute__((address_space(3)))
typedef unsigned short bf16_t;
typedef float f32x4 __attribute__((ext_vector_type(4)));
typedef float f32x2 __attribute__((ext_vector_type(2)));
typedef unsigned u32x4 __attribute__((ext_vector_type(4)));
typedef unsigned u32x2 __attribute__((ext_vector_type(2)));
typedef int i32x4 __attribute__((ext_vector_type(4)));

constexpr int DM = 1024, NB = 8, SEQ = 4096, NTOK = NB * SEQ, CTXL = 256, NCTX = NB * CTXL, NROWS_H = NTOK + NCTX;
constexpr int INCOLS = 5632, OFF_Q = 2048, OFF_K = 3072, OFF_VB = 3328, OFF_GATE = 3584;
constexpr int NE = 16, CAP = 512, DE = 2048, NPAIR = NE * NB * CAP;
constexpr float EPS = 1e-6f, LOG2E = 1.4426950408889634f, C2 = 0.125f * LOG2E;
constexpr int NTHREADS = 512, NWAVES = 8;

constexpr size_t MiB = 1u << 20;
constexpr size_t WS_CTL = 0;
constexpr size_t WS_MOD = 1 * MiB;
constexpr size_t WS_ROPE = 1 * MiB + 512 * 1024;
constexpr size_t WS_AFFT = 2 * MiB;
constexpr size_t WS_TOPI = 4 * MiB;
constexpr size_t WS_TOPW = 4 * MiB + 512 * 1024;
constexpr size_t WS_SLOT = 5 * MiB;
constexpr size_t WS_WSP = 7 * MiB;
constexpr size_t WS_WIN = 8 * MiB;
constexpr size_t WS_WAB = 19 * MiB;
constexpr size_t WS_WO = 23 * MiB;
constexpr size_t WS_R = 25 * MiB;
constexpr size_t WS_H = WS_R;
constexpr size_t WS_VA = WS_R + 68 * MiB;
constexpr size_t WS_KB = WS_VA + 64 * MiB;
constexpr size_t WS_VB = WS_KB + 17 * MiB;
constexpr size_t WS_G = WS_VB + 17 * MiB;
constexpr size_t WS_Y = WS_G + 128 * MiB;
constexpr size_t WS_TMP = WS_Y + 128 * MiB;
constexpr size_t WS_STATS = WS_TMP + 64 * MiB;
constexpr size_t WS_MERGED = WS_H;
constexpr size_t WS_WGU = WS_R;
constexpr size_t WS_WD = WS_R + 128 * MiB;
constexpr size_t WS_H2 = WS_R + 192 * MiB;
constexpr size_t WS_ACT = WS_R + 256 * MiB;
constexpr size_t WS_YB = WS_WGU;
constexpr size_t WS_END = 537 * MiB;
static_assert(WS_STATS + 4 * MiB <= WS_END && WS_ACT + 256 * MiB == WS_END, "ws map");

constexpr int LDS_BYTES = 147456;

__device__ __forceinline__ float bf2f(unsigned b) { return __uint_as_float(b << 16); }
__device__ __forceinline__ unsigned f2bf(float f) { unsigned u = __float_as_uint(f); return (u + 0x7fffu + ((u >> 16) & 1u)) >> 16; }
__device__ __forceinline__ unsigned pk2(float lo, float hi) { typedef float f2_ __attribute__((ext_vector_type(2))); typedef __bf16 b2_ __attribute__((ext_vector_type(2))); f2_ v = {lo, hi}; b2_ b = __builtin_convertvector(v, b2_); return __builtin_bit_cast(unsigned, b); }
__device__ __forceinline__ void st4bf(bf16_t* p, f32x4 v) { u32x2 w; w.x = pk2(v.x, v.y); w.y = pk2(v.z, v.w); *(u32x2*)p = w; }
__device__ __forceinline__ void st8bf(bf16_t* p, f32x4 a, f32x4 b) { u32x4 w; w.x = pk2(a.x, a.y); w.y = pk2(a.z, a.w); w.z = pk2(b.x, b.y); w.w = pk2(b.z, b.w); *(u32x4*)p = w; }
__device__ __forceinline__ void ld8bf(const bf16_t* p, f32x4& a, f32x4& b) { const u32x4 w = *(const u32x4*)p; a.x = bf2f(w.x & 0xffffu); a.y = bf2f(w.x >> 16); a.z = bf2f(w.y & 0xffffu); a.w = bf2f(w.y >> 16); b.x = bf2f(w.z & 0xffffu); b.y = bf2f(w.z >> 16); b.z = bf2f(w.w & 0xffffu); b.w = bf2f(w.w >> 16); }
__device__ __forceinline__ f32x4 ld4bf(const bf16_t* p) { const u32x2 w = *(const u32x2*)p; f32x4 v; v.x = bf2f(w.x & 0xffffu); v.y = bf2f(w.x >> 16); v.z = bf2f(w.y & 0xffffu); v.w = bf2f(w.y >> 16); return v; }
__device__ __forceinline__ float sigmoidf_(float x) { return __builtin_amdgcn_rcpf(1.f + __builtin_amdgcn_exp2f(x * -1.4426950409f)); }
__device__ __forceinline__ float siluf_(float x) { return x * __builtin_amdgcn_rcpf(1.f + __builtin_amdgcn_exp2f(x * -1.4426950409f)); }
__device__ __forceinline__ float gelu_t(float x) { const float t = x * __builtin_fmaf(x * x, -0.10294324f, -2.3022082f); return x * __builtin_amdgcn_rcpf(1.f + __builtin_amdgcn_exp2f(t)); }
__device__ __forceinline__ f32x2 rcp2_(f32x2 d) { f32x2 r; r.x = __builtin_amdgcn_rcpf(d.x); r.y = __builtin_amdgcn_rcpf(d.y); return r; }
__device__ __forceinline__ f32x2 exp2_2_(f32x2 t) { f32x2 e; e.x = __builtin_amdgcn_exp2f(t.x); e.y = __builtin_amdgcn_exp2f(t.y); return e; }
__device__ __forceinline__ f32x2 gelu2_(f32x2 x) { const f32x2 t = x * ((x * x) * -0.10294324f + -2.3022082f); return x * rcp2_(exp2_2_(t) + 1.0f); }
__device__ __forceinline__ f32x2 sigm2_(f32x2 x) { return rcp2_(exp2_2_(x * -1.4426950409f) + 1.0f); }
__device__ __forceinline__ f32x4 gelu4_(f32x4 v) { const f32x2 a = gelu2_((f32x2){v.x, v.y}), b = gelu2_((f32x2){v.z, v.w}); return (f32x4){a.x, a.y, b.x, b.y}; }
__device__ __forceinline__ f32x4 sigm4_(f32x4 v) { const f32x2 a = sigm2_((f32x2){v.x, v.y}), b = sigm2_((f32x2){v.z, v.w}); return (f32x4){a.x, a.y, b.x, b.y}; }
template <int CTRL> __device__ __forceinline__ float dpp_f(float v) { const int i = __builtin_bit_cast(int, v); return __builtin_bit_cast(float, __builtin_amdgcn_update_dpp(i, i, CTRL, 0xf, 0xf, true)); }
__device__ __forceinline__ float xchg16(float v) { auto r = __builtin_amdgcn_permlane16_swap(__float_as_uint(v), __float_as_uint(v), false, false); return __uint_as_float((threadIdx.x & 16) ? r[0] : r[1]); }
__device__ __forceinline__ float xchg32(float v) { auto r = __builtin_amdgcn_permlane32_swap(__float_as_uint(v), __float_as_uint(v), false, false); return __uint_as_float((threadIdx.x & 32) ? r[0] : r[1]); }
__device__ __forceinline__ float wave_sum(float v) {
    v += dpp_f<0xB1>(v); v += dpp_f<0x4E>(v); v += dpp_f<0x141>(v); v += dpp_f<0x140>(v); v += xchg16(v); v += xchg32(v);
    return v;
}
__device__ __forceinline__ int wave_sum_i(int v) {
#pragma unroll
    for (int o = 1; o < 64; o <<= 1) v += __shfl_xor(v, o);
    return v;
}
#define LDS_WAIT() asm volatile("s_waitcnt lgkmcnt(0)" ::: "memory")

struct Args { const float* in[23]; float* out; unsigned char* ws; int ph_lo, ph_hi, flags, pad; };
enum { I_X = 0, I_C, I_CTX, I_CCTX, I_WADA, I_BADA, I_N1G, I_WIN, I_BMG, I_LNG, I_LNB, I_WSP, I_BSP, I_SINK, I_WPA, I_WPB, I_WOUT, I_N2G, I_WR, I_WEG, I_WEU, I_WED, I_FING };

struct Unit { int pm, pn; };
struct Gemm {
    const bf16_t* A; const bf16_t* Bt; int lda, ldb, K;
    size_t bgs; int tpg_shift;
    const int* gidx;
};
constexpr int NXCD = 8, WGM = 8;
struct StaticOrder {
    int nM, nN, nwg, G, c, extra, rev;
    __device__ void init(int M, int N, int G_, int c_, int extra_ = 0, int rev_ = 0) { nM = M / 256; nN = N / 256; nwg = nM * nN; G = G_; c = c_; extra = extra_; rev = rev_; }
    __device__ bool next(int i, Unit& u) const {
        const long L = (long)i * G + c;
        if (L >= nwg) { const int x = (int)(L - nwg); if (x >= extra) return false; u.pm = NTOK / 256 + (x >> 1); u.pn = 12 + (x & 1); return true; }
        int wgid = (int)L; { const int q = nwg / NXCD, r = nwg % NXCD, xcd = wgid % NXCD, off = wgid / NXCD; wgid = (xcd < r ? xcd * (q + 1) : r * (q + 1) + (xcd - r) * q) + off; }
        const int nig = WGM * nN, gid = wgid / nig, fm = gid * WGM, gsz = (nM - fm) < WGM ? (nM - fm) : WGM;
        u.pm = fm + ((wgid % nig) % gsz); u.pn = (wgid % nig) / gsz; if (rev) u.pm = nM - 1 - u.pm; return true;
    }
};

struct OneUnit { int pm, pn; __device__ bool next(int i, Unit& u) const { if (i) return false; u.pm = pm; u.pn = pn; return true; } };

typedef f32x4 Acc[2][2][4][2];

namespace pg8 {
typedef short bf16x8 __attribute__((ext_vector_type(8)));
constexpr int BK = 64, HALF = 128, HTB = HALF * BK * 2, STAGE_BYTES = 8 * HTB;
__device__ __forceinline__ int lds_byte(int r, int c) { const int st = (r >> 4) * 2 + (c >> 5), rr = r & 15, cc = c & 31, ob = rr * 64 + cc * 2; return st * 1024 + (ob ^ (((ob >> 9) & 1) << 5)); }
__device__ __forceinline__ void stage_rc(int b, int& R, int& C) { const int st = b / 1024, sb = b % 1024, swz = sb ^ (((sb >> 9) & 1) << 5); R = (st >> 1) * 16 + swz / 64; C = (st & 1) * 32 + (swz % 64) / 2; }

template <class Epi, class Sched, bool GATHER, bool HOOK = false, bool RELAX = false>
__device__ __forceinline__ void gemm_phase(LAS unsigned char* lds, const Gemm g, const Sched& S, const Epi& E) {
    const int tid = threadIdx.x, wid = __builtin_amdgcn_readfirstlane(tid >> 6), lane = tid & 63, wr = wid >> 2, wc = wid & 3, fr = lane & 15, fq = lane >> 4;
    const int nt = g.K / BK;
    int Rs[2], Cs[2]; unsigned voffBp[2][2], voffB[2], voffBn[2], vA[2][2], vN[2][2];
#pragma unroll
    for (int i = 0; i < 2; ++i) { stage_rc(tid * 16 + i * 8192, Rs[i], Cs[i]); voffBp[0][i] = (unsigned)(Rs[i] * g.ldb + Cs[i]) * 2u;
        const int rho = Rs[i] & 31, Rb = (Rs[i] & ~31) + 8 * ((rho & 15) >> 2) + 4 * (rho >> 4) + (rho & 3); voffBp[1][i] = (unsigned)(Rb * g.ldb + Cs[i]) * 2u; }
    const size_t kstep = (size_t)(BK * 2);
    const size_t hstepB = (size_t)HALF * g.ldb * 2;
    const unsigned ldsw = (unsigned)wid * 1024u;
    const int aoff = lds_byte(wr * 64 + fr, fq * 8), boff = lds_byte(wc * 32 + fr, fq * 8);
#define PG8_SA(b, h) (((b) * 2 + (h)) * HTB)
#define PG8_SB(b, h) ((4 + (b) * 2 + (h)) * HTB)
#define PG8_STAGE(bufoff, gbase, voff) do { _Pragma("unroll") for (int _i = 0; _i < 2; ++_i) \
        __builtin_amdgcn_global_load_lds((const unsigned*)((const char*)(gbase) + (voff)[_i]), (LAS unsigned*)(lds + (bufoff) + ldsw + _i * 8192), 16, 0, 0); } while (0)
#define PG8_LDA(dst, b, h) do { _Pragma("unroll") for (int m = 0; m < 4; ++m) _Pragma("unroll") for (int k = 0; k < 2; ++k) dst[m][k] = *(const LAS bf16x8*)(lds + PG8_SA(b, h) + aoff + m * 2048 + k * 1024); } while (0)
#define PG8_LDB(dst, b, h) do { _Pragma("unroll") for (int n = 0; n < 2; ++n) _Pragma("unroll") for (int k = 0; k < 2; ++k) dst[n][k] = *(const LAS bf16x8*)(lds + PG8_SB(b, h) + boff + n * 2048 + k * 1024); } while (0)
#define PG8_MMA(ai, bj, At, Bt) do { __builtin_amdgcn_s_setprio(1); _Pragma("unroll") for (int m = 0; m < 4; ++m) _Pragma("unroll") for (int n = 0; n < 2; ++n) _Pragma("unroll") for (int k = 0; k < 2; ++k) \
        acc[ai][bj][m][n] = __builtin_amdgcn_mfma_f32_16x16x32_bf16(Bt[n][k], At[m][k], acc[ai][bj][m][n], 0, 0, 0); __builtin_amdgcn_s_setprio(0); } while (0)
#define PG8_WAIT_V(n) asm volatile("s_waitcnt vmcnt(" #n ")" ::: "memory")
#define PG8_WAIT_L(n) asm volatile("s_waitcnt lgkmcnt(" #n ")" ::: "memory")
#define PG8_BAR __builtin_amdgcn_s_barrier()
#define PG8_SCHED __builtin_amdgcn_sched_barrier(0)
#define PG8_AVOFF(dst, U) do { _Pragma("unroll") for (int _h = 0; _h < 2; ++_h) _Pragma("unroll") for (int _i = 0; _i < 2; ++_i) \
        dst[_h][_i] = GATHER ? (unsigned)((((U).pm >> 1) & 7) * SEQ + g.gidx[(U).pm * 256 + _h * 128 + Rs[_i]]) * (unsigned)(g.lda * 2) + (unsigned)(Cs[_i] * 2) \
                             : (unsigned)((_h * 128 + Rs[_i]) * g.lda + Cs[_i]) * 2u; } while (0)
#define PG8_ABASE(U) ((const char*)g.A + (GATHER ? (size_t)0 : (size_t)(U).pm * 256 * g.lda * 2))
#define PG8_BBASE(U) ((const char*)g.Bt + ((size_t)((U).pm >> g.tpg_shift) * g.bgs + (size_t)(U).pn * 256 * g.ldb) * 2)
    Unit cur, nxt; int ui = 0;
    if (!S.next(0, cur)) return;
    Acc acc;
#pragma unroll
    for (int a = 0; a < 2; ++a)
#pragma unroll
        for (int b = 0; b < 2; ++b)
#pragma unroll
            for (int m = 0; m < 4; ++m)
#pragma unroll
                for (int n = 0; n < 2; ++n) acc[a][b][m][n] = (f32x4){0.f, 0.f, 0.f, 0.f};
    bf16x8 At[4][2], B0[2][2], B1[2][2];
    PG8_AVOFF(vA, cur);
    { const bool pc = E.perm(cur); voffB[0] = pc ? voffBp[1][0] : voffBp[0][0]; voffB[1] = pc ? voffBp[1][1] : voffBp[0][1]; }
    const char* cA = PG8_ABASE(cur); const char* cB = PG8_BBASE(cur);
    PG8_STAGE(PG8_SB(0, 0), cB, voffB); PG8_STAGE(PG8_SB(0, 1), cB + hstepB, voffB); PG8_STAGE(PG8_SA(0, 0), cA, vA[0]); PG8_STAGE(PG8_SA(0, 1), cA, vA[1]);
    if (wr == 1) PG8_BAR;
    PG8_WAIT_V(2); PG8_BAR;
    PG8_STAGE(PG8_SB(1, 0), cB + kstep, voffB); PG8_STAGE(PG8_SA(1, 0), cA + kstep, vA[0]); PG8_STAGE(PG8_SB(1, 1), cB + hstepB + kstep, voffB);
    if constexpr (RELAX) { PG8_WAIT_V(0); } else { PG8_WAIT_V(6); } PG8_BAR;
    for (;;) {
        const bool has_next = S.next(ui + 1, nxt);
        const char* nA = has_next ? PG8_ABASE(nxt) : cA; const char* nB = has_next ? PG8_BBASE(nxt) : cB;
        { const bool pn_ = has_next ? E.perm(nxt) : E.perm(cur); voffBn[0] = pn_ ? voffBp[1][0] : voffBp[0][0]; voffBn[1] = pn_ ? voffBp[1][1] : voffBp[0][1]; }
        if (GATHER) {
#pragma unroll
            for (int h = 0; h < 2; ++h)
#pragma unroll
                for (int i = 0; i < 2; ++i) vN[h][i] = vA[h][i];
            if (has_next && wid == 0)
                __builtin_amdgcn_global_load_lds((const unsigned*)(g.gidx + nxt.pm * 256 + lane * 4), (LAS unsigned*)(lds + STAGE_BYTES + (ui & 1) * 1024), 16, 0, 0);
        }
        if constexpr (RELAX) {
#define PG8_WAIT_RELAX asm volatile("s_waitcnt vmcnt(%0)" :: "n"(8 + Epi::kStores) : "memory")
            const char* a1 = cA + kstep; const char* a2 = cA + 2 * kstep; const char* b2 = cB + 2 * kstep; const char* a3 = a2 + kstep; const char* b3 = b2 + kstep;
            PG8_LDB(B0, 0, 0); PG8_LDB(B1, 0, 1); PG8_SCHED; PG8_LDA(At, 0, 0); PG8_STAGE(PG8_SA(1, 1), a1, vA[1]);
            PG8_WAIT_RELAX; PG8_WAIT_L(0); PG8_BAR; PG8_MMA(0, 0, At, B0); PG8_MMA(0, 1, At, B1); PG8_BAR; PG8_SCHED;
            PG8_LDA(At, 0, 1); PG8_STAGE(PG8_SB(0, 0), b2, voffB); PG8_STAGE(PG8_SB(0, 1), b2 + hstepB, voffB); PG8_STAGE(PG8_SA(0, 0), a2, vA[0]);
            PG8_WAIT_RELAX; PG8_WAIT_L(0); PG8_BAR; PG8_MMA(1, 0, At, B0); PG8_MMA(1, 1, At, B1); PG8_BAR; PG8_SCHED;
            PG8_LDB(B0, 1, 0); PG8_LDB(B1, 1, 1); PG8_SCHED; PG8_LDA(At, 1, 0); PG8_STAGE(PG8_SA(0, 1), a2, vA[1]);
            PG8_WAIT_V(8); PG8_WAIT_L(0); PG8_BAR; PG8_MMA(0, 0, At, B0); PG8_MMA(0, 1, At, B1); PG8_BAR; PG8_SCHED;
            PG8_LDA(At, 1, 1); PG8_STAGE(PG8_SB(1, 0), b3, voffB); PG8_STAGE(PG8_SB(1, 1), b3 + hstepB, voffB); PG8_STAGE(PG8_SA(1, 0), a3, vA[0]);
            PG8_WAIT_V(8); PG8_WAIT_L(0); PG8_BAR; PG8_MMA(1, 0, At, B0); PG8_MMA(1, 1, At, B1); PG8_BAR; PG8_SCHED;
#undef PG8_WAIT_RELAX
        }
        for (int t = RELAX ? 2 : 0; t < nt; t += 2) {
            const bool last = (t == nt - 2);
            if (GATHER) { if (t == 4 && has_next) {
                const LAS int* li = (const LAS int*)(lds + STAGE_BYTES + (ui & 1) * 1024);
#pragma unroll
                for (int h = 0; h < 2; ++h)
#pragma unroll
                    for (int i = 0; i < 2; ++i) vN[h][i] = (unsigned)(((nxt.pm >> 1) & 7) * SEQ + li[h * 128 + Rs[i]]) * (unsigned)(g.lda * 2) + (unsigned)(Cs[i] * 2);
            } }
            if constexpr (HOOK) { if (t == (nt >> 1)) E.mid(acc, cur, wr, wc, fr, fq); }
            const char* a1 = cA + (size_t)(t + 1) * kstep;
            const char* a2 = last ? nA : cA + (size_t)(t + 2) * kstep; const char* b2 = last ? nB : cB + (size_t)(t + 2) * kstep;
            const char* a3 = a2 + kstep; const char* b3 = b2 + kstep;
            unsigned v2[2][2];
#pragma unroll
            for (int h = 0; h < 2; ++h)
#pragma unroll
                for (int i = 0; i < 2; ++i) v2[h][i] = (GATHER && last) ? vN[h][i] : vA[h][i];
            unsigned vb2[2]; vb2[0] = last ? voffBn[0] : voffB[0]; vb2[1] = last ? voffBn[1] : voffB[1];
            PG8_LDB(B0, 0, 0); PG8_LDB(B1, 0, 1); PG8_SCHED; PG8_LDA(At, 0, 0); PG8_STAGE(PG8_SA(1, 1), a1, vA[1]);
            PG8_WAIT_V(8); PG8_WAIT_L(0); PG8_BAR; PG8_MMA(0, 0, At, B0); PG8_MMA(0, 1, At, B1); PG8_BAR; PG8_SCHED;
            PG8_LDA(At, 0, 1); PG8_STAGE(PG8_SB(0, 0), b2, vb2); PG8_STAGE(PG8_SB(0, 1), b2 + hstepB, vb2); PG8_STAGE(PG8_SA(0, 0), a2, v2[0]);
            PG8_WAIT_V(8); PG8_WAIT_L(0); PG8_BAR; PG8_MMA(1, 0, At, B0); PG8_MMA(1, 1, At, B1); PG8_BAR; PG8_SCHED;
            PG8_LDB(B0, 1, 0); PG8_LDB(B1, 1, 1); PG8_SCHED; PG8_LDA(At, 1, 0); PG8_STAGE(PG8_SA(0, 1), a2, v2[1]);
            PG8_WAIT_V(8); PG8_WAIT_L(0); PG8_BAR; PG8_MMA(0, 0, At, B0); PG8_MMA(0, 1, At, B1); PG8_BAR; PG8_SCHED;
            PG8_LDA(At, 1, 1); PG8_STAGE(PG8_SB(1, 0), b3, vb2); PG8_STAGE(PG8_SB(1, 1), b3 + hstepB, vb2); PG8_STAGE(PG8_SA(1, 0), a3, v2[0]);
            PG8_WAIT_V(8); PG8_WAIT_L(0); PG8_BAR; PG8_MMA(1, 0, At, B0); PG8_MMA(1, 1, At, B1); PG8_BAR; PG8_SCHED;
        }
        if (wr == 0) PG8_BAR;
        E(acc, cur, wr, wc, fr, fq);
        if (!has_next) break;
#pragma unroll
        for (int a = 0; a < 2; ++a)
#pragma unroll
            for (int b = 0; b < 2; ++b)
#pragma unroll
                for (int m = 0; m < 4; ++m)
#pragma unroll
                    for (int n = 0; n < 2; ++n) acc[a][b][m][n] = (f32x4){0.f, 0.f, 0.f, 0.f};
        cur = nxt; cA = nA; cB = nB; ++ui; voffB[0] = voffBn[0]; voffB[1] = voffBn[1];
        if (GATHER) {
#pragma unroll
            for (int h = 0; h < 2; ++h)
#pragma unroll
                for (int i = 0; i < 2; ++i) vA[h][i] = vN[h][i];
        }
        if (wr == 1) PG8_BAR;
    }
    PG8_WAIT_V(0);
    PG8_BAR;
#undef PG8_SA
#undef PG8_SB
#undef PG8_STAGE
#undef PG8_LDA
#undef PG8_LDB
#undef PG8_MMA
#undef PG8_WAIT_V
#undef PG8_WAIT_L
#undef PG8_BAR
#undef PG8_SCHED
#undef PG8_AVOFF
#undef PG8_ABASE
#undef PG8_BBASE
}
}

#define GEMM_PHASE pg8::gemm_phase

struct EpiIn {
    bf16_t *Y, *VA, *KB, *VB, *G; const float* bgate; const f32x2* rope; f32x2* STATS;
    static constexpr int kStores = 16;
    __device__ __forceinline__ bool perm(const Unit& u) const { return u.pn < 8 || u.pn > 12; }
    template <int KIND> __device__ __forceinline__ void run(const Acc& acc, const Unit& u, int wr, int wc, int fr, int fq) const {
        const int pn = u.pn;
#pragma unroll
        for (int ai = 0; ai < 2; ++ai)
#pragma unroll
            for (int m = 0; m < 4; ++m) {
                const int row = u.pm * 256 + ai * 128 + wr * 64 + m * 16 + fr;
                float ssum = 0.f, ssq = 0.f;
#pragma unroll
                for (int bj = 0; bj < 2; ++bj) {
                    f32x4 v0 = acc[ai][bj][m][0], v1 = acc[ai][bj][m][1];
                    if constexpr (KIND == 0 || KIND == 1) {
                        const int c8 = bj * 128 + wc * 32 + 8 * fq;
                        v0 = gelu4_(v0); v1 = gelu4_(v1);
                        if constexpr (KIND == 0) st8bf(Y + (size_t)row * 2048 + pn * 256 + c8, v0, v1);
                        else {
                            st8bf(VA + (size_t)row * 1024 + (pn - 4) * 256 + c8, v0, v1);
                            ssum += ((v0.x + v0.y) + (v0.z + v0.w)) + ((v1.x + v1.y) + (v1.z + v1.w));
                            ssq += ((v0.x * v0.x + v0.y * v0.y) + (v0.z * v0.z + v0.w * v0.w)) + ((v1.x * v1.x + v1.y * v1.y) + (v1.z * v1.z + v1.w * v1.w));
                        }
                    } else if constexpr (KIND == 2) {
                        const int cl = bj * 128 + wc * 32 + 4 * fq;
                        f32x4 o0 = v0, o1 = v1;
                        if (row < NTOK) {
                            const int t = row & (SEQ - 1), pos = (wc & 1) ? (t & 63) : (t >> 6);
                            const f32x2* rp = rope + pos * 16 + 4 * fq;
#pragma unroll
                            for (int j = 0; j < 4; ++j) { const f32x2 cs = rp[j]; o0[j] = v0[j] * cs.x - v1[j] * cs.y; o1[j] = v0[j] * cs.y + v1[j] * cs.x; }
                        }
                        if (pn < 12) { bf16_t* p = Y + (size_t)row * 2048 + 1024 + (pn - 8) * 256 + cl; st4bf(p, o0 * C2); st4bf(p + 16, o1 * C2); }
                        else { bf16_t* p = KB + (size_t)row * 256 + cl; st4bf(p, o0); st4bf(p + 16, o1); }
                    } else if constexpr (KIND == 3) {
                        st8bf(VB + (size_t)row * 256 + bj * 128 + wc * 32 + 8 * fq, v0, v1);
                    } else {
                        if (bj == 0) {
                            const int ch = (pn - 14) * 128 + wc * 32 + 8 * fq;
                            const f32x4 a0 = sigm4_(v0 + *(const f32x4*)(bgate + ch)), a1 = sigm4_(v1 + *(const f32x4*)(bgate + ch + 4));
                            const f32x4 g0 = sigm4_(acc[ai][1][m][0] + *(const f32x4*)(bgate + 1024 + ch)), g1 = sigm4_(acc[ai][1][m][1] + *(const f32x4*)(bgate + 1024 + ch + 4));
                            f32x4 r0, r1;
#pragma unroll
                            for (int j = 0; j < 4; ++j) { r0[j] = a0[j] * __builtin_amdgcn_rcpf(g0[j]); r1[j] = a1[j] * __builtin_amdgcn_rcpf(g1[j]); }
                            st8bf(G + (size_t)row * 2048 + ch, r0, r1); st8bf(G + (size_t)row * 2048 + 1024 + ch, g0, g1);
                        }
                    }
                }
                if constexpr (KIND == 1) {
                    ssum += xchg16(ssum); ssum += xchg32(ssum); ssq += xchg16(ssq); ssq += xchg32(ssq);
                    if (fq == 0) STATS[(size_t)row * 16 + (pn - 4) * 4 + wc] = (f32x2){ssum, ssq};
                }
            }
    }
    __device__ __forceinline__ void operator()(const Acc& acc, const Unit& u, int wr, int wc, int fr, int fq) const {
        const int pn = u.pn;
        if (pn < 4) run<0>(acc, u, wr, wc, fr, fq);
        else if (pn < 8) run<1>(acc, u, wr, wc, fr, fq);
        else if (pn < 13) run<2>(acc, u, wr, wc, fr, fq);
        else if (pn == 13) run<3>(acc, u, wr, wc, fr, fq);
        else run<4>(acc, u, wr, wc, fr, fq);
    }
};
struct EpiAB {
    bf16_t* MERGED; const bf16_t* G;
    static constexpr int kStores = 16;
    __device__ __forceinline__ bool perm(const Unit&) const { return true; }
    __device__ __forceinline__ void mid(Acc& acc, const Unit& u, int wr, int wc, int fr, int fq) const {
        int zero; asm volatile("v_mov_b32 %0, 0" : "=v"(zero));
        const bf16_t* gp = G + (size_t)(u.pm * 256 + wr * 64 + fr + zero) * 2048 + u.pn * 256 + wc * 32 + 8 * fq;
#pragma unroll
        for (int ai = 0; ai < 2; ++ai)
#pragma unroll
            for (int m = 0; m < 4; ++m) {
#pragma unroll
                for (int bj = 0; bj < 2; ++bj) {
                    const bf16_t* q = gp + (size_t)(ai * 128 + m * 16) * 2048 + bj * 128;
                    f32x4 r0, r1; ld8bf(q, r0, r1);
                    acc[ai][bj][m][0] *= r0; acc[ai][bj][m][1] *= r1;
                    asm volatile("" ::: "memory");
                }
            }
    }
    __device__ __forceinline__ void operator()(const Acc& acc, const Unit& u, int wr, int wc, int fr, int fq) const {
#pragma unroll
        for (int ai = 0; ai < 2; ++ai)
#pragma unroll
            for (int m = 0; m < 4; ++m) {
                const int row = u.pm * 256 + ai * 128 + wr * 64 + m * 16 + fr;
#pragma unroll
                for (int bj = 0; bj < 2; ++bj) {
                    const int c8 = u.pn * 256 + bj * 128 + wc * 32 + 8 * fq;
                    f32x4 gb0, gb1; ld8bf(G + (size_t)row * 2048 + 1024 + c8, gb0, gb1);
                    st8bf(MERGED + (size_t)row * 1024 + c8, gb0 * acc[ai][bj][m][0], gb1 * acc[ai][bj][m][1]);
                }
            }
    }
};
struct EpiO {
    bf16_t* D16; const float* mod;
    static constexpr int kStores = 16;
    __device__ __forceinline__ bool perm(const Unit&) const { return true; }
    __device__ __forceinline__ void operator()(const Acc& acc, const Unit& u, int wr, int wc, int fr, int fq) const {
        const float* g1 = mod + (size_t)((u.pm * 256) >> 12) * 6144 + 2048;
#pragma unroll
        for (int bj = 0; bj < 2; ++bj) {
            const int c8 = u.pn * 256 + bj * 128 + wc * 32 + 8 * fq;
            const f32x4 ga = *(const f32x4*)(g1 + c8), gb = *(const f32x4*)(g1 + c8 + 4);
#pragma unroll
            for (int ai = 0; ai < 2; ++ai)
#pragma unroll
                for (int m = 0; m < 4; ++m) {
                    const int row = u.pm * 256 + ai * 128 + wr * 64 + m * 16 + fr;
                    st8bf(D16 + (size_t)row * 2048 + 1024 + c8, ga * acc[ai][bj][m][0], gb * acc[ai][bj][m][1]);
                }
        }
    }
};
struct EpiGU {
    bf16_t* ACT;
    static constexpr int kStores = 8;
    __device__ __forceinline__ bool perm(const Unit&) const { return true; }
    __device__ __forceinline__ void operator()(const Acc& acc, const Unit& u, int wr, int wc, int fr, int fq) const {
#pragma unroll
        for (int ai = 0; ai < 2; ++ai)
#pragma unroll
            for (int m = 0; m < 4; ++m) {
                const int prow = u.pm * 256 + ai * 128 + wr * 64 + m * 16 + fr;
                f32x4 a[2];
#pragma unroll
                for (int n = 0; n < 2; ++n) {
                    const f32x4 gt = acc[ai][0][m][n], up = acc[ai][1][m][n];
                    a[n] = gt * sigm4_(gt) * up;
                }
                st8bf(ACT + (size_t)prow * 2048 + u.pn * 128 + wc * 32 + 8 * fq, a[0], a[1]);
            }
    }
};
struct EpiD {
    bf16_t* YB; const float* TOPW;
    static constexpr int kStores = 16;
    __device__ __forceinline__ bool perm(const Unit&) const { return true; }
    __device__ __forceinline__ void operator()(const Acc& acc, const Unit& u, int wr, int wc, int fr, int fq) const {
#pragma unroll
        for (int ai = 0; ai < 2; ++ai)
#pragma unroll
            for (int m = 0; m < 4; ++m) {
                const int prow = u.pm * 256 + ai * 128 + wr * 64 + m * 16 + fr; const float w = TOPW[prow];
#pragma unroll
                for (int bj = 0; bj < 2; ++bj)
                    st8bf(YB + (size_t)prow * 1024 + u.pn * 256 + bj * 128 + wc * 32 + 8 * fq, acc[ai][bj][m][0] * w, acc[ai][bj][m][1] * w);
            }
    }
};

__device__ __forceinline__ void transpose_item(const float* W, int N, int k0, int n0, bf16_t* dst, int ldt, LAS float* scr, int lane) {
    const int kk = lane >> 3, nq = (lane & 7) * 4;
    f32x4 v[8];
#pragma unroll
    for (int i = 0; i < 8; ++i) v[i] = *(const f32x4*)(W + (size_t)(k0 + 8 * i + kk) * N + n0 + nq);
#pragma unroll
    for (int i = 0; i < 8; ++i) { LAS float* s = scr + (8 * i + kk) * 33 + nq; s[0] = v[i].x; s[1] = v[i].y; s[2] = v[i].z; s[3] = v[i].w; }
    LDS_WAIT();
    const int c = lane & 7;
#pragma unroll
    for (int j = 0; j < 4; ++j) {
        const int n = (lane >> 3) + 8 * j; const LAS float* s = scr + (8 * c) * 33 + n;
        u32x4 o; o.x = pk2(s[0 * 33], s[1 * 33]); o.y = pk2(s[2 * 33], s[3 * 33]); o.z = pk2(s[4 * 33], s[5 * 33]); o.w = pk2(s[6 * 33], s[7 * 33]);
        *(u32x4*)(dst + (size_t)n * ldt + 8 * c) = o;
    }
    LDS_WAIT();
}

struct TrItem { const float* src; bf16_t* dst; int N, ldt; };
__device__ __forceinline__ void tr_load(const TrItem& it, f32x4 (&v)[8], int lane) {
    const int kk = lane >> 3, nq = (lane & 7) * 4;
#pragma unroll
    for (int i = 0; i < 8; ++i) v[i] = *(const f32x4*)(it.src + (size_t)(8 * i + kk) * it.N + nq);
}
__device__ __forceinline__ void tr_store(const TrItem& it, const f32x4 (&v)[8], LAS float* scr, int lane) {
    const int kk = lane >> 3, nq = (lane & 7) * 4;
#pragma unroll
    for (int i = 0; i < 8; ++i) { LAS float* s = scr + (8 * i + kk) * 33 + nq; s[0] = v[i].x; s[1] = v[i].y; s[2] = v[i].z; s[3] = v[i].w; }
    LDS_WAIT();
    const int c = lane & 7;
#pragma unroll
    for (int j = 0; j < 4; ++j) {
        const int n = (lane >> 3) + 8 * j; const LAS float* s = scr + (8 * c) * 33 + n;
        u32x4 o; o.x = pk2(s[0 * 33], s[1 * 33]); o.y = pk2(s[2 * 33], s[3 * 33]); o.z = pk2(s[4 * 33], s[5 * 33]); o.w = pk2(s[6 * 33], s[7 * 33]);
        *(u32x4*)(it.dst + (size_t)n * it.ldt + 8 * c) = o;
    }
    LDS_WAIT();
}

__device__ __forceinline__ void adaln_task(int task, const float* c, const float* cctx, const float* w_ada, const float* b_ada, float* mod, LAS float* lds, int tid) {
    LAS float* s = lds; LAS float* red = lds + 9 * 1024;
    { float cv[18];
#pragma unroll
      for (int q = 0; q < 18; ++q) { const int i = tid + NTHREADS * q, r = i >> 10, k = i & 1023; cv[q] = r < 8 ? c[r * 1024 + k] : cctx[k]; }
#pragma unroll
      for (int q = 0; q < 18; ++q) s[tid + NTHREADS * q] = cv[q] * __builtin_amdgcn_rcpf(1.f + __expf(-cv[q])); }
    __syncthreads();
    const int ch = tid & 7, kr = tid >> 3;
    f32x4 acc[9];
#pragma unroll
    for (int r = 0; r < 9; ++r) acc[r] = (f32x4){0.f, 0.f, 0.f, 0.f};
    const float* wp = w_ada + (size_t)kr * 6144 + task * 32 + ch * 4;
    for (int it = 0; it < 16; ++it) {
        const f32x4 w = *(const f32x4*)(wp + (size_t)it * 64 * 6144); const int k = kr + it * 64;
#pragma unroll
        for (int r = 0; r < 9; ++r) acc[r] += s[r * 1024 + k] * w;
    }
#pragma unroll
    for (int r = 0; r < 9; ++r) *(LAS f32x4*)(red + (kr * 9 + r) * 32 + ch * 4) = acc[r];
    __syncthreads();
    if (tid < 288) { const int r = tid >> 5, col = tid & 31; float sum = 0.f; for (int q = 0; q < 64; ++q) sum += red[(q * 9 + r) * 32 + col]; mod[r * 6144 + task * 32 + col] = sum + b_ada[task * 32 + col]; }
    __syncthreads();
}

__device__ __forceinline__ void rope_table(f32x2* tab, int tid) {
    for (int idx = tid; idx < 1024; idx += NTHREADS) {
        const int pos = idx >> 4, i = idx & 15;
        double f = 1.0;
        for (int q = 0; q < i; ++q) f *= 0.56234132519034908;
        const float ang = (float)pos * (float)f;
        const double a = (double)ang, k = __builtin_rint(a * 0.15915494309189535), r = a - k * 6.283185307179586476925, r2 = r * r;
        double sn = r, ts = r, cs = 1.0, tc = 1.0;
        for (int n = 1; n <= 14; ++n) {
            tc *= -r2 / (double)((2 * n - 1) * (2 * n)); cs += tc;
            ts *= -r2 / (double)((2 * n) * (2 * n + 1)); sn += ts;
        }
        tab[idx] = (f32x2){(float)cs, (float)sn};
    }
}

__device__ __forceinline__ unsigned char* lds_raw_ptr(LAS unsigned char* p) { return (unsigned char*)p; }
namespace mix {
typedef short bf16x8 __attribute__((ext_vector_type(8)));
typedef short s16x4 __attribute__((ext_vector_type(4)));
typedef float f32x16 __attribute__((ext_vector_type(16)));
typedef __attribute__((address_space(3))) const char* lds_cptr;
__device__ __forceinline__ int crow(int r, int hi) { return (r & 3) + 8 * (r >> 2) + 4 * hi; }
__device__ __forceinline__ unsigned cvtpk(float lo, float hi) { typedef float f2 __attribute__((ext_vector_type(2))); typedef __bf16 b2 __attribute__((ext_vector_type(2))); f2 v = {lo, hi}; b2 b = __builtin_convertvector(v, b2); return __builtin_bit_cast(unsigned, b); }
__device__ __forceinline__ s16x4 vtr(lds_cptr p) { return __builtin_bit_cast(s16x4, __builtin_amdgcn_ds_read_tr16_b64_v4i16((__attribute__((address_space(3))) s16x4*)p)); }
__device__ __forceinline__ bf16x8 pk8(s16x4 lo, s16x4 hi) { return (bf16x8){lo[0], lo[1], lo[2], lo[3], hi[0], hi[1], hi[2], hi[3]}; }
__device__ __forceinline__ float max3f(float a, float b, float c) { float r; asm("v_max3_f32 %0, %1, %2, %3" : "=v"(r) : "v"(a), "v"(b), "v"(c)); return r; }
__device__ __forceinline__ float max2f(float a, float b) { float r; asm("v_max_f32_e32 %0, %1, %2" : "=v"(r) : "v"(a), "v"(b)); return r; }
__device__ __forceinline__ float swap_half(float v) { auto rr = __builtin_amdgcn_permlane32_swap(__float_as_uint(v), __float_as_uint(v), false, false); return __uint_as_float((threadIdx.x & 32) ? rr[0] : rr[1]); }

constexpr int A_K = 0, A_V = 24576, A_WS = 49152, A_QST = 53248, A_OST = A_QST, A_OSTW = 8192, A_END = A_QST + 8 * 8192;

__device__ __forceinline__ void attn_unit(int b, int n, int kvh, bf16_t* Y, bf16_t* O, int ldo, const bf16_t* KB, const bf16_t* VB, const float* sink, LAS unsigned char* lds) {
    const int tid = threadIdx.x, lane = tid & 63, r32 = lane & 31, hi = lane >> 5, wid = __builtin_amdgcn_readfirstlane(tid >> 6);
    const int head = kvh * 4 + (wid >> 1);
    const int qrow0 = b * SEQ + n * 128 + (wid & 1) * 64;
    bf16_t* Qw = Y + (size_t)qrow0 * 2048 + 1024 + head * 64;
    LAS bf16x8* qst = (LAS bf16x8*)(lds + A_QST + wid * 8192) + lane;
#pragma unroll
    for (int sb = 0; sb < 2; ++sb)
#pragma unroll
        for (int d0 = 0; d0 < 4; ++d0) qst[(sb * 4 + d0) * 64] = *(const bf16x8*)(Qw + (size_t)(32 * sb + r32) * 2048 + d0 * 16 + hi * 8);
    f32x16 o[2][2];
#pragma unroll
    for (int sb = 0; sb < 2; ++sb)
#pragma unroll
        for (int d0 = 0; d0 < 2; ++d0)
#pragma unroll
            for (int r = 0; r < 16; ++r) o[sb][d0][r] = 0.f;
    float m[2] = {-1e30f, -1e30f}, l[2] = {0.f, 0.f};
    LAS float* wsf = (LAS float*)(lds + A_WS) + wid * 128;
    const int jlo = (n == 0) ? 2 : 0, jhi = (n == 31) ? 3 : 5, T = 4 + (jhi - jlo + 1);
    const size_t koff = (size_t)lane * 256 + wid * 8 + kvh * 64;
    const size_t voff = (size_t)(16 * (wid & 3) + (lane >> 2)) * 256 + (wid >> 2) * 32 + (lane & 3) * 8 + kvh * 64;
    auto tile_row = [&](int t) -> long { return t < 4 ? (long)(NTOK + b * CTXL + 64 * t) : (long)(b * SEQ + (n - 1) * 128 + 64 * (jlo + t - 4)); };
    auto issue = [&](int t) {
        const long row = tile_row(t); const int buf = t % 3;
        __builtin_amdgcn_global_load_lds((const unsigned*)(KB + row * 256 + koff), (LAS unsigned*)(lds + A_K + buf * 8192 + wid * 1024), 16, 0, 0);
        __builtin_amdgcn_global_load_lds((const unsigned*)(VB + row * 256 + voff), (LAS unsigned*)(lds + A_V + buf * 8192 + wid * 1024), 16, 0, 0);
    };
    issue(0); issue(1);
    int slot = 0;
    for (int t = 0; t < T; ++t) {
        if (t + 1 < T) asm volatile("s_waitcnt vmcnt(2) lgkmcnt(0)" ::: "memory"); else asm volatile("s_waitcnt vmcnt(0) lgkmcnt(0)" ::: "memory");
        __builtin_amdgcn_s_barrier();
        if (t + 2 < T) issue(t + 2);
        const lds_cptr Kt = (lds_cptr)(lds + A_K + slot * 8192) + hi * 1024 + r32 * 16;
        const lds_cptr Vt = (lds_cptr)(lds + A_V + slot * 8192) + ((lane >> 4) & 1) * 32 + (lane & 3) * 8 + (4 * hi + ((lane & 15) >> 2)) * 64;
        slot = (slot == 2) ? 0 : slot + 1;
        const bool local = t >= 4;
        const int dl = 64 * (jlo + t - 4) - 128 - 64 * (wid & 1);
        if (local && (dl > 160 || dl < -191)) continue;
        f32x16 p0[2], p1[2];
#pragma unroll
        for (int sb = 0; sb < 2; ++sb)
#pragma unroll
            for (int r = 0; r < 16; ++r) { p0[sb][r] = 0.f; p1[sb][r] = 0.f; }
#pragma unroll
        for (int d0 = 0; d0 < 4; ++d0) {
            const bf16x8 k0 = *(const __attribute__((address_space(3))) bf16x8*)(Kt + d0 * 2048), k1 = *(const __attribute__((address_space(3))) bf16x8*)(Kt + d0 * 2048 + 512);
#pragma unroll
            for (int sb = 0; sb < 2; ++sb) {
                const bf16x8 qf = qst[(sb * 4 + d0) * 64];
                p0[sb] = __builtin_amdgcn_mfma_f32_32x32x16_bf16(k0, qf, p0[sb], 0, 0, 0);
                p1[sb] = __builtin_amdgcn_mfma_f32_32x32x16_bf16(k1, qf, p1[sb], 0, 0, 0);
            }
        }
        if (local && (dl < -97 || dl > 65 || dl - 32 < -97)) {
#pragma unroll
            for (int sb = 0; sb < 2; ++sb)
#pragma unroll
                for (int r = 0; r < 16; ++r) { const int rel = dl - 32 * sb + crow(r, hi) - r32; if (rel < -128 || rel > 128) p0[sb][r] = -1e30f; if (rel + 32 < -128 || rel + 32 > 128) p1[sb][r] = -1e30f; }
        }
        float mn[2];
        asm volatile("s_nop 15\n\ts_nop 7" : "+v"(p0[0]), "+v"(p1[0]), "+v"(p0[1]), "+v"(p1[1]));
#pragma unroll
        for (int sb = 0; sb < 2; ++sb) {
            float a = max3f(p0[sb][0], p0[sb][1], p1[sb][0]), b2 = max3f(p0[sb][2], p0[sb][3], p1[sb][1]); a = max3f(a, p1[sb][2], p1[sb][3]);
#pragma unroll
            for (int r = 4; r < 16; r += 4) { a = max3f(a, p0[sb][r], p0[sb][r + 1]); b2 = max3f(b2, p0[sb][r + 2], p0[sb][r + 3]); a = max3f(a, p1[sb][r], p1[sb][r + 1]); b2 = max3f(b2, p1[sb][r + 2], p1[sb][r + 3]); }
            float rm = max2f(a, b2);
            rm = max2f(rm, swap_half(rm));
            mn[sb] = max2f(m[sb], rm);
        }
        if (__any((mn[0] > m[0]) || (mn[1] > m[1]))) {
            const float f0 = __builtin_amdgcn_exp2f(m[0] - mn[0]), f1 = __builtin_amdgcn_exp2f(m[1] - mn[1]);
            l[0] *= f0; l[1] *= f1;
            if (hi == 0) { wsf[r32] = f0; wsf[64 + r32] = f1; }
            asm volatile("s_waitcnt lgkmcnt(0)" ::: "memory");
#pragma unroll
            for (int r = 0; r < 16; ++r) { const float a = wsf[crow(r, hi)], b2 = wsf[64 + crow(r, hi)]; o[0][0][r] *= a; o[0][1][r] *= a; o[1][0][r] *= b2; o[1][1][r] *= b2; }
            m[0] = mn[0]; m[1] = mn[1];
        }
        u32x4 pw[2][4];
#pragma unroll
        for (int sb = 0; sb < 2; ++sb) {
            float sacc = 0.f;
#pragma unroll
            for (int r = 0; r < 16; ++r) { p0[sb][r] = __builtin_amdgcn_exp2f(p0[sb][r] - m[sb]); p1[sb][r] = __builtin_amdgcn_exp2f(p1[sb][r] - m[sb]); sacc += p0[sb][r] + p1[sb][r]; }
            l[sb] += sacc;
#pragma unroll
            for (int q = 0; q < 4; ++q) { pw[sb][0][q] = cvtpk(p0[sb][2 * q], p0[sb][2 * q + 1]); pw[sb][1][q] = cvtpk(p0[sb][8 + 2 * q], p0[sb][9 + 2 * q]); pw[sb][2][q] = cvtpk(p1[sb][2 * q], p1[sb][2 * q + 1]); pw[sb][3][q] = cvtpk(p1[sb][8 + 2 * q], p1[sb][9 + 2 * q]); }
        }
#pragma unroll
        for (int d0 = 0; d0 < 2; ++d0)
#pragma unroll
            for (int ks = 0; ks < 4; ++ks) {
                const s16x4 vlo = vtr(Vt + d0 * 4096 + ks * 1024), vhi = vtr(Vt + d0 * 4096 + ks * 1024 + 512);
                const bf16x8 vf = pk8(vlo, vhi);
#pragma unroll
                for (int sb = 0; sb < 2; ++sb) o[sb][d0] = __builtin_amdgcn_mfma_f32_32x32x16_bf16(__builtin_bit_cast(bf16x8, pw[sb][ks]), vf, o[sb][d0], 0, 0, 0);
            }
    }
    const float s2 = sink[head] * LOG2E;
    LAS bf16_t* stg = (LAS bf16_t*)(lds + A_OST + wid * A_OSTW);
#pragma unroll
    for (int sb = 0; sb < 2; ++sb) {
        const float lt = l[sb] + swap_half(l[sb]);
        const float mf = fmaxf(m[sb], s2), f = __builtin_amdgcn_exp2f(m[sb] - mf), den = lt * f + __builtin_amdgcn_exp2f(s2 - mf);
        asm volatile("s_waitcnt lgkmcnt(0)" ::: "memory");
        if (hi == 0) wsf[sb * 64 + r32] = f / den;
        asm volatile("s_waitcnt lgkmcnt(0)" ::: "memory");
#pragma unroll
        for (int r = 0; r < 16; ++r) { const float sc = wsf[sb * 64 + crow(r, hi)]; const int orow = crow(r, hi);
            stg[orow * 64 + r32] = (bf16_t)f2bf(o[sb][0][r] * sc); stg[orow * 64 + 32 + r32] = (bf16_t)f2bf(o[sb][1][r] * sc); }
        asm volatile("s_waitcnt lgkmcnt(0)" ::: "memory");
#pragma unroll
        for (int i = 0; i < 4; ++i) { const int row = i * 8 + (lane >> 3), ch = lane & 7; const u32x4 v = *(const LAS u32x4*)(stg + row * 64 + ch * 8); *(u32x4*)(O + (size_t)(qrow0 + 32 * sb + row) * ldo + head * 64 + ch * 8) = v; }
        asm volatile("s_waitcnt lgkmcnt(0)" ::: "memory");
    }
    __syncthreads();
}

constexpr int G_V = 0, G_ST = 65536, G_STW = 8704, G_MU = G_ST + 8 * G_STW;
__device__ __forceinline__ void gmlp_unit(int task, bf16_t* Y, bf16_t* YO, int ldo, const bf16_t* VA, const bf16_t* WSP, const f32x2* STATS, const float* ln_g, const float* ln_b, const float* b_sp, LAS unsigned char* lds) {
    const int tid = threadIdx.x, lane = tid & 63, r32 = lane & 31, hi = lane >> 5, wid = __builtin_amdgcn_readfirstlane(tid >> 6);
    const int r0 = task * 128;
    LAS float* mu = (LAS float*)(lds + G_MU); LAS float* rs = mu + 128;
    if (tid < 128) {
        const f32x4* sp = (const f32x4*)(STATS + (size_t)(r0 + tid) * 16); float s = 0.f, ss = 0.f;
#pragma unroll
        for (int i = 0; i < 8; ++i) { const f32x4 v = sp[i]; s += v.x + v.z; ss += v.y + v.w; }
        const float mean = s * (1.f / 1024.f), var = fmaxf(ss * (1.f / 1024.f) - mean * mean, 0.f);
        mu[tid] = mean; rs[tid] = 1.0f / sqrtf(var + EPS);
    }
    u32x4 raw[4];
#pragma unroll
    for (int i = 0; i < 4; ++i) { const int idx = tid + NTHREADS * i, q = idx >> 4, c8 = idx & 15; raw[i] = *(const u32x4*)(VA + (size_t)(r0 + q) * 1024 + c8 * 8); }
    __syncthreads();
    const int pb = wid >> 1, dh = wid & 1;
    LAS float* st = (LAS float*)(lds + G_ST + wid * G_STW);
    for (int g8 = 0; g8 < 8; ++g8) {
        LAS unsigned char* vb = lds + G_V + (g8 & 1) * 32768;
#pragma unroll
        for (int i = 0; i < 4; ++i) {
            const int idx = tid + NTHREADS * i, q = idx >> 4, c8 = idx & 15, d = c8 * 8;
            const f32x4 g0 = *(const f32x4*)(ln_g + g8 * 128 + d), g1 = *(const f32x4*)(ln_g + g8 * 128 + d + 4), b0 = *(const f32x4*)(ln_b + g8 * 128 + d), b1 = *(const f32x4*)(ln_b + g8 * 128 + d + 4);
            const float mq = mu[q], rq = rs[q]; const u32x4 rw = raw[i];
            float v[8] = {bf2f(rw.x & 0xffffu), bf2f(rw.x >> 16), bf2f(rw.y & 0xffffu), bf2f(rw.y >> 16), bf2f(rw.z & 0xffffu), bf2f(rw.z >> 16), bf2f(rw.w & 0xffffu), bf2f(rw.w >> 16)};
#pragma unroll
            for (int e = 0; e < 4; ++e) { v[e] = (v[e] - mq) * rq * g0[e] + b0[e]; v[4 + e] = (v[4 + e] - mq) * rq * g1[e] + b1[e]; }
            u32x4 w; w.x = pk2(v[0], v[1]); w.y = pk2(v[2], v[3]); w.z = pk2(v[4], v[5]); w.w = pk2(v[6], v[7]);
            *(LAS u32x4*)(vb + ((d >> 5) * 8 + (q >> 4)) * 1024 + (q & 15) * 64 + (d & 31) * 2) = w;
        }
        if (g8 + 1 < 8) {
#pragma unroll
            for (int i = 0; i < 4; ++i) { const int idx = tid + NTHREADS * i, q = idx >> 4, c8 = idx & 15; raw[i] = *(const u32x4*)(VA + (size_t)(r0 + q) * 1024 + (g8 + 1) * 128 + c8 * 8); }
        }
        u32x4 ur[4]; bf16x8 af[8];
        const size_t ybase = (size_t)(r0 + 32 * pb + (lane >> 3)) * 2048 + g8 * 128 + 64 * dh + (lane & 7) * 8;
#pragma unroll
        for (int i = 0; i < 4; ++i) ur[i] = *(const u32x4*)(Y + ybase + (size_t)(8 * i) * 2048);
        const bf16_t* wrow = WSP + (size_t)g8 * 16384 + (size_t)(32 * pb + r32) * 128 + 8 * hi;
#pragma unroll
        for (int ks = 0; ks < 8; ++ks) af[ks] = *(const bf16x8*)(wrow + 16 * ks);
        __syncthreads();
        const lds_cptr Vb = (lds_cptr)vb + ((lane >> 4) & 1) * 32 + (lane & 3) * 8 + (8 * hi + ((lane & 15) >> 2)) * 64;
        f32x16 acc[2];
#pragma unroll
        for (int t2 = 0; t2 < 2; ++t2)
#pragma unroll
            for (int r = 0; r < 16; ++r) acc[t2][r] = 0.f;
#pragma unroll
        for (int ks = 0; ks < 8; ++ks) {
#pragma unroll
            for (int t2 = 0; t2 < 2; ++t2) {
                const int db = 2 * dh + t2;
                const s16x4 vlo = vtr(Vb + (db * 8 + ks) * 1024), vhi = vtr(Vb + (db * 8 + ks) * 1024 + 256);
                acc[t2] = __builtin_amdgcn_mfma_f32_32x32x16_bf16(af[ks], pk8(vlo, vhi), acc[t2], 0, 0, 0);
            }
        }
#pragma unroll
        for (int t2 = 0; t2 < 2; ++t2)
#pragma unroll
            for (int r = 0; r < 16; ++r) st[crow(r, hi) * 68 + 32 * t2 + r32] = acc[t2][r];
        asm volatile("s_waitcnt lgkmcnt(0)" ::: "memory");
#pragma unroll
        for (int i = 0; i < 4; ++i) {
            const int prow = 8 * i + (lane >> 3), ch = lane & 7;
            const f32x4 m0 = *(const LAS f32x4*)(st + prow * 68 + ch * 8), m1 = *(const LAS f32x4*)(st + prow * 68 + ch * 8 + 4);
            const float bs = b_sp[g8 * 128 + 32 * pb + prow]; const u32x4 uw = ur[i];
            u32x4 o;
            o.x = pk2(bf2f(uw.x & 0xffffu) * (m0.x + bs), bf2f(uw.x >> 16) * (m0.y + bs)); o.y = pk2(bf2f(uw.y & 0xffffu) * (m0.z + bs), bf2f(uw.y >> 16) * (m0.w + bs));
            o.z = pk2(bf2f(uw.z & 0xffffu) * (m1.x + bs), bf2f(uw.z >> 16) * (m1.y + bs)); o.w = pk2(bf2f(uw.w & 0xffffu) * (m1.z + bs), bf2f(uw.w >> 16) * (m1.w + bs));
            *(u32x4*)(YO + (size_t)(r0 + 32 * pb + prow) * ldo + g8 * 128 + 64 * dh + ch * 8) = o;
        }
        asm volatile("s_waitcnt lgkmcnt(0)" ::: "memory");
    }
    __syncthreads();
}
}

namespace att2 {
typedef short bf16x8 __attribute__((ext_vector_type(8)));
typedef short s16x4 __attribute__((ext_vector_type(4)));
typedef float f32x16 __attribute__((ext_vector_type(16)));
typedef __attribute__((address_space(3))) const char* lds_cptr;
typedef short v4i16_t __attribute__((ext_vector_type(4)));
__device__ __forceinline__ int crow(int r, int hi) { return (r & 3) + 8 * (r >> 2) + 4 * hi; }
#define SBAR() __builtin_amdgcn_sched_barrier(0)
constexpr int NSLOT = 3, SLOTB = 8192;
constexpr int LDS_K = 0, LDS_V = NSLOT * SLOTB, LDS_WS = 2 * NSLOT * SLOTB, LDS_OST = LDS_WS + 8 * 64 * 4, LDS_BYTES = LDS_OST + 8 * 4096;
__device__ __forceinline__ void glds16(const void* gsrc, unsigned lds_dst) { unsigned keep;
    asm volatile("s_mov_b32 %0, m0\n\ts_mov_b32 m0, %2\n\ts_nop 0\n\tglobal_load_lds_dwordx4 %1, off\n\ts_mov_b32 m0, %0" : "=&s"(keep) : "v"(gsrc), "s"(lds_dst) : "memory"); }
__device__ __forceinline__ float max3f(float a, float b, float c) { float r; asm("v_max3_f32 %0, %1, %2, %3" : "=v"(r) : "v"(a), "v"(b), "v"(c)); return r; }
__device__ __forceinline__ float max2f(float a, float b) { float r; asm("v_max_f32_e32 %0, %1, %2" : "=v"(r) : "v"(a), "v"(b)); return r; }
__device__ __forceinline__ float fadd_s(float a, float b) { float r; asm("v_add_f32_e32 %0, %1, %2" : "=v"(r) : "v"(a), "v"(b)); return r; }
__device__ __forceinline__ float fsub_s(float a, float b) { float r; asm("v_sub_f32_e32 %0, %1, %2" : "=v"(r) : "v"(a), "v"(b)); return r; }
typedef float f32x2_t __attribute__((ext_vector_type(2))); typedef __bf16 bf16x2_t __attribute__((ext_vector_type(2)));
__device__ __forceinline__ unsigned cvtpk_s(float lo, float hi) { f32x2_t v = {lo, hi}; bf16x2_t b = __builtin_convertvector(v, bf16x2_t); return __builtin_bit_cast(unsigned, b); }
#define WAIT_BAR(N) asm volatile("s_waitcnt vmcnt(" #N ") lgkmcnt(0)\n\ts_barrier" ::: "memory")
__device__ __forceinline__ void qkt(f32x16& p0, f32x16& p1, lds_cptr Kslot, const bf16x8* qr, const f32x16& negm, int r32, int hi) {
    const lds_cptr kb = Kslot + hi * 1024 + r32 * 16;
#pragma unroll
    for (int d0 = 0; d0 < 4; ++d0) {
        const bf16x8 b0 = *(const __attribute__((address_space(3))) bf16x8*)(kb + d0 * 2048);
        const bf16x8 b1 = *(const __attribute__((address_space(3))) bf16x8*)(kb + d0 * 2048 + 512);
        if (d0 == 0) { p0 = __builtin_amdgcn_mfma_f32_32x32x16_bf16(b0, qr[0], negm, 0, 0, 0); p1 = __builtin_amdgcn_mfma_f32_32x32x16_bf16(b1, qr[0], negm, 0, 0, 0); }
        else { p0 = __builtin_amdgcn_mfma_f32_32x32x16_bf16(b0, qr[d0], p0, 0, 0, 0); p1 = __builtin_amdgcn_mfma_f32_32x32x16_bf16(b1, qr[d0], p1, 0, 0, 0); }
    }
}
__device__ __forceinline__ void kload8(bf16x8* kf, lds_cptr kp) {
    kf[0] = *(const __attribute__((address_space(3))) bf16x8*)(kp);        kf[1] = *(const __attribute__((address_space(3))) bf16x8*)(kp + 512);
    kf[2] = *(const __attribute__((address_space(3))) bf16x8*)(kp + 2048); kf[3] = *(const __attribute__((address_space(3))) bf16x8*)(kp + 2560);
    kf[4] = *(const __attribute__((address_space(3))) bf16x8*)(kp + 4096); kf[5] = *(const __attribute__((address_space(3))) bf16x8*)(kp + 4608);
    kf[6] = *(const __attribute__((address_space(3))) bf16x8*)(kp + 6144); kf[7] = *(const __attribute__((address_space(3))) bf16x8*)(kp + 6656);
}
__device__ __forceinline__ void kload2(bf16x8* kf, lds_cptr kp, int j) { kf[2 * j] = *(const __attribute__((address_space(3))) bf16x8*)(kp + j * 2048); kf[2 * j + 1] = *(const __attribute__((address_space(3))) bf16x8*)(kp + j * 2048 + 512); }
__device__ __forceinline__ s16x4 vtr(lds_cptr p) { return __builtin_bit_cast(s16x4, __builtin_amdgcn_ds_read_tr16_b64_v4i16((__attribute__((address_space(3))) v4i16_t*)p)); }
__device__ __forceinline__ float rowmax(const f32x16& p0, const f32x16& p1) {
    float a = max3f(p0[0], p0[1], p1[0]), b = max3f(p0[2], p0[3], p1[1]); a = max3f(a, p1[2], p1[3]);
#pragma unroll
    for (int r = 4; r < 16; r += 4) { a = max3f(a, p0[r], p0[r + 1]); b = max3f(b, p0[r + 2], p0[r + 3]); a = max3f(a, p1[r], p1[r + 1]); b = max3f(b, p1[r + 2], p1[r + 3]); }
    const float m = max2f(a, b);
    auto rr = __builtin_amdgcn_permlane32_swap(__float_as_uint(m), __float_as_uint(m), false, false);
    return max2f(__uint_as_float(rr[0]), __uint_as_float(rr[1]));
}
__device__ __forceinline__ void pv(f32x16* o, int vb, bf16x8 pa0, bf16x8 pa1, bf16x8 pa2, bf16x8 pa3) {
#pragma unroll
    for (int d0 = 0; d0 < 2; ++d0) { s16x4 lo[4], hi[4];
#pragma unroll
        for (int ks = 0; ks < 4; ++ks) {
            asm volatile("ds_read_b64_tr_b16 %0,%1 offset:%c2" : "=&v"(lo[ks]) : "v"(vb), "i"(d0 * 4096 + ks * 1024) : "memory");
            asm volatile("ds_read_b64_tr_b16 %0,%1 offset:%c2" : "=&v"(hi[ks]) : "v"(vb), "i"(d0 * 4096 + ks * 1024 + 512) : "memory"); }
        asm volatile("s_waitcnt lgkmcnt(0)" ::: "memory"); SBAR();
#define PK(k) (bf16x8){lo[k][0], lo[k][1], lo[k][2], lo[k][3], hi[k][0], hi[k][1], hi[k][2], hi[k][3]}
        o[d0] = __builtin_amdgcn_mfma_f32_32x32x16_bf16(pa0, PK(0), o[d0], 0, 0, 0);
        o[d0] = __builtin_amdgcn_mfma_f32_32x32x16_bf16(pa1, PK(1), o[d0], 0, 0, 0);
        o[d0] = __builtin_amdgcn_mfma_f32_32x32x16_bf16(pa2, PK(2), o[d0], 0, 0, 0);
        o[d0] = __builtin_amdgcn_mfma_f32_32x32x16_bf16(pa3, PK(3), o[d0], 0, 0, 0);
#undef PK
    }
}
__device__ __forceinline__ void wmask(f32x16& p0, f32x16& p1, int dl, int r32, int hi) {
    const float NEG = -INFINITY;
#pragma unroll
    for (int r = 0; r < 16; ++r) { const int rel = dl + crow(r, hi) - r32; if (rel < -128 || rel > 128) p0[r] = NEG; if (rel + 32 < -128 || rel + 32 > 128) p1[r] = NEG; }
}

template <int THRL> __device__ __forceinline__ void attn_unit(int b, int n, int kvh, int hp, int base, bool primed, bool has_next, int nb, int nn, int nkvh, int nhp, bf16x8 (&qr)[4], int& nbase,
                                                              const bf16_t* Y, bf16_t* O, int ldo, const bf16_t* KB, const bf16_t* VB, const float* sink, LAS unsigned char* shm) {
    const int tid = threadIdx.x, lane = tid & 63, r32 = lane & 31, hi = lane >> 5; const int wid = __builtin_amdgcn_readfirstlane(tid >> 6);
    const int head = kvh * 4 + hp * 2 + (wid >> 2), qsub = wid & 3;
    const long qrow0 = (long)b * SEQ + n * 128 + qsub * 32;
    const bf16_t* Qw = Y + qrow0 * 2048 + 1024 + head * 64;
    const unsigned lds0 = (unsigned)(uintptr_t)shm;
    LAS float* wsf = (LAS float*)(shm + LDS_WS) + wid * 64;
    const long koff = (long)lane * 256 + kvh * 64 + wid * 8;
    const long voff = (long)(16 * (wid & 3) + (lane >> 2)) * 256 + kvh * 64 + (wid >> 2) * 32 + (lane & 3) * 8;
    const unsigned kdst = lds0 + LDS_K + wid * 1024, vdst = lds0 + LDS_V + wid * 1024;
    const int jlo = (n == 0) ? 2 : 0, jhi = (n == 31) ? 3 : 5, NT = 4 + (jhi - jlo + 1);
    const long lrow0 = (long)b * SEQ + (n - 1) * 128 + 64 * (jlo - 4), crow0 = (long)NTOK + b * CTXL;
#define TROW(t) ((t) < 4 ? crow0 + 64 * (t) : lrow0 + 64 * (t))
#define DMA_K(t, slot) glds16(KB + TROW(t) * 256 + koff, (unsigned)__builtin_amdgcn_readfirstlane(kdst + (slot)))
#define DMA_V(t, slot) glds16(VB + TROW(t) * 256 + voff, (unsigned)__builtin_amdgcn_readfirstlane(vdst + (slot)))
    const int vb0 = (int)(lds0 + LDS_V) + ((lane >> 4) & 1) * 32 + (lane & 3) * 8 + (4 * hi + ((lane & 15) >> 2)) * 64;
    bf16x8 kf[8];
    const lds_cptr shm3 = (lds_cptr)shm; const lds_cptr kp0 = shm3 + LDS_K + hi * 1024 + r32 * 16; const lds_cptr vp0 = shm3 + LDS_V + ((lane >> 4) & 1) * 32 + (lane & 3) * 8 + (4 * hi + ((lane & 15) >> 2)) * 64;
    const int s0 = base, s1 = (s0 == (NSLOT - 1) * SLOTB) ? 0 : s0 + SLOTB, s2 = (s1 == (NSLOT - 1) * SLOTB) ? 0 : s1 + SLOTB;
    if (!primed) {
        DMA_K(0, s0); DMA_V(0, s0); DMA_K(1, s1); DMA_K(2, s2);
#pragma unroll
        for (int d0 = 0; d0 < 4; ++d0) qr[d0] = *(const bf16x8*)(Qw + (long)r32 * 2048 + d0 * 16 + hi * 8);
    }
    float mhat = 0.f, l_reg = 0.f; f32x16 o[2]; o[0] = f32x16{}; o[1] = f32x16{}; f32x16 negm = f32x16{}; asm volatile("" : "+v"(negm));
    const int dq = -128 - 32 * qsub;
#define CMASK(P0, P1, t) do { if ((t) >= 4) { const int dl_ = 64 * (jlo + (t) - 4) + dq; if (dl_ < -97 || dl_ > 65) wmask(P0, P1, dl_, r32, hi); } } while (0)
    bool resc = false;
#define START(P0, P1) do { const float rm = rowmax(P0, P1); resc = false; \
    { const float dl = rm; mhat = fadd_s(mhat, dl); \
      _Pragma("unroll") for (int r = 0; r < 16; ++r) { P0[r] = fsub_s(P0[r], dl); P1[r] = fsub_s(P1[r], dl); } \
      _Pragma("unroll") for (int r = 0; r < 16; ++r) negm[r] = -mhat; asm volatile("" : "+v"(negm)); } \
    _Pragma("unroll") for (int r = 0; r < 16; ++r) P0[r] = __builtin_amdgcn_exp2f(P0[r]); } while (0)
#define RESC() do { if (resc) { asm volatile("s_waitcnt lgkmcnt(0)" ::: "memory"); \
      _Pragma("unroll") for (int d_ = 0; d_ < 2; ++d_) _Pragma("unroll") for (int r = 0; r < 16; ++r) o[d_][r] *= wsf[crow(r, hi)]; } } while (0)
    f32x16 pA0, pA1, pB0, pB1;
    int sl_prev = s0, sl_cur = s0, sl_next = s1;
#define ROT() do { sl_prev = sl_cur; sl_cur = sl_next; sl_next = (sl_next == (NSLOT - 1) * SLOTB) ? 0 : sl_next + SLOTB; } while (0)
    WAIT_BAR(7);
    qkt(pA0, pA1, shm3 + LDS_K + s0, qr, negm, r32, hi); asm volatile("s_nop 15\n\ts_nop 7" : "+v"(pA0), "+v"(pA1)); CMASK(pA0, pA1, 0);
    START(pA0, pA1);
    _Pragma("unroll") for (int r = 0; r < 16; ++r) pA1[r] = __builtin_amdgcn_exp2f(pA1[r]);
    WAIT_BAR(0);
    DMA_K(3, s0); DMA_V(1, s1);
    ROT();
    kload8(kf, kp0 + sl_cur);
    WAIT_BAR(2);
    s16x4 vlo[8], vhi[8]; u32x4 pw0, pw1, pw2, pw3;
#define PKW(P, B) cvtpk_s(P[B], P[B + 1])
#define PAF(k) __builtin_bit_cast(bf16x8, pw##k)
#define VFR(i) (bf16x8){vlo[i][0], vlo[i][1], vlo[i][2], vlo[i][3], vhi[i][0], vhi[i][1], vhi[i][2], vhi[i][3]}
#define PIN(x) asm volatile("" : "+v"(x))
#define MX3(a, b, c) __builtin_fmaxf(__builtin_fmaxf((a), (b)), (c))
#define GAPA(MF, A0, A1, A2, A3, W0, W1, PW) do { MF; sacc += A0; sacc += A1; sacc += A2; sacc += A3; PIN(sacc); W0; W1; PIN(PW); SBAR(); } while (0)
#define EX(v) __builtin_amdgcn_exp2f(v)
#define GAPB(MF, X, B) do { MF; X[B] = EX(X[B]); X[B + 1] = EX(X[B + 1]); X[B + 2] = EX(X[B + 2]); X[B + 3] = EX(X[B + 3]); PIN(X); SBAR(); } while (0)
#define VRD(i) do { vlo[i] = vtr(vp_ + (((i) >> 2) * 4096 + ((i) & 3) * 1024)); vhi[i] = vtr(vp_ + (((i) >> 2) * 4096 + ((i) & 3) * 1024 + 512)); } while (0)
#define KRD(G, j) do { if (G) { kload2(kf, kp0 + sl_next, j); SBAR(); } } while (0)
#define STEP(C0, C1, P0, P1, t, GK, GV, GL) do { SBAR(); \
    const lds_cptr vp_ = vp0 + sl_prev; \
    VRD(0); SBAR(); float sacc = (P0[0] + P0[1]); \
    GAPA(C0 = __builtin_amdgcn_mfma_f32_32x32x16_bf16(kf[0], qr[0], negm, 0, 0, 0), P0[2], P0[3], P0[4], P0[5],     pw0[0] = PKW(P0, 0), pw0[1] = PKW(P0, 2), pw0); \
    VRD(4); SBAR(); GAPA(C1 = __builtin_amdgcn_mfma_f32_32x32x16_bf16(kf[1], qr[0], negm, 0, 0, 0), P0[6], P0[7], P0[8], P0[9],     pw0[2] = PKW(P0, 4), pw0[3] = PKW(P0, 6), pw0); \
    VRD(1); SBAR(); GAPA(C0 = __builtin_amdgcn_mfma_f32_32x32x16_bf16(kf[2], qr[1], C0, 0, 0, 0),   P0[10], P0[11], P0[12], P0[13], pw1[0] = PKW(P0, 8), pw1[1] = PKW(P0, 10), pw1); \
    VRD(5); SBAR(); GAPA(C1 = __builtin_amdgcn_mfma_f32_32x32x16_bf16(kf[3], qr[1], C1, 0, 0, 0),   P0[14], P0[15], P1[0], P1[1],   pw1[2] = PKW(P0, 12), pw1[3] = PKW(P0, 14), pw1); \
    VRD(2); SBAR(); GAPA(C0 = __builtin_amdgcn_mfma_f32_32x32x16_bf16(kf[4], qr[2], C0, 0, 0, 0),   P1[2], P1[3], P1[4], P1[5],     pw2[0] = PKW(P1, 0), pw2[1] = PKW(P1, 2), pw2); \
    VRD(6); SBAR(); GAPA(C1 = __builtin_amdgcn_mfma_f32_32x32x16_bf16(kf[5], qr[2], C1, 0, 0, 0),   P1[6], P1[7], P1[8], P1[9],     pw2[2] = PKW(P1, 4), pw2[3] = PKW(P1, 6), pw2); \
    VRD(3); SBAR(); GAPA(C0 = __builtin_amdgcn_mfma_f32_32x32x16_bf16(kf[6], qr[3], C0, 0, 0, 0),   P1[10], P1[11], P1[12], P1[13], pw3[0] = PKW(P1, 8), pw3[1] = PKW(P1, 10), pw3); \
    VRD(7); SBAR(); GAPA(C1 = __builtin_amdgcn_mfma_f32_32x32x16_bf16(kf[7], qr[3], C1, 0, 0, 0),   P1[14], P1[15], 0.f, 0.f,       pw3[2] = PKW(P1, 12), pw3[3] = PKW(P1, 14), pw3); \
    l_reg += sacc; \
    if (GK) { DMA_K((t) + 3, sl_cur); } if (GV) { DMA_V((t) + 1, sl_next); } \
    CMASK(C0, C1, t); \
    { float a = MX3(C0[0], C0[1], C1[0]), b2 = MX3(C0[2], C0[3], C1[1]); a = MX3(a, C1[2], C1[3]); \
      _Pragma("unroll") for (int r = 4; r < 16; r += 4) { a = MX3(a, C0[r], C0[r + 1]); b2 = MX3(b2, C0[r + 2], C0[r + 3]); a = MX3(a, C1[r], C1[r + 1]); b2 = MX3(b2, C1[r + 2], C1[r + 3]); } \
      float rm = __builtin_fmaxf(a, b2); { auto rr = __builtin_amdgcn_permlane32_swap(__float_as_uint(rm), __float_as_uint(rm), false, false); rm = __builtin_fmaxf(__uint_as_float(rr[0]), __uint_as_float(rr[1])); } \
      resc = false; \
      if (__builtin_expect(__any(rm > (float)THRL), 0)) { const float dl = __builtin_fmaxf(rm, 0.f); mhat += dl; \
        _Pragma("unroll") for (int r = 0; r < 16; ++r) { C0[r] -= dl; C1[r] -= dl; } \
        _Pragma("unroll") for (int r = 0; r < 16; ++r) negm[r] = -mhat; asm volatile("" : "+v"(negm)); \
        const float f = __builtin_amdgcn_exp2f(-dl); l_reg *= f; if (hi == 0) wsf[r32] = f; resc = true; } } \
    SBAR(); \
    GAPB(o[0] = __builtin_amdgcn_mfma_f32_32x32x16_bf16(PAF(0), VFR(0), o[0], 0, 0, 0), C0, 0); \
    GAPB(o[1] = __builtin_amdgcn_mfma_f32_32x32x16_bf16(PAF(0), VFR(4), o[1], 0, 0, 0), C0, 4); \
    KRD(GL, 0); GAPB(o[0] = __builtin_amdgcn_mfma_f32_32x32x16_bf16(PAF(1), VFR(1), o[0], 0, 0, 0), C0, 8); \
    KRD(GL, 1); GAPB(o[1] = __builtin_amdgcn_mfma_f32_32x32x16_bf16(PAF(1), VFR(5), o[1], 0, 0, 0), C0, 12); \
    KRD(GL, 2); GAPB(o[0] = __builtin_amdgcn_mfma_f32_32x32x16_bf16(PAF(2), VFR(2), o[0], 0, 0, 0), C1, 0); \
    KRD(GL, 3); GAPB(o[1] = __builtin_amdgcn_mfma_f32_32x32x16_bf16(PAF(2), VFR(6), o[1], 0, 0, 0), C1, 4); \
    GAPB(o[0] = __builtin_amdgcn_mfma_f32_32x32x16_bf16(PAF(3), VFR(3), o[0], 0, 0, 0), C1, 8); \
    GAPB(o[1] = __builtin_amdgcn_mfma_f32_32x32x16_bf16(PAF(3), VFR(7), o[1], 0, 0, 0), C1, 12); \
    } while (0)
#define ENDW(tt) do { if ((tt) + 3 < NT) { WAIT_BAR(2); } else if ((tt) + 2 < NT) { WAIT_BAR(1); } else { WAIT_BAR(0); } } while (0)
    int t = 1;
    for (; t + 1 < NT; t += 2) {
        STEP(pB0, pB1, pA0, pA1, t, (t + 3 < NT), (t + 1 < NT), (t + 1 < NT));       ENDW(t);     RESC(); ROT();
        STEP(pA0, pA1, pB0, pB1, t + 1, (t + 4 < NT), (t + 2 < NT), (t + 2 < NT));   ENDW(t + 1); RESC(); ROT();
    }
    nbase = sl_next;
    if (has_next) {
        const long nr = (long)NTOK + nb * CTXL; const long nko = (long)lane * 256 + nkvh * 64 + wid * 8, nvo = (long)(16 * (wid & 3) + (lane >> 2)) * 256 + nkvh * 64 + (wid >> 2) * 32 + (lane & 3) * 8;
        const int n0 = sl_next, n1 = (n0 == (NSLOT - 1) * SLOTB) ? 0 : n0 + SLOTB, n2 = (n1 == (NSLOT - 1) * SLOTB) ? 0 : n1 + SLOTB;
        glds16(KB + nr * 256 + nko, (unsigned)__builtin_amdgcn_readfirstlane(kdst + n0)); glds16(VB + nr * 256 + nvo, (unsigned)__builtin_amdgcn_readfirstlane(vdst + n0));
        glds16(KB + (nr + 64) * 256 + nko, (unsigned)__builtin_amdgcn_readfirstlane(kdst + n1)); glds16(KB + (nr + 128) * 256 + nko, (unsigned)__builtin_amdgcn_readfirstlane(kdst + n2));
    }
    STEP(pB0, pB1, pA0, pA1, NT - 1, false, false, false); RESC();
    { float sacc = pB0[0] + pB0[1]; _Pragma("unroll") for (int r = 2; r < 16; ++r) sacc += pB0[r]; _Pragma("unroll") for (int r = 0; r < 16; ++r) sacc += pB1[r]; l_reg += sacc;
      pw0 = (u32x4){PKW(pB0, 0), PKW(pB0, 2), PKW(pB0, 4), PKW(pB0, 6)}; pw1 = (u32x4){PKW(pB0, 8), PKW(pB0, 10), PKW(pB0, 12), PKW(pB0, 14)}; pw2 = (u32x4){PKW(pB1, 0), PKW(pB1, 2), PKW(pB1, 4), PKW(pB1, 6)}; pw3 = (u32x4){PKW(pB1, 8), PKW(pB1, 10), PKW(pB1, 12), PKW(pB1, 14)};
      SBAR(); pv(o, vb0 + sl_cur, PAF(0), PAF(1), PAF(2), PAF(3)); }
    if (has_next) {
        asm volatile("" ::: "memory");
        const bf16_t* nQw = Y + ((long)nb * SEQ + nn * 128 + qsub * 32) * 2048 + 1024 + (nkvh * 4 + nhp * 2 + (wid >> 2)) * 64;
#pragma unroll
        for (int d0 = 0; d0 < 4; ++d0) qr[d0] = *(const bf16x8*)(nQw + (long)r32 * 2048 + d0 * 16 + hi * 8);
    }
    { auto rr = __builtin_amdgcn_permlane32_swap(__float_as_uint(l_reg), __float_as_uint(l_reg), false, false); l_reg = __uint_as_float(rr[0]) + __uint_as_float(rr[1]); }
    l_reg += __builtin_amdgcn_exp2f(fminf(sink[head] * LOG2E - mhat, 80.f));
    if (hi == 0) wsf[32 + r32] = l_reg; asm volatile("s_waitcnt lgkmcnt(0)" ::: "memory");
    float rli[16];
#pragma unroll
    for (int r = 0; r < 16; ++r) rli[r] = __builtin_amdgcn_rcpf(wsf[32 + crow(r, hi)]);
    bf16_t* Ow = O + qrow0 * ldo + head * 64;
    { LAS bf16_t* stg = (LAS bf16_t*)(shm + LDS_OST) + wid * 2048;
#pragma unroll
      for (int r = 0; r < 16; ++r) { const int orow = crow(r, hi);
#pragma unroll
          for (int d0 = 0; d0 < 2; ++d0) stg[orow * 64 + d0 * 32 + r32] = (bf16_t)(pk2(o[d0][r] * rli[r], 0.f) & 0xffffu); }
      asm volatile("s_waitcnt lgkmcnt(0)" ::: "memory");
#pragma unroll
      for (int i = 0; i < 4; ++i) { const int row = i * 8 + (lane >> 3), ch = lane & 7; const u32x4 v = *(const LAS u32x4*)(stg + row * 64 + ch * 8); *(u32x4*)(Ow + (long)row * ldo + ch * 8) = v; } }
    asm volatile("s_waitcnt lgkmcnt(0)\n\ts_barrier" ::: "memory");
#undef TROW
#undef DMA_K
#undef DMA_V
#undef CMASK
#undef START
#undef RESC
#undef ROT
#undef PKW
#undef PAF
#undef VFR
#undef PIN
#undef MX3
#undef GAPA
#undef GAPB
#undef EX
#undef VRD
#undef KRD
#undef STEP
#undef ENDW
}
#undef SBAR
#undef WAIT_BAR
}

#define XB_TMO      128
#define XB_XCNT(j)  (256  + 64 * (j))
#define XB_XSUB(j)  (1280 + 64 * (j))
#define XB_XGEN(j)  (2304 + 64 * (j))
#define XB_TOP      3328
#define XB_TOPGEN   3392
#define XCD_BAR_WORDS 3456
#define XB_SPIN_CAP (1u << 18)
__device__ __forceinline__ unsigned xb_ld(unsigned* p)              { return __hip_atomic_load(p, __ATOMIC_RELAXED, __HIP_MEMORY_SCOPE_AGENT); }
__device__ __forceinline__ unsigned xb_add(unsigned* p, unsigned v) { return __hip_atomic_fetch_add(p, v, __ATOMIC_RELAXED, __HIP_MEMORY_SCOPE_AGENT); }
__device__ __forceinline__ unsigned xb_xcc_id() { return (unsigned)__builtin_amdgcn_s_getreg((3 << 11) | 20) & 0xFu; }
#define XB_SPIN(cond, bar) do { unsigned _sp = 0; while (cond) { __builtin_amdgcn_s_sleep(1); \
    if ((++_sp & 255u) == 0u) { if (xb_ld(&(bar)[XB_TMO])) break; if (_sp > XB_SPIN_CAP) { atomicAdd(&(bar)[XB_TMO], 1u); break; } } } } while (0)
struct XcdBarrier { unsigned* bar; unsigned x; volatile LAS unsigned* st; };
__device__ __forceinline__ XcdBarrier xcd_barrier_post(unsigned* bar, volatile LAS unsigned* st) {
    XcdBarrier b; b.bar = bar; b.x = xb_xcc_id(); b.st = st;
    if (threadIdx.x == 0) (void)xb_add(&bar[XB_XCNT(b.x)], 1u);
    return b;
}
__device__ __forceinline__ void xcd_barrier_complete(unsigned* bar, unsigned x, unsigned& nloc, unsigned& nx) {
    const unsigned G = gridDim.x * gridDim.y * gridDim.z;
    unsigned sum, cnt, mine, sp = 0u;
    for (;;) {
        sum = 0u; cnt = 0u; mine = 0u;
#pragma unroll
        for (unsigned j = 0; j < 16; ++j) { const unsigned c = xb_ld(&bar[XB_XCNT(j)]); sum += c; cnt += (c > 0u) ? 1u : 0u; mine = (j == x) ? c : mine; }
        if (sum == G) break;
        __builtin_amdgcn_s_sleep(1);
        if ((++sp & 255u) == 0u) { if (xb_ld(&bar[XB_TMO])) break; if (sp > XB_SPIN_CAP) { atomicAdd(&bar[XB_TMO], 1u); break; } }
    }
    nloc = mine > 0u ? mine : 1u; nx = cnt > 0u ? cnt : 1u;
}
__device__ __forceinline__ void xcd_barrier(const XcdBarrier& b) {
    asm volatile("s_waitcnt vmcnt(0)" ::: "memory");
    __syncthreads();
    if (threadIdx.x == 0) {
        unsigned* bar = b.bar;
        __builtin_amdgcn_s_waitcnt(0);
        unsigned nloc = b.st[0], nx = b.st[1];
        if (nloc == 0u) { xcd_barrier_complete(bar, b.x, nloc, nx); b.st[0] = nloc; b.st[1] = nx; }
        const unsigned old = xb_add(&bar[XB_XSUB(b.x)], 1u);
        const unsigned gen = old / nloc;
        if (old + 1u == (gen + 1u) * nloc) {
            __builtin_amdgcn_fence(__ATOMIC_RELEASE, "agent");
            asm volatile("s_waitcnt vmcnt(0)" ::: "memory");
            const unsigned og = xb_add(&bar[XB_TOP], 1u);
            const unsigned tg = og / nx;
            if (og + 1u == (tg + 1u) * nx) xb_add(&bar[XB_TOPGEN], 1u);
            else XB_SPIN(xb_ld(&bar[XB_TOPGEN]) == tg, bar);
            __builtin_amdgcn_fence(__ATOMIC_ACQUIRE, "agent");
            xb_add(&bar[XB_XGEN(b.x)], 1u);
            asm volatile("s_waitcnt vmcnt(0)" ::: "memory");
        } else {
            XB_SPIN(xb_ld(&bar[XB_XGEN(b.x)]) == gen, bar);
            __builtin_amdgcn_fence(__ATOMIC_ACQUIRE, "agent");
            asm volatile("s_waitcnt vmcnt(0)" ::: "memory");
        }
    }
    __syncthreads();
}
constexpr int LDSCTL_OFF = LDS_BYTES - 256;
constexpr int CW_BAR = 4096, CW_CTX = 8192;

#ifndef PROBE_GMLP2
#define PROBE_GMLP2 0
#endif
#ifndef ATT_PIPE
#define ATT_PIPE 1
#endif
#ifndef ATT_THRL
#define ATT_THRL 8
#endif
#ifndef ONE_LAUNCH
#define ONE_LAUNCH 1
#endif
#ifndef FAST_MIX
#define FAST_MIX 1
#endif
#ifndef PROBE_SEQ
#define PROBE_SEQ 0, 1, 2, 3, 4, 5, 6, 7, 8, 9, 10, 11
#endif

enum { PH_PRO = 0, PH_HN, PH_IN, PH_MIX, PH_A, PH_O, PH_H2R, PH_WCONV, PH_TOPK, PH_GU, PH_D, PH_FIN, PH_COUNT };

__global__ void __launch_bounds__(NTHREADS, 2) fwd(Args args) {
    extern __shared__ __attribute__((aligned(16))) unsigned char lds_raw[];
    LAS unsigned char* lds = (LAS unsigned char*)lds_raw;
    const int tid = threadIdx.x, lane = tid & 63, wave = __builtin_amdgcn_readfirstlane(tid >> 6);
    const int G = gridDim.x, bid = blockIdx.x;
    unsigned char* ws = args.ws;
    const int lo = args.ph_lo, hi = args.ph_hi;
#define IN(k) (lo <= (k) && (k) < hi)
    float* MOD = (float*)(ws + WS_MOD); f32x2* ROPE = (f32x2*)(ws + WS_ROPE);
    float* AFFT = (float*)(ws + WS_AFFT); int* TOPI = (int*)(ws + WS_TOPI); float* TOPW = (float*)(ws + WS_TOPW); int* SLOT = (int*)(ws + WS_SLOT);
    bf16_t* WSP = (bf16_t*)(ws + WS_WSP); bf16_t* WIN = (bf16_t*)(ws + WS_WIN); bf16_t* WAB = (bf16_t*)(ws + WS_WAB); bf16_t* WO = (bf16_t*)(ws + WS_WO);
    bf16_t* H = (bf16_t*)(ws + WS_H); bf16_t* VA = (bf16_t*)(ws + WS_VA); bf16_t* KB = (bf16_t*)(ws + WS_KB); bf16_t* VB = (bf16_t*)(ws + WS_VB);
    bf16_t* GT = (bf16_t*)(ws + WS_G); bf16_t* Y = (bf16_t*)(ws + WS_Y); bf16_t* TMP = (bf16_t*)(ws + WS_TMP); bf16_t* MERGED = (bf16_t*)(ws + WS_MERGED);
    bf16_t* WGU = (bf16_t*)(ws + WS_WGU); bf16_t* WD = (bf16_t*)(ws + WS_WD); bf16_t* H2 = (bf16_t*)(ws + WS_H2); bf16_t* ACT = (bf16_t*)(ws + WS_ACT); bf16_t* YB = (bf16_t*)(ws + WS_YB);
    const int gw = bid * NWAVES + wave, NGW = G * NWAVES;
    if (tid < 64) ((LAS unsigned*)(lds + LDSCTL_OFF))[tid] = 0u;
    __syncthreads();
    XcdBarrier bar; bar.bar = (unsigned*)(ws + WS_CTL) + CW_BAR; bar.x = 0; bar.st = nullptr;
    if (ONE_LAUNCH) bar = xcd_barrier_post((unsigned*)(ws + WS_CTL) + CW_BAR, (volatile LAS unsigned*)(lds + LDSCTL_OFF));
#define SEAM(k) do { if (ONE_LAUNCH && IN(k) && IN((k) + 1)) xcd_barrier(bar); } while (0)

    if (IN(PH_PRO)) {
        if (bid < 192) adaln_task(bid, args.in[I_C], args.in[I_CCTX], args.in[I_WADA], args.in[I_BADA], MOD, (LAS float*)lds, tid);
        else if (bid == 192) rope_table(ROPE, tid);
        __syncthreads();
        for (int i = bid * NTHREADS + tid; i < 8 * 128 * 128 / 4; i += G * NTHREADS) st4bf(WSP + 4 * i, *(const f32x4*)(args.in[I_WSP] + 4 * i));
        LAS float* scr = (LAS float*)(lds + wave * 16384);
        constexpr int I_IN = 16 * 176, I_P = 16 * 32;
        for (int it = gw; it < I_IN + 3 * I_P; it += NGW) {
            int r = it;
            if (r < I_IN) { const int kb = r / 176, nb = r % 176, n0 = nb * 32; int drow = n0;
                if (n0 >= OFF_GATE) { const int gcol = n0 - OFF_GATE, isb = gcol >= 1024, ch = gcol & 1023; drow = OFF_GATE + 256 * (ch >> 7) + (ch & 127) + (isb ? 128 : 0); }
                transpose_item(args.in[I_WIN], INCOLS, kb * 64, n0, WIN + (size_t)drow * 1024 + kb * 64, 1024, scr, lane); continue; } r -= I_IN;
            if (r < I_P) { const int kb = r / 32, nb = r % 32; transpose_item(args.in[I_WPA], 1024, kb * 64, nb * 32, WAB + (size_t)(nb * 32) * 2048 + kb * 64, 2048, scr, lane); continue; } r -= I_P;
            if (r < I_P) { const int kb = r / 32, nb = r % 32; transpose_item(args.in[I_WPB], 1024, kb * 64, nb * 32, WAB + (size_t)(nb * 32) * 2048 + 1024 + kb * 64, 2048, scr, lane); continue; } r -= I_P;
            { const int kb = r / 32, nb = r % 32; transpose_item(args.in[I_WOUT], 1024, kb * 64, nb * 32, WO + (size_t)(nb * 32) * 1024 + kb * 64, 1024, scr, lane); }
        }
    }
    SEAM(PH_PRO);
    if (IN(PH_HN)) {
        const float* g1n = args.in[I_N1G];
        const int HCH = (NROWS_H + NGW - 1) / NGW;
        f32x4 am[4], sm[4]; int mcur = -1;
        for (int kk = 0; kk < HCH; ++kk) {
            const int row = gw * HCH + kk; if (row >= NROWS_H) break;
            const float* xr; int mrow;
            if (row < NTOK) { xr = args.in[I_X] + (size_t)row * 1024; mrow = row >> 12; } else { xr = args.in[I_CTX] + (size_t)(row - NTOK) * 1024; mrow = 8; }
            f32x4 v[4]; float ss = 0.f;
#pragma unroll
            for (int j = 0; j < 4; ++j) { v[j] = *(const f32x4*)(xr + 4 * lane + 256 * j); ss += (v[j].x * v[j].x + v[j].y * v[j].y) + (v[j].z * v[j].z + v[j].w * v[j].w); }
            if (mrow != mcur) { mcur = mrow; const float* sh = MOD + mrow * 6144; const float* sc = sh + 1024;
#pragma unroll
                for (int j = 0; j < 4; ++j) { const int col = 4 * lane + 256 * j; am[j] = *(const f32x4*)(g1n + col) * (1.f + *(const f32x4*)(sc + col)); sm[j] = *(const f32x4*)(sh + col); } }
            const float rstd = 1.0f / sqrtf(wave_sum(ss) * (1.f / 1024.f) + EPS);
#pragma unroll
            for (int j = 0; j < 4; ++j) st4bf(H + (size_t)row * 1024 + 4 * lane + 256 * j, (v[j] * rstd) * am[j] + sm[j]);
        }
    }
    SEAM(PH_HN);
    if (IN(PH_IN)) {
        Gemm g{H, WIN, 1024, 1024, 1024, 0, 30, nullptr}; StaticOrder S; S.init(NTOK, INCOLS, G, bid, G == 256 ? 0 : 16);
        EpiIn E{Y, VA, KB, VB, GT, args.in[I_BMG], ROPE, (f32x2*)(ws + WS_STATS)};
        GEMM_PHASE<EpiIn, StaticOrder, false>(lds, g, S, E);
    }
    SEAM(PH_IN);
    if (IN(PH_MIX) && FAST_MIX) {
        unsigned* ctxcnt = (unsigned*)(ws + WS_CTL) + CW_CTX;
        if (G == 256 && bid < 16) {
            Gemm g{H, WIN, 1024, 1024, 1024, 0, 30, nullptr}; OneUnit S{NTOK / 256 + (bid >> 1), 12 + (bid & 1)};
            EpiIn E{Y, VA, KB, VB, GT, args.in[I_BMG], ROPE, (f32x2*)(ws + WS_STATS)};
            GEMM_PHASE<EpiIn, OneUnit, false>(lds, g, S, E);
            asm volatile("s_waitcnt vmcnt(0)" ::: "memory");
            __syncthreads();
            if (tid == 0) { __builtin_amdgcn_fence(__ATOMIC_RELEASE, "agent"); asm volatile("s_waitcnt vmcnt(0)" ::: "memory"); xb_add(ctxcnt, 1u); }
        }
        if (!(args.flags & 8)) for (int task = bid; task < NB * 32; task += G) mix::gmlp_unit(task, Y, (args.flags & 2) ? TMP : Y, (args.flags & 2) ? 1024 : 2048, VA, WSP, (const f32x2*)(ws + WS_STATS), args.in[I_LNG], args.in[I_LNB], args.in[I_BSP], lds);
        if (tid == 0) {
            unsigned sp = 0; while (xb_ld(ctxcnt) < 16u) { __builtin_amdgcn_s_sleep(2); if (++sp > (1u << 22)) break; }
            __builtin_amdgcn_fence(__ATOMIC_ACQUIRE, "agent"); asm volatile("s_waitcnt vmcnt(0)" ::: "memory");
        }
        __syncthreads();
#if ATT_PIPE
        att2::bf16x8 att_qr[4]; int att_base = 0; bool att_primed = false;
        int ubase, ucnt;
        if (G != 256) { ubase = bid * 8; ucnt = 0; }
        else if (bid < 16) { ubase = 6 * bid; ucnt = 6; } else if (bid < 48) { ubase = 96 + 9 * (bid - 16); ucnt = 9; } else { ubase = 384 + 8 * (bid - 48); ucnt = 8; }
        if (!(args.flags & 1)) for (int i = 0; i < ucnt; ++i) {
            const int u_ = ubase + i, task = u_ >> 1, hp = u_ & 1, un = u_ + 1, ntask = un >> 1; const bool more = i + 1 < ucnt; int nbase_ = 0;
            att2::attn_unit<ATT_THRL>(task >> 7, (task >> 2) & 31, task & 3, hp, att_base, att_primed, more, ntask >> 7, (ntask >> 2) & 31, ntask & 3, un & 1, att_qr, nbase_,
                                      Y, (args.flags & 4) ? TMP : Y + 1024, (args.flags & 4) ? 1024 : 2048, KB, VB, args.in[I_SINK], lds);
            att_base = nbase_; att_primed = more;
        }
        if (G != 256 && !(args.flags & 1)) for (int u_ = bid; u_ < NB * 32 * 8; u_ += G) {
            const int task = u_ >> 1; int nbase_ = 0;
            att2::attn_unit<ATT_THRL>(task >> 7, (task >> 2) & 31, task & 3, u_ & 1, 0, false, false, 0, 0, 0, 0, att_qr, nbase_, Y, (args.flags & 4) ? TMP : Y + 1024, (args.flags & 4) ? 1024 : 2048, KB, VB, args.in[I_SINK], lds);
        }
#else
        if (!(args.flags & 1)) for (int task = bid; task < NB * 32 * 4; task += G) mix::attn_unit(task >> 7, (task >> 2) & 31, task & 3, Y, (args.flags & 4) ? TMP : Y + 1024, (args.flags & 4) ? 1024 : 2048, KB, VB, args.in[I_SINK], lds);
#endif
    }
    SEAM(PH_MIX);
    if (IN(PH_A)) {
        Gemm g{Y, WAB, 2048, 2048, 2048, 0, 30, nullptr}; StaticOrder S; S.init(NTOK, 1024, G, bid, 0, 1);
        EpiAB E{MERGED, GT};
        GEMM_PHASE<EpiAB, StaticOrder, false, true>(lds, g, S, E);
    }
    SEAM(PH_A);
    if (IN(PH_O)) {
        Gemm g{MERGED, WO, 1024, 1024, 1024, 0, 30, nullptr}; StaticOrder S; S.init(NTOK, 1024, G, bid);
        EpiO E{(bf16_t*)args.out, MOD};
        GEMM_PHASE<EpiO, StaticOrder, false>(lds, g, S, E);
    }
    SEAM(PH_O);
    if (IN(PH_H2R)) {
        LAS float* wT = (LAS float*)lds;
        { f32x4 wv[8];
#pragma unroll
          for (int k = 0; k < 8; ++k) wv[k] = *(const f32x4*)(args.in[I_WR] + 4 * (tid + NTHREADS * k));
#pragma unroll
          for (int k = 0; k < 8; ++k) { const int f = tid + NTHREADS * k, col = f >> 2, e0 = 4 * (f & 3); wT[e0 * 1024 + col] = wv[k].x; wT[(e0 + 1) * 1024 + col] = wv[k].y; wT[(e0 + 2) * 1024 + col] = wv[k].z; wT[(e0 + 3) * 1024 + col] = wv[k].w; } }
        __syncthreads();
        const float* g2n = args.in[I_N2G];
        const int H2CH = (NTOK / 2 + NGW - 1) / NGW;
        const bool h32 = lane & 32, h16 = lane & 16, h8 = lane & 8, h4 = lane & 4;
        const int myexp = 8 * (lane >> 5) + 4 * ((lane >> 4) & 1) + 2 * ((lane >> 3) & 1) + ((lane >> 2) & 1);
        const bf16_t* D16 = (const bf16_t*)args.out;
        f32x4 vn[2][4]; u32x2 dn[2][4];
#pragma unroll
        for (int q = 0; q < 2; ++q)
#pragma unroll
            for (int j = 0; j < 4; ++j) { const size_t r_ = (size_t)(2 * (NTOK / 2 - 1 - (gw * H2CH < NTOK / 2 ? gw * H2CH : 0)) + q); vn[q][j] = *(const f32x4*)(args.in[I_X] + r_ * 1024 + 4 * lane + 256 * j); dn[q][j] = *(const u32x2*)(D16 + r_ * 2048 + 1024 + 4 * lane + 256 * j); }
        f32x4 amod[4], smod[4]; int bcur = -1;
        for (int kk = 0; kk < H2CH; ++kk) {
            const int rp = gw * H2CH + kk; if (rp >= NTOK / 2) break;
            const int row0 = 2 * (NTOK / 2 - 1 - rp), b = row0 >> 12;
            if (b != bcur) { bcur = b; const float* sh = MOD + b * 6144 + 3072; const float* sc = sh + 1024;
#pragma unroll
                for (int j = 0; j < 4; ++j) { const int col = 4 * lane + 256 * j; amod[j] = *(const f32x4*)(g2n + col) * (1.f + *(const f32x4*)(sc + col)); smod[j] = *(const f32x4*)(sh + col); } }
            f32x4 v[2][4]; float ss[2] = {0.f, 0.f};
#pragma unroll
            for (int q = 0; q < 2; ++q)
#pragma unroll
                for (int j = 0; j < 4; ++j) { const u32x2 dw = dn[q][j]; v[q][j] = vn[q][j] + (f32x4){bf2f(dw.x & 0xffffu), bf2f(dw.x >> 16), bf2f(dw.y & 0xffffu), bf2f(dw.y >> 16)}; ss[q] += (v[q][j].x * v[q][j].x + v[q][j].y * v[q][j].y) + (v[q][j].z * v[q][j].z + v[q][j].w * v[q][j].w); }
            { const int rn = (kk + 1 < H2CH && rp + 1 < NTOK / 2) ? rp + 1 : rp;
#pragma unroll
              for (int q = 0; q < 2; ++q)
#pragma unroll
                  for (int j = 0; j < 4; ++j) { const size_t r_ = (size_t)(2 * (NTOK / 2 - 1 - rn) + q); vn[q][j] = *(const f32x4*)(args.in[I_X] + r_ * 1024 + 4 * lane + 256 * j); dn[q][j] = *(const u32x2*)(D16 + r_ * 2048 + 1024 + 4 * lane + 256 * j); } }
            float rstd[2];
#pragma unroll
            for (int q = 0; q < 2; ++q) rstd[q] = 1.0f / sqrtf(wave_sum(ss[q]) * (1.f / 1024.f) + EPS);
            float lg[2][16];
#pragma unroll
            for (int q = 0; q < 2; ++q)
#pragma unroll
                for (int e = 0; e < 16; ++e) lg[q][e] = 0.f;
            f32x4 wb[2][4];
#pragma unroll
            for (int e = 0; e < 4; ++e) wb[0][e] = *(const LAS f32x4*)(wT + e * 1024 + 4 * lane);
            f32x4 h[2];
#pragma unroll
            for (int g = 0; g < 16; ++g) {
                const int j = g >> 2, eg = g & 3, col = 4 * lane + 256 * j;
                if (g + 1 < 16) {
                    const int jn = (g + 1) >> 2, en = (g + 1) & 3;
#pragma unroll
                    for (int e = 0; e < 4; ++e) wb[(g + 1) & 1][e] = *(const LAS f32x4*)(wT + (4 * en + e) * 1024 + 4 * lane + 256 * jn);
                }
                if (eg == 0) {
#pragma unroll
                    for (int q = 0; q < 2; ++q) { h[q] = (v[q][j] * rstd[q]) * amod[j] + smod[j]; st4bf(H2 + (size_t)(row0 + q) * 1024 + col, h[q]); }
                }
#pragma unroll
                for (int e = 0; e < 4; ++e) {
                    const f32x4 w = wb[g & 1][e];
#pragma unroll
                    for (int q = 0; q < 2; ++q) lg[q][4 * eg + e] += (h[q].x * w.x + h[q].y * w.y) + (h[q].z * w.z + h[q].w * w.w);
                    asm volatile("" : "+v"(lg[0][4 * eg + e]), "+v"(lg[1][4 * eg + e]));
                }
                asm volatile("" ::: "memory");
            }
#pragma unroll
            for (int q = 0; q < 2; ++q) {
                float a8[8], a4[4], a2[2], a1;
#pragma unroll
                for (int i = 0; i < 8; ++i) { const float send = h32 ? lg[q][i] : lg[q][i + 8], keep = h32 ? lg[q][i + 8] : lg[q][i]; a8[i] = keep + xchg32(send); }
#pragma unroll
                for (int i = 0; i < 4; ++i) { const float send = h16 ? a8[i] : a8[i + 4], keep = h16 ? a8[i + 4] : a8[i]; a4[i] = keep + xchg16(send); }
#pragma unroll
                for (int i = 0; i < 2; ++i) { const float send = h8 ? a4[i] : a4[i + 2], keep = h8 ? a4[i + 2] : a4[i]; a2[i] = keep + dpp_f<0x140>(send); }
                { const float send = h4 ? a2[0] : a2[1], keep = h4 ? a2[1] : a2[0]; a1 = keep + dpp_f<0x141>(send); }
                a1 += dpp_f<0x4E>(a1); a1 += dpp_f<0xB1>(a1);
                float mx = a1;
                mx = fmaxf(mx, dpp_f<0x141>(mx)); mx = fmaxf(mx, dpp_f<0x140>(mx)); mx = fmaxf(mx, xchg16(mx)); mx = fmaxf(mx, xchg32(mx));
                const float p = __expf(a1 - mx); float den = p;
                den += dpp_f<0x141>(den); den += dpp_f<0x140>(den); den += xchg16(den); den += xchg32(den);
                if ((lane & 3) == 0) AFFT[(size_t)(b * 16 + myexp) * SEQ + ((row0 + q) & (SEQ - 1))] = p / den;
            }
        }
    }
    if (IN(PH_WCONV)) {
        __syncthreads();
        LAS float* scr = (LAS float*)(lds + wave * 16384);
        constexpr int I_G = 16 * 16 * 64, I_D = 16 * 32 * 32;
        auto item = [&](int it) -> TrItem {
            int r = it; TrItem t;
            if (r < 2 * I_G) {
                const int up = r >= I_G; if (up) r -= I_G;
                const int e = r >> 10, kb = (r >> 6) & 15, nb = r & 63, n0 = nb * 32;
                const int drow = 256 * (n0 >> 7) + (n0 & 127) + (up ? 128 : 0);
                t.src = args.in[up ? I_WEU : I_WEG] + (size_t)e * 1024 * 2048 + (size_t)(kb * 64) * 2048 + n0; t.N = 2048;
                t.dst = WGU + (size_t)e * 4096 * 1024 + (size_t)drow * 1024 + kb * 64; t.ldt = 1024;
            } else {
                r -= 2 * I_G;
                const int e = r >> 10, kb = (r >> 5) & 31, nb = r & 31;
                t.src = args.in[I_WED] + (size_t)e * 2048 * 1024 + (size_t)(kb * 64) * 1024 + nb * 32; t.N = 1024;
                t.dst = WD + (size_t)e * 1024 * 2048 + (size_t)(nb * 32) * 2048 + kb * 64; t.ldt = 2048;
            }
            return t;
        };
        constexpr int NIT = 2 * I_G + I_D;
        if (gw < NIT) {
            TrItem cur = item(gw); f32x4 vc[8], vn[8];
            tr_load(cur, vc, lane);
            for (int it = gw; it < NIT; it += NGW) {
                const bool more = it + NGW < NIT;
                TrItem nxt = cur;
                if (more) { nxt = item(it + NGW); tr_load(nxt, vn, lane); }
                tr_store(cur, vc, scr, lane);
                cur = nxt;
#pragma unroll
                for (int i = 0; i < 8; ++i) vc[i] = vn[i];
            }
        }
    }
    SEAM(PH_WCONV);
    if (IN(PH_TOPK)) {
        LAS int* wsum = (LAS int*)lds;
        for (int task = bid; task < NE * NB; task += G) {
            const int e = task >> 3, b = task & 7;
            const float* aff = AFFT + (size_t)(b * 16 + e) * SEQ;
            unsigned k[8];
            { const u32x4 a0 = *(const u32x4*)(aff + 8 * tid), a1 = *(const u32x4*)(aff + 8 * tid + 4); k[0] = a0.x; k[1] = a0.y; k[2] = a0.z; k[3] = a0.w; k[4] = a1.x; k[5] = a1.y; k[6] = a1.z; k[7] = a1.w; }
            unsigned T = 0u; int it = 0;
            __syncthreads();
            for (int bit = 30; bit >= 0; --bit, ++it) {
                const unsigned cand = T | (1u << bit); int c = 0;
#pragma unroll
                for (int j = 0; j < 8; ++j) c += __builtin_popcountll(__ballot(k[j] >= cand));
                if (lane == 0) wsum[(it & 1) * 8 + wave] = c;
                __syncthreads();
                int tot = 0;
#pragma unroll
                for (int w = 0; w < 8; ++w) tot += wsum[(it & 1) * 8 + w];
                if (tot >= CAP) T = cand;
            }
            int cg = 0, ce = 0;
#pragma unroll
            for (int j = 0; j < 8; ++j) { cg += (k[j] > T) ? 1 : 0; ce += (k[j] == T) ? 1 : 0; }
            LAS int* sc1 = wsum + 16; LAS int* sc2 = wsum + 32;
            int ie = ce, ig = cg;
#pragma unroll
            for (int o = 1; o < 64; o <<= 1) { const int te = __shfl_up(ie, o), tg = __shfl_up(ig, o); if (lane >= o) { ie += te; ig += tg; } }
            __syncthreads();
            if (lane == 63) { sc1[wave] = ie; sc2[wave] = ig; }
            __syncthreads();
            int ebase = ie - ce, totg = 0;
#pragma unroll
            for (int w = 0; w < 8; ++w) { if (w < wave) ebase += sc1[w]; totg += sc2[w]; }
            const int need = CAP - totg;
            int sel[8], cs = 0, er = ebase;
#pragma unroll
            for (int j = 0; j < 8; ++j) { const bool eq = (k[j] == T); sel[j] = (k[j] > T) || (eq && er < need); er += eq ? 1 : 0; cs += sel[j]; }
            int is = cs;
#pragma unroll
            for (int o = 1; o < 64; o <<= 1) { const int ts = __shfl_up(is, o); if (lane >= o) is += ts; }
            __syncthreads();
            if (lane == 63) sc1[wave] = is;
            __syncthreads();
            int sbase = is - cs;
#pragma unroll
            for (int w = 0; w < 8; ++w) if (w < wave) sbase += sc1[w];
#pragma unroll
            for (int j = 0; j < 8; ++j) {
                const int t = 8 * tid + j; int slot = -1;
                if (sel[j]) { slot = sbase; ++sbase; const int prow = (e * 8 + b) * CAP + slot; TOPI[prow] = t; TOPW[prow] = __uint_as_float(k[j]); }
                SLOT[((size_t)b * SEQ + t) * 16 + e] = slot;
            }
            __syncthreads();
        }
    }
    SEAM(PH_TOPK);
    if (IN(PH_GU)) {
        Gemm g{H2, WGU, 1024, 1024, 1024, (size_t)4096 * 1024, 4, TOPI}; StaticOrder S; S.init(NPAIR, 4096, G, bid);
        EpiGU E{ACT};
        GEMM_PHASE<EpiGU, StaticOrder, true, false, true>(lds, g, S, E);
    }
    SEAM(PH_GU);
    if (IN(PH_D)) {
        Gemm g{ACT, WD, 2048, 2048, 2048, (size_t)1024 * 2048, 4, nullptr}; StaticOrder S; S.init(NPAIR, 1024, G, bid, 0, 1);
        EpiD E{YB, TOPW};
        GEMM_PHASE<EpiD, StaticOrder, false>(lds, g, S, E);
    }
    SEAM(PH_D);
    if (IN(PH_FIN)) {
        const float* fg = args.in[I_FING];
        const bf16_t* ZROW = (const bf16_t*)(ws + WS_CTL + 512 * 1024);
        int sln[2] = {-1, -1};
        const int FCH = (NTOK / 2 + NGW - 1) / NGW;
        if (gw * FCH < NTOK / 2 && lane < 16) { sln[0] = SLOT[(size_t)(2 * gw * FCH) * 16 + lane]; sln[1] = SLOT[(size_t)(2 * gw * FCH + 1) * 16 + lane]; }
        f32x4 g2v[4], fgv[4]; int bcur = -1;
#pragma unroll
        for (int h = 0; h < 2; ++h) { fgv[2 * h] = *(const f32x4*)(fg + 512 * h + 8 * lane); fgv[2 * h + 1] = *(const f32x4*)(fg + 512 * h + 8 * lane + 4); }
        for (int kk = 0; kk < FCH; ++kk) {
            const int rp = gw * FCH + kk; if (rp >= NTOK / 2) break;
            const int row0 = 2 * rp, b = row0 >> 12;
            const int sl[2] = {sln[0], sln[1]};
            { const int rn = rp + 1; if (kk + 1 < FCH && rn < NTOK / 2 && lane < 16) { sln[0] = SLOT[(size_t)(2 * rn) * 16 + lane]; sln[1] = SLOT[(size_t)(2 * rn + 1) * 16 + lane]; } }
            if (b != bcur) { bcur = b; const float* g2 = MOD + b * 6144 + 5120;
#pragma unroll
                for (int h = 0; h < 2; ++h) { g2v[2 * h] = *(const f32x4*)(g2 + 512 * h + 8 * lane); g2v[2 * h + 1] = *(const f32x4*)(g2 + 512 * h + 8 * lane + 4); } }
            f32x4 xv[2][4], acc[2][4];
#pragma unroll
            for (int q = 0; q < 2; ++q)
#pragma unroll
                for (int h = 0; h < 2; ++h) { const float* xp = args.in[I_X] + (size_t)(row0 + q) * 1024 + 512 * h + 8 * lane; f32x4 d0_, d1_; ld8bf((const bf16_t*)args.out + (size_t)(row0 + q) * 2048 + 1024 + 512 * h + 8 * lane, d0_, d1_);
                    xv[q][2 * h] = *(const f32x4*)xp + d0_; xv[q][2 * h + 1] = *(const f32x4*)(xp + 4) + d1_;
                    acc[q][2 * h] = (f32x4){0.f, 0.f, 0.f, 0.f}; acc[q][2 * h + 1] = (f32x4){0.f, 0.f, 0.f, 0.f}; }
#pragma unroll
            for (int q = 0; q < 2; ++q) {
                unsigned long long mask = __ballot(sl[q] >= 0);
                for (;;) {
                    const bf16_t* yr[4];
#pragma unroll
                    for (int k = 0; k < 4; ++k) {
                        if (mask) { const int ex = __builtin_ctzll(mask); mask &= mask - 1; const int s = __builtin_amdgcn_readlane(sl[q], ex); yr[k] = YB + (size_t)((ex * 8 + b) * CAP + s) * 1024; }
                        else yr[k] = ZROW;
                    }
                    u32x4 y[4][2];
#pragma unroll
                    for (int k = 0; k < 4; ++k)
#pragma unroll
                        for (int h = 0; h < 2; ++h) y[k][h] = *(const u32x4*)(yr[k] + 512 * h + 8 * lane);
#pragma unroll
                    for (int k = 0; k < 4; ++k)
#pragma unroll
                        for (int h = 0; h < 2; ++h) { const u32x4 w = y[k][h];
                            acc[q][2 * h] += (f32x4){bf2f(w.x & 0xffffu), bf2f(w.x >> 16), bf2f(w.y & 0xffffu), bf2f(w.y >> 16)};
                            acc[q][2 * h + 1] += (f32x4){bf2f(w.z & 0xffffu), bf2f(w.z >> 16), bf2f(w.w & 0xffffu), bf2f(w.w >> 16)}; }
                    if (!mask) break;
                }
            }
#pragma unroll
            for (int q = 0; q < 2; ++q) {
                float ss = 0.f;
#pragma unroll
                for (int h = 0; h < 2; ++h)
#pragma unroll
                    for (int u4 = 0; u4 < 2; ++u4) { const int col = 512 * h + 8 * lane + 4 * u4; f32x4& v = xv[q][2 * h + u4]; v = v + g2v[2 * h + u4] * acc[q][2 * h + u4]; ss += (v.x * v.x + v.y * v.y) + (v.z * v.z + v.w * v.w); }
                const float rstd = 1.0f / sqrtf(wave_sum(ss) * (1.f / 1024.f) + EPS);
#pragma unroll
                for (int h = 0; h < 2; ++h)
#pragma unroll
                    for (int u4 = 0; u4 < 2; ++u4) { const int col = 512 * h + 8 * lane + 4 * u4; *(f32x4*)(args.out + (size_t)(row0 + q) * 1024 + col) = xv[q][2 * h + u4] * rstd * fgv[2 * h + u4]; }
            }
        }
    }
#undef IN
}

extern "C" void kernel_launch(void* const* d_in, const int* in_sizes, int n_in, void* d_out, int out_size, void* d_ws, size_t ws_size, hipStream_t stream) {
    static int grid = 0;
    if (grid == 0) {
        if (n_in != 23 || in_sizes[0] != NTOK * DM || out_size != NTOK * DM || ws_size < WS_END) {
            fprintf(stderr, "kernel_launch: unexpected problem (n_in %d, in0 %d, out %d, ws %zu < %zu?)\n", n_in, n_in > 0 ? in_sizes[0] : -1, out_size, ws_size, (size_t)WS_END); grid = -1; return; }
        if (hipFuncSetAttribute((const void*)fwd, hipFuncAttributeMaxDynamicSharedMemorySize, LDS_BYTES) != hipSuccess) { fprintf(stderr, "kernel_launch: hipFuncSetAttribute failed\n"); grid = -1; return; }
        int dev = 0, cus = 0;
        if (hipGetDevice(&dev) != hipSuccess || hipDeviceGetAttribute(&cus, hipDeviceAttributeMultiprocessorCount, dev) != hipSuccess) { grid = -1; return; }
        grid = cus;
    }
    if (grid < 0) return;
    (void)hipMemsetAsync((char*)d_ws + WS_CTL, 0, 1 * MiB, stream);
    Args a{};
    for (int i = 0; i < 23; ++i) a.in[i] = (const float*)d_in[i];
    a.out = (float*)d_out; a.ws = (unsigned char*)d_ws;
    if (ONE_LAUNCH) {
        a.ph_lo = 0; a.ph_hi = PH_COUNT;
        hipLaunchKernelGGL(fwd, dim3(grid), dim3(NTHREADS), LDS_BYTES, stream, a);
    } else {
        static const int seq[] = {PROBE_SEQ};
        for (unsigned i = 0; i < sizeof(seq) / sizeof(seq[0]); ++i) {
            a.ph_lo = seq[i] % 100; a.ph_hi = seq[i] % 100 + 1; a.flags = seq[i] / 100;
            hipLaunchKernelGGL(fwd, dim3(grid), dim3(NTHREADS), LDS_BYTES, stream, a);
        }
    }
}
```

```cpp
#include <hip/hip_runtime.h>
#include <cstdio>
#include <cstdint>

#define LAS __attribute__((address_space(3)))
typedef unsigned short bf16_t;
typedef float f32x4 __attribute__((ext_vector_type(4)));
typedef float f32x2 __attribute__((ext_vector_type(2)));
typedef unsigned u32x4 __attribute__((ext_vector_type(4)));
typedef unsigned u32x2 __attribute__((ext_vector_type(2)));
typedef int i32x4 __attribute__((ext_vector_type(4)));

constexpr int DM = 1024, NB = 8, SEQ = 4096, NTOK = NB * SEQ, CTXL = 256, NCTX = NB * CTXL, NROWS_H = NTOK + NCTX;
constexpr int INCOLS = 5632, OFF_Q = 2048, OFF_K = 3072, OFF_VB = 3328, OFF_GATE = 3584;
constexpr int NE = 16, CAP = 512, DE = 2048, NPAIR = NE * NB * CAP;
constexpr float EPS = 1e-6f, LOG2E = 1.4426950408889634f, C2 = 0.125f * LOG2E;
constexpr int NTHREADS = 512, NWAVES = 8;

constexpr size_t MiB = 1u << 20;
constexpr size_t WS_CTL = 0;
constexpr size_t WS_MOD = 1 * MiB;
constexpr size_t WS_ROPE = 1 * MiB + 512 * 1024;
constexpr size_t WS_AFFT = 2 * MiB;
constexpr size_t WS_TOPI = 4 * MiB;
constexpr size_t WS_TOPW = 4 * MiB + 512 * 1024;
constexpr size_t WS_SLOT = 5 * MiB;
constexpr size_t WS_WSP = 7 * MiB;
constexpr size_t WS_WIN = 8 * MiB;
constexpr size_t WS_WAB = 19 * MiB;
constexpr size_t WS_WO = 23 * MiB;
constexpr size_t WS_R = 25 * MiB;
constexpr size_t WS_H = WS_R;
constexpr size_t WS_VA = WS_R + 68 * MiB;
constexpr size_t WS_KB = WS_VA + 64 * MiB;
constexpr size_t WS_VB = WS_KB + 17 * MiB;
constexpr size_t WS_G = WS_VB + 17 * MiB;
constexpr size_t WS_Y = WS_G + 128 * MiB;
constexpr size_t WS_TMP = WS_Y + 128 * MiB;
constexpr size_t WS_STATS = WS_TMP + 64 * MiB;
constexpr size_t WS_MERGED = WS_H;
constexpr size_t WS_WGU = WS_R;
constexpr size_t WS_WD = WS_R + 128 * MiB;
constexpr size_t WS_H2 = WS_R + 192 * MiB;
constexpr size_t WS_ACT = WS_R + 256 * MiB;
constexpr size_t WS_YB = WS_WGU;
constexpr size_t WS_END = 537 * MiB;
static_assert(WS_STATS + 4 * MiB <= WS_END && WS_ACT + 256 * MiB == WS_END, "ws map");

constexpr int LDS_BYTES = 147456;

__device__ __forceinline__ float bf2f(unsigned b) { return __uint_as_float(b << 16); }
__device__ __forceinline__ unsigned f2bf(float f) { unsigned u = __float_as_uint(f); return (u + 0x7fffu + ((u >> 16) & 1u)) >> 16; }
__device__ __forceinline__ unsigned pk2(float lo, float hi) { typedef float f2_ __attribute__((ext_vector_type(2))); typedef __bf16 b2_ __attribute__((ext_vector_type(2))); f2_ v = {lo, hi}; b2_ b = __builtin_convertvector(v, b2_); return __builtin_bit_cast(unsigned, b); }
__device__ __forceinline__ void st4bf(bf16_t* p, f32x4 v) { u32x2 w; w.x = pk2(v.x, v.y); w.y = pk2(v.z, v.w); *(u32x2*)p = w; }
__device__ __forceinline__ void st8bf(bf16_t* p, f32x4 a, f32x4 b) { u32x4 w; w.x = pk2(a.x, a.y); w.y = pk2(a.z, a.w); w.z = pk2(b.x, b.y); w.w = pk2(b.z, b.w); *(u32x4*)p = w; }
__device__ __forceinline__ void ld8bf(const bf16_t* p, f32x4& a, f32x4& b) { const u32x4 w = *(const u32x4*)p; a.x = bf2f(w.x & 0xffffu); a.y = bf2f(w.x >> 16); a.z = bf2f(w.y & 0xffffu); a.w = bf2f(w.y >> 16); b.x = bf2f(w.z & 0xffffu); b.y = bf2f(w.z >> 16); b.z = bf2f(w.w & 0xffffu); b.w = bf2f(w.w >> 16); }
__device__ __forceinline__ f32x4 ld4bf(const bf16_t* p) { const u32x2 w = *(const u32x2*)p; f32x4 v; v.x = bf2f(w.x & 0xffffu); v.y = bf2f(w.x >> 16); v.z = bf2f(w.y & 0xffffu); v.w = bf2f(w.y >> 16); return v; }
__device__ __forceinline__ float sigmoidf_(float x) { return __builtin_amdgcn_rcpf(1.f + __builtin_amdgcn_exp2f(x * -1.4426950409f)); }
__device__ __forceinline__ float siluf_(float x) { return x * __builtin_amdgcn_rcpf(1.f + __builtin_amdgcn_exp2f(x * -1.4426950409f)); }
__device__ __forceinline__ float gelu_t(float x) { const float t = x * __builtin_fmaf(x * x, -0.10294324f, -2.3022082f); return x * __builtin_amdgcn_rcpf(1.f + __builtin_amdgcn_exp2f(t)); }
__device__ __forceinline__ f32x2 rcp2_(f32x2 d) { f32x2 r; r.x = __builtin_amdgcn_rcpf(d.x); r.y = __builtin_amdgcn_rcpf(d.y); return r; }
__device__ __forceinline__ f32x2 exp2_2_(f32x2 t) { f32x2 e; e.x = __builtin_amdgcn_exp2f(t.x); e.y = __builtin_amdgcn_exp2f(t.y); return e; }
__device__ __forceinline__ f32x2 gelu2_(f32x2 x) { const f32x2 t = x * ((x * x) * -0.10294324f + -2.3022082f); return x * rcp2_(exp2_2_(t) + 1.0f); }
__device__ __forceinline__ f32x2 sigm2_(f32x2 x) { return rcp2_(exp2_2_(x * -1.4426950409f) + 1.0f); }
__device__ __forceinline__ f32x4 gelu4_(f32x4 v) { const f32x2 a = gelu2_((f32x2){v.x, v.y}), b = gelu2_((f32x2){v.z, v.w}); return (f32x4){a.x, a.y, b.x, b.y}; }
__device__ __forceinline__ f32x4 sigm4_(f32x4 v) { const f32x2 a = sigm2_((f32x2){v.x, v.y}), b = sigm2_((f32x2){v.z, v.w}); return (f32x4){a.x, a.y, b.x, b.y}; }
template <int CTRL> __device__ __forceinline__ float dpp_f(float v) { const int i = __builtin_bit_cast(int, v); return __builtin_bit_cast(float, __builtin_amdgcn_update_dpp(i, i, CTRL, 0xf, 0xf, true)); }
__device__ __forceinline__ float xchg16(float v) { auto r = __builtin_amdgcn_permlane16_swap(__float_as_uint(v), __float_as_uint(v), false, false); return __uint_as_float((threadIdx.x & 16) ? r[0] : r[1]); }
__device__ __forceinline__ float xchg32(float v) { auto r = __builtin_amdgcn_permlane32_swap(__float_as_uint(v), __float_as_uint(v), false, false); return __uint_as_float((threadIdx.x & 32) ? r[0] : r[1]); }
__device__ __forceinline__ float wave_sum(float v) {
    v += dpp_f<0xB1>(v); v += dpp_f<0x4E>(v); v += dpp_f<0x141>(v); v += dpp_f<0x140>(v); v += xchg16(v); v += xchg32(v);
    return v;
}
__device__ __forceinline__ int wave_sum_i(int v) {
#pragma unroll
    for (int o = 1; o < 64; o <<= 1) v += __shfl_xor(v, o);
    return v;
}
#define LDS_WAIT() asm volatile("s_waitcnt lgkmcnt(0)" ::: "memory")

struct Args { const float* in[23]; float* out; unsigned char* ws; int ph_lo, ph_hi, flags, pad; };
enum { I_X = 0, I_C, I_CTX, I_CCTX, I_WADA, I_BADA, I_N1G, I_WIN, I_BMG, I_LNG, I_LNB, I_WSP, I_BSP, I_SINK, I_WPA, I_WPB, I_WOUT, I_N2G, I_WR, I_WEG, I_WEU, I_WED, I_FING };

struct Unit { int pm, pn; };
struct Gemm {
    const bf16_t* A; const bf16_t* Bt; int lda, ldb, K;
    size_t bgs; int tpg_shift;
    const int* gidx;
};
constexpr int NXCD = 8, WGM = 8;
struct StaticOrder {
    int nM, nN, nwg, G, c, extra, rev;
    __device__ void init(int M, int N, int G_, int c_, int extra_ = 0, int rev_ = 0) { nM = M / 256; nN = N / 256; nwg = nM * nN; G = G_; c = c_; extra = extra_; rev = rev_; }
    __device__ bool next(int i, Unit& u) const {
        const long L = (long)i * G + c;
        if (L >= nwg) { const int x = (int)(L - nwg); if (x >= extra) return false; u.pm = NTOK / 256 + (x >> 1); u.pn = 12 + (x & 1); return true; }
        int wgid = (int)L; { const int q = nwg / NXCD, r = nwg % NXCD, xcd = wgid % NXCD, off = wgid / NXCD; wgid = (xcd < r ? xcd * (q + 1) : r * (q + 1) + (xcd - r) * q) + off; }
        const int nig = WGM * nN, gid = wgid / nig, fm = gid * WGM, gsz = (nM - fm) < WGM ? (nM - fm) : WGM;
        u.pm = fm + ((wgid % nig) % gsz); u.pn = (wgid % nig) / gsz; if (rev) u.pm = nM - 1 - u.pm; return true;
    }
};

struct OneUnit { int pm, pn; __device__ bool next(int i, Unit& u) const { if (i) return false; u.pm = pm; u.pn = pn; return true; } };

typedef f32x4 Acc[2][2][4][2];

namespace pg8 {
typedef short bf16x8 __attribute__((ext_vector_type(8)));
constexpr int BK = 64, HALF = 128, HTB = HALF * BK * 2, STAGE_BYTES = 8 * HTB;
__device__ __forceinline__ int lds_byte(int r, int c) { const int st = (r >> 4) * 2 + (c >> 5), rr = r & 15, cc = c & 31, ob = rr * 64 + cc * 2; return st * 1024 + (ob ^ (((ob >> 9) & 1) << 5)); }
__device__ __forceinline__ void stage_rc(int b, int& R, int& C) { const int st = b / 1024, sb = b % 1024, swz = sb ^ (((sb >> 9) & 1) << 5); R = (st >> 1) * 16 + swz / 64; C = (st & 1) * 32 + (swz % 64) / 2; }

template <class Epi, class Sched, bool GATHER, bool HOOK = false, bool RELAX = false>
__device__ __forceinline__ void gemm_phase(LAS unsigned char* lds, const Gemm g, const Sched& S, const Epi& E) {
    const int tid = threadIdx.x, wid = __builtin_amdgcn_readfirstlane(tid >> 6), lane = tid & 63, wr = wid >> 2, wc = wid & 3, fr = lane & 15, fq = lane >> 4;
    const int nt = g.K / BK;
    int Rs[2], Cs[2]; unsigned voffBp[2][2], voffB[2], voffBn[2], vA[2][2], vN[2][2];
#pragma unroll
    for (int i = 0; i < 2; ++i) { stage_rc(tid * 16 + i * 8192, Rs[i], Cs[i]); voffBp[0][i] = (unsigned)(Rs[i] * g.ldb + Cs[i]) * 2u;
        const int rho = Rs[i] & 31, Rb = (Rs[i] & ~31) + 8 * ((rho & 15) >> 2) + 4 * (rho >> 4) + (rho & 3); voffBp[1][i] = (unsigned)(Rb * g.ldb + Cs[i]) * 2u; }
    const size_t kstep = (size_t)(BK * 2);
    const size_t hstepB = (size_t)HALF * g.ldb * 2;
    const unsigned ldsw = (unsigned)wid * 1024u;
    const int aoff = lds_byte(wr * 64 + fr, fq * 8), boff = lds_byte(wc * 32 + fr, fq * 8);
#define PG8_SA(b, h) (((b) * 2 + (h)) * HTB)
#define PG8_SB(b, h) ((4 + (b) * 2 + (h)) * HTB)
#define PG8_STAGE(bufoff, gbase, voff) do { _Pragma("unroll") for (int _i = 0; _i < 2; ++_i) \
        __builtin_amdgcn_global_load_lds((const unsigned*)((const char*)(gbase) + (voff)[_i]), (LAS unsigned*)(lds + (bufoff) + ldsw + _i * 8192), 16, 0, 0); } while (0)
#define PG8_LDA(dst, b, h) do { _Pragma("unroll") for (int m = 0; m < 4; ++m) _Pragma("unroll") for (int k = 0; k < 2; ++k) dst[m][k] = *(const LAS bf16x8*)(lds + PG8_SA(b, h) + aoff + m * 2048 + k * 1024); } while (0)
#define PG8_LDB(dst, b, h) do { _Pragma("unroll") for (int n = 0; n < 2; ++n) _Pragma("unroll") for (int k = 0; k < 2; ++k) dst[n][k] = *(const LAS bf16x8*)(lds + PG8_SB(b, h) + boff + n * 2048 + k * 1024); } while (0)
#define PG8_MMA(ai, bj, At, Bt) do { __builtin_amdgcn_s_setprio(1); _Pragma("unroll") for (int m = 0; m < 4; ++m) _Pragma("unroll") for (int n = 0; n < 2; ++n) _Pragma("unroll") for (int k = 0; k < 2; ++k) \
        acc[ai][bj][m][n] = __builtin_amdgcn_mfma_f32_16x16x32_bf16(Bt[n][k], At[m][k], acc[ai][bj][m][n], 0, 0, 0); __builtin_amdgcn_s_setprio(0); } while (0)
#define PG8_WAIT_V(n) asm volatile("s_waitcnt vmcnt(" #n ")" ::: "memory")
#define PG8_WAIT_L(n) asm volatile("s_waitcnt lgkmcnt(" #n ")" ::: "memory")
#define PG8_BAR __builtin_amdgcn_s_barrier()
#define PG8_SCHED __builtin_amdgcn_sched_barrier(0)
#define PG8_AVOFF(dst, U) do { _Pragma("unroll") for (int _h = 0; _h < 2; ++_h) _Pragma("unroll") for (int _i = 0; _i < 2; ++_i) \
        dst[_h][_i] = GATHER ? (unsigned)((((U).pm >> 1) & 7) * SEQ + g.gidx[(U).pm * 256 + _h * 128 + Rs[_i]]) * (unsigned)(g.lda * 2) + (unsigned)(Cs[_i] * 2) \
                             : (unsigned)((_h * 128 + Rs[_i]) * g.lda + Cs[_i]) * 2u; } while (0)
#define PG8_ABASE(U) ((const char*)g.A + (GATHER ? (size_t)0 : (size_t)(U).pm * 256 * g.lda * 2))
#define PG8_BBASE(U) ((const char*)g.Bt + ((size_t)((U).pm >> g.tpg_shift) * g.bgs + (size_t)(U).pn * 256 * g.ldb) * 2)
    Unit cur, nxt; int ui = 0;
    if (!S.next(0, cur)) return;
    Acc acc;
#pragma unroll
    for (int a = 0; a < 2; ++a)
#pragma unroll
        for (int b = 0; b < 2; ++b)
#pragma unroll
            for (int m = 0; m < 4; ++m)
#pragma unroll
                for (int n = 0; n < 2; ++n) acc[a][b][m][n] = (f32x4){0.f, 0.f, 0.f, 0.f};
    bf16x8 At[4][2], B0[2][2], B1[2][2];
    PG8_AVOFF(vA, cur);
    { const bool pc = E.perm(cur); voffB[0] = pc ? voffBp[1][0] : voffBp[0][0]; voffB[1] = pc ? voffBp[1][1] : voffBp[0][1]; }
    const char* cA = PG8_ABASE(cur); const char* cB = PG8_BBASE(cur);
    PG8_STAGE(PG8_SB(0, 0), cB, voffB); PG8_STAGE(PG8_SB(0, 1), cB + hstepB, voffB); PG8_STAGE(PG8_SA(0, 0), cA, vA[0]); PG8_STAGE(PG8_SA(0, 1), cA, vA[1]);
    if (wr == 1) PG8_BAR;
    PG8_WAIT_V(2); PG8_BAR;
    PG8_STAGE(PG8_SB(1, 0), cB + kstep, voffB); PG8_STAGE(PG8_SA(1, 0), cA + kstep, vA[0]); PG8_STAGE(PG8_SB(1, 1), cB + hstepB + kstep, voffB);
    if constexpr (RELAX) { PG8_WAIT_V(0); } else { PG8_WAIT_V(6); } PG8_BAR;
    for (;;) {
        const bool has_next = S.next(ui + 1, nxt);
        const char* nA = has_next ? PG8_ABASE(nxt) : cA; const char* nB = has_next ? PG8_BBASE(nxt) : cB;
        { const bool pn_ = has_next ? E.perm(nxt) : E.perm(cur); voffBn[0] = pn_ ? voffBp[1][0] : voffBp[0][0]; voffBn[1] = pn_ ? voffBp[1][1] : voffBp[0][1]; }
        if (GATHER) {
#pragma unroll
            for (int h = 0; h < 2; ++h)
#pragma unroll
                for (int i = 0; i < 2; ++i) vN[h][i] = vA[h][i];
            if (has_next && wid == 0)
                __builtin_amdgcn_global_load_lds((const unsigned*)(g.gidx + nxt.pm * 256 + lane * 4), (LAS unsigned*)(lds + STAGE_BYTES + (ui & 1) * 1024), 16, 0, 0);
        }
        if constexpr (RELAX) {
#define PG8_WAIT_RELAX asm volatile("s_waitcnt vmcnt(%0)" :: "n"(8 + Epi::kStores) : "memory")
            const char* a1 = cA + kstep; const char* a2 = cA + 2 * kstep; const char* b2 = cB + 2 * kstep; const char* a3 = a2 + kstep; const char* b3 = b2 + kstep;
            PG8_LDB(B0, 0, 0); PG8_LDB(B1, 0, 1); PG8_SCHED; PG8_LDA(At, 0, 0); PG8_STAGE(PG8_SA(1, 1), a1, vA[1]);
            PG8_WAIT_RELAX; PG8_WAIT_L(0); PG8_BAR; PG8_MMA(0, 0, At, B0); PG8_MMA(0, 1, At, B1); PG8_BAR; PG8_SCHED;
            PG8_LDA(At, 0, 1); PG8_STAGE(PG8_SB(0, 0), b2, voffB); PG8_STAGE(PG8_SB(0, 1), b2 + hstepB, voffB); PG8_STAGE(PG8_SA(0, 0), a2, vA[0]);
            PG8_WAIT_RELAX; PG8_WAIT_L(0); PG8_BAR; PG8_MMA(1, 0, At, B0); PG8_MMA(1, 1, At, B1); PG8_BAR; PG8_SCHED;
            PG8_LDB(B0, 1, 0); PG8_LDB(B1, 1, 1); PG8_SCHED; PG8_LDA(At, 1, 0); PG8_STAGE(PG8_SA(0, 1), a2, vA[1]);
            PG8_WAIT_V(8); PG8_WAIT_L(0); PG8_BAR; PG8_MMA(0, 0, At, B0); PG8_MMA(0, 1, At, B1); PG8_BAR; PG8_SCHED;
            PG8_LDA(At, 1, 1); PG8_STAGE(PG8_SB(1, 0), b3, voffB); PG8_STAGE(PG8_SB(1, 1), b3 + hstepB, voffB); PG8_STAGE(PG8_SA(1, 0), a3, vA[0]);
            PG8_WAIT_V(8); PG8_WAIT_L(0); PG8_BAR; PG8_MMA(1, 0, At, B0); PG8_MMA(1, 1, At, B1); PG8_BAR; PG8_SCHED;
#undef PG8_WAIT_RELAX
        }
        for (int t = RELAX ? 2 : 0; t < nt; t += 2) {
            const bool last = (t == nt - 2);
            if (GATHER) { if (t == 4 && has_next) {
                const LAS int* li = (const LAS int*)(lds + STAGE_BYTES + (ui & 1) * 1024);
#pragma unroll
                for (int h = 0; h < 2; ++h)
#pragma unroll
                    for (int i = 0; i < 2; ++i) vN[h][i] = (unsigned)(((nxt.pm >> 1) & 7) * SEQ + li[h * 128 + Rs[i]]) * (unsigned)(g.lda * 2) + (unsigned)(Cs[i] * 2);
            } }
            if constexpr (HOOK) { if (t == (nt >> 1)) E.mid(acc, cur, wr, wc, fr, fq); }
            const char* a1 = cA + (size_t)(t + 1) * kstep;
            const char* a2 = last ? nA : cA + (size_t)(t + 2) * kstep; const char* b2 = last ? nB : cB + (size_t)(t + 2) * kstep;
            const char* a3 = a2 + kstep; const char* b3 = b2 + kstep;
            unsigned v2[2][2];
#pragma unroll
            for (int h = 0; h < 2; ++h)
#pragma unroll
                for (int i = 0; i < 2; ++i) v2[h][i] = (GATHER && last) ? vN[h][i] : vA[h][i];
            unsigned vb2[2]; vb2[0] = last ? voffBn[0] : voffB[0]; vb2[1] = last ? voffBn[1] : voffB[1];
            PG8_LDB(B0, 0, 0); PG8_LDB(B1, 0, 1); PG8_SCHED; PG8_LDA(At, 0, 0); PG8_STAGE(PG8_SA(1, 1), a1, vA[1]);
            PG8_WAIT_V(8); PG8_WAIT_L(0); PG8_BAR; PG8_MMA(0, 0, At, B0); PG8_MMA(0, 1, At, B1); PG8_BAR; PG8_SCHED;
            PG8_LDA(At, 0, 1); PG8_STAGE(PG8_SB(0, 0), b2, vb2); PG8_STAGE(PG8_SB(0, 1), b2 + hstepB, vb2); PG8_STAGE(PG8_SA(0, 0), a2, v2[0]);
            PG8_WAIT_V(8); PG8_WAIT_L(0); PG8_BAR; PG8_MMA(1, 0, At, B0); PG8_MMA(1, 1, At, B1); PG8_BAR; PG8_SCHED;
            PG8_LDB(B0, 1, 0); PG8_LDB(B1, 1, 1); PG8_SCHED; PG8_LDA(At, 1, 0); PG8_STAGE(PG8_SA(0, 1), a2, v2[1]);
            PG8_WAIT_V(8); PG8_WAIT_L(0); PG8_BAR; PG8_MMA(0, 0, At, B0); PG8_MMA(0, 1, At, B1); PG8_BAR; PG8_SCHED;
            PG8_LDA(At, 1, 1); PG8_STAGE(PG8_SB(1, 0), b3, vb2); PG8_STAGE(PG8_SB(1, 1), b3 + hstepB, vb2); PG8_STAGE(PG8_SA(1, 0), a3, v2[0]);
            PG8_WAIT_V(8); PG8_WAIT_L(0); PG8_BAR; PG8_MMA(1, 0, At, B0); PG8_MMA(1, 1, At, B1); PG8_BAR; PG8_SCHED;
        }
        if (wr == 0) PG8_BAR;
        E(acc, cur, wr, wc, fr, fq);
        if (!has_next) break;
#pragma unroll
        for (int a = 0; a < 2; ++a)
#pragma unroll
            for (int b = 0; b < 2; ++b)
#pragma unroll
                for (int m = 0; m < 4; ++m)
#pragma unroll
                    for (int n = 0; n < 2; ++n) acc[a][b][m][n] = (f32x4){0.f, 0.f, 0.f, 0.f};
        cur = nxt; cA = nA; cB = nB; ++ui; voffB[0] = voffBn[0]; voffB[1] = voffBn[1];
        if (GATHER) {
#pragma unroll
            for (int h = 0; h < 2; ++h)
#pragma unroll
                for (int i = 0; i < 2; ++i) vA[h][i] = vN[h][i];
        }
        if (wr == 1) PG8_BAR;
    }
    PG8_WAIT_V(0);
    PG8_BAR;
#undef PG8_SA
#undef PG8_SB
#undef PG8_STAGE
#undef PG8_LDA
#undef PG8_LDB
#undef PG8_MMA
#undef PG8_WAIT_V
#undef PG8_WAIT_L
#undef PG8_BAR
#undef PG8_SCHED
#undef PG8_AVOFF
#undef PG8_ABASE
#undef PG8_BBASE
}
}

#define GEMM_PHASE pg8::gemm_phase

struct EpiIn {
    bf16_t *Y, *VA, *KB, *VB, *G; const float* bgate; const f32x2* rope; f32x2* STATS;
    static constexpr int kStores = 16;
    __device__ __forceinline__ bool perm(const Unit& u) const { return u.pn < 8 || u.pn > 12; }
    template <int KIND> __device__ __forceinline__ void run(const Acc& acc, const Unit& u, int wr, int wc, int fr, int fq) const {
        const int pn = u.pn;
#pragma unroll
        for (int ai = 0; ai < 2; ++ai)
#pragma unroll
            for (int m = 0; m < 4; ++m) {
                const int row = u.pm * 256 + ai * 128 + wr * 64 + m * 16 + fr;
                float ssum = 0.f, ssq = 0.f;
#pragma unroll
                for (int bj = 0; bj < 2; ++bj) {
                    f32x4 v0 = acc[ai][bj][m][0], v1 = acc[ai][bj][m][1];
                    if constexpr (KIND == 0 || KIND == 1) {
                        const int c8 = bj * 128 + wc * 32 + 8 * fq;
                        v0 = gelu4_(v0); v1 = gelu4_(v1);
                        if constexpr (KIND == 0) st8bf(Y + (size_t)row * 2048 + pn * 256 + c8, v0, v1);
                        else {
                            st8bf(VA + (size_t)row * 1024 + (pn - 4) * 256 + c8, v0, v1);
                            ssum += ((v0.x + v0.y) + (v0.z + v0.w)) + ((v1.x + v1.y) + (v1.z + v1.w));
                            ssq += ((v0.x * v0.x + v0.y * v0.y) + (v0.z * v0.z + v0.w * v0.w)) + ((v1.x * v1.x + v1.y * v1.y) + (v1.z * v1.z + v1.w * v1.w));
                        }
                    } else if constexpr (KIND == 2) {
                        const int cl = bj * 128 + wc * 32 + 4 * fq;
                        f32x4 o0 = v0, o1 = v1;
                        if (row < NTOK) {
                            const int t = row & (SEQ - 1), pos = (wc & 1) ? (t & 63) : (t >> 6);
                            const f32x2* rp = rope + pos * 16 + 4 * fq;
#pragma unroll
                            for (int j = 0; j < 4; ++j) { const f32x2 cs = rp[j]; o0[j] = v0[j] * cs.x - v1[j] * cs.y; o1[j] = v0[j] * cs.y + v1[j] * cs.x; }
                        }
                        if (pn < 12) { bf16_t* p = Y + (size_t)row * 2048 + 1024 + (pn - 8) * 256 + cl; st4bf(p, o0 * C2); st4bf(p + 16, o1 * C2); }
                        else { bf16_t* p = KB + (size_t)row * 256 + cl; st4bf(p, o0); st4bf(p + 16, o1); }
                    } else if constexpr (KIND == 3) {
                        st8bf(VB + (size_t)row * 256 + bj * 128 + wc * 32 + 8 * fq, v0, v1);
                    } else {
                        if (bj == 0) {
                            const int ch = (pn - 14) * 128 + wc * 32 + 8 * fq;
                            const f32x4 a0 = sigm4_(v0 + *(const f32x4*)(bgate + ch)), a1 = sigm4_(v1 + *(const f32x4*)(bgate + ch + 4));
                            const f32x4 g0 = sigm4_(acc[ai][1][m][0] + *(const f32x4*)(bgate + 1024 + ch)), g1 = sigm4_(acc[ai][1][m][1] + *(const f32x4*)(bgate + 1024 + ch + 4));
                            f32x4 r0, r1;
#pragma unroll
                            for (int j = 0; j < 4; ++j) { r0[j] = a0[j] * __builtin_amdgcn_rcpf(g0[j]); r1[j] = a1[j] * __builtin_amdgcn_rcpf(g1[j]); }
                            st8bf(G + (size_t)row * 2048 + ch, r0, r1); st8bf(G + (size_t)row * 2048 + 1024 + ch, g0, g1);
                        }
                    }
                }
                if constexpr (KIND == 1) {
                    ssum += xchg16(ssum); ssum += xchg32(ssum); ssq += xchg16(ssq); ssq += xchg32(ssq);
                    if (fq == 0) STATS[(size_t)row * 16 + (pn - 4) * 4 + wc] = (f32x2){ssum, ssq};
                }
            }
    }
    __device__ __forceinline__ void operator()(const Acc& acc, const Unit& u, int wr, int wc, int fr, int fq) const {
        const int pn = u.pn;
        if (pn < 4) run<0>(acc, u, wr, wc, fr, fq);
        else if (pn < 8) run<1>(acc, u, wr, wc, fr, fq);
        else if (pn < 13) run<2>(acc, u, wr, wc, fr, fq);
        else if (pn == 13) run<3>(acc, u, wr, wc, fr, fq);
        else run<4>(acc, u, wr, wc, fr, fq);
    }
};
struct EpiAB {
    bf16_t* MERGED; const bf16_t* G;
    static constexpr int kStores = 16;
    __device__ __forceinline__ bool perm(const Unit&) const { return true; }
    __device__ __forceinline__ void mid(Acc& acc, const Unit& u, int wr, int wc, int fr, int fq) const {
        int zero; asm volatile("v_mov_b32 %0, 0" : "=v"(zero));
        const bf16_t* gp = G + (size_t)(u.pm * 256 + wr * 64 + fr + zero) * 2048 + u.pn * 256 + wc * 32 + 8 * fq;
#pragma unroll
        for (int ai = 0; ai < 2; ++ai)
#pragma unroll
            for (int m = 0; m < 4; ++m) {
#pragma unroll
                for (int bj = 0; bj < 2; ++bj) {
                    const bf16_t* q = gp + (size_t)(ai * 128 + m * 16) * 2048 + bj * 128;
                    f32x4 r0, r1; ld8bf(q, r0, r1);
                    acc[ai][bj][m][0] *= r0; acc[ai][bj][m][1] *= r1;
                    asm volatile("" ::: "memory");
                }
            }
    }
    __device__ __forceinline__ void operator()(const Acc& acc, const Unit& u, int wr, int wc, int fr, int fq) const {
#pragma unroll
        for (int ai = 0; ai < 2; ++ai)
#pragma unroll
            for (int m = 0; m < 4; ++m) {
                const int row = u.pm * 256 + ai * 128 + wr * 64 + m * 16 + fr;
#pragma unroll
                for (int bj = 0; bj < 2; ++bj) {
                    const int c8 = u.pn * 256 + bj * 128 + wc * 32 + 8 * fq;
                    f32x4 gb0, gb1; ld8bf(G + (size_t)row * 2048 + 1024 + c8, gb0, gb1);
                    st8bf(MERGED + (size_t)row * 1024 + c8, gb0 * acc[ai][bj][m][0], gb1 * acc[ai][bj][m][1]);
                }
            }
    }
};
struct EpiO {
    bf16_t* D16; const float* mod;
    static constexpr int kStores = 16;
    __device__ __forceinline__ bool perm(const Unit&) const { return true; }
    __device__ __forceinline__ void operator()(const Acc& acc, const Unit& u, int wr, int wc, int fr, int fq) const {
        const float* g1 = mod + (size_t)((u.pm * 256) >> 12) * 6144 + 2048;
#pragma unroll
        for (int bj = 0; bj < 2; ++bj) {
            const int c8 = u.pn * 256 + bj * 128 + wc * 32 + 8 * fq;
            const f32x4 ga = *(const f32x4*)(g1 + c8), gb = *(const f32x4*)(g1 + c8 + 4);
#pragma unroll
            for (int ai = 0; ai < 2; ++ai)
#pragma unroll
                for (int m = 0; m < 4; ++m) {
                    const int row = u.pm * 256 + ai * 128 + wr * 64 + m * 16 + fr;
                    st8bf(D16 + (size_t)row * 2048 + 1024 + c8, ga * acc[ai][bj][m][0], gb * acc[ai][bj][m][1]);
                }
        }
    }
};
struct EpiGU {
    bf16_t* ACT;
    static constexpr int kStores = 8;
    __device__ __forceinline__ bool perm(const Unit&) const { return true; }
    __device__ __forceinline__ void operator()(const Acc& acc, const Unit& u, int wr, int wc, int fr, int fq) const {
#pragma unroll
        for (int ai = 0; ai < 2; ++ai)
#pragma unroll
            for (int m = 0; m < 4; ++m) {
                const int prow = u.pm * 256 + ai * 128 + wr * 64 + m * 16 + fr;
                f32x4 a[2];
#pragma unroll
                for (int n = 0; n < 2; ++n) {
                    const f32x4 gt = acc[ai][0][m][n], up = acc[ai][1][m][n];
                    a[n] = gt * sigm4_(gt) * up;
                }
                st8bf(ACT + (size_t)prow * 2048 + u.pn * 128 + wc * 32 + 8 * fq, a[0], a[1]);
            }
    }
};
struct EpiD {
    bf16_t* YB; const float* TOPW;
    static constexpr int kStores = 16;
    __device__ __forceinline__ bool perm(const Unit&) const { return true; }
    __device__ __forceinline__ void operator()(const Acc& acc, const Unit& u, int wr, int wc, int fr, int fq) const {
#pragma unroll
        for (int ai = 0; ai < 2; ++ai)
#pragma unroll
            for (int m = 0; m < 4; ++m) {
                const int prow = u.pm * 256 + ai * 128 + wr * 64 + m * 16 + fr; const float w = TOPW[prow];
#pragma unroll
                for (int bj = 0; bj < 2; ++bj)
                    st8bf(YB + (size_t)prow * 1024 + u.pn * 256 + bj * 128 + wc * 32 + 8 * fq, acc[ai][bj][m][0] * w, acc[ai][bj][m][1] * w);
            }
    }
};

__device__ __forceinline__ void transpose_item(const float* W, int N, int k0, int n0, bf16_t* dst, int ldt, LAS float* scr, int lane) {
    const int kk = lane >> 3, nq = (lane & 7) * 4;
    f32x4 v[8];
#pragma unroll
    for (int i = 0; i < 8; ++i) v[i] = *(const f32x4*)(W + (size_t)(k0 + 8 * i + kk) * N + n0 + nq);
#pragma unroll
    for (int i = 0; i < 8; ++i) { LAS float* s = scr + (8 * i + kk) * 33 + nq; s[0] = v[i].x; s[1] = v[i].y; s[2] = v[i].z; s[3] = v[i].w; }
    LDS_WAIT();
    const int c = lane & 7;
#pragma unroll
    for (int j = 0; j < 4; ++j) {
        const int n = (lane >> 3) + 8 * j; const LAS float* s = scr + (8 * c) * 33 + n;
        u32x4 o; o.x = pk2(s[0 * 33], s[1 * 33]); o.y = pk2(s[2 * 33], s[3 * 33]); o.z = pk2(s[4 * 33], s[5 * 33]); o.w = pk2(s[6 * 33], s[7 * 33]);
        *(u32x4*)(dst + (size_t)n * ldt + 8 * c) = o;
    }
    LDS_WAIT();
}

struct TrItem { const float* src; bf16_t* dst; int N, ldt; };
__device__ __forceinline__ void tr_load(const TrItem& it, f32x4 (&v)[8], int lane) {
    const int kk = lane >> 3, nq = (lane & 7) * 4;
#pragma unroll
    for (int i = 0; i < 8; ++i) v[i] = *(const f32x4*)(it.src + (size_t)(8 * i + kk) * it.N + nq);
}
__device__ __forceinline__ void tr_store(const TrItem& it, const f32x4 (&v)[8], LAS float* scr, int lane) {
    const int kk = lane >> 3, nq = (lane & 7) * 4;
#pragma unroll
    for (int i = 0; i < 8; ++i) { LAS float* s = scr + (8 * i + kk) * 33 + nq; s[0] = v[i].x; s[1] = v[i].y; s[2] = v[i].z; s[3] = v[i].w; }
    LDS_WAIT();
    const int c = lane & 7;
#pragma unroll
    for (int j = 0; j < 4; ++j) {
        const int n = (lane >> 3) + 8 * j; const LAS float* s = scr + (8 * c) * 33 + n;
        u32x4 o; o.x = pk2(s[0 * 33], s[1 * 33]); o.y = pk2(s[2 * 33], s[3 * 33]); o.z = pk2(s[4 * 33], s[5 * 33]); o.w = pk2(s[6 * 33], s[7 * 33]);
        *(u32x4*)(it.dst + (size_t)n * it.ldt + 8 * c) = o;
    }
    LDS_WAIT();
}

__device__ __forceinline__ void adaln_task(int task, const float* c, const float* cctx, const float* w_ada, const float* b_ada, float* mod, LAS float* lds, int tid) {
    LAS float* s = lds; LAS float* red = lds + 9 * 1024;
    { float cv[18];
#pragma unroll
      for (int q = 0; q < 18; ++q) { const int i = tid + NTHREADS * q, r = i >> 10, k = i & 1023; cv[q] = r < 8 ? c[r * 1024 + k] : cctx[k]; }
#pragma unroll
      for (int q = 0; q < 18; ++q) s[tid + NTHREADS * q] = cv[q] * __builtin_amdgcn_rcpf(1.f + __expf(-cv[q])); }
    __syncthreads();
    const int ch = tid & 7, kr = tid >> 3;
    f32x4 acc[9];
#pragma unroll
    for (int r = 0; r < 9; ++r) acc[r] = (f32x4){0.f, 0.f, 0.f, 0.f};
    const float* wp = w_ada + (size_t)kr * 6144 + task * 32 + ch * 4;
    for (int it = 0; it < 16; ++it) {
        const f32x4 w = *(const f32x4*)(wp + (size_t)it * 64 * 6144); const int k = kr + it * 64;
#pragma unroll
        for (int r = 0; r < 9; ++r) acc[r] += s[r * 1024 + k] * w;
    }
#pragma unroll
    for (int r = 0; r < 9; ++r) *(LAS f32x4*)(red + (kr * 9 + r) * 32 + ch * 4) = acc[r];
    __syncthreads();
    if (tid < 288) { const int r = tid >> 5, col = tid & 31; float sum = 0.f; for (int q = 0; q < 64; ++q) sum += red[(q * 9 + r) * 32 + col]; mod[r * 6144 + task * 32 + col] = sum + b_ada[task * 32 + col]; }
    __syncthreads();
}

__device__ __forceinline__ void rope_table(f32x2* tab, int tid) {
    for (int idx = tid; idx < 1024; idx += NTHREADS) {
        const int pos = idx >> 4, i = idx & 15;
        double f = 1.0;
        for (int q = 0; q < i; ++q) f *= 0.56234132519034908;
        const float ang = (float)pos * (float)f;
        const double a = (double)ang, k = __builtin_rint(a * 0.15915494309189535), r = a - k * 6.283185307179586476925, r2 = r * r;
        double sn = r, ts = r, cs = 1.0, tc = 1.0;
        for (int n = 1; n <= 14; ++n) {
            tc *= -r2 / (double)((2 * n - 1) * (2 * n)); cs += tc;
            ts *= -r2 / (double)((2 * n) * (2 * n + 1)); sn += ts;
        }
        tab[idx] = (f32x2){(float)cs, (float)sn};
    }
}

__device__ __forceinline__ unsigned char* lds_raw_ptr(LAS unsigned char* p) { return (unsigned char*)p; }
namespace mix {
typedef short bf16x8 __attribute__((ext_vector_type(8)));
typedef short s16x4 __attribute__((ext_vector_type(4)));
typedef float f32x16 __attribute__((ext_vector_type(16)));
typedef __attribute__((address_space(3))) const char* lds_cptr;
__device__ __forceinline__ int crow(int r, int hi) { return (r & 3) + 8 * (r >> 2) + 4 * hi; }
__device__ __forceinline__ unsigned cvtpk(float lo, float hi) { typedef float f2 __attribute__((ext_vector_type(2))); typedef __bf16 b2 __attribute__((ext_vector_type(2))); f2 v = {lo, hi}; b2 b = __builtin_convertvector(v, b2); return __builtin_bit_cast(unsigned, b); }
__device__ __forceinline__ s16x4 vtr(lds_cptr p) { return __builtin_bit_cast(s16x4, __builtin_amdgcn_ds_read_tr16_b64_v4i16((__attribute__((address_space(3))) s16x4*)p)); }
__device__ __forceinline__ bf16x8 pk8(s16x4 lo, s16x4 hi) { return (bf16x8){lo[0], lo[1], lo[2], lo[3], hi[0], hi[1], hi[2], hi[3]}; }
__device__ __forceinline__ float max3f(float a, float b, float c) { float r; asm("v_max3_f32 %0, %1, %2, %3" : "=v"(r) : "v"(a), "v"(b), "v"(c)); return r; }
__device__ __forceinline__ float max2f(float a, float b) { float r; asm("v_max_f32_e32 %0, %1, %2" : "=v"(r) : "v"(a), "v"(b)); return r; }
__device__ __forceinline__ float swap_half(float v) { auto rr = __builtin_amdgcn_permlane32_swap(__float_as_uint(v), __float_as_uint(v), false, false); return __uint_as_float((threadIdx.x & 32) ? rr[0] : rr[1]); }

constexpr int A_K = 0, A_V = 24576, A_WS = 49152, A_QST = 53248, A_OST = A_QST, A_OSTW = 8192, A_END = A_QST + 8 * 8192;

__device__ __forceinline__ void attn_unit(int b, int n, int kvh, bf16_t* Y, bf16_t* O, int ldo, const bf16_t* KB, const bf16_t* VB, const float* sink, LAS unsigned char* lds) {
    const int tid = threadIdx.x, lane = tid & 63, r32 = lane & 31, hi = lane >> 5, wid = __builtin_amdgcn_readfirstlane(tid >> 6);
    const int head = kvh * 4 + (wid >> 1);
    const int qrow0 = b * SEQ + n * 128 + (wid & 1) * 64;
    bf16_t* Qw = Y + (size_t)qrow0 * 2048 + 1024 + head * 64;
    LAS bf16x8* qst = (LAS bf16x8*)(lds + A_QST + wid * 8192) + lane;
#pragma unroll
    for (int sb = 0; sb < 2; ++sb)
#pragma unroll
        for (int d0 = 0; d0 < 4; ++d0) qst[(sb * 4 + d0) * 64] = *(const bf16x8*)(Qw + (size_t)(32 * sb + r32) * 2048 + d0 * 16 + hi * 8);
    f32x16 o[2][2];
#pragma unroll
    for (int sb = 0; sb < 2; ++sb)
#pragma unroll
        for (int d0 = 0; d0 < 2; ++d0)
#pragma unroll
            for (int r = 0; r < 16; ++r) o[sb][d0][r] = 0.f;
    float m[2] = {-1e30f, -1e30f}, l[2] = {0.f, 0.f};
    LAS float* wsf = (LAS float*)(lds + A_WS) + wid * 128;
    const int jlo = (n == 0) ? 2 : 0, jhi = (n == 31) ? 3 : 5, T = 4 + (jhi - jlo + 1);
    const size_t koff = (size_t)lane * 256 + wid * 8 + kvh * 64;
    const size_t voff = (size_t)(16 * (wid & 3) + (lane >> 2)) * 256 + (wid >> 2) * 32 + (lane & 3) * 8 + kvh * 64;
    auto tile_row = [&](int t) -> long { return t < 4 ? (long)(NTOK + b * CTXL + 64 * t) : (long)(b * SEQ + (n - 1) * 128 + 64 * (jlo + t - 4)); };
    auto issue = [&](int t) {
        const long row = tile_row(t); const int buf = t % 3;
        __builtin_amdgcn_global_load_lds((const unsigned*)(KB + row * 256 + koff), (LAS unsigned*)(lds + A_K + buf * 8192 + wid * 1024), 16, 0, 0);
        __builtin_amdgcn_global_load_lds((const unsigned*)(VB + row * 256 + voff), (LAS unsigned*)(lds + A_V + buf * 8192 + wid * 1024), 16, 0, 0);
    };
    issue(0); issue(1);
    int slot = 0;
    for (int t = 0; t < T; ++t) {
        if (t + 1 < T) asm volatile("s_waitcnt vmcnt(2) lgkmcnt(0)" ::: "memory"); else asm volatile("s_waitcnt vmcnt(0) lgkmcnt(0)" ::: "memory");
        __builtin_amdgcn_s_barrier();
        if (t + 2 < T) issue(t + 2);
        const lds_cptr Kt = (lds_cptr)(lds + A_K + slot * 8192) + hi * 1024 + r32 * 16;
        const lds_cptr Vt = (lds_cptr)(lds + A_V + slot * 8192) + ((lane >> 4) & 1) * 32 + (lane & 3) * 8 + (4 * hi + ((lane & 15) >> 2)) * 64;
        slot = (slot == 2) ? 0 : slot + 1;
        const bool local = t >= 4;
        const int dl = 64 * (jlo + t - 4) - 128 - 64 * (wid & 1);
        if (local && (dl > 160 || dl < -191)) continue;
        f32x16 p0[2], p1[2];
#pragma unroll
        for (int sb = 0; sb < 2; ++sb)
#pragma unroll
            for (int r = 0; r < 16; ++r) { p0[sb][r] = 0.f; p1[sb][r] = 0.f; }
#pragma unroll
        for (int d0 = 0; d0 < 4; ++d0) {
            const bf16x8 k0 = *(const __attribute__((address_space(3))) bf16x8*)(Kt + d0 * 2048), k1 = *(const __attribute__((address_space(3))) bf16x8*)(Kt + d0 * 2048 + 512);
#pragma unroll
            for (int sb = 0; sb < 2; ++sb) {
                const bf16x8 qf = qst[(sb * 4 + d0) * 64];
                p0[sb] = __builtin_amdgcn_mfma_f32_32x32x16_bf16(k0, qf, p0[sb], 0, 0, 0);
                p1[sb] = __builtin_amdgcn_mfma_f32_32x32x16_bf16(k1, qf, p1[sb], 0, 0, 0);
            }
        }
        if (local && (dl < -97 || dl > 65 || dl - 32 < -97)) {
#pragma unroll
            for (int sb = 0; sb < 2; ++sb)
#pragma unroll
                for (int r = 0; r < 16; ++r) { const int rel = dl - 32 * sb + crow(r, hi) - r32; if (rel < -128 || rel > 128) p0[sb][r] = -1e30f; if (rel + 32 < -128 || rel + 32 > 128) p1[sb][r] = -1e30f; }
        }
        float mn[2];
        asm volatile("s_nop 15\n\ts_nop 7" : "+v"(p0[0]), "+v"(p1[0]), "+v"(p0[1]), "+v"(p1[1]));
#pragma unroll
        for (int sb = 0; sb < 2; ++sb) {
            float a = max3f(p0[sb][0], p0[sb][1], p1[sb][0]), b2 = max3f(p0[sb][2], p0[sb][3], p1[sb][1]); a = max3f(a, p1[sb][2], p1[sb][3]);
#pragma unroll
            for (int r = 4; r < 16; r += 4) { a = max3f(a, p0[sb][r], p0[sb][r + 1]); b2 = max3f(b2, p0[sb][r + 2], p0[sb][r + 3]); a = max3f(a, p1[sb][r], p1[sb][r + 1]); b2 = max3f(b2, p1[sb][r + 2], p1[sb][r + 3]); }
            float rm = max2f(a, b2);
            rm = max2f(rm, swap_half(rm));
            mn[sb] = max2f(m[sb], rm);
        }
        if (__any((mn[0] > m[0]) || (mn[1] > m[1]))) {
            const float f0 = __builtin_amdgcn_exp2f(m[0] - mn[0]), f1 = __builtin_amdgcn_exp2f(m[1] - mn[1]);
            l[0] *= f0; l[1] *= f1;
            if (hi == 0) { wsf[r32] = f0; wsf[64 + r32] = f1; }
            asm volatile("s_waitcnt lgkmcnt(0)" ::: "memory");
#pragma unroll
            for (int r = 0; r < 16; ++r) { const float a = wsf[crow(r, hi)], b2 = wsf[64 + crow(r, hi)]; o[0][0][r] *= a; o[0][1][r] *= a; o[1][0][r] *= b2; o[1][1][r] *= b2; }
            m[0] = mn[0]; m[1] = mn[1];
        }
        u32x4 pw[2][4];
#pragma unroll
        for (int sb = 0; sb < 2; ++sb) {
            float sacc = 0.f;
#pragma unroll
            for (int r = 0; r < 16; ++r) { p0[sb][r] = __builtin_amdgcn_exp2f(p0[sb][r] - m[sb]); p1[sb][r] = __builtin_amdgcn_exp2f(p1[sb][r] - m[sb]); sacc += p0[sb][r] + p1[sb][r]; }
            l[sb] += sacc;
#pragma unroll
            for (int q = 0; q < 4; ++q) { pw[sb][0][q] = cvtpk(p0[sb][2 * q], p0[sb][2 * q + 1]); pw[sb][1][q] = cvtpk(p0[sb][8 + 2 * q], p0[sb][9 + 2 * q]); pw[sb][2][q] = cvtpk(p1[sb][2 * q], p1[sb][2 * q + 1]); pw[sb][3][q] = cvtpk(p1[sb][8 + 2 * q], p1[sb][9 + 2 * q]); }
        }
#pragma unroll
        for (int d0 = 0; d0 < 2; ++d0)
#pragma unroll
            for (int ks = 0; ks < 4; ++ks) {
                const s16x4 vlo = vtr(Vt + d0 * 4096 + ks * 1024), vhi = vtr(Vt + d0 * 4096 + ks * 1024 + 512);
                const bf16x8 vf = pk8(vlo, vhi);
#pragma unroll
                for (int sb = 0; sb < 2; ++sb) o[sb][d0] = __builtin_amdgcn_mfma_f32_32x32x16_bf16(__builtin_bit_cast(bf16x8, pw[sb][ks]), vf, o[sb][d0], 0, 0, 0);
            }
    }
    const float s2 = sink[head] * LOG2E;
    LAS bf16_t* stg = (LAS bf16_t*)(lds + A_OST + wid * A_OSTW);
#pragma unroll
    for (int sb = 0; sb < 2; ++sb) {
        const float lt = l[sb] + swap_half(l[sb]);
        const float mf = fmaxf(m[sb], s2), f = __builtin_amdgcn_exp2f(m[sb] - mf), den = lt * f + __builtin_amdgcn_exp2f(s2 - mf);
        asm volatile("s_waitcnt lgkmcnt(0)" ::: "memory");
        if (hi == 0) wsf[sb * 64 + r32] = f / den;
        asm volatile("s_waitcnt lgkmcnt(0)" ::: "memory");
#pragma unroll
        for (int r = 0; r < 16; ++r) { const float sc = wsf[sb * 64 + crow(r, hi)]; const int orow = crow(r, hi);
            stg[orow * 64 + r32] = (bf16_t)f2bf(o[sb][0][r] * sc); stg[orow * 64 + 32 + r32] = (bf16_t)f2bf(o[sb][1][r] * sc); }
        asm volatile("s_waitcnt lgkmcnt(0)" ::: "memory");
#pragma unroll
        for (int i = 0; i < 4; ++i) { const int row = i * 8 + (lane >> 3), ch = lane & 7; const u32x4 v = *(const LAS u32x4*)(stg + row * 64 + ch * 8); *(u32x4*)(O + (size_t)(qrow0 + 32 * sb + row) * ldo + head * 64 + ch * 8) = v; }
        asm volatile("s_waitcnt lgkmcnt(0)" ::: "memory");
    }
    __syncthreads();
}

constexpr int G_V = 0, G_ST = 65536, G_STW = 8704, G_MU = G_ST + 8 * G_STW;
__device__ __forceinline__ void gmlp_unit(int task, bf16_t* Y, bf16_t* YO, int ldo, const bf16_t* VA, const bf16_t* WSP, const f32x2* STATS, const float* ln_g, const float* ln_b, const float* b_sp, LAS unsigned char* lds) {
    const int tid = threadIdx.x, lane = tid & 63, r32 = lane & 31, hi = lane >> 5, wid = __builtin_amdgcn_readfirstlane(tid >> 6);
    const int r0 = task * 128;
    LAS float* mu = (LAS float*)(lds + G_MU); LAS float* rs = mu + 128;
    if (tid < 128) {
        const f32x4* sp = (const f32x4*)(STATS + (size_t)(r0 + tid) * 16); float s = 0.f, ss = 0.f;
#pragma unroll
        for (int i = 0; i < 8; ++i) { const f32x4 v = sp[i]; s += v.x + v.z; ss += v.y + v.w; }
        const float mean = s * (1.f / 1024.f), var = fmaxf(ss * (1.f / 1024.f) - mean * mean, 0.f);
        mu[tid] = mean; rs[tid] = 1.0f / sqrtf(var + EPS);
    }
    u32x4 raw[4];
#pragma unroll
    for (int i = 0; i < 4; ++i) { const int idx = tid + NTHREADS * i, q = idx >> 4, c8 = idx & 15; raw[i] = *(const u32x4*)(VA + (size_t)(r0 + q) * 1024 + c8 * 8); }
    __syncthreads();
    const int pb = wid >> 1, dh = wid & 1;
    LAS float* st = (LAS float*)(lds + G_ST + wid * G_STW);
    for (int g8 = 0; g8 < 8; ++g8) {
        LAS unsigned char* vb = lds + G_V + (g8 & 1) * 32768;
#pragma unroll
        for (int i = 0; i < 4; ++i) {
            const int idx = tid + NTHREADS * i, q = idx >> 4, c8 = idx & 15, d = c8 * 8;
            const f32x4 g0 = *(const f32x4*)(ln_g + g8 * 128 + d), g1 = *(const f32x4*)(ln_g + g8 * 128 + d + 4), b0 = *(const f32x4*)(ln_b + g8 * 128 + d), b1 = *(const f32x4*)(ln_b + g8 * 128 + d + 4);
            const float mq = mu[q], rq = rs[q]; const u32x4 rw = raw[i];
            float v[8] = {bf2f(rw.x & 0xffffu), bf2f(rw.x >> 16), bf2f(rw.y & 0xffffu), bf2f(rw.y >> 16), bf2f(rw.z & 0xffffu), bf2f(rw.z >> 16), bf2f(rw.w & 0xffffu), bf2f(rw.w >> 16)};
#pragma unroll
            for (int e = 0; e < 4; ++e) { v[e] = (v[e] - mq) * rq * g0[e] + b0[e]; v[4 + e] = (v[4 + e] - mq) * rq * g1[e] + b1[e]; }
            u32x4 w; w.x = pk2(v[0], v[1]); w.y = pk2(v[2], v[3]); w.z = pk2(v[4], v[5]); w.w = pk2(v[6], v[7]);
            *(LAS u32x4*)(vb + ((d >> 5) * 8 + (q >> 4)) * 1024 + (q & 15) * 64 + (d & 31) * 2) = w;
        }
        if (g8 + 1 < 8) {
#pragma unroll
            for (int i = 0; i < 4; ++i) { const int idx = tid + NTHREADS * i, q = idx >> 4, c8 = idx & 15; raw[i] = *(const u32x4*)(VA + (size_t)(r0 + q) * 1024 + (g8 + 1) * 128 + c8 * 8); }
        }
        u32x4 ur[4]; bf16x8 af[8];
        const size_t ybase = (size_t)(r0 + 32 * pb + (lane >> 3)) * 2048 + g8 * 128 + 64 * dh + (lane & 7) * 8;
#pragma unroll
        for (int i = 0; i < 4; ++i) ur[i] = *(const u32x4*)(Y + ybase + (size_t)(8 * i) * 2048);
        const bf16_t* wrow = WSP + (size_t)g8 * 16384 + (size_t)(32 * pb + r32) * 128 + 8 * hi;
#pragma unroll
        for (int ks = 0; ks < 8; ++ks) af[ks] = *(const bf16x8*)(wrow + 16 * ks);
        __syncthreads();
        const lds_cptr Vb = (lds_cptr)vb + ((lane >> 4) & 1) * 32 + (lane & 3) * 8 + (8 * hi + ((lane & 15) >> 2)) * 64;
        f32x16 acc[2];
#pragma unroll
        for (int t2 = 0; t2 < 2; ++t2)
#pragma unroll
            for (int r = 0; r < 16; ++r) acc[t2][r] = 0.f;
#pragma unroll
        for (int ks = 0; ks < 8; ++ks) {
#pragma unroll
            for (int t2 = 0; t2 < 2; ++t2) {
                const int db = 2 * dh + t2;
                const s16x4 vlo = vtr(Vb + (db * 8 + ks) * 1024), vhi = vtr(Vb + (db * 8 + ks) * 1024 + 256);
                acc[t2] = __builtin_amdgcn_mfma_f32_32x32x16_bf16(af[ks], pk8(vlo, vhi), acc[t2], 0, 0, 0);
            }
        }
#pragma unroll
        for (int t2 = 0; t2 < 2; ++t2)
#pragma unroll
            for (int r = 0; r < 16; ++r) st[crow(r, hi) * 68 + 32 * t2 + r32] = acc[t2][r];
        asm volatile("s_waitcnt lgkmcnt(0)" ::: "memory");
#pragma unroll
        for (int i = 0; i < 4; ++i) {
            const int prow = 8 * i + (lane >> 3), ch = lane & 7;
            const f32x4 m0 = *(const LAS f32x4*)(st + prow * 68 + ch * 8), m1 = *(const LAS f32x4*)(st + prow * 68 + ch * 8 + 4);
            const float bs = b_sp[g8 * 128 + 32 * pb + prow]; const u32x4 uw = ur[i];
            u32x4 o;
            o.x = pk2(bf2f(uw.x & 0xffffu) * (m0.x + bs), bf2f(uw.x >> 16) * (m0.y + bs)); o.y = pk2(bf2f(uw.y & 0xffffu) * (m0.z + bs), bf2f(uw.y >> 16) * (m0.w + bs));
            o.z = pk2(bf2f(uw.z & 0xffffu) * (m1.x + bs), bf2f(uw.z >> 16) * (m1.y + bs)); o.w = pk2(bf2f(uw.w & 0xffffu) * (m1.z + bs), bf2f(uw.w >> 16) * (m1.w + bs));
            *(u32x4*)(YO + (size_t)(r0 + 32 * pb + prow) * ldo + g8 * 128 + 64 * dh + ch * 8) = o;
        }
        asm volatile("s_waitcnt lgkmcnt(0)" ::: "memory");
    }
    __syncthreads();
}
}

namespace att2 {
typedef short bf16x8 __attribute__((ext_vector_type(8)));
typedef short s16x4 __attribute__((ext_vector_type(4)));
typedef float f32x16 __attribute__((ext_vector_type(16)));
typedef __attribute__((address_space(3))) const char* lds_cptr;
typedef short v4i16_t __attribute__((ext_vector_type(4)));
__device__ __forceinline__ int crow(int r, int hi) { return (r & 3) + 8 * (r >> 2) + 4 * hi; }
#define SBAR() __builtin_amdgcn_sched_barrier(0)
constexpr int NSLOT = 3, SLOTB = 8192;
constexpr int LDS_K = 0, LDS_V = NSLOT * SLOTB, LDS_WS = 2 * NSLOT * SLOTB, LDS_OST = LDS_WS + 8 * 64 * 4, LDS_BYTES = LDS_OST + 8 * 4096;
__device__ __forceinline__ void glds16(const void* gsrc, unsigned lds_dst) { unsigned keep;
    asm volatile("s_mov_b32 %0, m0\n\ts_mov_b32 m0, %2\n\ts_nop 0\n\tglobal_load_lds_dwordx4 %1, off\n\ts_mov_b32 m0, %0" : "=&s"(keep) : "v"(gsrc), "s"(lds_dst) : "memory"); }
__device__ __forceinline__ float max3f(float a, float b, float c) { float r; asm("v_max3_f32 %0, %1, %2, %3" : "=v"(r) : "v"(a), "v"(b), "v"(c)); return r; }
__device__ __forceinline__ float max2f(float a, float b) { float r; asm("v_max_f32_e32 %0, %1, %2" : "=v"(r) : "v"(a), "v"(b)); return r; }
__device__ __forceinline__ float fadd_s(float a, float b) { float r; asm("v_add_f32_e32 %0, %1, %2" : "=v"(r) : "v"(a), "v"(b)); return r; }
__device__ __forceinline__ float fsub_s(float a, float b) { float r; asm("v_sub_f32_e32 %0, %1, %2" : "=v"(r) : "v"(a), "v"(b)); return r; }
typedef float f32x2_t __attribute__((ext_vector_type(2))); typedef __bf16 bf16x2_t __attribute__((ext_vector_type(2)));
__device__ __forceinline__ unsigned cvtpk_s(float lo, float hi) { f32x2_t v = {lo, hi}; bf16x2_t b = __builtin_convertvector(v, bf16x2_t); return __builtin_bit_cast(unsigned, b); }
#define WAIT_BAR(N) asm volatile("s_waitcnt vmcnt(" #N ") lgkmcnt(0)\n\ts_barrier" ::: "memory")
__device__ __forceinline__ void qkt(f32x16& p0, f32x16& p1, lds_cptr Kslot, const bf16x8* qr, const f32x16& negm, int r32, int hi) {
    const lds_cptr kb = Kslot + hi * 1024 + r32 * 16;
#pragma unroll
    for (int d0 = 0; d0 < 4; ++d0) {
        const bf16x8 b0 = *(const __attribute__((address_space(3))) bf16x8*)(kb + d0 * 2048);
        const bf16x8 b1 = *(const __attribute__((address_space(3))) bf16x8*)(kb + d0 * 2048 + 512);
        if (d0 == 0) { p0 = __builtin_amdgcn_mfma_f32_32x32x16_bf16(b0, qr[0], negm, 0, 0, 0); p1 = __builtin_amdgcn_mfma_f32_32x32x16_bf16(b1, qr[0], negm, 0, 0, 0); }
        else { p0 = __builtin_amdgcn_mfma_f32_32x32x16_bf16(b0, qr[d0], p0, 0, 0, 0); p1 = __builtin_amdgcn_mfma_f32_32x32x16_bf16(b1, qr[d0], p1, 0, 0, 0); }
    }
}
__device__ __forceinline__ void kload8(bf16x8* kf, lds_cptr kp) {
    kf[0] = *(const __attribute__((address_space(3))) bf16x8*)(kp);        kf[1] = *(const __attribute__((address_space(3))) bf16x8*)(kp + 512);
    kf[2] = *(const __attribute__((address_space(3))) bf16x8*)(kp + 2048); kf[3] = *(const __attribute__((address_space(3))) bf16x8*)(kp + 2560);
    kf[4] = *(const __attribute__((address_space(3))) bf16x8*)(kp + 4096); kf[5] = *(const __attribute__((address_space(3))) bf16x8*)(kp + 4608);
    kf[6] = *(const __attribute__((address_space(3))) bf16x8*)(kp + 6144); kf[7] = *(const __attribute__((address_space(3))) bf16x8*)(kp + 6656);
}
__device__ __forceinline__ void kload2(bf16x8* kf, lds_cptr kp, int j) { kf[2 * j] = *(const __attribute__((address_space(3))) bf16x8*)(kp + j * 2048); kf[2 * j + 1] = *(const __attribute__((address_space(3))) bf16x8*)(kp + j * 2048 + 512); }
__device__ __forceinline__ s16x4 vtr(lds_cptr p) { return __builtin_bit_cast(s16x4, __builtin_amdgcn_ds_read_tr16_b64_v4i16((__attribute__((address_space(3))) v4i16_t*)p)); }
__device__ __forceinline__ float rowmax(const f32x16& p0, const f32x16& p1) {
    float a = max3f(p0[0], p0[1], p1[0]), b = max3f(p0[2], p0[3], p1[1]); a = max3f(a, p1[2], p1[3]);
#pragma unroll
    for (int r = 4; r < 16; r += 4) { a = max3f(a, p0[r], p0[r + 1]); b = max3f(b, p0[r + 2], p0[r + 3]); a = max3f(a, p1[r], p1[r + 1]); b = max3f(b, p1[r + 2], p1[r + 3]); }
    const float m = max2f(a, b);
    auto rr = __builtin_amdgcn_permlane32_swap(__float_as_uint(m), __float_as_uint(m), false, false);
    return max2f(__uint_as_float(rr[0]), __uint_as_float(rr[1]));
}
__device__ __forceinline__ void pv(f32x16* o, int vb, bf16x8 pa0, bf16x8 pa1, bf16x8 pa2, bf16x8 pa3) {
#pragma unroll
    for (int d0 = 0; d0 < 2; ++d0) { s16x4 lo[4], hi[4];
#pragma unroll
        for (int ks = 0; ks < 4; ++ks) {
            asm volatile("ds_read_b64_tr_b16 %0,%1 offset:%c2" : "=&v"(lo[ks]) : "v"(vb), "i"(d0 * 4096 + ks * 1024) : "memory");
            asm volatile("ds_read_b64_tr_b16 %0,%1 offset:%c2" : "=&v"(hi[ks]) : "v"(vb), "i"(d0 * 4096 + ks * 1024 + 512) : "memory"); }
        asm volatile("s_waitcnt lgkmcnt(0)" ::: "memory"); SBAR();
#define PK(k) (bf16x8){lo[k][0], lo[k][1], lo[k][2], lo[k][3], hi[k][0], hi[k][1], hi[k][2], hi[k][3]}
        o[d0] = __builtin_amdgcn_mfma_f32_32x32x16_bf16(pa0, PK(0), o[d0], 0, 0, 0);
        o[d0] = __builtin_amdgcn_mfma_f32_32x32x16_bf16(pa1, PK(1), o[d0], 0, 0, 0);
        o[d0] = __builtin_amdgcn_mfma_f32_32x32x16_bf16(pa2, PK(2), o[d0], 0, 0, 0);
        o[d0] = __builtin_amdgcn_mfma_f32_32x32x16_bf16(pa3, PK(3), o[d0], 0, 0, 0);
#undef PK
    }
}
__device__ __forceinline__ void wmask(f32x16& p0, f32x16& p1, int dl, int r32, int hi) {
    const float NEG = -INFINITY;
#pragma unroll
    for (int r = 0; r < 16; ++r) { const int rel = dl + crow(r, hi) - r32; if (rel < -128 || rel > 128) p0[r] = NEG; if (rel + 32 < -128 || rel + 32 > 128) p1[r] = NEG; }
}

template <int THRL> __device__ __forceinline__ void attn_unit(int b, int n, int kvh, int hp, int base, bool primed, bool has_next, int nb, int nn, int nkvh, int nhp, bf16x8 (&qr)[4], int& nbase,
                                                              const bf16_t* Y, bf16_t* O, int ldo, const bf16_t* KB, const bf16_t* VB, const float* sink, LAS unsigned char* shm) {
    const int tid = threadIdx.x, lane = tid & 63, r32 = lane & 31, hi = lane >> 5; const int wid = __builtin_amdgcn_readfirstlane(tid >> 6);
    const int head = kvh * 4 + hp * 2 + (wid >> 2), qsub = wid & 3;
    const long qrow0 = (long)b * SEQ + n * 128 + qsub * 32;
    const bf16_t* Qw = Y + qrow0 * 2048 + 1024 + head * 64;
    const unsigned lds0 = (unsigned)(uintptr_t)shm;
    LAS float* wsf = (LAS float*)(shm + LDS_WS) + wid * 64;
    const long koff = (long)lane * 256 + kvh * 64 + wid * 8;
    const long voff = (long)(16 * (wid & 3) + (lane >> 2)) * 256 + kvh * 64 + (wid >> 2) * 32 + (lane & 3) * 8;
    const unsigned kdst = lds0 + LDS_K + wid * 1024, vdst = lds0 + LDS_V + wid * 1024;
    const int jlo = (n == 0) ? 2 : 0, jhi = (n == 31) ? 3 : 5, NT = 4 + (jhi - jlo + 1);
    const long lrow0 = (long)b * SEQ + (n - 1) * 128 + 64 * (jlo - 4), crow0 = (long)NTOK + b * CTXL;
#define TROW(t) ((t) < 4 ? crow0 + 64 * (t) : lrow0 + 64 * (t))
#define DMA_K(t, slot) glds16(KB + TROW(t) * 256 + koff, (unsigned)__builtin_amdgcn_readfirstlane(kdst + (slot)))
#define DMA_V(t, slot) glds16(VB + TROW(t) * 256 + voff, (unsigned)__builtin_amdgcn_readfirstlane(vdst + (slot)))
    const int vb0 = (int)(lds0 + LDS_V) + ((lane >> 4) & 1) * 32 + (lane & 3) * 8 + (4 * hi + ((lane & 15) >> 2)) * 64;
    bf16x8 kf[8];
    const lds_cptr shm3 = (lds_cptr)shm; const lds_cptr kp0 = shm3 + LDS_K + hi * 1024 + r32 * 16; const lds_cptr vp0 = shm3 + LDS_V + ((lane >> 4) & 1) * 32 + (lane & 3) * 8 + (4 * hi + ((lane & 15) >> 2)) * 64;
    const int s0 = base, s1 = (s0 == (NSLOT - 1) * SLOTB) ? 0 : s0 + SLOTB, s2 = (s1 == (NSLOT - 1) * SLOTB) ? 0 : s1 + SLOTB;
    if (!primed) {
        DMA_K(0, s0); DMA_V(0, s0); DMA_K(1, s1); DMA_K(2, s2);
#pragma unroll
        for (int d0 = 0; d0 < 4; ++d0) qr[d0] = *(const bf16x8*)(Qw + (long)r32 * 2048 + d0 * 16 + hi * 8);
    }
    float mhat = 0.f, l_reg = 0.f; f32x16 o[2]; o[0] = f32x16{}; o[1] = f32x16{}; f32x16 negm = f32x16{}; asm volatile("" : "+v"(negm));
    const int dq = -128 - 32 * qsub;
#define CMASK(P0, P1, t) do { if ((t) >= 4) { const int dl_ = 64 * (jlo + (t) - 4) + dq; if (dl_ < -97 || dl_ > 65) wmask(P0, P1, dl_, r32, hi); } } while (0)
    bool resc = false;
#define START(P0, P1) do { const float rm = rowmax(P0, P1); resc = false; \
    { const float dl = rm; mhat = fadd_s(mhat, dl); \
      _Pragma("unroll") for (int r = 0; r < 16; ++r) { P0[r] = fsub_s(P0[r], dl); P1[r] = fsub_s(P1[r], dl); } \
      _Pragma("unroll") for (int r = 0; r < 16; ++r) negm[r] = -mhat; asm volatile("" : "+v"(negm)); } \
    _Pragma("unroll") for (int r = 0; r < 16; ++r) P0[r] = __builtin_amdgcn_exp2f(P0[r]); } while (0)
#define RESC() do { if (resc) { asm volatile("s_waitcnt lgkmcnt(0)" ::: "memory"); \
      _Pragma("unroll") for (int d_ = 0; d_ < 2; ++d_) _Pragma("unroll") for (int r = 0; r < 16; ++r) o[d_][r] *= wsf[crow(r, hi)]; } } while (0)
    f32x16 pA0, pA1, pB0, pB1;
    int sl_prev = s0, sl_cur = s0, sl_next = s1;
#define ROT() do { sl_prev = sl_cur; sl_cur = sl_next; sl_next = (sl_next == (NSLOT - 1) * SLOTB) ? 0 : sl_next + SLOTB; } while (0)
    WAIT_BAR(7);
    qkt(pA0, pA1, shm3 + LDS_K + s0, qr, negm, r32, hi); asm volatile("s_nop 15\n\ts_nop 7" : "+v"(pA0), "+v"(pA1)); CMASK(pA0, pA1, 0);
    START(pA0, pA1);
    _Pragma("unroll") for (int r = 0; r < 16; ++r) pA1[r] = __builtin_amdgcn_exp2f(pA1[r]);
    WAIT_BAR(0);
    DMA_K(3, s0); DMA_V(1, s1);
    ROT();
    kload8(kf, kp0 + sl_cur);
    WAIT_BAR(2);
    s16x4 vlo[8], vhi[8]; u32x4 pw0, pw1, pw2, pw3;
#define PKW(P, B) cvtpk_s(P[B], P[B + 1])
#define PAF(k) __builtin_bit_cast(bf16x8, pw##k)
#define VFR(i) (bf16x8){vlo[i][0], vlo[i][1], vlo[i][2], vlo[i][3], vhi[i][0], vhi[i][1], vhi[i][2], vhi[i][3]}
#define PIN(x) asm volatile("" : "+v"(x))
#define MX3(a, b, c) __builtin_fmaxf(__builtin_fmaxf((a), (b)), (c))
#define GAPA(MF, A0, A1, A2, A3, W0, W1, PW) do { MF; sacc += A0; sacc += A1; sacc += A2; sacc += A3; PIN(sacc); W0; W1; PIN(PW); SBAR(); } while (0)
#define EX(v) __builtin_amdgcn_exp2f(v)
#define GAPB(MF, X, B) do { MF; X[B] = EX(X[B]); X[B + 1] = EX(X[B + 1]); X[B + 2] = EX(X[B + 2]); X[B + 3] = EX(X[B + 3]); PIN(X); SBAR(); } while (0)
#define VRD(i) do { vlo[i] = vtr(vp_ + (((i) >> 2) * 4096 + ((i) & 3) * 1024)); vhi[i] = vtr(vp_ + (((i) >> 2) * 4096 + ((i) & 3) * 1024 + 512)); } while (0)
#define KRD(G, j) do { if (G) { kload2(kf, kp0 + sl_next, j); SBAR(); } } while (0)
#define STEP(C0, C1, P0, P1, t, GK, GV, GL) do { SBAR(); \
    const lds_cptr vp_ = vp0 + sl_prev; \
    VRD(0); SBAR(); float sacc = (P0[0] + P0[1]); \
    GAPA(C0 = __builtin_amdgcn_mfma_f32_32x32x16_bf16(kf[0], qr[0], negm, 0, 0, 0), P0[2], P0[3], P0[4], P0[5],     pw0[0] = PKW(P0, 0), pw0[1] = PKW(P0, 2), pw0); \
    VRD(4); SBAR(); GAPA(C1 = __builtin_amdgcn_mfma_f32_32x32x16_bf16(kf[1], qr[0], negm, 0, 0, 0), P0[6], P0[7], P0[8], P0[9],     pw0[2] = PKW(P0, 4), pw0[3] = PKW(P0, 6), pw0); \
    VRD(1); SBAR(); GAPA(C0 = __builtin_amdgcn_mfma_f32_32x32x16_bf16(kf[2], qr[1], C0, 0, 0, 0),   P0[10], P0[11], P0[12], P0[13], pw1[0] = PKW(P0, 8), pw1[1] = PKW(P0, 10), pw1); \
    VRD(5); SBAR(); GAPA(C1 = __builtin_amdgcn_mfma_f32_32x32x16_bf16(kf[3], qr[1], C1, 0, 0, 0),   P0[14], P0[15], P1[0], P1[1],   pw1[2] = PKW(P0, 12), pw1[3] = PKW(P0, 14), pw1); \
    VRD(2); SBAR(); GAPA(C0 = __builtin_amdgcn_mfma_f32_32x32x16_bf16(kf[4], qr[2], C0, 0, 0, 0),   P1[2], P1[3], P1[4], P1[5],     pw2[0] = PKW(P1, 0), pw2[1] = PKW(P1, 2), pw2); \
    VRD(6); SBAR(); GAPA(C1 = __builtin_amdgcn_mfma_f32_32x32x16_bf16(kf[5], qr[2], C1, 0, 0, 0),   P1[6], P1[7], P1[8], P1[9],     pw2[2] = PKW(P1, 4), pw2[3] = PKW(P1, 6), pw2); \
    VRD(3); SBAR(); GAPA(C0 = __builtin_amdgcn_mfma_f32_32x32x16_bf16(kf[6], qr[3], C0, 0, 0, 0),   P1[10], P1[11], P1[12], P1[13], pw3[0] = PKW(P1, 8), pw3[1] = PKW(P1, 10), pw3); \
    VRD(7); SBAR(); GAPA(C1 = __builtin_amdgcn_mfma_f32_32x32x16_bf16(kf[7], qr[3], C1, 0, 0, 0),   P1[14], P1[15], 0.f, 0.f,       pw3[2] = PKW(P1, 12), pw3[3] = PKW(P1, 14), pw3); \
    l_reg += sacc; \
    if (GK) { DMA_K((t) + 3, sl_cur); } if (GV) { DMA_V((t) + 1, sl_next); } \
    CMASK(C0, C1, t); \
    { float a = MX3(C0[0], C0[1], C1[0]), b2 = MX3(C0[2], C0[3], C1[1]); a = MX3(a, C1[2], C1[3]); \
      _Pragma("unroll") for (int r = 4; r < 16; r += 4) { a = MX3(a, C0[r], C0[r + 1]); b2 = MX3(b2, C0[r + 2], C0[r + 3]); a = MX3(a, C1[r], C1[r + 1]); b2 = MX3(b2, C1[r + 2], C1[r + 3]); } \
      float rm = __builtin_fmaxf(a, b2); { auto rr = __builtin_amdgcn_permlane32_swap(__float_as_uint(rm), __float_as_uint(rm), false, false); rm = __builtin_fmaxf(__uint_as_float(rr[0]), __uint_as_float(rr[1])); } \
      resc = false; \
      if (__builtin_expect(__any(rm > (float)THRL), 0)) { const float dl = __builtin_fmaxf(rm, 0.f); mhat += dl; \
        _Pragma("unroll") for (int r = 0; r < 16; ++r) { C0[r] -= dl; C1[r] -= dl; } \
        _Pragma("unroll") for (int r = 0; r < 16; ++r) negm[r] = -mhat; asm volatile("" : "+v"(negm)); \
        const float f = __builtin_amdgcn_exp2f(-dl); l_reg *= f; if (hi == 0) wsf[r32] = f; resc = true; } } \
    SBAR(); \
    GAPB(o[0] = __builtin_amdgcn_mfma_f32_32x32x16_bf16(PAF(0), VFR(0), o[0], 0, 0, 0), C0, 0); \
    GAPB(o[1] = __builtin_amdgcn_mfma_f32_32x32x16_bf16(PAF(0), VFR(4), o[1], 0, 0, 0), C0, 4); \
    KRD(GL, 0); GAPB(o[0] = __builtin_amdgcn_mfma_f32_32x32x16_bf16(PAF(1), VFR(1), o[0], 0, 0, 0), C0, 8); \
    KRD(GL, 1); GAPB(o[1] = __builtin_amdgcn_mfma_f32_32x32x16_bf16(PAF(1), VFR(5), o[1], 0, 0, 0), C0, 12); \
    KRD(GL, 2); GAPB(o[0] = __builtin_amdgcn_mfma_f32_32x32x16_bf16(PAF(2), VFR(2), o[0], 0, 0, 0), C1, 0); \
    KRD(GL, 3); GAPB(o[1] = __builtin_amdgcn_mfma_f32_32x32x16_bf16(PAF(2), VFR(6), o[1], 0, 0, 0), C1, 4); \
    GAPB(o[0] = __builtin_amdgcn_mfma_f32_32x32x16_bf16(PAF(3), VFR(3), o[0], 0, 0, 0), C1, 8); \
    GAPB(o[1] = __builtin_amdgcn_mfma_f32_32x32x16_bf16(PAF(3), VFR(7), o[1], 0, 0, 0), C1, 12); \
    } while (0)
#define ENDW(tt) do { if ((tt) + 3 < NT) { WAIT_BAR(2); } else if ((tt) + 2 < NT) { WAIT_BAR(1); } else { WAIT_BAR(0); } } while (0)
    int t = 1;
    for (; t + 1 < NT; t += 2) {
        STEP(pB0, pB1, pA0, pA1, t, (t + 3 < NT), (t + 1 < NT), (t + 1 < NT));       ENDW(t);     RESC(); ROT();
        STEP(pA0, pA1, pB0, pB1, t + 1, (t + 4 < NT), (t + 2 < NT), (t + 2 < NT));   ENDW(t + 1); RESC(); ROT();
    }
    nbase = sl_next;
    if (has_next) {
        const long nr = (long)NTOK + nb * CTXL; const long nko = (long)lane * 256 + nkvh * 64 + wid * 8, nvo = (long)(16 * (wid & 3) + (lane >> 2)) * 256 + nkvh * 64 + (wid >> 2) * 32 + (lane & 3) * 8;
        const int n0 = sl_next, n1 = (n0 == (NSLOT - 1) * SLOTB) ? 0 : n0 + SLOTB, n2 = (n1 == (NSLOT - 1) * SLOTB) ? 0 : n1 + SLOTB;
        glds16(KB + nr * 256 + nko, (unsigned)__builtin_amdgcn_readfirstlane(kdst + n0)); glds16(VB + nr * 256 + nvo, (unsigned)__builtin_amdgcn_readfirstlane(vdst + n0));
        glds16(KB + (nr + 64) * 256 + nko, (unsigned)__builtin_amdgcn_readfirstlane(kdst + n1)); glds16(KB + (nr + 128) * 256 + nko, (unsigned)__builtin_amdgcn_readfirstlane(kdst + n2));
    }
    STEP(pB0, pB1, pA0, pA1, NT - 1, false, false, false); RESC();
    { float sacc = pB0[0] + pB0[1]; _Pragma("unroll") for (int r = 2; r < 16; ++r) sacc += pB0[r]; _Pragma("unroll") for (int r = 0; r < 16; ++r) sacc += pB1[r]; l_reg += sacc;
      pw0 = (u32x4){PKW(pB0, 0), PKW(pB0, 2), PKW(pB0, 4), PKW(pB0, 6)}; pw1 = (u32x4){PKW(pB0, 8), PKW(pB0, 10), PKW(pB0, 12), PKW(pB0, 14)}; pw2 = (u32x4){PKW(pB1, 0), PKW(pB1, 2), PKW(pB1, 4), PKW(pB1, 6)}; pw3 = (u32x4){PKW(pB1, 8), PKW(pB1, 10), PKW(pB1, 12), PKW(pB1, 14)};
      SBAR(); pv(o, vb0 + sl_cur, PAF(0), PAF(1), PAF(2), PAF(3)); }
    if (has_next) {
        asm volatile("" ::: "memory");
        const bf16_t* nQw = Y + ((long)nb * SEQ + nn * 128 + qsub * 32) * 2048 + 1024 + (nkvh * 4 + nhp * 2 + (wid >> 2)) * 64;
#pragma unroll
        for (int d0 = 0; d0 < 4; ++d0) qr[d0] = *(const bf16x8*)(nQw + (long)r32 * 2048 + d0 * 16 + hi * 8);
    }
    { auto rr = __builtin_amdgcn_permlane32_swap(__float_as_uint(l_reg), __float_as_uint(l_reg), false, false); l_reg = __uint_as_float(rr[0]) + __uint_as_float(rr[1]); }
    l_reg += __builtin_amdgcn_exp2f(fminf(sink[head] * LOG2E - mhat, 80.f));
    if (hi == 0) wsf[32 + r32] = l_reg; asm volatile("s_waitcnt lgkmcnt(0)" ::: "memory");
    float rli[16];
#pragma unroll
    for (int r = 0; r < 16; ++r) rli[r] = __builtin_amdgcn_rcpf(wsf[32 + crow(r, hi)]);
    bf16_t* Ow = O + qrow0 * ldo + head * 64;
    { LAS bf16_t* stg = (LAS bf16_t*)(shm + LDS_OST) + wid * 2048;
#pragma unroll
      for (int r = 0; r < 16; ++r) { const int orow = crow(r, hi);
#pragma unroll
          for (int d0 = 0; d0 < 2; ++d0) stg[orow * 64 + d0 * 32 + r32] = (bf16_t)(pk2(o[d0][r] * rli[r], 0.f) & 0xffffu); }
      asm volatile("s_waitcnt lgkmcnt(0)" ::: "memory");
#pragma unroll
      for (int i = 0; i < 4; ++i) { const int row = i * 8 + (lane >> 3), ch = lane & 7; const u32x4 v = *(const LAS u32x4*)(stg + row * 64 + ch * 8); *(u32x4*)(Ow + (long)row * ldo + ch * 8) = v; } }
    asm volatile("s_waitcnt lgkmcnt(0)\n\ts_barrier" ::: "memory");
#undef TROW
#undef DMA_K
#undef DMA_V
#undef CMASK
#undef START
#undef RESC
#undef ROT
#undef PKW
#undef PAF
#undef VFR
#undef PIN
#undef MX3
#undef GAPA
#undef GAPB
#undef EX
#undef VRD
#undef KRD
#undef STEP
#undef ENDW
}
#undef SBAR
#undef WAIT_BAR
}

#define XB_TMO      128
#define XB_XCNT(j)  (256  + 64 * (j))
#define XB_XSUB(j)  (1280 + 64 * (j))
#define XB_XGEN(j)  (2304 + 64 * (j))
#define XB_TOP      3328
#define XB_TOPGEN   3392
#define XCD_BAR_WORDS 3456
#define XB_SPIN_CAP (1u << 18)
__device__ __forceinline__ unsigned xb_ld(unsigned* p)              { return __hip_atomic_load(p, __ATOMIC_RELAXED, __HIP_MEMORY_SCOPE_AGENT); }
__device__ __forceinline__ unsigned xb_add(unsigned* p, unsigned v) { return __hip_atomic_fetch_add(p, v, __ATOMIC_RELAXED, __HIP_MEMORY_SCOPE_AGENT); }
__device__ __forceinline__ unsigned xb_xcc_id() { return (unsigned)__builtin_amdgcn_s_getreg((3 << 11) | 20) & 0xFu; }
#define XB_SPIN(cond, bar) do { unsigned _sp = 0; while (cond) { __builtin_amdgcn_s_sleep(1); \
    if ((++_sp & 255u) == 0u) { if (xb_ld(&(bar)[XB_TMO])) break; if (_sp > XB_SPIN_CAP) { atomicAdd(&(bar)[XB_TMO], 1u); break; } } } } while (0)
struct XcdBarrier { unsigned* bar; unsigned x; volatile LAS unsigned* st; };
__device__ __forceinline__ XcdBarrier xcd_barrier_post(unsigned* bar, volatile LAS unsigned* st) {
    XcdBarrier b; b.bar = bar; b.x = xb_xcc_id(); b.st = st;
    if (threadIdx.x == 0) (void)xb_add(&bar[XB_XCNT(b.x)], 1u);
    return b;
}
__device__ __forceinline__ void xcd_barrier_complete(unsigned* bar, unsigned x, unsigned& nloc, unsigned& nx) {
    const unsigned G = gridDim.x * gridDim.y * gridDim.z;
    unsigned sum, cnt, mine, sp = 0u;
    for (;;) {
        sum = 0u; cnt = 0u; mine = 0u;
#pragma unroll
        for (unsigned j = 0; j < 16; ++j) { const unsigned c = xb_ld(&bar[XB_XCNT(j)]); sum += c; cnt += (c > 0u) ? 1u : 0u; mine = (j == x) ? c : mine; }
        if (sum == G) break;
        __builtin_amdgcn_s_sleep(1);
        if ((++sp & 255u) == 0u) { if (xb_ld(&bar[XB_TMO])) break; if (sp > XB_SPIN_CAP) { atomicAdd(&bar[XB_TMO], 1u); break; } }
    }
    nloc = mine > 0u ? mine : 1u; nx = cnt > 0u ? cnt : 1u;
}
__device__ __forceinline__ void xcd_barrier(const XcdBarrier& b) {
    asm volatile("s_waitcnt vmcnt(0)" ::: "memory");
    __syncthreads();
    if (threadIdx.x == 0) {
        unsigned* bar = b.bar;
        __builtin_amdgcn_s_waitcnt(0);
        unsigned nloc = b.st[0], nx = b.st[1];
        if (nloc == 0u) { xcd_barrier_complete(bar, b.x, nloc, nx); b.st[0] = nloc; b.st[1] = nx; }
        const unsigned old = xb_add(&bar[XB_XSUB(b.x)], 1u);
        const unsigned gen = old / nloc;
        if (old + 1u == (gen + 1u) * nloc) {
            __builtin_amdgcn_fence(__ATOMIC_RELEASE, "agent");
            asm volatile("s_waitcnt vmcnt(0)" ::: "memory");
            const unsigned og = xb_add(&bar[XB_TOP], 1u);
            const unsigned tg = og / nx;
            if (og + 1u == (tg + 1u) * nx) xb_add(&bar[XB_TOPGEN], 1u);
            else XB_SPIN(xb_ld(&bar[XB_TOPGEN]) == tg, bar);
            __builtin_amdgcn_fence(__ATOMIC_ACQUIRE, "agent");
            xb_add(&bar[XB_XGEN(b.x)], 1u);
            asm volatile("s_waitcnt vmcnt(0)" ::: "memory");
        } else {
            XB_SPIN(xb_ld(&bar[XB_XGEN(b.x)]) == gen, bar);
            __builtin_amdgcn_fence(__ATOMIC_ACQUIRE, "agent");
            asm volatile("s_waitcnt vmcnt(0)" ::: "memory");
        }
    }
    __syncthreads();
}
constexpr int LDSCTL_OFF = LDS_BYTES - 256;
constexpr int CW_BAR = 4096, CW_CTX = 8192;

#ifndef PROBE_GMLP2
#define PROBE_GMLP2 0
#endif
#ifndef ATT_PIPE
#define ATT_PIPE 1
#endif
#ifndef ATT_THRL
#define ATT_THRL 8
#endif
#ifndef ONE_LAUNCH
#define ONE_LAUNCH 1
#endif
#ifndef FAST_MIX
#define FAST_MIX 1
#endif
#ifndef PROBE_SEQ
#define PROBE_SEQ 0, 1, 2, 3, 4, 5, 6, 7, 8, 9, 10, 11
#endif

enum { PH_PRO = 0, PH_HN, PH_IN, PH_MIX, PH_A, PH_O, PH_H2R, PH_WCONV, PH_TOPK, PH_GU, PH_D, PH_FIN, PH_COUNT };

__global__ void __launch_bounds__(NTHREADS, 2) fwd(Args args) {
    extern __shared__ __attribute__((aligned(16))) unsigned char lds_raw[];
    LAS unsigned char* lds = (LAS unsigned char*)lds_raw;
    const int tid = threadIdx.x, lane = tid & 63, wave = __builtin_amdgcn_readfirstlane(tid >> 6);
    const int G = gridDim.x, bid = blockIdx.x;
    unsigned char* ws = args.ws;
    const int lo = args.ph_lo, hi = args.ph_hi;
#define IN(k) (lo <= (k) && (k) < hi)
    float* MOD = (float*)(ws + WS_MOD); f32x2* ROPE = (f32x2*)(ws + WS_ROPE);
    float* AFFT = (float*)(ws + WS_AFFT); int* TOPI = (int*)(ws + WS_TOPI); float* TOPW = (float*)(ws + WS_TOPW); int* SLOT = (int*)(ws + WS_SLOT);
    bf16_t* WSP = (bf16_t*)(ws + WS_WSP); bf16_t* WIN = (bf16_t*)(ws + WS_WIN); bf16_t* WAB = (bf16_t*)(ws + WS_WAB); bf16_t* WO = (bf16_t*)(ws + WS_WO);
    bf16_t* H = (bf16_t*)(ws + WS_H); bf16_t* VA = (bf16_t*)(ws + WS_VA); bf16_t* KB = (bf16_t*)(ws + WS_KB); bf16_t* VB = (bf16_t*)(ws + WS_VB);
    bf16_t* GT = (bf16_t*)(ws + WS_G); bf16_t* Y = (bf16_t*)(ws + WS_Y); bf16_t* TMP = (bf16_t*)(ws + WS_TMP); bf16_t* MERGED = (bf16_t*)(ws + WS_MERGED);
    bf16_t* WGU = (bf16_t*)(ws + WS_WGU); bf16_t* WD = (bf16_t*)(ws + WS_WD); bf16_t* H2 = (bf16_t*)(ws + WS_H2); bf16_t* ACT = (bf16_t*)(ws + WS_ACT); bf16_t* YB = (bf16_t*)(ws + WS_YB);
    const int gw = bid * NWAVES + wave, NGW = G * NWAVES;
    if (tid < 64) ((LAS unsigned*)(lds + LDSCTL_OFF))[tid] = 0u;
    __syncthreads();
    XcdBarrier bar; bar.bar = (unsigned*)(ws + WS_CTL) + CW_BAR; bar.x = 0; bar.st = nullptr;
    if (ONE_LAUNCH) bar = xcd_barrier_post((unsigned*)(ws + WS_CTL) + CW_BAR, (volatile LAS unsigned*)(lds + LDSCTL_OFF));
#define SEAM(k) do { if (ONE_LAUNCH && IN(k) && IN((k) + 1)) xcd_barrier(bar); } while (0)

    if (IN(PH_PRO)) {
        if (bid < 192) adaln_task(bid, args.in[I_C], args.in[I_CCTX], args.in[I_WADA], args.in[I_BADA], MOD, (LAS float*)lds, tid);
        else if (bid == 192) rope_table(ROPE, tid);
        __syncthreads();
        for (int i = bid * NTHREADS + tid; i < 8 * 128 * 128 / 4; i += G * NTHREADS) st4bf(WSP + 4 * i, *(const f32x4*)(args.in[I_WSP] + 4 * i));
        LAS float* scr = (LAS float*)(lds + wave * 16384);
        constexpr int I_IN = 16 * 176, I_P = 16 * 32;
        for (int it = gw; it < I_IN + 3 * I_P; it += NGW) {
            int r = it;
            if (r < I_IN) { const int kb = r / 176, nb = r % 176, n0 = nb * 32; int drow = n0;
                if (n0 >= OFF_GATE) { const int gcol = n0 - OFF_GATE, isb = gcol >= 1024, ch = gcol & 1023; drow = OFF_GATE + 256 * (ch >> 7) + (ch & 127) + (isb ? 128 : 0); }
                transpose_item(args.in[I_WIN], INCOLS, kb * 64, n0, WIN + (size_t)drow * 1024 + kb * 64, 1024, scr, lane); continue; } r -= I_IN;
            if (r < I_P) { const int kb = r / 32, nb = r % 32; transpose_item(args.in[I_WPA], 1024, kb * 64, nb * 32, WAB + (size_t)(nb * 32) * 2048 + kb * 64, 2048, scr, lane); continue; } r -= I_P;
            if (r < I_P) { const int kb = r / 32, nb = r % 32; transpose_item(args.in[I_WPB], 1024, kb * 64, nb * 32, WAB + (size_t)(nb * 32) * 2048 + 1024 + kb * 64, 2048, scr, lane); continue; } r -= I_P;
            { const int kb = r / 32, nb = r % 32; transpose_item(args.in[I_WOUT], 1024, kb * 64, nb * 32, WO + (size_t)(nb * 32) * 1024 + kb * 64, 1024, scr, lane); }
        }
    }
    SEAM(PH_PRO);
    if (IN(PH_HN)) {
        const float* g1n = args.in[I_N1G];
        const int HCH = (NROWS_H + NGW - 1) / NGW;
        f32x4 am[4], sm[4]; int mcur = -1;
        for (int kk = 0; kk < HCH; ++kk) {
            const int row = gw * HCH + kk; if (row >= NROWS_H) break;
            const float* xr; int mrow;
            if (row < NTOK) { xr = args.in[I_X] + (size_t)row * 1024; mrow = row >> 12; } else { xr = args.in[I_CTX] + (size_t)(row - NTOK) * 1024; mrow = 8; }
            f32x4 v[4]; float ss = 0.f;
#pragma unroll
            for (int j = 0; j < 4; ++j) { v[j] = *(const f32x4*)(xr + 4 * lane + 256 * j); ss += (v[j].x * v[j].x + v[j].y * v[j].y) + (v[j].z * v[j].z + v[j].w * v[j].w); }
            if (mrow != mcur) { mcur = mrow; const float* sh = MOD + mrow * 6144; const float* sc = sh + 1024;
#pragma unroll
                for (int j = 0; j < 4; ++j) { const int col = 4 * lane + 256 * j; am[j] = *(const f32x4*)(g1n + col) * (1.f + *(const f32x4*)(sc + col)); sm[j] = *(const f32x4*)(sh + col); } }
            const float rstd = 1.0f / sqrtf(wave_sum(ss) * (1.f / 1024.f) + EPS);
#pragma unroll
            for (int j = 0; j < 4; ++j) st4bf(H + (size_t)row * 1024 + 4 * lane + 256 * j, (v[j] * rstd) * am[j] + sm[j]);
        }
    }
    SEAM(PH_HN);
    if (IN(PH_IN)) {
        Gemm g{H, WIN, 1024, 1024, 1024, 0, 30, nullptr}; StaticOrder S; S.init(NTOK, INCOLS, G, bid, G == 256 ? 0 : 16);
        EpiIn E{Y, VA, KB, VB, GT, args.in[I_BMG], ROPE, (f32x2*)(ws + WS_STATS)};
        GEMM_PHASE<EpiIn, StaticOrder, false>(lds, g, S, E);
    }
    SEAM(PH_IN);
    if (IN(PH_MIX) && FAST_MIX) {
        unsigned* ctxcnt = (unsigned*)(ws + WS_CTL) + CW_CTX;
        if (G == 256 && bid < 16) {
            Gemm g{H, WIN, 1024, 1024, 1024, 0, 30, nullptr}; OneUnit S{NTOK / 256 + (bid >> 1), 12 + (bid & 1)};
            EpiIn E{Y, VA, KB, VB, GT, args.in[I_BMG], ROPE, (f32x2*)(ws + WS_STATS)};
            GEMM_PHASE<EpiIn, OneUnit, false>(lds, g, S, E);
            asm volatile("s_waitcnt vmcnt(0)" ::: "memory");
            __syncthreads();
            if (tid == 0) { __builtin_amdgcn_fence(__ATOMIC_RELEASE, "agent"); asm volatile("s_waitcnt vmcnt(0)" ::: "memory"); xb_add(ctxcnt, 1u); }
        }
        if (!(args.flags & 8)) for (int task = bid; task < NB * 32; task += G) mix::gmlp_unit(task, Y, (args.flags & 2) ? TMP : Y, (args.flags & 2) ? 1024 : 2048, VA, WSP, (const f32x2*)(ws + WS_STATS), args.in[I_LNG], args.in[I_LNB], args.in[I_BSP], lds);
        if (tid == 0) {
            unsigned sp = 0; while (xb_ld(ctxcnt) < 16u) { __builtin_amdgcn_s_sleep(2); if (++sp > (1u << 22)) break; }
            __builtin_amdgcn_fence(__ATOMIC_ACQUIRE, "agent"); asm volatile("s_waitcnt vmcnt(0)" ::: "memory");
        }
        __syncthreads();
#if ATT_PIPE
        att2::bf16x8 att_qr[4]; int att_base = 0; bool att_primed = false;
        int ubase, ucnt;
        if (G != 256) { ubase = bid * 8; ucnt = 0; }
        else if (bid < 16) { ubase = 6 * bid; ucnt = 6; } else if (bid < 48) { ubase = 96 + 9 * (bid - 16); ucnt = 9; } else { ubase = 384 + 8 * (bid - 48); ucnt = 8; }
        if (!(args.flags & 1)) for (int i = 0; i < ucnt; ++i) {
            const int u_ = ubase + i, task = u_ >> 1, hp = u_ & 1, un = u_ + 1, ntask = un >> 1; const bool more = i + 1 < ucnt; int nbase_ = 0;
            att2::attn_unit<ATT_THRL>(task >> 7, (task >> 2) & 31, task & 3, hp, att_base, att_primed, more, ntask >> 7, (ntask >> 2) & 31, ntask & 3, un & 1, att_qr, nbase_,
                                      Y, (args.flags & 4) ? TMP : Y + 1024, (args.flags & 4) ? 1024 : 2048, KB, VB, args.in[I_SINK], lds);
            att_base = nbase_; att_primed = more;
        }
        if (G != 256 && !(args.flags & 1)) for (int u_ = bid; u_ < NB * 32 * 8; u_ += G) {
            const int task = u_ >> 1; int nbase_ = 0;
            att2::attn_unit<ATT_THRL>(task >> 7, (task >> 2) & 31, task & 3, u_ & 1, 0, false, false, 0, 0, 0, 0, att_qr, nbase_, Y, (args.flags & 4) ? TMP : Y + 1024, (args.flags & 4) ? 1024 : 2048, KB, VB, args.in[I_SINK], lds);
        }
#else
        if (!(args.flags & 1)) for (int task = bid; task < NB * 32 * 4; task += G) mix::attn_unit(task >> 7, (task >> 2) & 31, task & 3, Y, (args.flags & 4) ? TMP : Y + 1024, (args.flags & 4) ? 1024 : 2048, KB, VB, args.in[I_SINK], lds);
#endif
    }
    SEAM(PH_MIX);
    if (IN(PH_A)) {
        Gemm g{Y, WAB, 2048, 2048, 2048, 0, 30, nullptr}; StaticOrder S; S.init(NTOK, 1024, G, bid, 0, 1);
        EpiAB E{MERGED, GT};
        GEMM_PHASE<EpiAB, StaticOrder, false, true>(lds, g, S, E);
    }
    SEAM(PH_A);
    if (IN(PH_O)) {
        Gemm g{MERGED, WO, 1024, 1024, 1024, 0, 30, nullptr}; StaticOrder S; S.init(NTOK, 1024, G, bid);
        EpiO E{(bf16_t*)args.out, MOD};
        GEMM_PHASE<EpiO, StaticOrder, false>(lds, g, S, E);
    }
    SEAM(PH_O);
    if (IN(PH_H2R)) {
        LAS float* wT = (LAS float*)lds;
        { f32x4 wv[8];
#pragma unroll
          for (int k = 0; k < 8; ++k) wv[k] = *(const f32x4*)(args.in[I_WR] + 4 * (tid + NTHREADS * k));
#pragma unroll
          for (int k = 0; k < 8; ++k) { const int f = tid + NTHREADS * k, col = f >> 2, e0 = 4 * (f & 3); wT[e0 * 1024 + col] = wv[k].x; wT[(e0 + 1) * 1024 + col] = wv[k].y; wT[(e0 + 2) * 1024 + col] = wv[k].z; wT[(e0 + 3) * 1024 + col] = wv[k].w; } }
        __syncthreads();
        const float* g2n = args.in[I_N2G];
        const int H2CH = (NTOK / 2 + NGW - 1) / NGW;
        const bool h32 = lane & 32, h16 = lane & 16, h8 = lane & 8, h4 = lane & 4;
        const int myexp = 8 * (lane >> 5) + 4 * ((lane >> 4) & 1) + 2 * ((lane >> 3) & 1) + ((lane >> 2) & 1);
        const bf16_t* D16 = (const bf16_t*)args.out;
        f32x4 vn[2][4]; u32x2 dn[2][4];
#pragma unroll
        for (int q = 0; q < 2; ++q)
#pragma unroll
            for (int j = 0; j < 4; ++j) { const size_t r_ = (size_t)(2 * (NTOK / 2 - 1 - (gw * H2CH < NTOK / 2 ? gw * H2CH : 0)) + q); vn[q][j] = *(const f32x4*)(args.in[I_X] + r_ * 1024 + 4 * lane + 256 * j); dn[q][j] = *(const u32x2*)(D16 + r_ * 2048 + 1024 + 4 * lane + 256 * j); }
        f32x4 amod[4], smod[4]; int bcur = -1;
        for (int kk = 0; kk < H2CH; ++kk) {
            const int rp = gw * H2CH + kk; if (rp >= NTOK / 2) break;
            const int row0 = 2 * (NTOK / 2 - 1 - rp), b = row0 >> 12;
            if (b != bcur) { bcur = b; const float* sh = MOD + b * 6144 + 3072; const float* sc = sh + 1024;
#pragma unroll
                for (int j = 0; j < 4; ++j) { const int col = 4 * lane + 256 * j; amod[j] = *(const f32x4*)(g2n + col) * (1.f + *(const f32x4*)(sc + col)); smod[j] = *(const f32x4*)(sh + col); } }
            f32x4 v[2][4]; float ss[2] = {0.f, 0.f};
#pragma unroll
            for (int q = 0; q < 2; ++q)
#pragma unroll
                for (int j = 0; j < 4; ++j) { const u32x2 dw = dn[q][j]; v[q][j] = vn[q][j] + (f32x4){bf2f(dw.x & 0xffffu), bf2f(dw.x >> 16), bf2f(dw.y & 0xffffu), bf2f(dw.y >> 16)}; ss[q] += (v[q][j].x * v[q][j].x + v[q][j].y * v[q][j].y) + (v[q][j].z * v[q][j].z + v[q][j].w * v[q][j].w); }
            { const int rn = (kk + 1 < H2CH && rp + 1 < NTOK / 2) ? rp + 1 : rp;
#pragma unroll
              for (int q = 0; q < 2; ++q)
#pragma unroll
                  for (int j = 0; j < 4; ++j) { const size_t r_ = (size_t)(2 * (NTOK / 2 - 1 - rn) + q); vn[q][j] = *(const f32x4*)(args.in[I_X] + r_ * 1024 + 4 * lane + 256 * j); dn[q][j] = *(const u32x2*)(D16 + r_ * 2048 + 1024 + 4 * lane + 256 * j); } }
            float rstd[2];
#pragma unroll
            for (int q = 0; q < 2; ++q) rstd[q] = 1.0f / sqrtf(wave_sum(ss[q]) * (1.f / 1024.f) + EPS);
            float lg[2][16];
#pragma unroll
            for (int q = 0; q < 2; ++q)
#pragma unroll
                for (int e = 0; e < 16; ++e) lg[q][e] = 0.f;
            f32x4 wb[2][4];
#pragma unroll
            for (int e = 0; e < 4; ++e) wb[0][e] = *(const LAS f32x4*)(wT + e * 1024 + 4 * lane);
            f32x4 h[2];
#pragma unroll
            for (int g = 0; g < 16; ++g) {
                const int j = g >> 2, eg = g & 3, col = 4 * lane + 256 * j;
                if (g + 1 < 16) {
                    const int jn = (g + 1) >> 2, en = (g + 1) & 3;
#pragma unroll
                    for (int e = 0; e < 4; ++e) wb[(g + 1) & 1][e] = *(const LAS f32x4*)(wT + (4 * en + e) * 1024 + 4 * lane + 256 * jn);
                }
                if (eg == 0) {
#pragma unroll
                    for (int q = 0; q < 2; ++q) { h[q] = (v[q][j] * rstd[q]) * amod[j] + smod[j]; st4bf(H2 + (size_t)(row0 + q) * 1024 + col, h[q]); }
                }
#pragma unroll
                for (int e = 0; e < 4; ++e) {
                    const f32x4 w = wb[g & 1][e];
#pragma unroll
                    for (int q = 0; q < 2; ++q) lg[q][4 * eg + e] += (h[q].x * w.x + h[q].y * w.y) + (h[q].z * w.z + h[q].w * w.w);
                    asm volatile("" : "+v"(lg[0][4 * eg + e]), "+v"(lg[1][4 * eg + e]));
                }
                asm volatile("" ::: "memory");
            }
#pragma unroll
            for (int q = 0; q < 2; ++q) {
                float a8[8], a4[4], a2[2], a1;
#pragma unroll
                for (int i = 0; i < 8; ++i) { const float send = h32 ? lg[q][i] : lg[q][i + 8], keep = h32 ? lg[q][i + 8] : lg[q][i]; a8[i] = keep + xchg32(send); }
#pragma unroll
                for (int i = 0; i < 4; ++i) { const float send = h16 ? a8[i] : a8[i + 4], keep = h16 ? a8[i + 4] : a8[i]; a4[i] = keep + xchg16(send); }
#pragma unroll
                for (int i = 0; i < 2; ++i) { const float send = h8 ? a4[i] : a4[i + 2], keep = h8 ? a4[i + 2] : a4[i]; a2[i] = keep + dpp_f<0x140>(send); }
                { const float send = h4 ? a2[0] : a2[1], keep = h4 ? a2[1] : a2[0]; a1 = keep + dpp_f<0x141>(send); }
                a1 += dpp_f<0x4E>(a1); a1 += dpp_f<0xB1>(a1);
                float mx = a1;
                mx = fmaxf(mx, dpp_f<0x141>(mx)); mx = fmaxf(mx, dpp_f<0x140>(mx)); mx = fmaxf(mx, xchg16(mx)); mx = fmaxf(mx, xchg32(mx));
                const float p = __expf(a1 - mx); float den = p;
                den += dpp_f<0x141>(den); den += dpp_f<0x140>(den); den += xchg16(den); den += xchg32(den);
                if ((lane & 3) == 0) AFFT[(size_t)(b * 16 + myexp) * SEQ + ((row0 + q) & (SEQ - 1))] = p / den;
            }
        }
    }
    if (IN(PH_WCONV)) {
        __syncthreads();
        LAS float* scr = (LAS float*)(lds + wave * 16384);
        constexpr int I_G = 16 * 16 * 64, I_D = 16 * 32 * 32;
        auto item = [&](int it) -> TrItem {
            int r = it; TrItem t;
            if (r < 2 * I_G) {
                const int up = r >= I_G; if (up) r -= I_G;
                r = (r & ~0x44) | ((r >> 4) & 0x4) | ((r << 4) & 0x40);
                const int e = r >> 10, kb = (r >> 6) & 15, nb = r & 63, n0 = nb * 32;
                const int drow = 256 * (n0 >> 7) + (n0 & 127) + (up ? 128 : 0);
                t.src = args.in[up ? I_WEU : I_WEG] + (size_t)e * 1024 * 2048 + (size_t)(kb * 64) * 2048 + n0; t.N = 2048;
                t.dst = WGU + (size_t)e * 4096 * 1024 + (size_t)drow * 1024 + kb * 64; t.ldt = 1024;
            } else {
                r -= 2 * I_G;
                r = (r & ~0x24) | ((r >> 3) & 0x4) | ((r << 3) & 0x20);
                const int e = r >> 10, kb = (r >> 5) & 31, nb = r & 31;
                t.src = args.in[I_WED] + (size_t)e * 2048 * 1024 + (size_t)(kb * 64) * 1024 + nb * 32; t.N = 1024;
                t.dst = WD + (size_t)e * 1024 * 2048 + (size_t)(nb * 32) * 2048 + kb * 64; t.ldt = 2048;
            }
            return t;
        };
        constexpr int NIT = 2 * I_G + I_D;
        if (gw < NIT) {
            TrItem cur = item(gw); f32x4 vc[8], vn[8];
            tr_load(cur, vc, lane);
            for (int it = gw; it < NIT; it += NGW) {
                const bool more = it + NGW < NIT;
                TrItem nxt = cur;
                if (more) { nxt = item(it + NGW); tr_load(nxt, vn, lane); }
                tr_store(cur, vc, scr, lane);
                cur = nxt;
#pragma unroll
                for (int i = 0; i < 8; ++i) vc[i] = vn[i];
            }
        }
    }
    SEAM(PH_WCONV);
    if (IN(PH_TOPK)) {
        LAS int* wsum = (LAS int*)lds;
        for (int task = bid; task < NE * NB; task += G) {
            const int e = task >> 3, b = task & 7;
            const float* aff = AFFT + (size_t)(b * 16 + e) * SEQ;
            unsigned k[8];
            { const u32x4 a0 = *(const u32x4*)(aff + 8 * tid), a1 = *(const u32x4*)(aff + 8 * tid + 4); k[0] = a0.x; k[1] = a0.y; k[2] = a0.z; k[3] = a0.w; k[4] = a1.x; k[5] = a1.y; k[6] = a1.z; k[7] = a1.w; }
            unsigned T = 0u; int it = 0;
            __syncthreads();
            for (int bit = 30; bit >= 0; --bit, ++it) {
                const unsigned cand = T | (1u << bit); int c = 0;
#pragma unroll
                for (int j = 0; j < 8; ++j) c += __builtin_popcountll(__ballot(k[j] >= cand));
                if (lane == 0) wsum[(it & 1) * 8 + wave] = c;
                __syncthreads();
                int tot = 0;
#pragma unroll
                for (int w = 0; w < 8; ++w) tot += wsum[(it & 1) * 8 + w];
                if (tot >= CAP) T = cand;
            }
            int cg = 0, ce = 0;
#pragma unroll
            for (int j = 0; j < 8; ++j) { cg += (k[j] > T) ? 1 : 0; ce += (k[j] == T) ? 1 : 0; }
            LAS int* sc1 = wsum + 16; LAS int* sc2 = wsum + 32;
            int ie = ce, ig = cg;
#pragma unroll
            for (int o = 1; o < 64; o <<= 1) { const int te = __shfl_up(ie, o), tg = __shfl_up(ig, o); if (lane >= o) { ie += te; ig += tg; } }
            __syncthreads();
            if (lane == 63) { sc1[wave] = ie; sc2[wave] = ig; }
            __syncthreads();
            int ebase = ie - ce, totg = 0;
#pragma unroll
            for (int w = 0; w < 8; ++w) { if (w < wave) ebase += sc1[w]; totg += sc2[w]; }
            const int need = CAP - totg;
            int sel[8], cs = 0, er = ebase;
#pragma unroll
            for (int j = 0; j < 8; ++j) { const bool eq = (k[j] == T); sel[j] = (k[j] > T) || (eq && er < need); er += eq ? 1 : 0; cs += sel[j]; }
            int is = cs;
#pragma unroll
            for (int o = 1; o < 64; o <<= 1) { const int ts = __shfl_up(is, o); if (lane >= o) is += ts; }
            __syncthreads();
            if (lane == 63) sc1[wave] = is;
            __syncthreads();
            int sbase = is - cs;
#pragma unroll
            for (int w = 0; w < 8; ++w) if (w < wave) sbase += sc1[w];
#pragma unroll
            for (int j = 0; j < 8; ++j) {
                const int t = 8 * tid + j; int slot = -1;
                if (sel[j]) { slot = sbase; ++sbase; const int prow = (e * 8 + b) * CAP + slot; TOPI[prow] = t; TOPW[prow] = __uint_as_float(k[j]); }
                SLOT[((size_t)b * SEQ + t) * 16 + e] = slot;
            }
            __syncthreads();
        }
    }
    SEAM(PH_TOPK);
    if (IN(PH_GU)) {
        Gemm g{H2, WGU, 1024, 1024, 1024, (size_t)4096 * 1024, 4, TOPI}; StaticOrder S; S.init(NPAIR, 4096, G, bid);
        EpiGU E{ACT};
        GEMM_PHASE<EpiGU, StaticOrder, true, false, true>(lds, g, S, E);
    }
    SEAM(PH_GU);
    if (IN(PH_D)) {
        Gemm g{ACT, WD, 2048, 2048, 2048, (size_t)1024 * 2048, 4, nullptr}; StaticOrder S; S.init(NPAIR, 1024, G, bid, 0, 1);
        EpiD E{YB, TOPW};
        GEMM_PHASE<EpiD, StaticOrder, false>(lds, g, S, E);
    }
    SEAM(PH_D);
    if (IN(PH_FIN)) {
        const float* fg = args.in[I_FING];
        const bf16_t* ZROW = (const bf16_t*)(ws + WS_CTL + 512 * 1024);
        int sln[2] = {-1, -1};
        const int FCH = (NTOK / 2 + NGW - 1) / NGW;
        if (gw * FCH < NTOK / 2 && lane < 16) { sln[0] = SLOT[(size_t)(2 * gw * FCH) * 16 + lane]; sln[1] = SLOT[(size_t)(2 * gw * FCH + 1) * 16 + lane]; }
        f32x4 g2v[4], fgv[4]; int bcur = -1;
#pragma unroll
        for (int h = 0; h < 2; ++h) { fgv[2 * h] = *(const f32x4*)(fg + 512 * h + 8 * lane); fgv[2 * h + 1] = *(const f32x4*)(fg + 512 * h + 8 * lane + 4); }
        for (int kk = 0; kk < FCH; ++kk) {
            const int rp = gw * FCH + kk; if (rp >= NTOK / 2) break;
            const int row0 = 2 * rp, b = row0 >> 12;
            const int sl[2] = {sln[0], sln[1]};
            { const int rn = rp + 1; if (kk + 1 < FCH && rn < NTOK / 2 && lane < 16) { sln[0] = SLOT[(size_t)(2 * rn) * 16 + lane]; sln[1] = SLOT[(size_t)(2 * rn + 1) * 16 + lane]; } }
            if (b != bcur) { bcur = b; const float* g2 = MOD + b * 6144 + 5120;
#pragma unroll
                for (int h = 0; h < 2; ++h) { g2v[2 * h] = *(const f32x4*)(g2 + 512 * h + 8 * lane); g2v[2 * h + 1] = *(const f32x4*)(g2 + 512 * h + 8 * lane + 4); } }
            f32x4 xv[2][4], acc[2][4];
#pragma unroll
            for (int q = 0; q < 2; ++q)
#pragma unroll
                for (int h = 0; h < 2; ++h) { const float* xp = args.in[I_X] + (size_t)(row0 + q) * 1024 + 512 * h + 8 * lane; f32x4 d0_, d1_; ld8bf((const bf16_t*)args.out + (size_t)(row0 + q) * 2048 + 1024 + 512 * h + 8 * lane, d0_, d1_);
                    xv[q][2 * h] = *(const f32x4*)xp + d0_; xv[q][2 * h + 1] = *(const f32x4*)(xp + 4) + d1_;
                    acc[q][2 * h] = (f32x4){0.f, 0.f, 0.f, 0.f}; acc[q][2 * h + 1] = (f32x4){0.f, 0.f, 0.f, 0.f}; }
#pragma unroll
            for (int q = 0; q < 2; ++q) {
                unsigned long long mask = __ballot(sl[q] >= 0);
                for (;;) {
                    const bf16_t* yr[4];
#pragma unroll
                    for (int k = 0; k < 4; ++k) {
                        if (mask) { const int ex = __builtin_ctzll(mask); mask &= mask - 1; const int s = __builtin_amdgcn_readlane(sl[q], ex); yr[k] = YB + (size_t)((ex * 8 + b) * CAP + s) * 1024; }
                        else yr[k] = ZROW;
                    }
                    u32x4 y[4][2];
#pragma unroll
                    for (int k = 0; k < 4; ++k)
#pragma unroll
                        for (int h = 0; h < 2; ++h) y[k][h] = *(const u32x4*)(yr[k] + 512 * h + 8 * lane);
#pragma unroll
                    for (int k = 0; k < 4; ++k)
#pragma unroll
                        for (int h = 0; h < 2; ++h) { const u32x4 w = y[k][h];
                            acc[q][2 * h] += (f32x4){bf2f(w.x & 0xffffu), bf2f(w.x >> 16), bf2f(w.y & 0xffffu), bf2f(w.y >> 16)};
                            acc[q][2 * h + 1] += (f32x4){bf2f(w.z & 0xffffu), bf2f(w.z >> 16), bf2f(w.w & 0xffffu), bf2f(w.w >> 16)}; }
                    if (!mask) break;
                }
            }
#pragma unroll
            for (int q = 0; q < 2; ++q) {
                float ss = 0.f;
#pragma unroll
                for (int h = 0; h < 2; ++h)
#pragma unroll
                    for (int u4 = 0; u4 < 2; ++u4) { const int col = 512 * h + 8 * lane + 4 * u4; f32x4& v = xv[q][2 * h + u4]; v = v + g2v[2 * h + u4] * acc[q][2 * h + u4]; ss += (v.x * v.x + v.y * v.y) + (v.z * v.z + v.w * v.w); }
                const float rstd = 1.0f / sqrtf(wave_sum(ss) * (1.f / 1024.f) + EPS);
#pragma unroll
                for (int h = 0; h < 2; ++h)
#pragma unroll
                    for (int u4 = 0; u4 < 2; ++u4) { const int col = 512 * h + 8 * lane + 4 * u4; *(f32x4*)(args.out + (size_t)(row0 + q) * 1024 + col) = xv[q][2 * h + u4] * rstd * fgv[2 * h + u4]; }
            }
        }
    }
#undef IN
}

extern "C" void kernel_launch(void* const* d_in, const int* in_sizes, int n_in, void* d_out, int out_size, void* d_ws, size_t ws_size, hipStream_t stream) {
    static int grid = 0;
    if (grid == 0) {
        if (n_in != 23 || in_sizes[0] != NTOK * DM || out_size != NTOK * DM || ws_size < WS_END) {
            fprintf(stderr, "kernel_launch: unexpected problem (n_in %d, in0 %d, out %d, ws %zu < %zu?)\n", n_in, n_in > 0 ? in_sizes[0] : -1, out_size, ws_size, (size_t)WS_END); grid = -1; return; }
        if (hipFuncSetAttribute((const void*)fwd, hipFuncAttributeMaxDynamicSharedMemorySize, LDS_BYTES) != hipSuccess) { fprintf(stderr, "kernel_launch: hipFuncSetAttribute failed\n"); grid = -1; return; }
        int dev = 0, cus = 0;
        if (hipGetDevice(&dev) != hipSuccess || hipDeviceGetAttribute(&cus, hipDeviceAttributeMultiprocessorCount, dev) != hipSuccess) { grid = -1; return; }
        grid = cus;
    }
    if (grid < 0) return;
    (void)hipMemsetAsync((char*)d_ws + WS_CTL, 0, 1 * MiB, stream);
    Args a{};
    for (int i = 0; i < 23; ++i) a.in[i] = (const float*)d_in[i];
    a.out = (float*)d_out; a.ws = (unsigned char*)d_ws;
    if (ONE_LAUNCH) {
        a.ph_lo = 0; a.ph_hi = PH_COUNT;
        hipLaunchKernelGGL(fwd, dim3(grid), dim3(NTHREADS), LDS_BYTES, stream, a);
    } else {
        static const int seq[] = {PROBE_SEQ};
        for (unsigned i = 0; i < sizeof(seq) / sizeof(seq[0]); ++i) {
            a.ph_lo = seq[i] % 100; a.ph_hi = seq[i] % 100 + 1; a.flags = seq[i] / 100;
            hipLaunchKernelGGL(fwd, dim3(grid), dim3(NTHREADS), LDS_BYTES, stream, a);
        }
    }
}
```

```cpp
#include <hip/hip_runtime.h>
#include <cstdio>
#include <cstdint>

#define LAS __attribute__((address_space(3)))
typedef unsigned short bf16_t;
typedef float f32x4 __attribute__((ext_vector_type(4)));
typedef float f32x2 __attribute__((ext_vector_type(2)));
typedef unsigned u32x4 __attribute__((ext_vector_type(4)));
typedef unsigned u32x2 __attribute__((ext_vector_type(2)));
typedef int i32x4 __attribute__((ext_vector_type(4)));

constexpr int DM = 1024, NB = 8, SEQ = 4096, NTOK = NB * SEQ, CTXL = 256, NCTX = NB * CTXL, NROWS_H = NTOK + NCTX;
constexpr int INCOLS = 5632, OFF_Q = 2048, OFF_K = 3072, OFF_VB = 3328, OFF_GATE = 3584;
constexpr int NE = 16, CAP = 512, DE = 2048, NPAIR = NE * NB * CAP;
constexpr float EPS = 1e-6f, LOG2E = 1.4426950408889634f, C2 = 0.125f * LOG2E;
constexpr int NTHREADS = 512, NWAVES = 8;

constexpr size_t MiB = 1u << 20;
constexpr size_t WS_CTL = 0;
constexpr size_t WS_MOD = 1 * MiB;
constexpr size_t WS_ROPE = 1 * MiB + 512 * 1024;
constexpr size_t WS_AFFT = 2 * MiB;
constexpr size_t WS_TOPI = 4 * MiB;
constexpr size_t WS_TOPW = 4 * MiB + 512 * 1024;
constexpr size_t WS_SLOT = 5 * MiB;
constexpr size_t WS_WSP = 7 * MiB;
constexpr size_t WS_WIN = 8 * MiB;
constexpr size_t WS_WAB = 19 * MiB;
constexpr size_t WS_WO = 23 * MiB;
constexpr size_t WS_R = 25 * MiB;
constexpr size_t WS_H = WS_R;
constexpr size_t WS_VA = WS_R + 68 * MiB;
constexpr size_t WS_KB = WS_VA + 64 * MiB;
constexpr size_t WS_VB = WS_KB + 17 * MiB;
constexpr size_t WS_G = WS_VB + 17 * MiB;
constexpr size_t WS_Y = WS_G + 128 * MiB;
constexpr size_t WS_TMP = WS_Y + 128 * MiB;
constexpr size_t WS_STATS = WS_TMP + 64 * MiB;
constexpr size_t WS_MERGED = WS_H;
constexpr size_t WS_WGU = WS_R;
constexpr size_t WS_WD = WS_R + 128 * MiB;
constexpr size_t WS_H2 = WS_R + 192 * MiB;
constexpr size_t WS_ACT = WS_R + 256 * MiB;
constexpr size_t WS_YB = WS_WGU;
constexpr size_t WS_END = 537 * MiB;
static_assert(WS_STATS + 4 * MiB <= WS_END && WS_ACT + 256 * MiB == WS_END, "ws map");

constexpr int LDS_BYTES = 147456;

__device__ __forceinline__ float bf2f(unsigned b) { return __uint_as_float(b << 16); }
__device__ __forceinline__ unsigned f2bf(float f) { unsigned u = __float_as_uint(f); return (u + 0x7fffu + ((u >> 16) & 1u)) >> 16; }
__device__ __forceinline__ unsigned pk2(float lo, float hi) { typedef float f2_ __attribute__((ext_vector_type(2))); typedef __bf16 b2_ __attribute__((ext_vector_type(2))); f2_ v = {lo, hi}; b2_ b = __builtin_convertvector(v, b2_); return __builtin_bit_cast(unsigned, b); }
__device__ __forceinline__ void st4bf(bf16_t* p, f32x4 v) { u32x2 w; w.x = pk2(v.x, v.y); w.y = pk2(v.z, v.w); *(u32x2*)p = w; }
__device__ __forceinline__ void st8bf(bf16_t* p, f32x4 a, f32x4 b) { u32x4 w; w.x = pk2(a.x, a.y); w.y = pk2(a.z, a.w); w.z = pk2(b.x, b.y); w.w = pk2(b.z, b.w); *(u32x4*)p = w; }
__device__ __forceinline__ void ld8bf(const bf16_t* p, f32x4& a, f32x4& b) { const u32x4 w = *(const u32x4*)p; a.x = bf2f(w.x & 0xffffu); a.y = bf2f(w.x >> 16); a.z = bf2f(w.y & 0xffffu); a.w = bf2f(w.y >> 16); b.x = bf2f(w.z & 0xffffu); b.y = bf2f(w.z >> 16); b.z = bf2f(w.w & 0xffffu); b.w = bf2f(w.w >> 16); }
__device__ __forceinline__ f32x4 ld4bf(const bf16_t* p) { const u32x2 w = *(const u32x2*)p; f32x4 v; v.x = bf2f(w.x & 0xffffu); v.y = bf2f(w.x >> 16); v.z = bf2f(w.y & 0xffffu); v.w = bf2f(w.y >> 16); return v; }
__device__ __forceinline__ float sigmoidf_(float x) { return __builtin_amdgcn_rcpf(1.f + __builtin_amdgcn_exp2f(x * -1.4426950409f)); }
__device__ __forceinline__ float siluf_(float x) { return x * __builtin_amdgcn_rcpf(1.f + __builtin_amdgcn_exp2f(x * -1.4426950409f)); }
__device__ __forceinline__ float gelu_t(float x) { const float t = x * __builtin_fmaf(x * x, -0.10294324f, -2.3022082f); return x * __builtin_amdgcn_rcpf(1.f + __builtin_amdgcn_exp2f(t)); }
__device__ __forceinline__ f32x2 rcp2_(f32x2 d) { f32x2 r; r.x = __builtin_amdgcn_rcpf(d.x); r.y = __builtin_amdgcn_rcpf(d.y); return r; }
__device__ __forceinline__ f32x2 exp2_2_(f32x2 t) { f32x2 e; e.x = __builtin_amdgcn_exp2f(t.x); e.y = __builtin_amdgcn_exp2f(t.y); return e; }
__device__ __forceinline__ f32x2 gelu2_(f32x2 x) { const f32x2 t = x * ((x * x) * -0.10294324f + -2.3022082f); return x * rcp2_(exp2_2_(t) + 1.0f); }
__device__ __forceinline__ f32x2 sigm2_(f32x2 x) { return rcp2_(exp2_2_(x * -1.4426950409f) + 1.0f); }
__device__ __forceinline__ f32x4 gelu4_(f32x4 v) { const f32x2 a = gelu2_((f32x2){v.x, v.y}), b = gelu2_((f32x2){v.z, v.w}); return (f32x4){a.x, a.y, b.x, b.y}; }
__device__ __forceinline__ f32x4 sigm4_(f32x4 v) { const f32x2 a = sigm2_((f32x2){v.x, v.y}), b = sigm2_((f32x2){v.z, v.w}); return (f32x4){a.x, a.y, b.x, b.y}; }
template <int CTRL> __device__ __forceinline__ float dpp_f(float v) { const int i = __builtin_bit_cast(int, v); return __builtin_bit_cast(float, __builtin_amdgcn_update_dpp(i, i, CTRL, 0xf, 0xf, true)); }
__device__ __forceinline__ float xchg16(float v) { auto r = __builtin_amdgcn_permlane16_swap(__float_as_uint(v), __float_as_uint(v), false, false); return __uint_as_float((threadIdx.x & 16) ? r[0] : r[1]); }
__device__ __forceinline__ float xchg32(float v) { auto r = __builtin_amdgcn_permlane32_swap(__float_as_uint(v), __float_as_uint(v), false, false); return __uint_as_float((threadIdx.x & 32) ? r[0] : r[1]); }
__device__ __forceinline__ float wave_sum(float v) {
    v += dpp_f<0xB1>(v); v += dpp_f<0x4E>(v); v += dpp_f<0x141>(v); v += dpp_f<0x140>(v); v += xchg16(v); v += xchg32(v);
    return v;
}
__device__ __forceinline__ int wave_sum_i(int v) {
#pragma unroll
    for (int o = 1; o < 64; o <<= 1) v += __shfl_xor(v, o);
    return v;
}
#define LDS_WAIT() asm volatile("s_waitcnt lgkmcnt(0)" ::: "memory")

struct Args { const float* in[23]; float* out; unsigned char* ws; int ph_lo, ph_hi, flags, pad; };
enum { I_X = 0, I_C, I_CTX, I_CCTX, I_WADA, I_BADA, I_N1G, I_WIN, I_BMG, I_LNG, I_LNB, I_WSP, I_BSP, I_SINK, I_WPA, I_WPB, I_WOUT, I_N2G, I_WR, I_WEG, I_WEU, I_WED, I_FING };

struct Unit { int pm, pn; };
struct Gemm {
    const bf16_t* A; const bf16_t* Bt; int lda, ldb, K;
    size_t bgs; int tpg_shift;
    const int* gidx;
};
constexpr int NXCD = 8, WGM = 8;
struct StaticOrder {
    int nM, nN, nwg, G, c, extra, rev;
    __device__ void init(int M, int N, int G_, int c_, int extra_ = 0, int rev_ = 0) { nM = M / 256; nN = N / 256; nwg = nM * nN; G = G_; c = c_; extra = extra_; rev = rev_; }
    __device__ bool next(int i, Unit& u) const {
        const long L = (long)i * G + c;
        if (L >= nwg) { const int x = (int)(L - nwg); if (x >= extra) return false; u.pm = NTOK / 256 + (x >> 1); u.pn = 12 + (x & 1); return true; }
        int wgid = (int)L; { const int q = nwg / NXCD, r = nwg % NXCD, xcd = wgid % NXCD, off = wgid / NXCD; wgid = (xcd < r ? xcd * (q + 1) : r * (q + 1) + (xcd - r) * q) + off; }
        const int nig = WGM * nN, gid = wgid / nig, fm = gid * WGM, gsz = (nM - fm) < WGM ? (nM - fm) : WGM;
        u.pm = fm + ((wgid % nig) % gsz); u.pn = (wgid % nig) / gsz; if (rev) u.pm = nM - 1 - u.pm; return true;
    }
};

struct OneUnit { int pm, pn; __device__ bool next(int i, Unit& u) const { if (i) return false; u.pm = pm; u.pn = pn; return true; } };

typedef f32x4 Acc[2][2][4][2];

namespace pg8 {
typedef short bf16x8 __attribute__((ext_vector_type(8)));
constexpr int BK = 64, HALF = 128, HTB = HALF * BK * 2, STAGE_BYTES = 8 * HTB;
__device__ __forceinline__ int lds_byte(int r, int c) { const int st = (r >> 4) * 2 + (c >> 5), rr = r & 15, cc = c & 31, ob = rr * 64 + cc * 2; return st * 1024 + (ob ^ (((ob >> 9) & 1) << 5)); }
__device__ __forceinline__ void stage_rc(int b, int& R, int& C) { const int st = b / 1024, sb = b % 1024, swz = sb ^ (((sb >> 9) & 1) << 5); R = (st >> 1) * 16 + swz / 64; C = (st & 1) * 32 + (swz % 64) / 2; }

template <class Epi, class Sched, bool GATHER, bool HOOK = false, bool RELAX = false>
__device__ __forceinline__ void gemm_phase(LAS unsigned char* lds, const Gemm g, const Sched& S, const Epi& E) {
    const int tid = threadIdx.x, wid = __builtin_amdgcn_readfirstlane(tid >> 6), lane = tid & 63, wr = wid >> 2, wc = wid & 3, fr = lane & 15, fq = lane >> 4;
    const int nt = g.K / BK;
    int Rs[2], Cs[2]; unsigned voffBp[2][2], voffB[2], voffBn[2], vA[2][2], vN[2][2];
#pragma unroll
    for (int i = 0; i < 2; ++i) { stage_rc(tid * 16 + i * 8192, Rs[i], Cs[i]); voffBp[0][i] = (unsigned)(Rs[i] * g.ldb + Cs[i]) * 2u;
        const int rho = Rs[i] & 31, Rb = (Rs[i] & ~31) + 8 * ((rho & 15) >> 2) + 4 * (rho >> 4) + (rho & 3); voffBp[1][i] = (unsigned)(Rb * g.ldb + Cs[i]) * 2u; }
    const size_t kstep = (size_t)(BK * 2);
    const size_t hstepB = (size_t)HALF * g.ldb * 2;
    const unsigned ldsw = (unsigned)wid * 1024u;
    const int aoff = lds_byte(wr * 64 + fr, fq * 8), boff = lds_byte(wc * 32 + fr, fq * 8);
#define PG8_SA(b, h) (((b) * 2 + (h)) * HTB)
#define PG8_SB(b, h) ((4 + (b) * 2 + (h)) * HTB)
#define PG8_STAGE(bufoff, gbase, voff) do { _Pragma("unroll") for (int _i = 0; _i < 2; ++_i) \
        __builtin_amdgcn_global_load_lds((const unsigned*)((const char*)(gbase) + (voff)[_i]), (LAS unsigned*)(lds + (bufoff) + ldsw + _i * 8192), 16, 0, 0); } while (0)
#define PG8_LDA(dst, b, h) do { _Pragma("unroll") for (int m = 0; m < 4; ++m) _Pragma("unroll") for (int k = 0; k < 2; ++k) dst[m][k] = *(const LAS bf16x8*)(lds + PG8_SA(b, h) + aoff + m * 2048 + k * 1024); } while (0)
#define PG8_LDB(dst, b, h) do { _Pragma("unroll") for (int n = 0; n < 2; ++n) _Pragma("unroll") for (int k = 0; k < 2; ++k) dst[n][k] = *(const LAS bf16x8*)(lds + PG8_SB(b, h) + boff + n * 2048 + k * 1024); } while (0)
#define PG8_MMA(ai, bj, At, Bt) do { __builtin_amdgcn_s_setprio(1); _Pragma("unroll") for (int m = 0; m < 4; ++m) _Pragma("unroll") for (int n = 0; n < 2; ++n) _Pragma("unroll") for (int k = 0; k < 2; ++k) \
        acc[ai][bj][m][n] = __builtin_amdgcn_mfma_f32_16x16x32_bf16(Bt[n][k], At[m][k], acc[ai][bj][m][n], 0, 0, 0); __builtin_amdgcn_s_setprio(0); } while (0)
#define PG8_WAIT_V(n) asm volatile("s_waitcnt vmcnt(" #n ")" ::: "memory")
#define PG8_WAIT_L(n) asm volatile("s_waitcnt lgkmcnt(" #n ")" ::: "memory")
#define PG8_BAR __builtin_amdgcn_s_barrier()
#define PG8_SCHED __builtin_amdgcn_sched_barrier(0)
#define PG8_AVOFF(dst, U) do { _Pragma("unroll") for (int _h = 0; _h < 2; ++_h) _Pragma("unroll") for (int _i = 0; _i < 2; ++_i) \
        dst[_h][_i] = GATHER ? (unsigned)((((U).pm >> 1) & 7) * SEQ + g.gidx[(U).pm * 256 + _h * 128 + Rs[_i]]) * (unsigned)(g.lda * 2) + (unsigned)(Cs[_i] * 2) \
                             : (unsigned)((_h * 128 + Rs[_i]) * g.lda + Cs[_i]) * 2u; } while (0)
#define PG8_ABASE(U) ((const char*)g.A + (GATHER ? (size_t)0 : (size_t)(U).pm * 256 * g.lda * 2))
#define PG8_BBASE(U) ((const char*)g.Bt + ((size_t)((U).pm >> g.tpg_shift) * g.bgs + (size_t)(U).pn * 256 * g.ldb) * 2)
    Unit cur, nxt; int ui = 0;
    if (!S.next(0, cur)) return;
    Acc acc;
#pragma unroll
    for (int a = 0; a < 2; ++a)
#pragma unroll
        for (int b = 0; b < 2; ++b)
#pragma unroll
            for (int m = 0; m < 4; ++m)
#pragma unroll
                for (int n = 0; n < 2; ++n) acc[a][b][m][n] = (f32x4){0.f, 0.f, 0.f, 0.f};
    bf16x8 At[4][2], B0[2][2], B1[2][2];
    PG8_AVOFF(vA, cur);
    { const bool pc = E.perm(cur); voffB[0] = pc ? voffBp[1][0] : voffBp[0][0]; voffB[1] = pc ? voffBp[1][1] : voffBp[0][1]; }
    const char* cA = PG8_ABASE(cur); const char* cB = PG8_BBASE(cur);
    PG8_STAGE(PG8_SB(0, 0), cB, voffB); PG8_STAGE(PG8_SB(0, 1), cB + hstepB, voffB); PG8_STAGE(PG8_SA(0, 0), cA, vA[0]); PG8_STAGE(PG8_SA(0, 1), cA, vA[1]);
    if (wr == 1) PG8_BAR;
    PG8_WAIT_V(2); PG8_BAR;
    PG8_STAGE(PG8_SB(1, 0), cB + kstep, voffB); PG8_STAGE(PG8_SA(1, 0), cA + kstep, vA[0]); PG8_STAGE(PG8_SB(1, 1), cB + hstepB + kstep, voffB);
    if constexpr (RELAX) { PG8_WAIT_V(0); } else { PG8_WAIT_V(6); } PG8_BAR;
    for (;;) {
        const bool has_next = S.next(ui + 1, nxt);
        const char* nA = has_next ? PG8_ABASE(nxt) : cA; const char* nB = has_next ? PG8_BBASE(nxt) : cB;
        { const bool pn_ = has_next ? E.perm(nxt) : E.perm(cur); voffBn[0] = pn_ ? voffBp[1][0] : voffBp[0][0]; voffBn[1] = pn_ ? voffBp[1][1] : voffBp[0][1]; }
        if (GATHER) {
#pragma unroll
            for (int h = 0; h < 2; ++h)
#pragma unroll
                for (int i = 0; i < 2; ++i) vN[h][i] = vA[h][i];
            if (has_next && wid == 0)
                __builtin_amdgcn_global_load_lds((const unsigned*)(g.gidx + nxt.pm * 256 + lane * 4), (LAS unsigned*)(lds + STAGE_BYTES + (ui & 1) * 1024), 16, 0, 0);
        }
        if constexpr (RELAX) {
#define PG8_WAIT_RELAX asm volatile("s_waitcnt vmcnt(%0)" :: "n"(8 + Epi::kStores) : "memory")
            const char* a1 = cA + kstep; const char* a2 = cA + 2 * kstep; const char* b2 = cB + 2 * kstep; const char* a3 = a2 + kstep; const char* b3 = b2 + kstep;
            PG8_LDB(B0, 0, 0); PG8_LDB(B1, 0, 1); PG8_SCHED; PG8_LDA(At, 0, 0); PG8_STAGE(PG8_SA(1, 1), a1, vA[1]);
            PG8_WAIT_RELAX; PG8_WAIT_L(0); PG8_BAR; PG8_MMA(0, 0, At, B0); PG8_MMA(0, 1, At, B1); PG8_BAR; PG8_SCHED;
            PG8_LDA(At, 0, 1); PG8_STAGE(PG8_SB(0, 0), b2, voffB); PG8_STAGE(PG8_SB(0, 1), b2 + hstepB, voffB); PG8_STAGE(PG8_SA(0, 0), a2, vA[0]);
            PG8_WAIT_RELAX; PG8_WAIT_L(0); PG8_BAR; PG8_MMA(1, 0, At, B0); PG8_MMA(1, 1, At, B1); PG8_BAR; PG8_SCHED;
            PG8_LDB(B0, 1, 0); PG8_LDB(B1, 1, 1); PG8_SCHED; PG8_LDA(At, 1, 0); PG8_STAGE(PG8_SA(0, 1), a2, vA[1]);
            PG8_WAIT_V(8); PG8_WAIT_L(0); PG8_BAR; PG8_MMA(0, 0, At, B0); PG8_MMA(0, 1, At, B1); PG8_BAR; PG8_SCHED;
            PG8_LDA(At, 1, 1); PG8_STAGE(PG8_SB(1, 0), b3, voffB); PG8_STAGE(PG8_SB(1, 1), b3 + hstepB, voffB); PG8_STAGE(PG8_SA(1, 0), a3, vA[0]);
            PG8_WAIT_V(8); PG8_WAIT_L(0); PG8_BAR; PG8_MMA(1, 0, At, B0); PG8_MMA(1, 1, At, B1); PG8_BAR; PG8_SCHED;
#undef PG8_WAIT_RELAX
        }
        for (int t = RELAX ? 2 : 0; t < nt; t += 2) {
            const bool last = (t == nt - 2);
            if (GATHER) { if (t == 4 && has_next) {
                const LAS int* li = (const LAS int*)(lds + STAGE_BYTES + (ui & 1) * 1024);
#pragma unroll
                for (int h = 0; h < 2; ++h)
#pragma unroll
                    for (int i = 0; i < 2; ++i) vN[h][i] = (unsigned)(((nxt.pm >> 1) & 7) * SEQ + li[h * 128 + Rs[i]]) * (unsigned)(g.lda * 2) + (unsigned)(Cs[i] * 2);
            } }
            if constexpr (HOOK) { if (t == (nt >> 1)) E.mid(acc, cur, wr, wc, fr, fq); }
            const char* a1 = cA + (size_t)(t + 1) * kstep;
            const char* a2 = last ? nA : cA + (size_t)(t + 2) * kstep; const char* b2 = last ? nB : cB + (size_t)(t + 2) * kstep;
            const char* a3 = a2 + kstep; const char* b3 = b2 + kstep;
            unsigned v2[2][2];
#pragma unroll
            for (int h = 0; h < 2; ++h)
#pragma unroll
                for (int i = 0; i < 2; ++i) v2[h][i] = (GATHER && last) ? vN[h][i] : vA[h][i];
            unsigned vb2[2]; vb2[0] = last ? voffBn[0] : voffB[0]; vb2[1] = last ? voffBn[1] : voffB[1];
            PG8_LDB(B0, 0, 0); PG8_LDB(B1, 0, 1); PG8_SCHED; PG8_LDA(At, 0, 0); PG8_STAGE(PG8_SA(1, 1), a1, vA[1]);
            PG8_WAIT_V(8); PG8_WAIT_L(0); PG8_BAR; PG8_MMA(0, 0, At, B0); PG8_MMA(0, 1, At, B1); PG8_BAR; PG8_SCHED;
            PG8_LDA(At, 0, 1); PG8_STAGE(PG8_SB(0, 0), b2, vb2); PG8_STAGE(PG8_SB(0, 1), b2 + hstepB, vb2); PG8_STAGE(PG8_SA(0, 0), a2, v2[0]);
            PG8_WAIT_V(8); PG8_WAIT_L(0); PG8_BAR; PG8_MMA(1, 0, At, B0); PG8_MMA(1, 1, At, B1); PG8_BAR; PG8_SCHED;
            PG8_LDB(B0, 1, 0); PG8_LDB(B1, 1, 1); PG8_SCHED; PG8_LDA(At, 1, 0); PG8_STAGE(PG8_SA(0, 1), a2, v2[1]);
            PG8_WAIT_V(8); PG8_WAIT_L(0); PG8_BAR; PG8_MMA(0, 0, At, B0); PG8_MMA(0, 1, At, B1); PG8_BAR; PG8_SCHED;
            PG8_LDA(At, 1, 1); PG8_STAGE(PG8_SB(1, 0), b3, vb2); PG8_STAGE(PG8_SB(1, 1), b3 + hstepB, vb2); PG8_STAGE(PG8_SA(1, 0), a3, v2[0]);
            PG8_WAIT_V(8); PG8_WAIT_L(0); PG8_BAR; PG8_MMA(1, 0, At, B0); PG8_MMA(1, 1, At, B1); PG8_BAR; PG8_SCHED;
        }
        if (wr == 0) PG8_BAR;
        E(acc, cur, wr, wc, fr, fq);
        if (!has_next) break;
#pragma unroll
        for (int a = 0; a < 2; ++a)
#pragma unroll
            for (int b = 0; b < 2; ++b)
#pragma unroll
                for (int m = 0; m < 4; ++m)
#pragma unroll
                    for (int n = 0; n < 2; ++n) acc[a][b][m][n] = (f32x4){0.f, 0.f, 0.f, 0.f};
        cur = nxt; cA = nA; cB = nB; ++ui; voffB[0] = voffBn[0]; voffB[1] = voffBn[1];
        if (GATHER) {
#pragma unroll
            for (int h = 0; h < 2; ++h)
#pragma unroll
                for (int i = 0; i < 2; ++i) vA[h][i] = vN[h][i];
        }
        if (wr == 1) PG8_BAR;
    }
    PG8_WAIT_V(0);
    PG8_BAR;
#undef PG8_SA
#undef PG8_SB
#undef PG8_STAGE
#undef PG8_LDA
#undef PG8_LDB
#undef PG8_MMA
#undef PG8_WAIT_V
#undef PG8_WAIT_L
#undef PG8_BAR
#undef PG8_SCHED
#undef PG8_AVOFF
#undef PG8_ABASE
#undef PG8_BBASE
}
}

#define GEMM_PHASE pg8::gemm_phase

struct EpiIn {
    bf16_t *Y, *VA, *KB, *VB, *G; const float* bgate; const f32x2* rope; f32x2* STATS;
    static constexpr int kStores = 16;
    __device__ __forceinline__ bool perm(const Unit& u) const { return u.pn < 8 || u.pn > 12; }
    template <int KIND> __device__ __forceinline__ void run(const Acc& acc, const Unit& u, int wr, int wc, int fr, int fq) const {
        const int pn = u.pn;
#pragma unroll
        for (int ai = 0; ai < 2; ++ai)
#pragma unroll
            for (int m = 0; m < 4; ++m) {
                const int row = u.pm * 256 + ai * 128 + wr * 64 + m * 16 + fr;
                float ssum = 0.f, ssq = 0.f;
#pragma unroll
                for (int bj = 0; bj < 2; ++bj) {
                    f32x4 v0 = acc[ai][bj][m][0], v1 = acc[ai][bj][m][1];
                    if constexpr (KIND == 0 || KIND == 1) {
                        const int c8 = bj * 128 + wc * 32 + 8 * fq;
                        v0 = gelu4_(v0); v1 = gelu4_(v1);
                        if constexpr (KIND == 0) st8bf(Y + (size_t)row * 2048 + pn * 256 + c8, v0, v1);
                        else {
                            st8bf(VA + (size_t)row * 1024 + (pn - 4) * 256 + c8, v0, v1);
                            ssum += ((v0.x + v0.y) + (v0.z + v0.w)) + ((v1.x + v1.y) + (v1.z + v1.w));
                            ssq += ((v0.x * v0.x + v0.y * v0.y) + (v0.z * v0.z + v0.w * v0.w)) + ((v1.x * v1.x + v1.y * v1.y) + (v1.z * v1.z + v1.w * v1.w));
                        }
                    } else if constexpr (KIND == 2) {
                        const int cl = bj * 128 + wc * 32 + 4 * fq;
                        f32x4 o0 = v0, o1 = v1;
                        if (row < NTOK) {
                            const int t = row & (SEQ - 1), pos = (wc & 1) ? (t & 63) : (t >> 6);
                            const f32x2* rp = rope + pos * 16 + 4 * fq;
#pragma unroll
                            for (int j = 0; j < 4; ++j) { const f32x2 cs = rp[j]; o0[j] = v0[j] * cs.x - v1[j] * cs.y; o1[j] = v0[j] * cs.y + v1[j] * cs.x; }
                        }
                        if (pn < 12) { bf16_t* p = Y + (size_t)row * 2048 + 1024 + (pn - 8) * 256 + cl; st4bf(p, o0 * C2); st4bf(p + 16, o1 * C2); }
                        else { bf16_t* p = KB + (size_t)row * 256 + cl; st4bf(p, o0); st4bf(p + 16, o1); }
                    } else if constexpr (KIND == 3) {
                        st8bf(VB + (size_t)row * 256 + bj * 128 + wc * 32 + 8 * fq, v0, v1);
                    } else {
                        if (bj == 0) {
                            const int ch = (pn - 14) * 128 + wc * 32 + 8 * fq;
                            const f32x4 a0 = sigm4_(v0 + *(const f32x4*)(bgate + ch)), a1 = sigm4_(v1 + *(const f32x4*)(bgate + ch + 4));
                            const f32x4 g0 = sigm4_(acc[ai][1][m][0] + *(const f32x4*)(bgate + 1024 + ch)), g1 = sigm4_(acc[ai][1][m][1] + *(const f32x4*)(bgate + 1024 + ch + 4));
                            f32x4 r0, r1;
#pragma unroll
                            for (int j = 0; j < 4; ++j) { r0[j] = a0[j] * __builtin_amdgcn_rcpf(g0[j]); r1[j] = a1[j] * __builtin_amdgcn_rcpf(g1[j]); }
                            st8bf(G + (size_t)row * 2048 + ch, r0, r1); st8bf(G + (size_t)row * 2048 + 1024 + ch, g0, g1);
                        }
                    }
                }
                if constexpr (KIND == 1) {
                    ssum += xchg16(ssum); ssum += xchg32(ssum); ssq += xchg16(ssq); ssq += xchg32(ssq);
                    if (fq == 0) STATS[(size_t)row * 16 + (pn - 4) * 4 + wc] = (f32x2){ssum, ssq};
                }
            }
    }
    __device__ __forceinline__ void operator()(const Acc& acc, const Unit& u, int wr, int wc, int fr, int fq) const {
        const int pn = u.pn;
        if (pn < 4) run<0>(acc, u, wr, wc, fr, fq);
        else if (pn < 8) run<1>(acc, u, wr, wc, fr, fq);
        else if (pn < 13) run<2>(acc, u, wr, wc, fr, fq);
        else if (pn == 13) run<3>(acc, u, wr, wc, fr, fq);
        else run<4>(acc, u, wr, wc, fr, fq);
    }
};
struct EpiAB {
    bf16_t* MERGED; const bf16_t* G;
    static constexpr int kStores = 16;
    __device__ __forceinline__ bool perm(const Unit&) const { return true; }
    __device__ __forceinline__ void mid(Acc& acc, const Unit& u, int wr, int wc, int fr, int fq) const {
        int zero; asm volatile("v_mov_b32 %0, 0" : "=v"(zero));
        const bf16_t* gp = G + (size_t)(u.pm * 256 + wr * 64 + fr + zero) * 2048 + u.pn * 256 + wc * 32 + 8 * fq;
#pragma unroll
        for (int ai = 0; ai < 2; ++ai)
#pragma unroll
            for (int m = 0; m < 4; ++m) {
#pragma unroll
                for (int bj = 0; bj < 2; ++bj) {
                    const bf16_t* q = gp + (size_t)(ai * 128 + m * 16) * 2048 + bj * 128;
                    f32x4 r0, r1; ld8bf(q, r0, r1);
                    acc[ai][bj][m][0] *= r0; acc[ai][bj][m][1] *= r1;
                    asm volatile("" ::: "memory");
                }
            }
    }
    __device__ __forceinline__ void operator()(const Acc& acc, const Unit& u, int wr, int wc, int fr, int fq) const {
#pragma unroll
        for (int ai = 0; ai < 2; ++ai)
#pragma unroll
            for (int m = 0; m < 4; ++m) {
                const int row = u.pm * 256 + ai * 128 + wr * 64 + m * 16 + fr;
#pragma unroll
                for (int bj = 0; bj < 2; ++bj) {
                    const int c8 = u.pn * 256 + bj * 128 + wc * 32 + 8 * fq;
                    f32x4 gb0, gb1; ld8bf(G + (size_t)row * 2048 + 1024 + c8, gb0, gb1);
                    st8bf(MERGED + (size_t)row * 1024 + c8, gb0 * acc[ai][bj][m][0], gb1 * acc[ai][bj][m][1]);
                }
            }
    }
};
struct EpiO {
    bf16_t* D16; const float* mod;
    static constexpr int kStores = 16;
    __device__ __forceinline__ bool perm(const Unit&) const { return true; }
    __device__ __forceinline__ void operator()(const Acc& acc, const Unit& u, int wr, int wc, int fr, int fq) const {
        const float* g1 = mod + (size_t)((u.pm * 256) >> 12) * 6144 + 2048;
#pragma unroll
        for (int bj = 0; bj < 2; ++bj) {
            const int c8 = u.pn * 256 + bj * 128 + wc * 32 + 8 * fq;
            const f32x4 ga = *(const f32x4*)(g1 + c8), gb = *(const f32x4*)(g1 + c8 + 4);
#pragma unroll
            for (int ai = 0; ai < 2; ++ai)
#pragma unroll
                for (int m = 0; m < 4; ++m) {
                    const int row = u.pm * 256 + ai * 128 + wr * 64 + m * 16 + fr;
                    st8bf(D16 + (size_t)row * 2048 + 1024 + c8, ga * acc[ai][bj][m][0], gb * acc[ai][bj][m][1]);
                }
        }
    }
};
struct EpiGU {
    bf16_t* ACT;
    static constexpr int kStores = 8;
    __device__ __forceinline__ bool perm(const Unit&) const { return true; }
    __device__ __forceinline__ void operator()(const Acc& acc, const Unit& u, int wr, int wc, int fr, int fq) const {
#pragma unroll
        for (int ai = 0; ai < 2; ++ai)
#pragma unroll
            for (int m = 0; m < 4; ++m) {
                const int prow = u.pm * 256 + ai * 128 + wr * 64 + m * 16 + fr;
                f32x4 a[2];
#pragma unroll
                for (int n = 0; n < 2; ++n) {
                    const f32x4 gt = acc[ai][0][m][n], up = acc[ai][1][m][n];
                    a[n] = gt * sigm4_(gt) * up;
                }
                st8bf(ACT + (size_t)prow * 2048 + u.pn * 128 + wc * 32 + 8 * fq, a[0], a[1]);
            }
    }
};
struct EpiD {
    bf16_t* YB; const float* TOPW;
    static constexpr int kStores = 16;
    __device__ __forceinline__ bool perm(const Unit&) const { return true; }
    __device__ __forceinline__ void operator()(const Acc& acc, const Unit& u, int wr, int wc, int fr, int fq) const {
#pragma unroll
        for (int ai = 0; ai < 2; ++ai)
#pragma unroll
            for (int m = 0; m < 4; ++m) {
                const int prow = u.pm * 256 + ai * 128 + wr * 64 + m * 16 + fr; const float w = TOPW[prow];
#pragma unroll
                for (int bj = 0; bj < 2; ++bj)
                    st8bf(YB + (size_t)prow * 1024 + u.pn * 256 + bj * 128 + wc * 32 + 8 * fq, acc[ai][bj][m][0] * w, acc[ai][bj][m][1] * w);
            }
    }
};

__device__ __forceinline__ void transpose_item(const float* W, int N, int k0, int n0, bf16_t* dst, int ldt, LAS float* scr, int lane) {
    const int kk = lane >> 3, nq = (lane & 7) * 4;
    f32x4 v[8];
#pragma unroll
    for (int i = 0; i < 8; ++i) v[i] = *(const f32x4*)(W + (size_t)(k0 + 8 * i + kk) * N + n0 + nq);
#pragma unroll
    for (int i = 0; i < 8; ++i) { LAS float* s = scr + (8 * i + kk) * 33 + nq; s[0] = v[i].x; s[1] = v[i].y; s[2] = v[i].z; s[3] = v[i].w; }
    LDS_WAIT();
    const int c = lane & 7;
#pragma unroll
    for (int j = 0; j < 4; ++j) {
        const int n = (lane >> 3) + 8 * j; const LAS float* s = scr + (8 * c) * 33 + n;
        u32x4 o; o.x = pk2(s[0 * 33], s[1 * 33]); o.y = pk2(s[2 * 33], s[3 * 33]); o.z = pk2(s[4 * 33], s[5 * 33]); o.w = pk2(s[6 * 33], s[7 * 33]);
        *(u32x4*)(dst + (size_t)n * ldt + 8 * c) = o;
    }
    LDS_WAIT();
}

struct TrItem { const float* src; bf16_t* dst; int N, ldt; };
__device__ __forceinline__ void tr_load(const TrItem& it, f32x4 (&v)[8], int lane) {
    const int kk = lane >> 3, nq = (lane & 7) * 4;
#pragma unroll
    for (int i = 0; i < 8; ++i) v[i] = *(const f32x4*)(it.src + (size_t)(8 * i + kk) * it.N + nq);
}
__device__ __forceinline__ void tr_store(const TrItem& it, const f32x4 (&v)[8], LAS float* scr, int lane) {
    const int kk = lane >> 3, nq = (lane & 7) * 4;
#pragma unroll
    for (int i = 0; i < 8; ++i) { LAS float* s = scr + (8 * i + kk) * 33 + nq; s[0] = v[i].x; s[1] = v[i].y; s[2] = v[i].z; s[3] = v[i].w; }
    LDS_WAIT();
    const int c = lane & 7;
#pragma unroll
    for (int j = 0; j < 4; ++j) {
        const int n = (lane >> 3) + 8 * j; const LAS float* s = scr + (8 * c) * 33 + n;
        u32x4 o; o.x = pk2(s[0 * 33], s[1 * 33]); o.y = pk2(s[2 * 33], s[3 * 33]); o.z = pk2(s[4 * 33], s[5 * 33]); o.w = pk2(s[6 * 33], s[7 * 33]);
        *(u32x4*)(it.dst + (size_t)n * it.ldt + 8 * c) = o;
    }
    LDS_WAIT();
}

__device__ __forceinline__ void adaln_task(int task, const float* c, const float* cctx, const float* w_ada, const float* b_ada, float* mod, LAS float* lds, int tid) {
    LAS float* s = lds; LAS float* red = lds + 9 * 1024;
    { float cv[18];
#pragma unroll
      for (int q = 0; q < 18; ++q) { const int i = tid + NTHREADS * q, r = i >> 10, k = i & 1023; cv[q] = r < 8 ? c[r * 1024 + k] : cctx[k]; }
#pragma unroll
      for (int q = 0; q < 18; ++q) s[tid + NTHREADS * q] = cv[q] * __builtin_amdgcn_rcpf(1.f + __expf(-cv[q])); }
    __syncthreads();
    const int ch = tid & 7, kr = tid >> 3;
    f32x4 acc[9];
#pragma unroll
    for (int r = 0; r < 9; ++r) acc[r] = (f32x4){0.f, 0.f, 0.f, 0.f};
    const float* wp = w_ada + (size_t)kr * 6144 + task * 32 + ch * 4;
    for (int it = 0; it < 16; ++it) {
        const f32x4 w = *(const f32x4*)(wp + (size_t)it * 64 * 6144); const int k = kr + it * 64;
#pragma unroll
        for (int r = 0; r < 9; ++r) acc[r] += s[r * 1024 + k] * w;
    }
#pragma unroll
    for (int r = 0; r < 9; ++r) *(LAS f32x4*)(red + (kr * 9 + r) * 32 + ch * 4) = acc[r];
    __syncthreads();
    if (tid < 288) { const int r = tid >> 5, col = tid & 31; float sum = 0.f; for (int q = 0; q < 64; ++q) sum += red[(q * 9 + r) * 32 + col]; mod[r * 6144 + task * 32 + col] = sum + b_ada[task * 32 + col]; }
    __syncthreads();
}

__device__ __forceinline__ void rope_table(f32x2* tab, int tid) {
    for (int idx = tid; idx < 1024; idx += NTHREADS) {
        const int pos = idx >> 4, i = idx & 15;
        double f = 1.0;
        for (int q = 0; q < i; ++q) f *= 0.56234132519034908;
        const float ang = (float)pos * (float)f;
        const double a = (double)ang, k = __builtin_rint(a * 0.15915494309189535), r = a - k * 6.283185307179586476925, r2 = r * r;
        double sn = r, ts = r, cs = 1.0, tc = 1.0;
        for (int n = 1; n <= 14; ++n) {
            tc *= -r2 / (double)((2 * n - 1) * (2 * n)); cs += tc;
            ts *= -r2 / (double)((2 * n) * (2 * n + 1)); sn += ts;
        }
        tab[idx] = (f32x2){(float)cs, (float)sn};
    }
}

__device__ __forceinline__ unsigned char* lds_raw_ptr(LAS unsigned char* p) { return (unsigned char*)p; }
namespace mix {
typedef short bf16x8 __attribute__((ext_vector_type(8)));
typedef short s16x4 __attribute__((ext_vector_type(4)));
typedef float f32x16 __attribute__((ext_vector_type(16)));
typedef __attribute__((address_space(3))) const char* lds_cptr;
__device__ __forceinline__ int crow(int r, int hi) { return (r & 3) + 8 * (r >> 2) + 4 * hi; }
__device__ __forceinline__ unsigned cvtpk(float lo, float hi) { typedef float f2 __attribute__((ext_vector_type(2))); typedef __bf16 b2 __attribute__((ext_vector_type(2))); f2 v = {lo, hi}; b2 b = __builtin_convertvector(v, b2); return __builtin_bit_cast(unsigned, b); }
__device__ __forceinline__ s16x4 vtr(lds_cptr p) { return __builtin_bit_cast(s16x4, __builtin_amdgcn_ds_read_tr16_b64_v4i16((__attribute__((address_space(3))) s16x4*)p)); }
__device__ __forceinline__ bf16x8 pk8(s16x4 lo, s16x4 hi) { return (bf16x8){lo[0], lo[1], lo[2], lo[3], hi[0], hi[1], hi[2], hi[3]}; }
__device__ __forceinline__ float max3f(float a, float b, float c) { float r; asm("v_max3_f32 %0, %1, %2, %3" : "=v"(r) : "v"(a), "v"(b), "v"(c)); return r; }
__device__ __forceinline__ float max2f(float a, float b) { float r; asm("v_max_f32_e32 %0, %1, %2" : "=v"(r) : "v"(a), "v"(b)); return r; }
__device__ __forceinline__ float swap_half(float v) { auto rr = __builtin_amdgcn_permlane32_swap(__float_as_uint(v), __float_as_uint(v), false, false); return __uint_as_float((threadIdx.x & 32) ? rr[0] : rr[1]); }

constexpr int A_K = 0, A_V = 24576, A_WS = 49152, A_QST = 53248, A_OST = A_QST, A_OSTW = 8192, A_END = A_QST + 8 * 8192;

__device__ __forceinline__ void attn_unit(int b, int n, int kvh, bf16_t* Y, bf16_t* O, int ldo, const bf16_t* KB, const bf16_t* VB, const float* sink, LAS unsigned char* lds) {
    const int tid = threadIdx.x, lane = tid & 63, r32 = lane & 31, hi = lane >> 5, wid = __builtin_amdgcn_readfirstlane(tid >> 6);
    const int head = kvh * 4 + (wid >> 1);
    const int qrow0 = b * SEQ + n * 128 + (wid & 1) * 64;
    bf16_t* Qw = Y + (size_t)qrow0 * 2048 + 1024 + head * 64;
    LAS bf16x8* qst = (LAS bf16x8*)(lds + A_QST + wid * 8192) + lane;
#pragma unroll
    for (int sb = 0; sb < 2; ++sb)
#pragma unroll
        for (int d0 = 0; d0 < 4; ++d0) qst[(sb * 4 + d0) * 64] = *(const bf16x8*)(Qw + (size_t)(32 * sb + r32) * 2048 + d0 * 16 + hi * 8);
    f32x16 o[2][2];
#pragma unroll
    for (int sb = 0; sb < 2; ++sb)
#pragma unroll
        for (int d0 = 0; d0 < 2; ++d0)
#pragma unroll
            for (int r = 0; r < 16; ++r) o[sb][d0][r] = 0.f;
    float m[2] = {-1e30f, -1e30f}, l[2] = {0.f, 0.f};
    LAS float* wsf = (LAS float*)(lds + A_WS) + wid * 128;
    const int jlo = (n == 0) ? 2 : 0, jhi = (n == 31) ? 3 : 5, T = 4 + (jhi - jlo + 1);
    const size_t koff = (size_t)lane * 256 + wid * 8 + kvh * 64;
    const size_t voff = (size_t)(16 * (wid & 3) + (lane >> 2)) * 256 + (wid >> 2) * 32 + (lane & 3) * 8 + kvh * 64;
    auto tile_row = [&](int t) -> long { return t < 4 ? (long)(NTOK + b * CTXL + 64 * t) : (long)(b * SEQ + (n - 1) * 128 + 64 * (jlo + t - 4)); };
    auto issue = [&](int t) {
        const long row = tile_row(t); const int buf = t % 3;
        __builtin_amdgcn_global_load_lds((const unsigned*)(KB + row * 256 + koff), (LAS unsigned*)(lds + A_K + buf * 8192 + wid * 1024), 16, 0, 0);
        __builtin_amdgcn_global_load_lds((const unsigned*)(VB + row * 256 + voff), (LAS unsigned*)(lds + A_V + buf * 8192 + wid * 1024), 16, 0, 0);
    };
    issue(0); issue(1);
    int slot = 0;
    for (int t = 0; t < T; ++t) {
        if (t + 1 < T) asm volatile("s_waitcnt vmcnt(2) lgkmcnt(0)" ::: "memory"); else asm volatile("s_waitcnt vmcnt(0) lgkmcnt(0)" ::: "memory");
        __builtin_amdgcn_s_barrier();
        if (t + 2 < T) issue(t + 2);
        const lds_cptr Kt = (lds_cptr)(lds + A_K + slot * 8192) + hi * 1024 + r32 * 16;
        const lds_cptr Vt = (lds_cptr)(lds + A_V + slot * 8192) + ((lane >> 4) & 1) * 32 + (lane & 3) * 8 + (4 * hi + ((lane & 15) >> 2)) * 64;
        slot = (slot == 2) ? 0 : slot + 1;
        const bool local = t >= 4;
        const int dl = 64 * (jlo + t - 4) - 128 - 64 * (wid & 1);
        if (local && (dl > 160 || dl < -191)) continue;
        f32x16 p0[2], p1[2];
#pragma unroll
        for (int sb = 0; sb < 2; ++sb)
#pragma unroll
            for (int r = 0; r < 16; ++r) { p0[sb][r] = 0.f; p1[sb][r] = 0.f; }
#pragma unroll
        for (int d0 = 0; d0 < 4; ++d0) {
            const bf16x8 k0 = *(const __attribute__((address_space(3))) bf16x8*)(Kt + d0 * 2048), k1 = *(const __attribute__((address_space(3))) bf16x8*)(Kt + d0 * 2048 + 512);
#pragma unroll
            for (int sb = 0; sb < 2; ++sb) {
                const bf16x8 qf = qst[(sb * 4 + d0) * 64];
                p0[sb] = __builtin_amdgcn_mfma_f32_32x32x16_bf16(k0, qf, p0[sb], 0, 0, 0);
                p1[sb] = __builtin_amdgcn_mfma_f32_32x32x16_bf16(k1, qf, p1[sb], 0, 0, 0);
            }
        }
        if (local && (dl < -97 || dl > 65 || dl - 32 < -97)) {
#pragma unroll
            for (int sb = 0; sb < 2; ++sb)
#pragma unroll
                for (int r = 0; r < 16; ++r) { const int rel = dl - 32 * sb + crow(r, hi) - r32; if (rel < -128 || rel > 128) p0[sb][r] = -1e30f; if (rel + 32 < -128 || rel + 32 > 128) p1[sb][r] = -1e30f; }
        }
        float mn[2];
        asm volatile("s_nop 15\n\ts_nop 7" : "+v"(p0[0]), "+v"(p1[0]), "+v"(p0[1]), "+v"(p1[1]));
#pragma unroll
        for (int sb = 0; sb < 2; ++sb) {
            float a = max3f(p0[sb][0], p0[sb][1], p1[sb][0]), b2 = max3f(p0[sb][2], p0[sb][3], p1[sb][1]); a = max3f(a, p1[sb][2], p1[sb][3]);
#pragma unroll
            for (int r = 4; r < 16; r += 4) { a = max3f(a, p0[sb][r], p0[sb][r + 1]); b2 = max3f(b2, p0[sb][r + 2], p0[sb][r + 3]); a = max3f(a, p1[sb][r], p1[sb][r + 1]); b2 = max3f(b2, p1[sb][r + 2], p1[sb][r + 3]); }
            float rm = max2f(a, b2);
            rm = max2f(rm, swap_half(rm));
            mn[sb] = max2f(m[sb], rm);
        }
        if (__any((mn[0] > m[0]) || (mn[1] > m[1]))) {
            const float f0 = __builtin_amdgcn_exp2f(m[0] - mn[0]), f1 = __builtin_amdgcn_exp2f(m[1] - mn[1]);
            l[0] *= f0; l[1] *= f1;
            if (hi == 0) { wsf[r32] = f0; wsf[64 + r32] = f1; }
            asm volatile("s_waitcnt lgkmcnt(0)" ::: "memory");
#pragma unroll
            for (int r = 0; r < 16; ++r) { const float a = wsf[crow(r, hi)], b2 = wsf[64 + crow(r, hi)]; o[0][0][r] *= a; o[0][1][r] *= a; o[1][0][r] *= b2; o[1][1][r] *= b2; }
            m[0] = mn[0]; m[1] = mn[1];
        }
        u32x4 pw[2][4];
#pragma unroll
        for (int sb = 0; sb < 2; ++sb) {
            float sacc = 0.f;
#pragma unroll
            for (int r = 0; r < 16; ++r) { p0[sb][r] = __builtin_amdgcn_exp2f(p0[sb][r] - m[sb]); p1[sb][r] = __builtin_amdgcn_exp2f(p1[sb][r] - m[sb]); sacc += p0[sb][r] + p1[sb][r]; }
            l[sb] += sacc;
#pragma unroll
            for (int q = 0; q < 4; ++q) { pw[sb][0][q] = cvtpk(p0[sb][2 * q], p0[sb][2 * q + 1]); pw[sb][1][q] = cvtpk(p0[sb][8 + 2 * q], p0[sb][9 + 2 * q]); pw[sb][2][q] = cvtpk(p1[sb][2 * q], p1[sb][2 * q + 1]); pw[sb][3][q] = cvtpk(p1[sb][8 + 2 * q], p1[sb][9 + 2 * q]); }
        }
#pragma unroll
        for (int d0 = 0; d0 < 2; ++d0)
#pragma unroll
            for (int ks = 0; ks < 4; ++ks) {
                const s16x4 vlo = vtr(Vt + d0 * 4096 + ks * 1024), vhi = vtr(Vt + d0 * 4096 + ks * 1024 + 512);
                const bf16x8 vf = pk8(vlo, vhi);
#pragma unroll
                for (int sb = 0; sb < 2; ++sb) o[sb][d0] = __builtin_amdgcn_mfma_f32_32x32x16_bf16(__builtin_bit_cast(bf16x8, pw[sb][ks]), vf, o[sb][d0], 0, 0, 0);
            }
    }
    const float s2 = sink[head] * LOG2E;
    LAS bf16_t* stg = (LAS bf16_t*)(lds + A_OST + wid * A_OSTW);
#pragma unroll
    for (int sb = 0; sb < 2; ++sb) {
        const float lt = l[sb] + swap_half(l[sb]);
        const float mf = fmaxf(m[sb], s2), f = __builtin_amdgcn_exp2f(m[sb] - mf), den = lt * f + __builtin_amdgcn_exp2f(s2 - mf);
        asm volatile("s_waitcnt lgkmcnt(0)" ::: "memory");
        if (hi == 0) wsf[sb * 64 + r32] = f / den;
        asm volatile("s_waitcnt lgkmcnt(0)" ::: "memory");
#pragma unroll
        for (int r = 0; r < 16; ++r) { const float sc = wsf[sb * 64 + crow(r, hi)]; const int orow = crow(r, hi);
            stg[orow * 64 + r32] = (bf16_t)f2bf(o[sb][0][r] * sc); stg[orow * 64 + 32 + r32] = (bf16_t)f2bf(o[sb][1][r] * sc); }
        asm volatile("s_waitcnt lgkmcnt(0)" ::: "memory");
#pragma unroll
        for (int i = 0; i < 4; ++i) { const int row = i * 8 + (lane >> 3), ch = lane & 7; const u32x4 v = *(const LAS u32x4*)(stg + row * 64 + ch * 8); *(u32x4*)(O + (size_t)(qrow0 + 32 * sb + row) * ldo + head * 64 + ch * 8) = v; }
        asm volatile("s_waitcnt lgkmcnt(0)" ::: "memory");
    }
    __syncthreads();
}

constexpr int G_V = 0, G_ST = 65536, G_STW = 8704, G_MU = G_ST + 8 * G_STW;
__device__ __forceinline__ void gmlp_unit(int task, bf16_t* Y, bf16_t* YO, int ldo, const bf16_t* VA, const bf16_t* WSP, const f32x2* STATS, const float* ln_g, const float* ln_b, const float* b_sp, LAS unsigned char* lds) {
    const int tid = threadIdx.x, lane = tid & 63, r32 = lane & 31, hi = lane >> 5, wid = __builtin_amdgcn_readfirstlane(tid >> 6);
    const int r0 = task * 128;
    LAS float* mu = (LAS float*)(lds + G_MU); LAS float* rs = mu + 128;
    if (tid < 128) {
        const f32x4* sp = (const f32x4*)(STATS + (size_t)(r0 + tid) * 16); float s = 0.f, ss = 0.f;
#pragma unroll
        for (int i = 0; i < 8; ++i) { const f32x4 v = sp[i]; s += v.x + v.z; ss += v.y + v.w; }
        const float mean = s * (1.f / 1024.f), var = fmaxf(ss * (1.f / 1024.f) - mean * mean, 0.f);
        mu[tid] = mean; rs[tid] = 1.0f / sqrtf(var + EPS);
    }
    u32x4 raw[4];
#pragma unroll
    for (int i = 0; i < 4; ++i) { const int idx = tid + NTHREADS * i, q = idx >> 4, c8 = idx & 15; raw[i] = *(const u32x4*)(VA + (size_t)(r0 + q) * 1024 + c8 * 8); }
    __syncthreads();
    const int pb = wid >> 1, dh = wid & 1;
    LAS float* st = (LAS float*)(lds + G_ST + wid * G_STW);
    for (int g8 = 0; g8 < 8; ++g8) {
        LAS unsigned char* vb = lds + G_V + (g8 & 1) * 32768;
#pragma unroll
        for (int i = 0; i < 4; ++i) {
            const int idx = tid + NTHREADS * i, q = idx >> 4, c8 = idx & 15, d = c8 * 8;
            const f32x4 g0 = *(const f32x4*)(ln_g + g8 * 128 + d), g1 = *(const f32x4*)(ln_g + g8 * 128 + d + 4), b0 = *(const f32x4*)(ln_b + g8 * 128 + d), b1 = *(const f32x4*)(ln_b + g8 * 128 + d + 4);
            const float mq = mu[q], rq = rs[q]; const u32x4 rw = raw[i];
            float v[8] = {bf2f(rw.x & 0xffffu), bf2f(rw.x >> 16), bf2f(rw.y & 0xffffu), bf2f(rw.y >> 16), bf2f(rw.z & 0xffffu), bf2f(rw.z >> 16), bf2f(rw.w & 0xffffu), bf2f(rw.w >> 16)};
#pragma unroll
            for (int e = 0; e < 4; ++e) { v[e] = (v[e] - mq) * rq * g0[e] + b0[e]; v[4 + e] = (v[4 + e] - mq) * rq * g1[e] + b1[e]; }
            u32x4 w; w.x = pk2(v[0], v[1]); w.y = pk2(v[2], v[3]); w.z = pk2(v[4], v[5]); w.w = pk2(v[6], v[7]);
            *(LAS u32x4*)(vb + ((d >> 5) * 8 + (q >> 4)) * 1024 + (q & 15) * 64 + (d & 31) * 2) = w;
        }
        if (g8 + 1 < 8) {
#pragma unroll
            for (int i = 0; i < 4; ++i) { const int idx = tid + NTHREADS * i, q = idx >> 4, c8 = idx & 15; raw[i] = *(const u32x4*)(VA + (size_t)(r0 + q) * 1024 + (g8 + 1) * 128 + c8 * 8); }
        }
        u32x4 ur[4]; bf16x8 af[8];
        const size_t ybase = (size_t)(r0 + 32 * pb + (lane >> 3)) * 2048 + g8 * 128 + 64 * dh + (lane & 7) * 8;
#pragma unroll
        for (int i = 0; i < 4; ++i) ur[i] = *(const u32x4*)(Y + ybase + (size_t)(8 * i) * 2048);
        const bf16_t* wrow = WSP + (size_t)g8 * 16384 + (size_t)(32 * pb + r32) * 128 + 8 * hi;
#pragma unroll
        for (int ks = 0; ks < 8; ++ks) af[ks] = *(const bf16x8*)(wrow + 16 * ks);
        __syncthreads();
        const lds_cptr Vb = (lds_cptr)vb + ((lane >> 4) & 1) * 32 + (lane & 3) * 8 + (8 * hi + ((lane & 15) >> 2)) * 64;
        f32x16 acc[2];
#pragma unroll
        for (int t2 = 0; t2 < 2; ++t2)
#pragma unroll
            for (int r = 0; r < 16; ++r) acc[t2][r] = 0.f;
#pragma unroll
        for (int ks = 0; ks < 8; ++ks) {
#pragma unroll
            for (int t2 = 0; t2 < 2; ++t2) {
                const int db = 2 * dh + t2;
                const s16x4 vlo = vtr(Vb + (db * 8 + ks) * 1024), vhi = vtr(Vb + (db * 8 + ks) * 1024 + 256);
                acc[t2] = __builtin_amdgcn_mfma_f32_32x32x16_bf16(af[ks], pk8(vlo, vhi), acc[t2], 0, 0, 0);
            }
        }
#pragma unroll
        for (int t2 = 0; t2 < 2; ++t2)
#pragma unroll
            for (int r = 0; r < 16; ++r) st[crow(r, hi) * 68 + 32 * t2 + r32] = acc[t2][r];
        asm volatile("s_waitcnt lgkmcnt(0)" ::: "memory");
#pragma unroll
        for (int i = 0; i < 4; ++i) {
            const int prow = 8 * i + (lane >> 3), ch = lane & 7;
            const f32x4 m0 = *(const LAS f32x4*)(st + prow * 68 + ch * 8), m1 = *(const LAS f32x4*)(st + prow * 68 + ch * 8 + 4);
            const float bs = b_sp[g8 * 128 + 32 * pb + prow]; const u32x4 uw = ur[i];
            u32x4 o;
            o.x = pk2(bf2f(uw.x & 0xffffu) * (m0.x + bs), bf2f(uw.x >> 16) * (m0.y + bs)); o.y = pk2(bf2f(uw.y & 0xffffu) * (m0.z + bs), bf2f(uw.y >> 16) * (m0.w + bs));
            o.z = pk2(bf2f(uw.z & 0xffffu) * (m1.x + bs), bf2f(uw.z >> 16) * (m1.y + bs)); o.w = pk2(bf2f(uw.w & 0xffffu) * (m1.z + bs), bf2f(uw.w >> 16) * (m1.w + bs));
            *(u32x4*)(YO + (size_t)(r0 + 32 * pb + prow) * ldo + g8 * 128 + 64 * dh + ch * 8) = o;
        }
        asm volatile("s_waitcnt lgkmcnt(0)" ::: "memory");
    }
    __syncthreads();
}
}

namespace att2 {
typedef short bf16x8 __attribute__((ext_vector_type(8)));
typedef short s16x4 __attribute__((ext_vector_type(4)));
typedef float f32x16 __attribute__((ext_vector_type(16)));
typedef __attribute__((address_space(3))) const char* lds_cptr;
typedef short v4i16_t __attribute__((ext_vector_type(4)));
__device__ __forceinline__ int crow(int r, int hi) { return (r & 3) + 8 * (r >> 2) + 4 * hi; }
#define SBAR() __builtin_amdgcn_sched_barrier(0)
constexpr int NSLOT = 3, SLOTB = 8192;
constexpr int LDS_K = 0, LDS_V = NSLOT * SLOTB, LDS_WS = 2 * NSLOT * SLOTB, LDS_OST = LDS_WS + 8 * 64 * 4, LDS_BYTES = LDS_OST + 8 * 4096;
__device__ __forceinline__ void glds16(const void* gsrc, unsigned lds_dst) { unsigned keep;
    asm volatile("s_mov_b32 %0, m0\n\ts_mov_b32 m0, %2\n\ts_nop 0\n\tglobal_load_lds_dwordx4 %1, off\n\ts_mov_b32 m0, %0" : "=&s"(keep) : "v"(gsrc), "s"(lds_dst) : "memory"); }
__device__ __forceinline__ float max3f(float a, float b, float c) { float r; asm("v_max3_f32 %0, %1, %2, %3" : "=v"(r) : "v"(a), "v"(b), "v"(c)); return r; }
__device__ __forceinline__ float max2f(float a, float b) { float r; asm("v_max_f32_e32 %0, %1, %2" : "=v"(r) : "v"(a), "v"(b)); return r; }
__device__ __forceinline__ float fadd_s(float a, float b) { float r; asm("v_add_f32_e32 %0, %1, %2" : "=v"(r) : "v"(a), "v"(b)); return r; }
__device__ __forceinline__ float fsub_s(float a, float b) { float r; asm("v_sub_f32_e32 %0, %1, %2" : "=v"(r) : "v"(a), "v"(b)); return r; }
typedef float f32x2_t __attribute__((ext_vector_type(2))); typedef __bf16 bf16x2_t __attribute__((ext_vector_type(2)));
__device__ __forceinline__ unsigned cvtpk_s(float lo, float hi) { f32x2_t v = {lo, hi}; bf16x2_t b = __builtin_convertvector(v, bf16x2_t); return __builtin_bit_cast(unsigned, b); }
#define WAIT_BAR(N) asm volatile("s_waitcnt vmcnt(" #N ") lgkmcnt(0)\n\ts_barrier" ::: "memory")
__device__ __forceinline__ void qkt(f32x16& p0, f32x16& p1, lds_cptr Kslot, const bf16x8* qr, const f32x16& negm, int r32, int hi) {
    const lds_cptr kb = Kslot + hi * 1024 + r32 * 16;
#pragma unroll
    for (int d0 = 0; d0 < 4; ++d0) {
        const bf16x8 b0 = *(const __attribute__((address_space(3))) bf16x8*)(kb + d0 * 2048);
        const bf16x8 b1 = *(const __attribute__((address_space(3))) bf16x8*)(kb + d0 * 2048 + 512);
        if (d0 == 0) { p0 = __builtin_amdgcn_mfma_f32_32x32x16_bf16(b0, qr[0], negm, 0, 0, 0); p1 = __builtin_amdgcn_mfma_f32_32x32x16_bf16(b1, qr[0], negm, 0, 0, 0); }
        else { p0 = __builtin_amdgcn_mfma_f32_32x32x16_bf16(b0, qr[d0], p0, 0, 0, 0); p1 = __builtin_amdgcn_mfma_f32_32x32x16_bf16(b1, qr[d0], p1, 0, 0, 0); }
    }
}
__device__ __forceinline__ void kload8(bf16x8* kf, lds_cptr kp) {
    kf[0] = *(const __attribute__((address_space(3))) bf16x8*)(kp);        kf[1] = *(const __attribute__((address_space(3))) bf16x8*)(kp + 512);
    kf[2] = *(const __attribute__((address_space(3))) bf16x8*)(kp + 2048); kf[3] = *(const __attribute__((address_space(3))) bf16x8*)(kp + 2560);
    kf[4] = *(const __attribute__((address_space(3))) bf16x8*)(kp + 4096); kf[5] = *(const __attribute__((address_space(3))) bf16x8*)(kp + 4608);
    kf[6] = *(const __attribute__((address_space(3))) bf16x8*)(kp + 6144); kf[7] = *(const __attribute__((address_space(3))) bf16x8*)(kp + 6656);
}
__device__ __forceinline__ void kload2(bf16x8* kf, lds_cptr kp, int j) { kf[2 * j] = *(const __attribute__((address_space(3))) bf16x8*)(kp + j * 2048); kf[2 * j + 1] = *(const __attribute__((address_space(3))) bf16x8*)(kp + j * 2048 + 512); }
__device__ __forceinline__ s16x4 vtr(lds_cptr p) { return __builtin_bit_cast(s16x4, __builtin_amdgcn_ds_read_tr16_b64_v4i16((__attribute__((address_space(3))) v4i16_t*)p)); }
__device__ __forceinline__ float rowmax(const f32x16& p0, const f32x16& p1) {
    float a = max3f(p0[0], p0[1], p1[0]), b = max3f(p0[2], p0[3], p1[1]); a = max3f(a, p1[2], p1[3]);
#pragma unroll
    for (int r = 4; r < 16; r += 4) { a = max3f(a, p0[r], p0[r + 1]); b = max3f(b, p0[r + 2], p0[r + 3]); a = max3f(a, p1[r], p1[r + 1]); b = max3f(b, p1[r + 2], p1[r + 3]); }
    const float m = max2f(a, b);
    auto rr = __builtin_amdgcn_permlane32_swap(__float_as_uint(m), __float_as_uint(m), false, false);
    return max2f(__uint_as_float(rr[0]), __uint_as_float(rr[1]));
}
__device__ __forceinline__ void pv(f32x16* o, int vb, bf16x8 pa0, bf16x8 pa1, bf16x8 pa2, bf16x8 pa3) {
#pragma unroll
    for (int d0 = 0; d0 < 2; ++d0) { s16x4 lo[4], hi[4];
#pragma unroll
        for (int ks = 0; ks < 4; ++ks) {
            asm volatile("ds_read_b64_tr_b16 %0,%1 offset:%c2" : "=&v"(lo[ks]) : "v"(vb), "i"(d0 * 4096 + ks * 1024) : "memory");
            asm volatile("ds_read_b64_tr_b16 %0,%1 offset:%c2" : "=&v"(hi[ks]) : "v"(vb), "i"(d0 * 4096 + ks * 1024 + 512) : "memory"); }
        asm volatile("s_waitcnt lgkmcnt(0)" ::: "memory"); SBAR();
#define PK(k) (bf16x8){lo[k][0], lo[k][1], lo[k][2], lo[k][3], hi[k][0], hi[k][1], hi[k][2], hi[k][3]}
        o[d0] = __builtin_amdgcn_mfma_f32_32x32x16_bf16(pa0, PK(0), o[d0], 0, 0, 0);
        o[d0] = __builtin_amdgcn_mfma_f32_32x32x16_bf16(pa1, PK(1), o[d0], 0, 0, 0);
        o[d0] = __builtin_amdgcn_mfma_f32_32x32x16_bf16(pa2, PK(2), o[d0], 0, 0, 0);
        o[d0] = __builtin_amdgcn_mfma_f32_32x32x16_bf16(pa3, PK(3), o[d0], 0, 0, 0);
#undef PK
    }
}
__device__ __forceinline__ void wmask(f32x16& p0, f32x16& p1, int dl, int r32, int hi) {
    const float NEG = -INFINITY;
#pragma unroll
    for (int r = 0; r < 16; ++r) { const int rel = dl + crow(r, hi) - r32; if (rel < -128 || rel > 128) p0[r] = NEG; if (rel + 32 < -128 || rel + 32 > 128) p1[r] = NEG; }
}

template <int THRL> __device__ __forceinline__ void attn_unit(int b, int n, int kvh, int hp, int base, bool primed, bool has_next, int nb, int nn, int nkvh, int nhp, bf16x8 (&qr)[4], int& nbase,
                                                              const bf16_t* Y, bf16_t* O, int ldo, const bf16_t* KB, const bf16_t* VB, const float* sink, LAS unsigned char* shm) {
    const int tid = threadIdx.x, lane = tid & 63, r32 = lane & 31, hi = lane >> 5; const int wid = __builtin_amdgcn_readfirstlane(tid >> 6);
    const int head = kvh * 4 + (wid >> 1), qsub = wid & 1;
    const long qrow0 = (long)b * SEQ + n * 64 + qsub * 32;
    const bf16_t* Qw = Y + qrow0 * 2048 + 1024 + head * 64;
    const unsigned lds0 = (unsigned)(uintptr_t)shm;
    LAS float* wsf = (LAS float*)(shm + LDS_WS) + wid * 64;
    const long koff = (long)lane * 256 + kvh * 64 + wid * 8;
    const long voff = (long)(16 * (wid & 3) + (lane >> 2)) * 256 + kvh * 64 + (wid >> 2) * 32 + (lane & 3) * 8;
    const unsigned kdst = lds0 + LDS_K + wid * 1024, vdst = lds0 + LDS_V + wid * 1024;
    const int jlo = (n == 0) ? 2 : (n == 1) ? 1 : 0, jhi = (n == 63) ? 2 : (n == 62) ? 3 : 4, NT = 4 + (jhi - jlo + 1);
    const long lrow0 = (long)b * SEQ + n * 64 - 128 + 64 * (jlo - 4), crow0 = (long)NTOK + b * CTXL;
#define TROW(t) ((t) < 4 ? crow0 + 64 * (t) : lrow0 + 64 * (t))
#define DMA_K(t, slot) glds16(KB + TROW(t) * 256 + koff, (unsigned)__builtin_amdgcn_readfirstlane(kdst + (slot)))
#define DMA_V(t, slot) glds16(VB + TROW(t) * 256 + voff, (unsigned)__builtin_amdgcn_readfirstlane(vdst + (slot)))
    const int vb0 = (int)(lds0 + LDS_V) + ((lane >> 4) & 1) * 32 + (lane & 3) * 8 + (4 * hi + ((lane & 15) >> 2)) * 64;
    bf16x8 kf[8];
    const lds_cptr shm3 = (lds_cptr)shm; const lds_cptr kp0 = shm3 + LDS_K + hi * 1024 + r32 * 16; const lds_cptr vp0 = shm3 + LDS_V + ((lane >> 4) & 1) * 32 + (lane & 3) * 8 + (4 * hi + ((lane & 15) >> 2)) * 64;
    const int s0 = base, s1 = (s0 == (NSLOT - 1) * SLOTB) ? 0 : s0 + SLOTB, s2 = (s1 == (NSLOT - 1) * SLOTB) ? 0 : s1 + SLOTB;
    if (!primed) {
        DMA_K(0, s0); DMA_V(0, s0); DMA_K(1, s1); DMA_K(2, s2);
#pragma unroll
        for (int d0 = 0; d0 < 4; ++d0) qr[d0] = *(const bf16x8*)(Qw + (long)r32 * 2048 + d0 * 16 + hi * 8);
    }
    float mhat = 0.f, l_reg = 0.f; f32x16 o[2]; o[0] = f32x16{}; o[1] = f32x16{}; f32x16 negm = f32x16{}; asm volatile("" : "+v"(negm));
    const int dq = -128 - 32 * qsub;
#define CMASK(P0, P1, t) do { if ((t) >= 4) { const int dl_ = 64 * (jlo + (t) - 4) + dq; if (dl_ < -97 || dl_ > 65) wmask(P0, P1, dl_, r32, hi); } } while (0)
    bool resc = false;
#define START(P0, P1) do { const float rm = rowmax(P0, P1); resc = false; \
    { const float dl = rm; mhat = fadd_s(mhat, dl); \
      _Pragma("unroll") for (int r = 0; r < 16; ++r) { P0[r] = fsub_s(P0[r], dl); P1[r] = fsub_s(P1[r], dl); } \
      _Pragma("unroll") for (int r = 0; r < 16; ++r) negm[r] = -mhat; asm volatile("" : "+v"(negm)); } \
    _Pragma("unroll") for (int r = 0; r < 16; ++r) P0[r] = __builtin_amdgcn_exp2f(P0[r]); } while (0)
#define RESC() do { if (resc) { asm volatile("s_waitcnt lgkmcnt(0)" ::: "memory"); \
      _Pragma("unroll") for (int d_ = 0; d_ < 2; ++d_) _Pragma("unroll") for (int r = 0; r < 16; ++r) o[d_][r] *= wsf[crow(r, hi)]; } } while (0)
    f32x16 pA0, pA1, pB0, pB1;
    int sl_prev = s0, sl_cur = s0, sl_next = s1;
#define ROT() do { sl_prev = sl_cur; sl_cur = sl_next; sl_next = (sl_next == (NSLOT - 1) * SLOTB) ? 0 : sl_next + SLOTB; } while (0)
    s16x4 vlo[8], vhi[8]; u32x4 pw0, pw1, pw2, pw3;
    const bool oddnt = NT & 1;
    WAIT_BAR(7);
#define PROLOG(X0, X1) do { qkt(X0, X1, shm3 + LDS_K + s0, qr, negm, r32, hi); asm volatile("s_nop 15\n\ts_nop 7" : "+v"(X0), "+v"(X1)); \
    START(X0, X1); \
    _Pragma("unroll") for (int r = 0; r < 16; ++r) X1[r] = __builtin_amdgcn_exp2f(X1[r]); \
    WAIT_BAR(0); \
    DMA_K(3, s0); DMA_V(1, s1); \
    ROT(); \
    kload8(kf, kp0 + sl_cur); \
    WAIT_BAR(2); } while (0)
#define PKW(P, B) cvtpk_s(P[B], P[B + 1])
#define PAF(k) __builtin_bit_cast(bf16x8, pw##k)
#define VFR(i) (bf16x8){vlo[i][0], vlo[i][1], vlo[i][2], vlo[i][3], vhi[i][0], vhi[i][1], vhi[i][2], vhi[i][3]}
#define PIN(x) asm volatile("" : "+v"(x))
#define MX3(a, b, c) __builtin_fmaxf(__builtin_fmaxf((a), (b)), (c))
#define GAPA(MF, A0, A1, A2, A3, W0, W1, PW) do { MF; sacc += A0; sacc += A1; sacc += A2; sacc += A3; PIN(sacc); W0; W1; PIN(PW); SBAR(); } while (0)
#define EX(v) __builtin_amdgcn_exp2f(v)
#define GAPB(MF, X, B) do { MF; X[B] = EX(X[B]); X[B + 1] = EX(X[B + 1]); X[B + 2] = EX(X[B + 2]); X[B + 3] = EX(X[B + 3]); PIN(X); SBAR(); } while (0)
#define VRD(i) do { vlo[i] = vtr(vp_ + (((i) >> 2) * 4096 + ((i) & 3) * 1024)); vhi[i] = vtr(vp_ + (((i) >> 2) * 4096 + ((i) & 3) * 1024 + 512)); } while (0)
#define KRD(G, j) do { if (G) { kload2(kf, kp0 + sl_next, j); SBAR(); } } while (0)
#define STEP(C0, C1, P0, P1, t, GK, GV, GL) do { SBAR(); \
    const lds_cptr vp_ = vp0 + sl_prev; \
    VRD(0); SBAR(); float sacc = (P0[0] + P0[1]); \
    GAPA(C0 = __builtin_amdgcn_mfma_f32_32x32x16_bf16(kf[0], qr[0], negm, 0, 0, 0), P0[2], P0[3], P0[4], P0[5],     pw0[0] = PKW(P0, 0), pw0[1] = PKW(P0, 2), pw0); \
    VRD(4); SBAR(); GAPA(C1 = __builtin_amdgcn_mfma_f32_32x32x16_bf16(kf[1], qr[0], negm, 0, 0, 0), P0[6], P0[7], P0[8], P0[9],     pw0[2] = PKW(P0, 4), pw0[3] = PKW(P0, 6), pw0); \
    VRD(1); SBAR(); GAPA(C0 = __builtin_amdgcn_mfma_f32_32x32x16_bf16(kf[2], qr[1], C0, 0, 0, 0),   P0[10], P0[11], P0[12], P0[13], pw1[0] = PKW(P0, 8), pw1[1] = PKW(P0, 10), pw1); \
    VRD(5); SBAR(); GAPA(C1 = __builtin_amdgcn_mfma_f32_32x32x16_bf16(kf[3], qr[1], C1, 0, 0, 0),   P0[14], P0[15], P1[0], P1[1],   pw1[2] = PKW(P0, 12), pw1[3] = PKW(P0, 14), pw1); \
    VRD(2); SBAR(); GAPA(C0 = __builtin_amdgcn_mfma_f32_32x32x16_bf16(kf[4], qr[2], C0, 0, 0, 0),   P1[2], P1[3], P1[4], P1[5],     pw2[0] = PKW(P1, 0), pw2[1] = PKW(P1, 2), pw2); \
    VRD(6); SBAR(); GAPA(C1 = __builtin_amdgcn_mfma_f32_32x32x16_bf16(kf[5], qr[2], C1, 0, 0, 0),   P1[6], P1[7], P1[8], P1[9],     pw2[2] = PKW(P1, 4), pw2[3] = PKW(P1, 6), pw2); \
    VRD(3); SBAR(); GAPA(C0 = __builtin_amdgcn_mfma_f32_32x32x16_bf16(kf[6], qr[3], C0, 0, 0, 0),   P1[10], P1[11], P1[12], P1[13], pw3[0] = PKW(P1, 8), pw3[1] = PKW(P1, 10), pw3); \
    VRD(7); SBAR(); GAPA(C1 = __builtin_amdgcn_mfma_f32_32x32x16_bf16(kf[7], qr[3], C1, 0, 0, 0),   P1[14], P1[15], 0.f, 0.f,       pw3[2] = PKW(P1, 12), pw3[3] = PKW(P1, 14), pw3); \
    l_reg += sacc; \
    if (GK) { DMA_K((t) + 3, sl_cur); } if (GV) { DMA_V((t) + 1, sl_next); } \
    CMASK(C0, C1, t); \
    { float a = MX3(C0[0], C0[1], C1[0]), b2 = MX3(C0[2], C0[3], C1[1]); a = MX3(a, C1[2], C1[3]); \
      _Pragma("unroll") for (int r = 4; r < 16; r += 4) { a = MX3(a, C0[r], C0[r + 1]); b2 = MX3(b2, C0[r + 2], C0[r + 3]); a = MX3(a, C1[r], C1[r + 1]); b2 = MX3(b2, C1[r + 2], C1[r + 3]); } \
      float rm = __builtin_fmaxf(a, b2); { auto rr = __builtin_amdgcn_permlane32_swap(__float_as_uint(rm), __float_as_uint(rm), false, false); rm = __builtin_fmaxf(__uint_as_float(rr[0]), __uint_as_float(rr[1])); } \
      resc = false; \
      if (__builtin_expect(__any(rm > (float)THRL), 0)) { const float dl = __builtin_fmaxf(rm, 0.f); mhat += dl; \
        _Pragma("unroll") for (int r = 0; r < 16; ++r) { C0[r] -= dl; C1[r] -= dl; } \
        _Pragma("unroll") for (int r = 0; r < 16; ++r) negm[r] = -mhat; asm volatile("" : "+v"(negm)); \
        const float f = __builtin_amdgcn_exp2f(-dl); l_reg *= f; if (hi == 0) wsf[r32] = f; resc = true; } } \
    SBAR(); \
    GAPB(o[0] = __builtin_amdgcn_mfma_f32_32x32x16_bf16(PAF(0), VFR(0), o[0], 0, 0, 0), C0, 0); \
    GAPB(o[1] = __builtin_amdgcn_mfma_f32_32x32x16_bf16(PAF(0), VFR(4), o[1], 0, 0, 0), C0, 4); \
    KRD(GL, 0); GAPB(o[0] = __builtin_amdgcn_mfma_f32_32x32x16_bf16(PAF(1), VFR(1), o[0], 0, 0, 0), C0, 8); \
    KRD(GL, 1); GAPB(o[1] = __builtin_amdgcn_mfma_f32_32x32x16_bf16(PAF(1), VFR(5), o[1], 0, 0, 0), C0, 12); \
    KRD(GL, 2); GAPB(o[0] = __builtin_amdgcn_mfma_f32_32x32x16_bf16(PAF(2), VFR(2), o[0], 0, 0, 0), C1, 0); \
    KRD(GL, 3); GAPB(o[1] = __builtin_amdgcn_mfma_f32_32x32x16_bf16(PAF(2), VFR(6), o[1], 0, 0, 0), C1, 4); \
    GAPB(o[0] = __builtin_amdgcn_mfma_f32_32x32x16_bf16(PAF(3), VFR(3), o[0], 0, 0, 0), C1, 8); \
    GAPB(o[1] = __builtin_amdgcn_mfma_f32_32x32x16_bf16(PAF(3), VFR(7), o[1], 0, 0, 0), C1, 12); \
    } while (0)
#define ENDW(tt) do { if ((tt) + 3 < NT) { WAIT_BAR(2); } else if ((tt) + 2 < NT) { WAIT_BAR(1); } else { WAIT_BAR(0); } } while (0)
    int t = 1;
    PROLOG(pA0, pA1);
    for (; t + 1 < NT; t += 2) {
        STEP(pB0, pB1, pA0, pA1, t, (t + 3 < NT), (t + 1 < NT), (t + 1 < NT));       ENDW(t);     RESC(); ROT();
        STEP(pA0, pA1, pB0, pB1, t + 1, (t + 4 < NT), (t + 2 < NT), (t + 2 < NT));   ENDW(t + 1); RESC(); ROT();
    }
    const int sl_last = oddnt ? sl_prev : sl_cur;
    nbase = oddnt ? sl_cur : sl_next;
    if (has_next) {
        const long nr = (long)NTOK + nb * CTXL; const long nko = (long)lane * 256 + nkvh * 64 + wid * 8, nvo = (long)(16 * (wid & 3) + (lane >> 2)) * 256 + nkvh * 64 + (wid >> 2) * 32 + (lane & 3) * 8;
        const int n0 = nbase, n1 = (n0 == (NSLOT - 1) * SLOTB) ? 0 : n0 + SLOTB, n2 = (n1 == (NSLOT - 1) * SLOTB) ? 0 : n1 + SLOTB;
        glds16(KB + nr * 256 + nko, (unsigned)__builtin_amdgcn_readfirstlane(kdst + n0)); glds16(VB + nr * 256 + nvo, (unsigned)__builtin_amdgcn_readfirstlane(vdst + n0));
        glds16(KB + (nr + 64) * 256 + nko, (unsigned)__builtin_amdgcn_readfirstlane(kdst + n1)); glds16(KB + (nr + 128) * 256 + nko, (unsigned)__builtin_amdgcn_readfirstlane(kdst + n2));
    }
    if (!oddnt) { STEP(pB0, pB1, pA0, pA1, NT - 1, false, false, false); RESC(); } else { pB0 = pA0; pB1 = pA1; }
    { float sacc = pB0[0] + pB0[1]; _Pragma("unroll") for (int r = 2; r < 16; ++r) sacc += pB0[r]; _Pragma("unroll") for (int r = 0; r < 16; ++r) sacc += pB1[r]; l_reg += sacc;
      pw0 = (u32x4){PKW(pB0, 0), PKW(pB0, 2), PKW(pB0, 4), PKW(pB0, 6)}; pw1 = (u32x4){PKW(pB0, 8), PKW(pB0, 10), PKW(pB0, 12), PKW(pB0, 14)}; pw2 = (u32x4){PKW(pB1, 0), PKW(pB1, 2), PKW(pB1, 4), PKW(pB1, 6)}; pw3 = (u32x4){PKW(pB1, 8), PKW(pB1, 10), PKW(pB1, 12), PKW(pB1, 14)};
      SBAR(); pv(o, vb0 + sl_last, PAF(0), PAF(1), PAF(2), PAF(3)); }
    if (has_next) {
        asm volatile("" ::: "memory");
        const bf16_t* nQw = Y + ((long)nb * SEQ + nn * 64 + qsub * 32) * 2048 + 1024 + (nkvh * 4 + (wid >> 1)) * 64;
#pragma unroll
        for (int d0 = 0; d0 < 4; ++d0) qr[d0] = *(const bf16x8*)(nQw + (long)r32 * 2048 + d0 * 16 + hi * 8);
    }
    { auto rr = __builtin_amdgcn_permlane32_swap(__float_as_uint(l_reg), __float_as_uint(l_reg), false, false); l_reg = __uint_as_float(rr[0]) + __uint_as_float(rr[1]); }
    l_reg += __builtin_amdgcn_exp2f(fminf(sink[head] * LOG2E - mhat, 80.f));
    if (hi == 0) wsf[32 + r32] = l_reg; asm volatile("s_waitcnt lgkmcnt(0)" ::: "memory");
    float rli[16];
#pragma unroll
    for (int r = 0; r < 16; ++r) rli[r] = __builtin_amdgcn_rcpf(wsf[32 + crow(r, hi)]);
    bf16_t* Ow = O + qrow0 * ldo + head * 64;
    { LAS bf16_t* stg = (LAS bf16_t*)(shm + LDS_OST) + wid * 2048;
#pragma unroll
      for (int r = 0; r < 16; ++r) { const int orow = crow(r, hi);
#pragma unroll
          for (int d0 = 0; d0 < 2; ++d0) stg[orow * 64 + d0 * 32 + r32] = (bf16_t)(pk2(o[d0][r] * rli[r], 0.f) & 0xffffu); }
      asm volatile("s_waitcnt lgkmcnt(0)" ::: "memory");
#pragma unroll
      for (int i = 0; i < 4; ++i) { const int row = i * 8 + (lane >> 3), ch = lane & 7; const u32x4 v = *(const LAS u32x4*)(stg + row * 64 + ch * 8); *(u32x4*)(Ow + (long)row * ldo + ch * 8) = v; } }
    asm volatile("s_waitcnt lgkmcnt(0)\n\ts_barrier" ::: "memory");
#undef TROW
#undef DMA_K
#undef DMA_V
#undef CMASK
#undef START
#undef RESC
#undef ROT
#undef PKW
#undef PAF
#undef VFR
#undef PIN
#undef MX3
#undef GAPA
#undef GAPB
#undef EX
#undef VRD
#undef KRD
#undef STEP
#undef ENDW
#undef PROLOG
}
#undef SBAR
#undef WAIT_BAR
}

#define XB_TMO      128
#define XB_XCNT(j)  (256  + 64 * (j))
#define XB_XSUB(j)  (1280 + 64 * (j))
#define XB_XGEN(j)  (2304 + 64 * (j))
#define XB_TOP      3328
#define XB_TOPGEN   3392
#define XCD_BAR_WORDS 3456
#define XB_SPIN_CAP (1u << 18)
__device__ __forceinline__ unsigned xb_ld(unsigned* p)              { return __hip_atomic_load(p, __ATOMIC_RELAXED, __HIP_MEMORY_SCOPE_AGENT); }
__device__ __forceinline__ unsigned xb_add(unsigned* p, unsigned v) { return __hip_atomic_fetch_add(p, v, __ATOMIC_RELAXED, __HIP_MEMORY_SCOPE_AGENT); }
__device__ __forceinline__ unsigned xb_xcc_id() { return (unsigned)__builtin_amdgcn_s_getreg((3 << 11) | 20) & 0xFu; }
#define XB_SPIN(cond, bar) do { unsigned _sp = 0; while (cond) { __builtin_amdgcn_s_sleep(1); \
    if ((++_sp & 255u) == 0u) { if (xb_ld(&(bar)[XB_TMO])) break; if (_sp > XB_SPIN_CAP) { atomicAdd(&(bar)[XB_TMO], 1u); break; } } } } while (0)
struct XcdBarrier { unsigned* bar; unsigned x; volatile LAS unsigned* st; };
__device__ __forceinline__ XcdBarrier xcd_barrier_post(unsigned* bar, volatile LAS unsigned* st) {
    XcdBarrier b; b.bar = bar; b.x = xb_xcc_id(); b.st = st;
    if (threadIdx.x == 0) (void)xb_add(&bar[XB_XCNT(b.x)], 1u);
    return b;
}
__device__ __forceinline__ void xcd_barrier_complete(unsigned* bar, unsigned x, unsigned& nloc, unsigned& nx) {
    const unsigned G = gridDim.x * gridDim.y * gridDim.z;
    unsigned sum, cnt, mine, sp = 0u;
    for (;;) {
        sum = 0u; cnt = 0u; mine = 0u;
#pragma unroll
        for (unsigned j = 0; j < 16; ++j) { const unsigned c = xb_ld(&bar[XB_XCNT(j)]); sum += c; cnt += (c > 0u) ? 1u : 0u; mine = (j == x) ? c : mine; }
        if (sum == G) break;
        __builtin_amdgcn_s_sleep(1);
        if ((++sp & 255u) == 0u) { if (xb_ld(&bar[XB_TMO])) break; if (sp > XB_SPIN_CAP) { atomicAdd(&bar[XB_TMO], 1u); break; } }
    }
    nloc = mine > 0u ? mine : 1u; nx = cnt > 0u ? cnt : 1u;
}
__device__ __forceinline__ void xcd_barrier(const XcdBarrier& b) {
    asm volatile("s_waitcnt vmcnt(0)" ::: "memory");
    __syncthreads();
    if (threadIdx.x == 0) {
        unsigned* bar = b.bar;
        __builtin_amdgcn_s_waitcnt(0);
        unsigned nloc = b.st[0], nx = b.st[1];
        if (nloc == 0u) { xcd_barrier_complete(bar, b.x, nloc, nx); b.st[0] = nloc; b.st[1] = nx; }
        const unsigned old = xb_add(&bar[XB_XSUB(b.x)], 1u);
        const unsigned gen = old / nloc;
        if (old + 1u == (gen + 1u) * nloc) {
            __builtin_amdgcn_fence(__ATOMIC_RELEASE, "agent");
            asm volatile("s_waitcnt vmcnt(0)" ::: "memory");
            const unsigned og = xb_add(&bar[XB_TOP], 1u);
            const unsigned tg = og / nx;
            if (og + 1u == (tg + 1u) * nx) xb_add(&bar[XB_TOPGEN], 1u);
            else XB_SPIN(xb_ld(&bar[XB_TOPGEN]) == tg, bar);
            __builtin_amdgcn_fence(__ATOMIC_ACQUIRE, "agent");
            xb_add(&bar[XB_XGEN(b.x)], 1u);
            asm volatile("s_waitcnt vmcnt(0)" ::: "memory");
        } else {
            XB_SPIN(xb_ld(&bar[XB_XGEN(b.x)]) == gen, bar);
            __builtin_amdgcn_fence(__ATOMIC_ACQUIRE, "agent");
            asm volatile("s_waitcnt vmcnt(0)" ::: "memory");
        }
    }
    __syncthreads();
}
constexpr int LDSCTL_OFF = LDS_BYTES - 256;
constexpr int CW_BAR = 4096, CW_CTX = 8192;

#ifndef PROBE_GMLP2
#define PROBE_GMLP2 0
#endif
#ifndef ATT_PIPE
#define ATT_PIPE 1
#endif
#ifndef ATT_THRL
#define ATT_THRL 8
#endif
#ifndef ONE_LAUNCH
#define ONE_LAUNCH 1
#endif
#ifndef FAST_MIX
#define FAST_MIX 1
#endif
#ifndef PROBE_SEQ
#define PROBE_SEQ 0, 1, 2, 3, 4, 5, 6, 7, 8, 9, 10, 11
#endif

enum { PH_PRO = 0, PH_HN, PH_IN, PH_MIX, PH_A, PH_O, PH_H2R, PH_WCONV, PH_TOPK, PH_GU, PH_D, PH_FIN, PH_COUNT };

__global__ void __launch_bounds__(NTHREADS, 2) fwd(Args args) {
    extern __shared__ __attribute__((aligned(16))) unsigned char lds_raw[];
    LAS unsigned char* lds = (LAS unsigned char*)lds_raw;
    const int tid = threadIdx.x, lane = tid & 63, wave = __builtin_amdgcn_readfirstlane(tid >> 6);
    const int G = gridDim.x, bid = blockIdx.x;
    unsigned char* ws = args.ws;
    const int lo = args.ph_lo, hi = args.ph_hi;
#define IN(k) (lo <= (k) && (k) < hi)
    float* MOD = (float*)(ws + WS_MOD); f32x2* ROPE = (f32x2*)(ws + WS_ROPE);
    float* AFFT = (float*)(ws + WS_AFFT); int* TOPI = (int*)(ws + WS_TOPI); float* TOPW = (float*)(ws + WS_TOPW); int* SLOT = (int*)(ws + WS_SLOT);
    bf16_t* WSP = (bf16_t*)(ws + WS_WSP); bf16_t* WIN = (bf16_t*)(ws + WS_WIN); bf16_t* WAB = (bf16_t*)(ws + WS_WAB); bf16_t* WO = (bf16_t*)(ws + WS_WO);
    bf16_t* H = (bf16_t*)(ws + WS_H); bf16_t* VA = (bf16_t*)(ws + WS_VA); bf16_t* KB = (bf16_t*)(ws + WS_KB); bf16_t* VB = (bf16_t*)(ws + WS_VB);
    bf16_t* GT = (bf16_t*)(ws + WS_G); bf16_t* Y = (bf16_t*)(ws + WS_Y); bf16_t* TMP = (bf16_t*)(ws + WS_TMP); bf16_t* MERGED = (bf16_t*)(ws + WS_MERGED);
    bf16_t* WGU = (bf16_t*)(ws + WS_WGU); bf16_t* WD = (bf16_t*)(ws + WS_WD); bf16_t* H2 = (bf16_t*)(ws + WS_H2); bf16_t* ACT = (bf16_t*)(ws + WS_ACT); bf16_t* YB = (bf16_t*)(ws + WS_YB);
    const int gw = bid * NWAVES + wave, NGW = G * NWAVES;
    if (tid < 64) ((LAS unsigned*)(lds + LDSCTL_OFF))[tid] = 0u;
    __syncthreads();
    XcdBarrier bar; bar.bar = (unsigned*)(ws + WS_CTL) + CW_BAR; bar.x = 0; bar.st = nullptr;
    if (ONE_LAUNCH) bar = xcd_barrier_post((unsigned*)(ws + WS_CTL) + CW_BAR, (volatile LAS unsigned*)(lds + LDSCTL_OFF));
#define SEAM(k) do { if (ONE_LAUNCH && IN(k) && IN((k) + 1)) xcd_barrier(bar); } while (0)

    if (IN(PH_PRO)) {
        if (bid < 192) adaln_task(bid, args.in[I_C], args.in[I_CCTX], args.in[I_WADA], args.in[I_BADA], MOD, (LAS float*)lds, tid);
        else if (bid == 192) rope_table(ROPE, tid);
        __syncthreads();
        for (int i = bid * NTHREADS + tid; i < 8 * 128 * 128 / 4; i += G * NTHREADS) st4bf(WSP + 4 * i, *(const f32x4*)(args.in[I_WSP] + 4 * i));
        LAS float* scr = (LAS float*)(lds + wave * 16384);
        constexpr int I_IN = 16 * 176, I_P = 16 * 32;
        for (int it = gw; it < I_IN + 3 * I_P; it += NGW) {
            int r = it;
            if (r < I_IN) { const int kb = r / 176, nb = r % 176, n0 = nb * 32; int drow = n0;
                if (n0 >= OFF_GATE) { const int gcol = n0 - OFF_GATE, isb = gcol >= 1024, ch = gcol & 1023; drow = OFF_GATE + 256 * (ch >> 7) + (ch & 127) + (isb ? 128 : 0); }
                transpose_item(args.in[I_WIN], INCOLS, kb * 64, n0, WIN + (size_t)drow * 1024 + kb * 64, 1024, scr, lane); continue; } r -= I_IN;
            if (r < I_P) { const int kb = r / 32, nb = r % 32; transpose_item(args.in[I_WPA], 1024, kb * 64, nb * 32, WAB + (size_t)(nb * 32) * 2048 + kb * 64, 2048, scr, lane); continue; } r -= I_P;
            if (r < I_P) { const int kb = r / 32, nb = r % 32; transpose_item(args.in[I_WPB], 1024, kb * 64, nb * 32, WAB + (size_t)(nb * 32) * 2048 + 1024 + kb * 64, 2048, scr, lane); continue; } r -= I_P;
            { const int kb = r / 32, nb = r % 32; transpose_item(args.in[I_WOUT], 1024, kb * 64, nb * 32, WO + (size_t)(nb * 32) * 1024 + kb * 64, 1024, scr, lane); }
        }
    }
    SEAM(PH_PRO);
    if (IN(PH_HN)) {
        const float* g1n = args.in[I_N1G];
        const int HCH = (NROWS_H + NGW - 1) / NGW;
        f32x4 am[4], sm[4]; int mcur = -1;
        for (int kk = 0; kk < HCH; ++kk) {
            const int row = gw * HCH + kk; if (row >= NROWS_H) break;
            const float* xr; int mrow;
            if (row < NTOK) { xr = args.in[I_X] + (size_t)row * 1024; mrow = row >> 12; } else { xr = args.in[I_CTX] + (size_t)(row - NTOK) * 1024; mrow = 8; }
            f32x4 v[4]; float ss = 0.f;
#pragma unroll
            for (int j = 0; j < 4; ++j) { v[j] = *(const f32x4*)(xr + 4 * lane + 256 * j); ss += (v[j].x * v[j].x + v[j].y * v[j].y) + (v[j].z * v[j].z + v[j].w * v[j].w); }
            if (mrow != mcur) { mcur = mrow; const float* sh = MOD + mrow * 6144; const float* sc = sh + 1024;
#pragma unroll
                for (int j = 0; j < 4; ++j) { const int col = 4 * lane + 256 * j; am[j] = *(const f32x4*)(g1n + col) * (1.f + *(const f32x4*)(sc + col)); sm[j] = *(const f32x4*)(sh + col); } }
            const float rstd = 1.0f / sqrtf(wave_sum(ss) * (1.f / 1024.f) + EPS);
#pragma unroll
            for (int j = 0; j < 4; ++j) st4bf(H + (size_t)row * 1024 + 4 * lane + 256 * j, (v[j] * rstd) * am[j] + sm[j]);
        }
    }
    SEAM(PH_HN);
    if (IN(PH_IN)) {
        Gemm g{H, WIN, 1024, 1024, 1024, 0, 30, nullptr}; StaticOrder S; S.init(NTOK, INCOLS, G, bid, G == 256 ? 0 : 16);
        EpiIn E{Y, VA, KB, VB, GT, args.in[I_BMG], ROPE, (f32x2*)(ws + WS_STATS)};
        GEMM_PHASE<EpiIn, StaticOrder, false>(lds, g, S, E);
    }
    SEAM(PH_IN);
    if (IN(PH_MIX) && FAST_MIX) {
        unsigned* ctxcnt = (unsigned*)(ws + WS_CTL) + CW_CTX;
        if (G == 256 && bid < 16) {
            Gemm g{H, WIN, 1024, 1024, 1024, 0, 30, nullptr}; OneUnit S{NTOK / 256 + (bid >> 1), 12 + (bid & 1)};
            EpiIn E{Y, VA, KB, VB, GT, args.in[I_BMG], ROPE, (f32x2*)(ws + WS_STATS)};
            GEMM_PHASE<EpiIn, OneUnit, false>(lds, g, S, E);
            asm volatile("s_waitcnt vmcnt(0)" ::: "memory");
            __syncthreads();
            if (tid == 0) { __builtin_amdgcn_fence(__ATOMIC_RELEASE, "agent"); asm volatile("s_waitcnt vmcnt(0)" ::: "memory"); xb_add(ctxcnt, 1u); }
        }
        if (!(args.flags & 8)) for (int task = bid; task < NB * 32; task += G) mix::gmlp_unit(task, Y, (args.flags & 2) ? TMP : Y, (args.flags & 2) ? 1024 : 2048, VA, WSP, (const f32x2*)(ws + WS_STATS), args.in[I_LNG], args.in[I_LNB], args.in[I_BSP], lds);
        if (tid == 0) {
            unsigned sp = 0; while (xb_ld(ctxcnt) < 16u) { __builtin_amdgcn_s_sleep(2); if (++sp > (1u << 22)) break; }
            __builtin_amdgcn_fence(__ATOMIC_ACQUIRE, "agent"); asm volatile("s_waitcnt vmcnt(0)" ::: "memory");
        }
        __syncthreads();
#if ATT_PIPE
        att2::bf16x8 att_qr[4]; int att_base = 0; bool att_primed = false;
        int ubase, ucnt;
        if (G != 256) { ubase = bid * 8; ucnt = 0; }
        else if (bid < 16) { ubase = 6 * bid; ucnt = 6; } else if (bid < 48) { ubase = 96 + 9 * (bid - 16); ucnt = 9; } else { ubase = 384 + 8 * (bid - 48); ucnt = 8; }
        if (!(args.flags & 1)) for (int i = 0; i < ucnt; ++i) {
            const int u_ = ubase + i, un = u_ + 1; const bool more = i + 1 < ucnt; int nbase_ = 0;
            att2::attn_unit<ATT_THRL>(u_ >> 8, (u_ >> 2) & 63, u_ & 3, 0, att_base, att_primed, more, un >> 8, (un >> 2) & 63, un & 3, 0, att_qr, nbase_,
                                      Y, (args.flags & 4) ? TMP : Y + 1024, (args.flags & 4) ? 1024 : 2048, KB, VB, args.in[I_SINK], lds);
            att_base = nbase_; att_primed = more;
        }
        if (G != 256 && !(args.flags & 1)) for (int u_ = bid; u_ < NB * 32 * 8; u_ += G) {
            int nbase_ = 0;
            att2::attn_unit<ATT_THRL>(u_ >> 8, (u_ >> 2) & 63, u_ & 3, 0, 0, false, false, 0, 0, 0, 0, att_qr, nbase_, Y, (args.flags & 4) ? TMP : Y + 1024, (args.flags & 4) ? 1024 : 2048, KB, VB, args.in[I_SINK], lds);
        }
#else
        if (!(args.flags & 1)) for (int task = bid; task < NB * 32 * 4; task += G) mix::attn_unit(task >> 7, (task >> 2) & 31, task & 3, Y, (args.flags & 4) ? TMP : Y + 1024, (args.flags & 4) ? 1024 : 2048, KB, VB, args.in[I_SINK], lds);
#endif
    }
    SEAM(PH_MIX);
    if (IN(PH_A)) {
        Gemm g{Y, WAB, 2048, 2048, 2048, 0, 30, nullptr}; StaticOrder S; S.init(NTOK, 1024, G, bid, 0, 1);
        EpiAB E{MERGED, GT};
        GEMM_PHASE<EpiAB, StaticOrder, false, true>(lds, g, S, E);
    }
    SEAM(PH_A);
    if (IN(PH_O)) {
        Gemm g{MERGED, WO, 1024, 1024, 1024, 0, 30, nullptr}; StaticOrder S; S.init(NTOK, 1024, G, bid);
        EpiO E{(bf16_t*)args.out, MOD};
        GEMM_PHASE<EpiO, StaticOrder, false>(lds, g, S, E);
    }
    SEAM(PH_O);
    if (IN(PH_H2R)) {
        LAS float* wT = (LAS float*)lds;
        { f32x4 wv[8];
#pragma unroll
          for (int k = 0; k < 8; ++k) wv[k] = *(const f32x4*)(args.in[I_WR] + 4 * (tid + NTHREADS * k));
#pragma unroll
          for (int k = 0; k < 8; ++k) { const int f = tid + NTHREADS * k, col = f >> 2, e0 = 4 * (f & 3); wT[e0 * 1024 + col] = wv[k].x; wT[(e0 + 1) * 1024 + col] = wv[k].y; wT[(e0 + 2) * 1024 + col] = wv[k].z; wT[(e0 + 3) * 1024 + col] = wv[k].w; } }
        __syncthreads();
        const float* g2n = args.in[I_N2G];
        const int H2CH = (NTOK / 2 + NGW - 1) / NGW;
        const bool h32 = lane & 32, h16 = lane & 16, h8 = lane & 8, h4 = lane & 4;
        const int myexp = 8 * (lane >> 5) + 4 * ((lane >> 4) & 1) + 2 * ((lane >> 3) & 1) + ((lane >> 2) & 1);
        const bf16_t* D16 = (const bf16_t*)args.out;
        f32x4 vn[2][4]; u32x2 dn[2][4];
#pragma unroll
        for (int q = 0; q < 2; ++q)
#pragma unroll
            for (int j = 0; j < 4; ++j) { const size_t r_ = (size_t)(2 * (NTOK / 2 - 1 - (gw * H2CH < NTOK / 2 ? gw * H2CH : 0)) + q); vn[q][j] = *(const f32x4*)(args.in[I_X] + r_ * 1024 + 4 * lane + 256 * j); dn[q][j] = *(const u32x2*)(D16 + r_ * 2048 + 1024 + 4 * lane + 256 * j); }
        f32x4 amod[4], smod[4]; int bcur = -1;
        for (int kk = 0; kk < H2CH; ++kk) {
            const int rp = gw * H2CH + kk; if (rp >= NTOK / 2) break;
            const int row0 = 2 * (NTOK / 2 - 1 - rp), b = row0 >> 12;
            if (b != bcur) { bcur = b; const float* sh = MOD + b * 6144 + 3072; const float* sc = sh + 1024;
#pragma unroll
                for (int j = 0; j < 4; ++j) { const int col = 4 * lane + 256 * j; amod[j] = *(const f32x4*)(g2n + col) * (1.f + *(const f32x4*)(sc + col)); smod[j] = *(const f32x4*)(sh + col); } }
            f32x4 v[2][4]; float ss[2] = {0.f, 0.f};
#pragma unroll
            for (int q = 0; q < 2; ++q)
#pragma unroll
                for (int j = 0; j < 4; ++j) { const u32x2 dw = dn[q][j]; v[q][j] = vn[q][j] + (f32x4){bf2f(dw.x & 0xffffu), bf2f(dw.x >> 16), bf2f(dw.y & 0xffffu), bf2f(dw.y >> 16)}; ss[q] += (v[q][j].x * v[q][j].x + v[q][j].y * v[q][j].y) + (v[q][j].z * v[q][j].z + v[q][j].w * v[q][j].w); }
            { const int rn = (kk + 1 < H2CH && rp + 1 < NTOK / 2) ? rp + 1 : rp;
#pragma unroll
              for (int q = 0; q < 2; ++q)
#pragma unroll
                  for (int j = 0; j < 4; ++j) { const size_t r_ = (size_t)(2 * (NTOK / 2 - 1 - rn) + q); vn[q][j] = *(const f32x4*)(args.in[I_X] + r_ * 1024 + 4 * lane + 256 * j); dn[q][j] = *(const u32x2*)(D16 + r_ * 2048 + 1024 + 4 * lane + 256 * j); } }
            float rstd[2];
#pragma unroll
            for (int q = 0; q < 2; ++q) rstd[q] = 1.0f / sqrtf(wave_sum(ss[q]) * (1.f / 1024.f) + EPS);
            float lg[2][16];
#pragma unroll
            for (int q = 0; q < 2; ++q)
#pragma unroll
                for (int e = 0; e < 16; ++e) lg[q][e] = 0.f;
            f32x4 wb[2][4];
#pragma unroll
            for (int e = 0; e < 4; ++e) wb[0][e] = *(const LAS f32x4*)(wT + e * 1024 + 4 * lane);
            f32x4 h[2];
#pragma unroll
            for (int g = 0; g < 16; ++g) {
                const int j = g >> 2, eg = g & 3, col = 4 * lane + 256 * j;
                if (g + 1 < 16) {
                    const int jn = (g + 1) >> 2, en = (g + 1) & 3;
#pragma unroll
                    for (int e = 0; e < 4; ++e) wb[(g + 1) & 1][e] = *(const LAS f32x4*)(wT + (4 * en + e) * 1024 + 4 * lane + 256 * jn);
                }
                if (eg == 0) {
#pragma unroll
                    for (int q = 0; q < 2; ++q) { h[q] = (v[q][j] * rstd[q]) * amod[j] + smod[j]; st4bf(H2 + (size_t)(row0 + q) * 1024 + col, h[q]); }
                }
#pragma unroll
                for (int e = 0; e < 4; ++e) {
                    const f32x4 w = wb[g & 1][e];
#pragma unroll
                    for (int q = 0; q < 2; ++q) lg[q][4 * eg + e] += (h[q].x * w.x + h[q].y * w.y) + (h[q].z * w.z + h[q].w * w.w);
                    asm volatile("" : "+v"(lg[0][4 * eg + e]), "+v"(lg[1][4 * eg + e]));
                }
                asm volatile("" ::: "memory");
            }
#pragma unroll
            for (int q = 0; q < 2; ++q) {
                float a8[8], a4[4], a2[2], a1;
#pragma unroll
                for (int i = 0; i < 8; ++i) { const float send = h32 ? lg[q][i] : lg[q][i + 8], keep = h32 ? lg[q][i + 8] : lg[q][i]; a8[i] = keep + xchg32(send); }
#pragma unroll
                for (int i = 0; i < 4; ++i) { const float send = h16 ? a8[i] : a8[i + 4], keep = h16 ? a8[i + 4] : a8[i]; a4[i] = keep + xchg16(send); }
#pragma unroll
                for (int i = 0; i < 2; ++i) { const float send = h8 ? a4[i] : a4[i + 2], keep = h8 ? a4[i + 2] : a4[i]; a2[i] = keep + dpp_f<0x140>(send); }
                { const float send = h4 ? a2[0] : a2[1], keep = h4 ? a2[1] : a2[0]; a1 = keep + dpp_f<0x141>(send); }
                a1 += dpp_f<0x4E>(a1); a1 += dpp_f<0xB1>(a1);
                float mx = a1;
                mx = fmaxf(mx, dpp_f<0x141>(mx)); mx = fmaxf(mx, dpp_f<0x140>(mx)); mx = fmaxf(mx, xchg16(mx)); mx = fmaxf(mx, xchg32(mx));
                const float p = __expf(a1 - mx); float den = p;
                den += dpp_f<0x141>(den); den += dpp_f<0x140>(den); den += xchg16(den); den += xchg32(den);
                if ((lane & 3) == 0) AFFT[(size_t)(b * 16 + myexp) * SEQ + ((row0 + q) & (SEQ - 1))] = p / den;
            }
        }
    }
    if (IN(PH_WCONV)) {
        __syncthreads();
        LAS float* scr = (LAS float*)(lds + wave * 16384);
        constexpr int I_G = 16 * 16 * 64, I_D = 16 * 32 * 32;
        auto item = [&](int it) -> TrItem {
            int r = it; TrItem t;
            if (r < 2 * I_G) {
                const int up = r >= I_G; if (up) r -= I_G;
                r = (r & ~0x44) | ((r >> 4) & 0x4) | ((r << 4) & 0x40);
                const int e = r >> 10, kb = (r >> 6) & 15, nb = r & 63, n0 = nb * 32;
                const int drow = 256 * (n0 >> 7) + (n0 & 127) + (up ? 128 : 0);
                t.src = args.in[up ? I_WEU : I_WEG] + (size_t)e * 1024 * 2048 + (size_t)(kb * 64) * 2048 + n0; t.N = 2048;
                t.dst = WGU + (size_t)e * 4096 * 1024 + (size_t)drow * 1024 + kb * 64; t.ldt = 1024;
            } else {
                r -= 2 * I_G;
                r = (r & ~0x24) | ((r >> 3) & 0x4) | ((r << 3) & 0x20);
                const int e = r >> 10, kb = (r >> 5) & 31, nb = r & 31;
                t.src = args.in[I_WED] + (size_t)e * 2048 * 1024 + (size_t)(kb * 64) * 1024 + nb * 32; t.N = 1024;
                t.dst = WD + (size_t)e * 1024 * 2048 + (size_t)(nb * 32) * 2048 + kb * 64; t.ldt = 2048;
            }
            return t;
        };
        constexpr int NIT = 2 * I_G + I_D;
        if (gw < NIT) {
            TrItem cur = item(gw); f32x4 vc[8], vn[8];
            tr_load(cur, vc, lane);
            for (int it = gw; it < NIT; it += NGW) {
                const bool more = it + NGW < NIT;
                TrItem nxt = cur;
                if (more) { nxt = item(it + NGW); tr_load(nxt, vn, lane); }
                tr_store(cur, vc, scr, lane);
                cur = nxt;
#pragma unroll
                for (int i = 0; i < 8; ++i) vc[i] = vn[i];
            }
        }
    }
    SEAM(PH_WCONV);
    if (IN(PH_TOPK)) {
        LAS int* wsum = (LAS int*)lds;
        for (int task = bid; task < NE * NB; task += G) {
            const int e = task >> 3, b = task & 7;
            const float* aff = AFFT + (size_t)(b * 16 + e) * SEQ;
            unsigned k[8];
            { const u32x4 a0 = *(const u32x4*)(aff + 8 * tid), a1 = *(const u32x4*)(aff + 8 * tid + 4); k[0] = a0.x; k[1] = a0.y; k[2] = a0.z; k[3] = a0.w; k[4] = a1.x; k[5] = a1.y; k[6] = a1.z; k[7] = a1.w; }
            unsigned T = 0u; int it = 0;
            __syncthreads();
            for (int bit = 30; bit >= 0; --bit, ++it) {
                const unsigned cand = T | (1u << bit); int c = 0;
#pragma unroll
                for (int j = 0; j < 8; ++j) c += __builtin_popcountll(__ballot(k[j] >= cand));
                if (lane == 0) wsum[(it & 1) * 8 + wave] = c;
                __syncthreads();
                int tot = 0;
#pragma unroll
                for (int w = 0; w < 8; ++w) tot += wsum[(it & 1) * 8 + w];
                if (tot >= CAP) T = cand;
            }
            int cg = 0, ce = 0;
#pragma unroll
            for (int j = 0; j < 8; ++j) { cg += (k[j] > T) ? 1 : 0; ce += (k[j] == T) ? 1 : 0; }
            LAS int* sc1 = wsum + 16; LAS int* sc2 = wsum + 32;
            int ie = ce, ig = cg;
#pragma unroll
            for (int o = 1; o < 64; o <<= 1) { const int te = __shfl_up(ie, o), tg = __shfl_up(ig, o); if (lane >= o) { ie += te; ig += tg; } }
            __syncthreads();
            if (lane == 63) { sc1[wave] = ie; sc2[wave] = ig; }
            __syncthreads();
            int ebase = ie - ce, totg = 0;
#pragma unroll
            for (int w = 0; w < 8; ++w) { if (w < wave) ebase += sc1[w]; totg += sc2[w]; }
            const int need = CAP - totg;
            int sel[8], cs = 0, er = ebase;
#pragma unroll
            for (int j = 0; j < 8; ++j) { const bool eq = (k[j] == T); sel[j] = (k[j] > T) || (eq && er < need); er += eq ? 1 : 0; cs += sel[j]; }
            int is = cs;
#pragma unroll
            for (int o = 1; o < 64; o <<= 1) { const int ts = __shfl_up(is, o); if (lane >= o) is += ts; }
            __syncthreads();
            if (lane == 63) sc1[wave] = is;
            __syncthreads();
            int sbase = is - cs;
#pragma unroll
            for (int w = 0; w < 8; ++w) if (w < wave) sbase += sc1[w];
#pragma unroll
            for (int j = 0; j < 8; ++j) {
                const int t = 8 * tid + j; int slot = -1;
                if (sel[j]) { slot = sbase; ++sbase; const int prow = (e * 8 + b) * CAP + slot; TOPI[prow] = t; TOPW[prow] = __uint_as_float(k[j]); }
                SLOT[((size_t)b * SEQ + t) * 16 + e] = slot;
            }
            __syncthreads();
        }
    }
    SEAM(PH_TOPK);
    if (IN(PH_GU)) {
        Gemm g{H2, WGU, 1024, 1024, 1024, (size_t)4096 * 1024, 4, TOPI}; StaticOrder S; S.init(NPAIR, 4096, G, bid);
        EpiGU E{ACT};
        GEMM_PHASE<EpiGU, StaticOrder, true, false, true>(lds, g, S, E);
    }
    SEAM(PH_GU);
    if (IN(PH_D)) {
        Gemm g{ACT, WD, 2048, 2048, 2048, (size_t)1024 * 2048, 4, nullptr}; StaticOrder S; S.init(NPAIR, 1024, G, bid, 0, 1);
        EpiD E{YB, TOPW};
        GEMM_PHASE<EpiD, StaticOrder, false>(lds, g, S, E);
    }
    SEAM(PH_D);
    if (IN(PH_FIN)) {
        const float* fg = args.in[I_FING];
        const bf16_t* ZROW = (const bf16_t*)(ws + WS_CTL + 512 * 1024);
        int sln[2] = {-1, -1};
        const int FCH = (NTOK / 2 + NGW - 1) / NGW;
        if (gw * FCH < NTOK / 2 && lane < 16) { sln[0] = SLOT[(size_t)(2 * gw * FCH) * 16 + lane]; sln[1] = SLOT[(size_t)(2 * gw * FCH + 1) * 16 + lane]; }
        f32x4 g2v[4], fgv[4]; int bcur = -1;
#pragma unroll
        for (int h = 0; h < 2; ++h) { fgv[2 * h] = *(const f32x4*)(fg + 512 * h + 8 * lane); fgv[2 * h + 1] = *(const f32x4*)(fg + 512 * h + 8 * lane + 4); }
        for (int kk = 0; kk < FCH; ++kk) {
            const int rp = gw * FCH + kk; if (rp >= NTOK / 2) break;
            const int row0 = 2 * rp, b = row0 >> 12;
            const int sl[2] = {sln[0], sln[1]};
            { const int rn = rp + 1; if (kk + 1 < FCH && rn < NTOK / 2 && lane < 16) { sln[0] = SLOT[(size_t)(2 * rn) * 16 + lane]; sln[1] = SLOT[(size_t)(2 * rn + 1) * 16 + lane]; } }
            if (b != bcur) { bcur = b; const float* g2 = MOD + b * 6144 + 5120;
#pragma unroll
                for (int h = 0; h < 2; ++h) { g2v[2 * h] = *(const f32x4*)(g2 + 512 * h + 8 * lane); g2v[2 * h + 1] = *(const f32x4*)(g2 + 512 * h + 8 * lane + 4); } }
            f32x4 xv[2][4], acc[2][4];
#pragma unroll
            for (int q = 0; q < 2; ++q)
#pragma unroll
                for (int h = 0; h < 2; ++h) { const float* xp = args.in[I_X] + (size_t)(row0 + q) * 1024 + 512 * h + 8 * lane; f32x4 d0_, d1_; ld8bf((const bf16_t*)args.out + (size_t)(row0 + q) * 2048 + 1024 + 512 * h + 8 * lane, d0_, d1_);
                    xv[q][2 * h] = *(const f32x4*)xp + d0_; xv[q][2 * h + 1] = *(const f32x4*)(xp + 4) + d1_;
                    acc[q][2 * h] = (f32x4){0.f, 0.f, 0.f, 0.f}; acc[q][2 * h + 1] = (f32x4){0.f, 0.f, 0.f, 0.f}; }
#pragma unroll
            for (int q = 0; q < 2; ++q) {
                unsigned long long mask = __ballot(sl[q] >= 0);
                for (;;) {
                    const bf16_t* yr[4];
#pragma unroll
                    for (int k = 0; k < 4; ++k) {
                        if (mask) { const int ex = __builtin_ctzll(mask); mask &= mask - 1; const int s = __builtin_amdgcn_readlane(sl[q], ex); yr[k] = YB + (size_t)((ex * 8 + b) * CAP + s) * 1024; }
                        else yr[k] = ZROW;
                    }
                    u32x4 y[4][2];
#pragma unroll
                    for (int k = 0; k < 4; ++k)
#pragma unroll
                        for (int h = 0; h < 2; ++h) y[k][h] = *(const u32x4*)(yr[k] + 512 * h + 8 * lane);
#pragma unroll
                    for (int k = 0; k < 4; ++k)
#pragma unroll
                        for (int h = 0; h < 2; ++h) { const u32x4 w = y[k][h];
                            acc[q][2 * h] += (f32x4){bf2f(w.x & 0xffffu), bf2f(w.x >> 16), bf2f(w.y & 0xffffu), bf2f(w.y >> 16)};
                            acc[q][2 * h + 1] += (f32x4){bf2f(w.z & 0xffffu), bf2f(w.z >> 16), bf2f(w.w & 0xffffu), bf2f(w.w >> 16)}; }
                    if (!mask) break;
                }
            }
#pragma unroll
            for (int q = 0; q < 2; ++q) {
                float ss = 0.f;
#pragma unroll
                for (int h = 0; h < 2; ++h)
#pragma unroll
                    for (int u4 = 0; u4 < 2; ++u4) { const int col = 512 * h + 8 * lane + 4 * u4; f32x4& v = xv[q][2 * h + u4]; v = v + g2v[2 * h + u4] * acc[q][2 * h + u4]; ss += (v.x * v.x + v.y * v.y) + (v.z * v.z + v.w * v.w); }
                const float rstd = 1.0f / sqrtf(wave_sum(ss) * (1.f / 1024.f) + EPS);
#pragma unroll
                for (int h = 0; h < 2; ++h)
#pragma unroll
                    for (int u4 = 0; u4 < 2; ++u4) { const int col = 512 * h + 8 * lane + 4 * u4; *(f32x4*)(args.out + (size_t)(row0 + q) * 1024 + col) = xv[q][2 * h + u4] * rstd * fgv[2 * h + u4]; }
            }
        }
    }
#undef IN
}

extern "C" void kernel_launch(void* const* d_in, const int* in_sizes, int n_in, void* d_out, int out_size, void* d_ws, size_t ws_size, hipStream_t stream) {
    static int grid = 0;
    if (grid == 0) {
        if (n_in != 23 || in_sizes[0] != NTOK * DM || out_size != NTOK * DM || ws_size < WS_END) {
            fprintf(stderr, "kernel_launch: unexpected problem (n_in %d, in0 %d, out %d, ws %zu < %zu?)\n", n_in, n_in > 0 ? in_sizes[0] : -1, out_size, ws_size, (size_t)WS_END); grid = -1; return; }
        if (hipFuncSetAttribute((const void*)fwd, hipFuncAttributeMaxDynamicSharedMemorySize, LDS_BYTES) != hipSuccess) { fprintf(stderr, "kernel_launch: hipFuncSetAttribute failed\n"); grid = -1; return; }
        int dev = 0, cus = 0;
        if (hipGetDevice(&dev) != hipSuccess || hipDeviceGetAttribute(&cus, hipDeviceAttributeMultiprocessorCount, dev) != hipSuccess) { grid = -1; return; }
        grid = cus;
    }
    if (grid < 0) return;
    (void)hipMemsetAsync((char*)d_ws + WS_CTL, 0, 1 * MiB, stream);
    Args a{};
    for (int i = 0; i < 23; ++i) a.in[i] = (const float*)d_in[i];
    a.out = (float*)d_out; a.ws = (unsigned char*)d_ws;
    if (ONE_LAUNCH) {
        a.ph_lo = 0; a.ph_hi = PH_COUNT;
        hipLaunchKernelGGL(fwd, dim3(grid), dim3(NTHREADS), LDS_BYTES, stream, a);
    } else {
        static const int seq[] = {PROBE_SEQ};
        for (unsigned i = 0; i < sizeof(seq) / sizeof(seq[0]); ++i) {
            a.ph_lo = seq[i] % 100; a.ph_hi = seq[i] % 100 + 1; a.flags = seq[i] / 100;
            hipLaunchKernelGGL(fwd, dim3(grid), dim3(NTHREADS), LDS_BYTES, stream, a);
        }
    }
}
```

```cpp
#include <hip/hip_runtime.h>
#include <cstdio>
#include <cstdint>

#define LAS __attribute__((address_space(3)))
typedef unsigned short bf16_t;
typedef float f32x4 __attribute__((ext_vector_type(4)));
typedef float f32x2 __attribute__((ext_vector_type(2)));
typedef unsigned u32x4 __attribute__((ext_vector_type(4)));
typedef unsigned u32x2 __attribute__((ext_vector_type(2)));
typedef int i32x4 __attribute__((ext_vector_type(4)));

constexpr int DM = 1024, NB = 8, SEQ = 4096, NTOK = NB * SEQ, CTXL = 256, NCTX = NB * CTXL, NROWS_H = NTOK + NCTX;
constexpr int INCOLS = 5632, OFF_Q = 2048, OFF_K = 3072, OFF_VB = 3328, OFF_GATE = 3584;
constexpr int NE = 16, CAP = 512, DE = 2048, NPAIR = NE * NB * CAP;
constexpr float EPS = 1e-6f, LOG2E = 1.4426950408889634f, C2 = 0.125f * LOG2E;
constexpr int NTHREADS = 512, NWAVES = 8;

constexpr size_t MiB = 1u << 20;
constexpr size_t WS_CTL = 0;
constexpr size_t WS_MOD = 1 * MiB;
constexpr size_t WS_ROPE = 1 * MiB + 512 * 1024;
constexpr size_t WS_AFFT = 2 * MiB;
constexpr size_t WS_TOPI = 4 * MiB;
constexpr size_t WS_TOPW = 4 * MiB + 512 * 1024;
constexpr size_t WS_SLOT = 5 * MiB;
constexpr size_t WS_WSP = 7 * MiB;
constexpr size_t WS_WIN = 8 * MiB;
constexpr size_t WS_WAB = 19 * MiB;
constexpr size_t WS_WO = 23 * MiB;
constexpr size_t WS_R = 25 * MiB;
constexpr size_t WS_H = WS_R;
constexpr size_t WS_VA = WS_R + 68 * MiB;
constexpr size_t WS_KB = WS_VA + 64 * MiB;
constexpr size_t WS_VB = WS_KB + 17 * MiB;
constexpr size_t WS_G = WS_VB + 17 * MiB;
constexpr size_t WS_Y = WS_G + 128 * MiB;
constexpr size_t WS_TMP = WS_Y + 128 * MiB;
constexpr size_t WS_STATS = WS_TMP + 64 * MiB;
constexpr size_t WS_MERGED = WS_H;
constexpr size_t WS_WGU = WS_R;
constexpr size_t WS_WD = WS_R + 128 * MiB;
constexpr size_t WS_H2 = WS_R + 192 * MiB;
constexpr size_t WS_ACT = WS_R + 256 * MiB;
constexpr size_t WS_YB = WS_WGU;
constexpr size_t WS_END = 537 * MiB;
static_assert(WS_STATS + 4 * MiB <= WS_END && WS_ACT + 256 * MiB == WS_END, "ws map");

constexpr int LDS_BYTES = 147456;

__device__ __forceinline__ float bf2f(unsigned b) { return __uint_as_float(b << 16); }
__device__ __forceinline__ unsigned f2bf(float f) { unsigned u = __float_as_uint(f); return (u + 0x7fffu + ((u >> 16) & 1u)) >> 16; }
__device__ __forceinline__ unsigned pk2(float lo, float hi) { typedef float f2_ __attribute__((ext_vector_type(2))); typedef __bf16 b2_ __attribute__((ext_vector_type(2))); f2_ v = {lo, hi}; b2_ b = __builtin_convertvector(v, b2_); return __builtin_bit_cast(unsigned, b); }
__device__ __forceinline__ void st4bf(bf16_t* p, f32x4 v) { u32x2 w; w.x = pk2(v.x, v.y); w.y = pk2(v.z, v.w); *(u32x2*)p = w; }
__device__ __forceinline__ void st8bf(bf16_t* p, f32x4 a, f32x4 b) { u32x4 w; w.x = pk2(a.x, a.y); w.y = pk2(a.z, a.w); w.z = pk2(b.x, b.y); w.w = pk2(b.z, b.w); *(u32x4*)p = w; }
__device__ __forceinline__ void ld8bf(const bf16_t* p, f32x4& a, f32x4& b) { const u32x4 w = *(const u32x4*)p; a.x = bf2f(w.x & 0xffffu); a.y = bf2f(w.x >> 16); a.z = bf2f(w.y & 0xffffu); a.w = bf2f(w.y >> 16); b.x = bf2f(w.z & 0xffffu); b.y = bf2f(w.z >> 16); b.z = bf2f(w.w & 0xffffu); b.w = bf2f(w.w >> 16); }
__device__ __forceinline__ f32x4 ld4bf(const bf16_t* p) { const u32x2 w = *(const u32x2*)p; f32x4 v; v.x = bf2f(w.x & 0xffffu); v.y = bf2f(w.x >> 16); v.z = bf2f(w.y & 0xffffu); v.w = bf2f(w.y >> 16); return v; }
__device__ __forceinline__ float sigmoidf_(float x) { return __builtin_amdgcn_rcpf(1.f + __builtin_amdgcn_exp2f(x * -1.4426950409f)); }
__device__ __forceinline__ float siluf_(float x) { return x * __builtin_amdgcn_rcpf(1.f + __builtin_amdgcn_exp2f(x * -1.4426950409f)); }
__device__ __forceinline__ float gelu_t(float x) { const float t = x * __builtin_fmaf(x * x, -0.10294324f, -2.3022082f); return x * __builtin_amdgcn_rcpf(1.f + __builtin_amdgcn_exp2f(t)); }
__device__ __forceinline__ f32x2 rcp2_(f32x2 d) { f32x2 r; r.x = __builtin_amdgcn_rcpf(d.x); r.y = __builtin_amdgcn_rcpf(d.y); return r; }
__device__ __forceinline__ f32x2 exp2_2_(f32x2 t) { f32x2 e; e.x = __builtin_amdgcn_exp2f(t.x); e.y = __builtin_amdgcn_exp2f(t.y); return e; }
__device__ __forceinline__ f32x2 gelu2_(f32x2 x) { const f32x2 t = x * ((x * x) * -0.10294324f + -2.3022082f); return x * rcp2_(exp2_2_(t) + 1.0f); }
__device__ __forceinline__ f32x2 sigm2_(f32x2 x) { return rcp2_(exp2_2_(x * -1.4426950409f) + 1.0f); }
__device__ __forceinline__ f32x4 gelu4_(f32x4 v) { const f32x2 a = gelu2_((f32x2){v.x, v.y}), b = gelu2_((f32x2){v.z, v.w}); return (f32x4){a.x, a.y, b.x, b.y}; }
__device__ __forceinline__ f32x4 sigm4_(f32x4 v) { const f32x2 a = sigm2_((f32x2){v.x, v.y}), b = sigm2_((f32x2){v.z, v.w}); return (f32x4){a.x, a.y, b.x, b.y}; }
template <int CTRL> __device__ __forceinline__ float dpp_f(float v) { const int i = __builtin_bit_cast(int, v); return __builtin_bit_cast(float, __builtin_amdgcn_update_dpp(i, i, CTRL, 0xf, 0xf, true)); }
__device__ __forceinline__ float xchg16(float v) { auto r = __builtin_amdgcn_permlane16_swap(__float_as_uint(v), __float_as_uint(v), false, false); return __uint_as_float((threadIdx.x & 16) ? r[0] : r[1]); }
__device__ __forceinline__ float xchg32(float v) { auto r = __builtin_amdgcn_permlane32_swap(__float_as_uint(v), __float_as_uint(v), false, false); return __uint_as_float((threadIdx.x & 32) ? r[0] : r[1]); }
__device__ __forceinline__ float wave_sum(float v) {
    v += dpp_f<0xB1>(v); v += dpp_f<0x4E>(v); v += dpp_f<0x141>(v); v += dpp_f<0x140>(v); v += xchg16(v); v += xchg32(v);
    return v;
}
__device__ __forceinline__ int wave_sum_i(int v) {
#pragma unroll
    for (int o = 1; o < 64; o <<= 1) v += __shfl_xor(v, o);
    return v;
}
#define LDS_WAIT() asm volatile("s_waitcnt lgkmcnt(0)" ::: "memory")

struct Args { const float* in[23]; float* out; unsigned char* ws; int ph_lo, ph_hi, flags, pad; };
enum { I_X = 0, I_C, I_CTX, I_CCTX, I_WADA, I_BADA, I_N1G, I_WIN, I_BMG, I_LNG, I_LNB, I_WSP, I_BSP, I_SINK, I_WPA, I_WPB, I_WOUT, I_N2G, I_WR, I_WEG, I_WEU, I_WED, I_FING };

struct Unit { int pm, pn; };
struct Gemm {
    const bf16_t* A; const bf16_t* Bt; int lda, ldb, K;
    size_t bgs; int tpg_shift;
    const int* gidx;
};
constexpr int NXCD = 8, WGM = 8;
struct StaticOrder {
    int nM, nN, nwg, G, c, extra, rev;
    __device__ void init(int M, int N, int G_, int c_, int extra_ = 0, int rev_ = 0) { nM = M / 256; nN = N / 256; nwg = nM * nN; G = G_; c = c_; extra = extra_; rev = rev_; }
    __device__ bool next(int i, Unit& u) const {
        const long L = (long)i * G + c;
        if (L >= nwg) { const int x = (int)(L - nwg); if (x >= extra) return false; u.pm = NTOK / 256 + (x >> 1); u.pn = 12 + (x & 1); return true; }
        int wgid = (int)L; { const int q = nwg / NXCD, r = nwg % NXCD, xcd = wgid % NXCD, off = wgid / NXCD; wgid = (xcd < r ? xcd * (q + 1) : r * (q + 1) + (xcd - r) * q) + off; }
        const int nig = WGM * nN, gid = wgid / nig, fm = gid * WGM, gsz = (nM - fm) < WGM ? (nM - fm) : WGM;
        u.pm = fm + ((wgid % nig) % gsz); u.pn = (wgid % nig) / gsz; if (rev) u.pm = nM - 1 - u.pm; return true;
    }
};

struct OneUnit { int pm, pn; __device__ bool next(int i, Unit& u) const { if (i) return false; u.pm = pm; u.pn = pn; return true; } };

typedef f32x4 Acc[2][2][4][2];

namespace pg8 {
typedef short bf16x8 __attribute__((ext_vector_type(8)));
constexpr int BK = 64, HALF = 128, HTB = HALF * BK * 2, STAGE_BYTES = 8 * HTB;
__device__ __forceinline__ int lds_byte(int r, int c) { const int st = (r >> 4) * 2 + (c >> 5), rr = r & 15, cc = c & 31, ob = rr * 64 + cc * 2; return st * 1024 + (ob ^ (((ob >> 9) & 1) << 5)); }
__device__ __forceinline__ void stage_rc(int b, int& R, int& C) { const int st = b / 1024, sb = b % 1024, swz = sb ^ (((sb >> 9) & 1) << 5); R = (st >> 1) * 16 + swz / 64; C = (st & 1) * 32 + (swz % 64) / 2; }

template <class Epi, class Sched, bool GATHER, bool HOOK = false, bool RELAX = false>
__device__ __forceinline__ void gemm_phase(LAS unsigned char* lds, const Gemm g, const Sched& S, const Epi& E) {
    const int tid = threadIdx.x, wid = __builtin_amdgcn_readfirstlane(tid >> 6), lane = tid & 63, wr = wid >> 2, wc = wid & 3, fr = lane & 15, fq = lane >> 4;
    const int nt = g.K / BK;
    int Rs[2], Cs[2]; unsigned voffBp[2][2], voffB[2], voffBn[2], vA[2][2], vN[2][2];
#pragma unroll
    for (int i = 0; i < 2; ++i) { stage_rc(tid * 16 + i * 8192, Rs[i], Cs[i]); voffBp[0][i] = (unsigned)(Rs[i] * g.ldb + Cs[i]) * 2u;
        const int rho = Rs[i] & 31, Rb = (Rs[i] & ~31) + 8 * ((rho & 15) >> 2) + 4 * (rho >> 4) + (rho & 3); voffBp[1][i] = (unsigned)(Rb * g.ldb + Cs[i]) * 2u; }
    const size_t kstep = (size_t)(BK * 2);
    const size_t hstepB = (size_t)HALF * g.ldb * 2;
    const unsigned ldsw = (unsigned)wid * 1024u;
    const int aoff = lds_byte(wr * 64 + fr, fq * 8), boff = lds_byte(wc * 32 + fr, fq * 8);
#define PG8_SA(b, h) (((b) * 2 + (h)) * HTB)
#define PG8_SB(b, h) ((4 + (b) * 2 + (h)) * HTB)
#define PG8_STAGE(bufoff, gbase, voff) do { _Pragma("unroll") for (int _i = 0; _i < 2; ++_i) \
        __builtin_amdgcn_global_load_lds((const unsigned*)((const char*)(gbase) + (voff)[_i]), (LAS unsigned*)(lds + (bufoff) + ldsw + _i * 8192), 16, 0, 0); } while (0)
#define PG8_LDA(dst, b, h) do { _Pragma("unroll") for (int m = 0; m < 4; ++m) _Pragma("unroll") for (int k = 0; k < 2; ++k) dst[m][k] = *(const LAS bf16x8*)(lds + PG8_SA(b, h) + aoff + m * 2048 + k * 1024); } while (0)
#define PG8_LDB(dst, b, h) do { _Pragma("unroll") for (int n = 0; n < 2; ++n) _Pragma("unroll") for (int k = 0; k < 2; ++k) dst[n][k] = *(const LAS bf16x8*)(lds + PG8_SB(b, h) + boff + n * 2048 + k * 1024); } while (0)
#define PG8_MMA(ai, bj, At, Bt) do { __builtin_amdgcn_s_setprio(1); _Pragma("unroll") for (int m = 0; m < 4; ++m) _Pragma("unroll") for (int n = 0; n < 2; ++n) _Pragma("unroll") for (int k = 0; k < 2; ++k) \
        acc[ai][bj][m][n] = __builtin_amdgcn_mfma_f32_16x16x32_bf16(Bt[n][k], At[m][k], acc[ai][bj][m][n], 0, 0, 0); __builtin_amdgcn_s_setprio(0); } while (0)
#define PG8_WAIT_V(n) asm volatile("s_waitcnt vmcnt(" #n ")" ::: "memory")
#define PG8_WAIT_L(n) asm volatile("s_waitcnt lgkmcnt(" #n ")" ::: "memory")
#define PG8_BAR __builtin_amdgcn_s_barrier()
#define PG8_SCHED __builtin_amdgcn_sched_barrier(0)
#define PG8_AVOFF(dst, U) do { _Pragma("unroll") for (int _h = 0; _h < 2; ++_h) _Pragma("unroll") for (int _i = 0; _i < 2; ++_i) \
        dst[_h][_i] = GATHER ? (unsigned)((((U).pm >> 1) & 7) * SEQ + g.gidx[(U).pm * 256 + _h * 128 + Rs[_i]]) * (unsigned)(g.lda * 2) + (unsigned)(Cs[_i] * 2) \
                             : (unsigned)((_h * 128 + Rs[_i]) * g.lda + Cs[_i]) * 2u; } while (0)
#define PG8_ABASE(U) ((const char*)g.A + (GATHER ? (size_t)0 : (size_t)(U).pm * 256 * g.lda * 2))
#define PG8_BBASE(U) ((const char*)g.Bt + ((size_t)((U).pm >> g.tpg_shift) * g.bgs + (size_t)(U).pn * 256 * g.ldb) * 2)
    Unit cur, nxt; int ui = 0;
    if (!S.next(0, cur)) return;
    Acc acc;
#pragma unroll
    for (int a = 0; a < 2; ++a)
#pragma unroll
        for (int b = 0; b < 2; ++b)
#pragma unroll
            for (int m = 0; m < 4; ++m)
#pragma unroll
                for (int n = 0; n < 2; ++n) acc[a][b][m][n] = (f32x4){0.f, 0.f, 0.f, 0.f};
    bf16x8 At[4][2], B0[2][2], B1[2][2];
    PG8_AVOFF(vA, cur);
    { const bool pc = E.perm(cur); voffB[0] = pc ? voffBp[1][0] : voffBp[0][0]; voffB[1] = pc ? voffBp[1][1] : voffBp[0][1]; }
    const char* cA = PG8_ABASE(cur); const char* cB = PG8_BBASE(cur);
    PG8_STAGE(PG8_SB(0, 0), cB, voffB); PG8_STAGE(PG8_SB(0, 1), cB + hstepB, voffB); PG8_STAGE(PG8_SA(0, 0), cA, vA[0]); PG8_STAGE(PG8_SA(0, 1), cA, vA[1]);
    if (wr == 1) PG8_BAR;
    PG8_WAIT_V(2); PG8_BAR;
    PG8_STAGE(PG8_SB(1, 0), cB + kstep, voffB); PG8_STAGE(PG8_SA(1, 0), cA + kstep, vA[0]); PG8_STAGE(PG8_SB(1, 1), cB + hstepB + kstep, voffB);
    if constexpr (RELAX) { PG8_WAIT_V(0); } else { PG8_WAIT_V(6); } PG8_BAR;
    for (;;) {
        const bool has_next = S.next(ui + 1, nxt);
        const char* nA = has_next ? PG8_ABASE(nxt) : cA; const char* nB = has_next ? PG8_BBASE(nxt) : cB;
        { const bool pn_ = has_next ? E.perm(nxt) : E.perm(cur); voffBn[0] = pn_ ? voffBp[1][0] : voffBp[0][0]; voffBn[1] = pn_ ? voffBp[1][1] : voffBp[0][1]; }
        if (GATHER) {
#pragma unroll
            for (int h = 0; h < 2; ++h)
#pragma unroll
                for (int i = 0; i < 2; ++i) vN[h][i] = vA[h][i];
            if (has_next && wid == 0)
                __builtin_amdgcn_global_load_lds((const unsigned*)(g.gidx + nxt.pm * 256 + lane * 4), (LAS unsigned*)(lds + STAGE_BYTES + (ui & 1) * 1024), 16, 0, 0);
        }
        if constexpr (RELAX) {
#define PG8_WAIT_RELAX asm volatile("s_waitcnt vmcnt(%0)" :: "n"(8 + Epi::kStores) : "memory")
            const char* a1 = cA + kstep; const char* a2 = cA + 2 * kstep; const char* b2 = cB + 2 * kstep; const char* a3 = a2 + kstep; const char* b3 = b2 + kstep;
            PG8_LDB(B0, 0, 0); PG8_LDB(B1, 0, 1); PG8_SCHED; PG8_LDA(At, 0, 0); PG8_STAGE(PG8_SA(1, 1), a1, vA[1]);
            PG8_WAIT_RELAX; PG8_WAIT_L(0); PG8_BAR; PG8_MMA(0, 0, At, B0); PG8_MMA(0, 1, At, B1); PG8_BAR; PG8_SCHED;
            PG8_LDA(At, 0, 1); PG8_STAGE(PG8_SB(0, 0), b2, voffB); PG8_STAGE(PG8_SB(0, 1), b2 + hstepB, voffB); PG8_STAGE(PG8_SA(0, 0), a2, vA[0]);
            PG8_WAIT_RELAX; PG8_WAIT_L(0); PG8_BAR; PG8_MMA(1, 0, At, B0); PG8_MMA(1, 1, At, B1); PG8_BAR; PG8_SCHED;
            PG8_LDB(B0, 1, 0); PG8_LDB(B1, 1, 1); PG8_SCHED; PG8_LDA(At, 1, 0); PG8_STAGE(PG8_SA(0, 1), a2, vA[1]);
            PG8_WAIT_V(8); PG8_WAIT_L(0); PG8_BAR; PG8_MMA(0, 0, At, B0); PG8_MMA(0, 1, At, B1); PG8_BAR; PG8_SCHED;
            PG8_LDA(At, 1, 1); PG8_STAGE(PG8_SB(1, 0), b3, voffB); PG8_STAGE(PG8_SB(1, 1), b3 + hstepB, voffB); PG8_STAGE(PG8_SA(1, 0), a3, vA[0]);
            PG8_WAIT_V(8); PG8_WAIT_L(0); PG8_BAR; PG8_MMA(1, 0, At, B0); PG8_MMA(1, 1, At, B1); PG8_BAR; PG8_SCHED;
#undef PG8_WAIT_RELAX
        }
        for (int t = RELAX ? 2 : 0; t < nt; t += 2) {
            const bool last = (t == nt - 2);
            if (GATHER) { if (t == 4 && has_next) {
                const LAS int* li = (const LAS int*)(lds + STAGE_BYTES + (ui & 1) * 1024);
#pragma unroll
                for (int h = 0; h < 2; ++h)
#pragma unroll
                    for (int i = 0; i < 2; ++i) vN[h][i] = (unsigned)(((nxt.pm >> 1) & 7) * SEQ + li[h * 128 + Rs[i]]) * (unsigned)(g.lda * 2) + (unsigned)(Cs[i] * 2);
            } }
            if constexpr (HOOK) { if (t == (nt >> 1)) E.mid(acc, cur, wr, wc, fr, fq); }
            const char* a1 = cA + (size_t)(t + 1) * kstep;
            const char* a2 = last ? nA : cA + (size_t)(t + 2) * kstep; const char* b2 = last ? nB : cB + (size_t)(t + 2) * kstep;
            const char* a3 = a2 + kstep; const char* b3 = b2 + kstep;
            unsigned v2[2][2];
#pragma unroll
            for (int h = 0; h < 2; ++h)
#pragma unroll
                for (int i = 0; i < 2; ++i) v2[h][i] = (GATHER && last) ? vN[h][i] : vA[h][i];
            unsigned vb2[2]; vb2[0] = last ? voffBn[0] : voffB[0]; vb2[1] = last ? voffBn[1] : voffB[1];
            PG8_LDB(B0, 0, 0); PG8_LDB(B1, 0, 1); PG8_SCHED; PG8_LDA(At, 0, 0); PG8_STAGE(PG8_SA(1, 1), a1, vA[1]);
            PG8_WAIT_V(8); PG8_WAIT_L(0); PG8_BAR; PG8_MMA(0, 0, At, B0); PG8_MMA(0, 1, At, B1); PG8_BAR; PG8_SCHED;
            PG8_LDA(At, 0, 1); PG8_STAGE(PG8_SB(0, 0), b2, vb2); PG8_STAGE(PG8_SB(0, 1), b2 + hstepB, vb2); PG8_STAGE(PG8_SA(0, 0), a2, v2[0]);
            PG8_WAIT_V(8); PG8_WAIT_L(0); PG8_BAR; PG8_MMA(1, 0, At, B0); PG8_MMA(1, 1, At, B1); PG8_BAR; PG8_SCHED;
            PG8_LDB(B0, 1, 0); PG8_LDB(B1, 1, 1); PG8_SCHED; PG8_LDA(At, 1, 0); PG8_STAGE(PG8_SA(0, 1), a2, v2[1]);
            PG8_WAIT_V(8); PG8_WAIT_L(0); PG8_BAR; PG8_MMA(0, 0, At, B0); PG8_MMA(0, 1, At, B1); PG8_BAR; PG8_SCHED;
            PG8_LDA(At, 1, 1); PG8_STAGE(PG8_SB(1, 0), b3, vb2); PG8_STAGE(PG8_SB(1, 1), b3 + hstepB, vb2); PG8_STAGE(PG8_SA(1, 0), a3, v2[0]);
            PG8_WAIT_V(8); PG8_WAIT_L(0); PG8_BAR; PG8_MMA(1, 0, At, B0); PG8_MMA(1, 1, At, B1); PG8_BAR; PG8_SCHED;
        }
        if (wr == 0) PG8_BAR;
        E(acc, cur, wr, wc, fr, fq);
        if (!has_next) break;
#pragma unroll
        for (int a = 0; a < 2; ++a)
#pragma unroll
            for (int b = 0; b < 2; ++b)
#pragma unroll
                for (int m = 0; m < 4; ++m)
#pragma unroll
                    for (int n = 0; n < 2; ++n) acc[a][b][m][n] = (f32x4){0.f, 0.f, 0.f, 0.f};
        cur = nxt; cA = nA; cB = nB; ++ui; voffB[0] = voffBn[0]; voffB[1] = voffBn[1];
        if (GATHER) {
#pragma unroll
            for (int h = 0; h < 2; ++h)
#pragma unroll
                for (int i = 0; i < 2; ++i) vA[h][i] = vN[h][i];
        }
        if (wr == 1) PG8_BAR;
    }
    PG8_WAIT_V(0);
    PG8_BAR;
#undef PG8_SA
#undef PG8_SB
#undef PG8_STAGE
#undef PG8_LDA
#undef PG8_LDB
#undef PG8_MMA
#undef PG8_WAIT_V
#undef PG8_WAIT_L
#undef PG8_BAR
#undef PG8_SCHED
#undef PG8_AVOFF
#undef PG8_ABASE
#undef PG8_BBASE
}
}

#define GEMM_PHASE pg8::gemm_phase

struct EpiIn {
    bf16_t *Y, *VA, *KB, *VB, *G; const float* bgate; const f32x2* rope; f32x2* STATS;
    static constexpr int kStores = 16;
    __device__ __forceinline__ bool perm(const Unit& u) const { return u.pn < 8 || u.pn > 12; }
    template <int KIND> __device__ __forceinline__ void run(const Acc& acc, const Unit& u, int wr, int wc, int fr, int fq) const {
        const int pn = u.pn;
#pragma unroll
        for (int ai = 0; ai < 2; ++ai)
#pragma unroll
            for (int m = 0; m < 4; ++m) {
                const int row = u.pm * 256 + ai * 128 + wr * 64 + m * 16 + fr;
                float ssum = 0.f, ssq = 0.f;
#pragma unroll
                for (int bj = 0; bj < 2; ++bj) {
                    f32x4 v0 = acc[ai][bj][m][0], v1 = acc[ai][bj][m][1];
                    if constexpr (KIND == 0 || KIND == 1) {
                        const int c8 = bj * 128 + wc * 32 + 8 * fq;
                        v0 = gelu4_(v0); v1 = gelu4_(v1);
                        if constexpr (KIND == 0) st8bf(Y + (size_t)row * 2048 + pn * 256 + c8, v0, v1);
                        else {
                            st8bf(VA + (size_t)row * 1024 + (pn - 4) * 256 + c8, v0, v1);
                            ssum += ((v0.x + v0.y) + (v0.z + v0.w)) + ((v1.x + v1.y) + (v1.z + v1.w));
                            ssq += ((v0.x * v0.x + v0.y * v0.y) + (v0.z * v0.z + v0.w * v0.w)) + ((v1.x * v1.x + v1.y * v1.y) + (v1.z * v1.z + v1.w * v1.w));
                        }
                    } else if constexpr (KIND == 2) {
                        const int cl = bj * 128 + wc * 32 + 4 * fq;
                        f32x4 o0 = v0, o1 = v1;
                        if (row < NTOK) {
                            const int t = row & (SEQ - 1), pos = (wc & 1) ? (t & 63) : (t >> 6);
                            const f32x2* rp = rope + pos * 16 + 4 * fq;
#pragma unroll
                            for (int j = 0; j < 4; ++j) { const f32x2 cs = rp[j]; o0[j] = v0[j] * cs.x - v1[j] * cs.y; o1[j] = v0[j] * cs.y + v1[j] * cs.x; }
                        }
                        if (pn < 12) { bf16_t* p = Y + (size_t)row * 2048 + 1024 + (pn - 8) * 256 + cl; st4bf(p, o0 * C2); st4bf(p + 16, o1 * C2); }
                        else { bf16_t* p = KB + (size_t)row * 256 + cl; st4bf(p, o0); st4bf(p + 16, o1); }
                    } else if constexpr (KIND == 3) {
                        st8bf(VB + (size_t)row * 256 + bj * 128 + wc * 32 + 8 * fq, v0, v1);
                    } else {
                        if (bj == 0) {
                            const int ch = (pn - 14) * 128 + wc * 32 + 8 * fq;
                            const f32x4 a0 = sigm4_(v0 + *(const f32x4*)(bgate + ch)), a1 = sigm4_(v1 + *(const f32x4*)(bgate + ch + 4));
                            const f32x4 g0 = sigm4_(acc[ai][1][m][0] + *(const f32x4*)(bgate + 1024 + ch)), g1 = sigm4_(acc[ai][1][m][1] + *(const f32x4*)(bgate + 1024 + ch + 4));
                            f32x4 r0, r1;
#pragma unroll
                            for (int j = 0; j < 4; ++j) { r0[j] = a0[j] * __builtin_amdgcn_rcpf(g0[j]); r1[j] = a1[j] * __builtin_amdgcn_rcpf(g1[j]); }
                            st8bf(G + (size_t)row * 2048 + ch, r0, r1); st8bf(G + (size_t)row * 2048 + 1024 + ch, g0, g1);
                        }
                    }
                }
                if constexpr (KIND == 1) {
                    ssum += xchg16(ssum); ssum += xchg32(ssum); ssq += xchg16(ssq); ssq += xchg32(ssq);
                    if (fq == 0) STATS[(size_t)row * 16 + (pn - 4) * 4 + wc] = (f32x2){ssum, ssq};
                }
            }
    }
    __device__ __forceinline__ void operator()(const Acc& acc, const Unit& u, int wr, int wc, int fr, int fq) const {
        const int pn = u.pn;
        if (pn < 4) run<0>(acc, u, wr, wc, fr, fq);
        else if (pn < 8) run<1>(acc, u, wr, wc, fr, fq);
        else if (pn < 13) run<2>(acc, u, wr, wc, fr, fq);
        else if (pn == 13) run<3>(acc, u, wr, wc, fr, fq);
        else run<4>(acc, u, wr, wc, fr, fq);
    }
};
struct EpiAB {
    bf16_t* MERGED; const bf16_t* G;
    static constexpr int kStores = 16;
    __device__ __forceinline__ bool perm(const Unit&) const { return true; }
    __device__ __forceinline__ void mid(Acc& acc, const Unit& u, int wr, int wc, int fr, int fq) const {
        int zero; asm volatile("v_mov_b32 %0, 0" : "=v"(zero));
        const bf16_t* gp = G + (size_t)(u.pm * 256 + wr * 64 + fr + zero) * 2048 + u.pn * 256 + wc * 32 + 8 * fq;
#pragma unroll
        for (int ai = 0; ai < 2; ++ai)
#pragma unroll
            for (int m = 0; m < 4; ++m) {
#pragma unroll
                for (int bj = 0; bj < 2; ++bj) {
                    const bf16_t* q = gp + (size_t)(ai * 128 + m * 16) * 2048 + bj * 128;
                    f32x4 r0, r1; ld8bf(q, r0, r1);
                    acc[ai][bj][m][0] *= r0; acc[ai][bj][m][1] *= r1;
                    asm volatile("" ::: "memory");
                }
            }
    }
    __device__ __forceinline__ void operator()(const Acc& acc, const Unit& u, int wr, int wc, int fr, int fq) const {
#pragma unroll
        for (int ai = 0; ai < 2; ++ai)
#pragma unroll
            for (int m = 0; m < 4; ++m) {
                const int row = u.pm * 256 + ai * 128 + wr * 64 + m * 16 + fr;
#pragma unroll
                for (int bj = 0; bj < 2; ++bj) {
                    const int c8 = u.pn * 256 + bj * 128 + wc * 32 + 8 * fq;
                    f32x4 gb0, gb1; ld8bf(G + (size_t)row * 2048 + 1024 + c8, gb0, gb1);
                    st8bf(MERGED + (size_t)row * 1024 + c8, gb0 * acc[ai][bj][m][0], gb1 * acc[ai][bj][m][1]);
                }
            }
    }
};
struct EpiO {
    bf16_t* D16; const float* mod;
    static constexpr int kStores = 16;
    __device__ __forceinline__ bool perm(const Unit&) const { return true; }
    __device__ __forceinline__ void operator()(const Acc& acc, const Unit& u, int wr, int wc, int fr, int fq) const {
        const float* g1 = mod + (size_t)((u.pm * 256) >> 12) * 6144 + 2048;
#pragma unroll
        for (int bj = 0; bj < 2; ++bj) {
            const int c8 = u.pn * 256 + bj * 128 + wc * 32 + 8 * fq;
            const f32x4 ga = *(const f32x4*)(g1 + c8), gb = *(const f32x4*)(g1 + c8 + 4);
#pragma unroll
            for (int ai = 0; ai < 2; ++ai)
#pragma unroll
                for (int m = 0; m < 4; ++m) {
                    const int row = u.pm * 256 + ai * 128 + wr * 64 + m * 16 + fr;
                    st8bf(D16 + (size_t)row * 2048 + 1024 + c8, ga * acc[ai][bj][m][0], gb * acc[ai][bj][m][1]);
                }
        }
    }
};
struct EpiGU {
    bf16_t* ACT;
    static constexpr int kStores = 8;
    __device__ __forceinline__ bool perm(const Unit&) const { return true; }
    __device__ __forceinline__ void operator()(const Acc& acc, const Unit& u, int wr, int wc, int fr, int fq) const {
#pragma unroll
        for (int ai = 0; ai < 2; ++ai)
#pragma unroll
            for (int m = 0; m < 4; ++m) {
                const int prow = u.pm * 256 + ai * 128 + wr * 64 + m * 16 + fr;
                f32x4 a[2];
#pragma unroll
                for (int n = 0; n < 2; ++n) {
                    const f32x4 gt = acc[ai][0][m][n], up = acc[ai][1][m][n];
                    a[n] = gt * sigm4_(gt) * up;
                }
                st8bf(ACT + (size_t)prow * 2048 + u.pn * 128 + wc * 32 + 8 * fq, a[0], a[1]);
            }
    }
};
struct EpiD {
    bf16_t* YB; const float* TOPW;
    static constexpr int kStores = 16;
    __device__ __forceinline__ bool perm(const Unit&) const { return true; }
    __device__ __forceinline__ void operator()(const Acc& acc, const Unit& u, int wr, int wc, int fr, int fq) const {
#pragma unroll
        for (int ai = 0; ai < 2; ++ai)
#pragma unroll
            for (int m = 0; m < 4; ++m) {
                const int prow = u.pm * 256 + ai * 128 + wr * 64 + m * 16 + fr; const float w = TOPW[prow];
#pragma unroll
                for (int bj = 0; bj < 2; ++bj)
                    st8bf(YB + (size_t)prow * 1024 + u.pn * 256 + bj * 128 + wc * 32 + 8 * fq, acc[ai][bj][m][0] * w, acc[ai][bj][m][1] * w);
            }
    }
};

__device__ __forceinline__ void transpose_item(const float* W, int N, int k0, int n0, bf16_t* dst, int ldt, LAS float* scr, int lane) {
    const int kk = lane >> 3, nq = (lane & 7) * 4;
    f32x4 v[8];
#pragma unroll
    for (int i = 0; i < 8; ++i) v[i] = *(const f32x4*)(W + (size_t)(k0 + 8 * i + kk) * N + n0 + nq);
#pragma unroll
    for (int i = 0; i < 8; ++i) { LAS float* s = scr + (8 * i + kk) * 33 + nq; s[0] = v[i].x; s[1] = v[i].y; s[2] = v[i].z; s[3] = v[i].w; }
    LDS_WAIT();
    const int c = lane & 7;
#pragma unroll
    for (int j = 0; j < 4; ++j) {
        const int n = (lane >> 3) + 8 * j; const LAS float* s = scr + (8 * c) * 33 + n;
        u32x4 o; o.x = pk2(s[0 * 33], s[1 * 33]); o.y = pk2(s[2 * 33], s[3 * 33]); o.z = pk2(s[4 * 33], s[5 * 33]); o.w = pk2(s[6 * 33], s[7 * 33]);
        *(u32x4*)(dst + (size_t)n * ldt + 8 * c) = o;
    }
    LDS_WAIT();
}

struct TrItem { const float* src; bf16_t* dst; int N, ldt; };
__device__ __forceinline__ void tr_load(const TrItem& it, f32x4 (&v)[8], int lane) {
    const int kk = lane >> 3, nq = (lane & 7) * 4;
#pragma unroll
    for (int i = 0; i < 8; ++i) v[i] = *(const f32x4*)(it.src + (size_t)(8 * i + kk) * it.N + nq);
}
__device__ __forceinline__ void tr_store(const TrItem& it, const f32x4 (&v)[8], LAS float* scr, int lane) {
    const int kk = lane >> 3, nq = (lane & 7) * 4;
#pragma unroll
    for (int i = 0; i < 8; ++i) { LAS float* s = scr + (8 * i + kk) * 33 + nq; s[0] = v[i].x; s[1] = v[i].y; s[2] = v[i].z; s[3] = v[i].w; }
    LDS_WAIT();
    const int c = lane & 7;
#pragma unroll
    for (int j = 0; j < 4; ++j) {
        const int n = (lane >> 3) + 8 * j; const LAS float* s = scr + (8 * c) * 33 + n;
        u32x4 o; o.x = pk2(s[0 * 33], s[1 * 33]); o.y = pk2(s[2 * 33], s[3 * 33]); o.z = pk2(s[4 * 33], s[5 * 33]); o.w = pk2(s[6 * 33], s[7 * 33]);
        *(u32x4*)(it.dst + (size_t)n * it.ldt + 8 * c) = o;
    }
    LDS_WAIT();
}

__device__ __forceinline__ void adaln_task(int task, const float* c, const float* cctx, const float* w_ada, const float* b_ada, float* mod, LAS float* lds, int tid) {
    LAS float* s = lds; LAS float* red = lds + 9 * 1024;
    { float cv[18];
#pragma unroll
      for (int q = 0; q < 18; ++q) { const int i = tid + NTHREADS * q, r = i >> 10, k = i & 1023; cv[q] = r < 8 ? c[r * 1024 + k] : cctx[k]; }
#pragma unroll
      for (int q = 0; q < 18; ++q) s[tid + NTHREADS * q] = cv[q] * __builtin_amdgcn_rcpf(1.f + __expf(-cv[q])); }
    __syncthreads();
    const int ch = tid & 7, kr = tid >> 3;
    f32x4 acc[9];
#pragma unroll
    for (int r = 0; r < 9; ++r) acc[r] = (f32x4){0.f, 0.f, 0.f, 0.f};
    const float* wp = w_ada + (size_t)kr * 6144 + task * 32 + ch * 4;
    for (int it = 0; it < 16; ++it) {
        const f32x4 w = *(const f32x4*)(wp + (size_t)it * 64 * 6144); const int k = kr + it * 64;
#pragma unroll
        for (int r = 0; r < 9; ++r) acc[r] += s[r * 1024 + k] * w;
    }
#pragma unroll
    for (int r = 0; r < 9; ++r) *(LAS f32x4*)(red + (kr * 9 + r) * 32 + ch * 4) = acc[r];
    __syncthreads();
    if (tid < 288) { const int r = tid >> 5, col = tid & 31; float sum = 0.f; for (int q = 0; q < 64; ++q) sum += red[(q * 9 + r) * 32 + col]; mod[r * 6144 + task * 32 + col] = sum + b_ada[task * 32 + col]; }
    __syncthreads();
}

__device__ __forceinline__ void rope_table(f32x2* tab, int tid) {
    for (int idx = tid; idx < 1024; idx += NTHREADS) {
        const int pos = idx >> 4, i = idx & 15;
        double f = 1.0;
        for (int q = 0; q < i; ++q) f *= 0.56234132519034908;
        const float ang = (float)pos * (float)f;
        const double a = (double)ang, k = __builtin_rint(a * 0.15915494309189535), r = a - k * 6.283185307179586476925, r2 = r * r;
        double sn = r, ts = r, cs = 1.0, tc = 1.0;
        for (int n = 1; n <= 14; ++n) {
            tc *= -r2 / (double)((2 * n - 1) * (2 * n)); cs += tc;
            ts *= -r2 / (double)((2 * n) * (2 * n + 1)); sn += ts;
        }
        tab[idx] = (f32x2){(float)cs, (float)sn};
    }
}

__device__ __forceinline__ unsigned char* lds_raw_ptr(LAS unsigned char* p) { return (unsigned char*)p; }
namespace mix {
typedef short bf16x8 __attribute__((ext_vector_type(8)));
typedef short s16x4 __attribute__((ext_vector_type(4)));
typedef float f32x16 __attribute__((ext_vector_type(16)));
typedef __attribute__((address_space(3))) const char* lds_cptr;
__device__ __forceinline__ int crow(int r, int hi) { return (r & 3) + 8 * (r >> 2) + 4 * hi; }
__device__ __forceinline__ unsigned cvtpk(float lo, float hi) { typedef float f2 __attribute__((ext_vector_type(2))); typedef __bf16 b2 __attribute__((ext_vector_type(2))); f2 v = {lo, hi}; b2 b = __builtin_convertvector(v, b2); return __builtin_bit_cast(unsigned, b); }
__device__ __forceinline__ s16x4 vtr(lds_cptr p) { return __builtin_bit_cast(s16x4, __builtin_amdgcn_ds_read_tr16_b64_v4i16((__attribute__((address_space(3))) s16x4*)p)); }
__device__ __forceinline__ bf16x8 pk8(s16x4 lo, s16x4 hi) { return (bf16x8){lo[0], lo[1], lo[2], lo[3], hi[0], hi[1], hi[2], hi[3]}; }
__device__ __forceinline__ float max3f(float a, float b, float c) { float r; asm("v_max3_f32 %0, %1, %2, %3" : "=v"(r) : "v"(a), "v"(b), "v"(c)); return r; }
__device__ __forceinline__ float max2f(float a, float b) { float r; asm("v_max_f32_e32 %0, %1, %2" : "=v"(r) : "v"(a), "v"(b)); return r; }
__device__ __forceinline__ float swap_half(float v) { auto rr = __builtin_amdgcn_permlane32_swap(__float_as_uint(v), __float_as_uint(v), false, false); return __uint_as_float((threadIdx.x & 32) ? rr[0] : rr[1]); }

constexpr int A_K = 0, A_V = 24576, A_WS = 49152, A_QST = 53248, A_OST = A_QST, A_OSTW = 8192, A_END = A_QST + 8 * 8192;

__device__ __forceinline__ void attn_unit(int b, int n, int kvh, bf16_t* Y, bf16_t* O, int ldo, const bf16_t* KB, const bf16_t* VB, const float* sink, LAS unsigned char* lds) {
    const int tid = threadIdx.x, lane = tid & 63, r32 = lane & 31, hi = lane >> 5, wid = __builtin_amdgcn_readfirstlane(tid >> 6);
    const int head = kvh * 4 + (wid >> 1);
    const int qrow0 = b * SEQ + n * 128 + (wid & 1) * 64;
    bf16_t* Qw = Y + (size_t)qrow0 * 2048 + 1024 + head * 64;
    LAS bf16x8* qst = (LAS bf16x8*)(lds + A_QST + wid * 8192) + lane;
#pragma unroll
    for (int sb = 0; sb < 2; ++sb)
#pragma unroll
        for (int d0 = 0; d0 < 4; ++d0) qst[(sb * 4 + d0) * 64] = *(const bf16x8*)(Qw + (size_t)(32 * sb + r32) * 2048 + d0 * 16 + hi * 8);
    f32x16 o[2][2];
#pragma unroll
    for (int sb = 0; sb < 2; ++sb)
#pragma unroll
        for (int d0 = 0; d0 < 2; ++d0)
#pragma unroll
            for (int r = 0; r < 16; ++r) o[sb][d0][r] = 0.f;
    float m[2] = {-1e30f, -1e30f}, l[2] = {0.f, 0.f};
    LAS float* wsf = (LAS float*)(lds + A_WS) + wid * 128;
    const int jlo = (n == 0) ? 2 : 0, jhi = (n == 31) ? 3 : 5, T = 4 + (jhi - jlo + 1);
    const size_t koff = (size_t)lane * 256 + wid * 8 + kvh * 64;
    const size_t voff = (size_t)(16 * (wid & 3) + (lane >> 2)) * 256 + (wid >> 2) * 32 + (lane & 3) * 8 + kvh * 64;
    auto tile_row = [&](int t) -> long { return t < 4 ? (long)(NTOK + b * CTXL + 64 * t) : (long)(b * SEQ + (n - 1) * 128 + 64 * (jlo + t - 4)); };
    auto issue = [&](int t) {
        const long row = tile_row(t); const int buf = t % 3;
        __builtin_amdgcn_global_load_lds((const unsigned*)(KB + row * 256 + koff), (LAS unsigned*)(lds + A_K + buf * 8192 + wid * 1024), 16, 0, 0);
        __builtin_amdgcn_global_load_lds((const unsigned*)(VB + row * 256 + voff), (LAS unsigned*)(lds + A_V + buf * 8192 + wid * 1024), 16, 0, 0);
    };
    issue(0); issue(1);
    int slot = 0;
    for (int t = 0; t < T; ++t) {
        if (t + 1 < T) asm volatile("s_waitcnt vmcnt(2) lgkmcnt(0)" ::: "memory"); else asm volatile("s_waitcnt vmcnt(0) lgkmcnt(0)" ::: "memory");
        __builtin_amdgcn_s_barrier();
        if (t + 2 < T) issue(t + 2);
        const lds_cptr Kt = (lds_cptr)(lds + A_K + slot * 8192) + hi * 1024 + r32 * 16;
        const lds_cptr Vt = (lds_cptr)(lds + A_V + slot * 8192) + ((lane >> 4) & 1) * 32 + (lane & 3) * 8 + (4 * hi + ((lane & 15) >> 2)) * 64;
        slot = (slot == 2) ? 0 : slot + 1;
        const bool local = t >= 4;
        const int dl = 64 * (jlo + t - 4) - 128 - 64 * (wid & 1);
        if (local && (dl > 160 || dl < -191)) continue;
        f32x16 p0[2], p1[2];
#pragma unroll
        for (int sb = 0; sb < 2; ++sb)
#pragma unroll
            for (int r = 0; r < 16; ++r) { p0[sb][r] = 0.f; p1[sb][r] = 0.f; }
#pragma unroll
        for (int d0 = 0; d0 < 4; ++d0) {
            const bf16x8 k0 = *(const __attribute__((address_space(3))) bf16x8*)(Kt + d0 * 2048), k1 = *(const __attribute__((address_space(3))) bf16x8*)(Kt + d0 * 2048 + 512);
#pragma unroll
            for (int sb = 0; sb < 2; ++sb) {
                const bf16x8 qf = qst[(sb * 4 + d0) * 64];
                p0[sb] = __builtin_amdgcn_mfma_f32_32x32x16_bf16(k0, qf, p0[sb], 0, 0, 0);
                p1[sb] = __builtin_amdgcn_mfma_f32_32x32x16_bf16(k1, qf, p1[sb], 0, 0, 0);
            }
        }
        if (local && (dl < -97 || dl > 65 || dl - 32 < -97)) {
#pragma unroll
            for (int sb = 0; sb < 2; ++sb)
#pragma unroll
                for (int r = 0; r < 16; ++r) { const int rel = dl - 32 * sb + crow(r, hi) - r32; if (rel < -128 || rel > 128) p0[sb][r] = -1e30f; if (rel + 32 < -128 || rel + 32 > 128) p1[sb][r] = -1e30f; }
        }
        float mn[2];
        asm volatile("s_nop 15\n\ts_nop 7" : "+v"(p0[0]), "+v"(p1[0]), "+v"(p0[1]), "+v"(p1[1]));
#pragma unroll
        for (int sb = 0; sb < 2; ++sb) {
            float a = max3f(p0[sb][0], p0[sb][1], p1[sb][0]), b2 = max3f(p0[sb][2], p0[sb][3], p1[sb][1]); a = max3f(a, p1[sb][2], p1[sb][3]);
#pragma unroll
            for (int r = 4; r < 16; r += 4) { a = max3f(a, p0[sb][r], p0[sb][r + 1]); b2 = max3f(b2, p0[sb][r + 2], p0[sb][r + 3]); a = max3f(a, p1[sb][r], p1[sb][r + 1]); b2 = max3f(b2, p1[sb][r + 2], p1[sb][r + 3]); }
            float rm = max2f(a, b2);
            rm = max2f(rm, swap_half(rm));
            mn[sb] = max2f(m[sb], rm);
        }
        if (__any((mn[0] > m[0]) || (mn[1] > m[1]))) {
            const float f0 = __builtin_amdgcn_exp2f(m[0] - mn[0]), f1 = __builtin_amdgcn_exp2f(m[1] - mn[1]);
            l[0] *= f0; l[1] *= f1;
            if (hi == 0) { wsf[r32] = f0; wsf[64 + r32] = f1; }
            asm volatile("s_waitcnt lgkmcnt(0)" ::: "memory");
#pragma unroll
            for (int r = 0; r < 16; ++r) { const float a = wsf[crow(r, hi)], b2 = wsf[64 + crow(r, hi)]; o[0][0][r] *= a; o[0][1][r] *= a; o[1][0][r] *= b2; o[1][1][r] *= b2; }
            m[0] = mn[0]; m[1] = mn[1];
        }
        u32x4 pw[2][4];
#pragma unroll
        for (int sb = 0; sb < 2; ++sb) {
            float sacc = 0.f;
#pragma unroll
            for (int r = 0; r < 16; ++r) { p0[sb][r] = __builtin_amdgcn_exp2f(p0[sb][r] - m[sb]); p1[sb][r] = __builtin_amdgcn_exp2f(p1[sb][r] - m[sb]); sacc += p0[sb][r] + p1[sb][r]; }
            l[sb] += sacc;
#pragma unroll
            for (int q = 0; q < 4; ++q) { pw[sb][0][q] = cvtpk(p0[sb][2 * q], p0[sb][2 * q + 1]); pw[sb][1][q] = cvtpk(p0[sb][8 + 2 * q], p0[sb][9 + 2 * q]); pw[sb][2][q] = cvtpk(p1[sb][2 * q], p1[sb][2 * q + 1]); pw[sb][3][q] = cvtpk(p1[sb][8 + 2 * q], p1[sb][9 + 2 * q]); }
        }
#pragma unroll
        for (int d0 = 0; d0 < 2; ++d0)
#pragma unroll
            for (int ks = 0; ks < 4; ++ks) {
                const s16x4 vlo = vtr(Vt + d0 * 4096 + ks * 1024), vhi = vtr(Vt + d0 * 4096 + ks * 1024 + 512);
                const bf16x8 vf = pk8(vlo, vhi);
#pragma unroll
                for (int sb = 0; sb < 2; ++sb) o[sb][d0] = __builtin_amdgcn_mfma_f32_32x32x16_bf16(__builtin_bit_cast(bf16x8, pw[sb][ks]), vf, o[sb][d0], 0, 0, 0);
            }
    }
    const float s2 = sink[head] * LOG2E;
    LAS bf16_t* stg = (LAS bf16_t*)(lds + A_OST + wid * A_OSTW);
#pragma unroll
    for (int sb = 0; sb < 2; ++sb) {
        const float lt = l[sb] + swap_half(l[sb]);
        const float mf = fmaxf(m[sb], s2), f = __builtin_amdgcn_exp2f(m[sb] - mf), den = lt * f + __builtin_amdgcn_exp2f(s2 - mf);
        asm volatile("s_waitcnt lgkmcnt(0)" ::: "memory");
        if (hi == 0) wsf[sb * 64 + r32] = f / den;
        asm volatile("s_waitcnt lgkmcnt(0)" ::: "memory");
#pragma unroll
        for (int r = 0; r < 16; ++r) { const float sc = wsf[sb * 64 + crow(r, hi)]; const int orow = crow(r, hi);
            stg[orow * 64 + r32] = (bf16_t)f2bf(o[sb][0][r] * sc); stg[orow * 64 + 32 + r32] = (bf16_t)f2bf(o[sb][1][r] * sc); }
        asm volatile("s_waitcnt lgkmcnt(0)" ::: "memory");
#pragma unroll
        for (int i = 0; i < 4; ++i) { const int row = i * 8 + (lane >> 3), ch = lane & 7; const u32x4 v = *(const LAS u32x4*)(stg + row * 64 + ch * 8); *(u32x4*)(O + (size_t)(qrow0 + 32 * sb + row) * ldo + head * 64 + ch * 8) = v; }
        asm volatile("s_waitcnt lgkmcnt(0)" ::: "memory");
    }
    __syncthreads();
}

constexpr int G_V = 0, G_ST = 65536, G_STW = 8704, G_MU = G_ST + 8 * G_STW;
__device__ __forceinline__ void gmlp_unit(int task, bf16_t* Y, bf16_t* YO, int ldo, const bf16_t* VA, const bf16_t* WSP, const f32x2* STATS, const float* ln_g, const float* ln_b, const float* b_sp, LAS unsigned char* lds) {
    const int tid = threadIdx.x, lane = tid & 63, r32 = lane & 31, hi = lane >> 5, wid = __builtin_amdgcn_readfirstlane(tid >> 6);
    const int r0 = task * 128;
    LAS float* mu = (LAS float*)(lds + G_MU); LAS float* rs = mu + 128;
    if (tid < 128) {
        const f32x4* sp = (const f32x4*)(STATS + (size_t)(r0 + tid) * 16); float s = 0.f, ss = 0.f;
#pragma unroll
        for (int i = 0; i < 8; ++i) { const f32x4 v = sp[i]; s += v.x + v.z; ss += v.y + v.w; }
        const float mean = s * (1.f / 1024.f), var = fmaxf(ss * (1.f / 1024.f) - mean * mean, 0.f);
        mu[tid] = mean; rs[tid] = 1.0f / sqrtf(var + EPS);
    }
    u32x4 raw[4];
#pragma unroll
    for (int i = 0; i < 4; ++i) { const int idx = tid + NTHREADS * i, q = idx >> 4, c8 = idx & 15; raw[i] = *(const u32x4*)(VA + (size_t)(r0 + q) * 1024 + c8 * 8); }
    const int dcol = (tid & 15) * 8;
    f32x4 lg0 = *(const f32x4*)(ln_g + dcol), lg1 = *(const f32x4*)(ln_g + dcol + 4), lb0 = *(const f32x4*)(ln_b + dcol), lb1 = *(const f32x4*)(ln_b + dcol + 4);
    __syncthreads();
    const int pb = wid >> 1, dh = wid & 1;
    LAS float* st = (LAS float*)(lds + G_ST + wid * G_STW);
    u32x4 ur[4], urn[4], opend[4]; bf16x8 af[8]; float bsr[4], bsn[4];
    const size_t ybase0 = (size_t)(r0 + 32 * pb + (lane >> 3)) * 2048 + 64 * dh + (lane & 7) * 8;
    const bf16_t* wrow0 = WSP + (size_t)(32 * pb + r32) * 128 + 8 * hi;
#pragma unroll
    for (int i = 0; i < 4; ++i) { ur[i] = *(const u32x4*)(Y + ybase0 + (size_t)(8 * i) * 2048); bsr[i] = b_sp[32 * pb + 8 * i + (lane >> 3)]; }
    for (int g8 = 0; g8 < 8; ++g8) {
        LAS unsigned char* vb = lds + G_V + (g8 & 1) * 32768;
#pragma unroll
        for (int i = 0; i < 4; ++i) {
            const int idx = tid + NTHREADS * i, q = idx >> 4, c8 = idx & 15, d = c8 * 8;
            const f32x4 g0 = lg0, g1 = lg1, b0 = lb0, b1 = lb1;
            const float mq = mu[q], rq = rs[q]; const u32x4 rw = raw[i];
            float v[8] = {bf2f(rw.x & 0xffffu), bf2f(rw.x >> 16), bf2f(rw.y & 0xffffu), bf2f(rw.y >> 16), bf2f(rw.z & 0xffffu), bf2f(rw.z >> 16), bf2f(rw.w & 0xffffu), bf2f(rw.w >> 16)};
#pragma unroll
            for (int e = 0; e < 4; ++e) { v[e] = (v[e] - mq) * rq * g0[e] + b0[e]; v[4 + e] = (v[4 + e] - mq) * rq * g1[e] + b1[e]; }
            u32x4 w; w.x = pk2(v[0], v[1]); w.y = pk2(v[2], v[3]); w.z = pk2(v[4], v[5]); w.w = pk2(v[6], v[7]);
            *(LAS u32x4*)(vb + ((d >> 5) * 8 + (q >> 4)) * 1024 + (q & 15) * 64 + (d & 31) * 2) = w;
        }
        if (g8 + 1 < 8) {
#pragma unroll
            for (int i = 0; i < 4; ++i) { const int idx = tid + NTHREADS * i, q = idx >> 4, c8 = idx & 15; raw[i] = *(const u32x4*)(VA + (size_t)(r0 + q) * 1024 + (g8 + 1) * 128 + c8 * 8); }
            const int dn = (g8 + 1) * 128 + dcol;
            lg0 = *(const f32x4*)(ln_g + dn); lg1 = *(const f32x4*)(ln_g + dn + 4); lb0 = *(const f32x4*)(ln_b + dn); lb1 = *(const f32x4*)(ln_b + dn + 4);
        }
        if (g8 + 1 < 8) {
#pragma unroll
            for (int i = 0; i < 4; ++i) { urn[i] = *(const u32x4*)(Y + ybase0 + (g8 + 1) * 128 + (size_t)(8 * i) * 2048); bsn[i] = b_sp[(g8 + 1) * 128 + 32 * pb + 8 * i + (lane >> 3)]; }
        }
#pragma unroll
        for (int ks = 0; ks < 8; ++ks) af[ks] = *(const bf16x8*)(wrow0 + (size_t)g8 * 16384 + 16 * ks);
        if (g8 > 0) {
#pragma unroll
            for (int i = 0; i < 4; ++i) *(u32x4*)(YO + (size_t)(r0 + 32 * pb + 8 * i + (lane >> 3)) * ldo + (g8 - 1) * 128 + 64 * dh + (lane & 7) * 8) = opend[i];
        }
        __syncthreads();
        const lds_cptr Vb = (lds_cptr)vb + ((lane >> 4) & 1) * 32 + (lane & 3) * 8 + (8 * hi + ((lane & 15) >> 2)) * 64;
        f32x16 acc[2];
#pragma unroll
        for (int t2 = 0; t2 < 2; ++t2)
#pragma unroll
            for (int r = 0; r < 16; ++r) acc[t2][r] = 0.f;
#pragma unroll
        for (int ks = 0; ks < 8; ++ks) {
#pragma unroll
            for (int t2 = 0; t2 < 2; ++t2) {
                const int db = 2 * dh + t2;
                const s16x4 vlo = vtr(Vb + (db * 8 + ks) * 1024), vhi = vtr(Vb + (db * 8 + ks) * 1024 + 256);
                acc[t2] = __builtin_amdgcn_mfma_f32_32x32x16_bf16(af[ks], pk8(vlo, vhi), acc[t2], 0, 0, 0);
            }
        }
#pragma unroll
        for (int t2 = 0; t2 < 2; ++t2)
#pragma unroll
            for (int r = 0; r < 16; ++r) st[crow(r, hi) * 68 + 32 * t2 + r32] = acc[t2][r];
        asm volatile("s_waitcnt lgkmcnt(0)" ::: "memory");
#pragma unroll
        for (int i = 0; i < 4; ++i) {
            const int prow = 8 * i + (lane >> 3), ch = lane & 7;
            const f32x4 m0 = *(const LAS f32x4*)(st + prow * 68 + ch * 8), m1 = *(const LAS f32x4*)(st + prow * 68 + ch * 8 + 4);
            const float bs = bsr[i]; const u32x4 uw = ur[i];
            u32x4 o;
            o.x = pk2(bf2f(uw.x & 0xffffu) * (m0.x + bs), bf2f(uw.x >> 16) * (m0.y + bs)); o.y = pk2(bf2f(uw.y & 0xffffu) * (m0.z + bs), bf2f(uw.y >> 16) * (m0.w + bs));
            o.z = pk2(bf2f(uw.z & 0xffffu) * (m1.x + bs), bf2f(uw.z >> 16) * (m1.y + bs)); o.w = pk2(bf2f(uw.w & 0xffffu) * (m1.z + bs), bf2f(uw.w >> 16) * (m1.w + bs));
            opend[i] = o;
        }
        asm volatile("s_waitcnt lgkmcnt(0)" ::: "memory");
#pragma unroll
        for (int i = 0; i < 4; ++i) { ur[i] = urn[i]; bsr[i] = bsn[i]; }
    }
#pragma unroll
    for (int i = 0; i < 4; ++i) *(u32x4*)(YO + (size_t)(r0 + 32 * pb + 8 * i + (lane >> 3)) * ldo + 7 * 128 + 64 * dh + (lane & 7) * 8) = opend[i];
    __syncthreads();
}
}

namespace att2 {
typedef short bf16x8 __attribute__((ext_vector_type(8)));
typedef short s16x4 __attribute__((ext_vector_type(4)));
typedef float f32x16 __attribute__((ext_vector_type(16)));
typedef __attribute__((address_space(3))) const char* lds_cptr;
typedef short v4i16_t __attribute__((ext_vector_type(4)));
__device__ __forceinline__ int crow(int r, int hi) { return (r & 3) + 8 * (r >> 2) + 4 * hi; }
#define SBAR() __builtin_amdgcn_sched_barrier(0)
constexpr int NSLOT = 3, SLOTB = 8192;
constexpr int LDS_K = 0, LDS_V = NSLOT * SLOTB, LDS_WS = 2 * NSLOT * SLOTB, LDS_OST = LDS_WS + 8 * 64 * 4, LDS_BYTES = LDS_OST + 8 * 4096;
__device__ __forceinline__ void glds16(const void* gsrc, unsigned lds_dst) { unsigned keep;
    asm volatile("s_mov_b32 %0, m0\n\ts_mov_b32 m0, %2\n\ts_nop 0\n\tglobal_load_lds_dwordx4 %1, off\n\ts_mov_b32 m0, %0" : "=&s"(keep) : "v"(gsrc), "s"(lds_dst) : "memory"); }
__device__ __forceinline__ float max3f(float a, float b, float c) { float r; asm("v_max3_f32 %0, %1, %2, %3" : "=v"(r) : "v"(a), "v"(b), "v"(c)); return r; }
__device__ __forceinline__ float max2f(float a, float b) { float r; asm("v_max_f32_e32 %0, %1, %2" : "=v"(r) : "v"(a), "v"(b)); return r; }
__device__ __forceinline__ float fadd_s(float a, float b) { float r; asm("v_add_f32_e32 %0, %1, %2" : "=v"(r) : "v"(a), "v"(b)); return r; }
__device__ __forceinline__ float fsub_s(float a, float b) { float r; asm("v_sub_f32_e32 %0, %1, %2" : "=v"(r) : "v"(a), "v"(b)); return r; }
typedef float f32x2_t __attribute__((ext_vector_type(2))); typedef __bf16 bf16x2_t __attribute__((ext_vector_type(2)));
__device__ __forceinline__ unsigned cvtpk_s(float lo, float hi) { f32x2_t v = {lo, hi}; bf16x2_t b = __builtin_convertvector(v, bf16x2_t); return __builtin_bit_cast(unsigned, b); }
#define WAIT_BAR(N) asm volatile("s_waitcnt vmcnt(" #N ") lgkmcnt(0)\n\ts_barrier" ::: "memory")
__device__ __forceinline__ void qkt(f32x16& p0, f32x16& p1, lds_cptr Kslot, const bf16x8* qr, const f32x16& negm, int r32, int hi) {
    const lds_cptr kb = Kslot + hi * 1024 + r32 * 16;
#pragma unroll
    for (int d0 = 0; d0 < 4; ++d0) {
        const bf16x8 b0 = *(const __attribute__((address_space(3))) bf16x8*)(kb + d0 * 2048);
        const bf16x8 b1 = *(const __attribute__((address_space(3))) bf16x8*)(kb + d0 * 2048 + 512);
        if (d0 == 0) { p0 = __builtin_amdgcn_mfma_f32_32x32x16_bf16(b0, qr[0], negm, 0, 0, 0); p1 = __builtin_amdgcn_mfma_f32_32x32x16_bf16(b1, qr[0], negm, 0, 0, 0); }
        else { p0 = __builtin_amdgcn_mfma_f32_32x32x16_bf16(b0, qr[d0], p0, 0, 0, 0); p1 = __builtin_amdgcn_mfma_f32_32x32x16_bf16(b1, qr[d0], p1, 0, 0, 0); }
    }
}
__device__ __forceinline__ void kload8(bf16x8* kf, lds_cptr kp) {
    kf[0] = *(const __attribute__((address_space(3))) bf16x8*)(kp);        kf[1] = *(const __attribute__((address_space(3))) bf16x8*)(kp + 512);
    kf[2] = *(const __attribute__((address_space(3))) bf16x8*)(kp + 2048); kf[3] = *(const __attribute__((address_space(3))) bf16x8*)(kp + 2560);
    kf[4] = *(const __attribute__((address_space(3))) bf16x8*)(kp + 4096); kf[5] = *(const __attribute__((address_space(3))) bf16x8*)(kp + 4608);
    kf[6] = *(const __attribute__((address_space(3))) bf16x8*)(kp + 6144); kf[7] = *(const __attribute__((address_space(3))) bf16x8*)(kp + 6656);
}
__device__ __forceinline__ void kload2(bf16x8* kf, lds_cptr kp, int j) { kf[2 * j] = *(const __attribute__((address_space(3))) bf16x8*)(kp + j * 2048); kf[2 * j + 1] = *(const __attribute__((address_space(3))) bf16x8*)(kp + j * 2048 + 512); }
__device__ __forceinline__ s16x4 vtr(lds_cptr p) { return __builtin_bit_cast(s16x4, __builtin_amdgcn_ds_read_tr16_b64_v4i16((__attribute__((address_space(3))) v4i16_t*)p)); }
__device__ __forceinline__ float rowmax(const f32x16& p0, const f32x16& p1) {
    float a = max3f(p0[0], p0[1], p1[0]), b = max3f(p0[2], p0[3], p1[1]); a = max3f(a, p1[2], p1[3]);
#pragma unroll
    for (int r = 4; r < 16; r += 4) { a = max3f(a, p0[r], p0[r + 1]); b = max3f(b, p0[r + 2], p0[r + 3]); a = max3f(a, p1[r], p1[r + 1]); b = max3f(b, p1[r + 2], p1[r + 3]); }
    const float m = max2f(a, b);
    auto rr = __builtin_amdgcn_permlane32_swap(__float_as_uint(m), __float_as_uint(m), false, false);
    return max2f(__uint_as_float(rr[0]), __uint_as_float(rr[1]));
}
__device__ __forceinline__ void pv(f32x16* o, int vb, bf16x8 pa0, bf16x8 pa1, bf16x8 pa2, bf16x8 pa3) {
#pragma unroll
    for (int d0 = 0; d0 < 2; ++d0) { s16x4 lo[4], hi[4];
#pragma unroll
        for (int ks = 0; ks < 4; ++ks) {
            asm volatile("ds_read_b64_tr_b16 %0,%1 offset:%c2" : "=&v"(lo[ks]) : "v"(vb), "i"(d0 * 4096 + ks * 1024) : "memory");
            asm volatile("ds_read_b64_tr_b16 %0,%1 offset:%c2" : "=&v"(hi[ks]) : "v"(vb), "i"(d0 * 4096 + ks * 1024 + 512) : "memory"); }
        asm volatile("s_waitcnt lgkmcnt(0)" ::: "memory"); SBAR();
#define PK(k) (bf16x8){lo[k][0], lo[k][1], lo[k][2], lo[k][3], hi[k][0], hi[k][1], hi[k][2], hi[k][3]}
        o[d0] = __builtin_amdgcn_mfma_f32_32x32x16_bf16(pa0, PK(0), o[d0], 0, 0, 0);
        o[d0] = __builtin_amdgcn_mfma_f32_32x32x16_bf16(pa1, PK(1), o[d0], 0, 0, 0);
        o[d0] = __builtin_amdgcn_mfma_f32_32x32x16_bf16(pa2, PK(2), o[d0], 0, 0, 0);
        o[d0] = __builtin_amdgcn_mfma_f32_32x32x16_bf16(pa3, PK(3), o[d0], 0, 0, 0);
#undef PK
    }
}
__device__ __forceinline__ void wmask(f32x16& p0, f32x16& p1, int dl, int r32, int hi) {
    const float NEG = -INFINITY;
#pragma unroll
    for (int r = 0; r < 16; ++r) { const int rel = dl + crow(r, hi) - r32; if (rel < -128 || rel > 128) p0[r] = NEG; if (rel + 32 < -128 || rel + 32 > 128) p1[r] = NEG; }
}

template <int THRL> __device__ __forceinline__ void attn_unit(int b, int n, int kvh, int hp, int base, bool primed, bool has_next, int nb, int nn, int nkvh, int nhp, bf16x8 (&qr)[4], int& nbase,
                                                              const bf16_t* Y, bf16_t* O, int ldo, const bf16_t* KB, const bf16_t* VB, const float* sink, LAS unsigned char* shm) {
    const int tid = threadIdx.x, lane = tid & 63, r32 = lane & 31, hi = lane >> 5; const int wid = __builtin_amdgcn_readfirstlane(tid >> 6);
    const int head = kvh * 4 + (wid >> 1), qsub = wid & 1;
    const long qrow0 = (long)b * SEQ + n * 64 + qsub * 32;
    const bf16_t* Qw = Y + qrow0 * 2048 + 1024 + head * 64;
    const unsigned lds0 = (unsigned)(uintptr_t)shm;
    LAS float* wsf = (LAS float*)(shm + LDS_WS) + wid * 64;
    const long koff = (long)lane * 256 + kvh * 64 + wid * 8;
    const long voff = (long)(16 * (wid & 3) + (lane >> 2)) * 256 + kvh * 64 + (wid >> 2) * 32 + (lane & 3) * 8;
    const unsigned kdst = lds0 + LDS_K + wid * 1024, vdst = lds0 + LDS_V + wid * 1024;
    const int jlo = (n == 0) ? 2 : (n == 1) ? 1 : 0, jhi = (n == 63) ? 2 : (n == 62) ? 3 : 4, NT = 4 + (jhi - jlo + 1);
    const long lrow0 = (long)b * SEQ + n * 64 - 128 + 64 * (jlo - 4), crow0 = (long)NTOK + b * CTXL;
#define TROW(t) ((t) < 4 ? crow0 + 64 * (t) : lrow0 + 64 * (t))
#define DMA_K(t, slot) glds16(KB + TROW(t) * 256 + koff, (unsigned)__builtin_amdgcn_readfirstlane(kdst + (slot)))
#define DMA_V(t, slot) glds16(VB + TROW(t) * 256 + voff, (unsigned)__builtin_amdgcn_readfirstlane(vdst + (slot)))
    const int vb0 = (int)(lds0 + LDS_V) + ((lane >> 4) & 1) * 32 + (lane & 3) * 8 + (4 * hi + ((lane & 15) >> 2)) * 64;
    bf16x8 kf[8];
    const lds_cptr shm3 = (lds_cptr)shm; const lds_cptr kp0 = shm3 + LDS_K + hi * 1024 + r32 * 16; const lds_cptr vp0 = shm3 + LDS_V + ((lane >> 4) & 1) * 32 + (lane & 3) * 8 + (4 * hi + ((lane & 15) >> 2)) * 64;
    const int s0 = base, s1 = (s0 == (NSLOT - 1) * SLOTB) ? 0 : s0 + SLOTB, s2 = (s1 == (NSLOT - 1) * SLOTB) ? 0 : s1 + SLOTB;
    if (!primed) {
        DMA_K(0, s0); DMA_V(0, s0); DMA_K(1, s1); DMA_K(2, s2);
#pragma unroll
        for (int d0 = 0; d0 < 4; ++d0) qr[d0] = *(const bf16x8*)(Qw + (long)r32 * 2048 + d0 * 16 + hi * 8);
    }
    float mhat = 0.f, l_reg = 0.f; f32x16 o[2]; o[0] = f32x16{}; o[1] = f32x16{}; f32x16 negm = f32x16{}; asm volatile("" : "+v"(negm));
    const int dq = -128 - 32 * qsub;
#define CMASK(P0, P1, t) do { if ((t) >= 4) { const int dl_ = 64 * (jlo + (t) - 4) + dq; if (dl_ < -97 || dl_ > 65) wmask(P0, P1, dl_, r32, hi); } } while (0)
    bool resc = false;
#define START(P0, P1) do { const float rm = rowmax(P0, P1); resc = false; \
    { const float dl = rm; mhat = fadd_s(mhat, dl); \
      _Pragma("unroll") for (int r = 0; r < 16; ++r) { P0[r] = fsub_s(P0[r], dl); P1[r] = fsub_s(P1[r], dl); } \
      _Pragma("unroll") for (int r = 0; r < 16; ++r) negm[r] = -mhat; asm volatile("" : "+v"(negm)); } \
    _Pragma("unroll") for (int r = 0; r < 16; ++r) P0[r] = __builtin_amdgcn_exp2f(P0[r]); } while (0)
#define RESC() do { if (resc) { asm volatile("s_waitcnt lgkmcnt(0)" ::: "memory"); \
      _Pragma("unroll") for (int d_ = 0; d_ < 2; ++d_) _Pragma("unroll") for (int r = 0; r < 16; ++r) o[d_][r] *= wsf[crow(r, hi)]; } } while (0)
    f32x16 pA0, pA1, pB0, pB1;
    int sl_prev = s0, sl_cur = s0, sl_next = s1;
#define ROT() do { sl_prev = sl_cur; sl_cur = sl_next; sl_next = (sl_next == (NSLOT - 1) * SLOTB) ? 0 : sl_next + SLOTB; } while (0)
    s16x4 vlo[8], vhi[8]; u32x4 pw0, pw1, pw2, pw3;
    const bool oddnt = NT & 1;
    WAIT_BAR(7);
#define PROLOG(X0, X1) do { qkt(X0, X1, shm3 + LDS_K + s0, qr, negm, r32, hi); asm volatile("s_nop 15\n\ts_nop 7" : "+v"(X0), "+v"(X1)); \
    START(X0, X1); \
    _Pragma("unroll") for (int r = 0; r < 16; ++r) X1[r] = __builtin_amdgcn_exp2f(X1[r]); \
    WAIT_BAR(0); \
    DMA_K(3, s0); DMA_V(1, s1); \
    ROT(); \
    kload8(kf, kp0 + sl_cur); \
    WAIT_BAR(2); } while (0)
#define PKW(P, B) cvtpk_s(P[B], P[B + 1])
#define PAF(k) __builtin_bit_cast(bf16x8, pw##k)
#define VFR(i) (bf16x8){vlo[i][0], vlo[i][1], vlo[i][2], vlo[i][3], vhi[i][0], vhi[i][1], vhi[i][2], vhi[i][3]}
#define PIN(x) asm volatile("" : "+v"(x))
#define MX3(a, b, c) __builtin_fmaxf(__builtin_fmaxf((a), (b)), (c))
#define GAPA(MF, A0, A1, A2, A3, W0, W1, PW) do { MF; sacc += A0; sacc += A1; sacc += A2; sacc += A3; PIN(sacc); W0; W1; PIN(PW); SBAR(); } while (0)
#define EX(v) __builtin_amdgcn_exp2f(v)
#define GAPB(MF, X, B) do { MF; X[B] = EX(X[B]); X[B + 1] = EX(X[B + 1]); X[B + 2] = EX(X[B + 2]); X[B + 3] = EX(X[B + 3]); PIN(X); SBAR(); } while (0)
#define VRD(i) do { vlo[i] = vtr(vp_ + (((i) >> 2) * 4096 + ((i) & 3) * 1024)); vhi[i] = vtr(vp_ + (((i) >> 2) * 4096 + ((i) & 3) * 1024 + 512)); } while (0)
#define KRD(G, j) do { if (G) { kload2(kf, kp0 + sl_next, j); SBAR(); } } while (0)
#define STEP(C0, C1, P0, P1, t, GK, GV, GL) do { SBAR(); \
    const lds_cptr vp_ = vp0 + sl_prev; \
    VRD(0); SBAR(); float sacc = (P0[0] + P0[1]); \
    GAPA(C0 = __builtin_amdgcn_mfma_f32_32x32x16_bf16(kf[0], qr[0], negm, 0, 0, 0), P0[2], P0[3], P0[4], P0[5],     pw0[0] = PKW(P0, 0), pw0[1] = PKW(P0, 2), pw0); \
    VRD(4); SBAR(); GAPA(C1 = __builtin_amdgcn_mfma_f32_32x32x16_bf16(kf[1], qr[0], negm, 0, 0, 0), P0[6], P0[7], P0[8], P0[9],     pw0[2] = PKW(P0, 4), pw0[3] = PKW(P0, 6), pw0); \
    VRD(1); SBAR(); GAPA(C0 = __builtin_amdgcn_mfma_f32_32x32x16_bf16(kf[2], qr[1], C0, 0, 0, 0),   P0[10], P0[11], P0[12], P0[13], pw1[0] = PKW(P0, 8), pw1[1] = PKW(P0, 10), pw1); \
    VRD(5); SBAR(); GAPA(C1 = __builtin_amdgcn_mfma_f32_32x32x16_bf16(kf[3], qr[1], C1, 0, 0, 0),   P0[14], P0[15], P1[0], P1[1],   pw1[2] = PKW(P0, 12), pw1[3] = PKW(P0, 14), pw1); \
    VRD(2); SBAR(); GAPA(C0 = __builtin_amdgcn_mfma_f32_32x32x16_bf16(kf[4], qr[2], C0, 0, 0, 0),   P1[2], P1[3], P1[4], P1[5],     pw2[0] = PKW(P1, 0), pw2[1] = PKW(P1, 2), pw2); \
    VRD(6); SBAR(); GAPA(C1 = __builtin_amdgcn_mfma_f32_32x32x16_bf16(kf[5], qr[2], C1, 0, 0, 0),   P1[6], P1[7], P1[8], P1[9],     pw2[2] = PKW(P1, 4), pw2[3] = PKW(P1, 6), pw2); \
    VRD(3); SBAR(); GAPA(C0 = __builtin_amdgcn_mfma_f32_32x32x16_bf16(kf[6], qr[3], C0, 0, 0, 0),   P1[10], P1[11], P1[12], P1[13], pw3[0] = PKW(P1, 8), pw3[1] = PKW(P1, 10), pw3); \
    VRD(7); SBAR(); GAPA(C1 = __builtin_amdgcn_mfma_f32_32x32x16_bf16(kf[7], qr[3], C1, 0, 0, 0),   P1[14], P1[15], 0.f, 0.f,       pw3[2] = PKW(P1, 12), pw3[3] = PKW(P1, 14), pw3); \
    l_reg += sacc; \
    if (GK) { DMA_K((t) + 3, sl_cur); } if (GV) { DMA_V((t) + 1, sl_next); } \
    CMASK(C0, C1, t); \
    { float a = MX3(C0[0], C0[1], C1[0]), b2 = MX3(C0[2], C0[3], C1[1]); a = MX3(a, C1[2], C1[3]); \
      _Pragma("unroll") for (int r = 4; r < 16; r += 4) { a = MX3(a, C0[r], C0[r + 1]); b2 = MX3(b2, C0[r + 2], C0[r + 3]); a = MX3(a, C1[r], C1[r + 1]); b2 = MX3(b2, C1[r + 2], C1[r + 3]); } \
      float rm = __builtin_fmaxf(a, b2); { auto rr = __builtin_amdgcn_permlane32_swap(__float_as_uint(rm), __float_as_uint(rm), false, false); rm = __builtin_fmaxf(__uint_as_float(rr[0]), __uint_as_float(rr[1])); } \
      resc = false; \
      if (__builtin_expect(__any(rm > (float)THRL), 0)) { const float dl = __builtin_fmaxf(rm, 0.f); mhat += dl; \
        _Pragma("unroll") for (int r = 0; r < 16; ++r) { C0[r] -= dl; C1[r] -= dl; } \
        _Pragma("unroll") for (int r = 0; r < 16; ++r) negm[r] = -mhat; asm volatile("" : "+v"(negm)); \
        const float f = __builtin_amdgcn_exp2f(-dl); l_reg *= f; if (hi == 0) wsf[r32] = f; resc = true; } } \
    SBAR(); \
    GAPB(o[0] = __builtin_amdgcn_mfma_f32_32x32x16_bf16(PAF(0), VFR(0), o[0], 0, 0, 0), C0, 0); \
    GAPB(o[1] = __builtin_amdgcn_mfma_f32_32x32x16_bf16(PAF(0), VFR(4), o[1], 0, 0, 0), C0, 4); \
    KRD(GL, 0); GAPB(o[0] = __builtin_amdgcn_mfma_f32_32x32x16_bf16(PAF(1), VFR(1), o[0], 0, 0, 0), C0, 8); \
    KRD(GL, 1); GAPB(o[1] = __builtin_amdgcn_mfma_f32_32x32x16_bf16(PAF(1), VFR(5), o[1], 0, 0, 0), C0, 12); \
    KRD(GL, 2); GAPB(o[0] = __builtin_amdgcn_mfma_f32_32x32x16_bf16(PAF(2), VFR(2), o[0], 0, 0, 0), C1, 0); \
    KRD(GL, 3); GAPB(o[1] = __builtin_amdgcn_mfma_f32_32x32x16_bf16(PAF(2), VFR(6), o[1], 0, 0, 0), C1, 4); \
    GAPB(o[0] = __builtin_amdgcn_mfma_f32_32x32x16_bf16(PAF(3), VFR(3), o[0], 0, 0, 0), C1, 8); \
    GAPB(o[1] = __builtin_amdgcn_mfma_f32_32x32x16_bf16(PAF(3), VFR(7), o[1], 0, 0, 0), C1, 12); \
    } while (0)
#define ENDW(tt) do { if ((tt) + 3 < NT) { WAIT_BAR(2); } else if ((tt) + 2 < NT) { WAIT_BAR(1); } else { WAIT_BAR(0); } } while (0)
    int t = 1;
    PROLOG(pA0, pA1);
    for (; t + 1 < NT; t += 2) {
        STEP(pB0, pB1, pA0, pA1, t, (t + 3 < NT), (t + 1 < NT), (t + 1 < NT));       ENDW(t);     RESC(); ROT();
        STEP(pA0, pA1, pB0, pB1, t + 1, (t + 4 < NT), (t + 2 < NT), (t + 2 < NT));   ENDW(t + 1); RESC(); ROT();
    }
    const int sl_last = oddnt ? sl_prev : sl_cur;
    nbase = oddnt ? sl_cur : sl_next;
    if (has_next) {
        const long nr = (long)NTOK + nb * CTXL; const long nko = (long)lane * 256 + nkvh * 64 + wid * 8, nvo = (long)(16 * (wid & 3) + (lane >> 2)) * 256 + nkvh * 64 + (wid >> 2) * 32 + (lane & 3) * 8;
        const int n0 = nbase, n1 = (n0 == (NSLOT - 1) * SLOTB) ? 0 : n0 + SLOTB, n2 = (n1 == (NSLOT - 1) * SLOTB) ? 0 : n1 + SLOTB;
        glds16(KB + nr * 256 + nko, (unsigned)__builtin_amdgcn_readfirstlane(kdst + n0)); glds16(VB + nr * 256 + nvo, (unsigned)__builtin_amdgcn_readfirstlane(vdst + n0));
        glds16(KB + (nr + 64) * 256 + nko, (unsigned)__builtin_amdgcn_readfirstlane(kdst + n1)); glds16(KB + (nr + 128) * 256 + nko, (unsigned)__builtin_amdgcn_readfirstlane(kdst + n2));
    }
    if (!oddnt) { STEP(pB0, pB1, pA0, pA1, NT - 1, false, false, false); RESC(); } else { pB0 = pA0; pB1 = pA1; }
    { float sacc = pB0[0] + pB0[1]; _Pragma("unroll") for (int r = 2; r < 16; ++r) sacc += pB0[r]; _Pragma("unroll") for (int r = 0; r < 16; ++r) sacc += pB1[r]; l_reg += sacc;
      pw0 = (u32x4){PKW(pB0, 0), PKW(pB0, 2), PKW(pB0, 4), PKW(pB0, 6)}; pw1 = (u32x4){PKW(pB0, 8), PKW(pB0, 10), PKW(pB0, 12), PKW(pB0, 14)}; pw2 = (u32x4){PKW(pB1, 0), PKW(pB1, 2), PKW(pB1, 4), PKW(pB1, 6)}; pw3 = (u32x4){PKW(pB1, 8), PKW(pB1, 10), PKW(pB1, 12), PKW(pB1, 14)};
      SBAR(); pv(o, vb0 + sl_last, PAF(0), PAF(1), PAF(2), PAF(3)); }
    if (has_next) {
        asm volatile("" ::: "memory");
        const bf16_t* nQw = Y + ((long)nb * SEQ + nn * 64 + qsub * 32) * 2048 + 1024 + (nkvh * 4 + (wid >> 1)) * 64;
#pragma unroll
        for (int d0 = 0; d0 < 4; ++d0) qr[d0] = *(const bf16x8*)(nQw + (long)r32 * 2048 + d0 * 16 + hi * 8);
    }
    { auto rr = __builtin_amdgcn_permlane32_swap(__float_as_uint(l_reg), __float_as_uint(l_reg), false, false); l_reg = __uint_as_float(rr[0]) + __uint_as_float(rr[1]); }
    l_reg += __builtin_amdgcn_exp2f(fminf(sink[head] * LOG2E - mhat, 80.f));
    if (hi == 0) wsf[32 + r32] = l_reg; asm volatile("s_waitcnt lgkmcnt(0)" ::: "memory");
    float rli[16];
#pragma unroll
    for (int r = 0; r < 16; ++r) rli[r] = __builtin_amdgcn_rcpf(wsf[32 + crow(r, hi)]);
    bf16_t* Ow = O + qrow0 * ldo + head * 64;
    { LAS bf16_t* stg = (LAS bf16_t*)(shm + LDS_OST) + wid * 2048;
#pragma unroll
      for (int r = 0; r < 16; ++r) { const int orow = crow(r, hi);
#pragma unroll
          for (int d0 = 0; d0 < 2; ++d0) stg[orow * 64 + d0 * 32 + r32] = (bf16_t)(pk2(o[d0][r] * rli[r], 0.f) & 0xffffu); }
      asm volatile("s_waitcnt lgkmcnt(0)" ::: "memory");
#pragma unroll
      for (int i = 0; i < 4; ++i) { const int row = i * 8 + (lane >> 3), ch = lane & 7; const u32x4 v = *(const LAS u32x4*)(stg + row * 64 + ch * 8); *(u32x4*)(Ow + (long)row * ldo + ch * 8) = v; } }
    asm volatile("s_waitcnt lgkmcnt(0)\n\ts_barrier" ::: "memory");
#undef TROW
#undef DMA_K
#undef DMA_V
#undef CMASK
#undef START
#undef RESC
#undef ROT
#undef PKW
#undef PAF
#undef VFR
#undef PIN
#undef MX3
#undef GAPA
#undef GAPB
#undef EX
#undef VRD
#undef KRD
#undef STEP
#undef ENDW
#undef PROLOG
}
#undef SBAR
#undef WAIT_BAR
}

#define XB_TMO      128
#define XB_XCNT(j)  (256  + 64 * (j))
#define XB_XSUB(j)  (1280 + 64 * (j))
#define XB_XGEN(j)  (2304 + 64 * (j))
#define XB_TOP      3328
#define XB_TOPGEN   3392
#define XCD_BAR_WORDS 3456
#define XB_SPIN_CAP (1u << 18)
__device__ __forceinline__ unsigned xb_ld(unsigned* p)              { return __hip_atomic_load(p, __ATOMIC_RELAXED, __HIP_MEMORY_SCOPE_AGENT); }
__device__ __forceinline__ unsigned xb_add(unsigned* p, unsigned v) { return __hip_atomic_fetch_add(p, v, __ATOMIC_RELAXED, __HIP_MEMORY_SCOPE_AGENT); }
__device__ __forceinline__ unsigned xb_xcc_id() { return (unsigned)__builtin_amdgcn_s_getreg((3 << 11) | 20) & 0xFu; }
#define XB_SPIN(cond, bar) do { unsigned _sp = 0; while (cond) { __builtin_amdgcn_s_sleep(1); \
    if ((++_sp & 255u) == 0u) { if (xb_ld(&(bar)[XB_TMO])) break; if (_sp > XB_SPIN_CAP) { atomicAdd(&(bar)[XB_TMO], 1u); break; } } } } while (0)
struct XcdBarrier { unsigned* bar; unsigned x; volatile LAS unsigned* st; };
__device__ __forceinline__ XcdBarrier xcd_barrier_post(unsigned* bar, volatile LAS unsigned* st) {
    XcdBarrier b; b.bar = bar; b.x = xb_xcc_id(); b.st = st;
    if (threadIdx.x == 0) (void)xb_add(&bar[XB_XCNT(b.x)], 1u);
    return b;
}
__device__ __forceinline__ void xcd_barrier_complete(unsigned* bar, unsigned x, unsigned& nloc, unsigned& nx) {
    const unsigned G = gridDim.x * gridDim.y * gridDim.z;
    unsigned sum, cnt, mine, sp = 0u;
    for (;;) {
        sum = 0u; cnt = 0u; mine = 0u;
#pragma unroll
        for (unsigned j = 0; j < 16; ++j) { const unsigned c = xb_ld(&bar[XB_XCNT(j)]); sum += c; cnt += (c > 0u) ? 1u : 0u; mine = (j == x) ? c : mine; }
        if (sum == G) break;
        __builtin_amdgcn_s_sleep(1);
        if ((++sp & 255u) == 0u) { if (xb_ld(&bar[XB_TMO])) break; if (sp > XB_SPIN_CAP) { atomicAdd(&bar[XB_TMO], 1u); break; } }
    }
    nloc = mine > 0u ? mine : 1u; nx = cnt > 0u ? cnt : 1u;
}
__device__ __forceinline__ void xcd_barrier(const XcdBarrier& b) {
    asm volatile("s_waitcnt vmcnt(0)" ::: "memory");
    __syncthreads();
    if (threadIdx.x == 0) {
        unsigned* bar = b.bar;
        __builtin_amdgcn_s_waitcnt(0);
        unsigned nloc = b.st[0], nx = b.st[1];
        if (nloc == 0u) { xcd_barrier_complete(bar, b.x, nloc, nx); b.st[0] = nloc; b.st[1] = nx; }
        const unsigned old = xb_add(&bar[XB_XSUB(b.x)], 1u);
        const unsigned gen = old / nloc;
        if (old + 1u == (gen + 1u) * nloc) {
            __builtin_amdgcn_fence(__ATOMIC_RELEASE, "agent");
            asm volatile("s_waitcnt vmcnt(0)" ::: "memory");
            const unsigned og = xb_add(&bar[XB_TOP], 1u);
            const unsigned tg = og / nx;
            if (og + 1u == (tg + 1u) * nx) xb_add(&bar[XB_TOPGEN], 1u);
            else XB_SPIN(xb_ld(&bar[XB_TOPGEN]) == tg, bar);
            __builtin_amdgcn_fence(__ATOMIC_ACQUIRE, "agent");
            xb_add(&bar[XB_XGEN(b.x)], 1u);
            asm volatile("s_waitcnt vmcnt(0)" ::: "memory");
        } else {
            XB_SPIN(xb_ld(&bar[XB_XGEN(b.x)]) == gen, bar);
            __builtin_amdgcn_fence(__ATOMIC_ACQUIRE, "agent");
            asm volatile("s_waitcnt vmcnt(0)" ::: "memory");
        }
    }
    __syncthreads();
}
constexpr int LDSCTL_OFF = LDS_BYTES - 256;
constexpr int CW_BAR = 4096, CW_CTX = 8192;

#ifndef PROBE_GMLP2
#define PROBE_GMLP2 0
#endif
#ifndef ATT_PIPE
#define ATT_PIPE 1
#endif
#ifndef ATT_THRL
#define ATT_THRL 8
#endif
#ifndef ONE_LAUNCH
#define ONE_LAUNCH 1
#endif
#ifndef FAST_MIX
#define FAST_MIX 1
#endif
#ifndef PROBE_SEQ
#define PROBE_SEQ 0, 1, 2, 3, 4, 5, 6, 7, 8, 9, 10, 11
#endif

enum { PH_PRO = 0, PH_HN, PH_IN, PH_MIX, PH_A, PH_O, PH_H2R, PH_WCONV, PH_TOPK, PH_GU, PH_D, PH_FIN, PH_COUNT };

__global__ void __launch_bounds__(NTHREADS, 2) fwd(Args args) {
    extern __shared__ __attribute__((aligned(16))) unsigned char lds_raw[];
    LAS unsigned char* lds = (LAS unsigned char*)lds_raw;
    const int tid = threadIdx.x, lane = tid & 63, wave = __builtin_amdgcn_readfirstlane(tid >> 6);
    const int G = gridDim.x, bid = blockIdx.x;
    unsigned char* ws = args.ws;
    const int lo = args.ph_lo, hi = args.ph_hi;
#define IN(k) (lo <= (k) && (k) < hi)
    float* MOD = (float*)(ws + WS_MOD); f32x2* ROPE = (f32x2*)(ws + WS_ROPE);
    float* AFFT = (float*)(ws + WS_AFFT); int* TOPI = (int*)(ws + WS_TOPI); float* TOPW = (float*)(ws + WS_TOPW); int* SLOT = (int*)(ws + WS_SLOT);
    bf16_t* WSP = (bf16_t*)(ws + WS_WSP); bf16_t* WIN = (bf16_t*)(ws + WS_WIN); bf16_t* WAB = (bf16_t*)(ws + WS_WAB); bf16_t* WO = (bf16_t*)(ws + WS_WO);
    bf16_t* H = (bf16_t*)(ws + WS_H); bf16_t* VA = (bf16_t*)(ws + WS_VA); bf16_t* KB = (bf16_t*)(ws + WS_KB); bf16_t* VB = (bf16_t*)(ws + WS_VB);
    bf16_t* GT = (bf16_t*)(ws + WS_G); bf16_t* Y = (bf16_t*)(ws + WS_Y); bf16_t* TMP = (bf16_t*)(ws + WS_TMP); bf16_t* MERGED = (bf16_t*)(ws + WS_MERGED);
    bf16_t* WGU = (bf16_t*)(ws + WS_WGU); bf16_t* WD = (bf16_t*)(ws + WS_WD); bf16_t* H2 = (bf16_t*)(ws + WS_H2); bf16_t* ACT = (bf16_t*)(ws + WS_ACT); bf16_t* YB = (bf16_t*)(ws + WS_YB);
    const int gw = bid * NWAVES + wave, NGW = G * NWAVES;
    if (tid < 64) ((LAS unsigned*)(lds + LDSCTL_OFF))[tid] = 0u;
    __syncthreads();
    XcdBarrier bar; bar.bar = (unsigned*)(ws + WS_CTL) + CW_BAR; bar.x = 0; bar.st = nullptr;
    if (ONE_LAUNCH) bar = xcd_barrier_post((unsigned*)(ws + WS_CTL) + CW_BAR, (volatile LAS unsigned*)(lds + LDSCTL_OFF));
#define SEAM(k) do { if (ONE_LAUNCH && IN(k) && IN((k) + 1)) xcd_barrier(bar); } while (0)

    if (IN(PH_PRO)) {
        if (bid < 192) adaln_task(bid, args.in[I_C], args.in[I_CCTX], args.in[I_WADA], args.in[I_BADA], MOD, (LAS float*)lds, tid);
        else if (bid == 192) rope_table(ROPE, tid);
        __syncthreads();
        for (int i = bid * NTHREADS + tid; i < 8 * 128 * 128 / 4; i += G * NTHREADS) st4bf(WSP + 4 * i, *(const f32x4*)(args.in[I_WSP] + 4 * i));
        LAS float* scr = (LAS float*)(lds + wave * 16384);
        constexpr int I_IN = 16 * 176, I_P = 16 * 32;
        for (int it = gw; it < I_IN + 3 * I_P; it += NGW) {
            int r = it;
            if (r < I_IN) { const int kb = r / 176, nb = r % 176, n0 = nb * 32; int drow = n0;
                if (n0 >= OFF_GATE) { const int gcol = n0 - OFF_GATE, isb = gcol >= 1024, ch = gcol & 1023; drow = OFF_GATE + 256 * (ch >> 7) + (ch & 127) + (isb ? 128 : 0); }
                transpose_item(args.in[I_WIN], INCOLS, kb * 64, n0, WIN + (size_t)drow * 1024 + kb * 64, 1024, scr, lane); continue; } r -= I_IN;
            if (r < I_P) { const int kb = r / 32, nb = r % 32; transpose_item(args.in[I_WPA], 1024, kb * 64, nb * 32, WAB + (size_t)(nb * 32) * 2048 + kb * 64, 2048, scr, lane); continue; } r -= I_P;
            if (r < I_P) { const int kb = r / 32, nb = r % 32; transpose_item(args.in[I_WPB], 1024, kb * 64, nb * 32, WAB + (size_t)(nb * 32) * 2048 + 1024 + kb * 64, 2048, scr, lane); continue; } r -= I_P;
            { const int kb = r / 32, nb = r % 32; transpose_item(args.in[I_WOUT], 1024, kb * 64, nb * 32, WO + (size_t)(nb * 32) * 1024 + kb * 64, 1024, scr, lane); }
        }
    }
    SEAM(PH_PRO);
    if (IN(PH_HN)) {
        const float* g1n = args.in[I_N1G];
        const int HCH = (NROWS_H + NGW - 1) / NGW;
        f32x4 am[4], sm[4]; int mcur = -1;
        for (int kk = 0; kk < HCH; ++kk) {
            const int row = gw * HCH + kk; if (row >= NROWS_H) break;
            const float* xr; int mrow;
            if (row < NTOK) { xr = args.in[I_X] + (size_t)row * 1024; mrow = row >> 12; } else { xr = args.in[I_CTX] + (size_t)(row - NTOK) * 1024; mrow = 8; }
            f32x4 v[4]; float ss = 0.f;
#pragma unroll
            for (int j = 0; j < 4; ++j) { v[j] = *(const f32x4*)(xr + 4 * lane + 256 * j); ss += (v[j].x * v[j].x + v[j].y * v[j].y) + (v[j].z * v[j].z + v[j].w * v[j].w); }
            if (mrow != mcur) { mcur = mrow; const float* sh = MOD + mrow * 6144; const float* sc = sh + 1024;
#pragma unroll
                for (int j = 0; j < 4; ++j) { const int col = 4 * lane + 256 * j; am[j] = *(const f32x4*)(g1n + col) * (1.f + *(const f32x4*)(sc + col)); sm[j] = *(const f32x4*)(sh + col); } }
            const float rstd = 1.0f / sqrtf(wave_sum(ss) * (1.f / 1024.f) + EPS);
#pragma unroll
            for (int j = 0; j < 4; ++j) st4bf(H + (size_t)row * 1024 + 4 * lane + 256 * j, (v[j] * rstd) * am[j] + sm[j]);
        }
    }
    SEAM(PH_HN);
    if (IN(PH_IN)) {
        Gemm g{H, WIN, 1024, 1024, 1024, 0, 30, nullptr}; StaticOrder S; S.init(NTOK, INCOLS, G, bid, G == 256 ? 0 : 16);
        EpiIn E{Y, VA, KB, VB, GT, args.in[I_BMG], ROPE, (f32x2*)(ws + WS_STATS)};
        GEMM_PHASE<EpiIn, StaticOrder, false>(lds, g, S, E);
    }
    SEAM(PH_IN);
    if (IN(PH_MIX) && FAST_MIX) {
        unsigned* ctxcnt = (unsigned*)(ws + WS_CTL) + CW_CTX;
        if (G == 256 && bid < 16) {
            Gemm g{H, WIN, 1024, 1024, 1024, 0, 30, nullptr}; OneUnit S{NTOK / 256 + (bid >> 1), 12 + (bid & 1)};
            EpiIn E{Y, VA, KB, VB, GT, args.in[I_BMG], ROPE, (f32x2*)(ws + WS_STATS)};
            GEMM_PHASE<EpiIn, OneUnit, false>(lds, g, S, E);
            asm volatile("s_waitcnt vmcnt(0)" ::: "memory");
            __syncthreads();
            if (tid == 0) { __builtin_amdgcn_fence(__ATOMIC_RELEASE, "agent"); asm volatile("s_waitcnt vmcnt(0)" ::: "memory"); xb_add(ctxcnt, 1u); }
        }
        if (!(args.flags & 8)) for (int task = bid; task < NB * 32; task += G) mix::gmlp_unit(task, Y, (args.flags & 2) ? TMP : Y, (args.flags & 2) ? 1024 : 2048, VA, WSP, (const f32x2*)(ws + WS_STATS), args.in[I_LNG], args.in[I_LNB], args.in[I_BSP], lds);
        if (tid == 0) {
            unsigned sp = 0; while (xb_ld(ctxcnt) < 16u) { __builtin_amdgcn_s_sleep(2); if (++sp > (1u << 22)) break; }
            __builtin_amdgcn_fence(__ATOMIC_ACQUIRE, "agent"); asm volatile("s_waitcnt vmcnt(0)" ::: "memory");
        }
        __syncthreads();
#if ATT_PIPE
        att2::bf16x8 att_qr[4]; int att_base = 0; bool att_primed = false;
        int ubase, ucnt;
        if (G != 256) { ubase = bid * 8; ucnt = 0; }
        else if (bid < 16) { ubase = 6 * bid; ucnt = 6; } else if (bid < 48) { ubase = 96 + 9 * (bid - 16); ucnt = 9; } else { ubase = 384 + 8 * (bid - 48); ucnt = 8; }
        if (!(args.flags & 1)) for (int i = 0; i < ucnt; ++i) {
            const int u_ = ubase + i, un = u_ + 1; const bool more = i + 1 < ucnt; int nbase_ = 0;
            att2::attn_unit<ATT_THRL>(u_ >> 8, (u_ >> 2) & 63, u_ & 3, 0, att_base, att_primed, more, un >> 8, (un >> 2) & 63, un & 3, 0, att_qr, nbase_,
                                      Y, (args.flags & 4) ? TMP : Y + 1024, (args.flags & 4) ? 1024 : 2048, KB, VB, args.in[I_SINK], lds);
            att_base = nbase_; att_primed = more;
        }
        if (G != 256 && !(args.flags & 1)) for (int u_ = bid; u_ < NB * 32 * 8; u_ += G) {
            int nbase_ = 0;
            att2::attn_unit<ATT_THRL>(u_ >> 8, (u_ >> 2) & 63, u_ & 3, 0, 0, false, false, 0, 0, 0, 0, att_qr, nbase_, Y, (args.flags & 4) ? TMP : Y + 1024, (args.flags & 4) ? 1024 : 2048, KB, VB, args.in[I_SINK], lds);
        }
#else
        if (!(args.flags & 1)) for (int task = bid; task < NB * 32 * 4; task += G) mix::attn_unit(task >> 7, (task >> 2) & 31, task & 3, Y, (args.flags & 4) ? TMP : Y + 1024, (args.flags & 4) ? 1024 : 2048, KB, VB, args.in[I_SINK], lds);
#endif
    }
    SEAM(PH_MIX);
    if (IN(PH_A)) {
        Gemm g{Y, WAB, 2048, 2048, 2048, 0, 30, nullptr}; StaticOrder S; S.init(NTOK, 1024, G, bid, 0, 1);
        EpiAB E{MERGED, GT};
        GEMM_PHASE<EpiAB, StaticOrder, false, true>(lds, g, S, E);
    }
    SEAM(PH_A);
    if (IN(PH_O)) {
        Gemm g{MERGED, WO, 1024, 1024, 1024, 0, 30, nullptr}; StaticOrder S; S.init(NTOK, 1024, G, bid);
        EpiO E{(bf16_t*)args.out, MOD};
        GEMM_PHASE<EpiO, StaticOrder, false>(lds, g, S, E);
    }
    SEAM(PH_O);
    if (IN(PH_H2R)) {
        LAS float* wT = (LAS float*)lds;
        { f32x4 wv[8];
#pragma unroll
          for (int k = 0; k < 8; ++k) wv[k] = *(const f32x4*)(args.in[I_WR] + 4 * (tid + NTHREADS * k));
#pragma unroll
          for (int k = 0; k < 8; ++k) { const int f = tid + NTHREADS * k, col = f >> 2, e0 = 4 * (f & 3); wT[e0 * 1024 + col] = wv[k].x; wT[(e0 + 1) * 1024 + col] = wv[k].y; wT[(e0 + 2) * 1024 + col] = wv[k].z; wT[(e0 + 3) * 1024 + col] = wv[k].w; } }
        __syncthreads();
        const float* g2n = args.in[I_N2G];
        const int H2CH = (NTOK / 2 + NGW - 1) / NGW;
        const bool h32 = lane & 32, h16 = lane & 16, h8 = lane & 8, h4 = lane & 4;
        const int myexp = 8 * (lane >> 5) + 4 * ((lane >> 4) & 1) + 2 * ((lane >> 3) & 1) + ((lane >> 2) & 1);
        const bf16_t* D16 = (const bf16_t*)args.out;
        f32x4 vn[2][4]; u32x2 dn[2][4];
#pragma unroll
        for (int q = 0; q < 2; ++q)
#pragma unroll
            for (int j = 0; j < 4; ++j) { const size_t r_ = (size_t)(2 * (NTOK / 2 - 1 - (gw * H2CH < NTOK / 2 ? gw * H2CH : 0)) + q); vn[q][j] = *(const f32x4*)(args.in[I_X] + r_ * 1024 + 4 * lane + 256 * j); dn[q][j] = *(const u32x2*)(D16 + r_ * 2048 + 1024 + 4 * lane + 256 * j); }
        f32x4 amod[4], smod[4]; int bcur = -1;
        for (int kk = 0; kk < H2CH; ++kk) {
            const int rp = gw * H2CH + kk; if (rp >= NTOK / 2) break;
            const int row0 = 2 * (NTOK / 2 - 1 - rp), b = row0 >> 12;
            if (b != bcur) { bcur = b; const float* sh = MOD + b * 6144 + 3072; const float* sc = sh + 1024;
#pragma unroll
                for (int j = 0; j < 4; ++j) { const int col = 4 * lane + 256 * j; amod[j] = *(const f32x4*)(g2n + col) * (1.f + *(const f32x4*)(sc + col)); smod[j] = *(const f32x4*)(sh + col); } }
            f32x4 v[2][4]; float ss[2] = {0.f, 0.f};
#pragma unroll
            for (int q = 0; q < 2; ++q)
#pragma unroll
                for (int j = 0; j < 4; ++j) { const u32x2 dw = dn[q][j]; v[q][j] = vn[q][j] + (f32x4){bf2f(dw.x & 0xffffu), bf2f(dw.x >> 16), bf2f(dw.y & 0xffffu), bf2f(dw.y >> 16)}; ss[q] += (v[q][j].x * v[q][j].x + v[q][j].y * v[q][j].y) + (v[q][j].z * v[q][j].z + v[q][j].w * v[q][j].w); }
            { const int rn = (kk + 1 < H2CH && rp + 1 < NTOK / 2) ? rp + 1 : rp;
#pragma unroll
              for (int q = 0; q < 2; ++q)
#pragma unroll
                  for (int j = 0; j < 4; ++j) { const size_t r_ = (size_t)(2 * (NTOK / 2 - 1 - rn) + q); vn[q][j] = *(const f32x4*)(args.in[I_X] + r_ * 1024 + 4 * lane + 256 * j); dn[q][j] = *(const u32x2*)(D16 + r_ * 2048 + 1024 + 4 * lane + 256 * j); } }
            float rstd[2];
#pragma unroll
            for (int q = 0; q < 2; ++q) rstd[q] = 1.0f / sqrtf(wave_sum(ss[q]) * (1.f / 1024.f) + EPS);
            float lg[2][16];
#pragma unroll
            for (int q = 0; q < 2; ++q)
#pragma unroll
                for (int e = 0; e < 16; ++e) lg[q][e] = 0.f;
            f32x4 wb[2][4];
#pragma unroll
            for (int e = 0; e < 4; ++e) wb[0][e] = *(const LAS f32x4*)(wT + e * 1024 + 4 * lane);
            f32x4 h[2];
#pragma unroll
            for (int g = 0; g < 16; ++g) {
                const int j = g >> 2, eg = g & 3, col = 4 * lane + 256 * j;
                if (g + 1 < 16) {
                    const int jn = (g + 1) >> 2, en = (g + 1) & 3;
#pragma unroll
                    for (int e = 0; e < 4; ++e) wb[(g + 1) & 1][e] = *(const LAS f32x4*)(wT + (4 * en + e) * 1024 + 4 * lane + 256 * jn);
                }
                if (eg == 0) {
#pragma unroll
                    for (int q = 0; q < 2; ++q) { h[q] = (v[q][j] * rstd[q]) * amod[j] + smod[j]; st4bf(H2 + (size_t)(row0 + q) * 1024 + col, h[q]); }
                }
#pragma unroll
                for (int e = 0; e < 4; ++e) {
                    const f32x4 w = wb[g & 1][e];
#pragma unroll
                    for (int q = 0; q < 2; ++q) lg[q][4 * eg + e] += (h[q].x * w.x + h[q].y * w.y) + (h[q].z * w.z + h[q].w * w.w);
                    asm volatile("" : "+v"(lg[0][4 * eg + e]), "+v"(lg[1][4 * eg + e]));
                }
                asm volatile("" ::: "memory");
            }
#pragma unroll
            for (int q = 0; q < 2; ++q) {
                float a8[8], a4[4], a2[2], a1;
#pragma unroll
                for (int i = 0; i < 8; ++i) { const float send = h32 ? lg[q][i] : lg[q][i + 8], keep = h32 ? lg[q][i + 8] : lg[q][i]; a8[i] = keep + xchg32(send); }
#pragma unroll
                for (int i = 0; i < 4; ++i) { const float send = h16 ? a8[i] : a8[i + 4], keep = h16 ? a8[i + 4] : a8[i]; a4[i] = keep + xchg16(send); }
#pragma unroll
                for (int i = 0; i < 2; ++i) { const float send = h8 ? a4[i] : a4[i + 2], keep = h8 ? a4[i + 2] : a4[i]; a2[i] = keep + dpp_f<0x140>(send); }
                { const float send = h4 ? a2[0] : a2[1], keep = h4 ? a2[1] : a2[0]; a1 = keep + dpp_f<0x141>(send); }
                a1 += dpp_f<0x4E>(a1); a1 += dpp_f<0xB1>(a1);
                float mx = a1;
                mx = fmaxf(mx, dpp_f<0x141>(mx)); mx = fmaxf(mx, dpp_f<0x140>(mx)); mx = fmaxf(mx, xchg16(mx)); mx = fmaxf(mx, xchg32(mx));
                const float p = __expf(a1 - mx); float den = p;
                den += dpp_f<0x141>(den); den += dpp_f<0x140>(den); den += xchg16(den); den += xchg32(den);
                if ((lane & 3) == 0) AFFT[(size_t)(b * 16 + myexp) * SEQ + ((row0 + q) & (SEQ - 1))] = p / den;
            }
        }
    }
    if (IN(PH_WCONV)) {
        __syncthreads();
        LAS float* scr = (LAS float*)(lds + wave * 16384);
        constexpr int I_G = 16 * 16 * 64, I_D = 16 * 32 * 32;
        auto item = [&](int it) -> TrItem {
            int r = it; TrItem t;
            if (r < 2 * I_G) {
                const int up = r >= I_G; if (up) r -= I_G;
                r = (r & ~0x44) | ((r >> 4) & 0x4) | ((r << 4) & 0x40);
                const int e = r >> 10, kb = (r >> 6) & 15, nb = r & 63, n0 = nb * 32;
                const int drow = 256 * (n0 >> 7) + (n0 & 127) + (up ? 128 : 0);
                t.src = args.in[up ? I_WEU : I_WEG] + (size_t)e * 1024 * 2048 + (size_t)(kb * 64) * 2048 + n0; t.N = 2048;
                t.dst = WGU + (size_t)e * 4096 * 1024 + (size_t)drow * 1024 + kb * 64; t.ldt = 1024;
            } else {
                r -= 2 * I_G;
                r = (r & ~0x24) | ((r >> 3) & 0x4) | ((r << 3) & 0x20);
                const int e = r >> 10, kb = (r >> 5) & 31, nb = r & 31;
                t.src = args.in[I_WED] + (size_t)e * 2048 * 1024 + (size_t)(kb * 64) * 1024 + nb * 32; t.N = 1024;
                t.dst = WD + (size_t)e * 1024 * 2048 + (size_t)(nb * 32) * 2048 + kb * 64; t.ldt = 2048;
            }
            return t;
        };
        constexpr int NIT = 2 * I_G + I_D;
        if (gw < NIT) {
            TrItem cur = item(gw); f32x4 vc[8], vn[8];
            tr_load(cur, vc, lane);
            for (int it = gw; it < NIT; it += NGW) {
                const bool more = it + NGW < NIT;
                TrItem nxt = cur;
                if (more) { nxt = item(it + NGW); tr_load(nxt, vn, lane); }
                tr_store(cur, vc, scr, lane);
                cur = nxt;
#pragma unroll
                for (int i = 0; i < 8; ++i) vc[i] = vn[i];
            }
        }
    }
    SEAM(PH_WCONV);
    if (IN(PH_TOPK)) {
        LAS int* wsum = (LAS int*)lds;
        for (int task = bid; task < NE * NB; task += G) {
            const int e = task >> 3, b = task & 7;
            const float* aff = AFFT + (size_t)(b * 16 + e) * SEQ;
            unsigned k[8];
            { const u32x4 a0 = *(const u32x4*)(aff + 8 * tid), a1 = *(const u32x4*)(aff + 8 * tid + 4); k[0] = a0.x; k[1] = a0.y; k[2] = a0.z; k[3] = a0.w; k[4] = a1.x; k[5] = a1.y; k[6] = a1.z; k[7] = a1.w; }
            unsigned T = 0u; int it = 0;
            __syncthreads();
            for (int bit = 30; bit >= 0; --bit, ++it) {
                const unsigned cand = T | (1u << bit); int c = 0;
#pragma unroll
                for (int j = 0; j < 8; ++j) c += __builtin_popcountll(__ballot(k[j] >= cand));
                if (lane == 0) wsum[(it & 1) * 8 + wave] = c;
                __syncthreads();
                int tot = 0;
#pragma unroll
                for (int w = 0; w < 8; ++w) tot += wsum[(it & 1) * 8 + w];
                if (tot >= CAP) T = cand;
            }
            int cg = 0, ce = 0;
#pragma unroll
            for (int j = 0; j < 8; ++j) { cg += (k[j] > T) ? 1 : 0; ce += (k[j] == T) ? 1 : 0; }
            LAS int* sc1 = wsum + 16; LAS int* sc2 = wsum + 32;
            int ie = ce, ig = cg;
#pragma unroll
            for (int o = 1; o < 64; o <<= 1) { const int te = __shfl_up(ie, o), tg = __shfl_up(ig, o); if (lane >= o) { ie += te; ig += tg; } }
            __syncthreads();
            if (lane == 63) { sc1[wave] = ie; sc2[wave] = ig; }
            __syncthreads();
            int ebase = ie - ce, totg = 0;
#pragma unroll
            for (int w = 0; w < 8; ++w) { if (w < wave) ebase += sc1[w]; totg += sc2[w]; }
            const int need = CAP - totg;
            int sel[8], cs = 0, er = ebase;
#pragma unroll
            for (int j = 0; j < 8; ++j) { const bool eq = (k[j] == T); sel[j] = (k[j] > T) || (eq && er < need); er += eq ? 1 : 0; cs += sel[j]; }
            int is = cs;
#pragma unroll
            for (int o = 1; o < 64; o <<= 1) { const int ts = __shfl_up(is, o); if (lane >= o) is += ts; }
            __syncthreads();
            if (lane == 63) sc1[wave] = is;
            __syncthreads();
            int sbase = is - cs;
#pragma unroll
            for (int w = 0; w < 8; ++w) if (w < wave) sbase += sc1[w];
#pragma unroll
            for (int j = 0; j < 8; ++j) {
                const int t = 8 * tid + j; int slot = -1;
                if (sel[j]) { slot = sbase; ++sbase; const int prow = (e * 8 + b) * CAP + slot; TOPI[prow] = t; TOPW[prow] = __uint_as_float(k[j]); }
                SLOT[((size_t)b * SEQ + t) * 16 + e] = slot;
            }
            __syncthreads();
        }
    }
    SEAM(PH_TOPK);
    if (IN(PH_GU)) {
        Gemm g{H2, WGU, 1024, 1024, 1024, (size_t)4096 * 1024, 4, TOPI}; StaticOrder S; S.init(NPAIR, 4096, G, bid);
        EpiGU E{ACT};
        GEMM_PHASE<EpiGU, StaticOrder, true, false, true>(lds, g, S, E);
    }
    SEAM(PH_GU);
    if (IN(PH_D)) {
        Gemm g{ACT, WD, 2048, 2048, 2048, (size_t)1024 * 2048, 4, nullptr}; StaticOrder S; S.init(NPAIR, 1024, G, bid, 0, 1);
        EpiD E{YB, TOPW};
        GEMM_PHASE<EpiD, StaticOrder, false>(lds, g, S, E);
    }
    SEAM(PH_D);
    if (IN(PH_FIN)) {
        const float* fg = args.in[I_FING];
        const bf16_t* ZROW = (const bf16_t*)(ws + WS_CTL + 512 * 1024);
        int sln[2] = {-1, -1};
        const int FCH = (NTOK / 2 + NGW - 1) / NGW;
        if (gw * FCH < NTOK / 2 && lane < 16) { sln[0] = SLOT[(size_t)(2 * gw * FCH) * 16 + lane]; sln[1] = SLOT[(size_t)(2 * gw * FCH + 1) * 16 + lane]; }
        f32x4 g2v[4], fgv[4]; int bcur = -1;
#pragma unroll
        for (int h = 0; h < 2; ++h) { fgv[2 * h] = *(const f32x4*)(fg + 512 * h + 8 * lane); fgv[2 * h + 1] = *(const f32x4*)(fg + 512 * h + 8 * lane + 4); }
        for (int kk = 0; kk < FCH; ++kk) {
            const int rp = gw * FCH + kk; if (rp >= NTOK / 2) break;
            const int row0 = 2 * rp, b = row0 >> 12;
            const int sl[2] = {sln[0], sln[1]};
            { const int rn = rp + 1; if (kk + 1 < FCH && rn < NTOK / 2 && lane < 16) { sln[0] = SLOT[(size_t)(2 * rn) * 16 + lane]; sln[1] = SLOT[(size_t)(2 * rn + 1) * 16 + lane]; } }
            if (b != bcur) { bcur = b; const float* g2 = MOD + b * 6144 + 5120;
#pragma unroll
                for (int h = 0; h < 2; ++h) { g2v[2 * h] = *(const f32x4*)(g2 + 512 * h + 8 * lane); g2v[2 * h + 1] = *(const f32x4*)(g2 + 512 * h + 8 * lane + 4); } }
            f32x4 xv[2][4], acc[2][4];
#pragma unroll
            for (int q = 0; q < 2; ++q)
#pragma unroll
                for (int h = 0; h < 2; ++h) { const float* xp = args.in[I_X] + (size_t)(row0 + q) * 1024 + 512 * h + 8 * lane; f32x4 d0_, d1_; ld8bf((const bf16_t*)args.out + (size_t)(row0 + q) * 2048 + 1024 + 512 * h + 8 * lane, d0_, d1_);
                    xv[q][2 * h] = *(const f32x4*)xp + d0_; xv[q][2 * h + 1] = *(const f32x4*)(xp + 4) + d1_;
                    acc[q][2 * h] = (f32x4){0.f, 0.f, 0.f, 0.f}; acc[q][2 * h + 1] = (f32x4){0.f, 0.f, 0.f, 0.f}; }
#pragma unroll
            for (int q = 0; q < 2; ++q) {
                unsigned long long mask = __ballot(sl[q] >= 0);
                for (;;) {
                    const bf16_t* yr[4];
#pragma unroll
                    for (int k = 0; k < 4; ++k) {
                        if (mask) { const int ex = __builtin_ctzll(mask); mask &= mask - 1; const int s = __builtin_amdgcn_readlane(sl[q], ex); yr[k] = YB + (size_t)((ex * 8 + b) * CAP + s) * 1024; }
                        else yr[k] = ZROW;
                    }
                    u32x4 y[4][2];
#pragma unroll
                    for (int k = 0; k < 4; ++k)
#pragma unroll
                        for (int h = 0; h < 2; ++h) y[k][h] = *(const u32x4*)(yr[k] + 512 * h + 8 * lane);
#pragma unroll
                    for (int k = 0; k < 4; ++k)
#pragma unroll
                        for (int h = 0; h < 2; ++h) { const u32x4 w = y[k][h];
                            acc[q][2 * h] += (f32x4){bf2f(w.x & 0xffffu), bf2f(w.x >> 16), bf2f(w.y & 0xffffu), bf2f(w.y >> 16)};
                            acc[q][2 * h + 1] += (f32x4){bf2f(w.z & 0xffffu), bf2f(w.z >> 16), bf2f(w.w & 0xffffu), bf2f(w.w >> 16)}; }
                    if (!mask) break;
                }
            }
#pragma unroll
            for (int q = 0; q < 2; ++q) {
                float ss = 0.f;
#pragma unroll
                for (int h = 0; h < 2; ++h)
#pragma unroll
                    for (int u4 = 0; u4 < 2; ++u4) { const int col = 512 * h + 8 * lane + 4 * u4; f32x4& v = xv[q][2 * h + u4]; v = v + g2v[2 * h + u4] * acc[q][2 * h + u4]; ss += (v.x * v.x + v.y * v.y) + (v.z * v.z + v.w * v.w); }
                const float rstd = 1.0f / sqrtf(wave_sum(ss) * (1.f / 1024.f) + EPS);
#pragma unroll
                for (int h = 0; h < 2; ++h)
#pragma unroll
                    for (int u4 = 0; u4 < 2; ++u4) { const int col = 512 * h + 8 * lane + 4 * u4; *(f32x4*)(args.out + (size_t)(row0 + q) * 1024 + col) = xv[q][2 * h + u4] * rstd * fgv[2 * h + u4]; }
            }
        }
    }
#undef IN
}

extern "C" void kernel_launch(void* const* d_in, const int* in_sizes, int n_in, void* d_out, int out_size, void* d_ws, size_t ws_size, hipStream_t stream) {
    static int grid = 0;
    if (grid == 0) {
        if (n_in != 23 || in_sizes[0] != NTOK * DM || out_size != NTOK * DM || ws_size < WS_END) {
            fprintf(stderr, "kernel_launch: unexpected problem (n_in %d, in0 %d, out %d, ws %zu < %zu?)\n", n_in, n_in > 0 ? in_sizes[0] : -1, out_size, ws_size, (size_t)WS_END); grid = -1; return; }
        if (hipFuncSetAttribute((const void*)fwd, hipFuncAttributeMaxDynamicSharedMemorySize, LDS_BYTES) != hipSuccess) { fprintf(stderr, "kernel_launch: hipFuncSetAttribute failed\n"); grid = -1; return; }
        int dev = 0, cus = 0;
        if (hipGetDevice(&dev) != hipSuccess || hipDeviceGetAttribute(&cus, hipDeviceAttributeMultiprocessorCount, dev) != hipSuccess) { grid = -1; return; }
        grid = cus;
    }
    if (grid < 0) return;
    (void)hipMemsetAsync((char*)d_ws + WS_CTL, 0, 1 * MiB, stream);
    Args a{};
    for (int i = 0; i < 23; ++i) a.in[i] = (const float*)d_in[i];
    a.out = (float*)d_out; a.ws = (unsigned char*)d_ws;
    if (ONE_LAUNCH) {
        a.ph_lo = 0; a.ph_hi = PH_COUNT;
        hipLaunchKernelGGL(fwd, dim3(grid), dim3(NTHREADS), LDS_BYTES, stream, a);
    } else {
        static const int seq[] = {PROBE_SEQ};
        for (unsigned i = 0; i < sizeof(seq) / sizeof(seq[0]); ++i) {
            a.ph_lo = seq[i] % 100; a.ph_hi = seq[i] % 100 + 1; a.flags = seq[i] / 100;
            hipLaunchKernelGGL(fwd, dim3(grid), dim3(NTHREADS), LDS_BYTES, stream, a);
        }
    }
}
```

```cpp
#include <hip/hip_runtime.h>
#include <cstdio>
#include <cstdint>

#define LAS __attribute__((address_space(3)))
typedef unsigned short bf16_t;
typedef float f32x4 __attribute__((ext_vector_type(4)));
typedef float f32x2 __attribute__((ext_vector_type(2)));
typedef unsigned u32x4 __attribute__((ext_vector_type(4)));
typedef unsigned u32x2 __attribute__((ext_vector_type(2)));
typedef int i32x4 __attribute__((ext_vector_type(4)));

constexpr int DM = 1024, NB = 8, SEQ = 4096, NTOK = NB * SEQ, CTXL = 256, NCTX = NB * CTXL, NROWS_H = NTOK + NCTX;
constexpr int INCOLS = 5632, OFF_Q = 2048, OFF_K = 3072, OFF_VB = 3328, OFF_GATE = 3584;
constexpr int NE = 16, CAP = 512, DE = 2048, NPAIR = NE * NB * CAP;
constexpr float EPS = 1e-6f, LOG2E = 1.4426950408889634f, C2 = 0.125f * LOG2E;
constexpr int NTHREADS = 512, NWAVES = 8;

constexpr size_t MiB = 1u << 20;
constexpr size_t WS_CTL = 0;
constexpr size_t WS_MOD = 1 * MiB;
constexpr size_t WS_ROPE = 1 * MiB + 512 * 1024;
constexpr size_t WS_AFFT = 2 * MiB;
constexpr size_t WS_TOPI = 4 * MiB;
constexpr size_t WS_TOPW = 4 * MiB + 512 * 1024;
constexpr size_t WS_SLOT = 5 * MiB;
constexpr size_t WS_WSP = 7 * MiB;
constexpr size_t WS_WIN = 8 * MiB;
constexpr size_t WS_WAB = 19 * MiB;
constexpr size_t WS_WO = 23 * MiB;
constexpr size_t WS_R = 25 * MiB;
constexpr size_t WS_H = WS_R;
constexpr size_t WS_VA = WS_R + 68 * MiB;
constexpr size_t WS_KB = WS_VA + 64 * MiB;
constexpr size_t WS_VB = WS_KB + 17 * MiB;
constexpr size_t WS_G = WS_VB + 17 * MiB;
constexpr size_t WS_Y = WS_G + 128 * MiB;
constexpr size_t WS_TMP = WS_Y + 128 * MiB;
constexpr size_t WS_STATS = 2 * MiB;
constexpr size_t WS_MERGED = WS_H;
constexpr size_t WS_WGU = WS_TMP;
constexpr size_t WS_WD = WS_VA;
constexpr size_t WS_H2 = WS_R;
constexpr size_t WS_ACT = WS_G;
constexpr size_t WS_YB = WS_WGU;
constexpr size_t WS_END = 575 * MiB;
static_assert(WS_STATS + 4 * MiB <= WS_WSP && WS_ACT + 256 * MiB == WS_TMP && WS_WGU + 128 * MiB == WS_END && WS_H2 + 64 * MiB <= WS_WD, "ws map");

constexpr int LDS_BYTES = 147456;

__device__ __forceinline__ float bf2f(unsigned b) { return __uint_as_float(b << 16); }
__device__ __forceinline__ unsigned f2bf(float f) { unsigned u = __float_as_uint(f); return (u + 0x7fffu + ((u >> 16) & 1u)) >> 16; }
__device__ __forceinline__ unsigned pk2(float lo, float hi) { typedef float f2_ __attribute__((ext_vector_type(2))); typedef __bf16 b2_ __attribute__((ext_vector_type(2))); f2_ v = {lo, hi}; b2_ b = __builtin_convertvector(v, b2_); return __builtin_bit_cast(unsigned, b); }
__device__ __forceinline__ void st4bf(bf16_t* p, f32x4 v) { u32x2 w; w.x = pk2(v.x, v.y); w.y = pk2(v.z, v.w); *(u32x2*)p = w; }
__device__ __forceinline__ void st8bf(bf16_t* p, f32x4 a, f32x4 b) { u32x4 w; w.x = pk2(a.x, a.y); w.y = pk2(a.z, a.w); w.z = pk2(b.x, b.y); w.w = pk2(b.z, b.w); *(u32x4*)p = w; }
__device__ __forceinline__ void ld8bf(const bf16_t* p, f32x4& a, f32x4& b) { const u32x4 w = *(const u32x4*)p; a.x = bf2f(w.x & 0xffffu); a.y = bf2f(w.x >> 16); a.z = bf2f(w.y & 0xffffu); a.w = bf2f(w.y >> 16); b.x = bf2f(w.z & 0xffffu); b.y = bf2f(w.z >> 16); b.z = bf2f(w.w & 0xffffu); b.w = bf2f(w.w >> 16); }
__device__ __forceinline__ f32x4 ld4bf(const bf16_t* p) { const u32x2 w = *(const u32x2*)p; f32x4 v; v.x = bf2f(w.x & 0xffffu); v.y = bf2f(w.x >> 16); v.z = bf2f(w.y & 0xffffu); v.w = bf2f(w.y >> 16); return v; }
__device__ __forceinline__ float sigmoidf_(float x) { return __builtin_amdgcn_rcpf(1.f + __builtin_amdgcn_exp2f(x * -1.4426950409f)); }
__device__ __forceinline__ float siluf_(float x) { return x * __builtin_amdgcn_rcpf(1.f + __builtin_amdgcn_exp2f(x * -1.4426950409f)); }
__device__ __forceinline__ float gelu_t(float x) { const float t = x * __builtin_fmaf(x * x, -0.10294324f, -2.3022082f); return x * __builtin_amdgcn_rcpf(1.f + __builtin_amdgcn_exp2f(t)); }
__device__ __forceinline__ f32x2 rcp2_(f32x2 d) { f32x2 r; r.x = __builtin_amdgcn_rcpf(d.x); r.y = __builtin_amdgcn_rcpf(d.y); return r; }
__device__ __forceinline__ f32x2 exp2_2_(f32x2 t) { f32x2 e; e.x = __builtin_amdgcn_exp2f(t.x); e.y = __builtin_amdgcn_exp2f(t.y); return e; }
__device__ __forceinline__ f32x2 gelu2_(f32x2 x) { const f32x2 t = x * ((x * x) * -0.10294324f + -2.3022082f); return x * rcp2_(exp2_2_(t) + 1.0f); }
__device__ __forceinline__ f32x2 sigm2_(f32x2 x) { return rcp2_(exp2_2_(x * -1.4426950409f) + 1.0f); }
__device__ __forceinline__ f32x4 gelu4_(f32x4 v) { const f32x2 a = gelu2_((f32x2){v.x, v.y}), b = gelu2_((f32x2){v.z, v.w}); return (f32x4){a.x, a.y, b.x, b.y}; }
__device__ __forceinline__ f32x4 sigm4_(f32x4 v) { const f32x2 a = sigm2_((f32x2){v.x, v.y}), b = sigm2_((f32x2){v.z, v.w}); return (f32x4){a.x, a.y, b.x, b.y}; }
template <int CTRL> __device__ __forceinline__ float dpp_f(float v) { const int i = __builtin_bit_cast(int, v); return __builtin_bit_cast(float, __builtin_amdgcn_update_dpp(i, i, CTRL, 0xf, 0xf, true)); }
__device__ __forceinline__ float xchg16(float v) { auto r = __builtin_amdgcn_permlane16_swap(__float_as_uint(v), __float_as_uint(v), false, false); return __uint_as_float((threadIdx.x & 16) ? r[0] : r[1]); }
__device__ __forceinline__ float xchg32(float v) { auto r = __builtin_amdgcn_permlane32_swap(__float_as_uint(v), __float_as_uint(v), false, false); return __uint_as_float((threadIdx.x & 32) ? r[0] : r[1]); }
__device__ __forceinline__ float wave_sum(float v) {
    v += dpp_f<0xB1>(v); v += dpp_f<0x4E>(v); v += dpp_f<0x141>(v); v += dpp_f<0x140>(v); v += xchg16(v); v += xchg32(v);
    return v;
}
__device__ __forceinline__ int wave_sum_i(int v) {
#pragma unroll
    for (int o = 1; o < 64; o <<= 1) v += __shfl_xor(v, o);
    return v;
}
#define LDS_WAIT() asm volatile("s_waitcnt lgkmcnt(0)" ::: "memory")

struct Args { const float* in[23]; float* out; unsigned char* ws; int ph_lo, ph_hi, flags, pad; };
enum { I_X = 0, I_C, I_CTX, I_CCTX, I_WADA, I_BADA, I_N1G, I_WIN, I_BMG, I_LNG, I_LNB, I_WSP, I_BSP, I_SINK, I_WPA, I_WPB, I_WOUT, I_N2G, I_WR, I_WEG, I_WEU, I_WED, I_FING };

struct Unit { int pm, pn; };
struct Gemm {
    const bf16_t* A; const bf16_t* Bt; int lda, ldb, K;
    size_t bgs; int tpg_shift;
    const int* gidx;
    int bmap = 0;
};
constexpr int NXCD = 8, WGM = 8;
struct StaticOrder {
    int nM, nN, nwg, G, c, extra, rev;
    __device__ void init(int M, int N, int G_, int c_, int extra_ = 0, int rev_ = 0) { nM = M / 256; nN = N / 256; nwg = nM * nN; G = G_; c = c_; extra = extra_; rev = rev_; }
    __device__ bool next(int i, Unit& u) const {
        const long L = (long)i * G + c;
        if (L >= nwg) { const int x = (int)(L - nwg); if (x >= extra) return false; u.pm = NTOK / 256 + (x >> 1); u.pn = 12 + (x & 1); return true; }
        int wgid = (int)L; { const int q = nwg / NXCD, r = nwg % NXCD, xcd = wgid % NXCD, off = wgid / NXCD; wgid = (xcd < r ? xcd * (q + 1) : r * (q + 1) + (xcd - r) * q) + off; }
        const int nig = WGM * nN, gid = wgid / nig, fm = gid * WGM, gsz = (nM - fm) < WGM ? (nM - fm) : WGM;
        u.pm = fm + ((wgid % nig) % gsz); u.pn = (wgid % nig) / gsz; if (rev) u.pm = nM - 1 - u.pm; return true;
    }
};

template <class S_> struct RangeSched { const S_& s; int i0, i1; __device__ bool next(int i, Unit& u) const { return (i0 + i < i1) && s.next(i0 + i, u); } };
struct OneUnit { int pm, pn; __device__ bool next(int i, Unit& u) const { if (i) return false; u.pm = pm; u.pn = pn; return true; } };

typedef f32x4 Acc[2][2][4][2];

namespace pg8 {
typedef short bf16x8 __attribute__((ext_vector_type(8)));
constexpr int BK = 64, HALF = 128, HTB = HALF * BK * 2, STAGE_BYTES = 8 * HTB;
__device__ __forceinline__ int lds_byte(int r, int c) { const int st = (r >> 4) * 2 + (c >> 5), rr = r & 15, cc = c & 31, ob = rr * 64 + cc * 2; return st * 1024 + (ob ^ (((ob >> 9) & 1) << 5)); }
__device__ __forceinline__ void stage_rc(int b, int& R, int& C) { const int st = b / 1024, sb = b % 1024, swz = sb ^ (((sb >> 9) & 1) << 5); R = (st >> 1) * 16 + swz / 64; C = (st & 1) * 32 + (swz % 64) / 2; }

template <class Epi, class Sched, bool GATHER, bool HOOK = false, bool RELAX = false>
__device__ __forceinline__ void gemm_phase(LAS unsigned char* lds, const Gemm g, const Sched& S, const Epi& E) {
    int tid_ = threadIdx.x; asm volatile("" : "+v"(tid_));
    const int tid = tid_, wid = __builtin_amdgcn_readfirstlane(tid >> 6), lane = tid & 63, wr = wid >> 2, wc = wid & 3, fr = lane & 15, fq = lane >> 4;
    const int nt = g.K / BK;
    int Rs[2], Cs[2]; unsigned voffBp[2][2], voffB[2], voffBn[2], vA[2][2], vN[2][2];
#pragma unroll
    for (int i = 0; i < 2; ++i) { stage_rc(tid * 16 + i * 8192, Rs[i], Cs[i]); { const int Rn = g.bmap ? 64 * (Rs[i] >> 5) + (Rs[i] & 31) : Rs[i]; voffBp[0][i] = (unsigned)(Rn * g.ldb + Cs[i]) * 2u; }
        const int rho = Rs[i] & 31, Rb = (Rs[i] & ~31) + 8 * ((rho & 15) >> 2) + 4 * (rho >> 4) + (rho & 3); { const int Rn = g.bmap ? 64 * (Rb >> 5) + (Rb & 31) : Rb; voffBp[1][i] = (unsigned)(Rn * g.ldb + Cs[i]) * 2u; } }
    const size_t kstep = (size_t)(BK * 2);
    const size_t hstepB = (size_t)(g.bmap ? 32 : HALF) * g.ldb * 2;
    const unsigned ldsw = (unsigned)wid * 1024u;
    const int aoff = lds_byte(wr * 64 + fr, fq * 8), boff = lds_byte(wc * 32 + fr, fq * 8);
#define PG8_SA(b, h) (((b) * 2 + (h)) * HTB)
#define PG8_SB(b, h) ((4 + (b) * 2 + (h)) * HTB)
#define PG8_STAGE(bufoff, gbase, voff) do { _Pragma("unroll") for (int _i = 0; _i < 2; ++_i) \
        __builtin_amdgcn_global_load_lds((const unsigned*)((const char*)(gbase) + (voff)[_i]), (LAS unsigned*)(lds + (bufoff) + ldsw + _i * 8192), 16, 0, 0); } while (0)
#define PG8_LDA(dst, b, h) do { _Pragma("unroll") for (int m = 0; m < 4; ++m) _Pragma("unroll") for (int k = 0; k < 2; ++k) dst[m][k] = *(const LAS bf16x8*)(lds + PG8_SA(b, h) + aoff + m * 2048 + k * 1024); } while (0)
#define PG8_LDB(dst, b, h) do { _Pragma("unroll") for (int n = 0; n < 2; ++n) _Pragma("unroll") for (int k = 0; k < 2; ++k) dst[n][k] = *(const LAS bf16x8*)(lds + PG8_SB(b, h) + boff + n * 2048 + k * 1024); } while (0)
#define PG8_MMA(ai, bj, At, Bt) do { __builtin_amdgcn_s_setprio(1); _Pragma("unroll") for (int m = 0; m < 4; ++m) _Pragma("unroll") for (int n = 0; n < 2; ++n) _Pragma("unroll") for (int k = 0; k < 2; ++k) \
        acc[ai][bj][m][n] = __builtin_amdgcn_mfma_f32_16x16x32_bf16(Bt[n][k], At[m][k], acc[ai][bj][m][n], 0, 0, 0); __builtin_amdgcn_s_setprio(0); } while (0)
#define PG8_WAIT_V(n) asm volatile("s_waitcnt vmcnt(" #n ")" ::: "memory")
#define PG8_WAIT_L(n) asm volatile("s_waitcnt lgkmcnt(" #n ")" ::: "memory")
#define PG8_BAR __builtin_amdgcn_s_barrier()
#define PG8_SCHED __builtin_amdgcn_sched_barrier(0)
#define PG8_AVOFF(dst, U) do { _Pragma("unroll") for (int _h = 0; _h < 2; ++_h) _Pragma("unroll") for (int _i = 0; _i < 2; ++_i) \
        dst[_h][_i] = GATHER ? (unsigned)((((U).pm >> 1) & 7) * SEQ + g.gidx[(U).pm * 256 + _h * 128 + Rs[_i]]) * (unsigned)(g.lda * 2) + (unsigned)(Cs[_i] * 2) \
                             : (unsigned)((_h * 128 + Rs[_i]) * g.lda + Cs[_i]) * 2u; } while (0)
#define PG8_ABASE(U) ((const char*)g.A + (GATHER ? (size_t)0 : (size_t)(U).pm * 256 * g.lda * 2))
#define PG8_BBASE(U) ((const char*)g.Bt + ((size_t)((U).pm >> g.tpg_shift) * g.bgs + (size_t)(U).pn * 256 * g.ldb) * 2)
    Unit cur, nxt; int ui = 0;
    if (!S.next(0, cur)) return;
    Acc acc;
#pragma unroll
    for (int a = 0; a < 2; ++a)
#pragma unroll
        for (int b = 0; b < 2; ++b)
#pragma unroll
            for (int m = 0; m < 4; ++m)
#pragma unroll
                for (int n = 0; n < 2; ++n) acc[a][b][m][n] = (f32x4){0.f, 0.f, 0.f, 0.f};
    bf16x8 At[4][2], B0[2][2], B1[2][2];
    PG8_AVOFF(vA, cur);
    { const bool pc = E.perm(cur); voffB[0] = pc ? voffBp[1][0] : voffBp[0][0]; voffB[1] = pc ? voffBp[1][1] : voffBp[0][1]; }
    const char* cA = PG8_ABASE(cur); const char* cB = PG8_BBASE(cur);
    PG8_STAGE(PG8_SB(0, 0), cB, voffB); PG8_STAGE(PG8_SB(0, 1), cB + hstepB, voffB); PG8_STAGE(PG8_SA(0, 0), cA, vA[0]); PG8_STAGE(PG8_SA(0, 1), cA, vA[1]);
    if (wr == 1) PG8_BAR;
    PG8_WAIT_V(2); PG8_BAR;
    PG8_STAGE(PG8_SB(1, 0), cB + kstep, voffB); PG8_STAGE(PG8_SA(1, 0), cA + kstep, vA[0]); PG8_STAGE(PG8_SB(1, 1), cB + hstepB + kstep, voffB);
    if constexpr (RELAX) { PG8_WAIT_V(0); } else { PG8_WAIT_V(6); } PG8_BAR;
    for (;;) {
        const bool has_next = S.next(ui + 1, nxt);
        const char* nA = has_next ? PG8_ABASE(nxt) : cA; const char* nB = has_next ? PG8_BBASE(nxt) : cB;
        { const bool pn_ = has_next ? E.perm(nxt) : E.perm(cur); voffBn[0] = pn_ ? voffBp[1][0] : voffBp[0][0]; voffBn[1] = pn_ ? voffBp[1][1] : voffBp[0][1]; }
        if (GATHER) {
#pragma unroll
            for (int h = 0; h < 2; ++h)
#pragma unroll
                for (int i = 0; i < 2; ++i) vN[h][i] = vA[h][i];
            if (has_next && wid == 0)
                __builtin_amdgcn_global_load_lds((const unsigned*)(g.gidx + nxt.pm * 256 + lane * 4), (LAS unsigned*)(lds + STAGE_BYTES + (ui & 1) * 1024), 16, 0, 0);
        }
        if constexpr (RELAX) {
#define PG8_WAIT_RELAX asm volatile("s_waitcnt vmcnt(%0)" :: "n"(8 + Epi::kStores) : "memory")
            const char* a1 = cA + kstep; const char* a2 = cA + 2 * kstep; const char* b2 = cB + 2 * kstep; const char* a3 = a2 + kstep; const char* b3 = b2 + kstep;
            PG8_LDB(B0, 0, 0); PG8_LDB(B1, 0, 1); PG8_SCHED; PG8_LDA(At, 0, 0); PG8_STAGE(PG8_SA(1, 1), a1, vA[1]);
            PG8_WAIT_RELAX; PG8_WAIT_L(0); PG8_BAR; PG8_MMA(0, 0, At, B0); PG8_MMA(0, 1, At, B1); PG8_BAR; PG8_SCHED;
            PG8_LDA(At, 0, 1); PG8_STAGE(PG8_SB(0, 0), b2, voffB); PG8_STAGE(PG8_SB(0, 1), b2 + hstepB, voffB); PG8_STAGE(PG8_SA(0, 0), a2, vA[0]);
            PG8_WAIT_RELAX; PG8_WAIT_L(0); PG8_BAR; PG8_MMA(1, 0, At, B0); PG8_MMA(1, 1, At, B1); PG8_BAR; PG8_SCHED;
            PG8_LDB(B0, 1, 0); PG8_LDB(B1, 1, 1); PG8_SCHED; PG8_LDA(At, 1, 0); PG8_STAGE(PG8_SA(0, 1), a2, vA[1]);
            PG8_WAIT_V(8); PG8_WAIT_L(0); PG8_BAR; PG8_MMA(0, 0, At, B0); PG8_MMA(0, 1, At, B1); PG8_BAR; PG8_SCHED;
            PG8_LDA(At, 1, 1); PG8_STAGE(PG8_SB(1, 0), b3, voffB); PG8_STAGE(PG8_SB(1, 1), b3 + hstepB, voffB); PG8_STAGE(PG8_SA(1, 0), a3, vA[0]);
            PG8_WAIT_V(8); PG8_WAIT_L(0); PG8_BAR; PG8_MMA(1, 0, At, B0); PG8_MMA(1, 1, At, B1); PG8_BAR; PG8_SCHED;
#undef PG8_WAIT_RELAX
        }
        for (int t = RELAX ? 2 : 0; t < nt; t += 2) {
            const bool last = (t == nt - 2);
            if (GATHER) { if (t == 4 && has_next) {
                const LAS int* li = (const LAS int*)(lds + STAGE_BYTES + (ui & 1) * 1024);
#pragma unroll
                for (int h = 0; h < 2; ++h)
#pragma unroll
                    for (int i = 0; i < 2; ++i) vN[h][i] = (unsigned)(((nxt.pm >> 1) & 7) * SEQ + li[h * 128 + Rs[i]]) * (unsigned)(g.lda * 2) + (unsigned)(Cs[i] * 2);
            } }
            if constexpr (HOOK) { if (t == (nt >> 1)) E.mid(acc, cur, wr, wc, fr, fq); }
            const char* a1 = cA + (size_t)(t + 1) * kstep;
            const char* a2 = last ? nA : cA + (size_t)(t + 2) * kstep; const char* b2 = last ? nB : cB + (size_t)(t + 2) * kstep;
            const char* a3 = a2 + kstep; const char* b3 = b2 + kstep;
            unsigned v2[2][2];
#pragma unroll
            for (int h = 0; h < 2; ++h)
#pragma unroll
                for (int i = 0; i < 2; ++i) v2[h][i] = (GATHER && last) ? vN[h][i] : vA[h][i];
            unsigned vb2[2]; vb2[0] = last ? voffBn[0] : voffB[0]; vb2[1] = last ? voffBn[1] : voffB[1];
            PG8_LDB(B0, 0, 0); PG8_LDB(B1, 0, 1); PG8_SCHED; PG8_LDA(At, 0, 0); PG8_STAGE(PG8_SA(1, 1), a1, vA[1]);
            PG8_WAIT_V(8); PG8_WAIT_L(0); PG8_BAR; PG8_MMA(0, 0, At, B0); PG8_MMA(0, 1, At, B1); PG8_BAR; PG8_SCHED;
            PG8_LDA(At, 0, 1); PG8_STAGE(PG8_SB(0, 0), b2, vb2); PG8_STAGE(PG8_SB(0, 1), b2 + hstepB, vb2); PG8_STAGE(PG8_SA(0, 0), a2, v2[0]);
            PG8_WAIT_V(8); PG8_WAIT_L(0); PG8_BAR; PG8_MMA(1, 0, At, B0); PG8_MMA(1, 1, At, B1); PG8_BAR; PG8_SCHED;
            PG8_LDB(B0, 1, 0); PG8_LDB(B1, 1, 1); PG8_SCHED; PG8_LDA(At, 1, 0); PG8_STAGE(PG8_SA(0, 1), a2, v2[1]);
            PG8_WAIT_V(8); PG8_WAIT_L(0); PG8_BAR; PG8_MMA(0, 0, At, B0); PG8_MMA(0, 1, At, B1); PG8_BAR; PG8_SCHED;
            PG8_LDA(At, 1, 1); PG8_STAGE(PG8_SB(1, 0), b3, vb2); PG8_STAGE(PG8_SB(1, 1), b3 + hstepB, vb2); PG8_STAGE(PG8_SA(1, 0), a3, v2[0]);
            PG8_WAIT_V(8); PG8_WAIT_L(0); PG8_BAR; PG8_MMA(1, 0, At, B0); PG8_MMA(1, 1, At, B1); PG8_BAR; PG8_SCHED;
        }
        if (wr == 0) PG8_BAR;
        E(acc, cur, wr, wc, fr, fq);
        if (!has_next) break;
#pragma unroll
        for (int a = 0; a < 2; ++a)
#pragma unroll
            for (int b = 0; b < 2; ++b)
#pragma unroll
                for (int m = 0; m < 4; ++m)
#pragma unroll
                    for (int n = 0; n < 2; ++n) acc[a][b][m][n] = (f32x4){0.f, 0.f, 0.f, 0.f};
        cur = nxt; cA = nA; cB = nB; ++ui; voffB[0] = voffBn[0]; voffB[1] = voffBn[1];
        if (GATHER) {
#pragma unroll
            for (int h = 0; h < 2; ++h)
#pragma unroll
                for (int i = 0; i < 2; ++i) vA[h][i] = vN[h][i];
        }
        if (wr == 1) PG8_BAR;
    }
    PG8_WAIT_V(0);
    PG8_BAR;
#undef PG8_SA
#undef PG8_SB
#undef PG8_STAGE
#undef PG8_LDA
#undef PG8_LDB
#undef PG8_MMA
#undef PG8_WAIT_V
#undef PG8_WAIT_L
#undef PG8_BAR
#undef PG8_SCHED
#undef PG8_AVOFF
#undef PG8_ABASE
#undef PG8_BBASE
}
}

#define GEMM_PHASE pg8::gemm_phase

__device__ __forceinline__ void trade8(const u32x4 c0, const u32x4 c1, const bool hi8, u32x4& lo, u32x4& hi) {
    const u32x4 snd = hi8 ? c0 : c1; u32x4 rcv;
    rcv.x = (unsigned)__builtin_amdgcn_update_dpp(0, (int)snd.x, 0x128, 0xf, 0xf, true); rcv.y = (unsigned)__builtin_amdgcn_update_dpp(0, (int)snd.y, 0x128, 0xf, 0xf, true);
    rcv.z = (unsigned)__builtin_amdgcn_update_dpp(0, (int)snd.z, 0x128, 0xf, 0xf, true); rcv.w = (unsigned)__builtin_amdgcn_update_dpp(0, (int)snd.w, 0x128, 0xf, 0xf, true);
    lo = hi8 ? rcv : c0; hi = hi8 ? c1 : rcv;
}
__device__ __forceinline__ u32x4 pk8(const f32x4 a, const f32x4 b) { return (u32x4){pk2(a.x, a.y), pk2(a.z, a.w), pk2(b.x, b.y), pk2(b.z, b.w)}; }
struct EpiIn {
    bf16_t *Y, *VA, *KB, *VB, *G; const float* bgate; const f32x2* rope; f32x2* STATS;
    static constexpr int kStores = 16;
    __device__ __forceinline__ bool perm(const Unit& u) const { return u.pn < 8 || u.pn > 12; }
    template <int KIND> __device__ __forceinline__ void run(const Acc& acc, const Unit& u, int wr, int wc, int fr, int fq) const {
        const int pn = u.pn;
        f32x4 bga0 = {}, bga1 = {}, bgb0 = {}, bgb1 = {};
        if constexpr (KIND == 4) { const int ch = (pn - 14) * 128 + wc * 32 + 8 * fq; bga0 = *(const f32x4*)(bgate + ch); bga1 = *(const f32x4*)(bgate + ch + 4); bgb0 = *(const f32x4*)(bgate + 1024 + ch); bgb1 = *(const f32x4*)(bgate + 1024 + ch + 4); }
#pragma unroll
        for (int ai = 0; ai < 2; ++ai) {
        f32x2 rcs[4][4];
        if constexpr (KIND == 2) {
#pragma unroll
            for (int m = 0; m < 4; ++m) { const int row = u.pm * 256 + ai * 128 + wr * 64 + m * 16 + fr, t = row & (SEQ - 1), pos = (row < NTOK) ? ((wc & 1) ? (t & 63) : (t >> 6)) : 0; const f32x2* rp = rope + pos * 16 + 4 * fq;
#pragma unroll
                for (int j = 0; j < 4; ++j) rcs[m][j] = rp[j]; }
        }
#pragma unroll
            for (int m = 0; m < 4; ++m) {
                const int row = u.pm * 256 + ai * 128 + wr * 64 + m * 16 + fr;
                float ssum = 0.f, ssq = 0.f;
#pragma unroll
                for (int bj = 0; bj < 2; ++bj) {
                    f32x4 v0 = acc[ai][bj][m][0], v1 = acc[ai][bj][m][1];
                    if constexpr (KIND == 0 || KIND == 1) {
                        const int c8 = bj * 128 + wc * 32 + 8 * fq;
                        v0 = gelu4_(v0); v1 = gelu4_(v1);
                        if constexpr (KIND == 0) st8bf(Y + (size_t)row * 2048 + pn * 256 + c8, v0, v1);
                        else {
                            st8bf(VA + (size_t)row * 1024 + (pn - 4) * 256 + c8, v0, v1);
                            ssum += ((v0.x + v0.y) + (v0.z + v0.w)) + ((v1.x + v1.y) + (v1.z + v1.w));
                            ssq += ((v0.x * v0.x + v0.y * v0.y) + (v0.z * v0.z + v0.w * v0.w)) + ((v1.x * v1.x + v1.y * v1.y) + (v1.z * v1.z + v1.w * v1.w));
                        }
                    } else if constexpr (KIND == 2) {
                        const int cl = bj * 128 + wc * 32 + 4 * fq;
                        f32x4 o0 = v0, o1 = v1;
                        if (row < NTOK) {
#pragma unroll
                            for (int j = 0; j < 4; ++j) { const f32x2 cs = rcs[m][j]; o0[j] = v0[j] * cs.x - v1[j] * cs.y; o1[j] = v0[j] * cs.y + v1[j] * cs.x; }
                        }
                        if (pn < 12) { o0 = o0 * C2; o1 = o1 * C2; }
                        const auto rx = __builtin_amdgcn_permlane16_swap(pk2(o0.x, o0.y), pk2(o1.x, o1.y), false, false);
                        const auto ry = __builtin_amdgcn_permlane16_swap(pk2(o0.z, o0.w), pk2(o1.z, o1.w), false, false);
                        const u32x4 w = {rx[0], ry[0], rx[1], ry[1]};
                        const int cw = cl + ((fq & 1) ? 12 : 0);
                        if (pn < 12) *(u32x4*)(Y + (size_t)row * 2048 + 1024 + (pn - 8) * 256 + cw) = w;
                        else *(u32x4*)(KB + (size_t)row * 256 + cw) = w;
                    } else if constexpr (KIND == 3) {
                        st8bf(VB + (size_t)row * 256 + bj * 128 + wc * 32 + 8 * fq, v0, v1);
                    } else {
                        if (bj == 0) {
                            const int ch = (pn - 14) * 128 + wc * 32 + 8 * fq;
                            const f32x4 a0 = sigm4_(v0 + bga0), a1 = sigm4_(v1 + bga1);
                            const f32x4 g0 = sigm4_(acc[ai][1][m][0] + bgb0), g1 = sigm4_(acc[ai][1][m][1] + bgb1);
                            f32x4 r0, r1;
#pragma unroll
                            for (int j = 0; j < 4; ++j) { r0[j] = a0[j] * __builtin_amdgcn_rcpf(g0[j]); r1[j] = a1[j] * __builtin_amdgcn_rcpf(g1[j]); }
                            st8bf(G + (size_t)row * 2048 + ch, r0, r1); st8bf(G + (size_t)row * 2048 + 1024 + ch, g0, g1);
                        }
                    }
                }
                if constexpr (KIND == 1) {
                    ssum += xchg16(ssum); ssum += xchg32(ssum); ssq += xchg16(ssq); ssq += xchg32(ssq);
                    if (fq == 0) STATS[(size_t)row * 16 + (pn - 4) * 4 + wc] = (f32x2){ssum, ssq};
                }
            }
        }
    }
    __device__ __forceinline__ void operator()(const Acc& acc, const Unit& u, int wr, int wc, int fr, int fq) const {
        const int pn = u.pn;
        if (pn < 4) run<0>(acc, u, wr, wc, fr, fq);
        else if (pn < 8) run<1>(acc, u, wr, wc, fr, fq);
        else if (pn < 13) run<2>(acc, u, wr, wc, fr, fq);
        else if (pn == 13) run<3>(acc, u, wr, wc, fr, fq);
        else run<4>(acc, u, wr, wc, fr, fq);
    }
};
struct EpiAB {
    bf16_t* MERGED; const bf16_t* G;
    static constexpr int kStores = 16;
    __device__ __forceinline__ bool perm(const Unit&) const { return true; }
    __device__ __forceinline__ void mid(Acc& acc, const Unit& u, int wr, int wc, int fr, int fq) const {
        int zero; asm volatile("v_mov_b32 %0, 0" : "=v"(zero));
        const bf16_t* gp = G + (size_t)(u.pm * 256 + wr * 64 + fr + zero) * 2048 + u.pn * 256 + wc * 64 + 8 * fq;
#pragma unroll
        for (int ai = 0; ai < 2; ++ai)
#pragma unroll
            for (int mh = 0; mh < 2; ++mh) {
                u32x4 raw[2][2];
#pragma unroll
                for (int ml = 0; ml < 2; ++ml)
#pragma unroll
                    for (int bj = 0; bj < 2; ++bj) raw[ml][bj] = *(const u32x4*)(gp + (size_t)(ai * 128 + (2 * mh + ml) * 16) * 2048 + bj * 32);
#pragma unroll
                for (int ml = 0; ml < 2; ++ml)
#pragma unroll
                    for (int bj = 0; bj < 2; ++bj) {
                        const u32x4 w = raw[ml][bj]; const int m = 2 * mh + ml;
                        const f32x4 r0 = {__uint_as_float(w.x << 16), __uint_as_float(w.x & 0xffff0000u), __uint_as_float(w.y << 16), __uint_as_float(w.y & 0xffff0000u)};
                        const f32x4 r1 = {__uint_as_float(w.z << 16), __uint_as_float(w.z & 0xffff0000u), __uint_as_float(w.w << 16), __uint_as_float(w.w & 0xffff0000u)};
                        acc[ai][bj][m][0] *= r0; acc[ai][bj][m][1] *= r1;
                    }
                asm volatile("" ::: "memory");
            }
    }
    __device__ __forceinline__ void operator()(const Acc& acc, const Unit& u, int wr, int wc, int fr, int fq) const {
#pragma unroll
        for (int ai = 0; ai < 2; ++ai)
#pragma unroll
            for (int mh = 0; mh < 2; ++mh) {
                u32x4 raw[2][2];
#pragma unroll
                for (int ml = 0; ml < 2; ++ml)
#pragma unroll
                    for (int bj = 0; bj < 2; ++bj) raw[ml][bj] = *(const u32x4*)(G + (size_t)(u.pm * 256 + ai * 128 + wr * 64 + (2 * mh + ml) * 16 + fr) * 2048 + 1024 + u.pn * 256 + wc * 64 + bj * 32 + 8 * fq);
#pragma unroll
                for (int ml = 0; ml < 2; ++ml) {
                    const int m = 2 * mh + ml; u32x4 pc[2];
#pragma unroll
                    for (int bj = 0; bj < 2; ++bj) {
                        const u32x4 w = raw[ml][bj];
                        const f32x4 gb0 = {__uint_as_float(w.x << 16), __uint_as_float(w.x & 0xffff0000u), __uint_as_float(w.y << 16), __uint_as_float(w.y & 0xffff0000u)};
                        const f32x4 gb1 = {__uint_as_float(w.z << 16), __uint_as_float(w.z & 0xffff0000u), __uint_as_float(w.w << 16), __uint_as_float(w.w & 0xffff0000u)};
                        pc[bj] = pk8(gb0 * acc[ai][bj][m][0], gb1 * acc[ai][bj][m][1]);
                    }
                    const bool hi8 = fr & 8; u32x4 lo, hi; trade8(pc[0], pc[1], hi8, lo, hi);
                    const int rowb = u.pm * 256 + ai * 128 + wr * 64 + m * 16 + (fr & 7), ccol = u.pn * 256 + 64 * wc + (hi8 ? 32 : 0) + 8 * fq;
                    *(u32x4*)(MERGED + (size_t)rowb * 1024 + ccol) = lo; *(u32x4*)(MERGED + (size_t)(rowb + 8) * 1024 + ccol) = hi;
                }
            }
    }
};
struct EpiO {
    bf16_t* D16; const float* mod;
    static constexpr int kStores = 16;
    __device__ __forceinline__ bool perm(const Unit&) const { return true; }
    __device__ __forceinline__ void operator()(const Acc& acc, const Unit& u, int wr, int wc, int fr, int fq) const {
        const float* g1 = mod + (size_t)((u.pm * 256) >> 12) * 6144 + 2048;
        f32x4 gav[2], gbv[2];
#pragma unroll
        for (int bj = 0; bj < 2; ++bj) { const int c8 = u.pn * 256 + 64 * wc + 32 * bj + 8 * fq; gav[bj] = *(const f32x4*)(g1 + c8); gbv[bj] = *(const f32x4*)(g1 + c8 + 4); }
        const bool hi8 = fr & 8;
        const int ccol = u.pn * 256 + 64 * wc + (hi8 ? 32 : 0) + 8 * fq;
#pragma unroll
        for (int ai = 0; ai < 2; ++ai)
#pragma unroll
            for (int m = 0; m < 4; ++m) {
                const f32x4 a0 = gav[0] * acc[ai][0][m][0], a1 = gbv[0] * acc[ai][0][m][1], b0 = gav[1] * acc[ai][1][m][0], b1 = gbv[1] * acc[ai][1][m][1];
                const u32x4 c0 = {pk2(a0.x, a0.y), pk2(a0.z, a0.w), pk2(a1.x, a1.y), pk2(a1.z, a1.w)}, c1 = {pk2(b0.x, b0.y), pk2(b0.z, b0.w), pk2(b1.x, b1.y), pk2(b1.z, b1.w)};
                const u32x4 snd = hi8 ? c0 : c1; u32x4 rcv;
                rcv.x = (unsigned)__builtin_amdgcn_update_dpp(0, (int)snd.x, 0x128, 0xf, 0xf, true); rcv.y = (unsigned)__builtin_amdgcn_update_dpp(0, (int)snd.y, 0x128, 0xf, 0xf, true);
                rcv.z = (unsigned)__builtin_amdgcn_update_dpp(0, (int)snd.z, 0x128, 0xf, 0xf, true); rcv.w = (unsigned)__builtin_amdgcn_update_dpp(0, (int)snd.w, 0x128, 0xf, 0xf, true);
                const int rowb = u.pm * 256 + ai * 128 + wr * 64 + m * 16 + (fr & 7);
                *(u32x4*)(D16 + (size_t)rowb * 2048 + 1024 + ccol) = hi8 ? rcv : c0;
                *(u32x4*)(D16 + (size_t)(rowb + 8) * 2048 + 1024 + ccol) = hi8 ? c1 : rcv;
            }
    }
};
struct EpiGU {
    bf16_t* ACT;
    static constexpr int kStores = 8;
    __device__ __forceinline__ bool perm(const Unit&) const { return true; }
    __device__ __forceinline__ void operator()(const Acc& acc, const Unit& u, int wr, int wc, int fr, int fq) const {
#pragma unroll
        for (int ai = 0; ai < 2; ++ai)
#pragma unroll
            for (int m = 0; m < 4; ++m) {
                const int prow = u.pm * 256 + ai * 128 + wr * 64 + m * 16 + fr;
                f32x4 a[2];
#pragma unroll
                for (int n = 0; n < 2; ++n) {
                    const f32x4 gt = acc[ai][0][m][n], up = acc[ai][1][m][n];
                    a[n] = gt * sigm4_(gt) * up;
                }
                st8bf(ACT + (size_t)prow * 2048 + u.pn * 128 + wc * 32 + 8 * fq, a[0], a[1]);
            }
    }
};
struct EpiD {
    bf16_t* YB; const float* TOPW;
    static constexpr int kStores = 16;
    __device__ __forceinline__ bool perm(const Unit&) const { return true; }
    __device__ __forceinline__ void operator()(const Acc& acc, const Unit& u, int wr, int wc, int fr, int fq) const {
        float wv[2][4];
#pragma unroll
        for (int ai = 0; ai < 2; ++ai)
#pragma unroll
            for (int m = 0; m < 4; ++m) wv[ai][m] = TOPW[u.pm * 256 + ai * 128 + wr * 64 + m * 16 + fr];
        const bool hi8 = fr & 8; const int ccol = u.pn * 256 + 64 * wc + (hi8 ? 32 : 0) + 8 * fq;
#pragma unroll
        for (int ai = 0; ai < 2; ++ai)
#pragma unroll
            for (int m = 0; m < 4; ++m) {
                const float w = wv[ai][m]; u32x4 lo, hi;
                trade8(pk8(acc[ai][0][m][0] * w, acc[ai][0][m][1] * w), pk8(acc[ai][1][m][0] * w, acc[ai][1][m][1] * w), hi8, lo, hi);
                const int rowb = u.pm * 256 + ai * 128 + wr * 64 + m * 16 + (fr & 7);
                *(u32x4*)(YB + (size_t)rowb * 1024 + ccol) = lo; *(u32x4*)(YB + (size_t)(rowb + 8) * 1024 + ccol) = hi;
            }
    }
};

__device__ __forceinline__ void transpose_item(const float* W, int N, int k0, int n0, bf16_t* dst, int ldt, LAS float* scr, int lane) {
    const int kk = lane >> 3, nq = (lane & 7) * 4;
    f32x4 v[8];
#pragma unroll
    for (int i = 0; i < 8; ++i) v[i] = *(const f32x4*)(W + (size_t)(k0 + 8 * i + kk) * N + n0 + nq);
#pragma unroll
    for (int i = 0; i < 8; ++i) { LAS float* s = scr + (8 * i + kk) * 33 + nq; s[0] = v[i].x; s[1] = v[i].y; s[2] = v[i].z; s[3] = v[i].w; }
    LDS_WAIT();
    const int c = lane & 7;
#pragma unroll
    for (int j = 0; j < 4; ++j) {
        const int n = (lane >> 3) + 8 * j; const LAS float* s = scr + (8 * c) * 33 + n;
        u32x4 o; o.x = pk2(s[0 * 33], s[1 * 33]); o.y = pk2(s[2 * 33], s[3 * 33]); o.z = pk2(s[4 * 33], s[5 * 33]); o.w = pk2(s[6 * 33], s[7 * 33]);
        *(u32x4*)(dst + (size_t)n * ldt + 8 * c) = o;
    }
    LDS_WAIT();
}

struct TrItem { const float* src; bf16_t* dst; int N, ldt; };
__device__ __forceinline__ void tr_load(const TrItem& it, f32x4 (&v)[8], int lane) {
    const int kk = lane >> 3, nq = (lane & 7) * 4;
#pragma unroll
    for (int i = 0; i < 8; ++i) v[i] = *(const f32x4*)(it.src + (size_t)(8 * i + kk) * it.N + nq);
}
__device__ __forceinline__ void tr_store(const TrItem& it, const f32x4 (&v)[8], LAS float* scr, int lane) {
    const int kk = lane >> 3, nq = (lane & 7) * 4;
#pragma unroll
    for (int i = 0; i < 8; ++i) { LAS float* s = scr + (8 * i + kk) * 33 + nq; s[0] = v[i].x; s[1] = v[i].y; s[2] = v[i].z; s[3] = v[i].w; }
    LDS_WAIT();
    const int c = lane & 7;
#pragma unroll
    for (int j = 0; j < 4; ++j) {
        const int n = (lane >> 3) + 8 * j; const LAS float* s = scr + (8 * c) * 33 + n;
        u32x4 o; o.x = pk2(s[0 * 33], s[1 * 33]); o.y = pk2(s[2 * 33], s[3 * 33]); o.z = pk2(s[4 * 33], s[5 * 33]); o.w = pk2(s[6 * 33], s[7 * 33]);
        *(u32x4*)(it.dst + (size_t)n * it.ldt + 8 * c) = o;
    }
    LDS_WAIT();
}

__device__ __forceinline__ void adaln_task(int task, const float* c, const float* cctx, const float* w_ada, const float* b_ada, float* mod, LAS float* lds, int tid) {
    LAS float* s = lds; LAS float* red = lds + 9 * 1024;
    { float cv[18];
#pragma unroll
      for (int q = 0; q < 18; ++q) { const int i = tid + NTHREADS * q, r = i >> 10, k = i & 1023; cv[q] = r < 8 ? c[r * 1024 + k] : cctx[k]; }
#pragma unroll
      for (int q = 0; q < 18; ++q) s[tid + NTHREADS * q] = cv[q] * __builtin_amdgcn_rcpf(1.f + __expf(-cv[q])); }
    __syncthreads();
    const int ch = tid & 7, kr = tid >> 3;
    f32x4 acc[9];
#pragma unroll
    for (int r = 0; r < 9; ++r) acc[r] = (f32x4){0.f, 0.f, 0.f, 0.f};
    const float* wp = w_ada + (size_t)kr * 6144 + task * 32 + ch * 4;
    for (int it = 0; it < 16; ++it) {
        const f32x4 w = *(const f32x4*)(wp + (size_t)it * 64 * 6144); const int k = kr + it * 64;
#pragma unroll
        for (int r = 0; r < 9; ++r) acc[r] += s[r * 1024 + k] * w;
    }
#pragma unroll
    for (int r = 0; r < 9; ++r) *(LAS f32x4*)(red + (kr * 9 + r) * 32 + ch * 4) = acc[r];
    __syncthreads();
    if (tid < 288) { const int r = tid >> 5, col = tid & 31; float sum = 0.f; for (int q = 0; q < 64; ++q) sum += red[(q * 9 + r) * 32 + col]; mod[r * 6144 + task * 32 + col] = sum + b_ada[task * 32 + col]; }
    __syncthreads();
}

__device__ __forceinline__ void rope_table(f32x2* tab, int tid) {
    for (int idx = tid; idx < 1024; idx += NTHREADS) {
        const int pos = idx >> 4, i = idx & 15;
        double f = 1.0;
        for (int q = 0; q < i; ++q) f *= 0.56234132519034908;
        const float ang = (float)pos * (float)f;
        const double a = (double)ang, k = __builtin_rint(a * 0.15915494309189535), r = a - k * 6.283185307179586476925, r2 = r * r;
        double sn = r, ts = r, cs = 1.0, tc = 1.0;
        for (int n = 1; n <= 14; ++n) {
            tc *= -r2 / (double)((2 * n - 1) * (2 * n)); cs += tc;
            ts *= -r2 / (double)((2 * n) * (2 * n + 1)); sn += ts;
        }
        tab[idx] = (f32x2){(float)cs, (float)sn};
    }
}

__device__ __forceinline__ unsigned char* lds_raw_ptr(LAS unsigned char* p) { return (unsigned char*)p; }
namespace mix {
typedef short bf16x8 __attribute__((ext_vector_type(8)));
typedef short s16x4 __attribute__((ext_vector_type(4)));
typedef float f32x16 __attribute__((ext_vector_type(16)));
typedef __attribute__((address_space(3))) const char* lds_cptr;
__device__ __forceinline__ int crow(int r, int hi) { return (r & 3) + 8 * (r >> 2) + 4 * hi; }
__device__ __forceinline__ unsigned cvtpk(float lo, float hi) { typedef float f2 __attribute__((ext_vector_type(2))); typedef __bf16 b2 __attribute__((ext_vector_type(2))); f2 v = {lo, hi}; b2 b = __builtin_convertvector(v, b2); return __builtin_bit_cast(unsigned, b); }
__device__ __forceinline__ s16x4 vtr(lds_cptr p) { return __builtin_bit_cast(s16x4, __builtin_amdgcn_ds_read_tr16_b64_v4i16((__attribute__((address_space(3))) s16x4*)p)); }
__device__ __forceinline__ bf16x8 pk8(s16x4 lo, s16x4 hi) { return (bf16x8){lo[0], lo[1], lo[2], lo[3], hi[0], hi[1], hi[2], hi[3]}; }
__device__ __forceinline__ float max3f(float a, float b, float c) { float r; asm("v_max3_f32 %0, %1, %2, %3" : "=v"(r) : "v"(a), "v"(b), "v"(c)); return r; }
__device__ __forceinline__ float max2f(float a, float b) { float r; asm("v_max_f32_e32 %0, %1, %2" : "=v"(r) : "v"(a), "v"(b)); return r; }
__device__ __forceinline__ float swap_half(float v) { auto rr = __builtin_amdgcn_permlane32_swap(__float_as_uint(v), __float_as_uint(v), false, false); return __uint_as_float((threadIdx.x & 32) ? rr[0] : rr[1]); }

constexpr int A_K = 0, A_V = 24576, A_WS = 49152, A_QST = 53248, A_OST = A_QST, A_OSTW = 8192, A_END = A_QST + 8 * 8192;

__device__ __forceinline__ void attn_unit(int b, int n, int kvh, bf16_t* Y, bf16_t* O, int ldo, const bf16_t* KB, const bf16_t* VB, const float* sink, LAS unsigned char* lds) {
    const int tid = threadIdx.x, lane = tid & 63, r32 = lane & 31, hi = lane >> 5, wid = __builtin_amdgcn_readfirstlane(tid >> 6);
    const int head = kvh * 4 + (wid >> 1);
    const int qrow0 = b * SEQ + n * 128 + (wid & 1) * 64;
    bf16_t* Qw = Y + (size_t)qrow0 * 2048 + 1024 + head * 64;
    LAS bf16x8* qst = (LAS bf16x8*)(lds + A_QST + wid * 8192) + lane;
#pragma unroll
    for (int sb = 0; sb < 2; ++sb)
#pragma unroll
        for (int d0 = 0; d0 < 4; ++d0) qst[(sb * 4 + d0) * 64] = *(const bf16x8*)(Qw + (size_t)(32 * sb + r32) * 2048 + d0 * 16 + hi * 8);
    f32x16 o[2][2];
#pragma unroll
    for (int sb = 0; sb < 2; ++sb)
#pragma unroll
        for (int d0 = 0; d0 < 2; ++d0)
#pragma unroll
            for (int r = 0; r < 16; ++r) o[sb][d0][r] = 0.f;
    float m[2] = {-1e30f, -1e30f}, l[2] = {0.f, 0.f};
    LAS float* wsf = (LAS float*)(lds + A_WS) + wid * 128;
    const int jlo = (n == 0) ? 2 : 0, jhi = (n == 31) ? 3 : 5, T = 4 + (jhi - jlo + 1);
    const size_t koff = (size_t)lane * 256 + wid * 8 + kvh * 64;
    const size_t voff = (size_t)(16 * (wid & 3) + (lane >> 2)) * 256 + (wid >> 2) * 32 + (lane & 3) * 8 + kvh * 64;
    auto tile_row = [&](int t) -> long { return t < 4 ? (long)(NTOK + b * CTXL + 64 * t) : (long)(b * SEQ + (n - 1) * 128 + 64 * (jlo + t - 4)); };
    auto issue = [&](int t) {
        const long row = tile_row(t); const int buf = t % 3;
        __builtin_amdgcn_global_load_lds((const unsigned*)(KB + row * 256 + koff), (LAS unsigned*)(lds + A_K + buf * 8192 + wid * 1024), 16, 0, 0);
        __builtin_amdgcn_global_load_lds((const unsigned*)(VB + row * 256 + voff), (LAS unsigned*)(lds + A_V + buf * 8192 + wid * 1024), 16, 0, 0);
    };
    issue(0); issue(1);
    int slot = 0;
    for (int t = 0; t < T; ++t) {
        if (t + 1 < T) asm volatile("s_waitcnt vmcnt(2) lgkmcnt(0)" ::: "memory"); else asm volatile("s_waitcnt vmcnt(0) lgkmcnt(0)" ::: "memory");
        __builtin_amdgcn_s_barrier();
        if (t + 2 < T) issue(t + 2);
        const lds_cptr Kt = (lds_cptr)(lds + A_K + slot * 8192) + hi * 1024 + r32 * 16;
        const lds_cptr Vt = (lds_cptr)(lds + A_V + slot * 8192) + ((lane >> 4) & 1) * 32 + (lane & 3) * 8 + (4 * hi + ((lane & 15) >> 2)) * 64;
        slot = (slot == 2) ? 0 : slot + 1;
        const bool local = t >= 4;
        const int dl = 64 * (jlo + t - 4) - 128 - 64 * (wid & 1);
        if (local && (dl > 160 || dl < -191)) continue;
        f32x16 p0[2], p1[2];
#pragma unroll
        for (int sb = 0; sb < 2; ++sb)
#pragma unroll
            for (int r = 0; r < 16; ++r) { p0[sb][r] = 0.f; p1[sb][r] = 0.f; }
#pragma unroll
        for (int d0 = 0; d0 < 4; ++d0) {
            const bf16x8 k0 = *(const __attribute__((address_space(3))) bf16x8*)(Kt + d0 * 2048), k1 = *(const __attribute__((address_space(3))) bf16x8*)(Kt + d0 * 2048 + 512);
#pragma unroll
            for (int sb = 0; sb < 2; ++sb) {
                const bf16x8 qf = qst[(sb * 4 + d0) * 64];
                p0[sb] = __builtin_amdgcn_mfma_f32_32x32x16_bf16(k0, qf, p0[sb], 0, 0, 0);
                p1[sb] = __builtin_amdgcn_mfma_f32_32x32x16_bf16(k1, qf, p1[sb], 0, 0, 0);
            }
        }
        if (local && (dl < -97 || dl > 65 || dl - 32 < -97)) {
#pragma unroll
            for (int sb = 0; sb < 2; ++sb)
#pragma unroll
                for (int r = 0; r < 16; ++r) { const int rel = dl - 32 * sb + crow(r, hi) - r32; if (rel < -128 || rel > 128) p0[sb][r] = -1e30f; if (rel + 32 < -128 || rel + 32 > 128) p1[sb][r] = -1e30f; }
        }
        float mn[2];
        asm volatile("s_nop 15\n\ts_nop 7" : "+v"(p0[0]), "+v"(p1[0]), "+v"(p0[1]), "+v"(p1[1]));
#pragma unroll
        for (int sb = 0; sb < 2; ++sb) {
            float a = max3f(p0[sb][0], p0[sb][1], p1[sb][0]), b2 = max3f(p0[sb][2], p0[sb][3], p1[sb][1]); a = max3f(a, p1[sb][2], p1[sb][3]);
#pragma unroll
            for (int r = 4; r < 16; r += 4) { a = max3f(a, p0[sb][r], p0[sb][r + 1]); b2 = max3f(b2, p0[sb][r + 2], p0[sb][r + 3]); a = max3f(a, p1[sb][r], p1[sb][r + 1]); b2 = max3f(b2, p1[sb][r + 2], p1[sb][r + 3]); }
            float rm = max2f(a, b2);
            rm = max2f(rm, swap_half(rm));
            mn[sb] = max2f(m[sb], rm);
        }
        if (__any((mn[0] > m[0]) || (mn[1] > m[1]))) {
            const float f0 = __builtin_amdgcn_exp2f(m[0] - mn[0]), f1 = __builtin_amdgcn_exp2f(m[1] - mn[1]);
            l[0] *= f0; l[1] *= f1;
            if (hi == 0) { wsf[r32] = f0; wsf[64 + r32] = f1; }
            asm volatile("s_waitcnt lgkmcnt(0)" ::: "memory");
#pragma unroll
            for (int r = 0; r < 16; ++r) { const float a = wsf[crow(r, hi)], b2 = wsf[64 + crow(r, hi)]; o[0][0][r] *= a; o[0][1][r] *= a; o[1][0][r] *= b2; o[1][1][r] *= b2; }
            m[0] = mn[0]; m[1] = mn[1];
        }
        u32x4 pw[2][4];
#pragma unroll
        for (int sb = 0; sb < 2; ++sb) {
            float sacc = 0.f;
#pragma unroll
            for (int r = 0; r < 16; ++r) { p0[sb][r] = __builtin_amdgcn_exp2f(p0[sb][r] - m[sb]); p1[sb][r] = __builtin_amdgcn_exp2f(p1[sb][r] - m[sb]); sacc += p0[sb][r] + p1[sb][r]; }
            l[sb] += sacc;
#pragma unroll
            for (int q = 0; q < 4; ++q) { pw[sb][0][q] = cvtpk(p0[sb][2 * q], p0[sb][2 * q + 1]); pw[sb][1][q] = cvtpk(p0[sb][8 + 2 * q], p0[sb][9 + 2 * q]); pw[sb][2][q] = cvtpk(p1[sb][2 * q], p1[sb][2 * q + 1]); pw[sb][3][q] = cvtpk(p1[sb][8 + 2 * q], p1[sb][9 + 2 * q]); }
        }
#pragma unroll
        for (int d0 = 0; d0 < 2; ++d0)
#pragma unroll
            for (int ks = 0; ks < 4; ++ks) {
                const s16x4 vlo = vtr(Vt + d0 * 4096 + ks * 1024), vhi = vtr(Vt + d0 * 4096 + ks * 1024 + 512);
                const bf16x8 vf = pk8(vlo, vhi);
#pragma unroll
                for (int sb = 0; sb < 2; ++sb) o[sb][d0] = __builtin_amdgcn_mfma_f32_32x32x16_bf16(__builtin_bit_cast(bf16x8, pw[sb][ks]), vf, o[sb][d0], 0, 0, 0);
            }
    }
    const float s2 = sink[head] * LOG2E;
    LAS bf16_t* stg = (LAS bf16_t*)(lds + A_OST + wid * A_OSTW);
#pragma unroll
    for (int sb = 0; sb < 2; ++sb) {
        const float lt = l[sb] + swap_half(l[sb]);
        const float mf = fmaxf(m[sb], s2), f = __builtin_amdgcn_exp2f(m[sb] - mf), den = lt * f + __builtin_amdgcn_exp2f(s2 - mf);
        asm volatile("s_waitcnt lgkmcnt(0)" ::: "memory");
        if (hi == 0) wsf[sb * 64 + r32] = f / den;
        asm volatile("s_waitcnt lgkmcnt(0)" ::: "memory");
#pragma unroll
        for (int r = 0; r < 16; ++r) { const float sc = wsf[sb * 64 + crow(r, hi)]; const int orow = crow(r, hi);
            stg[orow * 64 + r32] = (bf16_t)f2bf(o[sb][0][r] * sc); stg[orow * 64 + 32 + r32] = (bf16_t)f2bf(o[sb][1][r] * sc); }
        asm volatile("s_waitcnt lgkmcnt(0)" ::: "memory");
#pragma unroll
        for (int i = 0; i < 4; ++i) { const int row = i * 8 + (lane >> 3), ch = lane & 7; const u32x4 v = *(const LAS u32x4*)(stg + row * 64 + ch * 8); *(u32x4*)(O + (size_t)(qrow0 + 32 * sb + row) * ldo + head * 64 + ch * 8) = v; }
        asm volatile("s_waitcnt lgkmcnt(0)" ::: "memory");
    }
    __syncthreads();
}

constexpr int G_V = 0, G_ST = 65536, G_STW = 8704, G_MU = G_ST + 8 * G_STW;
__device__ __forceinline__ void gmlp_unit(int task, bf16_t* Y, bf16_t* YO, int ldo, const bf16_t* VA, const bf16_t* WSP, const f32x2* STATS, const float* ln_g, const float* ln_b, const float* b_sp, LAS unsigned char* lds) {
    const int tid = threadIdx.x, lane = tid & 63, r32 = lane & 31, hi = lane >> 5, wid = __builtin_amdgcn_readfirstlane(tid >> 6);
    const int r0 = task * 128;
    LAS float* mu = (LAS float*)(lds + G_MU); LAS float* rs = mu + 128;
    if (tid < 128) {
        const f32x4* sp = (const f32x4*)(STATS + (size_t)(r0 + tid) * 16); float s = 0.f, ss = 0.f;
#pragma unroll
        for (int i = 0; i < 8; ++i) { const f32x4 v = sp[i]; s += v.x + v.z; ss += v.y + v.w; }
        const float mean = s * (1.f / 1024.f), var = fmaxf(ss * (1.f / 1024.f) - mean * mean, 0.f);
        mu[tid] = mean; rs[tid] = 1.0f / sqrtf(var + EPS);
    }
    u32x4 raw[4];
#pragma unroll
    for (int i = 0; i < 4; ++i) { const int idx = tid + NTHREADS * i, q = idx >> 4, c8 = idx & 15; raw[i] = *(const u32x4*)(VA + (size_t)(r0 + q) * 1024 + c8 * 8); }
    const int dcol = (tid & 15) * 8;
    f32x4 lg0 = *(const f32x4*)(ln_g + dcol), lg1 = *(const f32x4*)(ln_g + dcol + 4), lb0 = *(const f32x4*)(ln_b + dcol), lb1 = *(const f32x4*)(ln_b + dcol + 4);
    __syncthreads();
    const int pb = wid >> 1, dh = wid & 1;
    LAS float* st = (LAS float*)(lds + G_ST + wid * G_STW);
    u32x4 ur[4]; bf16x8 af[8], afn[8]; float bsr[4];
    const size_t ybase0 = (size_t)(r0 + 32 * pb + (lane >> 3)) * 2048 + 64 * dh + (lane & 7) * 8;
    const bf16_t* wrow0 = WSP + (size_t)(32 * pb + r32) * 128 + 8 * hi;
#pragma unroll
    for (int ks = 0; ks < 8; ++ks) af[ks] = *(const bf16x8*)(wrow0 + 16 * ks);
    for (int g8 = 0; g8 < 8; ++g8) {
        LAS unsigned char* vb = lds + G_V + (g8 & 1) * 32768;
#pragma unroll
        for (int i = 0; i < 4; ++i) {
            const int idx = tid + NTHREADS * i, q = idx >> 4, c8 = idx & 15, d = c8 * 8;
            const f32x4 g0 = lg0, g1 = lg1, b0 = lb0, b1 = lb1;
            const float mq = mu[q], rq = rs[q]; const u32x4 rw = raw[i];
            float v[8] = {bf2f(rw.x & 0xffffu), bf2f(rw.x >> 16), bf2f(rw.y & 0xffffu), bf2f(rw.y >> 16), bf2f(rw.z & 0xffffu), bf2f(rw.z >> 16), bf2f(rw.w & 0xffffu), bf2f(rw.w >> 16)};
#pragma unroll
            for (int e = 0; e < 4; ++e) { v[e] = (v[e] - mq) * rq * g0[e] + b0[e]; v[4 + e] = (v[4 + e] - mq) * rq * g1[e] + b1[e]; }
            u32x4 w; w.x = pk2(v[0], v[1]); w.y = pk2(v[2], v[3]); w.z = pk2(v[4], v[5]); w.w = pk2(v[6], v[7]);
            *(LAS u32x4*)(vb + ((d >> 5) * 8 + (q >> 4)) * 1024 + (q & 15) * 64 + (d & 31) * 2) = w;
        }
        if (g8 + 1 < 8) {
#pragma unroll
            for (int i = 0; i < 4; ++i) { const int idx = tid + NTHREADS * i, q = idx >> 4, c8 = idx & 15; raw[i] = *(const u32x4*)(VA + (size_t)(r0 + q) * 1024 + (g8 + 1) * 128 + c8 * 8); }
            const int dn = (g8 + 1) * 128 + dcol;
            lg0 = *(const f32x4*)(ln_g + dn); lg1 = *(const f32x4*)(ln_g + dn + 4); lb0 = *(const f32x4*)(ln_b + dn); lb1 = *(const f32x4*)(ln_b + dn + 4);
        }
#pragma unroll
        for (int i = 0; i < 4; ++i) { ur[i] = *(const u32x4*)(Y + ybase0 + g8 * 128 + (size_t)(8 * i) * 2048); bsr[i] = b_sp[g8 * 128 + 32 * pb + 8 * i + (lane >> 3)]; }
        if (g8 + 1 < 8) {
#pragma unroll
            for (int ks = 0; ks < 8; ++ks) afn[ks] = *(const bf16x8*)(wrow0 + (size_t)(g8 + 1) * 16384 + 16 * ks);
        }
        __syncthreads();
        const lds_cptr Vb = (lds_cptr)vb + ((lane >> 4) & 1) * 32 + (lane & 3) * 8 + (8 * hi + ((lane & 15) >> 2)) * 64;
        f32x16 acc[2];
#pragma unroll
        for (int t2 = 0; t2 < 2; ++t2)
#pragma unroll
            for (int r = 0; r < 16; ++r) acc[t2][r] = 0.f;
#pragma unroll
        for (int ks = 0; ks < 8; ++ks) {
#pragma unroll
            for (int t2 = 0; t2 < 2; ++t2) {
                const int db = 2 * dh + t2;
                const s16x4 vlo = vtr(Vb + (db * 8 + ks) * 1024), vhi = vtr(Vb + (db * 8 + ks) * 1024 + 256);
                acc[t2] = __builtin_amdgcn_mfma_f32_32x32x16_bf16(af[ks], pk8(vlo, vhi), acc[t2], 0, 0, 0);
            }
        }
#pragma unroll
        for (int t2 = 0; t2 < 2; ++t2)
#pragma unroll
            for (int r = 0; r < 16; ++r) st[crow(r, hi) * 68 + 32 * t2 + r32] = acc[t2][r];
        asm volatile("s_waitcnt lgkmcnt(0)" ::: "memory");
#pragma unroll
        for (int i = 0; i < 4; ++i) {
            const int prow = 8 * i + (lane >> 3), ch = lane & 7;
            const f32x4 m0 = *(const LAS f32x4*)(st + prow * 68 + ch * 8), m1 = *(const LAS f32x4*)(st + prow * 68 + ch * 8 + 4);
            const float bs = bsr[i]; const u32x4 uw = ur[i];
            u32x4 o;
            o.x = pk2(bf2f(uw.x & 0xffffu) * (m0.x + bs), bf2f(uw.x >> 16) * (m0.y + bs)); o.y = pk2(bf2f(uw.y & 0xffffu) * (m0.z + bs), bf2f(uw.y >> 16) * (m0.w + bs));
            o.z = pk2(bf2f(uw.z & 0xffffu) * (m1.x + bs), bf2f(uw.z >> 16) * (m1.y + bs)); o.w = pk2(bf2f(uw.w & 0xffffu) * (m1.z + bs), bf2f(uw.w >> 16) * (m1.w + bs));
            *(u32x4*)(YO + (size_t)(r0 + 32 * pb + prow) * ldo + g8 * 128 + 64 * dh + ch * 8) = o;
        }
        asm volatile("s_waitcnt lgkmcnt(0)" ::: "memory");
#pragma unroll
        for (int ks = 0; ks < 8; ++ks) af[ks] = afn[ks];
    }
    __syncthreads();
}
}

namespace att2 {
typedef short bf16x8 __attribute__((ext_vector_type(8)));
typedef short s16x4 __attribute__((ext_vector_type(4)));
typedef float f32x16 __attribute__((ext_vector_type(16)));
typedef __attribute__((address_space(3))) const char* lds_cptr;
typedef short v4i16_t __attribute__((ext_vector_type(4)));
__device__ __forceinline__ int crow(int r, int hi) { return (r & 3) + 8 * (r >> 2) + 4 * hi; }
#define SBAR() __builtin_amdgcn_sched_barrier(0)
constexpr int NSLOT = 3, SLOTB = 8192;
constexpr int LDS_K = 0, LDS_V = NSLOT * SLOTB, LDS_WS = 2 * NSLOT * SLOTB, LDS_OST = LDS_WS + 8 * 64 * 4, LDS_BYTES = LDS_OST + 8 * 4096;
__device__ __forceinline__ void glds16(const void* gsrc, unsigned lds_dst) { unsigned keep;
    asm volatile("s_mov_b32 %0, m0\n\ts_mov_b32 m0, %2\n\ts_nop 0\n\tglobal_load_lds_dwordx4 %1, off\n\ts_mov_b32 m0, %0" : "=&s"(keep) : "v"(gsrc), "s"(lds_dst) : "memory"); }
__device__ __forceinline__ float max3f(float a, float b, float c) { float r; asm("v_max3_f32 %0, %1, %2, %3" : "=v"(r) : "v"(a), "v"(b), "v"(c)); return r; }
__device__ __forceinline__ float max2f(float a, float b) { float r; asm("v_max_f32_e32 %0, %1, %2" : "=v"(r) : "v"(a), "v"(b)); return r; }
__device__ __forceinline__ float fadd_s(float a, float b) { float r; asm("v_add_f32_e32 %0, %1, %2" : "=v"(r) : "v"(a), "v"(b)); return r; }
__device__ __forceinline__ float fsub_s(float a, float b) { float r; asm("v_sub_f32_e32 %0, %1, %2" : "=v"(r) : "v"(a), "v"(b)); return r; }
typedef float f32x2_t __attribute__((ext_vector_type(2))); typedef __bf16 bf16x2_t __attribute__((ext_vector_type(2)));
__device__ __forceinline__ unsigned cvtpk_s(float lo, float hi) { f32x2_t v = {lo, hi}; bf16x2_t b = __builtin_convertvector(v, bf16x2_t); return __builtin_bit_cast(unsigned, b); }
#define WAIT_BAR(N) asm volatile("s_waitcnt vmcnt(" #N ") lgkmcnt(0)\n\ts_barrier" ::: "memory")
__device__ __forceinline__ void qkt(f32x16& p0, f32x16& p1, lds_cptr Kslot, const bf16x8* qr, const f32x16& negm, int r32, int hi) {
    const lds_cptr kb = Kslot + hi * 1024 + r32 * 16;
#pragma unroll
    for (int d0 = 0; d0 < 4; ++d0) {
        const bf16x8 b0 = *(const __attribute__((address_space(3))) bf16x8*)(kb + d0 * 2048);
        const bf16x8 b1 = *(const __attribute__((address_space(3))) bf16x8*)(kb + d0 * 2048 + 512);
        if (d0 == 0) { p0 = __builtin_amdgcn_mfma_f32_32x32x16_bf16(b0, qr[0], negm, 0, 0, 0); p1 = __builtin_amdgcn_mfma_f32_32x32x16_bf16(b1, qr[0], negm, 0, 0, 0); }
        else { p0 = __builtin_amdgcn_mfma_f32_32x32x16_bf16(b0, qr[d0], p0, 0, 0, 0); p1 = __builtin_amdgcn_mfma_f32_32x32x16_bf16(b1, qr[d0], p1, 0, 0, 0); }
    }
}
__device__ __forceinline__ void kload8(bf16x8* kf, lds_cptr kp) {
    kf[0] = *(const __attribute__((address_space(3))) bf16x8*)(kp);        kf[1] = *(const __attribute__((address_space(3))) bf16x8*)(kp + 512);
    kf[2] = *(const __attribute__((address_space(3))) bf16x8*)(kp + 2048); kf[3] = *(const __attribute__((address_space(3))) bf16x8*)(kp + 2560);
    kf[4] = *(const __attribute__((address_space(3))) bf16x8*)(kp + 4096); kf[5] = *(const __attribute__((address_space(3))) bf16x8*)(kp + 4608);
    kf[6] = *(const __attribute__((address_space(3))) bf16x8*)(kp + 6144); kf[7] = *(const __attribute__((address_space(3))) bf16x8*)(kp + 6656);
}
__device__ __forceinline__ void kload2(bf16x8* kf, lds_cptr kp, int j) { kf[2 * j] = *(const __attribute__((address_space(3))) bf16x8*)(kp + j * 2048); kf[2 * j + 1] = *(const __attribute__((address_space(3))) bf16x8*)(kp + j * 2048 + 512); }
__device__ __forceinline__ s16x4 vtr(lds_cptr p) { return __builtin_bit_cast(s16x4, __builtin_amdgcn_ds_read_tr16_b64_v4i16((__attribute__((address_space(3))) v4i16_t*)p)); }
__device__ __forceinline__ float rowmax(const f32x16& p0, const f32x16& p1) {
    float a = max3f(p0[0], p0[1], p1[0]), b = max3f(p0[2], p0[3], p1[1]); a = max3f(a, p1[2], p1[3]);
#pragma unroll
    for (int r = 4; r < 16; r += 4) { a = max3f(a, p0[r], p0[r + 1]); b = max3f(b, p0[r + 2], p0[r + 3]); a = max3f(a, p1[r], p1[r + 1]); b = max3f(b, p1[r + 2], p1[r + 3]); }
    const float m = max2f(a, b);
    auto rr = __builtin_amdgcn_permlane32_swap(__float_as_uint(m), __float_as_uint(m), false, false);
    return max2f(__uint_as_float(rr[0]), __uint_as_float(rr[1]));
}
__device__ __forceinline__ void pv(f32x16* o, int vb, bf16x8 pa0, bf16x8 pa1, bf16x8 pa2, bf16x8 pa3) {
#pragma unroll
    for (int d0 = 0; d0 < 2; ++d0) { s16x4 lo[4], hi[4];
#pragma unroll
        for (int ks = 0; ks < 4; ++ks) {
            asm volatile("ds_read_b64_tr_b16 %0,%1 offset:%c2" : "=&v"(lo[ks]) : "v"(vb), "i"(d0 * 4096 + ks * 1024) : "memory");
            asm volatile("ds_read_b64_tr_b16 %0,%1 offset:%c2" : "=&v"(hi[ks]) : "v"(vb), "i"(d0 * 4096 + ks * 1024 + 512) : "memory"); }
        asm volatile("s_waitcnt lgkmcnt(0)" ::: "memory"); SBAR();
#define PK(k) (bf16x8){lo[k][0], lo[k][1], lo[k][2], lo[k][3], hi[k][0], hi[k][1], hi[k][2], hi[k][3]}
        o[d0] = __builtin_amdgcn_mfma_f32_32x32x16_bf16(pa0, PK(0), o[d0], 0, 0, 0);
        o[d0] = __builtin_amdgcn_mfma_f32_32x32x16_bf16(pa1, PK(1), o[d0], 0, 0, 0);
        o[d0] = __builtin_amdgcn_mfma_f32_32x32x16_bf16(pa2, PK(2), o[d0], 0, 0, 0);
        o[d0] = __builtin_amdgcn_mfma_f32_32x32x16_bf16(pa3, PK(3), o[d0], 0, 0, 0);
#undef PK
    }
}
__device__ __forceinline__ void wmask(f32x16& p0, f32x16& p1, int dl, int r32, int hi) {
    const float NEG = -INFINITY;
#pragma unroll
    for (int r = 0; r < 16; ++r) { const int rel = dl + crow(r, hi) - r32; if (rel < -128 || rel > 128) p0[r] = NEG; if (rel + 32 < -128 || rel + 32 > 128) p1[r] = NEG; }
}

template <int THRL> __device__ __forceinline__ void attn_unit(int b, int n, int kvh, int hp, int base, bool primed, bool has_next, int nb, int nn, int nkvh, int nhp, bf16x8 (&qr)[4], int& nbase,
                                                              const bf16_t* Y, bf16_t* O, int ldo, const bf16_t* KB, const bf16_t* VB, const float* sink, LAS unsigned char* shm) {
    const int tid = threadIdx.x, lane = tid & 63, r32 = lane & 31, hi = lane >> 5; const int wid = __builtin_amdgcn_readfirstlane(tid >> 6);
    const int head = kvh * 4 + (wid >> 1), qsub = wid & 1;
    const long qrow0 = (long)b * SEQ + n * 64 + qsub * 32;
    const bf16_t* Qw = Y + qrow0 * 2048 + 1024 + head * 64;
    const unsigned lds0 = (unsigned)(uintptr_t)shm;
    LAS float* wsf = (LAS float*)(shm + LDS_WS) + wid * 64;
    const long koff = (long)lane * 256 + kvh * 64 + wid * 8;
    const long voff = (long)(16 * (wid & 3) + (lane >> 2)) * 256 + kvh * 64 + (wid >> 2) * 32 + (lane & 3) * 8;
    const unsigned kdst = lds0 + LDS_K + wid * 1024, vdst = lds0 + LDS_V + wid * 1024;
    const int jlo = (n == 0) ? 2 : (n == 1) ? 1 : 0, jhi = (n == 63) ? 2 : (n == 62) ? 3 : 4, NT = 4 + (jhi - jlo + 1);
    const long lrow0 = (long)b * SEQ + n * 64 - 128 + 64 * (jlo - 4), crow0 = (long)NTOK + b * CTXL;
#define TROW(t) ((t) < 4 ? crow0 + 64 * (t) : lrow0 + 64 * (t))
#define DMA_K(t, slot) glds16(KB + TROW(t) * 256 + koff, (unsigned)__builtin_amdgcn_readfirstlane(kdst + (slot)))
#define DMA_V(t, slot) glds16(VB + TROW(t) * 256 + voff, (unsigned)__builtin_amdgcn_readfirstlane(vdst + (slot)))
    const int vb0 = (int)(lds0 + LDS_V) + ((lane >> 4) & 1) * 32 + (lane & 3) * 8 + (4 * hi + ((lane & 15) >> 2)) * 64;
    bf16x8 kf[8];
    const lds_cptr shm3 = (lds_cptr)shm; const lds_cptr kp0 = shm3 + LDS_K + hi * 1024 + r32 * 16; const lds_cptr vp0 = shm3 + LDS_V + ((lane >> 4) & 1) * 32 + (lane & 3) * 8 + (4 * hi + ((lane & 15) >> 2)) * 64;
    const int s0 = base, s1 = (s0 == (NSLOT - 1) * SLOTB) ? 0 : s0 + SLOTB, s2 = (s1 == (NSLOT - 1) * SLOTB) ? 0 : s1 + SLOTB;
    if (!primed) {
        DMA_K(0, s0); DMA_V(0, s0); DMA_K(1, s1); DMA_K(2, s2);
#pragma unroll
        for (int d0 = 0; d0 < 4; ++d0) qr[d0] = *(const bf16x8*)(Qw + (long)r32 * 2048 + d0 * 16 + hi * 8);
    }
    float mhat = 0.f, l_reg = 0.f; f32x16 o[2]; o[0] = f32x16{}; o[1] = f32x16{}; f32x16 negm = f32x16{}; asm volatile("" : "+v"(negm));
    const int dq = -128 - 32 * qsub;
#define CMASK(P0, P1, t) do { if ((t) >= 4) { const int dl_ = 64 * (jlo + (t) - 4) + dq; if (dl_ < -97 || dl_ > 65) wmask(P0, P1, dl_, r32, hi); } } while (0)
    bool resc = false;
#define START(P0, P1) do { const float rm = rowmax(P0, P1); resc = false; \
    { const float dl = rm; mhat = fadd_s(mhat, dl); \
      _Pragma("unroll") for (int r = 0; r < 16; ++r) { P0[r] = fsub_s(P0[r], dl); P1[r] = fsub_s(P1[r], dl); } \
      _Pragma("unroll") for (int r = 0; r < 16; ++r) negm[r] = -mhat; asm volatile("" : "+v"(negm)); } \
    _Pragma("unroll") for (int r = 0; r < 16; ++r) P0[r] = __builtin_amdgcn_exp2f(P0[r]); } while (0)
#define RESC() do { if (resc) { asm volatile("s_waitcnt lgkmcnt(0)" ::: "memory"); \
      _Pragma("unroll") for (int d_ = 0; d_ < 2; ++d_) _Pragma("unroll") for (int r = 0; r < 16; ++r) o[d_][r] *= wsf[crow(r, hi)]; } } while (0)
    f32x16 pA0, pA1, pB0, pB1;
    int sl_prev = s0, sl_cur = s0, sl_next = s1;
#define ROT() do { sl_prev = sl_cur; sl_cur = sl_next; sl_next = (sl_next == (NSLOT - 1) * SLOTB) ? 0 : sl_next + SLOTB; } while (0)
    s16x4 vlo[8], vhi[8]; u32x4 pw0, pw1, pw2, pw3;
    const bool oddnt = NT & 1;
    WAIT_BAR(7);
#define PROLOG(X0, X1) do { qkt(X0, X1, shm3 + LDS_K + s0, qr, negm, r32, hi); asm volatile("s_nop 15\n\ts_nop 7" : "+v"(X0), "+v"(X1)); \
    START(X0, X1); \
    _Pragma("unroll") for (int r = 0; r < 16; ++r) X1[r] = __builtin_amdgcn_exp2f(X1[r]); \
    WAIT_BAR(0); \
    DMA_K(3, s0); DMA_V(1, s1); \
    ROT(); \
    kload8(kf, kp0 + sl_cur); \
    WAIT_BAR(2); } while (0)
#define PKW(P, B) cvtpk_s(P[B], P[B + 1])
#define PAF(k) __builtin_bit_cast(bf16x8, pw##k)
#define VFR(i) (bf16x8){vlo[i][0], vlo[i][1], vlo[i][2], vlo[i][3], vhi[i][0], vhi[i][1], vhi[i][2], vhi[i][3]}
#define PIN(x) asm volatile("" : "+v"(x))
#define MX3(a, b, c) __builtin_fmaxf(__builtin_fmaxf((a), (b)), (c))
#define GAPA(MF, A0, A1, A2, A3, W0, W1, PW) do { MF; sacc += A0; sacc += A1; sacc += A2; sacc += A3; PIN(sacc); W0; W1; PIN(PW); SBAR(); } while (0)
#define EX(v) __builtin_amdgcn_exp2f(v)
#define GAPB(MF, X, B) do { MF; X[B] = EX(X[B]); X[B + 1] = EX(X[B + 1]); X[B + 2] = EX(X[B + 2]); X[B + 3] = EX(X[B + 3]); PIN(X); SBAR(); } while (0)
#define VRD(i) do { vlo[i] = vtr(vp_ + (((i) >> 2) * 4096 + ((i) & 3) * 1024)); vhi[i] = vtr(vp_ + (((i) >> 2) * 4096 + ((i) & 3) * 1024 + 512)); } while (0)
#define KRD(G, j) do { if (G) { kload2(kf, kp0 + sl_next, j); SBAR(); } } while (0)
#define STEP(C0, C1, P0, P1, t, GK, GV, GL) do { SBAR(); \
    const lds_cptr vp_ = vp0 + sl_prev; \
    VRD(0); SBAR(); float sacc = (P0[0] + P0[1]); \
    GAPA(C0 = __builtin_amdgcn_mfma_f32_32x32x16_bf16(kf[0], qr[0], negm, 0, 0, 0), P0[2], P0[3], P0[4], P0[5],     pw0[0] = PKW(P0, 0), pw0[1] = PKW(P0, 2), pw0); \
    VRD(4); SBAR(); GAPA(C1 = __builtin_amdgcn_mfma_f32_32x32x16_bf16(kf[1], qr[0], negm, 0, 0, 0), P0[6], P0[7], P0[8], P0[9],     pw0[2] = PKW(P0, 4), pw0[3] = PKW(P0, 6), pw0); \
    VRD(1); SBAR(); GAPA(C0 = __builtin_amdgcn_mfma_f32_32x32x16_bf16(kf[2], qr[1], C0, 0, 0, 0),   P0[10], P0[11], P0[12], P0[13], pw1[0] = PKW(P0, 8), pw1[1] = PKW(P0, 10), pw1); \
    VRD(5); SBAR(); GAPA(C1 = __builtin_amdgcn_mfma_f32_32x32x16_bf16(kf[3], qr[1], C1, 0, 0, 0),   P0[14], P0[15], P1[0], P1[1],   pw1[2] = PKW(P0, 12), pw1[3] = PKW(P0, 14), pw1); \
    VRD(2); SBAR(); GAPA(C0 = __builtin_amdgcn_mfma_f32_32x32x16_bf16(kf[4], qr[2], C0, 0, 0, 0),   P1[2], P1[3], P1[4], P1[5],     pw2[0] = PKW(P1, 0), pw2[1] = PKW(P1, 2), pw2); \
    VRD(6); SBAR(); GAPA(C1 = __builtin_amdgcn_mfma_f32_32x32x16_bf16(kf[5], qr[2], C1, 0, 0, 0),   P1[6], P1[7], P1[8], P1[9],     pw2[2] = PKW(P1, 4), pw2[3] = PKW(P1, 6), pw2); \
    VRD(3); SBAR(); GAPA(C0 = __builtin_amdgcn_mfma_f32_32x32x16_bf16(kf[6], qr[3], C0, 0, 0, 0),   P1[10], P1[11], P1[12], P1[13], pw3[0] = PKW(P1, 8), pw3[1] = PKW(P1, 10), pw3); \
    VRD(7); SBAR(); GAPA(C1 = __builtin_amdgcn_mfma_f32_32x32x16_bf16(kf[7], qr[3], C1, 0, 0, 0),   P1[14], P1[15], 0.f, 0.f,       pw3[2] = PKW(P1, 12), pw3[3] = PKW(P1, 14), pw3); \
    l_reg += sacc; \
    if (GK) { DMA_K((t) + 3, sl_cur); } if (GV) { DMA_V((t) + 1, sl_next); } \
    CMASK(C0, C1, t); \
    { float a = MX3(C0[0], C0[1], C1[0]), b2 = MX3(C0[2], C0[3], C1[1]); a = MX3(a, C1[2], C1[3]); \
      _Pragma("unroll") for (int r = 4; r < 16; r += 4) { a = MX3(a, C0[r], C0[r + 1]); b2 = MX3(b2, C0[r + 2], C0[r + 3]); a = MX3(a, C1[r], C1[r + 1]); b2 = MX3(b2, C1[r + 2], C1[r + 3]); } \
      float rm = __builtin_fmaxf(a, b2); { auto rr = __builtin_amdgcn_permlane32_swap(__float_as_uint(rm), __float_as_uint(rm), false, false); rm = __builtin_fmaxf(__uint_as_float(rr[0]), __uint_as_float(rr[1])); } \
      resc = false; \
      if (__builtin_expect(__any(rm > (float)THRL), 0)) { const float dl = __builtin_fmaxf(rm, 0.f); mhat += dl; \
        _Pragma("unroll") for (int r = 0; r < 16; ++r) { C0[r] -= dl; C1[r] -= dl; } \
        _Pragma("unroll") for (int r = 0; r < 16; ++r) negm[r] = -mhat; asm volatile("" : "+v"(negm)); \
        const float f = __builtin_amdgcn_exp2f(-dl); l_reg *= f; if (hi == 0) wsf[r32] = f; resc = true; } } \
    SBAR(); \
    GAPB(o[0] = __builtin_amdgcn_mfma_f32_32x32x16_bf16(PAF(0), VFR(0), o[0], 0, 0, 0), C0, 0); \
    GAPB(o[1] = __builtin_amdgcn_mfma_f32_32x32x16_bf16(PAF(0), VFR(4), o[1], 0, 0, 0), C0, 4); \
    KRD(GL, 0); GAPB(o[0] = __builtin_amdgcn_mfma_f32_32x32x16_bf16(PAF(1), VFR(1), o[0], 0, 0, 0), C0, 8); \
    KRD(GL, 1); GAPB(o[1] = __builtin_amdgcn_mfma_f32_32x32x16_bf16(PAF(1), VFR(5), o[1], 0, 0, 0), C0, 12); \
    KRD(GL, 2); GAPB(o[0] = __builtin_amdgcn_mfma_f32_32x32x16_bf16(PAF(2), VFR(2), o[0], 0, 0, 0), C1, 0); \
    KRD(GL, 3); GAPB(o[1] = __builtin_amdgcn_mfma_f32_32x32x16_bf16(PAF(2), VFR(6), o[1], 0, 0, 0), C1, 4); \
    GAPB(o[0] = __builtin_amdgcn_mfma_f32_32x32x16_bf16(PAF(3), VFR(3), o[0], 0, 0, 0), C1, 8); \
    GAPB(o[1] = __builtin_amdgcn_mfma_f32_32x32x16_bf16(PAF(3), VFR(7), o[1], 0, 0, 0), C1, 12); \
    } while (0)
#define ENDW(tt) do { if ((tt) + 3 < NT) { WAIT_BAR(2); } else if ((tt) + 2 < NT) { WAIT_BAR(1); } else { WAIT_BAR(0); } } while (0)
    int t = 1;
    PROLOG(pA0, pA1);
    for (; t + 1 < NT; t += 2) {
        STEP(pB0, pB1, pA0, pA1, t, (t + 3 < NT), (t + 1 < NT), (t + 1 < NT));       ENDW(t);     RESC(); ROT();
        STEP(pA0, pA1, pB0, pB1, t + 1, (t + 4 < NT), (t + 2 < NT), (t + 2 < NT));   ENDW(t + 1); RESC(); ROT();
    }
    const int sl_last = oddnt ? sl_prev : sl_cur;
    nbase = oddnt ? sl_cur : sl_next;
    if (has_next) {
        const long nr = (long)NTOK + nb * CTXL; const long nko = (long)lane * 256 + nkvh * 64 + wid * 8, nvo = (long)(16 * (wid & 3) + (lane >> 2)) * 256 + nkvh * 64 + (wid >> 2) * 32 + (lane & 3) * 8;
        const int n0 = nbase, n1 = (n0 == (NSLOT - 1) * SLOTB) ? 0 : n0 + SLOTB, n2 = (n1 == (NSLOT - 1) * SLOTB) ? 0 : n1 + SLOTB;
        glds16(KB + nr * 256 + nko, (unsigned)__builtin_amdgcn_readfirstlane(kdst + n0)); glds16(VB + nr * 256 + nvo, (unsigned)__builtin_amdgcn_readfirstlane(vdst + n0));
        glds16(KB + (nr + 64) * 256 + nko, (unsigned)__builtin_amdgcn_readfirstlane(kdst + n1)); glds16(KB + (nr + 128) * 256 + nko, (unsigned)__builtin_amdgcn_readfirstlane(kdst + n2));
    }
    if (!oddnt) { STEP(pB0, pB1, pA0, pA1, NT - 1, false, false, false); RESC(); } else { pB0 = pA0; pB1 = pA1; }
    { float sacc = pB0[0] + pB0[1]; _Pragma("unroll") for (int r = 2; r < 16; ++r) sacc += pB0[r]; _Pragma("unroll") for (int r = 0; r < 16; ++r) sacc += pB1[r]; l_reg += sacc;
      pw0 = (u32x4){PKW(pB0, 0), PKW(pB0, 2), PKW(pB0, 4), PKW(pB0, 6)}; pw1 = (u32x4){PKW(pB0, 8), PKW(pB0, 10), PKW(pB0, 12), PKW(pB0, 14)}; pw2 = (u32x4){PKW(pB1, 0), PKW(pB1, 2), PKW(pB1, 4), PKW(pB1, 6)}; pw3 = (u32x4){PKW(pB1, 8), PKW(pB1, 10), PKW(pB1, 12), PKW(pB1, 14)};
      SBAR(); pv(o, vb0 + sl_last, PAF(0), PAF(1), PAF(2), PAF(3)); }
    if (has_next) {
        asm volatile("" ::: "memory");
        const bf16_t* nQw = Y + ((long)nb * SEQ + nn * 64 + qsub * 32) * 2048 + 1024 + (nkvh * 4 + (wid >> 1)) * 64;
#pragma unroll
        for (int d0 = 0; d0 < 4; ++d0) qr[d0] = *(const bf16x8*)(nQw + (long)r32 * 2048 + d0 * 16 + hi * 8);
    }
    { auto rr = __builtin_amdgcn_permlane32_swap(__float_as_uint(l_reg), __float_as_uint(l_reg), false, false); l_reg = __uint_as_float(rr[0]) + __uint_as_float(rr[1]); }
    l_reg += __builtin_amdgcn_exp2f(fminf(sink[head] * LOG2E - mhat, 80.f));
    if (hi == 0) wsf[32 + r32] = l_reg; asm volatile("s_waitcnt lgkmcnt(0)" ::: "memory");
    float rli[16];
#pragma unroll
    for (int r = 0; r < 16; ++r) rli[r] = __builtin_amdgcn_rcpf(wsf[32 + crow(r, hi)]);
    bf16_t* Ow = O + qrow0 * ldo + head * 64;
    { LAS bf16_t* stg = (LAS bf16_t*)(shm + LDS_OST) + wid * 2048;
#pragma unroll
      for (int r = 0; r < 16; ++r) { const int orow = crow(r, hi);
#pragma unroll
          for (int d0 = 0; d0 < 2; ++d0) stg[orow * 64 + d0 * 32 + r32] = (bf16_t)(pk2(o[d0][r] * rli[r], 0.f) & 0xffffu); }
      asm volatile("s_waitcnt lgkmcnt(0)" ::: "memory");
#pragma unroll
      for (int i = 0; i < 4; ++i) { const int row = i * 8 + (lane >> 3), ch = lane & 7; const u32x4 v = *(const LAS u32x4*)(stg + row * 64 + ch * 8); *(u32x4*)(Ow + (long)row * ldo + ch * 8) = v; } }
    asm volatile("s_waitcnt lgkmcnt(0)\n\ts_barrier" ::: "memory");
#undef TROW
#undef DMA_K
#undef DMA_V
#undef CMASK
#undef START
#undef RESC
#undef ROT
#undef PKW
#undef PAF
#undef VFR
#undef PIN
#undef MX3
#undef GAPA
#undef GAPB
#undef EX
#undef VRD
#undef KRD
#undef STEP
#undef ENDW
#undef PROLOG
}
#undef SBAR
#undef WAIT_BAR
}

#define XB_TMO      128
#define XB_XCNT(j)  (256  + 64 * (j))
#define XB_XSUB(j)  (1280 + 64 * (j))
#define XB_XGEN(j)  (2304 + 64 * (j))
#define XB_TOP      3328
#define XB_TOPGEN   3392
#define XCD_BAR_WORDS 3456
#define XB_SPIN_CAP (1u << 18)
__device__ __forceinline__ unsigned xb_ld(unsigned* p)              { return __hip_atomic_load(p, __ATOMIC_RELAXED, __HIP_MEMORY_SCOPE_AGENT); }
__device__ __forceinline__ unsigned xb_add(unsigned* p, unsigned v) { return __hip_atomic_fetch_add(p, v, __ATOMIC_RELAXED, __HIP_MEMORY_SCOPE_AGENT); }
__device__ __forceinline__ unsigned xb_xcc_id() { return (unsigned)__builtin_amdgcn_s_getreg((3 << 11) | 20) & 0xFu; }
#define XB_SPIN(cond, bar) do { unsigned _sp = 0; while (cond) { __builtin_amdgcn_s_sleep(1); \
    if ((++_sp & 255u) == 0u) { if (xb_ld(&(bar)[XB_TMO])) break; if (_sp > XB_SPIN_CAP) { atomicAdd(&(bar)[XB_TMO], 1u); break; } } } } while (0)
struct XcdBarrier { unsigned* bar; unsigned x; volatile LAS unsigned* st; };
__device__ __forceinline__ XcdBarrier xcd_barrier_post(unsigned* bar, volatile LAS unsigned* st) {
    XcdBarrier b; b.bar = bar; b.x = xb_xcc_id(); b.st = st;
    if (threadIdx.x == 0) (void)xb_add(&bar[XB_XCNT(b.x)], 1u);
    return b;
}
__device__ __forceinline__ void xcd_barrier_complete(unsigned* bar, unsigned x, unsigned& nloc, unsigned& nx) {
    const unsigned G = gridDim.x * gridDim.y * gridDim.z;
    unsigned sum, cnt, mine, sp = 0u;
    for (;;) {
        sum = 0u; cnt = 0u; mine = 0u;
#pragma unroll
        for (unsigned j = 0; j < 16; ++j) { const unsigned c = xb_ld(&bar[XB_XCNT(j)]); sum += c; cnt += (c > 0u) ? 1u : 0u; mine = (j == x) ? c : mine; }
        if (sum == G) break;
        __builtin_amdgcn_s_sleep(1);
        if ((++sp & 255u) == 0u) { if (xb_ld(&bar[XB_TMO])) break; if (sp > XB_SPIN_CAP) { atomicAdd(&bar[XB_TMO], 1u); break; } }
    }
    nloc = mine > 0u ? mine : 1u; nx = cnt > 0u ? cnt : 1u;
}
__device__ __forceinline__ void xcd_barrier(const XcdBarrier& b) {
    asm volatile("s_waitcnt vmcnt(0)" ::: "memory");
    __syncthreads();
    if (threadIdx.x == 0) {
        unsigned* bar = b.bar;
        __builtin_amdgcn_s_waitcnt(0);
        unsigned nloc = b.st[0], nx = b.st[1];
        if (nloc == 0u) { xcd_barrier_complete(bar, b.x, nloc, nx); b.st[0] = nloc; b.st[1] = nx; }
        const unsigned old = xb_add(&bar[XB_XSUB(b.x)], 1u);
        const unsigned gen = old / nloc;
        if (old + 1u == (gen + 1u) * nloc) {
            __builtin_amdgcn_fence(__ATOMIC_RELEASE, "agent");
            asm volatile("s_waitcnt vmcnt(0)" ::: "memory");
            const unsigned og = xb_add(&bar[XB_TOP], 1u);
            const unsigned tg = og / nx;
            if (og + 1u == (tg + 1u) * nx) xb_add(&bar[XB_TOPGEN], 1u);
            else XB_SPIN(xb_ld(&bar[XB_TOPGEN]) == tg, bar);
            __builtin_amdgcn_fence(__ATOMIC_ACQUIRE, "agent");
            xb_add(&bar[XB_XGEN(b.x)], 1u);
            asm volatile("s_waitcnt vmcnt(0)" ::: "memory");
        } else {
            XB_SPIN(xb_ld(&bar[XB_XGEN(b.x)]) == gen, bar);
            __builtin_amdgcn_fence(__ATOMIC_ACQUIRE, "agent");
            asm volatile("s_waitcnt vmcnt(0)" ::: "memory");
        }
    }
    __syncthreads();
}
constexpr int LDSCTL_OFF = LDS_BYTES - 256;
constexpr int CW_BAR = 4096, CW_CTX = 8192;

#ifndef PROBE_GMLP2
#define PROBE_GMLP2 0
#endif
#ifndef ATT_PIPE
#define ATT_PIPE 1
#endif
#ifndef ATT_THRL
#define ATT_THRL 8
#endif
#ifndef ONE_LAUNCH
#define ONE_LAUNCH 1
#endif
#ifndef FAST_MIX
#define FAST_MIX 1
#endif
#ifndef PROBE_SEQ
#define PROBE_SEQ 0, 1, 2, 3, 4, 5, 6, 7, 8, 9, 10, 11
#endif

enum { PH_PRO = 0, PH_HN, PH_IN, PH_MIX, PH_A, PH_O, PH_H2R, PH_WCONV, PH_TOPK, PH_GU, PH_D, PH_FIN, PH_COUNT };

__device__ __forceinline__ const float* kin_(int i) {
    const unsigned long long kp = (unsigned long long)__builtin_amdgcn_kernarg_segment_ptr(); unsigned long long r;
    asm volatile("s_load_dwordx2 %0, %1, %2\n\ts_waitcnt lgkmcnt(0)" : "=s"(r) : "s"(kp), "s"(i * 8));
    return (const float*)r;
}
#define KIN(i) kin_(i)
__global__ void __launch_bounds__(NTHREADS, 2) fwd(Args args) {
    extern __shared__ __attribute__((aligned(16))) unsigned char lds_raw[];
    LAS unsigned char* lds = (LAS unsigned char*)lds_raw;
    const int tid = threadIdx.x, lane = tid & 63, wave = __builtin_amdgcn_readfirstlane(tid >> 6);
    const int G = gridDim.x, bid = blockIdx.x;
    unsigned char* ws = args.ws;
    const int lo = args.ph_lo, hi = args.ph_hi;
#define IN(k) (lo <= (k) && (k) < hi)
#define MOD ((float*)(ws + WS_MOD))
#define ROPE ((f32x2*)(ws + WS_ROPE))
#define AFFT ((float*)(ws + WS_AFFT))
#define TOPI ((int*)(ws + WS_TOPI))
#define TOPW ((float*)(ws + WS_TOPW))
#define SLOT ((int*)(ws + WS_SLOT))
#define WSP ((bf16_t*)(ws + WS_WSP))
#define WIN ((bf16_t*)(ws + WS_WIN))
#define WAB ((bf16_t*)(ws + WS_WAB))
#define WO ((bf16_t*)(ws + WS_WO))
#define H ((bf16_t*)(ws + WS_H))
#define VA ((bf16_t*)(ws + WS_VA))
#define KB ((bf16_t*)(ws + WS_KB))
#define VB ((bf16_t*)(ws + WS_VB))
#define GT ((bf16_t*)(ws + WS_G))
#define Y ((bf16_t*)(ws + WS_Y))
#define TMP ((bf16_t*)(ws + WS_TMP))
#define MERGED ((bf16_t*)(ws + WS_MERGED))
#define WGU ((bf16_t*)(ws + WS_WGU))
#define WD ((bf16_t*)(ws + WS_WD))
#define H2 ((bf16_t*)(ws + WS_H2))
#define ACT ((bf16_t*)(ws + WS_ACT))
#define YB ((bf16_t*)(ws + WS_YB))
    const int gw = bid * NWAVES + wave, NGW = G * NWAVES;
    if (tid < 64) ((LAS unsigned*)(lds + LDSCTL_OFF))[tid] = 0u;
    __syncthreads();
    XcdBarrier bar; bar.bar = (unsigned*)(ws + WS_CTL) + CW_BAR; bar.x = 0; bar.st = nullptr;
    if (ONE_LAUNCH) bar = xcd_barrier_post((unsigned*)(ws + WS_CTL) + CW_BAR, (volatile LAS unsigned*)(lds + LDSCTL_OFF));
#define SEAM(k) do { if (ONE_LAUNCH && IN(k) && IN((k) + 1)) xcd_barrier(bar); } while (0)

    if (IN(PH_PRO)) {
        if (bid < 192) adaln_task(bid, KIN(I_C), KIN(I_CCTX), KIN(I_WADA), KIN(I_BADA), MOD, (LAS float*)lds, tid);
        else if (bid == 192) rope_table(ROPE, tid);
        __syncthreads();
        { const float* wspin = KIN(I_WSP); for (int i = bid * NTHREADS + tid; i < 8 * 128 * 128 / 4; i += G * NTHREADS) st4bf(WSP + 4 * i, *(const f32x4*)(wspin + 4 * i)); }
        LAS float* scr = (LAS float*)(lds + wave * 16384);
        constexpr int I_IN = 16 * 176, I_P = 16 * 32;
        for (int it = gw; it < I_IN + 3 * I_P; it += NGW) {
            int r = it;
            if (r < I_IN) { const int kb = r / 176, nb = r % 176, n0 = nb * 32; int drow = n0;
                if (n0 >= OFF_GATE) { const int gcol = n0 - OFF_GATE, isb = gcol >= 1024, ch = gcol & 1023; drow = OFF_GATE + 256 * (ch >> 7) + (ch & 127) + (isb ? 128 : 0); }
                transpose_item(KIN(I_WIN), INCOLS, kb * 64, n0, WIN + (size_t)drow * 1024 + kb * 64, 1024, scr, lane); continue; } r -= I_IN;
            if (r < I_P) { const int kb = r / 32, nb = r % 32; transpose_item(KIN(I_WPA), 1024, kb * 64, nb * 32, WAB + (size_t)(nb * 32) * 2048 + kb * 64, 2048, scr, lane); continue; } r -= I_P;
            if (r < I_P) { const int kb = r / 32, nb = r % 32; transpose_item(KIN(I_WPB), 1024, kb * 64, nb * 32, WAB + (size_t)(nb * 32) * 2048 + 1024 + kb * 64, 2048, scr, lane); continue; } r -= I_P;
            { const int kb = r / 32, nb = r % 32; transpose_item(KIN(I_WOUT), 1024, kb * 64, nb * 32, WO + (size_t)(nb * 32) * 1024 + kb * 64, 1024, scr, lane); }
        }
    }
    SEAM(PH_PRO);
    if (IN(PH_HN)) {
        const float* g1n = KIN(I_N1G); const float* xin = KIN(I_X); const float* cxin = KIN(I_CTX);
        const int HCH = (NROWS_H + NGW - 1) / NGW;
        f32x4 am[4], sm[4]; int mcur = -1;
        auto rowptr = [&](int row) -> const float* { return row < NTOK ? xin + (size_t)row * 1024 : cxin + (size_t)(row - NTOK) * 1024; };
        f32x4 vn[4];
        { const int r0_ = gw * HCH < NROWS_H ? gw * HCH : 0; const float* xr = rowptr(r0_);
#pragma unroll
          for (int h = 0; h < 2; ++h) { vn[2 * h] = *(const f32x4*)(xr + 512 * h + 8 * lane); vn[2 * h + 1] = *(const f32x4*)(xr + 512 * h + 8 * lane + 4); } }
        for (int kk = 0; kk < HCH; ++kk) {
            const int row = gw * HCH + kk; if (row >= NROWS_H) break;
            const int mrow = row < NTOK ? (row >> 12) : 8;
            f32x4 v[4]; float ss = 0.f;
#pragma unroll
            for (int j = 0; j < 4; ++j) { v[j] = vn[j]; ss += (v[j].x * v[j].x + v[j].y * v[j].y) + (v[j].z * v[j].z + v[j].w * v[j].w); }
            { const int rn = (kk + 1 < HCH && row + 1 < NROWS_H) ? row + 1 : row; const float* xr = rowptr(rn);
#pragma unroll
              for (int h = 0; h < 2; ++h) { vn[2 * h] = *(const f32x4*)(xr + 512 * h + 8 * lane); vn[2 * h + 1] = *(const f32x4*)(xr + 512 * h + 8 * lane + 4); } }
            if (mrow != mcur) { mcur = mrow; const float* sh = MOD + mrow * 6144; const float* sc = sh + 1024;
#pragma unroll
                for (int j = 0; j < 4; ++j) { const int col = 512 * (j >> 1) + 8 * lane + 4 * (j & 1); am[j] = *(const f32x4*)(g1n + col) * (1.f + *(const f32x4*)(sc + col)); sm[j] = *(const f32x4*)(sh + col); } }
            const float rstd = 1.0f / sqrtf(wave_sum(ss) * (1.f / 1024.f) + EPS);
#pragma unroll
            for (int h = 0; h < 2; ++h) st8bf(H + (size_t)row * 1024 + 512 * h + 8 * lane, (v[2 * h] * rstd) * am[2 * h] + sm[2 * h], (v[2 * h + 1] * rstd) * am[2 * h + 1] + sm[2 * h + 1]);
        }
    }
    SEAM(PH_HN);
    constexpr int WC_GU = 16 * 2 * 16 * 64, WC_D = 16 * 32 * 32;
    auto wconv = [&](const bool down, int j0, int j1) {
        LAS float* scr = (LAS float*)(lds + wave * 16384);
        int ln = lane; asm volatile("" : "+v"(ln));
        const int nit = down ? WC_D : WC_GU;
        const float* const wsrc0 = KIN(down ? I_WED : I_WEG); const float* const wsrc1 = KIN(down ? I_WED : I_WEU);
        auto item = [&](int it) -> TrItem {
            TrItem t;
            if (!down) {
                const int e = it >> 11, up = (it >> 10) & 1; int r = it & 1023;
                r = (r & ~0x44) | ((r >> 4) & 0x4) | ((r << 4) & 0x40);
                const int kb = r >> 6, nb = r & 63, n0 = nb * 32;
                const int drow = 256 * (n0 >> 7) + (n0 & 127) + (up ? 128 : 0);
                t.src = (up ? wsrc1 : wsrc0) + (size_t)e * 1024 * 2048 + (size_t)(kb * 64) * 2048 + n0; t.N = 2048;
                t.dst = WGU + (size_t)e * 4096 * 1024 + (size_t)drow * 1024 + kb * 64; t.ldt = 1024;
            } else {
                int r = it;
                r = (r & ~0x24) | ((r >> 3) & 0x4) | ((r << 3) & 0x20);
                const int e = r >> 10, kb = (r >> 5) & 31, nb = r & 31;
                t.src = wsrc0 + (size_t)e * 2048 * 1024 + (size_t)(kb * 64) * 1024 + nb * 32; t.N = 1024;
                t.dst = WD + (size_t)e * 1024 * 2048 + (size_t)(nb * 32) * 2048 + kb * 64; t.ldt = 2048;
            }
            return t;
        };
        int it = gw + NGW * j0; const int itend = min(gw + NGW * j1, nit);
        if (it < itend) {
            TrItem cur = item(it); f32x4 vc[8], vn[8];
            tr_load(cur, vc, ln);
            for (; it < itend; it += NGW) {
                const bool more = it + NGW < itend;
                TrItem nxt = cur;
                if (more) { nxt = item(it + NGW); tr_load(nxt, vn, ln); }
                tr_store(cur, vc, scr, ln);
                cur = nxt;
#pragma unroll
                for (int i = 0; i < 8; ++i) vc[i] = vn[i];
            }
        }
    };
    const int wc_pat = (bid >> 3) & 7;
    const int wc_rgu = (WC_GU + NGW - 1) / NGW, wc_rd = (WC_D + NGW - 1) / NGW;
    if (IN(PH_IN)) {
        Gemm g{H, WIN, 1024, 1024, 1024, 0, 30, nullptr}; StaticOrder S; S.init(NTOK, INCOLS, G, bid, G == 256 ? 0 : 16);
        EpiIn E{Y, VA, KB, VB, GT, KIN(I_BMG), ROPE, (f32x2*)(ws + WS_STATS)};
        const int q = wc_pat & 3; int ub = 0;
#pragma unroll 1
        for (int k = 0; k < 4; ++k) {
            const int bk = (k < 3) ? q + 4 * k : (1 << 20);
            if (bk > ub) { __syncthreads(); RangeSched<StaticOrder> R{S, ub, bk}; GEMM_PHASE<EpiIn, RangeSched<StaticOrder>, false>(lds, g, R, E); __syncthreads(); }
            ub = bk;
            if (k < 3) wconv(false, (wc_rgu * k + 1) / 3, (wc_rgu * (k + 1) + 1) / 3);
        }
    }
    SEAM(PH_IN);
    if (IN(PH_MIX) && FAST_MIX) {
        unsigned* ctxcnt = (unsigned*)(ws + WS_CTL) + CW_CTX;
        if (G == 256 && bid < 16) {
            Gemm g{H, WIN, 1024, 1024, 1024, 0, 30, nullptr}; OneUnit S{NTOK / 256 + (bid >> 1), 12 + (bid & 1)};
            EpiIn E{Y, VA, KB, VB, GT, KIN(I_BMG), ROPE, (f32x2*)(ws + WS_STATS)};
            GEMM_PHASE<EpiIn, OneUnit, false>(lds, g, S, E);
            asm volatile("s_waitcnt vmcnt(0)" ::: "memory");
            __syncthreads();
            if (tid == 0) { __builtin_amdgcn_fence(__ATOMIC_RELEASE, "agent"); asm volatile("s_waitcnt vmcnt(0)" ::: "memory"); xb_add(ctxcnt, 1u); }
        }
        if (!(args.flags & 8)) for (int task = bid; task < NB * 32; task += G) mix::gmlp_unit(task, Y, (args.flags & 2) ? TMP : Y, (args.flags & 2) ? 1024 : 2048, VA, WSP, (const f32x2*)(ws + WS_STATS), KIN(I_LNG), KIN(I_LNB), KIN(I_BSP), lds);
        if (tid == 0) {
            unsigned sp = 0; while (xb_ld(ctxcnt) < 16u) { __builtin_amdgcn_s_sleep(2); if (++sp > (1u << 22)) break; }
            __builtin_amdgcn_fence(__ATOMIC_ACQUIRE, "agent"); asm volatile("s_waitcnt vmcnt(0)" ::: "memory");
        }
        __syncthreads();
#if ATT_PIPE
        att2::bf16x8 att_qr[4]; int att_base = 0; bool att_primed = false;
        const int ucnt = (G != 256) ? 0 : (bid < 16) ? 6 : (bid < 48) ? 9 : 8;
        auto unit_of = [&](int i, int& b_, int& n_, int& kvh_) {
            int m;
            if (bid < 16) m = 6 * bid + i;
            else if (bid < 48) { const int j = bid - 16;
                if (i < 4) { const int q = j & 3; b_ = j >> 2; kvh_ = (q & 1) * 2 + (i & 1); n_ = ((q >> 1) ? 62 : 0) + (i >> 1); return; }
                m = 96 + 5 * j + (i - 4); }
            else m = 256 + 8 * (bid - 48) + i;
            b_ = m / 240; const int rem = m - 240 * b_; n_ = 2 + (rem >> 2); kvh_ = rem & 3;
        };
        if (!(args.flags & 1)) for (int i = 0; i < ucnt; ++i) {
            int cb, cn, ck, xb = 0, xn = 0, xk = 0; unit_of(i, cb, cn, ck); const bool more = i + 1 < ucnt; if (more) unit_of(i + 1, xb, xn, xk); int nbase_ = 0;
            att2::attn_unit<ATT_THRL>(cb, cn, ck, 0, att_base, att_primed, more, xb, xn, xk, 0, att_qr, nbase_,
                                      Y, (args.flags & 4) ? TMP : Y + 1024, (args.flags & 4) ? 1024 : 2048, KB, VB, KIN(I_SINK), lds);
            att_base = nbase_; att_primed = more;
        }
        if (G != 256 && !(args.flags & 1)) for (int u_ = bid; u_ < NB * 32 * 8; u_ += G) {
            int nbase_ = 0;
            att2::attn_unit<ATT_THRL>(u_ >> 8, (u_ >> 2) & 63, u_ & 3, 0, 0, false, false, 0, 0, 0, 0, att_qr, nbase_, Y, (args.flags & 4) ? TMP : Y + 1024, (args.flags & 4) ? 1024 : 2048, KB, VB, KIN(I_SINK), lds);
        }
#else
        if (!(args.flags & 1)) for (int task = bid; task < NB * 32 * 4; task += G) mix::attn_unit(task >> 7, (task >> 2) & 31, task & 3, Y, (args.flags & 4) ? TMP : Y + 1024, (args.flags & 4) ? 1024 : 2048, KB, VB, KIN(I_SINK), lds);
#endif
    }
    SEAM(PH_MIX);
    if (IN(PH_A)) {
        Gemm g{Y, WAB, 2048, 2048, 2048, 0, 30, nullptr, 1}; StaticOrder S; S.init(NTOK, 1024, G, bid, 0, 1);
        EpiAB E{MERGED, GT};
        GEMM_PHASE<EpiAB, StaticOrder, false, true>(lds, g, S, E);
    }
    SEAM(PH_A);
    if (IN(PH_O)) {
        Gemm g{MERGED, WO, 1024, 1024, 1024, 0, 30, nullptr, 1}; StaticOrder S; S.init(NTOK, 1024, G, bid);
        EpiO E{(bf16_t*)args.out, MOD};
        GEMM_PHASE<EpiO, StaticOrder, false>(lds, g, S, E);
    }
    SEAM(PH_O);
    if (IN(PH_H2R)) {
        LAS float* wT = (LAS float*)lds;
        { f32x4 wv[8];
#pragma unroll
          for (int k = 0; k < 8; ++k) wv[k] = *(const f32x4*)(KIN(I_WR) + 4 * (tid + NTHREADS * k));
#pragma unroll
          for (int k = 0; k < 8; ++k) { const int f = tid + NTHREADS * k, col = f >> 2, e0 = 4 * (f & 3); wT[e0 * 1024 + col] = wv[k].x; wT[(e0 + 1) * 1024 + col] = wv[k].y; wT[(e0 + 2) * 1024 + col] = wv[k].z; wT[(e0 + 3) * 1024 + col] = wv[k].w; } }
        __syncthreads();
        const float* g2n = KIN(I_N2G); const float* const xin2 = KIN(I_X);
        const int H2CH = (NTOK / 2 + NGW - 1) / NGW;
        const bool h32 = lane & 32, h16 = lane & 16, h8 = lane & 8, h4 = lane & 4;
        const int myexp = 8 * (lane >> 5) + 4 * ((lane >> 4) & 1) + 2 * ((lane >> 3) & 1) + ((lane >> 2) & 1);
        const bf16_t* D16 = (const bf16_t*)args.out;
        f32x4 vn[2][4], vm[2][4]; u32x2 dn[2][4], dm[2][4];
        { const int rp0 = (gw * H2CH < NTOK / 2) ? gw * H2CH : 0, rp1 = (H2CH > 1 && rp0 + 1 < NTOK / 2) ? rp0 + 1 : rp0;
#pragma unroll
          for (int q = 0; q < 2; ++q)
#pragma unroll
            for (int j = 0; j < 4; ++j) { const size_t r_ = (size_t)(2 * (NTOK / 2 - 1 - rp0) + q), s_ = (size_t)(2 * (NTOK / 2 - 1 - rp1) + q);
                vn[q][j] = *(const f32x4*)(xin2 + r_ * 1024 + 4 * lane + 256 * j); dn[q][j] = *(const u32x2*)(D16 + r_ * 2048 + 1024 + 4 * lane + 256 * j);
                vm[q][j] = *(const f32x4*)(xin2 + s_ * 1024 + 4 * lane + 256 * j); dm[q][j] = *(const u32x2*)(D16 + s_ * 2048 + 1024 + 4 * lane + 256 * j); } }
        f32x4 amod[4], smod[4]; int bcur = -1;
        for (int kk = 0; kk < H2CH; ++kk) {
            const int rp = gw * H2CH + kk; if (rp >= NTOK / 2) break;
            const int row0 = 2 * (NTOK / 2 - 1 - rp), b = row0 >> 12;
            if (b != bcur) { bcur = b; const float* sh = MOD + b * 6144 + 3072; const float* sc = sh + 1024;
#pragma unroll
                for (int j = 0; j < 4; ++j) { const int col = 4 * lane + 256 * j; amod[j] = *(const f32x4*)(g2n + col) * (1.f + *(const f32x4*)(sc + col)); smod[j] = *(const f32x4*)(sh + col); } }
            f32x4 v[2][4]; float ss[2] = {0.f, 0.f};
#pragma unroll
            for (int q = 0; q < 2; ++q)
#pragma unroll
                for (int j = 0; j < 4; ++j) { const u32x2 dw = dn[q][j]; v[q][j] = vn[q][j] + (f32x4){bf2f(dw.x & 0xffffu), bf2f(dw.x >> 16), bf2f(dw.y & 0xffffu), bf2f(dw.y >> 16)}; ss[q] += (v[q][j].x * v[q][j].x + v[q][j].y * v[q][j].y) + (v[q][j].z * v[q][j].z + v[q][j].w * v[q][j].w); }
            { const int rn = (kk + 2 < H2CH && rp + 2 < NTOK / 2) ? rp + 2 : rp;
#pragma unroll
              for (int q = 0; q < 2; ++q)
#pragma unroll
                  for (int j = 0; j < 4; ++j) { const size_t r_ = (size_t)(2 * (NTOK / 2 - 1 - rn) + q); vn[q][j] = vm[q][j]; dn[q][j] = dm[q][j];
                      vm[q][j] = *(const f32x4*)(xin2 + r_ * 1024 + 4 * lane + 256 * j); dm[q][j] = *(const u32x2*)(D16 + r_ * 2048 + 1024 + 4 * lane + 256 * j); } }
            float rstd[2];
#pragma unroll
            for (int q = 0; q < 2; ++q) rstd[q] = 1.0f / sqrtf(wave_sum(ss[q]) * (1.f / 1024.f) + EPS);
            float lg[2][16];
#pragma unroll
            for (int q = 0; q < 2; ++q)
#pragma unroll
                for (int e = 0; e < 16; ++e) lg[q][e] = 0.f;
            f32x4 wb[2][4];
#pragma unroll
            for (int e = 0; e < 4; ++e) wb[0][e] = *(const LAS f32x4*)(wT + e * 1024 + 4 * lane);
            f32x4 h[2];
#pragma unroll
            for (int g = 0; g < 16; ++g) {
                const int j = g >> 2, eg = g & 3, col = 4 * lane + 256 * j;
                if (g + 1 < 16) {
                    const int jn = (g + 1) >> 2, en = (g + 1) & 3;
#pragma unroll
                    for (int e = 0; e < 4; ++e) wb[(g + 1) & 1][e] = *(const LAS f32x4*)(wT + (4 * en + e) * 1024 + 4 * lane + 256 * jn);
                }
                if (eg == 0) {
#pragma unroll
                    for (int q = 0; q < 2; ++q) { h[q] = (v[q][j] * rstd[q]) * amod[j] + smod[j]; st4bf(H2 + (size_t)(row0 + q) * 1024 + col, h[q]); }
                }
#pragma unroll
                for (int e = 0; e < 4; ++e) {
                    const f32x4 w = wb[g & 1][e];
#pragma unroll
                    for (int q = 0; q < 2; ++q) lg[q][4 * eg + e] += (h[q].x * w.x + h[q].y * w.y) + (h[q].z * w.z + h[q].w * w.w);
                    asm volatile("" : "+v"(lg[0][4 * eg + e]), "+v"(lg[1][4 * eg + e]));
                }
                asm volatile("" ::: "memory");
            }
#pragma unroll
            for (int q = 0; q < 2; ++q) {
                float a8[8], a4[4], a2[2], a1;
#pragma unroll
                for (int i = 0; i < 8; ++i) { const float send = h32 ? lg[q][i] : lg[q][i + 8], keep = h32 ? lg[q][i + 8] : lg[q][i]; a8[i] = keep + xchg32(send); }
#pragma unroll
                for (int i = 0; i < 4; ++i) { const float send = h16 ? a8[i] : a8[i + 4], keep = h16 ? a8[i + 4] : a8[i]; a4[i] = keep + xchg16(send); }
#pragma unroll
                for (int i = 0; i < 2; ++i) { const float send = h8 ? a4[i] : a4[i + 2], keep = h8 ? a4[i + 2] : a4[i]; a2[i] = keep + dpp_f<0x140>(send); }
                { const float send = h4 ? a2[0] : a2[1], keep = h4 ? a2[1] : a2[0]; a1 = keep + dpp_f<0x141>(send); }
                a1 += dpp_f<0x4E>(a1); a1 += dpp_f<0xB1>(a1);
                float mx = a1;
                mx = fmaxf(mx, dpp_f<0x141>(mx)); mx = fmaxf(mx, dpp_f<0x140>(mx)); mx = fmaxf(mx, xchg16(mx)); mx = fmaxf(mx, xchg32(mx));
                const float p = __expf(a1 - mx); float den = p;
                den += dpp_f<0x141>(den); den += dpp_f<0x140>(den); den += xchg16(den); den += xchg32(den);
                if ((lane & 3) == 0) AFFT[(size_t)(b * 16 + myexp) * SEQ + ((row0 + q) & (SEQ - 1))] = p / den;
            }
        }
    }
    if (IN(PH_WCONV)) { __syncthreads(); }
    SEAM(PH_WCONV);
    if (IN(PH_TOPK)) {
        LAS int* wsum = (LAS int*)lds;
        for (int task = bid; task < NE * NB; task += G) {
            const int e = task >> 3, b = task & 7;
            const float* aff = AFFT + (size_t)(b * 16 + e) * SEQ;
            unsigned k[8];
            { const u32x4 a0 = *(const u32x4*)(aff + 8 * tid), a1 = *(const u32x4*)(aff + 8 * tid + 4); k[0] = a0.x; k[1] = a0.y; k[2] = a0.z; k[3] = a0.w; k[4] = a1.x; k[5] = a1.y; k[6] = a1.z; k[7] = a1.w; }
            unsigned T = 0u; int it = 0;
            __syncthreads();
            for (int bit = 30; bit >= 0; --bit, ++it) {
                const unsigned cand = T | (1u << bit); int c = 0;
#pragma unroll
                for (int j = 0; j < 8; ++j) c += __builtin_popcountll(__ballot(k[j] >= cand));
                if (lane == 0) wsum[(it & 1) * 8 + wave] = c;
                __syncthreads();
                int tot = 0;
#pragma unroll
                for (int w = 0; w < 8; ++w) tot += wsum[(it & 1) * 8 + w];
                if (tot >= CAP) T = cand;
            }
            int cg = 0, ce = 0;
#pragma unroll
            for (int j = 0; j < 8; ++j) { cg += (k[j] > T) ? 1 : 0; ce += (k[j] == T) ? 1 : 0; }
            LAS int* sc1 = wsum + 16; LAS int* sc2 = wsum + 32;
            int ie = ce, ig = cg;
#pragma unroll
            for (int o = 1; o < 64; o <<= 1) { const int te = __shfl_up(ie, o), tg = __shfl_up(ig, o); if (lane >= o) { ie += te; ig += tg; } }
            __syncthreads();
            if (lane == 63) { sc1[wave] = ie; sc2[wave] = ig; }
            __syncthreads();
            int ebase = ie - ce, totg = 0;
#pragma unroll
            for (int w = 0; w < 8; ++w) { if (w < wave) ebase += sc1[w]; totg += sc2[w]; }
            const int need = CAP - totg;
            int sel[8], cs = 0, er = ebase;
#pragma unroll
            for (int j = 0; j < 8; ++j) { const bool eq = (k[j] == T); sel[j] = (k[j] > T) || (eq && er < need); er += eq ? 1 : 0; cs += sel[j]; }
            int is = cs;
#pragma unroll
            for (int o = 1; o < 64; o <<= 1) { const int ts = __shfl_up(is, o); if (lane >= o) is += ts; }
            __syncthreads();
            if (lane == 63) sc1[wave] = is;
            __syncthreads();
            int sbase = is - cs;
#pragma unroll
            for (int w = 0; w < 8; ++w) if (w < wave) sbase += sc1[w];
#pragma unroll
            for (int j = 0; j < 8; ++j) {
                const int t = 8 * tid + j; int slot = -1;
                if (sel[j]) { slot = sbase; ++sbase; const int prow = (e * 8 + b) * CAP + slot; TOPI[prow] = t; TOPW[prow] = __uint_as_float(k[j]); }
                SLOT[((size_t)b * SEQ + t) * 16 + e] = slot;
            }
            __syncthreads();
        }
    }
    SEAM(PH_TOPK);
    if (IN(PH_GU)) {
        Gemm g{H2, WGU, 1024, 1024, 1024, (size_t)4096 * 1024, 4, TOPI}; StaticOrder S; S.init(NPAIR, 4096, G, bid);
        EpiGU E{ACT};
        int ub = 0;
#pragma unroll 1
        for (int k = 0; k < 2; ++k) {
            const int bk = k ? (1 << 20) : 2 * wc_pat + 1;
            __syncthreads(); { RangeSched<StaticOrder> R{S, ub, bk}; GEMM_PHASE<EpiGU, RangeSched<StaticOrder>, true, false, true>(lds, g, R, E); } __syncthreads();
            ub = bk;
            if (k == 0) wconv(true, 0, wc_rd);
        }
    }
    SEAM(PH_GU);
    if (IN(PH_D)) {
        Gemm g{ACT, WD, 2048, 2048, 2048, (size_t)1024 * 2048, 4, nullptr, 1}; StaticOrder S; S.init(NPAIR, 1024, G, bid, 0, 1);
        EpiD E{YB, TOPW};
        GEMM_PHASE<EpiD, StaticOrder, false>(lds, g, S, E);
    }
    SEAM(PH_D);
    if (IN(PH_FIN)) {
        const float* fg = KIN(I_FING); const float* const xin3 = KIN(I_X);
        const bf16_t* ZROW = (const bf16_t*)(ws + WS_CTL + 512 * 1024);
        int sln[2] = {-1, -1};
        const int FCH = (NTOK / 2 + NGW - 1) / NGW;
        if (gw * FCH < NTOK / 2 && lane < 16) { sln[0] = SLOT[(size_t)(2 * gw * FCH) * 16 + lane]; sln[1] = SLOT[(size_t)(2 * gw * FCH + 1) * 16 + lane]; }
        f32x4 g2v[4], fgv[4]; int bcur = -1;
#pragma unroll
        for (int h = 0; h < 2; ++h) { fgv[2 * h] = *(const f32x4*)(fg + 512 * h + 8 * lane); fgv[2 * h + 1] = *(const f32x4*)(fg + 512 * h + 8 * lane + 4); }
        for (int kk = 0; kk < FCH; ++kk) {
            const int rp = gw * FCH + kk; if (rp >= NTOK / 2) break;
            const int row0 = 2 * rp, b = row0 >> 12;
            const int sl[2] = {sln[0], sln[1]};
            { const int rn = rp + 1; if (kk + 1 < FCH && rn < NTOK / 2 && lane < 16) { sln[0] = SLOT[(size_t)(2 * rn) * 16 + lane]; sln[1] = SLOT[(size_t)(2 * rn + 1) * 16 + lane]; } }
            if (b != bcur) { bcur = b; const float* g2 = MOD + b * 6144 + 5120;
#pragma unroll
                for (int h = 0; h < 2; ++h) { g2v[2 * h] = *(const f32x4*)(g2 + 512 * h + 8 * lane); g2v[2 * h + 1] = *(const f32x4*)(g2 + 512 * h + 8 * lane + 4); } }
            f32x4 xv[2][4], acc[2][4];
#pragma unroll
            for (int q = 0; q < 2; ++q)
#pragma unroll
                for (int h = 0; h < 2; ++h) { const float* xp = xin3 + (size_t)(row0 + q) * 1024 + 512 * h + 8 * lane; f32x4 d0_, d1_; ld8bf((const bf16_t*)args.out + (size_t)(row0 + q) * 2048 + 1024 + 512 * h + 8 * lane, d0_, d1_);
                    xv[q][2 * h] = *(const f32x4*)xp + d0_; xv[q][2 * h + 1] = *(const f32x4*)(xp + 4) + d1_;
                    acc[q][2 * h] = (f32x4){0.f, 0.f, 0.f, 0.f}; acc[q][2 * h + 1] = (f32x4){0.f, 0.f, 0.f, 0.f}; }
#pragma unroll
            for (int q = 0; q < 2; ++q) {
                unsigned long long mask = __ballot(sl[q] >= 0);
                for (;;) {
                    const bf16_t* yr[4];
#pragma unroll
                    for (int k = 0; k < 4; ++k) {
                        if (mask) { const int ex = __builtin_ctzll(mask); mask &= mask - 1; const int s = __builtin_amdgcn_readlane(sl[q], ex); yr[k] = YB + (size_t)((ex * 8 + b) * CAP + s) * 1024; }
                        else yr[k] = ZROW;
                    }
                    u32x4 y[4][2];
#pragma unroll
                    for (int k = 0; k < 4; ++k)
#pragma unroll
                        for (int h = 0; h < 2; ++h) y[k][h] = *(const u32x4*)(yr[k] + 512 * h + 8 * lane);
#pragma unroll
                    for (int k = 0; k < 4; ++k)
#pragma unroll
                        for (int h = 0; h < 2; ++h) { const u32x4 w = y[k][h];
                            acc[q][2 * h] += (f32x4){bf2f(w.x & 0xffffu), bf2f(w.x >> 16), bf2f(w.y & 0xffffu), bf2f(w.y >> 16)};
                            acc[q][2 * h + 1] += (f32x4){bf2f(w.z & 0xffffu), bf2f(w.z >> 16), bf2f(w.w & 0xffffu), bf2f(w.w >> 16)}; }
                    if (!mask) break;
                }
            }
#pragma unroll
            for (int q = 0; q < 2; ++q) {
                float ss = 0.f;
#pragma unroll
                for (int h = 0; h < 2; ++h)
#pragma unroll
                    for (int u4 = 0; u4 < 2; ++u4) { const int col = 512 * h + 8 * lane + 4 * u4; f32x4& v = xv[q][2 * h + u4]; v = v + g2v[2 * h + u4] * acc[q][2 * h + u4]; ss += (v.x * v.x + v.y * v.y) + (v.z * v.z + v.w * v.w); }
                const float rstd = 1.0f / sqrtf(wave_sum(ss) * (1.f / 1024.f) + EPS);
#pragma unroll
                for (int h = 0; h < 2; ++h)
#pragma unroll
                    for (int u4 = 0; u4 < 2; ++u4) { const int col = 512 * h + 8 * lane + 4 * u4; *(f32x4*)(args.out + (size_t)(row0 + q) * 1024 + col) = xv[q][2 * h + u4] * rstd * fgv[2 * h + u4]; }
            }
        }
    }
#undef IN
}

extern "C" void kernel_launch(void* const* d_in, const int* in_sizes, int n_in, void* d_out, int out_size, void* d_ws, size_t ws_size, hipStream_t stream) {
    static int grid = 0;
    if (grid == 0) {
        if (n_in != 23 || in_sizes[0] != NTOK * DM || out_size != NTOK * DM || ws_size < WS_END) {
            fprintf(stderr, "kernel_launch: unexpected problem (n_in %d, in0 %d, out %d, ws %zu < %zu?)\n", n_in, n_in > 0 ? in_sizes[0] : -1, out_size, ws_size, (size_t)WS_END); grid = -1; return; }
        if (hipFuncSetAttribute((const void*)fwd, hipFuncAttributeMaxDynamicSharedMemorySize, LDS_BYTES) != hipSuccess) { fprintf(stderr, "kernel_launch: hipFuncSetAttribute failed\n"); grid = -1; return; }
        int dev = 0, cus = 0;
        if (hipGetDevice(&dev) != hipSuccess || hipDeviceGetAttribute(&cus, hipDeviceAttributeMultiprocessorCount, dev) != hipSuccess) { grid = -1; return; }
        grid = cus;
    }
    if (grid < 0) return;
    (void)hipMemsetAsync((char*)d_ws + WS_CTL, 0, 1 * MiB, stream);
    Args a{};
    for (int i = 0; i < 23; ++i) a.in[i] = (const float*)d_in[i];
    a.out = (float*)d_out; a.ws = (unsigned char*)d_ws;
    if (ONE_LAUNCH) {
        a.ph_lo = 0; a.ph_hi = PH_COUNT;
        hipLaunchKernelGGL(fwd, dim3(grid), dim3(NTHREADS), LDS_BYTES, stream, a);
    } else {
        static const int seq[] = {PROBE_SEQ};
        for (unsigned i = 0; i < sizeof(seq) / sizeof(seq[0]); ++i) {
            a.ph_lo = seq[i] % 100; a.ph_hi = seq[i] % 100 + 1; a.flags = seq[i] / 100;
            hipLaunchKernelGGL(fwd, dim3(grid), dim3(NTHREADS), LDS_BYTES, stream, a);
        }
    }
}
```
